# Optimizing an MI355X kernel written in HIP

```python
import math
import jax, jax.numpy as jnp
from jax import lax
import numpy as np

D_MODEL = 2048
BATCH = 1
SEQ = 8192
DEPTH = 1

D_MIX = D_MODEL
D_S5 = D_MIX // 2
D_RG = D_MIX - D_S5
S5_GROUP = 16
S5_GROUPS = D_S5 // S5_GROUP
S5_STATE = 64
RG_HEADS = 16
RG_HEAD_DIM = D_RG // RG_HEADS
CONV_W = 4
RG_C = 8.0
D_IN = D_S5 + 2 * D_RG
D_FF = 4 * D_MODEL
PLE_DIM = 256
N_DIR = 2
LN_EPS = 1e-5
DN_ALPHA = (2.0 * DEPTH) ** 0.25
DN_BETA = (8.0 * DEPTH) ** -0.25

kernel_name = "hybrid_s5_rglru_postnorm_encoder"


def _layer_norm(x, g, b):
    xf = x.astype(jnp.float32)
    mu = jnp.mean(xf, axis=-1, keepdims=True)
    var = jnp.mean(jnp.square(xf - mu), axis=-1, keepdims=True)
    y = (xf - mu) * lax.rsqrt(var + LN_EPS) * g.astype(jnp.float32) + b.astype(jnp.float32)
    return y.astype(x.dtype)


def _rms_norm(x, g):
    xf = x.astype(jnp.float32)
    y = xf * lax.rsqrt(jnp.mean(jnp.square(xf), axis=-1, keepdims=True) + LN_EPS)
    return y * g.astype(jnp.float32)


def _linear_scan(a, b, reverse):
    def combine(left, right):
        a_l, b_l = left
        a_r, b_r = right
        return a_r * a_l, a_r * b_l + b_r
    _, h = lax.associative_scan(combine, (a, b), axis=1, reverse=reverse)
    return h


def _s5_mixer(u, lam_re, lam_im, log_step, b_re, b_im, c_re, c_im, d, glu_w, glu_b):
    bsz, seq, _ = u.shape
    f32 = jnp.float32
    uf = u.astype(f32).reshape(bsz, seq, S5_GROUPS, S5_GROUP)
    uc = uf.astype(jnp.complex64)
    lam = lax.complex(jnp.minimum(lam_re.astype(f32), -1e-4), lam_im.astype(f32))
    step = jnp.exp(log_step.astype(f32))[..., None]
    lam_bar = jnp.exp(lam * step)
    b_mat = lax.complex(b_re.astype(f32), b_im.astype(f32))
    b_bar = ((lam_bar - 1.0) / lam)[..., None] * b_mat
    c_mat = lax.complex(c_re.astype(f32), c_im.astype(f32))

    def direction(n, rev):
        bu = jnp.einsum('gpk,blgk->blgp', b_bar[n], uc)
        a = jnp.broadcast_to(lam_bar[n], bu.shape)
        hs = _linear_scan(a, bu, rev)
        return jnp.einsum('gkp,blgp->blgk', c_mat[n], hs).real

    y = direction(0, False) + direction(1, True) + d.astype(f32) * uf
    y = jax.nn.gelu(y.reshape(bsz, seq, D_S5))
    return y * jax.nn.sigmoid(y @ glu_w.astype(f32) + glu_b.astype(f32))


def _rglru_mixer(xb, zb, conv_w, conv_b, wa, ba, wx, bx, lam):
    bsz, seq, _ = xb.shape
    f32 = jnp.float32
    pad_l = CONV_W // 2
    xc = lax.conv_general_dilated(
        xb.astype(f32), conv_w.astype(f32)[:, None, :], window_strides=(1,),
        padding=[(pad_l, CONV_W - 1 - pad_l)], dimension_numbers=('NWC', 'WIO', 'NWC'),
        feature_group_count=D_RG) + conv_b.astype(f32)
    xh = xc.reshape(bsz, seq, RG_HEADS, RG_HEAD_DIM)

    def direction(n, rev):
        r = jax.nn.sigmoid(jnp.einsum('blhi,hij->blhj', xh, wa[n].astype(f32)) + ba[n].astype(f32))
        ig = jax.nn.sigmoid(jnp.einsum('blhi,hij->blhj', xh, wx[n].astype(f32)) + bx[n].astype(f32))
        log_a = -RG_C * r * jax.nn.softplus(-lam[n].astype(f32)).reshape(RG_HEADS, RG_HEAD_DIM)
        a = jnp.exp(log_a)
        bterm = jnp.sqrt(-jnp.expm1(2.0 * log_a)) * (ig * xh)
        return _linear_scan(a, bterm, rev)

    y = (direction(0, False) + direction(1, True)).reshape(bsz, seq, D_RG)
    return y * jax.nn.gelu(zb.astype(f32))


def setup_inputs(seed: int = 0) -> dict:
    key = jax.random.key(seed)
    k = jax.random.split(key, 40)
    f32 = jnp.float32

    def nrm(kk, shape, scale):
        return jax.random.normal(kk, shape, f32) * scale

    G, P, K = S5_GROUPS, S5_STATE, S5_GROUP
    H, hd = RG_HEADS, RG_HEAD_DIM
    u_dec = jax.random.uniform(k[22], (DEPTH, N_DIR, D_RG), f32, minval=0.9, maxval=0.999)
    s_dec = u_dec ** (1.0 / RG_C)
    return {
        "x": nrm(k[0], (BATCH, SEQ, D_MODEL), 1.0),
        "p": nrm(k[1], (DEPTH, BATCH, SEQ, PLE_DIM), 1.0),
        "ln_in_g": 1.0 + nrm(k[2], (D_MODEL,), 0.02),
        "ln_in_b": nrm(k[3], (D_MODEL,), 0.02),
        "w_in": nrm(k[4], (DEPTH, D_MODEL, D_IN), D_MODEL ** -0.5),
        "b_in": nrm(k[5], (DEPTH, D_IN), 0.02),
        "s5_lambda_re": -0.5 + nrm(k[6], (DEPTH, N_DIR, G, P), 0.01),
        "s5_lambda_im": math.pi * jnp.arange(P, dtype=f32) + nrm(k[7], (DEPTH, N_DIR, G, P), 0.01),
        "s5_log_step": jax.random.uniform(k[8], (DEPTH, N_DIR, G), f32,
                                          minval=math.log(1e-3), maxval=math.log(1e-1)),
        "s5_b_re": nrm(k[9], (DEPTH, N_DIR, G, P, K), (2.0 * K) ** -0.5),
        "s5_b_im": nrm(k[10], (DEPTH, N_DIR, G, P, K), (2.0 * K) ** -0.5),
        "s5_c_re": nrm(k[11], (DEPTH, N_DIR, G, K, P), (2.0 * P) ** -0.5),
        "s5_c_im": nrm(k[12], (DEPTH, N_DIR, G, K, P), (2.0 * P) ** -0.5),
        "s5_d": nrm(k[13], (DEPTH, G, K), 1.0),
        "s5_glu_w": nrm(k[14], (DEPTH, D_S5, D_S5), D_S5 ** -0.5),
        "s5_glu_b": nrm(k[15], (DEPTH, D_S5), 0.02),
        "rg_conv_w": nrm(k[16], (DEPTH, CONV_W, D_RG), CONV_W ** -0.5),
        "rg_conv_b": nrm(k[17], (DEPTH, D_RG), 0.02),
        "rg_wa": nrm(k[18], (DEPTH, N_DIR, H, hd, hd), hd ** -0.5),
        "rg_ba": nrm(k[19], (DEPTH, N_DIR, H, hd), 0.02),
        "rg_wx": nrm(k[20], (DEPTH, N_DIR, H, hd, hd), hd ** -0.5),
        "rg_bx": nrm(k[21], (DEPTH, N_DIR, H, hd), 0.02),
        "rg_lambda": jnp.log(s_dec) - jnp.log1p(-s_dec),
        "gn_s5": 1.0 + nrm(k[23], (DEPTH, D_S5), 0.02),
        "gn_rg": 1.0 + nrm(k[24], (DEPTH, D_RG), 0.02),
        "w_out": nrm(k[25], (DEPTH, D_MIX, D_MODEL), D_MIX ** -0.5 * DN_BETA),
        "b_out": nrm(k[26], (DEPTH, D_MODEL), 0.02),
        "ln1_g": 1.0 + nrm(k[27], (DEPTH, D_MODEL), 0.02),
        "ln1_b": nrm(k[28], (DEPTH, D_MODEL), 0.02),
        "w_ff1": nrm(k[29], (DEPTH, D_MODEL, D_FF), D_MODEL ** -0.5),
        "b_ff1": nrm(k[30], (DEPTH, D_FF), 0.02),
        "w_ff2": nrm(k[31], (DEPTH, D_FF, D_MODEL), D_FF ** -0.5 * DN_BETA),
        "b_ff2": nrm(k[32], (DEPTH, D_MODEL), 0.02),
        "ple_w": nrm(k[33], (DEPTH, PLE_DIM, D_MODEL), PLE_DIM ** -0.5 * DN_BETA),
        "ple_gate_w": nrm(k[34], (DEPTH, D_MODEL, D_MODEL), D_MODEL ** -0.5),
        "ple_gate_b": nrm(k[35], (DEPTH, D_MODEL), 0.02),
        "ln2_g": 1.0 + nrm(k[36], (DEPTH, D_MODEL), 0.02),
        "ln2_b": nrm(k[37], (DEPTH, D_MODEL), 0.02),
    }


def reference(x, p, ln_in_g, ln_in_b, w_in, b_in, s5_lambda_re, s5_lambda_im, s5_log_step,
              s5_b_re, s5_b_im, s5_c_re, s5_c_im, s5_d, s5_glu_w, s5_glu_b,
              rg_conv_w, rg_conv_b, rg_wa, rg_ba, rg_wx, rg_bx, rg_lambda,
              gn_s5, gn_rg, w_out, b_out, ln1_g, ln1_b,
              w_ff1, b_ff1, w_ff2, b_ff2, ple_w, ple_gate_w, ple_gate_b, ln2_g, ln2_b):
    dtype = x.dtype
    h = _layer_norm(x, ln_in_g, ln_in_b)
    for i in range(DEPTH):
        proj = h @ w_in[i] + b_in[i]
        u_s5 = proj[..., :D_S5]
        x_rg = proj[..., D_S5:D_S5 + D_RG]
        z_rg = proj[..., D_S5 + D_RG:]
        y_s5 = _s5_mixer(u_s5, s5_lambda_re[i], s5_lambda_im[i], s5_log_step[i],
                         s5_b_re[i], s5_b_im[i], s5_c_re[i], s5_c_im[i], s5_d[i],
                         s5_glu_w[i], s5_glu_b[i])
        y_rg = _rglru_mixer(x_rg, z_rg, rg_conv_w[i], rg_conv_b[i], rg_wa[i], rg_ba[i],
                            rg_wx[i], rg_bx[i], rg_lambda[i])
        y_cat = jnp.concatenate([_rms_norm(y_s5, gn_s5[i]), _rms_norm(y_rg, gn_rg[i])],
                                axis=-1).astype(dtype)
        mix = y_cat @ w_out[i] + b_out[i]
        h = _layer_norm(DN_ALPHA * h + mix, ln1_g[i], ln1_b[i])
        ff = jnp.square(jax.nn.relu(h @ w_ff1[i] + b_ff1[i])) @ w_ff2[i] + b_ff2[i]
        ple = jax.nn.sigmoid(h @ ple_gate_w[i] + ple_gate_b[i]) * (p[i] @ ple_w[i])
        h = _layer_norm(DN_ALPHA * h + ff + ple, ln2_g[i], ln2_b[i])
    return h.astype(dtype)
```

```cpp
#include <hip/hip_runtime.h>
#include <hip/hip_cooperative_groups.h>
#include <cstdio>
#include <cstdint>
namespace cg = cooperative_groups;

#ifndef PER_PHASE_LAUNCH
#define PER_PHASE_LAUNCH 0
#endif

#define LAS __attribute__((address_space(3)))
typedef unsigned short bf16_t;
typedef short bf16x8 __attribute__((ext_vector_type(8)));
typedef float f32x4 __attribute__((ext_vector_type(4)));
typedef float f32x2 __attribute__((ext_vector_type(2)));
typedef unsigned u32x4 __attribute__((ext_vector_type(4)));
typedef unsigned u32x2 __attribute__((ext_vector_type(2)));

constexpr int SEQ = 8192, DM = 2048, DIN = 3072, DS5 = 1024, DRG = 1024, NG = 64, NP = 64, NK = 16, NH = 16, HD = 64, DFF = 8192, PLE = 256;
constexpr int TC = 32, NCH = SEQ / TC;
constexpr float LN_EPS = 1e-5f, DN_ALPHA = 1.18920711500272f;
constexpr int NPHASE = 12;

constexpr size_t MiB = (size_t)1 << 20;
constexpr size_t WS_FF2T = 0, WS_HB = 32 * MiB, WS_FF1T = 64 * MiB, WS_PLEGT = 96 * MiB, WS_PLEWT = 104 * MiB, WS_PB = 105 * MiB, WS_WOUTT = 109 * MiB,
    WS_V2 = 64 * MiB, WS_G0 = 0, WS_G1 = 64 * MiB,
    WS_WG = 128 * MiB, WS_WC = 176 * MiB, WS_RGW = 192 * MiB, WS_GLUT = 194 * MiB, WS_XR = 196 * MiB, WS_YINTRA = 213 * MiB, WS_S = 229 * MiB, WS_HPREV = 245 * MiB, WS_WINT = 229 * MiB,
    WS_YS5G = 128 * MiB, WS_YCAT = 144 * MiB, WS_T = 128 * MiB,
    WS_AGG = 256 * MiB, WS_CARRY = 258 * MiB, WS_SUMSQ = 259 * MiB, WS_RGBIAS = 259 * MiB + 64 * 1024, WS_SP = WS_RGBIAS + 16 * 1024, WS_CTR = WS_SP + 8 * 1024, WS_END = 260 * MiB;
constexpr size_t DO_YPRE = 0, DO_Z = 32 * MiB, DO_U = 48 * MiB, DO_SG = 0, DO_PW = 32 * MiB;
constexpr int LDS_BYTES = 144 * 1024;

typedef __bf16 bf16x2_t __attribute__((ext_vector_type(2)));
__device__ __forceinline__ unsigned cvt_pk_bf16(float lo, float hi) { const f32x2 v = {lo, hi}; const bf16x2_t b = __builtin_convertvector(v, bf16x2_t); return __builtin_bit_cast(unsigned, b); }
__device__ __forceinline__ float bf_lo(unsigned w) { return __uint_as_float(w << 16); }
__device__ __forceinline__ float bf_hi(unsigned w) { return __uint_as_float(w & 0xffff0000u); }
__device__ __forceinline__ f32x4 bf4(u32x2 w) { return (f32x4){bf_lo(w.x), bf_hi(w.x), bf_lo(w.y), bf_hi(w.y)}; }
__device__ __forceinline__ float fast_sigmoid(float x) { return __builtin_amdgcn_rcpf(1.0f + __expf(-x)); }
__device__ __forceinline__ float gelu_tanh(float x) { const float u = 1.5957691216057308f * (x + 0.044715f * x * x * x); return x * fast_sigmoid(u); }
__device__ __forceinline__ float wave_sum(float v) {
#pragma unroll
    for (int o = 1; o < 64; o <<= 1) v += __shfl_xor(v, o);
    return v;
}
__device__ __forceinline__ int lane_id() { return (int)__builtin_amdgcn_mbcnt_hi(~0u, __builtin_amdgcn_mbcnt_lo(~0u, 0u)); }
__device__ __forceinline__ int fresh_lane() { unsigned z = 0; asm volatile("" : "+s"(z)); return (int)__builtin_amdgcn_mbcnt_hi(~0u, __builtin_amdgcn_mbcnt_lo(~0u, z)); }
#define LDS_WAIT() asm volatile("s_waitcnt lgkmcnt(0)" ::: "memory")

namespace pg8 {
constexpr int BM = 256, BK = 64, HALF = 128, HTB = HALF * BK * 2, STAGE_BYTES = 8 * HTB, NXCD = 8, WGM = 8;
__host__ __device__ __forceinline__ int lds_byte(int r, int c) { const int st = (r >> 4) * 2 + (c >> 5), rr = r & 15, cc = c & 31, ob = rr * 64 + cc * 2; return st * 1024 + (ob ^ (((ob >> 9) & 1) << 5)); }
__host__ __device__ __forceinline__ void stage_rc(int b, int& R, int& C) { const int st = b / 1024, sb = b % 1024, swz = sb ^ (((sb >> 9) & 1) << 5); R = (st >> 1) * 16 + swz / 64; C = (st & 1) * 32 + (swz % 64) / 2; }
__host__ __device__ __forceinline__ int perm32(int rho) { const int n = rho >> 4, i = rho & 15; return 8 * (i >> 2) + 4 * n + (i & 3); }

struct Unit { int pm, pn; };
struct StaticOrder {
    int nM, nN, nwg, G, c;
    __host__ __device__ void init(int M, int N, int G_, int c_) { nM = M / BM; nN = N / BM; nwg = nM * nN; G = G_; c = c_; }
    __host__ __device__ bool next(int i, Unit& u) const {
        const long L = (long)i * G + c; if (L >= nwg) return false;
        int wgid = (int)L; { const int q = nwg / NXCD, r = nwg % NXCD, xcd = wgid % NXCD, off = wgid / NXCD; wgid = (xcd < r ? xcd * (q + 1) : r * (q + 1) + (xcd - r) * q) + off; }
        const int nig = WGM * nN, gid = wgid / nig, fm = gid * WGM, gsz = (nM - fm) < WGM ? (nM - fm) : WGM;
        u.pm = fm + ((wgid % nig) % gsz); u.pn = (wgid % nig) / gsz; return true;
    }
};
struct GUnit { const char* A; const char* B; int i0, i1; };
struct GParm { int K; unsigned a_rs, a_ks; int a_cw, a_cs; };

template <class Epi, class Sched>
__device__ __forceinline__ void gemm_phase(LAS unsigned char* lds, const int wid, const GParm gp, const Sched& S, const Epi& E) {
    const int lane = fresh_lane(), tid = wid * 64 + lane, wr = wid >> 2, wc = wid & 3, fr = lane & 15, fq = lane >> 4;
    const int K = gp.K, nt = K / BK;
    unsigned voffA[2], voffB[2];
#pragma unroll
    for (int i = 0; i < 2; ++i) { int R, C; stage_rc(tid * 16 + i * 8192, R, C); const int Rb = Epi::PERM ? ((R & ~31) + perm32(R & 31)) : R;
        voffA[i] = (unsigned)R * gp.a_rs + (unsigned)((C / gp.a_cw) * gp.a_cs + (C % gp.a_cw)) * 2u; voffB[i] = (unsigned)(Rb * K + C) * 2u; }
    const size_t ksA = gp.a_ks, ksB = (size_t)(BK * 2);
    const size_t hsA = (size_t)HALF * gp.a_rs, hsB = (size_t)HALF * K * 2;
    const unsigned ldsw = (unsigned)wid * 1024u;
    const int aoff = lds_byte(wr * 64 + fr, fq * 8), boff = lds_byte(wc * 32 + fr, fq * 8);
#define PG8_SA(b, h) (((b) * 2 + (h)) * HTB)
#define PG8_SB(b, h) ((4 + (b) * 2 + (h)) * HTB)
#define PG8_STAGE(bufoff, gbase, voff) do { _Pragma("unroll") for (int _i = 0; _i < 2; ++_i) \
        __builtin_amdgcn_global_load_lds((const unsigned*)((const char*)(gbase) + (voff)[_i]), (LAS unsigned*)(lds + (bufoff) + ldsw + _i * 8192), 16, 0, 0); } while (0)
#define PG8_LDA(dst, b, h) do { _Pragma("unroll") for (int m = 0; m < 4; ++m) _Pragma("unroll") for (int k = 0; k < 2; ++k) dst[m][k] = *(const LAS bf16x8*)(lds + PG8_SA(b, h) + aoff + m * 2048 + k * 1024); } while (0)
#define PG8_LDB(dst, b, h) do { _Pragma("unroll") for (int n = 0; n < 2; ++n) _Pragma("unroll") for (int k = 0; k < 2; ++k) dst[n][k] = *(const LAS bf16x8*)(lds + PG8_SB(b, h) + boff + n * 2048 + k * 1024); } while (0)
#define PG8_MMA(ai, bj, At, Bt) do { __builtin_amdgcn_s_setprio(1); _Pragma("unroll") for (int m = 0; m < 4; ++m) _Pragma("unroll") for (int n = 0; n < 2; ++n) _Pragma("unroll") for (int k = 0; k < 2; ++k) \
        acc[ai][bj][m][n] = __builtin_amdgcn_mfma_f32_16x16x32_bf16(Bt[n][k], At[m][k], acc[ai][bj][m][n], 0, 0, 0); __builtin_amdgcn_s_setprio(0); } while (0)
#define PG8_WAIT_V(n) asm volatile("s_waitcnt vmcnt(" #n ")" ::: "memory")
#define PG8_WAIT_L(n) asm volatile("s_waitcnt lgkmcnt(" #n ")" ::: "memory")
#define PG8_BAR __builtin_amdgcn_s_barrier()
#define PG8_SCHED __builtin_amdgcn_sched_barrier(0)
    GUnit cur, nxt; int ui = 0;
    if (!S.next(0, cur)) return;
    f32x4 acc[2][2][4][2];
#pragma unroll
    for (int a = 0; a < 2; ++a)
#pragma unroll
        for (int b = 0; b < 2; ++b)
#pragma unroll
            for (int m = 0; m < 4; ++m)
#pragma unroll
                for (int n = 0; n < 2; ++n) acc[a][b][m][n] = (f32x4){0.f, 0.f, 0.f, 0.f};
    bf16x8 At[4][2], B0[2][2], B1[2][2];
    const char* cA = cur.A; const char* cB = cur.B;
    PG8_STAGE(PG8_SB(0, 0), cB, voffB); PG8_STAGE(PG8_SB(0, 1), cB + hsB, voffB); PG8_STAGE(PG8_SA(0, 0), cA, voffA); PG8_STAGE(PG8_SA(0, 1), cA + hsA, voffA);
    if (wr == 1) PG8_BAR;
    PG8_WAIT_V(2); PG8_BAR;
    PG8_STAGE(PG8_SB(1, 0), cB + ksB, voffB); PG8_STAGE(PG8_SA(1, 0), cA + ksA, voffA); PG8_STAGE(PG8_SB(1, 1), cB + hsB + ksB, voffB);
    PG8_WAIT_V(6); PG8_BAR;
    for (;;) {
        const bool has_next = S.next(ui + 1, nxt);
        const char* nA = has_next ? nxt.A : cA; const char* nB = has_next ? nxt.B : cB;
        for (int t = 0; t < nt; t += 2) {
            const bool last = (t == nt - 2);
            const char* a1 = cA + (size_t)(t + 1) * ksA;
            const char* a2 = last ? nA : cA + (size_t)(t + 2) * ksA; const char* b2 = last ? nB : cB + (size_t)(t + 2) * ksB;
            const char* a3 = a2 + ksA; const char* b3 = b2 + ksB;
            PG8_LDB(B0, 0, 0); PG8_LDB(B1, 0, 1); PG8_SCHED; PG8_LDA(At, 0, 0); PG8_STAGE(PG8_SA(1, 1), a1 + hsA, voffA);
            PG8_WAIT_V(8); PG8_WAIT_L(0); PG8_BAR; PG8_MMA(0, 0, At, B0); PG8_MMA(0, 1, At, B1); PG8_BAR; PG8_SCHED;
            PG8_LDA(At, 0, 1); PG8_STAGE(PG8_SB(0, 0), b2, voffB); PG8_STAGE(PG8_SB(0, 1), b2 + hsB, voffB); PG8_STAGE(PG8_SA(0, 0), a2, voffA);
            PG8_WAIT_V(8); PG8_WAIT_L(0); PG8_BAR; PG8_MMA(1, 0, At, B0); PG8_MMA(1, 1, At, B1); PG8_BAR; PG8_SCHED;
            PG8_LDB(B0, 1, 0); PG8_LDB(B1, 1, 1); PG8_SCHED; PG8_LDA(At, 1, 0); PG8_STAGE(PG8_SA(0, 1), a2 + hsA, voffA);
            PG8_WAIT_V(8); PG8_WAIT_L(0); PG8_BAR; PG8_MMA(0, 0, At, B0); PG8_MMA(0, 1, At, B1); PG8_BAR; PG8_SCHED;
            PG8_LDA(At, 1, 1); PG8_STAGE(PG8_SB(1, 0), b3, voffB); PG8_STAGE(PG8_SB(1, 1), b3 + hsB, voffB); PG8_STAGE(PG8_SA(1, 0), a3, voffA);
            PG8_WAIT_V(8); PG8_WAIT_L(0); PG8_BAR; PG8_MMA(1, 0, At, B0); PG8_MMA(1, 1, At, B1); PG8_BAR; PG8_SCHED;
        }
        if (wr == 0) PG8_BAR;
        { const int l_o = fresh_lane(); E(acc, cur, wr, wc, l_o & 15, l_o >> 4); }
        if (!has_next) break;
#pragma unroll
        for (int a = 0; a < 2; ++a)
#pragma unroll
            for (int b = 0; b < 2; ++b)
#pragma unroll
                for (int m = 0; m < 4; ++m)
#pragma unroll
                    for (int n = 0; n < 2; ++n) acc[a][b][m][n] = (f32x4){0.f, 0.f, 0.f, 0.f};
        cur = nxt; cA = nA; cB = nB; ++ui;
        if (wr == 1) PG8_BAR;
    }
    PG8_WAIT_V(0);
    PG8_BAR;
#undef PG8_SA
#undef PG8_SB
#undef PG8_STAGE
#undef PG8_LDA
#undef PG8_LDB
#undef PG8_MMA
#undef PG8_WAIT_V
#undef PG8_WAIT_L
#undef PG8_BAR
#undef PG8_SCHED
}
}
using pg8::GUnit; using pg8::GParm;
typedef f32x4 AccT[2][2][4][2];

struct SchedStd {
    pg8::StaticOrder so; const char* A; const char* B; size_t a_tile, b_tile;
    __device__ __forceinline__ bool next(int i, GUnit& u) const { pg8::Unit t; if (!so.next(i, t)) return false; u.A = A + (size_t)t.pm * a_tile; u.B = B + (size_t)t.pn * b_tile; u.i0 = t.pm; u.i1 = t.pn; return true; }
};
struct SchedS5a { const char* U; const char* WG; int G, c;
    __device__ __forceinline__ bool next(int i, GUnit& u) const { const int L = i * G + c; if (L >= 192) return false; const int g = L / 3, pn = L % 3;
        u.A = U + g * 32; u.B = WG + ((size_t)g * 768 + 256 * pn) * 512 * 2; u.i0 = g; u.i1 = pn; return true; } };
struct SchedS5b { const char* HP; const char* WC; int G, c;
    __device__ __forceinline__ bool next(int i, GUnit& u) const { const int L = i * G + c; if (L >= 128) return false; const int g = L / 2, pn = L % 2;
        u.A = HP + (size_t)g * 256 * 256 * 2; u.B = WC + ((size_t)g * 512 + 256 * pn) * 256 * 2; u.i0 = g; u.i1 = pn; return true; } };
struct SchedRG { const char* XR; const char* RGW; int G, c;
    __device__ __forceinline__ bool next(int i, GUnit& u) const { const int L = i * G + c; if (L >= 512) return false; const int h = L % 16, pm = L / 16;
        u.A = XR + ((size_t)(256 * pm) * 1024 + 64 * h) * 2; u.B = RGW + (size_t)h * 256 * 256 * 2; u.i0 = pm; u.i1 = h; return true; } };

template <int ACT> __device__ __forceinline__ void epi_bf16_store(const AccT& acc, bf16_t* tile, int ldc, const float* biast, int wr, int wc, int fr, int fq) {
    const int r0 = wr * 64 + fr, c0 = wc * 32 + 8 * fq;
    f32x4 bv[2][2];
#pragma unroll
    for (int bj = 0; bj < 2; ++bj)
#pragma unroll
        for (int n = 0; n < 2; ++n) bv[bj][n] = biast ? *(const f32x4*)(biast + c0 + bj * 128 + 4 * n) : (f32x4){0.f, 0.f, 0.f, 0.f};
#pragma unroll
    for (int ai = 0; ai < 2; ++ai)
#pragma unroll
        for (int m = 0; m < 4; ++m) { bf16_t* rowp = tile + (size_t)(r0 + ai * 128 + m * 16) * ldc + c0;
#pragma unroll
            for (int bj = 0; bj < 2; ++bj) { f32x4 v0 = acc[ai][bj][m][0] + bv[bj][0], v1 = acc[ai][bj][m][1] + bv[bj][1];
                if (ACT == 1) {
#pragma unroll
                    for (int j = 0; j < 4; ++j) { const float a = fmaxf(v0[j], 0.f), b = fmaxf(v1[j], 0.f); v0[j] = a * a; v1[j] = b * b; } }
                if (ACT == 2) {
#pragma unroll
                    for (int j = 0; j < 4; ++j) { v0[j] = fast_sigmoid(v0[j]); v1[j] = fast_sigmoid(v1[j]); } }
                u32x4 w; w.x = cvt_pk_bf16(v0[0], v0[1]); w.y = cvt_pk_bf16(v0[2], v0[3]); w.z = cvt_pk_bf16(v1[0], v1[1]); w.w = cvt_pk_bf16(v1[2], v1[3]);
                *(u32x4*)(rowp + bj * 128) = w; } }
}
struct EpiProj { static constexpr bool PERM = true; bf16_t *U, *XR, *Z; const float* bias;
    __device__ __forceinline__ void operator()(AccT& acc, const GUnit& u, int wr, int wc, int fr, int fq) const {
        const int pm = u.i0, pn = u.i1; bf16_t* base = pn < 4 ? U : (pn < 8 ? XR + 2 * 1024 : Z);
        epi_bf16_store<0>(acc, base + (size_t)pm * 256 * 1024 + (pn & 3) * 256, 1024, bias + pn * 256, wr, wc, fr, fq); } };
template <int ACT> struct EpiPlain { static constexpr bool PERM = true; bf16_t* O; int ldc; const float* bias;
    __device__ __forceinline__ void operator()(AccT& acc, const GUnit& u, int wr, int wc, int fr, int fq) const {
        epi_bf16_store<ACT>(acc, O + (size_t)u.i0 * 256 * ldc + u.i1 * 256, ldc, bias ? bias + u.i1 * 256 : nullptr, wr, wc, fr, fq); } };
struct EpiS5a { static constexpr bool PERM = true; bf16_t* YI; float* S;
    __device__ __forceinline__ void operator()(AccT& acc, const GUnit& u, int wr, int wc, int fr, int fq) const {
        const int g = u.i0, pn = u.i1;
#pragma unroll
        for (int ai = 0; ai < 2; ++ai)
#pragma unroll
            for (int m = 0; m < 4; ++m) { const int r = ai * 128 + wr * 64 + m * 16 + fr;
#pragma unroll
                for (int bj = 0; bj < 2; ++bj) { const int c8 = bj * 128 + wc * 32 + 8 * fq; const f32x4 v0 = acc[ai][bj][m][0], v1 = acc[ai][bj][m][1];
                    if (pn < 2) { const int col = pn * 256 + c8, t = col >> 4, k0 = col & 15;
                        u32x4 w; w.x = cvt_pk_bf16(v0[0], v0[1]); w.y = cvt_pk_bf16(v0[2], v0[3]); w.z = cvt_pk_bf16(v1[0], v1[1]); w.w = cvt_pk_bf16(v1[2], v1[3]);
                        *(u32x4*)(YI + (size_t)(r * TC + t) * 1024 + g * 16 + k0) = w; }
                    else { float* sp = S + ((size_t)g * NCH + r) * 256 + c8; *(f32x4*)sp = v0; *(f32x4*)(sp + 4) = v1; } } }
    } };
struct EpiS5b { static constexpr bool PERM = true; const bf16_t* YI; bf16_t* YG;
    __device__ __forceinline__ void operator()(AccT& acc, const GUnit& u, int wr, int wc, int fr, int fq) const {
        const int g = u.i0, pn = u.i1;
#pragma unroll
        for (int ai = 0; ai < 2; ++ai)
#pragma unroll
            for (int m = 0; m < 4; ++m) { const int r = ai * 128 + wr * 64 + m * 16 + fr;
#pragma unroll
                for (int bj = 0; bj < 2; ++bj) { const int col = pn * 256 + bj * 128 + wc * 32 + 8 * fq, t = col >> 4, k0 = col & 15;
                    const size_t off = (size_t)(r * TC + t) * 1024 + g * 16 + k0; const u32x4 yi = *(const u32x4*)(YI + off);
                    f32x4 v0 = acc[ai][bj][m][0] + (f32x4){bf_lo(yi.x), bf_hi(yi.x), bf_lo(yi.y), bf_hi(yi.y)}, v1 = acc[ai][bj][m][1] + (f32x4){bf_lo(yi.z), bf_hi(yi.z), bf_lo(yi.w), bf_hi(yi.w)};
#pragma unroll
                    for (int j = 0; j < 4; ++j) { v0[j] = gelu_tanh(v0[j]); v1[j] = gelu_tanh(v1[j]); }
                    u32x4 w; w.x = cvt_pk_bf16(v0[0], v0[1]); w.y = cvt_pk_bf16(v0[2], v0[3]); w.z = cvt_pk_bf16(v1[0], v1[1]); w.w = cvt_pk_bf16(v1[2], v1[3]);
                    *(u32x4*)(YG + off) = w; } }
    } };
struct EpiGlu { static constexpr bool PERM = true; const bf16_t* YG; bf16_t* YPRE; const float* bias;
    __device__ __forceinline__ void operator()(AccT& acc, const GUnit& u, int wr, int wc, int fr, int fq) const {
        const int pm = u.i0, pn = u.i1; const int c0 = pn * 256 + wc * 32 + 8 * fq;
        f32x4 bv[2][2];
#pragma unroll
        for (int bj = 0; bj < 2; ++bj)
#pragma unroll
            for (int n = 0; n < 2; ++n) bv[bj][n] = *(const f32x4*)(bias + c0 + bj * 128 + 4 * n);
#pragma unroll
        for (int ai = 0; ai < 2; ++ai)
#pragma unroll
            for (int m = 0; m < 4; ++m) { const int row = pm * 256 + ai * 128 + wr * 64 + m * 16 + fr;
#pragma unroll
                for (int bj = 0; bj < 2; ++bj) { const int col = c0 + bj * 128; const u32x4 yv = *(const u32x4*)(YG + (size_t)row * 1024 + col);
                    const f32x4 y0 = (f32x4){bf_lo(yv.x), bf_hi(yv.x), bf_lo(yv.y), bf_hi(yv.y)}, y1 = (f32x4){bf_lo(yv.z), bf_hi(yv.z), bf_lo(yv.w), bf_hi(yv.w)};
                    f32x4 v0 = acc[ai][bj][m][0] + bv[bj][0], v1 = acc[ai][bj][m][1] + bv[bj][1];
#pragma unroll
                    for (int j = 0; j < 4; ++j) { v0[j] = y0[j] * fast_sigmoid(v0[j]); v1[j] = y1[j] * fast_sigmoid(v1[j]); }
                    u32x4 w; w.x = cvt_pk_bf16(v0[0], v0[1]); w.y = cvt_pk_bf16(v0[2], v0[3]); w.z = cvt_pk_bf16(v1[0], v1[1]); w.w = cvt_pk_bf16(v1[2], v1[3]);
                    *(u32x4*)(YPRE + (size_t)row * 2048 + col) = w; }
                }
    } };
template <bool PLEADD> struct EpiRes { static constexpr bool PERM = false; const bf16_t* HBp; const float* bias; float* V; const bf16_t* SG; const bf16_t* PW;
    __device__ __forceinline__ void operator()(AccT& acc, const GUnit& u, int wr, int wc, int fr, int fq) const {
        const int pm = u.i0, pn = u.i1; const int c0 = pn * 256 + wc * 32 + 4 * fq;
        f32x4 bv[2][2];
#pragma unroll
        for (int bj = 0; bj < 2; ++bj)
#pragma unroll
            for (int n = 0; n < 2; ++n) bv[bj][n] = *(const f32x4*)(bias + c0 + bj * 128 + n * 16);
#pragma unroll
        for (int ai = 0; ai < 2; ++ai)
#pragma unroll
            for (int m = 0; m < 4; ++m) { const int row = pm * 256 + ai * 128 + wr * 64 + m * 16 + fr;
#pragma unroll
                for (int bj = 0; bj < 2; ++bj)
#pragma unroll
                    for (int n = 0; n < 2; ++n) { const size_t off = (size_t)row * 2048 + c0 + bj * 128 + n * 16;
                        f32x4 v = acc[ai][bj][m][n] + bv[bj][n] + DN_ALPHA * bf4(*(const u32x2*)(HBp + off));
                        if (PLEADD) v += bf4(*(const u32x2*)(SG + off)) * bf4(*(const u32x2*)(PW + off));
                        *(f32x4*)(V + off) = v; } }
    } };

struct EpiG { static constexpr bool PERM = true; bf16_t *G0, *G1; const float* bias;
    __device__ __forceinline__ void operator()(AccT& acc, const GUnit& u, int wr, int wc, int fr, int fq) const {
        const int pm = u.i0, h = u.i1; bf16_t* base = (pm < 16 ? G0 : G1) + (size_t)(pm & 15) * 256 * 4096 + h * 256;
        epi_bf16_store<0>(acc, base, 4096, bias + h * 256, wr, wc, fr, fq); } };
__device__ __forceinline__ float bfu(unsigned short v) { return __uint_as_float(((unsigned)v) << 16); }
__device__ __forceinline__ void rg_gate(float pa, float px, float spv, float xc, float& a, float& b) {
    const float r = fast_sigmoid(pa), ig = fast_sigmoid(px); const float la = spv * r; a = __expf(la); const float x = 2.0f * la;
    const float om = -x * (1.0f + x * (0.5f + x * (0.16666667f + x * (0.041666668f + x * (0.008333334f + x * 0.0013888889f)))));
    b = sqrtf(fmaxf(om, 0.f)) * ig * xc; }
struct RgCtx { const bf16_t *XR, *G0, *G1, *Z; const float *convw, *convb, *sp; float* agg; bf16_t* ypre; };
__device__ __forceinline__ const bf16_t* g_row(const RgCtx& R, int t) { return (t < 4096 ? R.G0 : R.G1) + (size_t)(t & 4095) * 4096; }
__device__ __forceinline__ void rg_pass_a(const RgCtx& R, int half, int seg, int tid) {
    const int c = half * 512 + tid, gcol = (c >> 6) * 256 + (c & 63), t0 = seg * 64;
    const float w0 = R.convw[c], w1 = R.convw[1024 + c], w2 = R.convw[2048 + c], w3 = R.convw[3072 + c], cb = R.convb[c], sp0 = R.sp[c], sp1 = R.sp[1024 + c];
    const bf16_t* xp = R.XR + c;
    float x0 = bfu(xp[(size_t)(t0 + 0) * 1024]), x1 = bfu(xp[(size_t)(t0 + 1) * 1024]), x2 = bfu(xp[(size_t)(t0 + 2) * 1024]);
    float Af = 1.f, Bf = 0.f, Ab = 1.f, Bb = 0.f;
    for (int tb = 0; tb < 64; tb += 16) {
        unsigned short ga0[16], ga1[16], gx0[16], gx1[16], xn[16];
#pragma unroll
        for (int i = 0; i < 16; ++i) { const int t = t0 + tb + i; const bf16_t* g = g_row(R, t) + gcol; ga0[i] = g[0]; ga1[i] = g[64]; gx0[i] = g[128]; gx1[i] = g[192]; xn[i] = xp[(size_t)(t + 3) * 1024]; }
#pragma unroll
        for (int i = 0; i < 16; ++i) { const float x3 = bfu(xn[i]); const float xc = cb + w0 * x0 + w1 * x1 + w2 * x2 + w3 * x3; x0 = x1; x1 = x2; x2 = x3;
            float a, b; rg_gate(bfu(ga0[i]), bfu(gx0[i]), sp0, xc, a, b); Bf = a * Bf + b; Af = a * Af;
            rg_gate(bfu(ga1[i]), bfu(gx1[i]), sp1, xc, a, b); Bb = Ab * b + Bb; Ab = Ab * a; }
    }
    *(f32x2*)(R.agg + ((size_t)(seg * 2 + 0) * 1024 + c) * 2) = (f32x2){Af, Bf};
    *(f32x2*)(R.agg + ((size_t)(seg * 2 + 1) * 1024 + c) * 2) = (f32x2){Ab, Bb};
}
__device__ __forceinline__ void rg_pass_c(const RgCtx& R, int half, int seg, int tid, LAS float* Lh) {
    const int c = half * 512 + tid, gcol = (c >> 6) * 256 + (c & 63), t0 = seg * 64;
    const float w0 = R.convw[c], w1 = R.convw[1024 + c], w2 = R.convw[2048 + c], w3 = R.convw[3072 + c], cb = R.convb[c], sp0 = R.sp[c], sp1 = R.sp[1024 + c];
    const f32x2* ag = (const f32x2*)R.agg;
    float hf = 0.f, hb = 0.f;
#pragma unroll 8
    for (int s2 = 0; s2 < seg; ++s2) { const f32x2 ab = ag[(size_t)(s2 * 2 + 0) * 1024 + c]; hf = ab[0] * hf + ab[1]; }
#pragma unroll 8
    for (int s2 = 127; s2 > seg; --s2) { const f32x2 ab = ag[(size_t)(s2 * 2 + 1) * 1024 + c]; hb = ab[0] * hb + ab[1]; }
    const bf16_t* xp = R.XR + c;
    {   float x0 = bfu(xp[(size_t)(t0 + 0) * 1024]), x1 = bfu(xp[(size_t)(t0 + 1) * 1024]), x2 = bfu(xp[(size_t)(t0 + 2) * 1024]);
        for (int tb = 0; tb < 64; tb += 16) {
            unsigned short ga0[16], gx0[16], xn[16];
#pragma unroll
            for (int i = 0; i < 16; ++i) { const int t = t0 + tb + i; const bf16_t* g = g_row(R, t) + gcol; ga0[i] = g[0]; gx0[i] = g[128]; xn[i] = xp[(size_t)(t + 3) * 1024]; }
#pragma unroll
            for (int i = 0; i < 16; ++i) { const float x3 = bfu(xn[i]); const float xc = cb + w0 * x0 + w1 * x1 + w2 * x2 + w3 * x3; x0 = x1; x1 = x2; x2 = x3;
                float a, b; rg_gate(bfu(ga0[i]), bfu(gx0[i]), sp0, xc, a, b); hf = a * hf + b; Lh[(tb + i) * 512 + tid] = hf; }
        }
    }
    {
        float y1 = bfu(xp[(size_t)(t0 + 64) * 1024]), y2 = bfu(xp[(size_t)(t0 + 65) * 1024]), y3 = bfu(xp[(size_t)(t0 + 66) * 1024]);
        for (int tb = 48; tb >= 0; tb -= 16) {
            unsigned short ga1[16], gx1[16], xn[16], zz[16];
#pragma unroll
            for (int i = 0; i < 16; ++i) { const int t = t0 + tb + 15 - i; const bf16_t* g = g_row(R, t) + gcol; ga1[i] = g[64]; gx1[i] = g[192]; xn[i] = xp[(size_t)t * 1024]; zz[i] = R.Z[(size_t)t * 1024 + c]; }
#pragma unroll
            for (int i = 0; i < 16; ++i) { const int tl = tb + 15 - i; const float y0 = bfu(xn[i]); const float xc = cb + w0 * y0 + w1 * y1 + w2 * y2 + w3 * y3; y3 = y2; y2 = y1; y1 = y0;
                float a, b; rg_gate(bfu(ga1[i]), bfu(gx1[i]), sp1, xc, a, b); hb = a * hb + b;
                const float o = (Lh[tl * 512 + tid] + hb) * gelu_tanh(bfu(zz[i]));
                R.ypre[(size_t)(t0 + tl) * 2048 + 1024 + c] = (bf16_t)(cvt_pk_bf16(o, 0.f) & 0xffffu); }
        }
    }
}


#ifndef NAIVE_GEMM
#define NAIVE_GEMM 0
#endif
template <class Epi, class Sched>
__device__ __forceinline__ void gemm_phase_naive(LAS unsigned char* lds, const int wid, const GParm gp, const Sched& S, const Epi& E) {
    const int lane = fresh_lane(), tid = wid * 64 + lane, wr = wid >> 2, wc = wid & 3, fr = lane & 15, fq = lane >> 4;
    GUnit cur;
    for (int ui = 0; S.next(ui, cur); ++ui) {
        f32x4 acc[2][2][4][2];
#pragma unroll
        for (int ai = 0; ai < 2; ++ai)
#pragma unroll
            for (int bj = 0; bj < 2; ++bj)
#pragma unroll
                for (int m = 0; m < 4; ++m)
#pragma unroll
                    for (int n = 0; n < 2; ++n)
#pragma unroll
                        for (int e = 0; e < 4; ++e) {
                            const int row = 128 * ai + 64 * wr + 16 * m + fr; const int col = Epi::PERM ? (128 * bj + 32 * wc + 8 * fq + 4 * n + e) : (128 * bj + 32 * wc + 16 * n + 4 * fq + e);
                            const char* ap = cur.A + (size_t)row * gp.a_rs; const char* bp = cur.B + (size_t)col * gp.K * 2; float sum = 0.f;
                            for (int k = 0; k < gp.K; k += 8) { const int kt = k >> 6, C = k & 63;
                                const u32x4 av = *(const u32x4*)(ap + (size_t)kt * gp.a_ks + ((C / gp.a_cw) * gp.a_cs + (C % gp.a_cw)) * 2), bv = *(const u32x4*)(bp + k * 2);
                                sum += bf_lo(av.x) * bf_lo(bv.x) + bf_hi(av.x) * bf_hi(bv.x) + bf_lo(av.y) * bf_lo(bv.y) + bf_hi(av.y) * bf_hi(bv.y) + bf_lo(av.z) * bf_lo(bv.z) + bf_hi(av.z) * bf_hi(bv.z) + bf_lo(av.w) * bf_lo(bv.w) + bf_hi(av.w) * bf_hi(bv.w); }
                            acc[ai][bj][m][n][e] = sum; }
        E(acc, cur, wr, wc, fr, fq);
    }
    __syncthreads();
}
#if NAIVE_GEMM
#define GEMM_PHASE gemm_phase_naive
#else
#define GEMM_PHASE pg8::gemm_phase
#endif
__device__ __forceinline__ void transpose_item(const float* W, int K, int N, bf16_t* WT, LAS float* scr, int item, int lane) {
    const int nblk = N / 32, kb = item / nblk, nb = item % nblk, k0 = 64 * kb, n0 = 32 * nb;
#pragma unroll 8
    for (int i = 0; i < 32; ++i) { const int kk = 2 * i + (lane >> 5); scr[kk * 33 + (lane & 31)] = W[(size_t)(k0 + kk) * N + n0 + (lane & 31)]; }
    LDS_WAIT();
    const int c = lane & 7;
#pragma unroll
    for (int j = 0; j < 4; ++j) { const int n = (lane >> 3) + 8 * j; const LAS float* s = scr + (8 * c) * 33 + n;
        u32x4 o; o.x = cvt_pk_bf16(s[0 * 33], s[1 * 33]); o.y = cvt_pk_bf16(s[2 * 33], s[3 * 33]); o.z = cvt_pk_bf16(s[4 * 33], s[5 * 33]); o.w = cvt_pk_bf16(s[6 * 33], s[7 * 33]);
        *(u32x4*)(WT + (size_t)(n0 + n) * K + k0 + 8 * c) = o; }
    LDS_WAIT();
}
template <bool OUT_BF16> __device__ __forceinline__ void ln_row(const float* xrow, const float* g, const float* b, void* orow, int lane) {
    const f32x4* xr = (const f32x4*)xrow + lane; f32x4 v[8]; float s = 0.f;
#pragma unroll
    for (int j = 0; j < 8; ++j) { v[j] = xr[64 * j]; s += (v[j][0] + v[j][1]) + (v[j][2] + v[j][3]); }
    const float mean = wave_sum(s) * (1.f / DM); float s2 = 0.f;
#pragma unroll
    for (int j = 0; j < 8; ++j) { v[j] = v[j] - mean; s2 += (v[j][0] * v[j][0] + v[j][1] * v[j][1]) + (v[j][2] * v[j][2] + v[j][3] * v[j][3]); }
    const float rstd = 1.0f / sqrtf(wave_sum(s2) * (1.f / DM) + LN_EPS);
#pragma unroll
    for (int j = 0; j < 8; ++j) { const f32x4 gg = ((const f32x4*)g)[lane + 64 * j], bb = ((const f32x4*)b)[lane + 64 * j]; const f32x4 o = v[j] * rstd * gg + bb;
        if (OUT_BF16) { u32x2 w; w.x = cvt_pk_bf16(o[0], o[1]); w.y = cvt_pk_bf16(o[2], o[3]); ((u32x2*)orow)[lane + 64 * j] = w; }
        else ((f32x4*)orow)[lane + 64 * j] = o; }
}
__device__ __forceinline__ void cpow(float lrs, float th, int j, float& re, float& im) {
    double a = (double)j * (double)th * 0.15915494309189535; a -= rint(a); const float af = 2.0f * (float)a;
    const float mag = expf((float)j * lrs); re = mag * cospif(af); im = mag * sinpif(af);
}


#ifndef NAIVE_RG
#define NAIVE_RG 0
#endif
__device__ __forceinline__ void naive_rg_channel(const RgCtx& R, int c) {
    const int gcol = (c >> 6) * 256 + (c & 63);
    const float w0 = R.convw[c], w1 = R.convw[1024 + c], w2 = R.convw[2048 + c], w3 = R.convw[3072 + c], cb = R.convb[c], sp0 = R.sp[c], sp1 = R.sp[1024 + c];
    const bf16_t* xp = R.XR + c; float h = 0.f;
    for (int t = 0; t < SEQ; ++t) { const float xc = cb + w0 * bfu(xp[(size_t)t * 1024]) + w1 * bfu(xp[(size_t)(t + 1) * 1024]) + w2 * bfu(xp[(size_t)(t + 2) * 1024]) + w3 * bfu(xp[(size_t)(t + 3) * 1024]);
        const bf16_t* g = g_row(R, t) + gcol; float a, b; rg_gate(bfu(g[0]), bfu(g[128]), sp0, xc, a, b); h = a * h + b;
        R.ypre[(size_t)t * 2048 + 1024 + c] = (bf16_t)(cvt_pk_bf16(h, 0.f) & 0xffffu); }
    __builtin_amdgcn_fence(__ATOMIC_SEQ_CST, "agent");
    h = 0.f;
    for (int t = SEQ - 1; t >= 0; --t) { const float xc = cb + w0 * bfu(xp[(size_t)t * 1024]) + w1 * bfu(xp[(size_t)(t + 1) * 1024]) + w2 * bfu(xp[(size_t)(t + 2) * 1024]) + w3 * bfu(xp[(size_t)(t + 3) * 1024]);
        const bf16_t* g = g_row(R, t) + gcol; float a, b; rg_gate(bfu(g[64]), bfu(g[192]), sp1, xc, a, b); h = a * h + b;
        const size_t o = (size_t)t * 2048 + 1024 + c; const float y = (bfu(R.ypre[o]) + h) * gelu_tanh(bfu(R.Z[(size_t)t * 1024 + c]));
        R.ypre[o] = (bf16_t)(cvt_pk_bf16(y, 0.f) & 0xffffu); }
}

#ifndef NAIVE_S5
#define NAIVE_S5 0
#endif
__device__ __forceinline__ void naive_s5_group(const float* const* in, const bf16_t* U, float* tmp, bf16_t* YG, int g, int lane) {
    const float *lre = in[6], *lim = in[7], *lstep = in[8], *bre = in[9], *bim = in[10], *cre = in[11], *cim = in[12], *dd = in[13];
    for (int n = 0; n < 2; ++n) {
        const int p = lane, pi = (n * 64 + g) * 64 + p;
        const float lr = fminf(lre[pi], -1e-4f), li = lim[pi], step = expf(lstep[n * 64 + g]); float ar, ai; cpow(lr * step, li * step, 1, ar, ai);
        const float nr = ar - 1.0f, ni = ai, den = lr * lr + li * li; const float qr = (nr * lr + ni * li) / den, qi = (ni * lr - nr * li) / den;
        float hr = 0.f, hi = 0.f;
        for (int tt = 0; tt < SEQ; ++tt) { const int t = n == 0 ? tt : SEQ - 1 - tt; const bf16_t* up = U + (size_t)t * 1024 + g * 16;
            float bur = 0.f, bui = 0.f;
#pragma unroll
            for (int k = 0; k < 16; ++k) { const float uv = bfu(up[k]); const float br = bre[(size_t)pi * 16 + k], bi = bim[(size_t)pi * 16 + k]; bur += (qr * br - qi * bi) * uv; bui += (qr * bi + qi * br) * uv; }
            const float nhr = ar * hr - ai * hi + bur, nhi = ar * hi + ai * hr + bui; hr = nhr; hi = nhi;
#pragma unroll
            for (int k = 0; k < 16; ++k) { const size_t ci = ((size_t)(n * 64 + g) * 16 + k) * 64 + p; float v = cre[ci] * hr - cim[ci] * hi; v = wave_sum(v);
                if (lane == k) { const size_t o = (size_t)t * 1024 + g * 16 + k;
                    if (n == 0) tmp[o] = v; else { const float y = tmp[o] + v + dd[g * 16 + k] * bfu(up[k]); YG[o] = (bf16_t)(cvt_pk_bf16(gelu_tanh(y), 0.f) & 0xffffu); } } }
        }
        __builtin_amdgcn_fence(__ATOMIC_SEQ_CST, "agent");
    }
}

__device__ __forceinline__ void grid_barrier(unsigned* bar, unsigned target, int wave) {
    asm volatile("s_waitcnt vmcnt(0)" ::: "memory");
    __syncthreads();
    if (wave == 0) { const int l = fresh_lane();
        if (l == 0) {
            __builtin_amdgcn_fence(__ATOMIC_RELEASE, "agent"); asm volatile("s_waitcnt vmcnt(0)" ::: "memory");
            __hip_atomic_fetch_add(bar, 1u, __ATOMIC_RELAXED, __HIP_MEMORY_SCOPE_AGENT);
            while (__hip_atomic_load(bar, __ATOMIC_RELAXED, __HIP_MEMORY_SCOPE_AGENT) < target) __builtin_amdgcn_s_sleep(2);
            __builtin_amdgcn_fence(__ATOMIC_ACQUIRE, "agent"); asm volatile("s_waitcnt vmcnt(0)" ::: "memory");
        } }
    __syncthreads();
}

struct Args { const float* in[38]; float* out; unsigned char* ws; int ph_lo, ph_hi; };

__device__ __forceinline__ void s5_precompute(const Args& a, int g, LAS float* L) {
    const int tid = threadIdx.x;
    const float *lre = a.in[6], *lim = a.in[7], *lstep = a.in[8], *bre = a.in[9], *bim = a.in[10], *cre = a.in[11], *cim = a.in[12], *dd = a.in[13];
    LAS float *PWre = L, *PWim = L + 4224, *BBre = L + 8448, *BBim = L + 10496, *CCre = L + 12544, *CCim = L + 14592, *MT = L + 16640;
    bf16_t* WGg = (bf16_t*)(a.ws + WS_WG) + (size_t)g * 768 * 512; bf16_t* WCg = (bf16_t*)(a.ws + WS_WC) + (size_t)g * 512 * 256;
    {
        const int np = tid & 127, jj = tid >> 7, n = np >> 6, p = np & 63; const int pi = (n * 64 + g) * 64 + p;
        const float lr = fminf(lre[pi], -1e-4f), li = lim[pi], step = expf(lstep[n * 64 + g]); const float lrs = lr * step, th = li * step;
        for (int j = jj; j <= 32; j += 4) { float r, i; cpow(lrs, th, j, r, i); PWre[np * 33 + j] = r; PWim[np * 33 + j] = i; }
        float l1r, l1i; cpow(lrs, th, 1, l1r, l1i);
        const float nr = l1r - 1.0f, ni = l1i, den = lr * lr + li * li; const float qr = (nr * lr + ni * li) / den, qi = (ni * lr - nr * li) / den;
#pragma unroll
        for (int k = jj * 4; k < jj * 4 + 4; ++k) { const float br = bre[(size_t)pi * 16 + k], bi = bim[(size_t)pi * 16 + k]; BBre[np * 16 + k] = qr * br - qi * bi; BBim[np * 16 + k] = qr * bi + qi * br; }
        for (int e = tid; e < 2048; e += 512) { const int n2 = e >> 10, k = (e >> 6) & 15, p2 = e & 63; const size_t ci = ((size_t)(n2 * 64 + g) * 16 + k) * 64 + p2; CCre[(n2 * 64 + p2) * 16 + k] = cre[ci]; CCim[(n2 * 64 + p2) * 16 + k] = cim[ci]; }
    }
    __syncthreads();
    for (int i = 0; i < 2; ++i) {
        const int bq = tid + 512 * i, n = bq >> 9, j = (bq >> 4) & 31, kob = (bq >> 2) & 3, kib = bq & 3;
        f32x4 m0 = {0.f, 0.f, 0.f, 0.f}, m1 = m0, m2 = m0, m3 = m0;
        for (int p = 0; p < 64; ++p) { const int np = n * 64 + p; const float pr = PWre[np * 33 + j], pi2 = PWim[np * 33 + j];
            const f32x4 br = *(const LAS f32x4*)(BBre + np * 16 + 4 * kib), bi = *(const LAS f32x4*)(BBim + np * 16 + 4 * kib), cr = *(const LAS f32x4*)(CCre + np * 16 + 4 * kob), ci = *(const LAS f32x4*)(CCim + np * 16 + 4 * kob);
            const f32x4 er = pr * br - pi2 * bi, ei = pr * bi + pi2 * br;
            m0 += cr[0] * er - ci[0] * ei; m1 += cr[1] * er - ci[1] * ei; m2 += cr[2] * er - ci[2] * ei; m3 += cr[3] * er - ci[3] * ei; }
        LAS float* o = MT + ((n * 32 + j) * 16 + 4 * kob) * 16 + 4 * kib;
        *(LAS f32x4*)o = m0; *(LAS f32x4*)(o + 16) = m1; *(LAS f32x4*)(o + 32) = m2; *(LAS f32x4*)(o + 48) = m3;
    }
    __syncthreads();
    for (int i = 0; i < 64; ++i) {
        const int idx = tid + 512 * i, row = idx >> 6, cp = idx & 63, t = row >> 4, ko = row & 15, s = cp >> 1, ki0 = (cp & 1) * 8;
        f32x4 v0, v1;
        if (t != s) { const LAS float* src = MT + (((t > s ? 0 : 1) * 32 + (t > s ? t - s : s - t)) * 16 + ko) * 16 + ki0; v0 = *(const LAS f32x4*)src; v1 = *(const LAS f32x4*)(src + 4); }
        else { const LAS float* s0 = MT + ko * 16 + ki0; const LAS float* s1 = MT + (32 * 16 + ko) * 16 + ki0; v0 = *(const LAS f32x4*)s0 + *(const LAS f32x4*)s1; v1 = *(const LAS f32x4*)(s0 + 4) + *(const LAS f32x4*)(s1 + 4);
            const float dv = dd[g * 16 + ko];
#pragma unroll
            for (int e = 0; e < 4; ++e) { if (ki0 + e == ko) v0[e] += dv; if (ki0 + 4 + e == ko) v1[e] += dv; } }
        u32x4 w; w.x = cvt_pk_bf16(v0[0], v0[1]); w.y = cvt_pk_bf16(v0[2], v0[3]); w.z = cvt_pk_bf16(v1[0], v1[1]); w.w = cvt_pk_bf16(v1[2], v1[3]);
        *(u32x4*)(WGg + (size_t)row * 512 + cp * 8) = w;
    }
    for (int i = 0; i < 32; ++i) {
        const int idx = tid + 512 * i, q = idx >> 6, cp = idx & 63, n = q >> 7, ri = (q >> 6) & 1, p = q & 63, s = cp >> 1, ki0 = (cp & 1) * 8, e = n == 0 ? 31 - s : s, np = n * 64 + p;
        const float pr = PWre[np * 33 + e], pi2 = PWim[np * 33 + e]; float v[8];
#pragma unroll
        for (int k = 0; k < 8; ++k) { const float br = BBre[np * 16 + ki0 + k], bi = BBim[np * 16 + ki0 + k]; v[k] = ri == 0 ? pr * br - pi2 * bi : pr * bi + pi2 * br; }
        u32x4 w; w.x = cvt_pk_bf16(v[0], v[1]); w.y = cvt_pk_bf16(v[2], v[3]); w.z = cvt_pk_bf16(v[4], v[5]); w.w = cvt_pk_bf16(v[6], v[7]);
        *(u32x4*)(WGg + (size_t)(512 + q) * 512 + cp * 8) = w;
    }
    for (int i = 0; i < 32; ++i) {
        const int idx = tid + 512 * i, row = idx >> 5, q0 = (idx & 31) * 8, n = q0 >> 7, ri = (q0 >> 6) & 1, p0 = q0 & 63, t = row >> 4, ko = row & 15, e = n == 0 ? t + 1 : 32 - t; float v[8];
#pragma unroll
        for (int k = 0; k < 8; ++k) { const int np = n * 64 + p0 + k; const float cr = CCre[np * 16 + ko], ci = CCim[np * 16 + ko], pr = PWre[np * 33 + e], pi2 = PWim[np * 33 + e];
            v[k] = ri == 0 ? cr * pr - ci * pi2 : -(cr * pi2 + ci * pr); }
        u32x4 w; w.x = cvt_pk_bf16(v[0], v[1]); w.y = cvt_pk_bf16(v[2], v[3]); w.z = cvt_pk_bf16(v[4], v[5]); w.w = cvt_pk_bf16(v[6], v[7]);
        *(u32x4*)(WCg + (size_t)row * 256 + q0) = w;
    }
    __syncthreads();
}


#ifndef DIAG
#define DIAG 0
#endif
__device__ __forceinline__ void diag_ffn(const float* const* in, const unsigned char* ws, const float* outp, unsigned* flagw, int gtid, int GT) {
    const bf16_t* h1 = (const bf16_t*)(ws + WS_HB); const bf16_t* T = (const bf16_t*)(ws + WS_T); const float* V2 = (const float*)(ws + WS_V2);
    const float *w1 = in[29], *b1 = in[30], *w2 = in[31], *b2 = in[32], *wp = in[33], *wg = in[34], *bg = in[35], *pp = in[1];
    for (int sidx = gtid; sidx < 16384; sidx += GT) {
        unsigned hsh = (unsigned)sidx * 2654435761u, h2 = ((unsigned)sidx + 977u) * 2246822519u; const int r = (hsh >> 8) % SEQ; const int c = (h2 >> 6) % DFF; const int c2 = c % DM;
        float a = b1[c]; for (int k = 0; k < DM; ++k) a += bfu(h1[(size_t)r * DM + k]) * w1[(size_t)k * DFF + c];
        a = fmaxf(a, 0.f); a = a * a; const float tv = bfu(T[(size_t)r * DFF + c]);
        if (fabsf(tv - a) > 0.008f * fabsf(a) + 0.006f) atomicAdd(flagw + 0, 1u);
        float f = b2[c2]; for (int k = 0; k < DFF; ++k) f += bfu(T[(size_t)r * DFF + k]) * w2[(size_t)k * DM + c2];
        float gt = bg[c2]; for (int k = 0; k < DM; ++k) gt += bfu(h1[(size_t)r * DM + k]) * wg[(size_t)k * DM + c2];
        float pw = 0.f; for (int k = 0; k < PLE; ++k) pw += pp[(size_t)r * PLE + k] * wp[(size_t)k * DM + c2];
        const float v2 = DN_ALPHA * bfu(h1[(size_t)r * DM + c2]) + f + fast_sigmoid(gt) * pw; const float got = V2[(size_t)r * DM + c2];
        if (fabsf(got - v2) > 0.008f * fabsf(v2) + 0.006f) atomicAdd(flagw + 1, 1u);
        { const float* vr = V2 + (size_t)r * DM; float m = 0.f; for (int k = 0; k < DM; ++k) m += vr[k]; m /= DM; float v = 0.f; for (int k = 0; k < DM; ++k) { const float d = vr[k] - m; v += d * d; } v /= DM;
          const float e = (vr[c2] - m) / sqrtf(v + LN_EPS) * in[36][c2] + in[37][c2]; const float go = outp[(size_t)r * DM + c2]; if (fabsf(go - e) > 0.004f * fabsf(e) + 0.003f) atomicAdd(flagw + 2, 1u); }
    }
}

__device__ __forceinline__ void diag_pre(const float* const* in, const unsigned char* ws, const unsigned char* dout, unsigned* flagw, int gtid, int GT) {
    const bf16_t* h0 = (const bf16_t*)(ws + WS_HB); const bf16_t* U = (const bf16_t*)(dout + DO_U); const bf16_t* XRb = (const bf16_t*)(ws + WS_XR) + 2048; const bf16_t* Z = (const bf16_t*)(dout + DO_Z);
    const bf16_t* ypre = (const bf16_t*)(dout + DO_YPRE); const bf16_t* ycat = (const bf16_t*)(ws + WS_YCAT); const bf16_t* yg = (const bf16_t*)(ws + WS_YS5G);
    const float *x = in[0], *lg = in[2], *lb = in[3], *win = in[4], *bin = in[5], *gw_ = in[14], *gb = in[15], *g5 = in[23], *gr = in[24];
    for (int sidx = gtid; sidx < 8192; sidx += GT) {
        unsigned hsh = (unsigned)sidx * 2654435761u, h2 = ((unsigned)sidx + 977u) * 2246822519u; const int r = (hsh >> 8) % SEQ; const int c = (h2 >> 6) % DIN; const int c2 = c % DM; const int c1 = c % DS5;
        { float m = 0.f; for (int k = 0; k < DM; ++k) m += x[(size_t)r * DM + k]; m /= DM; float v = 0.f; for (int k = 0; k < DM; ++k) { const float d = x[(size_t)r * DM + k] - m; v += d * d; } v /= DM;
          const float e = (x[(size_t)r * DM + c2] - m) / sqrtf(v + LN_EPS) * lg[c2] + lb[c2]; const float got = bfu(h0[(size_t)r * DM + c2]); if (fabsf(got - e) > 0.008f * fabsf(e) + 0.006f) atomicAdd(flagw + 0, 1u); }
        { float a = bin[c]; for (int k = 0; k < DM; ++k) a += bfu(h0[(size_t)r * DM + k]) * win[(size_t)k * DIN + c];
          const float got = c < 1024 ? bfu(U[(size_t)r * 1024 + c]) : (c < 2048 ? bfu(XRb[(size_t)r * 1024 + c - 1024]) : bfu(Z[(size_t)r * 1024 + c - 2048])); if (fabsf(got - a) > 0.008f * fabsf(a) + 0.006f) atomicAdd(flagw + 3, 1u); }
        { const int hf = c2 >> 10; float ss = 0.f; for (int k = 0; k < 1024; ++k) { const float y = bfu(ypre[(size_t)r * DM + hf * 1024 + k]); ss += y * y; }
          const float e = bfu(ypre[(size_t)r * DM + c2]) / sqrtf(ss / 1024.f + LN_EPS) * (hf ? gr[c2 - 1024] : g5[c2]); const float got = bfu(ycat[(size_t)r * DM + c2]); if (fabsf(got - e) > 0.008f * fabsf(e) + 0.006f) atomicAdd(flagw + 1, 1u); }
        { float a = gb[c1]; for (int k = 0; k < DS5; ++k) a += bfu(yg[(size_t)r * DS5 + k]) * gw_[(size_t)k * DS5 + c1];
          const float e = bfu(yg[(size_t)r * DS5 + c1]) * fast_sigmoid(a); const float got = bfu(ypre[(size_t)r * DM + c1]); if (fabsf(got - e) > 0.008f * fabsf(e) + 0.006f) atomicAdd(flagw + 2, 1u); }
    }
}

__device__ __forceinline__ void diag_v(const float* const* in, const unsigned char* ws, const unsigned char* dout, unsigned* flagw, int gtid, int GT) {
    const bf16_t* h0 = (const bf16_t*)(ws + WS_HB); const bf16_t* ycat = (const bf16_t*)(ws + WS_YCAT); const float* V = (const float*)dout; const float *wo = in[25], *bo = in[26];
    for (int sidx = gtid; sidx < 16384; sidx += GT) { unsigned hsh = (unsigned)sidx * 2654435761u, h2 = ((unsigned)sidx + 977u) * 2246822519u; const int r = (hsh >> 8) % SEQ; const int c = (h2 >> 6) % DM;
        float a = bo[c] + DN_ALPHA * bfu(h0[(size_t)r * DM + c]); for (int k = 0; k < DM; ++k) a += bfu(ycat[(size_t)r * DM + k]) * wo[(size_t)k * DM + c];
        const float got = V[(size_t)r * DM + c]; if (fabsf(got - a) > 0.008f * fabsf(a) + 0.006f) atomicAdd(flagw + 0, 1u); }
}

__device__ __forceinline__ void diag_g(const float* const* in, const unsigned char* ws, unsigned* flagw, int gtid, int GT) {
    const bf16_t* XRp = (const bf16_t*)(ws + WS_XR); const bf16_t* G0 = (const bf16_t*)(ws + WS_G0); const bf16_t* G1 = (const bf16_t*)(ws + WS_G1);
    const float *convw = in[16], *convb = in[17], *wa = in[18], *ba = in[19], *wx = in[20], *bxx = in[21];
    for (int sidx = gtid; sidx < 16384; sidx += GT) { unsigned hsh = (unsigned)sidx * 2654435761u; unsigned h2 = ((unsigned)sidx + 12345u) * 2246822519u; const int t = (hsh >> 7) % SEQ; const int col = (h2 >> 5) % 4096;
        const int h = col >> 8, row = col & 255, bj = row >> 7, dir = (row >> 6) & 1, ch = row & 63;
        const float* W = (bj == 0 ? wa : wx) + ((size_t)(dir * 16 + h) * 64) * 64 + ch; float a = (bj == 0 ? ba : bxx)[(dir * 16 + h) * 64 + ch];
        for (int i = 0; i < 64; ++i) { const int c = 64 * h + i; float xc = convb[c];
            for (int j = 0; j < 4; ++j) xc += convw[j * 1024 + c] * bfu(XRp[(size_t)(t + j) * 1024 + c]);
            a += xc * W[(size_t)i * 64]; }
        const float got = bfu((t < 4096 ? G0 : G1)[(size_t)(t & 4095) * 4096 + col]);
        if (fabsf(got - a) > 0.008f * fabsf(a) + 0.006f) atomicAdd(flagw + 0, 1u); }
}

#ifndef DIAG_HALF
#define DIAG_HALF 1
#endif
__device__ __forceinline__ void diag_max(const unsigned char* ws, unsigned* flagw, int gtid, int GT) {
    const bf16_t* ycat = (const bf16_t*)(ws + WS_YCAT); float mx = 0.f;
    for (size_t i = gtid; i < (size_t)SEQ * 1024; i += GT) { const size_t r = i >> 10, c = (i & 1023) + DIAG_HALF * 1024; mx = fmaxf(mx, fabsf(bfu(ycat[r * DM + c]))); }
    atomicMax(flagw + 0, __float_as_uint(mx));
}

#ifndef DIAG_SEL
#define DIAG_SEL 4
#endif
__device__ __forceinline__ void diag_rows(const float* outp, unsigned* flagw, int gw, int NGW, int lane) {
    for (int row = gw; row < SEQ; row += NGW) { float mx = 0.f; for (int j = lane; j < DM; j += 64) mx = fmaxf(mx, fabsf(outp[(size_t)row * DM + j]));
#pragma unroll
        for (int o = 1; o < 64; o <<= 1) mx = fmaxf(mx, __shfl_xor(mx, o));
        if (lane == 0 && mx > 12.0f) { atomicAdd(flagw + 0, 1u); atomicMin(flagw + 1, (unsigned)row); atomicMax(flagw + 2, (unsigned)row); } }
}

__device__ __forceinline__ void diag_rows_bf(const bf16_t* p, int ld, float thr, unsigned* flagw, int gw, int NGW, int lane) {
    for (int row = gw; row < SEQ; row += NGW) { float mx = 0.f; for (int j = lane; j < ld; j += 64) mx = fmaxf(mx, fabsf(bfu(p[(size_t)row * ld + j])));
#pragma unroll
        for (int o = 1; o < 64; o <<= 1) mx = fmaxf(mx, __shfl_xor(mx, o));
        if (lane == 0 && mx > thr) { atomicAdd(flagw + 0, 1u); atomicMin(flagw + 1, (unsigned)row); atomicMax(flagw + 2, (unsigned)row); } }
}
template <int PHMASK> __global__ void __launch_bounds__(512, 2) mega(Args args) {
    extern __shared__ __attribute__((aligned(16))) unsigned char lds_raw[];
    LAS unsigned char* lds = (LAS unsigned char*)lds_raw;
    const int wave = __builtin_amdgcn_readfirstlane((int)threadIdx.x >> 6);
    const int G = gridDim.x, bx = blockIdx.x;
    const int gw = bx * 8 + wave, NGW = G * 8, GT = G * 512;
#define PH_IDS const int lane = fresh_lane(), tid = wave * 64 + lane, gtid = bx * 512 + tid; (void)tid; (void)gtid; (void)lane
    unsigned char* ws = args.ws; unsigned char* dout = (unsigned char*)args.out;
#if DIAG == 2
    const int lo = args.ph_lo, hi = 7;
#elif DIAG == 3
    const int lo = args.ph_lo, hi = 8;
#elif DIAG == 4
    const int lo = args.ph_lo, hi = 5;
#elif DIAG == 6
    const int lo = args.ph_lo, hi = 7;
#elif DIAG == 8
    const int lo = args.ph_lo, hi = 9;
#elif DIAG == 11 || DIAG == 12
    const int lo = args.ph_lo, hi = 10;
#else
    const int lo = args.ph_lo, hi = args.ph_hi;
#endif
#define IN(k) (((PHMASK >> (k)) & 1) && lo <= (k) && (k) < hi)
    unsigned nbar = 0; unsigned* gbar = (unsigned*)(ws + WS_CTR) + 32;
    if (PHMASK == 0xfff && lo == 0 && hi == NPHASE) cg::this_grid().sync();
#define SEAM(k) do { if (IN(k) && IN((k) + 1)) { ++nbar; grid_barrier(gbar, nbar * (unsigned)G, wave); } } while (0)

#define MK_RG const RgCtx RG{(const bf16_t*)(ws + WS_XR), (const bf16_t*)(ws + WS_G0), (const bf16_t*)(ws + WS_G1), (const bf16_t*)(dout + DO_Z), args.in[16], args.in[17], (const float*)(ws + WS_SP), (float*)(ws + WS_AGG), (bf16_t*)(dout + DO_YPRE)}
    if (IN(0)) { PH_IDS;
        if (bx < 64) s5_precompute(args, bx, (LAS float*)lds);
        {
            LAS float* scr = (LAS float*)(lds + wave * 16384);
            unsigned* ctr = (unsigned*)(ws + WS_CTR);
            constexpr int I_IN = (DM / 64) * (DIN / 32), I_OUT = (DM / 64) * (DM / 32), I_PG = I_OUT, I_GLU = (DS5 / 64) * (DS5 / 32), I_PW = (PLE / 64) * (DM / 32), I_LN = SEQ / 8;
            constexpr int NITEMS = I_IN + I_OUT + I_PG + I_GLU + I_PW + I_LN;
            for (;;) {
                int it = 0; if (lane == 0) it = (int)atomicAdd(ctr, 1u); it = __builtin_amdgcn_readfirstlane(it);
                if (it >= NITEMS) break;
                int r = it;
                if (r < I_LN) { for (int q = 0; q < 8; ++q) { const int row = r * 8 + q; ln_row<true>(args.in[0] + (size_t)row * DM, args.in[2], args.in[3], (bf16_t*)(ws + WS_HB) + (size_t)row * DM, lane); } continue; } r -= I_LN;
                if (r < I_IN) { transpose_item(args.in[4], DM, DIN, (bf16_t*)(ws + WS_WINT), scr, r, lane); continue; } r -= I_IN;
                if (r < I_OUT) { transpose_item(args.in[25], DM, DM, (bf16_t*)(ws + WS_WOUTT), scr, r, lane); continue; } r -= I_OUT;
                if (r < I_PG) { transpose_item(args.in[34], DM, DM, (bf16_t*)(ws + WS_PLEGT), scr, r, lane); continue; } r -= I_PG;
                if (r < I_GLU) { transpose_item(args.in[14], DS5, DS5, (bf16_t*)(ws + WS_GLUT), scr, r, lane); continue; } r -= I_GLU;
                transpose_item(args.in[33], PLE, DM, (bf16_t*)(ws + WS_PLEWT), scr, r, lane);
            }
        }
        {   const float* pp = args.in[1]; bf16_t* pb = (bf16_t*)(ws + WS_PB);
            for (int i = gtid; i < SEQ * PLE / 4; i += GT) { const f32x4 v = ((const f32x4*)pp)[i]; u32x2 w; w.x = cvt_pk_bf16(v[0], v[1]); w.y = cvt_pk_bf16(v[2], v[3]); ((u32x2*)pb)[i] = w; }
            const float *convw = args.in[16], *convb = args.in[17], *wa = args.in[18], *ba = args.in[19], *wx = args.in[20], *bxx = args.in[21], *lam = args.in[22];
            bf16_t* rgw = (bf16_t*)(ws + WS_RGW);
            for (int i = gtid; i < 16 * 256 * 32; i += GT) { const int h = i >> 13, row = (i >> 5) & 255, K0 = (i & 31) * 8, j = K0 >> 6, i0 = K0 & 63, bj = row >> 7, hp = row & 127, dir = hp >> 6, ch = hp & 63;
                const float* W = (bj == 0 ? wa : wx) + ((size_t)(dir * 16 + h) * 64) * 64 + ch; float v[8];
#pragma unroll
                for (int k = 0; k < 8; ++k) v[k] = convw[j * 1024 + 64 * h + i0 + k] * W[(size_t)(i0 + k) * 64];
                u32x4 w; w.x = cvt_pk_bf16(v[0], v[1]); w.y = cvt_pk_bf16(v[2], v[3]); w.z = cvt_pk_bf16(v[4], v[5]); w.w = cvt_pk_bf16(v[6], v[7]);
                *(u32x4*)(rgw + ((size_t)h * 256 + row) * 256 + K0) = w; }
            float* rgb = (float*)(ws + WS_RGBIAS);
            for (int i = gtid; i < 16 * 256; i += GT) { const int h = i >> 8, row = i & 255, bj = row >> 7, hp = row & 127, dir = hp >> 6, ch = hp & 63;
                const float* W = (bj == 0 ? wa : wx) + ((size_t)(dir * 16 + h) * 64) * 64 + ch; float s = (bj == 0 ? ba : bxx)[(dir * 16 + h) * 64 + ch];
                for (int k = 0; k < 64; ++k) s += convb[64 * h + k] * W[(size_t)k * 64];
                rgb[i] = s; }
            float* spt = (float*)(ws + WS_SP);
            for (int i = gtid; i < 2 * 1024; i += GT) spt[i] = -8.0f * log1pf(expf(-lam[i]));
            unsigned* xr = (unsigned*)(ws + WS_XR);
            for (int i = gtid; i < 1024; i += GT) { xr[i] = 0u; xr[(size_t)(SEQ + 2) * 512 + i] = 0u; }
        }
    }
    SEAM(0);
    if (IN(1)) { PH_IDS;
        SchedStd S; S.so.init(SEQ, DIN, G, bx); S.A = (const char*)(ws + WS_HB); S.B = (const char*)(ws + WS_WINT); S.a_tile = (size_t)256 * DM * 2; S.b_tile = (size_t)256 * DM * 2;
        EpiProj E{(bf16_t*)(dout + DO_U), (bf16_t*)(ws + WS_XR), (bf16_t*)(dout + DO_Z), args.in[5]};
        GEMM_PHASE(lds, wave, GParm{DM, DM * 2, 128, 64, 0}, S, E);
    }
    SEAM(1);
    if (IN(2)) { PH_IDS;
        { SchedS5a S{(const char*)(dout + DO_U), (const char*)(ws + WS_WG), G, bx}; EpiS5a E{(bf16_t*)(ws + WS_YINTRA), (float*)(ws + WS_S)};
          GEMM_PHASE(lds, wave, GParm{512, TC * 1024 * 2, 4 * 1024 * 2, 16, 1024}, S, E); }
        { SchedRG S{(const char*)(ws + WS_XR), (const char*)(ws + WS_RGW), G, bx}; EpiG E{(bf16_t*)(ws + WS_G0), (bf16_t*)(ws + WS_G1), (const float*)(ws + WS_RGBIAS)};
          GEMM_PHASE(lds, wave, GParm{256, 2048, 2048, 64, 0}, S, E); }
    }
    SEAM(2);
    if (IN(3)) { PH_IDS;
        if (bx < 128) {
            const int g = bx >> 1, n = bx & 1; const float* Sg = (const float*)(ws + WS_S) + (size_t)g * NCH * 256 + n * 128; LAS float* Ls = (LAS float*)lds;
            for (int i = tid; i < NCH * 32; i += 512) { const int c = i >> 5, q4 = (i & 31) * 4; *(LAS f32x4*)(Ls + c * 128 + q4) = *(const f32x4*)(Sg + (size_t)c * 256 + q4); }
            __syncthreads();
            if (wave == 0) { const int p = lane, pi = (n * 64 + g) * 64 + p;
                const float lr = fminf(args.in[6][pi], -1e-4f), li = args.in[7][pi], step = expf(args.in[8][n * 64 + g]); float ar, ai; cpow(lr * step, li * step, TC, ar, ai);
                bf16_t* hp = (bf16_t*)(ws + WS_HPREV) + (size_t)g * NCH * 256 + n * 128; float hr = 0.f, him = 0.f;
                for (int cc = 0; cc < NCH; ++cc) { const int c = n == 0 ? cc : NCH - 1 - cc;
                    hp[(size_t)c * 256 + p] = (bf16_t)(cvt_pk_bf16(hr, 0.f) & 0xffffu); hp[(size_t)c * 256 + 64 + p] = (bf16_t)(cvt_pk_bf16(him, 0.f) & 0xffffu);
                    const float sr = Ls[c * 128 + p], si = Ls[c * 128 + 64 + p]; const float nr = ar * hr - ai * him + sr, ni = ar * him + ai * hr + si; hr = nr; him = ni; } }
            __syncthreads();
        }
        { MK_RG; for (int un = bx; un < 256; un += G) rg_pass_a(RG, un & 1, un >> 1, tid); }
    }
    SEAM(3);
    if (IN(4)) { PH_IDS;
#if NAIVE_S5
        if (gw < 64) naive_s5_group(args.in, (const bf16_t*)(dout + DO_U), (float*)(ws + WS_YINTRA), (bf16_t*)(ws + WS_YS5G), gw, lane);
#else
        { SchedS5b S{(const char*)(ws + WS_HPREV), (const char*)(ws + WS_WC), G, bx}; EpiS5b E{(const bf16_t*)(ws + WS_YINTRA), (bf16_t*)(ws + WS_YS5G)};
          GEMM_PHASE(lds, wave, GParm{256, 512, 128, 64, 0}, S, E); }
#endif
#if NAIVE_RG
        { MK_RG; if (gtid < 1024) naive_rg_channel(RG, gtid); }
#else
        { MK_RG; __syncthreads(); for (int un = bx; un < 256; un += G) { rg_pass_c(RG, un & 1, un >> 1, tid, (LAS float*)lds); __syncthreads(); } }
#endif
    }
    SEAM(4);
    if (IN(5)) { PH_IDS;
        SchedStd S; S.so.init(SEQ, DS5, G, bx); S.A = (const char*)(ws + WS_YS5G); S.B = (const char*)(ws + WS_GLUT); S.a_tile = (size_t)256 * DS5 * 2; S.b_tile = (size_t)256 * DS5 * 2;
        EpiGlu E{(const bf16_t*)(ws + WS_YS5G), (bf16_t*)(dout + DO_YPRE), args.in[15]};
        GEMM_PHASE(lds, wave, GParm{DS5, DS5 * 2, 128, 64, 0}, S, E);
    }
    SEAM(5);
    if (IN(6)) { PH_IDS;
        const float *g5 = args.in[23], *gr = args.in[24];
        for (int row = gw; row < SEQ; row += NGW) { const u32x4* yr = (const u32x4*)(dout + DO_YPRE) + (size_t)row * 256; u32x4* oc = (u32x4*)(ws + WS_YCAT) + (size_t)row * 256;
            u32x4 w[4]; float s0 = 0.f, s1 = 0.f;
#pragma unroll
            for (int j = 0; j < 4; ++j) { w[j] = yr[lane + 64 * j]; const float q = bf_lo(w[j].x) * bf_lo(w[j].x) + bf_hi(w[j].x) * bf_hi(w[j].x) + bf_lo(w[j].y) * bf_lo(w[j].y) + bf_hi(w[j].y) * bf_hi(w[j].y)
                + bf_lo(w[j].z) * bf_lo(w[j].z) + bf_hi(w[j].z) * bf_hi(w[j].z) + bf_lo(w[j].w) * bf_lo(w[j].w) + bf_hi(w[j].w) * bf_hi(w[j].w); if (j < 2) s0 += q; else s1 += q; }
            const float r0 = 1.0f / sqrtf(wave_sum(s0) * (1.f / 1024.f) + LN_EPS), r1 = 1.0f / sqrtf(wave_sum(s1) * (1.f / 1024.f) + LN_EPS);
#pragma unroll
            for (int j = 0; j < 4; ++j) { const int col = (lane + 64 * j) * 8; const float rs = j < 2 ? r0 : r1; const float* gp = j < 2 ? g5 + col : gr + (col - 1024);
                const f32x4 ga = *(const f32x4*)gp, gb = *(const f32x4*)(gp + 4);
                u32x4 o; o.x = cvt_pk_bf16(bf_lo(w[j].x) * rs * ga[0], bf_hi(w[j].x) * rs * ga[1]); o.y = cvt_pk_bf16(bf_lo(w[j].y) * rs * ga[2], bf_hi(w[j].y) * rs * ga[3]);
                o.z = cvt_pk_bf16(bf_lo(w[j].z) * rs * gb[0], bf_hi(w[j].z) * rs * gb[1]); o.w = cvt_pk_bf16(bf_lo(w[j].w) * rs * gb[2], bf_hi(w[j].w) * rs * gb[3]); oc[lane + 64 * j] = o; } }
        {
            LAS float* scr = (LAS float*)(lds + wave * 16384); unsigned* ctr = (unsigned*)(ws + WS_CTR) + 16;
            constexpr int I_FF1 = (DM / 64) * (DFF / 32), I_FF2 = (DFF / 64) * (DM / 32);
            for (;;) { int it = 0; if (lane == 0) it = (int)atomicAdd(ctr, 1u); it = __builtin_amdgcn_readfirstlane(it);
                if (it >= I_FF1 + I_FF2) break;
                if (it < I_FF1) transpose_item(args.in[29], DM, DFF, (bf16_t*)(ws + WS_FF1T), scr, it, lane);
                else transpose_item(args.in[31], DFF, DM, (bf16_t*)(ws + WS_FF2T), scr, it - I_FF1, lane); }
        }
    }
    SEAM(6);
    if (IN(7)) { PH_IDS;
        SchedStd S; S.so.init(SEQ, DM, G, bx); S.A = (const char*)(ws + WS_YCAT); S.B = (const char*)(ws + WS_WOUTT); S.a_tile = (size_t)256 * DM * 2; S.b_tile = (size_t)256 * DM * 2;
        EpiRes<false> E{(const bf16_t*)(ws + WS_HB), args.in[26], (float*)dout, nullptr, nullptr};
        GEMM_PHASE(lds, wave, GParm{DM, DM * 2, 128, 64, 0}, S, E);
    }
    SEAM(7);
    if (IN(8)) { PH_IDS; for (int row = gw; row < SEQ; row += NGW) ln_row<true>((const float*)dout + (size_t)row * DM, args.in[27], args.in[28], (bf16_t*)(ws + WS_HB) + (size_t)row * DM, lane); }
    SEAM(8);
    if (IN(9)) { PH_IDS;
        { SchedStd S; S.so.init(SEQ, DFF, G, bx); S.A = (const char*)(ws + WS_HB); S.B = (const char*)(ws + WS_FF1T); S.a_tile = (size_t)256 * DM * 2; S.b_tile = (size_t)256 * DM * 2;
          EpiPlain<1> E{(bf16_t*)(ws + WS_T), DFF, args.in[30]}; GEMM_PHASE(lds, wave, GParm{DM, DM * 2, 128, 64, 0}, S, E); }
        { SchedStd S; S.so.init(SEQ, DM, G, bx); S.A = (const char*)(ws + WS_HB); S.B = (const char*)(ws + WS_PLEGT); S.a_tile = (size_t)256 * DM * 2; S.b_tile = (size_t)256 * DM * 2;
          EpiPlain<2> E{(bf16_t*)(dout + DO_SG), DM, args.in[35]}; GEMM_PHASE(lds, wave, GParm{DM, DM * 2, 128, 64, 0}, S, E); }
        { SchedStd S; S.so.init(SEQ, DM, G, bx); S.A = (const char*)(ws + WS_PB); S.B = (const char*)(ws + WS_PLEWT); S.a_tile = (size_t)256 * PLE * 2; S.b_tile = (size_t)256 * PLE * 2;
          EpiPlain<0> E{(bf16_t*)(dout + DO_PW), DM, nullptr}; GEMM_PHASE(lds, wave, GParm{PLE, PLE * 2, 128, 64, 0}, S, E); }
    }
    SEAM(9);
    if (IN(10)) { PH_IDS;
        SchedStd S; S.so.init(SEQ, DM, G, bx); S.A = (const char*)(ws + WS_T); S.B = (const char*)(ws + WS_FF2T); S.a_tile = (size_t)256 * DFF * 2; S.b_tile = (size_t)256 * DFF * 2;
        EpiRes<true> E{(const bf16_t*)(ws + WS_HB), args.in[32], (float*)(ws + WS_V2), (const bf16_t*)(dout + DO_SG), (const bf16_t*)(dout + DO_PW)};
        GEMM_PHASE(lds, wave, GParm{DFF, DFF * 2, 128, 64, 0}, S, E);
    }
    SEAM(10);
    if (IN(11)) { PH_IDS; for (int row = gw; row < SEQ; row += NGW) ln_row<false>((const float*)(ws + WS_V2) + (size_t)row * DM, args.in[36], args.in[37], args.out + (size_t)row * DM, lane); }
#if DIAG
    { ++nbar; grid_barrier(gbar, nbar * (unsigned)G, wave); PH_IDS; unsigned* flagw = (unsigned*)(ws + WS_CTR) + 48;
#if DIAG == 1
      diag_ffn(args.in, ws, args.out, flagw, gtid, GT);
#elif DIAG == 2
      diag_pre(args.in, ws, dout, flagw, gtid, GT);
#elif DIAG == 3
      diag_v(args.in, ws, dout, flagw, gtid, GT);
#elif DIAG == 4
      diag_g(args.in, ws, flagw, gtid, GT);
#elif DIAG == 6
      diag_max(ws, flagw, gtid, GT);
#else
      if (bx == 0 && tid == 0) flagw[1] = 0xffffffffu;
      ++nbar; grid_barrier(gbar, nbar * (unsigned)G, wave);
#if DIAG == 7
      diag_rows(args.out, flagw, gw, NGW, lane);
#elif DIAG == 8
      diag_rows_bf((const bf16_t*)(ws + WS_HB), DM, 12.0f, flagw, gw, NGW, lane);
#elif DIAG == 9
      diag_rows((const float*)(ws + WS_V2), flagw, gw, NGW, lane);
#elif DIAG == 10
      diag_rows_bf((const bf16_t*)(ws + WS_T), DFF, 150.0f, flagw, gw, NGW, lane);
#elif DIAG == 11
      diag_rows_bf((const bf16_t*)(dout + DO_PW), DM, 8.0f, flagw, gw, NGW, lane);
#elif DIAG == 12
      diag_rows_bf((const bf16_t*)(dout + DO_SG), DM, 1.01f, flagw, gw, NGW, lane);
#endif
#endif
      ++nbar; grid_barrier(gbar, nbar * (unsigned)G, wave);
#if DIAG != 1
      for (int i = gtid; i < SEQ * DM; i += GT) args.out[i] = 0.f;
      ++nbar; grid_barrier(gbar, nbar * (unsigned)G, wave);
#endif
      if (bx == 0 && tid == 0) { unsigned code = 0; for (int q = 0; q < 4; ++q) if (__hip_atomic_load(flagw + q, __ATOMIC_RELAXED, __HIP_MEMORY_SCOPE_AGENT) > 100u) code |= 1u << q; if (DIAG >= 7) { const unsigned cnt = __hip_atomic_load(flagw, __ATOMIC_RELAXED, __HIP_MEMORY_SCOPE_AGENT), mn = __hip_atomic_load(flagw + 1, __ATOMIC_RELAXED, __HIP_MEMORY_SCOPE_AGENT), mxr = __hip_atomic_load(flagw + 2, __ATOMIC_RELAXED, __HIP_MEMORY_SCOPE_AGENT);
          const unsigned v = DIAG_SEL == 0 ? cnt : DIAG_SEL == 1 ? mn / 100u : DIAG_SEL == 2 ? mn % 100u : DIAG_SEL == 3 ? mxr / 100u : mxr % 100u; args.out[0] = 100.0f * (float)(v + 1u); }
      else args.out[0] = (DIAG == 6) ? 1000.0f * __uint_as_float(__hip_atomic_load(flagw, __ATOMIC_RELAXED, __HIP_MEMORY_SCOPE_AGENT)) : 1000.0f * (float)(code + 16u); } }
#endif
#undef IN
#undef SEAM
}


#if PER_PHASE_LAUNCH
template <int PH> static void set_attr_one() { (void)hipFuncSetAttribute((const void*)mega<(1 << PH)>, hipFuncAttributeMaxDynamicSharedMemorySize, LDS_BYTES); }
template <int PH> static void launch_one(Args a, int grid, hipStream_t stream) { a.ph_lo = PH; a.ph_hi = PH + 1; hipLaunchKernelGGL(mega<(1 << PH)>, dim3(grid), dim3(512), LDS_BYTES, stream, a); }
static void set_attrs() { set_attr_one<0>(); set_attr_one<1>(); set_attr_one<2>(); set_attr_one<3>(); set_attr_one<4>(); set_attr_one<5>(); set_attr_one<6>(); set_attr_one<7>(); set_attr_one<8>(); set_attr_one<9>(); set_attr_one<10>(); set_attr_one<11>(); }
static void launch_phases(const Args& a, int grid, hipStream_t stream) { launch_one<0>(a, grid, stream); launch_one<1>(a, grid, stream); launch_one<2>(a, grid, stream); launch_one<3>(a, grid, stream); launch_one<4>(a, grid, stream); launch_one<5>(a, grid, stream);
    launch_one<6>(a, grid, stream); launch_one<7>(a, grid, stream); launch_one<8>(a, grid, stream); launch_one<9>(a, grid, stream); launch_one<10>(a, grid, stream); launch_one<11>(a, grid, stream); }
#else
static void set_attrs() { (void)hipFuncSetAttribute((const void*)mega<0xfff>, hipFuncAttributeMaxDynamicSharedMemorySize, LDS_BYTES); }
#endif

extern "C" void kernel_launch(void* const* d_in, const int* in_sizes, int n_in, void* d_out, int out_size, void* d_ws, size_t ws_size, hipStream_t stream) {
    static int grid = 0;
    if (grid == 0) {
        if (n_in != 38 || out_size != SEQ * DM || ws_size < WS_END) { fprintf(stderr, "kernel_launch: unexpected shapes (n_in %d out %d ws %zu)\n", n_in, out_size, ws_size); grid = -1; return; }
        int dev = 0, cus = 0, per_cu = 0;
        hipGetDevice(&dev); hipDeviceGetAttribute(&cus, hipDeviceAttributeMultiprocessorCount, dev);
        set_attrs();
        per_cu = 1;
        (void)hipGetLastError();
        if (per_cu < 1) per_cu = 1;
        grid = cus;
    }
    if (grid < 0) return;
#ifdef POISON_NAN
    hipMemsetAsync(d_ws, 0xFF, WS_END, stream); hipMemsetAsync(d_out, 0xFF, (size_t)64 * MiB, stream);
#endif
    hipMemsetAsync((char*)d_ws + WS_CTR, 0, 256, stream);
    Args a{};
    for (int i = 0; i < 38; ++i) a.in[i] = (const float*)d_in[i];
    a.out = (float*)d_out; a.ws = (unsigned char*)d_ws;
#if PER_PHASE_LAUNCH
    launch_phases(a, grid, stream);
#else
    a.ph_lo = 0; a.ph_hi = NPHASE;
    void* kargs[] = {&a};
    hipError_t e = hipLaunchCooperativeKernel((const void*)mega<0xfff>, dim3(grid), dim3(512), kargs, LDS_BYTES, stream);
    if (e != hipSuccess) fprintf(stderr, "cooperative launch failed: %s (grid %d)\n", hipGetErrorString(e), grid);
#endif
}
```

```cpp
#include <hip/hip_runtime.h>
#include <hip/hip_cooperative_groups.h>
#include <cstdio>
#include <cstdint>
namespace cg = cooperative_groups;

#ifndef PER_PHASE_LAUNCH
#define PER_PHASE_LAUNCH 0
#endif

#define LAS __attribute__((address_space(3)))
typedef unsigned short bf16_t;
typedef short bf16x8 __attribute__((ext_vector_type(8)));
typedef float f32x4 __attribute__((ext_vector_type(4)));
typedef float f32x2 __attribute__((ext_vector_type(2)));
typedef unsigned u32x4 __attribute__((ext_vector_type(4)));
typedef unsigned u32x2 __attribute__((ext_vector_type(2)));

constexpr int SEQ = 8192, DM = 2048, DIN = 3072, DS5 = 1024, DRG = 1024, NG = 64, NP = 64, NK = 16, NH = 16, HD = 64, DFF = 8192, PLE = 256;
constexpr int TC = 32, NCH = SEQ / TC;
constexpr float LN_EPS = 1e-5f, DN_ALPHA = 1.18920711500272f;
constexpr int NPHASE = 12;

constexpr size_t MiB = (size_t)1 << 20;
constexpr size_t WS_FF2T = 0, WS_HB = 32 * MiB, WS_FF1T = 64 * MiB, WS_PLEGT = 96 * MiB, WS_PLEWT = 104 * MiB, WS_PB = 105 * MiB, WS_WOUTT = 109 * MiB,
    WS_V2 = 64 * MiB, WS_G0 = 0, WS_G1 = 64 * MiB,
    WS_WG = 128 * MiB, WS_WC = 176 * MiB, WS_RGW = 192 * MiB, WS_GLUT = 194 * MiB, WS_XR = 196 * MiB, WS_YINTRA = 213 * MiB, WS_S = 229 * MiB, WS_HPREV = 245 * MiB, WS_WINT = 229 * MiB,
    WS_YS5G = 128 * MiB, WS_YCAT = 144 * MiB, WS_T = 128 * MiB,
    WS_AGG = 256 * MiB, WS_CARRY = 258 * MiB, WS_SUMSQ = 259 * MiB, WS_RGBIAS = 259 * MiB + 64 * 1024, WS_SP = WS_RGBIAS + 16 * 1024, WS_CTR = WS_SP + 8 * 1024, WS_END = 260 * MiB;
constexpr size_t DO_YPRE = 0, DO_Z = 32 * MiB, DO_U = 48 * MiB, DO_SG = 0, DO_PW = 32 * MiB;
constexpr int LDS_BYTES = 144 * 1024;

typedef __bf16 bf16x2_t __attribute__((ext_vector_type(2)));
__device__ __forceinline__ unsigned cvt_pk_bf16(float lo, float hi) { const f32x2 v = {lo, hi}; const bf16x2_t b = __builtin_convertvector(v, bf16x2_t); return __builtin_bit_cast(unsigned, b); }
__device__ __forceinline__ float bf_lo(unsigned w) { return __uint_as_float(w << 16); }
__device__ __forceinline__ float bf_hi(unsigned w) { return __uint_as_float(w & 0xffff0000u); }
__device__ __forceinline__ f32x4 bf4(u32x2 w) { return (f32x4){bf_lo(w.x), bf_hi(w.x), bf_lo(w.y), bf_hi(w.y)}; }
__device__ __forceinline__ float fast_sigmoid(float x) { return __builtin_amdgcn_rcpf(1.0f + __expf(-x)); }
__device__ __forceinline__ float gelu_tanh(float x) { const float u = 1.5957691216057308f * (x + 0.044715f * x * x * x); return x * fast_sigmoid(u); }
__device__ __forceinline__ float wave_sum(float v) {
#pragma unroll
    for (int o = 1; o < 64; o <<= 1) v += __shfl_xor(v, o);
    return v;
}
__device__ __forceinline__ int lane_id() { return (int)__builtin_amdgcn_mbcnt_hi(~0u, __builtin_amdgcn_mbcnt_lo(~0u, 0u)); }
__device__ __forceinline__ int fresh_lane() { unsigned z = 0; asm volatile("" : "+s"(z)); return (int)__builtin_amdgcn_mbcnt_hi(~0u, __builtin_amdgcn_mbcnt_lo(~0u, z)); }
#define LDS_WAIT() asm volatile("s_waitcnt lgkmcnt(0)" ::: "memory")

namespace pg8 {
constexpr int BM = 256, BK = 64, HALF = 128, HTB = HALF * BK * 2, STAGE_BYTES = 8 * HTB, NXCD = 8, WGM = 8;
__host__ __device__ __forceinline__ int lds_byte(int r, int c) { const int st = (r >> 4) * 2 + (c >> 5), rr = r & 15, cc = c & 31, ob = rr * 64 + cc * 2; return st * 1024 + (ob ^ (((ob >> 9) & 1) << 5)); }
__host__ __device__ __forceinline__ void stage_rc(int b, int& R, int& C) { const int st = b / 1024, sb = b % 1024, swz = sb ^ (((sb >> 9) & 1) << 5); R = (st >> 1) * 16 + swz / 64; C = (st & 1) * 32 + (swz % 64) / 2; }
__host__ __device__ __forceinline__ int perm32(int rho) { const int n = rho >> 4, i = rho & 15; return 8 * (i >> 2) + 4 * n + (i & 3); }

struct Unit { int pm, pn; };
struct StaticOrder {
    int nM, nN, nwg, G, c;
    __host__ __device__ void init(int M, int N, int G_, int c_) { nM = M / BM; nN = N / BM; nwg = nM * nN; G = G_; c = c_; }
    __host__ __device__ bool next(int i, Unit& u) const {
        const long L = (long)i * G + c; if (L >= nwg) return false;
        int wgid = (int)L; { const int q = nwg / NXCD, r = nwg % NXCD, xcd = wgid % NXCD, off = wgid / NXCD; wgid = (xcd < r ? xcd * (q + 1) : r * (q + 1) + (xcd - r) * q) + off; }
        const int nig = WGM * nN, gid = wgid / nig, fm = gid * WGM, gsz = (nM - fm) < WGM ? (nM - fm) : WGM;
        u.pm = fm + ((wgid % nig) % gsz); u.pn = (wgid % nig) / gsz; return true;
    }
};
struct GUnit { const char* A; const char* B; int i0, i1; };
struct GParm { int K; unsigned a_rs, a_ks; int a_cw, a_cs; };

template <class Epi, class Sched>
__device__ __forceinline__ void gemm_phase(LAS unsigned char* lds, const int wid, const GParm gp, const Sched& S, const Epi& E) {
    const int lane = fresh_lane(), tid = wid * 64 + lane, wr = wid >> 2, wc = wid & 3, fr = lane & 15, fq = lane >> 4;
    const int K = gp.K, nt = K / BK;
    unsigned voffA[2], voffB[2];
#pragma unroll
    for (int i = 0; i < 2; ++i) { int R, C; stage_rc(tid * 16 + i * 8192, R, C); const int Rb = Epi::PERM ? ((R & ~31) + perm32(R & 31)) : R;
        voffA[i] = (unsigned)R * gp.a_rs + (unsigned)((C / gp.a_cw) * gp.a_cs + (C % gp.a_cw)) * 2u; voffB[i] = (unsigned)(Rb * K + C) * 2u; }
    const size_t ksA = gp.a_ks, ksB = (size_t)(BK * 2);
    const size_t hsA = (size_t)HALF * gp.a_rs, hsB = (size_t)HALF * K * 2;
    const unsigned ldsw = (unsigned)wid * 1024u;
    const int aoff = lds_byte(wr * 64 + fr, fq * 8), boff = lds_byte(wc * 32 + fr, fq * 8);
#define PG8_SA(b, h) (((b) * 2 + (h)) * HTB)
#define PG8_SB(b, h) ((4 + (b) * 2 + (h)) * HTB)
#define PG8_STAGE(bufoff, gbase, voff) do { _Pragma("unroll") for (int _i = 0; _i < 2; ++_i) \
        __builtin_amdgcn_global_load_lds((const unsigned*)((const char*)(gbase) + (voff)[_i]), (LAS unsigned*)(lds + (bufoff) + ldsw + _i * 8192), 16, 0, 0); } while (0)
#define PG8_LDA(dst, b, h) do { _Pragma("unroll") for (int m = 0; m < 4; ++m) _Pragma("unroll") for (int k = 0; k < 2; ++k) dst[m][k] = *(const LAS bf16x8*)(lds + PG8_SA(b, h) + aoff + m * 2048 + k * 1024); } while (0)
#define PG8_LDB(dst, b, h) do { _Pragma("unroll") for (int n = 0; n < 2; ++n) _Pragma("unroll") for (int k = 0; k < 2; ++k) dst[n][k] = *(const LAS bf16x8*)(lds + PG8_SB(b, h) + boff + n * 2048 + k * 1024); } while (0)
#define PG8_MMA(ai, bj, At, Bt) do { __builtin_amdgcn_s_setprio(1); _Pragma("unroll") for (int m = 0; m < 4; ++m) _Pragma("unroll") for (int n = 0; n < 2; ++n) _Pragma("unroll") for (int k = 0; k < 2; ++k) \
        acc[ai][bj][m][n] = __builtin_amdgcn_mfma_f32_16x16x32_bf16(Bt[n][k], At[m][k], acc[ai][bj][m][n], 0, 0, 0); __builtin_amdgcn_s_setprio(0); } while (0)
#define PG8_WAIT_V(n) asm volatile("s_waitcnt vmcnt(" #n ")" ::: "memory")
#define PG8_WAIT_L(n) asm volatile("s_waitcnt lgkmcnt(" #n ")" ::: "memory")
#define PG8_BAR __builtin_amdgcn_s_barrier()
#define PG8_SCHED __builtin_amdgcn_sched_barrier(0)
    GUnit cur, nxt; int ui = 0;
    if (!S.next(0, cur)) return;
    f32x4 acc[2][2][4][2];
#pragma unroll
    for (int a = 0; a < 2; ++a)
#pragma unroll
        for (int b = 0; b < 2; ++b)
#pragma unroll
            for (int m = 0; m < 4; ++m)
#pragma unroll
                for (int n = 0; n < 2; ++n) acc[a][b][m][n] = (f32x4){0.f, 0.f, 0.f, 0.f};
    bf16x8 At[4][2], B0[2][2], B1[2][2];
    const char* cA = cur.A; const char* cB = cur.B;
    PG8_STAGE(PG8_SB(0, 0), cB, voffB); PG8_STAGE(PG8_SB(0, 1), cB + hsB, voffB); PG8_STAGE(PG8_SA(0, 0), cA, voffA); PG8_STAGE(PG8_SA(0, 1), cA + hsA, voffA);
    if (wr == 1) PG8_BAR;
    PG8_WAIT_V(2); PG8_BAR;
    PG8_STAGE(PG8_SB(1, 0), cB + ksB, voffB); PG8_STAGE(PG8_SA(1, 0), cA + ksA, voffA); PG8_STAGE(PG8_SB(1, 1), cB + hsB + ksB, voffB);
    PG8_WAIT_V(6); PG8_BAR;
    for (;;) {
        const bool has_next = S.next(ui + 1, nxt);
        const char* nA = has_next ? nxt.A : cA; const char* nB = has_next ? nxt.B : cB;
        for (int t = 0; t < nt; t += 2) {
            const bool last = (t == nt - 2);
            const char* a1 = cA + (size_t)(t + 1) * ksA;
            const char* a2 = last ? nA : cA + (size_t)(t + 2) * ksA; const char* b2 = last ? nB : cB + (size_t)(t + 2) * ksB;
            const char* a3 = a2 + ksA; const char* b3 = b2 + ksB;
            PG8_LDB(B0, 0, 0); PG8_LDB(B1, 0, 1); PG8_SCHED; PG8_LDA(At, 0, 0); PG8_STAGE(PG8_SA(1, 1), a1 + hsA, voffA);
            PG8_WAIT_V(8); PG8_WAIT_L(0); PG8_BAR; PG8_MMA(0, 0, At, B0); PG8_MMA(0, 1, At, B1); PG8_BAR; PG8_SCHED;
            PG8_LDA(At, 0, 1); PG8_STAGE(PG8_SB(0, 0), b2, voffB); PG8_STAGE(PG8_SB(0, 1), b2 + hsB, voffB); PG8_STAGE(PG8_SA(0, 0), a2, voffA);
            PG8_WAIT_V(8); PG8_WAIT_L(0); PG8_BAR; PG8_MMA(1, 0, At, B0); PG8_MMA(1, 1, At, B1); PG8_BAR; PG8_SCHED;
            PG8_LDB(B0, 1, 0); PG8_LDB(B1, 1, 1); PG8_SCHED; PG8_LDA(At, 1, 0); PG8_STAGE(PG8_SA(0, 1), a2 + hsA, voffA);
            PG8_WAIT_V(8); PG8_WAIT_L(0); PG8_BAR; PG8_MMA(0, 0, At, B0); PG8_MMA(0, 1, At, B1); PG8_BAR; PG8_SCHED;
            PG8_LDA(At, 1, 1); PG8_STAGE(PG8_SB(1, 0), b3, voffB); PG8_STAGE(PG8_SB(1, 1), b3 + hsB, voffB); PG8_STAGE(PG8_SA(1, 0), a3, voffA);
            PG8_WAIT_V(8); PG8_WAIT_L(0); PG8_BAR; PG8_MMA(1, 0, At, B0); PG8_MMA(1, 1, At, B1); PG8_BAR; PG8_SCHED;
        }
        if (wr == 0) PG8_BAR;
        { const int l_o = fresh_lane(); E(acc, cur, wr, wc, l_o & 15, l_o >> 4); }
        if (!has_next) break;
#pragma unroll
        for (int a = 0; a < 2; ++a)
#pragma unroll
            for (int b = 0; b < 2; ++b)
#pragma unroll
                for (int m = 0; m < 4; ++m)
#pragma unroll
                    for (int n = 0; n < 2; ++n) acc[a][b][m][n] = (f32x4){0.f, 0.f, 0.f, 0.f};
        cur = nxt; cA = nA; cB = nB; ++ui;
        if (wr == 1) PG8_BAR;
    }
    PG8_WAIT_V(0);
    PG8_BAR;
#undef PG8_SA
#undef PG8_SB
#undef PG8_STAGE
#undef PG8_LDA
#undef PG8_LDB
#undef PG8_MMA
#undef PG8_WAIT_V
#undef PG8_WAIT_L
#undef PG8_BAR
#undef PG8_SCHED
}
}
using pg8::GUnit; using pg8::GParm;
typedef f32x4 AccT[2][2][4][2];

struct SchedStd {
    pg8::StaticOrder so; const char* A; const char* B; size_t a_tile, b_tile;
    __device__ __forceinline__ bool next(int i, GUnit& u) const { pg8::Unit t; if (!so.next(i, t)) return false; u.A = A + (size_t)t.pm * a_tile; u.B = B + (size_t)t.pn * b_tile; u.i0 = t.pm; u.i1 = t.pn; return true; }
};
struct SchedS5a { const char* U; const char* WG; int G, c;
    __device__ __forceinline__ bool next(int i, GUnit& u) const { const int L = i * G + c; if (L >= 192) return false; const int g = L / 3, pn = L % 3;
        u.A = U + g * 32; u.B = WG + ((size_t)g * 768 + 256 * pn) * 512 * 2; u.i0 = g; u.i1 = pn; return true; } };
struct SchedS5b { const char* HP; const char* WC; int G, c;
    __device__ __forceinline__ bool next(int i, GUnit& u) const { const int L = i * G + c; if (L >= 128) return false; const int g = L / 2, pn = L % 2;
        u.A = HP + (size_t)g * 256 * 256 * 2; u.B = WC + ((size_t)g * 512 + 256 * pn) * 256 * 2; u.i0 = g; u.i1 = pn; return true; } };
struct SchedRG { const char* XR; const char* RGW; int G, c;
    __device__ __forceinline__ bool next(int i, GUnit& u) const { const int L = i * G + c; if (L >= 512) return false; const int h = L % 16, pm = L / 16;
        u.A = XR + ((size_t)(256 * pm) * 1024 + 64 * h) * 2; u.B = RGW + (size_t)h * 256 * 256 * 2; u.i0 = pm; u.i1 = h; return true; } };

template <int ACT> __device__ __forceinline__ void epi_bf16_store(const AccT& acc, bf16_t* tile, int ldc, const float* biast, int wr, int wc, int fr, int fq) {
    const int r0 = wr * 64 + fr, c0 = wc * 32 + 8 * fq;
    f32x4 bv[2][2];
#pragma unroll
    for (int bj = 0; bj < 2; ++bj)
#pragma unroll
        for (int n = 0; n < 2; ++n) bv[bj][n] = biast ? *(const f32x4*)(biast + c0 + bj * 128 + 4 * n) : (f32x4){0.f, 0.f, 0.f, 0.f};
#pragma unroll
    for (int ai = 0; ai < 2; ++ai)
#pragma unroll
        for (int m = 0; m < 4; ++m) { bf16_t* rowp = tile + (size_t)(r0 + ai * 128 + m * 16) * ldc + c0;
#pragma unroll
            for (int bj = 0; bj < 2; ++bj) { f32x4 v0 = acc[ai][bj][m][0] + bv[bj][0], v1 = acc[ai][bj][m][1] + bv[bj][1];
                if (ACT == 1) {
#pragma unroll
                    for (int j = 0; j < 4; ++j) { const float a = fmaxf(v0[j], 0.f), b = fmaxf(v1[j], 0.f); v0[j] = a * a; v1[j] = b * b; } }
                if (ACT == 2) {
#pragma unroll
                    for (int j = 0; j < 4; ++j) { v0[j] = fast_sigmoid(v0[j]); v1[j] = fast_sigmoid(v1[j]); } }
                u32x4 w; w.x = cvt_pk_bf16(v0[0], v0[1]); w.y = cvt_pk_bf16(v0[2], v0[3]); w.z = cvt_pk_bf16(v1[0], v1[1]); w.w = cvt_pk_bf16(v1[2], v1[3]);
                *(u32x4*)(rowp + bj * 128) = w; } }
}
struct EpiProj { static constexpr bool PERM = true; bf16_t *U, *XR, *Z; const float* bias;
    __device__ __forceinline__ void operator()(AccT& acc, const GUnit& u, int wr, int wc, int fr, int fq) const {
        const int pm = u.i0, pn = u.i1; bf16_t* base = pn < 4 ? U : (pn < 8 ? XR + 2 * 1024 : Z);
        epi_bf16_store<0>(acc, base + (size_t)pm * 256 * 1024 + (pn & 3) * 256, 1024, bias + pn * 256, wr, wc, fr, fq); } };
template <int ACT> struct EpiPlain { static constexpr bool PERM = true; bf16_t* O; int ldc; const float* bias;
    __device__ __forceinline__ void operator()(AccT& acc, const GUnit& u, int wr, int wc, int fr, int fq) const {
        epi_bf16_store<ACT>(acc, O + (size_t)u.i0 * 256 * ldc + u.i1 * 256, ldc, bias ? bias + u.i1 * 256 : nullptr, wr, wc, fr, fq); } };
struct EpiS5a { static constexpr bool PERM = true; bf16_t* YI; float* S;
    __device__ __forceinline__ void operator()(AccT& acc, const GUnit& u, int wr, int wc, int fr, int fq) const {
        const int g = u.i0, pn = u.i1;
#pragma unroll
        for (int ai = 0; ai < 2; ++ai)
#pragma unroll
            for (int m = 0; m < 4; ++m) { const int r = ai * 128 + wr * 64 + m * 16 + fr;
#pragma unroll
                for (int bj = 0; bj < 2; ++bj) { const int c8 = bj * 128 + wc * 32 + 8 * fq; const f32x4 v0 = acc[ai][bj][m][0], v1 = acc[ai][bj][m][1];
                    if (pn < 2) { const int col = pn * 256 + c8, t = col >> 4, k0 = col & 15;
                        u32x4 w; w.x = cvt_pk_bf16(v0[0], v0[1]); w.y = cvt_pk_bf16(v0[2], v0[3]); w.z = cvt_pk_bf16(v1[0], v1[1]); w.w = cvt_pk_bf16(v1[2], v1[3]);
                        *(u32x4*)(YI + (size_t)(r * TC + t) * 1024 + g * 16 + k0) = w; }
                    else { float* sp = S + ((size_t)g * NCH + r) * 256 + c8; *(f32x4*)sp = v0; *(f32x4*)(sp + 4) = v1; } } }
    } };
struct EpiS5b { static constexpr bool PERM = true; const bf16_t* YI; bf16_t* YG;
    __device__ __forceinline__ void operator()(AccT& acc, const GUnit& u, int wr, int wc, int fr, int fq) const {
        const int g = u.i0, pn = u.i1;
#pragma unroll
        for (int ai = 0; ai < 2; ++ai)
#pragma unroll
            for (int m = 0; m < 4; ++m) { const int r = ai * 128 + wr * 64 + m * 16 + fr;
#pragma unroll
                for (int bj = 0; bj < 2; ++bj) { const int col = pn * 256 + bj * 128 + wc * 32 + 8 * fq, t = col >> 4, k0 = col & 15;
                    const size_t off = (size_t)(r * TC + t) * 1024 + g * 16 + k0; const u32x4 yi = *(const u32x4*)(YI + off);
                    f32x4 v0 = acc[ai][bj][m][0] + (f32x4){bf_lo(yi.x), bf_hi(yi.x), bf_lo(yi.y), bf_hi(yi.y)}, v1 = acc[ai][bj][m][1] + (f32x4){bf_lo(yi.z), bf_hi(yi.z), bf_lo(yi.w), bf_hi(yi.w)};
#pragma unroll
                    for (int j = 0; j < 4; ++j) { v0[j] = gelu_tanh(v0[j]); v1[j] = gelu_tanh(v1[j]); }
                    u32x4 w; w.x = cvt_pk_bf16(v0[0], v0[1]); w.y = cvt_pk_bf16(v0[2], v0[3]); w.z = cvt_pk_bf16(v1[0], v1[1]); w.w = cvt_pk_bf16(v1[2], v1[3]);
                    *(u32x4*)(YG + off) = w; } }
    } };
struct EpiGlu { static constexpr bool PERM = true; const bf16_t* YG; bf16_t* YPRE; const float* bias;
    __device__ __forceinline__ void operator()(AccT& acc, const GUnit& u, int wr, int wc, int fr, int fq) const {
        const int pm = u.i0, pn = u.i1; const int c0 = pn * 256 + wc * 32 + 8 * fq;
        f32x4 bv[2][2];
#pragma unroll
        for (int bj = 0; bj < 2; ++bj)
#pragma unroll
            for (int n = 0; n < 2; ++n) bv[bj][n] = *(const f32x4*)(bias + c0 + bj * 128 + 4 * n);
#pragma unroll
        for (int ai = 0; ai < 2; ++ai)
#pragma unroll
            for (int m = 0; m < 4; ++m) { const int row = pm * 256 + ai * 128 + wr * 64 + m * 16 + fr;
#pragma unroll
                for (int bj = 0; bj < 2; ++bj) { const int col = c0 + bj * 128; const u32x4 yv = *(const u32x4*)(YG + (size_t)row * 1024 + col);
                    const f32x4 y0 = (f32x4){bf_lo(yv.x), bf_hi(yv.x), bf_lo(yv.y), bf_hi(yv.y)}, y1 = (f32x4){bf_lo(yv.z), bf_hi(yv.z), bf_lo(yv.w), bf_hi(yv.w)};
                    f32x4 v0 = acc[ai][bj][m][0] + bv[bj][0], v1 = acc[ai][bj][m][1] + bv[bj][1];
#pragma unroll
                    for (int j = 0; j < 4; ++j) { v0[j] = y0[j] * fast_sigmoid(v0[j]); v1[j] = y1[j] * fast_sigmoid(v1[j]); }
                    u32x4 w; w.x = cvt_pk_bf16(v0[0], v0[1]); w.y = cvt_pk_bf16(v0[2], v0[3]); w.z = cvt_pk_bf16(v1[0], v1[1]); w.w = cvt_pk_bf16(v1[2], v1[3]);
                    *(u32x4*)(YPRE + (size_t)row * 2048 + col) = w; }
                }
    } };
template <bool PLEADD> struct EpiRes { static constexpr bool PERM = false; const bf16_t* HBp; const float* bias; float* V; const bf16_t* SG; const bf16_t* PW;
    __device__ __forceinline__ void operator()(AccT& acc, const GUnit& u, int wr, int wc, int fr, int fq) const {
        const int pm = u.i0, pn = u.i1; const int c0 = pn * 256 + wc * 32 + 4 * fq;
        f32x4 bv[2][2];
#pragma unroll
        for (int bj = 0; bj < 2; ++bj)
#pragma unroll
            for (int n = 0; n < 2; ++n) bv[bj][n] = *(const f32x4*)(bias + c0 + bj * 128 + n * 16);
#pragma unroll
        for (int ai = 0; ai < 2; ++ai)
#pragma unroll
            for (int m = 0; m < 4; ++m) { const int row = pm * 256 + ai * 128 + wr * 64 + m * 16 + fr;
#pragma unroll
                for (int bj = 0; bj < 2; ++bj)
#pragma unroll
                    for (int n = 0; n < 2; ++n) { const size_t off = (size_t)row * 2048 + c0 + bj * 128 + n * 16;
                        f32x4 v = acc[ai][bj][m][n] + bv[bj][n] + DN_ALPHA * bf4(*(const u32x2*)(HBp + off));
                        if (PLEADD) v += bf4(*(const u32x2*)(SG + off)) * bf4(*(const u32x2*)(PW + off));
                        *(f32x4*)(V + off) = v; } }
    } };

struct EpiG { static constexpr bool PERM = true; bf16_t *G0, *G1; const float* bias;
    __device__ __forceinline__ void operator()(AccT& acc, const GUnit& u, int wr, int wc, int fr, int fq) const {
        const int pm = u.i0, h = u.i1; bf16_t* base = (pm < 16 ? G0 : G1) + (size_t)(pm & 15) * 256 * 4096 + h * 256;
        epi_bf16_store<0>(acc, base, 4096, bias + h * 256, wr, wc, fr, fq); } };
__device__ __forceinline__ float bfu(unsigned short v) { return __uint_as_float(((unsigned)v) << 16); }
__device__ __forceinline__ void rg_gate(float pa, float px, float spv, float xc, float& a, float& b) {
    const float r = fast_sigmoid(pa), ig = fast_sigmoid(px); const float la = spv * r; a = __expf(la); const float x = 2.0f * la;
    const float om = -x * (1.0f + x * (0.5f + x * (0.16666667f + x * (0.041666668f + x * (0.008333334f + x * 0.0013888889f)))));
    b = sqrtf(fmaxf(om, 0.f)) * ig * xc; }
struct RgCtx { const bf16_t *XR, *G0, *G1, *Z; const float *convw, *convb, *sp; float* agg; bf16_t* ypre; };
__device__ __forceinline__ const bf16_t* g_row(const RgCtx& R, int t) { return (t < 4096 ? R.G0 : R.G1) + (size_t)(t & 4095) * 4096; }
__device__ __forceinline__ void rg_pass_a(const RgCtx& R, int half, int seg, int tid) {
    const int c = half * 512 + tid, gcol = (c >> 6) * 256 + (c & 63), t0 = seg * 64;
    const float w0 = R.convw[c], w1 = R.convw[1024 + c], w2 = R.convw[2048 + c], w3 = R.convw[3072 + c], cb = R.convb[c], sp0 = R.sp[c], sp1 = R.sp[1024 + c];
    const bf16_t* xp = R.XR + c;
    float x0 = bfu(xp[(size_t)(t0 + 0) * 1024]), x1 = bfu(xp[(size_t)(t0 + 1) * 1024]), x2 = bfu(xp[(size_t)(t0 + 2) * 1024]);
    float Af = 1.f, Bf = 0.f, Ab = 1.f, Bb = 0.f;
    for (int tb = 0; tb < 64; tb += 16) {
        unsigned short ga0[16], ga1[16], gx0[16], gx1[16], xn[16];
#pragma unroll
        for (int i = 0; i < 16; ++i) { const int t = t0 + tb + i; const bf16_t* g = g_row(R, t) + gcol; ga0[i] = g[0]; ga1[i] = g[64]; gx0[i] = g[128]; gx1[i] = g[192]; xn[i] = xp[(size_t)(t + 3) * 1024]; }
#pragma unroll
        for (int i = 0; i < 16; ++i) { const float x3 = bfu(xn[i]); const float xc = cb + w0 * x0 + w1 * x1 + w2 * x2 + w3 * x3; x0 = x1; x1 = x2; x2 = x3;
            float a, b; rg_gate(bfu(ga0[i]), bfu(gx0[i]), sp0, xc, a, b); Bf = a * Bf + b; Af = a * Af;
            rg_gate(bfu(ga1[i]), bfu(gx1[i]), sp1, xc, a, b); Bb = Ab * b + Bb; Ab = Ab * a; }
    }
    *(f32x2*)(R.agg + ((size_t)(seg * 2 + 0) * 1024 + c) * 2) = (f32x2){Af, Bf};
    *(f32x2*)(R.agg + ((size_t)(seg * 2 + 1) * 1024 + c) * 2) = (f32x2){Ab, Bb};
}
__device__ __forceinline__ void rg_pass_c(const RgCtx& R, int half, int seg, int tid, LAS float* Lh) {
    const int c = half * 512 + tid, gcol = (c >> 6) * 256 + (c & 63), t0 = seg * 64;
    const float w0 = R.convw[c], w1 = R.convw[1024 + c], w2 = R.convw[2048 + c], w3 = R.convw[3072 + c], cb = R.convb[c], sp0 = R.sp[c], sp1 = R.sp[1024 + c];
    const f32x2* ag = (const f32x2*)R.agg;
    float hf = 0.f, hb = 0.f;
#pragma unroll 8
    for (int s2 = 0; s2 < seg; ++s2) { const f32x2 ab = ag[(size_t)(s2 * 2 + 0) * 1024 + c]; hf = ab[0] * hf + ab[1]; }
#pragma unroll 8
    for (int s2 = 127; s2 > seg; --s2) { const f32x2 ab = ag[(size_t)(s2 * 2 + 1) * 1024 + c]; hb = ab[0] * hb + ab[1]; }
    const bf16_t* xp = R.XR + c;
    {   float x0 = bfu(xp[(size_t)(t0 + 0) * 1024]), x1 = bfu(xp[(size_t)(t0 + 1) * 1024]), x2 = bfu(xp[(size_t)(t0 + 2) * 1024]);
        for (int tb = 0; tb < 64; tb += 16) {
            unsigned short ga0[16], gx0[16], xn[16];
#pragma unroll
            for (int i = 0; i < 16; ++i) { const int t = t0 + tb + i; const bf16_t* g = g_row(R, t) + gcol; ga0[i] = g[0]; gx0[i] = g[128]; xn[i] = xp[(size_t)(t + 3) * 1024]; }
#pragma unroll
            for (int i = 0; i < 16; ++i) { const float x3 = bfu(xn[i]); const float xc = cb + w0 * x0 + w1 * x1 + w2 * x2 + w3 * x3; x0 = x1; x1 = x2; x2 = x3;
                float a, b; rg_gate(bfu(ga0[i]), bfu(gx0[i]), sp0, xc, a, b); hf = a * hf + b; Lh[(tb + i) * 512 + tid] = hf; }
        }
    }
    {
        float y1 = bfu(xp[(size_t)(t0 + 64) * 1024]), y2 = bfu(xp[(size_t)(t0 + 65) * 1024]), y3 = bfu(xp[(size_t)(t0 + 66) * 1024]);
        for (int tb = 48; tb >= 0; tb -= 16) {
            unsigned short ga1[16], gx1[16], xn[16], zz[16];
#pragma unroll
            for (int i = 0; i < 16; ++i) { const int t = t0 + tb + 15 - i; const bf16_t* g = g_row(R, t) + gcol; ga1[i] = g[64]; gx1[i] = g[192]; xn[i] = xp[(size_t)t * 1024]; zz[i] = R.Z[(size_t)t * 1024 + c]; }
#pragma unroll
            for (int i = 0; i < 16; ++i) { const int tl = tb + 15 - i; const float y0 = bfu(xn[i]); const float xc = cb + w0 * y0 + w1 * y1 + w2 * y2 + w3 * y3; y3 = y2; y2 = y1; y1 = y0;
                float a, b; rg_gate(bfu(ga1[i]), bfu(gx1[i]), sp1, xc, a, b); hb = a * hb + b;
                const float o = (Lh[tl * 512 + tid] + hb) * gelu_tanh(bfu(zz[i]));
                R.ypre[(size_t)(t0 + tl) * 2048 + 1024 + c] = (bf16_t)(cvt_pk_bf16(o, 0.f) & 0xffffu); }
        }
    }
}


#ifndef NAIVE_GEMM
#define NAIVE_GEMM 0
#endif
template <class Epi, class Sched>
__device__ __forceinline__ void gemm_phase_naive(LAS unsigned char* lds, const int wid, const GParm gp, const Sched& S, const Epi& E) {
    const int lane = fresh_lane(), tid = wid * 64 + lane, wr = wid >> 2, wc = wid & 3, fr = lane & 15, fq = lane >> 4;
    GUnit cur;
    for (int ui = 0; S.next(ui, cur); ++ui) {
        f32x4 acc[2][2][4][2];
#pragma unroll
        for (int ai = 0; ai < 2; ++ai)
#pragma unroll
            for (int bj = 0; bj < 2; ++bj)
#pragma unroll
                for (int m = 0; m < 4; ++m)
#pragma unroll
                    for (int n = 0; n < 2; ++n)
#pragma unroll
                        for (int e = 0; e < 4; ++e) {
                            const int row = 128 * ai + 64 * wr + 16 * m + fr; const int col = Epi::PERM ? (128 * bj + 32 * wc + 8 * fq + 4 * n + e) : (128 * bj + 32 * wc + 16 * n + 4 * fq + e);
                            const char* ap = cur.A + (size_t)row * gp.a_rs; const char* bp = cur.B + (size_t)col * gp.K * 2; float sum = 0.f;
                            for (int k = 0; k < gp.K; k += 8) { const int kt = k >> 6, C = k & 63;
                                const u32x4 av = *(const u32x4*)(ap + (size_t)kt * gp.a_ks + ((C / gp.a_cw) * gp.a_cs + (C % gp.a_cw)) * 2), bv = *(const u32x4*)(bp + k * 2);
                                sum += bf_lo(av.x) * bf_lo(bv.x) + bf_hi(av.x) * bf_hi(bv.x) + bf_lo(av.y) * bf_lo(bv.y) + bf_hi(av.y) * bf_hi(bv.y) + bf_lo(av.z) * bf_lo(bv.z) + bf_hi(av.z) * bf_hi(bv.z) + bf_lo(av.w) * bf_lo(bv.w) + bf_hi(av.w) * bf_hi(bv.w); }
                            acc[ai][bj][m][n][e] = sum; }
        E(acc, cur, wr, wc, fr, fq);
    }
    __syncthreads();
}
#if NAIVE_GEMM
#define GEMM_PHASE gemm_phase_naive
#else
#define GEMM_PHASE pg8::gemm_phase
#endif
__device__ __forceinline__ void transpose_item(const float* W, int K, int N, bf16_t* WT, LAS float* scr, int item, int lane) {
    const int nblk = N / 64, kb = item / nblk, nb = item % nblk, k0 = 64 * kb, n0 = 64 * nb;
    const float* src = W + (size_t)k0 * N + n0 + lane;
#pragma unroll 16
    for (int i = 0; i < 64; ++i) scr[i * 65 + lane] = src[(size_t)i * N];
    LDS_WAIT();
    const int c = lane & 7;
#pragma unroll
    for (int j = 0; j < 8; ++j) { const int n = (lane >> 3) + 8 * j; const LAS float* sp = scr + (8 * c) * 65 + n;
        u32x4 o; o.x = cvt_pk_bf16(sp[0 * 65], sp[1 * 65]); o.y = cvt_pk_bf16(sp[2 * 65], sp[3 * 65]); o.z = cvt_pk_bf16(sp[4 * 65], sp[5 * 65]); o.w = cvt_pk_bf16(sp[6 * 65], sp[7 * 65]);
        *(u32x4*)(WT + (size_t)(n0 + n) * K + k0 + 8 * c) = o; }
    LDS_WAIT();
}
template <bool OUT_BF16> __device__ __forceinline__ void ln_row(const float* xrow, const float* g, const float* b, void* orow, int lane) {
    const f32x4* xr = (const f32x4*)xrow + lane; f32x4 v[8]; float s = 0.f;
#pragma unroll
    for (int j = 0; j < 8; ++j) { v[j] = xr[64 * j]; s += (v[j][0] + v[j][1]) + (v[j][2] + v[j][3]); }
    const float mean = wave_sum(s) * (1.f / DM); float s2 = 0.f;
#pragma unroll
    for (int j = 0; j < 8; ++j) { v[j] = v[j] - mean; s2 += (v[j][0] * v[j][0] + v[j][1] * v[j][1]) + (v[j][2] * v[j][2] + v[j][3] * v[j][3]); }
    const float rstd = 1.0f / sqrtf(wave_sum(s2) * (1.f / DM) + LN_EPS);
#pragma unroll
    for (int j = 0; j < 8; ++j) { const f32x4 gg = ((const f32x4*)g)[lane + 64 * j], bb = ((const f32x4*)b)[lane + 64 * j]; const f32x4 o = v[j] * rstd * gg + bb;
        if (OUT_BF16) { u32x2 w; w.x = cvt_pk_bf16(o[0], o[1]); w.y = cvt_pk_bf16(o[2], o[3]); ((u32x2*)orow)[lane + 64 * j] = w; }
        else ((f32x4*)orow)[lane + 64 * j] = o; }
}
__device__ __forceinline__ void cpow(float lrs, float th, int j, float& re, float& im) {
    double a = (double)j * (double)th * 0.15915494309189535; a -= rint(a); const float af = 2.0f * (float)a;
    const float mag = expf((float)j * lrs); re = mag * cospif(af); im = mag * sinpif(af);
}


#ifndef NAIVE_RG
#define NAIVE_RG 0
#endif
__device__ __forceinline__ void naive_rg_channel(const RgCtx& R, int c) {
    const int gcol = (c >> 6) * 256 + (c & 63);
    const float w0 = R.convw[c], w1 = R.convw[1024 + c], w2 = R.convw[2048 + c], w3 = R.convw[3072 + c], cb = R.convb[c], sp0 = R.sp[c], sp1 = R.sp[1024 + c];
    const bf16_t* xp = R.XR + c; float h = 0.f;
    for (int t = 0; t < SEQ; ++t) { const float xc = cb + w0 * bfu(xp[(size_t)t * 1024]) + w1 * bfu(xp[(size_t)(t + 1) * 1024]) + w2 * bfu(xp[(size_t)(t + 2) * 1024]) + w3 * bfu(xp[(size_t)(t + 3) * 1024]);
        const bf16_t* g = g_row(R, t) + gcol; float a, b; rg_gate(bfu(g[0]), bfu(g[128]), sp0, xc, a, b); h = a * h + b;
        R.ypre[(size_t)t * 2048 + 1024 + c] = (bf16_t)(cvt_pk_bf16(h, 0.f) & 0xffffu); }
    __builtin_amdgcn_fence(__ATOMIC_SEQ_CST, "agent");
    h = 0.f;
    for (int t = SEQ - 1; t >= 0; --t) { const float xc = cb + w0 * bfu(xp[(size_t)t * 1024]) + w1 * bfu(xp[(size_t)(t + 1) * 1024]) + w2 * bfu(xp[(size_t)(t + 2) * 1024]) + w3 * bfu(xp[(size_t)(t + 3) * 1024]);
        const bf16_t* g = g_row(R, t) + gcol; float a, b; rg_gate(bfu(g[64]), bfu(g[192]), sp1, xc, a, b); h = a * h + b;
        const size_t o = (size_t)t * 2048 + 1024 + c; const float y = (bfu(R.ypre[o]) + h) * gelu_tanh(bfu(R.Z[(size_t)t * 1024 + c]));
        R.ypre[o] = (bf16_t)(cvt_pk_bf16(y, 0.f) & 0xffffu); }
}

#ifndef NAIVE_S5
#define NAIVE_S5 0
#endif
__device__ __forceinline__ void naive_s5_group(const float* const* in, const bf16_t* U, float* tmp, bf16_t* YG, int g, int lane) {
    const float *lre = in[6], *lim = in[7], *lstep = in[8], *bre = in[9], *bim = in[10], *cre = in[11], *cim = in[12], *dd = in[13];
    for (int n = 0; n < 2; ++n) {
        const int p = lane, pi = (n * 64 + g) * 64 + p;
        const float lr = fminf(lre[pi], -1e-4f), li = lim[pi], step = expf(lstep[n * 64 + g]); float ar, ai; cpow(lr * step, li * step, 1, ar, ai);
        const float nr = ar - 1.0f, ni = ai, den = lr * lr + li * li; const float qr = (nr * lr + ni * li) / den, qi = (ni * lr - nr * li) / den;
        float hr = 0.f, hi = 0.f;
        for (int tt = 0; tt < SEQ; ++tt) { const int t = n == 0 ? tt : SEQ - 1 - tt; const bf16_t* up = U + (size_t)t * 1024 + g * 16;
            float bur = 0.f, bui = 0.f;
#pragma unroll
            for (int k = 0; k < 16; ++k) { const float uv = bfu(up[k]); const float br = bre[(size_t)pi * 16 + k], bi = bim[(size_t)pi * 16 + k]; bur += (qr * br - qi * bi) * uv; bui += (qr * bi + qi * br) * uv; }
            const float nhr = ar * hr - ai * hi + bur, nhi = ar * hi + ai * hr + bui; hr = nhr; hi = nhi;
#pragma unroll
            for (int k = 0; k < 16; ++k) { const size_t ci = ((size_t)(n * 64 + g) * 16 + k) * 64 + p; float v = cre[ci] * hr - cim[ci] * hi; v = wave_sum(v);
                if (lane == k) { const size_t o = (size_t)t * 1024 + g * 16 + k;
                    if (n == 0) tmp[o] = v; else { const float y = tmp[o] + v + dd[g * 16 + k] * bfu(up[k]); YG[o] = (bf16_t)(cvt_pk_bf16(gelu_tanh(y), 0.f) & 0xffffu); } } }
        }
        __builtin_amdgcn_fence(__ATOMIC_SEQ_CST, "agent");
    }
}

__device__ __forceinline__ void grid_barrier(unsigned* bar, unsigned target, int wave) {
    asm volatile("s_waitcnt vmcnt(0)" ::: "memory");
    __syncthreads();
    if (wave == 0) { const int l = fresh_lane();
        if (l == 0) {
            __builtin_amdgcn_fence(__ATOMIC_RELEASE, "agent"); asm volatile("s_waitcnt vmcnt(0)" ::: "memory");
            __hip_atomic_fetch_add(bar, 1u, __ATOMIC_RELAXED, __HIP_MEMORY_SCOPE_AGENT);
            while (__hip_atomic_load(bar, __ATOMIC_RELAXED, __HIP_MEMORY_SCOPE_AGENT) < target) __builtin_amdgcn_s_sleep(2);
            __builtin_amdgcn_fence(__ATOMIC_ACQUIRE, "agent"); asm volatile("s_waitcnt vmcnt(0)" ::: "memory");
        } }
    __syncthreads();
}

struct Args { const float* in[38]; float* out; unsigned char* ws; int ph_lo, ph_hi; };

__device__ __forceinline__ void s5_precompute(const Args& a, int g, int hq, int nh, LAS float* L, const int tid) {
    const float *lre = a.in[6], *lim = a.in[7], *lstep = a.in[8], *bre = a.in[9], *bim = a.in[10], *cre = a.in[11], *cim = a.in[12], *dd = a.in[13];
    LAS float *PWre = L, *PWim = L + 4224, *BBre = L + 8448, *BBim = L + 10496, *CCre = L + 12544, *CCim = L + 14592, *MT = L + 16640;
    bf16_t* WGg = (bf16_t*)(a.ws + WS_WG) + (size_t)g * 768 * 512; bf16_t* WCg = (bf16_t*)(a.ws + WS_WC) + (size_t)g * 512 * 256;
    {
        const int np = tid & 127, jj = tid >> 7, n = np >> 6, p = np & 63; const int pi = (n * 64 + g) * 64 + p;
        const float lr = fminf(lre[pi], -1e-4f), li = lim[pi], step = expf(lstep[n * 64 + g]); const float lrs = lr * step, th = li * step;
        for (int j = jj; j <= 32; j += 4) { float r, i; cpow(lrs, th, j, r, i); PWre[np * 33 + j] = r; PWim[np * 33 + j] = i; }
        float l1r, l1i; cpow(lrs, th, 1, l1r, l1i);
        const float nr = l1r - 1.0f, ni = l1i, den = lr * lr + li * li; const float qr = (nr * lr + ni * li) / den, qi = (ni * lr - nr * li) / den;
#pragma unroll
        for (int k = jj * 4; k < jj * 4 + 4; ++k) { const float br = bre[(size_t)pi * 16 + k], bi = bim[(size_t)pi * 16 + k]; BBre[np * 16 + k] = qr * br - qi * bi; BBim[np * 16 + k] = qr * bi + qi * br; }
        for (int e = tid; e < 2048; e += 512) { const int n2 = e >> 10, k = (e >> 6) & 15, p2 = e & 63; const size_t ci = ((size_t)(n2 * 64 + g) * 16 + k) * 64 + p2; CCre[(n2 * 64 + p2) * 16 + k] = cre[ci]; CCim[(n2 * 64 + p2) * 16 + k] = cim[ci]; }
    }
    __syncthreads();
    for (int i = 0; i < 2; ++i) {
        const int bq = tid + 512 * i, n = bq >> 9, j = (bq >> 4) & 31, kob = (bq >> 2) & 3, kib = bq & 3;
        f32x4 m0 = {0.f, 0.f, 0.f, 0.f}, m1 = m0, m2 = m0, m3 = m0;
        for (int p = 0; p < 64; ++p) { const int np = n * 64 + p; const float pr = PWre[np * 33 + j], pi2 = PWim[np * 33 + j];
            const f32x4 br = *(const LAS f32x4*)(BBre + np * 16 + 4 * kib), bi = *(const LAS f32x4*)(BBim + np * 16 + 4 * kib), cr = *(const LAS f32x4*)(CCre + np * 16 + 4 * kob), ci = *(const LAS f32x4*)(CCim + np * 16 + 4 * kob);
            const f32x4 er = pr * br - pi2 * bi, ei = pr * bi + pi2 * br;
            m0 += cr[0] * er - ci[0] * ei; m1 += cr[1] * er - ci[1] * ei; m2 += cr[2] * er - ci[2] * ei; m3 += cr[3] * er - ci[3] * ei; }
        LAS float* o = MT + ((n * 32 + j) * 16 + 4 * kob) * 16 + 4 * kib;
        *(LAS f32x4*)o = m0; *(LAS f32x4*)(o + 16) = m1; *(LAS f32x4*)(o + 32) = m2; *(LAS f32x4*)(o + 48) = m3;
    }
    __syncthreads();
    for (int i = hq * (64 / nh); i < (hq + 1) * (64 / nh); ++i) {
        const int idx = tid + 512 * i, row = idx >> 6, cp = idx & 63, t = row >> 4, ko = row & 15, s = cp >> 1, ki0 = (cp & 1) * 8;
        f32x4 v0, v1;
        if (t != s) { const LAS float* src = MT + (((t > s ? 0 : 1) * 32 + (t > s ? t - s : s - t)) * 16 + ko) * 16 + ki0; v0 = *(const LAS f32x4*)src; v1 = *(const LAS f32x4*)(src + 4); }
        else { const LAS float* s0 = MT + ko * 16 + ki0; const LAS float* s1 = MT + (32 * 16 + ko) * 16 + ki0; v0 = *(const LAS f32x4*)s0 + *(const LAS f32x4*)s1; v1 = *(const LAS f32x4*)(s0 + 4) + *(const LAS f32x4*)(s1 + 4);
            const float dv = dd[g * 16 + ko];
#pragma unroll
            for (int e = 0; e < 4; ++e) { if (ki0 + e == ko) v0[e] += dv; if (ki0 + 4 + e == ko) v1[e] += dv; } }
        u32x4 w; w.x = cvt_pk_bf16(v0[0], v0[1]); w.y = cvt_pk_bf16(v0[2], v0[3]); w.z = cvt_pk_bf16(v1[0], v1[1]); w.w = cvt_pk_bf16(v1[2], v1[3]);
        *(u32x4*)(WGg + (size_t)row * 512 + cp * 8) = w;
    }
    for (int i = hq * (32 / nh); i < (hq + 1) * (32 / nh); ++i) {
        const int idx = tid + 512 * i, q = idx >> 6, cp = idx & 63, n = q >> 7, ri = (q >> 6) & 1, p = q & 63, s = cp >> 1, ki0 = (cp & 1) * 8, e = n == 0 ? 31 - s : s, np = n * 64 + p;
        const float pr = PWre[np * 33 + e], pi2 = PWim[np * 33 + e]; float v[8];
#pragma unroll
        for (int k = 0; k < 8; ++k) { const float br = BBre[np * 16 + ki0 + k], bi = BBim[np * 16 + ki0 + k]; v[k] = ri == 0 ? pr * br - pi2 * bi : pr * bi + pi2 * br; }
        u32x4 w; w.x = cvt_pk_bf16(v[0], v[1]); w.y = cvt_pk_bf16(v[2], v[3]); w.z = cvt_pk_bf16(v[4], v[5]); w.w = cvt_pk_bf16(v[6], v[7]);
        *(u32x4*)(WGg + (size_t)(512 + q) * 512 + cp * 8) = w;
    }
    for (int i = hq * (32 / nh); i < (hq + 1) * (32 / nh); ++i) {
        const int idx = tid + 512 * i, row = idx >> 5, q0 = (idx & 31) * 8, n = q0 >> 7, ri = (q0 >> 6) & 1, p0 = q0 & 63, t = row >> 4, ko = row & 15, e = n == 0 ? t + 1 : 32 - t; float v[8];
#pragma unroll
        for (int k = 0; k < 8; ++k) { const int np = n * 64 + p0 + k; const float cr = CCre[np * 16 + ko], ci = CCim[np * 16 + ko], pr = PWre[np * 33 + e], pi2 = PWim[np * 33 + e];
            v[k] = ri == 0 ? cr * pr - ci * pi2 : -(cr * pi2 + ci * pr); }
        u32x4 w; w.x = cvt_pk_bf16(v[0], v[1]); w.y = cvt_pk_bf16(v[2], v[3]); w.z = cvt_pk_bf16(v[4], v[5]); w.w = cvt_pk_bf16(v[6], v[7]);
        *(u32x4*)(WCg + (size_t)row * 256 + q0) = w;
    }
    __syncthreads();
}


#ifndef DIAG
#define DIAG 0
#endif
__device__ __forceinline__ void diag_ffn(const float* const* in, const unsigned char* ws, const float* outp, unsigned* flagw, int gtid, int GT) {
    const bf16_t* h1 = (const bf16_t*)(ws + WS_HB); const bf16_t* T = (const bf16_t*)(ws + WS_T); const float* V2 = (const float*)(ws + WS_V2);
    const float *w1 = in[29], *b1 = in[30], *w2 = in[31], *b2 = in[32], *wp = in[33], *wg = in[34], *bg = in[35], *pp = in[1];
    for (int sidx = gtid; sidx < 16384; sidx += GT) {
        unsigned hsh = (unsigned)sidx * 2654435761u, h2 = ((unsigned)sidx + 977u) * 2246822519u; const int r = (hsh >> 8) % SEQ; const int c = (h2 >> 6) % DFF; const int c2 = c % DM;
        float a = b1[c]; for (int k = 0; k < DM; ++k) a += bfu(h1[(size_t)r * DM + k]) * w1[(size_t)k * DFF + c];
        a = fmaxf(a, 0.f); a = a * a; const float tv = bfu(T[(size_t)r * DFF + c]);
        if (fabsf(tv - a) > 0.008f * fabsf(a) + 0.006f) atomicAdd(flagw + 0, 1u);
        float f = b2[c2]; for (int k = 0; k < DFF; ++k) f += bfu(T[(size_t)r * DFF + k]) * w2[(size_t)k * DM + c2];
        float gt = bg[c2]; for (int k = 0; k < DM; ++k) gt += bfu(h1[(size_t)r * DM + k]) * wg[(size_t)k * DM + c2];
        float pw = 0.f; for (int k = 0; k < PLE; ++k) pw += pp[(size_t)r * PLE + k] * wp[(size_t)k * DM + c2];
        const float v2 = DN_ALPHA * bfu(h1[(size_t)r * DM + c2]) + f + fast_sigmoid(gt) * pw; const float got = V2[(size_t)r * DM + c2];
        if (fabsf(got - v2) > 0.008f * fabsf(v2) + 0.006f) atomicAdd(flagw + 1, 1u);
        { const float* vr = V2 + (size_t)r * DM; float m = 0.f; for (int k = 0; k < DM; ++k) m += vr[k]; m /= DM; float v = 0.f; for (int k = 0; k < DM; ++k) { const float d = vr[k] - m; v += d * d; } v /= DM;
          const float e = (vr[c2] - m) / sqrtf(v + LN_EPS) * in[36][c2] + in[37][c2]; const float go = outp[(size_t)r * DM + c2]; if (fabsf(go - e) > 0.004f * fabsf(e) + 0.003f) atomicAdd(flagw + 2, 1u); }
    }
}

__device__ __forceinline__ void diag_pre(const float* const* in, const unsigned char* ws, const unsigned char* dout, unsigned* flagw, int gtid, int GT) {
    const bf16_t* h0 = (const bf16_t*)(ws + WS_HB); const bf16_t* U = (const bf16_t*)(dout + DO_U); const bf16_t* XRb = (const bf16_t*)(ws + WS_XR) + 2048; const bf16_t* Z = (const bf16_t*)(dout + DO_Z);
    const bf16_t* ypre = (const bf16_t*)(dout + DO_YPRE); const bf16_t* ycat = (const bf16_t*)(ws + WS_YCAT); const bf16_t* yg = (const bf16_t*)(ws + WS_YS5G);
    const float *x = in[0], *lg = in[2], *lb = in[3], *win = in[4], *bin = in[5], *gw_ = in[14], *gb = in[15], *g5 = in[23], *gr = in[24];
    for (int sidx = gtid; sidx < 8192; sidx += GT) {
        unsigned hsh = (unsigned)sidx * 2654435761u, h2 = ((unsigned)sidx + 977u) * 2246822519u; const int r = (hsh >> 8) % SEQ; const int c = (h2 >> 6) % DIN; const int c2 = c % DM; const int c1 = c % DS5;
        { float m = 0.f; for (int k = 0; k < DM; ++k) m += x[(size_t)r * DM + k]; m /= DM; float v = 0.f; for (int k = 0; k < DM; ++k) { const float d = x[(size_t)r * DM + k] - m; v += d * d; } v /= DM;
          const float e = (x[(size_t)r * DM + c2] - m) / sqrtf(v + LN_EPS) * lg[c2] + lb[c2]; const float got = bfu(h0[(size_t)r * DM + c2]); if (fabsf(got - e) > 0.008f * fabsf(e) + 0.006f) atomicAdd(flagw + 0, 1u); }
        { float a = bin[c]; for (int k = 0; k < DM; ++k) a += bfu(h0[(size_t)r * DM + k]) * win[(size_t)k * DIN + c];
          const float got = c < 1024 ? bfu(U[(size_t)r * 1024 + c]) : (c < 2048 ? bfu(XRb[(size_t)r * 1024 + c - 1024]) : bfu(Z[(size_t)r * 1024 + c - 2048])); if (fabsf(got - a) > 0.008f * fabsf(a) + 0.006f) atomicAdd(flagw + 3, 1u); }
        { const int hf = c2 >> 10; float ss = 0.f; for (int k = 0; k < 1024; ++k) { const float y = bfu(ypre[(size_t)r * DM + hf * 1024 + k]); ss += y * y; }
          const float e = bfu(ypre[(size_t)r * DM + c2]) / sqrtf(ss / 1024.f + LN_EPS) * (hf ? gr[c2 - 1024] : g5[c2]); const float got = bfu(ycat[(size_t)r * DM + c2]); if (fabsf(got - e) > 0.008f * fabsf(e) + 0.006f) atomicAdd(flagw + 1, 1u); }
        { float a = gb[c1]; for (int k = 0; k < DS5; ++k) a += bfu(yg[(size_t)r * DS5 + k]) * gw_[(size_t)k * DS5 + c1];
          const float e = bfu(yg[(size_t)r * DS5 + c1]) * fast_sigmoid(a); const float got = bfu(ypre[(size_t)r * DM + c1]); if (fabsf(got - e) > 0.008f * fabsf(e) + 0.006f) atomicAdd(flagw + 2, 1u); }
    }
}

__device__ __forceinline__ void diag_v(const float* const* in, const unsigned char* ws, const unsigned char* dout, unsigned* flagw, int gtid, int GT) {
    const bf16_t* h0 = (const bf16_t*)(ws + WS_HB); const bf16_t* ycat = (const bf16_t*)(ws + WS_YCAT); const float* V = (const float*)dout; const float *wo = in[25], *bo = in[26];
    for (int sidx = gtid; sidx < 16384; sidx += GT) { unsigned hsh = (unsigned)sidx * 2654435761u, h2 = ((unsigned)sidx + 977u) * 2246822519u; const int r = (hsh >> 8) % SEQ; const int c = (h2 >> 6) % DM;
        float a = bo[c] + DN_ALPHA * bfu(h0[(size_t)r * DM + c]); for (int k = 0; k < DM; ++k) a += bfu(ycat[(size_t)r * DM + k]) * wo[(size_t)k * DM + c];
        const float got = V[(size_t)r * DM + c]; if (fabsf(got - a) > 0.008f * fabsf(a) + 0.006f) atomicAdd(flagw + 0, 1u); }
}

__device__ __forceinline__ void diag_g(const float* const* in, const unsigned char* ws, unsigned* flagw, int gtid, int GT) {
    const bf16_t* XRp = (const bf16_t*)(ws + WS_XR); const bf16_t* G0 = (const bf16_t*)(ws + WS_G0); const bf16_t* G1 = (const bf16_t*)(ws + WS_G1);
    const float *convw = in[16], *convb = in[17], *wa = in[18], *ba = in[19], *wx = in[20], *bxx = in[21];
    for (int sidx = gtid; sidx < 16384; sidx += GT) { unsigned hsh = (unsigned)sidx * 2654435761u; unsigned h2 = ((unsigned)sidx + 12345u) * 2246822519u; const int t = (hsh >> 7) % SEQ; const int col = (h2 >> 5) % 4096;
        const int h = col >> 8, row = col & 255, bj = row >> 7, dir = (row >> 6) & 1, ch = row & 63;
        const float* W = (bj == 0 ? wa : wx) + ((size_t)(dir * 16 + h) * 64) * 64 + ch; float a = (bj == 0 ? ba : bxx)[(dir * 16 + h) * 64 + ch];
        for (int i = 0; i < 64; ++i) { const int c = 64 * h + i; float xc = convb[c];
            for (int j = 0; j < 4; ++j) xc += convw[j * 1024 + c] * bfu(XRp[(size_t)(t + j) * 1024 + c]);
            a += xc * W[(size_t)i * 64]; }
        const float got = bfu((t < 4096 ? G0 : G1)[(size_t)(t & 4095) * 4096 + col]);
        if (fabsf(got - a) > 0.008f * fabsf(a) + 0.006f) atomicAdd(flagw + 0, 1u); }
}

#ifndef DIAG_HALF
#define DIAG_HALF 1
#endif
__device__ __forceinline__ void diag_max(const unsigned char* ws, unsigned* flagw, int gtid, int GT) {
    const bf16_t* ycat = (const bf16_t*)(ws + WS_YCAT); float mx = 0.f;
    for (size_t i = gtid; i < (size_t)SEQ * 1024; i += GT) { const size_t r = i >> 10, c = (i & 1023) + DIAG_HALF * 1024; mx = fmaxf(mx, fabsf(bfu(ycat[r * DM + c]))); }
    atomicMax(flagw + 0, __float_as_uint(mx));
}

#ifndef DIAG_SEL
#define DIAG_SEL 4
#endif
__device__ __forceinline__ void diag_rows(const float* outp, unsigned* flagw, int gw, int NGW, int lane) {
    for (int row = gw; row < SEQ; row += NGW) { float mx = 0.f; for (int j = lane; j < DM; j += 64) mx = fmaxf(mx, fabsf(outp[(size_t)row * DM + j]));
#pragma unroll
        for (int o = 1; o < 64; o <<= 1) mx = fmaxf(mx, __shfl_xor(mx, o));
        if (lane == 0 && mx > 12.0f) { atomicAdd(flagw + 0, 1u); atomicMin(flagw + 1, (unsigned)row); atomicMax(flagw + 2, (unsigned)row); } }
}

__device__ __forceinline__ void diag_rows_bf(const bf16_t* p, int ld, float thr, unsigned* flagw, int gw, int NGW, int lane) {
    for (int row = gw; row < SEQ; row += NGW) { float mx = 0.f; for (int j = lane; j < ld; j += 64) mx = fmaxf(mx, fabsf(bfu(p[(size_t)row * ld + j])));
#pragma unroll
        for (int o = 1; o < 64; o <<= 1) mx = fmaxf(mx, __shfl_xor(mx, o));
        if (lane == 0 && mx > thr) { atomicAdd(flagw + 0, 1u); atomicMin(flagw + 1, (unsigned)row); atomicMax(flagw + 2, (unsigned)row); } }
}
template <int PHMASK> __global__ void __launch_bounds__(512, 2) mega(Args args) {
    extern __shared__ __attribute__((aligned(16))) unsigned char lds_raw[];
    LAS unsigned char* lds = (LAS unsigned char*)lds_raw;
    const int wave = __builtin_amdgcn_readfirstlane((int)threadIdx.x >> 6);
    const int G = gridDim.x, bx = blockIdx.x;
    const int gw = bx * 8 + wave, NGW = G * 8, GT = G * 512;
#define PH_IDS const int lane = fresh_lane(), tid = wave * 64 + lane, gtid = bx * 512 + tid; (void)tid; (void)gtid; (void)lane
    unsigned char* ws = args.ws; unsigned char* dout = (unsigned char*)args.out;
#if DIAG == 2
    const int lo = args.ph_lo, hi = 7;
#elif DIAG == 3
    const int lo = args.ph_lo, hi = 8;
#elif DIAG == 4
    const int lo = args.ph_lo, hi = 5;
#elif DIAG == 6
    const int lo = args.ph_lo, hi = 7;
#elif DIAG == 8
    const int lo = args.ph_lo, hi = 9;
#elif DIAG == 11 || DIAG == 12
    const int lo = args.ph_lo, hi = 10;
#else
    const int lo = args.ph_lo, hi = args.ph_hi;
#endif
#define IN(k) (((PHMASK >> (k)) & 1) && lo <= (k) && (k) < hi)
    unsigned nbar = 0; unsigned* gbar = (unsigned*)(ws + WS_CTR) + 32;
    if (PHMASK == 0xfff && lo == 0 && hi == NPHASE) cg::this_grid().sync();
#ifndef DBL_MASK
#define DBL_MASK 0
#endif
#define REPS(k) (((DBL_MASK >> (k)) & 1) ? 2 : 1)
#ifndef TSTAMP
#define TSTAMP 0
#define TS_A0 3
#define TS_A1 4
#define TS_B0 9
#define TS_B1 12
#endif
#define SEAM(k) do { if (IN(k) && IN((k) + 1)) { ++nbar; grid_barrier(gbar, nbar * (unsigned)G, wave); if (TSTAMP && bx == 0 && wave == 0) { if (fresh_lane() == 0) ((unsigned long long*)(ws + WS_CTR + 1024))[(k) + 1] = __builtin_amdgcn_s_memrealtime(); } } } while (0)

#define MK_RG const RgCtx RG{(const bf16_t*)(ws + WS_XR), (const bf16_t*)(ws + WS_G0), (const bf16_t*)(ws + WS_G1), (const bf16_t*)(dout + DO_Z), args.in[16], args.in[17], (const float*)(ws + WS_SP), (float*)(ws + WS_AGG), (bf16_t*)(dout + DO_YPRE)}
    if (TSTAMP && bx == 0 && wave == 0) { if (fresh_lane() == 0) ((unsigned long long*)(ws + WS_CTR + 1024))[0] = __builtin_amdgcn_s_memrealtime(); }
    for (int rep = 0; rep < REPS(0); ++rep) {
    if (IN(0)) { PH_IDS;
        if (G != 256) { for (int g = bx; g < 64; g += G) s5_precompute(args, g, 0, 1, (LAS float*)lds, tid); }
        {
            LAS float* scr = (LAS float*)(lds + wave * 16640);
            constexpr int I_IN = (DM / 64) * (DIN / 64), I_OUT = (DM / 64) * (DM / 64), I_PG = I_OUT, I_GLU = (DS5 / 64) * (DS5 / 64), I_PW = (PLE / 64) * (DM / 64), I_LN = SEQ / 8;
            constexpr int NITEMS = I_IN + I_OUT + I_PG + I_GLU + I_PW + I_LN;
            for (int it = gw; it < NITEMS; it += NGW) {
                int r = it;
                if (r < I_IN) { transpose_item(args.in[4], DM, DIN, (bf16_t*)(ws + WS_WINT), scr, r, lane); continue; } r -= I_IN;
                if (r < I_LN) { for (int q = 0; q < 8; ++q) { const int row = r * 8 + q; ln_row<true>(args.in[0] + (size_t)row * DM, args.in[2], args.in[3], (bf16_t*)(ws + WS_HB) + (size_t)row * DM, lane); } continue; } r -= I_LN;
                if (r < I_OUT) { transpose_item(args.in[25], DM, DM, (bf16_t*)(ws + WS_WOUTT), scr, r, lane); continue; } r -= I_OUT;
                if (r < I_PG) { transpose_item(args.in[34], DM, DM, (bf16_t*)(ws + WS_PLEGT), scr, r, lane); continue; } r -= I_PG;
                if (r < I_GLU) { transpose_item(args.in[14], DS5, DS5, (bf16_t*)(ws + WS_GLUT), scr, r, lane); continue; } r -= I_GLU;
                transpose_item(args.in[33], PLE, DM, (bf16_t*)(ws + WS_PLEWT), scr, r, lane);
            }
        }
        {   const float* pp = args.in[1]; bf16_t* pb = (bf16_t*)(ws + WS_PB);
            for (int i = gtid; i < SEQ * PLE / 4; i += GT) { const f32x4 v = ((const f32x4*)pp)[i]; u32x2 w; w.x = cvt_pk_bf16(v[0], v[1]); w.y = cvt_pk_bf16(v[2], v[3]); ((u32x2*)pb)[i] = w; }
            const float *convw = args.in[16], *convb = args.in[17], *wa = args.in[18], *ba = args.in[19], *wx = args.in[20], *bxx = args.in[21], *lam = args.in[22];
            bf16_t* rgw = (bf16_t*)(ws + WS_RGW);
            for (int i = gtid; i < 16 * 256 * 32; i += GT) { const int h = i >> 13, row = (i >> 5) & 255, K0 = (i & 31) * 8, j = K0 >> 6, i0 = K0 & 63, bj = row >> 7, hp = row & 127, dir = hp >> 6, ch = hp & 63;
                const float* W = (bj == 0 ? wa : wx) + ((size_t)(dir * 16 + h) * 64) * 64 + ch; float v[8];
#pragma unroll
                for (int k = 0; k < 8; ++k) v[k] = convw[j * 1024 + 64 * h + i0 + k] * W[(size_t)(i0 + k) * 64];
                u32x4 w; w.x = cvt_pk_bf16(v[0], v[1]); w.y = cvt_pk_bf16(v[2], v[3]); w.z = cvt_pk_bf16(v[4], v[5]); w.w = cvt_pk_bf16(v[6], v[7]);
                *(u32x4*)(rgw + ((size_t)h * 256 + row) * 256 + K0) = w; }
            float* rgb = (float*)(ws + WS_RGBIAS);
            for (int i = gtid; i < 16 * 256; i += GT) { const int h = i >> 8, row = i & 255, bj = row >> 7, hp = row & 127, dir = hp >> 6, ch = hp & 63;
                const float* W = (bj == 0 ? wa : wx) + ((size_t)(dir * 16 + h) * 64) * 64 + ch; float s = (bj == 0 ? ba : bxx)[(dir * 16 + h) * 64 + ch];
                for (int k = 0; k < 64; ++k) s += convb[64 * h + k] * W[(size_t)k * 64];
                rgb[i] = s; }
            float* spt = (float*)(ws + WS_SP);
            for (int i = gtid; i < 2 * 1024; i += GT) spt[i] = -8.0f * log1pf(expf(-lam[i]));
            unsigned* xr = (unsigned*)(ws + WS_XR);
            for (int i = gtid; i < 1024; i += GT) { xr[i] = 0u; xr[(size_t)(SEQ + 2) * 512 + i] = 0u; }
        }
    }
    if (rep + 1 < REPS(0)) { ++nbar; grid_barrier(gbar, nbar * (unsigned)G, wave); } }
    SEAM(0);
    for (int rep = 0; rep < REPS(1); ++rep) {
    if (IN(1)) { PH_IDS;
        SchedStd S; S.so.init(SEQ, DIN, G, bx); S.A = (const char*)(ws + WS_HB); S.B = (const char*)(ws + WS_WINT); S.a_tile = (size_t)256 * DM * 2; S.b_tile = (size_t)256 * DM * 2;
        EpiProj E{(bf16_t*)(dout + DO_U), (bf16_t*)(ws + WS_XR), (bf16_t*)(dout + DO_Z), args.in[5]};
        GEMM_PHASE(lds, wave, GParm{DM, DM * 2, 128, 64, 0}, S, E);
        if (G == 256 && bx >= 128) { __syncthreads(); const int t2 = wave * 64 + fresh_lane(); s5_precompute(args, (bx - 128) >> 1, (bx - 128) & 1, 2, (LAS float*)lds, t2); }
    }
    if (rep + 1 < REPS(1)) { ++nbar; grid_barrier(gbar, nbar * (unsigned)G, wave); } }
    SEAM(1);
    for (int rep = 0; rep < REPS(2); ++rep) {
    if (IN(2)) { PH_IDS;
        { SchedS5a S{(const char*)(dout + DO_U), (const char*)(ws + WS_WG), G, bx}; EpiS5a E{(bf16_t*)(ws + WS_YINTRA), (float*)(ws + WS_S)};
          GEMM_PHASE(lds, wave, GParm{512, TC * 1024 * 2, 4 * 1024 * 2, 16, 1024}, S, E); }
        { SchedRG S{(const char*)(ws + WS_XR), (const char*)(ws + WS_RGW), G, bx}; EpiG E{(bf16_t*)(ws + WS_G0), (bf16_t*)(ws + WS_G1), (const float*)(ws + WS_RGBIAS)};
          GEMM_PHASE(lds, wave, GParm{256, 2048, 2048, 64, 0}, S, E); }
    }
    if (rep + 1 < REPS(2)) { ++nbar; grid_barrier(gbar, nbar * (unsigned)G, wave); } }
    SEAM(2);
    for (int rep = 0; rep < REPS(3); ++rep) {
    if (IN(3)) { PH_IDS;
        if (bx < 128) {
            const int g = bx >> 1, n = bx & 1; const float* Sg = (const float*)(ws + WS_S) + (size_t)g * NCH * 256 + n * 128; LAS float* Ls = (LAS float*)lds;
            for (int i = tid; i < NCH * 32; i += 512) { const int c = i >> 5, q4 = (i & 31) * 4; *(LAS f32x4*)(Ls + c * 128 + q4) = *(const f32x4*)(Sg + (size_t)c * 256 + q4); }
            __syncthreads();
            if (wave == 0) { const int p = lane, pi = (n * 64 + g) * 64 + p;
                const float lr = fminf(args.in[6][pi], -1e-4f), li = args.in[7][pi], step = expf(args.in[8][n * 64 + g]); float ar, ai; cpow(lr * step, li * step, TC, ar, ai);
                bf16_t* hp = (bf16_t*)(ws + WS_HPREV) + (size_t)g * NCH * 256 + n * 128; float hr = 0.f, him = 0.f;
                for (int cc = 0; cc < NCH; ++cc) { const int c = n == 0 ? cc : NCH - 1 - cc;
                    hp[(size_t)c * 256 + p] = (bf16_t)(cvt_pk_bf16(hr, 0.f) & 0xffffu); hp[(size_t)c * 256 + 64 + p] = (bf16_t)(cvt_pk_bf16(him, 0.f) & 0xffffu);
                    const float sr = Ls[c * 128 + p], si = Ls[c * 128 + 64 + p]; const float nr = ar * hr - ai * him + sr, ni = ar * him + ai * hr + si; hr = nr; him = ni; } }
            __syncthreads();
        }
        { MK_RG; for (int un = bx; un < 256; un += G) rg_pass_a(RG, un & 1, un >> 1, tid); }
    }
    if (rep + 1 < REPS(3)) { ++nbar; grid_barrier(gbar, nbar * (unsigned)G, wave); } }
    SEAM(3);
    for (int rep = 0; rep < REPS(4); ++rep) {
    if (IN(4)) { PH_IDS;
#if NAIVE_S5
        if (gw < 64) naive_s5_group(args.in, (const bf16_t*)(dout + DO_U), (float*)(ws + WS_YINTRA), (bf16_t*)(ws + WS_YS5G), gw, lane);
#else
        { SchedS5b S{(const char*)(ws + WS_HPREV), (const char*)(ws + WS_WC), G, bx}; EpiS5b E{(const bf16_t*)(ws + WS_YINTRA), (bf16_t*)(ws + WS_YS5G)};
          GEMM_PHASE(lds, wave, GParm{256, 512, 128, 64, 0}, S, E); }
#endif
#if NAIVE_RG
        { MK_RG; if (gtid < 1024) naive_rg_channel(RG, gtid); }
#else
        { MK_RG; __syncthreads(); for (int un = bx; un < 256; un += G) { rg_pass_c(RG, un & 1, un >> 1, tid, (LAS float*)lds); __syncthreads(); } }
#endif
    }
    if (rep + 1 < REPS(4)) { ++nbar; grid_barrier(gbar, nbar * (unsigned)G, wave); } }
    SEAM(4);
    for (int rep = 0; rep < REPS(5); ++rep) {
    if (IN(5)) { PH_IDS;
        SchedStd S; S.so.init(SEQ, DS5, G, bx); S.A = (const char*)(ws + WS_YS5G); S.B = (const char*)(ws + WS_GLUT); S.a_tile = (size_t)256 * DS5 * 2; S.b_tile = (size_t)256 * DS5 * 2;
        EpiGlu E{(const bf16_t*)(ws + WS_YS5G), (bf16_t*)(dout + DO_YPRE), args.in[15]};
        GEMM_PHASE(lds, wave, GParm{DS5, DS5 * 2, 128, 64, 0}, S, E);
    }
    if (rep + 1 < REPS(5)) { ++nbar; grid_barrier(gbar, nbar * (unsigned)G, wave); } }
    SEAM(5);
    for (int rep = 0; rep < REPS(6); ++rep) {
    if (IN(6)) { PH_IDS;
        const float *g5 = args.in[23], *gr = args.in[24];
        for (int row = gw; row < SEQ; row += NGW) { const u32x4* yr = (const u32x4*)(dout + DO_YPRE) + (size_t)row * 256; u32x4* oc = (u32x4*)(ws + WS_YCAT) + (size_t)row * 256;
            u32x4 w[4]; float s0 = 0.f, s1 = 0.f;
#pragma unroll
            for (int j = 0; j < 4; ++j) { w[j] = yr[lane + 64 * j]; const float q = bf_lo(w[j].x) * bf_lo(w[j].x) + bf_hi(w[j].x) * bf_hi(w[j].x) + bf_lo(w[j].y) * bf_lo(w[j].y) + bf_hi(w[j].y) * bf_hi(w[j].y)
                + bf_lo(w[j].z) * bf_lo(w[j].z) + bf_hi(w[j].z) * bf_hi(w[j].z) + bf_lo(w[j].w) * bf_lo(w[j].w) + bf_hi(w[j].w) * bf_hi(w[j].w); if (j < 2) s0 += q; else s1 += q; }
            const float r0 = 1.0f / sqrtf(wave_sum(s0) * (1.f / 1024.f) + LN_EPS), r1 = 1.0f / sqrtf(wave_sum(s1) * (1.f / 1024.f) + LN_EPS);
#pragma unroll
            for (int j = 0; j < 4; ++j) { const int col = (lane + 64 * j) * 8; const float rs = j < 2 ? r0 : r1; const float* gp = j < 2 ? g5 + col : gr + (col - 1024);
                const f32x4 ga = *(const f32x4*)gp, gb = *(const f32x4*)(gp + 4);
                u32x4 o; o.x = cvt_pk_bf16(bf_lo(w[j].x) * rs * ga[0], bf_hi(w[j].x) * rs * ga[1]); o.y = cvt_pk_bf16(bf_lo(w[j].y) * rs * ga[2], bf_hi(w[j].y) * rs * ga[3]);
                o.z = cvt_pk_bf16(bf_lo(w[j].z) * rs * gb[0], bf_hi(w[j].z) * rs * gb[1]); o.w = cvt_pk_bf16(bf_lo(w[j].w) * rs * gb[2], bf_hi(w[j].w) * rs * gb[3]); oc[lane + 64 * j] = o; } }
        {
            LAS float* scr = (LAS float*)(lds + wave * 16640);
            constexpr int I_FF1 = (DM / 64) * (DFF / 64), I_FF2 = (DFF / 64) * (DM / 64);
            for (int it = gw; it < I_FF1 + I_FF2; it += NGW) {
                if (it < I_FF1) transpose_item(args.in[29], DM, DFF, (bf16_t*)(ws + WS_FF1T), scr, it, lane);
                else transpose_item(args.in[31], DFF, DM, (bf16_t*)(ws + WS_FF2T), scr, it - I_FF1, lane); }
        }
    }
    if (rep + 1 < REPS(6)) { ++nbar; grid_barrier(gbar, nbar * (unsigned)G, wave); } }
    SEAM(6);
    for (int rep = 0; rep < REPS(7); ++rep) {
    if (IN(7)) { PH_IDS;
        SchedStd S; S.so.init(SEQ, DM, G, bx); S.A = (const char*)(ws + WS_YCAT); S.B = (const char*)(ws + WS_WOUTT); S.a_tile = (size_t)256 * DM * 2; S.b_tile = (size_t)256 * DM * 2;
        EpiRes<false> E{(const bf16_t*)(ws + WS_HB), args.in[26], (float*)dout, nullptr, nullptr};
        GEMM_PHASE(lds, wave, GParm{DM, DM * 2, 128, 64, 0}, S, E);
    }
    if (rep + 1 < REPS(7)) { ++nbar; grid_barrier(gbar, nbar * (unsigned)G, wave); } }
    SEAM(7);
    for (int rep = 0; rep < REPS(8); ++rep) {
    if (IN(8)) { PH_IDS; for (int row = gw; row < SEQ; row += NGW) ln_row<true>((const float*)dout + (size_t)row * DM, args.in[27], args.in[28], (bf16_t*)(ws + WS_HB) + (size_t)row * DM, lane); }
    if (rep + 1 < REPS(8)) { ++nbar; grid_barrier(gbar, nbar * (unsigned)G, wave); } }
    SEAM(8);
    for (int rep = 0; rep < REPS(9); ++rep) {
    if (IN(9)) { PH_IDS;
        { SchedStd S; S.so.init(SEQ, DFF, G, bx); S.A = (const char*)(ws + WS_HB); S.B = (const char*)(ws + WS_FF1T); S.a_tile = (size_t)256 * DM * 2; S.b_tile = (size_t)256 * DM * 2;
          EpiPlain<1> E{(bf16_t*)(ws + WS_T), DFF, args.in[30]}; GEMM_PHASE(lds, wave, GParm{DM, DM * 2, 128, 64, 0}, S, E); }
        { SchedStd S; S.so.init(SEQ, DM, G, bx); S.A = (const char*)(ws + WS_HB); S.B = (const char*)(ws + WS_PLEGT); S.a_tile = (size_t)256 * DM * 2; S.b_tile = (size_t)256 * DM * 2;
          EpiPlain<2> E{(bf16_t*)(dout + DO_SG), DM, args.in[35]}; GEMM_PHASE(lds, wave, GParm{DM, DM * 2, 128, 64, 0}, S, E); }
        { SchedStd S; S.so.init(SEQ, DM, G, bx); S.A = (const char*)(ws + WS_PB); S.B = (const char*)(ws + WS_PLEWT); S.a_tile = (size_t)256 * PLE * 2; S.b_tile = (size_t)256 * PLE * 2;
          EpiPlain<0> E{(bf16_t*)(dout + DO_PW), DM, nullptr}; GEMM_PHASE(lds, wave, GParm{PLE, PLE * 2, 128, 64, 0}, S, E); }
    }
    if (rep + 1 < REPS(9)) { ++nbar; grid_barrier(gbar, nbar * (unsigned)G, wave); } }
    SEAM(9);
    for (int rep = 0; rep < REPS(10); ++rep) {
    if (IN(10)) { PH_IDS;
        SchedStd S; S.so.init(SEQ, DM, G, bx); S.A = (const char*)(ws + WS_T); S.B = (const char*)(ws + WS_FF2T); S.a_tile = (size_t)256 * DFF * 2; S.b_tile = (size_t)256 * DFF * 2;
        EpiRes<true> E{(const bf16_t*)(ws + WS_HB), args.in[32], (float*)(ws + WS_V2), (const bf16_t*)(dout + DO_SG), (const bf16_t*)(dout + DO_PW)};
        GEMM_PHASE(lds, wave, GParm{DFF, DFF * 2, 128, 64, 0}, S, E);
    }
    if (rep + 1 < REPS(10)) { ++nbar; grid_barrier(gbar, nbar * (unsigned)G, wave); } }
    SEAM(10);
    for (int rep = 0; rep < REPS(11); ++rep) {
    if (IN(11)) { PH_IDS; for (int row = gw; row < SEQ; row += NGW) ln_row<false>((const float*)(ws + WS_V2) + (size_t)row * DM, args.in[36], args.in[37], args.out + (size_t)row * DM, lane); }
    if (rep + 1 < REPS(11)) { ++nbar; grid_barrier(gbar, nbar * (unsigned)G, wave); } }
#if TSTAMP
    if (bx == 0 && wave == 0) { if (fresh_lane() == 0) { unsigned long long* st = (unsigned long long*)(ws + WS_CTR + 1024); st[12] = __builtin_amdgcn_s_memrealtime();
        args.out[0] = (float)(long long)(st[TS_A1] - st[TS_A0]) * 0.01f; } }
#endif
#if DIAG
    { ++nbar; grid_barrier(gbar, nbar * (unsigned)G, wave); PH_IDS; unsigned* flagw = (unsigned*)(ws + WS_CTR) + 48;
#if DIAG == 1
      diag_ffn(args.in, ws, args.out, flagw, gtid, GT);
#elif DIAG == 2
      diag_pre(args.in, ws, dout, flagw, gtid, GT);
#elif DIAG == 3
      diag_v(args.in, ws, dout, flagw, gtid, GT);
#elif DIAG == 4
      diag_g(args.in, ws, flagw, gtid, GT);
#elif DIAG == 6
      diag_max(ws, flagw, gtid, GT);
#else
      if (bx == 0 && tid == 0) flagw[1] = 0xffffffffu;
      ++nbar; grid_barrier(gbar, nbar * (unsigned)G, wave);
#if DIAG == 7
      diag_rows(args.out, flagw, gw, NGW, lane);
#elif DIAG == 8
      diag_rows_bf((const bf16_t*)(ws + WS_HB), DM, 12.0f, flagw, gw, NGW, lane);
#elif DIAG == 9
      diag_rows((const float*)(ws + WS_V2), flagw, gw, NGW, lane);
#elif DIAG == 10
      diag_rows_bf((const bf16_t*)(ws + WS_T), DFF, 150.0f, flagw, gw, NGW, lane);
#elif DIAG == 11
      diag_rows_bf((const bf16_t*)(dout + DO_PW), DM, 8.0f, flagw, gw, NGW, lane);
#elif DIAG == 12
      diag_rows_bf((const bf16_t*)(dout + DO_SG), DM, 1.01f, flagw, gw, NGW, lane);
#endif
#endif
      ++nbar; grid_barrier(gbar, nbar * (unsigned)G, wave);
#if DIAG != 1
      for (int i = gtid; i < SEQ * DM; i += GT) args.out[i] = 0.f;
      ++nbar; grid_barrier(gbar, nbar * (unsigned)G, wave);
#endif
      if (bx == 0 && tid == 0) { unsigned code = 0; for (int q = 0; q < 4; ++q) if (__hip_atomic_load(flagw + q, __ATOMIC_RELAXED, __HIP_MEMORY_SCOPE_AGENT) > 100u) code |= 1u << q; if (DIAG >= 7) { const unsigned cnt = __hip_atomic_load(flagw, __ATOMIC_RELAXED, __HIP_MEMORY_SCOPE_AGENT), mn = __hip_atomic_load(flagw + 1, __ATOMIC_RELAXED, __HIP_MEMORY_SCOPE_AGENT), mxr = __hip_atomic_load(flagw + 2, __ATOMIC_RELAXED, __HIP_MEMORY_SCOPE_AGENT);
          const unsigned v = DIAG_SEL == 0 ? cnt : DIAG_SEL == 1 ? mn / 100u : DIAG_SEL == 2 ? mn % 100u : DIAG_SEL == 3 ? mxr / 100u : mxr % 100u; args.out[0] = 100.0f * (float)(v + 1u); }
      else args.out[0] = (DIAG == 6) ? 1000.0f * __uint_as_float(__hip_atomic_load(flagw, __ATOMIC_RELAXED, __HIP_MEMORY_SCOPE_AGENT)) : 1000.0f * (float)(code + 16u); } }
#endif
#undef IN
#undef SEAM
}


#if PER_PHASE_LAUNCH
template <int PH> static void set_attr_one() { (void)hipFuncSetAttribute((const void*)mega<(1 << PH)>, hipFuncAttributeMaxDynamicSharedMemorySize, LDS_BYTES); }
template <int PH> static void launch_one(Args a, int grid, hipStream_t stream) { a.ph_lo = PH; a.ph_hi = PH + 1; hipLaunchKernelGGL(mega<(1 << PH)>, dim3(grid), dim3(512), LDS_BYTES, stream, a); }
static void set_attrs() { set_attr_one<0>(); set_attr_one<1>(); set_attr_one<2>(); set_attr_one<3>(); set_attr_one<4>(); set_attr_one<5>(); set_attr_one<6>(); set_attr_one<7>(); set_attr_one<8>(); set_attr_one<9>(); set_attr_one<10>(); set_attr_one<11>(); }
static void launch_phases(const Args& a, int grid, hipStream_t stream) { launch_one<0>(a, grid, stream); launch_one<1>(a, grid, stream); launch_one<2>(a, grid, stream); launch_one<3>(a, grid, stream); launch_one<4>(a, grid, stream); launch_one<5>(a, grid, stream);
    launch_one<6>(a, grid, stream); launch_one<7>(a, grid, stream); launch_one<8>(a, grid, stream); launch_one<9>(a, grid, stream); launch_one<10>(a, grid, stream); launch_one<11>(a, grid, stream); }
#else
static void set_attrs() { (void)hipFuncSetAttribute((const void*)mega<0xfff>, hipFuncAttributeMaxDynamicSharedMemorySize, LDS_BYTES); }
#endif

extern "C" void kernel_launch(void* const* d_in, const int* in_sizes, int n_in, void* d_out, int out_size, void* d_ws, size_t ws_size, hipStream_t stream) {
    static int grid = 0;
    if (grid == 0) {
        if (n_in != 38 || out_size != SEQ * DM || ws_size < WS_END) { fprintf(stderr, "kernel_launch: unexpected shapes (n_in %d out %d ws %zu)\n", n_in, out_size, ws_size); grid = -1; return; }
        int dev = 0, cus = 0, per_cu = 0;
        hipGetDevice(&dev); hipDeviceGetAttribute(&cus, hipDeviceAttributeMultiprocessorCount, dev);
        set_attrs();
        per_cu = 1;
        (void)hipGetLastError();
        if (per_cu < 1) per_cu = 1;
        grid = cus;
    }
    if (grid < 0) return;
#ifdef POISON_NAN
    hipMemsetAsync(d_ws, 0xFF, WS_END, stream); hipMemsetAsync(d_out, 0xFF, (size_t)64 * MiB, stream);
#endif
    hipMemsetAsync((char*)d_ws + WS_CTR, 0, 256, stream);
    Args a{};
    for (int i = 0; i < 38; ++i) a.in[i] = (const float*)d_in[i];
    a.out = (float*)d_out; a.ws = (unsigned char*)d_ws;
#if PER_PHASE_LAUNCH
    launch_phases(a, grid, stream);
#else
    a.ph_lo = 0; a.ph_hi = NPHASE;
    void* kargs[] = {&a};
    hipError_t e = hipLaunchCooperativeKernel((const void*)mega<0xfff>, dim3(grid), dim3(512), kargs, LDS_BYTES, stream);
    if (e != hipSuccess) fprintf(stderr, "cooperative launch failed: %s (grid %d)\n", hipGetErrorString(e), grid);
#endif
}
```

```cpp
#include <hip/hip_runtime.h>
#include <hip/hip_cooperative_groups.h>
#include <cstdio>
#include <cstdint>
namespace cg = cooperative_groups;

#ifndef PER_PHASE_LAUNCH
#define PER_PHASE_LAUNCH 0
#endif

#define LAS __attribute__((address_space(3)))
typedef unsigned short bf16_t;
typedef short bf16x8 __attribute__((ext_vector_type(8)));
typedef float f32x4 __attribute__((ext_vector_type(4)));
typedef float f32x2 __attribute__((ext_vector_type(2)));
typedef unsigned u32x4 __attribute__((ext_vector_type(4)));
typedef unsigned u32x2 __attribute__((ext_vector_type(2)));

constexpr int SEQ = 8192, DM = 2048, DIN = 3072, DS5 = 1024, DRG = 1024, NG = 64, NP = 64, NK = 16, NH = 16, HD = 64, DFF = 8192, PLE = 256;
constexpr int TC = 32, NCH = SEQ / TC;
constexpr float LN_EPS = 1e-5f, DN_ALPHA = 1.18920711500272f;
constexpr int NPHASE = 12;

constexpr size_t MiB = (size_t)1 << 20;
constexpr size_t WS_FF2T = 0, WS_HB = 32 * MiB, WS_FF1T = 64 * MiB, WS_PLEGT = 96 * MiB, WS_PLEWT = 104 * MiB, WS_PB = 105 * MiB, WS_WOUTT = 109 * MiB,
    WS_V2 = 64 * MiB, WS_G0 = 0, WS_G1 = 64 * MiB,
    WS_WG = 128 * MiB, WS_WC = 176 * MiB, WS_RGW = 192 * MiB, WS_GLUT = 194 * MiB, WS_XR = 196 * MiB, WS_YINTRA = 213 * MiB, WS_S = 229 * MiB, WS_HPREV = 245 * MiB, WS_WINT = 229 * MiB,
    WS_YS5G = 128 * MiB, WS_YCAT = 144 * MiB, WS_T = 128 * MiB,
    WS_AGG = 256 * MiB, WS_CARRY = 258 * MiB, WS_SUMSQ = 259 * MiB, WS_RGBIAS = 259 * MiB + 64 * 1024, WS_SP = WS_RGBIAS + 16 * 1024, WS_CTR = WS_SP + 8 * 1024, WS_END = 260 * MiB;
constexpr size_t DO_YPRE = 0, DO_Z = 32 * MiB, DO_U = 48 * MiB, DO_SG = 0, DO_PW = 32 * MiB;
constexpr int LDS_BYTES = 144 * 1024;

typedef __bf16 bf16x2_t __attribute__((ext_vector_type(2)));
__device__ __forceinline__ unsigned cvt_pk_bf16(float lo, float hi) { const f32x2 v = {lo, hi}; const bf16x2_t b = __builtin_convertvector(v, bf16x2_t); return __builtin_bit_cast(unsigned, b); }
__device__ __forceinline__ float bf_lo(unsigned w) { return __uint_as_float(w << 16); }
__device__ __forceinline__ float bf_hi(unsigned w) { return __uint_as_float(w & 0xffff0000u); }
__device__ __forceinline__ f32x4 bf4(u32x2 w) { return (f32x4){bf_lo(w.x), bf_hi(w.x), bf_lo(w.y), bf_hi(w.y)}; }
__device__ __forceinline__ float fast_sigmoid(float x) { return __builtin_amdgcn_rcpf(1.0f + __expf(-x)); }
__device__ __forceinline__ float gelu_tanh(float x) { const float u = 1.5957691216057308f * (x + 0.044715f * x * x * x); return x * fast_sigmoid(u); }
__device__ __forceinline__ float wave_sum(float v) {
#pragma unroll
    for (int o = 1; o < 64; o <<= 1) v += __shfl_xor(v, o);
    return v;
}
__device__ __forceinline__ int lane_id() { return (int)__builtin_amdgcn_mbcnt_hi(~0u, __builtin_amdgcn_mbcnt_lo(~0u, 0u)); }
__device__ __forceinline__ int fresh_lane() { unsigned z = 0; asm volatile("" : "+s"(z)); return (int)__builtin_amdgcn_mbcnt_hi(~0u, __builtin_amdgcn_mbcnt_lo(~0u, z)); }
#define LDS_WAIT() asm volatile("s_waitcnt lgkmcnt(0)" ::: "memory")

namespace pg8 {
constexpr int BM = 256, BK = 64, HALF = 128, HTB = HALF * BK * 2, STAGE_BYTES = 8 * HTB, NXCD = 8, WGM = 8;
__host__ __device__ __forceinline__ int lds_byte(int r, int c) { const int st = (r >> 4) * 2 + (c >> 5), rr = r & 15, cc = c & 31, ob = rr * 64 + cc * 2; return st * 1024 + (ob ^ (((ob >> 9) & 1) << 5)); }
__host__ __device__ __forceinline__ void stage_rc(int b, int& R, int& C) { const int st = b / 1024, sb = b % 1024, swz = sb ^ (((sb >> 9) & 1) << 5); R = (st >> 1) * 16 + swz / 64; C = (st & 1) * 32 + (swz % 64) / 2; }
__host__ __device__ __forceinline__ int perm32(int rho) { const int n = rho >> 4, i = rho & 15; return 8 * (i >> 2) + 4 * n + (i & 3); }

struct Unit { int pm, pn; };
struct StaticOrder {
    int nM, nN, nwg, G, c;
    __host__ __device__ void init(int M, int N, int G_, int c_) { nM = M / BM; nN = N / BM; nwg = nM * nN; G = G_; c = c_; }
    __host__ __device__ bool next(int i, Unit& u) const {
        const long L = (long)i * G + c; if (L >= nwg) return false;
        int wgid = (int)L; { const int q = nwg / NXCD, r = nwg % NXCD, xcd = wgid % NXCD, off = wgid / NXCD; wgid = (xcd < r ? xcd * (q + 1) : r * (q + 1) + (xcd - r) * q) + off; }
        const int nig = WGM * nN, gid = wgid / nig, fm = gid * WGM, gsz = (nM - fm) < WGM ? (nM - fm) : WGM;
        u.pm = fm + ((wgid % nig) % gsz); u.pn = (wgid % nig) / gsz; return true;
    }
};
struct GUnit { const char* A; const char* B; int i0, i1; };
struct GParm { int K; unsigned a_rs, a_ks; int a_cw, a_cs; };

template <class Epi, class Sched>
__device__ __forceinline__ void gemm_phase(LAS unsigned char* lds, const int wid, const GParm gp, const Sched& S, const Epi& E) {
    const int lane = fresh_lane(), tid = wid * 64 + lane, wr = wid >> 2, wc = wid & 3, fr = lane & 15, fq = lane >> 4;
    const int K = gp.K, nt = K / BK;
    unsigned voffA[2], voffB[2];
#pragma unroll
    for (int i = 0; i < 2; ++i) { int R, C; stage_rc(tid * 16 + i * 8192, R, C); const int Rb = Epi::PERM ? ((R & ~31) + perm32(R & 31)) : R;
        voffA[i] = (unsigned)R * gp.a_rs + (unsigned)((C / gp.a_cw) * gp.a_cs + (C % gp.a_cw)) * 2u; voffB[i] = (unsigned)(Rb * K + C) * 2u; }
    const size_t ksA = gp.a_ks, ksB = (size_t)(BK * 2);
    const size_t hsA = (size_t)HALF * gp.a_rs, hsB = (size_t)HALF * K * 2;
    const unsigned ldsw = (unsigned)wid * 1024u;
    const int aoff = lds_byte(wr * 64 + fr, fq * 8), boff = lds_byte(wc * 32 + fr, fq * 8);
#define PG8_SA(b, h) (((b) * 2 + (h)) * HTB)
#define PG8_SB(b, h) ((4 + (b) * 2 + (h)) * HTB)
#define PG8_STAGE(bufoff, gbase, voff) do { _Pragma("unroll") for (int _i = 0; _i < 2; ++_i) \
        __builtin_amdgcn_global_load_lds((const unsigned*)((const char*)(gbase) + (voff)[_i]), (LAS unsigned*)(lds + (bufoff) + ldsw + _i * 8192), 16, 0, 0); } while (0)
#define PG8_LDA(dst, b, h) do { _Pragma("unroll") for (int m = 0; m < 4; ++m) _Pragma("unroll") for (int k = 0; k < 2; ++k) dst[m][k] = *(const LAS bf16x8*)(lds + PG8_SA(b, h) + aoff + m * 2048 + k * 1024); } while (0)
#define PG8_LDB(dst, b, h) do { _Pragma("unroll") for (int n = 0; n < 2; ++n) _Pragma("unroll") for (int k = 0; k < 2; ++k) dst[n][k] = *(const LAS bf16x8*)(lds + PG8_SB(b, h) + boff + n * 2048 + k * 1024); } while (0)
#define PG8_MMA(ai, bj, At, Bt) do { __builtin_amdgcn_s_setprio(1); _Pragma("unroll") for (int m = 0; m < 4; ++m) _Pragma("unroll") for (int n = 0; n < 2; ++n) _Pragma("unroll") for (int k = 0; k < 2; ++k) \
        acc[ai][bj][m][n] = __builtin_amdgcn_mfma_f32_16x16x32_bf16(Bt[n][k], At[m][k], acc[ai][bj][m][n], 0, 0, 0); __builtin_amdgcn_s_setprio(0); } while (0)
#define PG8_WAIT_V(n) asm volatile("s_waitcnt vmcnt(" #n ")" ::: "memory")
#define PG8_WAIT_L(n) asm volatile("s_waitcnt lgkmcnt(" #n ")" ::: "memory")
#define PG8_BAR __builtin_amdgcn_s_barrier()
#define PG8_SCHED __builtin_amdgcn_sched_barrier(0)
    GUnit cur, nxt; int ui = 0;
    if (!S.next(0, cur)) return;
    f32x4 acc[2][2][4][2];
#pragma unroll
    for (int a = 0; a < 2; ++a)
#pragma unroll
        for (int b = 0; b < 2; ++b)
#pragma unroll
            for (int m = 0; m < 4; ++m)
#pragma unroll
                for (int n = 0; n < 2; ++n) acc[a][b][m][n] = (f32x4){0.f, 0.f, 0.f, 0.f};
    bf16x8 At[4][2], B0[2][2], B1[2][2];
    const char* cA = cur.A; const char* cB = cur.B;
    PG8_STAGE(PG8_SB(0, 0), cB, voffB); PG8_STAGE(PG8_SB(0, 1), cB + hsB, voffB); PG8_STAGE(PG8_SA(0, 0), cA, voffA); PG8_STAGE(PG8_SA(0, 1), cA + hsA, voffA);
    if (wr == 1) PG8_BAR;
    PG8_WAIT_V(2); PG8_BAR;
    PG8_STAGE(PG8_SB(1, 0), cB + ksB, voffB); PG8_STAGE(PG8_SA(1, 0), cA + ksA, voffA); PG8_STAGE(PG8_SB(1, 1), cB + hsB + ksB, voffB);
    PG8_WAIT_V(6); PG8_BAR;
    for (;;) {
        const bool has_next = S.next(ui + 1, nxt);
        const char* nA = has_next ? nxt.A : cA; const char* nB = has_next ? nxt.B : cB;
        for (int t = 0; t < nt; t += 2) {
            const bool last = (t == nt - 2);
            const char* a1 = cA + (size_t)(t + 1) * ksA;
            const char* a2 = last ? nA : cA + (size_t)(t + 2) * ksA; const char* b2 = last ? nB : cB + (size_t)(t + 2) * ksB;
            const char* a3 = a2 + ksA; const char* b3 = b2 + ksB;
            PG8_LDB(B0, 0, 0); PG8_LDB(B1, 0, 1); PG8_SCHED; PG8_LDA(At, 0, 0); PG8_STAGE(PG8_SA(1, 1), a1 + hsA, voffA);
            PG8_WAIT_V(8); PG8_WAIT_L(0); PG8_BAR; PG8_MMA(0, 0, At, B0); PG8_MMA(0, 1, At, B1); PG8_BAR; PG8_SCHED;
            PG8_LDA(At, 0, 1); PG8_STAGE(PG8_SB(0, 0), b2, voffB); PG8_STAGE(PG8_SB(0, 1), b2 + hsB, voffB); PG8_STAGE(PG8_SA(0, 0), a2, voffA);
            PG8_WAIT_V(8); PG8_WAIT_L(0); PG8_BAR; PG8_MMA(1, 0, At, B0); PG8_MMA(1, 1, At, B1); PG8_BAR; PG8_SCHED;
            PG8_LDB(B0, 1, 0); PG8_LDB(B1, 1, 1); PG8_SCHED; PG8_LDA(At, 1, 0); PG8_STAGE(PG8_SA(0, 1), a2 + hsA, voffA);
            PG8_WAIT_V(8); PG8_WAIT_L(0); PG8_BAR; PG8_MMA(0, 0, At, B0); PG8_MMA(0, 1, At, B1); PG8_BAR; PG8_SCHED;
            PG8_LDA(At, 1, 1); PG8_STAGE(PG8_SB(1, 0), b3, voffB); PG8_STAGE(PG8_SB(1, 1), b3 + hsB, voffB); PG8_STAGE(PG8_SA(1, 0), a3, voffA);
            PG8_WAIT_V(8); PG8_WAIT_L(0); PG8_BAR; PG8_MMA(1, 0, At, B0); PG8_MMA(1, 1, At, B1); PG8_BAR; PG8_SCHED;
        }
        if (wr == 0) PG8_BAR;
        { const int l_o = fresh_lane(); E(acc, cur, wr, wc, l_o & 15, l_o >> 4); }
        if (!has_next) break;
#pragma unroll
        for (int a = 0; a < 2; ++a)
#pragma unroll
            for (int b = 0; b < 2; ++b)
#pragma unroll
                for (int m = 0; m < 4; ++m)
#pragma unroll
                    for (int n = 0; n < 2; ++n) acc[a][b][m][n] = (f32x4){0.f, 0.f, 0.f, 0.f};
        cur = nxt; cA = nA; cB = nB; ++ui;
        if (wr == 1) PG8_BAR;
    }
    PG8_WAIT_V(0);
    PG8_BAR;
#undef PG8_SA
#undef PG8_SB
#undef PG8_STAGE
#undef PG8_LDA
#undef PG8_LDB
#undef PG8_MMA
#undef PG8_WAIT_V
#undef PG8_WAIT_L
#undef PG8_BAR
#undef PG8_SCHED
}
}
using pg8::GUnit; using pg8::GParm;
typedef f32x4 AccT[2][2][4][2];

struct SchedStd {
    pg8::StaticOrder so; const char* A; const char* B; size_t a_tile, b_tile;
    __device__ __forceinline__ bool next(int i, GUnit& u) const { pg8::Unit t; if (!so.next(i, t)) return false; u.A = A + (size_t)t.pm * a_tile; u.B = B + (size_t)t.pn * b_tile; u.i0 = t.pm; u.i1 = t.pn; return true; }
};
struct SchedS5a { const char* U; const char* WG; int G, c;
    __device__ __forceinline__ bool next(int i, GUnit& u) const { const int L = i * G + c; if (L >= 192) return false; const int g = L / 3, pn = L % 3;
        u.A = U + g * 32; u.B = WG + ((size_t)g * 768 + 256 * pn) * 512 * 2; u.i0 = g; u.i1 = pn; return true; } };
struct SchedS5b { const char* HP; const char* WC; int G, c;
    __device__ __forceinline__ bool next(int i, GUnit& u) const { const int L = i * G + c; if (L >= 128) return false; const int g = L / 2, pn = L % 2;
        u.A = HP + (size_t)g * 256 * 256 * 2; u.B = WC + ((size_t)g * 512 + 256 * pn) * 256 * 2; u.i0 = g; u.i1 = pn; return true; } };
struct SchedRG { const char* XR; const char* RGW; int G, c;
    __device__ __forceinline__ bool next(int i, GUnit& u) const { const int L = i * G + c; if (L >= 512) return false; const int h = L % 16, pm = L / 16;
        u.A = XR + ((size_t)(256 * pm) * 1024 + 64 * h) * 2; u.B = RGW + (size_t)h * 256 * 256 * 2; u.i0 = pm; u.i1 = h; return true; } };

template <int ACT> __device__ __forceinline__ void epi_bf16_store(const AccT& acc, bf16_t* tile, int ldc, const float* biast, int wr, int wc, int fr, int fq) {
    const int r0 = wr * 64 + fr, c0 = wc * 32 + 8 * fq;
    f32x4 bv[2][2];
#pragma unroll
    for (int bj = 0; bj < 2; ++bj)
#pragma unroll
        for (int n = 0; n < 2; ++n) bv[bj][n] = biast ? *(const f32x4*)(biast + c0 + bj * 128 + 4 * n) : (f32x4){0.f, 0.f, 0.f, 0.f};
#pragma unroll
    for (int ai = 0; ai < 2; ++ai)
#pragma unroll
        for (int m = 0; m < 4; ++m) { bf16_t* rowp = tile + (size_t)(r0 + ai * 128 + m * 16) * ldc + c0;
#pragma unroll
            for (int bj = 0; bj < 2; ++bj) { f32x4 v0 = acc[ai][bj][m][0] + bv[bj][0], v1 = acc[ai][bj][m][1] + bv[bj][1];
                if (ACT == 1) {
#pragma unroll
                    for (int j = 0; j < 4; ++j) { const float a = fmaxf(v0[j], 0.f), b = fmaxf(v1[j], 0.f); v0[j] = a * a; v1[j] = b * b; } }
                if (ACT == 2) {
#pragma unroll
                    for (int j = 0; j < 4; ++j) { v0[j] = fast_sigmoid(v0[j]); v1[j] = fast_sigmoid(v1[j]); } }
                u32x4 w; w.x = cvt_pk_bf16(v0[0], v0[1]); w.y = cvt_pk_bf16(v0[2], v0[3]); w.z = cvt_pk_bf16(v1[0], v1[1]); w.w = cvt_pk_bf16(v1[2], v1[3]);
                *(u32x4*)(rowp + bj * 128) = w; } }
}
struct EpiProj { static constexpr bool PERM = true; bf16_t *U, *XR, *Z; const float* bias;
    __device__ __forceinline__ void operator()(AccT& acc, const GUnit& u, int wr, int wc, int fr, int fq) const {
        const int pm = u.i0, pn = u.i1; bf16_t* base = pn < 4 ? U : (pn < 8 ? XR + 2 * 1024 : Z);
        epi_bf16_store<0>(acc, base + (size_t)pm * 256 * 1024 + (pn & 3) * 256, 1024, bias + pn * 256, wr, wc, fr, fq); } };
template <int ACT> struct EpiPlain { static constexpr bool PERM = true; bf16_t* O; int ldc; const float* bias;
    __device__ __forceinline__ void operator()(AccT& acc, const GUnit& u, int wr, int wc, int fr, int fq) const {
        epi_bf16_store<ACT>(acc, O + (size_t)u.i0 * 256 * ldc + u.i1 * 256, ldc, bias ? bias + u.i1 * 256 : nullptr, wr, wc, fr, fq); } };
struct EpiS5a { static constexpr bool PERM = true; bf16_t* YI; float* S;
    __device__ __forceinline__ void operator()(AccT& acc, const GUnit& u, int wr, int wc, int fr, int fq) const {
        const int g = u.i0, pn = u.i1;
#pragma unroll
        for (int ai = 0; ai < 2; ++ai)
#pragma unroll
            for (int m = 0; m < 4; ++m) { const int r = ai * 128 + wr * 64 + m * 16 + fr;
#pragma unroll
                for (int bj = 0; bj < 2; ++bj) { const int c8 = bj * 128 + wc * 32 + 8 * fq; const f32x4 v0 = acc[ai][bj][m][0], v1 = acc[ai][bj][m][1];
                    if (pn < 2) { const int col = pn * 256 + c8, t = col >> 4, k0 = col & 15;
                        u32x4 w; w.x = cvt_pk_bf16(v0[0], v0[1]); w.y = cvt_pk_bf16(v0[2], v0[3]); w.z = cvt_pk_bf16(v1[0], v1[1]); w.w = cvt_pk_bf16(v1[2], v1[3]);
                        *(u32x4*)(YI + (size_t)(r * TC + t) * 1024 + g * 16 + k0) = w; }
                    else { float* sp = S + ((size_t)g * NCH + r) * 256 + c8; *(f32x4*)sp = v0; *(f32x4*)(sp + 4) = v1; } } }
    } };
struct EpiS5b { static constexpr bool PERM = true; const bf16_t* YI; bf16_t* YG;
    __device__ __forceinline__ void operator()(AccT& acc, const GUnit& u, int wr, int wc, int fr, int fq) const {
        const int g = u.i0, pn = u.i1;
#pragma unroll
        for (int ai = 0; ai < 2; ++ai)
#pragma unroll
            for (int m = 0; m < 4; ++m) { const int r = ai * 128 + wr * 64 + m * 16 + fr;
#pragma unroll
                for (int bj = 0; bj < 2; ++bj) { const int col = pn * 256 + bj * 128 + wc * 32 + 8 * fq, t = col >> 4, k0 = col & 15;
                    const size_t off = (size_t)(r * TC + t) * 1024 + g * 16 + k0; const u32x4 yi = *(const u32x4*)(YI + off);
                    f32x4 v0 = acc[ai][bj][m][0] + (f32x4){bf_lo(yi.x), bf_hi(yi.x), bf_lo(yi.y), bf_hi(yi.y)}, v1 = acc[ai][bj][m][1] + (f32x4){bf_lo(yi.z), bf_hi(yi.z), bf_lo(yi.w), bf_hi(yi.w)};
#pragma unroll
                    for (int j = 0; j < 4; ++j) { v0[j] = gelu_tanh(v0[j]); v1[j] = gelu_tanh(v1[j]); }
                    u32x4 w; w.x = cvt_pk_bf16(v0[0], v0[1]); w.y = cvt_pk_bf16(v0[2], v0[3]); w.z = cvt_pk_bf16(v1[0], v1[1]); w.w = cvt_pk_bf16(v1[2], v1[3]);
                    *(u32x4*)(YG + off) = w; } }
    } };
struct EpiGlu { static constexpr bool PERM = true; const bf16_t* YG; bf16_t* YPRE; const float* bias;
    __device__ __forceinline__ void operator()(AccT& acc, const GUnit& u, int wr, int wc, int fr, int fq) const {
        const int pm = u.i0, pn = u.i1; const int c0 = pn * 256 + wc * 32 + 8 * fq;
        f32x4 bv[2][2];
#pragma unroll
        for (int bj = 0; bj < 2; ++bj)
#pragma unroll
            for (int n = 0; n < 2; ++n) bv[bj][n] = *(const f32x4*)(bias + c0 + bj * 128 + 4 * n);
#pragma unroll
        for (int ai = 0; ai < 2; ++ai)
#pragma unroll
            for (int m = 0; m < 4; ++m) { const int row = pm * 256 + ai * 128 + wr * 64 + m * 16 + fr;
#pragma unroll
                for (int bj = 0; bj < 2; ++bj) { const int col = c0 + bj * 128; const u32x4 yv = *(const u32x4*)(YG + (size_t)row * 1024 + col);
                    const f32x4 y0 = (f32x4){bf_lo(yv.x), bf_hi(yv.x), bf_lo(yv.y), bf_hi(yv.y)}, y1 = (f32x4){bf_lo(yv.z), bf_hi(yv.z), bf_lo(yv.w), bf_hi(yv.w)};
                    f32x4 v0 = acc[ai][bj][m][0] + bv[bj][0], v1 = acc[ai][bj][m][1] + bv[bj][1];
#pragma unroll
                    for (int j = 0; j < 4; ++j) { v0[j] = y0[j] * fast_sigmoid(v0[j]); v1[j] = y1[j] * fast_sigmoid(v1[j]); }
                    u32x4 w; w.x = cvt_pk_bf16(v0[0], v0[1]); w.y = cvt_pk_bf16(v0[2], v0[3]); w.z = cvt_pk_bf16(v1[0], v1[1]); w.w = cvt_pk_bf16(v1[2], v1[3]);
                    *(u32x4*)(YPRE + (size_t)row * 2048 + col) = w; }
                }
    } };
template <bool PLEADD> struct EpiRes { static constexpr bool PERM = false; const bf16_t* HBp; const float* bias; float* V; const bf16_t* SG; const bf16_t* PW;
    __device__ __forceinline__ void operator()(AccT& acc, const GUnit& u, int wr, int wc, int fr, int fq) const {
        const int pm = u.i0, pn = u.i1; const int c0 = pn * 256 + wc * 32 + 4 * fq;
        f32x4 bv[2][2];
#pragma unroll
        for (int bj = 0; bj < 2; ++bj)
#pragma unroll
            for (int n = 0; n < 2; ++n) bv[bj][n] = *(const f32x4*)(bias + c0 + bj * 128 + n * 16);
#pragma unroll
        for (int ai = 0; ai < 2; ++ai)
#pragma unroll
            for (int m = 0; m < 4; ++m) { const int row = pm * 256 + ai * 128 + wr * 64 + m * 16 + fr;
#pragma unroll
                for (int bj = 0; bj < 2; ++bj)
#pragma unroll
                    for (int n = 0; n < 2; ++n) { const size_t off = (size_t)row * 2048 + c0 + bj * 128 + n * 16;
                        f32x4 v = acc[ai][bj][m][n] + bv[bj][n] + DN_ALPHA * bf4(*(const u32x2*)(HBp + off));
                        if (PLEADD) v += bf4(*(const u32x2*)(SG + off)) * bf4(*(const u32x2*)(PW + off));
                        *(f32x4*)(V + off) = v; } }
    } };

struct EpiG { static constexpr bool PERM = true; bf16_t *G0, *G1; const float* bias;
    __device__ __forceinline__ void operator()(AccT& acc, const GUnit& u, int wr, int wc, int fr, int fq) const {
        const int pm = u.i0, h = u.i1; bf16_t* base = (pm < 16 ? G0 : G1) + (size_t)(pm & 15) * 256 * 4096 + h * 256;
        epi_bf16_store<0>(acc, base, 4096, bias + h * 256, wr, wc, fr, fq); } };
__device__ __forceinline__ float bfu(unsigned short v) { return __uint_as_float(((unsigned)v) << 16); }
__device__ __forceinline__ void rg_gate(float pa, float px, float spv, float xc, float& a, float& b) {
    const float r = fast_sigmoid(pa), ig = fast_sigmoid(px); const float la = spv * r; a = __expf(la); const float x = 2.0f * la;
    const float om = -x * (1.0f + x * (0.5f + x * (0.16666667f + x * (0.041666668f + x * 0.008333334f))));
    b = __builtin_amdgcn_sqrtf(fmaxf(om, 0.f)) * ig * xc; }
struct RgCtx { const bf16_t *XR, *G0, *G1, *Z; const float *convw, *convb, *sp; float* agg; bf16_t* ypre; };
__device__ __forceinline__ const bf16_t* g_row(const RgCtx& R, int t) { return (t < 4096 ? R.G0 : R.G1) + (size_t)(t & 4095) * 4096; }
__device__ __forceinline__ void rg_pass_a(const RgCtx& R, int half, int seg, int tid) {
    const int c = half * 512 + tid, gcol = (c >> 6) * 256 + (c & 63) * 4, t0 = seg * 64;
    const float w0 = R.convw[c], w1 = R.convw[1024 + c], w2 = R.convw[2048 + c], w3 = R.convw[3072 + c], cb = R.convb[c], sp0 = R.sp[c], sp1 = R.sp[1024 + c];
    const bf16_t* xp = R.XR + c;
    float x0 = bfu(xp[(size_t)(t0 + 0) * 1024]), x1 = bfu(xp[(size_t)(t0 + 1) * 1024]), x2 = bfu(xp[(size_t)(t0 + 2) * 1024]);
    float Af = 1.f, Bf = 0.f, Ab = 1.f, Bb = 0.f;
    for (int tb = 0; tb < 64; tb += 16) {
        u32x2 gq[16]; unsigned short xn[16];
#pragma unroll
        for (int i = 0; i < 16; ++i) { const int t = t0 + tb + i; gq[i] = *(const u32x2*)(g_row(R, t) + gcol); xn[i] = xp[(size_t)(t + 3) * 1024]; }
#pragma unroll
        for (int i = 0; i < 16; ++i) { const float x3 = bfu(xn[i]); const float xc = cb + w0 * x0 + w1 * x1 + w2 * x2 + w3 * x3; x0 = x1; x1 = x2; x2 = x3;
            float a, b; rg_gate(bf_lo(gq[i].x), bf_lo(gq[i].y), sp0, xc, a, b); Bf = a * Bf + b; Af = a * Af;
            rg_gate(bf_hi(gq[i].x), bf_hi(gq[i].y), sp1, xc, a, b); Bb = Ab * b + Bb; Ab = Ab * a; }
    }
    *(f32x2*)(R.agg + ((size_t)(seg * 2 + 0) * 1024 + c) * 2) = (f32x2){Af, Bf};
    *(f32x2*)(R.agg + ((size_t)(seg * 2 + 1) * 1024 + c) * 2) = (f32x2){Ab, Bb};
}
__device__ __forceinline__ void rg_pass_c(const RgCtx& R, int half, int seg, int tid, LAS float* Lh) {
    const int c = half * 512 + tid, gcol = (c >> 6) * 256 + (c & 63) * 4, t0 = seg * 64;
    const float w0 = R.convw[c], w1 = R.convw[1024 + c], w2 = R.convw[2048 + c], w3 = R.convw[3072 + c], cb = R.convb[c], sp0 = R.sp[c], sp1 = R.sp[1024 + c];
    const f32x2* ag = (const f32x2*)R.agg;
    float hf = 0.f, hb = 0.f;
    {
#pragma unroll 1
        for (int sb = 0; sb < 128; sb += 32) { f32x2 ab[32];
#pragma unroll
            for (int i = 0; i < 32; ++i) { const int s2 = sb + i; ab[i] = (s2 < seg) ? ag[(size_t)(s2 * 2 + 0) * 1024 + c] : (f32x2){1.f, 0.f}; }
#pragma unroll
            for (int i = 0; i < 32; ++i) hf = ab[i][0] * hf + ab[i][1]; }
#pragma unroll 1
        for (int sb = 96; sb >= 0; sb -= 32) { f32x2 ab[32];
#pragma unroll
            for (int i = 0; i < 32; ++i) { const int s2 = sb + 31 - i; ab[i] = (s2 > seg) ? ag[(size_t)(s2 * 2 + 1) * 1024 + c] : (f32x2){1.f, 0.f}; }
#pragma unroll
            for (int i = 0; i < 32; ++i) hb = ab[i][0] * hb + ab[i][1]; }
    }
    const bf16_t* xp = R.XR + c;
    {   float x0 = bfu(xp[(size_t)(t0 + 0) * 1024]), x1 = bfu(xp[(size_t)(t0 + 1) * 1024]), x2 = bfu(xp[(size_t)(t0 + 2) * 1024]);
        for (int tb = 0; tb < 64; tb += 16) {
            u32x2 gq[16]; unsigned short xn[16];
#pragma unroll
            for (int i = 0; i < 16; ++i) { const int t = t0 + tb + i; gq[i] = *(const u32x2*)(g_row(R, t) + gcol); xn[i] = xp[(size_t)(t + 3) * 1024]; }
#pragma unroll
            for (int i = 0; i < 16; ++i) { const float x3 = bfu(xn[i]); const float xc = cb + w0 * x0 + w1 * x1 + w2 * x2 + w3 * x3; x0 = x1; x1 = x2; x2 = x3;
                float a, b; rg_gate(bf_lo(gq[i].x), bf_lo(gq[i].y), sp0, xc, a, b); hf = a * hf + b; Lh[(tb + i) * 512 + tid] = hf; }
        }
    }
    {
        float y1 = bfu(xp[(size_t)(t0 + 64) * 1024]), y2 = bfu(xp[(size_t)(t0 + 65) * 1024]), y3 = bfu(xp[(size_t)(t0 + 66) * 1024]);
        for (int tb = 48; tb >= 0; tb -= 16) {
            u32x2 gq[16]; unsigned short xn[16], zz[16];
#pragma unroll
            for (int i = 0; i < 16; ++i) { const int t = t0 + tb + 15 - i; gq[i] = *(const u32x2*)(g_row(R, t) + gcol); xn[i] = xp[(size_t)t * 1024]; zz[i] = R.Z[(size_t)t * 1024 + c]; }
#pragma unroll
            for (int i = 0; i < 16; ++i) { const int tl = tb + 15 - i; const float y0 = bfu(xn[i]); const float xc = cb + w0 * y0 + w1 * y1 + w2 * y2 + w3 * y3; y3 = y2; y2 = y1; y1 = y0;
                float a, b; rg_gate(bf_hi(gq[i].x), bf_hi(gq[i].y), sp1, xc, a, b); hb = a * hb + b;
                const float o = (Lh[tl * 512 + tid] + hb) * gelu_tanh(bfu(zz[i]));
                R.ypre[(size_t)(t0 + tl) * 2048 + 1024 + c] = (bf16_t)(cvt_pk_bf16(o, 0.f) & 0xffffu); }
        }
    }
}

#ifndef NAIVE_GEMM
#define NAIVE_GEMM 0
#endif
template <class Epi, class Sched>
__device__ __forceinline__ void gemm_phase_naive(LAS unsigned char* lds, const int wid, const GParm gp, const Sched& S, const Epi& E) {
    const int lane = fresh_lane(), tid = wid * 64 + lane, wr = wid >> 2, wc = wid & 3, fr = lane & 15, fq = lane >> 4;
    GUnit cur;
    for (int ui = 0; S.next(ui, cur); ++ui) {
        f32x4 acc[2][2][4][2];
#pragma unroll
        for (int ai = 0; ai < 2; ++ai)
#pragma unroll
            for (int bj = 0; bj < 2; ++bj)
#pragma unroll
                for (int m = 0; m < 4; ++m)
#pragma unroll
                    for (int n = 0; n < 2; ++n)
#pragma unroll
                        for (int e = 0; e < 4; ++e) {
                            const int row = 128 * ai + 64 * wr + 16 * m + fr; const int col = Epi::PERM ? (128 * bj + 32 * wc + 8 * fq + 4 * n + e) : (128 * bj + 32 * wc + 16 * n + 4 * fq + e);
                            const char* ap = cur.A + (size_t)row * gp.a_rs; const char* bp = cur.B + (size_t)col * gp.K * 2; float sum = 0.f;
                            for (int k = 0; k < gp.K; k += 8) { const int kt = k >> 6, C = k & 63;
                                const u32x4 av = *(const u32x4*)(ap + (size_t)kt * gp.a_ks + ((C / gp.a_cw) * gp.a_cs + (C % gp.a_cw)) * 2), bv = *(const u32x4*)(bp + k * 2);
                                sum += bf_lo(av.x) * bf_lo(bv.x) + bf_hi(av.x) * bf_hi(bv.x) + bf_lo(av.y) * bf_lo(bv.y) + bf_hi(av.y) * bf_hi(bv.y) + bf_lo(av.z) * bf_lo(bv.z) + bf_hi(av.z) * bf_hi(bv.z) + bf_lo(av.w) * bf_lo(bv.w) + bf_hi(av.w) * bf_hi(bv.w); }
                            acc[ai][bj][m][n][e] = sum; }
        E(acc, cur, wr, wc, fr, fq);
    }
    __syncthreads();
}
#if NAIVE_GEMM
#define GEMM_PHASE gemm_phase_naive
#else
#define GEMM_PHASE pg8::gemm_phase
#endif
__device__ __forceinline__ void transpose_item(const float* W, int K, int N, bf16_t* WT, LAS float* scr, int item, int lane) {
    const int nblk = N / 64, kb = item / nblk, nb = item % nblk, k0 = 64 * kb, n0 = 64 * nb;
    const float* src = W + (size_t)k0 * N + n0 + lane;
#pragma unroll 32
    for (int i = 0; i < 64; ++i) scr[i * 65 + lane] = src[(size_t)i * N];
    LDS_WAIT();
    const int c = lane & 7;
#pragma unroll
    for (int j = 0; j < 8; ++j) { const int n = (lane >> 3) + 8 * j; const LAS float* sp = scr + (8 * c) * 65 + n;
        u32x4 o; o.x = cvt_pk_bf16(sp[0 * 65], sp[1 * 65]); o.y = cvt_pk_bf16(sp[2 * 65], sp[3 * 65]); o.z = cvt_pk_bf16(sp[4 * 65], sp[5 * 65]); o.w = cvt_pk_bf16(sp[6 * 65], sp[7 * 65]);
        *(u32x4*)(WT + (size_t)(n0 + n) * K + k0 + 8 * c) = o; }
    LDS_WAIT();
}
template <bool OUT_BF16> __device__ __forceinline__ void ln_row(const float* xrow, const float* g, const float* b, void* orow, int lane) {
    const f32x4* xr = (const f32x4*)xrow + lane; f32x4 v[8]; float s = 0.f;
#pragma unroll
    for (int j = 0; j < 8; ++j) { v[j] = xr[64 * j]; s += (v[j][0] + v[j][1]) + (v[j][2] + v[j][3]); }
    const float mean = wave_sum(s) * (1.f / DM); float s2 = 0.f;
#pragma unroll
    for (int j = 0; j < 8; ++j) { v[j] = v[j] - mean; s2 += (v[j][0] * v[j][0] + v[j][1] * v[j][1]) + (v[j][2] * v[j][2] + v[j][3] * v[j][3]); }
    const float rstd = 1.0f / sqrtf(wave_sum(s2) * (1.f / DM) + LN_EPS);
#pragma unroll
    for (int j = 0; j < 8; ++j) { const f32x4 gg = ((const f32x4*)g)[lane + 64 * j], bb = ((const f32x4*)b)[lane + 64 * j]; const f32x4 o = v[j] * rstd * gg + bb;
        if (OUT_BF16) { u32x2 w; w.x = cvt_pk_bf16(o[0], o[1]); w.y = cvt_pk_bf16(o[2], o[3]); ((u32x2*)orow)[lane + 64 * j] = w; }
        else ((f32x4*)orow)[lane + 64 * j] = o; }
}
__device__ __forceinline__ void cpow(float lrs, float th, int j, float& re, float& im) {
    double a = (double)j * (double)th * 0.15915494309189535; a -= rint(a); const float af = 2.0f * (float)a;
    const float mag = expf((float)j * lrs); re = mag * cospif(af); im = mag * sinpif(af);
}


#ifndef NAIVE_RG
#define NAIVE_RG 0
#endif
__device__ __forceinline__ void naive_rg_channel(const RgCtx& R, int c) {
    const int gcol = (c >> 6) * 256 + (c & 63);
    const float w0 = R.convw[c], w1 = R.convw[1024 + c], w2 = R.convw[2048 + c], w3 = R.convw[3072 + c], cb = R.convb[c], sp0 = R.sp[c], sp1 = R.sp[1024 + c];
    const bf16_t* xp = R.XR + c; float h = 0.f;
    for (int t = 0; t < SEQ; ++t) { const float xc = cb + w0 * bfu(xp[(size_t)t * 1024]) + w1 * bfu(xp[(size_t)(t + 1) * 1024]) + w2 * bfu(xp[(size_t)(t + 2) * 1024]) + w3 * bfu(xp[(size_t)(t + 3) * 1024]);
        const bf16_t* g = g_row(R, t) + gcol; float a, b; rg_gate(bfu(g[0]), bfu(g[128]), sp0, xc, a, b); h = a * h + b;
        R.ypre[(size_t)t * 2048 + 1024 + c] = (bf16_t)(cvt_pk_bf16(h, 0.f) & 0xffffu); }
    __builtin_amdgcn_fence(__ATOMIC_SEQ_CST, "agent");
    h = 0.f;
    for (int t = SEQ - 1; t >= 0; --t) { const float xc = cb + w0 * bfu(xp[(size_t)t * 1024]) + w1 * bfu(xp[(size_t)(t + 1) * 1024]) + w2 * bfu(xp[(size_t)(t + 2) * 1024]) + w3 * bfu(xp[(size_t)(t + 3) * 1024]);
        const bf16_t* g = g_row(R, t) + gcol; float a, b; rg_gate(bfu(g[64]), bfu(g[192]), sp1, xc, a, b); h = a * h + b;
        const size_t o = (size_t)t * 2048 + 1024 + c; const float y = (bfu(R.ypre[o]) + h) * gelu_tanh(bfu(R.Z[(size_t)t * 1024 + c]));
        R.ypre[o] = (bf16_t)(cvt_pk_bf16(y, 0.f) & 0xffffu); }
}

#ifndef NAIVE_S5
#define NAIVE_S5 0
#endif
__device__ __forceinline__ void naive_s5_group(const float* const* in, const bf16_t* U, float* tmp, bf16_t* YG, int g, int lane) {
    const float *lre = in[6], *lim = in[7], *lstep = in[8], *bre = in[9], *bim = in[10], *cre = in[11], *cim = in[12], *dd = in[13];
    for (int n = 0; n < 2; ++n) {
        const int p = lane, pi = (n * 64 + g) * 64 + p;
        const float lr = fminf(lre[pi], -1e-4f), li = lim[pi], step = expf(lstep[n * 64 + g]); float ar, ai; cpow(lr * step, li * step, 1, ar, ai);
        const float nr = ar - 1.0f, ni = ai, den = lr * lr + li * li; const float qr = (nr * lr + ni * li) / den, qi = (ni * lr - nr * li) / den;
        float hr = 0.f, hi = 0.f;
        for (int tt = 0; tt < SEQ; ++tt) { const int t = n == 0 ? tt : SEQ - 1 - tt; const bf16_t* up = U + (size_t)t * 1024 + g * 16;
            float bur = 0.f, bui = 0.f;
#pragma unroll
            for (int k = 0; k < 16; ++k) { const float uv = bfu(up[k]); const float br = bre[(size_t)pi * 16 + k], bi = bim[(size_t)pi * 16 + k]; bur += (qr * br - qi * bi) * uv; bui += (qr * bi + qi * br) * uv; }
            const float nhr = ar * hr - ai * hi + bur, nhi = ar * hi + ai * hr + bui; hr = nhr; hi = nhi;
#pragma unroll
            for (int k = 0; k < 16; ++k) { const size_t ci = ((size_t)(n * 64 + g) * 16 + k) * 64 + p; float v = cre[ci] * hr - cim[ci] * hi; v = wave_sum(v);
                if (lane == k) { const size_t o = (size_t)t * 1024 + g * 16 + k;
                    if (n == 0) tmp[o] = v; else { const float y = tmp[o] + v + dd[g * 16 + k] * bfu(up[k]); YG[o] = (bf16_t)(cvt_pk_bf16(gelu_tanh(y), 0.f) & 0xffffu); } } }
        }
        __builtin_amdgcn_fence(__ATOMIC_SEQ_CST, "agent");
    }
}

__device__ __forceinline__ void grid_barrier(unsigned* bar, unsigned target, int wave) {
    asm volatile("s_waitcnt vmcnt(0)" ::: "memory");
    __syncthreads();
    if (wave == 0) { const int l = fresh_lane();
        if (l == 0) {
            __builtin_amdgcn_fence(__ATOMIC_RELEASE, "agent"); asm volatile("s_waitcnt vmcnt(0)" ::: "memory");
            __hip_atomic_fetch_add(bar, 1u, __ATOMIC_RELAXED, __HIP_MEMORY_SCOPE_AGENT);
            while (__hip_atomic_load(bar, __ATOMIC_RELAXED, __HIP_MEMORY_SCOPE_AGENT) < target) __builtin_amdgcn_s_sleep(2);
            __builtin_amdgcn_fence(__ATOMIC_ACQUIRE, "agent"); asm volatile("s_waitcnt vmcnt(0)" ::: "memory");
        } }
    __syncthreads();
}

struct Args { const float* in[38]; float* out; unsigned char* ws; int ph_lo, ph_hi; };
typedef const float* cfp_t;
typedef const __attribute__((address_space(4))) cfp_t* kin_t;

__device__ __forceinline__ void s5_precompute(const kin_t ain, unsigned char* aws, int g, int hq, int nh, LAS float* L, const int tid) {
    const float *lre = ain[6], *lim = ain[7], *lstep = ain[8], *bre = ain[9], *bim = ain[10], *cre = ain[11], *cim = ain[12], *dd = ain[13];
    LAS float *PWre = L, *PWim = L + 4224, *BBre = L + 8448, *BBim = L + 10496, *CCre = L + 12544, *CCim = L + 14592, *MT = L + 16640;
    bf16_t* WGg = (bf16_t*)(aws + WS_WG) + (size_t)g * 768 * 512; bf16_t* WCg = (bf16_t*)(aws + WS_WC) + (size_t)g * 512 * 256;
    {
        const int np = tid & 127, jj = tid >> 7, n = np >> 6, p = np & 63; const int pi = (n * 64 + g) * 64 + p;
        const float lr = fminf(lre[pi], -1e-4f), li = lim[pi], step = expf(lstep[n * 64 + g]); const float lrs = lr * step, th = li * step;
        for (int j = jj; j <= 32; j += 4) { float r, i; cpow(lrs, th, j, r, i); PWre[np * 33 + j] = r; PWim[np * 33 + j] = i; }
        float l1r, l1i; cpow(lrs, th, 1, l1r, l1i);
        const float nr = l1r - 1.0f, ni = l1i, den = lr * lr + li * li; const float qr = (nr * lr + ni * li) / den, qi = (ni * lr - nr * li) / den;
#pragma unroll
        for (int k = jj * 4; k < jj * 4 + 4; ++k) { const float br = bre[(size_t)pi * 16 + k], bi = bim[(size_t)pi * 16 + k]; BBre[np * 16 + k] = qr * br - qi * bi; BBim[np * 16 + k] = qr * bi + qi * br; }
        for (int e = tid; e < 2048; e += 512) { const int n2 = e >> 10, k = (e >> 6) & 15, p2 = e & 63; const size_t ci = ((size_t)(n2 * 64 + g) * 16 + k) * 64 + p2; CCre[(n2 * 64 + p2) * 16 + k] = cre[ci]; CCim[(n2 * 64 + p2) * 16 + k] = cim[ci]; }
    }
    __syncthreads();
    for (int i = 0; i < 2; ++i) {
        const int bq = tid + 512 * i, n = bq >> 9, j = (bq >> 4) & 31, kob = (bq >> 2) & 3, kib = bq & 3;
        f32x4 m0 = {0.f, 0.f, 0.f, 0.f}, m1 = m0, m2 = m0, m3 = m0;
        for (int p = 0; p < 64; ++p) { const int np = n * 64 + p; const float pr = PWre[np * 33 + j], pi2 = PWim[np * 33 + j];
            const f32x4 br = *(const LAS f32x4*)(BBre + np * 16 + 4 * kib), bi = *(const LAS f32x4*)(BBim + np * 16 + 4 * kib), cr = *(const LAS f32x4*)(CCre + np * 16 + 4 * kob), ci = *(const LAS f32x4*)(CCim + np * 16 + 4 * kob);
            const f32x4 er = pr * br - pi2 * bi, ei = pr * bi + pi2 * br;
            m0 += cr[0] * er - ci[0] * ei; m1 += cr[1] * er - ci[1] * ei; m2 += cr[2] * er - ci[2] * ei; m3 += cr[3] * er - ci[3] * ei; }
        LAS float* o = MT + ((n * 32 + j) * 16 + 4 * kob) * 16 + 4 * kib;
        *(LAS f32x4*)o = m0; *(LAS f32x4*)(o + 16) = m1; *(LAS f32x4*)(o + 32) = m2; *(LAS f32x4*)(o + 48) = m3;
    }
    __syncthreads();
    for (int i = hq * (64 / nh); i < (hq + 1) * (64 / nh); ++i) {
        const int idx = tid + 512 * i, row = idx >> 6, cp = idx & 63, t = row >> 4, ko = row & 15, s = cp >> 1, ki0 = (cp & 1) * 8;
        f32x4 v0, v1;
        if (t != s) { const LAS float* src = MT + (((t > s ? 0 : 1) * 32 + (t > s ? t - s : s - t)) * 16 + ko) * 16 + ki0; v0 = *(const LAS f32x4*)src; v1 = *(const LAS f32x4*)(src + 4); }
        else { const LAS float* s0 = MT + ko * 16 + ki0; const LAS float* s1 = MT + (32 * 16 + ko) * 16 + ki0; v0 = *(const LAS f32x4*)s0 + *(const LAS f32x4*)s1; v1 = *(const LAS f32x4*)(s0 + 4) + *(const LAS f32x4*)(s1 + 4);
            const float dv = dd[g * 16 + ko];
#pragma unroll
            for (int e = 0; e < 4; ++e) { if (ki0 + e == ko) v0[e] += dv; if (ki0 + 4 + e == ko) v1[e] += dv; } }
        u32x4 w; w.x = cvt_pk_bf16(v0[0], v0[1]); w.y = cvt_pk_bf16(v0[2], v0[3]); w.z = cvt_pk_bf16(v1[0], v1[1]); w.w = cvt_pk_bf16(v1[2], v1[3]);
        *(u32x4*)(WGg + (size_t)row * 512 + cp * 8) = w;
    }
    for (int i = hq * (32 / nh); i < (hq + 1) * (32 / nh); ++i) {
        const int idx = tid + 512 * i, q = idx >> 6, cp = idx & 63, n = q >> 7, ri = (q >> 6) & 1, p = q & 63, s = cp >> 1, ki0 = (cp & 1) * 8, e = n == 0 ? 31 - s : s, np = n * 64 + p;
        const float pr = PWre[np * 33 + e], pi2 = PWim[np * 33 + e]; float v[8];
#pragma unroll
        for (int k = 0; k < 8; ++k) { const float br = BBre[np * 16 + ki0 + k], bi = BBim[np * 16 + ki0 + k]; v[k] = ri == 0 ? pr * br - pi2 * bi : pr * bi + pi2 * br; }
        u32x4 w; w.x = cvt_pk_bf16(v[0], v[1]); w.y = cvt_pk_bf16(v[2], v[3]); w.z = cvt_pk_bf16(v[4], v[5]); w.w = cvt_pk_bf16(v[6], v[7]);
        *(u32x4*)(WGg + (size_t)(512 + q) * 512 + cp * 8) = w;
    }
    for (int i = hq * (32 / nh); i < (hq + 1) * (32 / nh); ++i) {
        const int idx = tid + 512 * i, row = idx >> 5, q0 = (idx & 31) * 8, n = q0 >> 7, ri = (q0 >> 6) & 1, p0 = q0 & 63, t = row >> 4, ko = row & 15, e = n == 0 ? t + 1 : 32 - t; float v[8];
#pragma unroll
        for (int k = 0; k < 8; ++k) { const int np = n * 64 + p0 + k; const float cr = CCre[np * 16 + ko], ci = CCim[np * 16 + ko], pr = PWre[np * 33 + e], pi2 = PWim[np * 33 + e];
            v[k] = ri == 0 ? cr * pr - ci * pi2 : -(cr * pi2 + ci * pr); }
        u32x4 w; w.x = cvt_pk_bf16(v[0], v[1]); w.y = cvt_pk_bf16(v[2], v[3]); w.z = cvt_pk_bf16(v[4], v[5]); w.w = cvt_pk_bf16(v[6], v[7]);
        *(u32x4*)(WCg + (size_t)row * 256 + q0) = w;
    }
    __syncthreads();
}


#ifndef DIAG
#define DIAG 0
#endif
__device__ __forceinline__ void diag_ffn(const float* const* in, const unsigned char* ws, const float* outp, unsigned* flagw, int gtid, int GT) {
    const bf16_t* h1 = (const bf16_t*)(ws + WS_HB); const bf16_t* T = (const bf16_t*)(ws + WS_T); const float* V2 = (const float*)(ws + WS_V2);
    const float *w1 = in[29], *b1 = in[30], *w2 = in[31], *b2 = in[32], *wp = in[33], *wg = in[34], *bg = in[35], *pp = in[1];
    for (int sidx = gtid; sidx < 16384; sidx += GT) {
        unsigned hsh = (unsigned)sidx * 2654435761u, h2 = ((unsigned)sidx + 977u) * 2246822519u; const int r = (hsh >> 8) % SEQ; const int c = (h2 >> 6) % DFF; const int c2 = c % DM;
        float a = b1[c]; for (int k = 0; k < DM; ++k) a += bfu(h1[(size_t)r * DM + k]) * w1[(size_t)k * DFF + c];
        a = fmaxf(a, 0.f); a = a * a; const float tv = bfu(T[(size_t)r * DFF + c]);
        if (fabsf(tv - a) > 0.008f * fabsf(a) + 0.006f) atomicAdd(flagw + 0, 1u);
        float f = b2[c2]; for (int k = 0; k < DFF; ++k) f += bfu(T[(size_t)r * DFF + k]) * w2[(size_t)k * DM + c2];
        float gt = bg[c2]; for (int k = 0; k < DM; ++k) gt += bfu(h1[(size_t)r * DM + k]) * wg[(size_t)k * DM + c2];
        float pw = 0.f; for (int k = 0; k < PLE; ++k) pw += pp[(size_t)r * PLE + k] * wp[(size_t)k * DM + c2];
        const float v2 = DN_ALPHA * bfu(h1[(size_t)r * DM + c2]) + f + fast_sigmoid(gt) * pw; const float got = V2[(size_t)r * DM + c2];
        if (fabsf(got - v2) > 0.008f * fabsf(v2) + 0.006f) atomicAdd(flagw + 1, 1u);
        { const float* vr = V2 + (size_t)r * DM; float m = 0.f; for (int k = 0; k < DM; ++k) m += vr[k]; m /= DM; float v = 0.f; for (int k = 0; k < DM; ++k) { const float d = vr[k] - m; v += d * d; } v /= DM;
          const float e = (vr[c2] - m) / sqrtf(v + LN_EPS) * in[36][c2] + in[37][c2]; const float go = outp[(size_t)r * DM + c2]; if (fabsf(go - e) > 0.004f * fabsf(e) + 0.003f) atomicAdd(flagw + 2, 1u); }
    }
}

__device__ __forceinline__ void diag_pre(const float* const* in, const unsigned char* ws, const unsigned char* dout, unsigned* flagw, int gtid, int GT) {
    const bf16_t* h0 = (const bf16_t*)(ws + WS_HB); const bf16_t* U = (const bf16_t*)(dout + DO_U); const bf16_t* XRb = (const bf16_t*)(ws + WS_XR) + 2048; const bf16_t* Z = (const bf16_t*)(dout + DO_Z);
    const bf16_t* ypre = (const bf16_t*)(dout + DO_YPRE); const bf16_t* ycat = (const bf16_t*)(ws + WS_YCAT); const bf16_t* yg = (const bf16_t*)(ws + WS_YS5G);
    const float *x = in[0], *lg = in[2], *lb = in[3], *win = in[4], *bin = in[5], *gw_ = in[14], *gb = in[15], *g5 = in[23], *gr = in[24];
    for (int sidx = gtid; sidx < 8192; sidx += GT) {
        unsigned hsh = (unsigned)sidx * 2654435761u, h2 = ((unsigned)sidx + 977u) * 2246822519u; const int r = (hsh >> 8) % SEQ; const int c = (h2 >> 6) % DIN; const int c2 = c % DM; const int c1 = c % DS5;
        { float m = 0.f; for (int k = 0; k < DM; ++k) m += x[(size_t)r * DM + k]; m /= DM; float v = 0.f; for (int k = 0; k < DM; ++k) { const float d = x[(size_t)r * DM + k] - m; v += d * d; } v /= DM;
          const float e = (x[(size_t)r * DM + c2] - m) / sqrtf(v + LN_EPS) * lg[c2] + lb[c2]; const float got = bfu(h0[(size_t)r * DM + c2]); if (fabsf(got - e) > 0.008f * fabsf(e) + 0.006f) atomicAdd(flagw + 0, 1u); }
        { float a = bin[c]; for (int k = 0; k < DM; ++k) a += bfu(h0[(size_t)r * DM + k]) * win[(size_t)k * DIN + c];
          const float got = c < 1024 ? bfu(U[(size_t)r * 1024 + c]) : (c < 2048 ? bfu(XRb[(size_t)r * 1024 + c - 1024]) : bfu(Z[(size_t)r * 1024 + c - 2048])); if (fabsf(got - a) > 0.008f * fabsf(a) + 0.006f) atomicAdd(flagw + 3, 1u); }
        { const int hf = c2 >> 10; float ss = 0.f; for (int k = 0; k < 1024; ++k) { const float y = bfu(ypre[(size_t)r * DM + hf * 1024 + k]); ss += y * y; }
          const float e = bfu(ypre[(size_t)r * DM + c2]) / sqrtf(ss / 1024.f + LN_EPS) * (hf ? gr[c2 - 1024] : g5[c2]); const float got = bfu(ycat[(size_t)r * DM + c2]); if (fabsf(got - e) > 0.008f * fabsf(e) + 0.006f) atomicAdd(flagw + 1, 1u); }
        { float a = gb[c1]; for (int k = 0; k < DS5; ++k) a += bfu(yg[(size_t)r * DS5 + k]) * gw_[(size_t)k * DS5 + c1];
          const float e = bfu(yg[(size_t)r * DS5 + c1]) * fast_sigmoid(a); const float got = bfu(ypre[(size_t)r * DM + c1]); if (fabsf(got - e) > 0.008f * fabsf(e) + 0.006f) atomicAdd(flagw + 2, 1u); }
    }
}

__device__ __forceinline__ void diag_v(const float* const* in, const unsigned char* ws, const unsigned char* dout, unsigned* flagw, int gtid, int GT) {
    const bf16_t* h0 = (const bf16_t*)(ws + WS_HB); const bf16_t* ycat = (const bf16_t*)(ws + WS_YCAT); const float* V = (const float*)dout; const float *wo = in[25], *bo = in[26];
    for (int sidx = gtid; sidx < 16384; sidx += GT) { unsigned hsh = (unsigned)sidx * 2654435761u, h2 = ((unsigned)sidx + 977u) * 2246822519u; const int r = (hsh >> 8) % SEQ; const int c = (h2 >> 6) % DM;
        float a = bo[c] + DN_ALPHA * bfu(h0[(size_t)r * DM + c]); for (int k = 0; k < DM; ++k) a += bfu(ycat[(size_t)r * DM + k]) * wo[(size_t)k * DM + c];
        const float got = V[(size_t)r * DM + c]; if (fabsf(got - a) > 0.008f * fabsf(a) + 0.006f) atomicAdd(flagw + 0, 1u); }
}

__device__ __forceinline__ void diag_g(const float* const* in, const unsigned char* ws, unsigned* flagw, int gtid, int GT) {
    const bf16_t* XRp = (const bf16_t*)(ws + WS_XR); const bf16_t* G0 = (const bf16_t*)(ws + WS_G0); const bf16_t* G1 = (const bf16_t*)(ws + WS_G1);
    const float *convw = in[16], *convb = in[17], *wa = in[18], *ba = in[19], *wx = in[20], *bxx = in[21];
    for (int sidx = gtid; sidx < 16384; sidx += GT) { unsigned hsh = (unsigned)sidx * 2654435761u; unsigned h2 = ((unsigned)sidx + 12345u) * 2246822519u; const int t = (hsh >> 7) % SEQ; const int col = (h2 >> 5) % 4096;
        const int h = col >> 8, row = col & 255, bj = row >> 7, dir = (row >> 6) & 1, ch = row & 63;
        const float* W = (bj == 0 ? wa : wx) + ((size_t)(dir * 16 + h) * 64) * 64 + ch; float a = (bj == 0 ? ba : bxx)[(dir * 16 + h) * 64 + ch];
        for (int i = 0; i < 64; ++i) { const int c = 64 * h + i; float xc = convb[c];
            for (int j = 0; j < 4; ++j) xc += convw[j * 1024 + c] * bfu(XRp[(size_t)(t + j) * 1024 + c]);
            a += xc * W[(size_t)i * 64]; }
        const float got = bfu((t < 4096 ? G0 : G1)[(size_t)(t & 4095) * 4096 + col]);
        if (fabsf(got - a) > 0.008f * fabsf(a) + 0.006f) atomicAdd(flagw + 0, 1u); }
}

#ifndef DIAG_HALF
#define DIAG_HALF 1
#endif
__device__ __forceinline__ void diag_max(const unsigned char* ws, unsigned* flagw, int gtid, int GT) {
    const bf16_t* ycat = (const bf16_t*)(ws + WS_YCAT); float mx = 0.f;
    for (size_t i = gtid; i < (size_t)SEQ * 1024; i += GT) { const size_t r = i >> 10, c = (i & 1023) + DIAG_HALF * 1024; mx = fmaxf(mx, fabsf(bfu(ycat[r * DM + c]))); }
    atomicMax(flagw + 0, __float_as_uint(mx));
}

#ifndef DIAG_SEL
#define DIAG_SEL 4
#endif
__device__ __forceinline__ void diag_rows(const float* outp, unsigned* flagw, int gw, int NGW, int lane) {
    for (int row = gw; row < SEQ; row += NGW) { float mx = 0.f; for (int j = lane; j < DM; j += 64) mx = fmaxf(mx, fabsf(outp[(size_t)row * DM + j]));
#pragma unroll
        for (int o = 1; o < 64; o <<= 1) mx = fmaxf(mx, __shfl_xor(mx, o));
        if (lane == 0 && mx > 12.0f) { atomicAdd(flagw + 0, 1u); atomicMin(flagw + 1, (unsigned)row); atomicMax(flagw + 2, (unsigned)row); } }
}

__device__ __forceinline__ void diag_rows_bf(const bf16_t* p, int ld, float thr, unsigned* flagw, int gw, int NGW, int lane) {
    for (int row = gw; row < SEQ; row += NGW) { float mx = 0.f; for (int j = lane; j < ld; j += 64) mx = fmaxf(mx, fabsf(bfu(p[(size_t)row * ld + j])));
#pragma unroll
        for (int o = 1; o < 64; o <<= 1) mx = fmaxf(mx, __shfl_xor(mx, o));
        if (lane == 0 && mx > thr) { atomicAdd(flagw + 0, 1u); atomicMin(flagw + 1, (unsigned)row); atomicMax(flagw + 2, (unsigned)row); } }
}
template <int PHMASK> __global__ void __launch_bounds__(512, 2) mega(Args) {
    extern __shared__ __attribute__((aligned(16))) unsigned char lds_raw[];
    LAS unsigned char* lds = (LAS unsigned char*)lds_raw;
    const int wave = __builtin_amdgcn_readfirstlane((int)threadIdx.x >> 6);
    const int G = gridDim.x, bx = blockIdx.x;
    const int gw = bx * 8 + wave, NGW = G * 8, GT = G * 512;
#define PH_IDS const int lane = fresh_lane(), tid = wave * 64 + lane, gtid = bx * 512 + tid; (void)tid; (void)gtid; (void)lane
    const kin_t KIN = (kin_t)__builtin_amdgcn_kernarg_segment_ptr();
    unsigned char* ws = (unsigned char*)KIN[39]; unsigned char* dout = (unsigned char*)KIN[38];
    const int* kint = (const int*)0; (void)kint;
#if DIAG == 2
    const int lo = ((const __attribute__((address_space(4))) int*)KIN)[80], hi = 7;
#elif DIAG == 3
    const int lo = ((const __attribute__((address_space(4))) int*)KIN)[80], hi = 8;
#elif DIAG == 4
    const int lo = ((const __attribute__((address_space(4))) int*)KIN)[80], hi = 5;
#elif DIAG == 6
    const int lo = ((const __attribute__((address_space(4))) int*)KIN)[80], hi = 7;
#elif DIAG == 8
    const int lo = ((const __attribute__((address_space(4))) int*)KIN)[80], hi = 9;
#elif DIAG == 11 || DIAG == 12
    const int lo = ((const __attribute__((address_space(4))) int*)KIN)[80], hi = 10;
#else
    const int lo = ((const __attribute__((address_space(4))) int*)KIN)[80], hi = ((const __attribute__((address_space(4))) int*)KIN)[81];
#endif
#define IN(k) (((PHMASK >> (k)) & 1) && lo <= (k) && (k) < hi)
    unsigned nbar = 0; unsigned* gbar = (unsigned*)(ws + WS_CTR) + 32;
    if (PHMASK == 0xfff && lo == 0 && hi == NPHASE) cg::this_grid().sync();
#ifndef DBL_MASK
#define DBL_MASK 0
#endif
#define REPS(k) (((DBL_MASK >> (k)) & 1) ? 2 : 1)
#ifndef TSTAMP
#define TSTAMP 0
#define TS_A0 6
#define TS_A1 7
#define TS_B0 9
#define TS_B1 12
#endif
#define SEAM(k) do { if (IN(k) && IN((k) + 1)) { ++nbar; grid_barrier(gbar, nbar * (unsigned)G, wave); if (TSTAMP && bx == 0 && wave == 0) { if (fresh_lane() == 0) ((unsigned long long*)(ws + WS_CTR + 1024))[(k) + 1] = __builtin_amdgcn_s_memrealtime(); } } } while (0)

#define MK_RG const RgCtx RG{(const bf16_t*)(ws + WS_XR), (const bf16_t*)(ws + WS_G0), (const bf16_t*)(ws + WS_G1), (const bf16_t*)(dout + DO_Z), KIN[16], KIN[17], (const float*)(ws + WS_SP), (float*)(ws + WS_AGG), (bf16_t*)(dout + DO_YPRE)}
    if (TSTAMP && bx == 0 && wave == 0) { if (fresh_lane() == 0) ((unsigned long long*)(ws + WS_CTR + 1024))[0] = __builtin_amdgcn_s_memrealtime(); }
    for (int rep = 0; rep < REPS(0); ++rep) {
    if (IN(0)) { PH_IDS;
        if (G != 256) { for (int g = bx; g < 64; g += G) s5_precompute(KIN, ws, g, 0, 1, (LAS float*)lds, tid); }
        {
            LAS float* scr = (LAS float*)(lds + wave * 16640);
            constexpr int I_IN = (DM / 64) * (DIN / 64), I_OUT = (DM / 64) * (DM / 64), I_PG = I_OUT, I_GLU = (DS5 / 64) * (DS5 / 64), I_PW = (PLE / 64) * (DM / 64), I_LN = SEQ / 8;
            constexpr int NITEMS = I_IN + I_OUT + I_PG + I_GLU + I_PW + I_LN;
            for (int it = gw; it < NITEMS; it += NGW) {
                int r = it;
                if (r < I_IN) { transpose_item(KIN[4], DM, DIN, (bf16_t*)(ws + WS_WINT), scr, r, lane); continue; } r -= I_IN;
                if (r < I_LN) { for (int q = 0; q < 8; ++q) { const int row = r * 8 + q; ln_row<true>(KIN[0] + (size_t)row * DM, KIN[2], KIN[3], (bf16_t*)(ws + WS_HB) + (size_t)row * DM, lane); } continue; } r -= I_LN;
                if (r < I_OUT) { transpose_item(KIN[25], DM, DM, (bf16_t*)(ws + WS_WOUTT), scr, r, lane); continue; } r -= I_OUT;
                if (r < I_PG) { transpose_item(KIN[34], DM, DM, (bf16_t*)(ws + WS_PLEGT), scr, r, lane); continue; } r -= I_PG;
                if (r < I_GLU) { transpose_item(KIN[14], DS5, DS5, (bf16_t*)(ws + WS_GLUT), scr, r, lane); continue; } r -= I_GLU;
                transpose_item(KIN[33], PLE, DM, (bf16_t*)(ws + WS_PLEWT), scr, r, lane);
            }
        }
        {   const float* pp = KIN[1]; bf16_t* pb = (bf16_t*)(ws + WS_PB);
            for (int i = gtid; i < SEQ * PLE / 4; i += GT) { const f32x4 v = ((const f32x4*)pp)[i]; u32x2 w; w.x = cvt_pk_bf16(v[0], v[1]); w.y = cvt_pk_bf16(v[2], v[3]); ((u32x2*)pb)[i] = w; }
            const float *convw = KIN[16], *convb = KIN[17], *wa = KIN[18], *ba = KIN[19], *wx = KIN[20], *bxx = KIN[21], *lam = KIN[22];
            bf16_t* rgw = (bf16_t*)(ws + WS_RGW);
            for (int i = gtid; i < 16 * 256 * 32; i += GT) { const int h = i >> 13, row = (i >> 5) & 255, K0 = (i & 31) * 8, j = K0 >> 6, i0 = K0 & 63, ch = row >> 2, bj = (row >> 1) & 1, dir = row & 1;
                const float* W = (bj == 0 ? wa : wx) + ((size_t)(dir * 16 + h) * 64) * 64 + ch; float v[8];
#pragma unroll
                for (int k = 0; k < 8; ++k) v[k] = convw[j * 1024 + 64 * h + i0 + k] * W[(size_t)(i0 + k) * 64];
                u32x4 w; w.x = cvt_pk_bf16(v[0], v[1]); w.y = cvt_pk_bf16(v[2], v[3]); w.z = cvt_pk_bf16(v[4], v[5]); w.w = cvt_pk_bf16(v[6], v[7]);
                *(u32x4*)(rgw + ((size_t)h * 256 + row) * 256 + K0) = w; }
            float* rgb = (float*)(ws + WS_RGBIAS);
            for (int i = gtid; i < 16 * 256; i += GT) { const int h = i >> 8, row = i & 255, ch = row >> 2, bj = (row >> 1) & 1, dir = row & 1;
                const float* W = (bj == 0 ? wa : wx) + ((size_t)(dir * 16 + h) * 64) * 64 + ch; float s = (bj == 0 ? ba : bxx)[(dir * 16 + h) * 64 + ch];
                for (int k = 0; k < 64; ++k) s += convb[64 * h + k] * W[(size_t)k * 64];
                rgb[i] = s; }
            float* spt = (float*)(ws + WS_SP);
            for (int i = gtid; i < 2 * 1024; i += GT) spt[i] = -8.0f * log1pf(expf(-lam[i]));
            unsigned* xr = (unsigned*)(ws + WS_XR);
            for (int i = gtid; i < 1024; i += GT) { xr[i] = 0u; xr[(size_t)(SEQ + 2) * 512 + i] = 0u; }
        }
    }
    if (rep + 1 < REPS(0)) { ++nbar; grid_barrier(gbar, nbar * (unsigned)G, wave); } }
    SEAM(0);
    for (int rep = 0; rep < REPS(1); ++rep) {
    if (IN(1)) { PH_IDS;
        SchedStd S; S.so.init(SEQ, DIN, G, bx); S.A = (const char*)(ws + WS_HB); S.B = (const char*)(ws + WS_WINT); S.a_tile = (size_t)256 * DM * 2; S.b_tile = (size_t)256 * DM * 2;
        EpiProj E{(bf16_t*)(dout + DO_U), (bf16_t*)(ws + WS_XR), (bf16_t*)(dout + DO_Z), KIN[5]};
        GEMM_PHASE(lds, wave, GParm{DM, DM * 2, 128, 64, 0}, S, E);
        if (G == 256 && bx >= 128) { __syncthreads(); const int t2 = wave * 64 + fresh_lane(); s5_precompute(KIN, ws, (bx - 128) >> 1, (bx - 128) & 1, 2, (LAS float*)lds, t2); }
    }
    if (rep + 1 < REPS(1)) { ++nbar; grid_barrier(gbar, nbar * (unsigned)G, wave); } }
    SEAM(1);
    for (int rep = 0; rep < REPS(2); ++rep) {
    if (IN(2)) { PH_IDS;
        { SchedS5a S{(const char*)(dout + DO_U), (const char*)(ws + WS_WG), G, bx}; EpiS5a E{(bf16_t*)(ws + WS_YINTRA), (float*)(ws + WS_S)};
          GEMM_PHASE(lds, wave, GParm{512, TC * 1024 * 2, 4 * 1024 * 2, 16, 1024}, S, E); }
        { SchedRG S{(const char*)(ws + WS_XR), (const char*)(ws + WS_RGW), G, bx}; EpiG E{(bf16_t*)(ws + WS_G0), (bf16_t*)(ws + WS_G1), (const float*)(ws + WS_RGBIAS)};
          GEMM_PHASE(lds, wave, GParm{256, 2048, 2048, 64, 0}, S, E); }
    }
    if (rep + 1 < REPS(2)) { ++nbar; grid_barrier(gbar, nbar * (unsigned)G, wave); } }
    SEAM(2);
    for (int rep = 0; rep < REPS(3); ++rep) {
    if (IN(3)) { PH_IDS;
        if (bx < 128) {
            const int g = bx >> 1, n = bx & 1; const float* Sg = (const float*)(ws + WS_S) + (size_t)g * NCH * 256 + n * 128; LAS float* Ls = (LAS float*)lds;
            for (int i = tid; i < NCH * 32; i += 512) { const int c = i >> 5, q4 = (i & 31) * 4; *(LAS f32x4*)(Ls + c * 128 + q4) = *(const f32x4*)(Sg + (size_t)c * 256 + q4); }
            __syncthreads();
            if (wave == 0) { const int p = lane, pi = (n * 64 + g) * 64 + p;
                const float lr = fminf(KIN[6][pi], -1e-4f), li = KIN[7][pi], step = expf(KIN[8][n * 64 + g]); float ar, ai; cpow(lr * step, li * step, TC, ar, ai);
                bf16_t* hp = (bf16_t*)(ws + WS_HPREV) + (size_t)g * NCH * 256 + n * 128; float hr = 0.f, him = 0.f;
                for (int cc = 0; cc < NCH; ++cc) { const int c = n == 0 ? cc : NCH - 1 - cc;
                    hp[(size_t)c * 256 + p] = (bf16_t)(cvt_pk_bf16(hr, 0.f) & 0xffffu); hp[(size_t)c * 256 + 64 + p] = (bf16_t)(cvt_pk_bf16(him, 0.f) & 0xffffu);
                    const float sr = Ls[c * 128 + p], si = Ls[c * 128 + 64 + p]; const float nr = ar * hr - ai * him + sr, ni = ar * him + ai * hr + si; hr = nr; him = ni; } }
            __syncthreads();
        }
        { MK_RG; for (int un = bx; un < 256; un += G) rg_pass_a(RG, un & 1, un >> 1, tid); }
    }
    if (rep + 1 < REPS(3)) { ++nbar; grid_barrier(gbar, nbar * (unsigned)G, wave); } }
    SEAM(3);
    for (int rep = 0; rep < REPS(4); ++rep) {
    if (IN(4)) { PH_IDS;
#if NAIVE_S5
        if (gw < 64) naive_s5_group((const float* const*)0, (const bf16_t*)(dout + DO_U), (float*)(ws + WS_YINTRA), (bf16_t*)(ws + WS_YS5G), gw, lane);
#else
        { SchedS5b S{(const char*)(ws + WS_HPREV), (const char*)(ws + WS_WC), G, bx}; EpiS5b E{(const bf16_t*)(ws + WS_YINTRA), (bf16_t*)(ws + WS_YS5G)};
          GEMM_PHASE(lds, wave, GParm{256, 512, 128, 64, 0}, S, E); }
#endif
#if NAIVE_RG
        { MK_RG; if (gtid < 1024) naive_rg_channel(RG, gtid); }
#else
        { MK_RG; __syncthreads(); for (int un = bx; un < 256; un += G) { rg_pass_c(RG, un & 1, un >> 1, tid, (LAS float*)lds); __syncthreads(); } }
#endif
    }
    if (rep + 1 < REPS(4)) { ++nbar; grid_barrier(gbar, nbar * (unsigned)G, wave); } }
    SEAM(4);
    for (int rep = 0; rep < REPS(5); ++rep) {
    if (IN(5)) { PH_IDS;
        SchedStd S; S.so.init(SEQ, DS5, G, bx); S.A = (const char*)(ws + WS_YS5G); S.B = (const char*)(ws + WS_GLUT); S.a_tile = (size_t)256 * DS5 * 2; S.b_tile = (size_t)256 * DS5 * 2;
        EpiGlu E{(const bf16_t*)(ws + WS_YS5G), (bf16_t*)(dout + DO_YPRE), KIN[15]};
        GEMM_PHASE(lds, wave, GParm{DS5, DS5 * 2, 128, 64, 0}, S, E);
    }
    if (rep + 1 < REPS(5)) { ++nbar; grid_barrier(gbar, nbar * (unsigned)G, wave); } }
    SEAM(5);
    for (int rep = 0; rep < REPS(6); ++rep) {
    if (IN(6)) { PH_IDS;
        const float *g5 = KIN[23], *gr = KIN[24];
        for (int row = gw; row < SEQ; row += NGW) { const u32x4* yr = (const u32x4*)(dout + DO_YPRE) + (size_t)row * 256; u32x4* oc = (u32x4*)(ws + WS_YCAT) + (size_t)row * 256;
            u32x4 w[4]; float s0 = 0.f, s1 = 0.f;
#pragma unroll
            for (int j = 0; j < 4; ++j) { w[j] = yr[lane + 64 * j]; const float q = bf_lo(w[j].x) * bf_lo(w[j].x) + bf_hi(w[j].x) * bf_hi(w[j].x) + bf_lo(w[j].y) * bf_lo(w[j].y) + bf_hi(w[j].y) * bf_hi(w[j].y)
                + bf_lo(w[j].z) * bf_lo(w[j].z) + bf_hi(w[j].z) * bf_hi(w[j].z) + bf_lo(w[j].w) * bf_lo(w[j].w) + bf_hi(w[j].w) * bf_hi(w[j].w); if (j < 2) s0 += q; else s1 += q; }
            const float r0 = 1.0f / sqrtf(wave_sum(s0) * (1.f / 1024.f) + LN_EPS), r1 = 1.0f / sqrtf(wave_sum(s1) * (1.f / 1024.f) + LN_EPS);
#pragma unroll
            for (int j = 0; j < 4; ++j) { const int col = (lane + 64 * j) * 8; const float rs = j < 2 ? r0 : r1; const float* gp = j < 2 ? g5 + col : gr + (col - 1024);
                const f32x4 ga = *(const f32x4*)gp, gb = *(const f32x4*)(gp + 4);
                u32x4 o; o.x = cvt_pk_bf16(bf_lo(w[j].x) * rs * ga[0], bf_hi(w[j].x) * rs * ga[1]); o.y = cvt_pk_bf16(bf_lo(w[j].y) * rs * ga[2], bf_hi(w[j].y) * rs * ga[3]);
                o.z = cvt_pk_bf16(bf_lo(w[j].z) * rs * gb[0], bf_hi(w[j].z) * rs * gb[1]); o.w = cvt_pk_bf16(bf_lo(w[j].w) * rs * gb[2], bf_hi(w[j].w) * rs * gb[3]); oc[lane + 64 * j] = o; } }
        {
            LAS float* scr = (LAS float*)(lds + wave * 16640);
            constexpr int I_FF1 = (DM / 64) * (DFF / 64), I_FF2 = (DFF / 64) * (DM / 64);
            for (int it = gw; it < I_FF1 + I_FF2; it += NGW) {
                if (it < I_FF1) transpose_item(KIN[29], DM, DFF, (bf16_t*)(ws + WS_FF1T), scr, it, lane);
                else transpose_item(KIN[31], DFF, DM, (bf16_t*)(ws + WS_FF2T), scr, it - I_FF1, lane); }
        }
    }
    if (rep + 1 < REPS(6)) { ++nbar; grid_barrier(gbar, nbar * (unsigned)G, wave); } }
    SEAM(6);
    for (int rep = 0; rep < REPS(7); ++rep) {
    if (IN(7)) { PH_IDS;
        SchedStd S; S.so.init(SEQ, DM, G, bx); S.A = (const char*)(ws + WS_YCAT); S.B = (const char*)(ws + WS_WOUTT); S.a_tile = (size_t)256 * DM * 2; S.b_tile = (size_t)256 * DM * 2;
        EpiRes<false> E{(const bf16_t*)(ws + WS_HB), KIN[26], (float*)dout, nullptr, nullptr};
        GEMM_PHASE(lds, wave, GParm{DM, DM * 2, 128, 64, 0}, S, E);
    }
    if (rep + 1 < REPS(7)) { ++nbar; grid_barrier(gbar, nbar * (unsigned)G, wave); } }
    SEAM(7);
    for (int rep = 0; rep < REPS(8); ++rep) {
    if (IN(8)) { PH_IDS; for (int row = gw; row < SEQ; row += NGW) ln_row<true>((const float*)dout + (size_t)row * DM, KIN[27], KIN[28], (bf16_t*)(ws + WS_HB) + (size_t)row * DM, lane); }
    if (rep + 1 < REPS(8)) { ++nbar; grid_barrier(gbar, nbar * (unsigned)G, wave); } }
    SEAM(8);
    for (int rep = 0; rep < REPS(9); ++rep) {
    if (IN(9)) { PH_IDS;
        { SchedStd S; S.so.init(SEQ, DFF, G, bx); S.A = (const char*)(ws + WS_HB); S.B = (const char*)(ws + WS_FF1T); S.a_tile = (size_t)256 * DM * 2; S.b_tile = (size_t)256 * DM * 2;
          EpiPlain<1> E{(bf16_t*)(ws + WS_T), DFF, KIN[30]}; GEMM_PHASE(lds, wave, GParm{DM, DM * 2, 128, 64, 0}, S, E); }
        { SchedStd S; S.so.init(SEQ, DM, G, bx); S.A = (const char*)(ws + WS_HB); S.B = (const char*)(ws + WS_PLEGT); S.a_tile = (size_t)256 * DM * 2; S.b_tile = (size_t)256 * DM * 2;
          EpiPlain<2> E{(bf16_t*)(dout + DO_SG), DM, KIN[35]}; GEMM_PHASE(lds, wave, GParm{DM, DM * 2, 128, 64, 0}, S, E); }
        { SchedStd S; S.so.init(SEQ, DM, G, bx); S.A = (const char*)(ws + WS_PB); S.B = (const char*)(ws + WS_PLEWT); S.a_tile = (size_t)256 * PLE * 2; S.b_tile = (size_t)256 * PLE * 2;
          EpiPlain<0> E{(bf16_t*)(dout + DO_PW), DM, nullptr}; GEMM_PHASE(lds, wave, GParm{PLE, PLE * 2, 128, 64, 0}, S, E); }
    }
    if (rep + 1 < REPS(9)) { ++nbar; grid_barrier(gbar, nbar * (unsigned)G, wave); } }
    SEAM(9);
    for (int rep = 0; rep < REPS(10); ++rep) {
    if (IN(10)) { PH_IDS;
        SchedStd S; S.so.init(SEQ, DM, G, bx); S.A = (const char*)(ws + WS_T); S.B = (const char*)(ws + WS_FF2T); S.a_tile = (size_t)256 * DFF * 2; S.b_tile = (size_t)256 * DFF * 2;
        EpiRes<true> E{(const bf16_t*)(ws + WS_HB), KIN[32], (float*)(ws + WS_V2), (const bf16_t*)(dout + DO_SG), (const bf16_t*)(dout + DO_PW)};
        GEMM_PHASE(lds, wave, GParm{DFF, DFF * 2, 128, 64, 0}, S, E);
    }
    if (rep + 1 < REPS(10)) { ++nbar; grid_barrier(gbar, nbar * (unsigned)G, wave); } }
    SEAM(10);
    for (int rep = 0; rep < REPS(11); ++rep) {
    if (IN(11)) { PH_IDS; for (int row = gw; row < SEQ; row += NGW) ln_row<false>((const float*)(ws + WS_V2) + (size_t)row * DM, KIN[36], KIN[37], ((float*)KIN[38]) + (size_t)row * DM, lane); }
    if (rep + 1 < REPS(11)) { ++nbar; grid_barrier(gbar, nbar * (unsigned)G, wave); } }
#if TSTAMP
    if (bx == 0 && wave == 0) { if (fresh_lane() == 0) { unsigned long long* st = (unsigned long long*)(ws + WS_CTR + 1024); st[12] = __builtin_amdgcn_s_memrealtime();
        ((float*)KIN[38])[0] = (float)(long long)(st[TS_A1] - st[TS_A0]) * 0.01f; } }
#endif
#if DIAG
    { ++nbar; grid_barrier(gbar, nbar * (unsigned)G, wave); PH_IDS; unsigned* flagw = (unsigned*)(ws + WS_CTR) + 48;
#if DIAG == 1
      diag_ffn((const float* const*)0, ws, ((float*)KIN[38]), flagw, gtid, GT);
#elif DIAG == 2
      diag_pre((const float* const*)0, ws, dout, flagw, gtid, GT);
#elif DIAG == 3
      diag_v((const float* const*)0, ws, dout, flagw, gtid, GT);
#elif DIAG == 4
      diag_g((const float* const*)0, ws, flagw, gtid, GT);
#elif DIAG == 6
      diag_max(ws, flagw, gtid, GT);
#else
      if (bx == 0 && tid == 0) flagw[1] = 0xffffffffu;
      ++nbar; grid_barrier(gbar, nbar * (unsigned)G, wave);
#if DIAG == 7
      diag_rows(((float*)KIN[38]), flagw, gw, NGW, lane);
#elif DIAG == 8
      diag_rows_bf((const bf16_t*)(ws + WS_HB), DM, 12.0f, flagw, gw, NGW, lane);
#elif DIAG == 9
      diag_rows((const float*)(ws + WS_V2), flagw, gw, NGW, lane);
#elif DIAG == 10
      diag_rows_bf((const bf16_t*)(ws + WS_T), DFF, 150.0f, flagw, gw, NGW, lane);
#elif DIAG == 11
      diag_rows_bf((const bf16_t*)(dout + DO_PW), DM, 8.0f, flagw, gw, NGW, lane);
#elif DIAG == 12
      diag_rows_bf((const bf16_t*)(dout + DO_SG), DM, 1.01f, flagw, gw, NGW, lane);
#endif
#endif
      ++nbar; grid_barrier(gbar, nbar * (unsigned)G, wave);
#if DIAG != 1
      for (int i = gtid; i < SEQ * DM; i += GT) ((float*)KIN[38])[i] = 0.f;
      ++nbar; grid_barrier(gbar, nbar * (unsigned)G, wave);
#endif
      if (bx == 0 && tid == 0) { unsigned code = 0; for (int q = 0; q < 4; ++q) if (__hip_atomic_load(flagw + q, __ATOMIC_RELAXED, __HIP_MEMORY_SCOPE_AGENT) > 100u) code |= 1u << q; if (DIAG >= 7) { const unsigned cnt = __hip_atomic_load(flagw, __ATOMIC_RELAXED, __HIP_MEMORY_SCOPE_AGENT), mn = __hip_atomic_load(flagw + 1, __ATOMIC_RELAXED, __HIP_MEMORY_SCOPE_AGENT), mxr = __hip_atomic_load(flagw + 2, __ATOMIC_RELAXED, __HIP_MEMORY_SCOPE_AGENT);
          const unsigned v = DIAG_SEL == 0 ? cnt : DIAG_SEL == 1 ? mn / 100u : DIAG_SEL == 2 ? mn % 100u : DIAG_SEL == 3 ? mxr / 100u : mxr % 100u; ((float*)KIN[38])[0] = 100.0f * (float)(v + 1u); }
      else ((float*)KIN[38])[0] = (DIAG == 6) ? 1000.0f * __uint_as_float(__hip_atomic_load(flagw, __ATOMIC_RELAXED, __HIP_MEMORY_SCOPE_AGENT)) : 1000.0f * (float)(code + 16u); } }
#endif
#undef IN
#undef SEAM
}


#if PER_PHASE_LAUNCH
template <int PH> static void set_attr_one() { (void)hipFuncSetAttribute((const void*)mega<(1 << PH)>, hipFuncAttributeMaxDynamicSharedMemorySize, LDS_BYTES); }
template <int PH> static void launch_one(Args a, int grid, hipStream_t stream) { a.ph_lo = PH; a.ph_hi = PH + 1; hipLaunchKernelGGL(mega<(1 << PH)>, dim3(grid), dim3(512), LDS_BYTES, stream, a); }
static void set_attrs() { set_attr_one<0>(); set_attr_one<1>(); set_attr_one<2>(); set_attr_one<3>(); set_attr_one<4>(); set_attr_one<5>(); set_attr_one<6>(); set_attr_one<7>(); set_attr_one<8>(); set_attr_one<9>(); set_attr_one<10>(); set_attr_one<11>(); }
static void launch_phases(const Args& a, int grid, hipStream_t stream) { launch_one<0>(a, grid, stream); launch_one<1>(a, grid, stream); launch_one<2>(a, grid, stream); launch_one<3>(a, grid, stream); launch_one<4>(a, grid, stream); launch_one<5>(a, grid, stream);
    launch_one<6>(a, grid, stream); launch_one<7>(a, grid, stream); launch_one<8>(a, grid, stream); launch_one<9>(a, grid, stream); launch_one<10>(a, grid, stream); launch_one<11>(a, grid, stream); }
#else
static void set_attrs() { (void)hipFuncSetAttribute((const void*)mega<0xfff>, hipFuncAttributeMaxDynamicSharedMemorySize, LDS_BYTES); }
#endif

extern "C" void kernel_launch(void* const* d_in, const int* in_sizes, int n_in, void* d_out, int out_size, void* d_ws, size_t ws_size, hipStream_t stream) {
    static int grid = 0;
    if (grid == 0) {
        if (n_in != 38 || out_size != SEQ * DM || ws_size < WS_END) { fprintf(stderr, "kernel_launch: unexpected shapes (n_in %d out %d ws %zu)\n", n_in, out_size, ws_size); grid = -1; return; }
        int dev = 0, cus = 0, per_cu = 0;
        hipGetDevice(&dev); hipDeviceGetAttribute(&cus, hipDeviceAttributeMultiprocessorCount, dev);
        set_attrs();
        per_cu = 1;
        (void)hipGetLastError();
        if (per_cu < 1) per_cu = 1;
        grid = cus;
    }
    if (grid < 0) return;
#ifdef POISON_NAN
    hipMemsetAsync(d_ws, 0xFF, WS_END, stream); hipMemsetAsync(d_out, 0xFF, (size_t)64 * MiB, stream);
#endif
    hipMemsetAsync((char*)d_ws + WS_CTR, 0, 256, stream);
    Args a{};
    for (int i = 0; i < 38; ++i) a.in[i] = (const float*)d_in[i];
    a.out = (float*)d_out; a.ws = (unsigned char*)d_ws;
#if PER_PHASE_LAUNCH
    launch_phases(a, grid, stream);
#else
    a.ph_lo = 0; a.ph_hi = NPHASE;
    void* kargs[] = {&a};
    hipError_t e = hipLaunchCooperativeKernel((const void*)mega<0xfff>, dim3(grid), dim3(512), kargs, LDS_BYTES, stream);
    if (e != hipSuccess) fprintf(stderr, "cooperative launch failed: %s (grid %d)\n", hipGetErrorString(e), grid);
#endif
}
```

```cpp
#include <hip/hip_runtime.h>
#include <hip/hip_cooperative_groups.h>
#include <cstdio>
#include <cstdint>
namespace cg = cooperative_groups;

#ifndef PER_PHASE_LAUNCH
#define PER_PHASE_LAUNCH 0
#endif

#define LAS __attribute__((address_space(3)))
typedef unsigned short bf16_t;
typedef short bf16x8 __attribute__((ext_vector_type(8)));
typedef float f32x4 __attribute__((ext_vector_type(4)));
typedef float f32x2 __attribute__((ext_vector_type(2)));
typedef unsigned u32x4 __attribute__((ext_vector_type(4)));
typedef unsigned u32x2 __attribute__((ext_vector_type(2)));

constexpr int SEQ = 8192, DM = 2048, DIN = 3072, DS5 = 1024, DRG = 1024, NG = 64, NP = 64, NK = 16, NH = 16, HD = 64, DFF = 8192, PLE = 256;
constexpr int TC = 32, NCH = SEQ / TC;
constexpr float LN_EPS = 1e-5f, DN_ALPHA = 1.18920711500272f;
constexpr int NPHASE = 12;

constexpr size_t MiB = (size_t)1 << 20;
constexpr size_t WS_FF2T = 0, WS_HB = 32 * MiB, WS_FF1T = 64 * MiB, WS_PLEGT = 96 * MiB, WS_PLEWT = 104 * MiB, WS_PB = 105 * MiB, WS_WOUTT = 109 * MiB,
    WS_V2 = 64 * MiB, WS_G0 = 0, WS_G1 = 64 * MiB,
    WS_WG = 128 * MiB, WS_WC = 176 * MiB, WS_RGW = 192 * MiB, WS_GLUT = 194 * MiB, WS_XR = 196 * MiB, WS_YINTRA = 213 * MiB, WS_S = 229 * MiB, WS_HPREV = 245 * MiB, WS_WINT = 229 * MiB,
    WS_YS5G = 128 * MiB, WS_YCAT = 144 * MiB, WS_T = 128 * MiB,
    WS_AGG = 256 * MiB, WS_CARRY = 258 * MiB, WS_SUMSQ = 259 * MiB, WS_RGBIAS = 259 * MiB + 64 * 1024, WS_SP = WS_RGBIAS + 16 * 1024, WS_CTR = WS_SP + 8 * 1024, WS_END = 260 * MiB;
constexpr size_t DO_YPRE = 0, DO_Z = 32 * MiB, DO_U = 48 * MiB, DO_SG = 0, DO_PW = 32 * MiB;
constexpr int GM_STRIDE = SEQ * 16;
constexpr int LDS_BYTES = 152 * 1024;

typedef __bf16 bf16x2_t __attribute__((ext_vector_type(2)));
__device__ __forceinline__ unsigned cvt_pk_bf16(float lo, float hi) { const f32x2 v = {lo, hi}; const bf16x2_t b = __builtin_convertvector(v, bf16x2_t); return __builtin_bit_cast(unsigned, b); }
__device__ __forceinline__ float bf_lo(unsigned w) { return __uint_as_float(w << 16); }
__device__ __forceinline__ float bf_hi(unsigned w) { return __uint_as_float(w & 0xffff0000u); }
__device__ __forceinline__ f32x4 bf4(u32x2 w) { return (f32x4){bf_lo(w.x), bf_hi(w.x), bf_lo(w.y), bf_hi(w.y)}; }
__device__ __forceinline__ float fast_sigmoid(float x) { return __builtin_amdgcn_rcpf(1.0f + __expf(-x)); }
__device__ __forceinline__ float gelu_tanh(float x) { const float u = 1.5957691216057308f * (x + 0.044715f * x * x * x); return x * fast_sigmoid(u); }
__device__ __forceinline__ float wave_sum(float v) {
#pragma unroll
    for (int o = 1; o < 64; o <<= 1) v += __shfl_xor(v, o);
    return v;
}
__device__ __forceinline__ int lane_id() { return (int)__builtin_amdgcn_mbcnt_hi(~0u, __builtin_amdgcn_mbcnt_lo(~0u, 0u)); }
__device__ __forceinline__ int fresh_lane() { unsigned z = 0; asm volatile("" : "+s"(z)); return (int)__builtin_amdgcn_mbcnt_hi(~0u, __builtin_amdgcn_mbcnt_lo(~0u, z)); }
#define LDS_WAIT() asm volatile("s_waitcnt lgkmcnt(0)" ::: "memory")

namespace pg8 {
constexpr int BM = 256, BK = 64, HALF = 128, HTB = HALF * BK * 2, STAGE_BYTES = 8 * HTB, NXCD = 8, WGM = 8;
__host__ __device__ __forceinline__ int lds_byte(int r, int c) { const int st = (r >> 4) * 2 + (c >> 5), rr = r & 15, cc = c & 31, ob = rr * 64 + cc * 2; return st * 1024 + (ob ^ (((ob >> 9) & 1) << 5)); }
__host__ __device__ __forceinline__ void stage_rc(int b, int& R, int& C) { const int st = b / 1024, sb = b % 1024, swz = sb ^ (((sb >> 9) & 1) << 5); R = (st >> 1) * 16 + swz / 64; C = (st & 1) * 32 + (swz % 64) / 2; }
__host__ __device__ __forceinline__ int perm32(int rho) { const int n = rho >> 4, i = rho & 15; return 8 * (i >> 2) + 4 * n + (i & 3); }

struct Unit { int pm, pn; };
struct StaticOrder {
    int nM, nN, nwg, G, c;
    __host__ __device__ void init(int M, int N, int G_, int c_) { nM = M / BM; nN = N / BM; nwg = nM * nN; G = G_; c = c_; }
    __host__ __device__ bool next(int i, Unit& u) const {
        const long L = (long)i * G + c; if (L >= nwg) return false;
        int wgid = (int)L; { const int q = nwg / NXCD, r = nwg % NXCD, xcd = wgid % NXCD, off = wgid / NXCD; wgid = (xcd < r ? xcd * (q + 1) : r * (q + 1) + (xcd - r) * q) + off; }
        const int nig = WGM * nN, gid = wgid / nig, fm = gid * WGM, gsz = (nM - fm) < WGM ? (nM - fm) : WGM;
        u.pm = fm + ((wgid % nig) % gsz); u.pn = (wgid % nig) / gsz; return true;
    }
};
struct GUnit { const char* A; const char* B; int i0, i1; };
struct GParm { int K; unsigned a_rs, a_ks; int a_cw, a_cs; };

template <class Epi, class Sched>
__device__ __forceinline__ void gemm_phase(LAS unsigned char* lds, const int wid, const GParm gp, const Sched& S, const Epi& E) {
    const int lane = fresh_lane(), tid = wid * 64 + lane, wr = wid >> 2, wc = wid & 3, fr = lane & 15, fq = lane >> 4;
    const int K = gp.K, nt = K / BK;
    unsigned voffA[2], voffB[2];
#pragma unroll
    for (int i = 0; i < 2; ++i) { int R, C; stage_rc(tid * 16 + i * 8192, R, C); const int Rb = Epi::PERM ? ((R & ~31) + perm32(R & 31)) : R;
        voffA[i] = (unsigned)R * gp.a_rs + (unsigned)((C / gp.a_cw) * gp.a_cs + (C % gp.a_cw)) * 2u; voffB[i] = (unsigned)(Rb * K + C) * 2u; }
    const size_t ksA = gp.a_ks, ksB = (size_t)(BK * 2);
    const size_t hsA = (size_t)HALF * gp.a_rs, hsB = (size_t)HALF * K * 2;
    const unsigned ldsw = (unsigned)wid * 1024u;
    const int aoff = lds_byte(wr * 64 + fr, fq * 8), boff = lds_byte(wc * 32 + fr, fq * 8);
#define PG8_SA(b, h) (((b) * 2 + (h)) * HTB)
#define PG8_SB(b, h) ((4 + (b) * 2 + (h)) * HTB)
#define PG8_STAGE(bufoff, gbase, voff) do { _Pragma("unroll") for (int _i = 0; _i < 2; ++_i) \
        __builtin_amdgcn_global_load_lds((const unsigned*)((const char*)(gbase) + (voff)[_i]), (LAS unsigned*)(lds + (bufoff) + ldsw + _i * 8192), 16, 0, 0); } while (0)
#define PG8_LDA(dst, b, h) do { _Pragma("unroll") for (int m = 0; m < 4; ++m) _Pragma("unroll") for (int k = 0; k < 2; ++k) dst[m][k] = *(const LAS bf16x8*)(lds + PG8_SA(b, h) + aoff + m * 2048 + k * 1024); } while (0)
#define PG8_LDB(dst, b, h) do { _Pragma("unroll") for (int n = 0; n < 2; ++n) _Pragma("unroll") for (int k = 0; k < 2; ++k) dst[n][k] = *(const LAS bf16x8*)(lds + PG8_SB(b, h) + boff + n * 2048 + k * 1024); } while (0)
#define PG8_MMA(ai, bj, At, Bt) do { __builtin_amdgcn_s_setprio(1); _Pragma("unroll") for (int m = 0; m < 4; ++m) _Pragma("unroll") for (int n = 0; n < 2; ++n) _Pragma("unroll") for (int k = 0; k < 2; ++k) \
        acc[ai][bj][m][n] = __builtin_amdgcn_mfma_f32_16x16x32_bf16(Bt[n][k], At[m][k], acc[ai][bj][m][n], 0, 0, 0); __builtin_amdgcn_s_setprio(0); } while (0)
#define PG8_WAIT_V(n) asm volatile("s_waitcnt vmcnt(" #n ")" ::: "memory")
#define PG8_WAIT_L(n) asm volatile("s_waitcnt lgkmcnt(" #n ")" ::: "memory")
#define PG8_BAR __builtin_amdgcn_s_barrier()
#define PG8_SCHED __builtin_amdgcn_sched_barrier(0)
    GUnit cur, nxt; int ui = 0;
    if (!S.next(0, cur)) return;
    f32x4 acc[2][2][4][2];
#pragma unroll
    for (int a = 0; a < 2; ++a)
#pragma unroll
        for (int b = 0; b < 2; ++b)
#pragma unroll
            for (int m = 0; m < 4; ++m)
#pragma unroll
                for (int n = 0; n < 2; ++n) acc[a][b][m][n] = (f32x4){0.f, 0.f, 0.f, 0.f};
    bf16x8 At[4][2], B0[2][2], B1[2][2];
    const char* cA = cur.A; const char* cB = cur.B;
    PG8_STAGE(PG8_SB(0, 0), cB, voffB); PG8_STAGE(PG8_SB(0, 1), cB + hsB, voffB); PG8_STAGE(PG8_SA(0, 0), cA, voffA); PG8_STAGE(PG8_SA(0, 1), cA + hsA, voffA);
    if (wr == 1) PG8_BAR;
    PG8_WAIT_V(2); PG8_BAR;
    PG8_STAGE(PG8_SB(1, 0), cB + ksB, voffB); PG8_STAGE(PG8_SA(1, 0), cA + ksA, voffA); PG8_STAGE(PG8_SB(1, 1), cB + hsB + ksB, voffB);
    PG8_WAIT_V(6); PG8_BAR;
    for (;;) {
        const bool has_next = S.next(ui + 1, nxt);
        const char* nA = has_next ? nxt.A : cA; const char* nB = has_next ? nxt.B : cB;
        for (int t = 0; t < nt; t += 2) {
            const bool last = (t == nt - 2);
            const char* a1 = cA + (size_t)(t + 1) * ksA;
            const char* a2 = last ? nA : cA + (size_t)(t + 2) * ksA; const char* b2 = last ? nB : cB + (size_t)(t + 2) * ksB;
            const char* a3 = a2 + ksA; const char* b3 = b2 + ksB;
            PG8_LDB(B0, 0, 0); PG8_LDB(B1, 0, 1); PG8_SCHED; PG8_LDA(At, 0, 0); PG8_STAGE(PG8_SA(1, 1), a1 + hsA, voffA);
            PG8_WAIT_V(8); PG8_WAIT_L(0); PG8_BAR; PG8_MMA(0, 0, At, B0); PG8_MMA(0, 1, At, B1); PG8_BAR; PG8_SCHED;
            PG8_LDA(At, 0, 1); PG8_STAGE(PG8_SB(0, 0), b2, voffB); PG8_STAGE(PG8_SB(0, 1), b2 + hsB, voffB); PG8_STAGE(PG8_SA(0, 0), a2, voffA);
            PG8_WAIT_V(8); PG8_WAIT_L(0); PG8_BAR; PG8_MMA(1, 0, At, B0); PG8_MMA(1, 1, At, B1); PG8_BAR; PG8_SCHED;
            PG8_LDB(B0, 1, 0); PG8_LDB(B1, 1, 1); PG8_SCHED; PG8_LDA(At, 1, 0); PG8_STAGE(PG8_SA(0, 1), a2 + hsA, voffA);
            PG8_WAIT_V(8); PG8_WAIT_L(0); PG8_BAR; PG8_MMA(0, 0, At, B0); PG8_MMA(0, 1, At, B1); PG8_BAR; PG8_SCHED;
            PG8_LDA(At, 1, 1); PG8_STAGE(PG8_SB(1, 0), b3, voffB); PG8_STAGE(PG8_SB(1, 1), b3 + hsB, voffB); PG8_STAGE(PG8_SA(1, 0), a3, voffA);
            PG8_WAIT_V(8); PG8_WAIT_L(0); PG8_BAR; PG8_MMA(1, 0, At, B0); PG8_MMA(1, 1, At, B1); PG8_BAR; PG8_SCHED;
        }
        if (wr == 0) PG8_BAR;
        { const int l_o = fresh_lane(); E(acc, cur, wr, wc, l_o & 15, l_o >> 4); }
        if (!has_next) break;
#pragma unroll
        for (int a = 0; a < 2; ++a)
#pragma unroll
            for (int b = 0; b < 2; ++b)
#pragma unroll
                for (int m = 0; m < 4; ++m)
#pragma unroll
                    for (int n = 0; n < 2; ++n) acc[a][b][m][n] = (f32x4){0.f, 0.f, 0.f, 0.f};
        cur = nxt; cA = nA; cB = nB; ++ui;
        if (wr == 1) PG8_BAR;
    }
    PG8_WAIT_V(0);
    PG8_BAR;
#undef PG8_SA
#undef PG8_SB
#undef PG8_STAGE
#undef PG8_LDA
#undef PG8_LDB
#undef PG8_MMA
#undef PG8_WAIT_V
#undef PG8_WAIT_L
#undef PG8_BAR
#undef PG8_SCHED
}
}
using pg8::GUnit; using pg8::GParm;
typedef f32x4 AccT[2][2][4][2];

struct SchedStd {
    pg8::StaticOrder so; const char* A; const char* B; size_t a_tile, b_tile;
    __device__ __forceinline__ bool next(int i, GUnit& u) const { pg8::Unit t; if (!so.next(i, t)) return false; u.A = A + (size_t)t.pm * a_tile; u.B = B + (size_t)t.pn * b_tile; u.i0 = t.pm; u.i1 = t.pn; return true; }
};
struct SchedS5a { const char* U; const char* WG; int G, c;
    __device__ __forceinline__ bool next(int i, GUnit& u) const { const int L = i * G + c; if (L >= 192) return false; const int g = L / 3, pn = L % 3;
        u.A = U + (size_t)g * GM_STRIDE * 2; u.B = WG + ((size_t)g * 768 + 256 * pn) * 512 * 2; u.i0 = g; u.i1 = pn; return true; } };
struct SchedS5b { const char* HP; const char* WC; int G, c;
    __device__ __forceinline__ bool next(int i, GUnit& u) const { const int L = i * G + c; if (L >= 128) return false; const int g = L / 2, pn = L % 2;
        u.A = HP + (size_t)g * 256 * 256 * 2; u.B = WC + ((size_t)g * 512 + 256 * pn) * 256 * 2; u.i0 = g; u.i1 = pn; return true; } };
struct SchedRG { const char* XR; const char* RGW; int G, c;
    __device__ __forceinline__ bool next(int i, GUnit& u) const { const int L = i * G + c; if (L >= 512) return false; const int h = L % 16, pm = L / 16;
        u.A = XR + ((size_t)(256 * pm) * 1024 + 64 * h) * 2; u.B = RGW + (size_t)h * 256 * 256 * 2; u.i0 = pm; u.i1 = h; return true; } };

template <int ACT> __device__ __forceinline__ void epi_bf16_store(const AccT& acc, bf16_t* tile, int ldc, const float* biast, int wr, int wc, int fr, int fq) {
    const int r0 = wr * 64 + fr, c0 = wc * 32 + 8 * fq;
    f32x4 bv[2][2];
#pragma unroll
    for (int bj = 0; bj < 2; ++bj)
#pragma unroll
        for (int n = 0; n < 2; ++n) bv[bj][n] = biast ? *(const f32x4*)(biast + c0 + bj * 128 + 4 * n) : (f32x4){0.f, 0.f, 0.f, 0.f};
#pragma unroll
    for (int ai = 0; ai < 2; ++ai)
#pragma unroll
        for (int m = 0; m < 4; ++m) { bf16_t* rowp = tile + (size_t)(r0 + ai * 128 + m * 16) * ldc + c0;
#pragma unroll
            for (int bj = 0; bj < 2; ++bj) { f32x4 v0 = acc[ai][bj][m][0] + bv[bj][0], v1 = acc[ai][bj][m][1] + bv[bj][1];
                if (ACT == 1) {
#pragma unroll
                    for (int j = 0; j < 4; ++j) { const float a = fmaxf(v0[j], 0.f), b = fmaxf(v1[j], 0.f); v0[j] = a * a; v1[j] = b * b; } }
                if (ACT == 2) {
#pragma unroll
                    for (int j = 0; j < 4; ++j) { v0[j] = fast_sigmoid(v0[j]); v1[j] = fast_sigmoid(v1[j]); } }
                u32x4 w; w.x = cvt_pk_bf16(v0[0], v0[1]); w.y = cvt_pk_bf16(v0[2], v0[3]); w.z = cvt_pk_bf16(v1[0], v1[1]); w.w = cvt_pk_bf16(v1[2], v1[3]);
                *(u32x4*)(rowp + bj * 128) = w; } }
}
struct EpiProj { static constexpr bool PERM = true; bf16_t *U, *XR, *Z; const float* bias;
    __device__ __forceinline__ void operator()(AccT& acc, const GUnit& u, int wr, int wc, int fr, int fq) const {
        const int pm = u.i0, pn = u.i1;
        if (pn >= 4) { bf16_t* base = pn < 8 ? XR + 2 * 1024 : Z; epi_bf16_store<0>(acc, base + (size_t)pm * 256 * 1024 + (pn & 3) * 256, 1024, bias + pn * 256, wr, wc, fr, fq); return; }
        const int c0 = pn * 256 + wc * 32 + 8 * fq;
#pragma unroll
        for (int bj = 0; bj < 2; ++bj) { const int col = c0 + bj * 128; const f32x4 b0 = *(const f32x4*)(bias + col), b1 = *(const f32x4*)(bias + col + 4); bf16_t* gp = U + (size_t)(col >> 4) * GM_STRIDE + (col & 15);
#pragma unroll
            for (int ai = 0; ai < 2; ++ai)
#pragma unroll
                for (int m = 0; m < 4; ++m) { const int row = pm * 256 + ai * 128 + wr * 64 + m * 16 + fr; const f32x4 v0 = acc[ai][bj][m][0] + b0, v1 = acc[ai][bj][m][1] + b1;
                    u32x4 w; w.x = cvt_pk_bf16(v0[0], v0[1]); w.y = cvt_pk_bf16(v0[2], v0[3]); w.z = cvt_pk_bf16(v1[0], v1[1]); w.w = cvt_pk_bf16(v1[2], v1[3]);
                    *(u32x4*)(gp + (size_t)row * 16) = w; } }
    } };
template <int ACT> struct EpiPlain { static constexpr bool PERM = true; bf16_t* O; int ldc; const float* bias;
    __device__ __forceinline__ void operator()(AccT& acc, const GUnit& u, int wr, int wc, int fr, int fq) const {
        epi_bf16_store<ACT>(acc, O + (size_t)u.i0 * 256 * ldc + u.i1 * 256, ldc, bias ? bias + u.i1 * 256 : nullptr, wr, wc, fr, fq); } };
struct EpiS5a { static constexpr bool PERM = true; bf16_t* YI; float* S;
    __device__ __forceinline__ void operator()(AccT& acc, const GUnit& u, int wr, int wc, int fr, int fq) const {
        const int g = u.i0, pn = u.i1;
#pragma unroll
        for (int ai = 0; ai < 2; ++ai)
#pragma unroll
            for (int m = 0; m < 4; ++m) { const int r = ai * 128 + wr * 64 + m * 16 + fr;
#pragma unroll
                for (int bj = 0; bj < 2; ++bj) { const int c8 = bj * 128 + wc * 32 + 8 * fq; const f32x4 v0 = acc[ai][bj][m][0], v1 = acc[ai][bj][m][1];
                    if (pn < 2) { const int col = pn * 256 + c8, t = col >> 4, k0 = col & 15;
                        u32x4 w; w.x = cvt_pk_bf16(v0[0], v0[1]); w.y = cvt_pk_bf16(v0[2], v0[3]); w.z = cvt_pk_bf16(v1[0], v1[1]); w.w = cvt_pk_bf16(v1[2], v1[3]);
                        *(u32x4*)(YI + (size_t)g * GM_STRIDE + (size_t)r * 512 + col) = w; (void)t; (void)k0; }
                    else { float* sp = S + ((size_t)g * NCH + r) * 256 + c8; *(f32x4*)sp = v0; *(f32x4*)(sp + 4) = v1; } } }
    } };
struct EpiS5b { static constexpr bool PERM = true; const bf16_t* YI; bf16_t* YG;
    __device__ __forceinline__ void operator()(AccT& acc, const GUnit& u, int wr, int wc, int fr, int fq) const {
        const int g = u.i0, pn = u.i1;
#pragma unroll
        for (int ai = 0; ai < 2; ++ai)
#pragma unroll
            for (int m = 0; m < 4; ++m) { const int r = ai * 128 + wr * 64 + m * 16 + fr;
#pragma unroll
                for (int bj = 0; bj < 2; ++bj) { const int col = pn * 256 + bj * 128 + wc * 32 + 8 * fq, t = col >> 4, k0 = col & 15;
                    const size_t off = (size_t)g * GM_STRIDE + (size_t)r * 512 + col; (void)t; (void)k0; const u32x4 yi = *(const u32x4*)(YI + off);
                    f32x4 v0 = acc[ai][bj][m][0] + (f32x4){bf_lo(yi.x), bf_hi(yi.x), bf_lo(yi.y), bf_hi(yi.y)}, v1 = acc[ai][bj][m][1] + (f32x4){bf_lo(yi.z), bf_hi(yi.z), bf_lo(yi.w), bf_hi(yi.w)};
#pragma unroll
                    for (int j = 0; j < 4; ++j) { v0[j] = gelu_tanh(v0[j]); v1[j] = gelu_tanh(v1[j]); }
                    u32x4 w; w.x = cvt_pk_bf16(v0[0], v0[1]); w.y = cvt_pk_bf16(v0[2], v0[3]); w.z = cvt_pk_bf16(v1[0], v1[1]); w.w = cvt_pk_bf16(v1[2], v1[3]);
                    *(u32x4*)(YG + off) = w; } }
    } };
struct EpiGlu { static constexpr bool PERM = true; const bf16_t* YG; bf16_t* YPRE; const float* bias;
    __device__ __forceinline__ void operator()(AccT& acc, const GUnit& u, int wr, int wc, int fr, int fq) const {
        const int pm = u.i0, pn = u.i1; const int c0 = pn * 256 + wc * 32 + 8 * fq;
        f32x4 bv[2][2];
#pragma unroll
        for (int bj = 0; bj < 2; ++bj)
#pragma unroll
            for (int n = 0; n < 2; ++n) bv[bj][n] = *(const f32x4*)(bias + c0 + bj * 128 + 4 * n);
#pragma unroll
        for (int ai = 0; ai < 2; ++ai)
#pragma unroll
            for (int m = 0; m < 4; ++m) { const int row = pm * 256 + ai * 128 + wr * 64 + m * 16 + fr;
#pragma unroll
                for (int bj = 0; bj < 2; ++bj) { const int col = c0 + bj * 128; const u32x4 yv = *(const u32x4*)(YG + (size_t)(col >> 4) * GM_STRIDE + (size_t)row * 16 + (col & 15));
                    const f32x4 y0 = (f32x4){bf_lo(yv.x), bf_hi(yv.x), bf_lo(yv.y), bf_hi(yv.y)}, y1 = (f32x4){bf_lo(yv.z), bf_hi(yv.z), bf_lo(yv.w), bf_hi(yv.w)};
                    f32x4 v0 = acc[ai][bj][m][0] + bv[bj][0], v1 = acc[ai][bj][m][1] + bv[bj][1];
#pragma unroll
                    for (int j = 0; j < 4; ++j) { v0[j] = y0[j] * fast_sigmoid(v0[j]); v1[j] = y1[j] * fast_sigmoid(v1[j]); }
                    u32x4 w; w.x = cvt_pk_bf16(v0[0], v0[1]); w.y = cvt_pk_bf16(v0[2], v0[3]); w.z = cvt_pk_bf16(v1[0], v1[1]); w.w = cvt_pk_bf16(v1[2], v1[3]);
                    *(u32x4*)(YPRE + (size_t)row * 2048 + col) = w; }
                }
    } };
template <bool PLEADD> struct EpiRes { static constexpr bool PERM = false; const bf16_t* HBp; const float* bias; float* V; const bf16_t* SG; const bf16_t* PW;
    __device__ __forceinline__ void operator()(AccT& acc, const GUnit& u, int wr, int wc, int fr, int fq) const {
        const int pm = u.i0, pn = u.i1; const int c0 = pn * 256 + wc * 32 + 4 * fq;
        f32x4 bv[2][2];
#pragma unroll
        for (int bj = 0; bj < 2; ++bj)
#pragma unroll
            for (int n = 0; n < 2; ++n) bv[bj][n] = *(const f32x4*)(bias + c0 + bj * 128 + n * 16);
#pragma unroll
        for (int ai = 0; ai < 2; ++ai)
#pragma unroll
            for (int m = 0; m < 4; ++m) { const int row = pm * 256 + ai * 128 + wr * 64 + m * 16 + fr;
#pragma unroll
                for (int bj = 0; bj < 2; ++bj)
#pragma unroll
                    for (int n = 0; n < 2; ++n) { const size_t off = (size_t)row * 2048 + c0 + bj * 128 + n * 16;
                        f32x4 v = acc[ai][bj][m][n] + bv[bj][n] + DN_ALPHA * bf4(*(const u32x2*)(HBp + off));
                        if (PLEADD) v += bf4(*(const u32x2*)(SG + off)) * bf4(*(const u32x2*)(PW + off));
                        *(f32x4*)(V + off) = v; } }
    } };

struct EpiG { static constexpr bool PERM = true; bf16_t *G0, *G1; const float* bias;
    __device__ __forceinline__ void operator()(AccT& acc, const GUnit& u, int wr, int wc, int fr, int fq) const {
        const int pm = u.i0, h = u.i1; bf16_t* base = (pm < 16 ? G0 : G1) + (size_t)(pm & 15) * 256 * 4096 + h * 256;
        epi_bf16_store<0>(acc, base, 4096, bias + h * 256, wr, wc, fr, fq); } };
__device__ __forceinline__ float bfu(unsigned short v) { return __uint_as_float(((unsigned)v) << 16); }
__device__ __forceinline__ void rg_gate(float pa, float px, float spv, float xc, float& a, float& b) {
    const float r = fast_sigmoid(pa), ig = fast_sigmoid(px); const float la = spv * r; a = __expf(la); const float x = 2.0f * la;
    const float om = -x * (1.0f + x * (0.5f + x * (0.16666667f + x * (0.041666668f + x * 0.008333334f))));
    b = __builtin_amdgcn_sqrtf(fmaxf(om, 0.f)) * ig * xc; }
__device__ __forceinline__ void rg_gate2(float pa, float px, float spv, float xc, float& a, float& b, float& r) {
    r = fast_sigmoid(pa); const float ig = fast_sigmoid(px); const float la = spv * r; a = __expf(la); const float x = 2.0f * la;
    const float om = -x * (1.0f + x * (0.5f + x * (0.16666667f + x * (0.041666668f + x * 0.008333334f))));
    b = __builtin_amdgcn_sqrtf(fmaxf(om, 0.f)) * ig * xc; }
struct RgCtx { const bf16_t *XR, *G0, *G1, *Z; const float *convw, *convb, *sp; float* agg; bf16_t* ypre; };
__device__ __forceinline__ const bf16_t* g_row(const RgCtx& R, int t) { return (t < 4096 ? R.G0 : R.G1) + (size_t)(t & 4095) * 4096; }
__device__ __forceinline__ void rg_pass_a(const RgCtx& R, int half, int seg, int tid) {
    const int c = half * 512 + tid, gcol = (c >> 6) * 256 + (c & 63) * 4, t0 = seg * 64;
    const float w0 = R.convw[c], w1 = R.convw[1024 + c], w2 = R.convw[2048 + c], w3 = R.convw[3072 + c], cb = R.convb[c], sp0 = R.sp[c], sp1 = R.sp[1024 + c];
    const bf16_t* xp = R.XR + c;
    float x0 = bfu(xp[(size_t)(t0 + 0) * 1024]), x1 = bfu(xp[(size_t)(t0 + 1) * 1024]), x2 = bfu(xp[(size_t)(t0 + 2) * 1024]);
    float Af = 1.f, Bf = 0.f, Ab = 1.f, Bb = 0.f;
    for (int tb = 0; tb < 64; tb += 16) {
        u32x2 gq[16]; unsigned short xn[16];
#pragma unroll
        for (int i = 0; i < 16; ++i) { const int t = t0 + tb + i; gq[i] = *(const u32x2*)(g_row(R, t) + gcol); xn[i] = xp[(size_t)(t + 3) * 1024]; }
#pragma unroll
        for (int i = 0; i < 16; ++i) { const float x3 = bfu(xn[i]); const float xc = cb + w0 * x0 + w1 * x1 + w2 * x2 + w3 * x3; x0 = x1; x1 = x2; x2 = x3;
            float a, b, r0, r1, b0; rg_gate2(bf_lo(gq[i].x), bf_lo(gq[i].y), sp0, xc, a, b, r0); Bf = a * Bf + b; Af = a * Af; b0 = b;
            rg_gate2(bf_hi(gq[i].x), bf_hi(gq[i].y), sp1, xc, a, b, r1); Bb = Ab * b + Bb; Ab = Ab * a;
            u32x2 w; w.x = cvt_pk_bf16(r0, r1); w.y = cvt_pk_bf16(b0, b); *(u32x2*)((bf16_t*)g_row(R, t0 + tb + i) + gcol) = w; }
    }
    *(f32x2*)(R.agg + ((size_t)(seg * 2 + 0) * 1024 + c) * 2) = (f32x2){Af, Bf};
    *(f32x2*)(R.agg + ((size_t)(seg * 2 + 1) * 1024 + c) * 2) = (f32x2){Ab, Bb};
}
__device__ __forceinline__ void rg_pass_c(const RgCtx& R, int half, int seg, int tid, LAS float* Lh) {
    const int c = half * 512 + tid, gcol = (c >> 6) * 256 + (c & 63) * 4, t0 = seg * 64;
    const float sp0 = R.sp[c], sp1 = R.sp[1024 + c];
    const f32x2* ag = (const f32x2*)R.agg;
    float hf = 0.f, hb = 0.f;
    {
#pragma unroll 1
        for (int sb = 0; sb < 128; sb += 32) { f32x2 ab[32];
#pragma unroll
            for (int i = 0; i < 32; ++i) { const int s2 = sb + i; ab[i] = (s2 < seg) ? ag[(size_t)(s2 * 2 + 0) * 1024 + c] : (f32x2){1.f, 0.f}; }
#pragma unroll
            for (int i = 0; i < 32; ++i) hf = ab[i][0] * hf + ab[i][1]; }
#pragma unroll 1
        for (int sb = 96; sb >= 0; sb -= 32) { f32x2 ab[32];
#pragma unroll
            for (int i = 0; i < 32; ++i) { const int s2 = sb + 31 - i; ab[i] = (s2 > seg) ? ag[(size_t)(s2 * 2 + 1) * 1024 + c] : (f32x2){1.f, 0.f}; }
#pragma unroll
            for (int i = 0; i < 32; ++i) hb = ab[i][0] * hb + ab[i][1]; }
    }
    {
        for (int tb = 0; tb < 64; tb += 16) {
            u32x2 gq[16];
#pragma unroll
            for (int i = 0; i < 16; ++i) gq[i] = *(const u32x2*)(g_row(R, t0 + tb + i) + gcol);
#pragma unroll
            for (int i = 0; i < 16; ++i) { const float a = __expf(sp0 * bf_lo(gq[i].x)); hf = a * hf + bf_lo(gq[i].y); Lh[(tb + i) * 512 + tid] = hf; }
        }
    }
    {
        for (int tb = 48; tb >= 0; tb -= 16) {
            u32x2 gq[16]; unsigned short zz[16];
#pragma unroll
            for (int i = 0; i < 16; ++i) { const int t = t0 + tb + 15 - i; gq[i] = *(const u32x2*)(g_row(R, t) + gcol); zz[i] = R.Z[(size_t)t * 1024 + c]; }
#pragma unroll
            for (int i = 0; i < 16; ++i) { const int tl = tb + 15 - i; const float a = __expf(sp1 * bf_hi(gq[i].x)); hb = a * hb + bf_hi(gq[i].y);
                const float o = (Lh[tl * 512 + tid] + hb) * gelu_tanh(bfu(zz[i]));
                R.ypre[(size_t)(t0 + tl) * 2048 + 1024 + c] = (bf16_t)(cvt_pk_bf16(o, 0.f) & 0xffffu); }
        }
    }
}

#ifndef NAIVE_GEMM
#define NAIVE_GEMM 0
#endif
template <class Epi, class Sched>
__device__ __forceinline__ void gemm_phase_naive(LAS unsigned char* lds, const int wid, const GParm gp, const Sched& S, const Epi& E) {
    const int lane = fresh_lane(), tid = wid * 64 + lane, wr = wid >> 2, wc = wid & 3, fr = lane & 15, fq = lane >> 4;
    GUnit cur;
    for (int ui = 0; S.next(ui, cur); ++ui) {
        f32x4 acc[2][2][4][2];
#pragma unroll
        for (int ai = 0; ai < 2; ++ai)
#pragma unroll
            for (int bj = 0; bj < 2; ++bj)
#pragma unroll
                for (int m = 0; m < 4; ++m)
#pragma unroll
                    for (int n = 0; n < 2; ++n)
#pragma unroll
                        for (int e = 0; e < 4; ++e) {
                            const int row = 128 * ai + 64 * wr + 16 * m + fr; const int col = Epi::PERM ? (128 * bj + 32 * wc + 8 * fq + 4 * n + e) : (128 * bj + 32 * wc + 16 * n + 4 * fq + e);
                            const char* ap = cur.A + (size_t)row * gp.a_rs; const char* bp = cur.B + (size_t)col * gp.K * 2; float sum = 0.f;
                            for (int k = 0; k < gp.K; k += 8) { const int kt = k >> 6, C = k & 63;
                                const u32x4 av = *(const u32x4*)(ap + (size_t)kt * gp.a_ks + ((C / gp.a_cw) * gp.a_cs + (C % gp.a_cw)) * 2), bv = *(const u32x4*)(bp + k * 2);
                                sum += bf_lo(av.x) * bf_lo(bv.x) + bf_hi(av.x) * bf_hi(bv.x) + bf_lo(av.y) * bf_lo(bv.y) + bf_hi(av.y) * bf_hi(bv.y) + bf_lo(av.z) * bf_lo(bv.z) + bf_hi(av.z) * bf_hi(bv.z) + bf_lo(av.w) * bf_lo(bv.w) + bf_hi(av.w) * bf_hi(bv.w); }
                            acc[ai][bj][m][n][e] = sum; }
        E(acc, cur, wr, wc, fr, fq);
    }
    __syncthreads();
}
#if NAIVE_GEMM
#define GEMM_PHASE gemm_phase_naive
#else
#define GEMM_PHASE pg8::gemm_phase
#endif
__device__ __forceinline__ void transpose_item(const float* W, int K, int N, bf16_t* WT, LAS float* scr, int item, int lane) {
    const int nblk = N / 64, kb = item / nblk, nb = item % nblk, k0 = 64 * kb, n0 = 64 * nb;
    const float* src = W + (size_t)k0 * N + n0 + lane;
#pragma unroll 32
    for (int i = 0; i < 64; ++i) scr[i * 65 + lane] = src[(size_t)i * N];
    LDS_WAIT();
    const int c = lane & 7;
#pragma unroll
    for (int j = 0; j < 8; ++j) { const int n = (lane >> 3) + 8 * j; const LAS float* sp = scr + (8 * c) * 65 + n;
        u32x4 o; o.x = cvt_pk_bf16(sp[0 * 65], sp[1 * 65]); o.y = cvt_pk_bf16(sp[2 * 65], sp[3 * 65]); o.z = cvt_pk_bf16(sp[4 * 65], sp[5 * 65]); o.w = cvt_pk_bf16(sp[6 * 65], sp[7 * 65]);
        *(u32x4*)(WT + (size_t)(n0 + n) * K + k0 + 8 * c) = o; }
    LDS_WAIT();
}
template <bool OUT_BF16> __device__ __forceinline__ void ln_row(const float* xrow, const float* g, const float* b, void* orow, int lane) {
    const f32x4* xr = (const f32x4*)xrow + lane; f32x4 v[8]; float s = 0.f;
#pragma unroll
    for (int j = 0; j < 8; ++j) { v[j] = xr[64 * j]; s += (v[j][0] + v[j][1]) + (v[j][2] + v[j][3]); }
    const float mean = wave_sum(s) * (1.f / DM); float s2 = 0.f;
#pragma unroll
    for (int j = 0; j < 8; ++j) { v[j] = v[j] - mean; s2 += (v[j][0] * v[j][0] + v[j][1] * v[j][1]) + (v[j][2] * v[j][2] + v[j][3] * v[j][3]); }
    const float rstd = 1.0f / sqrtf(wave_sum(s2) * (1.f / DM) + LN_EPS);
#pragma unroll
    for (int j = 0; j < 8; ++j) { const f32x4 gg = ((const f32x4*)g)[lane + 64 * j], bb = ((const f32x4*)b)[lane + 64 * j]; const f32x4 o = v[j] * rstd * gg + bb;
        if (OUT_BF16) { u32x2 w; w.x = cvt_pk_bf16(o[0], o[1]); w.y = cvt_pk_bf16(o[2], o[3]); ((u32x2*)orow)[lane + 64 * j] = w; }
        else ((f32x4*)orow)[lane + 64 * j] = o; }
}
__device__ __forceinline__ void cpow(float lrs, float th, int j, float& re, float& im) {
    double a = (double)j * (double)th * 0.15915494309189535; a -= rint(a); const float af = 2.0f * (float)a;
    const float mag = expf((float)j * lrs); re = mag * cospif(af); im = mag * sinpif(af);
}


#ifndef NAIVE_RG
#define NAIVE_RG 0
#endif
__device__ __forceinline__ void naive_rg_channel(const RgCtx& R, int c) {
    const int gcol = (c >> 6) * 256 + (c & 63);
    const float w0 = R.convw[c], w1 = R.convw[1024 + c], w2 = R.convw[2048 + c], w3 = R.convw[3072 + c], cb = R.convb[c], sp0 = R.sp[c], sp1 = R.sp[1024 + c];
    const bf16_t* xp = R.XR + c; float h = 0.f;
    for (int t = 0; t < SEQ; ++t) { const float xc = cb + w0 * bfu(xp[(size_t)t * 1024]) + w1 * bfu(xp[(size_t)(t + 1) * 1024]) + w2 * bfu(xp[(size_t)(t + 2) * 1024]) + w3 * bfu(xp[(size_t)(t + 3) * 1024]);
        const bf16_t* g = g_row(R, t) + gcol; float a, b; rg_gate(bfu(g[0]), bfu(g[128]), sp0, xc, a, b); h = a * h + b;
        R.ypre[(size_t)t * 2048 + 1024 + c] = (bf16_t)(cvt_pk_bf16(h, 0.f) & 0xffffu); }
    __builtin_amdgcn_fence(__ATOMIC_SEQ_CST, "agent");
    h = 0.f;
    for (int t = SEQ - 1; t >= 0; --t) { const float xc = cb + w0 * bfu(xp[(size_t)t * 1024]) + w1 * bfu(xp[(size_t)(t + 1) * 1024]) + w2 * bfu(xp[(size_t)(t + 2) * 1024]) + w3 * bfu(xp[(size_t)(t + 3) * 1024]);
        const bf16_t* g = g_row(R, t) + gcol; float a, b; rg_gate(bfu(g[64]), bfu(g[192]), sp1, xc, a, b); h = a * h + b;
        const size_t o = (size_t)t * 2048 + 1024 + c; const float y = (bfu(R.ypre[o]) + h) * gelu_tanh(bfu(R.Z[(size_t)t * 1024 + c]));
        R.ypre[o] = (bf16_t)(cvt_pk_bf16(y, 0.f) & 0xffffu); }
}

#ifndef NAIVE_S5
#define NAIVE_S5 0
#endif
__device__ __forceinline__ void naive_s5_group(const float* const* in, const bf16_t* U, float* tmp, bf16_t* YG, int g, int lane) {
    const float *lre = in[6], *lim = in[7], *lstep = in[8], *bre = in[9], *bim = in[10], *cre = in[11], *cim = in[12], *dd = in[13];
    for (int n = 0; n < 2; ++n) {
        const int p = lane, pi = (n * 64 + g) * 64 + p;
        const float lr = fminf(lre[pi], -1e-4f), li = lim[pi], step = expf(lstep[n * 64 + g]); float ar, ai; cpow(lr * step, li * step, 1, ar, ai);
        const float nr = ar - 1.0f, ni = ai, den = lr * lr + li * li; const float qr = (nr * lr + ni * li) / den, qi = (ni * lr - nr * li) / den;
        float hr = 0.f, hi = 0.f;
        for (int tt = 0; tt < SEQ; ++tt) { const int t = n == 0 ? tt : SEQ - 1 - tt; const bf16_t* up = U + (size_t)t * 1024 + g * 16;
            float bur = 0.f, bui = 0.f;
#pragma unroll
            for (int k = 0; k < 16; ++k) { const float uv = bfu(up[k]); const float br = bre[(size_t)pi * 16 + k], bi = bim[(size_t)pi * 16 + k]; bur += (qr * br - qi * bi) * uv; bui += (qr * bi + qi * br) * uv; }
            const float nhr = ar * hr - ai * hi + bur, nhi = ar * hi + ai * hr + bui; hr = nhr; hi = nhi;
#pragma unroll
            for (int k = 0; k < 16; ++k) { const size_t ci = ((size_t)(n * 64 + g) * 16 + k) * 64 + p; float v = cre[ci] * hr - cim[ci] * hi; v = wave_sum(v);
                if (lane == k) { const size_t o = (size_t)t * 1024 + g * 16 + k;
                    if (n == 0) tmp[o] = v; else { const float y = tmp[o] + v + dd[g * 16 + k] * bfu(up[k]); YG[o] = (bf16_t)(cvt_pk_bf16(gelu_tanh(y), 0.f) & 0xffffu); } } }
        }
        __builtin_amdgcn_fence(__ATOMIC_SEQ_CST, "agent");
    }
}

__device__ __forceinline__ void grid_barrier(unsigned* bar, unsigned target, int wave) {
    asm volatile("s_waitcnt vmcnt(0)" ::: "memory");
    __syncthreads();
    if (wave == 0) { const int l = fresh_lane();
        if (l == 0) {
            __builtin_amdgcn_fence(__ATOMIC_RELEASE, "agent"); asm volatile("s_waitcnt vmcnt(0)" ::: "memory");
            __hip_atomic_fetch_add(bar, 1u, __ATOMIC_RELAXED, __HIP_MEMORY_SCOPE_AGENT);
            while (__hip_atomic_load(bar, __ATOMIC_RELAXED, __HIP_MEMORY_SCOPE_AGENT) < target) __builtin_amdgcn_s_sleep(2);
            __builtin_amdgcn_fence(__ATOMIC_ACQUIRE, "agent"); asm volatile("s_waitcnt vmcnt(0)" ::: "memory");
        } }
    __syncthreads();
}

struct Args { const float* in[38]; float* out; unsigned char* ws; int ph_lo, ph_hi; };
typedef const float* cfp_t;
typedef const __attribute__((address_space(4))) cfp_t* kin_t;

__device__ __forceinline__ void s5_precompute(const kin_t ain, unsigned char* aws, int g, int hq, int nh, LAS float* L, const int tid) {
    const float *lre = ain[6], *lim = ain[7], *lstep = ain[8], *bre = ain[9], *bim = ain[10], *cre = ain[11], *cim = ain[12], *dd = ain[13];
    LAS float *PWre = L, *PWim = L + 4224, *BBre = L + 8448, *BBim = L + 10496, *CCre = L + 12544, *CCim = L + 14592, *MT = L + 16640, *C2re = L + 33280, *C2im = L + 35328;
    bf16_t* WGg = (bf16_t*)(aws + WS_WG) + (size_t)g * 768 * 512; bf16_t* WCg = (bf16_t*)(aws + WS_WC) + (size_t)g * 512 * 256;
    {
        const int np = tid & 127, jj = tid >> 7, n = np >> 6, p = np & 63; const int pi = (n * 64 + g) * 64 + p;
        const float lr = fminf(lre[pi], -1e-4f), li = lim[pi], step = expf(lstep[n * 64 + g]); const float lrs = lr * step, th = li * step;
        for (int j = jj; j <= 32; j += 4) { float r, i; cpow(lrs, th, j, r, i); PWre[np * 33 + j] = r; PWim[np * 33 + j] = i; }
        float l1r, l1i; cpow(lrs, th, 1, l1r, l1i);
        const float nr = l1r - 1.0f, ni = l1i, den = lr * lr + li * li; const float qr = (nr * lr + ni * li) / den, qi = (ni * lr - nr * li) / den;
#pragma unroll
        for (int k = jj * 4; k < jj * 4 + 4; ++k) { const float br = bre[(size_t)pi * 16 + k], bi = bim[(size_t)pi * 16 + k]; BBre[np * 16 + k] = qr * br - qi * bi; BBim[np * 16 + k] = qr * bi + qi * br; }
        for (int e = tid; e < 2048; e += 512) { const int n2 = e >> 10, k = (e >> 6) & 15, p2 = e & 63; const size_t ci = ((size_t)(n2 * 64 + g) * 16 + k) * 64 + p2; CCre[(n2 * 64 + p2) * 16 + k] = cre[ci]; CCim[(n2 * 64 + p2) * 16 + k] = cim[ci]; C2re[e] = cre[ci]; C2im[e] = cim[ci]; }
    }
    __syncthreads();
    for (int i = 0; i < 3; ++i) {
        if (nh == 2) { if (i < 2 && i != hq) continue; if (i == 2 && (hq != 0 || tid >= 16)) continue; } else if (i == 2) continue;
        const int bq = (i == 2) ? 512 + tid : tid + 512 * i, n = bq >> 9, j = (bq >> 4) & 31, kob = (bq >> 2) & 3, kib = bq & 3;
        f32x4 m0 = {0.f, 0.f, 0.f, 0.f}, m1 = m0, m2 = m0, m3 = m0;
        for (int p = 0; p < 64; ++p) { const int np = n * 64 + p; const float pr = PWre[np * 33 + j], pi2 = PWim[np * 33 + j];
            const f32x4 br = *(const LAS f32x4*)(BBre + np * 16 + 4 * kib), bi = *(const LAS f32x4*)(BBim + np * 16 + 4 * kib), cr = *(const LAS f32x4*)(CCre + np * 16 + 4 * kob), ci = *(const LAS f32x4*)(CCim + np * 16 + 4 * kob);
            const f32x4 er = pr * br - pi2 * bi, ei = pr * bi + pi2 * br;
            m0 += cr[0] * er - ci[0] * ei; m1 += cr[1] * er - ci[1] * ei; m2 += cr[2] * er - ci[2] * ei; m3 += cr[3] * er - ci[3] * ei; }
        LAS float* o = MT + (n * 32 + j) * 260 + (4 * kob) * 16 + 4 * kib;
        *(LAS f32x4*)o = m0; *(LAS f32x4*)(o + 16) = m1; *(LAS f32x4*)(o + 32) = m2; *(LAS f32x4*)(o + 48) = m3;
    }
    __syncthreads();
    for (int i = 0; i < 64; ++i) {
        const int idx = tid + 512 * i, row = idx >> 6, cp = idx & 63, t = row >> 4, ko = row & 15, s = cp >> 1, ki0 = (cp & 1) * 8;
        if (nh == 2 && ((t >= s) != (hq == 0))) continue;
        f32x4 v0, v1;
        if (t != s) { const LAS float* src = MT + ((t > s ? 0 : 1) * 32 + (t > s ? t - s : s - t)) * 260 + ko * 16 + ki0; v0 = *(const LAS f32x4*)src; v1 = *(const LAS f32x4*)(src + 4); }
        else { const LAS float* s0 = MT + ko * 16 + ki0; const LAS float* s1 = MT + 32 * 260 + ko * 16 + ki0; v0 = *(const LAS f32x4*)s0 + *(const LAS f32x4*)s1; v1 = *(const LAS f32x4*)(s0 + 4) + *(const LAS f32x4*)(s1 + 4);
            const float dv = dd[g * 16 + ko];
#pragma unroll
            for (int e = 0; e < 4; ++e) { if (ki0 + e == ko) v0[e] += dv; if (ki0 + 4 + e == ko) v1[e] += dv; } }
        u32x4 w; w.x = cvt_pk_bf16(v0[0], v0[1]); w.y = cvt_pk_bf16(v0[2], v0[3]); w.z = cvt_pk_bf16(v1[0], v1[1]); w.w = cvt_pk_bf16(v1[2], v1[3]);
        *(u32x4*)(WGg + (size_t)row * 512 + cp * 8) = w;
    }
    for (int i = hq * (32 / nh); i < (hq + 1) * (32 / nh); ++i) {
        const int idx = tid + 512 * i, q = idx >> 6, cp = idx & 63, n = q >> 7, ri = (q >> 6) & 1, p = q & 63, s = cp >> 1, ki0 = (cp & 1) * 8, e = n == 0 ? 31 - s : s, np = n * 64 + p;
        const float pr = PWre[np * 33 + e], pi2 = PWim[np * 33 + e]; float v[8];
#pragma unroll
        for (int k = 0; k < 8; ++k) { const float br = BBre[np * 16 + ki0 + k], bi = BBim[np * 16 + ki0 + k]; v[k] = ri == 0 ? pr * br - pi2 * bi : pr * bi + pi2 * br; }
        u32x4 w; w.x = cvt_pk_bf16(v[0], v[1]); w.y = cvt_pk_bf16(v[2], v[3]); w.z = cvt_pk_bf16(v[4], v[5]); w.w = cvt_pk_bf16(v[6], v[7]);
        *(u32x4*)(WGg + (size_t)(512 + q) * 512 + cp * 8) = w;
    }
    for (int i = 0; i < 32 / nh; ++i) {
        const int idx = tid + 512 * i, row = nh == 2 ? idx >> 4 : idx >> 5, q0 = nh == 2 ? hq * 128 + (idx & 15) * 8 : (idx & 31) * 8, n = q0 >> 7, ri = (q0 >> 6) & 1, p0 = q0 & 63, t = row >> 4, ko = row & 15, e = n == 0 ? t + 1 : 32 - t; float v[8];
#pragma unroll
        for (int k = 0; k < 8; ++k) { const int np = n * 64 + p0 + k; const float cr = C2re[(n * 16 + ko) * 64 + p0 + k], ci = C2im[(n * 16 + ko) * 64 + p0 + k], pr = PWre[np * 33 + e], pi2 = PWim[np * 33 + e];
            v[k] = ri == 0 ? cr * pr - ci * pi2 : -(cr * pi2 + ci * pr); }
        u32x4 w; w.x = cvt_pk_bf16(v[0], v[1]); w.y = cvt_pk_bf16(v[2], v[3]); w.z = cvt_pk_bf16(v[4], v[5]); w.w = cvt_pk_bf16(v[6], v[7]);
        *(u32x4*)(WCg + (size_t)row * 256 + q0) = w;
    }
    __syncthreads();
}


#ifndef DIAG
#define DIAG 0
#endif
__device__ __forceinline__ void diag_ffn(const float* const* in, const unsigned char* ws, const float* outp, unsigned* flagw, int gtid, int GT) {
    const bf16_t* h1 = (const bf16_t*)(ws + WS_HB); const bf16_t* T = (const bf16_t*)(ws + WS_T); const float* V2 = (const float*)(ws + WS_V2);
    const float *w1 = in[29], *b1 = in[30], *w2 = in[31], *b2 = in[32], *wp = in[33], *wg = in[34], *bg = in[35], *pp = in[1];
    for (int sidx = gtid; sidx < 16384; sidx += GT) {
        unsigned hsh = (unsigned)sidx * 2654435761u, h2 = ((unsigned)sidx + 977u) * 2246822519u; const int r = (hsh >> 8) % SEQ; const int c = (h2 >> 6) % DFF; const int c2 = c % DM;
        float a = b1[c]; for (int k = 0; k < DM; ++k) a += bfu(h1[(size_t)r * DM + k]) * w1[(size_t)k * DFF + c];
        a = fmaxf(a, 0.f); a = a * a; const float tv = bfu(T[(size_t)r * DFF + c]);
        if (fabsf(tv - a) > 0.008f * fabsf(a) + 0.006f) atomicAdd(flagw + 0, 1u);
        float f = b2[c2]; for (int k = 0; k < DFF; ++k) f += bfu(T[(size_t)r * DFF + k]) * w2[(size_t)k * DM + c2];
        float gt = bg[c2]; for (int k = 0; k < DM; ++k) gt += bfu(h1[(size_t)r * DM + k]) * wg[(size_t)k * DM + c2];
        float pw = 0.f; for (int k = 0; k < PLE; ++k) pw += pp[(size_t)r * PLE + k] * wp[(size_t)k * DM + c2];
        const float v2 = DN_ALPHA * bfu(h1[(size_t)r * DM + c2]) + f + fast_sigmoid(gt) * pw; const float got = V2[(size_t)r * DM + c2];
        if (fabsf(got - v2) > 0.008f * fabsf(v2) + 0.006f) atomicAdd(flagw + 1, 1u);
        { const float* vr = V2 + (size_t)r * DM; float m = 0.f; for (int k = 0; k < DM; ++k) m += vr[k]; m /= DM; float v = 0.f; for (int k = 0; k < DM; ++k) { const float d = vr[k] - m; v += d * d; } v /= DM;
          const float e = (vr[c2] - m) / sqrtf(v + LN_EPS) * in[36][c2] + in[37][c2]; const float go = outp[(size_t)r * DM + c2]; if (fabsf(go - e) > 0.004f * fabsf(e) + 0.003f) atomicAdd(flagw + 2, 1u); }
    }
}

__device__ __forceinline__ void diag_pre(const float* const* in, const unsigned char* ws, const unsigned char* dout, unsigned* flagw, int gtid, int GT) {
    const bf16_t* h0 = (const bf16_t*)(ws + WS_HB); const bf16_t* U = (const bf16_t*)(dout + DO_U); const bf16_t* XRb = (const bf16_t*)(ws + WS_XR) + 2048; const bf16_t* Z = (const bf16_t*)(dout + DO_Z);
    const bf16_t* ypre = (const bf16_t*)(dout + DO_YPRE); const bf16_t* ycat = (const bf16_t*)(ws + WS_YCAT); const bf16_t* yg = (const bf16_t*)(ws + WS_YS5G);
    const float *x = in[0], *lg = in[2], *lb = in[3], *win = in[4], *bin = in[5], *gw_ = in[14], *gb = in[15], *g5 = in[23], *gr = in[24];
    for (int sidx = gtid; sidx < 8192; sidx += GT) {
        unsigned hsh = (unsigned)sidx * 2654435761u, h2 = ((unsigned)sidx + 977u) * 2246822519u; const int r = (hsh >> 8) % SEQ; const int c = (h2 >> 6) % DIN; const int c2 = c % DM; const int c1 = c % DS5;
        { float m = 0.f; for (int k = 0; k < DM; ++k) m += x[(size_t)r * DM + k]; m /= DM; float v = 0.f; for (int k = 0; k < DM; ++k) { const float d = x[(size_t)r * DM + k] - m; v += d * d; } v /= DM;
          const float e = (x[(size_t)r * DM + c2] - m) / sqrtf(v + LN_EPS) * lg[c2] + lb[c2]; const float got = bfu(h0[(size_t)r * DM + c2]); if (fabsf(got - e) > 0.008f * fabsf(e) + 0.006f) atomicAdd(flagw + 0, 1u); }
        { float a = bin[c]; for (int k = 0; k < DM; ++k) a += bfu(h0[(size_t)r * DM + k]) * win[(size_t)k * DIN + c];
          const float got = c < 1024 ? bfu(U[(size_t)r * 1024 + c]) : (c < 2048 ? bfu(XRb[(size_t)r * 1024 + c - 1024]) : bfu(Z[(size_t)r * 1024 + c - 2048])); if (fabsf(got - a) > 0.008f * fabsf(a) + 0.006f) atomicAdd(flagw + 3, 1u); }
        { const int hf = c2 >> 10; float ss = 0.f; for (int k = 0; k < 1024; ++k) { const float y = bfu(ypre[(size_t)r * DM + hf * 1024 + k]); ss += y * y; }
          const float e = bfu(ypre[(size_t)r * DM + c2]) / sqrtf(ss / 1024.f + LN_EPS) * (hf ? gr[c2 - 1024] : g5[c2]); const float got = bfu(ycat[(size_t)r * DM + c2]); if (fabsf(got - e) > 0.008f * fabsf(e) + 0.006f) atomicAdd(flagw + 1, 1u); }
        { float a = gb[c1]; for (int k = 0; k < DS5; ++k) a += bfu(yg[(size_t)r * DS5 + k]) * gw_[(size_t)k * DS5 + c1];
          const float e = bfu(yg[(size_t)r * DS5 + c1]) * fast_sigmoid(a); const float got = bfu(ypre[(size_t)r * DM + c1]); if (fabsf(got - e) > 0.008f * fabsf(e) + 0.006f) atomicAdd(flagw + 2, 1u); }
    }
}

__device__ __forceinline__ void diag_v(const float* const* in, const unsigned char* ws, const unsigned char* dout, unsigned* flagw, int gtid, int GT) {
    const bf16_t* h0 = (const bf16_t*)(ws + WS_HB); const bf16_t* ycat = (const bf16_t*)(ws + WS_YCAT); const float* V = (const float*)dout; const float *wo = in[25], *bo = in[26];
    for (int sidx = gtid; sidx < 16384; sidx += GT) { unsigned hsh = (unsigned)sidx * 2654435761u, h2 = ((unsigned)sidx + 977u) * 2246822519u; const int r = (hsh >> 8) % SEQ; const int c = (h2 >> 6) % DM;
        float a = bo[c] + DN_ALPHA * bfu(h0[(size_t)r * DM + c]); for (int k = 0; k < DM; ++k) a += bfu(ycat[(size_t)r * DM + k]) * wo[(size_t)k * DM + c];
        const float got = V[(size_t)r * DM + c]; if (fabsf(got - a) > 0.008f * fabsf(a) + 0.006f) atomicAdd(flagw + 0, 1u); }
}

__device__ __forceinline__ void diag_g(const float* const* in, const unsigned char* ws, unsigned* flagw, int gtid, int GT) {
    const bf16_t* XRp = (const bf16_t*)(ws + WS_XR); const bf16_t* G0 = (const bf16_t*)(ws + WS_G0); const bf16_t* G1 = (const bf16_t*)(ws + WS_G1);
    const float *convw = in[16], *convb = in[17], *wa = in[18], *ba = in[19], *wx = in[20], *bxx = in[21];
    for (int sidx = gtid; sidx < 16384; sidx += GT) { unsigned hsh = (unsigned)sidx * 2654435761u; unsigned h2 = ((unsigned)sidx + 12345u) * 2246822519u; const int t = (hsh >> 7) % SEQ; const int col = (h2 >> 5) % 4096;
        const int h = col >> 8, row = col & 255, bj = row >> 7, dir = (row >> 6) & 1, ch = row & 63;
        const float* W = (bj == 0 ? wa : wx) + ((size_t)(dir * 16 + h) * 64) * 64 + ch; float a = (bj == 0 ? ba : bxx)[(dir * 16 + h) * 64 + ch];
        for (int i = 0; i < 64; ++i) { const int c = 64 * h + i; float xc = convb[c];
            for (int j = 0; j < 4; ++j) xc += convw[j * 1024 + c] * bfu(XRp[(size_t)(t + j) * 1024 + c]);
            a += xc * W[(size_t)i * 64]; }
        const float got = bfu((t < 4096 ? G0 : G1)[(size_t)(t & 4095) * 4096 + col]);
        if (fabsf(got - a) > 0.008f * fabsf(a) + 0.006f) atomicAdd(flagw + 0, 1u); }
}

#ifndef DIAG_HALF
#define DIAG_HALF 1
#endif
__device__ __forceinline__ void diag_max(const unsigned char* ws, unsigned* flagw, int gtid, int GT) {
    const bf16_t* ycat = (const bf16_t*)(ws + WS_YCAT); float mx = 0.f;
    for (size_t i = gtid; i < (size_t)SEQ * 1024; i += GT) { const size_t r = i >> 10, c = (i & 1023) + DIAG_HALF * 1024; mx = fmaxf(mx, fabsf(bfu(ycat[r * DM + c]))); }
    atomicMax(flagw + 0, __float_as_uint(mx));
}

#ifndef DIAG_SEL
#define DIAG_SEL 4
#endif
__device__ __forceinline__ void diag_rows(const float* outp, unsigned* flagw, int gw, int NGW, int lane) {
    for (int row = gw; row < SEQ; row += NGW) { float mx = 0.f; for (int j = lane; j < DM; j += 64) mx = fmaxf(mx, fabsf(outp[(size_t)row * DM + j]));
#pragma unroll
        for (int o = 1; o < 64; o <<= 1) mx = fmaxf(mx, __shfl_xor(mx, o));
        if (lane == 0 && mx > 12.0f) { atomicAdd(flagw + 0, 1u); atomicMin(flagw + 1, (unsigned)row); atomicMax(flagw + 2, (unsigned)row); } }
}

__device__ __forceinline__ void diag_rows_bf(const bf16_t* p, int ld, float thr, unsigned* flagw, int gw, int NGW, int lane) {
    for (int row = gw; row < SEQ; row += NGW) { float mx = 0.f; for (int j = lane; j < ld; j += 64) mx = fmaxf(mx, fabsf(bfu(p[(size_t)row * ld + j])));
#pragma unroll
        for (int o = 1; o < 64; o <<= 1) mx = fmaxf(mx, __shfl_xor(mx, o));
        if (lane == 0 && mx > thr) { atomicAdd(flagw + 0, 1u); atomicMin(flagw + 1, (unsigned)row); atomicMax(flagw + 2, (unsigned)row); } }
}
template <int PHMASK> __global__ void __launch_bounds__(512, 2) mega(Args) {
    extern __shared__ __attribute__((aligned(16))) unsigned char lds_raw[];
    LAS unsigned char* lds = (LAS unsigned char*)lds_raw;
    const int wave = __builtin_amdgcn_readfirstlane((int)threadIdx.x >> 6);
    const int G = gridDim.x, bx = blockIdx.x;
    const int gw = bx * 8 + wave, NGW = G * 8, GT = G * 512;
#define PH_IDS const int lane = fresh_lane(), tid = wave * 64 + lane, gtid = bx * 512 + tid; (void)tid; (void)gtid; (void)lane
    const kin_t KIN = (kin_t)__builtin_amdgcn_kernarg_segment_ptr();
    unsigned char* ws = (unsigned char*)KIN[39]; unsigned char* dout = (unsigned char*)KIN[38];
    const int* kint = (const int*)0; (void)kint;
#if DIAG == 2
    const int lo = ((const __attribute__((address_space(4))) int*)KIN)[80], hi = 7;
#elif DIAG == 3
    const int lo = ((const __attribute__((address_space(4))) int*)KIN)[80], hi = 8;
#elif DIAG == 4
    const int lo = ((const __attribute__((address_space(4))) int*)KIN)[80], hi = 5;
#elif DIAG == 6
    const int lo = ((const __attribute__((address_space(4))) int*)KIN)[80], hi = 7;
#elif DIAG == 8
    const int lo = ((const __attribute__((address_space(4))) int*)KIN)[80], hi = 9;
#elif DIAG == 11 || DIAG == 12
    const int lo = ((const __attribute__((address_space(4))) int*)KIN)[80], hi = 10;
#else
    const int lo = ((const __attribute__((address_space(4))) int*)KIN)[80], hi = ((const __attribute__((address_space(4))) int*)KIN)[81];
#endif
#define IN(k) (((PHMASK >> (k)) & 1) && lo <= (k) && (k) < hi)
    unsigned nbar = 0; unsigned* gbar = (unsigned*)(ws + WS_CTR) + 32;
    if (PHMASK == 0xfff && lo == 0 && hi == NPHASE) cg::this_grid().sync();
#ifndef DBL_MASK
#define DBL_MASK 0
#endif
#define REPS(k) (((DBL_MASK >> (k)) & 1) ? 2 : 1)
#ifndef TSTAMP
#define TSTAMP 0
#define TS_A0 6
#define TS_A1 7
#define TS_B0 9
#define TS_B1 12
#endif
#define SEAM(k) do { if (IN(k) && IN((k) + 1)) { ++nbar; grid_barrier(gbar, nbar * (unsigned)G, wave); if (TSTAMP && bx == 0 && wave == 0) { if (fresh_lane() == 0) ((unsigned long long*)(ws + WS_CTR + 1024))[(k) + 1] = __builtin_amdgcn_s_memrealtime(); } } } while (0)

#define MK_RG const RgCtx RG{(const bf16_t*)(ws + WS_XR), (const bf16_t*)(ws + WS_G0), (const bf16_t*)(ws + WS_G1), (const bf16_t*)(dout + DO_Z), KIN[16], KIN[17], (const float*)(ws + WS_SP), (float*)(ws + WS_AGG), (bf16_t*)(dout + DO_YPRE)}
    if (TSTAMP && bx == 0 && wave == 0) { if (fresh_lane() == 0) ((unsigned long long*)(ws + WS_CTR + 1024))[0] = __builtin_amdgcn_s_memrealtime(); }
    for (int rep = 0; rep < REPS(0); ++rep) {
    if (IN(0)) { PH_IDS;
        if (G != 256) { for (int g = bx; g < 64; g += G) s5_precompute(KIN, ws, g, 0, 1, (LAS float*)lds, tid); }
        {
            LAS float* scr = (LAS float*)(lds + wave * 16640);
            constexpr int I_IN = (DM / 64) * (DIN / 64), I_OUT = (DM / 64) * (DM / 64), I_PG = I_OUT, I_GLU = (DS5 / 64) * (DS5 / 64), I_PW = (PLE / 64) * (DM / 64), I_LN = SEQ / 8;
            constexpr int NITEMS = I_IN + I_OUT + I_PG + I_GLU + I_PW + I_LN;
            for (int it = gw; it < NITEMS; it += NGW) {
                int r = it;
                if (r < I_IN) { transpose_item(KIN[4], DM, DIN, (bf16_t*)(ws + WS_WINT), scr, r, lane); continue; } r -= I_IN;
                if (r < I_LN) { for (int q = 0; q < 8; ++q) { const int row = r * 8 + q; ln_row<true>(KIN[0] + (size_t)row * DM, KIN[2], KIN[3], (bf16_t*)(ws + WS_HB) + (size_t)row * DM, lane); } continue; } r -= I_LN;
                if (r < I_OUT) { transpose_item(KIN[25], DM, DM, (bf16_t*)(ws + WS_WOUTT), scr, r, lane); continue; } r -= I_OUT;
                if (r < I_PG) { transpose_item(KIN[34], DM, DM, (bf16_t*)(ws + WS_PLEGT), scr, r, lane); continue; } r -= I_PG;
                if (r < I_GLU) { transpose_item(KIN[14], DS5, DS5, (bf16_t*)(ws + WS_GLUT), scr, r, lane); continue; } r -= I_GLU;
                transpose_item(KIN[33], PLE, DM, (bf16_t*)(ws + WS_PLEWT), scr, r, lane);
            }
        }
        {   const float* pp = KIN[1]; bf16_t* pb = (bf16_t*)(ws + WS_PB);
            for (int i = gtid; i < SEQ * PLE / 4; i += GT) { const f32x4 v = ((const f32x4*)pp)[i]; u32x2 w; w.x = cvt_pk_bf16(v[0], v[1]); w.y = cvt_pk_bf16(v[2], v[3]); ((u32x2*)pb)[i] = w; }
            const float *convw = KIN[16], *convb = KIN[17], *wa = KIN[18], *ba = KIN[19], *wx = KIN[20], *bxx = KIN[21], *lam = KIN[22];
            bf16_t* rgw = (bf16_t*)(ws + WS_RGW);
            for (int i = gtid; i < 16 * 256 * 32; i += GT) { const int h = i >> 13, row = (i >> 5) & 255, K0 = (i & 31) * 8, j = K0 >> 6, i0 = K0 & 63, ch = row >> 2, bj = (row >> 1) & 1, dir = row & 1;
                const float* W = (bj == 0 ? wa : wx) + ((size_t)(dir * 16 + h) * 64) * 64 + ch; float v[8];
#pragma unroll
                for (int k = 0; k < 8; ++k) v[k] = convw[j * 1024 + 64 * h + i0 + k] * W[(size_t)(i0 + k) * 64];
                u32x4 w; w.x = cvt_pk_bf16(v[0], v[1]); w.y = cvt_pk_bf16(v[2], v[3]); w.z = cvt_pk_bf16(v[4], v[5]); w.w = cvt_pk_bf16(v[6], v[7]);
                *(u32x4*)(rgw + ((size_t)h * 256 + row) * 256 + K0) = w; }
            float* rgb = (float*)(ws + WS_RGBIAS);
            for (int i = gtid; i < 16 * 256; i += GT) { const int h = i >> 8, row = i & 255, ch = row >> 2, bj = (row >> 1) & 1, dir = row & 1;
                const float* W = (bj == 0 ? wa : wx) + ((size_t)(dir * 16 + h) * 64) * 64 + ch; float s = (bj == 0 ? ba : bxx)[(dir * 16 + h) * 64 + ch];
                for (int k = 0; k < 64; ++k) s += convb[64 * h + k] * W[(size_t)k * 64];
                rgb[i] = s; }
            float* spt = (float*)(ws + WS_SP);
            for (int i = gtid; i < 2 * 1024; i += GT) spt[i] = -8.0f * log1pf(expf(-lam[i]));
            unsigned* xr = (unsigned*)(ws + WS_XR);
            for (int i = gtid; i < 1024; i += GT) { xr[i] = 0u; xr[(size_t)(SEQ + 2) * 512 + i] = 0u; }
        }
    }
    if (rep + 1 < REPS(0)) { ++nbar; grid_barrier(gbar, nbar * (unsigned)G, wave); } }
    SEAM(0);
    for (int rep = 0; rep < REPS(1); ++rep) {
    if (IN(1)) { PH_IDS;
        SchedStd S; S.so.init(SEQ, DIN, G, bx); S.A = (const char*)(ws + WS_HB); S.B = (const char*)(ws + WS_WINT); S.a_tile = (size_t)256 * DM * 2; S.b_tile = (size_t)256 * DM * 2;
        EpiProj E{(bf16_t*)(dout + DO_U), (bf16_t*)(ws + WS_XR), (bf16_t*)(dout + DO_Z), KIN[5]};
        GEMM_PHASE(lds, wave, GParm{DM, DM * 2, 128, 64, 0}, S, E);
        if (G == 256 && bx >= 128) { __syncthreads(); const int t2 = wave * 64 + fresh_lane(); s5_precompute(KIN, ws, (bx - 128) >> 1, (bx - 128) & 1, 2, (LAS float*)lds, t2); }
    }
    if (rep + 1 < REPS(1)) { ++nbar; grid_barrier(gbar, nbar * (unsigned)G, wave); } }
    SEAM(1);
    for (int rep = 0; rep < REPS(2); ++rep) {
    if (IN(2)) { PH_IDS;
        { SchedS5a S{(const char*)(dout + DO_U), (const char*)(ws + WS_WG), G, bx}; EpiS5a E{(bf16_t*)(ws + WS_YINTRA), (float*)(ws + WS_S)};
          GEMM_PHASE(lds, wave, GParm{512, 1024, 128, 64, 0}, S, E); }
        { SchedRG S{(const char*)(ws + WS_XR), (const char*)(ws + WS_RGW), G, bx}; EpiG E{(bf16_t*)(ws + WS_G0), (bf16_t*)(ws + WS_G1), (const float*)(ws + WS_RGBIAS)};
          GEMM_PHASE(lds, wave, GParm{256, 2048, 2048, 64, 0}, S, E); }
    }
    if (rep + 1 < REPS(2)) { ++nbar; grid_barrier(gbar, nbar * (unsigned)G, wave); } }
    SEAM(2);
    for (int rep = 0; rep < REPS(3); ++rep) {
    if (IN(3)) { PH_IDS;
        if (bx < 128) {
            const int g = bx >> 1, n = bx & 1; const float* Sg = (const float*)(ws + WS_S) + (size_t)g * NCH * 256 + n * 128; LAS float* Ls = (LAS float*)lds;
            for (int i = tid; i < NCH * 32; i += 512) { const int c = i >> 5, q4 = (i & 31) * 4; *(LAS f32x4*)(Ls + c * 128 + q4) = *(const f32x4*)(Sg + (size_t)c * 256 + q4); }
            __syncthreads();
            if (wave == 0) { const int p = lane, pi = (n * 64 + g) * 64 + p;
                const float lr = fminf(KIN[6][pi], -1e-4f), li = KIN[7][pi], step = expf(KIN[8][n * 64 + g]); float ar, ai; cpow(lr * step, li * step, TC, ar, ai);
                bf16_t* hp = (bf16_t*)(ws + WS_HPREV) + (size_t)g * NCH * 256 + n * 128; float hr = 0.f, him = 0.f;
                for (int cc = 0; cc < NCH; ++cc) { const int c = n == 0 ? cc : NCH - 1 - cc;
                    hp[(size_t)c * 256 + p] = (bf16_t)(cvt_pk_bf16(hr, 0.f) & 0xffffu); hp[(size_t)c * 256 + 64 + p] = (bf16_t)(cvt_pk_bf16(him, 0.f) & 0xffffu);
                    const float sr = Ls[c * 128 + p], si = Ls[c * 128 + 64 + p]; const float nr = ar * hr - ai * him + sr, ni = ar * him + ai * hr + si; hr = nr; him = ni; } }
            __syncthreads();
        }
        { MK_RG; for (int un = bx; un < 256; un += G) rg_pass_a(RG, un & 1, un >> 1, tid); }
    }
    if (rep + 1 < REPS(3)) { ++nbar; grid_barrier(gbar, nbar * (unsigned)G, wave); } }
    SEAM(3);
    for (int rep = 0; rep < REPS(4); ++rep) {
    if (IN(4)) { PH_IDS;
#if NAIVE_S5
        if (gw < 64) naive_s5_group((const float* const*)0, (const bf16_t*)(dout + DO_U), (float*)(ws + WS_YINTRA), (bf16_t*)(ws + WS_YS5G), gw, lane);
#else
        { SchedS5b S{(const char*)(ws + WS_HPREV), (const char*)(ws + WS_WC), G, bx}; EpiS5b E{(const bf16_t*)(ws + WS_YINTRA), (bf16_t*)(ws + WS_YS5G)};
          GEMM_PHASE(lds, wave, GParm{256, 512, 128, 64, 0}, S, E); }
#endif
#if NAIVE_RG
        { MK_RG; if (gtid < 1024) naive_rg_channel(RG, gtid); }
#else
        { MK_RG; __syncthreads(); for (int un = bx; un < 256; un += G) { rg_pass_c(RG, un & 1, un >> 1, tid, (LAS float*)lds); __syncthreads(); } }
#endif
    }
    if (rep + 1 < REPS(4)) { ++nbar; grid_barrier(gbar, nbar * (unsigned)G, wave); } }
    SEAM(4);
    for (int rep = 0; rep < REPS(5); ++rep) {
    if (IN(5)) { PH_IDS;
        SchedStd S; S.so.init(SEQ, DS5, G, bx); S.A = (const char*)(ws + WS_YS5G); S.B = (const char*)(ws + WS_GLUT); S.a_tile = (size_t)256 * 16 * 2; S.b_tile = (size_t)256 * DS5 * 2;
        EpiGlu E{(const bf16_t*)(ws + WS_YS5G), (bf16_t*)(dout + DO_YPRE), KIN[15]};
        GEMM_PHASE(lds, wave, GParm{DS5, 32, 4u * GM_STRIDE * 2u, 16, GM_STRIDE}, S, E);
        if (G == 256 && bx >= 128) {
            LAS float* scr = (LAS float*)(lds + wave * 16640); constexpr int I_FF1 = (DM / 64) * (DFF / 64);
            for (int it = (bx - 128) * 8 + wave; it < I_FF1; it += 1024) transpose_item(KIN[29], DM, DFF, (bf16_t*)(ws + WS_FF1T), scr, it, lane); }
    }
    if (rep + 1 < REPS(5)) { ++nbar; grid_barrier(gbar, nbar * (unsigned)G, wave); } }
    SEAM(5);
    for (int rep = 0; rep < REPS(6); ++rep) {
    if (IN(6)) { PH_IDS;
        const float *g5 = KIN[23], *gr = KIN[24];
        for (int row = gw; row < SEQ; row += NGW) { const u32x4* yr = (const u32x4*)(dout + DO_YPRE) + (size_t)row * 256; u32x4* oc = (u32x4*)(ws + WS_YCAT) + (size_t)row * 256;
            u32x4 w[4]; float s0 = 0.f, s1 = 0.f;
#pragma unroll
            for (int j = 0; j < 4; ++j) { w[j] = yr[lane + 64 * j]; const float q = bf_lo(w[j].x) * bf_lo(w[j].x) + bf_hi(w[j].x) * bf_hi(w[j].x) + bf_lo(w[j].y) * bf_lo(w[j].y) + bf_hi(w[j].y) * bf_hi(w[j].y)
                + bf_lo(w[j].z) * bf_lo(w[j].z) + bf_hi(w[j].z) * bf_hi(w[j].z) + bf_lo(w[j].w) * bf_lo(w[j].w) + bf_hi(w[j].w) * bf_hi(w[j].w); if (j < 2) s0 += q; else s1 += q; }
            const float r0 = 1.0f / sqrtf(wave_sum(s0) * (1.f / 1024.f) + LN_EPS), r1 = 1.0f / sqrtf(wave_sum(s1) * (1.f / 1024.f) + LN_EPS);
#pragma unroll
            for (int j = 0; j < 4; ++j) { const int col = (lane + 64 * j) * 8; const float rs = j < 2 ? r0 : r1; const float* gp = j < 2 ? g5 + col : gr + (col - 1024);
                const f32x4 ga = *(const f32x4*)gp, gb = *(const f32x4*)(gp + 4);
                u32x4 o; o.x = cvt_pk_bf16(bf_lo(w[j].x) * rs * ga[0], bf_hi(w[j].x) * rs * ga[1]); o.y = cvt_pk_bf16(bf_lo(w[j].y) * rs * ga[2], bf_hi(w[j].y) * rs * ga[3]);
                o.z = cvt_pk_bf16(bf_lo(w[j].z) * rs * gb[0], bf_hi(w[j].z) * rs * gb[1]); o.w = cvt_pk_bf16(bf_lo(w[j].w) * rs * gb[2], bf_hi(w[j].w) * rs * gb[3]); oc[lane + 64 * j] = o; } }
        {
            LAS float* scr = (LAS float*)(lds + wave * 16640);
            constexpr int I_FF1 = (DM / 64) * (DFF / 64), I_FF2 = (DFF / 64) * (DM / 64);
            for (int it = gw; it < (G == 256 ? I_FF2 : I_FF1 + I_FF2); it += NGW) {
                if (it < I_FF2) transpose_item(KIN[31], DFF, DM, (bf16_t*)(ws + WS_FF2T), scr, it, lane);
                else transpose_item(KIN[29], DM, DFF, (bf16_t*)(ws + WS_FF1T), scr, it - I_FF2, lane); }
        }
    }
    if (rep + 1 < REPS(6)) { ++nbar; grid_barrier(gbar, nbar * (unsigned)G, wave); } }
    SEAM(6);
    for (int rep = 0; rep < REPS(7); ++rep) {
    if (IN(7)) { PH_IDS;
        SchedStd S; S.so.init(SEQ, DM, G, bx); S.A = (const char*)(ws + WS_YCAT); S.B = (const char*)(ws + WS_WOUTT); S.a_tile = (size_t)256 * DM * 2; S.b_tile = (size_t)256 * DM * 2;
        EpiRes<false> E{(const bf16_t*)(ws + WS_HB), KIN[26], (float*)dout, nullptr, nullptr};
        GEMM_PHASE(lds, wave, GParm{DM, DM * 2, 128, 64, 0}, S, E);
    }
    if (rep + 1 < REPS(7)) { ++nbar; grid_barrier(gbar, nbar * (unsigned)G, wave); } }
    SEAM(7);
    for (int rep = 0; rep < REPS(8); ++rep) {
    if (IN(8)) { PH_IDS; for (int row = gw; row < SEQ; row += NGW) ln_row<true>((const float*)dout + (size_t)row * DM, KIN[27], KIN[28], (bf16_t*)(ws + WS_HB) + (size_t)row * DM, lane); }
    if (rep + 1 < REPS(8)) { ++nbar; grid_barrier(gbar, nbar * (unsigned)G, wave); } }
    SEAM(8);
    for (int rep = 0; rep < REPS(9); ++rep) {
    if (IN(9)) { PH_IDS;
        { SchedStd S; S.so.init(SEQ, DFF, G, bx); S.A = (const char*)(ws + WS_HB); S.B = (const char*)(ws + WS_FF1T); S.a_tile = (size_t)256 * DM * 2; S.b_tile = (size_t)256 * DM * 2;
          EpiPlain<1> E{(bf16_t*)(ws + WS_T), DFF, KIN[30]}; GEMM_PHASE(lds, wave, GParm{DM, DM * 2, 128, 64, 0}, S, E); }
        { SchedStd S; S.so.init(SEQ, DM, G, bx); S.A = (const char*)(ws + WS_HB); S.B = (const char*)(ws + WS_PLEGT); S.a_tile = (size_t)256 * DM * 2; S.b_tile = (size_t)256 * DM * 2;
          EpiPlain<2> E{(bf16_t*)(dout + DO_SG), DM, KIN[35]}; GEMM_PHASE(lds, wave, GParm{DM, DM * 2, 128, 64, 0}, S, E); }
        { SchedStd S; S.so.init(SEQ, DM, G, bx); S.A = (const char*)(ws + WS_PB); S.B = (const char*)(ws + WS_PLEWT); S.a_tile = (size_t)256 * PLE * 2; S.b_tile = (size_t)256 * PLE * 2;
          EpiPlain<0> E{(bf16_t*)(dout + DO_PW), DM, nullptr}; GEMM_PHASE(lds, wave, GParm{PLE, PLE * 2, 128, 64, 0}, S, E); }
    }
    if (rep + 1 < REPS(9)) { ++nbar; grid_barrier(gbar, nbar * (unsigned)G, wave); } }
    SEAM(9);
    for (int rep = 0; rep < REPS(10); ++rep) {
    if (IN(10)) { PH_IDS;
        SchedStd S; S.so.init(SEQ, DM, G, bx); S.A = (const char*)(ws + WS_T); S.B = (const char*)(ws + WS_FF2T); S.a_tile = (size_t)256 * DFF * 2; S.b_tile = (size_t)256 * DFF * 2;
        EpiRes<true> E{(const bf16_t*)(ws + WS_HB), KIN[32], (float*)(ws + WS_V2), (const bf16_t*)(dout + DO_SG), (const bf16_t*)(dout + DO_PW)};
        GEMM_PHASE(lds, wave, GParm{DFF, DFF * 2, 128, 64, 0}, S, E);
    }
    if (rep + 1 < REPS(10)) { ++nbar; grid_barrier(gbar, nbar * (unsigned)G, wave); } }
    SEAM(10);
    for (int rep = 0; rep < REPS(11); ++rep) {
    if (IN(11)) { PH_IDS; for (int row = gw; row < SEQ; row += NGW) ln_row<false>((const float*)(ws + WS_V2) + (size_t)row * DM, KIN[36], KIN[37], ((float*)KIN[38]) + (size_t)row * DM, lane); }
    if (rep + 1 < REPS(11)) { ++nbar; grid_barrier(gbar, nbar * (unsigned)G, wave); } }
#if TSTAMP
    if (bx == 0 && wave == 0) { if (fresh_lane() == 0) { unsigned long long* st = (unsigned long long*)(ws + WS_CTR + 1024); st[12] = __builtin_amdgcn_s_memrealtime();
        ((float*)KIN[38])[0] = (float)(long long)(st[TS_A1] - st[TS_A0]) * 0.01f; } }
#endif
#if DIAG
    { ++nbar; grid_barrier(gbar, nbar * (unsigned)G, wave); PH_IDS; unsigned* flagw = (unsigned*)(ws + WS_CTR) + 48;
#if DIAG == 1
      diag_ffn((const float* const*)0, ws, ((float*)KIN[38]), flagw, gtid, GT);
#elif DIAG == 2
      diag_pre((const float* const*)0, ws, dout, flagw, gtid, GT);
#elif DIAG == 3
      diag_v((const float* const*)0, ws, dout, flagw, gtid, GT);
#elif DIAG == 4
      diag_g((const float* const*)0, ws, flagw, gtid, GT);
#elif DIAG == 6
      diag_max(ws, flagw, gtid, GT);
#else
      if (bx == 0 && tid == 0) flagw[1] = 0xffffffffu;
      ++nbar; grid_barrier(gbar, nbar * (unsigned)G, wave);
#if DIAG == 7
      diag_rows(((float*)KIN[38]), flagw, gw, NGW, lane);
#elif DIAG == 8
      diag_rows_bf((const bf16_t*)(ws + WS_HB), DM, 12.0f, flagw, gw, NGW, lane);
#elif DIAG == 9
      diag_rows((const float*)(ws + WS_V2), flagw, gw, NGW, lane);
#elif DIAG == 10
      diag_rows_bf((const bf16_t*)(ws + WS_T), DFF, 150.0f, flagw, gw, NGW, lane);
#elif DIAG == 11
      diag_rows_bf((const bf16_t*)(dout + DO_PW), DM, 8.0f, flagw, gw, NGW, lane);
#elif DIAG == 12
      diag_rows_bf((const bf16_t*)(dout + DO_SG), DM, 1.01f, flagw, gw, NGW, lane);
#endif
#endif
      ++nbar; grid_barrier(gbar, nbar * (unsigned)G, wave);
#if DIAG != 1
      for (int i = gtid; i < SEQ * DM; i += GT) ((float*)KIN[38])[i] = 0.f;
      ++nbar; grid_barrier(gbar, nbar * (unsigned)G, wave);
#endif
      if (bx == 0 && tid == 0) { unsigned code = 0; for (int q = 0; q < 4; ++q) if (__hip_atomic_load(flagw + q, __ATOMIC_RELAXED, __HIP_MEMORY_SCOPE_AGENT) > 100u) code |= 1u << q; if (DIAG >= 7) { const unsigned cnt = __hip_atomic_load(flagw, __ATOMIC_RELAXED, __HIP_MEMORY_SCOPE_AGENT), mn = __hip_atomic_load(flagw + 1, __ATOMIC_RELAXED, __HIP_MEMORY_SCOPE_AGENT), mxr = __hip_atomic_load(flagw + 2, __ATOMIC_RELAXED, __HIP_MEMORY_SCOPE_AGENT);
          const unsigned v = DIAG_SEL == 0 ? cnt : DIAG_SEL == 1 ? mn / 100u : DIAG_SEL == 2 ? mn % 100u : DIAG_SEL == 3 ? mxr / 100u : mxr % 100u; ((float*)KIN[38])[0] = 100.0f * (float)(v + 1u); }
      else ((float*)KIN[38])[0] = (DIAG == 6) ? 1000.0f * __uint_as_float(__hip_atomic_load(flagw, __ATOMIC_RELAXED, __HIP_MEMORY_SCOPE_AGENT)) : 1000.0f * (float)(code + 16u); } }
#endif
#undef IN
#undef SEAM
}


#if PER_PHASE_LAUNCH
template <int PH> static void set_attr_one() { (void)hipFuncSetAttribute((const void*)mega<(1 << PH)>, hipFuncAttributeMaxDynamicSharedMemorySize, LDS_BYTES); }
template <int PH> static void launch_one(Args a, int grid, hipStream_t stream) { a.ph_lo = PH; a.ph_hi = PH + 1; hipLaunchKernelGGL(mega<(1 << PH)>, dim3(grid), dim3(512), LDS_BYTES, stream, a); }
static void set_attrs() { set_attr_one<0>(); set_attr_one<1>(); set_attr_one<2>(); set_attr_one<3>(); set_attr_one<4>(); set_attr_one<5>(); set_attr_one<6>(); set_attr_one<7>(); set_attr_one<8>(); set_attr_one<9>(); set_attr_one<10>(); set_attr_one<11>(); }
static void launch_phases(const Args& a, int grid, hipStream_t stream) { launch_one<0>(a, grid, stream); launch_one<1>(a, grid, stream); launch_one<2>(a, grid, stream); launch_one<3>(a, grid, stream); launch_one<4>(a, grid, stream); launch_one<5>(a, grid, stream);
    launch_one<6>(a, grid, stream); launch_one<7>(a, grid, stream); launch_one<8>(a, grid, stream); launch_one<9>(a, grid, stream); launch_one<10>(a, grid, stream); launch_one<11>(a, grid, stream); }
#else
static void set_attrs() { (void)hipFuncSetAttribute((const void*)mega<0xfff>, hipFuncAttributeMaxDynamicSharedMemorySize, LDS_BYTES); }
#endif

extern "C" void kernel_launch(void* const* d_in, const int* in_sizes, int n_in, void* d_out, int out_size, void* d_ws, size_t ws_size, hipStream_t stream) {
    static int grid = 0;
    if (grid == 0) {
        if (n_in != 38 || out_size != SEQ * DM || ws_size < WS_END) { fprintf(stderr, "kernel_launch: unexpected shapes (n_in %d out %d ws %zu)\n", n_in, out_size, ws_size); grid = -1; return; }
        int dev = 0, cus = 0, per_cu = 0;
        hipGetDevice(&dev); hipDeviceGetAttribute(&cus, hipDeviceAttributeMultiprocessorCount, dev);
        set_attrs();
        per_cu = 1;
        (void)hipGetLastError();
        if (per_cu < 1) per_cu = 1;
        grid = cus;
    }
    if (grid < 0) return;
#ifdef POISON_NAN
    hipMemsetAsync(d_ws, 0xFF, WS_END, stream); hipMemsetAsync(d_out, 0xFF, (size_t)64 * MiB, stream);
#endif
    hipMemsetAsync((char*)d_ws + WS_CTR, 0, 256, stream);
    Args a{};
    for (int i = 0; i < 38; ++i) a.in[i] = (const float*)d_in[i];
    a.out = (float*)d_out; a.ws = (unsigned char*)d_ws;
#if PER_PHASE_LAUNCH
    launch_phases(a, grid, stream);
#else
    a.ph_lo = 0; a.ph_hi = NPHASE;
    void* kargs[] = {&a};
    hipError_t e = hipLaunchCooperativeKernel((const void*)mega<0xfff>, dim3(grid), dim3(512), kargs, LDS_BYTES, stream);
    if (e != hipSuccess) fprintf(stderr, "cooperative launch failed: %s (grid %d)\n", hipGetErrorString(e), grid);
#endif
}
```

```cpp
#include <hip/hip_runtime.h>
#include <hip/hip_cooperative_groups.h>
#include <cstdio>
#include <cstdint>
namespace cg = cooperative_groups;

#ifndef PER_PHASE_LAUNCH
#define PER_PHASE_LAUNCH 0
#endif

#ifndef TSTAMP
#define TSTAMP 0
#define TS_A0 22
#define TS_A1 23
#define TS_B0 9
#define TS_B1 12
#endif
#define LAS __attribute__((address_space(3)))
typedef unsigned short bf16_t;
typedef short bf16x8 __attribute__((ext_vector_type(8)));
typedef float f32x4 __attribute__((ext_vector_type(4)));
typedef float f32x2 __attribute__((ext_vector_type(2)));
typedef unsigned u32x4 __attribute__((ext_vector_type(4)));
typedef unsigned u32x2 __attribute__((ext_vector_type(2)));

constexpr int SEQ = 8192, DM = 2048, DIN = 3072, DS5 = 1024, DRG = 1024, NG = 64, NP = 64, NK = 16, NH = 16, HD = 64, DFF = 8192, PLE = 256;
constexpr int TC = 32, NCH = SEQ / TC;
constexpr float LN_EPS = 1e-5f, DN_ALPHA = 1.18920711500272f;
constexpr int NPHASE = 12;

constexpr size_t MiB = (size_t)1 << 20;
constexpr size_t WS_FF2T = 0, WS_HB = 32 * MiB, WS_FF1T = 64 * MiB, WS_PLEGT = 96 * MiB, WS_PLEWT = 104 * MiB, WS_PB = 105 * MiB, WS_WOUTT = 109 * MiB,
    WS_V2 = 64 * MiB, WS_G0 = 0, WS_G1 = 64 * MiB,
    WS_WG = 128 * MiB, WS_WC = 176 * MiB, WS_RGW = 192 * MiB, WS_GLUT = 194 * MiB, WS_XR = 196 * MiB, WS_YINTRA = 213 * MiB, WS_S = 229 * MiB, WS_HPREV = 245 * MiB, WS_WINT = 229 * MiB,
    WS_YS5G = 128 * MiB, WS_YCAT = 144 * MiB, WS_T = 128 * MiB,
    WS_AGG = 256 * MiB, WS_CARRY = 258 * MiB, WS_SUMSQ = 259 * MiB, WS_RGBIAS = 259 * MiB + 64 * 1024, WS_SP = WS_RGBIAS + 16 * 1024, WS_CTR = WS_SP + 8 * 1024, WS_END = 260 * MiB;
constexpr size_t DO_YPRE = 0, DO_Z = 32 * MiB, DO_U = 48 * MiB, DO_SG = 0, DO_PW = 32 * MiB;
constexpr int GM_STRIDE = SEQ * 16;
constexpr int LDS_BYTES = 152 * 1024;

typedef __bf16 bf16x2_t __attribute__((ext_vector_type(2)));
__device__ __forceinline__ unsigned cvt_pk_bf16(float lo, float hi) { const f32x2 v = {lo, hi}; const bf16x2_t b = __builtin_convertvector(v, bf16x2_t); return __builtin_bit_cast(unsigned, b); }
__device__ __forceinline__ float bf_lo(unsigned w) { return __uint_as_float(w << 16); }
__device__ __forceinline__ float bf_hi(unsigned w) { return __uint_as_float(w & 0xffff0000u); }
__device__ __forceinline__ f32x4 bf4(u32x2 w) { return (f32x4){bf_lo(w.x), bf_hi(w.x), bf_lo(w.y), bf_hi(w.y)}; }
__device__ __forceinline__ float fast_sigmoid(float x) { return __builtin_amdgcn_rcpf(1.0f + __expf(-x)); }
__device__ __forceinline__ float gelu_tanh(float x) { const float u = 1.5957691216057308f * (x + 0.044715f * x * x * x); return x * fast_sigmoid(u); }
__device__ __forceinline__ float wave_sum(float v) {
#pragma unroll
    for (int o = 1; o < 64; o <<= 1) v += __shfl_xor(v, o);
    return v;
}
__device__ __forceinline__ int lane_id() { return (int)__builtin_amdgcn_mbcnt_hi(~0u, __builtin_amdgcn_mbcnt_lo(~0u, 0u)); }
__device__ __forceinline__ int fresh_lane() { unsigned z = 0; asm volatile("" : "+s"(z)); return (int)__builtin_amdgcn_mbcnt_hi(~0u, __builtin_amdgcn_mbcnt_lo(~0u, z)); }
#define LDS_WAIT() asm volatile("s_waitcnt lgkmcnt(0)" ::: "memory")

namespace pg8 {
constexpr int BM = 256, BK = 64, HALF = 128, HTB = HALF * BK * 2, STAGE_BYTES = 8 * HTB, NXCD = 8, WGM = 8;
__host__ __device__ __forceinline__ int lds_byte(int r, int c) { const int st = (r >> 4) * 2 + (c >> 5), rr = r & 15, cc = c & 31, ob = rr * 64 + cc * 2; return st * 1024 + (ob ^ (((ob >> 9) & 1) << 5)); }
__host__ __device__ __forceinline__ void stage_rc(int b, int& R, int& C) { const int st = b / 1024, sb = b % 1024, swz = sb ^ (((sb >> 9) & 1) << 5); R = (st >> 1) * 16 + swz / 64; C = (st & 1) * 32 + (swz % 64) / 2; }
__host__ __device__ __forceinline__ int perm32(int rho) { const int n = rho >> 4, i = rho & 15; return 8 * (i >> 2) + 4 * n + (i & 3); }

struct Unit { int pm, pn; };
struct StaticOrder {
    int nM, nN, nwg, G, c;
    __host__ __device__ void init(int M, int N, int G_, int c_) { nM = M / BM; nN = N / BM; nwg = nM * nN; G = G_; c = c_; }
    __host__ __device__ bool next(int i, Unit& u) const {
        const long L = (long)i * G + c; if (L >= nwg) return false;
        int wgid = (int)L; { const int q = nwg / NXCD, r = nwg % NXCD, xcd = wgid % NXCD, off = wgid / NXCD; wgid = (xcd < r ? xcd * (q + 1) : r * (q + 1) + (xcd - r) * q) + off; }
        const int nig = WGM * nN, gid = wgid / nig, fm = gid * WGM, gsz = (nM - fm) < WGM ? (nM - fm) : WGM;
        u.pm = fm + ((wgid % nig) % gsz); u.pn = (wgid % nig) / gsz; return true;
    }
};
struct GUnit { const char* A; const char* B; int i0, i1; };
struct GParm { int K; unsigned a_rs, a_ks; int a_cw, a_cs; };

template <class Epi, class Sched>
__device__ __forceinline__ void gemm_phase(LAS unsigned char* lds, const int wid, const GParm gp, const Sched& S, const Epi& E) {
    const int lane = fresh_lane(), tid = wid * 64 + lane, wr = wid >> 2, wc = wid & 3, fr = lane & 15, fq = lane >> 4;
    const int K = gp.K, nt = K / BK;
    unsigned voffA[2], voffB[2];
#pragma unroll
    for (int i = 0; i < 2; ++i) { int R, C; stage_rc(tid * 16 + i * 8192, R, C); const int Rb = Epi::PERM ? ((R & ~31) + perm32(R & 31)) : R;
        voffA[i] = (unsigned)R * gp.a_rs + (unsigned)((C / gp.a_cw) * gp.a_cs + (C % gp.a_cw)) * 2u; voffB[i] = (unsigned)(Rb * K + C) * 2u; }
    const size_t ksA = gp.a_ks, ksB = (size_t)(BK * 2);
    const size_t hsA = (size_t)HALF * gp.a_rs, hsB = (size_t)HALF * K * 2;
    const unsigned ldsw = (unsigned)wid * 1024u;
    const int aoff = lds_byte(wr * 64 + fr, fq * 8), boff = lds_byte(wc * 32 + fr, fq * 8);
#define PG8_SA(b, h) (((b) * 2 + (h)) * HTB)
#define PG8_SB(b, h) ((4 + (b) * 2 + (h)) * HTB)
#define PG8_STAGE(bufoff, gbase, voff) do { _Pragma("unroll") for (int _i = 0; _i < 2; ++_i) \
        __builtin_amdgcn_global_load_lds((const unsigned*)((const char*)(gbase) + (voff)[_i]), (LAS unsigned*)(lds + (bufoff) + ldsw + _i * 8192), 16, 0, 0); } while (0)
#define PG8_LDA(dst, b, h) do { _Pragma("unroll") for (int m = 0; m < 4; ++m) _Pragma("unroll") for (int k = 0; k < 2; ++k) dst[m][k] = *(const LAS bf16x8*)(lds + PG8_SA(b, h) + aoff + m * 2048 + k * 1024); } while (0)
#define PG8_LDB(dst, b, h) do { _Pragma("unroll") for (int n = 0; n < 2; ++n) _Pragma("unroll") for (int k = 0; k < 2; ++k) dst[n][k] = *(const LAS bf16x8*)(lds + PG8_SB(b, h) + boff + n * 2048 + k * 1024); } while (0)
#define PG8_MMA(ai, bj, At, Bt) do { __builtin_amdgcn_s_setprio(1); _Pragma("unroll") for (int m = 0; m < 4; ++m) _Pragma("unroll") for (int n = 0; n < 2; ++n) _Pragma("unroll") for (int k = 0; k < 2; ++k) \
        acc[ai][bj][m][n] = __builtin_amdgcn_mfma_f32_16x16x32_bf16(Bt[n][k], At[m][k], acc[ai][bj][m][n], 0, 0, 0); __builtin_amdgcn_s_setprio(0); } while (0)
#define PG8_WAIT_V(n) asm volatile("s_waitcnt vmcnt(" #n ")" ::: "memory")
#define PG8_WAIT_L(n) asm volatile("s_waitcnt lgkmcnt(" #n ")" ::: "memory")
#define PG8_BAR __builtin_amdgcn_s_barrier()
#define PG8_SCHED __builtin_amdgcn_sched_barrier(0)
    GUnit cur, nxt; int ui = 0;
    if (!S.next(0, cur)) return;
    f32x4 acc[2][2][4][2];
#pragma unroll
    for (int a = 0; a < 2; ++a)
#pragma unroll
        for (int b = 0; b < 2; ++b)
#pragma unroll
            for (int m = 0; m < 4; ++m)
#pragma unroll
                for (int n = 0; n < 2; ++n) acc[a][b][m][n] = (f32x4){0.f, 0.f, 0.f, 0.f};
    bf16x8 At[4][2], B0[2][2], B1[2][2];
    const char* cA = cur.A; const char* cB = cur.B;
    PG8_STAGE(PG8_SB(0, 0), cB, voffB); PG8_STAGE(PG8_SB(0, 1), cB + hsB, voffB); PG8_STAGE(PG8_SA(0, 0), cA, voffA); PG8_STAGE(PG8_SA(0, 1), cA + hsA, voffA);
    if (wr == 1) PG8_BAR;
    PG8_WAIT_V(2); PG8_BAR;
    PG8_STAGE(PG8_SB(1, 0), cB + ksB, voffB); PG8_STAGE(PG8_SA(1, 0), cA + ksA, voffA); PG8_STAGE(PG8_SB(1, 1), cB + hsB + ksB, voffB);
    PG8_WAIT_V(6); PG8_BAR;
    for (;;) {
        const bool has_next = S.next(ui + 1, nxt);
        const char* nA = has_next ? nxt.A : cA; const char* nB = has_next ? nxt.B : cB;
        for (int t = 0; t < nt; t += 2) {
            const bool last = (t == nt - 2);
            const char* a1 = cA + (size_t)(t + 1) * ksA;
            const char* a2 = last ? nA : cA + (size_t)(t + 2) * ksA; const char* b2 = last ? nB : cB + (size_t)(t + 2) * ksB;
            const char* a3 = a2 + ksA; const char* b3 = b2 + ksB;
            PG8_LDB(B0, 0, 0); PG8_LDB(B1, 0, 1); PG8_SCHED; PG8_LDA(At, 0, 0); PG8_STAGE(PG8_SA(1, 1), a1 + hsA, voffA);
            PG8_WAIT_V(8); PG8_WAIT_L(0); PG8_BAR; PG8_MMA(0, 0, At, B0); PG8_MMA(0, 1, At, B1); PG8_BAR; PG8_SCHED;
            PG8_LDA(At, 0, 1); PG8_STAGE(PG8_SB(0, 0), b2, voffB); PG8_STAGE(PG8_SB(0, 1), b2 + hsB, voffB); PG8_STAGE(PG8_SA(0, 0), a2, voffA);
            PG8_WAIT_V(8); PG8_WAIT_L(0); PG8_BAR; PG8_MMA(1, 0, At, B0); PG8_MMA(1, 1, At, B1); PG8_BAR; PG8_SCHED;
            PG8_LDB(B0, 1, 0); PG8_LDB(B1, 1, 1); PG8_SCHED; PG8_LDA(At, 1, 0); PG8_STAGE(PG8_SA(0, 1), a2 + hsA, voffA);
            PG8_WAIT_V(8); PG8_WAIT_L(0); PG8_BAR; PG8_MMA(0, 0, At, B0); PG8_MMA(0, 1, At, B1); PG8_BAR; PG8_SCHED;
            PG8_LDA(At, 1, 1); PG8_STAGE(PG8_SB(1, 0), b3, voffB); PG8_STAGE(PG8_SB(1, 1), b3 + hsB, voffB); PG8_STAGE(PG8_SA(1, 0), a3, voffA);
            PG8_WAIT_V(8); PG8_WAIT_L(0); PG8_BAR; PG8_MMA(1, 0, At, B0); PG8_MMA(1, 1, At, B1); PG8_BAR; PG8_SCHED;
        }
        if (wr == 0) PG8_BAR;
        if constexpr (!Epi::AFTER_DRAIN) { const int l_o = fresh_lane(); E(acc, cur, wr, wc, l_o & 15, l_o >> 4); }
        if (!has_next) break;
#pragma unroll
        for (int a = 0; a < 2; ++a)
#pragma unroll
            for (int b = 0; b < 2; ++b)
#pragma unroll
                for (int m = 0; m < 4; ++m)
#pragma unroll
                    for (int n = 0; n < 2; ++n) acc[a][b][m][n] = (f32x4){0.f, 0.f, 0.f, 0.f};
        cur = nxt; cA = nA; cB = nB; ++ui;
        if (wr == 1) PG8_BAR;
    }
    PG8_WAIT_V(0);
    PG8_BAR;
    if constexpr (Epi::AFTER_DRAIN) { const int l_o = fresh_lane(); E.fused(acc, cur, wr, wc, l_o & 15, l_o >> 4, lds, wid); }
#undef PG8_SA
#undef PG8_SB
#undef PG8_STAGE
#undef PG8_LDA
#undef PG8_LDB
#undef PG8_MMA
#undef PG8_WAIT_V
#undef PG8_WAIT_L
#undef PG8_BAR
#undef PG8_SCHED
}
}
using pg8::GUnit; using pg8::GParm;
typedef f32x4 AccT[2][2][4][2];

struct SchedStd {
    pg8::StaticOrder so; const char* A; const char* B; size_t a_tile, b_tile;
    __device__ __forceinline__ bool next(int i, GUnit& u) const { pg8::Unit t; if (!so.next(i, t)) return false; u.A = A + (size_t)t.pm * a_tile; u.B = B + (size_t)t.pn * b_tile; u.i0 = t.pm; u.i1 = t.pn; return true; }
};
struct SchedS5a { const char* U; const char* WG; int G, c;
    __device__ __forceinline__ bool next(int i, GUnit& u) const { const int L = i * G + c; if (L >= 192) return false; const int g = L / 3, pn = L % 3;
        u.A = U + (size_t)g * GM_STRIDE * 2; u.B = WG + ((size_t)g * 768 + 256 * pn) * 512 * 2; u.i0 = g; u.i1 = pn; return true; } };
struct SchedS5b { const char* HP; const char* WC; int G, c;
    __device__ __forceinline__ bool next(int i, GUnit& u) const { const int L = i * G + c; if (L >= 128) return false; const int g = L / 2, pn = L % 2;
        u.A = HP + (size_t)g * 256 * 256 * 2; u.B = WC + ((size_t)g * 512 + 256 * pn) * 256 * 2; u.i0 = g; u.i1 = pn; return true; } };
struct SchedRG { const char* XR; const char* RGW; int G, c;
    __device__ __forceinline__ bool next(int i, GUnit& u) const { const int L = i * G + c; if (L >= 512) return false; const int h = L % 16, pm = L / 16;
        u.A = XR + ((size_t)(256 * pm) * 1024 + 64 * h) * 2; u.B = RGW + (size_t)h * 256 * 256 * 2; u.i0 = pm; u.i1 = h; return true; } };

template <int ACT> __device__ __forceinline__ void epi_bf16_store(const AccT& acc, bf16_t* tile, int ldc, const float* biast, int wr, int wc, int fr, int fq) {
    const int r0 = wr * 64 + fr, c0 = wc * 32 + 8 * fq;
    f32x4 bv[2][2];
#pragma unroll
    for (int bj = 0; bj < 2; ++bj)
#pragma unroll
        for (int n = 0; n < 2; ++n) bv[bj][n] = biast ? *(const f32x4*)(biast + c0 + bj * 128 + 4 * n) : (f32x4){0.f, 0.f, 0.f, 0.f};
#pragma unroll
    for (int ai = 0; ai < 2; ++ai)
#pragma unroll
        for (int m = 0; m < 4; ++m) { bf16_t* rowp = tile + (size_t)(r0 + ai * 128 + m * 16) * ldc + c0;
#pragma unroll
            for (int bj = 0; bj < 2; ++bj) { f32x4 v0 = acc[ai][bj][m][0] + bv[bj][0], v1 = acc[ai][bj][m][1] + bv[bj][1];
                if (ACT == 1) {
#pragma unroll
                    for (int j = 0; j < 4; ++j) { const float a = fmaxf(v0[j], 0.f), b = fmaxf(v1[j], 0.f); v0[j] = a * a; v1[j] = b * b; } }
                if (ACT == 2) {
#pragma unroll
                    for (int j = 0; j < 4; ++j) { v0[j] = fast_sigmoid(v0[j]); v1[j] = fast_sigmoid(v1[j]); } }
                u32x4 w; w.x = cvt_pk_bf16(v0[0], v0[1]); w.y = cvt_pk_bf16(v0[2], v0[3]); w.z = cvt_pk_bf16(v1[0], v1[1]); w.w = cvt_pk_bf16(v1[2], v1[3]);
                *(u32x4*)(rowp + bj * 128) = w; } }
}
struct EpiProj { static constexpr bool PERM = true, AFTER_DRAIN = false; bf16_t *U, *XR, *Z; const float* bias;
    __device__ __forceinline__ void operator()(AccT& acc, const GUnit& u, int wr, int wc, int fr, int fq) const {
        const int pm = u.i0, pn = u.i1;
        if (pn >= 4) { bf16_t* base = pn < 8 ? XR + 2 * 1024 : Z; epi_bf16_store<0>(acc, base + (size_t)pm * 256 * 1024 + (pn & 3) * 256, 1024, bias + pn * 256, wr, wc, fr, fq); return; }
        const int c0 = pn * 256 + wc * 32 + 8 * fq;
#pragma unroll
        for (int bj = 0; bj < 2; ++bj) { const int col = c0 + bj * 128; const f32x4 b0 = *(const f32x4*)(bias + col), b1 = *(const f32x4*)(bias + col + 4); bf16_t* gp = U + (size_t)(col >> 4) * GM_STRIDE + (col & 15);
#pragma unroll
            for (int ai = 0; ai < 2; ++ai)
#pragma unroll
                for (int m = 0; m < 4; ++m) { const int row = pm * 256 + ai * 128 + wr * 64 + m * 16 + fr; const f32x4 v0 = acc[ai][bj][m][0] + b0, v1 = acc[ai][bj][m][1] + b1;
                    u32x4 w; w.x = cvt_pk_bf16(v0[0], v0[1]); w.y = cvt_pk_bf16(v0[2], v0[3]); w.z = cvt_pk_bf16(v1[0], v1[1]); w.w = cvt_pk_bf16(v1[2], v1[3]);
                    *(u32x4*)(gp + (size_t)row * 16) = w; } }
    } };
template <int ACT> struct EpiPlain { static constexpr bool PERM = true, AFTER_DRAIN = false; bf16_t* O; int ldc; const float* bias;
    __device__ __forceinline__ void operator()(AccT& acc, const GUnit& u, int wr, int wc, int fr, int fq) const {
        epi_bf16_store<ACT>(acc, O + (size_t)u.i0 * 256 * ldc + u.i1 * 256, ldc, bias ? bias + u.i1 * 256 : nullptr, wr, wc, fr, fq); } };
struct EpiS5a { static constexpr bool PERM = true, AFTER_DRAIN = false; bf16_t* YI; float* S;
    __device__ __forceinline__ void operator()(AccT& acc, const GUnit& u, int wr, int wc, int fr, int fq) const {
        const int g = u.i0, pn = u.i1;
#pragma unroll
        for (int ai = 0; ai < 2; ++ai)
#pragma unroll
            for (int m = 0; m < 4; ++m) { const int r = ai * 128 + wr * 64 + m * 16 + fr;
#pragma unroll
                for (int bj = 0; bj < 2; ++bj) { const int c8 = bj * 128 + wc * 32 + 8 * fq; const f32x4 v0 = acc[ai][bj][m][0], v1 = acc[ai][bj][m][1];
                    if (pn < 2) { const int col = pn * 256 + c8, t = col >> 4, k0 = col & 15;
                        u32x4 w; w.x = cvt_pk_bf16(v0[0], v0[1]); w.y = cvt_pk_bf16(v0[2], v0[3]); w.z = cvt_pk_bf16(v1[0], v1[1]); w.w = cvt_pk_bf16(v1[2], v1[3]);
                        *(u32x4*)(YI + (size_t)g * GM_STRIDE + (size_t)r * 512 + col) = w; (void)t; (void)k0; }
                    else { float* sp = S + ((size_t)g * NCH + r) * 256 + c8; *(f32x4*)sp = v0; *(f32x4*)(sp + 4) = v1; } } }
    } };
struct EpiS5b { static constexpr bool PERM = true, AFTER_DRAIN = false; const bf16_t* YI; bf16_t* YG;
    __device__ __forceinline__ void operator()(AccT& acc, const GUnit& u, int wr, int wc, int fr, int fq) const {
        const int g = u.i0, pn = u.i1;
#pragma unroll
        for (int ai = 0; ai < 2; ++ai)
#pragma unroll
            for (int m = 0; m < 4; ++m) { const int r = ai * 128 + wr * 64 + m * 16 + fr;
#pragma unroll
                for (int bj = 0; bj < 2; ++bj) { const int col = pn * 256 + bj * 128 + wc * 32 + 8 * fq, t = col >> 4, k0 = col & 15;
                    const size_t off = (size_t)g * GM_STRIDE + (size_t)r * 512 + col; (void)t; (void)k0; const u32x4 yi = *(const u32x4*)(YI + off);
                    f32x4 v0 = acc[ai][bj][m][0] + (f32x4){bf_lo(yi.x), bf_hi(yi.x), bf_lo(yi.y), bf_hi(yi.y)}, v1 = acc[ai][bj][m][1] + (f32x4){bf_lo(yi.z), bf_hi(yi.z), bf_lo(yi.w), bf_hi(yi.w)};
#pragma unroll
                    for (int j = 0; j < 4; ++j) { v0[j] = gelu_tanh(v0[j]); v1[j] = gelu_tanh(v1[j]); }
                    u32x4 w; w.x = cvt_pk_bf16(v0[0], v0[1]); w.y = cvt_pk_bf16(v0[2], v0[3]); w.z = cvt_pk_bf16(v1[0], v1[1]); w.w = cvt_pk_bf16(v1[2], v1[3]);
                    *(u32x4*)(YG + off) = w; } }
    } };
struct EpiGlu { static constexpr bool PERM = true, AFTER_DRAIN = false; const bf16_t* YG; bf16_t* YPRE; const float* bias;
    __device__ __forceinline__ void operator()(AccT& acc, const GUnit& u, int wr, int wc, int fr, int fq) const {
        const int pm = u.i0, pn = u.i1; const int c0 = pn * 256 + wc * 32 + 8 * fq;
        f32x4 bv[2][2];
#pragma unroll
        for (int bj = 0; bj < 2; ++bj)
#pragma unroll
            for (int n = 0; n < 2; ++n) bv[bj][n] = *(const f32x4*)(bias + c0 + bj * 128 + 4 * n);
#pragma unroll
        for (int ai = 0; ai < 2; ++ai)
#pragma unroll
            for (int m = 0; m < 4; ++m) { const int row = pm * 256 + ai * 128 + wr * 64 + m * 16 + fr;
#pragma unroll
                for (int bj = 0; bj < 2; ++bj) { const int col = c0 + bj * 128; const u32x4 yv = *(const u32x4*)(YG + (size_t)(col >> 4) * GM_STRIDE + (size_t)row * 16 + (col & 15));
                    const f32x4 y0 = (f32x4){bf_lo(yv.x), bf_hi(yv.x), bf_lo(yv.y), bf_hi(yv.y)}, y1 = (f32x4){bf_lo(yv.z), bf_hi(yv.z), bf_lo(yv.w), bf_hi(yv.w)};
                    f32x4 v0 = acc[ai][bj][m][0] + bv[bj][0], v1 = acc[ai][bj][m][1] + bv[bj][1];
#pragma unroll
                    for (int j = 0; j < 4; ++j) { v0[j] = y0[j] * fast_sigmoid(v0[j]); v1[j] = y1[j] * fast_sigmoid(v1[j]); }
                    u32x4 w; w.x = cvt_pk_bf16(v0[0], v0[1]); w.y = cvt_pk_bf16(v0[2], v0[3]); w.z = cvt_pk_bf16(v1[0], v1[1]); w.w = cvt_pk_bf16(v1[2], v1[3]);
                    *(u32x4*)(YPRE + (size_t)row * 2048 + col) = w; }
                }
    } };
template <bool PLEADD> struct EpiRes { static constexpr bool PERM = false, AFTER_DRAIN = false; const bf16_t* HBp; const float* bias; float* V; const bf16_t* SG; const bf16_t* PW;
    __device__ __forceinline__ void operator()(AccT& acc, const GUnit& u, int wr, int wc, int fr, int fq) const {
        const int pm = u.i0, pn = u.i1; const int c0 = pn * 256 + wc * 32 + 4 * fq;
        f32x4 bv[2][2];
#pragma unroll
        for (int bj = 0; bj < 2; ++bj)
#pragma unroll
            for (int n = 0; n < 2; ++n) bv[bj][n] = *(const f32x4*)(bias + c0 + bj * 128 + n * 16);
#pragma unroll
        for (int ai = 0; ai < 2; ++ai)
#pragma unroll
            for (int m = 0; m < 4; ++m) { const int row = pm * 256 + ai * 128 + wr * 64 + m * 16 + fr;
#pragma unroll
                for (int bj = 0; bj < 2; ++bj)
#pragma unroll
                    for (int n = 0; n < 2; ++n) { const size_t off = (size_t)row * 2048 + c0 + bj * 128 + n * 16;
                        f32x4 v = acc[ai][bj][m][n] + bv[bj][n] + DN_ALPHA * bf4(*(const u32x2*)(HBp + off));
                        if (PLEADD) v += bf4(*(const u32x2*)(SG + off)) * bf4(*(const u32x2*)(PW + off));
                        *(f32x4*)(V + off) = v; } }
    } };


struct PanelStats8 { unsigned long long* xbuf; unsigned* cnt; float eps;
    __device__ __forceinline__ void run(const AccT& v, int pm, int pn, int wr, int wc, int fr, int fq, LAS unsigned char* lds, int wid) const {
        LAS f32x2* P = (LAS f32x2*)lds; LAS f32x2* S = (LAS f32x2*)(lds + 8192); const int lane = fq * 16 + fr;
#pragma unroll
        for (int ai = 0; ai < 2; ++ai)
#pragma unroll
            for (int m = 0; m < 4; ++m) { float s = 0.f;
#pragma unroll
                for (int bj = 0; bj < 2; ++bj)
#pragma unroll
                    for (int n = 0; n < 2; ++n) { const f32x4 x = v[ai][bj][m][n]; s += (x[0] + x[1]) + (x[2] + x[3]); }
                s += __shfl_xor(s, 16); s += __shfl_xor(s, 32);
                const float mw = s * (1.0f / 64.0f); float q = 0.f;
#pragma unroll
                for (int bj = 0; bj < 2; ++bj)
#pragma unroll
                    for (int n = 0; n < 2; ++n) { const f32x4 d = v[ai][bj][m][n] - mw; q += (d[0] * d[0] + d[1] * d[1]) + (d[2] * d[2] + d[3] * d[3]); }
                q += __shfl_xor(q, 16); q += __shfl_xor(q, 32);
                if (fq == 0) P[(ai * 128 + wr * 64 + m * 16 + fr) * 4 + wc] = (f32x2){mw, q}; }
        asm volatile("s_waitcnt lgkmcnt(0)" ::: "memory"); __builtin_amdgcn_s_barrier(); asm volatile("" ::: "memory");
        const int row = wid * 32 + (lane & 31);
        if (lane < 32) { const f32x2 a = P[row * 4 + 0], b = P[row * 4 + 1], c = P[row * 4 + 2], d = P[row * 4 + 3];
            const float mt = (a[0] + b[0] + c[0] + d[0]) * 0.25f; const float da = a[0] - mt, db = b[0] - mt, dc = c[0] - mt, dd = d[0] - mt;
            const float m2 = (a[1] + b[1]) + (c[1] + d[1]) + 64.0f * ((da * da + db * db) + (dc * dc + dd * dd));
            __hip_atomic_store(xbuf + ((size_t)(pm * 256 + row) * 8 + pn), ((unsigned long long)__float_as_uint(m2) << 32) | __float_as_uint(mt), __ATOMIC_RELAXED, __HIP_MEMORY_SCOPE_AGENT); }
        asm volatile("s_waitcnt vmcnt(0)" ::: "memory");
        if (lane == 0) __hip_atomic_fetch_add(cnt + 64 * pm, 1u, __ATOMIC_RELAXED, __HIP_MEMORY_SCOPE_AGENT);
        if (wid == 0) { unsigned sp = 0;
            while ((unsigned)__builtin_amdgcn_readfirstlane(__hip_atomic_load(cnt + 64 * pm, __ATOMIC_RELAXED, __HIP_MEMORY_SCOPE_AGENT)) < 64u) { __builtin_amdgcn_s_sleep(2); if (++sp > (1u << 22)) break; }
            __builtin_amdgcn_fence(__ATOMIC_ACQUIRE, "agent"); }
        asm volatile("s_waitcnt vmcnt(0) lgkmcnt(0)" ::: "memory"); __builtin_amdgcn_s_barrier(); asm volatile("" ::: "memory");
        if (lane < 32) { const unsigned long long* slot = xbuf + (size_t)(pm * 256 + row) * 8; float mt[8], m2[8]; float ms = 0.f;
#pragma unroll
            for (int t = 0; t < 8; ++t) { const unsigned long long w = __hip_atomic_load(slot + t, __ATOMIC_RELAXED, __HIP_MEMORY_SCOPE_AGENT); mt[t] = __uint_as_float((unsigned)w); m2[t] = __uint_as_float((unsigned)(w >> 32)); ms += mt[t]; }
            const float mean = ms * 0.125f; float q = 0.f;
#pragma unroll
            for (int t = 0; t < 8; ++t) { const float dm = mt[t] - mean; q += m2[t] + 256.0f * dm * dm; }
            S[row] = (f32x2){mean, 1.0f / sqrtf(q * (1.0f / 2048.0f) + eps)}; }
        asm volatile("s_waitcnt lgkmcnt(0)" ::: "memory"); __builtin_amdgcn_s_barrier(); asm volatile("" ::: "memory");
    } };
struct EpiResLn1 { static constexpr bool PERM = false, AFTER_DRAIN = true; bf16_t* HBp; const float *bias, *lng, *lnb; PanelStats8 st;
    __device__ __forceinline__ void fused(AccT& acc, const GUnit& u, int wr, int wc, int fr, int fq, LAS unsigned char* lds, int wid) const {
        const int pm = u.i0, pn = u.i1; const int c0 = pn * 256 + wc * 32 + 4 * fq; const LAS f32x2* S = (const LAS f32x2*)(lds + 8192);
#pragma unroll
        for (int bj = 0; bj < 2; ++bj)
#pragma unroll
            for (int n = 0; n < 2; ++n) { const f32x4 bv = *(const f32x4*)(bias + c0 + bj * 128 + n * 16);
#pragma unroll
                for (int ai = 0; ai < 2; ++ai)
#pragma unroll
                    for (int m = 0; m < 4; ++m) { const size_t off = (size_t)(pm * 256 + ai * 128 + wr * 64 + m * 16 + fr) * 2048 + c0 + bj * 128 + n * 16;
                        acc[ai][bj][m][n] += bv + DN_ALPHA * bf4(*(const u32x2*)(HBp + off)); } }
        st.run(acc, pm, pn, wr, wc, fr, fq, lds, wid);
#pragma unroll
        for (int bj = 0; bj < 2; ++bj)
#pragma unroll
            for (int n = 0; n < 2; ++n) { const f32x4 gg = *(const f32x4*)(lng + c0 + bj * 128 + n * 16), bb = *(const f32x4*)(lnb + c0 + bj * 128 + n * 16);
#pragma unroll
                for (int ai = 0; ai < 2; ++ai)
#pragma unroll
                    for (int m = 0; m < 4; ++m) { const int r = ai * 128 + wr * 64 + m * 16 + fr; const f32x2 sr = S[r]; const size_t off = (size_t)(pm * 256 + r) * 2048 + c0 + bj * 128 + n * 16;
                        const f32x4 o = (acc[ai][bj][m][n] - sr[0]) * sr[1] * gg + bb; u32x2 w; w.x = cvt_pk_bf16(o[0], o[1]); w.y = cvt_pk_bf16(o[2], o[3]); *(u32x2*)(HBp + off) = w; } }
    } };
struct EpiG { static constexpr bool PERM = true, AFTER_DRAIN = false; bf16_t *G0, *G1; const float* bias;
    __device__ __forceinline__ void operator()(AccT& acc, const GUnit& u, int wr, int wc, int fr, int fq) const {
        const int pm = u.i0, h = u.i1; bf16_t* base = (pm < 16 ? G0 : G1) + (size_t)(pm & 15) * 256 * 4096 + h * 256;
        epi_bf16_store<0>(acc, base, 4096, bias + h * 256, wr, wc, fr, fq); } };
__device__ __forceinline__ float bfu(unsigned short v) { return __uint_as_float(((unsigned)v) << 16); }
__device__ __forceinline__ void rg_gate(float pa, float px, float spv, float xc, float& a, float& b) {
    const float r = fast_sigmoid(pa), ig = fast_sigmoid(px); const float la = spv * r; a = __expf(la); const float x = 2.0f * la;
    const float om = -x * (1.0f + x * (0.5f + x * (0.16666667f + x * (0.041666668f + x * 0.008333334f))));
    b = __builtin_amdgcn_sqrtf(fmaxf(om, 0.f)) * ig * xc; }
__device__ __forceinline__ void rg_gate2(float pa, float px, float spv, float xc, float& a, float& b, float& r) {
    r = fast_sigmoid(pa); const float ig = fast_sigmoid(px); const float la = spv * r; a = __expf(la); const float x = 2.0f * la;
    const float om = -x * (1.0f + x * (0.5f + x * (0.16666667f + x * (0.041666668f + x * 0.008333334f))));
    b = __builtin_amdgcn_sqrtf(fmaxf(om, 0.f)) * ig * xc; }
struct RgCtx { const bf16_t *XR, *G0, *G1, *Z; const float *convw, *convb, *sp; float* agg; bf16_t* ypre; };
__device__ __forceinline__ const bf16_t* g_row(const RgCtx& R, int t) { return (t < 4096 ? R.G0 : R.G1) + (size_t)(t & 4095) * 4096; }
__device__ __forceinline__ void rg_pass_a(const RgCtx& R, int half, int seg, int tid) {
    const int c = half * 512 + tid, gcol = (c >> 6) * 256 + (c & 63) * 4, t0 = seg * 64;
    const float w0 = R.convw[c], w1 = R.convw[1024 + c], w2 = R.convw[2048 + c], w3 = R.convw[3072 + c], cb = R.convb[c], sp0 = R.sp[c], sp1 = R.sp[1024 + c];
    const bf16_t* xp = R.XR + c;
    float x0 = bfu(xp[(size_t)(t0 + 0) * 1024]), x1 = bfu(xp[(size_t)(t0 + 1) * 1024]), x2 = bfu(xp[(size_t)(t0 + 2) * 1024]);
    float Af = 1.f, Bf = 0.f, Ab = 1.f, Bb = 0.f;
    for (int tb = 0; tb < 64; tb += 16) {
        u32x2 gq[16]; unsigned short xn[16];
#pragma unroll
        for (int i = 0; i < 16; ++i) { const int t = t0 + tb + i; gq[i] = *(const u32x2*)(g_row(R, t) + gcol); xn[i] = xp[(size_t)(t + 3) * 1024]; }
#pragma unroll
        for (int i = 0; i < 16; ++i) { const float x3 = bfu(xn[i]); const float xc = cb + w0 * x0 + w1 * x1 + w2 * x2 + w3 * x3; x0 = x1; x1 = x2; x2 = x3;
            float a, b, r0, r1, b0; rg_gate2(bf_lo(gq[i].x), bf_lo(gq[i].y), sp0, xc, a, b, r0); Bf = a * Bf + b; Af = a * Af; b0 = b;
            rg_gate2(bf_hi(gq[i].x), bf_hi(gq[i].y), sp1, xc, a, b, r1); Bb = Ab * b + Bb; Ab = Ab * a;
            u32x2 w; w.x = cvt_pk_bf16(r0, r1); w.y = cvt_pk_bf16(b0, b); *(u32x2*)((bf16_t*)g_row(R, t0 + tb + i) + gcol) = w; }
    }
    *(f32x2*)(R.agg + ((size_t)(seg * 2 + 0) * 1024 + c) * 2) = (f32x2){Af, Bf};
    *(f32x2*)(R.agg + ((size_t)(seg * 2 + 1) * 1024 + c) * 2) = (f32x2){Ab, Bb};
}
__device__ __forceinline__ void rg_pass_c(const RgCtx& R, int half, int seg, int tid, LAS float* Lh) {
    const int c = half * 512 + tid, gcol = (c >> 6) * 256 + (c & 63) * 4, t0 = seg * 64;
    const float sp0 = R.sp[c], sp1 = R.sp[1024 + c];
    const f32x2* ag = (const f32x2*)R.agg;
    float hf = 0.f, hb = 0.f;
    {
#pragma unroll 1
        for (int sb = 0; sb < 128; sb += 32) { f32x2 ab[32];
#pragma unroll
            for (int i = 0; i < 32; ++i) { const int s2 = sb + i; ab[i] = (s2 < seg) ? ag[(size_t)(s2 * 2 + 0) * 1024 + c] : (f32x2){1.f, 0.f}; }
#pragma unroll
            for (int i = 0; i < 32; ++i) hf = ab[i][0] * hf + ab[i][1]; }
#pragma unroll 1
        for (int sb = 96; sb >= 0; sb -= 32) { f32x2 ab[32];
#pragma unroll
            for (int i = 0; i < 32; ++i) { const int s2 = sb + 31 - i; ab[i] = (s2 > seg) ? ag[(size_t)(s2 * 2 + 1) * 1024 + c] : (f32x2){1.f, 0.f}; }
#pragma unroll
            for (int i = 0; i < 32; ++i) hb = ab[i][0] * hb + ab[i][1]; }
    }
    {
        for (int tb = 0; tb < 64; tb += 16) {
            u32x2 gq[16];
#pragma unroll
            for (int i = 0; i < 16; ++i) gq[i] = *(const u32x2*)(g_row(R, t0 + tb + i) + gcol);
#pragma unroll
            for (int i = 0; i < 16; ++i) { const float a = __expf(sp0 * bf_lo(gq[i].x)); hf = a * hf + bf_lo(gq[i].y); Lh[(tb + i) * 512 + tid] = hf; }
        }
    }
    {
        for (int tb = 48; tb >= 0; tb -= 16) {
            u32x2 gq[16]; unsigned short zz[16];
#pragma unroll
            for (int i = 0; i < 16; ++i) { const int t = t0 + tb + 15 - i; gq[i] = *(const u32x2*)(g_row(R, t) + gcol); zz[i] = R.Z[(size_t)t * 1024 + c]; }
#pragma unroll
            for (int i = 0; i < 16; ++i) { const int tl = tb + 15 - i; const float a = __expf(sp1 * bf_hi(gq[i].x)); hb = a * hb + bf_hi(gq[i].y);
                const float o = (Lh[tl * 512 + tid] + hb) * gelu_tanh(bfu(zz[i]));
                R.ypre[(size_t)(t0 + tl) * 2048 + 1024 + c] = (bf16_t)(cvt_pk_bf16(o, 0.f) & 0xffffu); }
        }
    }
}

#ifndef NAIVE_GEMM
#define NAIVE_GEMM 0
#endif
template <class Epi, class Sched>
__device__ __forceinline__ void gemm_phase_naive(LAS unsigned char* lds, const int wid, const GParm gp, const Sched& S, const Epi& E) {
    const int lane = fresh_lane(), tid = wid * 64 + lane, wr = wid >> 2, wc = wid & 3, fr = lane & 15, fq = lane >> 4;
    GUnit cur;
    for (int ui = 0; S.next(ui, cur); ++ui) {
        f32x4 acc[2][2][4][2];
#pragma unroll
        for (int ai = 0; ai < 2; ++ai)
#pragma unroll
            for (int bj = 0; bj < 2; ++bj)
#pragma unroll
                for (int m = 0; m < 4; ++m)
#pragma unroll
                    for (int n = 0; n < 2; ++n)
#pragma unroll
                        for (int e = 0; e < 4; ++e) {
                            const int row = 128 * ai + 64 * wr + 16 * m + fr; const int col = Epi::PERM ? (128 * bj + 32 * wc + 8 * fq + 4 * n + e) : (128 * bj + 32 * wc + 16 * n + 4 * fq + e);
                            const char* ap = cur.A + (size_t)row * gp.a_rs; const char* bp = cur.B + (size_t)col * gp.K * 2; float sum = 0.f;
                            for (int k = 0; k < gp.K; k += 8) { const int kt = k >> 6, C = k & 63;
                                const u32x4 av = *(const u32x4*)(ap + (size_t)kt * gp.a_ks + ((C / gp.a_cw) * gp.a_cs + (C % gp.a_cw)) * 2), bv = *(const u32x4*)(bp + k * 2);
                                sum += bf_lo(av.x) * bf_lo(bv.x) + bf_hi(av.x) * bf_hi(bv.x) + bf_lo(av.y) * bf_lo(bv.y) + bf_hi(av.y) * bf_hi(bv.y) + bf_lo(av.z) * bf_lo(bv.z) + bf_hi(av.z) * bf_hi(bv.z) + bf_lo(av.w) * bf_lo(bv.w) + bf_hi(av.w) * bf_hi(bv.w); }
                            acc[ai][bj][m][n][e] = sum; }
        if constexpr (Epi::AFTER_DRAIN) { __syncthreads(); E.fused(acc, cur, wr, wc, fr, fq, lds, wid); } else E(acc, cur, wr, wc, fr, fq);
    }
    __syncthreads();
}
#if NAIVE_GEMM
#define GEMM_PHASE gemm_phase_naive
#else
#define GEMM_PHASE pg8::gemm_phase
#endif
__device__ __forceinline__ void transpose_item(const float* W, int K, int N, bf16_t* WT, LAS float* scr, int item, int lane) {
    const int nblk = N / 64, kb = item / nblk, nb = item % nblk, k0 = 64 * kb, n0 = 64 * nb;
    const float* src = W + (size_t)k0 * N + n0 + lane;
#pragma unroll 32
    for (int i = 0; i < 64; ++i) scr[i * 65 + lane] = src[(size_t)i * N];
    LDS_WAIT();
    const int c = lane & 7;
#pragma unroll
    for (int j = 0; j < 8; ++j) { const int n = (lane >> 3) + 8 * j; const LAS float* sp = scr + (8 * c) * 65 + n;
        u32x4 o; o.x = cvt_pk_bf16(sp[0 * 65], sp[1 * 65]); o.y = cvt_pk_bf16(sp[2 * 65], sp[3 * 65]); o.z = cvt_pk_bf16(sp[4 * 65], sp[5 * 65]); o.w = cvt_pk_bf16(sp[6 * 65], sp[7 * 65]);
        *(u32x4*)(WT + (size_t)(n0 + n) * K + k0 + 8 * c) = o; }
    LDS_WAIT();
}
template <bool OUT_BF16> __device__ __forceinline__ void ln_row(const float* xrow, const float* g, const float* b, void* orow, int lane) {
    const f32x4* xr = (const f32x4*)xrow + lane; f32x4 v[8]; float s = 0.f;
#pragma unroll
    for (int j = 0; j < 8; ++j) { v[j] = xr[64 * j]; s += (v[j][0] + v[j][1]) + (v[j][2] + v[j][3]); }
    const float mean = wave_sum(s) * (1.f / DM); float s2 = 0.f;
#pragma unroll
    for (int j = 0; j < 8; ++j) { v[j] = v[j] - mean; s2 += (v[j][0] * v[j][0] + v[j][1] * v[j][1]) + (v[j][2] * v[j][2] + v[j][3] * v[j][3]); }
    const float rstd = 1.0f / sqrtf(wave_sum(s2) * (1.f / DM) + LN_EPS);
#pragma unroll
    for (int j = 0; j < 8; ++j) { const f32x4 gg = ((const f32x4*)g)[lane + 64 * j], bb = ((const f32x4*)b)[lane + 64 * j]; const f32x4 o = v[j] * rstd * gg + bb;
        if (OUT_BF16) { u32x2 w; w.x = cvt_pk_bf16(o[0], o[1]); w.y = cvt_pk_bf16(o[2], o[3]); ((u32x2*)orow)[lane + 64 * j] = w; }
        else ((f32x4*)orow)[lane + 64 * j] = o; }
}
__device__ __forceinline__ void cpow(float lrs, float th, int j, float& re, float& im) {
    double a = (double)j * (double)th * 0.15915494309189535; a -= rint(a); const float af = 2.0f * (float)a;
    const float mag = expf((float)j * lrs); re = mag * cospif(af); im = mag * sinpif(af);
}


#ifndef NAIVE_RG
#define NAIVE_RG 0
#endif
__device__ __forceinline__ void naive_rg_channel(const RgCtx& R, int c) {
    const int gcol = (c >> 6) * 256 + (c & 63);
    const float w0 = R.convw[c], w1 = R.convw[1024 + c], w2 = R.convw[2048 + c], w3 = R.convw[3072 + c], cb = R.convb[c], sp0 = R.sp[c], sp1 = R.sp[1024 + c];
    const bf16_t* xp = R.XR + c; float h = 0.f;
    for (int t = 0; t < SEQ; ++t) { const float xc = cb + w0 * bfu(xp[(size_t)t * 1024]) + w1 * bfu(xp[(size_t)(t + 1) * 1024]) + w2 * bfu(xp[(size_t)(t + 2) * 1024]) + w3 * bfu(xp[(size_t)(t + 3) * 1024]);
        const bf16_t* g = g_row(R, t) + gcol; float a, b; rg_gate(bfu(g[0]), bfu(g[128]), sp0, xc, a, b); h = a * h + b;
        R.ypre[(size_t)t * 2048 + 1024 + c] = (bf16_t)(cvt_pk_bf16(h, 0.f) & 0xffffu); }
    __builtin_amdgcn_fence(__ATOMIC_SEQ_CST, "agent");
    h = 0.f;
    for (int t = SEQ - 1; t >= 0; --t) { const float xc = cb + w0 * bfu(xp[(size_t)t * 1024]) + w1 * bfu(xp[(size_t)(t + 1) * 1024]) + w2 * bfu(xp[(size_t)(t + 2) * 1024]) + w3 * bfu(xp[(size_t)(t + 3) * 1024]);
        const bf16_t* g = g_row(R, t) + gcol; float a, b; rg_gate(bfu(g[64]), bfu(g[192]), sp1, xc, a, b); h = a * h + b;
        const size_t o = (size_t)t * 2048 + 1024 + c; const float y = (bfu(R.ypre[o]) + h) * gelu_tanh(bfu(R.Z[(size_t)t * 1024 + c]));
        R.ypre[o] = (bf16_t)(cvt_pk_bf16(y, 0.f) & 0xffffu); }
}

#ifndef NAIVE_S5
#define NAIVE_S5 0
#endif
__device__ __forceinline__ void naive_s5_group(const float* const* in, const bf16_t* U, float* tmp, bf16_t* YG, int g, int lane) {
    const float *lre = in[6], *lim = in[7], *lstep = in[8], *bre = in[9], *bim = in[10], *cre = in[11], *cim = in[12], *dd = in[13];
    for (int n = 0; n < 2; ++n) {
        const int p = lane, pi = (n * 64 + g) * 64 + p;
        const float lr = fminf(lre[pi], -1e-4f), li = lim[pi], step = expf(lstep[n * 64 + g]); float ar, ai; cpow(lr * step, li * step, 1, ar, ai);
        const float nr = ar - 1.0f, ni = ai, den = lr * lr + li * li; const float qr = (nr * lr + ni * li) / den, qi = (ni * lr - nr * li) / den;
        float hr = 0.f, hi = 0.f;
        for (int tt = 0; tt < SEQ; ++tt) { const int t = n == 0 ? tt : SEQ - 1 - tt; const bf16_t* up = U + (size_t)t * 1024 + g * 16;
            float bur = 0.f, bui = 0.f;
#pragma unroll
            for (int k = 0; k < 16; ++k) { const float uv = bfu(up[k]); const float br = bre[(size_t)pi * 16 + k], bi = bim[(size_t)pi * 16 + k]; bur += (qr * br - qi * bi) * uv; bui += (qr * bi + qi * br) * uv; }
            const float nhr = ar * hr - ai * hi + bur, nhi = ar * hi + ai * hr + bui; hr = nhr; hi = nhi;
#pragma unroll
            for (int k = 0; k < 16; ++k) { const size_t ci = ((size_t)(n * 64 + g) * 16 + k) * 64 + p; float v = cre[ci] * hr - cim[ci] * hi; v = wave_sum(v);
                if (lane == k) { const size_t o = (size_t)t * 1024 + g * 16 + k;
                    if (n == 0) tmp[o] = v; else { const float y = tmp[o] + v + dd[g * 16 + k] * bfu(up[k]); YG[o] = (bf16_t)(cvt_pk_bf16(gelu_tanh(y), 0.f) & 0xffffu); } } }
        }
        __builtin_amdgcn_fence(__ATOMIC_SEQ_CST, "agent");
    }
}

__device__ __forceinline__ void grid_barrier(unsigned* bar, unsigned target, int wave) {
    asm volatile("s_waitcnt vmcnt(0)" ::: "memory");
    __syncthreads();
    if (wave == 0) { const int l = fresh_lane();
        if (l == 0) {
            __builtin_amdgcn_fence(__ATOMIC_RELEASE, "agent"); asm volatile("s_waitcnt vmcnt(0)" ::: "memory");
            __hip_atomic_fetch_add(bar, 1u, __ATOMIC_RELAXED, __HIP_MEMORY_SCOPE_AGENT);
            while (__hip_atomic_load(bar, __ATOMIC_RELAXED, __HIP_MEMORY_SCOPE_AGENT) < target) __builtin_amdgcn_s_sleep(2);
            __builtin_amdgcn_fence(__ATOMIC_ACQUIRE, "agent"); asm volatile("s_waitcnt vmcnt(0)" ::: "memory");
        } }
    __syncthreads();
}

struct Args { const float* in[38]; float* out; unsigned char* ws; int ph_lo, ph_hi; };
typedef const float* cfp_t;
typedef const __attribute__((address_space(4))) cfp_t* kin_t;

__device__ __forceinline__ void s5_precompute(const kin_t ain, unsigned char* aws, int g, int hq, int nh, LAS float* L, const int tid) {
    const float *lre = ain[6], *lim = ain[7], *lstep = ain[8], *bre = ain[9], *bim = ain[10], *cre = ain[11], *cim = ain[12], *dd = ain[13];
    LAS float *PWre = L, *PWim = L + 4224, *BBre = L + 8448, *BBim = L + 10496, *CCre = L + 12544, *CCim = L + 14592, *MT = L + 16640, *C2re = L + 33280, *C2im = L + 35328, *Dl = L + 37376;
    bf16_t* WGg = (bf16_t*)(aws + WS_WG) + (size_t)g * 768 * 512; bf16_t* WCg = (bf16_t*)(aws + WS_WC) + (size_t)g * 512 * 256;
#define PSTAMP(i) do { if (TSTAMP && blockIdx.x == 128 && tid == 0) ((unsigned long long*)(aws + WS_CTR + 1024))[i] = __builtin_amdgcn_s_memrealtime(); } while (0)
    PSTAMP(20);
    {
        const int np = tid & 127, jj = tid >> 7, n = np >> 6, p = np & 63; const int pi = (n * 64 + g) * 64 + p;
        const float lr = fminf(lre[pi], -1e-4f), li = lim[pi], step = expf(lstep[n * 64 + g]); const float lrs = lr * step, th = li * step;
        for (int j = jj; j <= 32; j += 4) { float r, i; cpow(lrs, th, j, r, i); PWre[np * 33 + j] = r; PWim[np * 33 + j] = i; }
        float l1r, l1i; cpow(lrs, th, 1, l1r, l1i);
        const float nr = l1r - 1.0f, ni = l1i, den = lr * lr + li * li; const float qr = (nr * lr + ni * li) / den, qi = (ni * lr - nr * li) / den;
#pragma unroll
        for (int k = jj * 4; k < jj * 4 + 4; ++k) { const float br = bre[(size_t)pi * 16 + k], bi = bim[(size_t)pi * 16 + k]; BBre[np * 16 + k] = qr * br - qi * bi; BBim[np * 16 + k] = qr * bi + qi * br; }
        for (int e = tid; e < 2048; e += 512) { const int n2 = e >> 10, k = (e >> 6) & 15, p2 = e & 63; const size_t ci = ((size_t)(n2 * 64 + g) * 16 + k) * 64 + p2; CCre[(n2 * 64 + p2) * 16 + k] = cre[ci]; CCim[(n2 * 64 + p2) * 16 + k] = cim[ci]; C2re[e] = cre[ci]; C2im[e] = cim[ci]; }
        if (tid < 16) Dl[tid] = dd[g * 16 + tid];
    }
    __syncthreads();
    PSTAMP(21);
    for (int i = 0; i < 3; ++i) {
        if (nh == 2) { if (i < 2 && i != hq) continue; if (i == 2 && (hq != 0 || tid >= 16)) continue; } else if (i == 2) continue;
        const int bq = (i == 2) ? 512 + tid : tid + 512 * i, n = bq >> 9, j = (bq >> 4) & 31, kob = (bq >> 2) & 3, kib = bq & 3;
        f32x4 m0 = {0.f, 0.f, 0.f, 0.f}, m1 = m0, m2 = m0, m3 = m0;
        for (int p = 0; p < 64; ++p) { const int np = n * 64 + p; const float pr = PWre[np * 33 + j], pi2 = PWim[np * 33 + j];
            const f32x4 br = *(const LAS f32x4*)(BBre + np * 16 + 4 * kib), bi = *(const LAS f32x4*)(BBim + np * 16 + 4 * kib), cr = *(const LAS f32x4*)(CCre + np * 16 + 4 * kob), ci = *(const LAS f32x4*)(CCim + np * 16 + 4 * kob);
            const f32x4 er = pr * br - pi2 * bi, ei = pr * bi + pi2 * br;
            m0 += cr[0] * er - ci[0] * ei; m1 += cr[1] * er - ci[1] * ei; m2 += cr[2] * er - ci[2] * ei; m3 += cr[3] * er - ci[3] * ei; }
        LAS float* o = MT + (n * 32 + j) * 260 + (4 * kob) * 16 + 4 * kib;
        *(LAS f32x4*)o = m0; *(LAS f32x4*)(o + 16) = m1; *(LAS f32x4*)(o + 32) = m2; *(LAS f32x4*)(o + 48) = m3;
    }
    __syncthreads();
    PSTAMP(22);
    for (int i = 0; i < 64; ++i) {
        const int idx = tid + 512 * i, row = idx >> 6, cp = idx & 63, t = row >> 4, ko = row & 15, s = cp >> 1, ki0 = (cp & 1) * 8;
        if (nh == 2 && ((t >= s) != (hq == 0))) continue;
        f32x4 v0, v1;
        if (t != s) { const LAS float* src = MT + ((t > s ? 0 : 1) * 32 + (t > s ? t - s : s - t)) * 260 + ko * 16 + ki0; v0 = *(const LAS f32x4*)src; v1 = *(const LAS f32x4*)(src + 4); }
        else { const LAS float* s0 = MT + ko * 16 + ki0; const LAS float* s1 = MT + 32 * 260 + ko * 16 + ki0; v0 = *(const LAS f32x4*)s0 + *(const LAS f32x4*)s1; v1 = *(const LAS f32x4*)(s0 + 4) + *(const LAS f32x4*)(s1 + 4);
            const float dv = Dl[ko];
#pragma unroll
            for (int e = 0; e < 4; ++e) { if (ki0 + e == ko) v0[e] += dv; if (ki0 + 4 + e == ko) v1[e] += dv; } }
        u32x4 w; w.x = cvt_pk_bf16(v0[0], v0[1]); w.y = cvt_pk_bf16(v0[2], v0[3]); w.z = cvt_pk_bf16(v1[0], v1[1]); w.w = cvt_pk_bf16(v1[2], v1[3]);
        *(u32x4*)(WGg + (size_t)row * 512 + cp * 8) = w;
    }
    for (int i = hq * (32 / nh); i < (hq + 1) * (32 / nh); ++i) {
        const int idx = tid + 512 * i, q = idx >> 6, cp = idx & 63, n = q >> 7, ri = (q >> 6) & 1, p = q & 63, s = cp >> 1, ki0 = (cp & 1) * 8, e = n == 0 ? 31 - s : s, np = n * 64 + p;
        const float pr = PWre[np * 33 + e], pi2 = PWim[np * 33 + e]; float v[8];
#pragma unroll
        for (int k = 0; k < 8; ++k) { const float br = BBre[np * 16 + ki0 + k], bi = BBim[np * 16 + ki0 + k]; v[k] = ri == 0 ? pr * br - pi2 * bi : pr * bi + pi2 * br; }
        u32x4 w; w.x = cvt_pk_bf16(v[0], v[1]); w.y = cvt_pk_bf16(v[2], v[3]); w.z = cvt_pk_bf16(v[4], v[5]); w.w = cvt_pk_bf16(v[6], v[7]);
        *(u32x4*)(WGg + (size_t)(512 + q) * 512 + cp * 8) = w;
    }
    for (int i = 0; i < 32 / nh; ++i) {
        const int idx = tid + 512 * i, row = nh == 2 ? idx >> 4 : idx >> 5, q0 = nh == 2 ? hq * 128 + (idx & 15) * 8 : (idx & 31) * 8, n = q0 >> 7, ri = (q0 >> 6) & 1, p0 = q0 & 63, t = row >> 4, ko = row & 15, e = n == 0 ? t + 1 : 32 - t; float v[8];
#pragma unroll
        for (int k = 0; k < 8; ++k) { const int np = n * 64 + p0 + k; const float cr = C2re[(n * 16 + ko) * 64 + p0 + k], ci = C2im[(n * 16 + ko) * 64 + p0 + k], pr = PWre[np * 33 + e], pi2 = PWim[np * 33 + e];
            v[k] = ri == 0 ? cr * pr - ci * pi2 : -(cr * pi2 + ci * pr); }
        u32x4 w; w.x = cvt_pk_bf16(v[0], v[1]); w.y = cvt_pk_bf16(v[2], v[3]); w.z = cvt_pk_bf16(v[4], v[5]); w.w = cvt_pk_bf16(v[6], v[7]);
        *(u32x4*)(WCg + (size_t)row * 256 + q0) = w;
    }
    __syncthreads();
    PSTAMP(23);
}


#ifndef DIAG
#define DIAG 0
#endif
__device__ __forceinline__ void diag_ffn(const float* const* in, const unsigned char* ws, const float* outp, unsigned* flagw, int gtid, int GT) {
    const bf16_t* h1 = (const bf16_t*)(ws + WS_HB); const bf16_t* T = (const bf16_t*)(ws + WS_T); const float* V2 = (const float*)(ws + WS_V2);
    const float *w1 = in[29], *b1 = in[30], *w2 = in[31], *b2 = in[32], *wp = in[33], *wg = in[34], *bg = in[35], *pp = in[1];
    for (int sidx = gtid; sidx < 16384; sidx += GT) {
        unsigned hsh = (unsigned)sidx * 2654435761u, h2 = ((unsigned)sidx + 977u) * 2246822519u; const int r = (hsh >> 8) % SEQ; const int c = (h2 >> 6) % DFF; const int c2 = c % DM;
        float a = b1[c]; for (int k = 0; k < DM; ++k) a += bfu(h1[(size_t)r * DM + k]) * w1[(size_t)k * DFF + c];
        a = fmaxf(a, 0.f); a = a * a; const float tv = bfu(T[(size_t)r * DFF + c]);
        if (fabsf(tv - a) > 0.008f * fabsf(a) + 0.006f) atomicAdd(flagw + 0, 1u);
        float f = b2[c2]; for (int k = 0; k < DFF; ++k) f += bfu(T[(size_t)r * DFF + k]) * w2[(size_t)k * DM + c2];
        float gt = bg[c2]; for (int k = 0; k < DM; ++k) gt += bfu(h1[(size_t)r * DM + k]) * wg[(size_t)k * DM + c2];
        float pw = 0.f; for (int k = 0; k < PLE; ++k) pw += pp[(size_t)r * PLE + k] * wp[(size_t)k * DM + c2];
        const float v2 = DN_ALPHA * bfu(h1[(size_t)r * DM + c2]) + f + fast_sigmoid(gt) * pw; const float got = V2[(size_t)r * DM + c2];
        if (fabsf(got - v2) > 0.008f * fabsf(v2) + 0.006f) atomicAdd(flagw + 1, 1u);
        { const float* vr = V2 + (size_t)r * DM; float m = 0.f; for (int k = 0; k < DM; ++k) m += vr[k]; m /= DM; float v = 0.f; for (int k = 0; k < DM; ++k) { const float d = vr[k] - m; v += d * d; } v /= DM;
          const float e = (vr[c2] - m) / sqrtf(v + LN_EPS) * in[36][c2] + in[37][c2]; const float go = outp[(size_t)r * DM + c2]; if (fabsf(go - e) > 0.004f * fabsf(e) + 0.003f) atomicAdd(flagw + 2, 1u); }
    }
}

__device__ __forceinline__ void diag_pre(const float* const* in, const unsigned char* ws, const unsigned char* dout, unsigned* flagw, int gtid, int GT) {
    const bf16_t* h0 = (const bf16_t*)(ws + WS_HB); const bf16_t* U = (const bf16_t*)(dout + DO_U); const bf16_t* XRb = (const bf16_t*)(ws + WS_XR) + 2048; const bf16_t* Z = (const bf16_t*)(dout + DO_Z);
    const bf16_t* ypre = (const bf16_t*)(dout + DO_YPRE); const bf16_t* ycat = (const bf16_t*)(ws + WS_YCAT); const bf16_t* yg = (const bf16_t*)(ws + WS_YS5G);
    const float *x = in[0], *lg = in[2], *lb = in[3], *win = in[4], *bin = in[5], *gw_ = in[14], *gb = in[15], *g5 = in[23], *gr = in[24];
    for (int sidx = gtid; sidx < 8192; sidx += GT) {
        unsigned hsh = (unsigned)sidx * 2654435761u, h2 = ((unsigned)sidx + 977u) * 2246822519u; const int r = (hsh >> 8) % SEQ; const int c = (h2 >> 6) % DIN; const int c2 = c % DM; const int c1 = c % DS5;
        { float m = 0.f; for (int k = 0; k < DM; ++k) m += x[(size_t)r * DM + k]; m /= DM; float v = 0.f; for (int k = 0; k < DM; ++k) { const float d = x[(size_t)r * DM + k] - m; v += d * d; } v /= DM;
          const float e = (x[(size_t)r * DM + c2] - m) / sqrtf(v + LN_EPS) * lg[c2] + lb[c2]; const float got = bfu(h0[(size_t)r * DM + c2]); if (fabsf(got - e) > 0.008f * fabsf(e) + 0.006f) atomicAdd(flagw + 0, 1u); }
        { float a = bin[c]; for (int k = 0; k < DM; ++k) a += bfu(h0[(size_t)r * DM + k]) * win[(size_t)k * DIN + c];
          const float got = c < 1024 ? bfu(U[(size_t)r * 1024 + c]) : (c < 2048 ? bfu(XRb[(size_t)r * 1024 + c - 1024]) : bfu(Z[(size_t)r * 1024 + c - 2048])); if (fabsf(got - a) > 0.008f * fabsf(a) + 0.006f) atomicAdd(flagw + 3, 1u); }
        { const int hf = c2 >> 10; float ss = 0.f; for (int k = 0; k < 1024; ++k) { const float y = bfu(ypre[(size_t)r * DM + hf * 1024 + k]); ss += y * y; }
          const float e = bfu(ypre[(size_t)r * DM + c2]) / sqrtf(ss / 1024.f + LN_EPS) * (hf ? gr[c2 - 1024] : g5[c2]); const float got = bfu(ycat[(size_t)r * DM + c2]); if (fabsf(got - e) > 0.008f * fabsf(e) + 0.006f) atomicAdd(flagw + 1, 1u); }
        { float a = gb[c1]; for (int k = 0; k < DS5; ++k) a += bfu(yg[(size_t)r * DS5 + k]) * gw_[(size_t)k * DS5 + c1];
          const float e = bfu(yg[(size_t)r * DS5 + c1]) * fast_sigmoid(a); const float got = bfu(ypre[(size_t)r * DM + c1]); if (fabsf(got - e) > 0.008f * fabsf(e) + 0.006f) atomicAdd(flagw + 2, 1u); }
    }
}

__device__ __forceinline__ void diag_v(const float* const* in, const unsigned char* ws, const unsigned char* dout, unsigned* flagw, int gtid, int GT) {
    const bf16_t* h0 = (const bf16_t*)(ws + WS_HB); const bf16_t* ycat = (const bf16_t*)(ws + WS_YCAT); const float* V = (const float*)dout; const float *wo = in[25], *bo = in[26];
    for (int sidx = gtid; sidx < 16384; sidx += GT) { unsigned hsh = (unsigned)sidx * 2654435761u, h2 = ((unsigned)sidx + 977u) * 2246822519u; const int r = (hsh >> 8) % SEQ; const int c = (h2 >> 6) % DM;
        float a = bo[c] + DN_ALPHA * bfu(h0[(size_t)r * DM + c]); for (int k = 0; k < DM; ++k) a += bfu(ycat[(size_t)r * DM + k]) * wo[(size_t)k * DM + c];
        const float got = V[(size_t)r * DM + c]; if (fabsf(got - a) > 0.008f * fabsf(a) + 0.006f) atomicAdd(flagw + 0, 1u); }
}

__device__ __forceinline__ void diag_g(const float* const* in, const unsigned char* ws, unsigned* flagw, int gtid, int GT) {
    const bf16_t* XRp = (const bf16_t*)(ws + WS_XR); const bf16_t* G0 = (const bf16_t*)(ws + WS_G0); const bf16_t* G1 = (const bf16_t*)(ws + WS_G1);
    const float *convw = in[16], *convb = in[17], *wa = in[18], *ba = in[19], *wx = in[20], *bxx = in[21];
    for (int sidx = gtid; sidx < 16384; sidx += GT) { unsigned hsh = (unsigned)sidx * 2654435761u; unsigned h2 = ((unsigned)sidx + 12345u) * 2246822519u; const int t = (hsh >> 7) % SEQ; const int col = (h2 >> 5) % 4096;
        const int h = col >> 8, row = col & 255, bj = row >> 7, dir = (row >> 6) & 1, ch = row & 63;
        const float* W = (bj == 0 ? wa : wx) + ((size_t)(dir * 16 + h) * 64) * 64 + ch; float a = (bj == 0 ? ba : bxx)[(dir * 16 + h) * 64 + ch];
        for (int i = 0; i < 64; ++i) { const int c = 64 * h + i; float xc = convb[c];
            for (int j = 0; j < 4; ++j) xc += convw[j * 1024 + c] * bfu(XRp[(size_t)(t + j) * 1024 + c]);
            a += xc * W[(size_t)i * 64]; }
        const float got = bfu((t < 4096 ? G0 : G1)[(size_t)(t & 4095) * 4096 + col]);
        if (fabsf(got - a) > 0.008f * fabsf(a) + 0.006f) atomicAdd(flagw + 0, 1u); }
}

#ifndef DIAG_HALF
#define DIAG_HALF 1
#endif
__device__ __forceinline__ void diag_max(const unsigned char* ws, unsigned* flagw, int gtid, int GT) {
    const bf16_t* ycat = (const bf16_t*)(ws + WS_YCAT); float mx = 0.f;
    for (size_t i = gtid; i < (size_t)SEQ * 1024; i += GT) { const size_t r = i >> 10, c = (i & 1023) + DIAG_HALF * 1024; mx = fmaxf(mx, fabsf(bfu(ycat[r * DM + c]))); }
    atomicMax(flagw + 0, __float_as_uint(mx));
}

#ifndef DIAG_SEL
#define DIAG_SEL 4
#endif
__device__ __forceinline__ void diag_rows(const float* outp, unsigned* flagw, int gw, int NGW, int lane) {
    for (int row = gw; row < SEQ; row += NGW) { float mx = 0.f; for (int j = lane; j < DM; j += 64) mx = fmaxf(mx, fabsf(outp[(size_t)row * DM + j]));
#pragma unroll
        for (int o = 1; o < 64; o <<= 1) mx = fmaxf(mx, __shfl_xor(mx, o));
        if (lane == 0 && mx > 12.0f) { atomicAdd(flagw + 0, 1u); atomicMin(flagw + 1, (unsigned)row); atomicMax(flagw + 2, (unsigned)row); } }
}

__device__ __forceinline__ void diag_rows_bf(const bf16_t* p, int ld, float thr, unsigned* flagw, int gw, int NGW, int lane) {
    for (int row = gw; row < SEQ; row += NGW) { float mx = 0.f; for (int j = lane; j < ld; j += 64) mx = fmaxf(mx, fabsf(bfu(p[(size_t)row * ld + j])));
#pragma unroll
        for (int o = 1; o < 64; o <<= 1) mx = fmaxf(mx, __shfl_xor(mx, o));
        if (lane == 0 && mx > thr) { atomicAdd(flagw + 0, 1u); atomicMin(flagw + 1, (unsigned)row); atomicMax(flagw + 2, (unsigned)row); } }
}
template <int PHMASK> __global__ void __launch_bounds__(512, 2) mega(Args) {
    extern __shared__ __attribute__((aligned(16))) unsigned char lds_raw[];
    LAS unsigned char* lds = (LAS unsigned char*)lds_raw;
    const int wave = __builtin_amdgcn_readfirstlane((int)threadIdx.x >> 6);
    const int G = gridDim.x, bx = blockIdx.x;
    const int gw = bx * 8 + wave, NGW = G * 8, GT = G * 512;
#define PH_IDS const int lane = fresh_lane(), tid = wave * 64 + lane, gtid = bx * 512 + tid; (void)tid; (void)gtid; (void)lane
    const kin_t KIN = (kin_t)__builtin_amdgcn_kernarg_segment_ptr();
    unsigned char* ws = (unsigned char*)KIN[39]; unsigned char* dout = (unsigned char*)KIN[38];
    const int* kint = (const int*)0; (void)kint;
#if DIAG == 2
    const int lo = ((const __attribute__((address_space(4))) int*)KIN)[80], hi = 7;
#elif DIAG == 3
    const int lo = ((const __attribute__((address_space(4))) int*)KIN)[80], hi = 8;
#elif DIAG == 4
    const int lo = ((const __attribute__((address_space(4))) int*)KIN)[80], hi = 5;
#elif DIAG == 6
    const int lo = ((const __attribute__((address_space(4))) int*)KIN)[80], hi = 7;
#elif DIAG == 8
    const int lo = ((const __attribute__((address_space(4))) int*)KIN)[80], hi = 9;
#elif DIAG == 11 || DIAG == 12
    const int lo = ((const __attribute__((address_space(4))) int*)KIN)[80], hi = 10;
#else
    const int lo = ((const __attribute__((address_space(4))) int*)KIN)[80], hi = ((const __attribute__((address_space(4))) int*)KIN)[81];
#endif
#define IN(k) (((PHMASK >> (k)) & 1) && lo <= (k) && (k) < hi)
    unsigned nbar = 0; unsigned* gbar = (unsigned*)(ws + WS_CTR) + 32;
    if (PHMASK == 0xfff && lo == 0 && hi == NPHASE) cg::this_grid().sync();
#ifndef DBL_MASK
#define DBL_MASK 0
#endif
#define REPS(k) (((DBL_MASK >> (k)) & 1) ? 2 : 1)
#define SEAM(k) do { if (IN(k) && IN((k) + 1)) { ++nbar; grid_barrier(gbar, nbar * (unsigned)G, wave); if (TSTAMP && bx == 0 && wave == 0) { if (fresh_lane() == 0) ((unsigned long long*)(ws + WS_CTR + 1024))[(k) + 1] = __builtin_amdgcn_s_memrealtime(); } } } while (0)

#define MK_RG const RgCtx RG{(const bf16_t*)(ws + WS_XR), (const bf16_t*)(ws + WS_G0), (const bf16_t*)(ws + WS_G1), (const bf16_t*)(dout + DO_Z), KIN[16], KIN[17], (const float*)(ws + WS_SP), (float*)(ws + WS_AGG), (bf16_t*)(dout + DO_YPRE)}
    if (TSTAMP && bx == 0 && wave == 0) { if (fresh_lane() == 0) ((unsigned long long*)(ws + WS_CTR + 1024))[0] = __builtin_amdgcn_s_memrealtime(); }
    for (int rep = 0; rep < REPS(0); ++rep) {
    if (IN(0)) { PH_IDS;
        if (G != 256) { for (int g = bx; g < 64; g += G) s5_precompute(KIN, ws, g, 0, 1, (LAS float*)lds, tid); }
        {
            LAS float* scr = (LAS float*)(lds + wave * 16640);
            constexpr int I_IN = (DM / 64) * (DIN / 64), I_OUT = (DM / 64) * (DM / 64), I_PG = I_OUT, I_GLU = (DS5 / 64) * (DS5 / 64), I_PW = (PLE / 64) * (DM / 64), I_LN = SEQ / 8;
            constexpr int NITEMS = I_IN + I_OUT + I_PG + I_GLU + I_PW + I_LN;
            for (int it = gw; it < NITEMS; it += NGW) {
                int r = it;
                if (r < I_IN) { transpose_item(KIN[4], DM, DIN, (bf16_t*)(ws + WS_WINT), scr, r, lane); continue; } r -= I_IN;
                if (r < I_LN) { for (int q = 0; q < 8; ++q) { const int row = r * 8 + q; ln_row<true>(KIN[0] + (size_t)row * DM, KIN[2], KIN[3], (bf16_t*)(ws + WS_HB) + (size_t)row * DM, lane); } continue; } r -= I_LN;
                if (r < I_OUT) { transpose_item(KIN[25], DM, DM, (bf16_t*)(ws + WS_WOUTT), scr, r, lane); continue; } r -= I_OUT;
                if (r < I_PG) { transpose_item(KIN[34], DM, DM, (bf16_t*)(ws + WS_PLEGT), scr, r, lane); continue; } r -= I_PG;
                if (r < I_GLU) { transpose_item(KIN[14], DS5, DS5, (bf16_t*)(ws + WS_GLUT), scr, r, lane); continue; } r -= I_GLU;
                transpose_item(KIN[33], PLE, DM, (bf16_t*)(ws + WS_PLEWT), scr, r, lane);
            }
        }
        {   const float* pp = KIN[1]; bf16_t* pb = (bf16_t*)(ws + WS_PB);
            for (int i = gtid; i < SEQ * PLE / 4; i += GT) { const f32x4 v = ((const f32x4*)pp)[i]; u32x2 w; w.x = cvt_pk_bf16(v[0], v[1]); w.y = cvt_pk_bf16(v[2], v[3]); ((u32x2*)pb)[i] = w; }
            const float *convw = KIN[16], *convb = KIN[17], *wa = KIN[18], *ba = KIN[19], *wx = KIN[20], *bxx = KIN[21], *lam = KIN[22];
            bf16_t* rgw = (bf16_t*)(ws + WS_RGW);
            for (int i = gtid; i < 16 * 256 * 32; i += GT) { const int h = i >> 13, row = (i >> 5) & 255, K0 = (i & 31) * 8, j = K0 >> 6, i0 = K0 & 63, ch = row >> 2, bj = (row >> 1) & 1, dir = row & 1;
                const float* W = (bj == 0 ? wa : wx) + ((size_t)(dir * 16 + h) * 64) * 64 + ch; float v[8];
#pragma unroll
                for (int k = 0; k < 8; ++k) v[k] = convw[j * 1024 + 64 * h + i0 + k] * W[(size_t)(i0 + k) * 64];
                u32x4 w; w.x = cvt_pk_bf16(v[0], v[1]); w.y = cvt_pk_bf16(v[2], v[3]); w.z = cvt_pk_bf16(v[4], v[5]); w.w = cvt_pk_bf16(v[6], v[7]);
                *(u32x4*)(rgw + ((size_t)h * 256 + row) * 256 + K0) = w; }
            float* rgb = (float*)(ws + WS_RGBIAS);
            for (int i = gtid; i < 16 * 256; i += GT) { const int h = i >> 8, row = i & 255, ch = row >> 2, bj = (row >> 1) & 1, dir = row & 1;
                const float* W = (bj == 0 ? wa : wx) + ((size_t)(dir * 16 + h) * 64) * 64 + ch; float s = (bj == 0 ? ba : bxx)[(dir * 16 + h) * 64 + ch];
                for (int k = 0; k < 64; ++k) s += convb[64 * h + k] * W[(size_t)k * 64];
                rgb[i] = s; }
            float* spt = (float*)(ws + WS_SP);
            for (int i = gtid; i < 2 * 1024; i += GT) spt[i] = -8.0f * log1pf(expf(-lam[i]));
            unsigned* xr = (unsigned*)(ws + WS_XR);
            for (int i = gtid; i < 1024; i += GT) { xr[i] = 0u; xr[(size_t)(SEQ + 2) * 512 + i] = 0u; }
        }
    }
    if (rep + 1 < REPS(0)) { ++nbar; grid_barrier(gbar, nbar * (unsigned)G, wave); } }
    SEAM(0);
    for (int rep = 0; rep < REPS(1); ++rep) {
    if (IN(1)) { PH_IDS;
        SchedStd S; S.so.init(SEQ, DIN, G, bx); S.A = (const char*)(ws + WS_HB); S.B = (const char*)(ws + WS_WINT); S.a_tile = (size_t)256 * DM * 2; S.b_tile = (size_t)256 * DM * 2;
        EpiProj E{(bf16_t*)(dout + DO_U), (bf16_t*)(ws + WS_XR), (bf16_t*)(dout + DO_Z), KIN[5]};
        GEMM_PHASE(lds, wave, GParm{DM, DM * 2, 128, 64, 0}, S, E);
        if (G == 256 && bx >= 128) { __syncthreads(); const int t2 = wave * 64 + fresh_lane(); s5_precompute(KIN, ws, (bx - 128) >> 1, (bx - 128) & 1, 2, (LAS float*)lds, t2); }
    }
    if (rep + 1 < REPS(1)) { ++nbar; grid_barrier(gbar, nbar * (unsigned)G, wave); } }
    SEAM(1);
    for (int rep = 0; rep < REPS(2); ++rep) {
    if (IN(2)) { PH_IDS;
        { SchedS5a S{(const char*)(dout + DO_U), (const char*)(ws + WS_WG), G, bx}; EpiS5a E{(bf16_t*)(ws + WS_YINTRA), (float*)(ws + WS_S)};
          GEMM_PHASE(lds, wave, GParm{512, 1024, 128, 64, 0}, S, E); }
        { SchedRG S{(const char*)(ws + WS_XR), (const char*)(ws + WS_RGW), G, bx}; EpiG E{(bf16_t*)(ws + WS_G0), (bf16_t*)(ws + WS_G1), (const float*)(ws + WS_RGBIAS)};
          GEMM_PHASE(lds, wave, GParm{256, 2048, 2048, 64, 0}, S, E); }
    }
    if (rep + 1 < REPS(2)) { ++nbar; grid_barrier(gbar, nbar * (unsigned)G, wave); } }
    SEAM(2);
    for (int rep = 0; rep < REPS(3); ++rep) {
    if (IN(3)) { PH_IDS;
        if (bx < 128) {
            const int g = bx >> 1, n = bx & 1; const float* Sg = (const float*)(ws + WS_S) + (size_t)g * NCH * 256 + n * 128; LAS float* Ls = (LAS float*)lds;
            for (int i = tid; i < NCH * 32; i += 512) { const int c = i >> 5, q4 = (i & 31) * 4; *(LAS f32x4*)(Ls + c * 128 + q4) = *(const f32x4*)(Sg + (size_t)c * 256 + q4); }
            __syncthreads();
            if (wave == 0) { const int p = lane, pi = (n * 64 + g) * 64 + p;
                const float lr = fminf(KIN[6][pi], -1e-4f), li = KIN[7][pi], step = expf(KIN[8][n * 64 + g]); float ar, ai; cpow(lr * step, li * step, TC, ar, ai);
                bf16_t* hp = (bf16_t*)(ws + WS_HPREV) + (size_t)g * NCH * 256 + n * 128; float hr = 0.f, him = 0.f;
                for (int cc = 0; cc < NCH; ++cc) { const int c = n == 0 ? cc : NCH - 1 - cc;
                    hp[(size_t)c * 256 + p] = (bf16_t)(cvt_pk_bf16(hr, 0.f) & 0xffffu); hp[(size_t)c * 256 + 64 + p] = (bf16_t)(cvt_pk_bf16(him, 0.f) & 0xffffu);
                    const float sr = Ls[c * 128 + p], si = Ls[c * 128 + 64 + p]; const float nr = ar * hr - ai * him + sr, ni = ar * him + ai * hr + si; hr = nr; him = ni; } }
            __syncthreads();
        }
        { MK_RG; for (int un = bx; un < 256; un += G) rg_pass_a(RG, un & 1, un >> 1, tid); }
    }
    if (rep + 1 < REPS(3)) { ++nbar; grid_barrier(gbar, nbar * (unsigned)G, wave); } }
    SEAM(3);
    for (int rep = 0; rep < REPS(4); ++rep) {
    if (IN(4)) { PH_IDS;
#if NAIVE_S5
        if (gw < 64) naive_s5_group((const float* const*)0, (const bf16_t*)(dout + DO_U), (float*)(ws + WS_YINTRA), (bf16_t*)(ws + WS_YS5G), gw, lane);
#else
        { SchedS5b S{(const char*)(ws + WS_HPREV), (const char*)(ws + WS_WC), G, bx}; EpiS5b E{(const bf16_t*)(ws + WS_YINTRA), (bf16_t*)(ws + WS_YS5G)};
          GEMM_PHASE(lds, wave, GParm{256, 512, 128, 64, 0}, S, E); }
#endif
#if NAIVE_RG
        { MK_RG; if (gtid < 1024) naive_rg_channel(RG, gtid); }
#else
        { MK_RG; __syncthreads(); for (int un = bx; un < 256; un += G) { rg_pass_c(RG, un & 1, un >> 1, tid, (LAS float*)lds); __syncthreads(); } }
#endif
    }
    if (rep + 1 < REPS(4)) { ++nbar; grid_barrier(gbar, nbar * (unsigned)G, wave); } }
    SEAM(4);
    for (int rep = 0; rep < REPS(5); ++rep) {
    if (IN(5)) { PH_IDS;
        SchedStd S; S.so.init(SEQ, DS5, G, bx); S.A = (const char*)(ws + WS_YS5G); S.B = (const char*)(ws + WS_GLUT); S.a_tile = (size_t)256 * 16 * 2; S.b_tile = (size_t)256 * DS5 * 2;
        EpiGlu E{(const bf16_t*)(ws + WS_YS5G), (bf16_t*)(dout + DO_YPRE), KIN[15]};
        GEMM_PHASE(lds, wave, GParm{DS5, 32, 4u * GM_STRIDE * 2u, 16, GM_STRIDE}, S, E);
        if (G == 256 && bx >= 128) {
            LAS float* scr = (LAS float*)(lds + wave * 16640); constexpr int I_FF1 = (DM / 64) * (DFF / 64);
            for (int it = (bx - 128) * 8 + wave; it < I_FF1; it += 1024) transpose_item(KIN[29], DM, DFF, (bf16_t*)(ws + WS_FF1T), scr, it, lane); }
    }
    if (rep + 1 < REPS(5)) { ++nbar; grid_barrier(gbar, nbar * (unsigned)G, wave); } }
    SEAM(5);
    for (int rep = 0; rep < REPS(6); ++rep) {
    if (IN(6)) { PH_IDS;
        const float *g5 = KIN[23], *gr = KIN[24];
        for (int row = gw; row < SEQ; row += NGW) { const u32x4* yr = (const u32x4*)(dout + DO_YPRE) + (size_t)row * 256; u32x4* oc = (u32x4*)(ws + WS_YCAT) + (size_t)row * 256;
            u32x4 w[4]; float s0 = 0.f, s1 = 0.f;
#pragma unroll
            for (int j = 0; j < 4; ++j) { w[j] = yr[lane + 64 * j]; const float q = bf_lo(w[j].x) * bf_lo(w[j].x) + bf_hi(w[j].x) * bf_hi(w[j].x) + bf_lo(w[j].y) * bf_lo(w[j].y) + bf_hi(w[j].y) * bf_hi(w[j].y)
                + bf_lo(w[j].z) * bf_lo(w[j].z) + bf_hi(w[j].z) * bf_hi(w[j].z) + bf_lo(w[j].w) * bf_lo(w[j].w) + bf_hi(w[j].w) * bf_hi(w[j].w); if (j < 2) s0 += q; else s1 += q; }
            const float r0 = 1.0f / sqrtf(wave_sum(s0) * (1.f / 1024.f) + LN_EPS), r1 = 1.0f / sqrtf(wave_sum(s1) * (1.f / 1024.f) + LN_EPS);
#pragma unroll
            for (int j = 0; j < 4; ++j) { const int col = (lane + 64 * j) * 8; const float rs = j < 2 ? r0 : r1; const float* gp = j < 2 ? g5 + col : gr + (col - 1024);
                const f32x4 ga = *(const f32x4*)gp, gb = *(const f32x4*)(gp + 4);
                u32x4 o; o.x = cvt_pk_bf16(bf_lo(w[j].x) * rs * ga[0], bf_hi(w[j].x) * rs * ga[1]); o.y = cvt_pk_bf16(bf_lo(w[j].y) * rs * ga[2], bf_hi(w[j].y) * rs * ga[3]);
                o.z = cvt_pk_bf16(bf_lo(w[j].z) * rs * gb[0], bf_hi(w[j].z) * rs * gb[1]); o.w = cvt_pk_bf16(bf_lo(w[j].w) * rs * gb[2], bf_hi(w[j].w) * rs * gb[3]); oc[lane + 64 * j] = o; } }
        {
            LAS float* scr = (LAS float*)(lds + wave * 16640);
            constexpr int I_FF1 = (DM / 64) * (DFF / 64), I_FF2 = (DFF / 64) * (DM / 64);
            for (int it = gw; it < (G == 256 ? I_FF2 : I_FF1 + I_FF2); it += NGW) {
                if (it < I_FF2) transpose_item(KIN[31], DFF, DM, (bf16_t*)(ws + WS_FF2T), scr, it, lane);
                else transpose_item(KIN[29], DM, DFF, (bf16_t*)(ws + WS_FF1T), scr, it - I_FF2, lane); }
        }
    }
    if (rep + 1 < REPS(6)) { ++nbar; grid_barrier(gbar, nbar * (unsigned)G, wave); } }
    SEAM(6);
    for (int rep = 0; rep < REPS(7); ++rep) {
    if (IN(7)) { PH_IDS;
        SchedStd S; S.so.init(SEQ, DM, G, bx); S.A = (const char*)(ws + WS_YCAT); S.B = (const char*)(ws + WS_WOUTT); S.a_tile = (size_t)256 * DM * 2; S.b_tile = (size_t)256 * DM * 2;
        EpiResLn1 E{(bf16_t*)(ws + WS_HB), KIN[26], KIN[27], KIN[28], PanelStats8{(unsigned long long*)(ws + WS_AGG), (unsigned*)(ws + WS_CTR) + 1024, LN_EPS}};
        GEMM_PHASE(lds, wave, GParm{DM, DM * 2, 128, 64, 0}, S, E);
    }
    if (rep + 1 < REPS(7)) { ++nbar; grid_barrier(gbar, nbar * (unsigned)G, wave); } }
    for (int rep = 0; rep < REPS(8); ++rep) {
    if (IN(8)) { }
    if (rep + 1 < REPS(8)) { ++nbar; grid_barrier(gbar, nbar * (unsigned)G, wave); } }
    SEAM(8);
    for (int rep = 0; rep < REPS(9); ++rep) {
    if (IN(9)) { PH_IDS;
        { SchedStd S; S.so.init(SEQ, DFF, G, bx); S.A = (const char*)(ws + WS_HB); S.B = (const char*)(ws + WS_FF1T); S.a_tile = (size_t)256 * DM * 2; S.b_tile = (size_t)256 * DM * 2;
          EpiPlain<1> E{(bf16_t*)(ws + WS_T), DFF, KIN[30]}; GEMM_PHASE(lds, wave, GParm{DM, DM * 2, 128, 64, 0}, S, E); }
        { SchedStd S; S.so.init(SEQ, DM, G, bx); S.A = (const char*)(ws + WS_HB); S.B = (const char*)(ws + WS_PLEGT); S.a_tile = (size_t)256 * DM * 2; S.b_tile = (size_t)256 * DM * 2;
          EpiPlain<2> E{(bf16_t*)(dout + DO_SG), DM, KIN[35]}; GEMM_PHASE(lds, wave, GParm{DM, DM * 2, 128, 64, 0}, S, E); }
        { SchedStd S; S.so.init(SEQ, DM, G, bx); S.A = (const char*)(ws + WS_PB); S.B = (const char*)(ws + WS_PLEWT); S.a_tile = (size_t)256 * PLE * 2; S.b_tile = (size_t)256 * PLE * 2;
          EpiPlain<0> E{(bf16_t*)(dout + DO_PW), DM, nullptr}; GEMM_PHASE(lds, wave, GParm{PLE, PLE * 2, 128, 64, 0}, S, E); }
    }
    if (rep + 1 < REPS(9)) { ++nbar; grid_barrier(gbar, nbar * (unsigned)G, wave); } }
    SEAM(9);
    for (int rep = 0; rep < REPS(10); ++rep) {
    if (IN(10)) { PH_IDS;
        SchedStd S; S.so.init(SEQ, DM, G, bx); S.A = (const char*)(ws + WS_T); S.B = (const char*)(ws + WS_FF2T); S.a_tile = (size_t)256 * DFF * 2; S.b_tile = (size_t)256 * DFF * 2;
        EpiRes<true> E{(const bf16_t*)(ws + WS_HB), KIN[32], (float*)(ws + WS_V2), (const bf16_t*)(dout + DO_SG), (const bf16_t*)(dout + DO_PW)};
        GEMM_PHASE(lds, wave, GParm{DFF, DFF * 2, 128, 64, 0}, S, E);
    }
    if (rep + 1 < REPS(10)) { ++nbar; grid_barrier(gbar, nbar * (unsigned)G, wave); } }
    SEAM(10);
    for (int rep = 0; rep < REPS(11); ++rep) {
    if (IN(11)) { PH_IDS; for (int row = gw; row < SEQ; row += NGW) ln_row<false>((const float*)(ws + WS_V2) + (size_t)row * DM, KIN[36], KIN[37], ((float*)KIN[38]) + (size_t)row * DM, lane); }
    if (rep + 1 < REPS(11)) { ++nbar; grid_barrier(gbar, nbar * (unsigned)G, wave); } }
#if TSTAMP
    if (bx == 0 && wave == 0) { if (fresh_lane() == 0) { unsigned long long* st = (unsigned long long*)(ws + WS_CTR + 1024); st[12] = __builtin_amdgcn_s_memrealtime();
        ((float*)KIN[38])[0] = (float)(long long)(__hip_atomic_load(st + TS_A1, __ATOMIC_RELAXED, __HIP_MEMORY_SCOPE_AGENT) - __hip_atomic_load(st + TS_A0, __ATOMIC_RELAXED, __HIP_MEMORY_SCOPE_AGENT)) * 0.01f; } }
#endif
#if DIAG
    { ++nbar; grid_barrier(gbar, nbar * (unsigned)G, wave); PH_IDS; unsigned* flagw = (unsigned*)(ws + WS_CTR) + 48;
#if DIAG == 1
      diag_ffn((const float* const*)0, ws, ((float*)KIN[38]), flagw, gtid, GT);
#elif DIAG == 2
      diag_pre((const float* const*)0, ws, dout, flagw, gtid, GT);
#elif DIAG == 3
      diag_v((const float* const*)0, ws, dout, flagw, gtid, GT);
#elif DIAG == 4
      diag_g((const float* const*)0, ws, flagw, gtid, GT);
#elif DIAG == 6
      diag_max(ws, flagw, gtid, GT);
#else
      if (bx == 0 && tid == 0) flagw[1] = 0xffffffffu;
      ++nbar; grid_barrier(gbar, nbar * (unsigned)G, wave);
#if DIAG == 7
      diag_rows(((float*)KIN[38]), flagw, gw, NGW, lane);
#elif DIAG == 8
      diag_rows_bf((const bf16_t*)(ws + WS_HB), DM, 12.0f, flagw, gw, NGW, lane);
#elif DIAG == 9
      diag_rows((const float*)(ws + WS_V2), flagw, gw, NGW, lane);
#elif DIAG == 10
      diag_rows_bf((const bf16_t*)(ws + WS_T), DFF, 150.0f, flagw, gw, NGW, lane);
#elif DIAG == 11
      diag_rows_bf((const bf16_t*)(dout + DO_PW), DM, 8.0f, flagw, gw, NGW, lane);
#elif DIAG == 12
      diag_rows_bf((const bf16_t*)(dout + DO_SG), DM, 1.01f, flagw, gw, NGW, lane);
#endif
#endif
      ++nbar; grid_barrier(gbar, nbar * (unsigned)G, wave);
#if DIAG != 1
      for (int i = gtid; i < SEQ * DM; i += GT) ((float*)KIN[38])[i] = 0.f;
      ++nbar; grid_barrier(gbar, nbar * (unsigned)G, wave);
#endif
      if (bx == 0 && tid == 0) { unsigned code = 0; for (int q = 0; q < 4; ++q) if (__hip_atomic_load(flagw + q, __ATOMIC_RELAXED, __HIP_MEMORY_SCOPE_AGENT) > 100u) code |= 1u << q; if (DIAG >= 7) { const unsigned cnt = __hip_atomic_load(flagw, __ATOMIC_RELAXED, __HIP_MEMORY_SCOPE_AGENT), mn = __hip_atomic_load(flagw + 1, __ATOMIC_RELAXED, __HIP_MEMORY_SCOPE_AGENT), mxr = __hip_atomic_load(flagw + 2, __ATOMIC_RELAXED, __HIP_MEMORY_SCOPE_AGENT);
          const unsigned v = DIAG_SEL == 0 ? cnt : DIAG_SEL == 1 ? mn / 100u : DIAG_SEL == 2 ? mn % 100u : DIAG_SEL == 3 ? mxr / 100u : mxr % 100u; ((float*)KIN[38])[0] = 100.0f * (float)(v + 1u); }
      else ((float*)KIN[38])[0] = (DIAG == 6) ? 1000.0f * __uint_as_float(__hip_atomic_load(flagw, __ATOMIC_RELAXED, __HIP_MEMORY_SCOPE_AGENT)) : 1000.0f * (float)(code + 16u); } }
#endif
#undef IN
#undef SEAM
}


#if PER_PHASE_LAUNCH
template <int PH> static void set_attr_one() { (void)hipFuncSetAttribute((const void*)mega<(1 << PH)>, hipFuncAttributeMaxDynamicSharedMemorySize, LDS_BYTES); }
template <int PH> static void launch_one(Args a, int grid, hipStream_t stream) { a.ph_lo = PH; a.ph_hi = PH + 1; hipLaunchKernelGGL(mega<(1 << PH)>, dim3(grid), dim3(512), LDS_BYTES, stream, a); }
static void set_attrs() { set_attr_one<0>(); set_attr_one<1>(); set_attr_one<2>(); set_attr_one<3>(); set_attr_one<4>(); set_attr_one<5>(); set_attr_one<6>(); set_attr_one<7>(); set_attr_one<8>(); set_attr_one<9>(); set_attr_one<10>(); set_attr_one<11>(); }
static void launch_phases(const Args& a, int grid, hipStream_t stream) { launch_one<0>(a, grid, stream); launch_one<1>(a, grid, stream); launch_one<2>(a, grid, stream); launch_one<3>(a, grid, stream); launch_one<4>(a, grid, stream); launch_one<5>(a, grid, stream);
    launch_one<6>(a, grid, stream); launch_one<7>(a, grid, stream); launch_one<8>(a, grid, stream); launch_one<9>(a, grid, stream); launch_one<10>(a, grid, stream); launch_one<11>(a, grid, stream); }
#else
static void set_attrs() { (void)hipFuncSetAttribute((const void*)mega<0xfff>, hipFuncAttributeMaxDynamicSharedMemorySize, LDS_BYTES); }
#endif

extern "C" void kernel_launch(void* const* d_in, const int* in_sizes, int n_in, void* d_out, int out_size, void* d_ws, size_t ws_size, hipStream_t stream) {
    static int grid = 0;
    if (grid == 0) {
        if (n_in != 38 || out_size != SEQ * DM || ws_size < WS_END) { fprintf(stderr, "kernel_launch: unexpected shapes (n_in %d out %d ws %zu)\n", n_in, out_size, ws_size); grid = -1; return; }
        int dev = 0, cus = 0, per_cu = 0;
        hipGetDevice(&dev); hipDeviceGetAttribute(&cus, hipDeviceAttributeMultiprocessorCount, dev);
        set_attrs();
        per_cu = 1;
        (void)hipGetLastError();
        if (per_cu < 1) per_cu = 1;
        grid = cus;
    }
    if (grid < 0) return;
#ifdef POISON_NAN
    hipMemsetAsync(d_ws, 0xFF, WS_END, stream); hipMemsetAsync(d_out, 0xFF, (size_t)64 * MiB, stream);
#endif
    hipMemsetAsync((char*)d_ws + WS_CTR, 0, 32768, stream);
    Args a{};
    for (int i = 0; i < 38; ++i) a.in[i] = (const float*)d_in[i];
    a.out = (float*)d_out; a.ws = (unsigned char*)d_ws;
#if PER_PHASE_LAUNCH
    launch_phases(a, grid, stream);
#else
    a.ph_lo = 0; a.ph_hi = NPHASE;
    void* kargs[] = {&a};
    hipError_t e = hipLaunchCooperativeKernel((const void*)mega<0xfff>, dim3(grid), dim3(512), kargs, LDS_BYTES, stream);
    if (e != hipSuccess) fprintf(stderr, "cooperative launch failed: %s (grid %d)\n", hipGetErrorString(e), grid);
#endif
}
```

```cpp
#include <hip/hip_runtime.h>
#include <hip/hip_cooperative_groups.h>
#include <cstdio>
#include <cstdint>
namespace cg = cooperative_groups;

#ifndef PER_PHASE_LAUNCH
#define PER_PHASE_LAUNCH 0
#endif

#ifndef TSTAMP
#define TSTAMP 0
#define TS_A0 22
#define TS_A1 23
#define TS_B0 9
#define TS_B1 12
#endif
#define LAS __attribute__((address_space(3)))
typedef unsigned short bf16_t;
typedef short bf16x8 __attribute__((ext_vector_type(8)));
typedef float f32x4 __attribute__((ext_vector_type(4)));
typedef float f32x2 __attribute__((ext_vector_type(2)));
typedef unsigned u32x4 __attribute__((ext_vector_type(4)));
typedef unsigned u32x2 __attribute__((ext_vector_type(2)));

constexpr int SEQ = 8192, DM = 2048, DIN = 3072, DS5 = 1024, DRG = 1024, NG = 64, NP = 64, NK = 16, NH = 16, HD = 64, DFF = 8192, PLE = 256;
constexpr int TC = 32, NCH = SEQ / TC;
constexpr float LN_EPS = 1e-5f, DN_ALPHA = 1.18920711500272f;
constexpr int NPHASE = 12;

constexpr size_t MiB = (size_t)1 << 20;
constexpr size_t WS_FF2T = 0, WS_HB = 32 * MiB, WS_FF1T = 64 * MiB, WS_PLEGT = 96 * MiB, WS_PLEWT = 104 * MiB, WS_PB = 105 * MiB, WS_WOUTT = 109 * MiB,
    WS_V2 = 64 * MiB, WS_G0 = 0, WS_G1 = 64 * MiB,
    WS_WG = 128 * MiB, WS_WC = 176 * MiB, WS_RGW = 192 * MiB, WS_GLUT = 194 * MiB, WS_XR = 196 * MiB, WS_YINTRA = 213 * MiB, WS_S = 229 * MiB, WS_HPREV = 245 * MiB, WS_WINT = 229 * MiB,
    WS_YS5G = 128 * MiB, WS_YCAT = 144 * MiB, WS_T = 128 * MiB,
    WS_AGG = 256 * MiB, WS_CARRY = 258 * MiB, WS_SUMSQ = 259 * MiB, WS_RGBIAS = 259 * MiB + 64 * 1024, WS_SP = WS_RGBIAS + 16 * 1024, WS_CTR = WS_SP + 8 * 1024, WS_END = 260 * MiB;
constexpr size_t DO_YPRE = 0, DO_Z = 32 * MiB, DO_U = 48 * MiB, DO_SG = 0, DO_PW = 32 * MiB;
constexpr int GM_STRIDE = SEQ * 16;
constexpr int LDS_BYTES = 152 * 1024;

typedef __bf16 bf16x2_t __attribute__((ext_vector_type(2)));
__device__ __forceinline__ unsigned cvt_pk_bf16(float lo, float hi) { const f32x2 v = {lo, hi}; const bf16x2_t b = __builtin_convertvector(v, bf16x2_t); return __builtin_bit_cast(unsigned, b); }
__device__ __forceinline__ float bf_lo(unsigned w) { return __uint_as_float(w << 16); }
__device__ __forceinline__ float bf_hi(unsigned w) { return __uint_as_float(w & 0xffff0000u); }
__device__ __forceinline__ f32x4 bf4(u32x2 w) { return (f32x4){bf_lo(w.x), bf_hi(w.x), bf_lo(w.y), bf_hi(w.y)}; }
__device__ __forceinline__ float fast_sigmoid(float x) { return __builtin_amdgcn_rcpf(1.0f + __expf(-x)); }
__device__ __forceinline__ float gelu_tanh(float x) { const float u = 1.5957691216057308f * (x + 0.044715f * x * x * x); return x * fast_sigmoid(u); }
__device__ __forceinline__ float wave_sum(float v) {
#pragma unroll
    for (int o = 1; o < 64; o <<= 1) v += __shfl_xor(v, o);
    return v;
}
__device__ __forceinline__ int lane_id() { return (int)__builtin_amdgcn_mbcnt_hi(~0u, __builtin_amdgcn_mbcnt_lo(~0u, 0u)); }
__device__ __forceinline__ int fresh_lane() { unsigned z = 0; asm volatile("" : "+s"(z)); return (int)__builtin_amdgcn_mbcnt_hi(~0u, __builtin_amdgcn_mbcnt_lo(~0u, z)); }
#define LDS_WAIT() asm volatile("s_waitcnt lgkmcnt(0)" ::: "memory")

namespace pg8 {
constexpr int BM = 256, BK = 64, HALF = 128, HTB = HALF * BK * 2, STAGE_BYTES = 8 * HTB, NXCD = 8, WGM = 8;
__host__ __device__ __forceinline__ int lds_byte(int r, int c) { const int st = (r >> 4) * 2 + (c >> 5), rr = r & 15, cc = c & 31, ob = rr * 64 + cc * 2; return st * 1024 + (ob ^ (((ob >> 9) & 1) << 5)); }
__host__ __device__ __forceinline__ void stage_rc(int b, int& R, int& C) { const int st = b / 1024, sb = b % 1024, swz = sb ^ (((sb >> 9) & 1) << 5); R = (st >> 1) * 16 + swz / 64; C = (st & 1) * 32 + (swz % 64) / 2; }
__host__ __device__ __forceinline__ int perm32(int rho) { const int n = rho >> 4, i = rho & 15; return 8 * (i >> 2) + 4 * n + (i & 3); }

struct Unit { int pm, pn; };
struct StaticOrder {
    int nM, nN, nwg, G, c;
    __host__ __device__ void init(int M, int N, int G_, int c_) { nM = M / BM; nN = N / BM; nwg = nM * nN; G = G_; c = c_; }
    __host__ __device__ bool next(int i, Unit& u) const {
        const long L = (long)i * G + c; if (L >= nwg) return false;
        int wgid = (int)L; { const int q = nwg / NXCD, r = nwg % NXCD, xcd = wgid % NXCD, off = wgid / NXCD; wgid = (xcd < r ? xcd * (q + 1) : r * (q + 1) + (xcd - r) * q) + off; }
        const int nig = WGM * nN, gid = wgid / nig, fm = gid * WGM, gsz = (nM - fm) < WGM ? (nM - fm) : WGM;
        u.pm = fm + ((wgid % nig) % gsz); u.pn = (wgid % nig) / gsz; return true;
    }
};
struct GUnit { const char* A; const char* B; int i0, i1; };
struct GParm { int K; unsigned a_rs, a_ks; int a_cw, a_cs; };

template <class Epi, class Sched>
__device__ __forceinline__ void gemm_phase(LAS unsigned char* lds, const int wid, const GParm gp, const Sched& S, const Epi& E) {
    const int lane = fresh_lane(), tid = wid * 64 + lane, wr = wid >> 2, wc = wid & 3, fr = lane & 15, fq = lane >> 4;
    const int K = gp.K, nt = K / BK;
    unsigned voffA[2], voffB[2];
#pragma unroll
    for (int i = 0; i < 2; ++i) { int R, C; stage_rc(tid * 16 + i * 8192, R, C); const int Rb = Epi::PERM ? ((R & ~31) + perm32(R & 31)) : R;
        voffA[i] = (unsigned)R * gp.a_rs + (unsigned)((C / gp.a_cw) * gp.a_cs + (C % gp.a_cw)) * 2u; voffB[i] = (unsigned)(Rb * K + C) * 2u; }
    const size_t ksA = gp.a_ks, ksB = (size_t)(BK * 2);
    const size_t hsA = (size_t)HALF * gp.a_rs, hsB = (size_t)HALF * K * 2;
    const unsigned ldsw = (unsigned)wid * 1024u;
    const int aoff = lds_byte(wr * 64 + fr, fq * 8), boff = lds_byte(wc * 32 + fr, fq * 8);
#define PG8_SA(b, h) (((b) * 2 + (h)) * HTB)
#define PG8_SB(b, h) ((4 + (b) * 2 + (h)) * HTB)
#define PG8_STAGE(bufoff, gbase, voff) do { _Pragma("unroll") for (int _i = 0; _i < 2; ++_i) \
        __builtin_amdgcn_global_load_lds((const unsigned*)((const char*)(gbase) + (voff)[_i]), (LAS unsigned*)(lds + (bufoff) + ldsw + _i * 8192), 16, 0, 0); } while (0)
#define PG8_LDA(dst, b, h) do { _Pragma("unroll") for (int m = 0; m < 4; ++m) _Pragma("unroll") for (int k = 0; k < 2; ++k) dst[m][k] = *(const LAS bf16x8*)(lds + PG8_SA(b, h) + aoff + m * 2048 + k * 1024); } while (0)
#define PG8_LDB(dst, b, h) do { _Pragma("unroll") for (int n = 0; n < 2; ++n) _Pragma("unroll") for (int k = 0; k < 2; ++k) dst[n][k] = *(const LAS bf16x8*)(lds + PG8_SB(b, h) + boff + n * 2048 + k * 1024); } while (0)
#define PG8_MMA(ai, bj, At, Bt) do { __builtin_amdgcn_s_setprio(1); _Pragma("unroll") for (int m = 0; m < 4; ++m) _Pragma("unroll") for (int n = 0; n < 2; ++n) _Pragma("unroll") for (int k = 0; k < 2; ++k) \
        acc[ai][bj][m][n] = __builtin_amdgcn_mfma_f32_16x16x32_bf16(Bt[n][k], At[m][k], acc[ai][bj][m][n], 0, 0, 0); __builtin_amdgcn_s_setprio(0); } while (0)
#define PG8_WAIT_V(n) asm volatile("s_waitcnt vmcnt(" #n ")" ::: "memory")
#define PG8_WAIT_L(n) asm volatile("s_waitcnt lgkmcnt(" #n ")" ::: "memory")
#define PG8_BAR __builtin_amdgcn_s_barrier()
#define PG8_SCHED __builtin_amdgcn_sched_barrier(0)
    GUnit cur, nxt; int ui = 0;
    if (!S.next(0, cur)) return;
    f32x4 acc[2][2][4][2];
#pragma unroll
    for (int a = 0; a < 2; ++a)
#pragma unroll
        for (int b = 0; b < 2; ++b)
#pragma unroll
            for (int m = 0; m < 4; ++m)
#pragma unroll
                for (int n = 0; n < 2; ++n) acc[a][b][m][n] = (f32x4){0.f, 0.f, 0.f, 0.f};
    bf16x8 At[4][2], B0[2][2], B1[2][2];
    const char* cA = cur.A; const char* cB = cur.B;
    PG8_STAGE(PG8_SB(0, 0), cB, voffB); PG8_STAGE(PG8_SB(0, 1), cB + hsB, voffB); PG8_STAGE(PG8_SA(0, 0), cA, voffA); PG8_STAGE(PG8_SA(0, 1), cA + hsA, voffA);
    if (wr == 1) PG8_BAR;
    PG8_WAIT_V(2); PG8_BAR;
    PG8_STAGE(PG8_SB(1, 0), cB + ksB, voffB); PG8_STAGE(PG8_SA(1, 0), cA + ksA, voffA); PG8_STAGE(PG8_SB(1, 1), cB + hsB + ksB, voffB);
    PG8_WAIT_V(6); PG8_BAR;
    for (;;) {
        const bool has_next = S.next(ui + 1, nxt);
        const char* nA = has_next ? nxt.A : cA; const char* nB = has_next ? nxt.B : cB;
        for (int t = 0; t < nt; t += 2) {
            const bool last = (t == nt - 2);
            const char* a1 = cA + (size_t)(t + 1) * ksA;
            const char* a2 = last ? nA : cA + (size_t)(t + 2) * ksA; const char* b2 = last ? nB : cB + (size_t)(t + 2) * ksB;
            const char* a3 = a2 + ksA; const char* b3 = b2 + ksB;
            PG8_LDB(B0, 0, 0); PG8_LDB(B1, 0, 1); PG8_SCHED; PG8_LDA(At, 0, 0); PG8_STAGE(PG8_SA(1, 1), a1 + hsA, voffA);
            PG8_WAIT_V(8); PG8_WAIT_L(0); PG8_BAR; PG8_MMA(0, 0, At, B0); PG8_MMA(0, 1, At, B1); PG8_BAR; PG8_SCHED;
            PG8_LDA(At, 0, 1); PG8_STAGE(PG8_SB(0, 0), b2, voffB); PG8_STAGE(PG8_SB(0, 1), b2 + hsB, voffB); PG8_STAGE(PG8_SA(0, 0), a2, voffA);
            PG8_WAIT_V(8); PG8_WAIT_L(0); PG8_BAR; PG8_MMA(1, 0, At, B0); PG8_MMA(1, 1, At, B1); PG8_BAR; PG8_SCHED;
            PG8_LDB(B0, 1, 0); PG8_LDB(B1, 1, 1); PG8_SCHED; PG8_LDA(At, 1, 0); PG8_STAGE(PG8_SA(0, 1), a2 + hsA, voffA);
            PG8_WAIT_V(8); PG8_WAIT_L(0); PG8_BAR; PG8_MMA(0, 0, At, B0); PG8_MMA(0, 1, At, B1); PG8_BAR; PG8_SCHED;
            PG8_LDA(At, 1, 1); PG8_STAGE(PG8_SB(1, 0), b3, voffB); PG8_STAGE(PG8_SB(1, 1), b3 + hsB, voffB); PG8_STAGE(PG8_SA(1, 0), a3, voffA);
            PG8_WAIT_V(8); PG8_WAIT_L(0); PG8_BAR; PG8_MMA(1, 0, At, B0); PG8_MMA(1, 1, At, B1); PG8_BAR; PG8_SCHED;
        }
        if (wr == 0) PG8_BAR;
        if constexpr (!Epi::AFTER_DRAIN) { const int l_o = fresh_lane(); E(acc, cur, wr, wc, l_o & 15, l_o >> 4); }
        if (!has_next) break;
#pragma unroll
        for (int a = 0; a < 2; ++a)
#pragma unroll
            for (int b = 0; b < 2; ++b)
#pragma unroll
                for (int m = 0; m < 4; ++m)
#pragma unroll
                    for (int n = 0; n < 2; ++n) acc[a][b][m][n] = (f32x4){0.f, 0.f, 0.f, 0.f};
        cur = nxt; cA = nA; cB = nB; ++ui;
        if (wr == 1) PG8_BAR;
    }
    PG8_WAIT_V(0);
    PG8_BAR;
    if constexpr (Epi::AFTER_DRAIN) { const int l_o = fresh_lane(); E.fused(acc, cur, wr, wc, l_o & 15, l_o >> 4, lds, wid); }
#undef PG8_SA
#undef PG8_SB
#undef PG8_STAGE
#undef PG8_LDA
#undef PG8_LDB
#undef PG8_MMA
#undef PG8_WAIT_V
#undef PG8_WAIT_L
#undef PG8_BAR
#undef PG8_SCHED
}
}
using pg8::GUnit; using pg8::GParm;
typedef f32x4 AccT[2][2][4][2];

struct SchedStd {
    pg8::StaticOrder so; const char* A; const char* B; size_t a_tile, b_tile;
    __device__ __forceinline__ bool next(int i, GUnit& u) const { pg8::Unit t; if (!so.next(i, t)) return false; u.A = A + (size_t)t.pm * a_tile; u.B = B + (size_t)t.pn * b_tile; u.i0 = t.pm; u.i1 = t.pn; return true; }
};
struct SchedS5a { const char* U; const char* WG; int G, c;
    __device__ __forceinline__ bool next(int i, GUnit& u) const { const int L = i * G + c; if (L >= 192) return false; const int g = L / 3, pn = L % 3;
        u.A = U + (size_t)g * GM_STRIDE * 2; u.B = WG + ((size_t)g * 768 + 256 * pn) * 512 * 2; u.i0 = g; u.i1 = pn; return true; } };
struct SchedS5b { const char* HP; const char* WC; int G, c;
    __device__ __forceinline__ bool next(int i, GUnit& u) const { const int L = i * G + c; if (L >= 128) return false; const int g = L / 2, pn = L % 2;
        u.A = HP + (size_t)g * 256 * 256 * 2; u.B = WC + ((size_t)g * 512 + 256 * pn) * 256 * 2; u.i0 = g; u.i1 = pn; return true; } };
struct SchedRG { const char* XR; const char* RGW; int G, c;
    __device__ __forceinline__ bool next(int i, GUnit& u) const { const int L = i * G + c; if (L >= 512) return false; const int h = L % 16, pm = L / 16;
        u.A = XR + ((size_t)(256 * pm) * 1024 + 64 * h) * 2; u.B = RGW + (size_t)h * 256 * 256 * 2; u.i0 = pm; u.i1 = h; return true; } };

template <int ACT> __device__ __forceinline__ void epi_bf16_store(const AccT& acc, bf16_t* tile, int ldc, const float* biast, int wr, int wc, int fr, int fq) {
    const int r0 = wr * 64 + fr, c0 = wc * 32 + 8 * fq;
    f32x4 bv[2][2];
#pragma unroll
    for (int bj = 0; bj < 2; ++bj)
#pragma unroll
        for (int n = 0; n < 2; ++n) bv[bj][n] = biast ? *(const f32x4*)(biast + c0 + bj * 128 + 4 * n) : (f32x4){0.f, 0.f, 0.f, 0.f};
#pragma unroll
    for (int ai = 0; ai < 2; ++ai)
#pragma unroll
        for (int m = 0; m < 4; ++m) { bf16_t* rowp = tile + (size_t)(r0 + ai * 128 + m * 16) * ldc + c0;
#pragma unroll
            for (int bj = 0; bj < 2; ++bj) { f32x4 v0 = acc[ai][bj][m][0] + bv[bj][0], v1 = acc[ai][bj][m][1] + bv[bj][1];
                if (ACT == 1) {
#pragma unroll
                    for (int j = 0; j < 4; ++j) { const float a = fmaxf(v0[j], 0.f), b = fmaxf(v1[j], 0.f); v0[j] = a * a; v1[j] = b * b; } }
                if (ACT == 2) {
#pragma unroll
                    for (int j = 0; j < 4; ++j) { v0[j] = fast_sigmoid(v0[j]); v1[j] = fast_sigmoid(v1[j]); } }
                u32x4 w; w.x = cvt_pk_bf16(v0[0], v0[1]); w.y = cvt_pk_bf16(v0[2], v0[3]); w.z = cvt_pk_bf16(v1[0], v1[1]); w.w = cvt_pk_bf16(v1[2], v1[3]);
                *(u32x4*)(rowp + bj * 128) = w; } }
}
struct EpiProj { static constexpr bool PERM = true, AFTER_DRAIN = false; bf16_t *U, *XR, *Z; const float* bias;
    __device__ __forceinline__ void operator()(AccT& acc, const GUnit& u, int wr, int wc, int fr, int fq) const {
        const int pm = u.i0, pn = u.i1;
        if (pn >= 4) { bf16_t* base = pn < 8 ? XR + 2 * 1024 : Z; epi_bf16_store<0>(acc, base + (size_t)pm * 256 * 1024 + (pn & 3) * 256, 1024, bias + pn * 256, wr, wc, fr, fq); return; }
        const int c0 = pn * 256 + wc * 32 + 8 * fq;
#pragma unroll
        for (int bj = 0; bj < 2; ++bj) { const int col = c0 + bj * 128; const f32x4 b0 = *(const f32x4*)(bias + col), b1 = *(const f32x4*)(bias + col + 4); bf16_t* gp = U + (size_t)(col >> 4) * GM_STRIDE + (col & 15);
#pragma unroll
            for (int ai = 0; ai < 2; ++ai)
#pragma unroll
                for (int m = 0; m < 4; ++m) { const int row = pm * 256 + ai * 128 + wr * 64 + m * 16 + fr; const f32x4 v0 = acc[ai][bj][m][0] + b0, v1 = acc[ai][bj][m][1] + b1;
                    u32x4 w; w.x = cvt_pk_bf16(v0[0], v0[1]); w.y = cvt_pk_bf16(v0[2], v0[3]); w.z = cvt_pk_bf16(v1[0], v1[1]); w.w = cvt_pk_bf16(v1[2], v1[3]);
                    *(u32x4*)(gp + (size_t)row * 16) = w; } }
    } };
template <int ACT> struct EpiPlain { static constexpr bool PERM = true, AFTER_DRAIN = false; bf16_t* O; int ldc; const float* bias; size_t pstride;
    __device__ __forceinline__ void operator()(AccT& acc, const GUnit& u, int wr, int wc, int fr, int fq) const {
        epi_bf16_store<ACT>(acc, O + (size_t)u.i0 * (pstride ? pstride : (size_t)256 * ldc) + u.i1 * 256, ldc, bias ? bias + u.i1 * 256 : nullptr, wr, wc, fr, fq); } };
struct EpiS5a { static constexpr bool PERM = true, AFTER_DRAIN = false; bf16_t* YI; float* S;
    __device__ __forceinline__ void operator()(AccT& acc, const GUnit& u, int wr, int wc, int fr, int fq) const {
        const int g = u.i0, pn = u.i1;
#pragma unroll
        for (int ai = 0; ai < 2; ++ai)
#pragma unroll
            for (int m = 0; m < 4; ++m) { const int r = ai * 128 + wr * 64 + m * 16 + fr;
#pragma unroll
                for (int bj = 0; bj < 2; ++bj) { const int c8 = bj * 128 + wc * 32 + 8 * fq; const f32x4 v0 = acc[ai][bj][m][0], v1 = acc[ai][bj][m][1];
                    if (pn < 2) { const int col = pn * 256 + c8, t = col >> 4, k0 = col & 15;
                        u32x4 w; w.x = cvt_pk_bf16(v0[0], v0[1]); w.y = cvt_pk_bf16(v0[2], v0[3]); w.z = cvt_pk_bf16(v1[0], v1[1]); w.w = cvt_pk_bf16(v1[2], v1[3]);
                        *(u32x4*)(YI + (size_t)g * GM_STRIDE + (size_t)r * 512 + col) = w; (void)t; (void)k0; }
                    else { float* sp = S + ((size_t)g * NCH + r) * 256 + c8; *(f32x4*)sp = v0; *(f32x4*)(sp + 4) = v1; } } }
    } };
struct EpiS5b { static constexpr bool PERM = true, AFTER_DRAIN = false; const bf16_t* YI; bf16_t* YG;
    __device__ __forceinline__ void operator()(AccT& acc, const GUnit& u, int wr, int wc, int fr, int fq) const {
        const int g = u.i0, pn = u.i1;
#pragma unroll
        for (int ai = 0; ai < 2; ++ai)
#pragma unroll
            for (int m = 0; m < 4; ++m) { const int r = ai * 128 + wr * 64 + m * 16 + fr;
#pragma unroll
                for (int bj = 0; bj < 2; ++bj) { const int col = pn * 256 + bj * 128 + wc * 32 + 8 * fq, t = col >> 4, k0 = col & 15;
                    const size_t off = (size_t)g * GM_STRIDE + (size_t)r * 512 + col; (void)t; (void)k0; const u32x4 yi = *(const u32x4*)(YI + off);
                    f32x4 v0 = acc[ai][bj][m][0] + (f32x4){bf_lo(yi.x), bf_hi(yi.x), bf_lo(yi.y), bf_hi(yi.y)}, v1 = acc[ai][bj][m][1] + (f32x4){bf_lo(yi.z), bf_hi(yi.z), bf_lo(yi.w), bf_hi(yi.w)};
#pragma unroll
                    for (int j = 0; j < 4; ++j) { v0[j] = gelu_tanh(v0[j]); v1[j] = gelu_tanh(v1[j]); }
                    u32x4 w; w.x = cvt_pk_bf16(v0[0], v0[1]); w.y = cvt_pk_bf16(v0[2], v0[3]); w.z = cvt_pk_bf16(v1[0], v1[1]); w.w = cvt_pk_bf16(v1[2], v1[3]);
                    *(u32x4*)(YG + off) = w; } }
    } };
struct EpiGlu { static constexpr bool PERM = true, AFTER_DRAIN = false; const bf16_t* YG; bf16_t* YPRE; const float* bias;
    __device__ __forceinline__ void operator()(AccT& acc, const GUnit& u, int wr, int wc, int fr, int fq) const {
        const int pm = u.i0, pn = u.i1; const int c0 = pn * 256 + wc * 32 + 8 * fq;
        f32x4 bv[2][2];
#pragma unroll
        for (int bj = 0; bj < 2; ++bj)
#pragma unroll
            for (int n = 0; n < 2; ++n) bv[bj][n] = *(const f32x4*)(bias + c0 + bj * 128 + 4 * n);
#pragma unroll
        for (int ai = 0; ai < 2; ++ai)
#pragma unroll
            for (int m = 0; m < 4; ++m) { const int row = pm * 256 + ai * 128 + wr * 64 + m * 16 + fr;
#pragma unroll
                for (int bj = 0; bj < 2; ++bj) { const int col = c0 + bj * 128; const u32x4 yv = *(const u32x4*)(YG + (size_t)(col >> 4) * GM_STRIDE + (size_t)row * 16 + (col & 15));
                    const f32x4 y0 = (f32x4){bf_lo(yv.x), bf_hi(yv.x), bf_lo(yv.y), bf_hi(yv.y)}, y1 = (f32x4){bf_lo(yv.z), bf_hi(yv.z), bf_lo(yv.w), bf_hi(yv.w)};
                    f32x4 v0 = acc[ai][bj][m][0] + bv[bj][0], v1 = acc[ai][bj][m][1] + bv[bj][1];
#pragma unroll
                    for (int j = 0; j < 4; ++j) { v0[j] = y0[j] * fast_sigmoid(v0[j]); v1[j] = y1[j] * fast_sigmoid(v1[j]); }
                    u32x4 w; w.x = cvt_pk_bf16(v0[0], v0[1]); w.y = cvt_pk_bf16(v0[2], v0[3]); w.z = cvt_pk_bf16(v1[0], v1[1]); w.w = cvt_pk_bf16(v1[2], v1[3]);
                    *(u32x4*)(YPRE + (size_t)row * 2048 + col) = w; }
                }
    } };
template <bool PLEADD> struct EpiRes { static constexpr bool PERM = false, AFTER_DRAIN = false; const bf16_t* HBp; const float* bias; float* V; const bf16_t* SG; const bf16_t* PW;
    __device__ __forceinline__ void operator()(AccT& acc, const GUnit& u, int wr, int wc, int fr, int fq) const {
        const int pm = u.i0, pn = u.i1; const int c0 = pn * 256 + wc * 32 + 4 * fq;
        f32x4 bv[2][2];
#pragma unroll
        for (int bj = 0; bj < 2; ++bj)
#pragma unroll
            for (int n = 0; n < 2; ++n) bv[bj][n] = *(const f32x4*)(bias + c0 + bj * 128 + n * 16);
#pragma unroll
        for (int ai = 0; ai < 2; ++ai)
#pragma unroll
            for (int m = 0; m < 4; ++m) { const int row = pm * 256 + ai * 128 + wr * 64 + m * 16 + fr;
#pragma unroll
                for (int bj = 0; bj < 2; ++bj)
#pragma unroll
                    for (int n = 0; n < 2; ++n) { const size_t off = (size_t)row * 2048 + c0 + bj * 128 + n * 16;
                        f32x4 v = acc[ai][bj][m][n] + bv[bj][n] + DN_ALPHA * bf4(*(const u32x2*)(HBp + off));
                        if (PLEADD) v += bf4(*(const u32x2*)(SG + off)) * bf4(*(const u32x2*)(PW + off));
                        *(f32x4*)(V + off) = v; } }
    } };


struct PanelStats8 { unsigned long long* xbuf; unsigned* cnt; float eps;
    __device__ __forceinline__ void run(const AccT& v, int pm, int pn, int wr, int wc, int fr, int fq, LAS unsigned char* lds, int wid) const {
        LAS f32x2* P = (LAS f32x2*)lds; LAS f32x2* S = (LAS f32x2*)(lds + 8192); const int lane = fq * 16 + fr;
#pragma unroll
        for (int ai = 0; ai < 2; ++ai)
#pragma unroll
            for (int m = 0; m < 4; ++m) { float s = 0.f;
#pragma unroll
                for (int bj = 0; bj < 2; ++bj)
#pragma unroll
                    for (int n = 0; n < 2; ++n) { const f32x4 x = v[ai][bj][m][n]; s += (x[0] + x[1]) + (x[2] + x[3]); }
                s += __shfl_xor(s, 16); s += __shfl_xor(s, 32);
                const float mw = s * (1.0f / 64.0f); float q = 0.f;
#pragma unroll
                for (int bj = 0; bj < 2; ++bj)
#pragma unroll
                    for (int n = 0; n < 2; ++n) { const f32x4 d = v[ai][bj][m][n] - mw; q += (d[0] * d[0] + d[1] * d[1]) + (d[2] * d[2] + d[3] * d[3]); }
                q += __shfl_xor(q, 16); q += __shfl_xor(q, 32);
                if (fq == 0) P[(ai * 128 + wr * 64 + m * 16 + fr) * 4 + wc] = (f32x2){mw, q}; }
        asm volatile("s_waitcnt lgkmcnt(0)" ::: "memory"); __builtin_amdgcn_s_barrier(); asm volatile("" ::: "memory");
        const int row = wid * 32 + (lane & 31);
        if (lane < 32) { const f32x2 a = P[row * 4 + 0], b = P[row * 4 + 1], c = P[row * 4 + 2], d = P[row * 4 + 3];
            const float mt = (a[0] + b[0] + c[0] + d[0]) * 0.25f; const float da = a[0] - mt, db = b[0] - mt, dc = c[0] - mt, dd = d[0] - mt;
            const float m2 = (a[1] + b[1]) + (c[1] + d[1]) + 64.0f * ((da * da + db * db) + (dc * dc + dd * dd));
            __hip_atomic_store(xbuf + ((size_t)(pm * 256 + row) * 8 + pn), ((unsigned long long)__float_as_uint(m2) << 32) | __float_as_uint(mt), __ATOMIC_RELAXED, __HIP_MEMORY_SCOPE_AGENT); }
        asm volatile("s_waitcnt vmcnt(0)" ::: "memory");
        if (lane == 0) __hip_atomic_fetch_add(cnt + 64 * pm, 1u, __ATOMIC_RELAXED, __HIP_MEMORY_SCOPE_AGENT);
        if (wid == 0) { unsigned sp = 0;
            while ((unsigned)__builtin_amdgcn_readfirstlane(__hip_atomic_load(cnt + 64 * pm, __ATOMIC_RELAXED, __HIP_MEMORY_SCOPE_AGENT)) < 64u) { __builtin_amdgcn_s_sleep(2); if (++sp > (1u << 22)) break; }
            __builtin_amdgcn_fence(__ATOMIC_ACQUIRE, "agent"); }
        asm volatile("s_waitcnt vmcnt(0) lgkmcnt(0)" ::: "memory"); __builtin_amdgcn_s_barrier(); asm volatile("" ::: "memory");
        if (lane < 32) { const unsigned long long* slot = xbuf + (size_t)(pm * 256 + row) * 8; float mt[8], m2[8]; float ms = 0.f;
#pragma unroll
            for (int t = 0; t < 8; ++t) { const unsigned long long w = __hip_atomic_load(slot + t, __ATOMIC_RELAXED, __HIP_MEMORY_SCOPE_AGENT); mt[t] = __uint_as_float((unsigned)w); m2[t] = __uint_as_float((unsigned)(w >> 32)); ms += mt[t]; }
            const float mean = ms * 0.125f; float q = 0.f;
#pragma unroll
            for (int t = 0; t < 8; ++t) { const float dm = mt[t] - mean; q += m2[t] + 256.0f * dm * dm; }
            S[row] = (f32x2){mean, 1.0f / sqrtf(q * (1.0f / 2048.0f) + eps)}; }
        asm volatile("s_waitcnt lgkmcnt(0)" ::: "memory"); __builtin_amdgcn_s_barrier(); asm volatile("" ::: "memory");
    } };
struct EpiResLn1 { static constexpr bool PERM = false, AFTER_DRAIN = true; bf16_t* HBp; const float *bias, *lng, *lnb; PanelStats8 st;
    __device__ __forceinline__ void fused(AccT& acc, const GUnit& u, int wr, int wc, int fr, int fq, LAS unsigned char* lds, int wid) const {
        const int pm = u.i0, pn = u.i1; const int c0 = pn * 256 + wc * 32 + 4 * fq; const LAS f32x2* S = (const LAS f32x2*)(lds + 8192);
#pragma unroll
        for (int bj = 0; bj < 2; ++bj)
#pragma unroll
            for (int n = 0; n < 2; ++n) { const f32x4 bv = *(const f32x4*)(bias + c0 + bj * 128 + n * 16);
#pragma unroll
                for (int ai = 0; ai < 2; ++ai)
#pragma unroll
                    for (int m = 0; m < 4; ++m) { const size_t off = (size_t)(pm * 256 + ai * 128 + wr * 64 + m * 16 + fr) * 2048 + c0 + bj * 128 + n * 16;
                        acc[ai][bj][m][n] += bv + DN_ALPHA * bf4(*(const u32x2*)(HBp + off)); } }
        st.run(acc, pm, pn, wr, wc, fr, fq, lds, wid);
#pragma unroll
        for (int bj = 0; bj < 2; ++bj)
#pragma unroll
            for (int n = 0; n < 2; ++n) { const f32x4 gg = *(const f32x4*)(lng + c0 + bj * 128 + n * 16), bb = *(const f32x4*)(lnb + c0 + bj * 128 + n * 16);
#pragma unroll
                for (int ai = 0; ai < 2; ++ai)
#pragma unroll
                    for (int m = 0; m < 4; ++m) { const int r = ai * 128 + wr * 64 + m * 16 + fr; const f32x2 sr = S[r]; const size_t off = (size_t)(pm * 256 + r) * 2048 + c0 + bj * 128 + n * 16;
                        const f32x4 o = (acc[ai][bj][m][n] - sr[0]) * sr[1] * gg + bb; u32x2 w; w.x = cvt_pk_bf16(o[0], o[1]); w.y = cvt_pk_bf16(o[2], o[3]); *(u32x2*)(HBp + off) = w; } }
    } };
struct EpiResLn2 { static constexpr bool PERM = false, AFTER_DRAIN = true; const bf16_t* HBp; const float *bias, *lng, *lnb; float* out; const bf16_t* SGPW; PanelStats8 st;
    __device__ __forceinline__ void fused(AccT& acc, const GUnit& u, int wr, int wc, int fr, int fq, LAS unsigned char* lds, int wid) const {
        const int pm = u.i0, pn = u.i1; const int c0 = pn * 256 + wc * 32 + 4 * fq; const LAS f32x2* S = (const LAS f32x2*)(lds + 8192);
        const bf16_t* sgp = SGPW + (size_t)pm * (1u << 20);
        f32x4 bv[2][2];
#pragma unroll
        for (int bj = 0; bj < 2; ++bj)
#pragma unroll
            for (int n = 0; n < 2; ++n) bv[bj][n] = *(const f32x4*)(bias + c0 + bj * 128 + n * 16);
#pragma unroll
        for (int ai = 0; ai < 2; ++ai)
#pragma unroll
            for (int m = 0; m < 4; ++m) { const int r = ai * 128 + wr * 64 + m * 16 + fr; const size_t lo = (size_t)r * 2048 + c0; const bf16_t* hp = HBp + (size_t)(pm * 256 + r) * 2048 + c0;
#pragma unroll
                for (int bj = 0; bj < 2; ++bj)
#pragma unroll
                    for (int n = 0; n < 2; ++n) { const int co = bj * 128 + n * 16;
                        acc[ai][bj][m][n] += bv[bj][n] + DN_ALPHA * bf4(*(const u32x2*)(hp + co)) + bf4(*(const u32x2*)(sgp + lo + co)) * bf4(*(const u32x2*)(sgp + (1u << 19) + lo + co)); }
                asm volatile("" : "+v"(acc[ai][0][m][0]), "+v"(acc[ai][0][m][1]), "+v"(acc[ai][1][m][0]), "+v"(acc[ai][1][m][1])); }
        st.run(acc, pm, pn, wr, wc, fr, fq, lds, wid);
#pragma unroll
        for (int bj = 0; bj < 2; ++bj)
#pragma unroll
            for (int n = 0; n < 2; ++n) { const f32x4 gg = *(const f32x4*)(lng + c0 + bj * 128 + n * 16), bb = *(const f32x4*)(lnb + c0 + bj * 128 + n * 16);
#pragma unroll
                for (int ai = 0; ai < 2; ++ai)
#pragma unroll
                    for (int m = 0; m < 4; ++m) { const int r = ai * 128 + wr * 64 + m * 16 + fr; const f32x2 sr = S[r];
                        *(f32x4*)(out + (size_t)(pm * 256 + r) * 2048 + c0 + bj * 128 + n * 16) = (acc[ai][bj][m][n] - sr[0]) * sr[1] * gg + bb; } }
    } };
struct EpiG { static constexpr bool PERM = true, AFTER_DRAIN = false; bf16_t *G0, *G1; const float* bias;
    __device__ __forceinline__ void operator()(AccT& acc, const GUnit& u, int wr, int wc, int fr, int fq) const {
        const int pm = u.i0, h = u.i1; bf16_t* base = (pm < 16 ? G0 : G1) + (size_t)(pm & 15) * 256 * 4096 + h * 256;
        epi_bf16_store<0>(acc, base, 4096, bias + h * 256, wr, wc, fr, fq); } };
__device__ __forceinline__ float bfu(unsigned short v) { return __uint_as_float(((unsigned)v) << 16); }
__device__ __forceinline__ void rg_gate(float pa, float px, float spv, float xc, float& a, float& b) {
    const float r = fast_sigmoid(pa), ig = fast_sigmoid(px); const float la = spv * r; a = __expf(la); const float x = 2.0f * la;
    const float om = -x * (1.0f + x * (0.5f + x * (0.16666667f + x * (0.041666668f + x * 0.008333334f))));
    b = __builtin_amdgcn_sqrtf(fmaxf(om, 0.f)) * ig * xc; }
__device__ __forceinline__ void rg_gate2(float pa, float px, float spv, float xc, float& a, float& b, float& r) {
    r = fast_sigmoid(pa); const float ig = fast_sigmoid(px); const float la = spv * r; a = __expf(la); const float x = 2.0f * la;
    const float om = -x * (1.0f + x * (0.5f + x * (0.16666667f + x * (0.041666668f + x * 0.008333334f))));
    b = __builtin_amdgcn_sqrtf(fmaxf(om, 0.f)) * ig * xc; }
struct RgCtx { const bf16_t *XR, *G0, *G1, *Z; const float *convw, *convb, *sp; float* agg; bf16_t* ypre; };
__device__ __forceinline__ const bf16_t* g_row(const RgCtx& R, int t) { return (t < 4096 ? R.G0 : R.G1) + (size_t)(t & 4095) * 4096; }
__device__ __forceinline__ void rg_pass_a(const RgCtx& R, int half, int seg, int tid) {
    const int c = half * 512 + tid, gcol = (c >> 6) * 256 + (c & 63) * 4, t0 = seg * 64;
    const float w0 = R.convw[c], w1 = R.convw[1024 + c], w2 = R.convw[2048 + c], w3 = R.convw[3072 + c], cb = R.convb[c], sp0 = R.sp[c], sp1 = R.sp[1024 + c];
    const bf16_t* xp = R.XR + c;
    float x0 = bfu(xp[(size_t)(t0 + 0) * 1024]), x1 = bfu(xp[(size_t)(t0 + 1) * 1024]), x2 = bfu(xp[(size_t)(t0 + 2) * 1024]);
    float Af = 1.f, Bf = 0.f, Ab = 1.f, Bb = 0.f;
    for (int tb = 0; tb < 64; tb += 16) {
        u32x2 gq[16]; unsigned short xn[16];
#pragma unroll
        for (int i = 0; i < 16; ++i) { const int t = t0 + tb + i; gq[i] = *(const u32x2*)(g_row(R, t) + gcol); xn[i] = xp[(size_t)(t + 3) * 1024]; }
#pragma unroll
        for (int i = 0; i < 16; ++i) { const float x3 = bfu(xn[i]); const float xc = cb + w0 * x0 + w1 * x1 + w2 * x2 + w3 * x3; x0 = x1; x1 = x2; x2 = x3;
            float a, b, r0, r1, b0; rg_gate2(bf_lo(gq[i].x), bf_lo(gq[i].y), sp0, xc, a, b, r0); Bf = a * Bf + b; Af = a * Af; b0 = b;
            rg_gate2(bf_hi(gq[i].x), bf_hi(gq[i].y), sp1, xc, a, b, r1); Bb = Ab * b + Bb; Ab = Ab * a;
            u32x2 w; w.x = cvt_pk_bf16(r0, r1); w.y = cvt_pk_bf16(b0, b); *(u32x2*)((bf16_t*)g_row(R, t0 + tb + i) + gcol) = w; }
    }
    *(f32x2*)(R.agg + ((size_t)(seg * 2 + 0) * 1024 + c) * 2) = (f32x2){Af, Bf};
    *(f32x2*)(R.agg + ((size_t)(seg * 2 + 1) * 1024 + c) * 2) = (f32x2){Ab, Bb};
}
__device__ __forceinline__ void rg_pass_c(const RgCtx& R, int half, int seg, int tid, LAS float* Lh) {
    const int c = half * 512 + tid, gcol = (c >> 6) * 256 + (c & 63) * 4, t0 = seg * 64;
    const float sp0 = R.sp[c], sp1 = R.sp[1024 + c];
    const f32x2* ag = (const f32x2*)R.agg;
    float hf = 0.f, hb = 0.f;
    {
#pragma unroll 1
        for (int sb = 0; sb < 128; sb += 32) { f32x2 ab[32];
#pragma unroll
            for (int i = 0; i < 32; ++i) { const int s2 = sb + i; ab[i] = (s2 < seg) ? ag[(size_t)(s2 * 2 + 0) * 1024 + c] : (f32x2){1.f, 0.f}; }
#pragma unroll
            for (int i = 0; i < 32; ++i) hf = ab[i][0] * hf + ab[i][1]; }
#pragma unroll 1
        for (int sb = 96; sb >= 0; sb -= 32) { f32x2 ab[32];
#pragma unroll
            for (int i = 0; i < 32; ++i) { const int s2 = sb + 31 - i; ab[i] = (s2 > seg) ? ag[(size_t)(s2 * 2 + 1) * 1024 + c] : (f32x2){1.f, 0.f}; }
#pragma unroll
            for (int i = 0; i < 32; ++i) hb = ab[i][0] * hb + ab[i][1]; }
    }
    {
        for (int tb = 0; tb < 64; tb += 16) {
            u32x2 gq[16];
#pragma unroll
            for (int i = 0; i < 16; ++i) gq[i] = *(const u32x2*)(g_row(R, t0 + tb + i) + gcol);
#pragma unroll
            for (int i = 0; i < 16; ++i) { const float a = __expf(sp0 * bf_lo(gq[i].x)); hf = a * hf + bf_lo(gq[i].y); Lh[(tb + i) * 512 + tid] = hf; }
        }
    }
    {
        for (int tb = 48; tb >= 0; tb -= 16) {
            u32x2 gq[16]; unsigned short zz[16];
#pragma unroll
            for (int i = 0; i < 16; ++i) { const int t = t0 + tb + 15 - i; gq[i] = *(const u32x2*)(g_row(R, t) + gcol); zz[i] = R.Z[(size_t)t * 1024 + c]; }
#pragma unroll
            for (int i = 0; i < 16; ++i) { const int tl = tb + 15 - i; const float a = __expf(sp1 * bf_hi(gq[i].x)); hb = a * hb + bf_hi(gq[i].y);
                const float o = (Lh[tl * 512 + tid] + hb) * gelu_tanh(bfu(zz[i]));
                R.ypre[(size_t)(t0 + tl) * 2048 + 1024 + c] = (bf16_t)(cvt_pk_bf16(o, 0.f) & 0xffffu); }
        }
    }
}

#ifndef NAIVE_GEMM
#define NAIVE_GEMM 0
#endif
template <class Epi, class Sched>
__device__ __forceinline__ void gemm_phase_naive(LAS unsigned char* lds, const int wid, const GParm gp, const Sched& S, const Epi& E) {
    const int lane = fresh_lane(), tid = wid * 64 + lane, wr = wid >> 2, wc = wid & 3, fr = lane & 15, fq = lane >> 4;
    GUnit cur;
    for (int ui = 0; S.next(ui, cur); ++ui) {
        f32x4 acc[2][2][4][2];
#pragma unroll
        for (int ai = 0; ai < 2; ++ai)
#pragma unroll
            for (int bj = 0; bj < 2; ++bj)
#pragma unroll
                for (int m = 0; m < 4; ++m)
#pragma unroll
                    for (int n = 0; n < 2; ++n)
#pragma unroll
                        for (int e = 0; e < 4; ++e) {
                            const int row = 128 * ai + 64 * wr + 16 * m + fr; const int col = Epi::PERM ? (128 * bj + 32 * wc + 8 * fq + 4 * n + e) : (128 * bj + 32 * wc + 16 * n + 4 * fq + e);
                            const char* ap = cur.A + (size_t)row * gp.a_rs; const char* bp = cur.B + (size_t)col * gp.K * 2; float sum = 0.f;
                            for (int k = 0; k < gp.K; k += 8) { const int kt = k >> 6, C = k & 63;
                                const u32x4 av = *(const u32x4*)(ap + (size_t)kt * gp.a_ks + ((C / gp.a_cw) * gp.a_cs + (C % gp.a_cw)) * 2), bv = *(const u32x4*)(bp + k * 2);
                                sum += bf_lo(av.x) * bf_lo(bv.x) + bf_hi(av.x) * bf_hi(bv.x) + bf_lo(av.y) * bf_lo(bv.y) + bf_hi(av.y) * bf_hi(bv.y) + bf_lo(av.z) * bf_lo(bv.z) + bf_hi(av.z) * bf_hi(bv.z) + bf_lo(av.w) * bf_lo(bv.w) + bf_hi(av.w) * bf_hi(bv.w); }
                            acc[ai][bj][m][n][e] = sum; }
        if constexpr (Epi::AFTER_DRAIN) { __syncthreads(); E.fused(acc, cur, wr, wc, fr, fq, lds, wid); } else E(acc, cur, wr, wc, fr, fq);
    }
    __syncthreads();
}
#if NAIVE_GEMM
#define GEMM_PHASE gemm_phase_naive
#else
#define GEMM_PHASE pg8::gemm_phase
#endif
__device__ __forceinline__ void transpose_item(const float* W, int K, int N, bf16_t* WT, LAS float* scr, int item, int lane) {
    const int nblk = N / 64, kb = item / nblk, nb = item % nblk, k0 = 64 * kb, n0 = 64 * nb;
    const float* src = W + (size_t)k0 * N + n0 + lane;
#pragma unroll 32
    for (int i = 0; i < 64; ++i) scr[i * 65 + lane] = src[(size_t)i * N];
    LDS_WAIT();
    const int c = lane & 7;
#pragma unroll
    for (int j = 0; j < 8; ++j) { const int n = (lane >> 3) + 8 * j; const LAS float* sp = scr + (8 * c) * 65 + n;
        u32x4 o; o.x = cvt_pk_bf16(sp[0 * 65], sp[1 * 65]); o.y = cvt_pk_bf16(sp[2 * 65], sp[3 * 65]); o.z = cvt_pk_bf16(sp[4 * 65], sp[5 * 65]); o.w = cvt_pk_bf16(sp[6 * 65], sp[7 * 65]);
        *(u32x4*)(WT + (size_t)(n0 + n) * K + k0 + 8 * c) = o; }
    LDS_WAIT();
}
template <bool OUT_BF16> __device__ __forceinline__ void ln_row(const float* xrow, const float* g, const float* b, void* orow, int lane) {
    const f32x4* xr = (const f32x4*)xrow + lane; f32x4 v[8]; float s = 0.f;
#pragma unroll
    for (int j = 0; j < 8; ++j) { v[j] = xr[64 * j]; s += (v[j][0] + v[j][1]) + (v[j][2] + v[j][3]); }
    const float mean = wave_sum(s) * (1.f / DM); float s2 = 0.f;
#pragma unroll
    for (int j = 0; j < 8; ++j) { v[j] = v[j] - mean; s2 += (v[j][0] * v[j][0] + v[j][1] * v[j][1]) + (v[j][2] * v[j][2] + v[j][3] * v[j][3]); }
    const float rstd = 1.0f / sqrtf(wave_sum(s2) * (1.f / DM) + LN_EPS);
#pragma unroll
    for (int j = 0; j < 8; ++j) { const f32x4 gg = ((const f32x4*)g)[lane + 64 * j], bb = ((const f32x4*)b)[lane + 64 * j]; const f32x4 o = v[j] * rstd * gg + bb;
        if (OUT_BF16) { u32x2 w; w.x = cvt_pk_bf16(o[0], o[1]); w.y = cvt_pk_bf16(o[2], o[3]); ((u32x2*)orow)[lane + 64 * j] = w; }
        else ((f32x4*)orow)[lane + 64 * j] = o; }
}
__device__ __forceinline__ void cpow(float lrs, float th, int j, float& re, float& im) {
    double a = (double)j * (double)th * 0.15915494309189535; a -= rint(a); const float af = 2.0f * (float)a;
    const float mag = expf((float)j * lrs); re = mag * cospif(af); im = mag * sinpif(af);
}


#ifndef NAIVE_RG
#define NAIVE_RG 0
#endif
__device__ __forceinline__ void naive_rg_channel(const RgCtx& R, int c) {
    const int gcol = (c >> 6) * 256 + (c & 63);
    const float w0 = R.convw[c], w1 = R.convw[1024 + c], w2 = R.convw[2048 + c], w3 = R.convw[3072 + c], cb = R.convb[c], sp0 = R.sp[c], sp1 = R.sp[1024 + c];
    const bf16_t* xp = R.XR + c; float h = 0.f;
    for (int t = 0; t < SEQ; ++t) { const float xc = cb + w0 * bfu(xp[(size_t)t * 1024]) + w1 * bfu(xp[(size_t)(t + 1) * 1024]) + w2 * bfu(xp[(size_t)(t + 2) * 1024]) + w3 * bfu(xp[(size_t)(t + 3) * 1024]);
        const bf16_t* g = g_row(R, t) + gcol; float a, b; rg_gate(bfu(g[0]), bfu(g[128]), sp0, xc, a, b); h = a * h + b;
        R.ypre[(size_t)t * 2048 + 1024 + c] = (bf16_t)(cvt_pk_bf16(h, 0.f) & 0xffffu); }
    __builtin_amdgcn_fence(__ATOMIC_SEQ_CST, "agent");
    h = 0.f;
    for (int t = SEQ - 1; t >= 0; --t) { const float xc = cb + w0 * bfu(xp[(size_t)t * 1024]) + w1 * bfu(xp[(size_t)(t + 1) * 1024]) + w2 * bfu(xp[(size_t)(t + 2) * 1024]) + w3 * bfu(xp[(size_t)(t + 3) * 1024]);
        const bf16_t* g = g_row(R, t) + gcol; float a, b; rg_gate(bfu(g[64]), bfu(g[192]), sp1, xc, a, b); h = a * h + b;
        const size_t o = (size_t)t * 2048 + 1024 + c; const float y = (bfu(R.ypre[o]) + h) * gelu_tanh(bfu(R.Z[(size_t)t * 1024 + c]));
        R.ypre[o] = (bf16_t)(cvt_pk_bf16(y, 0.f) & 0xffffu); }
}

#ifndef NAIVE_S5
#define NAIVE_S5 0
#endif
__device__ __forceinline__ void naive_s5_group(const float* const* in, const bf16_t* U, float* tmp, bf16_t* YG, int g, int lane) {
    const float *lre = in[6], *lim = in[7], *lstep = in[8], *bre = in[9], *bim = in[10], *cre = in[11], *cim = in[12], *dd = in[13];
    for (int n = 0; n < 2; ++n) {
        const int p = lane, pi = (n * 64 + g) * 64 + p;
        const float lr = fminf(lre[pi], -1e-4f), li = lim[pi], step = expf(lstep[n * 64 + g]); float ar, ai; cpow(lr * step, li * step, 1, ar, ai);
        const float nr = ar - 1.0f, ni = ai, den = lr * lr + li * li; const float qr = (nr * lr + ni * li) / den, qi = (ni * lr - nr * li) / den;
        float hr = 0.f, hi = 0.f;
        for (int tt = 0; tt < SEQ; ++tt) { const int t = n == 0 ? tt : SEQ - 1 - tt; const bf16_t* up = U + (size_t)t * 1024 + g * 16;
            float bur = 0.f, bui = 0.f;
#pragma unroll
            for (int k = 0; k < 16; ++k) { const float uv = bfu(up[k]); const float br = bre[(size_t)pi * 16 + k], bi = bim[(size_t)pi * 16 + k]; bur += (qr * br - qi * bi) * uv; bui += (qr * bi + qi * br) * uv; }
            const float nhr = ar * hr - ai * hi + bur, nhi = ar * hi + ai * hr + bui; hr = nhr; hi = nhi;
#pragma unroll
            for (int k = 0; k < 16; ++k) { const size_t ci = ((size_t)(n * 64 + g) * 16 + k) * 64 + p; float v = cre[ci] * hr - cim[ci] * hi; v = wave_sum(v);
                if (lane == k) { const size_t o = (size_t)t * 1024 + g * 16 + k;
                    if (n == 0) tmp[o] = v; else { const float y = tmp[o] + v + dd[g * 16 + k] * bfu(up[k]); YG[o] = (bf16_t)(cvt_pk_bf16(gelu_tanh(y), 0.f) & 0xffffu); } } }
        }
        __builtin_amdgcn_fence(__ATOMIC_SEQ_CST, "agent");
    }
}

__device__ __forceinline__ void grid_barrier(unsigned* bar, unsigned target, int wave) {
    asm volatile("s_waitcnt vmcnt(0)" ::: "memory");
    __syncthreads();
    if (wave == 0) { const int l = fresh_lane();
        if (l == 0) {
            __builtin_amdgcn_fence(__ATOMIC_RELEASE, "agent"); asm volatile("s_waitcnt vmcnt(0)" ::: "memory");
            __hip_atomic_fetch_add(bar, 1u, __ATOMIC_RELAXED, __HIP_MEMORY_SCOPE_AGENT);
            while (__hip_atomic_load(bar, __ATOMIC_RELAXED, __HIP_MEMORY_SCOPE_AGENT) < target) __builtin_amdgcn_s_sleep(2);
            __builtin_amdgcn_fence(__ATOMIC_ACQUIRE, "agent"); asm volatile("s_waitcnt vmcnt(0)" ::: "memory");
        } }
    __syncthreads();
}

struct Args { const float* in[38]; float* out; unsigned char* ws; int ph_lo, ph_hi; };
typedef const float* cfp_t;
typedef const __attribute__((address_space(4))) cfp_t* kin_t;

__device__ __forceinline__ void s5_precompute(const kin_t ain, unsigned char* aws, int g, int hq, int nh, LAS float* L, const int tid) {
    const float *lre = ain[6], *lim = ain[7], *lstep = ain[8], *bre = ain[9], *bim = ain[10], *cre = ain[11], *cim = ain[12], *dd = ain[13];
    LAS float *PWre = L, *PWim = L + 4224, *BBre = L + 8448, *BBim = L + 10496, *CCre = L + 12544, *CCim = L + 14592, *MT = L + 16640, *C2re = L + 33280, *C2im = L + 35328, *Dl = L + 37376;
    bf16_t* WGg = (bf16_t*)(aws + WS_WG) + (size_t)g * 768 * 512; bf16_t* WCg = (bf16_t*)(aws + WS_WC) + (size_t)g * 512 * 256;
#define PSTAMP(i) do { if (TSTAMP && blockIdx.x == 128 && tid == 0) ((unsigned long long*)(aws + WS_CTR + 1024))[i] = __builtin_amdgcn_s_memrealtime(); } while (0)
    PSTAMP(20);
    {
        const int np = tid & 127, jj = tid >> 7, n = np >> 6, p = np & 63; const int pi = (n * 64 + g) * 64 + p;
        const float lr = fminf(lre[pi], -1e-4f), li = lim[pi], step = expf(lstep[n * 64 + g]); const float lrs = lr * step, th = li * step;
        for (int j = jj; j <= 32; j += 4) { float r, i; cpow(lrs, th, j, r, i); PWre[np * 33 + j] = r; PWim[np * 33 + j] = i; }
        float l1r, l1i; cpow(lrs, th, 1, l1r, l1i);
        const float nr = l1r - 1.0f, ni = l1i, den = lr * lr + li * li; const float qr = (nr * lr + ni * li) / den, qi = (ni * lr - nr * li) / den;
#pragma unroll
        for (int k = jj * 4; k < jj * 4 + 4; ++k) { const float br = bre[(size_t)pi * 16 + k], bi = bim[(size_t)pi * 16 + k]; BBre[np * 16 + k] = qr * br - qi * bi; BBim[np * 16 + k] = qr * bi + qi * br; }
        for (int e = tid; e < 2048; e += 512) { const int n2 = e >> 10, k = (e >> 6) & 15, p2 = e & 63; const size_t ci = ((size_t)(n2 * 64 + g) * 16 + k) * 64 + p2; CCre[(n2 * 64 + p2) * 16 + k] = cre[ci]; CCim[(n2 * 64 + p2) * 16 + k] = cim[ci]; C2re[e] = cre[ci]; C2im[e] = cim[ci]; }
        if (tid < 16) Dl[tid] = dd[g * 16 + tid];
    }
    __syncthreads();
    PSTAMP(21);
    for (int i = 0; i < 3; ++i) {
        if (nh == 2) { if (i < 2 && i != hq) continue; if (i == 2 && (hq != 0 || tid >= 16)) continue; } else if (i == 2) continue;
        const int bq = (i == 2) ? 512 + tid : tid + 512 * i, n = bq >> 9, j = (bq >> 4) & 31, kob = (bq >> 2) & 3, kib = bq & 3;
        f32x4 m0 = {0.f, 0.f, 0.f, 0.f}, m1 = m0, m2 = m0, m3 = m0;
        for (int p = 0; p < 64; ++p) { const int np = n * 64 + p; const float pr = PWre[np * 33 + j], pi2 = PWim[np * 33 + j];
            const f32x4 br = *(const LAS f32x4*)(BBre + np * 16 + 4 * kib), bi = *(const LAS f32x4*)(BBim + np * 16 + 4 * kib), cr = *(const LAS f32x4*)(CCre + np * 16 + 4 * kob), ci = *(const LAS f32x4*)(CCim + np * 16 + 4 * kob);
            const f32x4 er = pr * br - pi2 * bi, ei = pr * bi + pi2 * br;
            m0 += cr[0] * er - ci[0] * ei; m1 += cr[1] * er - ci[1] * ei; m2 += cr[2] * er - ci[2] * ei; m3 += cr[3] * er - ci[3] * ei; }
        LAS float* o = MT + (n * 32 + j) * 260 + (4 * kob) * 16 + 4 * kib;
        *(LAS f32x4*)o = m0; *(LAS f32x4*)(o + 16) = m1; *(LAS f32x4*)(o + 32) = m2; *(LAS f32x4*)(o + 48) = m3;
    }
    __syncthreads();
    PSTAMP(22);
    for (int i = 0; i < 64; ++i) {
        const int idx = tid + 512 * i, row = idx >> 6, cp = idx & 63, t = row >> 4, ko = row & 15, s = cp >> 1, ki0 = (cp & 1) * 8;
        if (nh == 2 && ((t >= s) != (hq == 0))) continue;
        f32x4 v0, v1;
        if (t != s) { const LAS float* src = MT + ((t > s ? 0 : 1) * 32 + (t > s ? t - s : s - t)) * 260 + ko * 16 + ki0; v0 = *(const LAS f32x4*)src; v1 = *(const LAS f32x4*)(src + 4); }
        else { const LAS float* s0 = MT + ko * 16 + ki0; const LAS float* s1 = MT + 32 * 260 + ko * 16 + ki0; v0 = *(const LAS f32x4*)s0 + *(const LAS f32x4*)s1; v1 = *(const LAS f32x4*)(s0 + 4) + *(const LAS f32x4*)(s1 + 4);
            const float dv = Dl[ko];
#pragma unroll
            for (int e = 0; e < 4; ++e) { if (ki0 + e == ko) v0[e] += dv; if (ki0 + 4 + e == ko) v1[e] += dv; } }
        u32x4 w; w.x = cvt_pk_bf16(v0[0], v0[1]); w.y = cvt_pk_bf16(v0[2], v0[3]); w.z = cvt_pk_bf16(v1[0], v1[1]); w.w = cvt_pk_bf16(v1[2], v1[3]);
        *(u32x4*)(WGg + (size_t)row * 512 + cp * 8) = w;
    }
    for (int i = hq * (32 / nh); i < (hq + 1) * (32 / nh); ++i) {
        const int idx = tid + 512 * i, q = idx >> 6, cp = idx & 63, n = q >> 7, ri = (q >> 6) & 1, p = q & 63, s = cp >> 1, ki0 = (cp & 1) * 8, e = n == 0 ? 31 - s : s, np = n * 64 + p;
        const float pr = PWre[np * 33 + e], pi2 = PWim[np * 33 + e]; float v[8];
#pragma unroll
        for (int k = 0; k < 8; ++k) { const float br = BBre[np * 16 + ki0 + k], bi = BBim[np * 16 + ki0 + k]; v[k] = ri == 0 ? pr * br - pi2 * bi : pr * bi + pi2 * br; }
        u32x4 w; w.x = cvt_pk_bf16(v[0], v[1]); w.y = cvt_pk_bf16(v[2], v[3]); w.z = cvt_pk_bf16(v[4], v[5]); w.w = cvt_pk_bf16(v[6], v[7]);
        *(u32x4*)(WGg + (size_t)(512 + q) * 512 + cp * 8) = w;
    }
    for (int i = 0; i < 32 / nh; ++i) {
        const int idx = tid + 512 * i, row = nh == 2 ? idx >> 4 : idx >> 5, q0 = nh == 2 ? hq * 128 + (idx & 15) * 8 : (idx & 31) * 8, n = q0 >> 7, ri = (q0 >> 6) & 1, p0 = q0 & 63, t = row >> 4, ko = row & 15, e = n == 0 ? t + 1 : 32 - t; float v[8];
#pragma unroll
        for (int k = 0; k < 8; ++k) { const int np = n * 64 + p0 + k; const float cr = C2re[(n * 16 + ko) * 64 + p0 + k], ci = C2im[(n * 16 + ko) * 64 + p0 + k], pr = PWre[np * 33 + e], pi2 = PWim[np * 33 + e];
            v[k] = ri == 0 ? cr * pr - ci * pi2 : -(cr * pi2 + ci * pr); }
        u32x4 w; w.x = cvt_pk_bf16(v[0], v[1]); w.y = cvt_pk_bf16(v[2], v[3]); w.z = cvt_pk_bf16(v[4], v[5]); w.w = cvt_pk_bf16(v[6], v[7]);
        *(u32x4*)(WCg + (size_t)row * 256 + q0) = w;
    }
    __syncthreads();
    PSTAMP(23);
}


#ifndef DIAG
#define DIAG 0
#endif
__device__ __forceinline__ void diag_ffn(const float* const* in, const unsigned char* ws, const float* outp, unsigned* flagw, int gtid, int GT) {
    const bf16_t* h1 = (const bf16_t*)(ws + WS_HB); const bf16_t* T = (const bf16_t*)(ws + WS_T); const float* V2 = (const float*)(ws + WS_V2);
    const float *w1 = in[29], *b1 = in[30], *w2 = in[31], *b2 = in[32], *wp = in[33], *wg = in[34], *bg = in[35], *pp = in[1];
    for (int sidx = gtid; sidx < 16384; sidx += GT) {
        unsigned hsh = (unsigned)sidx * 2654435761u, h2 = ((unsigned)sidx + 977u) * 2246822519u; const int r = (hsh >> 8) % SEQ; const int c = (h2 >> 6) % DFF; const int c2 = c % DM;
        float a = b1[c]; for (int k = 0; k < DM; ++k) a += bfu(h1[(size_t)r * DM + k]) * w1[(size_t)k * DFF + c];
        a = fmaxf(a, 0.f); a = a * a; const float tv = bfu(T[(size_t)r * DFF + c]);
        if (fabsf(tv - a) > 0.008f * fabsf(a) + 0.006f) atomicAdd(flagw + 0, 1u);
        float f = b2[c2]; for (int k = 0; k < DFF; ++k) f += bfu(T[(size_t)r * DFF + k]) * w2[(size_t)k * DM + c2];
        float gt = bg[c2]; for (int k = 0; k < DM; ++k) gt += bfu(h1[(size_t)r * DM + k]) * wg[(size_t)k * DM + c2];
        float pw = 0.f; for (int k = 0; k < PLE; ++k) pw += pp[(size_t)r * PLE + k] * wp[(size_t)k * DM + c2];
        const float v2 = DN_ALPHA * bfu(h1[(size_t)r * DM + c2]) + f + fast_sigmoid(gt) * pw; const float got = V2[(size_t)r * DM + c2];
        if (fabsf(got - v2) > 0.008f * fabsf(v2) + 0.006f) atomicAdd(flagw + 1, 1u);
        { const float* vr = V2 + (size_t)r * DM; float m = 0.f; for (int k = 0; k < DM; ++k) m += vr[k]; m /= DM; float v = 0.f; for (int k = 0; k < DM; ++k) { const float d = vr[k] - m; v += d * d; } v /= DM;
          const float e = (vr[c2] - m) / sqrtf(v + LN_EPS) * in[36][c2] + in[37][c2]; const float go = outp[(size_t)r * DM + c2]; if (fabsf(go - e) > 0.004f * fabsf(e) + 0.003f) atomicAdd(flagw + 2, 1u); }
    }
}

__device__ __forceinline__ void diag_pre(const float* const* in, const unsigned char* ws, const unsigned char* dout, unsigned* flagw, int gtid, int GT) {
    const bf16_t* h0 = (const bf16_t*)(ws + WS_HB); const bf16_t* U = (const bf16_t*)(dout + DO_U); const bf16_t* XRb = (const bf16_t*)(ws + WS_XR) + 2048; const bf16_t* Z = (const bf16_t*)(dout + DO_Z);
    const bf16_t* ypre = (const bf16_t*)(dout + DO_YPRE); const bf16_t* ycat = (const bf16_t*)(ws + WS_YCAT); const bf16_t* yg = (const bf16_t*)(ws + WS_YS5G);
    const float *x = in[0], *lg = in[2], *lb = in[3], *win = in[4], *bin = in[5], *gw_ = in[14], *gb = in[15], *g5 = in[23], *gr = in[24];
    for (int sidx = gtid; sidx < 8192; sidx += GT) {
        unsigned hsh = (unsigned)sidx * 2654435761u, h2 = ((unsigned)sidx + 977u) * 2246822519u; const int r = (hsh >> 8) % SEQ; const int c = (h2 >> 6) % DIN; const int c2 = c % DM; const int c1 = c % DS5;
        { float m = 0.f; for (int k = 0; k < DM; ++k) m += x[(size_t)r * DM + k]; m /= DM; float v = 0.f; for (int k = 0; k < DM; ++k) { const float d = x[(size_t)r * DM + k] - m; v += d * d; } v /= DM;
          const float e = (x[(size_t)r * DM + c2] - m) / sqrtf(v + LN_EPS) * lg[c2] + lb[c2]; const float got = bfu(h0[(size_t)r * DM + c2]); if (fabsf(got - e) > 0.008f * fabsf(e) + 0.006f) atomicAdd(flagw + 0, 1u); }
        { float a = bin[c]; for (int k = 0; k < DM; ++k) a += bfu(h0[(size_t)r * DM + k]) * win[(size_t)k * DIN + c];
          const float got = c < 1024 ? bfu(U[(size_t)r * 1024 + c]) : (c < 2048 ? bfu(XRb[(size_t)r * 1024 + c - 1024]) : bfu(Z[(size_t)r * 1024 + c - 2048])); if (fabsf(got - a) > 0.008f * fabsf(a) + 0.006f) atomicAdd(flagw + 3, 1u); }
        { const int hf = c2 >> 10; float ss = 0.f; for (int k = 0; k < 1024; ++k) { const float y = bfu(ypre[(size_t)r * DM + hf * 1024 + k]); ss += y * y; }
          const float e = bfu(ypre[(size_t)r * DM + c2]) / sqrtf(ss / 1024.f + LN_EPS) * (hf ? gr[c2 - 1024] : g5[c2]); const float got = bfu(ycat[(size_t)r * DM + c2]); if (fabsf(got - e) > 0.008f * fabsf(e) + 0.006f) atomicAdd(flagw + 1, 1u); }
        { float a = gb[c1]; for (int k = 0; k < DS5; ++k) a += bfu(yg[(size_t)r * DS5 + k]) * gw_[(size_t)k * DS5 + c1];
          const float e = bfu(yg[(size_t)r * DS5 + c1]) * fast_sigmoid(a); const float got = bfu(ypre[(size_t)r * DM + c1]); if (fabsf(got - e) > 0.008f * fabsf(e) + 0.006f) atomicAdd(flagw + 2, 1u); }
    }
}

__device__ __forceinline__ void diag_v(const float* const* in, const unsigned char* ws, const unsigned char* dout, unsigned* flagw, int gtid, int GT) {
    const bf16_t* h0 = (const bf16_t*)(ws + WS_HB); const bf16_t* ycat = (const bf16_t*)(ws + WS_YCAT); const float* V = (const float*)dout; const float *wo = in[25], *bo = in[26];
    for (int sidx = gtid; sidx < 16384; sidx += GT) { unsigned hsh = (unsigned)sidx * 2654435761u, h2 = ((unsigned)sidx + 977u) * 2246822519u; const int r = (hsh >> 8) % SEQ; const int c = (h2 >> 6) % DM;
        float a = bo[c] + DN_ALPHA * bfu(h0[(size_t)r * DM + c]); for (int k = 0; k < DM; ++k) a += bfu(ycat[(size_t)r * DM + k]) * wo[(size_t)k * DM + c];
        const float got = V[(size_t)r * DM + c]; if (fabsf(got - a) > 0.008f * fabsf(a) + 0.006f) atomicAdd(flagw + 0, 1u); }
}

__device__ __forceinline__ void diag_g(const float* const* in, const unsigned char* ws, unsigned* flagw, int gtid, int GT) {
    const bf16_t* XRp = (const bf16_t*)(ws + WS_XR); const bf16_t* G0 = (const bf16_t*)(ws + WS_G0); const bf16_t* G1 = (const bf16_t*)(ws + WS_G1);
    const float *convw = in[16], *convb = in[17], *wa = in[18], *ba = in[19], *wx = in[20], *bxx = in[21];
    for (int sidx = gtid; sidx < 16384; sidx += GT) { unsigned hsh = (unsigned)sidx * 2654435761u; unsigned h2 = ((unsigned)sidx + 12345u) * 2246822519u; const int t = (hsh >> 7) % SEQ; const int col = (h2 >> 5) % 4096;
        const int h = col >> 8, row = col & 255, bj = row >> 7, dir = (row >> 6) & 1, ch = row & 63;
        const float* W = (bj == 0 ? wa : wx) + ((size_t)(dir * 16 + h) * 64) * 64 + ch; float a = (bj == 0 ? ba : bxx)[(dir * 16 + h) * 64 + ch];
        for (int i = 0; i < 64; ++i) { const int c = 64 * h + i; float xc = convb[c];
            for (int j = 0; j < 4; ++j) xc += convw[j * 1024 + c] * bfu(XRp[(size_t)(t + j) * 1024 + c]);
            a += xc * W[(size_t)i * 64]; }
        const float got = bfu((t < 4096 ? G0 : G1)[(size_t)(t & 4095) * 4096 + col]);
        if (fabsf(got - a) > 0.008f * fabsf(a) + 0.006f) atomicAdd(flagw + 0, 1u); }
}

#ifndef DIAG_HALF
#define DIAG_HALF 1
#endif
__device__ __forceinline__ void diag_max(const unsigned char* ws, unsigned* flagw, int gtid, int GT) {
    const bf16_t* ycat = (const bf16_t*)(ws + WS_YCAT); float mx = 0.f;
    for (size_t i = gtid; i < (size_t)SEQ * 1024; i += GT) { const size_t r = i >> 10, c = (i & 1023) + DIAG_HALF * 1024; mx = fmaxf(mx, fabsf(bfu(ycat[r * DM + c]))); }
    atomicMax(flagw + 0, __float_as_uint(mx));
}

#ifndef DIAG_SEL
#define DIAG_SEL 4
#endif
__device__ __forceinline__ void diag_rows(const float* outp, unsigned* flagw, int gw, int NGW, int lane) {
    for (int row = gw; row < SEQ; row += NGW) { float mx = 0.f; for (int j = lane; j < DM; j += 64) mx = fmaxf(mx, fabsf(outp[(size_t)row * DM + j]));
#pragma unroll
        for (int o = 1; o < 64; o <<= 1) mx = fmaxf(mx, __shfl_xor(mx, o));
        if (lane == 0 && mx > 12.0f) { atomicAdd(flagw + 0, 1u); atomicMin(flagw + 1, (unsigned)row); atomicMax(flagw + 2, (unsigned)row); } }
}

__device__ __forceinline__ void diag_rows_bf(const bf16_t* p, int ld, float thr, unsigned* flagw, int gw, int NGW, int lane) {
    for (int row = gw; row < SEQ; row += NGW) { float mx = 0.f; for (int j = lane; j < ld; j += 64) mx = fmaxf(mx, fabsf(bfu(p[(size_t)row * ld + j])));
#pragma unroll
        for (int o = 1; o < 64; o <<= 1) mx = fmaxf(mx, __shfl_xor(mx, o));
        if (lane == 0 && mx > thr) { atomicAdd(flagw + 0, 1u); atomicMin(flagw + 1, (unsigned)row); atomicMax(flagw + 2, (unsigned)row); } }
}
template <int PHMASK> __global__ void __launch_bounds__(512, 2) mega(Args) {
    extern __shared__ __attribute__((aligned(16))) unsigned char lds_raw[];
    LAS unsigned char* lds = (LAS unsigned char*)lds_raw;
    const int wave = __builtin_amdgcn_readfirstlane((int)threadIdx.x >> 6);
    const int G = gridDim.x, bx = blockIdx.x;
    const int gw = bx * 8 + wave, NGW = G * 8, GT = G * 512;
#define PH_IDS const int lane = fresh_lane(), tid = wave * 64 + lane, gtid = bx * 512 + tid; (void)tid; (void)gtid; (void)lane
    const kin_t KIN = (kin_t)__builtin_amdgcn_kernarg_segment_ptr();
    unsigned char* ws = (unsigned char*)KIN[39]; unsigned char* dout = (unsigned char*)KIN[38];
    const int* kint = (const int*)0; (void)kint;
#if DIAG == 2
    const int lo = ((const __attribute__((address_space(4))) int*)KIN)[80], hi = 7;
#elif DIAG == 3
    const int lo = ((const __attribute__((address_space(4))) int*)KIN)[80], hi = 8;
#elif DIAG == 4
    const int lo = ((const __attribute__((address_space(4))) int*)KIN)[80], hi = 5;
#elif DIAG == 6
    const int lo = ((const __attribute__((address_space(4))) int*)KIN)[80], hi = 7;
#elif DIAG == 8
    const int lo = ((const __attribute__((address_space(4))) int*)KIN)[80], hi = 9;
#elif DIAG == 11 || DIAG == 12
    const int lo = ((const __attribute__((address_space(4))) int*)KIN)[80], hi = 10;
#else
    const int lo = ((const __attribute__((address_space(4))) int*)KIN)[80], hi = ((const __attribute__((address_space(4))) int*)KIN)[81];
#endif
#define IN(k) (((PHMASK >> (k)) & 1) && lo <= (k) && (k) < hi)
    unsigned nbar = 0; unsigned* gbar = (unsigned*)(ws + WS_CTR) + 32;
    if (PHMASK == 0xfff && lo == 0 && hi == NPHASE) cg::this_grid().sync();
#ifndef DBL_MASK
#define DBL_MASK 0
#endif
#define REPS(k) (((DBL_MASK >> (k)) & 1) ? 2 : 1)
#define SEAM(k) do { if (IN(k) && IN((k) + 1)) { ++nbar; grid_barrier(gbar, nbar * (unsigned)G, wave); if (TSTAMP && bx == 0 && wave == 0) { if (fresh_lane() == 0) ((unsigned long long*)(ws + WS_CTR + 1024))[(k) + 1] = __builtin_amdgcn_s_memrealtime(); } } } while (0)

#define MK_RG const RgCtx RG{(const bf16_t*)(ws + WS_XR), (const bf16_t*)(ws + WS_G0), (const bf16_t*)(ws + WS_G1), (const bf16_t*)(dout + DO_Z), KIN[16], KIN[17], (const float*)(ws + WS_SP), (float*)(ws + WS_AGG), (bf16_t*)(dout + DO_YPRE)}
    if (TSTAMP && bx == 0 && wave == 0) { if (fresh_lane() == 0) ((unsigned long long*)(ws + WS_CTR + 1024))[0] = __builtin_amdgcn_s_memrealtime(); }
    for (int rep = 0; rep < REPS(0); ++rep) {
    if (IN(0)) { PH_IDS;
        if (G != 256) { for (int g = bx; g < 64; g += G) s5_precompute(KIN, ws, g, 0, 1, (LAS float*)lds, tid); }
        {
            LAS float* scr = (LAS float*)(lds + wave * 16640);
            constexpr int I_IN = (DM / 64) * (DIN / 64), I_OUT = (DM / 64) * (DM / 64), I_PG = I_OUT, I_GLU = (DS5 / 64) * (DS5 / 64), I_PW = (PLE / 64) * (DM / 64), I_LN = SEQ / 8;
            constexpr int NITEMS = I_IN + I_OUT + I_PG + I_GLU + I_PW + I_LN;
            for (int it = gw; it < NITEMS; it += NGW) {
                int r = it;
                if (r < I_IN) { transpose_item(KIN[4], DM, DIN, (bf16_t*)(ws + WS_WINT), scr, r, lane); continue; } r -= I_IN;
                if (r < I_LN) { for (int q = 0; q < 8; ++q) { const int row = r * 8 + q; ln_row<true>(KIN[0] + (size_t)row * DM, KIN[2], KIN[3], (bf16_t*)(ws + WS_HB) + (size_t)row * DM, lane); } continue; } r -= I_LN;
                if (r < I_OUT) { transpose_item(KIN[25], DM, DM, (bf16_t*)(ws + WS_WOUTT), scr, r, lane); continue; } r -= I_OUT;
                if (r < I_PG) { transpose_item(KIN[34], DM, DM, (bf16_t*)(ws + WS_PLEGT), scr, r, lane); continue; } r -= I_PG;
                if (r < I_GLU) { transpose_item(KIN[14], DS5, DS5, (bf16_t*)(ws + WS_GLUT), scr, r, lane); continue; } r -= I_GLU;
                transpose_item(KIN[33], PLE, DM, (bf16_t*)(ws + WS_PLEWT), scr, r, lane);
            }
        }
        {   const float* pp = KIN[1]; bf16_t* pb = (bf16_t*)(ws + WS_PB);
            for (int i = gtid; i < SEQ * PLE / 4; i += GT) { const f32x4 v = ((const f32x4*)pp)[i]; u32x2 w; w.x = cvt_pk_bf16(v[0], v[1]); w.y = cvt_pk_bf16(v[2], v[3]); ((u32x2*)pb)[i] = w; }
            const float *convw = KIN[16], *convb = KIN[17], *wa = KIN[18], *ba = KIN[19], *wx = KIN[20], *bxx = KIN[21], *lam = KIN[22];
            bf16_t* rgw = (bf16_t*)(ws + WS_RGW);
            for (int i = gtid; i < 16 * 256 * 32; i += GT) { const int h = i >> 13, row = (i >> 5) & 255, K0 = (i & 31) * 8, j = K0 >> 6, i0 = K0 & 63, ch = row >> 2, bj = (row >> 1) & 1, dir = row & 1;
                const float* W = (bj == 0 ? wa : wx) + ((size_t)(dir * 16 + h) * 64) * 64 + ch; float v[8];
#pragma unroll
                for (int k = 0; k < 8; ++k) v[k] = convw[j * 1024 + 64 * h + i0 + k] * W[(size_t)(i0 + k) * 64];
                u32x4 w; w.x = cvt_pk_bf16(v[0], v[1]); w.y = cvt_pk_bf16(v[2], v[3]); w.z = cvt_pk_bf16(v[4], v[5]); w.w = cvt_pk_bf16(v[6], v[7]);
                *(u32x4*)(rgw + ((size_t)h * 256 + row) * 256 + K0) = w; }
            float* rgb = (float*)(ws + WS_RGBIAS);
            for (int i = gtid; i < 16 * 256; i += GT) { const int h = i >> 8, row = i & 255, ch = row >> 2, bj = (row >> 1) & 1, dir = row & 1;
                const float* W = (bj == 0 ? wa : wx) + ((size_t)(dir * 16 + h) * 64) * 64 + ch; float s = (bj == 0 ? ba : bxx)[(dir * 16 + h) * 64 + ch];
                for (int k = 0; k < 64; ++k) s += convb[64 * h + k] * W[(size_t)k * 64];
                rgb[i] = s; }
            float* spt = (float*)(ws + WS_SP);
            for (int i = gtid; i < 2 * 1024; i += GT) spt[i] = -8.0f * log1pf(expf(-lam[i]));
            unsigned* xr = (unsigned*)(ws + WS_XR);
            for (int i = gtid; i < 1024; i += GT) { xr[i] = 0u; xr[(size_t)(SEQ + 2) * 512 + i] = 0u; }
        }
    }
    if (rep + 1 < REPS(0)) { ++nbar; grid_barrier(gbar, nbar * (unsigned)G, wave); } }
    SEAM(0);
    for (int rep = 0; rep < REPS(1); ++rep) {
    if (IN(1)) { PH_IDS;
        SchedStd S; S.so.init(SEQ, DIN, G, bx); S.A = (const char*)(ws + WS_HB); S.B = (const char*)(ws + WS_WINT); S.a_tile = (size_t)256 * DM * 2; S.b_tile = (size_t)256 * DM * 2;
        EpiProj E{(bf16_t*)(dout + DO_U), (bf16_t*)(ws + WS_XR), (bf16_t*)(dout + DO_Z), KIN[5]};
        GEMM_PHASE(lds, wave, GParm{DM, DM * 2, 128, 64, 0}, S, E);
        if (G == 256 && bx >= 128) { __syncthreads(); const int t2 = wave * 64 + fresh_lane(); s5_precompute(KIN, ws, (bx - 128) >> 1, (bx - 128) & 1, 2, (LAS float*)lds, t2); }
    }
    if (rep + 1 < REPS(1)) { ++nbar; grid_barrier(gbar, nbar * (unsigned)G, wave); } }
    SEAM(1);
    for (int rep = 0; rep < REPS(2); ++rep) {
    if (IN(2)) { PH_IDS;
        { SchedS5a S{(const char*)(dout + DO_U), (const char*)(ws + WS_WG), G, bx}; EpiS5a E{(bf16_t*)(ws + WS_YINTRA), (float*)(ws + WS_S)};
          GEMM_PHASE(lds, wave, GParm{512, 1024, 128, 64, 0}, S, E); }
        { SchedRG S{(const char*)(ws + WS_XR), (const char*)(ws + WS_RGW), G, bx}; EpiG E{(bf16_t*)(ws + WS_G0), (bf16_t*)(ws + WS_G1), (const float*)(ws + WS_RGBIAS)};
          GEMM_PHASE(lds, wave, GParm{256, 2048, 2048, 64, 0}, S, E); }
    }
    if (rep + 1 < REPS(2)) { ++nbar; grid_barrier(gbar, nbar * (unsigned)G, wave); } }
    SEAM(2);
    for (int rep = 0; rep < REPS(3); ++rep) {
    if (IN(3)) { PH_IDS;
        if (bx < 128) {
            const int g = bx >> 1, n = bx & 1; const float* Sg = (const float*)(ws + WS_S) + (size_t)g * NCH * 256 + n * 128; LAS float* Ls = (LAS float*)lds;
            for (int i = tid; i < NCH * 32; i += 512) { const int c = i >> 5, q4 = (i & 31) * 4; *(LAS f32x4*)(Ls + c * 128 + q4) = *(const f32x4*)(Sg + (size_t)c * 256 + q4); }
            __syncthreads();
            if (wave == 0) { const int p = lane, pi = (n * 64 + g) * 64 + p;
                const float lr = fminf(KIN[6][pi], -1e-4f), li = KIN[7][pi], step = expf(KIN[8][n * 64 + g]); float ar, ai; cpow(lr * step, li * step, TC, ar, ai);
                bf16_t* hp = (bf16_t*)(ws + WS_HPREV) + (size_t)g * NCH * 256 + n * 128; float hr = 0.f, him = 0.f;
                for (int cc = 0; cc < NCH; ++cc) { const int c = n == 0 ? cc : NCH - 1 - cc;
                    hp[(size_t)c * 256 + p] = (bf16_t)(cvt_pk_bf16(hr, 0.f) & 0xffffu); hp[(size_t)c * 256 + 64 + p] = (bf16_t)(cvt_pk_bf16(him, 0.f) & 0xffffu);
                    const float sr = Ls[c * 128 + p], si = Ls[c * 128 + 64 + p]; const float nr = ar * hr - ai * him + sr, ni = ar * him + ai * hr + si; hr = nr; him = ni; } }
            __syncthreads();
        }
        { MK_RG; for (int un = bx; un < 256; un += G) rg_pass_a(RG, un & 1, un >> 1, tid); }
    }
    if (rep + 1 < REPS(3)) { ++nbar; grid_barrier(gbar, nbar * (unsigned)G, wave); } }
    SEAM(3);
    for (int rep = 0; rep < REPS(4); ++rep) {
    if (IN(4)) { PH_IDS;
#if NAIVE_S5
        if (gw < 64) naive_s5_group((const float* const*)0, (const bf16_t*)(dout + DO_U), (float*)(ws + WS_YINTRA), (bf16_t*)(ws + WS_YS5G), gw, lane);
#else
        { SchedS5b S{(const char*)(ws + WS_HPREV), (const char*)(ws + WS_WC), G, bx}; EpiS5b E{(const bf16_t*)(ws + WS_YINTRA), (bf16_t*)(ws + WS_YS5G)};
          GEMM_PHASE(lds, wave, GParm{256, 512, 128, 64, 0}, S, E); }
#endif
#if NAIVE_RG
        { MK_RG; if (gtid < 1024) naive_rg_channel(RG, gtid); }
#else
        { MK_RG; __syncthreads(); for (int un = bx; un < 256; un += G) { rg_pass_c(RG, un & 1, un >> 1, tid, (LAS float*)lds); __syncthreads(); } }
#endif
    }
    if (rep + 1 < REPS(4)) { ++nbar; grid_barrier(gbar, nbar * (unsigned)G, wave); } }
    SEAM(4);
    for (int rep = 0; rep < REPS(5); ++rep) {
    if (IN(5)) { PH_IDS;
        SchedStd S; S.so.init(SEQ, DS5, G, bx); S.A = (const char*)(ws + WS_YS5G); S.B = (const char*)(ws + WS_GLUT); S.a_tile = (size_t)256 * 16 * 2; S.b_tile = (size_t)256 * DS5 * 2;
        EpiGlu E{(const bf16_t*)(ws + WS_YS5G), (bf16_t*)(dout + DO_YPRE), KIN[15]};
        GEMM_PHASE(lds, wave, GParm{DS5, 32, 4u * GM_STRIDE * 2u, 16, GM_STRIDE}, S, E);
        if (G == 256 && bx >= 128) {
            LAS float* scr = (LAS float*)(lds + wave * 16640); constexpr int I_FF1 = (DM / 64) * (DFF / 64);
            for (int it = (bx - 128) * 8 + wave; it < I_FF1; it += 1024) transpose_item(KIN[29], DM, DFF, (bf16_t*)(ws + WS_FF1T), scr, it, lane); }
    }
    if (rep + 1 < REPS(5)) { ++nbar; grid_barrier(gbar, nbar * (unsigned)G, wave); } }
    SEAM(5);
    for (int rep = 0; rep < REPS(6); ++rep) {
    if (IN(6)) { PH_IDS;
        const float *g5 = KIN[23], *gr = KIN[24];
        for (int row = gw; row < SEQ; row += NGW) { const u32x4* yr = (const u32x4*)(dout + DO_YPRE) + (size_t)row * 256; u32x4* oc = (u32x4*)(ws + WS_YCAT) + (size_t)row * 256;
            u32x4 w[4]; float s0 = 0.f, s1 = 0.f;
#pragma unroll
            for (int j = 0; j < 4; ++j) { w[j] = yr[lane + 64 * j]; const float q = bf_lo(w[j].x) * bf_lo(w[j].x) + bf_hi(w[j].x) * bf_hi(w[j].x) + bf_lo(w[j].y) * bf_lo(w[j].y) + bf_hi(w[j].y) * bf_hi(w[j].y)
                + bf_lo(w[j].z) * bf_lo(w[j].z) + bf_hi(w[j].z) * bf_hi(w[j].z) + bf_lo(w[j].w) * bf_lo(w[j].w) + bf_hi(w[j].w) * bf_hi(w[j].w); if (j < 2) s0 += q; else s1 += q; }
            const float r0 = 1.0f / sqrtf(wave_sum(s0) * (1.f / 1024.f) + LN_EPS), r1 = 1.0f / sqrtf(wave_sum(s1) * (1.f / 1024.f) + LN_EPS);
#pragma unroll
            for (int j = 0; j < 4; ++j) { const int col = (lane + 64 * j) * 8; const float rs = j < 2 ? r0 : r1; const float* gp = j < 2 ? g5 + col : gr + (col - 1024);
                const f32x4 ga = *(const f32x4*)gp, gb = *(const f32x4*)(gp + 4);
                u32x4 o; o.x = cvt_pk_bf16(bf_lo(w[j].x) * rs * ga[0], bf_hi(w[j].x) * rs * ga[1]); o.y = cvt_pk_bf16(bf_lo(w[j].y) * rs * ga[2], bf_hi(w[j].y) * rs * ga[3]);
                o.z = cvt_pk_bf16(bf_lo(w[j].z) * rs * gb[0], bf_hi(w[j].z) * rs * gb[1]); o.w = cvt_pk_bf16(bf_lo(w[j].w) * rs * gb[2], bf_hi(w[j].w) * rs * gb[3]); oc[lane + 64 * j] = o; } }
        {
            LAS float* scr = (LAS float*)(lds + wave * 16640);
            constexpr int I_FF1 = (DM / 64) * (DFF / 64), I_FF2 = (DFF / 64) * (DM / 64);
            for (int it = gw; it < (G == 256 ? I_FF2 : I_FF1 + I_FF2); it += NGW) {
                if (it < I_FF2) transpose_item(KIN[31], DFF, DM, (bf16_t*)(ws + WS_FF2T), scr, it, lane);
                else transpose_item(KIN[29], DM, DFF, (bf16_t*)(ws + WS_FF1T), scr, it - I_FF2, lane); }
        }
    }
    if (rep + 1 < REPS(6)) { ++nbar; grid_barrier(gbar, nbar * (unsigned)G, wave); } }
    SEAM(6);
    for (int rep = 0; rep < REPS(7); ++rep) {
    if (IN(7)) { PH_IDS;
        SchedStd S; S.so.init(SEQ, DM, G, bx); S.A = (const char*)(ws + WS_YCAT); S.B = (const char*)(ws + WS_WOUTT); S.a_tile = (size_t)256 * DM * 2; S.b_tile = (size_t)256 * DM * 2;
        EpiResLn1 E{(bf16_t*)(ws + WS_HB), KIN[26], KIN[27], KIN[28], PanelStats8{(unsigned long long*)(ws + WS_AGG), (unsigned*)(ws + WS_CTR) + 1024, LN_EPS}};
        GEMM_PHASE(lds, wave, GParm{DM, DM * 2, 128, 64, 0}, S, E);
    }
    if (rep + 1 < REPS(7)) { ++nbar; grid_barrier(gbar, nbar * (unsigned)G, wave); } }
    for (int rep = 0; rep < REPS(8); ++rep) {
    if (IN(8)) { }
    if (rep + 1 < REPS(8)) { ++nbar; grid_barrier(gbar, nbar * (unsigned)G, wave); } }
    SEAM(8);
    for (int rep = 0; rep < REPS(9); ++rep) {
    if (IN(9)) { PH_IDS;
        { SchedStd S; S.so.init(SEQ, DFF, G, bx); S.A = (const char*)(ws + WS_HB); S.B = (const char*)(ws + WS_FF1T); S.a_tile = (size_t)256 * DM * 2; S.b_tile = (size_t)256 * DM * 2;
          EpiPlain<1> E{(bf16_t*)(ws + WS_T), DFF, KIN[30], 0}; GEMM_PHASE(lds, wave, GParm{DM, DM * 2, 128, 64, 0}, S, E); }
        { SchedStd S; S.so.init(SEQ, DM, G, bx); S.A = (const char*)(ws + WS_HB); S.B = (const char*)(ws + WS_PLEGT); S.a_tile = (size_t)256 * DM * 2; S.b_tile = (size_t)256 * DM * 2;
          EpiPlain<2> E{(bf16_t*)dout, DM, KIN[35], (size_t)1 << 20}; GEMM_PHASE(lds, wave, GParm{DM, DM * 2, 128, 64, 0}, S, E); }
        { SchedStd S; S.so.init(SEQ, DM, G, bx); S.A = (const char*)(ws + WS_PB); S.B = (const char*)(ws + WS_PLEWT); S.a_tile = (size_t)256 * PLE * 2; S.b_tile = (size_t)256 * PLE * 2;
          EpiPlain<0> E{(bf16_t*)dout + ((size_t)1 << 19), DM, nullptr, (size_t)1 << 20}; GEMM_PHASE(lds, wave, GParm{PLE, PLE * 2, 128, 64, 0}, S, E); }
    }
    if (rep + 1 < REPS(9)) { ++nbar; grid_barrier(gbar, nbar * (unsigned)G, wave); } }
    SEAM(9);
    for (int rep = 0; rep < REPS(10); ++rep) {
    if (IN(10)) { PH_IDS;
        SchedStd S; S.so.init(SEQ, DM, G, bx); S.A = (const char*)(ws + WS_T); S.B = (const char*)(ws + WS_FF2T); S.a_tile = (size_t)256 * DFF * 2; S.b_tile = (size_t)256 * DFF * 2;
        EpiResLn2 E{(const bf16_t*)(ws + WS_HB), KIN[32], KIN[36], KIN[37], (float*)dout, (const bf16_t*)dout, PanelStats8{(unsigned long long*)(ws + WS_AGG) + 65536, (unsigned*)(ws + WS_CTR) + 1024 + 64 * 32, LN_EPS}};
        GEMM_PHASE(lds, wave, GParm{DFF, DFF * 2, 128, 64, 0}, S, E);
    }
    if (rep + 1 < REPS(10)) { ++nbar; grid_barrier(gbar, nbar * (unsigned)G, wave); } }
    for (int rep = 0; rep < REPS(11); ++rep) {
    if (IN(11)) { }
    if (rep + 1 < REPS(11)) { ++nbar; grid_barrier(gbar, nbar * (unsigned)G, wave); } }
#if TSTAMP
    if (bx == 0 && wave == 0) { if (fresh_lane() == 0) { unsigned long long* st = (unsigned long long*)(ws + WS_CTR + 1024); st[12] = __builtin_amdgcn_s_memrealtime();
        ((float*)KIN[38])[0] = (float)(long long)(__hip_atomic_load(st + TS_A1, __ATOMIC_RELAXED, __HIP_MEMORY_SCOPE_AGENT) - __hip_atomic_load(st + TS_A0, __ATOMIC_RELAXED, __HIP_MEMORY_SCOPE_AGENT)) * 0.01f; } }
#endif
#if DIAG
    { ++nbar; grid_barrier(gbar, nbar * (unsigned)G, wave); PH_IDS; unsigned* flagw = (unsigned*)(ws + WS_CTR) + 48;
#if DIAG == 1
      diag_ffn((const float* const*)0, ws, ((float*)KIN[38]), flagw, gtid, GT);
#elif DIAG == 2
      diag_pre((const float* const*)0, ws, dout, flagw, gtid, GT);
#elif DIAG == 3
      diag_v((const float* const*)0, ws, dout, flagw, gtid, GT);
#elif DIAG == 4
      diag_g((const float* const*)0, ws, flagw, gtid, GT);
#elif DIAG == 6
      diag_max(ws, flagw, gtid, GT);
#else
      if (bx == 0 && tid == 0) flagw[1] = 0xffffffffu;
      ++nbar; grid_barrier(gbar, nbar * (unsigned)G, wave);
#if DIAG == 7
      diag_rows(((float*)KIN[38]), flagw, gw, NGW, lane);
#elif DIAG == 8
      diag_rows_bf((const bf16_t*)(ws + WS_HB), DM, 12.0f, flagw, gw, NGW, lane);
#elif DIAG == 9
      diag_rows((const float*)(ws + WS_V2), flagw, gw, NGW, lane);
#elif DIAG == 10
      diag_rows_bf((const bf16_t*)(ws + WS_T), DFF, 150.0f, flagw, gw, NGW, lane);
#elif DIAG == 11
      diag_rows_bf((const bf16_t*)(dout + DO_PW), DM, 8.0f, flagw, gw, NGW, lane);
#elif DIAG == 12
      diag_rows_bf((const bf16_t*)(dout + DO_SG), DM, 1.01f, flagw, gw, NGW, lane);
#endif
#endif
      ++nbar; grid_barrier(gbar, nbar * (unsigned)G, wave);
#if DIAG != 1
      for (int i = gtid; i < SEQ * DM; i += GT) ((float*)KIN[38])[i] = 0.f;
      ++nbar; grid_barrier(gbar, nbar * (unsigned)G, wave);
#endif
      if (bx == 0 && tid == 0) { unsigned code = 0; for (int q = 0; q < 4; ++q) if (__hip_atomic_load(flagw + q, __ATOMIC_RELAXED, __HIP_MEMORY_SCOPE_AGENT) > 100u) code |= 1u << q; if (DIAG >= 7) { const unsigned cnt = __hip_atomic_load(flagw, __ATOMIC_RELAXED, __HIP_MEMORY_SCOPE_AGENT), mn = __hip_atomic_load(flagw + 1, __ATOMIC_RELAXED, __HIP_MEMORY_SCOPE_AGENT), mxr = __hip_atomic_load(flagw + 2, __ATOMIC_RELAXED, __HIP_MEMORY_SCOPE_AGENT);
          const unsigned v = DIAG_SEL == 0 ? cnt : DIAG_SEL == 1 ? mn / 100u : DIAG_SEL == 2 ? mn % 100u : DIAG_SEL == 3 ? mxr / 100u : mxr % 100u; ((float*)KIN[38])[0] = 100.0f * (float)(v + 1u); }
      else ((float*)KIN[38])[0] = (DIAG == 6) ? 1000.0f * __uint_as_float(__hip_atomic_load(flagw, __ATOMIC_RELAXED, __HIP_MEMORY_SCOPE_AGENT)) : 1000.0f * (float)(code + 16u); } }
#endif
#undef IN
#undef SEAM
}


#if PER_PHASE_LAUNCH
template <int PH> static void set_attr_one() { (void)hipFuncSetAttribute((const void*)mega<(1 << PH)>, hipFuncAttributeMaxDynamicSharedMemorySize, LDS_BYTES); }
template <int PH> static void launch_one(Args a, int grid, hipStream_t stream) { a.ph_lo = PH; a.ph_hi = PH + 1; hipLaunchKernelGGL(mega<(1 << PH)>, dim3(grid), dim3(512), LDS_BYTES, stream, a); }
static void set_attrs() { set_attr_one<0>(); set_attr_one<1>(); set_attr_one<2>(); set_attr_one<3>(); set_attr_one<4>(); set_attr_one<5>(); set_attr_one<6>(); set_attr_one<7>(); set_attr_one<8>(); set_attr_one<9>(); set_attr_one<10>(); set_attr_one<11>(); }
static void launch_phases(const Args& a, int grid, hipStream_t stream) { launch_one<0>(a, grid, stream); launch_one<1>(a, grid, stream); launch_one<2>(a, grid, stream); launch_one<3>(a, grid, stream); launch_one<4>(a, grid, stream); launch_one<5>(a, grid, stream);
    launch_one<6>(a, grid, stream); launch_one<7>(a, grid, stream); launch_one<8>(a, grid, stream); launch_one<9>(a, grid, stream); launch_one<10>(a, grid, stream); launch_one<11>(a, grid, stream); }
#else
static void set_attrs() { (void)hipFuncSetAttribute((const void*)mega<0xfff>, hipFuncAttributeMaxDynamicSharedMemorySize, LDS_BYTES); }
#endif

extern "C" void kernel_launch(void* const* d_in, const int* in_sizes, int n_in, void* d_out, int out_size, void* d_ws, size_t ws_size, hipStream_t stream) {
    static int grid = 0;
    if (grid == 0) {
        if (n_in != 38 || out_size != SEQ * DM || ws_size < WS_END) { fprintf(stderr, "kernel_launch: unexpected shapes (n_in %d out %d ws %zu)\n", n_in, out_size, ws_size); grid = -1; return; }
        int dev = 0, cus = 0, per_cu = 0;
        hipGetDevice(&dev); hipDeviceGetAttribute(&cus, hipDeviceAttributeMultiprocessorCount, dev);
        set_attrs();
        per_cu = 1;
        (void)hipGetLastError();
        if (per_cu < 1) per_cu = 1;
        grid = cus;
    }
    if (grid < 0) return;
#ifdef POISON_NAN
    hipMemsetAsync(d_ws, 0xFF, WS_END, stream); hipMemsetAsync(d_out, 0xFF, (size_t)64 * MiB, stream);
#endif
    hipMemsetAsync((char*)d_ws + WS_CTR, 0, 32768, stream);
    Args a{};
    for (int i = 0; i < 38; ++i) a.in[i] = (const float*)d_in[i];
    a.out = (float*)d_out; a.ws = (unsigned char*)d_ws;
#if PER_PHASE_LAUNCH
    launch_phases(a, grid, stream);
#else
    a.ph_lo = 0; a.ph_hi = NPHASE;
    void* kargs[] = {&a};
    hipError_t e = hipLaunchCooperativeKernel((const void*)mega<0xfff>, dim3(grid), dim3(512), kargs, LDS_BYTES, stream);
    if (e != hipSuccess) fprintf(stderr, "cooperative launch failed: %s (grid %d)\n", hipGetErrorString(e), grid);
#endif
}
```

```cpp
#include <hip/hip_runtime.h>
#include <hip/hip_cooperative_groups.h>
#include <cstdio>
#include <cstdint>
namespace cg = cooperative_groups;

#ifndef PER_PHASE_LAUNCH
#define PER_PHASE_LAUNCH 0
#endif

#ifndef TSTAMP
#define TSTAMP 0
#define TS_A0 22
#define TS_A1 23
#define TS_B0 9
#define TS_B1 12
#endif
#define LAS __attribute__((address_space(3)))
typedef unsigned short bf16_t;
typedef short bf16x8 __attribute__((ext_vector_type(8)));
typedef float f32x4 __attribute__((ext_vector_type(4)));
typedef float f32x2 __attribute__((ext_vector_type(2)));
typedef unsigned u32x4 __attribute__((ext_vector_type(4)));
typedef unsigned u32x2 __attribute__((ext_vector_type(2)));

constexpr int SEQ = 8192, DM = 2048, DIN = 3072, DS5 = 1024, DRG = 1024, NG = 64, NP = 64, NK = 16, NH = 16, HD = 64, DFF = 8192, PLE = 256;
constexpr int TC = 32, NCH = SEQ / TC;
constexpr float LN_EPS = 1e-5f, DN_ALPHA = 1.18920711500272f;
constexpr int NPHASE = 12;

constexpr size_t MiB = (size_t)1 << 20;
constexpr size_t WS_FF2T = 0, WS_HB = 32 * MiB, WS_FF1T = 64 * MiB, WS_PLEGT = 96 * MiB, WS_PLEWT = 104 * MiB, WS_PB = 105 * MiB, WS_WOUTT = 109 * MiB,
    WS_V2 = 64 * MiB, WS_G0 = 0, WS_G1 = 64 * MiB,
    WS_WG = 128 * MiB, WS_WC = 176 * MiB, WS_RGW = 192 * MiB, WS_GLUT = 194 * MiB, WS_XR = 196 * MiB, WS_YINTRA = 213 * MiB, WS_S = 229 * MiB, WS_HPREV = 245 * MiB, WS_WINT = 229 * MiB,
    WS_YS5G = 128 * MiB, WS_YCAT = 144 * MiB, WS_T = 128 * MiB,
    WS_AGG = 256 * MiB, WS_CARRY = 258 * MiB, WS_SUMSQ = 259 * MiB, WS_RGBIAS = 259 * MiB + 64 * 1024, WS_SP = WS_RGBIAS + 16 * 1024, WS_CTR = WS_SP + 8 * 1024, WS_END = 260 * MiB;
constexpr size_t DO_YPRE = 0, DO_Z = 32 * MiB, DO_U = 48 * MiB, DO_SG = 0, DO_PW = 32 * MiB;
constexpr int GM_STRIDE = SEQ * 16;
constexpr int LDS_BYTES = 152 * 1024;

typedef __bf16 bf16x2_t __attribute__((ext_vector_type(2)));
__device__ __forceinline__ unsigned cvt_pk_bf16(float lo, float hi) { const f32x2 v = {lo, hi}; const bf16x2_t b = __builtin_convertvector(v, bf16x2_t); return __builtin_bit_cast(unsigned, b); }
__device__ __forceinline__ float bf_lo(unsigned w) { return __uint_as_float(w << 16); }
__device__ __forceinline__ float bf_hi(unsigned w) { return __uint_as_float(w & 0xffff0000u); }
__device__ __forceinline__ f32x4 bf4(u32x2 w) { return (f32x4){bf_lo(w.x), bf_hi(w.x), bf_lo(w.y), bf_hi(w.y)}; }
__device__ __forceinline__ float fast_sigmoid(float x) { return __builtin_amdgcn_rcpf(1.0f + __expf(-x)); }
__device__ __forceinline__ float gelu_tanh(float x) { const float u = 1.5957691216057308f * (x + 0.044715f * x * x * x); return x * fast_sigmoid(u); }
__device__ __forceinline__ float wave_sum(float v) {
#pragma unroll
    for (int o = 1; o < 64; o <<= 1) v += __shfl_xor(v, o);
    return v;
}
__device__ __forceinline__ int lane_id() { return (int)__builtin_amdgcn_mbcnt_hi(~0u, __builtin_amdgcn_mbcnt_lo(~0u, 0u)); }
__device__ __forceinline__ int fresh_lane() { unsigned z = 0; asm volatile("" : "+s"(z)); return (int)__builtin_amdgcn_mbcnt_hi(~0u, __builtin_amdgcn_mbcnt_lo(~0u, z)); }
#define LDS_WAIT() asm volatile("s_waitcnt lgkmcnt(0)" ::: "memory")

namespace pg8 {
constexpr int BM = 256, BK = 64, HALF = 128, HTB = HALF * BK * 2, STAGE_BYTES = 8 * HTB, NXCD = 8, WGM = 8;
__host__ __device__ __forceinline__ int lds_byte(int r, int c) { const int st = (r >> 4) * 2 + (c >> 5), rr = r & 15, cc = c & 31, ob = rr * 64 + cc * 2; return st * 1024 + (ob ^ (((ob >> 9) & 1) << 5)); }
__host__ __device__ __forceinline__ void stage_rc(int b, int& R, int& C) { const int st = b / 1024, sb = b % 1024, swz = sb ^ (((sb >> 9) & 1) << 5); R = (st >> 1) * 16 + swz / 64; C = (st & 1) * 32 + (swz % 64) / 2; }
__host__ __device__ __forceinline__ int perm32(int rho) { const int n = rho >> 4, i = rho & 15; return 8 * (i >> 2) + 4 * n + (i & 3); }

struct Unit { int pm, pn; };
struct StaticOrder {
    int nM, nN, nwg, G, c;
    __host__ __device__ void init(int M, int N, int G_, int c_) { nM = M / BM; nN = N / BM; nwg = nM * nN; G = G_; c = c_; }
    __host__ __device__ bool next(int i, Unit& u) const {
        const long L = (long)i * G + c; if (L >= nwg) return false;
        int wgid = (int)L; { const int q = nwg / NXCD, r = nwg % NXCD, xcd = wgid % NXCD, off = wgid / NXCD; wgid = (xcd < r ? xcd * (q + 1) : r * (q + 1) + (xcd - r) * q) + off; }
        const int nig = WGM * nN, gid = wgid / nig, fm = gid * WGM, gsz = (nM - fm) < WGM ? (nM - fm) : WGM;
        u.pm = fm + ((wgid % nig) % gsz); u.pn = (wgid % nig) / gsz; return true;
    }
};
struct GUnit { const char* A; const char* B; int i0, i1; };
struct GParm { int K; unsigned a_rs, a_ks; int a_cw, a_cs; };

template <class Epi, class Sched>
__device__ __forceinline__ void gemm_phase(LAS unsigned char* lds, const int wid, const GParm gp, const Sched& S, const Epi& E) {
    const int lane = fresh_lane(), tid = wid * 64 + lane, wr = wid >> 2, wc = wid & 3, fr = lane & 15, fq = lane >> 4;
    const int K = gp.K, nt = K / BK;
    unsigned voffA[2], voffB[2];
#pragma unroll
    for (int i = 0; i < 2; ++i) { int R, C; stage_rc(tid * 16 + i * 8192, R, C); const int Rb = Epi::PERM ? ((R & ~31) + perm32(R & 31)) : R;
        voffA[i] = (unsigned)R * gp.a_rs + (unsigned)((C / gp.a_cw) * gp.a_cs + (C % gp.a_cw)) * 2u; voffB[i] = (unsigned)(Rb * K + C) * 2u; }
    const size_t ksA = gp.a_ks, ksB = (size_t)(BK * 2);
    const size_t hsA = (size_t)HALF * gp.a_rs, hsB = (size_t)HALF * K * 2;
    const unsigned ldsw = (unsigned)wid * 1024u;
    const int aoff = lds_byte(wr * 64 + fr, fq * 8), boff = lds_byte(wc * 32 + fr, fq * 8);
#define PG8_SA(b, h) (((b) * 2 + (h)) * HTB)
#define PG8_SB(b, h) ((4 + (b) * 2 + (h)) * HTB)
#define PG8_STAGE(bufoff, gbase, voff) do { _Pragma("unroll") for (int _i = 0; _i < 2; ++_i) \
        __builtin_amdgcn_global_load_lds((const unsigned*)((const char*)(gbase) + (voff)[_i]), (LAS unsigned*)(lds + (bufoff) + ldsw + _i * 8192), 16, 0, 0); } while (0)
#define PG8_LDA(dst, b, h) do { _Pragma("unroll") for (int m = 0; m < 4; ++m) _Pragma("unroll") for (int k = 0; k < 2; ++k) dst[m][k] = *(const LAS bf16x8*)(lds + PG8_SA(b, h) + aoff + m * 2048 + k * 1024); } while (0)
#define PG8_LDB(dst, b, h) do { _Pragma("unroll") for (int n = 0; n < 2; ++n) _Pragma("unroll") for (int k = 0; k < 2; ++k) dst[n][k] = *(const LAS bf16x8*)(lds + PG8_SB(b, h) + boff + n * 2048 + k * 1024); } while (0)
#define PG8_MMA(ai, bj, At, Bt) do { __builtin_amdgcn_s_setprio(1); _Pragma("unroll") for (int m = 0; m < 4; ++m) _Pragma("unroll") for (int n = 0; n < 2; ++n) _Pragma("unroll") for (int k = 0; k < 2; ++k) \
        acc[ai][bj][m][n] = __builtin_amdgcn_mfma_f32_16x16x32_bf16(Bt[n][k], At[m][k], acc[ai][bj][m][n], 0, 0, 0); __builtin_amdgcn_s_setprio(0); } while (0)
#define PG8_WAIT_V(n) asm volatile("s_waitcnt vmcnt(" #n ")" ::: "memory")
#define PG8_WAIT_L(n) asm volatile("s_waitcnt lgkmcnt(" #n ")" ::: "memory")
#define PG8_BAR __builtin_amdgcn_s_barrier()
#define PG8_SCHED __builtin_amdgcn_sched_barrier(0)
    GUnit cur, nxt; int ui = 0;
    if (!S.next(0, cur)) return;
    f32x4 acc[2][2][4][2];
#pragma unroll
    for (int a = 0; a < 2; ++a)
#pragma unroll
        for (int b = 0; b < 2; ++b)
#pragma unroll
            for (int m = 0; m < 4; ++m)
#pragma unroll
                for (int n = 0; n < 2; ++n) acc[a][b][m][n] = (f32x4){0.f, 0.f, 0.f, 0.f};
    bf16x8 At[4][2], B0[2][2], B1[2][2];
    const char* cA = cur.A; const char* cB = cur.B;
    PG8_STAGE(PG8_SB(0, 0), cB, voffB); PG8_STAGE(PG8_SB(0, 1), cB + hsB, voffB); PG8_STAGE(PG8_SA(0, 0), cA, voffA); PG8_STAGE(PG8_SA(0, 1), cA + hsA, voffA);
    if (wr == 1) PG8_BAR;
    PG8_WAIT_V(2); PG8_BAR;
    PG8_STAGE(PG8_SB(1, 0), cB + ksB, voffB); PG8_STAGE(PG8_SA(1, 0), cA + ksA, voffA); PG8_STAGE(PG8_SB(1, 1), cB + hsB + ksB, voffB);
    PG8_WAIT_V(6); PG8_BAR;
    for (;;) {
        const bool has_next = S.next(ui + 1, nxt);
        const char* nA = has_next ? nxt.A : cA; const char* nB = has_next ? nxt.B : cB;
        for (int t = 0; t < nt; t += 2) {
            const bool last = (t == nt - 2);
            const char* a1 = cA + (size_t)(t + 1) * ksA;
            const char* a2 = last ? nA : cA + (size_t)(t + 2) * ksA; const char* b2 = last ? nB : cB + (size_t)(t + 2) * ksB;
            const char* a3 = a2 + ksA; const char* b3 = b2 + ksB;
            PG8_LDB(B0, 0, 0); PG8_LDB(B1, 0, 1); PG8_SCHED; PG8_LDA(At, 0, 0); PG8_STAGE(PG8_SA(1, 1), a1 + hsA, voffA);
            PG8_WAIT_V(8); PG8_WAIT_L(0); PG8_BAR; PG8_MMA(0, 0, At, B0); PG8_MMA(0, 1, At, B1); PG8_BAR; PG8_SCHED;
            PG8_LDA(At, 0, 1); PG8_STAGE(PG8_SB(0, 0), b2, voffB); PG8_STAGE(PG8_SB(0, 1), b2 + hsB, voffB); PG8_STAGE(PG8_SA(0, 0), a2, voffA);
            PG8_WAIT_V(8); PG8_WAIT_L(0); PG8_BAR; PG8_MMA(1, 0, At, B0); PG8_MMA(1, 1, At, B1); PG8_BAR; PG8_SCHED;
            PG8_LDB(B0, 1, 0); PG8_LDB(B1, 1, 1); PG8_SCHED; PG8_LDA(At, 1, 0); PG8_STAGE(PG8_SA(0, 1), a2 + hsA, voffA);
            PG8_WAIT_V(8); PG8_WAIT_L(0); PG8_BAR; PG8_MMA(0, 0, At, B0); PG8_MMA(0, 1, At, B1); PG8_BAR; PG8_SCHED;
            PG8_LDA(At, 1, 1); PG8_STAGE(PG8_SB(1, 0), b3, voffB); PG8_STAGE(PG8_SB(1, 1), b3 + hsB, voffB); PG8_STAGE(PG8_SA(1, 0), a3, voffA);
            PG8_WAIT_V(8); PG8_WAIT_L(0); PG8_BAR; PG8_MMA(1, 0, At, B0); PG8_MMA(1, 1, At, B1); PG8_BAR; PG8_SCHED;
        }
        if (wr == 0) PG8_BAR;
        if constexpr (!Epi::AFTER_DRAIN) { const int l_o = fresh_lane(); E(acc, cur, wr, wc, l_o & 15, l_o >> 4); }
        if (!has_next) break;
#pragma unroll
        for (int a = 0; a < 2; ++a)
#pragma unroll
            for (int b = 0; b < 2; ++b)
#pragma unroll
                for (int m = 0; m < 4; ++m)
#pragma unroll
                    for (int n = 0; n < 2; ++n) acc[a][b][m][n] = (f32x4){0.f, 0.f, 0.f, 0.f};
        cur = nxt; cA = nA; cB = nB; ++ui;
        if (wr == 1) PG8_BAR;
    }
    PG8_WAIT_V(0);
    PG8_BAR;
    if constexpr (Epi::AFTER_DRAIN) { const int l_o = fresh_lane(); E.fused(acc, cur, wr, wc, l_o & 15, l_o >> 4, lds, wid); }
#undef PG8_SA
#undef PG8_SB
#undef PG8_STAGE
#undef PG8_LDA
#undef PG8_LDB
#undef PG8_MMA
#undef PG8_WAIT_V
#undef PG8_WAIT_L
#undef PG8_BAR
#undef PG8_SCHED
}
}
using pg8::GUnit; using pg8::GParm;
typedef f32x4 AccT[2][2][4][2];

struct SchedStd {
    pg8::StaticOrder so; const char* A; const char* B; size_t a_tile, b_tile;
    __device__ __forceinline__ bool next(int i, GUnit& u) const { pg8::Unit t; if (!so.next(i, t)) return false; u.A = A + (size_t)t.pm * a_tile; u.B = B + (size_t)t.pn * b_tile; u.i0 = t.pm; u.i1 = t.pn; return true; }
};
struct SchedS5a { const char* U; const char* WG; int G, c;
    __device__ __forceinline__ bool next(int i, GUnit& u) const { const int L = i * G + c; if (L >= 192) return false; const int g = L / 3, pn = L % 3;
        u.A = U + (size_t)g * GM_STRIDE * 2; u.B = WG + ((size_t)g * 768 + 256 * pn) * 512 * 2; u.i0 = g; u.i1 = pn; return true; } };
struct SchedS5b { const char* HP; const char* WC; int G, c;
    __device__ __forceinline__ bool next(int i, GUnit& u) const { const int L = i * G + c; if (L >= 128) return false; const int g = L / 2, pn = L % 2;
        u.A = HP + (size_t)g * 256 * 256 * 2; u.B = WC + ((size_t)g * 512 + 256 * pn) * 256 * 2; u.i0 = g; u.i1 = pn; return true; } };
struct SchedRG { const char* XR; const char* RGW; int G, c;
    __device__ __forceinline__ bool next(int i, GUnit& u) const { const int L = i * G + c; if (L >= 512) return false; const int h = L % 16, pm = L / 16;
        u.A = XR + ((size_t)(256 * pm) * 1024 + 64 * h) * 2; u.B = RGW + (size_t)h * 256 * 256 * 2; u.i0 = pm; u.i1 = h; return true; } };

template <int ACT> __device__ __forceinline__ void epi_bf16_store(const AccT& acc, bf16_t* tile, int ldc, const float* biast, int wr, int wc, int fr, int fq) {
    const int r0 = wr * 64 + fr, c0 = wc * 32 + 8 * fq;
    f32x4 bv[2][2];
#pragma unroll
    for (int bj = 0; bj < 2; ++bj)
#pragma unroll
        for (int n = 0; n < 2; ++n) bv[bj][n] = biast ? *(const f32x4*)(biast + c0 + bj * 128 + 4 * n) : (f32x4){0.f, 0.f, 0.f, 0.f};
#pragma unroll
    for (int ai = 0; ai < 2; ++ai)
#pragma unroll
        for (int m = 0; m < 4; ++m) { bf16_t* rowp = tile + (size_t)(r0 + ai * 128 + m * 16) * ldc + c0;
#pragma unroll
            for (int bj = 0; bj < 2; ++bj) { f32x4 v0 = acc[ai][bj][m][0] + bv[bj][0], v1 = acc[ai][bj][m][1] + bv[bj][1];
                if (ACT == 1) {
#pragma unroll
                    for (int j = 0; j < 4; ++j) { const float a = fmaxf(v0[j], 0.f), b = fmaxf(v1[j], 0.f); v0[j] = a * a; v1[j] = b * b; } }
                if (ACT == 2) {
#pragma unroll
                    for (int j = 0; j < 4; ++j) { v0[j] = fast_sigmoid(v0[j]); v1[j] = fast_sigmoid(v1[j]); } }
                u32x4 w; w.x = cvt_pk_bf16(v0[0], v0[1]); w.y = cvt_pk_bf16(v0[2], v0[3]); w.z = cvt_pk_bf16(v1[0], v1[1]); w.w = cvt_pk_bf16(v1[2], v1[3]);
                *(u32x4*)(rowp + bj * 128) = w; } }
}
struct EpiProj { static constexpr bool PERM = true, AFTER_DRAIN = false; bf16_t *U, *XR, *Z; const float* bias;
    __device__ __forceinline__ void operator()(AccT& acc, const GUnit& u, int wr, int wc, int fr, int fq) const {
        const int pm = u.i0, pn = u.i1;
        if (pn >= 4) { bf16_t* base = pn < 8 ? XR + 2 * 1024 : Z; epi_bf16_store<0>(acc, base + (size_t)pm * 256 * 1024 + (pn & 3) * 256, 1024, bias + pn * 256, wr, wc, fr, fq); return; }
        const int c0 = pn * 256 + wc * 32 + 8 * fq;
#pragma unroll
        for (int bj = 0; bj < 2; ++bj) { const int col = c0 + bj * 128; const f32x4 b0 = *(const f32x4*)(bias + col), b1 = *(const f32x4*)(bias + col + 4); bf16_t* gp = U + (size_t)(col >> 4) * GM_STRIDE + (col & 15);
#pragma unroll
            for (int ai = 0; ai < 2; ++ai)
#pragma unroll
                for (int m = 0; m < 4; ++m) { const int row = pm * 256 + ai * 128 + wr * 64 + m * 16 + fr; const f32x4 v0 = acc[ai][bj][m][0] + b0, v1 = acc[ai][bj][m][1] + b1;
                    u32x4 w; w.x = cvt_pk_bf16(v0[0], v0[1]); w.y = cvt_pk_bf16(v0[2], v0[3]); w.z = cvt_pk_bf16(v1[0], v1[1]); w.w = cvt_pk_bf16(v1[2], v1[3]);
                    *(u32x4*)(gp + (size_t)row * 16) = w; } }
    } };
template <int ACT> struct EpiPlain { static constexpr bool PERM = true, AFTER_DRAIN = false; bf16_t* O; int ldc; const float* bias; size_t pstride;
    __device__ __forceinline__ void operator()(AccT& acc, const GUnit& u, int wr, int wc, int fr, int fq) const {
        epi_bf16_store<ACT>(acc, O + (size_t)u.i0 * (pstride ? pstride : (size_t)256 * ldc) + u.i1 * 256, ldc, bias ? bias + u.i1 * 256 : nullptr, wr, wc, fr, fq); } };
struct EpiS5a { static constexpr bool PERM = true, AFTER_DRAIN = false; bf16_t* YI; float* S;
    __device__ __forceinline__ void operator()(AccT& acc, const GUnit& u, int wr, int wc, int fr, int fq) const {
        const int g = u.i0, pn = u.i1;
#pragma unroll
        for (int ai = 0; ai < 2; ++ai)
#pragma unroll
            for (int m = 0; m < 4; ++m) { const int r = ai * 128 + wr * 64 + m * 16 + fr;
#pragma unroll
                for (int bj = 0; bj < 2; ++bj) { const int c8 = bj * 128 + wc * 32 + 8 * fq; const f32x4 v0 = acc[ai][bj][m][0], v1 = acc[ai][bj][m][1];
                    if (pn < 2) { const int col = pn * 256 + c8, t = col >> 4, k0 = col & 15;
                        u32x4 w; w.x = cvt_pk_bf16(v0[0], v0[1]); w.y = cvt_pk_bf16(v0[2], v0[3]); w.z = cvt_pk_bf16(v1[0], v1[1]); w.w = cvt_pk_bf16(v1[2], v1[3]);
                        *(u32x4*)(YI + (size_t)g * GM_STRIDE + (size_t)r * 512 + col) = w; (void)t; (void)k0; }
                    else { float* sp = S + ((size_t)g * NCH + r) * 256 + c8; *(f32x4*)sp = v0; *(f32x4*)(sp + 4) = v1; } } }
    } };
struct EpiS5b { static constexpr bool PERM = true, AFTER_DRAIN = false; const bf16_t* YI; bf16_t* YG;
    __device__ __forceinline__ void operator()(AccT& acc, const GUnit& u, int wr, int wc, int fr, int fq) const {
        const int g = u.i0, pn = u.i1;
#pragma unroll
        for (int ai = 0; ai < 2; ++ai)
#pragma unroll
            for (int m = 0; m < 4; ++m) { const int r = ai * 128 + wr * 64 + m * 16 + fr;
#pragma unroll
                for (int bj = 0; bj < 2; ++bj) { const int col = pn * 256 + bj * 128 + wc * 32 + 8 * fq, t = col >> 4, k0 = col & 15;
                    const size_t off = (size_t)g * GM_STRIDE + (size_t)r * 512 + col; (void)t; (void)k0; const u32x4 yi = *(const u32x4*)(YI + off);
                    f32x4 v0 = acc[ai][bj][m][0] + (f32x4){bf_lo(yi.x), bf_hi(yi.x), bf_lo(yi.y), bf_hi(yi.y)}, v1 = acc[ai][bj][m][1] + (f32x4){bf_lo(yi.z), bf_hi(yi.z), bf_lo(yi.w), bf_hi(yi.w)};
#pragma unroll
                    for (int j = 0; j < 4; ++j) { v0[j] = gelu_tanh(v0[j]); v1[j] = gelu_tanh(v1[j]); }
                    u32x4 w; w.x = cvt_pk_bf16(v0[0], v0[1]); w.y = cvt_pk_bf16(v0[2], v0[3]); w.z = cvt_pk_bf16(v1[0], v1[1]); w.w = cvt_pk_bf16(v1[2], v1[3]);
                    *(u32x4*)(YG + off) = w; } }
    } };
struct EpiGlu { static constexpr bool PERM = true, AFTER_DRAIN = false; const bf16_t* YG; bf16_t* YPRE; const float* bias;
    __device__ __forceinline__ void operator()(AccT& acc, const GUnit& u, int wr, int wc, int fr, int fq) const {
        const int pm = u.i0, pn = u.i1; const int c0 = pn * 256 + wc * 32 + 8 * fq;
        f32x4 bv[2][2];
#pragma unroll
        for (int bj = 0; bj < 2; ++bj)
#pragma unroll
            for (int n = 0; n < 2; ++n) bv[bj][n] = *(const f32x4*)(bias + c0 + bj * 128 + 4 * n);
#pragma unroll
        for (int ai = 0; ai < 2; ++ai)
#pragma unroll
            for (int m = 0; m < 4; ++m) { const int row = pm * 256 + ai * 128 + wr * 64 + m * 16 + fr;
#pragma unroll
                for (int bj = 0; bj < 2; ++bj) { const int col = c0 + bj * 128; const u32x4 yv = *(const u32x4*)(YG + (size_t)(col >> 4) * GM_STRIDE + (size_t)row * 16 + (col & 15));
                    const f32x4 y0 = (f32x4){bf_lo(yv.x), bf_hi(yv.x), bf_lo(yv.y), bf_hi(yv.y)}, y1 = (f32x4){bf_lo(yv.z), bf_hi(yv.z), bf_lo(yv.w), bf_hi(yv.w)};
                    f32x4 v0 = acc[ai][bj][m][0] + bv[bj][0], v1 = acc[ai][bj][m][1] + bv[bj][1];
#pragma unroll
                    for (int j = 0; j < 4; ++j) { v0[j] = y0[j] * fast_sigmoid(v0[j]); v1[j] = y1[j] * fast_sigmoid(v1[j]); }
                    u32x4 w; w.x = cvt_pk_bf16(v0[0], v0[1]); w.y = cvt_pk_bf16(v0[2], v0[3]); w.z = cvt_pk_bf16(v1[0], v1[1]); w.w = cvt_pk_bf16(v1[2], v1[3]);
                    *(u32x4*)(YPRE + (size_t)row * 2048 + col) = w; }
                }
    } };
template <bool PLEADD> struct EpiRes { static constexpr bool PERM = false, AFTER_DRAIN = false; const bf16_t* HBp; const float* bias; float* V; const bf16_t* SG; const bf16_t* PW;
    __device__ __forceinline__ void operator()(AccT& acc, const GUnit& u, int wr, int wc, int fr, int fq) const {
        const int pm = u.i0, pn = u.i1; const int c0 = pn * 256 + wc * 32 + 4 * fq;
        f32x4 bv[2][2];
#pragma unroll
        for (int bj = 0; bj < 2; ++bj)
#pragma unroll
            for (int n = 0; n < 2; ++n) bv[bj][n] = *(const f32x4*)(bias + c0 + bj * 128 + n * 16);
#pragma unroll
        for (int ai = 0; ai < 2; ++ai)
#pragma unroll
            for (int m = 0; m < 4; ++m) { const int row = pm * 256 + ai * 128 + wr * 64 + m * 16 + fr;
#pragma unroll
                for (int bj = 0; bj < 2; ++bj)
#pragma unroll
                    for (int n = 0; n < 2; ++n) { const size_t off = (size_t)row * 2048 + c0 + bj * 128 + n * 16;
                        f32x4 v = acc[ai][bj][m][n] + bv[bj][n] + DN_ALPHA * bf4(*(const u32x2*)(HBp + off));
                        if (PLEADD) v += bf4(*(const u32x2*)(SG + off)) * bf4(*(const u32x2*)(PW + off));
                        *(f32x4*)(V + off) = v; } }
    } };


struct PanelStats8 { unsigned long long* xbuf; unsigned* cnt; float eps;
    __device__ __forceinline__ void run(const AccT& v, int pm, int pn, int wr, int wc, int fr, int fq, LAS unsigned char* lds, int wid) const {
        LAS f32x2* P = (LAS f32x2*)lds; LAS f32x2* S = (LAS f32x2*)(lds + 8192); const int lane = fq * 16 + fr;
#pragma unroll
        for (int ai = 0; ai < 2; ++ai)
#pragma unroll
            for (int m = 0; m < 4; ++m) { float s = 0.f;
#pragma unroll
                for (int bj = 0; bj < 2; ++bj)
#pragma unroll
                    for (int n = 0; n < 2; ++n) { const f32x4 x = v[ai][bj][m][n]; s += (x[0] + x[1]) + (x[2] + x[3]); }
                s += __shfl_xor(s, 16); s += __shfl_xor(s, 32);
                const float mw = s * (1.0f / 64.0f); float q = 0.f;
#pragma unroll
                for (int bj = 0; bj < 2; ++bj)
#pragma unroll
                    for (int n = 0; n < 2; ++n) { const f32x4 d = v[ai][bj][m][n] - mw; q += (d[0] * d[0] + d[1] * d[1]) + (d[2] * d[2] + d[3] * d[3]); }
                q += __shfl_xor(q, 16); q += __shfl_xor(q, 32);
                if (fq == 0) P[(ai * 128 + wr * 64 + m * 16 + fr) * 4 + wc] = (f32x2){mw, q}; }
        asm volatile("s_waitcnt lgkmcnt(0)" ::: "memory"); __builtin_amdgcn_s_barrier(); asm volatile("" ::: "memory");
        const int row = wid * 32 + (lane & 31);
        if (lane < 32) { const f32x2 a = P[row * 4 + 0], b = P[row * 4 + 1], c = P[row * 4 + 2], d = P[row * 4 + 3];
            const float mt = (a[0] + b[0] + c[0] + d[0]) * 0.25f; const float da = a[0] - mt, db = b[0] - mt, dc = c[0] - mt, dd = d[0] - mt;
            const float m2 = (a[1] + b[1]) + (c[1] + d[1]) + 64.0f * ((da * da + db * db) + (dc * dc + dd * dd));
            __hip_atomic_store(xbuf + ((size_t)(pm * 256 + row) * 8 + pn), ((unsigned long long)__float_as_uint(m2) << 32) | __float_as_uint(mt), __ATOMIC_RELAXED, __HIP_MEMORY_SCOPE_AGENT); }
        asm volatile("s_waitcnt vmcnt(0)" ::: "memory");
        if (lane == 0) __hip_atomic_fetch_add(cnt + 64 * pm, 1u, __ATOMIC_RELAXED, __HIP_MEMORY_SCOPE_AGENT);
        if (wid == 0) { unsigned sp = 0;
            while ((unsigned)__builtin_amdgcn_readfirstlane(__hip_atomic_load(cnt + 64 * pm, __ATOMIC_RELAXED, __HIP_MEMORY_SCOPE_AGENT)) < 64u) { __builtin_amdgcn_s_sleep(2); if (++sp > (1u << 22)) break; }
            __builtin_amdgcn_fence(__ATOMIC_ACQUIRE, "agent"); }
        asm volatile("s_waitcnt vmcnt(0) lgkmcnt(0)" ::: "memory"); __builtin_amdgcn_s_barrier(); asm volatile("" ::: "memory");
        if (lane < 32) { const unsigned long long* slot = xbuf + (size_t)(pm * 256 + row) * 8; float mt[8], m2[8]; float ms = 0.f;
#pragma unroll
            for (int t = 0; t < 8; ++t) { const unsigned long long w = __hip_atomic_load(slot + t, __ATOMIC_RELAXED, __HIP_MEMORY_SCOPE_AGENT); mt[t] = __uint_as_float((unsigned)w); m2[t] = __uint_as_float((unsigned)(w >> 32)); ms += mt[t]; }
            const float mean = ms * 0.125f; float q = 0.f;
#pragma unroll
            for (int t = 0; t < 8; ++t) { const float dm = mt[t] - mean; q += m2[t] + 256.0f * dm * dm; }
            S[row] = (f32x2){mean, 1.0f / sqrtf(q * (1.0f / 2048.0f) + eps)}; }
        asm volatile("s_waitcnt lgkmcnt(0)" ::: "memory"); __builtin_amdgcn_s_barrier(); asm volatile("" ::: "memory");
    } };
struct EpiResLn1 { static constexpr bool PERM = false, AFTER_DRAIN = true; bf16_t* HBp; const float *bias, *lng, *lnb; PanelStats8 st;
    __device__ __forceinline__ void fused(AccT& acc, const GUnit& u, int wr, int wc, int fr, int fq, LAS unsigned char* lds, int wid) const {
        const int pm = u.i0, pn = u.i1; const int c0 = pn * 256 + wc * 32 + 4 * fq; const LAS f32x2* S = (const LAS f32x2*)(lds + 8192);
#pragma unroll
        for (int bj = 0; bj < 2; ++bj)
#pragma unroll
            for (int n = 0; n < 2; ++n) { const f32x4 bv = *(const f32x4*)(bias + c0 + bj * 128 + n * 16);
#pragma unroll
                for (int ai = 0; ai < 2; ++ai)
#pragma unroll
                    for (int m = 0; m < 4; ++m) { const size_t off = (size_t)(pm * 256 + ai * 128 + wr * 64 + m * 16 + fr) * 2048 + c0 + bj * 128 + n * 16;
                        acc[ai][bj][m][n] += bv + DN_ALPHA * bf4(*(const u32x2*)(HBp + off)); } }
        st.run(acc, pm, pn, wr, wc, fr, fq, lds, wid);
#pragma unroll
        for (int bj = 0; bj < 2; ++bj)
#pragma unroll
            for (int n = 0; n < 2; ++n) { const f32x4 gg = *(const f32x4*)(lng + c0 + bj * 128 + n * 16), bb = *(const f32x4*)(lnb + c0 + bj * 128 + n * 16);
#pragma unroll
                for (int ai = 0; ai < 2; ++ai)
#pragma unroll
                    for (int m = 0; m < 4; ++m) { const int r = ai * 128 + wr * 64 + m * 16 + fr; const f32x2 sr = S[r]; const size_t off = (size_t)(pm * 256 + r) * 2048 + c0 + bj * 128 + n * 16;
                        const f32x4 o = (acc[ai][bj][m][n] - sr[0]) * sr[1] * gg + bb; u32x2 w; w.x = cvt_pk_bf16(o[0], o[1]); w.y = cvt_pk_bf16(o[2], o[3]); *(u32x2*)(HBp + off) = w; } }
    } };
struct EpiResLn2 { static constexpr bool PERM = false, AFTER_DRAIN = true; const bf16_t* HBp; const float *bias, *lng, *lnb; float* out; const bf16_t* SGPW; PanelStats8 st;
    __device__ __forceinline__ void fused(AccT& acc, const GUnit& u, int wr, int wc, int fr, int fq, LAS unsigned char* lds, int wid) const {
        const int pm = u.i0, pn = u.i1; const int c0 = pn * 256 + wc * 32 + 4 * fq; const LAS f32x2* S = (const LAS f32x2*)(lds + 8192);
        const bf16_t* sgp = SGPW + (size_t)pm * (1u << 20);
        f32x4 bv[2][2];
#pragma unroll
        for (int bj = 0; bj < 2; ++bj)
#pragma unroll
            for (int n = 0; n < 2; ++n) bv[bj][n] = *(const f32x4*)(bias + c0 + bj * 128 + n * 16);
#pragma unroll
        for (int ai = 0; ai < 2; ++ai)
#pragma unroll
            for (int m = 0; m < 4; ++m) { const int r = ai * 128 + wr * 64 + m * 16 + fr; const size_t lo = (size_t)r * 2048 + c0; const bf16_t* hp = HBp + (size_t)(pm * 256 + r) * 2048 + c0;
#pragma unroll
                for (int bj = 0; bj < 2; ++bj)
#pragma unroll
                    for (int n = 0; n < 2; ++n) { const int co = bj * 128 + n * 16;
                        acc[ai][bj][m][n] += bv[bj][n] + DN_ALPHA * bf4(*(const u32x2*)(hp + co)) + bf4(*(const u32x2*)(sgp + lo + co)) * bf4(*(const u32x2*)(sgp + (1u << 19) + lo + co)); }
                asm volatile("" : "+v"(acc[ai][0][m][0]), "+v"(acc[ai][0][m][1]), "+v"(acc[ai][1][m][0]), "+v"(acc[ai][1][m][1])); }
        st.run(acc, pm, pn, wr, wc, fr, fq, lds, wid);
#pragma unroll
        for (int bj = 0; bj < 2; ++bj)
#pragma unroll
            for (int n = 0; n < 2; ++n) { const f32x4 gg = *(const f32x4*)(lng + c0 + bj * 128 + n * 16), bb = *(const f32x4*)(lnb + c0 + bj * 128 + n * 16);
#pragma unroll
                for (int ai = 0; ai < 2; ++ai)
#pragma unroll
                    for (int m = 0; m < 4; ++m) { const int r = ai * 128 + wr * 64 + m * 16 + fr; const f32x2 sr = S[r];
                        *(f32x4*)(out + (size_t)(pm * 256 + r) * 2048 + c0 + bj * 128 + n * 16) = (acc[ai][bj][m][n] - sr[0]) * sr[1] * gg + bb; } }
    } };
struct EpiG { static constexpr bool PERM = true, AFTER_DRAIN = false; bf16_t *G0, *G1; const float* bias;
    __device__ __forceinline__ void operator()(AccT& acc, const GUnit& u, int wr, int wc, int fr, int fq) const {
        const int pm = u.i0, h = u.i1; bf16_t* base = (pm < 16 ? G0 : G1) + (size_t)(pm & 15) * 256 * 4096 + h * 256;
        epi_bf16_store<0>(acc, base, 4096, bias + h * 256, wr, wc, fr, fq); } };
__device__ __forceinline__ float bfu(unsigned short v) { return __uint_as_float(((unsigned)v) << 16); }
__device__ __forceinline__ void rg_gate(float pa, float px, float spv, float xc, float& a, float& b) {
    const float r = fast_sigmoid(pa), ig = fast_sigmoid(px); const float la = spv * r; a = __expf(la); const float x = 2.0f * la;
    const float om = -x * (1.0f + x * (0.5f + x * (0.16666667f + x * (0.041666668f + x * 0.008333334f))));
    b = __builtin_amdgcn_sqrtf(fmaxf(om, 0.f)) * ig * xc; }
__device__ __forceinline__ void rg_gate2(float pa, float px, float spv, float xc, float& a, float& b, float& r) {
    r = fast_sigmoid(pa); const float ig = fast_sigmoid(px); const float la = spv * r; a = __expf(la); const float x = 2.0f * la;
    const float om = -x * (1.0f + x * (0.5f + x * (0.16666667f + x * (0.041666668f + x * 0.008333334f))));
    b = __builtin_amdgcn_sqrtf(fmaxf(om, 0.f)) * ig * xc; }
struct RgCtx { const bf16_t *XR, *G0, *G1, *Z; const float *convw, *convb, *sp; float* agg; bf16_t* ypre; };
__device__ __forceinline__ const bf16_t* g_row(const RgCtx& R, int t) { return (t < 4096 ? R.G0 : R.G1) + (size_t)(t & 4095) * 4096; }
__device__ __forceinline__ void rg_pass_a(const RgCtx& R, int half, int seg, int tid) {
    const int c = half * 512 + tid, gcol = (c >> 6) * 256 + (c & 63) * 4, t0 = seg * 64;
    const float w0 = R.convw[c], w1 = R.convw[1024 + c], w2 = R.convw[2048 + c], w3 = R.convw[3072 + c], cb = R.convb[c], sp0 = R.sp[c], sp1 = R.sp[1024 + c];
    const bf16_t* xp = R.XR + c;
    float x0 = bfu(xp[(size_t)(t0 + 0) * 1024]), x1 = bfu(xp[(size_t)(t0 + 1) * 1024]), x2 = bfu(xp[(size_t)(t0 + 2) * 1024]);
    float Af = 1.f, Bf = 0.f, Ab = 1.f, Bb = 0.f;
    for (int tb = 0; tb < 64; tb += 16) {
        u32x2 gq[16]; unsigned short xn[16];
#pragma unroll
        for (int i = 0; i < 16; ++i) { const int t = t0 + tb + i; gq[i] = *(const u32x2*)(g_row(R, t) + gcol); xn[i] = xp[(size_t)(t + 3) * 1024]; }
#pragma unroll
        for (int i = 0; i < 16; ++i) { const float x3 = bfu(xn[i]); const float xc = cb + w0 * x0 + w1 * x1 + w2 * x2 + w3 * x3; x0 = x1; x1 = x2; x2 = x3;
            float a, b, r0, r1, b0; rg_gate2(bf_lo(gq[i].x), bf_lo(gq[i].y), sp0, xc, a, b, r0); Bf = a * Bf + b; Af = a * Af; b0 = b;
            rg_gate2(bf_hi(gq[i].x), bf_hi(gq[i].y), sp1, xc, a, b, r1); Bb = Ab * b + Bb; Ab = Ab * a;
            u32x2 w; w.x = cvt_pk_bf16(r0, r1); w.y = cvt_pk_bf16(b0, b); *(u32x2*)((bf16_t*)g_row(R, t0 + tb + i) + gcol) = w; }
    }
    *(f32x2*)(R.agg + ((size_t)(seg * 2 + 0) * 1024 + c) * 2) = (f32x2){Af, Bf};
    *(f32x2*)(R.agg + ((size_t)(seg * 2 + 1) * 1024 + c) * 2) = (f32x2){Ab, Bb};
}
__device__ __forceinline__ void rg_pass_c(const RgCtx& R, int half, int seg, int tid, LAS float* Lh) {
    const int c = half * 512 + tid, gcol = (c >> 6) * 256 + (c & 63) * 4, t0 = seg * 64;
    const float sp0 = R.sp[c], sp1 = R.sp[1024 + c];
    const f32x2* ag = (const f32x2*)R.agg;
    float hf = 0.f, hb = 0.f;
    {
#pragma unroll 1
        for (int sb = 0; sb < 128; sb += 32) { f32x2 ab[32];
#pragma unroll
            for (int i = 0; i < 32; ++i) { const int s2 = sb + i; ab[i] = (s2 < seg) ? ag[(size_t)(s2 * 2 + 0) * 1024 + c] : (f32x2){1.f, 0.f}; }
#pragma unroll
            for (int i = 0; i < 32; ++i) hf = ab[i][0] * hf + ab[i][1]; }
#pragma unroll 1
        for (int sb = 96; sb >= 0; sb -= 32) { f32x2 ab[32];
#pragma unroll
            for (int i = 0; i < 32; ++i) { const int s2 = sb + 31 - i; ab[i] = (s2 > seg) ? ag[(size_t)(s2 * 2 + 1) * 1024 + c] : (f32x2){1.f, 0.f}; }
#pragma unroll
            for (int i = 0; i < 32; ++i) hb = ab[i][0] * hb + ab[i][1]; }
    }
    {
        for (int tb = 0; tb < 64; tb += 16) {
            u32x2 gq[16];
#pragma unroll
            for (int i = 0; i < 16; ++i) gq[i] = *(const u32x2*)(g_row(R, t0 + tb + i) + gcol);
#pragma unroll
            for (int i = 0; i < 16; ++i) { const float a = __expf(sp0 * bf_lo(gq[i].x)); hf = a * hf + bf_lo(gq[i].y); Lh[(tb + i) * 512 + tid] = hf; }
        }
    }
    {
        for (int tb = 48; tb >= 0; tb -= 16) {
            u32x2 gq[16]; unsigned short zz[16];
#pragma unroll
            for (int i = 0; i < 16; ++i) { const int t = t0 + tb + 15 - i; gq[i] = *(const u32x2*)(g_row(R, t) + gcol); zz[i] = R.Z[(size_t)t * 1024 + c]; }
#pragma unroll
            for (int i = 0; i < 16; ++i) { const int tl = tb + 15 - i; const float a = __expf(sp1 * bf_hi(gq[i].x)); hb = a * hb + bf_hi(gq[i].y);
                const float o = (Lh[tl * 512 + tid] + hb) * gelu_tanh(bfu(zz[i]));
                R.ypre[(size_t)(t0 + tl) * 2048 + 1024 + c] = (bf16_t)(cvt_pk_bf16(o, 0.f) & 0xffffu); }
        }
    }
}

#ifndef NAIVE_GEMM
#define NAIVE_GEMM 0
#endif
template <class Epi, class Sched>
__device__ __forceinline__ void gemm_phase_naive(LAS unsigned char* lds, const int wid, const GParm gp, const Sched& S, const Epi& E) {
    const int lane = fresh_lane(), tid = wid * 64 + lane, wr = wid >> 2, wc = wid & 3, fr = lane & 15, fq = lane >> 4;
    GUnit cur;
    for (int ui = 0; S.next(ui, cur); ++ui) {
        f32x4 acc[2][2][4][2];
#pragma unroll
        for (int ai = 0; ai < 2; ++ai)
#pragma unroll
            for (int bj = 0; bj < 2; ++bj)
#pragma unroll
                for (int m = 0; m < 4; ++m)
#pragma unroll
                    for (int n = 0; n < 2; ++n)
#pragma unroll
                        for (int e = 0; e < 4; ++e) {
                            const int row = 128 * ai + 64 * wr + 16 * m + fr; const int col = Epi::PERM ? (128 * bj + 32 * wc + 8 * fq + 4 * n + e) : (128 * bj + 32 * wc + 16 * n + 4 * fq + e);
                            const char* ap = cur.A + (size_t)row * gp.a_rs; const char* bp = cur.B + (size_t)col * gp.K * 2; float sum = 0.f;
                            for (int k = 0; k < gp.K; k += 8) { const int kt = k >> 6, C = k & 63;
                                const u32x4 av = *(const u32x4*)(ap + (size_t)kt * gp.a_ks + ((C / gp.a_cw) * gp.a_cs + (C % gp.a_cw)) * 2), bv = *(const u32x4*)(bp + k * 2);
                                sum += bf_lo(av.x) * bf_lo(bv.x) + bf_hi(av.x) * bf_hi(bv.x) + bf_lo(av.y) * bf_lo(bv.y) + bf_hi(av.y) * bf_hi(bv.y) + bf_lo(av.z) * bf_lo(bv.z) + bf_hi(av.z) * bf_hi(bv.z) + bf_lo(av.w) * bf_lo(bv.w) + bf_hi(av.w) * bf_hi(bv.w); }
                            acc[ai][bj][m][n][e] = sum; }
        if constexpr (Epi::AFTER_DRAIN) { __syncthreads(); E.fused(acc, cur, wr, wc, fr, fq, lds, wid); } else E(acc, cur, wr, wc, fr, fq);
    }
    __syncthreads();
}
#if NAIVE_GEMM
#define GEMM_PHASE gemm_phase_naive
#else
#define GEMM_PHASE pg8::gemm_phase
#endif
__device__ __forceinline__ void transpose_item(const float* W, int K, int N, bf16_t* WT, LAS float* scr, int item, int lane) {
    const int nblk = N / 64, kb = item / nblk, nb = item % nblk, k0 = 64 * kb, n0 = 64 * nb;
    const float* src = W + (size_t)k0 * N + n0 + lane;
#pragma unroll 32
    for (int i = 0; i < 64; ++i) scr[i * 65 + lane] = src[(size_t)i * N];
    LDS_WAIT();
    const int c = lane & 7;
#pragma unroll
    for (int j = 0; j < 8; ++j) { const int n = (lane >> 3) + 8 * j; const LAS float* sp = scr + (8 * c) * 65 + n;
        u32x4 o; o.x = cvt_pk_bf16(sp[0 * 65], sp[1 * 65]); o.y = cvt_pk_bf16(sp[2 * 65], sp[3 * 65]); o.z = cvt_pk_bf16(sp[4 * 65], sp[5 * 65]); o.w = cvt_pk_bf16(sp[6 * 65], sp[7 * 65]);
        *(u32x4*)(WT + (size_t)(n0 + n) * K + k0 + 8 * c) = o; }
    LDS_WAIT();
}
template <bool OUT_BF16> __device__ __forceinline__ void ln_row(const float* xrow, const float* g, const float* b, void* orow, int lane) {
    const f32x4* xr = (const f32x4*)xrow + lane; f32x4 v[8]; float s = 0.f;
#pragma unroll
    for (int j = 0; j < 8; ++j) { v[j] = xr[64 * j]; s += (v[j][0] + v[j][1]) + (v[j][2] + v[j][3]); }
    const float mean = wave_sum(s) * (1.f / DM); float s2 = 0.f;
#pragma unroll
    for (int j = 0; j < 8; ++j) { v[j] = v[j] - mean; s2 += (v[j][0] * v[j][0] + v[j][1] * v[j][1]) + (v[j][2] * v[j][2] + v[j][3] * v[j][3]); }
    const float rstd = 1.0f / sqrtf(wave_sum(s2) * (1.f / DM) + LN_EPS);
#pragma unroll
    for (int j = 0; j < 8; ++j) { const f32x4 gg = ((const f32x4*)g)[lane + 64 * j], bb = ((const f32x4*)b)[lane + 64 * j]; const f32x4 o = v[j] * rstd * gg + bb;
        if (OUT_BF16) { u32x2 w; w.x = cvt_pk_bf16(o[0], o[1]); w.y = cvt_pk_bf16(o[2], o[3]); ((u32x2*)orow)[lane + 64 * j] = w; }
        else ((f32x4*)orow)[lane + 64 * j] = o; }
}
__device__ __forceinline__ void cpow(float lrs, float th, int j, float& re, float& im) {
    double a = (double)j * (double)th * 0.15915494309189535; a -= rint(a); const float af = 2.0f * (float)a;
    const float mag = expf((float)j * lrs); re = mag * cospif(af); im = mag * sinpif(af);
}


#ifndef NAIVE_RG
#define NAIVE_RG 0
#endif
__device__ __forceinline__ void naive_rg_channel(const RgCtx& R, int c) {
    const int gcol = (c >> 6) * 256 + (c & 63);
    const float w0 = R.convw[c], w1 = R.convw[1024 + c], w2 = R.convw[2048 + c], w3 = R.convw[3072 + c], cb = R.convb[c], sp0 = R.sp[c], sp1 = R.sp[1024 + c];
    const bf16_t* xp = R.XR + c; float h = 0.f;
    for (int t = 0; t < SEQ; ++t) { const float xc = cb + w0 * bfu(xp[(size_t)t * 1024]) + w1 * bfu(xp[(size_t)(t + 1) * 1024]) + w2 * bfu(xp[(size_t)(t + 2) * 1024]) + w3 * bfu(xp[(size_t)(t + 3) * 1024]);
        const bf16_t* g = g_row(R, t) + gcol; float a, b; rg_gate(bfu(g[0]), bfu(g[128]), sp0, xc, a, b); h = a * h + b;
        R.ypre[(size_t)t * 2048 + 1024 + c] = (bf16_t)(cvt_pk_bf16(h, 0.f) & 0xffffu); }
    __builtin_amdgcn_fence(__ATOMIC_SEQ_CST, "agent");
    h = 0.f;
    for (int t = SEQ - 1; t >= 0; --t) { const float xc = cb + w0 * bfu(xp[(size_t)t * 1024]) + w1 * bfu(xp[(size_t)(t + 1) * 1024]) + w2 * bfu(xp[(size_t)(t + 2) * 1024]) + w3 * bfu(xp[(size_t)(t + 3) * 1024]);
        const bf16_t* g = g_row(R, t) + gcol; float a, b; rg_gate(bfu(g[64]), bfu(g[192]), sp1, xc, a, b); h = a * h + b;
        const size_t o = (size_t)t * 2048 + 1024 + c; const float y = (bfu(R.ypre[o]) + h) * gelu_tanh(bfu(R.Z[(size_t)t * 1024 + c]));
        R.ypre[o] = (bf16_t)(cvt_pk_bf16(y, 0.f) & 0xffffu); }
}

#ifndef NAIVE_S5
#define NAIVE_S5 0
#endif
__device__ __forceinline__ void naive_s5_group(const float* const* in, const bf16_t* U, float* tmp, bf16_t* YG, int g, int lane) {
    const float *lre = in[6], *lim = in[7], *lstep = in[8], *bre = in[9], *bim = in[10], *cre = in[11], *cim = in[12], *dd = in[13];
    for (int n = 0; n < 2; ++n) {
        const int p = lane, pi = (n * 64 + g) * 64 + p;
        const float lr = fminf(lre[pi], -1e-4f), li = lim[pi], step = expf(lstep[n * 64 + g]); float ar, ai; cpow(lr * step, li * step, 1, ar, ai);
        const float nr = ar - 1.0f, ni = ai, den = lr * lr + li * li; const float qr = (nr * lr + ni * li) / den, qi = (ni * lr - nr * li) / den;
        float hr = 0.f, hi = 0.f;
        for (int tt = 0; tt < SEQ; ++tt) { const int t = n == 0 ? tt : SEQ - 1 - tt; const bf16_t* up = U + (size_t)t * 1024 + g * 16;
            float bur = 0.f, bui = 0.f;
#pragma unroll
            for (int k = 0; k < 16; ++k) { const float uv = bfu(up[k]); const float br = bre[(size_t)pi * 16 + k], bi = bim[(size_t)pi * 16 + k]; bur += (qr * br - qi * bi) * uv; bui += (qr * bi + qi * br) * uv; }
            const float nhr = ar * hr - ai * hi + bur, nhi = ar * hi + ai * hr + bui; hr = nhr; hi = nhi;
#pragma unroll
            for (int k = 0; k < 16; ++k) { const size_t ci = ((size_t)(n * 64 + g) * 16 + k) * 64 + p; float v = cre[ci] * hr - cim[ci] * hi; v = wave_sum(v);
                if (lane == k) { const size_t o = (size_t)t * 1024 + g * 16 + k;
                    if (n == 0) tmp[o] = v; else { const float y = tmp[o] + v + dd[g * 16 + k] * bfu(up[k]); YG[o] = (bf16_t)(cvt_pk_bf16(gelu_tanh(y), 0.f) & 0xffffu); } } }
        }
        __builtin_amdgcn_fence(__ATOMIC_SEQ_CST, "agent");
    }
}

#define XB_TMO      128
#define XB_XCNT(j)  (256  + 64 * (j))
#define XB_XSUB(j)  (1280 + 64 * (j))
#define XB_XGEN(j)  (2304 + 64 * (j))
#define XB_TOP      3328
#define XB_TOPGEN   3392
#define XCD_BAR_WORDS 3456
#define XB_SPIN_CAP (1u << 18)
__device__ __forceinline__ unsigned xb_ld(unsigned* p)              { return __hip_atomic_load(p, __ATOMIC_RELAXED, __HIP_MEMORY_SCOPE_AGENT); }
__device__ __forceinline__ unsigned xb_add(unsigned* p, unsigned v) { return __hip_atomic_fetch_add(p, v, __ATOMIC_RELAXED, __HIP_MEMORY_SCOPE_AGENT); }
__device__ __forceinline__ unsigned xb_xcc_id() { return (unsigned)__builtin_amdgcn_s_getreg((3 << 11) | 20) & 0xFu; }
#define XB_SPIN(cond, bar) do { unsigned _sp = 0; while (cond) { __builtin_amdgcn_s_sleep(1); \
    if ((++_sp & 255u) == 0u) { if (xb_ld(&(bar)[XB_TMO])) break; if (_sp > XB_SPIN_CAP) { atomicAdd(&(bar)[XB_TMO], 1u); break; } } } } while (0)
struct XcdBarrier { unsigned* bar; unsigned x; volatile LAS unsigned* st; };
__device__ __forceinline__ void xcd_barrier_complete(unsigned* bar, unsigned x, unsigned G, unsigned& nloc, unsigned& nx) {
    unsigned sum, cnt, mine, sp = 0u;
    for (;;) {
        sum = 0u; cnt = 0u; mine = 0u;
#pragma unroll
        for (unsigned j = 0; j < 16; ++j) { const unsigned c = xb_ld(&bar[XB_XCNT(j)]); sum += c; cnt += (c > 0u) ? 1u : 0u; mine = (j == x) ? c : mine; }
        if (sum == G) break;
        __builtin_amdgcn_s_sleep(1);
        if ((++sp & 255u) == 0u) { if (xb_ld(&bar[XB_TMO])) break; if (sp > XB_SPIN_CAP) { atomicAdd(&bar[XB_TMO], 1u); break; } }
    }
    nloc = mine > 0u ? mine : 1u; nx = cnt > 0u ? cnt : 1u;
}
__device__ __forceinline__ void xcd_barrier(const XcdBarrier& b, unsigned G, int wave) {
    asm volatile("s_waitcnt vmcnt(0)" ::: "memory");
    __syncthreads();
    if (wave == 0) { if (fresh_lane() == 0) {
        unsigned* bar = b.bar;
        __builtin_amdgcn_s_waitcnt(0);
        unsigned nloc = b.st[0], nx = b.st[1];
        if (nloc == 0u) { xcd_barrier_complete(bar, b.x, G, nloc, nx); b.st[0] = nloc; b.st[1] = nx; }
        const unsigned old = xb_add(&bar[XB_XSUB(b.x)], 1u);
        const unsigned gen = old / nloc;
        if (old + 1u == (gen + 1u) * nloc) {
            __builtin_amdgcn_fence(__ATOMIC_RELEASE, "agent");
            asm volatile("s_waitcnt vmcnt(0)" ::: "memory");
            const unsigned og = xb_add(&bar[XB_TOP], 1u);
            const unsigned tg = og / nx;
            if (og + 1u == (tg + 1u) * nx) xb_add(&bar[XB_TOPGEN], 1u);
            else XB_SPIN(xb_ld(&bar[XB_TOPGEN]) == tg, bar);
            __builtin_amdgcn_fence(__ATOMIC_ACQUIRE, "agent");
            xb_add(&bar[XB_XGEN(b.x)], 1u);
            asm volatile("s_waitcnt vmcnt(0)" ::: "memory");
        } else {
            XB_SPIN(xb_ld(&bar[XB_XGEN(b.x)]) == gen, bar);
            __builtin_amdgcn_fence(__ATOMIC_ACQUIRE, "agent");
            asm volatile("s_waitcnt vmcnt(0)" ::: "memory");
        }
    } }
    __syncthreads();
}

__device__ __forceinline__ void grid_barrier(unsigned* bar, unsigned target, int wave) {
    asm volatile("s_waitcnt vmcnt(0)" ::: "memory");
    __syncthreads();
    if (wave == 0) { const int l = fresh_lane();
        if (l == 0) {
            __builtin_amdgcn_fence(__ATOMIC_RELEASE, "agent"); asm volatile("s_waitcnt vmcnt(0)" ::: "memory");
            __hip_atomic_fetch_add(bar, 1u, __ATOMIC_RELAXED, __HIP_MEMORY_SCOPE_AGENT);
            while (__hip_atomic_load(bar, __ATOMIC_RELAXED, __HIP_MEMORY_SCOPE_AGENT) < target) __builtin_amdgcn_s_sleep(2);
            __builtin_amdgcn_fence(__ATOMIC_ACQUIRE, "agent"); asm volatile("s_waitcnt vmcnt(0)" ::: "memory");
        } }
    __syncthreads();
}

struct Args { const float* in[38]; float* out; unsigned char* ws; int ph_lo, ph_hi; };
typedef const float* cfp_t;
typedef const __attribute__((address_space(4))) cfp_t* kin_t;

__device__ __forceinline__ void s5_precompute(const kin_t ain, unsigned char* aws, int g, int hq, int nh, LAS float* L, const int tid) {
    const float *lre = ain[6], *lim = ain[7], *lstep = ain[8], *bre = ain[9], *bim = ain[10], *cre = ain[11], *cim = ain[12], *dd = ain[13];
    LAS float *PWre = L, *PWim = L + 4224, *BBre = L + 8448, *BBim = L + 10496, *CCre = L + 12544, *CCim = L + 14592, *MT = L + 16640, *C2re = L + 33280, *C2im = L + 35328, *Dl = L + 37376;
    bf16_t* WGg = (bf16_t*)(aws + WS_WG) + (size_t)g * 768 * 512; bf16_t* WCg = (bf16_t*)(aws + WS_WC) + (size_t)g * 512 * 256;
#define PSTAMP(i) do { if (TSTAMP && blockIdx.x == 128 && tid == 0) ((unsigned long long*)(aws + WS_CTR + 1024))[i] = __builtin_amdgcn_s_memrealtime(); } while (0)
    PSTAMP(20);
    {
        const int np = tid & 127, jj = tid >> 7, n = np >> 6, p = np & 63; const int pi = (n * 64 + g) * 64 + p;
        const float lr = fminf(lre[pi], -1e-4f), li = lim[pi], step = expf(lstep[n * 64 + g]); const float lrs = lr * step, th = li * step;
        for (int j = jj; j <= 32; j += 4) { float r, i; cpow(lrs, th, j, r, i); PWre[np * 33 + j] = r; PWim[np * 33 + j] = i; }
        float l1r, l1i; cpow(lrs, th, 1, l1r, l1i);
        const float nr = l1r - 1.0f, ni = l1i, den = lr * lr + li * li; const float qr = (nr * lr + ni * li) / den, qi = (ni * lr - nr * li) / den;
#pragma unroll
        for (int k = jj * 4; k < jj * 4 + 4; ++k) { const float br = bre[(size_t)pi * 16 + k], bi = bim[(size_t)pi * 16 + k]; BBre[np * 16 + k] = qr * br - qi * bi; BBim[np * 16 + k] = qr * bi + qi * br; }
        for (int e = tid; e < 2048; e += 512) { const int n2 = e >> 10, k = (e >> 6) & 15, p2 = e & 63; const size_t ci = ((size_t)(n2 * 64 + g) * 16 + k) * 64 + p2; CCre[(n2 * 64 + p2) * 16 + k] = cre[ci]; CCim[(n2 * 64 + p2) * 16 + k] = cim[ci]; C2re[e] = cre[ci]; C2im[e] = cim[ci]; }
        if (tid < 16) Dl[tid] = dd[g * 16 + tid];
    }
    __syncthreads();
    PSTAMP(21);
    for (int i = 0; i < 3; ++i) {
        if (nh == 2) { if (i < 2 && i != hq) continue; if (i == 2 && (hq != 0 || tid >= 16)) continue; } else if (i == 2) continue;
        const int bq = (i == 2) ? 512 + tid : tid + 512 * i, n = bq >> 9, j = (bq >> 4) & 31, kob = (bq >> 2) & 3, kib = bq & 3;
        f32x4 m0 = {0.f, 0.f, 0.f, 0.f}, m1 = m0, m2 = m0, m3 = m0;
        for (int p = 0; p < 64; ++p) { const int np = n * 64 + p; const float pr = PWre[np * 33 + j], pi2 = PWim[np * 33 + j];
            const f32x4 br = *(const LAS f32x4*)(BBre + np * 16 + 4 * kib), bi = *(const LAS f32x4*)(BBim + np * 16 + 4 * kib), cr = *(const LAS f32x4*)(CCre + np * 16 + 4 * kob), ci = *(const LAS f32x4*)(CCim + np * 16 + 4 * kob);
            const f32x4 er = pr * br - pi2 * bi, ei = pr * bi + pi2 * br;
            m0 += cr[0] * er - ci[0] * ei; m1 += cr[1] * er - ci[1] * ei; m2 += cr[2] * er - ci[2] * ei; m3 += cr[3] * er - ci[3] * ei; }
        LAS float* o = MT + (n * 32 + j) * 260 + (4 * kob) * 16 + 4 * kib;
        *(LAS f32x4*)o = m0; *(LAS f32x4*)(o + 16) = m1; *(LAS f32x4*)(o + 32) = m2; *(LAS f32x4*)(o + 48) = m3;
    }
    __syncthreads();
    PSTAMP(22);
    for (int i = 0; i < 64; ++i) {
        const int idx = tid + 512 * i, row = idx >> 6, cp = idx & 63, t = row >> 4, ko = row & 15, s = cp >> 1, ki0 = (cp & 1) * 8;
        if (nh == 2 && ((t >= s) != (hq == 0))) continue;
        f32x4 v0, v1;
        if (t != s) { const LAS float* src = MT + ((t > s ? 0 : 1) * 32 + (t > s ? t - s : s - t)) * 260 + ko * 16 + ki0; v0 = *(const LAS f32x4*)src; v1 = *(const LAS f32x4*)(src + 4); }
        else { const LAS float* s0 = MT + ko * 16 + ki0; const LAS float* s1 = MT + 32 * 260 + ko * 16 + ki0; v0 = *(const LAS f32x4*)s0 + *(const LAS f32x4*)s1; v1 = *(const LAS f32x4*)(s0 + 4) + *(const LAS f32x4*)(s1 + 4);
            const float dv = Dl[ko];
#pragma unroll
            for (int e = 0; e < 4; ++e) { if (ki0 + e == ko) v0[e] += dv; if (ki0 + 4 + e == ko) v1[e] += dv; } }
        u32x4 w; w.x = cvt_pk_bf16(v0[0], v0[1]); w.y = cvt_pk_bf16(v0[2], v0[3]); w.z = cvt_pk_bf16(v1[0], v1[1]); w.w = cvt_pk_bf16(v1[2], v1[3]);
        *(u32x4*)(WGg + (size_t)row * 512 + cp * 8) = w;
    }
    for (int i = hq * (32 / nh); i < (hq + 1) * (32 / nh); ++i) {
        const int idx = tid + 512 * i, q = idx >> 6, cp = idx & 63, n = q >> 7, ri = (q >> 6) & 1, p = q & 63, s = cp >> 1, ki0 = (cp & 1) * 8, e = n == 0 ? 31 - s : s, np = n * 64 + p;
        const float pr = PWre[np * 33 + e], pi2 = PWim[np * 33 + e]; float v[8];
#pragma unroll
        for (int k = 0; k < 8; ++k) { const float br = BBre[np * 16 + ki0 + k], bi = BBim[np * 16 + ki0 + k]; v[k] = ri == 0 ? pr * br - pi2 * bi : pr * bi + pi2 * br; }
        u32x4 w; w.x = cvt_pk_bf16(v[0], v[1]); w.y = cvt_pk_bf16(v[2], v[3]); w.z = cvt_pk_bf16(v[4], v[5]); w.w = cvt_pk_bf16(v[6], v[7]);
        *(u32x4*)(WGg + (size_t)(512 + q) * 512 + cp * 8) = w;
    }
    for (int i = 0; i < 32 / nh; ++i) {
        const int idx = tid + 512 * i, row = nh == 2 ? idx >> 4 : idx >> 5, q0 = nh == 2 ? hq * 128 + (idx & 15) * 8 : (idx & 31) * 8, n = q0 >> 7, ri = (q0 >> 6) & 1, p0 = q0 & 63, t = row >> 4, ko = row & 15, e = n == 0 ? t + 1 : 32 - t; float v[8];
#pragma unroll
        for (int k = 0; k < 8; ++k) { const int np = n * 64 + p0 + k; const float cr = C2re[(n * 16 + ko) * 64 + p0 + k], ci = C2im[(n * 16 + ko) * 64 + p0 + k], pr = PWre[np * 33 + e], pi2 = PWim[np * 33 + e];
            v[k] = ri == 0 ? cr * pr - ci * pi2 : -(cr * pi2 + ci * pr); }
        u32x4 w; w.x = cvt_pk_bf16(v[0], v[1]); w.y = cvt_pk_bf16(v[2], v[3]); w.z = cvt_pk_bf16(v[4], v[5]); w.w = cvt_pk_bf16(v[6], v[7]);
        *(u32x4*)(WCg + (size_t)row * 256 + q0) = w;
    }
    __syncthreads();
    PSTAMP(23);
}


#ifndef DIAG
#define DIAG 0
#endif
__device__ __forceinline__ void diag_ffn(const float* const* in, const unsigned char* ws, const float* outp, unsigned* flagw, int gtid, int GT) {
    const bf16_t* h1 = (const bf16_t*)(ws + WS_HB); const bf16_t* T = (const bf16_t*)(ws + WS_T); const float* V2 = (const float*)(ws + WS_V2);
    const float *w1 = in[29], *b1 = in[30], *w2 = in[31], *b2 = in[32], *wp = in[33], *wg = in[34], *bg = in[35], *pp = in[1];
    for (int sidx = gtid; sidx < 16384; sidx += GT) {
        unsigned hsh = (unsigned)sidx * 2654435761u, h2 = ((unsigned)sidx + 977u) * 2246822519u; const int r = (hsh >> 8) % SEQ; const int c = (h2 >> 6) % DFF; const int c2 = c % DM;
        float a = b1[c]; for (int k = 0; k < DM; ++k) a += bfu(h1[(size_t)r * DM + k]) * w1[(size_t)k * DFF + c];
        a = fmaxf(a, 0.f); a = a * a; const float tv = bfu(T[(size_t)r * DFF + c]);
        if (fabsf(tv - a) > 0.008f * fabsf(a) + 0.006f) atomicAdd(flagw + 0, 1u);
        float f = b2[c2]; for (int k = 0; k < DFF; ++k) f += bfu(T[(size_t)r * DFF + k]) * w2[(size_t)k * DM + c2];
        float gt = bg[c2]; for (int k = 0; k < DM; ++k) gt += bfu(h1[(size_t)r * DM + k]) * wg[(size_t)k * DM + c2];
        float pw = 0.f; for (int k = 0; k < PLE; ++k) pw += pp[(size_t)r * PLE + k] * wp[(size_t)k * DM + c2];
        const float v2 = DN_ALPHA * bfu(h1[(size_t)r * DM + c2]) + f + fast_sigmoid(gt) * pw; const float got = V2[(size_t)r * DM + c2];
        if (fabsf(got - v2) > 0.008f * fabsf(v2) + 0.006f) atomicAdd(flagw + 1, 1u);
        { const float* vr = V2 + (size_t)r * DM; float m = 0.f; for (int k = 0; k < DM; ++k) m += vr[k]; m /= DM; float v = 0.f; for (int k = 0; k < DM; ++k) { const float d = vr[k] - m; v += d * d; } v /= DM;
          const float e = (vr[c2] - m) / sqrtf(v + LN_EPS) * in[36][c2] + in[37][c2]; const float go = outp[(size_t)r * DM + c2]; if (fabsf(go - e) > 0.004f * fabsf(e) + 0.003f) atomicAdd(flagw + 2, 1u); }
    }
}

__device__ __forceinline__ void diag_pre(const float* const* in, const unsigned char* ws, const unsigned char* dout, unsigned* flagw, int gtid, int GT) {
    const bf16_t* h0 = (const bf16_t*)(ws + WS_HB); const bf16_t* U = (const bf16_t*)(dout + DO_U); const bf16_t* XRb = (const bf16_t*)(ws + WS_XR) + 2048; const bf16_t* Z = (const bf16_t*)(dout + DO_Z);
    const bf16_t* ypre = (const bf16_t*)(dout + DO_YPRE); const bf16_t* ycat = (const bf16_t*)(ws + WS_YCAT); const bf16_t* yg = (const bf16_t*)(ws + WS_YS5G);
    const float *x = in[0], *lg = in[2], *lb = in[3], *win = in[4], *bin = in[5], *gw_ = in[14], *gb = in[15], *g5 = in[23], *gr = in[24];
    for (int sidx = gtid; sidx < 8192; sidx += GT) {
        unsigned hsh = (unsigned)sidx * 2654435761u, h2 = ((unsigned)sidx + 977u) * 2246822519u; const int r = (hsh >> 8) % SEQ; const int c = (h2 >> 6) % DIN; const int c2 = c % DM; const int c1 = c % DS5;
        { float m = 0.f; for (int k = 0; k < DM; ++k) m += x[(size_t)r * DM + k]; m /= DM; float v = 0.f; for (int k = 0; k < DM; ++k) { const float d = x[(size_t)r * DM + k] - m; v += d * d; } v /= DM;
          const float e = (x[(size_t)r * DM + c2] - m) / sqrtf(v + LN_EPS) * lg[c2] + lb[c2]; const float got = bfu(h0[(size_t)r * DM + c2]); if (fabsf(got - e) > 0.008f * fabsf(e) + 0.006f) atomicAdd(flagw + 0, 1u); }
        { float a = bin[c]; for (int k = 0; k < DM; ++k) a += bfu(h0[(size_t)r * DM + k]) * win[(size_t)k * DIN + c];
          const float got = c < 1024 ? bfu(U[(size_t)r * 1024 + c]) : (c < 2048 ? bfu(XRb[(size_t)r * 1024 + c - 1024]) : bfu(Z[(size_t)r * 1024 + c - 2048])); if (fabsf(got - a) > 0.008f * fabsf(a) + 0.006f) atomicAdd(flagw + 3, 1u); }
        { const int hf = c2 >> 10; float ss = 0.f; for (int k = 0; k < 1024; ++k) { const float y = bfu(ypre[(size_t)r * DM + hf * 1024 + k]); ss += y * y; }
          const float e = bfu(ypre[(size_t)r * DM + c2]) / sqrtf(ss / 1024.f + LN_EPS) * (hf ? gr[c2 - 1024] : g5[c2]); const float got = bfu(ycat[(size_t)r * DM + c2]); if (fabsf(got - e) > 0.008f * fabsf(e) + 0.006f) atomicAdd(flagw + 1, 1u); }
        { float a = gb[c1]; for (int k = 0; k < DS5; ++k) a += bfu(yg[(size_t)r * DS5 + k]) * gw_[(size_t)k * DS5 + c1];
          const float e = bfu(yg[(size_t)r * DS5 + c1]) * fast_sigmoid(a); const float got = bfu(ypre[(size_t)r * DM + c1]); if (fabsf(got - e) > 0.008f * fabsf(e) + 0.006f) atomicAdd(flagw + 2, 1u); }
    }
}

__device__ __forceinline__ void diag_v(const float* const* in, const unsigned char* ws, const unsigned char* dout, unsigned* flagw, int gtid, int GT) {
    const bf16_t* h0 = (const bf16_t*)(ws + WS_HB); const bf16_t* ycat = (const bf16_t*)(ws + WS_YCAT); const float* V = (const float*)dout; const float *wo = in[25], *bo = in[26];
    for (int sidx = gtid; sidx < 16384; sidx += GT) { unsigned hsh = (unsigned)sidx * 2654435761u, h2 = ((unsigned)sidx + 977u) * 2246822519u; const int r = (hsh >> 8) % SEQ; const int c = (h2 >> 6) % DM;
        float a = bo[c] + DN_ALPHA * bfu(h0[(size_t)r * DM + c]); for (int k = 0; k < DM; ++k) a += bfu(ycat[(size_t)r * DM + k]) * wo[(size_t)k * DM + c];
        const float got = V[(size_t)r * DM + c]; if (fabsf(got - a) > 0.008f * fabsf(a) + 0.006f) atomicAdd(flagw + 0, 1u); }
}

__device__ __forceinline__ void diag_g(const float* const* in, const unsigned char* ws, unsigned* flagw, int gtid, int GT) {
    const bf16_t* XRp = (const bf16_t*)(ws + WS_XR); const bf16_t* G0 = (const bf16_t*)(ws + WS_G0); const bf16_t* G1 = (const bf16_t*)(ws + WS_G1);
    const float *convw = in[16], *convb = in[17], *wa = in[18], *ba = in[19], *wx = in[20], *bxx = in[21];
    for (int sidx = gtid; sidx < 16384; sidx += GT) { unsigned hsh = (unsigned)sidx * 2654435761u; unsigned h2 = ((unsigned)sidx + 12345u) * 2246822519u; const int t = (hsh >> 7) % SEQ; const int col = (h2 >> 5) % 4096;
        const int h = col >> 8, row = col & 255, bj = row >> 7, dir = (row >> 6) & 1, ch = row & 63;
        const float* W = (bj == 0 ? wa : wx) + ((size_t)(dir * 16 + h) * 64) * 64 + ch; float a = (bj == 0 ? ba : bxx)[(dir * 16 + h) * 64 + ch];
        for (int i = 0; i < 64; ++i) { const int c = 64 * h + i; float xc = convb[c];
            for (int j = 0; j < 4; ++j) xc += convw[j * 1024 + c] * bfu(XRp[(size_t)(t + j) * 1024 + c]);
            a += xc * W[(size_t)i * 64]; }
        const float got = bfu((t < 4096 ? G0 : G1)[(size_t)(t & 4095) * 4096 + col]);
        if (fabsf(got - a) > 0.008f * fabsf(a) + 0.006f) atomicAdd(flagw + 0, 1u); }
}

#ifndef DIAG_HALF
#define DIAG_HALF 1
#endif
__device__ __forceinline__ void diag_max(const unsigned char* ws, unsigned* flagw, int gtid, int GT) {
    const bf16_t* ycat = (const bf16_t*)(ws + WS_YCAT); float mx = 0.f;
    for (size_t i = gtid; i < (size_t)SEQ * 1024; i += GT) { const size_t r = i >> 10, c = (i & 1023) + DIAG_HALF * 1024; mx = fmaxf(mx, fabsf(bfu(ycat[r * DM + c]))); }
    atomicMax(flagw + 0, __float_as_uint(mx));
}

#ifndef DIAG_SEL
#define DIAG_SEL 4
#endif
__device__ __forceinline__ void diag_rows(const float* outp, unsigned* flagw, int gw, int NGW, int lane) {
    for (int row = gw; row < SEQ; row += NGW) { float mx = 0.f; for (int j = lane; j < DM; j += 64) mx = fmaxf(mx, fabsf(outp[(size_t)row * DM + j]));
#pragma unroll
        for (int o = 1; o < 64; o <<= 1) mx = fmaxf(mx, __shfl_xor(mx, o));
        if (lane == 0 && mx > 12.0f) { atomicAdd(flagw + 0, 1u); atomicMin(flagw + 1, (unsigned)row); atomicMax(flagw + 2, (unsigned)row); } }
}

__device__ __forceinline__ void diag_rows_bf(const bf16_t* p, int ld, float thr, unsigned* flagw, int gw, int NGW, int lane) {
    for (int row = gw; row < SEQ; row += NGW) { float mx = 0.f; for (int j = lane; j < ld; j += 64) mx = fmaxf(mx, fabsf(bfu(p[(size_t)row * ld + j])));
#pragma unroll
        for (int o = 1; o < 64; o <<= 1) mx = fmaxf(mx, __shfl_xor(mx, o));
        if (lane == 0 && mx > thr) { atomicAdd(flagw + 0, 1u); atomicMin(flagw + 1, (unsigned)row); atomicMax(flagw + 2, (unsigned)row); } }
}
template <int PHMASK> __global__ void __launch_bounds__(512, 2) mega(Args) {
    extern __shared__ __attribute__((aligned(16))) unsigned char lds_raw[];
    LAS unsigned char* lds = (LAS unsigned char*)lds_raw;
    const int wave = __builtin_amdgcn_readfirstlane((int)threadIdx.x >> 6);
    const int G = gridDim.x, bx = blockIdx.x;
    const int gw = bx * 8 + wave, NGW = G * 8, GT = G * 512;
#define PH_IDS const int lane = fresh_lane(), tid = wave * 64 + lane, gtid = bx * 512 + tid; (void)tid; (void)gtid; (void)lane
    const kin_t KIN = (kin_t)__builtin_amdgcn_kernarg_segment_ptr();
    unsigned char* ws = (unsigned char*)KIN[39]; unsigned char* dout = (unsigned char*)KIN[38];
    const int* kint = (const int*)0; (void)kint;
#if DIAG == 2
    const int lo = ((const __attribute__((address_space(4))) int*)KIN)[80], hi = 7;
#elif DIAG == 3
    const int lo = ((const __attribute__((address_space(4))) int*)KIN)[80], hi = 8;
#elif DIAG == 4
    const int lo = ((const __attribute__((address_space(4))) int*)KIN)[80], hi = 5;
#elif DIAG == 6
    const int lo = ((const __attribute__((address_space(4))) int*)KIN)[80], hi = 7;
#elif DIAG == 8
    const int lo = ((const __attribute__((address_space(4))) int*)KIN)[80], hi = 9;
#elif DIAG == 11 || DIAG == 12
    const int lo = ((const __attribute__((address_space(4))) int*)KIN)[80], hi = 10;
#else
    const int lo = ((const __attribute__((address_space(4))) int*)KIN)[80], hi = ((const __attribute__((address_space(4))) int*)KIN)[81];
#endif
#define IN(k) (((PHMASK >> (k)) & 1) && lo <= (k) && (k) < hi)
    unsigned nbar = 0; unsigned* gbar = (unsigned*)(ws + WS_CTR) + 32; (void)gbar;
    XcdBarrier xb; xb.bar = (unsigned*)(ws + WS_CTR) + 5120; xb.x = xb_xcc_id(); xb.st = (volatile LAS unsigned*)(lds + 155000);
    if (wave == 0) { if (fresh_lane() == 0) { xb.st[0] = 0u; xb.st[1] = 0u; (void)xb_add(&xb.bar[XB_XCNT(xb.x)], 1u); } }
    __syncthreads();
    if (PHMASK == 0xfff && lo == 0 && hi == NPHASE) cg::this_grid().sync();
#ifndef DBL_MASK
#define DBL_MASK 0
#endif
#define REPS(k) (((DBL_MASK >> (k)) & 1) ? 2 : 1)
#define SEAM(k) do { if (IN(k) && IN((k) + 1)) { ++nbar; xcd_barrier(xb, (unsigned)G, wave); if (TSTAMP && bx == 0 && wave == 0) { if (fresh_lane() == 0) ((unsigned long long*)(ws + WS_CTR + 1024))[(k) + 1] = __builtin_amdgcn_s_memrealtime(); } } } while (0)

#define MK_RG const RgCtx RG{(const bf16_t*)(ws + WS_XR), (const bf16_t*)(ws + WS_G0), (const bf16_t*)(ws + WS_G1), (const bf16_t*)(dout + DO_Z), KIN[16], KIN[17], (const float*)(ws + WS_SP), (float*)(ws + WS_AGG), (bf16_t*)(dout + DO_YPRE)}
    if (TSTAMP && bx == 0 && wave == 0) { if (fresh_lane() == 0) ((unsigned long long*)(ws + WS_CTR + 1024))[0] = __builtin_amdgcn_s_memrealtime(); }
    for (int rep = 0; rep < REPS(0); ++rep) {
    if (IN(0)) { PH_IDS;
        if (G != 256) { for (int g = bx; g < 64; g += G) s5_precompute(KIN, ws, g, 0, 1, (LAS float*)lds, tid); }
        {
            LAS float* scr = (LAS float*)(lds + wave * 16640);
            constexpr int I_IN = (DM / 64) * (DIN / 64), I_OUT = (DM / 64) * (DM / 64), I_PG = I_OUT, I_GLU = (DS5 / 64) * (DS5 / 64), I_PW = (PLE / 64) * (DM / 64), I_LN = SEQ / 8;
            constexpr int NITEMS = I_IN + I_OUT + I_PG + I_GLU + I_PW + I_LN;
            for (int it = gw; it < NITEMS; it += NGW) {
                int r = it;
                if (r < I_IN) { transpose_item(KIN[4], DM, DIN, (bf16_t*)(ws + WS_WINT), scr, r, lane); continue; } r -= I_IN;
                if (r < I_LN) { for (int q = 0; q < 8; ++q) { const int row = r * 8 + q; ln_row<true>(KIN[0] + (size_t)row * DM, KIN[2], KIN[3], (bf16_t*)(ws + WS_HB) + (size_t)row * DM, lane); } continue; } r -= I_LN;
                if (r < I_OUT) { transpose_item(KIN[25], DM, DM, (bf16_t*)(ws + WS_WOUTT), scr, r, lane); continue; } r -= I_OUT;
                if (r < I_PG) { transpose_item(KIN[34], DM, DM, (bf16_t*)(ws + WS_PLEGT), scr, r, lane); continue; } r -= I_PG;
                if (r < I_GLU) { transpose_item(KIN[14], DS5, DS5, (bf16_t*)(ws + WS_GLUT), scr, r, lane); continue; } r -= I_GLU;
                transpose_item(KIN[33], PLE, DM, (bf16_t*)(ws + WS_PLEWT), scr, r, lane);
            }
        }
        {   const float* pp = KIN[1]; bf16_t* pb = (bf16_t*)(ws + WS_PB);
            for (int i = gtid; i < SEQ * PLE / 4; i += GT) { const f32x4 v = ((const f32x4*)pp)[i]; u32x2 w; w.x = cvt_pk_bf16(v[0], v[1]); w.y = cvt_pk_bf16(v[2], v[3]); ((u32x2*)pb)[i] = w; }
            const float *convw = KIN[16], *convb = KIN[17], *wa = KIN[18], *ba = KIN[19], *wx = KIN[20], *bxx = KIN[21], *lam = KIN[22];
            bf16_t* rgw = (bf16_t*)(ws + WS_RGW);
            for (int i = gtid; i < 16 * 256 * 32; i += GT) { const int h = i >> 13, row = (i >> 5) & 255, K0 = (i & 31) * 8, j = K0 >> 6, i0 = K0 & 63, ch = row >> 2, bj = (row >> 1) & 1, dir = row & 1;
                const float* W = (bj == 0 ? wa : wx) + ((size_t)(dir * 16 + h) * 64) * 64 + ch; float v[8];
#pragma unroll
                for (int k = 0; k < 8; ++k) v[k] = convw[j * 1024 + 64 * h + i0 + k] * W[(size_t)(i0 + k) * 64];
                u32x4 w; w.x = cvt_pk_bf16(v[0], v[1]); w.y = cvt_pk_bf16(v[2], v[3]); w.z = cvt_pk_bf16(v[4], v[5]); w.w = cvt_pk_bf16(v[6], v[7]);
                *(u32x4*)(rgw + ((size_t)h * 256 + row) * 256 + K0) = w; }
            float* rgb = (float*)(ws + WS_RGBIAS);
            for (int i = gtid; i < 16 * 256; i += GT) { const int h = i >> 8, row = i & 255, ch = row >> 2, bj = (row >> 1) & 1, dir = row & 1;
                const float* W = (bj == 0 ? wa : wx) + ((size_t)(dir * 16 + h) * 64) * 64 + ch; float s = (bj == 0 ? ba : bxx)[(dir * 16 + h) * 64 + ch];
                for (int k = 0; k < 64; ++k) s += convb[64 * h + k] * W[(size_t)k * 64];
                rgb[i] = s; }
            float* spt = (float*)(ws + WS_SP);
            for (int i = gtid; i < 2 * 1024; i += GT) spt[i] = -8.0f * log1pf(expf(-lam[i]));
            unsigned* xr = (unsigned*)(ws + WS_XR);
            for (int i = gtid; i < 1024; i += GT) { xr[i] = 0u; xr[(size_t)(SEQ + 2) * 512 + i] = 0u; }
        }
    }
    if (rep + 1 < REPS(0)) { ++nbar; xcd_barrier(xb, (unsigned)G, wave); } }
    SEAM(0);
    for (int rep = 0; rep < REPS(1); ++rep) {
    if (IN(1)) { PH_IDS;
        SchedStd S; S.so.init(SEQ, DIN, G, bx); S.A = (const char*)(ws + WS_HB); S.B = (const char*)(ws + WS_WINT); S.a_tile = (size_t)256 * DM * 2; S.b_tile = (size_t)256 * DM * 2;
        EpiProj E{(bf16_t*)(dout + DO_U), (bf16_t*)(ws + WS_XR), (bf16_t*)(dout + DO_Z), KIN[5]};
        GEMM_PHASE(lds, wave, GParm{DM, DM * 2, 128, 64, 0}, S, E);
        if (G == 256 && bx >= 128) { __syncthreads(); const int t2 = wave * 64 + fresh_lane(); s5_precompute(KIN, ws, (bx - 128) >> 1, (bx - 128) & 1, 2, (LAS float*)lds, t2); }
    }
    if (rep + 1 < REPS(1)) { ++nbar; xcd_barrier(xb, (unsigned)G, wave); } }
    SEAM(1);
    for (int rep = 0; rep < REPS(2); ++rep) {
    if (IN(2)) { PH_IDS;
        { SchedS5a S{(const char*)(dout + DO_U), (const char*)(ws + WS_WG), G, bx}; EpiS5a E{(bf16_t*)(ws + WS_YINTRA), (float*)(ws + WS_S)};
          GEMM_PHASE(lds, wave, GParm{512, 1024, 128, 64, 0}, S, E); }
        { SchedRG S{(const char*)(ws + WS_XR), (const char*)(ws + WS_RGW), G, bx}; EpiG E{(bf16_t*)(ws + WS_G0), (bf16_t*)(ws + WS_G1), (const float*)(ws + WS_RGBIAS)};
          GEMM_PHASE(lds, wave, GParm{256, 2048, 2048, 64, 0}, S, E); }
    }
    if (rep + 1 < REPS(2)) { ++nbar; xcd_barrier(xb, (unsigned)G, wave); } }
    SEAM(2);
    for (int rep = 0; rep < REPS(3); ++rep) {
    if (IN(3)) { PH_IDS;
        if (bx < 128) {
            const int g = bx >> 1, n = bx & 1; const float* Sg = (const float*)(ws + WS_S) + (size_t)g * NCH * 256 + n * 128; LAS float* Ls = (LAS float*)lds;
            for (int i = tid; i < NCH * 32; i += 512) { const int c = i >> 5, q4 = (i & 31) * 4; *(LAS f32x4*)(Ls + c * 128 + q4) = *(const f32x4*)(Sg + (size_t)c * 256 + q4); }
            __syncthreads();
            if (wave == 0) { const int p = lane, pi = (n * 64 + g) * 64 + p;
                const float lr = fminf(KIN[6][pi], -1e-4f), li = KIN[7][pi], step = expf(KIN[8][n * 64 + g]); float ar, ai; cpow(lr * step, li * step, TC, ar, ai);
                bf16_t* hp = (bf16_t*)(ws + WS_HPREV) + (size_t)g * NCH * 256 + n * 128; float hr = 0.f, him = 0.f;
                for (int cc = 0; cc < NCH; ++cc) { const int c = n == 0 ? cc : NCH - 1 - cc;
                    hp[(size_t)c * 256 + p] = (bf16_t)(cvt_pk_bf16(hr, 0.f) & 0xffffu); hp[(size_t)c * 256 + 64 + p] = (bf16_t)(cvt_pk_bf16(him, 0.f) & 0xffffu);
                    const float sr = Ls[c * 128 + p], si = Ls[c * 128 + 64 + p]; const float nr = ar * hr - ai * him + sr, ni = ar * him + ai * hr + si; hr = nr; him = ni; } }
            __syncthreads();
        }
        { MK_RG; for (int un = bx; un < 256; un += G) rg_pass_a(RG, un & 1, un >> 1, tid); }
    }
    if (rep + 1 < REPS(3)) { ++nbar; xcd_barrier(xb, (unsigned)G, wave); } }
    SEAM(3);
    for (int rep = 0; rep < REPS(4); ++rep) {
    if (IN(4)) { PH_IDS;
#if NAIVE_S5
        if (gw < 64) naive_s5_group((const float* const*)0, (const bf16_t*)(dout + DO_U), (float*)(ws + WS_YINTRA), (bf16_t*)(ws + WS_YS5G), gw, lane);
#else
        { SchedS5b S{(const char*)(ws + WS_HPREV), (const char*)(ws + WS_WC), G, bx}; EpiS5b E{(const bf16_t*)(ws + WS_YINTRA), (bf16_t*)(ws + WS_YS5G)};
          GEMM_PHASE(lds, wave, GParm{256, 512, 128, 64, 0}, S, E); }
#endif
#if NAIVE_RG
        { MK_RG; if (gtid < 1024) naive_rg_channel(RG, gtid); }
#else
        { MK_RG; __syncthreads(); for (int un = bx; un < 256; un += G) { rg_pass_c(RG, un & 1, un >> 1, tid, (LAS float*)lds); __syncthreads(); } }
#endif
    }
    if (rep + 1 < REPS(4)) { ++nbar; xcd_barrier(xb, (unsigned)G, wave); } }
    SEAM(4);
    for (int rep = 0; rep < REPS(5); ++rep) {
    if (IN(5)) { PH_IDS;
        SchedStd S; S.so.init(SEQ, DS5, G, bx); S.A = (const char*)(ws + WS_YS5G); S.B = (const char*)(ws + WS_GLUT); S.a_tile = (size_t)256 * 16 * 2; S.b_tile = (size_t)256 * DS5 * 2;
        EpiGlu E{(const bf16_t*)(ws + WS_YS5G), (bf16_t*)(dout + DO_YPRE), KIN[15]};
        GEMM_PHASE(lds, wave, GParm{DS5, 32, 4u * GM_STRIDE * 2u, 16, GM_STRIDE}, S, E);
        if (G == 256 && bx >= 128) {
            LAS float* scr = (LAS float*)(lds + wave * 16640); constexpr int I_FF1 = (DM / 64) * (DFF / 64);
            for (int it = (bx - 128) * 8 + wave; it < I_FF1; it += 1024) transpose_item(KIN[29], DM, DFF, (bf16_t*)(ws + WS_FF1T), scr, it, lane); }
    }
    if (rep + 1 < REPS(5)) { ++nbar; xcd_barrier(xb, (unsigned)G, wave); } }
    SEAM(5);
    for (int rep = 0; rep < REPS(6); ++rep) {
    if (IN(6)) { PH_IDS;
        const float *g5 = KIN[23], *gr = KIN[24];
        for (int row = gw; row < SEQ; row += NGW) { const u32x4* yr = (const u32x4*)(dout + DO_YPRE) + (size_t)row * 256; u32x4* oc = (u32x4*)(ws + WS_YCAT) + (size_t)row * 256;
            u32x4 w[4]; float s0 = 0.f, s1 = 0.f;
#pragma unroll
            for (int j = 0; j < 4; ++j) { w[j] = yr[lane + 64 * j]; const float q = bf_lo(w[j].x) * bf_lo(w[j].x) + bf_hi(w[j].x) * bf_hi(w[j].x) + bf_lo(w[j].y) * bf_lo(w[j].y) + bf_hi(w[j].y) * bf_hi(w[j].y)
                + bf_lo(w[j].z) * bf_lo(w[j].z) + bf_hi(w[j].z) * bf_hi(w[j].z) + bf_lo(w[j].w) * bf_lo(w[j].w) + bf_hi(w[j].w) * bf_hi(w[j].w); if (j < 2) s0 += q; else s1 += q; }
            const float r0 = 1.0f / sqrtf(wave_sum(s0) * (1.f / 1024.f) + LN_EPS), r1 = 1.0f / sqrtf(wave_sum(s1) * (1.f / 1024.f) + LN_EPS);
#pragma unroll
            for (int j = 0; j < 4; ++j) { const int col = (lane + 64 * j) * 8; const float rs = j < 2 ? r0 : r1; const float* gp = j < 2 ? g5 + col : gr + (col - 1024);
                const f32x4 ga = *(const f32x4*)gp, gb = *(const f32x4*)(gp + 4);
                u32x4 o; o.x = cvt_pk_bf16(bf_lo(w[j].x) * rs * ga[0], bf_hi(w[j].x) * rs * ga[1]); o.y = cvt_pk_bf16(bf_lo(w[j].y) * rs * ga[2], bf_hi(w[j].y) * rs * ga[3]);
                o.z = cvt_pk_bf16(bf_lo(w[j].z) * rs * gb[0], bf_hi(w[j].z) * rs * gb[1]); o.w = cvt_pk_bf16(bf_lo(w[j].w) * rs * gb[2], bf_hi(w[j].w) * rs * gb[3]); oc[lane + 64 * j] = o; } }
        {
            LAS float* scr = (LAS float*)(lds + wave * 16640);
            constexpr int I_FF1 = (DM / 64) * (DFF / 64), I_FF2 = (DFF / 64) * (DM / 64);
            for (int it = gw; it < (G == 256 ? I_FF2 : I_FF1 + I_FF2); it += NGW) {
                if (it < I_FF2) transpose_item(KIN[31], DFF, DM, (bf16_t*)(ws + WS_FF2T), scr, it, lane);
                else transpose_item(KIN[29], DM, DFF, (bf16_t*)(ws + WS_FF1T), scr, it - I_FF2, lane); }
        }
    }
    if (rep + 1 < REPS(6)) { ++nbar; xcd_barrier(xb, (unsigned)G, wave); } }
    SEAM(6);
    for (int rep = 0; rep < REPS(7); ++rep) {
    if (IN(7)) { PH_IDS;
        SchedStd S; S.so.init(SEQ, DM, G, bx); S.A = (const char*)(ws + WS_YCAT); S.B = (const char*)(ws + WS_WOUTT); S.a_tile = (size_t)256 * DM * 2; S.b_tile = (size_t)256 * DM * 2;
        EpiResLn1 E{(bf16_t*)(ws + WS_HB), KIN[26], KIN[27], KIN[28], PanelStats8{(unsigned long long*)(ws + WS_AGG), (unsigned*)(ws + WS_CTR) + 1024, LN_EPS}};
        GEMM_PHASE(lds, wave, GParm{DM, DM * 2, 128, 64, 0}, S, E);
    }
    if (rep + 1 < REPS(7)) { ++nbar; xcd_barrier(xb, (unsigned)G, wave); } }
    for (int rep = 0; rep < REPS(8); ++rep) {
    if (IN(8)) { }
    if (rep + 1 < REPS(8)) { ++nbar; xcd_barrier(xb, (unsigned)G, wave); } }
    SEAM(8);
    for (int rep = 0; rep < REPS(9); ++rep) {
    if (IN(9)) { PH_IDS;
        { SchedStd S; S.so.init(SEQ, DFF, G, bx); S.A = (const char*)(ws + WS_HB); S.B = (const char*)(ws + WS_FF1T); S.a_tile = (size_t)256 * DM * 2; S.b_tile = (size_t)256 * DM * 2;
          EpiPlain<1> E{(bf16_t*)(ws + WS_T), DFF, KIN[30], 0}; GEMM_PHASE(lds, wave, GParm{DM, DM * 2, 128, 64, 0}, S, E); }
        { SchedStd S; S.so.init(SEQ, DM, G, bx); S.A = (const char*)(ws + WS_HB); S.B = (const char*)(ws + WS_PLEGT); S.a_tile = (size_t)256 * DM * 2; S.b_tile = (size_t)256 * DM * 2;
          EpiPlain<2> E{(bf16_t*)dout, DM, KIN[35], (size_t)1 << 20}; GEMM_PHASE(lds, wave, GParm{DM, DM * 2, 128, 64, 0}, S, E); }
        { SchedStd S; S.so.init(SEQ, DM, G, bx); S.A = (const char*)(ws + WS_PB); S.B = (const char*)(ws + WS_PLEWT); S.a_tile = (size_t)256 * PLE * 2; S.b_tile = (size_t)256 * PLE * 2;
          EpiPlain<0> E{(bf16_t*)dout + ((size_t)1 << 19), DM, nullptr, (size_t)1 << 20}; GEMM_PHASE(lds, wave, GParm{PLE, PLE * 2, 128, 64, 0}, S, E); }
    }
    if (rep + 1 < REPS(9)) { ++nbar; xcd_barrier(xb, (unsigned)G, wave); } }
    SEAM(9);
    for (int rep = 0; rep < REPS(10); ++rep) {
    if (IN(10)) { PH_IDS;
        SchedStd S; S.so.init(SEQ, DM, G, bx); S.A = (const char*)(ws + WS_T); S.B = (const char*)(ws + WS_FF2T); S.a_tile = (size_t)256 * DFF * 2; S.b_tile = (size_t)256 * DFF * 2;
        EpiResLn2 E{(const bf16_t*)(ws + WS_HB), KIN[32], KIN[36], KIN[37], (float*)dout, (const bf16_t*)dout, PanelStats8{(unsigned long long*)(ws + WS_AGG) + 65536, (unsigned*)(ws + WS_CTR) + 1024 + 64 * 32, LN_EPS}};
        GEMM_PHASE(lds, wave, GParm{DFF, DFF * 2, 128, 64, 0}, S, E);
    }
    if (rep + 1 < REPS(10)) { ++nbar; xcd_barrier(xb, (unsigned)G, wave); } }
    for (int rep = 0; rep < REPS(11); ++rep) {
    if (IN(11)) { }
    if (rep + 1 < REPS(11)) { ++nbar; xcd_barrier(xb, (unsigned)G, wave); } }
#ifdef EXTRA_BARRIERS
    for (int eb = 0; eb < EXTRA_BARRIERS; ++eb) { ++nbar; xcd_barrier(xb, (unsigned)G, wave); }
#endif
#if TSTAMP
    if (bx == 0 && wave == 0) { if (fresh_lane() == 0) { unsigned long long* st = (unsigned long long*)(ws + WS_CTR + 1024); st[12] = __builtin_amdgcn_s_memrealtime();
        ((float*)KIN[38])[0] = (float)(long long)(__hip_atomic_load(st + TS_A1, __ATOMIC_RELAXED, __HIP_MEMORY_SCOPE_AGENT) - __hip_atomic_load(st + TS_A0, __ATOMIC_RELAXED, __HIP_MEMORY_SCOPE_AGENT)) * 0.01f; } }
#endif
#if DIAG
    { ++nbar; xcd_barrier(xb, (unsigned)G, wave); PH_IDS; unsigned* flagw = (unsigned*)(ws + WS_CTR) + 48;
#if DIAG == 1
      diag_ffn((const float* const*)0, ws, ((float*)KIN[38]), flagw, gtid, GT);
#elif DIAG == 2
      diag_pre((const float* const*)0, ws, dout, flagw, gtid, GT);
#elif DIAG == 3
      diag_v((const float* const*)0, ws, dout, flagw, gtid, GT);
#elif DIAG == 4
      diag_g((const float* const*)0, ws, flagw, gtid, GT);
#elif DIAG == 6
      diag_max(ws, flagw, gtid, GT);
#else
      if (bx == 0 && tid == 0) flagw[1] = 0xffffffffu;
      ++nbar; xcd_barrier(xb, (unsigned)G, wave);
#if DIAG == 7
      diag_rows(((float*)KIN[38]), flagw, gw, NGW, lane);
#elif DIAG == 8
      diag_rows_bf((const bf16_t*)(ws + WS_HB), DM, 12.0f, flagw, gw, NGW, lane);
#elif DIAG == 9
      diag_rows((const float*)(ws + WS_V2), flagw, gw, NGW, lane);
#elif DIAG == 10
      diag_rows_bf((const bf16_t*)(ws + WS_T), DFF, 150.0f, flagw, gw, NGW, lane);
#elif DIAG == 11
      diag_rows_bf((const bf16_t*)(dout + DO_PW), DM, 8.0f, flagw, gw, NGW, lane);
#elif DIAG == 12
      diag_rows_bf((const bf16_t*)(dout + DO_SG), DM, 1.01f, flagw, gw, NGW, lane);
#endif
#endif
      ++nbar; xcd_barrier(xb, (unsigned)G, wave);
#if DIAG != 1
      for (int i = gtid; i < SEQ * DM; i += GT) ((float*)KIN[38])[i] = 0.f;
      ++nbar; xcd_barrier(xb, (unsigned)G, wave);
#endif
      if (bx == 0 && tid == 0) { unsigned code = 0; for (int q = 0; q < 4; ++q) if (__hip_atomic_load(flagw + q, __ATOMIC_RELAXED, __HIP_MEMORY_SCOPE_AGENT) > 100u) code |= 1u << q; if (DIAG >= 7) { const unsigned cnt = __hip_atomic_load(flagw, __ATOMIC_RELAXED, __HIP_MEMORY_SCOPE_AGENT), mn = __hip_atomic_load(flagw + 1, __ATOMIC_RELAXED, __HIP_MEMORY_SCOPE_AGENT), mxr = __hip_atomic_load(flagw + 2, __ATOMIC_RELAXED, __HIP_MEMORY_SCOPE_AGENT);
          const unsigned v = DIAG_SEL == 0 ? cnt : DIAG_SEL == 1 ? mn / 100u : DIAG_SEL == 2 ? mn % 100u : DIAG_SEL == 3 ? mxr / 100u : mxr % 100u; ((float*)KIN[38])[0] = 100.0f * (float)(v + 1u); }
      else ((float*)KIN[38])[0] = (DIAG == 6) ? 1000.0f * __uint_as_float(__hip_atomic_load(flagw, __ATOMIC_RELAXED, __HIP_MEMORY_SCOPE_AGENT)) : 1000.0f * (float)(code + 16u); } }
#endif
#undef IN
#undef SEAM
}


#if PER_PHASE_LAUNCH
template <int PH> static void set_attr_one() { (void)hipFuncSetAttribute((const void*)mega<(1 << PH)>, hipFuncAttributeMaxDynamicSharedMemorySize, LDS_BYTES); }
template <int PH> static void launch_one(Args a, int grid, hipStream_t stream) { a.ph_lo = PH; a.ph_hi = PH + 1; hipLaunchKernelGGL(mega<(1 << PH)>, dim3(grid), dim3(512), LDS_BYTES, stream, a); }
static void set_attrs() { set_attr_one<0>(); set_attr_one<1>(); set_attr_one<2>(); set_attr_one<3>(); set_attr_one<4>(); set_attr_one<5>(); set_attr_one<6>(); set_attr_one<7>(); set_attr_one<8>(); set_attr_one<9>(); set_attr_one<10>(); set_attr_one<11>(); }
static void launch_phases(const Args& a, int grid, hipStream_t stream) { launch_one<0>(a, grid, stream); launch_one<1>(a, grid, stream); launch_one<2>(a, grid, stream); launch_one<3>(a, grid, stream); launch_one<4>(a, grid, stream); launch_one<5>(a, grid, stream);
    launch_one<6>(a, grid, stream); launch_one<7>(a, grid, stream); launch_one<8>(a, grid, stream); launch_one<9>(a, grid, stream); launch_one<10>(a, grid, stream); launch_one<11>(a, grid, stream); }
#else
static void set_attrs() { (void)hipFuncSetAttribute((const void*)mega<0xfff>, hipFuncAttributeMaxDynamicSharedMemorySize, LDS_BYTES); }
#endif

extern "C" void kernel_launch(void* const* d_in, const int* in_sizes, int n_in, void* d_out, int out_size, void* d_ws, size_t ws_size, hipStream_t stream) {
    static int grid = 0;
    if (grid == 0) {
        if (n_in != 38 || out_size != SEQ * DM || ws_size < WS_END) { fprintf(stderr, "kernel_launch: unexpected shapes (n_in %d out %d ws %zu)\n", n_in, out_size, ws_size); grid = -1; return; }
        int dev = 0, cus = 0, per_cu = 0;
        hipGetDevice(&dev); hipDeviceGetAttribute(&cus, hipDeviceAttributeMultiprocessorCount, dev);
        set_attrs();
        per_cu = 1;
        (void)hipGetLastError();
        if (per_cu < 1) per_cu = 1;
        grid = cus;
    }
    if (grid < 0) return;
#ifdef POISON_NAN
    hipMemsetAsync(d_ws, 0xFF, WS_END, stream); hipMemsetAsync(d_out, 0xFF, (size_t)64 * MiB, stream);
#endif
    hipMemsetAsync((char*)d_ws + WS_CTR, 0, 40960, stream);
    Args a{};
    for (int i = 0; i < 38; ++i) a.in[i] = (const float*)d_in[i];
    a.out = (float*)d_out; a.ws = (unsigned char*)d_ws;
#if PER_PHASE_LAUNCH
    launch_phases(a, grid, stream);
#else
    a.ph_lo = 0; a.ph_hi = NPHASE;
    void* kargs[] = {&a};
    hipError_t e = hipLaunchCooperativeKernel((const void*)mega<0xfff>, dim3(grid), dim3(512), kargs, LDS_BYTES, stream);
    if (e != hipSuccess) fprintf(stderr, "cooperative launch failed: %s (grid %d)\n", hipGetErrorString(e), grid);
#endif
}
```

```cpp
#include <hip/hip_runtime.h>
#include <hip/hip_cooperative_groups.h>
#include <cstdio>
#include <cstdint>
namespace cg = cooperative_groups;

#ifndef PER_PHASE_LAUNCH
#define PER_PHASE_LAUNCH 0
#endif

#ifndef TSTAMP
#define TSTAMP 0
#define TS_A0 4
#define TS_A1 5
#define TS_B0 9
#define TS_B1 12
#endif
#define LAS __attribute__((address_space(3)))
typedef unsigned short bf16_t;
typedef short bf16x8 __attribute__((ext_vector_type(8)));
typedef float f32x4 __attribute__((ext_vector_type(4)));
typedef float f32x2 __attribute__((ext_vector_type(2)));
typedef unsigned u32x4 __attribute__((ext_vector_type(4)));
typedef unsigned u32x2 __attribute__((ext_vector_type(2)));

constexpr int SEQ = 8192, DM = 2048, DIN = 3072, DS5 = 1024, DRG = 1024, NG = 64, NP = 64, NK = 16, NH = 16, HD = 64, DFF = 8192, PLE = 256;
constexpr int TC = 32, NCH = SEQ / TC;
constexpr float LN_EPS = 1e-5f, DN_ALPHA = 1.18920711500272f;
constexpr int NPHASE = 12;

constexpr size_t MiB = (size_t)1 << 20;
constexpr size_t WS_FF2T = 0, WS_HB = 32 * MiB, WS_FF1T = 64 * MiB, WS_PLEGT = 96 * MiB, WS_PLEWT = 104 * MiB, WS_PB = 105 * MiB, WS_WOUTT = 109 * MiB,
    WS_V2 = 64 * MiB, WS_G0 = 0, WS_G1 = 64 * MiB,
    WS_WG = 128 * MiB, WS_WC = 176 * MiB, WS_RGW = 192 * MiB, WS_GLUT = 194 * MiB, WS_XR = 196 * MiB, WS_YINTRA = 213 * MiB, WS_S = 229 * MiB, WS_HPREV = 245 * MiB, WS_WINT = 229 * MiB,
    WS_YS5G = 128 * MiB, WS_YCAT = 144 * MiB, WS_T = 128 * MiB,
    WS_AGG = 256 * MiB, WS_CARRY = 258 * MiB, WS_SUMSQ = 259 * MiB, WS_RGBIAS = 259 * MiB + 64 * 1024, WS_SP = WS_RGBIAS + 16 * 1024, WS_CTR = WS_SP + 8 * 1024, WS_END = 260 * MiB;
constexpr size_t DO_YPRE = 0, DO_Z = 32 * MiB, DO_U = 48 * MiB, DO_SG = 0, DO_PW = 32 * MiB;
constexpr int GM_STRIDE = SEQ * 16;
constexpr int LDS_BYTES = 152 * 1024;

typedef __bf16 bf16x2_t __attribute__((ext_vector_type(2)));
__device__ __forceinline__ unsigned cvt_pk_bf16(float lo, float hi) { const f32x2 v = {lo, hi}; const bf16x2_t b = __builtin_convertvector(v, bf16x2_t); return __builtin_bit_cast(unsigned, b); }
__device__ __forceinline__ float bf_lo(unsigned w) { return __uint_as_float(w << 16); }
__device__ __forceinline__ float bf_hi(unsigned w) { return __uint_as_float(w & 0xffff0000u); }
__device__ __forceinline__ f32x4 bf4(u32x2 w) { return (f32x4){bf_lo(w.x), bf_hi(w.x), bf_lo(w.y), bf_hi(w.y)}; }
__device__ __forceinline__ float fast_sigmoid(float x) { return __builtin_amdgcn_rcpf(1.0f + __expf(-x)); }
__device__ __forceinline__ float gelu_tanh(float x) { const float u = 1.5957691216057308f * (x + 0.044715f * x * x * x); return x * fast_sigmoid(u); }
__device__ __forceinline__ float wave_sum(float v) {
#pragma unroll
    for (int o = 1; o < 64; o <<= 1) v += __shfl_xor(v, o);
    return v;
}
__device__ __forceinline__ int lane_id() { return (int)__builtin_amdgcn_mbcnt_hi(~0u, __builtin_amdgcn_mbcnt_lo(~0u, 0u)); }
__device__ __forceinline__ int fresh_lane() { unsigned z = 0; asm volatile("" : "+s"(z)); return (int)__builtin_amdgcn_mbcnt_hi(~0u, __builtin_amdgcn_mbcnt_lo(~0u, z)); }
#define LDS_WAIT() asm volatile("s_waitcnt lgkmcnt(0)" ::: "memory")

namespace pg8 {
constexpr int BM = 256, BK = 64, HALF = 128, HTB = HALF * BK * 2, STAGE_BYTES = 8 * HTB, NXCD = 8, WGM = 8;
__host__ __device__ __forceinline__ int lds_byte(int r, int c) { const int st = (r >> 4) * 2 + (c >> 5), rr = r & 15, cc = c & 31, ob = rr * 64 + cc * 2; return st * 1024 + (ob ^ (((ob >> 9) & 1) << 5)); }
__host__ __device__ __forceinline__ void stage_rc(int b, int& R, int& C) { const int st = b / 1024, sb = b % 1024, swz = sb ^ (((sb >> 9) & 1) << 5); R = (st >> 1) * 16 + swz / 64; C = (st & 1) * 32 + (swz % 64) / 2; }
__host__ __device__ __forceinline__ int perm32(int rho) { const int n = rho >> 4, i = rho & 15; return 8 * (i >> 2) + 4 * n + (i & 3); }

struct Unit { int pm, pn; };
struct StaticOrder {
    int nM, nN, nwg, G, c;
    __host__ __device__ void init(int M, int N, int G_, int c_) { nM = M / BM; nN = N / BM; nwg = nM * nN; G = G_; c = c_; }
    __host__ __device__ bool next(int i, Unit& u) const {
        const long L = (long)i * G + c; if (L >= nwg) return false;
        int wgid = (int)L; { const int q = nwg / NXCD, r = nwg % NXCD, xcd = wgid % NXCD, off = wgid / NXCD; wgid = (xcd < r ? xcd * (q + 1) : r * (q + 1) + (xcd - r) * q) + off; }
        const int nig = WGM * nN, gid = wgid / nig, fm = gid * WGM, gsz = (nM - fm) < WGM ? (nM - fm) : WGM;
        u.pm = fm + ((wgid % nig) % gsz); u.pn = (wgid % nig) / gsz; return true;
    }
};
struct GUnit { const char* A; const char* B; int i0, i1; };
struct GParm { int K; unsigned a_rs, a_ks; int a_cw, a_cs; };

template <class Epi, class Sched>
__device__ __forceinline__ void gemm_phase(LAS unsigned char* lds, const int wid, const GParm gp, const Sched& S, const Epi& E) {
    const int lane = fresh_lane(), tid = wid * 64 + lane, wr = wid >> 2, wc = wid & 3, fr = lane & 15, fq = lane >> 4;
    const int K = gp.K, nt = K / BK;
    unsigned voffA[2], voffB[2];
#pragma unroll
    for (int i = 0; i < 2; ++i) { int R, C; stage_rc(tid * 16 + i * 8192, R, C); const int Rb = Epi::PERM ? ((R & ~31) + perm32(R & 31)) : R;
        voffA[i] = (unsigned)R * gp.a_rs + (unsigned)((C / gp.a_cw) * gp.a_cs + (C % gp.a_cw)) * 2u; voffB[i] = (unsigned)(Rb * K + C) * 2u; }
    const size_t ksA = gp.a_ks, ksB = (size_t)(BK * 2);
    const size_t hsA = (size_t)HALF * gp.a_rs, hsB = (size_t)HALF * K * 2;
    const unsigned ldsw = (unsigned)wid * 1024u;
    const int aoff = lds_byte(wr * 64 + fr, fq * 8), boff = lds_byte(wc * 32 + fr, fq * 8);
#define PG8_SA(b, h) (((b) * 2 + (h)) * HTB)
#define PG8_SB(b, h) ((4 + (b) * 2 + (h)) * HTB)
#define PG8_STAGE(bufoff, gbase, voff) do { _Pragma("unroll") for (int _i = 0; _i < 2; ++_i) \
        __builtin_amdgcn_global_load_lds((const unsigned*)((const char*)(gbase) + (voff)[_i]), (LAS unsigned*)(lds + (bufoff) + ldsw + _i * 8192), 16, 0, 0); } while (0)
#define PG8_LDA(dst, b, h) do { _Pragma("unroll") for (int m = 0; m < 4; ++m) _Pragma("unroll") for (int k = 0; k < 2; ++k) dst[m][k] = *(const LAS bf16x8*)(lds + PG8_SA(b, h) + aoff + m * 2048 + k * 1024); } while (0)
#define PG8_LDB(dst, b, h) do { _Pragma("unroll") for (int n = 0; n < 2; ++n) _Pragma("unroll") for (int k = 0; k < 2; ++k) dst[n][k] = *(const LAS bf16x8*)(lds + PG8_SB(b, h) + boff + n * 2048 + k * 1024); } while (0)
#define PG8_MMA(ai, bj, At, Bt) do { __builtin_amdgcn_s_setprio(1); _Pragma("unroll") for (int m = 0; m < 4; ++m) _Pragma("unroll") for (int n = 0; n < 2; ++n) _Pragma("unroll") for (int k = 0; k < 2; ++k) \
        acc[ai][bj][m][n] = __builtin_amdgcn_mfma_f32_16x16x32_bf16(Bt[n][k], At[m][k], acc[ai][bj][m][n], 0, 0, 0); __builtin_amdgcn_s_setprio(0); } while (0)
#define PG8_WAIT_V(n) asm volatile("s_waitcnt vmcnt(" #n ")" ::: "memory")
#define PG8_WAIT_L(n) asm volatile("s_waitcnt lgkmcnt(" #n ")" ::: "memory")
#define PG8_BAR __builtin_amdgcn_s_barrier()
#define PG8_SCHED __builtin_amdgcn_sched_barrier(0)
    GUnit cur, nxt; int ui = 0;
    if (!S.next(0, cur)) return;
    f32x4 acc[2][2][4][2];
#pragma unroll
    for (int a = 0; a < 2; ++a)
#pragma unroll
        for (int b = 0; b < 2; ++b)
#pragma unroll
            for (int m = 0; m < 4; ++m)
#pragma unroll
                for (int n = 0; n < 2; ++n) acc[a][b][m][n] = (f32x4){0.f, 0.f, 0.f, 0.f};
    bf16x8 At[4][2], B0[2][2], B1[2][2];
    const char* cA = cur.A; const char* cB = cur.B;
    PG8_STAGE(PG8_SB(0, 0), cB, voffB); PG8_STAGE(PG8_SB(0, 1), cB + hsB, voffB); PG8_STAGE(PG8_SA(0, 0), cA, voffA); PG8_STAGE(PG8_SA(0, 1), cA + hsA, voffA);
    if (wr == 1) PG8_BAR;
    PG8_WAIT_V(2); PG8_BAR;
    PG8_STAGE(PG8_SB(1, 0), cB + ksB, voffB); PG8_STAGE(PG8_SA(1, 0), cA + ksA, voffA); PG8_STAGE(PG8_SB(1, 1), cB + hsB + ksB, voffB);
    PG8_WAIT_V(6); PG8_BAR;
    for (;;) {
        const bool has_next = S.next(ui + 1, nxt);
        const char* nA = has_next ? nxt.A : cA; const char* nB = has_next ? nxt.B : cB;
        for (int t = 0; t < nt; t += 2) {
            const bool last = (t == nt - 2);
            const char* a1 = cA + (size_t)(t + 1) * ksA;
            const char* a2 = last ? nA : cA + (size_t)(t + 2) * ksA; const char* b2 = last ? nB : cB + (size_t)(t + 2) * ksB;
            const char* a3 = a2 + ksA; const char* b3 = b2 + ksB;
            PG8_LDB(B0, 0, 0); PG8_LDB(B1, 0, 1); PG8_SCHED; PG8_LDA(At, 0, 0); PG8_STAGE(PG8_SA(1, 1), a1 + hsA, voffA);
            PG8_WAIT_V(8); PG8_WAIT_L(0); PG8_BAR; PG8_MMA(0, 0, At, B0); PG8_MMA(0, 1, At, B1); PG8_BAR; PG8_SCHED;
            PG8_LDA(At, 0, 1); PG8_STAGE(PG8_SB(0, 0), b2, voffB); PG8_STAGE(PG8_SB(0, 1), b2 + hsB, voffB); PG8_STAGE(PG8_SA(0, 0), a2, voffA);
            PG8_WAIT_V(8); PG8_WAIT_L(0); PG8_BAR; PG8_MMA(1, 0, At, B0); PG8_MMA(1, 1, At, B1); PG8_BAR; PG8_SCHED;
            PG8_LDB(B0, 1, 0); PG8_LDB(B1, 1, 1); PG8_SCHED; PG8_LDA(At, 1, 0); PG8_STAGE(PG8_SA(0, 1), a2 + hsA, voffA);
            PG8_WAIT_V(8); PG8_WAIT_L(0); PG8_BAR; PG8_MMA(0, 0, At, B0); PG8_MMA(0, 1, At, B1); PG8_BAR; PG8_SCHED;
            PG8_LDA(At, 1, 1); PG8_STAGE(PG8_SB(1, 0), b3, voffB); PG8_STAGE(PG8_SB(1, 1), b3 + hsB, voffB); PG8_STAGE(PG8_SA(1, 0), a3, voffA);
            PG8_WAIT_V(8); PG8_WAIT_L(0); PG8_BAR; PG8_MMA(1, 0, At, B0); PG8_MMA(1, 1, At, B1); PG8_BAR; PG8_SCHED;
        }
        if (wr == 0) PG8_BAR;
        if constexpr (!Epi::AFTER_DRAIN) { const int l_o = fresh_lane(); E(acc, cur, wr, wc, l_o & 15, l_o >> 4); }
        if (!has_next) break;
#pragma unroll
        for (int a = 0; a < 2; ++a)
#pragma unroll
            for (int b = 0; b < 2; ++b)
#pragma unroll
                for (int m = 0; m < 4; ++m)
#pragma unroll
                    for (int n = 0; n < 2; ++n) acc[a][b][m][n] = (f32x4){0.f, 0.f, 0.f, 0.f};
        cur = nxt; cA = nA; cB = nB; ++ui;
        if (wr == 1) PG8_BAR;
    }
    PG8_WAIT_V(0);
    PG8_BAR;
    if constexpr (Epi::AFTER_DRAIN) { const int l_o = fresh_lane(); E.fused(acc, cur, wr, wc, l_o & 15, l_o >> 4, lds, wid); }
#undef PG8_SA
#undef PG8_SB
#undef PG8_STAGE
#undef PG8_LDA
#undef PG8_LDB
#undef PG8_MMA
#undef PG8_WAIT_V
#undef PG8_WAIT_L
#undef PG8_BAR
#undef PG8_SCHED
}
}
using pg8::GUnit; using pg8::GParm;
typedef f32x4 AccT[2][2][4][2];

struct SchedStd {
    pg8::StaticOrder so; const char* A; const char* B; size_t a_tile, b_tile;
    __device__ __forceinline__ bool next(int i, GUnit& u) const { pg8::Unit t; if (!so.next(i, t)) return false; u.A = A + (size_t)t.pm * a_tile; u.B = B + (size_t)t.pn * b_tile; u.i0 = t.pm; u.i1 = t.pn; return true; }
};
struct SchedS5a { const char* U; const char* WG; int G, c;
    __device__ __forceinline__ bool next(int i, GUnit& u) const { const int L = i * G + c; if (L >= 192) return false; const int g = L / 3, pn = L % 3;
        u.A = U + (size_t)g * GM_STRIDE * 2; u.B = WG + ((size_t)g * 768 + 256 * pn) * 512 * 2; u.i0 = g; u.i1 = pn; return true; } };
struct SchedS5b { const char* HP; const char* WC; int G, c;
    __device__ __forceinline__ bool next(int i, GUnit& u) const { const int L = i * G + c; if (L >= 128) return false; const int g = L / 2, pn = L % 2;
        u.A = HP + (size_t)g * 256 * 256 * 2; u.B = WC + ((size_t)g * 512 + 256 * pn) * 256 * 2; u.i0 = g; u.i1 = pn; return true; } };
struct SchedRG { const char* XR; const char* RGW; int G, c;
    __device__ __forceinline__ bool next(int i, GUnit& u) const { const int L = i * G + c; if (L >= 512) return false; const int h = L % 16, pm = L / 16;
        u.A = XR + ((size_t)(256 * pm) * 1024 + 64 * h) * 2; u.B = RGW + (size_t)h * 256 * 256 * 2; u.i0 = pm; u.i1 = h; return true; } };

template <int ACT> __device__ __forceinline__ void epi_bf16_store(const AccT& acc, bf16_t* tile, int ldc, const float* biast, int wr, int wc, int fr, int fq) {
    const int r0 = wr * 64 + fr, c0 = wc * 32 + 8 * fq;
    f32x4 bv[2][2];
#pragma unroll
    for (int bj = 0; bj < 2; ++bj)
#pragma unroll
        for (int n = 0; n < 2; ++n) bv[bj][n] = biast ? *(const f32x4*)(biast + c0 + bj * 128 + 4 * n) : (f32x4){0.f, 0.f, 0.f, 0.f};
#pragma unroll
    for (int ai = 0; ai < 2; ++ai)
#pragma unroll
        for (int m = 0; m < 4; ++m) { bf16_t* rowp = tile + (size_t)(r0 + ai * 128 + m * 16) * ldc + c0;
#pragma unroll
            for (int bj = 0; bj < 2; ++bj) { f32x4 v0 = acc[ai][bj][m][0] + bv[bj][0], v1 = acc[ai][bj][m][1] + bv[bj][1];
                if (ACT == 1) {
#pragma unroll
                    for (int j = 0; j < 4; ++j) { const float a = fmaxf(v0[j], 0.f), b = fmaxf(v1[j], 0.f); v0[j] = a * a; v1[j] = b * b; } }
                if (ACT == 2) {
#pragma unroll
                    for (int j = 0; j < 4; ++j) { v0[j] = fast_sigmoid(v0[j]); v1[j] = fast_sigmoid(v1[j]); } }
                u32x4 w; w.x = cvt_pk_bf16(v0[0], v0[1]); w.y = cvt_pk_bf16(v0[2], v0[3]); w.z = cvt_pk_bf16(v1[0], v1[1]); w.w = cvt_pk_bf16(v1[2], v1[3]);
                *(u32x4*)(rowp + bj * 128) = w; } }
}
struct EpiProj { static constexpr bool PERM = true, AFTER_DRAIN = false; bf16_t *U, *XR, *Z; const float* bias;
    __device__ __forceinline__ void operator()(AccT& acc, const GUnit& u, int wr, int wc, int fr, int fq) const {
        const int pm = u.i0, pn = u.i1;
        if (pn >= 4) { bf16_t* base = pn < 8 ? XR + 2 * 1024 : Z; epi_bf16_store<0>(acc, base + (size_t)pm * 256 * 1024 + (pn & 3) * 256, 1024, bias + pn * 256, wr, wc, fr, fq); return; }
        const int c0 = pn * 256 + wc * 32 + 8 * fq;
#pragma unroll
        for (int bj = 0; bj < 2; ++bj) { const int col = c0 + bj * 128; const f32x4 b0 = *(const f32x4*)(bias + col), b1 = *(const f32x4*)(bias + col + 4); bf16_t* gp = U + (size_t)(col >> 4) * GM_STRIDE + (col & 15);
#pragma unroll
            for (int ai = 0; ai < 2; ++ai)
#pragma unroll
                for (int m = 0; m < 4; ++m) { const int row = pm * 256 + ai * 128 + wr * 64 + m * 16 + fr; const f32x4 v0 = acc[ai][bj][m][0] + b0, v1 = acc[ai][bj][m][1] + b1;
                    u32x4 w; w.x = cvt_pk_bf16(v0[0], v0[1]); w.y = cvt_pk_bf16(v0[2], v0[3]); w.z = cvt_pk_bf16(v1[0], v1[1]); w.w = cvt_pk_bf16(v1[2], v1[3]);
                    *(u32x4*)(gp + (size_t)row * 16) = w; } }
    } };
template <int ACT> struct EpiPlain { static constexpr bool PERM = true, AFTER_DRAIN = false; bf16_t* O; int ldc; const float* bias; size_t pstride;
    __device__ __forceinline__ void operator()(AccT& acc, const GUnit& u, int wr, int wc, int fr, int fq) const {
        epi_bf16_store<ACT>(acc, O + (size_t)u.i0 * (pstride ? pstride : (size_t)256 * ldc) + u.i1 * 256, ldc, bias ? bias + u.i1 * 256 : nullptr, wr, wc, fr, fq); } };
struct EpiS5a { static constexpr bool PERM = true, AFTER_DRAIN = false; bf16_t* YI; float* S;
    __device__ __forceinline__ void operator()(AccT& acc, const GUnit& u, int wr, int wc, int fr, int fq) const {
        const int g = u.i0, pn = u.i1;
#pragma unroll
        for (int ai = 0; ai < 2; ++ai)
#pragma unroll
            for (int m = 0; m < 4; ++m) { const int r = ai * 128 + wr * 64 + m * 16 + fr;
#pragma unroll
                for (int bj = 0; bj < 2; ++bj) { const int c8 = bj * 128 + wc * 32 + 8 * fq; const f32x4 v0 = acc[ai][bj][m][0], v1 = acc[ai][bj][m][1];
                    if (pn < 2) { const int col = pn * 256 + c8, t = col >> 4, k0 = col & 15;
                        u32x4 w; w.x = cvt_pk_bf16(v0[0], v0[1]); w.y = cvt_pk_bf16(v0[2], v0[3]); w.z = cvt_pk_bf16(v1[0], v1[1]); w.w = cvt_pk_bf16(v1[2], v1[3]);
                        *(u32x4*)(YI + (size_t)g * GM_STRIDE + (size_t)r * 512 + col) = w; (void)t; (void)k0; }
                    else { float* sp = S + ((size_t)g * NCH + r) * 256 + c8; *(f32x4*)sp = v0; *(f32x4*)(sp + 4) = v1; } } }
    } };
struct EpiS5b { static constexpr bool PERM = true, AFTER_DRAIN = false; const bf16_t* YI; bf16_t* YG;
    __device__ __forceinline__ void operator()(AccT& acc, const GUnit& u, int wr, int wc, int fr, int fq) const {
        const int g = u.i0, pn = u.i1;
#pragma unroll
        for (int ai = 0; ai < 2; ++ai)
#pragma unroll
            for (int m = 0; m < 4; ++m) { const int r = ai * 128 + wr * 64 + m * 16 + fr;
#pragma unroll
                for (int bj = 0; bj < 2; ++bj) { const int col = pn * 256 + bj * 128 + wc * 32 + 8 * fq, t = col >> 4, k0 = col & 15;
                    const size_t off = (size_t)g * GM_STRIDE + (size_t)r * 512 + col; (void)t; (void)k0; const u32x4 yi = *(const u32x4*)(YI + off);
                    f32x4 v0 = acc[ai][bj][m][0] + (f32x4){bf_lo(yi.x), bf_hi(yi.x), bf_lo(yi.y), bf_hi(yi.y)}, v1 = acc[ai][bj][m][1] + (f32x4){bf_lo(yi.z), bf_hi(yi.z), bf_lo(yi.w), bf_hi(yi.w)};
#pragma unroll
                    for (int j = 0; j < 4; ++j) { v0[j] = gelu_tanh(v0[j]); v1[j] = gelu_tanh(v1[j]); }
                    u32x4 w; w.x = cvt_pk_bf16(v0[0], v0[1]); w.y = cvt_pk_bf16(v0[2], v0[3]); w.z = cvt_pk_bf16(v1[0], v1[1]); w.w = cvt_pk_bf16(v1[2], v1[3]);
                    *(u32x4*)(YG + off) = w; } }
    } };
struct EpiGlu { static constexpr bool PERM = true, AFTER_DRAIN = false; const bf16_t* YG; bf16_t* YPRE; const float* bias;
    __device__ __forceinline__ void operator()(AccT& acc, const GUnit& u, int wr, int wc, int fr, int fq) const {
        const int pm = u.i0, pn = u.i1; const int c0 = pn * 256 + wc * 32 + 8 * fq;
        f32x4 bv[2][2];
#pragma unroll
        for (int bj = 0; bj < 2; ++bj)
#pragma unroll
            for (int n = 0; n < 2; ++n) bv[bj][n] = *(const f32x4*)(bias + c0 + bj * 128 + 4 * n);
#pragma unroll
        for (int ai = 0; ai < 2; ++ai)
#pragma unroll
            for (int m = 0; m < 4; ++m) { const int row = pm * 256 + ai * 128 + wr * 64 + m * 16 + fr;
#pragma unroll
                for (int bj = 0; bj < 2; ++bj) { const int col = c0 + bj * 128; const u32x4 yv = *(const u32x4*)(YG + (size_t)(col >> 4) * GM_STRIDE + (size_t)row * 16 + (col & 15));
                    const f32x4 y0 = (f32x4){bf_lo(yv.x), bf_hi(yv.x), bf_lo(yv.y), bf_hi(yv.y)}, y1 = (f32x4){bf_lo(yv.z), bf_hi(yv.z), bf_lo(yv.w), bf_hi(yv.w)};
                    f32x4 v0 = acc[ai][bj][m][0] + bv[bj][0], v1 = acc[ai][bj][m][1] + bv[bj][1];
#pragma unroll
                    for (int j = 0; j < 4; ++j) { v0[j] = y0[j] * fast_sigmoid(v0[j]); v1[j] = y1[j] * fast_sigmoid(v1[j]); }
                    u32x4 w; w.x = cvt_pk_bf16(v0[0], v0[1]); w.y = cvt_pk_bf16(v0[2], v0[3]); w.z = cvt_pk_bf16(v1[0], v1[1]); w.w = cvt_pk_bf16(v1[2], v1[3]);
                    *(u32x4*)(YPRE + (size_t)row * 2048 + col) = w; }
                }
    } };
template <bool PLEADD> struct EpiRes { static constexpr bool PERM = false, AFTER_DRAIN = false; const bf16_t* HBp; const float* bias; float* V; const bf16_t* SG; const bf16_t* PW;
    __device__ __forceinline__ void operator()(AccT& acc, const GUnit& u, int wr, int wc, int fr, int fq) const {
        const int pm = u.i0, pn = u.i1; const int c0 = pn * 256 + wc * 32 + 4 * fq;
        f32x4 bv[2][2];
#pragma unroll
        for (int bj = 0; bj < 2; ++bj)
#pragma unroll
            for (int n = 0; n < 2; ++n) bv[bj][n] = *(const f32x4*)(bias + c0 + bj * 128 + n * 16);
#pragma unroll
        for (int ai = 0; ai < 2; ++ai)
#pragma unroll
            for (int m = 0; m < 4; ++m) { const int row = pm * 256 + ai * 128 + wr * 64 + m * 16 + fr;
#pragma unroll
                for (int bj = 0; bj < 2; ++bj)
#pragma unroll
                    for (int n = 0; n < 2; ++n) { const size_t off = (size_t)row * 2048 + c0 + bj * 128 + n * 16;
                        f32x4 v = acc[ai][bj][m][n] + bv[bj][n] + DN_ALPHA * bf4(*(const u32x2*)(HBp + off));
                        if (PLEADD) v += bf4(*(const u32x2*)(SG + off)) * bf4(*(const u32x2*)(PW + off));
                        *(f32x4*)(V + off) = v; } }
    } };


struct PanelStats8 { unsigned long long* xbuf; unsigned* cnt; float eps;
    __device__ __forceinline__ void run(const AccT& v, int pm, int pn, int wr, int wc, int fr, int fq, LAS unsigned char* lds, int wid) const {
        LAS f32x2* P = (LAS f32x2*)lds; LAS f32x2* S = (LAS f32x2*)(lds + 8192); const int lane = fq * 16 + fr;
#pragma unroll
        for (int ai = 0; ai < 2; ++ai)
#pragma unroll
            for (int m = 0; m < 4; ++m) { float s = 0.f;
#pragma unroll
                for (int bj = 0; bj < 2; ++bj)
#pragma unroll
                    for (int n = 0; n < 2; ++n) { const f32x4 x = v[ai][bj][m][n]; s += (x[0] + x[1]) + (x[2] + x[3]); }
                s += __shfl_xor(s, 16); s += __shfl_xor(s, 32);
                const float mw = s * (1.0f / 64.0f); float q = 0.f;
#pragma unroll
                for (int bj = 0; bj < 2; ++bj)
#pragma unroll
                    for (int n = 0; n < 2; ++n) { const f32x4 d = v[ai][bj][m][n] - mw; q += (d[0] * d[0] + d[1] * d[1]) + (d[2] * d[2] + d[3] * d[3]); }
                q += __shfl_xor(q, 16); q += __shfl_xor(q, 32);
                if (fq == 0) P[(ai * 128 + wr * 64 + m * 16 + fr) * 4 + wc] = (f32x2){mw, q}; }
        asm volatile("s_waitcnt lgkmcnt(0)" ::: "memory"); __builtin_amdgcn_s_barrier(); asm volatile("" ::: "memory");
        const int row = wid * 32 + (lane & 31);
        if (lane < 32) { const f32x2 a = P[row * 4 + 0], b = P[row * 4 + 1], c = P[row * 4 + 2], d = P[row * 4 + 3];
            const float mt = (a[0] + b[0] + c[0] + d[0]) * 0.25f; const float da = a[0] - mt, db = b[0] - mt, dc = c[0] - mt, dd = d[0] - mt;
            const float m2 = (a[1] + b[1]) + (c[1] + d[1]) + 64.0f * ((da * da + db * db) + (dc * dc + dd * dd));
            __hip_atomic_store(xbuf + ((size_t)(pm * 256 + row) * 8 + pn), ((unsigned long long)__float_as_uint(m2) << 32) | __float_as_uint(mt), __ATOMIC_RELAXED, __HIP_MEMORY_SCOPE_AGENT); }
        asm volatile("s_waitcnt vmcnt(0)" ::: "memory");
        if (lane == 0) __hip_atomic_fetch_add(cnt + 64 * pm, 1u, __ATOMIC_RELAXED, __HIP_MEMORY_SCOPE_AGENT);
        if (wid == 0) { unsigned sp = 0;
            while ((unsigned)__builtin_amdgcn_readfirstlane(__hip_atomic_load(cnt + 64 * pm, __ATOMIC_RELAXED, __HIP_MEMORY_SCOPE_AGENT)) < 64u) { __builtin_amdgcn_s_sleep(2); if (++sp > (1u << 22)) break; }
            __builtin_amdgcn_fence(__ATOMIC_ACQUIRE, "agent"); }
        asm volatile("s_waitcnt vmcnt(0) lgkmcnt(0)" ::: "memory"); __builtin_amdgcn_s_barrier(); asm volatile("" ::: "memory");
        if (lane < 32) { const unsigned long long* slot = xbuf + (size_t)(pm * 256 + row) * 8; float mt[8], m2[8]; float ms = 0.f;
#pragma unroll
            for (int t = 0; t < 8; ++t) { const unsigned long long w = __hip_atomic_load(slot + t, __ATOMIC_RELAXED, __HIP_MEMORY_SCOPE_AGENT); mt[t] = __uint_as_float((unsigned)w); m2[t] = __uint_as_float((unsigned)(w >> 32)); ms += mt[t]; }
            const float mean = ms * 0.125f; float q = 0.f;
#pragma unroll
            for (int t = 0; t < 8; ++t) { const float dm = mt[t] - mean; q += m2[t] + 256.0f * dm * dm; }
            S[row] = (f32x2){mean, 1.0f / sqrtf(q * (1.0f / 2048.0f) + eps)}; }
        asm volatile("s_waitcnt lgkmcnt(0)" ::: "memory"); __builtin_amdgcn_s_barrier(); asm volatile("" ::: "memory");
    } };
struct EpiResLn1 { static constexpr bool PERM = false, AFTER_DRAIN = true; bf16_t* HBp; const float *bias, *lng, *lnb; PanelStats8 st;
    __device__ __forceinline__ void fused(AccT& acc, const GUnit& u, int wr, int wc, int fr, int fq, LAS unsigned char* lds, int wid) const {
        const int pm = u.i0, pn = u.i1; const int c0 = pn * 256 + wc * 32 + 4 * fq; const LAS f32x2* S = (const LAS f32x2*)(lds + 8192);
#pragma unroll
        for (int bj = 0; bj < 2; ++bj)
#pragma unroll
            for (int n = 0; n < 2; ++n) { const f32x4 bv = *(const f32x4*)(bias + c0 + bj * 128 + n * 16);
#pragma unroll
                for (int ai = 0; ai < 2; ++ai)
#pragma unroll
                    for (int m = 0; m < 4; ++m) { const size_t off = (size_t)(pm * 256 + ai * 128 + wr * 64 + m * 16 + fr) * 2048 + c0 + bj * 128 + n * 16;
                        acc[ai][bj][m][n] += bv + DN_ALPHA * bf4(*(const u32x2*)(HBp + off)); } }
        st.run(acc, pm, pn, wr, wc, fr, fq, lds, wid);
#pragma unroll
        for (int bj = 0; bj < 2; ++bj)
#pragma unroll
            for (int n = 0; n < 2; ++n) { const f32x4 gg = *(const f32x4*)(lng + c0 + bj * 128 + n * 16), bb = *(const f32x4*)(lnb + c0 + bj * 128 + n * 16);
#pragma unroll
                for (int ai = 0; ai < 2; ++ai)
#pragma unroll
                    for (int m = 0; m < 4; ++m) { const int r = ai * 128 + wr * 64 + m * 16 + fr; const f32x2 sr = S[r]; const size_t off = (size_t)(pm * 256 + r) * 2048 + c0 + bj * 128 + n * 16;
                        const f32x4 o = (acc[ai][bj][m][n] - sr[0]) * sr[1] * gg + bb; u32x2 w; w.x = cvt_pk_bf16(o[0], o[1]); w.y = cvt_pk_bf16(o[2], o[3]); *(u32x2*)(HBp + off) = w; } }
    } };
struct EpiResLn2 { static constexpr bool PERM = false, AFTER_DRAIN = true; const bf16_t* HBp; const float *bias, *lng, *lnb; float* out; const bf16_t* SGPW; PanelStats8 st;
    __device__ __forceinline__ void fused(AccT& acc, const GUnit& u, int wr, int wc, int fr, int fq, LAS unsigned char* lds, int wid) const {
        const int pm = u.i0, pn = u.i1; const int c0 = pn * 256 + wc * 32 + 4 * fq; const LAS f32x2* S = (const LAS f32x2*)(lds + 8192);
        const bf16_t* sgp = SGPW + (size_t)pm * (1u << 20);
        f32x4 bv[2][2];
#pragma unroll
        for (int bj = 0; bj < 2; ++bj)
#pragma unroll
            for (int n = 0; n < 2; ++n) bv[bj][n] = *(const f32x4*)(bias + c0 + bj * 128 + n * 16);
#pragma unroll
        for (int ai = 0; ai < 2; ++ai)
#pragma unroll
            for (int m = 0; m < 4; ++m) { const int r = ai * 128 + wr * 64 + m * 16 + fr; const size_t lo = (size_t)r * 2048 + c0; const bf16_t* hp = HBp + (size_t)(pm * 256 + r) * 2048 + c0;
#pragma unroll
                for (int bj = 0; bj < 2; ++bj)
#pragma unroll
                    for (int n = 0; n < 2; ++n) { const int co = bj * 128 + n * 16;
                        acc[ai][bj][m][n] += bv[bj][n] + DN_ALPHA * bf4(*(const u32x2*)(hp + co)) + bf4(*(const u32x2*)(sgp + lo + co)) * bf4(*(const u32x2*)(sgp + (1u << 19) + lo + co)); }
                asm volatile("" : "+v"(acc[ai][0][m][0]), "+v"(acc[ai][0][m][1]), "+v"(acc[ai][1][m][0]), "+v"(acc[ai][1][m][1])); }
        st.run(acc, pm, pn, wr, wc, fr, fq, lds, wid);
#pragma unroll
        for (int bj = 0; bj < 2; ++bj)
#pragma unroll
            for (int n = 0; n < 2; ++n) { const f32x4 gg = *(const f32x4*)(lng + c0 + bj * 128 + n * 16), bb = *(const f32x4*)(lnb + c0 + bj * 128 + n * 16);
#pragma unroll
                for (int ai = 0; ai < 2; ++ai)
#pragma unroll
                    for (int m = 0; m < 4; ++m) { const int r = ai * 128 + wr * 64 + m * 16 + fr; const f32x2 sr = S[r];
                        *(f32x4*)(out + (size_t)(pm * 256 + r) * 2048 + c0 + bj * 128 + n * 16) = (acc[ai][bj][m][n] - sr[0]) * sr[1] * gg + bb; } }
    } };
struct EpiG { static constexpr bool PERM = true, AFTER_DRAIN = false; bf16_t *G0, *G1; const float* bias;
    __device__ __forceinline__ void operator()(AccT& acc, const GUnit& u, int wr, int wc, int fr, int fq) const {
        const int pm = u.i0, h = u.i1; bf16_t* base = (pm < 16 ? G0 : G1) + (size_t)(pm & 15) * 256 * 4096 + h * 256;
        epi_bf16_store<0>(acc, base, 4096, bias + h * 256, wr, wc, fr, fq); } };
__device__ __forceinline__ float bfu(unsigned short v) { return __uint_as_float(((unsigned)v) << 16); }
__device__ __forceinline__ void rg_gate(float pa, float px, float spv, float xc, float& a, float& b) {
    const float r = fast_sigmoid(pa), ig = fast_sigmoid(px); const float la = spv * r; a = __expf(la); const float x = 2.0f * la;
    const float om = -x * (1.0f + x * (0.5f + x * (0.16666667f + x * (0.041666668f + x * 0.008333334f))));
    b = __builtin_amdgcn_sqrtf(fmaxf(om, 0.f)) * ig * xc; }
__device__ __forceinline__ void rg_gate2(float pa, float px, float spv, float xc, float& a, float& b, float& r) {
    r = fast_sigmoid(pa); const float ig = fast_sigmoid(px); const float la = spv * r; a = __expf(la); const float x = 2.0f * la;
    const float om = -x * (1.0f + x * (0.5f + x * (0.16666667f + x * (0.041666668f + x * 0.008333334f))));
    b = __builtin_amdgcn_sqrtf(fmaxf(om, 0.f)) * ig * xc; }
struct RgCtx { const bf16_t *XR, *G0, *G1, *Z; const float *convw, *convb, *sp; float* agg; bf16_t* ypre; };
__device__ __forceinline__ const bf16_t* g_row(const RgCtx& R, int t) { return (t < 4096 ? R.G0 : R.G1) + (size_t)(t & 4095) * 4096; }
__device__ __forceinline__ void rg_pass_a(const RgCtx& R, int half, int seg, int tid) {
    const int c = half * 512 + tid, gcol = (c >> 6) * 256 + (c & 63) * 4, t0 = seg * 64;
    const float w0 = R.convw[c], w1 = R.convw[1024 + c], w2 = R.convw[2048 + c], w3 = R.convw[3072 + c], cb = R.convb[c], sp0 = R.sp[c], sp1 = R.sp[1024 + c];
    const bf16_t* xp = R.XR + c;
    float x0 = bfu(xp[(size_t)(t0 + 0) * 1024]), x1 = bfu(xp[(size_t)(t0 + 1) * 1024]), x2 = bfu(xp[(size_t)(t0 + 2) * 1024]);
    float Af = 1.f, Bf = 0.f, Ab = 1.f, Bb = 0.f;
    for (int tb = 0; tb < 64; tb += 16) {
        u32x2 gq[16]; unsigned short xn[16];
#pragma unroll
        for (int i = 0; i < 16; ++i) { const int t = t0 + tb + i; gq[i] = *(const u32x2*)(g_row(R, t) + gcol); xn[i] = xp[(size_t)(t + 3) * 1024]; }
#pragma unroll
        for (int i = 0; i < 16; ++i) { const float x3 = bfu(xn[i]); const float xc = cb + w0 * x0 + w1 * x1 + w2 * x2 + w3 * x3; x0 = x1; x1 = x2; x2 = x3;
            float a, b, r0, r1, b0; rg_gate2(bf_lo(gq[i].x), bf_lo(gq[i].y), sp0, xc, a, b, r0); Bf = a * Bf + b; Af = a * Af; b0 = b;
            rg_gate2(bf_hi(gq[i].x), bf_hi(gq[i].y), sp1, xc, a, b, r1); Bb = Ab * b + Bb; Ab = Ab * a;
            u32x2 w; w.x = cvt_pk_bf16(r0, r1); w.y = cvt_pk_bf16(b0, b); *(u32x2*)((bf16_t*)g_row(R, t0 + tb + i) + gcol) = w; }
    }
    *(f32x2*)(R.agg + ((size_t)(seg * 2 + 0) * 1024 + c) * 2) = (f32x2){Af, Bf};
    *(f32x2*)(R.agg + ((size_t)(seg * 2 + 1) * 1024 + c) * 2) = (f32x2){Ab, Bb};
}
__device__ __forceinline__ void rg_pass_c(const RgCtx& R, int half, int seg, int tid, LAS float* Lh) {
    const int c = half * 512 + tid, gcol = (c >> 6) * 256 + (c & 63) * 4, t0 = seg * 64;
    const float sp0 = R.sp[c], sp1 = R.sp[1024 + c];
    const f32x2* ag = (const f32x2*)R.agg;
    float hf = 0.f, hb = 0.f;
    {
#pragma unroll 1
        for (int sb = 0; sb < 128; sb += 32) { f32x2 ab[32];
#pragma unroll
            for (int i = 0; i < 32; ++i) { const int s2 = sb + i; ab[i] = (s2 < seg) ? ag[(size_t)(s2 * 2 + 0) * 1024 + c] : (f32x2){1.f, 0.f}; }
#pragma unroll
            for (int i = 0; i < 32; ++i) hf = ab[i][0] * hf + ab[i][1]; }
#pragma unroll 1
        for (int sb = 96; sb >= 0; sb -= 32) { f32x2 ab[32];
#pragma unroll
            for (int i = 0; i < 32; ++i) { const int s2 = sb + 31 - i; ab[i] = (s2 > seg) ? ag[(size_t)(s2 * 2 + 1) * 1024 + c] : (f32x2){1.f, 0.f}; }
#pragma unroll
            for (int i = 0; i < 32; ++i) hb = ab[i][0] * hb + ab[i][1]; }
    }
    {
        for (int tb = 0; tb < 64; tb += 16) {
            u32x2 gq[16];
#pragma unroll
            for (int i = 0; i < 16; ++i) gq[i] = *(const u32x2*)(g_row(R, t0 + tb + i) + gcol);
#pragma unroll
            for (int i = 0; i < 16; ++i) { const float a = __expf(sp0 * bf_lo(gq[i].x)); hf = a * hf + bf_lo(gq[i].y); Lh[(tb + i) * 512 + tid] = hf; }
        }
    }
    {
        for (int tb = 48; tb >= 0; tb -= 16) {
            u32x2 gq[16]; unsigned short zz[16];
#pragma unroll
            for (int i = 0; i < 16; ++i) { const int t = t0 + tb + 15 - i; gq[i] = *(const u32x2*)(g_row(R, t) + gcol); zz[i] = R.Z[(size_t)t * 1024 + c]; }
#pragma unroll
            for (int i = 0; i < 16; ++i) { const int tl = tb + 15 - i; const float a = __expf(sp1 * bf_hi(gq[i].x)); hb = a * hb + bf_hi(gq[i].y);
                const float o = (Lh[tl * 512 + tid] + hb) * gelu_tanh(bfu(zz[i]));
                R.ypre[(size_t)(t0 + tl) * 2048 + 1024 + c] = (bf16_t)(cvt_pk_bf16(o, 0.f) & 0xffffu); }
        }
    }
}

#ifndef NAIVE_GEMM
#define NAIVE_GEMM 0
#endif
template <class Epi, class Sched>
__device__ __forceinline__ void gemm_phase_naive(LAS unsigned char* lds, const int wid, const GParm gp, const Sched& S, const Epi& E) {
    const int lane = fresh_lane(), tid = wid * 64 + lane, wr = wid >> 2, wc = wid & 3, fr = lane & 15, fq = lane >> 4;
    GUnit cur;
    for (int ui = 0; S.next(ui, cur); ++ui) {
        f32x4 acc[2][2][4][2];
#pragma unroll
        for (int ai = 0; ai < 2; ++ai)
#pragma unroll
            for (int bj = 0; bj < 2; ++bj)
#pragma unroll
                for (int m = 0; m < 4; ++m)
#pragma unroll
                    for (int n = 0; n < 2; ++n)
#pragma unroll
                        for (int e = 0; e < 4; ++e) {
                            const int row = 128 * ai + 64 * wr + 16 * m + fr; const int col = Epi::PERM ? (128 * bj + 32 * wc + 8 * fq + 4 * n + e) : (128 * bj + 32 * wc + 16 * n + 4 * fq + e);
                            const char* ap = cur.A + (size_t)row * gp.a_rs; const char* bp = cur.B + (size_t)col * gp.K * 2; float sum = 0.f;
                            for (int k = 0; k < gp.K; k += 8) { const int kt = k >> 6, C = k & 63;
                                const u32x4 av = *(const u32x4*)(ap + (size_t)kt * gp.a_ks + ((C / gp.a_cw) * gp.a_cs + (C % gp.a_cw)) * 2), bv = *(const u32x4*)(bp + k * 2);
                                sum += bf_lo(av.x) * bf_lo(bv.x) + bf_hi(av.x) * bf_hi(bv.x) + bf_lo(av.y) * bf_lo(bv.y) + bf_hi(av.y) * bf_hi(bv.y) + bf_lo(av.z) * bf_lo(bv.z) + bf_hi(av.z) * bf_hi(bv.z) + bf_lo(av.w) * bf_lo(bv.w) + bf_hi(av.w) * bf_hi(bv.w); }
                            acc[ai][bj][m][n][e] = sum; }
        if constexpr (Epi::AFTER_DRAIN) { __syncthreads(); E.fused(acc, cur, wr, wc, fr, fq, lds, wid); } else E(acc, cur, wr, wc, fr, fq);
    }
    __syncthreads();
}
#if NAIVE_GEMM
#define GEMM_PHASE gemm_phase_naive
#else
#define GEMM_PHASE pg8::gemm_phase
#endif
__device__ __forceinline__ void transpose_item(const float* W, int K, int N, bf16_t* WT, LAS float* scr, int item, int lane) {
    const int nblk = N / 64, kb = item / nblk, nb = item % nblk, k0 = 64 * kb, n0 = 64 * nb;
    const float* src = W + (size_t)k0 * N + n0 + lane;
#pragma unroll 32
    for (int i = 0; i < 64; ++i) scr[i * 65 + lane] = src[(size_t)i * N];
    LDS_WAIT();
    const int c = lane & 7;
#pragma unroll
    for (int j = 0; j < 8; ++j) { const int n = (lane >> 3) + 8 * j; const LAS float* sp = scr + (8 * c) * 65 + n;
        u32x4 o; o.x = cvt_pk_bf16(sp[0 * 65], sp[1 * 65]); o.y = cvt_pk_bf16(sp[2 * 65], sp[3 * 65]); o.z = cvt_pk_bf16(sp[4 * 65], sp[5 * 65]); o.w = cvt_pk_bf16(sp[6 * 65], sp[7 * 65]);
        *(u32x4*)(WT + (size_t)(n0 + n) * K + k0 + 8 * c) = o; }
    LDS_WAIT();
}
template <bool OUT_BF16> __device__ __forceinline__ void ln_row(const float* xrow, const float* g, const float* b, void* orow, int lane) {
    const f32x4* xr = (const f32x4*)xrow + lane; f32x4 v[8]; float s = 0.f;
#pragma unroll
    for (int j = 0; j < 8; ++j) { v[j] = xr[64 * j]; s += (v[j][0] + v[j][1]) + (v[j][2] + v[j][3]); }
    const float mean = wave_sum(s) * (1.f / DM); float s2 = 0.f;
#pragma unroll
    for (int j = 0; j < 8; ++j) { v[j] = v[j] - mean; s2 += (v[j][0] * v[j][0] + v[j][1] * v[j][1]) + (v[j][2] * v[j][2] + v[j][3] * v[j][3]); }
    const float rstd = 1.0f / sqrtf(wave_sum(s2) * (1.f / DM) + LN_EPS);
#pragma unroll
    for (int j = 0; j < 8; ++j) { const f32x4 gg = ((const f32x4*)g)[lane + 64 * j], bb = ((const f32x4*)b)[lane + 64 * j]; const f32x4 o = v[j] * rstd * gg + bb;
        if (OUT_BF16) { u32x2 w; w.x = cvt_pk_bf16(o[0], o[1]); w.y = cvt_pk_bf16(o[2], o[3]); ((u32x2*)orow)[lane + 64 * j] = w; }
        else ((f32x4*)orow)[lane + 64 * j] = o; }
}
__device__ __forceinline__ void cpow(float lrs, float th, int j, float& re, float& im) {
    double a = (double)j * (double)th * 0.15915494309189535; a -= rint(a); const float af = 2.0f * (float)a;
    const float mag = expf((float)j * lrs); re = mag * cospif(af); im = mag * sinpif(af);
}


#ifndef NAIVE_RG
#define NAIVE_RG 0
#endif
__device__ __forceinline__ void naive_rg_channel(const RgCtx& R, int c) {
    const int gcol = (c >> 6) * 256 + (c & 63);
    const float w0 = R.convw[c], w1 = R.convw[1024 + c], w2 = R.convw[2048 + c], w3 = R.convw[3072 + c], cb = R.convb[c], sp0 = R.sp[c], sp1 = R.sp[1024 + c];
    const bf16_t* xp = R.XR + c; float h = 0.f;
    for (int t = 0; t < SEQ; ++t) { const float xc = cb + w0 * bfu(xp[(size_t)t * 1024]) + w1 * bfu(xp[(size_t)(t + 1) * 1024]) + w2 * bfu(xp[(size_t)(t + 2) * 1024]) + w3 * bfu(xp[(size_t)(t + 3) * 1024]);
        const bf16_t* g = g_row(R, t) + gcol; float a, b; rg_gate(bfu(g[0]), bfu(g[128]), sp0, xc, a, b); h = a * h + b;
        R.ypre[(size_t)t * 2048 + 1024 + c] = (bf16_t)(cvt_pk_bf16(h, 0.f) & 0xffffu); }
    __builtin_amdgcn_fence(__ATOMIC_SEQ_CST, "agent");
    h = 0.f;
    for (int t = SEQ - 1; t >= 0; --t) { const float xc = cb + w0 * bfu(xp[(size_t)t * 1024]) + w1 * bfu(xp[(size_t)(t + 1) * 1024]) + w2 * bfu(xp[(size_t)(t + 2) * 1024]) + w3 * bfu(xp[(size_t)(t + 3) * 1024]);
        const bf16_t* g = g_row(R, t) + gcol; float a, b; rg_gate(bfu(g[64]), bfu(g[192]), sp1, xc, a, b); h = a * h + b;
        const size_t o = (size_t)t * 2048 + 1024 + c; const float y = (bfu(R.ypre[o]) + h) * gelu_tanh(bfu(R.Z[(size_t)t * 1024 + c]));
        R.ypre[o] = (bf16_t)(cvt_pk_bf16(y, 0.f) & 0xffffu); }
}

#ifndef NAIVE_S5
#define NAIVE_S5 0
#endif
__device__ __forceinline__ void naive_s5_group(const float* const* in, const bf16_t* U, float* tmp, bf16_t* YG, int g, int lane) {
    const float *lre = in[6], *lim = in[7], *lstep = in[8], *bre = in[9], *bim = in[10], *cre = in[11], *cim = in[12], *dd = in[13];
    for (int n = 0; n < 2; ++n) {
        const int p = lane, pi = (n * 64 + g) * 64 + p;
        const float lr = fminf(lre[pi], -1e-4f), li = lim[pi], step = expf(lstep[n * 64 + g]); float ar, ai; cpow(lr * step, li * step, 1, ar, ai);
        const float nr = ar - 1.0f, ni = ai, den = lr * lr + li * li; const float qr = (nr * lr + ni * li) / den, qi = (ni * lr - nr * li) / den;
        float hr = 0.f, hi = 0.f;
        for (int tt = 0; tt < SEQ; ++tt) { const int t = n == 0 ? tt : SEQ - 1 - tt; const bf16_t* up = U + (size_t)t * 1024 + g * 16;
            float bur = 0.f, bui = 0.f;
#pragma unroll
            for (int k = 0; k < 16; ++k) { const float uv = bfu(up[k]); const float br = bre[(size_t)pi * 16 + k], bi = bim[(size_t)pi * 16 + k]; bur += (qr * br - qi * bi) * uv; bui += (qr * bi + qi * br) * uv; }
            const float nhr = ar * hr - ai * hi + bur, nhi = ar * hi + ai * hr + bui; hr = nhr; hi = nhi;
#pragma unroll
            for (int k = 0; k < 16; ++k) { const size_t ci = ((size_t)(n * 64 + g) * 16 + k) * 64 + p; float v = cre[ci] * hr - cim[ci] * hi; v = wave_sum(v);
                if (lane == k) { const size_t o = (size_t)t * 1024 + g * 16 + k;
                    if (n == 0) tmp[o] = v; else { const float y = tmp[o] + v + dd[g * 16 + k] * bfu(up[k]); YG[o] = (bf16_t)(cvt_pk_bf16(gelu_tanh(y), 0.f) & 0xffffu); } } }
        }
        __builtin_amdgcn_fence(__ATOMIC_SEQ_CST, "agent");
    }
}

#define XB_TMO      128
#define XB_XCNT(j)  (256  + 64 * (j))
#define XB_XSUB(j)  (1280 + 64 * (j))
#define XB_XGEN(j)  (2304 + 64 * (j))
#define XB_TOP      3328
#define XB_TOPGEN   3392
#define XCD_BAR_WORDS 3456
#define XB_SPIN_CAP (1u << 18)
__device__ __forceinline__ unsigned xb_ld(unsigned* p)              { return __hip_atomic_load(p, __ATOMIC_RELAXED, __HIP_MEMORY_SCOPE_AGENT); }
__device__ __forceinline__ unsigned xb_add(unsigned* p, unsigned v) { return __hip_atomic_fetch_add(p, v, __ATOMIC_RELAXED, __HIP_MEMORY_SCOPE_AGENT); }
__device__ __forceinline__ unsigned xb_xcc_id() { return (unsigned)__builtin_amdgcn_s_getreg((3 << 11) | 20) & 0xFu; }
#define XB_SPIN(cond, bar) do { unsigned _sp = 0; while (cond) { __builtin_amdgcn_s_sleep(1); \
    if ((++_sp & 255u) == 0u) { if (xb_ld(&(bar)[XB_TMO])) break; if (_sp > XB_SPIN_CAP) { atomicAdd(&(bar)[XB_TMO], 1u); break; } } } } while (0)
struct XcdBarrier { unsigned* bar; unsigned x; volatile LAS unsigned* st; };
__device__ __forceinline__ void xcd_barrier_complete(unsigned* bar, unsigned x, unsigned G, unsigned& nloc, unsigned& nx) {
    unsigned sum, cnt, mine, sp = 0u;
    for (;;) {
        sum = 0u; cnt = 0u; mine = 0u;
#pragma unroll
        for (unsigned j = 0; j < 16; ++j) { const unsigned c = xb_ld(&bar[XB_XCNT(j)]); sum += c; cnt += (c > 0u) ? 1u : 0u; mine = (j == x) ? c : mine; }
        if (sum == G) break;
        __builtin_amdgcn_s_sleep(1);
        if ((++sp & 255u) == 0u) { if (xb_ld(&bar[XB_TMO])) break; if (sp > XB_SPIN_CAP) { atomicAdd(&bar[XB_TMO], 1u); break; } }
    }
    nloc = mine > 0u ? mine : 1u; nx = cnt > 0u ? cnt : 1u;
}
__device__ __forceinline__ void xcd_barrier(const XcdBarrier& b, unsigned G, int wave) {
    asm volatile("s_waitcnt vmcnt(0)" ::: "memory");
    __syncthreads();
    if (wave == 0) { if (fresh_lane() == 0) {
        unsigned* bar = b.bar;
        __builtin_amdgcn_s_waitcnt(0);
        unsigned nloc = b.st[0], nx = b.st[1];
        if (nloc == 0u) { xcd_barrier_complete(bar, b.x, G, nloc, nx); b.st[0] = nloc; b.st[1] = nx; }
        const unsigned old = xb_add(&bar[XB_XSUB(b.x)], 1u);
        const unsigned gen = old / nloc;
        if (old + 1u == (gen + 1u) * nloc) {
            __builtin_amdgcn_fence(__ATOMIC_RELEASE, "agent");
            asm volatile("s_waitcnt vmcnt(0)" ::: "memory");
            const unsigned og = xb_add(&bar[XB_TOP], 1u);
            const unsigned tg = og / nx;
            if (og + 1u == (tg + 1u) * nx) xb_add(&bar[XB_TOPGEN], 1u);
            else XB_SPIN(xb_ld(&bar[XB_TOPGEN]) == tg, bar);
            __builtin_amdgcn_fence(__ATOMIC_ACQUIRE, "agent");
            xb_add(&bar[XB_XGEN(b.x)], 1u);
            asm volatile("s_waitcnt vmcnt(0)" ::: "memory");
        } else {
            XB_SPIN(xb_ld(&bar[XB_XGEN(b.x)]) == gen, bar);
            __builtin_amdgcn_fence(__ATOMIC_ACQUIRE, "agent");
            asm volatile("s_waitcnt vmcnt(0)" ::: "memory");
        }
    } }
    __syncthreads();
}

__device__ __forceinline__ void grid_barrier(unsigned* bar, unsigned target, int wave) {
    asm volatile("s_waitcnt vmcnt(0)" ::: "memory");
    __syncthreads();
    if (wave == 0) { const int l = fresh_lane();
        if (l == 0) {
            __builtin_amdgcn_fence(__ATOMIC_RELEASE, "agent"); asm volatile("s_waitcnt vmcnt(0)" ::: "memory");
            __hip_atomic_fetch_add(bar, 1u, __ATOMIC_RELAXED, __HIP_MEMORY_SCOPE_AGENT);
            while (__hip_atomic_load(bar, __ATOMIC_RELAXED, __HIP_MEMORY_SCOPE_AGENT) < target) __builtin_amdgcn_s_sleep(2);
            __builtin_amdgcn_fence(__ATOMIC_ACQUIRE, "agent"); asm volatile("s_waitcnt vmcnt(0)" ::: "memory");
        } }
    __syncthreads();
}

struct Args { const float* in[38]; float* out; unsigned char* ws; int ph_lo, ph_hi; };
typedef const float* cfp_t;
typedef const __attribute__((address_space(4))) cfp_t* kin_t;

__device__ __forceinline__ void s5_precompute(const kin_t ain, unsigned char* aws, int g, int hq, int nh, LAS float* L, const int tid) {
    const float *lre = ain[6], *lim = ain[7], *lstep = ain[8], *bre = ain[9], *bim = ain[10], *cre = ain[11], *cim = ain[12], *dd = ain[13];
    LAS float *PWre = L, *PWim = L + 4224, *BBre = L + 8448, *BBim = L + 10496, *CCre = L + 12544, *CCim = L + 14592, *MT = L + 16640, *C2re = L + 33280, *C2im = L + 35328, *Dl = L + 37376;
    bf16_t* WGg = (bf16_t*)(aws + WS_WG) + (size_t)g * 768 * 512; bf16_t* WCg = (bf16_t*)(aws + WS_WC) + (size_t)g * 512 * 256;
#define PSTAMP(i) do { if (TSTAMP && blockIdx.x == 128 && tid == 0) ((unsigned long long*)(aws + WS_CTR + 1024))[i] = __builtin_amdgcn_s_memrealtime(); } while (0)
    PSTAMP(20);
    {
        const int np = tid & 127, jj = tid >> 7, n = np >> 6, p = np & 63; const int pi = (n * 64 + g) * 64 + p;
        const float lr = fminf(lre[pi], -1e-4f), li = lim[pi], step = expf(lstep[n * 64 + g]); const float lrs = lr * step, th = li * step;
        for (int j = jj; j <= 32; j += 4) { float r, i; cpow(lrs, th, j, r, i); PWre[np * 33 + j] = r; PWim[np * 33 + j] = i; }
        float l1r, l1i; cpow(lrs, th, 1, l1r, l1i);
        const float nr = l1r - 1.0f, ni = l1i, den = lr * lr + li * li; const float qr = (nr * lr + ni * li) / den, qi = (ni * lr - nr * li) / den;
#pragma unroll
        for (int k = jj * 4; k < jj * 4 + 4; ++k) { const float br = bre[(size_t)pi * 16 + k], bi = bim[(size_t)pi * 16 + k]; BBre[np * 16 + k] = qr * br - qi * bi; BBim[np * 16 + k] = qr * bi + qi * br; }
        for (int e = tid; e < 2048; e += 512) { const int n2 = e >> 10, k = (e >> 6) & 15, p2 = e & 63; const size_t ci = ((size_t)(n2 * 64 + g) * 16 + k) * 64 + p2; CCre[(n2 * 64 + p2) * 16 + k] = cre[ci]; CCim[(n2 * 64 + p2) * 16 + k] = cim[ci]; C2re[e] = cre[ci]; C2im[e] = cim[ci]; }
        if (tid < 16) Dl[tid] = dd[g * 16 + tid];
    }
    __syncthreads();
    PSTAMP(21);
    for (int i = 0; i < 3; ++i) {
        if (nh == 2) { if (i < 2 && i != hq) continue; if (i == 2 && (hq != 0 || tid >= 16)) continue; } else if (i == 2) continue;
        const int bq = (i == 2) ? 512 + tid : tid + 512 * i, n = bq >> 9, j = (bq >> 4) & 31, kob = (bq >> 2) & 3, kib = bq & 3;
        f32x4 m0 = {0.f, 0.f, 0.f, 0.f}, m1 = m0, m2 = m0, m3 = m0;
        for (int p = 0; p < 64; ++p) { const int np = n * 64 + p; const float pr = PWre[np * 33 + j], pi2 = PWim[np * 33 + j];
            const f32x4 br = *(const LAS f32x4*)(BBre + np * 16 + 4 * kib), bi = *(const LAS f32x4*)(BBim + np * 16 + 4 * kib), cr = *(const LAS f32x4*)(CCre + np * 16 + 4 * kob), ci = *(const LAS f32x4*)(CCim + np * 16 + 4 * kob);
            const f32x4 er = pr * br - pi2 * bi, ei = pr * bi + pi2 * br;
            m0 += cr[0] * er - ci[0] * ei; m1 += cr[1] * er - ci[1] * ei; m2 += cr[2] * er - ci[2] * ei; m3 += cr[3] * er - ci[3] * ei; }
        LAS float* o = MT + (n * 32 + j) * 260 + (4 * kob) * 16 + 4 * kib;
        *(LAS f32x4*)o = m0; *(LAS f32x4*)(o + 16) = m1; *(LAS f32x4*)(o + 32) = m2; *(LAS f32x4*)(o + 48) = m3;
    }
    __syncthreads();
    PSTAMP(22);
    for (int i = 0; i < 64; ++i) {
        const int idx = tid + 512 * i, row = idx >> 6, cp = idx & 63, t = row >> 4, ko = row & 15, s = cp >> 1, ki0 = (cp & 1) * 8;
        if (nh == 2 && ((t >= s) != (hq == 0))) continue;
        f32x4 v0, v1;
        if (t != s) { const LAS float* src = MT + ((t > s ? 0 : 1) * 32 + (t > s ? t - s : s - t)) * 260 + ko * 16 + ki0; v0 = *(const LAS f32x4*)src; v1 = *(const LAS f32x4*)(src + 4); }
        else { const LAS float* s0 = MT + ko * 16 + ki0; const LAS float* s1 = MT + 32 * 260 + ko * 16 + ki0; v0 = *(const LAS f32x4*)s0 + *(const LAS f32x4*)s1; v1 = *(const LAS f32x4*)(s0 + 4) + *(const LAS f32x4*)(s1 + 4);
            const float dv = Dl[ko];
#pragma unroll
            for (int e = 0; e < 4; ++e) { if (ki0 + e == ko) v0[e] += dv; if (ki0 + 4 + e == ko) v1[e] += dv; } }
        u32x4 w; w.x = cvt_pk_bf16(v0[0], v0[1]); w.y = cvt_pk_bf16(v0[2], v0[3]); w.z = cvt_pk_bf16(v1[0], v1[1]); w.w = cvt_pk_bf16(v1[2], v1[3]);
        *(u32x4*)(WGg + (size_t)row * 512 + cp * 8) = w;
    }
    for (int i = hq * (32 / nh); i < (hq + 1) * (32 / nh); ++i) {
        const int idx = tid + 512 * i, q = idx >> 6, cp = idx & 63, n = q >> 7, ri = (q >> 6) & 1, p = q & 63, s = cp >> 1, ki0 = (cp & 1) * 8, e = n == 0 ? 31 - s : s, np = n * 64 + p;
        const float pr = PWre[np * 33 + e], pi2 = PWim[np * 33 + e]; float v[8];
#pragma unroll
        for (int k = 0; k < 8; ++k) { const float br = BBre[np * 16 + ki0 + k], bi = BBim[np * 16 + ki0 + k]; v[k] = ri == 0 ? pr * br - pi2 * bi : pr * bi + pi2 * br; }
        u32x4 w; w.x = cvt_pk_bf16(v[0], v[1]); w.y = cvt_pk_bf16(v[2], v[3]); w.z = cvt_pk_bf16(v[4], v[5]); w.w = cvt_pk_bf16(v[6], v[7]);
        *(u32x4*)(WGg + (size_t)(512 + q) * 512 + cp * 8) = w;
    }
    for (int i = 0; i < 32 / nh; ++i) {
        const int idx = tid + 512 * i, row = nh == 2 ? idx >> 4 : idx >> 5, q0 = nh == 2 ? hq * 128 + (idx & 15) * 8 : (idx & 31) * 8, n = q0 >> 7, ri = (q0 >> 6) & 1, p0 = q0 & 63, t = row >> 4, ko = row & 15, e = n == 0 ? t + 1 : 32 - t; float v[8];
#pragma unroll
        for (int k = 0; k < 8; ++k) { const int np = n * 64 + p0 + k; const float cr = C2re[(n * 16 + ko) * 64 + p0 + k], ci = C2im[(n * 16 + ko) * 64 + p0 + k], pr = PWre[np * 33 + e], pi2 = PWim[np * 33 + e];
            v[k] = ri == 0 ? cr * pr - ci * pi2 : -(cr * pi2 + ci * pr); }
        u32x4 w; w.x = cvt_pk_bf16(v[0], v[1]); w.y = cvt_pk_bf16(v[2], v[3]); w.z = cvt_pk_bf16(v[4], v[5]); w.w = cvt_pk_bf16(v[6], v[7]);
        *(u32x4*)(WCg + (size_t)row * 256 + q0) = w;
    }
    __syncthreads();
    PSTAMP(23);
}


#ifndef DIAG
#define DIAG 0
#endif
__device__ __forceinline__ void diag_ffn(const float* const* in, const unsigned char* ws, const float* outp, unsigned* flagw, int gtid, int GT) {
    const bf16_t* h1 = (const bf16_t*)(ws + WS_HB); const bf16_t* T = (const bf16_t*)(ws + WS_T); const float* V2 = (const float*)(ws + WS_V2);
    const float *w1 = in[29], *b1 = in[30], *w2 = in[31], *b2 = in[32], *wp = in[33], *wg = in[34], *bg = in[35], *pp = in[1];
    for (int sidx = gtid; sidx < 16384; sidx += GT) {
        unsigned hsh = (unsigned)sidx * 2654435761u, h2 = ((unsigned)sidx + 977u) * 2246822519u; const int r = (hsh >> 8) % SEQ; const int c = (h2 >> 6) % DFF; const int c2 = c % DM;
        float a = b1[c]; for (int k = 0; k < DM; ++k) a += bfu(h1[(size_t)r * DM + k]) * w1[(size_t)k * DFF + c];
        a = fmaxf(a, 0.f); a = a * a; const float tv = bfu(T[(size_t)r * DFF + c]);
        if (fabsf(tv - a) > 0.008f * fabsf(a) + 0.006f) atomicAdd(flagw + 0, 1u);
        float f = b2[c2]; for (int k = 0; k < DFF; ++k) f += bfu(T[(size_t)r * DFF + k]) * w2[(size_t)k * DM + c2];
        float gt = bg[c2]; for (int k = 0; k < DM; ++k) gt += bfu(h1[(size_t)r * DM + k]) * wg[(size_t)k * DM + c2];
        float pw = 0.f; for (int k = 0; k < PLE; ++k) pw += pp[(size_t)r * PLE + k] * wp[(size_t)k * DM + c2];
        const float v2 = DN_ALPHA * bfu(h1[(size_t)r * DM + c2]) + f + fast_sigmoid(gt) * pw; const float got = V2[(size_t)r * DM + c2];
        if (fabsf(got - v2) > 0.008f * fabsf(v2) + 0.006f) atomicAdd(flagw + 1, 1u);
        { const float* vr = V2 + (size_t)r * DM; float m = 0.f; for (int k = 0; k < DM; ++k) m += vr[k]; m /= DM; float v = 0.f; for (int k = 0; k < DM; ++k) { const float d = vr[k] - m; v += d * d; } v /= DM;
          const float e = (vr[c2] - m) / sqrtf(v + LN_EPS) * in[36][c2] + in[37][c2]; const float go = outp[(size_t)r * DM + c2]; if (fabsf(go - e) > 0.004f * fabsf(e) + 0.003f) atomicAdd(flagw + 2, 1u); }
    }
}

__device__ __forceinline__ void diag_pre(const float* const* in, const unsigned char* ws, const unsigned char* dout, unsigned* flagw, int gtid, int GT) {
    const bf16_t* h0 = (const bf16_t*)(ws + WS_HB); const bf16_t* U = (const bf16_t*)(dout + DO_U); const bf16_t* XRb = (const bf16_t*)(ws + WS_XR) + 2048; const bf16_t* Z = (const bf16_t*)(dout + DO_Z);
    const bf16_t* ypre = (const bf16_t*)(dout + DO_YPRE); const bf16_t* ycat = (const bf16_t*)(ws + WS_YCAT); const bf16_t* yg = (const bf16_t*)(ws + WS_YS5G);
    const float *x = in[0], *lg = in[2], *lb = in[3], *win = in[4], *bin = in[5], *gw_ = in[14], *gb = in[15], *g5 = in[23], *gr = in[24];
    for (int sidx = gtid; sidx < 8192; sidx += GT) {
        unsigned hsh = (unsigned)sidx * 2654435761u, h2 = ((unsigned)sidx + 977u) * 2246822519u; const int r = (hsh >> 8) % SEQ; const int c = (h2 >> 6) % DIN; const int c2 = c % DM; const int c1 = c % DS5;
        { float m = 0.f; for (int k = 0; k < DM; ++k) m += x[(size_t)r * DM + k]; m /= DM; float v = 0.f; for (int k = 0; k < DM; ++k) { const float d = x[(size_t)r * DM + k] - m; v += d * d; } v /= DM;
          const float e = (x[(size_t)r * DM + c2] - m) / sqrtf(v + LN_EPS) * lg[c2] + lb[c2]; const float got = bfu(h0[(size_t)r * DM + c2]); if (fabsf(got - e) > 0.008f * fabsf(e) + 0.006f) atomicAdd(flagw + 0, 1u); }
        { float a = bin[c]; for (int k = 0; k < DM; ++k) a += bfu(h0[(size_t)r * DM + k]) * win[(size_t)k * DIN + c];
          const float got = c < 1024 ? bfu(U[(size_t)r * 1024 + c]) : (c < 2048 ? bfu(XRb[(size_t)r * 1024 + c - 1024]) : bfu(Z[(size_t)r * 1024 + c - 2048])); if (fabsf(got - a) > 0.008f * fabsf(a) + 0.006f) atomicAdd(flagw + 3, 1u); }
        { const int hf = c2 >> 10; float ss = 0.f; for (int k = 0; k < 1024; ++k) { const float y = bfu(ypre[(size_t)r * DM + hf * 1024 + k]); ss += y * y; }
          const float e = bfu(ypre[(size_t)r * DM + c2]) / sqrtf(ss / 1024.f + LN_EPS) * (hf ? gr[c2 - 1024] : g5[c2]); const float got = bfu(ycat[(size_t)r * DM + c2]); if (fabsf(got - e) > 0.008f * fabsf(e) + 0.006f) atomicAdd(flagw + 1, 1u); }
        { float a = gb[c1]; for (int k = 0; k < DS5; ++k) a += bfu(yg[(size_t)r * DS5 + k]) * gw_[(size_t)k * DS5 + c1];
          const float e = bfu(yg[(size_t)r * DS5 + c1]) * fast_sigmoid(a); const float got = bfu(ypre[(size_t)r * DM + c1]); if (fabsf(got - e) > 0.008f * fabsf(e) + 0.006f) atomicAdd(flagw + 2, 1u); }
    }
}

__device__ __forceinline__ void diag_v(const float* const* in, const unsigned char* ws, const unsigned char* dout, unsigned* flagw, int gtid, int GT) {
    const bf16_t* h0 = (const bf16_t*)(ws + WS_HB); const bf16_t* ycat = (const bf16_t*)(ws + WS_YCAT); const float* V = (const float*)dout; const float *wo = in[25], *bo = in[26];
    for (int sidx = gtid; sidx < 16384; sidx += GT) { unsigned hsh = (unsigned)sidx * 2654435761u, h2 = ((unsigned)sidx + 977u) * 2246822519u; const int r = (hsh >> 8) % SEQ; const int c = (h2 >> 6) % DM;
        float a = bo[c] + DN_ALPHA * bfu(h0[(size_t)r * DM + c]); for (int k = 0; k < DM; ++k) a += bfu(ycat[(size_t)r * DM + k]) * wo[(size_t)k * DM + c];
        const float got = V[(size_t)r * DM + c]; if (fabsf(got - a) > 0.008f * fabsf(a) + 0.006f) atomicAdd(flagw + 0, 1u); }
}

__device__ __forceinline__ void diag_g(const float* const* in, const unsigned char* ws, unsigned* flagw, int gtid, int GT) {
    const bf16_t* XRp = (const bf16_t*)(ws + WS_XR); const bf16_t* G0 = (const bf16_t*)(ws + WS_G0); const bf16_t* G1 = (const bf16_t*)(ws + WS_G1);
    const float *convw = in[16], *convb = in[17], *wa = in[18], *ba = in[19], *wx = in[20], *bxx = in[21];
    for (int sidx = gtid; sidx < 16384; sidx += GT) { unsigned hsh = (unsigned)sidx * 2654435761u; unsigned h2 = ((unsigned)sidx + 12345u) * 2246822519u; const int t = (hsh >> 7) % SEQ; const int col = (h2 >> 5) % 4096;
        const int h = col >> 8, row = col & 255, bj = row >> 7, dir = (row >> 6) & 1, ch = row & 63;
        const float* W = (bj == 0 ? wa : wx) + ((size_t)(dir * 16 + h) * 64) * 64 + ch; float a = (bj == 0 ? ba : bxx)[(dir * 16 + h) * 64 + ch];
        for (int i = 0; i < 64; ++i) { const int c = 64 * h + i; float xc = convb[c];
            for (int j = 0; j < 4; ++j) xc += convw[j * 1024 + c] * bfu(XRp[(size_t)(t + j) * 1024 + c]);
            a += xc * W[(size_t)i * 64]; }
        const float got = bfu((t < 4096 ? G0 : G1)[(size_t)(t & 4095) * 4096 + col]);
        if (fabsf(got - a) > 0.008f * fabsf(a) + 0.006f) atomicAdd(flagw + 0, 1u); }
}

#ifndef DIAG_HALF
#define DIAG_HALF 1
#endif
__device__ __forceinline__ void diag_max(const unsigned char* ws, unsigned* flagw, int gtid, int GT) {
    const bf16_t* ycat = (const bf16_t*)(ws + WS_YCAT); float mx = 0.f;
    for (size_t i = gtid; i < (size_t)SEQ * 1024; i += GT) { const size_t r = i >> 10, c = (i & 1023) + DIAG_HALF * 1024; mx = fmaxf(mx, fabsf(bfu(ycat[r * DM + c]))); }
    atomicMax(flagw + 0, __float_as_uint(mx));
}

#ifndef DIAG_SEL
#define DIAG_SEL 4
#endif
__device__ __forceinline__ void diag_rows(const float* outp, unsigned* flagw, int gw, int NGW, int lane) {
    for (int row = gw; row < SEQ; row += NGW) { float mx = 0.f; for (int j = lane; j < DM; j += 64) mx = fmaxf(mx, fabsf(outp[(size_t)row * DM + j]));
#pragma unroll
        for (int o = 1; o < 64; o <<= 1) mx = fmaxf(mx, __shfl_xor(mx, o));
        if (lane == 0 && mx > 12.0f) { atomicAdd(flagw + 0, 1u); atomicMin(flagw + 1, (unsigned)row); atomicMax(flagw + 2, (unsigned)row); } }
}

__device__ __forceinline__ void diag_rows_bf(const bf16_t* p, int ld, float thr, unsigned* flagw, int gw, int NGW, int lane) {
    for (int row = gw; row < SEQ; row += NGW) { float mx = 0.f; for (int j = lane; j < ld; j += 64) mx = fmaxf(mx, fabsf(bfu(p[(size_t)row * ld + j])));
#pragma unroll
        for (int o = 1; o < 64; o <<= 1) mx = fmaxf(mx, __shfl_xor(mx, o));
        if (lane == 0 && mx > thr) { atomicAdd(flagw + 0, 1u); atomicMin(flagw + 1, (unsigned)row); atomicMax(flagw + 2, (unsigned)row); } }
}
template <int PHMASK> __global__ void __launch_bounds__(512, 2) mega(Args) {
    extern __shared__ __attribute__((aligned(16))) unsigned char lds_raw[];
    LAS unsigned char* lds = (LAS unsigned char*)lds_raw;
    const int wave = __builtin_amdgcn_readfirstlane((int)threadIdx.x >> 6);
    const int G = gridDim.x, bx = blockIdx.x;
    const int gw = bx * 8 + wave, NGW = G * 8, GT = G * 512;
#define PH_IDS const int lane = fresh_lane(), tid = wave * 64 + lane, gtid = bx * 512 + tid; (void)tid; (void)gtid; (void)lane
    const kin_t KIN = (kin_t)__builtin_amdgcn_kernarg_segment_ptr();
    unsigned char* ws = (unsigned char*)KIN[39]; unsigned char* dout = (unsigned char*)KIN[38];
    const int* kint = (const int*)0; (void)kint;
#if DIAG == 2
    const int lo = ((const __attribute__((address_space(4))) int*)KIN)[80], hi = 7;
#elif DIAG == 3
    const int lo = ((const __attribute__((address_space(4))) int*)KIN)[80], hi = 8;
#elif DIAG == 4
    const int lo = ((const __attribute__((address_space(4))) int*)KIN)[80], hi = 5;
#elif DIAG == 6
    const int lo = ((const __attribute__((address_space(4))) int*)KIN)[80], hi = 7;
#elif DIAG == 8
    const int lo = ((const __attribute__((address_space(4))) int*)KIN)[80], hi = 9;
#elif DIAG == 11 || DIAG == 12
    const int lo = ((const __attribute__((address_space(4))) int*)KIN)[80], hi = 10;
#else
    const int lo = ((const __attribute__((address_space(4))) int*)KIN)[80], hi = ((const __attribute__((address_space(4))) int*)KIN)[81];
#endif
#define IN(k) (((PHMASK >> (k)) & 1) && lo <= (k) && (k) < hi)
    unsigned nbar = 0; unsigned* gbar = (unsigned*)(ws + WS_CTR) + 32; (void)gbar;
    XcdBarrier xb; xb.bar = (unsigned*)(ws + WS_CTR) + 5120; xb.x = xb_xcc_id(); xb.st = (volatile LAS unsigned*)(lds + 155000);
    if (wave == 0) { if (fresh_lane() == 0) { xb.st[0] = 0u; xb.st[1] = 0u; (void)xb_add(&xb.bar[XB_XCNT(xb.x)], 1u); } }
    __syncthreads();
    if (PHMASK == 0xfff && hi > 4096) cg::this_grid().sync();
#ifndef DBL_MASK
#define DBL_MASK 0
#endif
#define REPS(k) (((DBL_MASK >> (k)) & 1) ? 2 : 1)
#define SEAM(k) do { if (IN(k) && IN((k) + 1)) { ++nbar; xcd_barrier(xb, (unsigned)G, wave); if (TSTAMP && bx == 0 && wave == 0) { if (fresh_lane() == 0) ((unsigned long long*)(ws + WS_CTR + 1024))[(k) + 1] = __builtin_amdgcn_s_memrealtime(); } } } while (0)

#define MK_RG const RgCtx RG{(const bf16_t*)(ws + WS_XR), (const bf16_t*)(ws + WS_G0), (const bf16_t*)(ws + WS_G1), (const bf16_t*)(dout + DO_Z), KIN[16], KIN[17], (const float*)(ws + WS_SP), (float*)(ws + WS_AGG), (bf16_t*)(dout + DO_YPRE)}
    if (TSTAMP && bx == 0 && wave == 0) { if (fresh_lane() == 0) ((unsigned long long*)(ws + WS_CTR + 1024))[0] = __builtin_amdgcn_s_memrealtime(); }
    for (int rep = 0; rep < REPS(0); ++rep) {
    if (IN(0)) { PH_IDS;
        if (G != 256) { for (int g = bx; g < 64; g += G) s5_precompute(KIN, ws, g, 0, 1, (LAS float*)lds, tid); }
        {
            LAS float* scr = (LAS float*)(lds + wave * 16640);
            constexpr int I_IN = (DM / 64) * (DIN / 64), I_OUT = (DM / 64) * (DM / 64), I_PG = I_OUT, I_GLU = (DS5 / 64) * (DS5 / 64), I_PW = (PLE / 64) * (DM / 64), I_LN = SEQ / 8;
            constexpr int NITEMS = I_IN + I_OUT + I_PG + I_GLU + I_PW + I_LN;
            for (int it = gw; it < NITEMS; it += NGW) {
                int r = it;
                if (r < I_IN) { transpose_item(KIN[4], DM, DIN, (bf16_t*)(ws + WS_WINT), scr, r, lane); continue; } r -= I_IN;
                if (r < I_LN) { for (int q = 0; q < 8; ++q) { const int row = r * 8 + q; ln_row<true>(KIN[0] + (size_t)row * DM, KIN[2], KIN[3], (bf16_t*)(ws + WS_HB) + (size_t)row * DM, lane); } continue; } r -= I_LN;
                if (r < I_OUT) { transpose_item(KIN[25], DM, DM, (bf16_t*)(ws + WS_WOUTT), scr, r, lane); continue; } r -= I_OUT;
                if (r < I_PG) { transpose_item(KIN[34], DM, DM, (bf16_t*)(ws + WS_PLEGT), scr, r, lane); continue; } r -= I_PG;
                if (r < I_GLU) { transpose_item(KIN[14], DS5, DS5, (bf16_t*)(ws + WS_GLUT), scr, r, lane); continue; } r -= I_GLU;
                transpose_item(KIN[33], PLE, DM, (bf16_t*)(ws + WS_PLEWT), scr, r, lane);
            }
        }
        {   const float* pp = KIN[1]; bf16_t* pb = (bf16_t*)(ws + WS_PB);
            for (int i = gtid; i < SEQ * PLE / 4; i += GT) { const f32x4 v = ((const f32x4*)pp)[i]; u32x2 w; w.x = cvt_pk_bf16(v[0], v[1]); w.y = cvt_pk_bf16(v[2], v[3]); ((u32x2*)pb)[i] = w; }
            const float *convw = KIN[16], *convb = KIN[17], *wa = KIN[18], *ba = KIN[19], *wx = KIN[20], *bxx = KIN[21], *lam = KIN[22];
            bf16_t* rgw = (bf16_t*)(ws + WS_RGW);
            for (int i = gtid; i < 16 * 256 * 32; i += GT) { const int h = i >> 13, row = (i >> 5) & 255, K0 = (i & 31) * 8, j = K0 >> 6, i0 = K0 & 63, ch = row >> 2, bj = (row >> 1) & 1, dir = row & 1;
                const float* W = (bj == 0 ? wa : wx) + ((size_t)(dir * 16 + h) * 64) * 64 + ch; float v[8];
#pragma unroll
                for (int k = 0; k < 8; ++k) v[k] = convw[j * 1024 + 64 * h + i0 + k] * W[(size_t)(i0 + k) * 64];
                u32x4 w; w.x = cvt_pk_bf16(v[0], v[1]); w.y = cvt_pk_bf16(v[2], v[3]); w.z = cvt_pk_bf16(v[4], v[5]); w.w = cvt_pk_bf16(v[6], v[7]);
                *(u32x4*)(rgw + ((size_t)h * 256 + row) * 256 + K0) = w; }
            float* rgb = (float*)(ws + WS_RGBIAS);
            for (int i = gtid; i < 16 * 256; i += GT) { const int h = i >> 8, row = i & 255, ch = row >> 2, bj = (row >> 1) & 1, dir = row & 1;
                const float* W = (bj == 0 ? wa : wx) + ((size_t)(dir * 16 + h) * 64) * 64 + ch; float s = (bj == 0 ? ba : bxx)[(dir * 16 + h) * 64 + ch];
                for (int k = 0; k < 64; ++k) s += convb[64 * h + k] * W[(size_t)k * 64];
                rgb[i] = s; }
            float* spt = (float*)(ws + WS_SP);
            for (int i = gtid; i < 2 * 1024; i += GT) spt[i] = -8.0f * log1pf(expf(-lam[i]));
            unsigned* xr = (unsigned*)(ws + WS_XR);
            for (int i = gtid; i < 1024; i += GT) { xr[i] = 0u; xr[(size_t)(SEQ + 2) * 512 + i] = 0u; }
        }
    }
    if (rep + 1 < REPS(0)) { ++nbar; xcd_barrier(xb, (unsigned)G, wave); } }
    SEAM(0);
    for (int rep = 0; rep < REPS(1); ++rep) {
    if (IN(1)) { PH_IDS;
        SchedStd S; S.so.init(SEQ, DIN, G, bx); S.A = (const char*)(ws + WS_HB); S.B = (const char*)(ws + WS_WINT); S.a_tile = (size_t)256 * DM * 2; S.b_tile = (size_t)256 * DM * 2;
        EpiProj E{(bf16_t*)(dout + DO_U), (bf16_t*)(ws + WS_XR), (bf16_t*)(dout + DO_Z), KIN[5]};
        GEMM_PHASE(lds, wave, GParm{DM, DM * 2, 128, 64, 0}, S, E);
        if (G == 256 && bx >= 128) { __syncthreads(); const int t2 = wave * 64 + fresh_lane(); s5_precompute(KIN, ws, (bx - 128) >> 1, (bx - 128) & 1, 2, (LAS float*)lds, t2); }
    }
    if (rep + 1 < REPS(1)) { ++nbar; xcd_barrier(xb, (unsigned)G, wave); } }
    SEAM(1);
    for (int rep = 0; rep < REPS(2); ++rep) {
    if (IN(2)) { PH_IDS;
        { SchedS5a S{(const char*)(dout + DO_U), (const char*)(ws + WS_WG), G, bx}; EpiS5a E{(bf16_t*)(ws + WS_YINTRA), (float*)(ws + WS_S)};
          GEMM_PHASE(lds, wave, GParm{512, 1024, 128, 64, 0}, S, E); }
        { SchedRG S{(const char*)(ws + WS_XR), (const char*)(ws + WS_RGW), G, bx}; EpiG E{(bf16_t*)(ws + WS_G0), (bf16_t*)(ws + WS_G1), (const float*)(ws + WS_RGBIAS)};
          GEMM_PHASE(lds, wave, GParm{256, 2048, 2048, 64, 0}, S, E); }
    }
    if (rep + 1 < REPS(2)) { ++nbar; xcd_barrier(xb, (unsigned)G, wave); } }
    SEAM(2);
    for (int rep = 0; rep < REPS(3); ++rep) {
    if (IN(3)) { PH_IDS;
        if (bx < 128) {
            const int g = bx >> 1, n = bx & 1; const float* Sg = (const float*)(ws + WS_S) + (size_t)g * NCH * 256 + n * 128; LAS float* Ls = (LAS float*)lds;
            for (int i = tid; i < NCH * 32; i += 512) { const int c = i >> 5, q4 = (i & 31) * 4; *(LAS f32x4*)(Ls + c * 128 + q4) = *(const f32x4*)(Sg + (size_t)c * 256 + q4); }
            __syncthreads();
            if (wave == 0) { const int p = lane, pi = (n * 64 + g) * 64 + p;
                const float lr = fminf(KIN[6][pi], -1e-4f), li = KIN[7][pi], step = expf(KIN[8][n * 64 + g]); float ar, ai; cpow(lr * step, li * step, TC, ar, ai);
                bf16_t* hp = (bf16_t*)(ws + WS_HPREV) + (size_t)g * NCH * 256 + n * 128; float hr = 0.f, him = 0.f;
                for (int cc = 0; cc < NCH; ++cc) { const int c = n == 0 ? cc : NCH - 1 - cc;
                    hp[(size_t)c * 256 + p] = (bf16_t)(cvt_pk_bf16(hr, 0.f) & 0xffffu); hp[(size_t)c * 256 + 64 + p] = (bf16_t)(cvt_pk_bf16(him, 0.f) & 0xffffu);
                    const float sr = Ls[c * 128 + p], si = Ls[c * 128 + 64 + p]; const float nr = ar * hr - ai * him + sr, ni = ar * him + ai * hr + si; hr = nr; him = ni; } }
            __syncthreads();
        }
        { MK_RG; for (int un = bx; un < 256; un += G) rg_pass_a(RG, un & 1, un >> 1, tid); }
    }
    if (rep + 1 < REPS(3)) { ++nbar; xcd_barrier(xb, (unsigned)G, wave); } }
    SEAM(3);
    for (int rep = 0; rep < REPS(4); ++rep) {
    if (IN(4)) { PH_IDS;
#if NAIVE_S5
        if (gw < 64) naive_s5_group((const float* const*)0, (const bf16_t*)(dout + DO_U), (float*)(ws + WS_YINTRA), (bf16_t*)(ws + WS_YS5G), gw, lane);
#else
        { SchedS5b S{(const char*)(ws + WS_HPREV), (const char*)(ws + WS_WC), G, bx}; EpiS5b E{(const bf16_t*)(ws + WS_YINTRA), (bf16_t*)(ws + WS_YS5G)};
          GEMM_PHASE(lds, wave, GParm{256, 512, 128, 64, 0}, S, E); }
#endif
#if NAIVE_RG
        { MK_RG; if (gtid < 1024) naive_rg_channel(RG, gtid); }
#else
        { MK_RG; __syncthreads(); for (int un = bx; un < 256; un += G) { rg_pass_c(RG, un & 1, un >> 1, tid, (LAS float*)lds); __syncthreads(); } }
#endif
    }
    if (rep + 1 < REPS(4)) { ++nbar; xcd_barrier(xb, (unsigned)G, wave); } }
    SEAM(4);
    for (int rep = 0; rep < REPS(5); ++rep) {
    if (IN(5)) { PH_IDS;
        SchedStd S; S.so.init(SEQ, DS5, G, bx); S.A = (const char*)(ws + WS_YS5G); S.B = (const char*)(ws + WS_GLUT); S.a_tile = (size_t)256 * 16 * 2; S.b_tile = (size_t)256 * DS5 * 2;
        EpiGlu E{(const bf16_t*)(ws + WS_YS5G), (bf16_t*)(dout + DO_YPRE), KIN[15]};
        GEMM_PHASE(lds, wave, GParm{DS5, 32, 4u * GM_STRIDE * 2u, 16, GM_STRIDE}, S, E);
        if (G == 256 && bx >= 128) {
            LAS float* scr = (LAS float*)(lds + wave * 16640); constexpr int I_FF1 = (DM / 64) * (DFF / 64);
            for (int it = (bx - 128) * 8 + wave; it < I_FF1; it += 1024) transpose_item(KIN[29], DM, DFF, (bf16_t*)(ws + WS_FF1T), scr, it, lane); }
    }
    if (rep + 1 < REPS(5)) { ++nbar; xcd_barrier(xb, (unsigned)G, wave); } }
    SEAM(5);
    for (int rep = 0; rep < REPS(6); ++rep) {
    if (IN(6)) { PH_IDS;
        const float *g5 = KIN[23], *gr = KIN[24];
        for (int row = gw; row < SEQ; row += NGW) { const u32x4* yr = (const u32x4*)(dout + DO_YPRE) + (size_t)row * 256; u32x4* oc = (u32x4*)(ws + WS_YCAT) + (size_t)row * 256;
            u32x4 w[4]; float s0 = 0.f, s1 = 0.f;
#pragma unroll
            for (int j = 0; j < 4; ++j) { w[j] = yr[lane + 64 * j]; const float q = bf_lo(w[j].x) * bf_lo(w[j].x) + bf_hi(w[j].x) * bf_hi(w[j].x) + bf_lo(w[j].y) * bf_lo(w[j].y) + bf_hi(w[j].y) * bf_hi(w[j].y)
                + bf_lo(w[j].z) * bf_lo(w[j].z) + bf_hi(w[j].z) * bf_hi(w[j].z) + bf_lo(w[j].w) * bf_lo(w[j].w) + bf_hi(w[j].w) * bf_hi(w[j].w); if (j < 2) s0 += q; else s1 += q; }
            const float r0 = 1.0f / sqrtf(wave_sum(s0) * (1.f / 1024.f) + LN_EPS), r1 = 1.0f / sqrtf(wave_sum(s1) * (1.f / 1024.f) + LN_EPS);
#pragma unroll
            for (int j = 0; j < 4; ++j) { const int col = (lane + 64 * j) * 8; const float rs = j < 2 ? r0 : r1; const float* gp = j < 2 ? g5 + col : gr + (col - 1024);
                const f32x4 ga = *(const f32x4*)gp, gb = *(const f32x4*)(gp + 4);
                u32x4 o; o.x = cvt_pk_bf16(bf_lo(w[j].x) * rs * ga[0], bf_hi(w[j].x) * rs * ga[1]); o.y = cvt_pk_bf16(bf_lo(w[j].y) * rs * ga[2], bf_hi(w[j].y) * rs * ga[3]);
                o.z = cvt_pk_bf16(bf_lo(w[j].z) * rs * gb[0], bf_hi(w[j].z) * rs * gb[1]); o.w = cvt_pk_bf16(bf_lo(w[j].w) * rs * gb[2], bf_hi(w[j].w) * rs * gb[3]); oc[lane + 64 * j] = o; } }
        {
            LAS float* scr = (LAS float*)(lds + wave * 16640);
            constexpr int I_FF1 = (DM / 64) * (DFF / 64), I_FF2 = (DFF / 64) * (DM / 64);
            for (int it = gw; it < (G == 256 ? I_FF2 : I_FF1 + I_FF2); it += NGW) {
                if (it < I_FF2) transpose_item(KIN[31], DFF, DM, (bf16_t*)(ws + WS_FF2T), scr, it, lane);
                else transpose_item(KIN[29], DM, DFF, (bf16_t*)(ws + WS_FF1T), scr, it - I_FF2, lane); }
        }
    }
    if (rep + 1 < REPS(6)) { ++nbar; xcd_barrier(xb, (unsigned)G, wave); } }
    SEAM(6);
    for (int rep = 0; rep < REPS(7); ++rep) {
    if (IN(7)) { PH_IDS;
        SchedStd S; S.so.init(SEQ, DM, G, bx); S.A = (const char*)(ws + WS_YCAT); S.B = (const char*)(ws + WS_WOUTT); S.a_tile = (size_t)256 * DM * 2; S.b_tile = (size_t)256 * DM * 2;
        EpiResLn1 E{(bf16_t*)(ws + WS_HB), KIN[26], KIN[27], KIN[28], PanelStats8{(unsigned long long*)(ws + WS_AGG), (unsigned*)(ws + WS_CTR) + 1024, LN_EPS}};
        GEMM_PHASE(lds, wave, GParm{DM, DM * 2, 128, 64, 0}, S, E);
    }
    if (rep + 1 < REPS(7)) { ++nbar; xcd_barrier(xb, (unsigned)G, wave); } }
    for (int rep = 0; rep < REPS(8); ++rep) {
    if (IN(8)) { }
    if (rep + 1 < REPS(8)) { ++nbar; xcd_barrier(xb, (unsigned)G, wave); } }
    SEAM(8);
    for (int rep = 0; rep < REPS(9); ++rep) {
    if (IN(9)) { PH_IDS;
        { SchedStd S; S.so.init(SEQ, DFF, G, bx); S.A = (const char*)(ws + WS_HB); S.B = (const char*)(ws + WS_FF1T); S.a_tile = (size_t)256 * DM * 2; S.b_tile = (size_t)256 * DM * 2;
          EpiPlain<1> E{(bf16_t*)(ws + WS_T), DFF, KIN[30], 0}; GEMM_PHASE(lds, wave, GParm{DM, DM * 2, 128, 64, 0}, S, E); }
        { SchedStd S; S.so.init(SEQ, DM, G, bx); S.A = (const char*)(ws + WS_HB); S.B = (const char*)(ws + WS_PLEGT); S.a_tile = (size_t)256 * DM * 2; S.b_tile = (size_t)256 * DM * 2;
          EpiPlain<2> E{(bf16_t*)dout, DM, KIN[35], (size_t)1 << 20}; GEMM_PHASE(lds, wave, GParm{DM, DM * 2, 128, 64, 0}, S, E); }
        { SchedStd S; S.so.init(SEQ, DM, G, bx); S.A = (const char*)(ws + WS_PB); S.B = (const char*)(ws + WS_PLEWT); S.a_tile = (size_t)256 * PLE * 2; S.b_tile = (size_t)256 * PLE * 2;
          EpiPlain<0> E{(bf16_t*)dout + ((size_t)1 << 19), DM, nullptr, (size_t)1 << 20}; GEMM_PHASE(lds, wave, GParm{PLE, PLE * 2, 128, 64, 0}, S, E); }
    }
    if (rep + 1 < REPS(9)) { ++nbar; xcd_barrier(xb, (unsigned)G, wave); } }
    SEAM(9);
    for (int rep = 0; rep < REPS(10); ++rep) {
    if (IN(10)) { PH_IDS;
        SchedStd S; S.so.init(SEQ, DM, G, bx); S.A = (const char*)(ws + WS_T); S.B = (const char*)(ws + WS_FF2T); S.a_tile = (size_t)256 * DFF * 2; S.b_tile = (size_t)256 * DFF * 2;
        EpiResLn2 E{(const bf16_t*)(ws + WS_HB), KIN[32], KIN[36], KIN[37], (float*)dout, (const bf16_t*)dout, PanelStats8{(unsigned long long*)(ws + WS_AGG) + 65536, (unsigned*)(ws + WS_CTR) + 1024 + 64 * 32, LN_EPS}};
        GEMM_PHASE(lds, wave, GParm{DFF, DFF * 2, 128, 64, 0}, S, E);
    }
    if (rep + 1 < REPS(10)) { ++nbar; xcd_barrier(xb, (unsigned)G, wave); } }
    for (int rep = 0; rep < REPS(11); ++rep) {
    if (IN(11)) { }
    if (rep + 1 < REPS(11)) { ++nbar; xcd_barrier(xb, (unsigned)G, wave); } }
#ifdef EXTRA_BARRIERS
    for (int eb = 0; eb < EXTRA_BARRIERS; ++eb) { ++nbar; xcd_barrier(xb, (unsigned)G, wave); }
#endif
#if TSTAMP
    if (bx == 0 && wave == 0) { if (fresh_lane() == 0) { unsigned long long* st = (unsigned long long*)(ws + WS_CTR + 1024); st[12] = __builtin_amdgcn_s_memrealtime();
        ((float*)KIN[38])[0] = 8.0f * floorf((float)(long long)(__hip_atomic_load(st + TS_A1, __ATOMIC_RELAXED, __HIP_MEMORY_SCOPE_AGENT) - __hip_atomic_load(st + TS_A0, __ATOMIC_RELAXED, __HIP_MEMORY_SCOPE_AGENT)) * 0.00125f + 0.5f); } }
#endif
#if DIAG
    { ++nbar; xcd_barrier(xb, (unsigned)G, wave); PH_IDS; unsigned* flagw = (unsigned*)(ws + WS_CTR) + 48;
#if DIAG == 1
      diag_ffn((const float* const*)0, ws, ((float*)KIN[38]), flagw, gtid, GT);
#elif DIAG == 2
      diag_pre((const float* const*)0, ws, dout, flagw, gtid, GT);
#elif DIAG == 3
      diag_v((const float* const*)0, ws, dout, flagw, gtid, GT);
#elif DIAG == 4
      diag_g((const float* const*)0, ws, flagw, gtid, GT);
#elif DIAG == 6
      diag_max(ws, flagw, gtid, GT);
#else
      if (bx == 0 && tid == 0) flagw[1] = 0xffffffffu;
      ++nbar; xcd_barrier(xb, (unsigned)G, wave);
#if DIAG == 7
      diag_rows(((float*)KIN[38]), flagw, gw, NGW, lane);
#elif DIAG == 8
      diag_rows_bf((const bf16_t*)(ws + WS_HB), DM, 12.0f, flagw, gw, NGW, lane);
#elif DIAG == 9
      diag_rows((const float*)(ws + WS_V2), flagw, gw, NGW, lane);
#elif DIAG == 10
      diag_rows_bf((const bf16_t*)(ws + WS_T), DFF, 150.0f, flagw, gw, NGW, lane);
#elif DIAG == 11
      diag_rows_bf((const bf16_t*)(dout + DO_PW), DM, 8.0f, flagw, gw, NGW, lane);
#elif DIAG == 12
      diag_rows_bf((const bf16_t*)(dout + DO_SG), DM, 1.01f, flagw, gw, NGW, lane);
#endif
#endif
      ++nbar; xcd_barrier(xb, (unsigned)G, wave);
#if DIAG != 1
      for (int i = gtid; i < SEQ * DM; i += GT) ((float*)KIN[38])[i] = 0.f;
      ++nbar; xcd_barrier(xb, (unsigned)G, wave);
#endif
      if (bx == 0 && tid == 0) { unsigned code = 0; for (int q = 0; q < 4; ++q) if (__hip_atomic_load(flagw + q, __ATOMIC_RELAXED, __HIP_MEMORY_SCOPE_AGENT) > 100u) code |= 1u << q; if (DIAG >= 7) { const unsigned cnt = __hip_atomic_load(flagw, __ATOMIC_RELAXED, __HIP_MEMORY_SCOPE_AGENT), mn = __hip_atomic_load(flagw + 1, __ATOMIC_RELAXED, __HIP_MEMORY_SCOPE_AGENT), mxr = __hip_atomic_load(flagw + 2, __ATOMIC_RELAXED, __HIP_MEMORY_SCOPE_AGENT);
          const unsigned v = DIAG_SEL == 0 ? cnt : DIAG_SEL == 1 ? mn / 100u : DIAG_SEL == 2 ? mn % 100u : DIAG_SEL == 3 ? mxr / 100u : mxr % 100u; ((float*)KIN[38])[0] = 100.0f * (float)(v + 1u); }
      else ((float*)KIN[38])[0] = (DIAG == 6) ? 1000.0f * __uint_as_float(__hip_atomic_load(flagw, __ATOMIC_RELAXED, __HIP_MEMORY_SCOPE_AGENT)) : 1000.0f * (float)(code + 16u); } }
#endif
#undef IN
#undef SEAM
}


#if PER_PHASE_LAUNCH
template <int PH> static void set_attr_one() { (void)hipFuncSetAttribute((const void*)mega<(1 << PH)>, hipFuncAttributeMaxDynamicSharedMemorySize, LDS_BYTES); }
template <int PH> static void launch_one(Args a, int grid, hipStream_t stream) { a.ph_lo = PH; a.ph_hi = PH + 1; hipLaunchKernelGGL(mega<(1 << PH)>, dim3(grid), dim3(512), LDS_BYTES, stream, a); }
static void set_attrs() { set_attr_one<0>(); set_attr_one<1>(); set_attr_one<2>(); set_attr_one<3>(); set_attr_one<4>(); set_attr_one<5>(); set_attr_one<6>(); set_attr_one<7>(); set_attr_one<8>(); set_attr_one<9>(); set_attr_one<10>(); set_attr_one<11>(); }
static void launch_phases(const Args& a, int grid, hipStream_t stream) { launch_one<0>(a, grid, stream); launch_one<1>(a, grid, stream); launch_one<2>(a, grid, stream); launch_one<3>(a, grid, stream); launch_one<4>(a, grid, stream); launch_one<5>(a, grid, stream);
    launch_one<6>(a, grid, stream); launch_one<7>(a, grid, stream); launch_one<8>(a, grid, stream); launch_one<9>(a, grid, stream); launch_one<10>(a, grid, stream); launch_one<11>(a, grid, stream); }
#else
static void set_attrs() { (void)hipFuncSetAttribute((const void*)mega<0xfff>, hipFuncAttributeMaxDynamicSharedMemorySize, LDS_BYTES); }
#endif

extern "C" void kernel_launch(void* const* d_in, const int* in_sizes, int n_in, void* d_out, int out_size, void* d_ws, size_t ws_size, hipStream_t stream) {
    static int grid = 0;
    if (grid == 0) {
        if (n_in != 38 || out_size != SEQ * DM || ws_size < WS_END) { fprintf(stderr, "kernel_launch: unexpected shapes (n_in %d out %d ws %zu)\n", n_in, out_size, ws_size); grid = -1; return; }
        int dev = 0, cus = 0, per_cu = 0;
        hipGetDevice(&dev); hipDeviceGetAttribute(&cus, hipDeviceAttributeMultiprocessorCount, dev);
        set_attrs();
        per_cu = 1;
        (void)hipGetLastError();
        if (per_cu < 1) per_cu = 1;
        grid = cus;
    }
    if (grid < 0) return;
#ifdef POISON_NAN
    hipMemsetAsync(d_ws, 0xFF, WS_END, stream); hipMemsetAsync(d_out, 0xFF, (size_t)64 * MiB, stream);
#endif
    hipMemsetAsync((char*)d_ws + WS_CTR, 0, 40960, stream);
    Args a{};
    for (int i = 0; i < 38; ++i) a.in[i] = (const float*)d_in[i];
    a.out = (float*)d_out; a.ws = (unsigned char*)d_ws;
#if PER_PHASE_LAUNCH
    launch_phases(a, grid, stream);
#else
    a.ph_lo = 0; a.ph_hi = NPHASE;
    void* kargs[] = {&a};
    hipError_t e = hipLaunchCooperativeKernel((const void*)mega<0xfff>, dim3(grid), dim3(512), kargs, LDS_BYTES, stream);
    if (e != hipSuccess) fprintf(stderr, "cooperative launch failed: %s (grid %d)\n", hipGetErrorString(e), grid);
#endif
}
```

```cpp
#include <hip/hip_runtime.h>
#include <hip/hip_cooperative_groups.h>
#include <cstdio>
#include <cstdint>
namespace cg = cooperative_groups;

#ifndef PER_PHASE_LAUNCH
#define PER_PHASE_LAUNCH 0
#endif

#ifndef TSTAMP
#define TSTAMP 0
#define TS_A0 4
#define TS_A1 5
#define TS_B0 9
#define TS_B1 12
#endif
#define LAS __attribute__((address_space(3)))
typedef unsigned short bf16_t;
typedef short bf16x8 __attribute__((ext_vector_type(8)));
typedef float f32x4 __attribute__((ext_vector_type(4)));
typedef float f32x2 __attribute__((ext_vector_type(2)));
typedef unsigned u32x4 __attribute__((ext_vector_type(4)));
typedef unsigned u32x2 __attribute__((ext_vector_type(2)));

constexpr int SEQ = 8192, DM = 2048, DIN = 3072, DS5 = 1024, DRG = 1024, NG = 64, NP = 64, NK = 16, NH = 16, HD = 64, DFF = 8192, PLE = 256;
constexpr int TC = 32, NCH = SEQ / TC;
constexpr float LN_EPS = 1e-5f, DN_ALPHA = 1.18920711500272f;
constexpr int NPHASE = 12;

constexpr size_t MiB = (size_t)1 << 20;
constexpr size_t WS_FF2T = 0, WS_HB = 32 * MiB, WS_FF1T = 64 * MiB, WS_PLEGT = 96 * MiB, WS_PLEWT = 104 * MiB, WS_PB = 105 * MiB, WS_WOUTT = 109 * MiB,
    WS_V2 = 64 * MiB, WS_G0 = 0, WS_G1 = 64 * MiB,
    WS_WG = 128 * MiB, WS_WC = 176 * MiB, WS_RGW = 192 * MiB, WS_GLUT = 194 * MiB, WS_XR = 196 * MiB, WS_YINTRA = 213 * MiB, WS_S = 229 * MiB, WS_HPREV = 245 * MiB, WS_WINT = 229 * MiB,
    WS_YS5G = 128 * MiB, WS_YCAT = 144 * MiB, WS_T = 128 * MiB,
    WS_AGG = 256 * MiB, WS_CARRY = 258 * MiB, WS_SUMSQ = 259 * MiB, WS_RGBIAS = 259 * MiB + 64 * 1024, WS_SP = WS_RGBIAS + 16 * 1024, WS_CTR = WS_SP + 8 * 1024, WS_END = 260 * MiB;
constexpr size_t DO_YPRE = 0, DO_Z = 32 * MiB, DO_U = 48 * MiB, DO_SG = 0, DO_PW = 32 * MiB;
constexpr int FF1_IN_P5 = 3072;
constexpr int GM_STRIDE = SEQ * 16;
constexpr int LDS_BYTES = 152 * 1024;

typedef __bf16 bf16x2_t __attribute__((ext_vector_type(2)));
__device__ __forceinline__ unsigned cvt_pk_bf16(float lo, float hi) { const f32x2 v = {lo, hi}; const bf16x2_t b = __builtin_convertvector(v, bf16x2_t); return __builtin_bit_cast(unsigned, b); }
__device__ __forceinline__ float bf_lo(unsigned w) { return __uint_as_float(w << 16); }
__device__ __forceinline__ float bf_hi(unsigned w) { return __uint_as_float(w & 0xffff0000u); }
__device__ __forceinline__ f32x4 bf4(u32x2 w) { return (f32x4){bf_lo(w.x), bf_hi(w.x), bf_lo(w.y), bf_hi(w.y)}; }
__device__ __forceinline__ float fast_sigmoid(float x) { return __builtin_amdgcn_rcpf(1.0f + __expf(-x)); }
__device__ __forceinline__ float gelu_tanh(float x) { const float u = 1.5957691216057308f * (x + 0.044715f * x * x * x); return x * fast_sigmoid(u); }
__device__ __forceinline__ float wave_sum(float v) {
#pragma unroll
    for (int o = 1; o < 64; o <<= 1) v += __shfl_xor(v, o);
    return v;
}
__device__ __forceinline__ int lane_id() { return (int)__builtin_amdgcn_mbcnt_hi(~0u, __builtin_amdgcn_mbcnt_lo(~0u, 0u)); }
__device__ __forceinline__ int fresh_lane() { unsigned z = 0; asm volatile("" : "+s"(z)); return (int)__builtin_amdgcn_mbcnt_hi(~0u, __builtin_amdgcn_mbcnt_lo(~0u, z)); }
#define LDS_WAIT() asm volatile("s_waitcnt lgkmcnt(0)" ::: "memory")

namespace pg8 {
constexpr int BM = 256, BK = 64, HALF = 128, HTB = HALF * BK * 2, STAGE_BYTES = 8 * HTB, NXCD = 8, WGM = 8;
__host__ __device__ __forceinline__ int lds_byte(int r, int c) { const int st = (r >> 4) * 2 + (c >> 5), rr = r & 15, cc = c & 31, ob = rr * 64 + cc * 2; return st * 1024 + (ob ^ (((ob >> 9) & 1) << 5)); }
__host__ __device__ __forceinline__ void stage_rc(int b, int& R, int& C) { const int st = b / 1024, sb = b % 1024, swz = sb ^ (((sb >> 9) & 1) << 5); R = (st >> 1) * 16 + swz / 64; C = (st & 1) * 32 + (swz % 64) / 2; }
__host__ __device__ __forceinline__ int perm32(int rho) { const int n = rho >> 4, i = rho & 15; return 8 * (i >> 2) + 4 * n + (i & 3); }

struct Unit { int pm, pn; };
struct StaticOrder {
    int nM, nN, nwg, G, c;
    __host__ __device__ void init(int M, int N, int G_, int c_) { nM = M / BM; nN = N / BM; nwg = nM * nN; G = G_; c = c_; }
    __host__ __device__ bool next(int i, Unit& u) const {
        const long L = (long)i * G + c; if (L >= nwg) return false;
        int wgid = (int)L; { const int q = nwg / NXCD, r = nwg % NXCD, xcd = wgid % NXCD, off = wgid / NXCD; wgid = (xcd < r ? xcd * (q + 1) : r * (q + 1) + (xcd - r) * q) + off; }
        const int nig = WGM * nN, gid = wgid / nig, fm = gid * WGM, gsz = (nM - fm) < WGM ? (nM - fm) : WGM;
        u.pm = fm + ((wgid % nig) % gsz); u.pn = (wgid % nig) / gsz; return true;
    }
};
struct GUnit { const char* A; const char* B; int i0, i1; };
struct GParm { int K; unsigned a_rs, a_ks; int a_cw, a_cs; };

template <class Epi, class Sched>
__device__ __forceinline__ void gemm_phase(LAS unsigned char* lds, const int wid, const GParm gp, const Sched& S, const Epi& E) {
    const int lane = fresh_lane(), tid = wid * 64 + lane, wr = wid >> 2, wc = wid & 3, fr = lane & 15, fq = lane >> 4;
    const int K = gp.K, nt = K / BK;
    unsigned voffA[2], voffB[2];
#pragma unroll
    for (int i = 0; i < 2; ++i) { int R, C; stage_rc(tid * 16 + i * 8192, R, C); const int Rb = Epi::PERM ? ((R & ~31) + perm32(R & 31)) : R;
        voffA[i] = (unsigned)R * gp.a_rs + (unsigned)((C / gp.a_cw) * gp.a_cs + (C % gp.a_cw)) * 2u; voffB[i] = (unsigned)(Rb * K + C) * 2u; }
    const size_t ksA = gp.a_ks, ksB = (size_t)(BK * 2);
    const size_t hsA = (size_t)HALF * gp.a_rs, hsB = (size_t)HALF * K * 2;
    const unsigned ldsw = (unsigned)wid * 1024u;
    const int aoff = lds_byte(wr * 64 + fr, fq * 8), boff = lds_byte(wc * 32 + fr, fq * 8);
#define PG8_SA(b, h) (((b) * 2 + (h)) * HTB)
#define PG8_SB(b, h) ((4 + (b) * 2 + (h)) * HTB)
#define PG8_STAGE(bufoff, gbase, voff) do { _Pragma("unroll") for (int _i = 0; _i < 2; ++_i) \
        __builtin_amdgcn_global_load_lds((const unsigned*)((const char*)(gbase) + (voff)[_i]), (LAS unsigned*)(lds + (bufoff) + ldsw + _i * 8192), 16, 0, 0); } while (0)
#define PG8_LDA(dst, b, h) do { _Pragma("unroll") for (int m = 0; m < 4; ++m) _Pragma("unroll") for (int k = 0; k < 2; ++k) dst[m][k] = *(const LAS bf16x8*)(lds + PG8_SA(b, h) + aoff + m * 2048 + k * 1024); } while (0)
#define PG8_LDB(dst, b, h) do { _Pragma("unroll") for (int n = 0; n < 2; ++n) _Pragma("unroll") for (int k = 0; k < 2; ++k) dst[n][k] = *(const LAS bf16x8*)(lds + PG8_SB(b, h) + boff + n * 2048 + k * 1024); } while (0)
#define PG8_MMA(ai, bj, At, Bt) do { __builtin_amdgcn_s_setprio(1); _Pragma("unroll") for (int m = 0; m < 4; ++m) _Pragma("unroll") for (int n = 0; n < 2; ++n) _Pragma("unroll") for (int k = 0; k < 2; ++k) \
        acc[ai][bj][m][n] = __builtin_amdgcn_mfma_f32_16x16x32_bf16(Bt[n][k], At[m][k], acc[ai][bj][m][n], 0, 0, 0); __builtin_amdgcn_s_setprio(0); } while (0)
#define PG8_WAIT_V(n) asm volatile("s_waitcnt vmcnt(" #n ")" ::: "memory")
#define PG8_WAIT_L(n) asm volatile("s_waitcnt lgkmcnt(" #n ")" ::: "memory")
#define PG8_BAR __builtin_amdgcn_s_barrier()
#define PG8_SCHED __builtin_amdgcn_sched_barrier(0)
    GUnit cur, nxt; int ui = 0;
    if (!S.next(0, cur)) return;
    f32x4 acc[2][2][4][2];
#pragma unroll
    for (int a = 0; a < 2; ++a)
#pragma unroll
        for (int b = 0; b < 2; ++b)
#pragma unroll
            for (int m = 0; m < 4; ++m)
#pragma unroll
                for (int n = 0; n < 2; ++n) acc[a][b][m][n] = (f32x4){0.f, 0.f, 0.f, 0.f};
    bf16x8 At[4][2], B0[2][2], B1[2][2];
    const char* cA = cur.A; const char* cB = cur.B;
    PG8_STAGE(PG8_SB(0, 0), cB, voffB); PG8_STAGE(PG8_SB(0, 1), cB + hsB, voffB); PG8_STAGE(PG8_SA(0, 0), cA, voffA); PG8_STAGE(PG8_SA(0, 1), cA + hsA, voffA);
    if (wr == 1) PG8_BAR;
    PG8_WAIT_V(2); PG8_BAR;
    PG8_STAGE(PG8_SB(1, 0), cB + ksB, voffB); PG8_STAGE(PG8_SA(1, 0), cA + ksA, voffA); PG8_STAGE(PG8_SB(1, 1), cB + hsB + ksB, voffB);
    PG8_WAIT_V(6); PG8_BAR;
    for (;;) {
        const bool has_next = S.next(ui + 1, nxt);
        const char* nA = has_next ? nxt.A : cA; const char* nB = has_next ? nxt.B : cB;
        for (int t = 0; t < nt; t += 2) {
            const bool last = (t == nt - 2);
            const char* a1 = cA + (size_t)(t + 1) * ksA;
            const char* a2 = last ? nA : cA + (size_t)(t + 2) * ksA; const char* b2 = last ? nB : cB + (size_t)(t + 2) * ksB;
            const char* a3 = a2 + ksA; const char* b3 = b2 + ksB;
            PG8_LDB(B0, 0, 0); PG8_LDB(B1, 0, 1); PG8_SCHED; PG8_LDA(At, 0, 0); PG8_STAGE(PG8_SA(1, 1), a1 + hsA, voffA);
            PG8_WAIT_V(8); PG8_WAIT_L(0); PG8_BAR; PG8_MMA(0, 0, At, B0); PG8_MMA(0, 1, At, B1); PG8_BAR; PG8_SCHED;
            PG8_LDA(At, 0, 1); PG8_STAGE(PG8_SB(0, 0), b2, voffB); PG8_STAGE(PG8_SB(0, 1), b2 + hsB, voffB); PG8_STAGE(PG8_SA(0, 0), a2, voffA);
            PG8_WAIT_V(8); PG8_WAIT_L(0); PG8_BAR; PG8_MMA(1, 0, At, B0); PG8_MMA(1, 1, At, B1); PG8_BAR; PG8_SCHED;
            PG8_LDB(B0, 1, 0); PG8_LDB(B1, 1, 1); PG8_SCHED; PG8_LDA(At, 1, 0); PG8_STAGE(PG8_SA(0, 1), a2 + hsA, voffA);
            PG8_WAIT_V(8); PG8_WAIT_L(0); PG8_BAR; PG8_MMA(0, 0, At, B0); PG8_MMA(0, 1, At, B1); PG8_BAR; PG8_SCHED;
            PG8_LDA(At, 1, 1); PG8_STAGE(PG8_SB(1, 0), b3, voffB); PG8_STAGE(PG8_SB(1, 1), b3 + hsB, voffB); PG8_STAGE(PG8_SA(1, 0), a3, voffA);
            PG8_WAIT_V(8); PG8_WAIT_L(0); PG8_BAR; PG8_MMA(1, 0, At, B0); PG8_MMA(1, 1, At, B1); PG8_BAR; PG8_SCHED;
        }
        if (wr == 0) PG8_BAR;
        if constexpr (!Epi::AFTER_DRAIN) { const int l_o = fresh_lane(); E(acc, cur, wr, wc, l_o & 15, l_o >> 4); }
        if (!has_next) break;
#pragma unroll
        for (int a = 0; a < 2; ++a)
#pragma unroll
            for (int b = 0; b < 2; ++b)
#pragma unroll
                for (int m = 0; m < 4; ++m)
#pragma unroll
                    for (int n = 0; n < 2; ++n) acc[a][b][m][n] = (f32x4){0.f, 0.f, 0.f, 0.f};
        cur = nxt; cA = nA; cB = nB; ++ui;
        if (wr == 1) PG8_BAR;
    }
    PG8_WAIT_V(0);
    PG8_BAR;
    if constexpr (Epi::AFTER_DRAIN) { const int l_o = fresh_lane(); E.fused(acc, cur, wr, wc, l_o & 15, l_o >> 4, lds, wid); }
#undef PG8_SA
#undef PG8_SB
#undef PG8_STAGE
#undef PG8_LDA
#undef PG8_LDB
#undef PG8_MMA
#undef PG8_WAIT_V
#undef PG8_WAIT_L
#undef PG8_BAR
#undef PG8_SCHED
}
}
using pg8::GUnit; using pg8::GParm;
typedef f32x4 AccT[2][2][4][2];

struct SchedStd {
    pg8::StaticOrder so; const char* A; const char* B; size_t a_tile, b_tile;
    __device__ __forceinline__ bool next(int i, GUnit& u) const { pg8::Unit t; if (!so.next(i, t)) return false; u.A = A + (size_t)t.pm * a_tile; u.B = B + (size_t)t.pn * b_tile; u.i0 = t.pm; u.i1 = t.pn; return true; }
};
struct SchedS5a { const char* U; const char* WG; int G, c;
    __device__ __forceinline__ bool next(int i, GUnit& u) const { const int L = i * G + c; if (L >= 192) return false; const int g = L / 3, pn = L % 3;
        u.A = U + (size_t)g * GM_STRIDE * 2; u.B = WG + ((size_t)g * 768 + 256 * pn) * 512 * 2; u.i0 = g; u.i1 = pn; return true; } };
struct SchedS5b { const char* HP; const char* WC; int G, c;
    __device__ __forceinline__ bool next(int i, GUnit& u) const { const int L = i * G + c; if (L >= 128) return false; const int g = L / 2, pn = L % 2;
        u.A = HP + (size_t)g * 256 * 256 * 2; u.B = WC + ((size_t)g * 512 + 256 * pn) * 256 * 2; u.i0 = g; u.i1 = pn; return true; } };
struct SchedRG { const char* XR; const char* RGW; int G, c;
    __device__ __forceinline__ bool next(int i, GUnit& u) const { const int L = i * G + c; if (L >= 512) return false; const int h = L % 16, pm = L / 16;
        u.A = XR + ((size_t)(256 * pm) * 1024 + 64 * h) * 2; u.B = RGW + (size_t)h * 256 * 256 * 2; u.i0 = pm; u.i1 = h; return true; } };

template <int ACT> __device__ __forceinline__ void epi_bf16_store(const AccT& acc, bf16_t* tile, int ldc, const float* biast, int wr, int wc, int fr, int fq) {
    const int r0 = wr * 64 + fr, c0 = wc * 32 + 8 * fq;
    f32x4 bv[2][2];
#pragma unroll
    for (int bj = 0; bj < 2; ++bj)
#pragma unroll
        for (int n = 0; n < 2; ++n) bv[bj][n] = biast ? *(const f32x4*)(biast + c0 + bj * 128 + 4 * n) : (f32x4){0.f, 0.f, 0.f, 0.f};
#pragma unroll
    for (int ai = 0; ai < 2; ++ai)
#pragma unroll
        for (int m = 0; m < 4; ++m) { bf16_t* rowp = tile + (size_t)(r0 + ai * 128 + m * 16) * ldc + c0;
#pragma unroll
            for (int bj = 0; bj < 2; ++bj) { f32x4 v0 = acc[ai][bj][m][0] + bv[bj][0], v1 = acc[ai][bj][m][1] + bv[bj][1];
                if (ACT == 1) {
#pragma unroll
                    for (int j = 0; j < 4; ++j) { const float a = fmaxf(v0[j], 0.f), b = fmaxf(v1[j], 0.f); v0[j] = a * a; v1[j] = b * b; } }
                if (ACT == 2) {
#pragma unroll
                    for (int j = 0; j < 4; ++j) { v0[j] = fast_sigmoid(v0[j]); v1[j] = fast_sigmoid(v1[j]); } }
                u32x4 w; w.x = cvt_pk_bf16(v0[0], v0[1]); w.y = cvt_pk_bf16(v0[2], v0[3]); w.z = cvt_pk_bf16(v1[0], v1[1]); w.w = cvt_pk_bf16(v1[2], v1[3]);
                *(u32x4*)(rowp + bj * 128) = w; } }
}
struct EpiProj { static constexpr bool PERM = true, AFTER_DRAIN = false; bf16_t *U, *XR, *Z; const float* bias;
    __device__ __forceinline__ void operator()(AccT& acc, const GUnit& u, int wr, int wc, int fr, int fq) const {
        const int pm = u.i0, pn = u.i1;
        if (pn >= 4) { bf16_t* base = pn < 8 ? XR + 2 * 1024 : Z; epi_bf16_store<0>(acc, base + (size_t)pm * 256 * 1024 + (pn & 3) * 256, 1024, bias + pn * 256, wr, wc, fr, fq); return; }
        const int c0 = pn * 256 + wc * 32 + 8 * fq;
#pragma unroll
        for (int bj = 0; bj < 2; ++bj) { const int col = c0 + bj * 128; const f32x4 b0 = *(const f32x4*)(bias + col), b1 = *(const f32x4*)(bias + col + 4); bf16_t* gp = U + (size_t)(col >> 4) * GM_STRIDE + (col & 15);
#pragma unroll
            for (int ai = 0; ai < 2; ++ai)
#pragma unroll
                for (int m = 0; m < 4; ++m) { const int row = pm * 256 + ai * 128 + wr * 64 + m * 16 + fr; const f32x4 v0 = acc[ai][bj][m][0] + b0, v1 = acc[ai][bj][m][1] + b1;
                    u32x4 w; w.x = cvt_pk_bf16(v0[0], v0[1]); w.y = cvt_pk_bf16(v0[2], v0[3]); w.z = cvt_pk_bf16(v1[0], v1[1]); w.w = cvt_pk_bf16(v1[2], v1[3]);
                    *(u32x4*)(gp + (size_t)row * 16) = w; } }
    } };
template <int ACT> struct EpiPlain { static constexpr bool PERM = true, AFTER_DRAIN = false; bf16_t* O; int ldc; const float* bias; size_t pstride;
    __device__ __forceinline__ void operator()(AccT& acc, const GUnit& u, int wr, int wc, int fr, int fq) const {
        epi_bf16_store<ACT>(acc, O + (size_t)u.i0 * (pstride ? pstride : (size_t)256 * ldc) + u.i1 * 256, ldc, bias ? bias + u.i1 * 256 : nullptr, wr, wc, fr, fq); } };
struct EpiFF1G { static constexpr bool PERM = true, AFTER_DRAIN = false; bf16_t* T; bf16_t* SG; const float *b1, *bg;
    __device__ __forceinline__ void operator()(AccT& acc, const GUnit& u, int wr, int wc, int fr, int fq) const {
        const int pm = u.i0, pn = u.i1;
        if (pn < 32) epi_bf16_store<1>(acc, T + (size_t)pm * 256 * DFF + pn * 256, DFF, b1 + pn * 256, wr, wc, fr, fq);
        else epi_bf16_store<2>(acc, SG + (size_t)pm * ((size_t)1 << 20) + (pn - 32) * 256, DM, bg + (pn - 32) * 256, wr, wc, fr, fq); } };
struct EpiS5a { static constexpr bool PERM = true, AFTER_DRAIN = false; bf16_t* YI; float* S;
    __device__ __forceinline__ void operator()(AccT& acc, const GUnit& u, int wr, int wc, int fr, int fq) const {
        const int g = u.i0, pn = u.i1;
#pragma unroll
        for (int ai = 0; ai < 2; ++ai)
#pragma unroll
            for (int m = 0; m < 4; ++m) { const int r = ai * 128 + wr * 64 + m * 16 + fr;
#pragma unroll
                for (int bj = 0; bj < 2; ++bj) { const int c8 = bj * 128 + wc * 32 + 8 * fq; const f32x4 v0 = acc[ai][bj][m][0], v1 = acc[ai][bj][m][1];
                    if (pn < 2) { const int col = pn * 256 + c8, t = col >> 4, k0 = col & 15;
                        u32x4 w; w.x = cvt_pk_bf16(v0[0], v0[1]); w.y = cvt_pk_bf16(v0[2], v0[3]); w.z = cvt_pk_bf16(v1[0], v1[1]); w.w = cvt_pk_bf16(v1[2], v1[3]);
                        *(u32x4*)(YI + (size_t)g * GM_STRIDE + (size_t)r * 512 + col) = w; (void)t; (void)k0; }
                    else { float* sp = S + ((size_t)g * NCH + r) * 256 + c8; *(f32x4*)sp = v0; *(f32x4*)(sp + 4) = v1; } } }
    } };
struct EpiS5b { static constexpr bool PERM = true, AFTER_DRAIN = false; const bf16_t* YI; bf16_t* YG;
    __device__ __forceinline__ void operator()(AccT& acc, const GUnit& u, int wr, int wc, int fr, int fq) const {
        const int g = u.i0, pn = u.i1;
#pragma unroll
        for (int ai = 0; ai < 2; ++ai)
#pragma unroll
            for (int m = 0; m < 4; ++m) { const int r = ai * 128 + wr * 64 + m * 16 + fr;
#pragma unroll
                for (int bj = 0; bj < 2; ++bj) { const int col = pn * 256 + bj * 128 + wc * 32 + 8 * fq, t = col >> 4, k0 = col & 15;
                    const size_t off = (size_t)g * GM_STRIDE + (size_t)r * 512 + col; (void)t; (void)k0; const u32x4 yi = *(const u32x4*)(YI + off);
                    f32x4 v0 = acc[ai][bj][m][0] + (f32x4){bf_lo(yi.x), bf_hi(yi.x), bf_lo(yi.y), bf_hi(yi.y)}, v1 = acc[ai][bj][m][1] + (f32x4){bf_lo(yi.z), bf_hi(yi.z), bf_lo(yi.w), bf_hi(yi.w)};
#pragma unroll
                    for (int j = 0; j < 4; ++j) { v0[j] = gelu_tanh(v0[j]); v1[j] = gelu_tanh(v1[j]); }
                    u32x4 w; w.x = cvt_pk_bf16(v0[0], v0[1]); w.y = cvt_pk_bf16(v0[2], v0[3]); w.z = cvt_pk_bf16(v1[0], v1[1]); w.w = cvt_pk_bf16(v1[2], v1[3]);
                    *(u32x4*)(YG + off) = w; } }
    } };
struct EpiGlu { static constexpr bool PERM = true, AFTER_DRAIN = false; const bf16_t* YG; bf16_t* YPRE; const float* bias;
    __device__ __forceinline__ void operator()(AccT& acc, const GUnit& u, int wr, int wc, int fr, int fq) const {
        const int pm = u.i0, pn = u.i1; const int c0 = pn * 256 + wc * 32 + 8 * fq;
        f32x4 bv[2][2];
#pragma unroll
        for (int bj = 0; bj < 2; ++bj)
#pragma unroll
            for (int n = 0; n < 2; ++n) bv[bj][n] = *(const f32x4*)(bias + c0 + bj * 128 + 4 * n);
#pragma unroll
        for (int ai = 0; ai < 2; ++ai)
#pragma unroll
            for (int m = 0; m < 4; ++m) { const int row = pm * 256 + ai * 128 + wr * 64 + m * 16 + fr;
#pragma unroll
                for (int bj = 0; bj < 2; ++bj) { const int col = c0 + bj * 128; const u32x4 yv = *(const u32x4*)(YG + (size_t)(col >> 4) * GM_STRIDE + (size_t)row * 16 + (col & 15));
                    const f32x4 y0 = (f32x4){bf_lo(yv.x), bf_hi(yv.x), bf_lo(yv.y), bf_hi(yv.y)}, y1 = (f32x4){bf_lo(yv.z), bf_hi(yv.z), bf_lo(yv.w), bf_hi(yv.w)};
                    f32x4 v0 = acc[ai][bj][m][0] + bv[bj][0], v1 = acc[ai][bj][m][1] + bv[bj][1];
#pragma unroll
                    for (int j = 0; j < 4; ++j) { v0[j] = y0[j] * fast_sigmoid(v0[j]); v1[j] = y1[j] * fast_sigmoid(v1[j]); }
                    u32x4 w; w.x = cvt_pk_bf16(v0[0], v0[1]); w.y = cvt_pk_bf16(v0[2], v0[3]); w.z = cvt_pk_bf16(v1[0], v1[1]); w.w = cvt_pk_bf16(v1[2], v1[3]);
                    *(u32x4*)(YPRE + (size_t)row * 2048 + col) = w; }
                }
    } };
template <bool PLEADD> struct EpiRes { static constexpr bool PERM = false, AFTER_DRAIN = false; const bf16_t* HBp; const float* bias; float* V; const bf16_t* SG; const bf16_t* PW;
    __device__ __forceinline__ void operator()(AccT& acc, const GUnit& u, int wr, int wc, int fr, int fq) const {
        const int pm = u.i0, pn = u.i1; const int c0 = pn * 256 + wc * 32 + 4 * fq;
        f32x4 bv[2][2];
#pragma unroll
        for (int bj = 0; bj < 2; ++bj)
#pragma unroll
            for (int n = 0; n < 2; ++n) bv[bj][n] = *(const f32x4*)(bias + c0 + bj * 128 + n * 16);
#pragma unroll
        for (int ai = 0; ai < 2; ++ai)
#pragma unroll
            for (int m = 0; m < 4; ++m) { const int row = pm * 256 + ai * 128 + wr * 64 + m * 16 + fr;
#pragma unroll
                for (int bj = 0; bj < 2; ++bj)
#pragma unroll
                    for (int n = 0; n < 2; ++n) { const size_t off = (size_t)row * 2048 + c0 + bj * 128 + n * 16;
                        f32x4 v = acc[ai][bj][m][n] + bv[bj][n] + DN_ALPHA * bf4(*(const u32x2*)(HBp + off));
                        if (PLEADD) v += bf4(*(const u32x2*)(SG + off)) * bf4(*(const u32x2*)(PW + off));
                        *(f32x4*)(V + off) = v; } }
    } };


struct PanelStats8 { unsigned long long* xbuf; unsigned* cnt; float eps;
    __device__ __forceinline__ void run(const AccT& v, int pm, int pn, int wr, int wc, int fr, int fq, LAS unsigned char* lds, int wid) const {
        LAS f32x2* P = (LAS f32x2*)lds; LAS f32x2* S = (LAS f32x2*)(lds + 8192); const int lane = fq * 16 + fr;
#pragma unroll
        for (int ai = 0; ai < 2; ++ai)
#pragma unroll
            for (int m = 0; m < 4; ++m) { float s = 0.f;
#pragma unroll
                for (int bj = 0; bj < 2; ++bj)
#pragma unroll
                    for (int n = 0; n < 2; ++n) { const f32x4 x = v[ai][bj][m][n]; s += (x[0] + x[1]) + (x[2] + x[3]); }
                s += __shfl_xor(s, 16); s += __shfl_xor(s, 32);
                const float mw = s * (1.0f / 64.0f); float q = 0.f;
#pragma unroll
                for (int bj = 0; bj < 2; ++bj)
#pragma unroll
                    for (int n = 0; n < 2; ++n) { const f32x4 d = v[ai][bj][m][n] - mw; q += (d[0] * d[0] + d[1] * d[1]) + (d[2] * d[2] + d[3] * d[3]); }
                q += __shfl_xor(q, 16); q += __shfl_xor(q, 32);
                if (fq == 0) P[(ai * 128 + wr * 64 + m * 16 + fr) * 4 + wc] = (f32x2){mw, q}; }
        asm volatile("s_waitcnt lgkmcnt(0)" ::: "memory"); __builtin_amdgcn_s_barrier(); asm volatile("" ::: "memory");
        const int row = wid * 32 + (lane & 31);
        if (lane < 32) { const f32x2 a = P[row * 4 + 0], b = P[row * 4 + 1], c = P[row * 4 + 2], d = P[row * 4 + 3];
            const float mt = (a[0] + b[0] + c[0] + d[0]) * 0.25f; const float da = a[0] - mt, db = b[0] - mt, dc = c[0] - mt, dd = d[0] - mt;
            const float m2 = (a[1] + b[1]) + (c[1] + d[1]) + 64.0f * ((da * da + db * db) + (dc * dc + dd * dd));
            __hip_atomic_store(xbuf + ((size_t)(pm * 256 + row) * 8 + pn), ((unsigned long long)__float_as_uint(m2) << 32) | __float_as_uint(mt), __ATOMIC_RELAXED, __HIP_MEMORY_SCOPE_AGENT); }
        asm volatile("s_waitcnt vmcnt(0)" ::: "memory");
        if (lane == 0) __hip_atomic_fetch_add(cnt + 64 * pm, 1u, __ATOMIC_RELAXED, __HIP_MEMORY_SCOPE_AGENT);
        if (wid == 0) { unsigned sp = 0;
            while ((unsigned)__builtin_amdgcn_readfirstlane(__hip_atomic_load(cnt + 64 * pm, __ATOMIC_RELAXED, __HIP_MEMORY_SCOPE_AGENT)) < 64u) { __builtin_amdgcn_s_sleep(2); if (++sp > (1u << 22)) break; }
            __builtin_amdgcn_fence(__ATOMIC_ACQUIRE, "agent"); }
        asm volatile("s_waitcnt vmcnt(0) lgkmcnt(0)" ::: "memory"); __builtin_amdgcn_s_barrier(); asm volatile("" ::: "memory");
        if (lane < 32) { const unsigned long long* slot = xbuf + (size_t)(pm * 256 + row) * 8; float mt[8], m2[8]; float ms = 0.f;
#pragma unroll
            for (int t = 0; t < 8; ++t) { const unsigned long long w = __hip_atomic_load(slot + t, __ATOMIC_RELAXED, __HIP_MEMORY_SCOPE_AGENT); mt[t] = __uint_as_float((unsigned)w); m2[t] = __uint_as_float((unsigned)(w >> 32)); ms += mt[t]; }
            const float mean = ms * 0.125f; float q = 0.f;
#pragma unroll
            for (int t = 0; t < 8; ++t) { const float dm = mt[t] - mean; q += m2[t] + 256.0f * dm * dm; }
            S[row] = (f32x2){mean, 1.0f / sqrtf(q * (1.0f / 2048.0f) + eps)}; }
        asm volatile("s_waitcnt lgkmcnt(0)" ::: "memory"); __builtin_amdgcn_s_barrier(); asm volatile("" ::: "memory");
    } };
struct EpiResLn1 { static constexpr bool PERM = false, AFTER_DRAIN = true; bf16_t* HBp; const float *bias, *lng, *lnb; PanelStats8 st;
    __device__ __forceinline__ void fused(AccT& acc, const GUnit& u, int wr, int wc, int fr, int fq, LAS unsigned char* lds, int wid) const {
        const int pm = u.i0, pn = u.i1; const int c0 = pn * 256 + wc * 32 + 4 * fq; const LAS f32x2* S = (const LAS f32x2*)(lds + 8192);
#pragma unroll
        for (int bj = 0; bj < 2; ++bj)
#pragma unroll
            for (int n = 0; n < 2; ++n) { const f32x4 bv = *(const f32x4*)(bias + c0 + bj * 128 + n * 16);
#pragma unroll
                for (int ai = 0; ai < 2; ++ai)
#pragma unroll
                    for (int m = 0; m < 4; ++m) { const size_t off = (size_t)(pm * 256 + ai * 128 + wr * 64 + m * 16 + fr) * 2048 + c0 + bj * 128 + n * 16;
                        acc[ai][bj][m][n] += bv + DN_ALPHA * bf4(*(const u32x2*)(HBp + off)); } }
        st.run(acc, pm, pn, wr, wc, fr, fq, lds, wid);
#pragma unroll
        for (int bj = 0; bj < 2; ++bj)
#pragma unroll
            for (int n = 0; n < 2; ++n) { const f32x4 gg = *(const f32x4*)(lng + c0 + bj * 128 + n * 16), bb = *(const f32x4*)(lnb + c0 + bj * 128 + n * 16);
#pragma unroll
                for (int ai = 0; ai < 2; ++ai)
#pragma unroll
                    for (int m = 0; m < 4; ++m) { const int r = ai * 128 + wr * 64 + m * 16 + fr; const f32x2 sr = S[r]; const size_t off = (size_t)(pm * 256 + r) * 2048 + c0 + bj * 128 + n * 16;
                        const f32x4 o = (acc[ai][bj][m][n] - sr[0]) * sr[1] * gg + bb; u32x2 w; w.x = cvt_pk_bf16(o[0], o[1]); w.y = cvt_pk_bf16(o[2], o[3]); *(u32x2*)(HBp + off) = w; } }
    } };
struct EpiResLn2 { static constexpr bool PERM = false, AFTER_DRAIN = true; const bf16_t* HBp; const float *bias, *lng, *lnb; float* out; const bf16_t* SGPW; PanelStats8 st;
    __device__ __forceinline__ void fused(AccT& acc, const GUnit& u, int wr, int wc, int fr, int fq, LAS unsigned char* lds, int wid) const {
        const int pm = u.i0, pn = u.i1; const int c0 = pn * 256 + wc * 32 + 4 * fq; const LAS f32x2* S = (const LAS f32x2*)(lds + 8192);
        const bf16_t* sgp = SGPW + (size_t)pm * (1u << 20);
        f32x4 bv[2][2];
#pragma unroll
        for (int bj = 0; bj < 2; ++bj)
#pragma unroll
            for (int n = 0; n < 2; ++n) bv[bj][n] = *(const f32x4*)(bias + c0 + bj * 128 + n * 16);
#pragma unroll
        for (int ai = 0; ai < 2; ++ai)
#pragma unroll
            for (int m = 0; m < 4; ++m) { const int r = ai * 128 + wr * 64 + m * 16 + fr; const size_t lo = (size_t)r * 2048 + c0; const bf16_t* hp = HBp + (size_t)(pm * 256 + r) * 2048 + c0;
#pragma unroll
                for (int bj = 0; bj < 2; ++bj)
#pragma unroll
                    for (int n = 0; n < 2; ++n) { const int co = bj * 128 + n * 16;
                        acc[ai][bj][m][n] += bv[bj][n] + DN_ALPHA * bf4(*(const u32x2*)(hp + co)) + bf4(*(const u32x2*)(sgp + lo + co)) * bf4(*(const u32x2*)(sgp + (1u << 19) + lo + co)); }
                asm volatile("" : "+v"(acc[ai][0][m][0]), "+v"(acc[ai][0][m][1]), "+v"(acc[ai][1][m][0]), "+v"(acc[ai][1][m][1])); }
        st.run(acc, pm, pn, wr, wc, fr, fq, lds, wid);
#pragma unroll
        for (int bj = 0; bj < 2; ++bj)
#pragma unroll
            for (int n = 0; n < 2; ++n) { const f32x4 gg = *(const f32x4*)(lng + c0 + bj * 128 + n * 16), bb = *(const f32x4*)(lnb + c0 + bj * 128 + n * 16);
#pragma unroll
                for (int ai = 0; ai < 2; ++ai)
#pragma unroll
                    for (int m = 0; m < 4; ++m) { const int r = ai * 128 + wr * 64 + m * 16 + fr; const f32x2 sr = S[r];
                        *(f32x4*)(out + (size_t)(pm * 256 + r) * 2048 + c0 + bj * 128 + n * 16) = (acc[ai][bj][m][n] - sr[0]) * sr[1] * gg + bb; } }
    } };
struct EpiG { static constexpr bool PERM = true, AFTER_DRAIN = false; bf16_t *G0, *G1; const float* bias;
    __device__ __forceinline__ void operator()(AccT& acc, const GUnit& u, int wr, int wc, int fr, int fq) const {
        const int pm = u.i0, h = u.i1; bf16_t* base = (pm < 16 ? G0 : G1) + (size_t)(pm & 15) * 256 * 4096 + h * 256;
        epi_bf16_store<0>(acc, base, 4096, bias + h * 256, wr, wc, fr, fq); } };
__device__ __forceinline__ float bfu(unsigned short v) { return __uint_as_float(((unsigned)v) << 16); }
__device__ __forceinline__ void rg_gate(float pa, float px, float spv, float xc, float& a, float& b) {
    const float r = fast_sigmoid(pa), ig = fast_sigmoid(px); const float la = spv * r; a = __expf(la); const float x = 2.0f * la;
    const float om = -x * (1.0f + x * (0.5f + x * (0.16666667f + x * (0.041666668f + x * 0.008333334f))));
    b = __builtin_amdgcn_sqrtf(fmaxf(om, 0.f)) * ig * xc; }
__device__ __forceinline__ void rg_gate2(float pa, float px, float spv, float xc, float& a, float& b, float& r) {
    r = fast_sigmoid(pa); const float ig = fast_sigmoid(px); const float la = spv * r; a = __expf(la); const float x = 2.0f * la;
    const float om = -x * (1.0f + x * (0.5f + x * (0.16666667f + x * (0.041666668f + x * 0.008333334f))));
    b = __builtin_amdgcn_sqrtf(fmaxf(om, 0.f)) * ig * xc; }
struct RgCtx { const bf16_t *XR, *G0, *G1, *Z; const float *convw, *convb, *sp; float* agg; bf16_t* ypre; };
__device__ __forceinline__ const bf16_t* g_row(const RgCtx& R, int t) { return (t < 4096 ? R.G0 : R.G1) + (size_t)(t & 4095) * 4096; }
__device__ __forceinline__ void rg_pass_a(const RgCtx& R, int half, int seg, int tid) {
    const int c = half * 512 + tid, gcol = (c >> 6) * 256 + (c & 63) * 4, t0 = seg * 64;
    const float w0 = R.convw[c], w1 = R.convw[1024 + c], w2 = R.convw[2048 + c], w3 = R.convw[3072 + c], cb = R.convb[c], sp0 = R.sp[c], sp1 = R.sp[1024 + c];
    const bf16_t* xp = R.XR + c;
    float x0 = bfu(xp[(size_t)(t0 + 0) * 1024]), x1 = bfu(xp[(size_t)(t0 + 1) * 1024]), x2 = bfu(xp[(size_t)(t0 + 2) * 1024]);
    float Af = 1.f, Bf = 0.f, Ab = 1.f, Bb = 0.f;
    for (int tb = 0; tb < 64; tb += 16) {
        u32x2 gq[16]; unsigned short xn[16];
#pragma unroll
        for (int i = 0; i < 16; ++i) { const int t = t0 + tb + i; gq[i] = *(const u32x2*)(g_row(R, t) + gcol); xn[i] = xp[(size_t)(t + 3) * 1024]; }
#pragma unroll
        for (int i = 0; i < 16; ++i) { const float x3 = bfu(xn[i]); const float xc = cb + w0 * x0 + w1 * x1 + w2 * x2 + w3 * x3; x0 = x1; x1 = x2; x2 = x3;
            float a, b, r0, r1, b0; rg_gate2(bf_lo(gq[i].x), bf_lo(gq[i].y), sp0, xc, a, b, r0); Bf = a * Bf + b; Af = a * Af; b0 = b;
            rg_gate2(bf_hi(gq[i].x), bf_hi(gq[i].y), sp1, xc, a, b, r1); Bb = Ab * b + Bb; Ab = Ab * a;
            u32x2 w; w.x = cvt_pk_bf16(r0, r1); w.y = cvt_pk_bf16(b0, b); *(u32x2*)((bf16_t*)g_row(R, t0 + tb + i) + gcol) = w; }
    }
    *(f32x2*)(R.agg + ((size_t)(seg * 2 + 0) * 1024 + c) * 2) = (f32x2){Af, Bf};
    *(f32x2*)(R.agg + ((size_t)(seg * 2 + 1) * 1024 + c) * 2) = (f32x2){Ab, Bb};
}
__device__ __forceinline__ void rg_pass_c(const RgCtx& R, int half, int seg, int tid, LAS float* Lh) {
    const int c = half * 512 + tid, gcol = (c >> 6) * 256 + (c & 63) * 4, t0 = seg * 64;
    const float sp0 = R.sp[c], sp1 = R.sp[1024 + c];
    const f32x2* ag = (const f32x2*)R.agg;
    float hf = 0.f, hb = 0.f;
    {
#pragma unroll 1
        for (int sb = 0; sb < 128; sb += 32) { f32x2 ab[32];
#pragma unroll
            for (int i = 0; i < 32; ++i) { const int s2 = sb + i; ab[i] = (s2 < seg) ? ag[(size_t)(s2 * 2 + 0) * 1024 + c] : (f32x2){1.f, 0.f}; }
#pragma unroll
            for (int i = 0; i < 32; ++i) hf = ab[i][0] * hf + ab[i][1]; }
#pragma unroll 1
        for (int sb = 96; sb >= 0; sb -= 32) { f32x2 ab[32];
#pragma unroll
            for (int i = 0; i < 32; ++i) { const int s2 = sb + 31 - i; ab[i] = (s2 > seg) ? ag[(size_t)(s2 * 2 + 1) * 1024 + c] : (f32x2){1.f, 0.f}; }
#pragma unroll
            for (int i = 0; i < 32; ++i) hb = ab[i][0] * hb + ab[i][1]; }
    }
    {
        for (int tb = 0; tb < 64; tb += 16) {
            u32x2 gq[16];
#pragma unroll
            for (int i = 0; i < 16; ++i) gq[i] = *(const u32x2*)(g_row(R, t0 + tb + i) + gcol);
#pragma unroll
            for (int i = 0; i < 16; ++i) { const float a = __expf(sp0 * bf_lo(gq[i].x)); hf = a * hf + bf_lo(gq[i].y); Lh[(tb + i) * 512 + tid] = hf; }
        }
    }
    {
        for (int tb = 48; tb >= 0; tb -= 16) {
            u32x2 gq[16]; unsigned short zz[16];
#pragma unroll
            for (int i = 0; i < 16; ++i) { const int t = t0 + tb + 15 - i; gq[i] = *(const u32x2*)(g_row(R, t) + gcol); zz[i] = R.Z[(size_t)t * 1024 + c]; }
#pragma unroll
            for (int i = 0; i < 16; ++i) { const int tl = tb + 15 - i; const float a = __expf(sp1 * bf_hi(gq[i].x)); hb = a * hb + bf_hi(gq[i].y);
                const float o = (Lh[tl * 512 + tid] + hb) * gelu_tanh(bfu(zz[i]));
                R.ypre[(size_t)(t0 + tl) * 2048 + 1024 + c] = (bf16_t)(cvt_pk_bf16(o, 0.f) & 0xffffu); }
        }
    }
}

#ifndef NAIVE_GEMM
#define NAIVE_GEMM 0
#endif
template <class Epi, class Sched>
__device__ __forceinline__ void gemm_phase_naive(LAS unsigned char* lds, const int wid, const GParm gp, const Sched& S, const Epi& E) {
    const int lane = fresh_lane(), tid = wid * 64 + lane, wr = wid >> 2, wc = wid & 3, fr = lane & 15, fq = lane >> 4;
    GUnit cur;
    for (int ui = 0; S.next(ui, cur); ++ui) {
        f32x4 acc[2][2][4][2];
#pragma unroll
        for (int ai = 0; ai < 2; ++ai)
#pragma unroll
            for (int bj = 0; bj < 2; ++bj)
#pragma unroll
                for (int m = 0; m < 4; ++m)
#pragma unroll
                    for (int n = 0; n < 2; ++n)
#pragma unroll
                        for (int e = 0; e < 4; ++e) {
                            const int row = 128 * ai + 64 * wr + 16 * m + fr; const int col = Epi::PERM ? (128 * bj + 32 * wc + 8 * fq + 4 * n + e) : (128 * bj + 32 * wc + 16 * n + 4 * fq + e);
                            const char* ap = cur.A + (size_t)row * gp.a_rs; const char* bp = cur.B + (size_t)col * gp.K * 2; float sum = 0.f;
                            for (int k = 0; k < gp.K; k += 8) { const int kt = k >> 6, C = k & 63;
                                const u32x4 av = *(const u32x4*)(ap + (size_t)kt * gp.a_ks + ((C / gp.a_cw) * gp.a_cs + (C % gp.a_cw)) * 2), bv = *(const u32x4*)(bp + k * 2);
                                sum += bf_lo(av.x) * bf_lo(bv.x) + bf_hi(av.x) * bf_hi(bv.x) + bf_lo(av.y) * bf_lo(bv.y) + bf_hi(av.y) * bf_hi(bv.y) + bf_lo(av.z) * bf_lo(bv.z) + bf_hi(av.z) * bf_hi(bv.z) + bf_lo(av.w) * bf_lo(bv.w) + bf_hi(av.w) * bf_hi(bv.w); }
                            acc[ai][bj][m][n][e] = sum; }
        if constexpr (Epi::AFTER_DRAIN) { __syncthreads(); E.fused(acc, cur, wr, wc, fr, fq, lds, wid); } else E(acc, cur, wr, wc, fr, fq);
    }
    __syncthreads();
}
#if NAIVE_GEMM
#define GEMM_PHASE gemm_phase_naive
#else
#define GEMM_PHASE pg8::gemm_phase
#endif
__device__ __forceinline__ void transpose_item(const float* W, int K, int N, bf16_t* WT, LAS float* scr, int item, int lane) {
    const int nblk = N / 64, kb = item / nblk, nb = item % nblk, k0 = 64 * kb, n0 = 64 * nb;
    const float* src = W + (size_t)k0 * N + n0 + lane;
#pragma unroll 32
    for (int i = 0; i < 64; ++i) scr[i * 65 + lane] = src[(size_t)i * N];
    LDS_WAIT();
    const int c = lane & 7;
#pragma unroll
    for (int j = 0; j < 8; ++j) { const int n = (lane >> 3) + 8 * j; const LAS float* sp = scr + (8 * c) * 65 + n;
        u32x4 o; o.x = cvt_pk_bf16(sp[0 * 65], sp[1 * 65]); o.y = cvt_pk_bf16(sp[2 * 65], sp[3 * 65]); o.z = cvt_pk_bf16(sp[4 * 65], sp[5 * 65]); o.w = cvt_pk_bf16(sp[6 * 65], sp[7 * 65]);
        *(u32x4*)(WT + (size_t)(n0 + n) * K + k0 + 8 * c) = o; }
    LDS_WAIT();
}
template <bool OUT_BF16> __device__ __forceinline__ void ln_row(const float* xrow, const float* g, const float* b, void* orow, int lane) {
    const f32x4* xr = (const f32x4*)xrow + lane; f32x4 v[8]; float s = 0.f;
#pragma unroll
    for (int j = 0; j < 8; ++j) { v[j] = xr[64 * j]; s += (v[j][0] + v[j][1]) + (v[j][2] + v[j][3]); }
    const float mean = wave_sum(s) * (1.f / DM); float s2 = 0.f;
#pragma unroll
    for (int j = 0; j < 8; ++j) { v[j] = v[j] - mean; s2 += (v[j][0] * v[j][0] + v[j][1] * v[j][1]) + (v[j][2] * v[j][2] + v[j][3] * v[j][3]); }
    const float rstd = 1.0f / sqrtf(wave_sum(s2) * (1.f / DM) + LN_EPS);
#pragma unroll
    for (int j = 0; j < 8; ++j) { const f32x4 gg = ((const f32x4*)g)[lane + 64 * j], bb = ((const f32x4*)b)[lane + 64 * j]; const f32x4 o = v[j] * rstd * gg + bb;
        if (OUT_BF16) { u32x2 w; w.x = cvt_pk_bf16(o[0], o[1]); w.y = cvt_pk_bf16(o[2], o[3]); ((u32x2*)orow)[lane + 64 * j] = w; }
        else ((f32x4*)orow)[lane + 64 * j] = o; }
}
__device__ __forceinline__ void cpow(float lrs, float th, int j, float& re, float& im) {
    double a = (double)j * (double)th * 0.15915494309189535; a -= rint(a); const float af = 2.0f * (float)a;
    const float mag = expf((float)j * lrs); re = mag * cospif(af); im = mag * sinpif(af);
}


#ifndef NAIVE_RG
#define NAIVE_RG 0
#endif
__device__ __forceinline__ void naive_rg_channel(const RgCtx& R, int c) {
    const int gcol = (c >> 6) * 256 + (c & 63);
    const float w0 = R.convw[c], w1 = R.convw[1024 + c], w2 = R.convw[2048 + c], w3 = R.convw[3072 + c], cb = R.convb[c], sp0 = R.sp[c], sp1 = R.sp[1024 + c];
    const bf16_t* xp = R.XR + c; float h = 0.f;
    for (int t = 0; t < SEQ; ++t) { const float xc = cb + w0 * bfu(xp[(size_t)t * 1024]) + w1 * bfu(xp[(size_t)(t + 1) * 1024]) + w2 * bfu(xp[(size_t)(t + 2) * 1024]) + w3 * bfu(xp[(size_t)(t + 3) * 1024]);
        const bf16_t* g = g_row(R, t) + gcol; float a, b; rg_gate(bfu(g[0]), bfu(g[128]), sp0, xc, a, b); h = a * h + b;
        R.ypre[(size_t)t * 2048 + 1024 + c] = (bf16_t)(cvt_pk_bf16(h, 0.f) & 0xffffu); }
    __builtin_amdgcn_fence(__ATOMIC_SEQ_CST, "agent");
    h = 0.f;
    for (int t = SEQ - 1; t >= 0; --t) { const float xc = cb + w0 * bfu(xp[(size_t)t * 1024]) + w1 * bfu(xp[(size_t)(t + 1) * 1024]) + w2 * bfu(xp[(size_t)(t + 2) * 1024]) + w3 * bfu(xp[(size_t)(t + 3) * 1024]);
        const bf16_t* g = g_row(R, t) + gcol; float a, b; rg_gate(bfu(g[64]), bfu(g[192]), sp1, xc, a, b); h = a * h + b;
        const size_t o = (size_t)t * 2048 + 1024 + c; const float y = (bfu(R.ypre[o]) + h) * gelu_tanh(bfu(R.Z[(size_t)t * 1024 + c]));
        R.ypre[o] = (bf16_t)(cvt_pk_bf16(y, 0.f) & 0xffffu); }
}

#ifndef NAIVE_S5
#define NAIVE_S5 0
#endif
__device__ __forceinline__ void naive_s5_group(const float* const* in, const bf16_t* U, float* tmp, bf16_t* YG, int g, int lane) {
    const float *lre = in[6], *lim = in[7], *lstep = in[8], *bre = in[9], *bim = in[10], *cre = in[11], *cim = in[12], *dd = in[13];
    for (int n = 0; n < 2; ++n) {
        const int p = lane, pi = (n * 64 + g) * 64 + p;
        const float lr = fminf(lre[pi], -1e-4f), li = lim[pi], step = expf(lstep[n * 64 + g]); float ar, ai; cpow(lr * step, li * step, 1, ar, ai);
        const float nr = ar - 1.0f, ni = ai, den = lr * lr + li * li; const float qr = (nr * lr + ni * li) / den, qi = (ni * lr - nr * li) / den;
        float hr = 0.f, hi = 0.f;
        for (int tt = 0; tt < SEQ; ++tt) { const int t = n == 0 ? tt : SEQ - 1 - tt; const bf16_t* up = U + (size_t)t * 1024 + g * 16;
            float bur = 0.f, bui = 0.f;
#pragma unroll
            for (int k = 0; k < 16; ++k) { const float uv = bfu(up[k]); const float br = bre[(size_t)pi * 16 + k], bi = bim[(size_t)pi * 16 + k]; bur += (qr * br - qi * bi) * uv; bui += (qr * bi + qi * br) * uv; }
            const float nhr = ar * hr - ai * hi + bur, nhi = ar * hi + ai * hr + bui; hr = nhr; hi = nhi;
#pragma unroll
            for (int k = 0; k < 16; ++k) { const size_t ci = ((size_t)(n * 64 + g) * 16 + k) * 64 + p; float v = cre[ci] * hr - cim[ci] * hi; v = wave_sum(v);
                if (lane == k) { const size_t o = (size_t)t * 1024 + g * 16 + k;
                    if (n == 0) tmp[o] = v; else { const float y = tmp[o] + v + dd[g * 16 + k] * bfu(up[k]); YG[o] = (bf16_t)(cvt_pk_bf16(gelu_tanh(y), 0.f) & 0xffffu); } } }
        }
        __builtin_amdgcn_fence(__ATOMIC_SEQ_CST, "agent");
    }
}

#define XB_TMO      128
#define XB_XCNT(j)  (256  + 64 * (j))
#define XB_XSUB(j)  (1280 + 64 * (j))
#define XB_XGEN(j)  (2304 + 64 * (j))
#define XB_TOP      3328
#define XB_TOPGEN   3392
#define XCD_BAR_WORDS 3456
#define XB_SPIN_CAP (1u << 18)
__device__ __forceinline__ unsigned xb_ld(unsigned* p)              { return __hip_atomic_load(p, __ATOMIC_RELAXED, __HIP_MEMORY_SCOPE_AGENT); }
__device__ __forceinline__ unsigned xb_add(unsigned* p, unsigned v) { return __hip_atomic_fetch_add(p, v, __ATOMIC_RELAXED, __HIP_MEMORY_SCOPE_AGENT); }
__device__ __forceinline__ unsigned xb_xcc_id() { return (unsigned)__builtin_amdgcn_s_getreg((3 << 11) | 20) & 0xFu; }
#define XB_SPIN(cond, bar) do { unsigned _sp = 0; while (cond) { __builtin_amdgcn_s_sleep(1); \
    if ((++_sp & 255u) == 0u) { if (xb_ld(&(bar)[XB_TMO])) break; if (_sp > XB_SPIN_CAP) { atomicAdd(&(bar)[XB_TMO], 1u); break; } } } } while (0)
struct XcdBarrier { unsigned* bar; unsigned x; volatile LAS unsigned* st; };
__device__ __forceinline__ void xcd_barrier_complete(unsigned* bar, unsigned x, unsigned G, unsigned& nloc, unsigned& nx) {
    unsigned sum, cnt, mine, sp = 0u;
    for (;;) {
        sum = 0u; cnt = 0u; mine = 0u;
#pragma unroll
        for (unsigned j = 0; j < 16; ++j) { const unsigned c = xb_ld(&bar[XB_XCNT(j)]); sum += c; cnt += (c > 0u) ? 1u : 0u; mine = (j == x) ? c : mine; }
        if (sum == G) break;
        __builtin_amdgcn_s_sleep(1);
        if ((++sp & 255u) == 0u) { if (xb_ld(&bar[XB_TMO])) break; if (sp > XB_SPIN_CAP) { atomicAdd(&bar[XB_TMO], 1u); break; } }
    }
    nloc = mine > 0u ? mine : 1u; nx = cnt > 0u ? cnt : 1u;
}
__device__ __forceinline__ void xcd_barrier(const XcdBarrier& b, unsigned G, int wave) {
    asm volatile("s_waitcnt vmcnt(0)" ::: "memory");
    __syncthreads();
    if (wave == 0) { if (fresh_lane() == 0) {
        unsigned* bar = b.bar;
        __builtin_amdgcn_s_waitcnt(0);
        unsigned nloc = b.st[0], nx = b.st[1];
        if (nloc == 0u) { xcd_barrier_complete(bar, b.x, G, nloc, nx); b.st[0] = nloc; b.st[1] = nx; }
        const unsigned old = xb_add(&bar[XB_XSUB(b.x)], 1u);
        const unsigned gen = old / nloc;
        if (old + 1u == (gen + 1u) * nloc) {
            __builtin_amdgcn_fence(__ATOMIC_RELEASE, "agent");
            asm volatile("s_waitcnt vmcnt(0)" ::: "memory");
            const unsigned og = xb_add(&bar[XB_TOP], 1u);
            const unsigned tg = og / nx;
            if (og + 1u == (tg + 1u) * nx) xb_add(&bar[XB_TOPGEN], 1u);
            else XB_SPIN(xb_ld(&bar[XB_TOPGEN]) == tg, bar);
            __builtin_amdgcn_fence(__ATOMIC_ACQUIRE, "agent");
            xb_add(&bar[XB_XGEN(b.x)], 1u);
            asm volatile("s_waitcnt vmcnt(0)" ::: "memory");
        } else {
            XB_SPIN(xb_ld(&bar[XB_XGEN(b.x)]) == gen, bar);
            __builtin_amdgcn_fence(__ATOMIC_ACQUIRE, "agent");
            asm volatile("s_waitcnt vmcnt(0)" ::: "memory");
        }
    } }
    __syncthreads();
}

__device__ __forceinline__ void grid_barrier(unsigned* bar, unsigned target, int wave) {
    asm volatile("s_waitcnt vmcnt(0)" ::: "memory");
    __syncthreads();
    if (wave == 0) { const int l = fresh_lane();
        if (l == 0) {
            __builtin_amdgcn_fence(__ATOMIC_RELEASE, "agent"); asm volatile("s_waitcnt vmcnt(0)" ::: "memory");
            __hip_atomic_fetch_add(bar, 1u, __ATOMIC_RELAXED, __HIP_MEMORY_SCOPE_AGENT);
            while (__hip_atomic_load(bar, __ATOMIC_RELAXED, __HIP_MEMORY_SCOPE_AGENT) < target) __builtin_amdgcn_s_sleep(2);
            __builtin_amdgcn_fence(__ATOMIC_ACQUIRE, "agent"); asm volatile("s_waitcnt vmcnt(0)" ::: "memory");
        } }
    __syncthreads();
}

struct Args { const float* in[38]; float* out; unsigned char* ws; int ph_lo, ph_hi; };
typedef const float* cfp_t;
typedef const __attribute__((address_space(4))) cfp_t* kin_t;

__device__ __forceinline__ void s5_precompute(const kin_t ain, unsigned char* aws, int g, int hq, int nh, LAS float* L, const int tid) {
    const float *lre = ain[6], *lim = ain[7], *lstep = ain[8], *bre = ain[9], *bim = ain[10], *cre = ain[11], *cim = ain[12], *dd = ain[13];
    LAS float *PWre = L, *PWim = L + 4224, *BBre = L + 8448, *BBim = L + 10496, *CCre = L + 12544, *CCim = L + 14592, *MT = L + 16640, *C2re = L + 33280, *C2im = L + 35328, *Dl = L + 37376;
    bf16_t* WGg = (bf16_t*)(aws + WS_WG) + (size_t)g * 768 * 512; bf16_t* WCg = (bf16_t*)(aws + WS_WC) + (size_t)g * 512 * 256;
#define PSTAMP(i) do { if (TSTAMP && blockIdx.x == 128 && tid == 0) ((unsigned long long*)(aws + WS_CTR + 1024))[i] = __builtin_amdgcn_s_memrealtime(); } while (0)
    PSTAMP(20);
    {
        const int np = tid & 127, jj = tid >> 7, n = np >> 6, p = np & 63; const int pi = (n * 64 + g) * 64 + p;
        const float lr = fminf(lre[pi], -1e-4f), li = lim[pi], step = expf(lstep[n * 64 + g]); const float lrs = lr * step, th = li * step;
        for (int j = jj; j <= 32; j += 4) { float r, i; cpow(lrs, th, j, r, i); PWre[np * 33 + j] = r; PWim[np * 33 + j] = i; }
        float l1r, l1i; cpow(lrs, th, 1, l1r, l1i);
        const float nr = l1r - 1.0f, ni = l1i, den = lr * lr + li * li; const float qr = (nr * lr + ni * li) / den, qi = (ni * lr - nr * li) / den;
#pragma unroll
        for (int k = jj * 4; k < jj * 4 + 4; ++k) { const float br = bre[(size_t)pi * 16 + k], bi = bim[(size_t)pi * 16 + k]; BBre[np * 16 + k] = qr * br - qi * bi; BBim[np * 16 + k] = qr * bi + qi * br; }
        for (int e = tid; e < 2048; e += 512) { const int n2 = e >> 10, k = (e >> 6) & 15, p2 = e & 63; const size_t ci = ((size_t)(n2 * 64 + g) * 16 + k) * 64 + p2; CCre[(n2 * 64 + p2) * 16 + k] = cre[ci]; CCim[(n2 * 64 + p2) * 16 + k] = cim[ci]; C2re[e] = cre[ci]; C2im[e] = cim[ci]; }
        if (tid < 16) Dl[tid] = dd[g * 16 + tid];
    }
    __syncthreads();
    PSTAMP(21);
    for (int i = 0; i < 3; ++i) {
        if (nh == 2) { if (i < 2 && i != hq) continue; if (i == 2 && (hq != 0 || tid >= 16)) continue; } else if (i == 2) continue;
        const int bq = (i == 2) ? 512 + tid : tid + 512 * i, n = bq >> 9, j = (bq >> 4) & 31, kob = (bq >> 2) & 3, kib = bq & 3;
        f32x4 m0 = {0.f, 0.f, 0.f, 0.f}, m1 = m0, m2 = m0, m3 = m0;
        for (int p = 0; p < 64; ++p) { const int np = n * 64 + p; const float pr = PWre[np * 33 + j], pi2 = PWim[np * 33 + j];
            const f32x4 br = *(const LAS f32x4*)(BBre + np * 16 + 4 * kib), bi = *(const LAS f32x4*)(BBim + np * 16 + 4 * kib), cr = *(const LAS f32x4*)(CCre + np * 16 + 4 * kob), ci = *(const LAS f32x4*)(CCim + np * 16 + 4 * kob);
            const f32x4 er = pr * br - pi2 * bi, ei = pr * bi + pi2 * br;
            m0 += cr[0] * er - ci[0] * ei; m1 += cr[1] * er - ci[1] * ei; m2 += cr[2] * er - ci[2] * ei; m3 += cr[3] * er - ci[3] * ei; }
        LAS float* o = MT + (n * 32 + j) * 260 + (4 * kob) * 16 + 4 * kib;
        *(LAS f32x4*)o = m0; *(LAS f32x4*)(o + 16) = m1; *(LAS f32x4*)(o + 32) = m2; *(LAS f32x4*)(o + 48) = m3;
    }
    __syncthreads();
    PSTAMP(22);
    for (int i = 0; i < 64; ++i) {
        const int idx = tid + 512 * i, row = idx >> 6, cp = idx & 63, t = row >> 4, ko = row & 15, s = cp >> 1, ki0 = (cp & 1) * 8;
        if (nh == 2 && ((t >= s) != (hq == 0))) continue;
        f32x4 v0, v1;
        if (t != s) { const LAS float* src = MT + ((t > s ? 0 : 1) * 32 + (t > s ? t - s : s - t)) * 260 + ko * 16 + ki0; v0 = *(const LAS f32x4*)src; v1 = *(const LAS f32x4*)(src + 4); }
        else { const LAS float* s0 = MT + ko * 16 + ki0; const LAS float* s1 = MT + 32 * 260 + ko * 16 + ki0; v0 = *(const LAS f32x4*)s0 + *(const LAS f32x4*)s1; v1 = *(const LAS f32x4*)(s0 + 4) + *(const LAS f32x4*)(s1 + 4);
            const float dv = Dl[ko];
#pragma unroll
            for (int e = 0; e < 4; ++e) { if (ki0 + e == ko) v0[e] += dv; if (ki0 + 4 + e == ko) v1[e] += dv; } }
        u32x4 w; w.x = cvt_pk_bf16(v0[0], v0[1]); w.y = cvt_pk_bf16(v0[2], v0[3]); w.z = cvt_pk_bf16(v1[0], v1[1]); w.w = cvt_pk_bf16(v1[2], v1[3]);
        *(u32x4*)(WGg + (size_t)row * 512 + cp * 8) = w;
    }
    for (int i = hq * (32 / nh); i < (hq + 1) * (32 / nh); ++i) {
        const int idx = tid + 512 * i, q = idx >> 6, cp = idx & 63, n = q >> 7, ri = (q >> 6) & 1, p = q & 63, s = cp >> 1, ki0 = (cp & 1) * 8, e = n == 0 ? 31 - s : s, np = n * 64 + p;
        const float pr = PWre[np * 33 + e], pi2 = PWim[np * 33 + e]; float v[8];
#pragma unroll
        for (int k = 0; k < 8; ++k) { const float br = BBre[np * 16 + ki0 + k], bi = BBim[np * 16 + ki0 + k]; v[k] = ri == 0 ? pr * br - pi2 * bi : pr * bi + pi2 * br; }
        u32x4 w; w.x = cvt_pk_bf16(v[0], v[1]); w.y = cvt_pk_bf16(v[2], v[3]); w.z = cvt_pk_bf16(v[4], v[5]); w.w = cvt_pk_bf16(v[6], v[7]);
        *(u32x4*)(WGg + (size_t)(512 + q) * 512 + cp * 8) = w;
    }
    for (int i = 0; i < 32 / nh; ++i) {
        const int idx = tid + 512 * i, row = nh == 2 ? idx >> 4 : idx >> 5, q0 = nh == 2 ? hq * 128 + (idx & 15) * 8 : (idx & 31) * 8, n = q0 >> 7, ri = (q0 >> 6) & 1, p0 = q0 & 63, t = row >> 4, ko = row & 15, e = n == 0 ? t + 1 : 32 - t; float v[8];
#pragma unroll
        for (int k = 0; k < 8; ++k) { const int np = n * 64 + p0 + k; const float cr = C2re[(n * 16 + ko) * 64 + p0 + k], ci = C2im[(n * 16 + ko) * 64 + p0 + k], pr = PWre[np * 33 + e], pi2 = PWim[np * 33 + e];
            v[k] = ri == 0 ? cr * pr - ci * pi2 : -(cr * pi2 + ci * pr); }
        u32x4 w; w.x = cvt_pk_bf16(v[0], v[1]); w.y = cvt_pk_bf16(v[2], v[3]); w.z = cvt_pk_bf16(v[4], v[5]); w.w = cvt_pk_bf16(v[6], v[7]);
        *(u32x4*)(WCg + (size_t)row * 256 + q0) = w;
    }
    __syncthreads();
    PSTAMP(23);
}


#ifndef DIAG
#define DIAG 0
#endif
__device__ __forceinline__ void diag_ffn(const float* const* in, const unsigned char* ws, const float* outp, unsigned* flagw, int gtid, int GT) {
    const bf16_t* h1 = (const bf16_t*)(ws + WS_HB); const bf16_t* T = (const bf16_t*)(ws + WS_T); const float* V2 = (const float*)(ws + WS_V2);
    const float *w1 = in[29], *b1 = in[30], *w2 = in[31], *b2 = in[32], *wp = in[33], *wg = in[34], *bg = in[35], *pp = in[1];
    for (int sidx = gtid; sidx < 16384; sidx += GT) {
        unsigned hsh = (unsigned)sidx * 2654435761u, h2 = ((unsigned)sidx + 977u) * 2246822519u; const int r = (hsh >> 8) % SEQ; const int c = (h2 >> 6) % DFF; const int c2 = c % DM;
        float a = b1[c]; for (int k = 0; k < DM; ++k) a += bfu(h1[(size_t)r * DM + k]) * w1[(size_t)k * DFF + c];
        a = fmaxf(a, 0.f); a = a * a; const float tv = bfu(T[(size_t)r * DFF + c]);
        if (fabsf(tv - a) > 0.008f * fabsf(a) + 0.006f) atomicAdd(flagw + 0, 1u);
        float f = b2[c2]; for (int k = 0; k < DFF; ++k) f += bfu(T[(size_t)r * DFF + k]) * w2[(size_t)k * DM + c2];
        float gt = bg[c2]; for (int k = 0; k < DM; ++k) gt += bfu(h1[(size_t)r * DM + k]) * wg[(size_t)k * DM + c2];
        float pw = 0.f; for (int k = 0; k < PLE; ++k) pw += pp[(size_t)r * PLE + k] * wp[(size_t)k * DM + c2];
        const float v2 = DN_ALPHA * bfu(h1[(size_t)r * DM + c2]) + f + fast_sigmoid(gt) * pw; const float got = V2[(size_t)r * DM + c2];
        if (fabsf(got - v2) > 0.008f * fabsf(v2) + 0.006f) atomicAdd(flagw + 1, 1u);
        { const float* vr = V2 + (size_t)r * DM; float m = 0.f; for (int k = 0; k < DM; ++k) m += vr[k]; m /= DM; float v = 0.f; for (int k = 0; k < DM; ++k) { const float d = vr[k] - m; v += d * d; } v /= DM;
          const float e = (vr[c2] - m) / sqrtf(v + LN_EPS) * in[36][c2] + in[37][c2]; const float go = outp[(size_t)r * DM + c2]; if (fabsf(go - e) > 0.004f * fabsf(e) + 0.003f) atomicAdd(flagw + 2, 1u); }
    }
}

__device__ __forceinline__ void diag_pre(const float* const* in, const unsigned char* ws, const unsigned char* dout, unsigned* flagw, int gtid, int GT) {
    const bf16_t* h0 = (const bf16_t*)(ws + WS_HB); const bf16_t* U = (const bf16_t*)(dout + DO_U); const bf16_t* XRb = (const bf16_t*)(ws + WS_XR) + 2048; const bf16_t* Z = (const bf16_t*)(dout + DO_Z);
    const bf16_t* ypre = (const bf16_t*)(dout + DO_YPRE); const bf16_t* ycat = (const bf16_t*)(ws + WS_YCAT); const bf16_t* yg = (const bf16_t*)(ws + WS_YS5G);
    const float *x = in[0], *lg = in[2], *lb = in[3], *win = in[4], *bin = in[5], *gw_ = in[14], *gb = in[15], *g5 = in[23], *gr = in[24];
    for (int sidx = gtid; sidx < 8192; sidx += GT) {
        unsigned hsh = (unsigned)sidx * 2654435761u, h2 = ((unsigned)sidx + 977u) * 2246822519u; const int r = (hsh >> 8) % SEQ; const int c = (h2 >> 6) % DIN; const int c2 = c % DM; const int c1 = c % DS5;
        { float m = 0.f; for (int k = 0; k < DM; ++k) m += x[(size_t)r * DM + k]; m /= DM; float v = 0.f; for (int k = 0; k < DM; ++k) { const float d = x[(size_t)r * DM + k] - m; v += d * d; } v /= DM;
          const float e = (x[(size_t)r * DM + c2] - m) / sqrtf(v + LN_EPS) * lg[c2] + lb[c2]; const float got = bfu(h0[(size_t)r * DM + c2]); if (fabsf(got - e) > 0.008f * fabsf(e) + 0.006f) atomicAdd(flagw + 0, 1u); }
        { float a = bin[c]; for (int k = 0; k < DM; ++k) a += bfu(h0[(size_t)r * DM + k]) * win[(size_t)k * DIN + c];
          const float got = c < 1024 ? bfu(U[(size_t)r * 1024 + c]) : (c < 2048 ? bfu(XRb[(size_t)r * 1024 + c - 1024]) : bfu(Z[(size_t)r * 1024 + c - 2048])); if (fabsf(got - a) > 0.008f * fabsf(a) + 0.006f) atomicAdd(flagw + 3, 1u); }
        { const int hf = c2 >> 10; float ss = 0.f; for (int k = 0; k < 1024; ++k) { const float y = bfu(ypre[(size_t)r * DM + hf * 1024 + k]); ss += y * y; }
          const float e = bfu(ypre[(size_t)r * DM + c2]) / sqrtf(ss / 1024.f + LN_EPS) * (hf ? gr[c2 - 1024] : g5[c2]); const float got = bfu(ycat[(size_t)r * DM + c2]); if (fabsf(got - e) > 0.008f * fabsf(e) + 0.006f) atomicAdd(flagw + 1, 1u); }
        { float a = gb[c1]; for (int k = 0; k < DS5; ++k) a += bfu(yg[(size_t)r * DS5 + k]) * gw_[(size_t)k * DS5 + c1];
          const float e = bfu(yg[(size_t)r * DS5 + c1]) * fast_sigmoid(a); const float got = bfu(ypre[(size_t)r * DM + c1]); if (fabsf(got - e) > 0.008f * fabsf(e) + 0.006f) atomicAdd(flagw + 2, 1u); }
    }
}

__device__ __forceinline__ void diag_v(const float* const* in, const unsigned char* ws, const unsigned char* dout, unsigned* flagw, int gtid, int GT) {
    const bf16_t* h0 = (const bf16_t*)(ws + WS_HB); const bf16_t* ycat = (const bf16_t*)(ws + WS_YCAT); const float* V = (const float*)dout; const float *wo = in[25], *bo = in[26];
    for (int sidx = gtid; sidx < 16384; sidx += GT) { unsigned hsh = (unsigned)sidx * 2654435761u, h2 = ((unsigned)sidx + 977u) * 2246822519u; const int r = (hsh >> 8) % SEQ; const int c = (h2 >> 6) % DM;
        float a = bo[c] + DN_ALPHA * bfu(h0[(size_t)r * DM + c]); for (int k = 0; k < DM; ++k) a += bfu(ycat[(size_t)r * DM + k]) * wo[(size_t)k * DM + c];
        const float got = V[(size_t)r * DM + c]; if (fabsf(got - a) > 0.008f * fabsf(a) + 0.006f) atomicAdd(flagw + 0, 1u); }
}

__device__ __forceinline__ void diag_g(const float* const* in, const unsigned char* ws, unsigned* flagw, int gtid, int GT) {
    const bf16_t* XRp = (const bf16_t*)(ws + WS_XR); const bf16_t* G0 = (const bf16_t*)(ws + WS_G0); const bf16_t* G1 = (const bf16_t*)(ws + WS_G1);
    const float *convw = in[16], *convb = in[17], *wa = in[18], *ba = in[19], *wx = in[20], *bxx = in[21];
    for (int sidx = gtid; sidx < 16384; sidx += GT) { unsigned hsh = (unsigned)sidx * 2654435761u; unsigned h2 = ((unsigned)sidx + 12345u) * 2246822519u; const int t = (hsh >> 7) % SEQ; const int col = (h2 >> 5) % 4096;
        const int h = col >> 8, row = col & 255, bj = row >> 7, dir = (row >> 6) & 1, ch = row & 63;
        const float* W = (bj == 0 ? wa : wx) + ((size_t)(dir * 16 + h) * 64) * 64 + ch; float a = (bj == 0 ? ba : bxx)[(dir * 16 + h) * 64 + ch];
        for (int i = 0; i < 64; ++i) { const int c = 64 * h + i; float xc = convb[c];
            for (int j = 0; j < 4; ++j) xc += convw[j * 1024 + c] * bfu(XRp[(size_t)(t + j) * 1024 + c]);
            a += xc * W[(size_t)i * 64]; }
        const float got = bfu((t < 4096 ? G0 : G1)[(size_t)(t & 4095) * 4096 + col]);
        if (fabsf(got - a) > 0.008f * fabsf(a) + 0.006f) atomicAdd(flagw + 0, 1u); }
}

#ifndef DIAG_HALF
#define DIAG_HALF 1
#endif
__device__ __forceinline__ void diag_max(const unsigned char* ws, unsigned* flagw, int gtid, int GT) {
    const bf16_t* ycat = (const bf16_t*)(ws + WS_YCAT); float mx = 0.f;
    for (size_t i = gtid; i < (size_t)SEQ * 1024; i += GT) { const size_t r = i >> 10, c = (i & 1023) + DIAG_HALF * 1024; mx = fmaxf(mx, fabsf(bfu(ycat[r * DM + c]))); }
    atomicMax(flagw + 0, __float_as_uint(mx));
}

#ifndef DIAG_SEL
#define DIAG_SEL 4
#endif
__device__ __forceinline__ void diag_rows(const float* outp, unsigned* flagw, int gw, int NGW, int lane) {
    for (int row = gw; row < SEQ; row += NGW) { float mx = 0.f; for (int j = lane; j < DM; j += 64) mx = fmaxf(mx, fabsf(outp[(size_t)row * DM + j]));
#pragma unroll
        for (int o = 1; o < 64; o <<= 1) mx = fmaxf(mx, __shfl_xor(mx, o));
        if (lane == 0 && mx > 12.0f) { atomicAdd(flagw + 0, 1u); atomicMin(flagw + 1, (unsigned)row); atomicMax(flagw + 2, (unsigned)row); } }
}

__device__ __forceinline__ void diag_rows_bf(const bf16_t* p, int ld, float thr, unsigned* flagw, int gw, int NGW, int lane) {
    for (int row = gw; row < SEQ; row += NGW) { float mx = 0.f; for (int j = lane; j < ld; j += 64) mx = fmaxf(mx, fabsf(bfu(p[(size_t)row * ld + j])));
#pragma unroll
        for (int o = 1; o < 64; o <<= 1) mx = fmaxf(mx, __shfl_xor(mx, o));
        if (lane == 0 && mx > thr) { atomicAdd(flagw + 0, 1u); atomicMin(flagw + 1, (unsigned)row); atomicMax(flagw + 2, (unsigned)row); } }
}
template <int PHMASK> __global__ void __launch_bounds__(512, 2) mega(Args) {
    extern __shared__ __attribute__((aligned(16))) unsigned char lds_raw[];
    LAS unsigned char* lds = (LAS unsigned char*)lds_raw;
    const int wave = __builtin_amdgcn_readfirstlane((int)threadIdx.x >> 6);
    const int G = gridDim.x, bx = blockIdx.x;
    const int gw = bx * 8 + wave, NGW = G * 8, GT = G * 512;
#define PH_IDS const int lane = fresh_lane(), tid = wave * 64 + lane, gtid = bx * 512 + tid; (void)tid; (void)gtid; (void)lane
    const kin_t KIN = (kin_t)__builtin_amdgcn_kernarg_segment_ptr();
    unsigned char* ws = (unsigned char*)KIN[39]; unsigned char* dout = (unsigned char*)KIN[38];
    const int* kint = (const int*)0; (void)kint;
#if DIAG == 2
    const int lo = ((const __attribute__((address_space(4))) int*)KIN)[80], hi = 7;
#elif DIAG == 3
    const int lo = ((const __attribute__((address_space(4))) int*)KIN)[80], hi = 8;
#elif DIAG == 4
    const int lo = ((const __attribute__((address_space(4))) int*)KIN)[80], hi = 5;
#elif DIAG == 6
    const int lo = ((const __attribute__((address_space(4))) int*)KIN)[80], hi = 7;
#elif DIAG == 8
    const int lo = ((const __attribute__((address_space(4))) int*)KIN)[80], hi = 9;
#elif DIAG == 11 || DIAG == 12
    const int lo = ((const __attribute__((address_space(4))) int*)KIN)[80], hi = 10;
#else
    const int lo = ((const __attribute__((address_space(4))) int*)KIN)[80], hi = ((const __attribute__((address_space(4))) int*)KIN)[81];
#endif
#define IN(k) (((PHMASK >> (k)) & 1) && lo <= (k) && (k) < hi)
    unsigned nbar = 0; unsigned* gbar = (unsigned*)(ws + WS_CTR) + 32; (void)gbar;
    XcdBarrier xb; xb.bar = (unsigned*)(ws + WS_CTR) + 5120; xb.x = xb_xcc_id(); xb.st = (volatile LAS unsigned*)(lds + 155000);
    if (wave == 0) { if (fresh_lane() == 0) { xb.st[0] = 0u; xb.st[1] = 0u; (void)xb_add(&xb.bar[XB_XCNT(xb.x)], 1u); } }
    __syncthreads();
    if (PHMASK == 0xfff && hi > 4096) cg::this_grid().sync();
#ifndef DBL_MASK
#define DBL_MASK 0
#endif
#define REPS(k) (((DBL_MASK >> (k)) & 1) ? 2 : 1)
#define SEAM(k) do { if (IN(k) && IN((k) + 1)) { ++nbar; xcd_barrier(xb, (unsigned)G, wave); if (TSTAMP && bx == 0 && wave == 0) { if (fresh_lane() == 0) ((unsigned long long*)(ws + WS_CTR + 1024))[(k) + 1] = __builtin_amdgcn_s_memrealtime(); } } } while (0)

#define MK_RG const RgCtx RG{(const bf16_t*)(ws + WS_XR), (const bf16_t*)(ws + WS_G0), (const bf16_t*)(ws + WS_G1), (const bf16_t*)(dout + DO_Z), KIN[16], KIN[17], (const float*)(ws + WS_SP), (float*)(ws + WS_AGG), (bf16_t*)(dout + DO_YPRE)}
    if (TSTAMP && bx == 0 && wave == 0) { if (fresh_lane() == 0) ((unsigned long long*)(ws + WS_CTR + 1024))[0] = __builtin_amdgcn_s_memrealtime(); }
    for (int rep = 0; rep < REPS(0); ++rep) {
    if (IN(0)) { PH_IDS;
        if (G != 256) { for (int g = bx; g < 64; g += G) s5_precompute(KIN, ws, g, 0, 1, (LAS float*)lds, tid); }
        {
            LAS float* scr = (LAS float*)(lds + wave * 16640);
            constexpr int I_IN = (DM / 64) * (DIN / 64), I_OUT = (DM / 64) * (DM / 64), I_PG = I_OUT, I_GLU = (DS5 / 64) * (DS5 / 64), I_PW = (PLE / 64) * (DM / 64), I_LN = SEQ / 8;
            constexpr int NITEMS = I_IN + I_OUT + I_PG + I_GLU + I_PW + I_LN;
            for (int it = gw; it < NITEMS; it += NGW) {
                int r = it;
                if (r < I_IN) { transpose_item(KIN[4], DM, DIN, (bf16_t*)(ws + WS_WINT), scr, r, lane); continue; } r -= I_IN;
                if (r < I_LN) { for (int q = 0; q < 8; ++q) { const int row = r * 8 + q; ln_row<true>(KIN[0] + (size_t)row * DM, KIN[2], KIN[3], (bf16_t*)(ws + WS_HB) + (size_t)row * DM, lane); } continue; } r -= I_LN;
                if (r < I_OUT) { transpose_item(KIN[25], DM, DM, (bf16_t*)(ws + WS_WOUTT), scr, r, lane); continue; } r -= I_OUT;
                if (r < I_PG) { transpose_item(KIN[34], DM, DM, (bf16_t*)(ws + WS_PLEGT), scr, r, lane); continue; } r -= I_PG;
                if (r < I_GLU) { transpose_item(KIN[14], DS5, DS5, (bf16_t*)(ws + WS_GLUT), scr, r, lane); continue; } r -= I_GLU;
                transpose_item(KIN[33], PLE, DM, (bf16_t*)(ws + WS_PLEWT), scr, r, lane);
            }
        }
        {   const float* pp = KIN[1]; bf16_t* pb = (bf16_t*)(ws + WS_PB);
            for (int i = gtid; i < SEQ * PLE / 4; i += GT) { const f32x4 v = ((const f32x4*)pp)[i]; u32x2 w; w.x = cvt_pk_bf16(v[0], v[1]); w.y = cvt_pk_bf16(v[2], v[3]); ((u32x2*)pb)[i] = w; }
            const float *convw = KIN[16], *convb = KIN[17], *wa = KIN[18], *ba = KIN[19], *wx = KIN[20], *bxx = KIN[21], *lam = KIN[22];
            bf16_t* rgw = (bf16_t*)(ws + WS_RGW);
            for (int i = gtid; i < 16 * 256 * 32; i += GT) { const int h = i >> 13, row = (i >> 5) & 255, K0 = (i & 31) * 8, j = K0 >> 6, i0 = K0 & 63, ch = row >> 2, bj = (row >> 1) & 1, dir = row & 1;
                const float* W = (bj == 0 ? wa : wx) + ((size_t)(dir * 16 + h) * 64) * 64 + ch; float v[8];
#pragma unroll
                for (int k = 0; k < 8; ++k) v[k] = convw[j * 1024 + 64 * h + i0 + k] * W[(size_t)(i0 + k) * 64];
                u32x4 w; w.x = cvt_pk_bf16(v[0], v[1]); w.y = cvt_pk_bf16(v[2], v[3]); w.z = cvt_pk_bf16(v[4], v[5]); w.w = cvt_pk_bf16(v[6], v[7]);
                *(u32x4*)(rgw + ((size_t)h * 256 + row) * 256 + K0) = w; }
            float* rgb = (float*)(ws + WS_RGBIAS);
            for (int i = gtid; i < 16 * 256; i += GT) { const int h = i >> 8, row = i & 255, ch = row >> 2, bj = (row >> 1) & 1, dir = row & 1;
                const float* W = (bj == 0 ? wa : wx) + ((size_t)(dir * 16 + h) * 64) * 64 + ch; float s = (bj == 0 ? ba : bxx)[(dir * 16 + h) * 64 + ch];
                for (int k = 0; k < 64; ++k) s += convb[64 * h + k] * W[(size_t)k * 64];
                rgb[i] = s; }
            float* spt = (float*)(ws + WS_SP);
            for (int i = gtid; i < 2 * 1024; i += GT) spt[i] = -8.0f * log1pf(expf(-lam[i]));
            unsigned* xr = (unsigned*)(ws + WS_XR);
            for (int i = gtid; i < 1024; i += GT) { xr[i] = 0u; xr[(size_t)(SEQ + 2) * 512 + i] = 0u; }
        }
    }
    if (rep + 1 < REPS(0)) { ++nbar; xcd_barrier(xb, (unsigned)G, wave); } }
    SEAM(0);
    for (int rep = 0; rep < REPS(1); ++rep) {
    if (IN(1)) { PH_IDS;
        SchedStd S; S.so.init(SEQ, DIN, G, bx); S.A = (const char*)(ws + WS_HB); S.B = (const char*)(ws + WS_WINT); S.a_tile = (size_t)256 * DM * 2; S.b_tile = (size_t)256 * DM * 2;
        EpiProj E{(bf16_t*)(dout + DO_U), (bf16_t*)(ws + WS_XR), (bf16_t*)(dout + DO_Z), KIN[5]};
        GEMM_PHASE(lds, wave, GParm{DM, DM * 2, 128, 64, 0}, S, E);
        if (G == 256 && bx >= 128) { __syncthreads(); const int t2 = wave * 64 + fresh_lane(); s5_precompute(KIN, ws, (bx - 128) >> 1, (bx - 128) & 1, 2, (LAS float*)lds, t2); }
    }
    if (rep + 1 < REPS(1)) { ++nbar; xcd_barrier(xb, (unsigned)G, wave); } }
    SEAM(1);
    for (int rep = 0; rep < REPS(2); ++rep) {
    if (IN(2)) { PH_IDS;
        { SchedS5a S{(const char*)(dout + DO_U), (const char*)(ws + WS_WG), G, bx}; EpiS5a E{(bf16_t*)(ws + WS_YINTRA), (float*)(ws + WS_S)};
          GEMM_PHASE(lds, wave, GParm{512, 1024, 128, 64, 0}, S, E); }
        { SchedRG S{(const char*)(ws + WS_XR), (const char*)(ws + WS_RGW), G, bx}; EpiG E{(bf16_t*)(ws + WS_G0), (bf16_t*)(ws + WS_G1), (const float*)(ws + WS_RGBIAS)};
          GEMM_PHASE(lds, wave, GParm{256, 2048, 2048, 64, 0}, S, E); }
    }
    if (rep + 1 < REPS(2)) { ++nbar; xcd_barrier(xb, (unsigned)G, wave); } }
    SEAM(2);
    for (int rep = 0; rep < REPS(3); ++rep) {
    if (IN(3)) { PH_IDS;
        if (bx < 128) {
            const int g = bx >> 1, n = bx & 1; const float* Sg = (const float*)(ws + WS_S) + (size_t)g * NCH * 256 + n * 128; LAS float* Ls = (LAS float*)lds;
            for (int i = tid; i < NCH * 32; i += 512) { const int c = i >> 5, q4 = (i & 31) * 4; *(LAS f32x4*)(Ls + c * 128 + q4) = *(const f32x4*)(Sg + (size_t)c * 256 + q4); }
            __syncthreads();
            if (wave == 0) { const int p = lane, pi = (n * 64 + g) * 64 + p;
                const float lr = fminf(KIN[6][pi], -1e-4f), li = KIN[7][pi], step = expf(KIN[8][n * 64 + g]); float ar, ai; cpow(lr * step, li * step, TC, ar, ai);
                bf16_t* hp = (bf16_t*)(ws + WS_HPREV) + (size_t)g * NCH * 256 + n * 128; float hr = 0.f, him = 0.f;
                for (int cc = 0; cc < NCH; ++cc) { const int c = n == 0 ? cc : NCH - 1 - cc;
                    hp[(size_t)c * 256 + p] = (bf16_t)(cvt_pk_bf16(hr, 0.f) & 0xffffu); hp[(size_t)c * 256 + 64 + p] = (bf16_t)(cvt_pk_bf16(him, 0.f) & 0xffffu);
                    const float sr = Ls[c * 128 + p], si = Ls[c * 128 + 64 + p]; const float nr = ar * hr - ai * him + sr, ni = ar * him + ai * hr + si; hr = nr; him = ni; } }
            __syncthreads();
        }
        { MK_RG; for (int un = bx; un < 256; un += G) rg_pass_a(RG, un & 1, un >> 1, tid); }
    }
    if (rep + 1 < REPS(3)) { ++nbar; xcd_barrier(xb, (unsigned)G, wave); } }
    SEAM(3);
    for (int rep = 0; rep < REPS(4); ++rep) {
    if (IN(4)) { PH_IDS;
#if NAIVE_S5
        if (gw < 64) naive_s5_group((const float* const*)0, (const bf16_t*)(dout + DO_U), (float*)(ws + WS_YINTRA), (bf16_t*)(ws + WS_YS5G), gw, lane);
#else
        { SchedS5b S{(const char*)(ws + WS_HPREV), (const char*)(ws + WS_WC), G, bx}; EpiS5b E{(const bf16_t*)(ws + WS_YINTRA), (bf16_t*)(ws + WS_YS5G)};
          GEMM_PHASE(lds, wave, GParm{256, 512, 128, 64, 0}, S, E); }
#endif
#if NAIVE_RG
        { MK_RG; if (gtid < 1024) naive_rg_channel(RG, gtid); }
#else
        { MK_RG; __syncthreads(); for (int un = bx; un < 256; un += G) { rg_pass_c(RG, un & 1, un >> 1, tid, (LAS float*)lds); __syncthreads(); } }
#endif
    }
    if (rep + 1 < REPS(4)) { ++nbar; xcd_barrier(xb, (unsigned)G, wave); } }
    SEAM(4);
    for (int rep = 0; rep < REPS(5); ++rep) {
    if (IN(5)) { PH_IDS;
        SchedStd S; S.so.init(SEQ, DS5, G, bx); S.A = (const char*)(ws + WS_YS5G); S.B = (const char*)(ws + WS_GLUT); S.a_tile = (size_t)256 * 16 * 2; S.b_tile = (size_t)256 * DS5 * 2;
        EpiGlu E{(const bf16_t*)(ws + WS_YS5G), (bf16_t*)(dout + DO_YPRE), KIN[15]};
        GEMM_PHASE(lds, wave, GParm{DS5, 32, 4u * GM_STRIDE * 2u, 16, GM_STRIDE}, S, E);
        if (G == 256 && bx >= 128) {
            LAS float* scr = (LAS float*)(lds + wave * 16640); constexpr int I_FF1 = (DM / 64) * (DFF / 64);
            for (int it = (bx - 128) * 8 + wave; it < FF1_IN_P5; it += 1024) transpose_item(KIN[29], DM, DFF, (bf16_t*)(ws + WS_FF1T), scr, it, lane); }
    }
    if (rep + 1 < REPS(5)) { ++nbar; xcd_barrier(xb, (unsigned)G, wave); } }
    SEAM(5);
    for (int rep = 0; rep < REPS(6); ++rep) {
    if (IN(6)) { PH_IDS;
        const float *g5 = KIN[23], *gr = KIN[24];
        for (int row = gw; row < SEQ; row += NGW) { const u32x4* yr = (const u32x4*)(dout + DO_YPRE) + (size_t)row * 256; u32x4* oc = (u32x4*)(ws + WS_YCAT) + (size_t)row * 256;
            u32x4 w[4]; float s0 = 0.f, s1 = 0.f;
#pragma unroll
            for (int j = 0; j < 4; ++j) { w[j] = yr[lane + 64 * j]; const float q = bf_lo(w[j].x) * bf_lo(w[j].x) + bf_hi(w[j].x) * bf_hi(w[j].x) + bf_lo(w[j].y) * bf_lo(w[j].y) + bf_hi(w[j].y) * bf_hi(w[j].y)
                + bf_lo(w[j].z) * bf_lo(w[j].z) + bf_hi(w[j].z) * bf_hi(w[j].z) + bf_lo(w[j].w) * bf_lo(w[j].w) + bf_hi(w[j].w) * bf_hi(w[j].w); if (j < 2) s0 += q; else s1 += q; }
            const float r0 = 1.0f / sqrtf(wave_sum(s0) * (1.f / 1024.f) + LN_EPS), r1 = 1.0f / sqrtf(wave_sum(s1) * (1.f / 1024.f) + LN_EPS);
#pragma unroll
            for (int j = 0; j < 4; ++j) { const int col = (lane + 64 * j) * 8; const float rs = j < 2 ? r0 : r1; const float* gp = j < 2 ? g5 + col : gr + (col - 1024);
                const f32x4 ga = *(const f32x4*)gp, gb = *(const f32x4*)(gp + 4);
                u32x4 o; o.x = cvt_pk_bf16(bf_lo(w[j].x) * rs * ga[0], bf_hi(w[j].x) * rs * ga[1]); o.y = cvt_pk_bf16(bf_lo(w[j].y) * rs * ga[2], bf_hi(w[j].y) * rs * ga[3]);
                o.z = cvt_pk_bf16(bf_lo(w[j].z) * rs * gb[0], bf_hi(w[j].z) * rs * gb[1]); o.w = cvt_pk_bf16(bf_lo(w[j].w) * rs * gb[2], bf_hi(w[j].w) * rs * gb[3]); oc[lane + 64 * j] = o; } }
        {
            LAS float* scr = (LAS float*)(lds + wave * 16640);
            constexpr int I_FF1 = (DM / 64) * (DFF / 64), I_FF2 = (DFF / 64) * (DM / 64);
            const int ff1_lo = (G == 256) ? FF1_IN_P5 : 0;
            for (int it = gw; it < I_FF2 + (I_FF1 - ff1_lo); it += NGW) {
                if (it < I_FF2) transpose_item(KIN[31], DFF, DM, (bf16_t*)(ws + WS_FF2T), scr, it, lane);
                else transpose_item(KIN[29], DM, DFF, (bf16_t*)(ws + WS_FF1T), scr, ff1_lo + it - I_FF2, lane); }
        }
    }
    if (rep + 1 < REPS(6)) { ++nbar; xcd_barrier(xb, (unsigned)G, wave); } }
    SEAM(6);
    for (int rep = 0; rep < REPS(7); ++rep) {
    if (IN(7)) { PH_IDS;
        SchedStd S; S.so.init(SEQ, DM, G, bx); S.A = (const char*)(ws + WS_YCAT); S.B = (const char*)(ws + WS_WOUTT); S.a_tile = (size_t)256 * DM * 2; S.b_tile = (size_t)256 * DM * 2;
        EpiResLn1 E{(bf16_t*)(ws + WS_HB), KIN[26], KIN[27], KIN[28], PanelStats8{(unsigned long long*)(ws + WS_AGG), (unsigned*)(ws + WS_CTR) + 1024, LN_EPS}};
        GEMM_PHASE(lds, wave, GParm{DM, DM * 2, 128, 64, 0}, S, E);
    }
    if (rep + 1 < REPS(7)) { ++nbar; xcd_barrier(xb, (unsigned)G, wave); } }
    for (int rep = 0; rep < REPS(8); ++rep) {
    if (IN(8)) { }
    if (rep + 1 < REPS(8)) { ++nbar; xcd_barrier(xb, (unsigned)G, wave); } }
    SEAM(8);
    for (int rep = 0; rep < REPS(9); ++rep) {
    if (IN(9)) { PH_IDS;
        static_assert(WS_PLEGT == WS_FF1T + (size_t)DFF * DM * 2, "gate weights must follow the FF1 weights");
        { SchedStd S; S.so.init(SEQ, DFF + DM, G, bx); S.A = (const char*)(ws + WS_HB); S.B = (const char*)(ws + WS_FF1T); S.a_tile = (size_t)256 * DM * 2; S.b_tile = (size_t)256 * DM * 2;
          EpiFF1G E{(bf16_t*)(ws + WS_T), (bf16_t*)dout, KIN[30], KIN[35]}; GEMM_PHASE(lds, wave, GParm{DM, DM * 2, 128, 64, 0}, S, E); }
        { SchedStd S; S.so.init(SEQ, DM, G, bx); S.A = (const char*)(ws + WS_PB); S.B = (const char*)(ws + WS_PLEWT); S.a_tile = (size_t)256 * PLE * 2; S.b_tile = (size_t)256 * PLE * 2;
          EpiPlain<0> E{(bf16_t*)dout + ((size_t)1 << 19), DM, nullptr, (size_t)1 << 20}; GEMM_PHASE(lds, wave, GParm{PLE, PLE * 2, 128, 64, 0}, S, E); }
    }
    if (rep + 1 < REPS(9)) { ++nbar; xcd_barrier(xb, (unsigned)G, wave); } }
    SEAM(9);
    for (int rep = 0; rep < REPS(10); ++rep) {
    if (IN(10)) { PH_IDS;
        SchedStd S; S.so.init(SEQ, DM, G, bx); S.A = (const char*)(ws + WS_T); S.B = (const char*)(ws + WS_FF2T); S.a_tile = (size_t)256 * DFF * 2; S.b_tile = (size_t)256 * DFF * 2;
        EpiResLn2 E{(const bf16_t*)(ws + WS_HB), KIN[32], KIN[36], KIN[37], (float*)dout, (const bf16_t*)dout, PanelStats8{(unsigned long long*)(ws + WS_AGG) + 65536, (unsigned*)(ws + WS_CTR) + 1024 + 64 * 32, LN_EPS}};
        GEMM_PHASE(lds, wave, GParm{DFF, DFF * 2, 128, 64, 0}, S, E);
    }
    if (rep + 1 < REPS(10)) { ++nbar; xcd_barrier(xb, (unsigned)G, wave); } }
    for (int rep = 0; rep < REPS(11); ++rep) {
    if (IN(11)) { }
    if (rep + 1 < REPS(11)) { ++nbar; xcd_barrier(xb, (unsigned)G, wave); } }
#ifdef EXTRA_BARRIERS
    for (int eb = 0; eb < EXTRA_BARRIERS; ++eb) { ++nbar; xcd_barrier(xb, (unsigned)G, wave); }
#endif
#if TSTAMP
    if (bx == 0 && wave == 0) { if (fresh_lane() == 0) { unsigned long long* st = (unsigned long long*)(ws + WS_CTR + 1024); st[12] = __builtin_amdgcn_s_memrealtime();
        ((float*)KIN[38])[0] = 8.0f * floorf((float)(long long)(__hip_atomic_load(st + TS_A1, __ATOMIC_RELAXED, __HIP_MEMORY_SCOPE_AGENT) - __hip_atomic_load(st + TS_A0, __ATOMIC_RELAXED, __HIP_MEMORY_SCOPE_AGENT)) * 0.00125f + 0.5f); } }
#endif
#if DIAG
    { ++nbar; xcd_barrier(xb, (unsigned)G, wave); PH_IDS; unsigned* flagw = (unsigned*)(ws + WS_CTR) + 48;
#if DIAG == 1
      diag_ffn((const float* const*)0, ws, ((float*)KIN[38]), flagw, gtid, GT);
#elif DIAG == 2
      diag_pre((const float* const*)0, ws, dout, flagw, gtid, GT);
#elif DIAG == 3
      diag_v((const float* const*)0, ws, dout, flagw, gtid, GT);
#elif DIAG == 4
      diag_g((const float* const*)0, ws, flagw, gtid, GT);
#elif DIAG == 6
      diag_max(ws, flagw, gtid, GT);
#else
      if (bx == 0 && tid == 0) flagw[1] = 0xffffffffu;
      ++nbar; xcd_barrier(xb, (unsigned)G, wave);
#if DIAG == 7
      diag_rows(((float*)KIN[38]), flagw, gw, NGW, lane);
#elif DIAG == 8
      diag_rows_bf((const bf16_t*)(ws + WS_HB), DM, 12.0f, flagw, gw, NGW, lane);
#elif DIAG == 9
      diag_rows((const float*)(ws + WS_V2), flagw, gw, NGW, lane);
#elif DIAG == 10
      diag_rows_bf((const bf16_t*)(ws + WS_T), DFF, 150.0f, flagw, gw, NGW, lane);
#elif DIAG == 11
      diag_rows_bf((const bf16_t*)(dout + DO_PW), DM, 8.0f, flagw, gw, NGW, lane);
#elif DIAG == 12
      diag_rows_bf((const bf16_t*)(dout + DO_SG), DM, 1.01f, flagw, gw, NGW, lane);
#endif
#endif
      ++nbar; xcd_barrier(xb, (unsigned)G, wave);
#if DIAG != 1
      for (int i = gtid; i < SEQ * DM; i += GT) ((float*)KIN[38])[i] = 0.f;
      ++nbar; xcd_barrier(xb, (unsigned)G, wave);
#endif
      if (bx == 0 && tid == 0) { unsigned code = 0; for (int q = 0; q < 4; ++q) if (__hip_atomic_load(flagw + q, __ATOMIC_RELAXED, __HIP_MEMORY_SCOPE_AGENT) > 100u) code |= 1u << q; if (DIAG >= 7) { const unsigned cnt = __hip_atomic_load(flagw, __ATOMIC_RELAXED, __HIP_MEMORY_SCOPE_AGENT), mn = __hip_atomic_load(flagw + 1, __ATOMIC_RELAXED, __HIP_MEMORY_SCOPE_AGENT), mxr = __hip_atomic_load(flagw + 2, __ATOMIC_RELAXED, __HIP_MEMORY_SCOPE_AGENT);
          const unsigned v = DIAG_SEL == 0 ? cnt : DIAG_SEL == 1 ? mn / 100u : DIAG_SEL == 2 ? mn % 100u : DIAG_SEL == 3 ? mxr / 100u : mxr % 100u; ((float*)KIN[38])[0] = 100.0f * (float)(v + 1u); }
      else ((float*)KIN[38])[0] = (DIAG == 6) ? 1000.0f * __uint_as_float(__hip_atomic_load(flagw, __ATOMIC_RELAXED, __HIP_MEMORY_SCOPE_AGENT)) : 1000.0f * (float)(code + 16u); } }
#endif
#undef IN
#undef SEAM
}


#if PER_PHASE_LAUNCH
template <int PH> static void set_attr_one() { (void)hipFuncSetAttribute((const void*)mega<(1 << PH)>, hipFuncAttributeMaxDynamicSharedMemorySize, LDS_BYTES); }
template <int PH> static void launch_one(Args a, int grid, hipStream_t stream) { a.ph_lo = PH; a.ph_hi = PH + 1; hipLaunchKernelGGL(mega<(1 << PH)>, dim3(grid), dim3(512), LDS_BYTES, stream, a); }
static void set_attrs() { set_attr_one<0>(); set_attr_one<1>(); set_attr_one<2>(); set_attr_one<3>(); set_attr_one<4>(); set_attr_one<5>(); set_attr_one<6>(); set_attr_one<7>(); set_attr_one<8>(); set_attr_one<9>(); set_attr_one<10>(); set_attr_one<11>(); }
static void launch_phases(const Args& a, int grid, hipStream_t stream) { launch_one<0>(a, grid, stream); launch_one<1>(a, grid, stream); launch_one<2>(a, grid, stream); launch_one<3>(a, grid, stream); launch_one<4>(a, grid, stream); launch_one<5>(a, grid, stream);
    launch_one<6>(a, grid, stream); launch_one<7>(a, grid, stream); launch_one<8>(a, grid, stream); launch_one<9>(a, grid, stream); launch_one<10>(a, grid, stream); launch_one<11>(a, grid, stream); }
#else
static void set_attrs() { (void)hipFuncSetAttribute((const void*)mega<0xfff>, hipFuncAttributeMaxDynamicSharedMemorySize, LDS_BYTES); }
#endif

extern "C" void kernel_launch(void* const* d_in, const int* in_sizes, int n_in, void* d_out, int out_size, void* d_ws, size_t ws_size, hipStream_t stream) {
    static int grid = 0;
    if (grid == 0) {
        if (n_in != 38 || out_size != SEQ * DM || ws_size < WS_END) { fprintf(stderr, "kernel_launch: unexpected shapes (n_in %d out %d ws %zu)\n", n_in, out_size, ws_size); grid = -1; return; }
        int dev = 0, cus = 0, per_cu = 0;
        hipGetDevice(&dev); hipDeviceGetAttribute(&cus, hipDeviceAttributeMultiprocessorCount, dev);
        set_attrs();
        per_cu = 1;
        (void)hipGetLastError();
        if (per_cu < 1) per_cu = 1;
        grid = cus;
    }
    if (grid < 0) return;
#ifdef POISON_NAN
    hipMemsetAsync(d_ws, 0xFF, WS_END, stream); hipMemsetAsync(d_out, 0xFF, (size_t)64 * MiB, stream);
#endif
    hipMemsetAsync((char*)d_ws + WS_CTR, 0, 40960, stream);
    Args a{};
    for (int i = 0; i < 38; ++i) a.in[i] = (const float*)d_in[i];
    a.out = (float*)d_out; a.ws = (unsigned char*)d_ws;
#if PER_PHASE_LAUNCH
    launch_phases(a, grid, stream);
#else
    a.ph_lo = 0; a.ph_hi = NPHASE;
    void* kargs[] = {&a};
    hipError_t e = hipLaunchCooperativeKernel((const void*)mega<0xfff>, dim3(grid), dim3(512), kargs, LDS_BYTES, stream);
    if (e != hipSuccess) fprintf(stderr, "cooperative launch failed: %s (grid %d)\n", hipGetErrorString(e), grid);
#endif
}
```

```cpp
#include <hip/hip_runtime.h>
#include <hip/hip_cooperative_groups.h>
#include <cstdio>
#include <cstdint>
namespace cg = cooperative_groups;

#ifndef PER_PHASE_LAUNCH
#define PER_PHASE_LAUNCH 0
#endif

#ifndef TSTAMP
#define TSTAMP 0
#define TS_A0 4
#define TS_A1 5
#define TS_B0 9
#define TS_B1 12
#endif
#define LAS __attribute__((address_space(3)))
typedef unsigned short bf16_t;
typedef short bf16x8 __attribute__((ext_vector_type(8)));
typedef float f32x4 __attribute__((ext_vector_type(4)));
typedef float f32x2 __attribute__((ext_vector_type(2)));
typedef unsigned u32x4 __attribute__((ext_vector_type(4)));
typedef unsigned u32x2 __attribute__((ext_vector_type(2)));

constexpr int SEQ = 8192, DM = 2048, DIN = 3072, DS5 = 1024, DRG = 1024, NG = 64, NP = 64, NK = 16, NH = 16, HD = 64, DFF = 8192, PLE = 256;
constexpr int TC = 32, NCH = SEQ / TC;
constexpr float LN_EPS = 1e-5f, DN_ALPHA = 1.18920711500272f;
constexpr int NPHASE = 12;

constexpr size_t MiB = (size_t)1 << 20;
constexpr size_t WS_FF2T = 0, WS_HB = 32 * MiB, WS_FF1T = 64 * MiB, WS_PLEGT = 96 * MiB, WS_PLEWT = 104 * MiB, WS_PB = 105 * MiB, WS_WOUTT = 109 * MiB,
    WS_V2 = 64 * MiB, WS_G0 = 0, WS_G1 = 64 * MiB,
    WS_WG = 128 * MiB, WS_WC = 176 * MiB, WS_RGW = 192 * MiB, WS_GLUT = 194 * MiB, WS_XR = 196 * MiB, WS_YINTRA = 213 * MiB, WS_S = 229 * MiB, WS_HPREV = 245 * MiB, WS_WINT = 229 * MiB,
    WS_YS5G = 128 * MiB, WS_YCAT = 144 * MiB, WS_T = 128 * MiB,
    WS_AGG = 256 * MiB, WS_CARRY = 258 * MiB, WS_SUMSQ = 259 * MiB, WS_RGBIAS = 259 * MiB + 64 * 1024, WS_SP = WS_RGBIAS + 16 * 1024, WS_CTR = WS_SP + 8 * 1024, WS_END = 260 * MiB;
constexpr size_t DO_YPRE = 0, DO_Z = 32 * MiB, DO_U = 48 * MiB, DO_SG = 0, DO_PW = 32 * MiB;
constexpr int FF1_IN_P5 = 3072;
constexpr int GM_STRIDE = SEQ * 16;
constexpr int LDS_BYTES = 152 * 1024;

typedef __bf16 bf16x2_t __attribute__((ext_vector_type(2)));
__device__ __forceinline__ unsigned cvt_pk_bf16(float lo, float hi) { const f32x2 v = {lo, hi}; const bf16x2_t b = __builtin_convertvector(v, bf16x2_t); return __builtin_bit_cast(unsigned, b); }
__device__ __forceinline__ float bf_lo(unsigned w) { return __uint_as_float(w << 16); }
__device__ __forceinline__ float bf_hi(unsigned w) { return __uint_as_float(w & 0xffff0000u); }
__device__ __forceinline__ f32x4 bf4(u32x2 w) { return (f32x4){bf_lo(w.x), bf_hi(w.x), bf_lo(w.y), bf_hi(w.y)}; }
__device__ __forceinline__ float fast_sigmoid(float x) { return __builtin_amdgcn_rcpf(1.0f + __expf(-x)); }
__device__ __forceinline__ float gelu_tanh(float x) { const float u = 1.5957691216057308f * (x + 0.044715f * x * x * x); return x * fast_sigmoid(u); }
__device__ __forceinline__ float wave_sum(float v) {
#pragma unroll
    for (int o = 1; o < 64; o <<= 1) v += __shfl_xor(v, o);
    return v;
}
__device__ __forceinline__ int lane_id() { return (int)__builtin_amdgcn_mbcnt_hi(~0u, __builtin_amdgcn_mbcnt_lo(~0u, 0u)); }
__device__ __forceinline__ int fresh_lane() { unsigned z = 0; asm volatile("" : "+s"(z)); return (int)__builtin_amdgcn_mbcnt_hi(~0u, __builtin_amdgcn_mbcnt_lo(~0u, z)); }
#define LDS_WAIT() asm volatile("s_waitcnt lgkmcnt(0)" ::: "memory")

namespace pg8 {
constexpr int BM = 256, BK = 64, HALF = 128, HTB = HALF * BK * 2, STAGE_BYTES = 8 * HTB, NXCD = 8, WGM = 8;
__host__ __device__ __forceinline__ int lds_byte(int r, int c) { const int st = (r >> 4) * 2 + (c >> 5), rr = r & 15, cc = c & 31, ob = rr * 64 + cc * 2; return st * 1024 + (ob ^ (((ob >> 9) & 1) << 5)); }
__host__ __device__ __forceinline__ void stage_rc(int b, int& R, int& C) { const int st = b / 1024, sb = b % 1024, swz = sb ^ (((sb >> 9) & 1) << 5); R = (st >> 1) * 16 + swz / 64; C = (st & 1) * 32 + (swz % 64) / 2; }
__host__ __device__ __forceinline__ int perm32(int rho) { const int n = rho >> 4, i = rho & 15; return 8 * (i >> 2) + 4 * n + (i & 3); }

struct Unit { int pm, pn; };
struct StaticOrder {
    int nM, nN, nwg, G, c;
    __host__ __device__ void init(int M, int N, int G_, int c_) { nM = M / BM; nN = N / BM; nwg = nM * nN; G = G_; c = c_; }
    __host__ __device__ bool next(int i, Unit& u) const {
        const long L = (long)i * G + c; if (L >= nwg) return false;
        int wgid = (int)L; { const int q = nwg / NXCD, r = nwg % NXCD, xcd = wgid % NXCD, off = wgid / NXCD; wgid = (xcd < r ? xcd * (q + 1) : r * (q + 1) + (xcd - r) * q) + off; }
        const int nig = WGM * nN, gid = wgid / nig, fm = gid * WGM, gsz = (nM - fm) < WGM ? (nM - fm) : WGM;
        u.pm = fm + ((wgid % nig) % gsz); u.pn = (wgid % nig) / gsz; return true;
    }
};
struct GUnit { const char* A; const char* B; int i0, i1; };
struct GParm { int K; unsigned a_rs, a_ks; int a_cw, a_cs; };

template <class Epi, class Sched>
__device__ __forceinline__ void gemm_phase(LAS unsigned char* lds, const int wid, const GParm gp, const Sched& S, const Epi& E) {
    const int lane = fresh_lane(), tid = wid * 64 + lane, wr = wid >> 2, wc = wid & 3, fr = lane & 15, fq = lane >> 4;
    const int K = gp.K, nt = K / BK;
    unsigned voffA[2], voffB[2];
#pragma unroll
    for (int i = 0; i < 2; ++i) { int R, C; stage_rc(tid * 16 + i * 8192, R, C); const int Rb = Epi::PERM ? ((R & ~31) + perm32(R & 31)) : R;
        voffA[i] = (unsigned)R * gp.a_rs + (unsigned)((C / gp.a_cw) * gp.a_cs + (C % gp.a_cw)) * 2u; voffB[i] = (unsigned)(Rb * K + C) * 2u; }
    const size_t ksA = gp.a_ks, ksB = (size_t)(BK * 2);
    const size_t hsA = (size_t)HALF * gp.a_rs, hsB = (size_t)HALF * K * 2;
    const unsigned ldsw = (unsigned)wid * 1024u;
    const int aoff = lds_byte(wr * 64 + fr, fq * 8), boff = lds_byte(wc * 32 + fr, fq * 8);
#define PG8_SA(b, h) (((b) * 2 + (h)) * HTB)
#define PG8_SB(b, h) ((4 + (b) * 2 + (h)) * HTB)
#define PG8_STAGE(bufoff, gbase, voff) do { _Pragma("unroll") for (int _i = 0; _i < 2; ++_i) \
        __builtin_amdgcn_global_load_lds((const unsigned*)((const char*)(gbase) + (voff)[_i]), (LAS unsigned*)(lds + (bufoff) + ldsw + _i * 8192), 16, 0, 0); } while (0)
#define PG8_LDA(dst, b, h) do { _Pragma("unroll") for (int m = 0; m < 4; ++m) _Pragma("unroll") for (int k = 0; k < 2; ++k) dst[m][k] = *(const LAS bf16x8*)(lds + PG8_SA(b, h) + aoff + m * 2048 + k * 1024); } while (0)
#define PG8_LDB(dst, b, h) do { _Pragma("unroll") for (int n = 0; n < 2; ++n) _Pragma("unroll") for (int k = 0; k < 2; ++k) dst[n][k] = *(const LAS bf16x8*)(lds + PG8_SB(b, h) + boff + n * 2048 + k * 1024); } while (0)
#define PG8_MMA(ai, bj, At, Bt) do { __builtin_amdgcn_s_setprio(1); _Pragma("unroll") for (int m = 0; m < 4; ++m) _Pragma("unroll") for (int n = 0; n < 2; ++n) _Pragma("unroll") for (int k = 0; k < 2; ++k) \
        acc[ai][bj][m][n] = __builtin_amdgcn_mfma_f32_16x16x32_bf16(Bt[n][k], At[m][k], acc[ai][bj][m][n], 0, 0, 0); __builtin_amdgcn_s_setprio(0); } while (0)
#define PG8_WAIT_V(n) asm volatile("s_waitcnt vmcnt(" #n ")" ::: "memory")
#define PG8_WAIT_L(n) asm volatile("s_waitcnt lgkmcnt(" #n ")" ::: "memory")
#define PG8_BAR __builtin_amdgcn_s_barrier()
#define PG8_SCHED __builtin_amdgcn_sched_barrier(0)
    GUnit cur, nxt; int ui = 0;
    if (!S.next(0, cur)) return;
    f32x4 acc[2][2][4][2];
#pragma unroll
    for (int a = 0; a < 2; ++a)
#pragma unroll
        for (int b = 0; b < 2; ++b)
#pragma unroll
            for (int m = 0; m < 4; ++m)
#pragma unroll
                for (int n = 0; n < 2; ++n) acc[a][b][m][n] = (f32x4){0.f, 0.f, 0.f, 0.f};
    bf16x8 At[4][2], B0[2][2], B1[2][2];
    const char* cA = cur.A; const char* cB = cur.B;
    PG8_STAGE(PG8_SB(0, 0), cB, voffB); PG8_STAGE(PG8_SB(0, 1), cB + hsB, voffB); PG8_STAGE(PG8_SA(0, 0), cA, voffA); PG8_STAGE(PG8_SA(0, 1), cA + hsA, voffA);
    if (wr == 1) PG8_BAR;
    PG8_WAIT_V(2); PG8_BAR;
    PG8_STAGE(PG8_SB(1, 0), cB + ksB, voffB); PG8_STAGE(PG8_SA(1, 0), cA + ksA, voffA); PG8_STAGE(PG8_SB(1, 1), cB + hsB + ksB, voffB);
    PG8_WAIT_V(6); PG8_BAR;
    for (;;) {
        const bool has_next = S.next(ui + 1, nxt);
        const char* nA = has_next ? nxt.A : cA; const char* nB = has_next ? nxt.B : cB;
        for (int t = 0; t < nt; t += 2) {
            const bool last = (t == nt - 2);
            const char* a1 = cA + (size_t)(t + 1) * ksA;
            const char* a2 = last ? nA : cA + (size_t)(t + 2) * ksA; const char* b2 = last ? nB : cB + (size_t)(t + 2) * ksB;
            const char* a3 = a2 + ksA; const char* b3 = b2 + ksB;
            PG8_LDB(B0, 0, 0); PG8_LDB(B1, 0, 1); PG8_SCHED; PG8_LDA(At, 0, 0); PG8_STAGE(PG8_SA(1, 1), a1 + hsA, voffA);
            PG8_WAIT_V(8); PG8_WAIT_L(0); PG8_BAR; PG8_MMA(0, 0, At, B0); PG8_MMA(0, 1, At, B1); PG8_BAR; PG8_SCHED;
            PG8_LDA(At, 0, 1); PG8_STAGE(PG8_SB(0, 0), b2, voffB); PG8_STAGE(PG8_SB(0, 1), b2 + hsB, voffB); PG8_STAGE(PG8_SA(0, 0), a2, voffA);
            PG8_WAIT_V(8); PG8_WAIT_L(0); PG8_BAR; PG8_MMA(1, 0, At, B0); PG8_MMA(1, 1, At, B1); PG8_BAR; PG8_SCHED;
            PG8_LDB(B0, 1, 0); PG8_LDB(B1, 1, 1); PG8_SCHED; PG8_LDA(At, 1, 0); PG8_STAGE(PG8_SA(0, 1), a2 + hsA, voffA);
            PG8_WAIT_V(8); PG8_WAIT_L(0); PG8_BAR; PG8_MMA(0, 0, At, B0); PG8_MMA(0, 1, At, B1); PG8_BAR; PG8_SCHED;
            PG8_LDA(At, 1, 1); PG8_STAGE(PG8_SB(1, 0), b3, voffB); PG8_STAGE(PG8_SB(1, 1), b3 + hsB, voffB); PG8_STAGE(PG8_SA(1, 0), a3, voffA);
            PG8_WAIT_V(8); PG8_WAIT_L(0); PG8_BAR; PG8_MMA(1, 0, At, B0); PG8_MMA(1, 1, At, B1); PG8_BAR; PG8_SCHED;
        }
        if (wr == 0) PG8_BAR;
        if constexpr (!Epi::AFTER_DRAIN) { const int l_o = fresh_lane(); E(acc, cur, wr, wc, l_o & 15, l_o >> 4); }
        if (!has_next) break;
#pragma unroll
        for (int a = 0; a < 2; ++a)
#pragma unroll
            for (int b = 0; b < 2; ++b)
#pragma unroll
                for (int m = 0; m < 4; ++m)
#pragma unroll
                    for (int n = 0; n < 2; ++n) acc[a][b][m][n] = (f32x4){0.f, 0.f, 0.f, 0.f};
        cur = nxt; cA = nA; cB = nB; ++ui;
        if (wr == 1) PG8_BAR;
    }
    PG8_WAIT_V(0);
    PG8_BAR;
    if constexpr (Epi::AFTER_DRAIN) { const int l_o = fresh_lane(); E.fused(acc, cur, wr, wc, l_o & 15, l_o >> 4, lds, wid); }
#undef PG8_SA
#undef PG8_SB
#undef PG8_STAGE
#undef PG8_LDA
#undef PG8_LDB
#undef PG8_MMA
#undef PG8_WAIT_V
#undef PG8_WAIT_L
#undef PG8_BAR
#undef PG8_SCHED
}
}
using pg8::GUnit; using pg8::GParm;
typedef f32x4 AccT[2][2][4][2];

struct SchedStd {
    pg8::StaticOrder so; const char* A; const char* B; size_t a_tile, b_tile;
    __device__ __forceinline__ bool next(int i, GUnit& u) const { pg8::Unit t; if (!so.next(i, t)) return false; u.A = A + (size_t)t.pm * a_tile; u.B = B + (size_t)t.pn * b_tile; u.i0 = t.pm; u.i1 = t.pn; return true; }
};
struct SchedS5a { const char* U; const char* WG; int G, c;
    __device__ __forceinline__ bool next(int i, GUnit& u) const { const int L = i * G + c; if (L >= 192) return false; const int g = L / 3, pn = L % 3;
        u.A = U + (size_t)g * GM_STRIDE * 2; u.B = WG + ((size_t)g * 768 + 256 * pn) * 512 * 2; u.i0 = g; u.i1 = pn; return true; } };
struct SchedS5b { const char* HP; const char* WC; int G, c;
    __device__ __forceinline__ bool next(int i, GUnit& u) const { const int L = i * G + c; if (L >= 128) return false; const int g = L / 2, pn = L % 2;
        u.A = HP + (size_t)g * 256 * 256 * 2; u.B = WC + ((size_t)g * 512 + 256 * pn) * 256 * 2; u.i0 = g; u.i1 = pn; return true; } };
struct SchedRG { const char* XR; const char* RGW; int G, c;
    __device__ __forceinline__ bool next(int i, GUnit& u) const { const int L = i * G + c; if (L >= 512) return false; const int h = L % 16, pm = L / 16;
        u.A = XR + ((size_t)(256 * pm) * 1024 + 64 * h) * 2; u.B = RGW + (size_t)h * 256 * 256 * 2; u.i0 = pm; u.i1 = h; return true; } };

template <int ACT> __device__ __forceinline__ void epi_bf16_store(const AccT& acc, bf16_t* tile, int ldc, const float* biast, int wr, int wc, int fr, int fq) {
    const int r0 = wr * 64 + fr, c0 = wc * 32 + 8 * fq;
    f32x4 bv[2][2];
#pragma unroll
    for (int bj = 0; bj < 2; ++bj)
#pragma unroll
        for (int n = 0; n < 2; ++n) bv[bj][n] = biast ? *(const f32x4*)(biast + c0 + bj * 128 + 4 * n) : (f32x4){0.f, 0.f, 0.f, 0.f};
#pragma unroll
    for (int ai = 0; ai < 2; ++ai)
#pragma unroll
        for (int m = 0; m < 4; ++m) { bf16_t* rowp = tile + (size_t)(r0 + ai * 128 + m * 16) * ldc + c0;
#pragma unroll
            for (int bj = 0; bj < 2; ++bj) { f32x4 v0 = acc[ai][bj][m][0] + bv[bj][0], v1 = acc[ai][bj][m][1] + bv[bj][1];
                if (ACT == 1) {
#pragma unroll
                    for (int j = 0; j < 4; ++j) { const float a = fmaxf(v0[j], 0.f), b = fmaxf(v1[j], 0.f); v0[j] = a * a; v1[j] = b * b; } }
                if (ACT == 2) {
#pragma unroll
                    for (int j = 0; j < 4; ++j) { v0[j] = fast_sigmoid(v0[j]); v1[j] = fast_sigmoid(v1[j]); } }
                u32x4 w; w.x = cvt_pk_bf16(v0[0], v0[1]); w.y = cvt_pk_bf16(v0[2], v0[3]); w.z = cvt_pk_bf16(v1[0], v1[1]); w.w = cvt_pk_bf16(v1[2], v1[3]);
                *(u32x4*)(rowp + bj * 128) = w; } }
}
struct EpiProj { static constexpr bool PERM = true, AFTER_DRAIN = false; bf16_t *U, *XR, *Z; const float* bias;
    __device__ __forceinline__ void operator()(AccT& acc, const GUnit& u, int wr, int wc, int fr, int fq) const {
        const int pm = u.i0, pn = u.i1;
        if (pn >= 4) { bf16_t* base = pn < 8 ? XR + 2 * 1024 : Z; epi_bf16_store<0>(acc, base + (size_t)pm * 256 * 1024 + (pn & 3) * 256, 1024, bias + pn * 256, wr, wc, fr, fq); return; }
        const int c0 = pn * 256 + wc * 32 + 8 * fq;
#pragma unroll
        for (int bj = 0; bj < 2; ++bj) { const int col = c0 + bj * 128; const f32x4 b0 = *(const f32x4*)(bias + col), b1 = *(const f32x4*)(bias + col + 4); bf16_t* gp = U + (size_t)(col >> 4) * GM_STRIDE + (col & 15);
#pragma unroll
            for (int ai = 0; ai < 2; ++ai)
#pragma unroll
                for (int m = 0; m < 4; ++m) { const int row = pm * 256 + ai * 128 + wr * 64 + m * 16 + fr; const f32x4 v0 = acc[ai][bj][m][0] + b0, v1 = acc[ai][bj][m][1] + b1;
                    u32x4 w; w.x = cvt_pk_bf16(v0[0], v0[1]); w.y = cvt_pk_bf16(v0[2], v0[3]); w.z = cvt_pk_bf16(v1[0], v1[1]); w.w = cvt_pk_bf16(v1[2], v1[3]);
                    *(u32x4*)(gp + (size_t)row * 16) = w; } }
    } };
template <int ACT> struct EpiPlain { static constexpr bool PERM = true, AFTER_DRAIN = false; bf16_t* O; int ldc; const float* bias; size_t pstride;
    __device__ __forceinline__ void operator()(AccT& acc, const GUnit& u, int wr, int wc, int fr, int fq) const {
        epi_bf16_store<ACT>(acc, O + (size_t)u.i0 * (pstride ? pstride : (size_t)256 * ldc) + u.i1 * 256, ldc, bias ? bias + u.i1 * 256 : nullptr, wr, wc, fr, fq); } };
struct EpiFF1G { static constexpr bool PERM = true, AFTER_DRAIN = false; bf16_t* T; bf16_t* SG; const float *b1, *bg;
    __device__ __forceinline__ void operator()(AccT& acc, const GUnit& u, int wr, int wc, int fr, int fq) const {
        const int pm = u.i0, pn = u.i1;
        if (pn < 32) epi_bf16_store<1>(acc, T + (size_t)pm * 256 * DFF + pn * 256, DFF, b1 + pn * 256, wr, wc, fr, fq);
        else epi_bf16_store<2>(acc, SG + (size_t)pm * ((size_t)1 << 20) + (pn - 32) * 256, DM, bg + (pn - 32) * 256, wr, wc, fr, fq); } };
struct EpiS5a { static constexpr bool PERM = true, AFTER_DRAIN = false; bf16_t* YI; float* S;
    __device__ __forceinline__ void operator()(AccT& acc, const GUnit& u, int wr, int wc, int fr, int fq) const {
        const int g = u.i0, pn = u.i1;
#pragma unroll
        for (int ai = 0; ai < 2; ++ai)
#pragma unroll
            for (int m = 0; m < 4; ++m) { const int r = ai * 128 + wr * 64 + m * 16 + fr;
#pragma unroll
                for (int bj = 0; bj < 2; ++bj) { const int c8 = bj * 128 + wc * 32 + 8 * fq; const f32x4 v0 = acc[ai][bj][m][0], v1 = acc[ai][bj][m][1];
                    if (pn < 2) { const int col = pn * 256 + c8, t = col >> 4, k0 = col & 15;
                        u32x4 w; w.x = cvt_pk_bf16(v0[0], v0[1]); w.y = cvt_pk_bf16(v0[2], v0[3]); w.z = cvt_pk_bf16(v1[0], v1[1]); w.w = cvt_pk_bf16(v1[2], v1[3]);
                        *(u32x4*)(YI + (size_t)g * GM_STRIDE + (size_t)r * 512 + col) = w; (void)t; (void)k0; }
                    else { float* sp = S + ((size_t)g * NCH + r) * 256 + c8; *(f32x4*)sp = v0; *(f32x4*)(sp + 4) = v1; } } }
    } };
struct EpiS5b { static constexpr bool PERM = true, AFTER_DRAIN = false; const bf16_t* YI; bf16_t* YG;
    __device__ __forceinline__ void operator()(AccT& acc, const GUnit& u, int wr, int wc, int fr, int fq) const {
        const int g = u.i0, pn = u.i1;
#pragma unroll
        for (int ai = 0; ai < 2; ++ai)
#pragma unroll
            for (int m = 0; m < 4; ++m) { const int r = ai * 128 + wr * 64 + m * 16 + fr;
#pragma unroll
                for (int bj = 0; bj < 2; ++bj) { const int col = pn * 256 + bj * 128 + wc * 32 + 8 * fq, t = col >> 4, k0 = col & 15;
                    const size_t off = (size_t)g * GM_STRIDE + (size_t)r * 512 + col; (void)t; (void)k0; const u32x4 yi = *(const u32x4*)(YI + off);
                    f32x4 v0 = acc[ai][bj][m][0] + (f32x4){bf_lo(yi.x), bf_hi(yi.x), bf_lo(yi.y), bf_hi(yi.y)}, v1 = acc[ai][bj][m][1] + (f32x4){bf_lo(yi.z), bf_hi(yi.z), bf_lo(yi.w), bf_hi(yi.w)};
#pragma unroll
                    for (int j = 0; j < 4; ++j) { v0[j] = gelu_tanh(v0[j]); v1[j] = gelu_tanh(v1[j]); }
                    u32x4 w; w.x = cvt_pk_bf16(v0[0], v0[1]); w.y = cvt_pk_bf16(v0[2], v0[3]); w.z = cvt_pk_bf16(v1[0], v1[1]); w.w = cvt_pk_bf16(v1[2], v1[3]);
                    *(u32x4*)(YG + off) = w; } }
    } };
struct EpiGlu { static constexpr bool PERM = true, AFTER_DRAIN = false; const bf16_t* YG; bf16_t* YPRE; const float* bias;
    __device__ __forceinline__ void operator()(AccT& acc, const GUnit& u, int wr, int wc, int fr, int fq) const {
        const int pm = u.i0, pn = u.i1; const int c0 = pn * 256 + wc * 32 + 8 * fq;
        f32x4 bv[2][2];
#pragma unroll
        for (int bj = 0; bj < 2; ++bj)
#pragma unroll
            for (int n = 0; n < 2; ++n) bv[bj][n] = *(const f32x4*)(bias + c0 + bj * 128 + 4 * n);
#pragma unroll
        for (int ai = 0; ai < 2; ++ai)
#pragma unroll
            for (int m = 0; m < 4; ++m) { const int row = pm * 256 + ai * 128 + wr * 64 + m * 16 + fr;
#pragma unroll
                for (int bj = 0; bj < 2; ++bj) { const int col = c0 + bj * 128; const u32x4 yv = *(const u32x4*)(YG + (size_t)(col >> 4) * GM_STRIDE + (size_t)row * 16 + (col & 15));
                    const f32x4 y0 = (f32x4){bf_lo(yv.x), bf_hi(yv.x), bf_lo(yv.y), bf_hi(yv.y)}, y1 = (f32x4){bf_lo(yv.z), bf_hi(yv.z), bf_lo(yv.w), bf_hi(yv.w)};
                    f32x4 v0 = acc[ai][bj][m][0] + bv[bj][0], v1 = acc[ai][bj][m][1] + bv[bj][1];
#pragma unroll
                    for (int j = 0; j < 4; ++j) { v0[j] = y0[j] * fast_sigmoid(v0[j]); v1[j] = y1[j] * fast_sigmoid(v1[j]); }
                    u32x4 w; w.x = cvt_pk_bf16(v0[0], v0[1]); w.y = cvt_pk_bf16(v0[2], v0[3]); w.z = cvt_pk_bf16(v1[0], v1[1]); w.w = cvt_pk_bf16(v1[2], v1[3]);
                    *(u32x4*)(YPRE + (size_t)row * 2048 + col) = w; }
                }
    } };
template <bool PLEADD> struct EpiRes { static constexpr bool PERM = false, AFTER_DRAIN = false; const bf16_t* HBp; const float* bias; float* V; const bf16_t* SG; const bf16_t* PW;
    __device__ __forceinline__ void operator()(AccT& acc, const GUnit& u, int wr, int wc, int fr, int fq) const {
        const int pm = u.i0, pn = u.i1; const int c0 = pn * 256 + wc * 32 + 4 * fq;
        f32x4 bv[2][2];
#pragma unroll
        for (int bj = 0; bj < 2; ++bj)
#pragma unroll
            for (int n = 0; n < 2; ++n) bv[bj][n] = *(const f32x4*)(bias + c0 + bj * 128 + n * 16);
#pragma unroll
        for (int ai = 0; ai < 2; ++ai)
#pragma unroll
            for (int m = 0; m < 4; ++m) { const int row = pm * 256 + ai * 128 + wr * 64 + m * 16 + fr;
#pragma unroll
                for (int bj = 0; bj < 2; ++bj)
#pragma unroll
                    for (int n = 0; n < 2; ++n) { const size_t off = (size_t)row * 2048 + c0 + bj * 128 + n * 16;
                        f32x4 v = acc[ai][bj][m][n] + bv[bj][n] + DN_ALPHA * bf4(*(const u32x2*)(HBp + off));
                        if (PLEADD) v += bf4(*(const u32x2*)(SG + off)) * bf4(*(const u32x2*)(PW + off));
                        *(f32x4*)(V + off) = v; } }
    } };


struct PanelStats8 { unsigned long long* xbuf; unsigned* cnt; float eps;
    __device__ __forceinline__ void run(const AccT& v, int pm, int pn, int wr, int wc, int fr, int fq, LAS unsigned char* lds, int wid) const {
        LAS f32x2* P = (LAS f32x2*)lds; LAS f32x2* S = (LAS f32x2*)(lds + 8192); const int lane = fq * 16 + fr;
#pragma unroll
        for (int ai = 0; ai < 2; ++ai)
#pragma unroll
            for (int m = 0; m < 4; ++m) { float s = 0.f;
#pragma unroll
                for (int bj = 0; bj < 2; ++bj)
#pragma unroll
                    for (int n = 0; n < 2; ++n) { const f32x4 x = v[ai][bj][m][n]; s += (x[0] + x[1]) + (x[2] + x[3]); }
                s += __shfl_xor(s, 16); s += __shfl_xor(s, 32);
                const float mw = s * (1.0f / 64.0f); float q = 0.f;
#pragma unroll
                for (int bj = 0; bj < 2; ++bj)
#pragma unroll
                    for (int n = 0; n < 2; ++n) { const f32x4 d = v[ai][bj][m][n] - mw; q += (d[0] * d[0] + d[1] * d[1]) + (d[2] * d[2] + d[3] * d[3]); }
                q += __shfl_xor(q, 16); q += __shfl_xor(q, 32);
                if (fq == 0) P[(ai * 128 + wr * 64 + m * 16 + fr) * 4 + wc] = (f32x2){mw, q}; }
        asm volatile("s_waitcnt lgkmcnt(0)" ::: "memory"); __builtin_amdgcn_s_barrier(); asm volatile("" ::: "memory");
        const int row = wid * 32 + (lane & 31);
        if (lane < 32) { const f32x2 a = P[row * 4 + 0], b = P[row * 4 + 1], c = P[row * 4 + 2], d = P[row * 4 + 3];
            const float mt = (a[0] + b[0] + c[0] + d[0]) * 0.25f; const float da = a[0] - mt, db = b[0] - mt, dc = c[0] - mt, dd = d[0] - mt;
            const float m2 = (a[1] + b[1]) + (c[1] + d[1]) + 64.0f * ((da * da + db * db) + (dc * dc + dd * dd));
            __hip_atomic_store(xbuf + ((size_t)(pm * 256 + row) * 8 + pn), ((unsigned long long)__float_as_uint(m2) << 32) | __float_as_uint(mt), __ATOMIC_RELAXED, __HIP_MEMORY_SCOPE_AGENT); }
        asm volatile("s_waitcnt vmcnt(0)" ::: "memory");
        if (lane == 0) __hip_atomic_fetch_add(cnt + 64 * pm, 1u, __ATOMIC_RELAXED, __HIP_MEMORY_SCOPE_AGENT);
        if (wid == 0) { unsigned sp = 0;
            while ((unsigned)__builtin_amdgcn_readfirstlane(__hip_atomic_load(cnt + 64 * pm, __ATOMIC_RELAXED, __HIP_MEMORY_SCOPE_AGENT)) < 64u) { __builtin_amdgcn_s_sleep(2); if (++sp > (1u << 22)) break; }
            __builtin_amdgcn_fence(__ATOMIC_ACQUIRE, "agent"); }
        asm volatile("s_waitcnt vmcnt(0) lgkmcnt(0)" ::: "memory"); __builtin_amdgcn_s_barrier(); asm volatile("" ::: "memory");
        if (lane < 32) { const unsigned long long* slot = xbuf + (size_t)(pm * 256 + row) * 8; float mt[8], m2[8]; float ms = 0.f;
#pragma unroll
            for (int t = 0; t < 8; ++t) { const unsigned long long w = __hip_atomic_load(slot + t, __ATOMIC_RELAXED, __HIP_MEMORY_SCOPE_AGENT); mt[t] = __uint_as_float((unsigned)w); m2[t] = __uint_as_float((unsigned)(w >> 32)); ms += mt[t]; }
            const float mean = ms * 0.125f; float q = 0.f;
#pragma unroll
            for (int t = 0; t < 8; ++t) { const float dm = mt[t] - mean; q += m2[t] + 256.0f * dm * dm; }
            S[row] = (f32x2){mean, 1.0f / sqrtf(q * (1.0f / 2048.0f) + eps)}; }
        asm volatile("s_waitcnt lgkmcnt(0)" ::: "memory"); __builtin_amdgcn_s_barrier(); asm volatile("" ::: "memory");
    } };
struct EpiResLn1 { static constexpr bool PERM = false, AFTER_DRAIN = true; bf16_t* HBp; const float *bias, *lng, *lnb; PanelStats8 st;
    __device__ __forceinline__ void fused(AccT& acc, const GUnit& u, int wr, int wc, int fr, int fq, LAS unsigned char* lds, int wid) const {
        const int pm = u.i0, pn = u.i1; const int c0 = pn * 256 + wc * 32 + 4 * fq; const LAS f32x2* S = (const LAS f32x2*)(lds + 8192);
#pragma unroll
        for (int bj = 0; bj < 2; ++bj)
#pragma unroll
            for (int n = 0; n < 2; ++n) { const f32x4 bv = *(const f32x4*)(bias + c0 + bj * 128 + n * 16);
#pragma unroll
                for (int ai = 0; ai < 2; ++ai)
#pragma unroll
                    for (int m = 0; m < 4; ++m) { const size_t off = (size_t)(pm * 256 + ai * 128 + wr * 64 + m * 16 + fr) * 2048 + c0 + bj * 128 + n * 16;
                        acc[ai][bj][m][n] += bv + DN_ALPHA * bf4(*(const u32x2*)(HBp + off)); } }
        st.run(acc, pm, pn, wr, wc, fr, fq, lds, wid);
#pragma unroll
        for (int bj = 0; bj < 2; ++bj)
#pragma unroll
            for (int n = 0; n < 2; ++n) { const f32x4 gg = *(const f32x4*)(lng + c0 + bj * 128 + n * 16), bb = *(const f32x4*)(lnb + c0 + bj * 128 + n * 16);
#pragma unroll
                for (int ai = 0; ai < 2; ++ai)
#pragma unroll
                    for (int m = 0; m < 4; ++m) { const int r = ai * 128 + wr * 64 + m * 16 + fr; const f32x2 sr = S[r]; const size_t off = (size_t)(pm * 256 + r) * 2048 + c0 + bj * 128 + n * 16;
                        const f32x4 o = (acc[ai][bj][m][n] - sr[0]) * sr[1] * gg + bb; u32x2 w; w.x = cvt_pk_bf16(o[0], o[1]); w.y = cvt_pk_bf16(o[2], o[3]); *(u32x2*)(HBp + off) = w; } }
    } };
struct EpiResLn2 { static constexpr bool PERM = false, AFTER_DRAIN = true; const bf16_t* HBp; const float *bias, *lng, *lnb; float* out; const bf16_t* SGPW; PanelStats8 st;
    __device__ __forceinline__ void fused(AccT& acc, const GUnit& u, int wr, int wc, int fr, int fq, LAS unsigned char* lds, int wid) const {
        const int pm = u.i0, pn = u.i1; const int c0 = pn * 256 + wc * 32 + 4 * fq; const LAS f32x2* S = (const LAS f32x2*)(lds + 8192);
        const bf16_t* sgp = SGPW + (size_t)pm * (1u << 20);
        f32x4 bv[2][2];
#pragma unroll
        for (int bj = 0; bj < 2; ++bj)
#pragma unroll
            for (int n = 0; n < 2; ++n) bv[bj][n] = *(const f32x4*)(bias + c0 + bj * 128 + n * 16);
#pragma unroll
        for (int ai = 0; ai < 2; ++ai)
#pragma unroll
            for (int m = 0; m < 4; ++m) { const int r = ai * 128 + wr * 64 + m * 16 + fr; const size_t lo = (size_t)r * 2048 + c0; const bf16_t* hp = HBp + (size_t)(pm * 256 + r) * 2048 + c0;
#pragma unroll
                for (int bj = 0; bj < 2; ++bj)
#pragma unroll
                    for (int n = 0; n < 2; ++n) { const int co = bj * 128 + n * 16;
                        acc[ai][bj][m][n] += bv[bj][n] + DN_ALPHA * bf4(*(const u32x2*)(hp + co)) + bf4(*(const u32x2*)(sgp + lo + co)) * bf4(*(const u32x2*)(sgp + (1u << 19) + lo + co)); }
                asm volatile("" : "+v"(acc[ai][0][m][0]), "+v"(acc[ai][0][m][1]), "+v"(acc[ai][1][m][0]), "+v"(acc[ai][1][m][1])); }
        st.run(acc, pm, pn, wr, wc, fr, fq, lds, wid);
#pragma unroll
        for (int bj = 0; bj < 2; ++bj)
#pragma unroll
            for (int n = 0; n < 2; ++n) { const f32x4 gg = *(const f32x4*)(lng + c0 + bj * 128 + n * 16), bb = *(const f32x4*)(lnb + c0 + bj * 128 + n * 16);
#pragma unroll
                for (int ai = 0; ai < 2; ++ai)
#pragma unroll
                    for (int m = 0; m < 4; ++m) { const int r = ai * 128 + wr * 64 + m * 16 + fr; const f32x2 sr = S[r];
                        *(f32x4*)(out + (size_t)(pm * 256 + r) * 2048 + c0 + bj * 128 + n * 16) = (acc[ai][bj][m][n] - sr[0]) * sr[1] * gg + bb; } }
    } };
struct EpiG { static constexpr bool PERM = true, AFTER_DRAIN = false; bf16_t *G0, *G1; const float* bias;
    __device__ __forceinline__ void operator()(AccT& acc, const GUnit& u, int wr, int wc, int fr, int fq) const {
        const int pm = u.i0, h = u.i1; bf16_t* base = (pm < 16 ? G0 : G1) + (size_t)(pm & 15) * 256 * 4096 + h * 256;
        epi_bf16_store<0>(acc, base, 4096, bias + h * 256, wr, wc, fr, fq); } };
__device__ __forceinline__ float bfu(unsigned short v) { return __uint_as_float(((unsigned)v) << 16); }
__device__ __forceinline__ void rg_gate(float pa, float px, float spv, float xc, float& a, float& b) {
    const float r = fast_sigmoid(pa), ig = fast_sigmoid(px); const float la = spv * r; a = __expf(la); const float x = 2.0f * la;
    const float om = -x * (1.0f + x * (0.5f + x * (0.16666667f + x * (0.041666668f + x * 0.008333334f))));
    b = __builtin_amdgcn_sqrtf(fmaxf(om, 0.f)) * ig * xc; }
__device__ __forceinline__ void rg_gate2(float pa, float px, float spv, float xc, float& a, float& b, float& r) {
    r = fast_sigmoid(pa); const float ig = fast_sigmoid(px); const float la = spv * r; a = __expf(la); const float x = 2.0f * la;
    const float om = -x * (1.0f + x * (0.5f + x * (0.16666667f + x * (0.041666668f + x * 0.008333334f))));
    b = __builtin_amdgcn_sqrtf(fmaxf(om, 0.f)) * ig * xc; }
struct RgCtx { const bf16_t *XR, *G0, *G1, *Z; const float *convw, *convb, *sp; float* agg; bf16_t* ypre; };
__device__ __forceinline__ const bf16_t* g_row(const RgCtx& R, int t) { return (t < 4096 ? R.G0 : R.G1) + (size_t)(t & 4095) * 4096; }
__device__ __forceinline__ void rg_pass_a(const RgCtx& R, int half, int seg, int tid) {
    const int c = half * 512 + tid, gcol = (c >> 6) * 256 + (c & 63) * 4, t0 = seg * 64;
    const float w0 = R.convw[c], w1 = R.convw[1024 + c], w2 = R.convw[2048 + c], w3 = R.convw[3072 + c], cb = R.convb[c], sp0 = R.sp[c], sp1 = R.sp[1024 + c];
    const bf16_t* xp = R.XR + c;
    float x0 = bfu(xp[(size_t)(t0 + 0) * 1024]), x1 = bfu(xp[(size_t)(t0 + 1) * 1024]), x2 = bfu(xp[(size_t)(t0 + 2) * 1024]);
    float Af = 1.f, Bf = 0.f, Ab = 1.f, Bb = 0.f;
    for (int tb = 0; tb < 64; tb += 16) {
        u32x2 gq[16]; unsigned short xn[16];
#pragma unroll
        for (int i = 0; i < 16; ++i) { const int t = t0 + tb + i; gq[i] = *(const u32x2*)(g_row(R, t) + gcol); xn[i] = xp[(size_t)(t + 3) * 1024]; }
#pragma unroll
        for (int i = 0; i < 16; ++i) { const float x3 = bfu(xn[i]); const float xc = cb + w0 * x0 + w1 * x1 + w2 * x2 + w3 * x3; x0 = x1; x1 = x2; x2 = x3;
            float a, b, r0, r1, b0; rg_gate2(bf_lo(gq[i].x), bf_lo(gq[i].y), sp0, xc, a, b, r0); Bf = a * Bf + b; Af = a * Af; b0 = b;
            rg_gate2(bf_hi(gq[i].x), bf_hi(gq[i].y), sp1, xc, a, b, r1); Bb = Ab * b + Bb; Ab = Ab * a;
            u32x2 w; w.x = cvt_pk_bf16(r0, r1); w.y = cvt_pk_bf16(b0, b); *(u32x2*)((bf16_t*)g_row(R, t0 + tb + i) + gcol) = w; }
    }
    *(f32x2*)(R.agg + ((size_t)(seg * 2 + 0) * 1024 + c) * 2) = (f32x2){Af, Bf};
    *(f32x2*)(R.agg + ((size_t)(seg * 2 + 1) * 1024 + c) * 2) = (f32x2){Ab, Bb};
}
__device__ __forceinline__ void rg_pass_c(const RgCtx& R, int half, int seg, int tid, LAS float* Lh) {
    const int c = half * 512 + tid, gcol = (c >> 6) * 256 + (c & 63) * 4, t0 = seg * 64;
    const float sp0 = R.sp[c], sp1 = R.sp[1024 + c];
    const f32x2* ag = (const f32x2*)R.agg;
    float hf = 0.f, hb = 0.f;
    {
#pragma unroll 1
        for (int sb = 0; sb < 128; sb += 32) { f32x2 ab[32];
#pragma unroll
            for (int i = 0; i < 32; ++i) { const int s2 = sb + i; ab[i] = (s2 < seg) ? ag[(size_t)(s2 * 2 + 0) * 1024 + c] : (f32x2){1.f, 0.f}; }
#pragma unroll
            for (int i = 0; i < 32; ++i) hf = ab[i][0] * hf + ab[i][1]; }
#pragma unroll 1
        for (int sb = 96; sb >= 0; sb -= 32) { f32x2 ab[32];
#pragma unroll
            for (int i = 0; i < 32; ++i) { const int s2 = sb + 31 - i; ab[i] = (s2 > seg) ? ag[(size_t)(s2 * 2 + 1) * 1024 + c] : (f32x2){1.f, 0.f}; }
#pragma unroll
            for (int i = 0; i < 32; ++i) hb = ab[i][0] * hb + ab[i][1]; }
    }
    {
        for (int tb = 0; tb < 64; tb += 16) {
            u32x2 gq[16];
#pragma unroll
            for (int i = 0; i < 16; ++i) gq[i] = *(const u32x2*)(g_row(R, t0 + tb + i) + gcol);
#pragma unroll
            for (int i = 0; i < 16; ++i) { const float a = __expf(sp0 * bf_lo(gq[i].x)); hf = a * hf + bf_lo(gq[i].y); Lh[(tb + i) * 512 + tid] = hf; }
        }
    }
    {
        for (int tb = 48; tb >= 0; tb -= 16) {
            u32x2 gq[16]; unsigned short zz[16];
#pragma unroll
            for (int i = 0; i < 16; ++i) { const int t = t0 + tb + 15 - i; gq[i] = *(const u32x2*)(g_row(R, t) + gcol); zz[i] = R.Z[(size_t)t * 1024 + c]; }
#pragma unroll
            for (int i = 0; i < 16; ++i) { const int tl = tb + 15 - i; const float a = __expf(sp1 * bf_hi(gq[i].x)); hb = a * hb + bf_hi(gq[i].y);
                const float o = (Lh[tl * 512 + tid] + hb) * gelu_tanh(bfu(zz[i]));
                R.ypre[(size_t)(t0 + tl) * 2048 + 1024 + c] = (bf16_t)(cvt_pk_bf16(o, 0.f) & 0xffffu); }
        }
    }
}

#ifndef NAIVE_GEMM
#define NAIVE_GEMM 0
#endif
template <class Epi, class Sched>
__device__ __forceinline__ void gemm_phase_naive(LAS unsigned char* lds, const int wid, const GParm gp, const Sched& S, const Epi& E) {
    const int lane = fresh_lane(), tid = wid * 64 + lane, wr = wid >> 2, wc = wid & 3, fr = lane & 15, fq = lane >> 4;
    GUnit cur;
    for (int ui = 0; S.next(ui, cur); ++ui) {
        f32x4 acc[2][2][4][2];
#pragma unroll
        for (int ai = 0; ai < 2; ++ai)
#pragma unroll
            for (int bj = 0; bj < 2; ++bj)
#pragma unroll
                for (int m = 0; m < 4; ++m)
#pragma unroll
                    for (int n = 0; n < 2; ++n)
#pragma unroll
                        for (int e = 0; e < 4; ++e) {
                            const int row = 128 * ai + 64 * wr + 16 * m + fr; const int col = Epi::PERM ? (128 * bj + 32 * wc + 8 * fq + 4 * n + e) : (128 * bj + 32 * wc + 16 * n + 4 * fq + e);
                            const char* ap = cur.A + (size_t)row * gp.a_rs; const char* bp = cur.B + (size_t)col * gp.K * 2; float sum = 0.f;
                            for (int k = 0; k < gp.K; k += 8) { const int kt = k >> 6, C = k & 63;
                                const u32x4 av = *(const u32x4*)(ap + (size_t)kt * gp.a_ks + ((C / gp.a_cw) * gp.a_cs + (C % gp.a_cw)) * 2), bv = *(const u32x4*)(bp + k * 2);
                                sum += bf_lo(av.x) * bf_lo(bv.x) + bf_hi(av.x) * bf_hi(bv.x) + bf_lo(av.y) * bf_lo(bv.y) + bf_hi(av.y) * bf_hi(bv.y) + bf_lo(av.z) * bf_lo(bv.z) + bf_hi(av.z) * bf_hi(bv.z) + bf_lo(av.w) * bf_lo(bv.w) + bf_hi(av.w) * bf_hi(bv.w); }
                            acc[ai][bj][m][n][e] = sum; }
        if constexpr (Epi::AFTER_DRAIN) { __syncthreads(); E.fused(acc, cur, wr, wc, fr, fq, lds, wid); } else E(acc, cur, wr, wc, fr, fq);
    }
    __syncthreads();
}
#if NAIVE_GEMM
#define GEMM_PHASE gemm_phase_naive
#else
#define GEMM_PHASE pg8::gemm_phase
#endif
__device__ __forceinline__ void transpose_item(const float* W, int K, int N, bf16_t* WT, LAS float* scr, int item, int lane) {
    const int nblk = N / 64, kb = item / nblk, nb = item % nblk, k0 = 64 * kb, n0 = 64 * nb;
    const float* src = W + (size_t)k0 * N + n0 + lane;
#pragma unroll 32
    for (int i = 0; i < 64; ++i) scr[i * 65 + lane] = src[(size_t)i * N];
    LDS_WAIT();
    const int c = lane & 7;
#pragma unroll
    for (int j = 0; j < 8; ++j) { const int n = (lane >> 3) + 8 * j; const LAS float* sp = scr + (8 * c) * 65 + n;
        u32x4 o; o.x = cvt_pk_bf16(sp[0 * 65], sp[1 * 65]); o.y = cvt_pk_bf16(sp[2 * 65], sp[3 * 65]); o.z = cvt_pk_bf16(sp[4 * 65], sp[5 * 65]); o.w = cvt_pk_bf16(sp[6 * 65], sp[7 * 65]);
        *(u32x4*)(WT + (size_t)(n0 + n) * K + k0 + 8 * c) = o; }
    LDS_WAIT();
}
template <bool OUT_BF16> __device__ __forceinline__ void ln_row(const float* xrow, const float* g, const float* b, void* orow, int lane) {
    const f32x4* xr = (const f32x4*)xrow + lane; f32x4 v[8]; float s = 0.f;
#pragma unroll
    for (int j = 0; j < 8; ++j) { v[j] = xr[64 * j]; s += (v[j][0] + v[j][1]) + (v[j][2] + v[j][3]); }
    const float mean = wave_sum(s) * (1.f / DM); float s2 = 0.f;
#pragma unroll
    for (int j = 0; j < 8; ++j) { v[j] = v[j] - mean; s2 += (v[j][0] * v[j][0] + v[j][1] * v[j][1]) + (v[j][2] * v[j][2] + v[j][3] * v[j][3]); }
    const float rstd = 1.0f / sqrtf(wave_sum(s2) * (1.f / DM) + LN_EPS);
#pragma unroll
    for (int j = 0; j < 8; ++j) { const f32x4 gg = ((const f32x4*)g)[lane + 64 * j], bb = ((const f32x4*)b)[lane + 64 * j]; const f32x4 o = v[j] * rstd * gg + bb;
        if (OUT_BF16) { u32x2 w; w.x = cvt_pk_bf16(o[0], o[1]); w.y = cvt_pk_bf16(o[2], o[3]); ((u32x2*)orow)[lane + 64 * j] = w; }
        else ((f32x4*)orow)[lane + 64 * j] = o; }
}
__device__ __forceinline__ void cpow(float lrs, float th, int j, float& re, float& im) {
    double a = (double)j * (double)th * 0.15915494309189535; a -= rint(a); const float af = 2.0f * (float)a;
    const float mag = expf((float)j * lrs); re = mag * cospif(af); im = mag * sinpif(af);
}


#ifndef NAIVE_RG
#define NAIVE_RG 0
#endif
__device__ __forceinline__ void naive_rg_channel(const RgCtx& R, int c) {
    const int gcol = (c >> 6) * 256 + (c & 63);
    const float w0 = R.convw[c], w1 = R.convw[1024 + c], w2 = R.convw[2048 + c], w3 = R.convw[3072 + c], cb = R.convb[c], sp0 = R.sp[c], sp1 = R.sp[1024 + c];
    const bf16_t* xp = R.XR + c; float h = 0.f;
    for (int t = 0; t < SEQ; ++t) { const float xc = cb + w0 * bfu(xp[(size_t)t * 1024]) + w1 * bfu(xp[(size_t)(t + 1) * 1024]) + w2 * bfu(xp[(size_t)(t + 2) * 1024]) + w3 * bfu(xp[(size_t)(t + 3) * 1024]);
        const bf16_t* g = g_row(R, t) + gcol; float a, b; rg_gate(bfu(g[0]), bfu(g[128]), sp0, xc, a, b); h = a * h + b;
        R.ypre[(size_t)t * 2048 + 1024 + c] = (bf16_t)(cvt_pk_bf16(h, 0.f) & 0xffffu); }
    __builtin_amdgcn_fence(__ATOMIC_SEQ_CST, "agent");
    h = 0.f;
    for (int t = SEQ - 1; t >= 0; --t) { const float xc = cb + w0 * bfu(xp[(size_t)t * 1024]) + w1 * bfu(xp[(size_t)(t + 1) * 1024]) + w2 * bfu(xp[(size_t)(t + 2) * 1024]) + w3 * bfu(xp[(size_t)(t + 3) * 1024]);
        const bf16_t* g = g_row(R, t) + gcol; float a, b; rg_gate(bfu(g[64]), bfu(g[192]), sp1, xc, a, b); h = a * h + b;
        const size_t o = (size_t)t * 2048 + 1024 + c; const float y = (bfu(R.ypre[o]) + h) * gelu_tanh(bfu(R.Z[(size_t)t * 1024 + c]));
        R.ypre[o] = (bf16_t)(cvt_pk_bf16(y, 0.f) & 0xffffu); }
}

#ifndef NAIVE_S5
#define NAIVE_S5 0
#endif
__device__ __forceinline__ void naive_s5_group(const float* const* in, const bf16_t* U, float* tmp, bf16_t* YG, int g, int lane) {
    const float *lre = in[6], *lim = in[7], *lstep = in[8], *bre = in[9], *bim = in[10], *cre = in[11], *cim = in[12], *dd = in[13];
    for (int n = 0; n < 2; ++n) {
        const int p = lane, pi = (n * 64 + g) * 64 + p;
        const float lr = fminf(lre[pi], -1e-4f), li = lim[pi], step = expf(lstep[n * 64 + g]); float ar, ai; cpow(lr * step, li * step, 1, ar, ai);
        const float nr = ar - 1.0f, ni = ai, den = lr * lr + li * li; const float qr = (nr * lr + ni * li) / den, qi = (ni * lr - nr * li) / den;
        float hr = 0.f, hi = 0.f;
        for (int tt = 0; tt < SEQ; ++tt) { const int t = n == 0 ? tt : SEQ - 1 - tt; const bf16_t* up = U + (size_t)t * 1024 + g * 16;
            float bur = 0.f, bui = 0.f;
#pragma unroll
            for (int k = 0; k < 16; ++k) { const float uv = bfu(up[k]); const float br = bre[(size_t)pi * 16 + k], bi = bim[(size_t)pi * 16 + k]; bur += (qr * br - qi * bi) * uv; bui += (qr * bi + qi * br) * uv; }
            const float nhr = ar * hr - ai * hi + bur, nhi = ar * hi + ai * hr + bui; hr = nhr; hi = nhi;
#pragma unroll
            for (int k = 0; k < 16; ++k) { const size_t ci = ((size_t)(n * 64 + g) * 16 + k) * 64 + p; float v = cre[ci] * hr - cim[ci] * hi; v = wave_sum(v);
                if (lane == k) { const size_t o = (size_t)t * 1024 + g * 16 + k;
                    if (n == 0) tmp[o] = v; else { const float y = tmp[o] + v + dd[g * 16 + k] * bfu(up[k]); YG[o] = (bf16_t)(cvt_pk_bf16(gelu_tanh(y), 0.f) & 0xffffu); } } }
        }
        __builtin_amdgcn_fence(__ATOMIC_SEQ_CST, "agent");
    }
}

#define XB_TMO      128
#define XB_XCNT(j)  (256  + 64 * (j))
#define XB_XSUB(j)  (1280 + 64 * (j))
#define XB_XGEN(j)  (2304 + 64 * (j))
#define XB_TOP      3328
#define XB_TOPGEN   3392
#define XCD_BAR_WORDS 3456
#define XB_SPIN_CAP (1u << 18)
__device__ __forceinline__ unsigned xb_ld(unsigned* p)              { return __hip_atomic_load(p, __ATOMIC_RELAXED, __HIP_MEMORY_SCOPE_AGENT); }
__device__ __forceinline__ unsigned xb_add(unsigned* p, unsigned v) { return __hip_atomic_fetch_add(p, v, __ATOMIC_RELAXED, __HIP_MEMORY_SCOPE_AGENT); }
__device__ __forceinline__ unsigned xb_xcc_id() { return (unsigned)__builtin_amdgcn_s_getreg((3 << 11) | 20) & 0xFu; }
#define XB_SPIN(cond, bar) do { unsigned _sp = 0; while (cond) { __builtin_amdgcn_s_sleep(1); \
    if ((++_sp & 255u) == 0u) { if (xb_ld(&(bar)[XB_TMO])) break; if (_sp > XB_SPIN_CAP) { atomicAdd(&(bar)[XB_TMO], 1u); break; } } } } while (0)
struct XcdBarrier { unsigned* bar; unsigned x; volatile LAS unsigned* st; };
__device__ __forceinline__ void xcd_barrier_complete(unsigned* bar, unsigned x, unsigned G, unsigned& nloc, unsigned& nx) {
    unsigned sum, cnt, mine, sp = 0u;
    for (;;) {
        sum = 0u; cnt = 0u; mine = 0u;
#pragma unroll
        for (unsigned j = 0; j < 16; ++j) { const unsigned c = xb_ld(&bar[XB_XCNT(j)]); sum += c; cnt += (c > 0u) ? 1u : 0u; mine = (j == x) ? c : mine; }
        if (sum == G) break;
        __builtin_amdgcn_s_sleep(1);
        if ((++sp & 255u) == 0u) { if (xb_ld(&bar[XB_TMO])) break; if (sp > XB_SPIN_CAP) { atomicAdd(&bar[XB_TMO], 1u); break; } }
    }
    nloc = mine > 0u ? mine : 1u; nx = cnt > 0u ? cnt : 1u;
}
__device__ __forceinline__ void xcd_barrier(const XcdBarrier& b, unsigned G, int wave) {
    asm volatile("s_waitcnt vmcnt(0)" ::: "memory");
    __syncthreads();
    if (wave == 0) { if (fresh_lane() == 0) {
        unsigned* bar = b.bar;
        __builtin_amdgcn_s_waitcnt(0);
        unsigned nloc = b.st[0], nx = b.st[1];
        if (nloc == 0u) { xcd_barrier_complete(bar, b.x, G, nloc, nx); b.st[0] = nloc; b.st[1] = nx; }
        const unsigned old = xb_add(&bar[XB_XSUB(b.x)], 1u);
        const unsigned gen = old / nloc;
        if (old + 1u == (gen + 1u) * nloc) {
            __builtin_amdgcn_fence(__ATOMIC_RELEASE, "agent");
            asm volatile("s_waitcnt vmcnt(0)" ::: "memory");
            const unsigned og = xb_add(&bar[XB_TOP], 1u);
            const unsigned tg = og / nx;
            if (og + 1u == (tg + 1u) * nx) xb_add(&bar[XB_TOPGEN], 1u);
            else XB_SPIN(xb_ld(&bar[XB_TOPGEN]) == tg, bar);
            __builtin_amdgcn_fence(__ATOMIC_ACQUIRE, "agent");
            xb_add(&bar[XB_XGEN(b.x)], 1u);
            asm volatile("s_waitcnt vmcnt(0)" ::: "memory");
        } else {
            XB_SPIN(xb_ld(&bar[XB_XGEN(b.x)]) == gen, bar);
            __builtin_amdgcn_fence(__ATOMIC_ACQUIRE, "agent");
            asm volatile("s_waitcnt vmcnt(0)" ::: "memory");
        }
    } }
    __syncthreads();
}

__device__ __forceinline__ void grid_barrier(unsigned* bar, unsigned target, int wave) {
    asm volatile("s_waitcnt vmcnt(0)" ::: "memory");
    __syncthreads();
    if (wave == 0) { const int l = fresh_lane();
        if (l == 0) {
            __builtin_amdgcn_fence(__ATOMIC_RELEASE, "agent"); asm volatile("s_waitcnt vmcnt(0)" ::: "memory");
            __hip_atomic_fetch_add(bar, 1u, __ATOMIC_RELAXED, __HIP_MEMORY_SCOPE_AGENT);
            while (__hip_atomic_load(bar, __ATOMIC_RELAXED, __HIP_MEMORY_SCOPE_AGENT) < target) __builtin_amdgcn_s_sleep(2);
            __builtin_amdgcn_fence(__ATOMIC_ACQUIRE, "agent"); asm volatile("s_waitcnt vmcnt(0)" ::: "memory");
        } }
    __syncthreads();
}

struct Args { const float* in[38]; float* out; unsigned char* ws; int ph_lo, ph_hi; };
typedef const float* cfp_t;
typedef const __attribute__((address_space(4))) cfp_t* kin_t;

__device__ __forceinline__ void s5_precompute(const kin_t ain, unsigned char* aws, int g, int hq, int nh, LAS float* L, const int tid) {
    const float *lre = ain[6], *lim = ain[7], *lstep = ain[8], *bre = ain[9], *bim = ain[10], *cre = ain[11], *cim = ain[12], *dd = ain[13];
    LAS float *PWre = L, *PWim = L + 4224, *BBre = L + 8448, *BBim = L + 10496, *CCre = L + 12544, *CCim = L + 14592, *MT = L + 16640, *C2re = L + 33280, *C2im = L + 35328, *Dl = L + 37376;
    bf16_t* WGg = (bf16_t*)(aws + WS_WG) + (size_t)g * 768 * 512; bf16_t* WCg = (bf16_t*)(aws + WS_WC) + (size_t)g * 512 * 256;
#define PSTAMP(i) do { if (TSTAMP && blockIdx.x == 128 && tid == 0) ((unsigned long long*)(aws + WS_CTR + 1024))[i] = __builtin_amdgcn_s_memrealtime(); } while (0)
    PSTAMP(20);
    {
        const int np = tid & 127, jj = tid >> 7, n = np >> 6, p = np & 63; const int pi = (n * 64 + g) * 64 + p;
        const float lr = fminf(lre[pi], -1e-4f), li = lim[pi], step = expf(lstep[n * 64 + g]); const float lrs = lr * step, th = li * step;
        for (int j = jj; j <= 32; j += 4) { float r, i; cpow(lrs, th, j, r, i); PWre[np * 33 + j] = r; PWim[np * 33 + j] = i; }
        float l1r, l1i; cpow(lrs, th, 1, l1r, l1i);
        const float nr = l1r - 1.0f, ni = l1i, den = lr * lr + li * li; const float qr = (nr * lr + ni * li) / den, qi = (ni * lr - nr * li) / den;
#pragma unroll
        for (int k = jj * 4; k < jj * 4 + 4; ++k) { const float br = bre[(size_t)pi * 16 + k], bi = bim[(size_t)pi * 16 + k]; BBre[np * 16 + k] = qr * br - qi * bi; BBim[np * 16 + k] = qr * bi + qi * br; }
        for (int e = tid; e < 2048; e += 512) { const int n2 = e >> 10, k = (e >> 6) & 15, p2 = e & 63; const size_t ci = ((size_t)(n2 * 64 + g) * 16 + k) * 64 + p2; CCre[(n2 * 64 + p2) * 16 + k] = cre[ci]; CCim[(n2 * 64 + p2) * 16 + k] = cim[ci]; C2re[e] = cre[ci]; C2im[e] = cim[ci]; }
        if (tid < 16) Dl[tid] = dd[g * 16 + tid];
    }
    __syncthreads();
    PSTAMP(21);
    for (int i = 0; i < 3; ++i) {
        if (nh == 2) { if (i < 2 && i != hq) continue; if (i == 2 && (hq != 0 || tid >= 16)) continue; } else if (i == 2) continue;
        const int bq = (i == 2) ? 512 + tid : tid + 512 * i, n = bq >> 9, j = (bq >> 4) & 31, kob = (bq >> 2) & 3, kib = bq & 3;
        f32x4 m0 = {0.f, 0.f, 0.f, 0.f}, m1 = m0, m2 = m0, m3 = m0;
        for (int p = 0; p < 64; ++p) { const int np = n * 64 + p; const float pr = PWre[np * 33 + j], pi2 = PWim[np * 33 + j];
            const f32x4 br = *(const LAS f32x4*)(BBre + np * 16 + 4 * kib), bi = *(const LAS f32x4*)(BBim + np * 16 + 4 * kib), cr = *(const LAS f32x4*)(CCre + np * 16 + 4 * kob), ci = *(const LAS f32x4*)(CCim + np * 16 + 4 * kob);
            const f32x4 er = pr * br - pi2 * bi, ei = pr * bi + pi2 * br;
            m0 += cr[0] * er - ci[0] * ei; m1 += cr[1] * er - ci[1] * ei; m2 += cr[2] * er - ci[2] * ei; m3 += cr[3] * er - ci[3] * ei; }
        LAS float* o = MT + (n * 32 + j) * 260 + (4 * kob) * 16 + 4 * kib;
        *(LAS f32x4*)o = m0; *(LAS f32x4*)(o + 16) = m1; *(LAS f32x4*)(o + 32) = m2; *(LAS f32x4*)(o + 48) = m3;
    }
    __syncthreads();
    PSTAMP(22);
    for (int i = 0; i < 64; ++i) {
        const int idx = tid + 512 * i, row = idx >> 6, cp = idx & 63, t = row >> 4, ko = row & 15, s = cp >> 1, ki0 = (cp & 1) * 8;
        if (nh == 2 && ((t >= s) != (hq == 0))) continue;
        f32x4 v0, v1;
        if (t != s) { const LAS float* src = MT + ((t > s ? 0 : 1) * 32 + (t > s ? t - s : s - t)) * 260 + ko * 16 + ki0; v0 = *(const LAS f32x4*)src; v1 = *(const LAS f32x4*)(src + 4); }
        else { const LAS float* s0 = MT + ko * 16 + ki0; const LAS float* s1 = MT + 32 * 260 + ko * 16 + ki0; v0 = *(const LAS f32x4*)s0 + *(const LAS f32x4*)s1; v1 = *(const LAS f32x4*)(s0 + 4) + *(const LAS f32x4*)(s1 + 4);
            const float dv = Dl[ko];
#pragma unroll
            for (int e = 0; e < 4; ++e) { if (ki0 + e == ko) v0[e] += dv; if (ki0 + 4 + e == ko) v1[e] += dv; } }
        u32x4 w; w.x = cvt_pk_bf16(v0[0], v0[1]); w.y = cvt_pk_bf16(v0[2], v0[3]); w.z = cvt_pk_bf16(v1[0], v1[1]); w.w = cvt_pk_bf16(v1[2], v1[3]);
        *(u32x4*)(WGg + (size_t)row * 512 + cp * 8) = w;
    }
    for (int i = hq * (32 / nh); i < (hq + 1) * (32 / nh); ++i) {
        const int idx = tid + 512 * i, q = idx >> 6, cp = idx & 63, n = q >> 7, ri = (q >> 6) & 1, p = q & 63, s = cp >> 1, ki0 = (cp & 1) * 8, e = n == 0 ? 31 - s : s, np = n * 64 + p;
        const float pr = PWre[np * 33 + e], pi2 = PWim[np * 33 + e]; float v[8];
#pragma unroll
        for (int k = 0; k < 8; ++k) { const float br = BBre[np * 16 + ki0 + k], bi = BBim[np * 16 + ki0 + k]; v[k] = ri == 0 ? pr * br - pi2 * bi : pr * bi + pi2 * br; }
        u32x4 w; w.x = cvt_pk_bf16(v[0], v[1]); w.y = cvt_pk_bf16(v[2], v[3]); w.z = cvt_pk_bf16(v[4], v[5]); w.w = cvt_pk_bf16(v[6], v[7]);
        *(u32x4*)(WGg + (size_t)(512 + q) * 512 + cp * 8) = w;
    }
    for (int i = 0; i < 32 / nh; ++i) {
        const int idx = tid + 512 * i, row = nh == 2 ? idx >> 4 : idx >> 5, q0 = nh == 2 ? hq * 128 + (idx & 15) * 8 : (idx & 31) * 8, n = q0 >> 7, ri = (q0 >> 6) & 1, p0 = q0 & 63, t = row >> 4, ko = row & 15, e = n == 0 ? t + 1 : 32 - t; float v[8];
#pragma unroll
        for (int k = 0; k < 8; ++k) { const int np = n * 64 + p0 + k; const float cr = C2re[(n * 16 + ko) * 64 + p0 + k], ci = C2im[(n * 16 + ko) * 64 + p0 + k], pr = PWre[np * 33 + e], pi2 = PWim[np * 33 + e];
            v[k] = ri == 0 ? cr * pr - ci * pi2 : -(cr * pi2 + ci * pr); }
        u32x4 w; w.x = cvt_pk_bf16(v[0], v[1]); w.y = cvt_pk_bf16(v[2], v[3]); w.z = cvt_pk_bf16(v[4], v[5]); w.w = cvt_pk_bf16(v[6], v[7]);
        *(u32x4*)(WCg + (size_t)row * 256 + q0) = w;
    }
    __syncthreads();
    PSTAMP(23);
}


#ifndef DIAG
#define DIAG 0
#endif
__device__ __forceinline__ void diag_ffn(const float* const* in, const unsigned char* ws, const float* outp, unsigned* flagw, int gtid, int GT) {
    const bf16_t* h1 = (const bf16_t*)(ws + WS_HB); const bf16_t* T = (const bf16_t*)(ws + WS_T); const float* V2 = (const float*)(ws + WS_V2);
    const float *w1 = in[29], *b1 = in[30], *w2 = in[31], *b2 = in[32], *wp = in[33], *wg = in[34], *bg = in[35], *pp = in[1];
    for (int sidx = gtid; sidx < 16384; sidx += GT) {
        unsigned hsh = (unsigned)sidx * 2654435761u, h2 = ((unsigned)sidx + 977u) * 2246822519u; const int r = (hsh >> 8) % SEQ; const int c = (h2 >> 6) % DFF; const int c2 = c % DM;
        float a = b1[c]; for (int k = 0; k < DM; ++k) a += bfu(h1[(size_t)r * DM + k]) * w1[(size_t)k * DFF + c];
        a = fmaxf(a, 0.f); a = a * a; const float tv = bfu(T[(size_t)r * DFF + c]);
        if (fabsf(tv - a) > 0.008f * fabsf(a) + 0.006f) atomicAdd(flagw + 0, 1u);
        float f = b2[c2]; for (int k = 0; k < DFF; ++k) f += bfu(T[(size_t)r * DFF + k]) * w2[(size_t)k * DM + c2];
        float gt = bg[c2]; for (int k = 0; k < DM; ++k) gt += bfu(h1[(size_t)r * DM + k]) * wg[(size_t)k * DM + c2];
        float pw = 0.f; for (int k = 0; k < PLE; ++k) pw += pp[(size_t)r * PLE + k] * wp[(size_t)k * DM + c2];
        const float v2 = DN_ALPHA * bfu(h1[(size_t)r * DM + c2]) + f + fast_sigmoid(gt) * pw; const float got = V2[(size_t)r * DM + c2];
        if (fabsf(got - v2) > 0.008f * fabsf(v2) + 0.006f) atomicAdd(flagw + 1, 1u);
        { const float* vr = V2 + (size_t)r * DM; float m = 0.f; for (int k = 0; k < DM; ++k) m += vr[k]; m /= DM; float v = 0.f; for (int k = 0; k < DM; ++k) { const float d = vr[k] - m; v += d * d; } v /= DM;
          const float e = (vr[c2] - m) / sqrtf(v + LN_EPS) * in[36][c2] + in[37][c2]; const float go = outp[(size_t)r * DM + c2]; if (fabsf(go - e) > 0.004f * fabsf(e) + 0.003f) atomicAdd(flagw + 2, 1u); }
    }
}

__device__ __forceinline__ void diag_pre(const float* const* in, const unsigned char* ws, const unsigned char* dout, unsigned* flagw, int gtid, int GT) {
    const bf16_t* h0 = (const bf16_t*)(ws + WS_HB); const bf16_t* U = (const bf16_t*)(dout + DO_U); const bf16_t* XRb = (const bf16_t*)(ws + WS_XR) + 2048; const bf16_t* Z = (const bf16_t*)(dout + DO_Z);
    const bf16_t* ypre = (const bf16_t*)(dout + DO_YPRE); const bf16_t* ycat = (const bf16_t*)(ws + WS_YCAT); const bf16_t* yg = (const bf16_t*)(ws + WS_YS5G);
    const float *x = in[0], *lg = in[2], *lb = in[3], *win = in[4], *bin = in[5], *gw_ = in[14], *gb = in[15], *g5 = in[23], *gr = in[24];
    for (int sidx = gtid; sidx < 8192; sidx += GT) {
        unsigned hsh = (unsigned)sidx * 2654435761u, h2 = ((unsigned)sidx + 977u) * 2246822519u; const int r = (hsh >> 8) % SEQ; const int c = (h2 >> 6) % DIN; const int c2 = c % DM; const int c1 = c % DS5;
        { float m = 0.f; for (int k = 0; k < DM; ++k) m += x[(size_t)r * DM + k]; m /= DM; float v = 0.f; for (int k = 0; k < DM; ++k) { const float d = x[(size_t)r * DM + k] - m; v += d * d; } v /= DM;
          const float e = (x[(size_t)r * DM + c2] - m) / sqrtf(v + LN_EPS) * lg[c2] + lb[c2]; const float got = bfu(h0[(size_t)r * DM + c2]); if (fabsf(got - e) > 0.008f * fabsf(e) + 0.006f) atomicAdd(flagw + 0, 1u); }
        { float a = bin[c]; for (int k = 0; k < DM; ++k) a += bfu(h0[(size_t)r * DM + k]) * win[(size_t)k * DIN + c];
          const float got = c < 1024 ? bfu(U[(size_t)r * 1024 + c]) : (c < 2048 ? bfu(XRb[(size_t)r * 1024 + c - 1024]) : bfu(Z[(size_t)r * 1024 + c - 2048])); if (fabsf(got - a) > 0.008f * fabsf(a) + 0.006f) atomicAdd(flagw + 3, 1u); }
        { const int hf = c2 >> 10; float ss = 0.f; for (int k = 0; k < 1024; ++k) { const float y = bfu(ypre[(size_t)r * DM + hf * 1024 + k]); ss += y * y; }
          const float e = bfu(ypre[(size_t)r * DM + c2]) / sqrtf(ss / 1024.f + LN_EPS) * (hf ? gr[c2 - 1024] : g5[c2]); const float got = bfu(ycat[(size_t)r * DM + c2]); if (fabsf(got - e) > 0.008f * fabsf(e) + 0.006f) atomicAdd(flagw + 1, 1u); }
        { float a = gb[c1]; for (int k = 0; k < DS5; ++k) a += bfu(yg[(size_t)r * DS5 + k]) * gw_[(size_t)k * DS5 + c1];
          const float e = bfu(yg[(size_t)r * DS5 + c1]) * fast_sigmoid(a); const float got = bfu(ypre[(size_t)r * DM + c1]); if (fabsf(got - e) > 0.008f * fabsf(e) + 0.006f) atomicAdd(flagw + 2, 1u); }
    }
}

__device__ __forceinline__ void diag_v(const float* const* in, const unsigned char* ws, const unsigned char* dout, unsigned* flagw, int gtid, int GT) {
    const bf16_t* h0 = (const bf16_t*)(ws + WS_HB); const bf16_t* ycat = (const bf16_t*)(ws + WS_YCAT); const float* V = (const float*)dout; const float *wo = in[25], *bo = in[26];
    for (int sidx = gtid; sidx < 16384; sidx += GT) { unsigned hsh = (unsigned)sidx * 2654435761u, h2 = ((unsigned)sidx + 977u) * 2246822519u; const int r = (hsh >> 8) % SEQ; const int c = (h2 >> 6) % DM;
        float a = bo[c] + DN_ALPHA * bfu(h0[(size_t)r * DM + c]); for (int k = 0; k < DM; ++k) a += bfu(ycat[(size_t)r * DM + k]) * wo[(size_t)k * DM + c];
        const float got = V[(size_t)r * DM + c]; if (fabsf(got - a) > 0.008f * fabsf(a) + 0.006f) atomicAdd(flagw + 0, 1u); }
}

__device__ __forceinline__ void diag_g(const float* const* in, const unsigned char* ws, unsigned* flagw, int gtid, int GT) {
    const bf16_t* XRp = (const bf16_t*)(ws + WS_XR); const bf16_t* G0 = (const bf16_t*)(ws + WS_G0); const bf16_t* G1 = (const bf16_t*)(ws + WS_G1);
    const float *convw = in[16], *convb = in[17], *wa = in[18], *ba = in[19], *wx = in[20], *bxx = in[21];
    for (int sidx = gtid; sidx < 16384; sidx += GT) { unsigned hsh = (unsigned)sidx * 2654435761u; unsigned h2 = ((unsigned)sidx + 12345u) * 2246822519u; const int t = (hsh >> 7) % SEQ; const int col = (h2 >> 5) % 4096;
        const int h = col >> 8, row = col & 255, bj = row >> 7, dir = (row >> 6) & 1, ch = row & 63;
        const float* W = (bj == 0 ? wa : wx) + ((size_t)(dir * 16 + h) * 64) * 64 + ch; float a = (bj == 0 ? ba : bxx)[(dir * 16 + h) * 64 + ch];
        for (int i = 0; i < 64; ++i) { const int c = 64 * h + i; float xc = convb[c];
            for (int j = 0; j < 4; ++j) xc += convw[j * 1024 + c] * bfu(XRp[(size_t)(t + j) * 1024 + c]);
            a += xc * W[(size_t)i * 64]; }
        const float got = bfu((t < 4096 ? G0 : G1)[(size_t)(t & 4095) * 4096 + col]);
        if (fabsf(got - a) > 0.008f * fabsf(a) + 0.006f) atomicAdd(flagw + 0, 1u); }
}

#ifndef DIAG_HALF
#define DIAG_HALF 1
#endif
__device__ __forceinline__ void diag_max(const unsigned char* ws, unsigned* flagw, int gtid, int GT) {
    const bf16_t* ycat = (const bf16_t*)(ws + WS_YCAT); float mx = 0.f;
    for (size_t i = gtid; i < (size_t)SEQ * 1024; i += GT) { const size_t r = i >> 10, c = (i & 1023) + DIAG_HALF * 1024; mx = fmaxf(mx, fabsf(bfu(ycat[r * DM + c]))); }
    atomicMax(flagw + 0, __float_as_uint(mx));
}

#ifndef DIAG_SEL
#define DIAG_SEL 4
#endif
__device__ __forceinline__ void diag_rows(const float* outp, unsigned* flagw, int gw, int NGW, int lane) {
    for (int row = gw; row < SEQ; row += NGW) { float mx = 0.f; for (int j = lane; j < DM; j += 64) mx = fmaxf(mx, fabsf(outp[(size_t)row * DM + j]));
#pragma unroll
        for (int o = 1; o < 64; o <<= 1) mx = fmaxf(mx, __shfl_xor(mx, o));
        if (lane == 0 && mx > 12.0f) { atomicAdd(flagw + 0, 1u); atomicMin(flagw + 1, (unsigned)row); atomicMax(flagw + 2, (unsigned)row); } }
}

__device__ __forceinline__ void diag_rows_bf(const bf16_t* p, int ld, float thr, unsigned* flagw, int gw, int NGW, int lane) {
    for (int row = gw; row < SEQ; row += NGW) { float mx = 0.f; for (int j = lane; j < ld; j += 64) mx = fmaxf(mx, fabsf(bfu(p[(size_t)row * ld + j])));
#pragma unroll
        for (int o = 1; o < 64; o <<= 1) mx = fmaxf(mx, __shfl_xor(mx, o));
        if (lane == 0 && mx > thr) { atomicAdd(flagw + 0, 1u); atomicMin(flagw + 1, (unsigned)row); atomicMax(flagw + 2, (unsigned)row); } }
}
template <int PHMASK> __global__ void __launch_bounds__(512, 2) mega(Args) {
    extern __shared__ __attribute__((aligned(16))) unsigned char lds_raw[];
    LAS unsigned char* lds = (LAS unsigned char*)lds_raw;
    const int wave = __builtin_amdgcn_readfirstlane((int)threadIdx.x >> 6);
    const int G = gridDim.x, bx = blockIdx.x;
    const int gw = bx * 8 + wave, NGW = G * 8, GT = G * 512;
#define PH_IDS const int lane = fresh_lane(), tid = wave * 64 + lane, gtid = bx * 512 + tid; (void)tid; (void)gtid; (void)lane
    const kin_t KIN = (kin_t)__builtin_amdgcn_kernarg_segment_ptr();
    unsigned char* ws = (unsigned char*)KIN[39]; unsigned char* dout = (unsigned char*)KIN[38];
    const int* kint = (const int*)0; (void)kint;
#if DIAG == 2
    const int lo = ((const __attribute__((address_space(4))) int*)KIN)[80], hi = 7;
#elif DIAG == 3
    const int lo = ((const __attribute__((address_space(4))) int*)KIN)[80], hi = 8;
#elif DIAG == 4
    const int lo = ((const __attribute__((address_space(4))) int*)KIN)[80], hi = 5;
#elif DIAG == 6
    const int lo = ((const __attribute__((address_space(4))) int*)KIN)[80], hi = 7;
#elif DIAG == 8
    const int lo = ((const __attribute__((address_space(4))) int*)KIN)[80], hi = 9;
#elif DIAG == 11 || DIAG == 12
    const int lo = ((const __attribute__((address_space(4))) int*)KIN)[80], hi = 10;
#else
    const int lo = ((const __attribute__((address_space(4))) int*)KIN)[80], hi = ((const __attribute__((address_space(4))) int*)KIN)[81];
#endif
#define IN(k) (((PHMASK >> (k)) & 1) && lo <= (k) && (k) < hi)
    unsigned nbar = 0; unsigned* gbar = (unsigned*)(ws + WS_CTR) + 32; (void)gbar;
    XcdBarrier xb; xb.bar = (unsigned*)(ws + WS_CTR) + 5120; xb.x = xb_xcc_id(); xb.st = (volatile LAS unsigned*)(lds + 155000);
    if (wave == 0) { if (fresh_lane() == 0) { xb.st[0] = 0u; xb.st[1] = 0u; (void)xb_add(&xb.bar[XB_XCNT(xb.x)], 1u); } }
    __syncthreads();
    if (PHMASK == 0xfff && hi > 4096) cg::this_grid().sync();
#ifndef DBL_MASK
#define DBL_MASK 0
#endif
#define REPS(k) (((DBL_MASK >> (k)) & 1) ? 2 : 1)
#define SEAM(k) do { if (IN(k) && IN((k) + 1)) { ++nbar; xcd_barrier(xb, (unsigned)G, wave); if (TSTAMP && bx == 0 && wave == 0) { if (fresh_lane() == 0) ((unsigned long long*)(ws + WS_CTR + 1024))[(k) + 1] = __builtin_amdgcn_s_memrealtime(); } } } while (0)

#define MK_RG const RgCtx RG{(const bf16_t*)(ws + WS_XR), (const bf16_t*)(ws + WS_G0), (const bf16_t*)(ws + WS_G1), (const bf16_t*)(dout + DO_Z), KIN[16], KIN[17], (const float*)(ws + WS_SP), (float*)(ws + WS_AGG), (bf16_t*)(dout + DO_YPRE)}
    if (TSTAMP && bx == 0 && wave == 0) { if (fresh_lane() == 0) ((unsigned long long*)(ws + WS_CTR + 1024))[0] = __builtin_amdgcn_s_memrealtime(); }
    for (int rep = 0; rep < REPS(0); ++rep) {
    if (IN(0)) { PH_IDS;
        if (G != 256) { for (int g = bx; g < 64; g += G) s5_precompute(KIN, ws, g, 0, 1, (LAS float*)lds, tid); }
        {
            LAS float* scr = (LAS float*)(lds + wave * 16640);
            constexpr int I_IN = (DM / 64) * (DIN / 64), I_OUT = (DM / 64) * (DM / 64), I_PG = I_OUT, I_GLU = (DS5 / 64) * (DS5 / 64), I_PW = (PLE / 64) * (DM / 64), I_LN = SEQ / 8;
            constexpr int NITEMS = I_IN + I_OUT + I_PG + I_GLU + I_PW + I_LN;
            for (int it = gw; it < NITEMS; it += NGW) {
                int r = it;
                if (r < I_IN) { transpose_item(KIN[4], DM, DIN, (bf16_t*)(ws + WS_WINT), scr, r, lane); continue; } r -= I_IN;
                if (r < I_LN) { for (int q = 0; q < 8; ++q) { const int row = r * 8 + q; ln_row<true>(KIN[0] + (size_t)row * DM, KIN[2], KIN[3], (bf16_t*)(ws + WS_HB) + (size_t)row * DM, lane); } continue; } r -= I_LN;
                if (r < I_OUT) { transpose_item(KIN[25], DM, DM, (bf16_t*)(ws + WS_WOUTT), scr, r, lane); continue; } r -= I_OUT;
                if (r < I_PG) { transpose_item(KIN[34], DM, DM, (bf16_t*)(ws + WS_PLEGT), scr, r, lane); continue; } r -= I_PG;
                if (r < I_GLU) { transpose_item(KIN[14], DS5, DS5, (bf16_t*)(ws + WS_GLUT), scr, r, lane); continue; } r -= I_GLU;
                transpose_item(KIN[33], PLE, DM, (bf16_t*)(ws + WS_PLEWT), scr, r, lane);
            }
        }
        {   const float* pp = KIN[1]; bf16_t* pb = (bf16_t*)(ws + WS_PB);
            for (int i = gtid; i < SEQ * PLE / 4; i += GT) { const f32x4 v = ((const f32x4*)pp)[i]; u32x2 w; w.x = cvt_pk_bf16(v[0], v[1]); w.y = cvt_pk_bf16(v[2], v[3]); ((u32x2*)pb)[i] = w; }
            const float *convw = KIN[16], *convb = KIN[17], *wa = KIN[18], *ba = KIN[19], *wx = KIN[20], *bxx = KIN[21], *lam = KIN[22];
            bf16_t* rgw = (bf16_t*)(ws + WS_RGW);
            for (int i = gtid; i < 16 * 256 * 32; i += GT) { const int h = i >> 13, row = (i >> 5) & 255, K0 = (i & 31) * 8, j = K0 >> 6, i0 = K0 & 63, ch = row >> 2, bj = (row >> 1) & 1, dir = row & 1;
                const float* W = (bj == 0 ? wa : wx) + ((size_t)(dir * 16 + h) * 64) * 64 + ch; float v[8];
#pragma unroll
                for (int k = 0; k < 8; ++k) v[k] = convw[j * 1024 + 64 * h + i0 + k] * W[(size_t)(i0 + k) * 64];
                u32x4 w; w.x = cvt_pk_bf16(v[0], v[1]); w.y = cvt_pk_bf16(v[2], v[3]); w.z = cvt_pk_bf16(v[4], v[5]); w.w = cvt_pk_bf16(v[6], v[7]);
                *(u32x4*)(rgw + ((size_t)h * 256 + row) * 256 + K0) = w; }
            float* rgb = (float*)(ws + WS_RGBIAS);
            for (int i = gtid; i < 16 * 256; i += GT) { const int h = i >> 8, row = i & 255, ch = row >> 2, bj = (row >> 1) & 1, dir = row & 1;
                const float* W = (bj == 0 ? wa : wx) + ((size_t)(dir * 16 + h) * 64) * 64 + ch; float s = (bj == 0 ? ba : bxx)[(dir * 16 + h) * 64 + ch];
#pragma unroll
                for (int k = 0; k < 64; ++k) s += convb[64 * h + k] * W[(size_t)k * 64];
                rgb[i] = s; }
            float* spt = (float*)(ws + WS_SP);
            for (int i = gtid; i < 2 * 1024; i += GT) spt[i] = -8.0f * log1pf(expf(-lam[i]));
            unsigned* xr = (unsigned*)(ws + WS_XR);
            for (int i = gtid; i < 1024; i += GT) { xr[i] = 0u; xr[(size_t)(SEQ + 2) * 512 + i] = 0u; }
        }
    }
    if (rep + 1 < REPS(0)) { ++nbar; xcd_barrier(xb, (unsigned)G, wave); } }
    SEAM(0);
    for (int rep = 0; rep < REPS(1); ++rep) {
    if (IN(1)) { PH_IDS;
        SchedStd S; S.so.init(SEQ, DIN, G, bx); S.A = (const char*)(ws + WS_HB); S.B = (const char*)(ws + WS_WINT); S.a_tile = (size_t)256 * DM * 2; S.b_tile = (size_t)256 * DM * 2;
        EpiProj E{(bf16_t*)(dout + DO_U), (bf16_t*)(ws + WS_XR), (bf16_t*)(dout + DO_Z), KIN[5]};
        GEMM_PHASE(lds, wave, GParm{DM, DM * 2, 128, 64, 0}, S, E);
        if (G == 256 && bx >= 128) { __syncthreads(); const int t2 = wave * 64 + fresh_lane(); s5_precompute(KIN, ws, (bx - 128) >> 1, (bx - 128) & 1, 2, (LAS float*)lds, t2); }
    }
    if (rep + 1 < REPS(1)) { ++nbar; xcd_barrier(xb, (unsigned)G, wave); } }
    SEAM(1);
    for (int rep = 0; rep < REPS(2); ++rep) {
    if (IN(2)) { PH_IDS;
        { SchedS5a S{(const char*)(dout + DO_U), (const char*)(ws + WS_WG), G, bx}; EpiS5a E{(bf16_t*)(ws + WS_YINTRA), (float*)(ws + WS_S)};
          GEMM_PHASE(lds, wave, GParm{512, 1024, 128, 64, 0}, S, E); }
        { SchedRG S{(const char*)(ws + WS_XR), (const char*)(ws + WS_RGW), G, bx}; EpiG E{(bf16_t*)(ws + WS_G0), (bf16_t*)(ws + WS_G1), (const float*)(ws + WS_RGBIAS)};
          GEMM_PHASE(lds, wave, GParm{256, 2048, 2048, 64, 0}, S, E); }
    }
    if (rep + 1 < REPS(2)) { ++nbar; xcd_barrier(xb, (unsigned)G, wave); } }
    SEAM(2);
    for (int rep = 0; rep < REPS(3); ++rep) {
    if (IN(3)) { PH_IDS;
        if (bx < 128) {
            const int g = bx >> 1, n = bx & 1; const float* Sg = (const float*)(ws + WS_S) + (size_t)g * NCH * 256 + n * 128; LAS float* Ls = (LAS float*)lds;
            for (int i = tid; i < NCH * 32; i += 512) { const int c = i >> 5, q4 = (i & 31) * 4; *(LAS f32x4*)(Ls + c * 128 + q4) = *(const f32x4*)(Sg + (size_t)c * 256 + q4); }
            __syncthreads();
            if (wave == 0) { const int p = lane, pi = (n * 64 + g) * 64 + p;
                const float lr = fminf(KIN[6][pi], -1e-4f), li = KIN[7][pi], step = expf(KIN[8][n * 64 + g]); float ar, ai; cpow(lr * step, li * step, TC, ar, ai);
                bf16_t* hp = (bf16_t*)(ws + WS_HPREV) + (size_t)g * NCH * 256 + n * 128; float hr = 0.f, him = 0.f;
                for (int cc = 0; cc < NCH; ++cc) { const int c = n == 0 ? cc : NCH - 1 - cc;
                    hp[(size_t)c * 256 + p] = (bf16_t)(cvt_pk_bf16(hr, 0.f) & 0xffffu); hp[(size_t)c * 256 + 64 + p] = (bf16_t)(cvt_pk_bf16(him, 0.f) & 0xffffu);
                    const float sr = Ls[c * 128 + p], si = Ls[c * 128 + 64 + p]; const float nr = ar * hr - ai * him + sr, ni = ar * him + ai * hr + si; hr = nr; him = ni; } }
            __syncthreads();
        }
        { MK_RG; for (int un = bx; un < 256; un += G) rg_pass_a(RG, un & 1, un >> 1, tid); }
    }
    if (rep + 1 < REPS(3)) { ++nbar; xcd_barrier(xb, (unsigned)G, wave); } }
    SEAM(3);
    for (int rep = 0; rep < REPS(4); ++rep) {
    if (IN(4)) { PH_IDS;
#if NAIVE_S5
        if (gw < 64) naive_s5_group((const float* const*)0, (const bf16_t*)(dout + DO_U), (float*)(ws + WS_YINTRA), (bf16_t*)(ws + WS_YS5G), gw, lane);
#else
        { SchedS5b S{(const char*)(ws + WS_HPREV), (const char*)(ws + WS_WC), G, bx}; EpiS5b E{(const bf16_t*)(ws + WS_YINTRA), (bf16_t*)(ws + WS_YS5G)};
          GEMM_PHASE(lds, wave, GParm{256, 512, 128, 64, 0}, S, E); }
#endif
#if NAIVE_RG
        { MK_RG; if (gtid < 1024) naive_rg_channel(RG, gtid); }
#else
        { MK_RG; __syncthreads(); for (int un = bx; un < 256; un += G) { rg_pass_c(RG, un & 1, un >> 1, tid, (LAS float*)lds); __syncthreads(); } }
#endif
    }
    if (rep + 1 < REPS(4)) { ++nbar; xcd_barrier(xb, (unsigned)G, wave); } }
    SEAM(4);
    for (int rep = 0; rep < REPS(5); ++rep) {
    if (IN(5)) { PH_IDS;
        SchedStd S; S.so.init(SEQ, DS5, G, bx); S.A = (const char*)(ws + WS_YS5G); S.B = (const char*)(ws + WS_GLUT); S.a_tile = (size_t)256 * 16 * 2; S.b_tile = (size_t)256 * DS5 * 2;
        EpiGlu E{(const bf16_t*)(ws + WS_YS5G), (bf16_t*)(dout + DO_YPRE), KIN[15]};
        GEMM_PHASE(lds, wave, GParm{DS5, 32, 4u * GM_STRIDE * 2u, 16, GM_STRIDE}, S, E);
        if (G == 256 && bx >= 128) {
            LAS float* scr = (LAS float*)(lds + wave * 16640); constexpr int I_FF1 = (DM / 64) * (DFF / 64);
            for (int it = (bx - 128) * 8 + wave; it < FF1_IN_P5; it += 1024) transpose_item(KIN[29], DM, DFF, (bf16_t*)(ws + WS_FF1T), scr, it, lane); }
    }
    if (rep + 1 < REPS(5)) { ++nbar; xcd_barrier(xb, (unsigned)G, wave); } }
    SEAM(5);
    for (int rep = 0; rep < REPS(6); ++rep) {
    if (IN(6)) { PH_IDS;
        const float *g5 = KIN[23], *gr = KIN[24];
        for (int row = gw; row < SEQ; row += NGW) { const u32x4* yr = (const u32x4*)(dout + DO_YPRE) + (size_t)row * 256; u32x4* oc = (u32x4*)(ws + WS_YCAT) + (size_t)row * 256;
            u32x4 w[4]; float s0 = 0.f, s1 = 0.f;
#pragma unroll
            for (int j = 0; j < 4; ++j) { w[j] = yr[lane + 64 * j]; const float q = bf_lo(w[j].x) * bf_lo(w[j].x) + bf_hi(w[j].x) * bf_hi(w[j].x) + bf_lo(w[j].y) * bf_lo(w[j].y) + bf_hi(w[j].y) * bf_hi(w[j].y)
                + bf_lo(w[j].z) * bf_lo(w[j].z) + bf_hi(w[j].z) * bf_hi(w[j].z) + bf_lo(w[j].w) * bf_lo(w[j].w) + bf_hi(w[j].w) * bf_hi(w[j].w); if (j < 2) s0 += q; else s1 += q; }
            const float r0 = 1.0f / sqrtf(wave_sum(s0) * (1.f / 1024.f) + LN_EPS), r1 = 1.0f / sqrtf(wave_sum(s1) * (1.f / 1024.f) + LN_EPS);
#pragma unroll
            for (int j = 0; j < 4; ++j) { const int col = (lane + 64 * j) * 8; const float rs = j < 2 ? r0 : r1; const float* gp = j < 2 ? g5 + col : gr + (col - 1024);
                const f32x4 ga = *(const f32x4*)gp, gb = *(const f32x4*)(gp + 4);
                u32x4 o; o.x = cvt_pk_bf16(bf_lo(w[j].x) * rs * ga[0], bf_hi(w[j].x) * rs * ga[1]); o.y = cvt_pk_bf16(bf_lo(w[j].y) * rs * ga[2], bf_hi(w[j].y) * rs * ga[3]);
                o.z = cvt_pk_bf16(bf_lo(w[j].z) * rs * gb[0], bf_hi(w[j].z) * rs * gb[1]); o.w = cvt_pk_bf16(bf_lo(w[j].w) * rs * gb[2], bf_hi(w[j].w) * rs * gb[3]); oc[lane + 64 * j] = o; } }
        {
            LAS float* scr = (LAS float*)(lds + wave * 16640);
            constexpr int I_FF1 = (DM / 64) * (DFF / 64), I_FF2 = (DFF / 64) * (DM / 64);
            const int ff1_lo = (G == 256) ? FF1_IN_P5 : 0;
            for (int it = gw; it < I_FF2 + (I_FF1 - ff1_lo); it += NGW) {
                if (it < I_FF2) transpose_item(KIN[31], DFF, DM, (bf16_t*)(ws + WS_FF2T), scr, it, lane);
                else transpose_item(KIN[29], DM, DFF, (bf16_t*)(ws + WS_FF1T), scr, ff1_lo + it - I_FF2, lane); }
        }
    }
    if (rep + 1 < REPS(6)) { ++nbar; xcd_barrier(xb, (unsigned)G, wave); } }
    SEAM(6);
    for (int rep = 0; rep < REPS(7); ++rep) {
    if (IN(7)) { PH_IDS;
        SchedStd S; S.so.init(SEQ, DM, G, bx); S.A = (const char*)(ws + WS_YCAT); S.B = (const char*)(ws + WS_WOUTT); S.a_tile = (size_t)256 * DM * 2; S.b_tile = (size_t)256 * DM * 2;
        EpiResLn1 E{(bf16_t*)(ws + WS_HB), KIN[26], KIN[27], KIN[28], PanelStats8{(unsigned long long*)(ws + WS_AGG), (unsigned*)(ws + WS_CTR) + 1024, LN_EPS}};
        GEMM_PHASE(lds, wave, GParm{DM, DM * 2, 128, 64, 0}, S, E);
    }
    if (rep + 1 < REPS(7)) { ++nbar; xcd_barrier(xb, (unsigned)G, wave); } }
    for (int rep = 0; rep < REPS(8); ++rep) {
    if (IN(8)) { }
    if (rep + 1 < REPS(8)) { ++nbar; xcd_barrier(xb, (unsigned)G, wave); } }
    SEAM(8);
    for (int rep = 0; rep < REPS(9); ++rep) {
    if (IN(9)) { PH_IDS;
        static_assert(WS_PLEGT == WS_FF1T + (size_t)DFF * DM * 2, "gate weights must follow the FF1 weights");
        { SchedStd S; S.so.init(SEQ, DFF + DM, G, bx); S.A = (const char*)(ws + WS_HB); S.B = (const char*)(ws + WS_FF1T); S.a_tile = (size_t)256 * DM * 2; S.b_tile = (size_t)256 * DM * 2;
          EpiFF1G E{(bf16_t*)(ws + WS_T), (bf16_t*)dout, KIN[30], KIN[35]}; GEMM_PHASE(lds, wave, GParm{DM, DM * 2, 128, 64, 0}, S, E); }
        { SchedStd S; S.so.init(SEQ, DM, G, bx); S.A = (const char*)(ws + WS_PB); S.B = (const char*)(ws + WS_PLEWT); S.a_tile = (size_t)256 * PLE * 2; S.b_tile = (size_t)256 * PLE * 2;
          EpiPlain<0> E{(bf16_t*)dout + ((size_t)1 << 19), DM, nullptr, (size_t)1 << 20}; GEMM_PHASE(lds, wave, GParm{PLE, PLE * 2, 128, 64, 0}, S, E); }
    }
    if (rep + 1 < REPS(9)) { ++nbar; xcd_barrier(xb, (unsigned)G, wave); } }
    SEAM(9);
    for (int rep = 0; rep < REPS(10); ++rep) {
    if (IN(10)) { PH_IDS;
        SchedStd S; S.so.init(SEQ, DM, G, bx); S.A = (const char*)(ws + WS_T); S.B = (const char*)(ws + WS_FF2T); S.a_tile = (size_t)256 * DFF * 2; S.b_tile = (size_t)256 * DFF * 2;
        EpiResLn2 E{(const bf16_t*)(ws + WS_HB), KIN[32], KIN[36], KIN[37], (float*)dout, (const bf16_t*)dout, PanelStats8{(unsigned long long*)(ws + WS_AGG) + 65536, (unsigned*)(ws + WS_CTR) + 1024 + 64 * 32, LN_EPS}};
        GEMM_PHASE(lds, wave, GParm{DFF, DFF * 2, 128, 64, 0}, S, E);
    }
    if (rep + 1 < REPS(10)) { ++nbar; xcd_barrier(xb, (unsigned)G, wave); } }
    for (int rep = 0; rep < REPS(11); ++rep) {
    if (IN(11)) { }
    if (rep + 1 < REPS(11)) { ++nbar; xcd_barrier(xb, (unsigned)G, wave); } }
#ifdef EXTRA_BARRIERS
    for (int eb = 0; eb < EXTRA_BARRIERS; ++eb) { ++nbar; xcd_barrier(xb, (unsigned)G, wave); }
#endif
#if TSTAMP
    if (bx == 0 && wave == 0) { if (fresh_lane() == 0) { unsigned long long* st = (unsigned long long*)(ws + WS_CTR + 1024); st[12] = __builtin_amdgcn_s_memrealtime();
        ((float*)KIN[38])[0] = 8.0f * floorf((float)(long long)(__hip_atomic_load(st + TS_A1, __ATOMIC_RELAXED, __HIP_MEMORY_SCOPE_AGENT) - __hip_atomic_load(st + TS_A0, __ATOMIC_RELAXED, __HIP_MEMORY_SCOPE_AGENT)) * 0.00125f + 0.5f); } }
#endif
#if DIAG
    { ++nbar; xcd_barrier(xb, (unsigned)G, wave); PH_IDS; unsigned* flagw = (unsigned*)(ws + WS_CTR) + 48;
#if DIAG == 1
      diag_ffn((const float* const*)0, ws, ((float*)KIN[38]), flagw, gtid, GT);
#elif DIAG == 2
      diag_pre((const float* const*)0, ws, dout, flagw, gtid, GT);
#elif DIAG == 3
      diag_v((const float* const*)0, ws, dout, flagw, gtid, GT);
#elif DIAG == 4
      diag_g((const float* const*)0, ws, flagw, gtid, GT);
#elif DIAG == 6
      diag_max(ws, flagw, gtid, GT);
#else
      if (bx == 0 && tid == 0) flagw[1] = 0xffffffffu;
      ++nbar; xcd_barrier(xb, (unsigned)G, wave);
#if DIAG == 7
      diag_rows(((float*)KIN[38]), flagw, gw, NGW, lane);
#elif DIAG == 8
      diag_rows_bf((const bf16_t*)(ws + WS_HB), DM, 12.0f, flagw, gw, NGW, lane);
#elif DIAG == 9
      diag_rows((const float*)(ws + WS_V2), flagw, gw, NGW, lane);
#elif DIAG == 10
      diag_rows_bf((const bf16_t*)(ws + WS_T), DFF, 150.0f, flagw, gw, NGW, lane);
#elif DIAG == 11
      diag_rows_bf((const bf16_t*)(dout + DO_PW), DM, 8.0f, flagw, gw, NGW, lane);
#elif DIAG == 12
      diag_rows_bf((const bf16_t*)(dout + DO_SG), DM, 1.01f, flagw, gw, NGW, lane);
#endif
#endif
      ++nbar; xcd_barrier(xb, (unsigned)G, wave);
#if DIAG != 1
      for (int i = gtid; i < SEQ * DM; i += GT) ((float*)KIN[38])[i] = 0.f;
      ++nbar; xcd_barrier(xb, (unsigned)G, wave);
#endif
      if (bx == 0 && tid == 0) { unsigned code = 0; for (int q = 0; q < 4; ++q) if (__hip_atomic_load(flagw + q, __ATOMIC_RELAXED, __HIP_MEMORY_SCOPE_AGENT) > 100u) code |= 1u << q; if (DIAG >= 7) { const unsigned cnt = __hip_atomic_load(flagw, __ATOMIC_RELAXED, __HIP_MEMORY_SCOPE_AGENT), mn = __hip_atomic_load(flagw + 1, __ATOMIC_RELAXED, __HIP_MEMORY_SCOPE_AGENT), mxr = __hip_atomic_load(flagw + 2, __ATOMIC_RELAXED, __HIP_MEMORY_SCOPE_AGENT);
          const unsigned v = DIAG_SEL == 0 ? cnt : DIAG_SEL == 1 ? mn / 100u : DIAG_SEL == 2 ? mn % 100u : DIAG_SEL == 3 ? mxr / 100u : mxr % 100u; ((float*)KIN[38])[0] = 100.0f * (float)(v + 1u); }
      else ((float*)KIN[38])[0] = (DIAG == 6) ? 1000.0f * __uint_as_float(__hip_atomic_load(flagw, __ATOMIC_RELAXED, __HIP_MEMORY_SCOPE_AGENT)) : 1000.0f * (float)(code + 16u); } }
#endif
#undef IN
#undef SEAM
}


#if PER_PHASE_LAUNCH
template <int PH> static void set_attr_one() { (void)hipFuncSetAttribute((const void*)mega<(1 << PH)>, hipFuncAttributeMaxDynamicSharedMemorySize, LDS_BYTES); }
template <int PH> static void launch_one(Args a, int grid, hipStream_t stream) { a.ph_lo = PH; a.ph_hi = PH + 1; hipLaunchKernelGGL(mega<(1 << PH)>, dim3(grid), dim3(512), LDS_BYTES, stream, a); }
static void set_attrs() { set_attr_one<0>(); set_attr_one<1>(); set_attr_one<2>(); set_attr_one<3>(); set_attr_one<4>(); set_attr_one<5>(); set_attr_one<6>(); set_attr_one<7>(); set_attr_one<8>(); set_attr_one<9>(); set_attr_one<10>(); set_attr_one<11>(); }
static void launch_phases(const Args& a, int grid, hipStream_t stream) { launch_one<0>(a, grid, stream); launch_one<1>(a, grid, stream); launch_one<2>(a, grid, stream); launch_one<3>(a, grid, stream); launch_one<4>(a, grid, stream); launch_one<5>(a, grid, stream);
    launch_one<6>(a, grid, stream); launch_one<7>(a, grid, stream); launch_one<8>(a, grid, stream); launch_one<9>(a, grid, stream); launch_one<10>(a, grid, stream); launch_one<11>(a, grid, stream); }
#else
static void set_attrs() { (void)hipFuncSetAttribute((const void*)mega<0xfff>, hipFuncAttributeMaxDynamicSharedMemorySize, LDS_BYTES); }
#endif

extern "C" void kernel_launch(void* const* d_in, const int* in_sizes, int n_in, void* d_out, int out_size, void* d_ws, size_t ws_size, hipStream_t stream) {
    static int grid = 0;
    if (grid == 0) {
        if (n_in != 38 || out_size != SEQ * DM || ws_size < WS_END) { fprintf(stderr, "kernel_launch: unexpected shapes (n_in %d out %d ws %zu)\n", n_in, out_size, ws_size); grid = -1; return; }
        int dev = 0, cus = 0, per_cu = 0;
        hipGetDevice(&dev); hipDeviceGetAttribute(&cus, hipDeviceAttributeMultiprocessorCount, dev);
        set_attrs();
        per_cu = 1;
        (void)hipGetLastError();
        if (per_cu < 1) per_cu = 1;
        grid = cus;
    }
    if (grid < 0) return;
#ifdef POISON_NAN
    hipMemsetAsync(d_ws, 0xFF, WS_END, stream); hipMemsetAsync(d_out, 0xFF, (size_t)64 * MiB, stream);
#endif
    hipMemsetAsync((char*)d_ws + WS_CTR, 0, 40960, stream);
    Args a{};
    for (int i = 0; i < 38; ++i) a.in[i] = (const float*)d_in[i];
    a.out = (float*)d_out; a.ws = (unsigned char*)d_ws;
#if PER_PHASE_LAUNCH
    launch_phases(a, grid, stream);
#else
    a.ph_lo = 0; a.ph_hi = NPHASE;
    void* kargs[] = {&a};
    hipError_t e = hipLaunchCooperativeKernel((const void*)mega<0xfff>, dim3(grid), dim3(512), kargs, LDS_BYTES, stream);
    if (e != hipSuccess) fprintf(stderr, "cooperative launch failed: %s (grid %d)\n", hipGetErrorString(e), grid);
#endif
}
```

```cpp
#include <hip/hip_runtime.h>
#include <hip/hip_cooperative_groups.h>
#include <cstdio>
#include <cstdint>
namespace cg = cooperative_groups;

#ifndef PER_PHASE_LAUNCH
#define PER_PHASE_LAUNCH 0
#endif

#ifndef TSTAMP
#define TSTAMP 0
#define TS_A0 4
#define TS_A1 5
#define TS_B0 9
#define TS_B1 12
#endif
#define LAS __attribute__((address_space(3)))
typedef unsigned short bf16_t;
typedef short bf16x8 __attribute__((ext_vector_type(8)));
typedef float f32x4 __attribute__((ext_vector_type(4)));
typedef float f32x2 __attribute__((ext_vector_type(2)));
typedef unsigned u32x4 __attribute__((ext_vector_type(4)));
typedef unsigned u32x2 __attribute__((ext_vector_type(2)));

constexpr int SEQ = 8192, DM = 2048, DIN = 3072, DS5 = 1024, DRG = 1024, NG = 64, NP = 64, NK = 16, NH = 16, HD = 64, DFF = 8192, PLE = 256;
constexpr int TC = 32, NCH = SEQ / TC;
constexpr float LN_EPS = 1e-5f, DN_ALPHA = 1.18920711500272f;
constexpr int NPHASE = 12;

constexpr size_t MiB = (size_t)1 << 20;
constexpr size_t WS_FF2T = 0, WS_HB = 32 * MiB, WS_FF1T = 64 * MiB, WS_PLEGT = 96 * MiB, WS_PLEWT = 104 * MiB, WS_PB = 105 * MiB, WS_WOUTT = 109 * MiB,
    WS_V2 = 64 * MiB, WS_G0 = 0, WS_G1 = 64 * MiB,
    WS_WG = 128 * MiB, WS_WC = 176 * MiB, WS_RGW = 192 * MiB, WS_GLUT = 194 * MiB, WS_XR = 196 * MiB, WS_YINTRA = 213 * MiB, WS_S = 229 * MiB, WS_HPREV = 245 * MiB, WS_WINT = 229 * MiB,
    WS_YS5G = 128 * MiB, WS_YCAT = 144 * MiB, WS_T = 128 * MiB,
    WS_AGG = 256 * MiB, WS_CARRY = 258 * MiB, WS_SUMSQ = 259 * MiB, WS_RGBIAS = 259 * MiB + 64 * 1024, WS_SP = WS_RGBIAS + 16 * 1024, WS_CTR = WS_SP + 8 * 1024, WS_END = 260 * MiB;
constexpr size_t DO_YPRE = 0, DO_Z = 32 * MiB, DO_U = 48 * MiB, DO_SG = 0, DO_PW = 32 * MiB;
constexpr int FF1_IN_P5 = 3072;
constexpr int GM_STRIDE = SEQ * 16;
constexpr int LDS_BYTES = 152 * 1024;

typedef __bf16 bf16x2_t __attribute__((ext_vector_type(2)));
__device__ __forceinline__ unsigned cvt_pk_bf16(float lo, float hi) { const f32x2 v = {lo, hi}; const bf16x2_t b = __builtin_convertvector(v, bf16x2_t); return __builtin_bit_cast(unsigned, b); }
__device__ __forceinline__ float bf_lo(unsigned w) { return __uint_as_float(w << 16); }
__device__ __forceinline__ float bf_hi(unsigned w) { return __uint_as_float(w & 0xffff0000u); }
__device__ __forceinline__ f32x4 bf4(u32x2 w) { return (f32x4){bf_lo(w.x), bf_hi(w.x), bf_lo(w.y), bf_hi(w.y)}; }
__device__ __forceinline__ float fast_sigmoid(float x) { return __builtin_amdgcn_rcpf(1.0f + __expf(-x)); }
__device__ __forceinline__ float gelu_tanh(float x) { const float u = 1.5957691216057308f * (x + 0.044715f * x * x * x); return x * fast_sigmoid(u); }
__device__ __forceinline__ float wave_sum(float v) {
#pragma unroll
    for (int o = 1; o < 64; o <<= 1) v += __shfl_xor(v, o);
    return v;
}
__device__ __forceinline__ int lane_id() { return (int)__builtin_amdgcn_mbcnt_hi(~0u, __builtin_amdgcn_mbcnt_lo(~0u, 0u)); }
__device__ __forceinline__ int fresh_lane() { unsigned z = 0; asm volatile("" : "+s"(z)); return (int)__builtin_amdgcn_mbcnt_hi(~0u, __builtin_amdgcn_mbcnt_lo(~0u, z)); }
#define LDS_WAIT() asm volatile("s_waitcnt lgkmcnt(0)" ::: "memory")

namespace pg8 {
constexpr int BM = 256, BK = 64, HALF = 128, HTB = HALF * BK * 2, STAGE_BYTES = 8 * HTB, NXCD = 8, WGM = 8;
__host__ __device__ __forceinline__ int lds_byte(int r, int c) { const int st = (r >> 4) * 2 + (c >> 5), rr = r & 15, cc = c & 31, ob = rr * 64 + cc * 2; return st * 1024 + (ob ^ (((ob >> 9) & 1) << 5)); }
__host__ __device__ __forceinline__ void stage_rc(int b, int& R, int& C) { const int st = b / 1024, sb = b % 1024, swz = sb ^ (((sb >> 9) & 1) << 5); R = (st >> 1) * 16 + swz / 64; C = (st & 1) * 32 + (swz % 64) / 2; }
__host__ __device__ __forceinline__ int perm32(int rho) { const int n = rho >> 4, i = rho & 15; return 8 * (i >> 2) + 4 * n + (i & 3); }

struct Unit { int pm, pn; };
struct StaticOrder {
    int nM, nN, nwg, G, c;
    __host__ __device__ void init(int M, int N, int G_, int c_) { nM = M / BM; nN = N / BM; nwg = nM * nN; G = G_; c = c_; }
    __host__ __device__ bool next(int i, Unit& u) const {
        const long L = (long)i * G + c; if (L >= nwg) return false;
        int wgid = (int)L; { const int q = nwg / NXCD, r = nwg % NXCD, xcd = wgid % NXCD, off = wgid / NXCD; wgid = (xcd < r ? xcd * (q + 1) : r * (q + 1) + (xcd - r) * q) + off; }
        const int nig = WGM * nN, gid = wgid / nig, fm = gid * WGM, gsz = (nM - fm) < WGM ? (nM - fm) : WGM;
        u.pm = fm + ((wgid % nig) % gsz); u.pn = (wgid % nig) / gsz; return true;
    }
};
struct GUnit { const char* A; const char* B; int i0, i1; };
struct GParm { int K; unsigned a_rs, a_ks; int a_cw, a_cs; };

template <class Epi, class Sched>
__device__ __forceinline__ void gemm_phase(LAS unsigned char* lds, const int wid, const GParm gp, const Sched& S, const Epi& E) {
    const int lane = fresh_lane(), tid = wid * 64 + lane, wr = wid >> 2, wc = wid & 3, fr = lane & 15, fq = lane >> 4;
    const int K = gp.K, nt = K / BK;
    unsigned voffA[2], voffB[2];
#pragma unroll
    for (int i = 0; i < 2; ++i) { int R, C; stage_rc(tid * 16 + i * 8192, R, C); const int Rb = Epi::PERM ? ((R & ~31) + perm32(R & 31)) : R;
        voffA[i] = (unsigned)R * gp.a_rs + (unsigned)((C / gp.a_cw) * gp.a_cs + (C % gp.a_cw)) * 2u; voffB[i] = (unsigned)(Rb * K + C) * 2u; }
    const size_t ksA = gp.a_ks, ksB = (size_t)(BK * 2);
    const size_t hsA = (size_t)HALF * gp.a_rs, hsB = (size_t)HALF * K * 2;
    const unsigned ldsw = (unsigned)wid * 1024u;
    const int aoff = lds_byte(wr * 64 + fr, fq * 8), boff = lds_byte(wc * 32 + fr, fq * 8);
#define PG8_SA(b, h) (((b) * 2 + (h)) * HTB)
#define PG8_SB(b, h) ((4 + (b) * 2 + (h)) * HTB)
#define PG8_STAGE(bufoff, gbase, voff) do { _Pragma("unroll") for (int _i = 0; _i < 2; ++_i) \
        __builtin_amdgcn_global_load_lds((const unsigned*)((const char*)(gbase) + (voff)[_i]), (LAS unsigned*)(lds + (bufoff) + ldsw + _i * 8192), 16, 0, 0); } while (0)
#define PG8_LDA(dst, b, h) do { _Pragma("unroll") for (int m = 0; m < 4; ++m) _Pragma("unroll") for (int k = 0; k < 2; ++k) dst[m][k] = *(const LAS bf16x8*)(lds + PG8_SA(b, h) + aoff + m * 2048 + k * 1024); } while (0)
#define PG8_LDB(dst, b, h) do { _Pragma("unroll") for (int n = 0; n < 2; ++n) _Pragma("unroll") for (int k = 0; k < 2; ++k) dst[n][k] = *(const LAS bf16x8*)(lds + PG8_SB(b, h) + boff + n * 2048 + k * 1024); } while (0)
#define PG8_MMA(ai, bj, At, Bt) do { __builtin_amdgcn_s_setprio(1); _Pragma("unroll") for (int m = 0; m < 4; ++m) _Pragma("unroll") for (int n = 0; n < 2; ++n) _Pragma("unroll") for (int k = 0; k < 2; ++k) \
        acc[ai][bj][m][n] = __builtin_amdgcn_mfma_f32_16x16x32_bf16(Bt[n][k], At[m][k], acc[ai][bj][m][n], 0, 0, 0); __builtin_amdgcn_s_setprio(0); } while (0)
#define PG8_WAIT_V(n) asm volatile("s_waitcnt vmcnt(" #n ")" ::: "memory")
#define PG8_WAIT_L(n) asm volatile("s_waitcnt lgkmcnt(" #n ")" ::: "memory")
#define PG8_BAR __builtin_amdgcn_s_barrier()
#define PG8_SCHED __builtin_amdgcn_sched_barrier(0)
    GUnit cur, nxt; int ui = 0;
    if (!S.next(0, cur)) return;
    f32x4 acc[2][2][4][2];
#pragma unroll
    for (int a = 0; a < 2; ++a)
#pragma unroll
        for (int b = 0; b < 2; ++b)
#pragma unroll
            for (int m = 0; m < 4; ++m)
#pragma unroll
                for (int n = 0; n < 2; ++n) acc[a][b][m][n] = (f32x4){0.f, 0.f, 0.f, 0.f};
    bf16x8 At[4][2], B0[2][2], B1[2][2];
    const char* cA = cur.A; const char* cB = cur.B;
    PG8_STAGE(PG8_SB(0, 0), cB, voffB); PG8_STAGE(PG8_SB(0, 1), cB + hsB, voffB); PG8_STAGE(PG8_SA(0, 0), cA, voffA); PG8_STAGE(PG8_SA(0, 1), cA + hsA, voffA);
    if (wr == 1) PG8_BAR;
    PG8_WAIT_V(2); PG8_BAR;
    PG8_STAGE(PG8_SB(1, 0), cB + ksB, voffB); PG8_STAGE(PG8_SA(1, 0), cA + ksA, voffA); PG8_STAGE(PG8_SB(1, 1), cB + hsB + ksB, voffB);
    PG8_WAIT_V(6); PG8_BAR;
    for (;;) {
        const bool has_next = S.next(ui + 1, nxt);
        const char* nA = has_next ? nxt.A : cA; const char* nB = has_next ? nxt.B : cB;
        for (int t = 0; t < nt; t += 2) {
            const bool last = (t == nt - 2);
            const char* a1 = cA + (size_t)(t + 1) * ksA;
            const char* a2 = last ? nA : cA + (size_t)(t + 2) * ksA; const char* b2 = last ? nB : cB + (size_t)(t + 2) * ksB;
            const char* a3 = a2 + ksA; const char* b3 = b2 + ksB;
            PG8_LDB(B0, 0, 0); PG8_LDB(B1, 0, 1); PG8_SCHED; PG8_LDA(At, 0, 0); PG8_STAGE(PG8_SA(1, 1), a1 + hsA, voffA);
            PG8_WAIT_V(8); PG8_WAIT_L(0); PG8_BAR; PG8_MMA(0, 0, At, B0); PG8_MMA(0, 1, At, B1); PG8_BAR; PG8_SCHED;
            PG8_LDA(At, 0, 1); PG8_STAGE(PG8_SB(0, 0), b2, voffB); PG8_STAGE(PG8_SB(0, 1), b2 + hsB, voffB); PG8_STAGE(PG8_SA(0, 0), a2, voffA);
            PG8_WAIT_V(8); PG8_WAIT_L(0); PG8_BAR; PG8_MMA(1, 0, At, B0); PG8_MMA(1, 1, At, B1); PG8_BAR; PG8_SCHED;
            PG8_LDB(B0, 1, 0); PG8_LDB(B1, 1, 1); PG8_SCHED; PG8_LDA(At, 1, 0); PG8_STAGE(PG8_SA(0, 1), a2 + hsA, voffA);
            PG8_WAIT_V(8); PG8_WAIT_L(0); PG8_BAR; PG8_MMA(0, 0, At, B0); PG8_MMA(0, 1, At, B1); PG8_BAR; PG8_SCHED;
            PG8_LDA(At, 1, 1); PG8_STAGE(PG8_SB(1, 0), b3, voffB); PG8_STAGE(PG8_SB(1, 1), b3 + hsB, voffB); PG8_STAGE(PG8_SA(1, 0), a3, voffA);
            PG8_WAIT_V(8); PG8_WAIT_L(0); PG8_BAR; PG8_MMA(1, 0, At, B0); PG8_MMA(1, 1, At, B1); PG8_BAR; PG8_SCHED;
        }
        if (wr == 0) PG8_BAR;
        if constexpr (!Epi::AFTER_DRAIN) { const int l_o = fresh_lane(); E(acc, cur, wr, wc, l_o & 15, l_o >> 4); }
        if (!has_next) break;
#pragma unroll
        for (int a = 0; a < 2; ++a)
#pragma unroll
            for (int b = 0; b < 2; ++b)
#pragma unroll
                for (int m = 0; m < 4; ++m)
#pragma unroll
                    for (int n = 0; n < 2; ++n) acc[a][b][m][n] = (f32x4){0.f, 0.f, 0.f, 0.f};
        cur = nxt; cA = nA; cB = nB; ++ui;
        if (wr == 1) PG8_BAR;
    }
    PG8_WAIT_V(0);
    PG8_BAR;
    if constexpr (Epi::AFTER_DRAIN) { const int l_o = fresh_lane(); E.fused(acc, cur, wr, wc, l_o & 15, l_o >> 4, lds, wid); }
#undef PG8_SA
#undef PG8_SB
#undef PG8_STAGE
#undef PG8_LDA
#undef PG8_LDB
#undef PG8_MMA
#undef PG8_WAIT_V
#undef PG8_WAIT_L
#undef PG8_BAR
#undef PG8_SCHED
}
}
using pg8::GUnit; using pg8::GParm;
typedef f32x4 AccT[2][2][4][2];

struct SchedStd {
    pg8::StaticOrder so; const char* A; const char* B; size_t a_tile, b_tile;
    __device__ __forceinline__ bool next(int i, GUnit& u) const { pg8::Unit t; if (!so.next(i, t)) return false; u.A = A + (size_t)t.pm * a_tile; u.B = B + (size_t)t.pn * b_tile; u.i0 = t.pm; u.i1 = t.pn; return true; }
};
struct SchedS5a { const char* U; const char* WG; int G, c;
    __device__ __forceinline__ bool next(int i, GUnit& u) const { const int L = i * G + c; if (L >= 192) return false; const int g = L / 3, pn = L % 3;
        u.A = U + (size_t)g * GM_STRIDE * 2; u.B = WG + ((size_t)g * 768 + 256 * pn) * 512 * 2; u.i0 = g; u.i1 = pn; return true; } };
struct SchedS5b { const char* HP; const char* WC; int G, c;
    __device__ __forceinline__ bool next(int i, GUnit& u) const { const int L = i * G + c; if (L >= 128) return false; const int g = L / 2, pn = L % 2;
        u.A = HP + (size_t)g * 256 * 256 * 2; u.B = WC + ((size_t)g * 512 + 256 * pn) * 256 * 2; u.i0 = g; u.i1 = pn; return true; } };
struct SchedRG { const char* XR; const char* RGW; int G, c;
    __device__ __forceinline__ bool next(int i, GUnit& u) const { const int L = i * G + c; if (L >= 512) return false; const int h = L % 16, pm = L / 16;
        u.A = XR + ((size_t)(256 * pm) * 1024 + 64 * h) * 2; u.B = RGW + (size_t)h * 256 * 256 * 2; u.i0 = pm; u.i1 = h; return true; } };

template <int ACT> __device__ __forceinline__ void epi_bf16_store(const AccT& acc, bf16_t* tile, int ldc, const float* biast, int wr, int wc, int fr, int fq) {
    const int r0 = wr * 64 + fr, c0 = wc * 32 + 8 * fq;
    f32x4 bv[2][2];
#pragma unroll
    for (int bj = 0; bj < 2; ++bj)
#pragma unroll
        for (int n = 0; n < 2; ++n) bv[bj][n] = biast ? *(const f32x4*)(biast + c0 + bj * 128 + 4 * n) : (f32x4){0.f, 0.f, 0.f, 0.f};
#pragma unroll
    for (int ai = 0; ai < 2; ++ai)
#pragma unroll
        for (int m = 0; m < 4; ++m) { bf16_t* rowp = tile + (size_t)(r0 + ai * 128 + m * 16) * ldc + c0;
#pragma unroll
            for (int bj = 0; bj < 2; ++bj) { f32x4 v0 = acc[ai][bj][m][0] + bv[bj][0], v1 = acc[ai][bj][m][1] + bv[bj][1];
                if (ACT == 1) {
#pragma unroll
                    for (int j = 0; j < 4; ++j) { const float a = fmaxf(v0[j], 0.f), b = fmaxf(v1[j], 0.f); v0[j] = a * a; v1[j] = b * b; } }
                if (ACT == 2) {
#pragma unroll
                    for (int j = 0; j < 4; ++j) { v0[j] = fast_sigmoid(v0[j]); v1[j] = fast_sigmoid(v1[j]); } }
                u32x4 w; w.x = cvt_pk_bf16(v0[0], v0[1]); w.y = cvt_pk_bf16(v0[2], v0[3]); w.z = cvt_pk_bf16(v1[0], v1[1]); w.w = cvt_pk_bf16(v1[2], v1[3]);
                *(u32x4*)(rowp + bj * 128) = w; } }
}
struct EpiProj { static constexpr bool PERM = true, AFTER_DRAIN = false; bf16_t *U, *XR, *Z; const float* bias;
    __device__ __forceinline__ void operator()(AccT& acc, const GUnit& u, int wr, int wc, int fr, int fq) const {
        const int pm = u.i0, pn = u.i1;
        if (pn >= 4) { bf16_t* base = pn < 8 ? XR + 2 * 1024 : Z; epi_bf16_store<0>(acc, base + (size_t)pm * 256 * 1024 + (pn & 3) * 256, 1024, bias + pn * 256, wr, wc, fr, fq); return; }
        const int c0 = pn * 256 + wc * 32 + 8 * fq;
#pragma unroll
        for (int bj = 0; bj < 2; ++bj) { const int col = c0 + bj * 128; const f32x4 b0 = *(const f32x4*)(bias + col), b1 = *(const f32x4*)(bias + col + 4); bf16_t* gp = U + (size_t)(col >> 4) * GM_STRIDE + (col & 15);
#pragma unroll
            for (int ai = 0; ai < 2; ++ai)
#pragma unroll
                for (int m = 0; m < 4; ++m) { const int row = pm * 256 + ai * 128 + wr * 64 + m * 16 + fr; const f32x4 v0 = acc[ai][bj][m][0] + b0, v1 = acc[ai][bj][m][1] + b1;
                    u32x4 w; w.x = cvt_pk_bf16(v0[0], v0[1]); w.y = cvt_pk_bf16(v0[2], v0[3]); w.z = cvt_pk_bf16(v1[0], v1[1]); w.w = cvt_pk_bf16(v1[2], v1[3]);
                    *(u32x4*)(gp + (size_t)row * 16) = w; } }
    } };
template <int ACT> struct EpiPlain { static constexpr bool PERM = true, AFTER_DRAIN = false; bf16_t* O; int ldc; const float* bias; size_t pstride;
    __device__ __forceinline__ void operator()(AccT& acc, const GUnit& u, int wr, int wc, int fr, int fq) const {
        epi_bf16_store<ACT>(acc, O + (size_t)u.i0 * (pstride ? pstride : (size_t)256 * ldc) + u.i1 * 256, ldc, bias ? bias + u.i1 * 256 : nullptr, wr, wc, fr, fq); } };
struct EpiFF1G { static constexpr bool PERM = true, AFTER_DRAIN = false; bf16_t* T; bf16_t* SG; const float *b1, *bg;
    __device__ __forceinline__ void operator()(AccT& acc, const GUnit& u, int wr, int wc, int fr, int fq) const {
        const int pm = u.i0, pn = u.i1;
        if (pn < 32) epi_bf16_store<1>(acc, T + (size_t)pm * 256 * DFF + pn * 256, DFF, b1 + pn * 256, wr, wc, fr, fq);
        else epi_bf16_store<2>(acc, SG + (size_t)pm * ((size_t)1 << 20) + (pn - 32) * 256, DM, bg + (pn - 32) * 256, wr, wc, fr, fq); } };
struct EpiS5a { static constexpr bool PERM = true, AFTER_DRAIN = false; bf16_t* YI; float* S;
    __device__ __forceinline__ void operator()(AccT& acc, const GUnit& u, int wr, int wc, int fr, int fq) const {
        const int g = u.i0, pn = u.i1;
#pragma unroll
        for (int ai = 0; ai < 2; ++ai)
#pragma unroll
            for (int m = 0; m < 4; ++m) { const int r = ai * 128 + wr * 64 + m * 16 + fr;
#pragma unroll
                for (int bj = 0; bj < 2; ++bj) { const int c8 = bj * 128 + wc * 32 + 8 * fq; const f32x4 v0 = acc[ai][bj][m][0], v1 = acc[ai][bj][m][1];
                    if (pn < 2) { const int col = pn * 256 + c8, t = col >> 4, k0 = col & 15;
                        u32x4 w; w.x = cvt_pk_bf16(v0[0], v0[1]); w.y = cvt_pk_bf16(v0[2], v0[3]); w.z = cvt_pk_bf16(v1[0], v1[1]); w.w = cvt_pk_bf16(v1[2], v1[3]);
                        *(u32x4*)(YI + (size_t)g * GM_STRIDE + (size_t)r * 512 + col) = w; (void)t; (void)k0; }
                    else { float* sp = S + ((size_t)g * NCH + r) * 256 + c8; *(f32x4*)sp = v0; *(f32x4*)(sp + 4) = v1; } } }
    } };
struct EpiS5b { static constexpr bool PERM = true, AFTER_DRAIN = false; const bf16_t* YI; bf16_t* YG;
    __device__ __forceinline__ void operator()(AccT& acc, const GUnit& u, int wr, int wc, int fr, int fq) const {
        const int g = u.i0, pn = u.i1;
#pragma unroll
        for (int ai = 0; ai < 2; ++ai)
#pragma unroll
            for (int m = 0; m < 4; ++m) { const int r = ai * 128 + wr * 64 + m * 16 + fr;
#pragma unroll
                for (int bj = 0; bj < 2; ++bj) { const int col = pn * 256 + bj * 128 + wc * 32 + 8 * fq, t = col >> 4, k0 = col & 15;
                    const size_t off = (size_t)g * GM_STRIDE + (size_t)r * 512 + col; (void)t; (void)k0; const u32x4 yi = *(const u32x4*)(YI + off);
                    f32x4 v0 = acc[ai][bj][m][0] + (f32x4){bf_lo(yi.x), bf_hi(yi.x), bf_lo(yi.y), bf_hi(yi.y)}, v1 = acc[ai][bj][m][1] + (f32x4){bf_lo(yi.z), bf_hi(yi.z), bf_lo(yi.w), bf_hi(yi.w)};
#pragma unroll
                    for (int j = 0; j < 4; ++j) { v0[j] = gelu_tanh(v0[j]); v1[j] = gelu_tanh(v1[j]); }
                    u32x4 w; w.x = cvt_pk_bf16(v0[0], v0[1]); w.y = cvt_pk_bf16(v0[2], v0[3]); w.z = cvt_pk_bf16(v1[0], v1[1]); w.w = cvt_pk_bf16(v1[2], v1[3]);
                    *(u32x4*)(YG + off) = w; } }
    } };
struct EpiGlu { static constexpr bool PERM = true, AFTER_DRAIN = false; const bf16_t* YG; bf16_t* YPRE; const float* bias;
    __device__ __forceinline__ void operator()(AccT& acc, const GUnit& u, int wr, int wc, int fr, int fq) const {
        const int pm = u.i0, pn = u.i1; const int c0 = pn * 256 + wc * 32 + 8 * fq;
        f32x4 bv[2][2];
#pragma unroll
        for (int bj = 0; bj < 2; ++bj)
#pragma unroll
            for (int n = 0; n < 2; ++n) bv[bj][n] = *(const f32x4*)(bias + c0 + bj * 128 + 4 * n);
#pragma unroll
        for (int ai = 0; ai < 2; ++ai)
#pragma unroll
            for (int m = 0; m < 4; ++m) { const int row = pm * 256 + ai * 128 + wr * 64 + m * 16 + fr;
#pragma unroll
                for (int bj = 0; bj < 2; ++bj) { const int col = c0 + bj * 128; const u32x4 yv = *(const u32x4*)(YG + (size_t)(col >> 4) * GM_STRIDE + (size_t)row * 16 + (col & 15));
                    const f32x4 y0 = (f32x4){bf_lo(yv.x), bf_hi(yv.x), bf_lo(yv.y), bf_hi(yv.y)}, y1 = (f32x4){bf_lo(yv.z), bf_hi(yv.z), bf_lo(yv.w), bf_hi(yv.w)};
                    f32x4 v0 = acc[ai][bj][m][0] + bv[bj][0], v1 = acc[ai][bj][m][1] + bv[bj][1];
#pragma unroll
                    for (int j = 0; j < 4; ++j) { v0[j] = y0[j] * fast_sigmoid(v0[j]); v1[j] = y1[j] * fast_sigmoid(v1[j]); }
                    u32x4 w; w.x = cvt_pk_bf16(v0[0], v0[1]); w.y = cvt_pk_bf16(v0[2], v0[3]); w.z = cvt_pk_bf16(v1[0], v1[1]); w.w = cvt_pk_bf16(v1[2], v1[3]);
                    *(u32x4*)(YPRE + (size_t)row * 2048 + col) = w; }
                }
    } };
template <bool PLEADD> struct EpiRes { static constexpr bool PERM = false, AFTER_DRAIN = false; const bf16_t* HBp; const float* bias; float* V; const bf16_t* SG; const bf16_t* PW;
    __device__ __forceinline__ void operator()(AccT& acc, const GUnit& u, int wr, int wc, int fr, int fq) const {
        const int pm = u.i0, pn = u.i1; const int c0 = pn * 256 + wc * 32 + 4 * fq;
        f32x4 bv[2][2];
#pragma unroll
        for (int bj = 0; bj < 2; ++bj)
#pragma unroll
            for (int n = 0; n < 2; ++n) bv[bj][n] = *(const f32x4*)(bias + c0 + bj * 128 + n * 16);
#pragma unroll
        for (int ai = 0; ai < 2; ++ai)
#pragma unroll
            for (int m = 0; m < 4; ++m) { const int row = pm * 256 + ai * 128 + wr * 64 + m * 16 + fr;
#pragma unroll
                for (int bj = 0; bj < 2; ++bj)
#pragma unroll
                    for (int n = 0; n < 2; ++n) { const size_t off = (size_t)row * 2048 + c0 + bj * 128 + n * 16;
                        f32x4 v = acc[ai][bj][m][n] + bv[bj][n] + DN_ALPHA * bf4(*(const u32x2*)(HBp + off));
                        if (PLEADD) v += bf4(*(const u32x2*)(SG + off)) * bf4(*(const u32x2*)(PW + off));
                        *(f32x4*)(V + off) = v; } }
    } };


struct PanelStats8 { unsigned long long* xbuf; unsigned* cnt; float eps;
    __device__ __forceinline__ void run(const AccT& v, int pm, int pn, int wr, int wc, int fr, int fq, LAS unsigned char* lds, int wid) const {
        LAS f32x2* P = (LAS f32x2*)lds; LAS f32x2* S = (LAS f32x2*)(lds + 8192); const int lane = fq * 16 + fr;
#pragma unroll
        for (int ai = 0; ai < 2; ++ai)
#pragma unroll
            for (int m = 0; m < 4; ++m) { float s = 0.f;
#pragma unroll
                for (int bj = 0; bj < 2; ++bj)
#pragma unroll
                    for (int n = 0; n < 2; ++n) { const f32x4 x = v[ai][bj][m][n]; s += (x[0] + x[1]) + (x[2] + x[3]); }
                s += __shfl_xor(s, 16); s += __shfl_xor(s, 32);
                const float mw = s * (1.0f / 64.0f); float q = 0.f;
#pragma unroll
                for (int bj = 0; bj < 2; ++bj)
#pragma unroll
                    for (int n = 0; n < 2; ++n) { const f32x4 d = v[ai][bj][m][n] - mw; q += (d[0] * d[0] + d[1] * d[1]) + (d[2] * d[2] + d[3] * d[3]); }
                q += __shfl_xor(q, 16); q += __shfl_xor(q, 32);
                if (fq == 0) P[(ai * 128 + wr * 64 + m * 16 + fr) * 4 + wc] = (f32x2){mw, q}; }
        asm volatile("s_waitcnt lgkmcnt(0)" ::: "memory"); __builtin_amdgcn_s_barrier(); asm volatile("" ::: "memory");
        const int row = wid * 32 + (lane & 31);
        if (lane < 32) { const f32x2 a = P[row * 4 + 0], b = P[row * 4 + 1], c = P[row * 4 + 2], d = P[row * 4 + 3];
            const float mt = (a[0] + b[0] + c[0] + d[0]) * 0.25f; const float da = a[0] - mt, db = b[0] - mt, dc = c[0] - mt, dd = d[0] - mt;
            const float m2 = (a[1] + b[1]) + (c[1] + d[1]) + 64.0f * ((da * da + db * db) + (dc * dc + dd * dd));
            __hip_atomic_store(xbuf + ((size_t)(pm * 256 + row) * 8 + pn), ((unsigned long long)__float_as_uint(m2) << 32) | __float_as_uint(mt), __ATOMIC_RELAXED, __HIP_MEMORY_SCOPE_AGENT); }
        asm volatile("s_waitcnt vmcnt(0)" ::: "memory");
        if (lane == 0) __hip_atomic_fetch_add(cnt + 64 * pm, 1u, __ATOMIC_RELAXED, __HIP_MEMORY_SCOPE_AGENT);
        if (wid == 0) { unsigned sp = 0;
            while ((unsigned)__builtin_amdgcn_readfirstlane(__hip_atomic_load(cnt + 64 * pm, __ATOMIC_RELAXED, __HIP_MEMORY_SCOPE_AGENT)) < 64u) { __builtin_amdgcn_s_sleep(2); if (++sp > (1u << 22)) break; }
            __builtin_amdgcn_fence(__ATOMIC_ACQUIRE, "agent"); }
        asm volatile("s_waitcnt vmcnt(0) lgkmcnt(0)" ::: "memory"); __builtin_amdgcn_s_barrier(); asm volatile("" ::: "memory");
        if (lane < 32) { const unsigned long long* slot = xbuf + (size_t)(pm * 256 + row) * 8; float mt[8], m2[8]; float ms = 0.f;
#pragma unroll
            for (int t = 0; t < 8; ++t) { const unsigned long long w = __hip_atomic_load(slot + t, __ATOMIC_RELAXED, __HIP_MEMORY_SCOPE_AGENT); mt[t] = __uint_as_float((unsigned)w); m2[t] = __uint_as_float((unsigned)(w >> 32)); ms += mt[t]; }
            const float mean = ms * 0.125f; float q = 0.f;
#pragma unroll
            for (int t = 0; t < 8; ++t) { const float dm = mt[t] - mean; q += m2[t] + 256.0f * dm * dm; }
            S[row] = (f32x2){mean, 1.0f / sqrtf(q * (1.0f / 2048.0f) + eps)}; }
        asm volatile("s_waitcnt lgkmcnt(0)" ::: "memory"); __builtin_amdgcn_s_barrier(); asm volatile("" ::: "memory");
    } };
struct EpiResLn1 { static constexpr bool PERM = false, AFTER_DRAIN = true; bf16_t* HBp; const float *bias, *lng, *lnb; PanelStats8 st;
    __device__ __forceinline__ void fused(AccT& acc, const GUnit& u, int wr, int wc, int fr, int fq, LAS unsigned char* lds, int wid) const {
        const int pm = u.i0, pn = u.i1; const int c0 = pn * 256 + wc * 32 + 4 * fq; const LAS f32x2* S = (const LAS f32x2*)(lds + 8192);
#pragma unroll
        for (int bj = 0; bj < 2; ++bj)
#pragma unroll
            for (int n = 0; n < 2; ++n) { const f32x4 bv = *(const f32x4*)(bias + c0 + bj * 128 + n * 16);
#pragma unroll
                for (int ai = 0; ai < 2; ++ai)
#pragma unroll
                    for (int m = 0; m < 4; ++m) { const size_t off = (size_t)(pm * 256 + ai * 128 + wr * 64 + m * 16 + fr) * 2048 + c0 + bj * 128 + n * 16;
                        acc[ai][bj][m][n] += bv + DN_ALPHA * bf4(*(const u32x2*)(HBp + off)); } }
        st.run(acc, pm, pn, wr, wc, fr, fq, lds, wid);
#pragma unroll
        for (int bj = 0; bj < 2; ++bj)
#pragma unroll
            for (int n = 0; n < 2; ++n) { const f32x4 gg = *(const f32x4*)(lng + c0 + bj * 128 + n * 16), bb = *(const f32x4*)(lnb + c0 + bj * 128 + n * 16);
#pragma unroll
                for (int ai = 0; ai < 2; ++ai)
#pragma unroll
                    for (int m = 0; m < 4; ++m) { const int r = ai * 128 + wr * 64 + m * 16 + fr; const f32x2 sr = S[r]; const size_t off = (size_t)(pm * 256 + r) * 2048 + c0 + bj * 128 + n * 16;
                        const f32x4 o = (acc[ai][bj][m][n] - sr[0]) * sr[1] * gg + bb; u32x2 w; w.x = cvt_pk_bf16(o[0], o[1]); w.y = cvt_pk_bf16(o[2], o[3]); *(u32x2*)(HBp + off) = w; } }
    } };
struct EpiResLn2 { static constexpr bool PERM = false, AFTER_DRAIN = true; const bf16_t* HBp; const float *bias, *lng, *lnb; float* out; const bf16_t* SGPW; PanelStats8 st;
    __device__ __forceinline__ void fused(AccT& acc, const GUnit& u, int wr, int wc, int fr, int fq, LAS unsigned char* lds, int wid) const {
        const int pm = u.i0, pn = u.i1; const int c0 = pn * 256 + wc * 32 + 4 * fq; const LAS f32x2* S = (const LAS f32x2*)(lds + 8192);
        const bf16_t* sgp = SGPW + (size_t)pm * (1u << 20);
        f32x4 bv[2][2];
#pragma unroll
        for (int bj = 0; bj < 2; ++bj)
#pragma unroll
            for (int n = 0; n < 2; ++n) bv[bj][n] = *(const f32x4*)(bias + c0 + bj * 128 + n * 16);
#pragma unroll
        for (int ai = 0; ai < 2; ++ai)
#pragma unroll
            for (int m = 0; m < 4; ++m) { const int r = ai * 128 + wr * 64 + m * 16 + fr; const size_t lo = (size_t)r * 2048 + c0; const bf16_t* hp = HBp + (size_t)(pm * 256 + r) * 2048 + c0;
#pragma unroll
                for (int bj = 0; bj < 2; ++bj)
#pragma unroll
                    for (int n = 0; n < 2; ++n) { const int co = bj * 128 + n * 16;
                        acc[ai][bj][m][n] += bv[bj][n] + DN_ALPHA * bf4(*(const u32x2*)(hp + co)) + bf4(*(const u32x2*)(sgp + lo + co)) * bf4(*(const u32x2*)(sgp + (1u << 19) + lo + co)); }
                asm volatile("" : "+v"(acc[ai][0][m][0]), "+v"(acc[ai][0][m][1]), "+v"(acc[ai][1][m][0]), "+v"(acc[ai][1][m][1])); }
        st.run(acc, pm, pn, wr, wc, fr, fq, lds, wid);
#pragma unroll
        for (int bj = 0; bj < 2; ++bj)
#pragma unroll
            for (int n = 0; n < 2; ++n) { const f32x4 gg = *(const f32x4*)(lng + c0 + bj * 128 + n * 16), bb = *(const f32x4*)(lnb + c0 + bj * 128 + n * 16);
#pragma unroll
                for (int ai = 0; ai < 2; ++ai)
#pragma unroll
                    for (int m = 0; m < 4; ++m) { const int r = ai * 128 + wr * 64 + m * 16 + fr; const f32x2 sr = S[r];
                        *(f32x4*)(out + (size_t)(pm * 256 + r) * 2048 + c0 + bj * 128 + n * 16) = (acc[ai][bj][m][n] - sr[0]) * sr[1] * gg + bb; } }
    } };
struct EpiG { static constexpr bool PERM = true, AFTER_DRAIN = false; bf16_t *G0, *G1; const float* bias;
    __device__ __forceinline__ void operator()(AccT& acc, const GUnit& u, int wr, int wc, int fr, int fq) const {
        const int pm = u.i0, h = u.i1; bf16_t* base = (pm < 16 ? G0 : G1) + (size_t)(pm & 15) * 256 * 4096 + h * 256;
        epi_bf16_store<0>(acc, base, 4096, bias + h * 256, wr, wc, fr, fq); } };
__device__ __forceinline__ float bfu(unsigned short v) { return __uint_as_float(((unsigned)v) << 16); }
__device__ __forceinline__ void rg_gate(float pa, float px, float spv, float xc, float& a, float& b) {
    const float r = fast_sigmoid(pa), ig = fast_sigmoid(px); const float la = spv * r; a = __expf(la); const float x = 2.0f * la;
    const float om = -x * (1.0f + x * (0.5f + x * (0.16666667f + x * (0.041666668f + x * 0.008333334f))));
    b = __builtin_amdgcn_sqrtf(fmaxf(om, 0.f)) * ig * xc; }
__device__ __forceinline__ void rg_gate2(float pa, float px, float spv, float xc, float& a, float& b, float& r) {
    r = fast_sigmoid(pa); const float ig = fast_sigmoid(px); const float la = spv * r; a = __expf(la); const float x = 2.0f * la;
    const float om = -x * (1.0f + x * (0.5f + x * (0.16666667f + x * (0.041666668f + x * 0.008333334f))));
    b = __builtin_amdgcn_sqrtf(fmaxf(om, 0.f)) * ig * xc; }
struct RgCtx { const bf16_t *XR, *G0, *G1, *Z; const float *convw, *convb, *sp; float* agg; bf16_t* ypre; };
__device__ __forceinline__ const bf16_t* g_row(const RgCtx& R, int t) { return (t < 4096 ? R.G0 : R.G1) + (size_t)(t & 4095) * 4096; }
__device__ __forceinline__ void rg_pass_a(const RgCtx& R, int half, int seg, int tid) {
    const int c = half * 512 + tid, gcol = (c >> 6) * 256 + (c & 63) * 4, t0 = seg * 64;
    const float w0 = R.convw[c], w1 = R.convw[1024 + c], w2 = R.convw[2048 + c], w3 = R.convw[3072 + c], cb = R.convb[c], sp0 = R.sp[c], sp1 = R.sp[1024 + c];
    const bf16_t* xp = R.XR + c;
    float x0 = bfu(xp[(size_t)(t0 + 0) * 1024]), x1 = bfu(xp[(size_t)(t0 + 1) * 1024]), x2 = bfu(xp[(size_t)(t0 + 2) * 1024]);
    float Af = 1.f, Bf = 0.f, Ab = 1.f, Bb = 0.f;
    for (int tb = 0; tb < 64; tb += 16) {
        u32x2 gq[16]; unsigned short xn[16];
#pragma unroll
        for (int i = 0; i < 16; ++i) { const int t = t0 + tb + i; gq[i] = *(const u32x2*)(g_row(R, t) + gcol); xn[i] = xp[(size_t)(t + 3) * 1024]; }
#pragma unroll
        for (int i = 0; i < 16; ++i) { const float x3 = bfu(xn[i]); const float xc = cb + w0 * x0 + w1 * x1 + w2 * x2 + w3 * x3; x0 = x1; x1 = x2; x2 = x3;
            float a, b, r0, r1, b0; rg_gate2(bf_lo(gq[i].x), bf_lo(gq[i].y), sp0, xc, a, b, r0); Bf = a * Bf + b; Af = a * Af; b0 = b;
            rg_gate2(bf_hi(gq[i].x), bf_hi(gq[i].y), sp1, xc, a, b, r1); Bb = Ab * b + Bb; Ab = Ab * a;
            u32x2 w; w.x = cvt_pk_bf16(r0, r1); w.y = cvt_pk_bf16(b0, b); *(u32x2*)((bf16_t*)g_row(R, t0 + tb + i) + gcol) = w; }
    }
    *(f32x2*)(R.agg + ((size_t)(seg * 2 + 0) * 1024 + c) * 2) = (f32x2){Af, Bf};
    *(f32x2*)(R.agg + ((size_t)(seg * 2 + 1) * 1024 + c) * 2) = (f32x2){Ab, Bb};
}
__device__ __forceinline__ void rg_pass_c(const RgCtx& R, int half, int seg, int tid, LAS float* Lh) {
    const int c = half * 512 + tid, gcol = (c >> 6) * 256 + (c & 63) * 4, t0 = seg * 64;
    const float sp0 = R.sp[c], sp1 = R.sp[1024 + c];
    const f32x2* ag = (const f32x2*)R.agg;
    float hf = 0.f, hb = 0.f;
    {
#pragma unroll 1
        for (int sb = 0; sb < 128; sb += 32) { f32x2 ab[32];
#pragma unroll
            for (int i = 0; i < 32; ++i) { const int s2 = sb + i; ab[i] = (s2 < seg) ? ag[(size_t)(s2 * 2 + 0) * 1024 + c] : (f32x2){1.f, 0.f}; }
#pragma unroll
            for (int i = 0; i < 32; ++i) hf = ab[i][0] * hf + ab[i][1]; }
#pragma unroll 1
        for (int sb = 96; sb >= 0; sb -= 32) { f32x2 ab[32];
#pragma unroll
            for (int i = 0; i < 32; ++i) { const int s2 = sb + 31 - i; ab[i] = (s2 > seg) ? ag[(size_t)(s2 * 2 + 1) * 1024 + c] : (f32x2){1.f, 0.f}; }
#pragma unroll
            for (int i = 0; i < 32; ++i) hb = ab[i][0] * hb + ab[i][1]; }
    }
    {
        for (int tb = 0; tb < 64; tb += 16) {
            u32x2 gq[16];
#pragma unroll
            for (int i = 0; i < 16; ++i) gq[i] = *(const u32x2*)(g_row(R, t0 + tb + i) + gcol);
#pragma unroll
            for (int i = 0; i < 16; ++i) { const float a = __expf(sp0 * bf_lo(gq[i].x)); hf = a * hf + bf_lo(gq[i].y); Lh[(tb + i) * 512 + tid] = hf; }
        }
    }
    {
        for (int tb = 48; tb >= 0; tb -= 16) {
            u32x2 gq[16]; unsigned short zz[16];
#pragma unroll
            for (int i = 0; i < 16; ++i) { const int t = t0 + tb + 15 - i; gq[i] = *(const u32x2*)(g_row(R, t) + gcol); zz[i] = R.Z[(size_t)t * 1024 + c]; }
#pragma unroll
            for (int i = 0; i < 16; ++i) { const int tl = tb + 15 - i; const float a = __expf(sp1 * bf_hi(gq[i].x)); hb = a * hb + bf_hi(gq[i].y);
                const float o = (Lh[tl * 512 + tid] + hb) * gelu_tanh(bfu(zz[i]));
                R.ypre[(size_t)(t0 + tl) * 2048 + 1024 + c] = (bf16_t)(cvt_pk_bf16(o, 0.f) & 0xffffu); }
        }
    }
}

#ifndef NAIVE_GEMM
#define NAIVE_GEMM 0
#endif
template <class Epi, class Sched>
__device__ __forceinline__ void gemm_phase_naive(LAS unsigned char* lds, const int wid, const GParm gp, const Sched& S, const Epi& E) {
    const int lane = fresh_lane(), tid = wid * 64 + lane, wr = wid >> 2, wc = wid & 3, fr = lane & 15, fq = lane >> 4;
    GUnit cur;
    for (int ui = 0; S.next(ui, cur); ++ui) {
        f32x4 acc[2][2][4][2];
#pragma unroll
        for (int ai = 0; ai < 2; ++ai)
#pragma unroll
            for (int bj = 0; bj < 2; ++bj)
#pragma unroll
                for (int m = 0; m < 4; ++m)
#pragma unroll
                    for (int n = 0; n < 2; ++n)
#pragma unroll
                        for (int e = 0; e < 4; ++e) {
                            const int row = 128 * ai + 64 * wr + 16 * m + fr; const int col = Epi::PERM ? (128 * bj + 32 * wc + 8 * fq + 4 * n + e) : (128 * bj + 32 * wc + 16 * n + 4 * fq + e);
                            const char* ap = cur.A + (size_t)row * gp.a_rs; const char* bp = cur.B + (size_t)col * gp.K * 2; float sum = 0.f;
                            for (int k = 0; k < gp.K; k += 8) { const int kt = k >> 6, C = k & 63;
                                const u32x4 av = *(const u32x4*)(ap + (size_t)kt * gp.a_ks + ((C / gp.a_cw) * gp.a_cs + (C % gp.a_cw)) * 2), bv = *(const u32x4*)(bp + k * 2);
                                sum += bf_lo(av.x) * bf_lo(bv.x) + bf_hi(av.x) * bf_hi(bv.x) + bf_lo(av.y) * bf_lo(bv.y) + bf_hi(av.y) * bf_hi(bv.y) + bf_lo(av.z) * bf_lo(bv.z) + bf_hi(av.z) * bf_hi(bv.z) + bf_lo(av.w) * bf_lo(bv.w) + bf_hi(av.w) * bf_hi(bv.w); }
                            acc[ai][bj][m][n][e] = sum; }
        if constexpr (Epi::AFTER_DRAIN) { __syncthreads(); E.fused(acc, cur, wr, wc, fr, fq, lds, wid); } else E(acc, cur, wr, wc, fr, fq);
    }
    __syncthreads();
}
#if NAIVE_GEMM
#define GEMM_PHASE gemm_phase_naive
#else
#define GEMM_PHASE pg8::gemm_phase
#endif
__device__ __forceinline__ void transpose_item(const float* W, int K, int N, bf16_t* WT, LAS float* scr, int item, int lane) {
    const int nblk = N / 64, kb = item / nblk, nb = item % nblk, k0 = 64 * kb, n0 = 64 * nb;
    const float* src = W + (size_t)k0 * N + n0 + lane;
#pragma unroll 32
    for (int i = 0; i < 64; ++i) scr[i * 65 + lane] = src[(size_t)i * N];
    LDS_WAIT();
    const int c = lane & 7;
#pragma unroll
    for (int j = 0; j < 8; ++j) { const int n = (lane >> 3) + 8 * j; const LAS float* sp = scr + (8 * c) * 65 + n;
        u32x4 o; o.x = cvt_pk_bf16(sp[0 * 65], sp[1 * 65]); o.y = cvt_pk_bf16(sp[2 * 65], sp[3 * 65]); o.z = cvt_pk_bf16(sp[4 * 65], sp[5 * 65]); o.w = cvt_pk_bf16(sp[6 * 65], sp[7 * 65]);
        *(u32x4*)(WT + (size_t)(n0 + n) * K + k0 + 8 * c) = o; }
    LDS_WAIT();
}
template <bool OUT_BF16> __device__ __forceinline__ void ln_row(const float* xrow, const float* g, const float* b, void* orow, int lane) {
    const f32x4* xr = (const f32x4*)xrow + lane; f32x4 v[8]; float s = 0.f;
#pragma unroll
    for (int j = 0; j < 8; ++j) { v[j] = xr[64 * j]; s += (v[j][0] + v[j][1]) + (v[j][2] + v[j][3]); }
    const float mean = wave_sum(s) * (1.f / DM); float s2 = 0.f;
#pragma unroll
    for (int j = 0; j < 8; ++j) { v[j] = v[j] - mean; s2 += (v[j][0] * v[j][0] + v[j][1] * v[j][1]) + (v[j][2] * v[j][2] + v[j][3] * v[j][3]); }
    const float rstd = 1.0f / sqrtf(wave_sum(s2) * (1.f / DM) + LN_EPS);
#pragma unroll
    for (int j = 0; j < 8; ++j) { const f32x4 gg = ((const f32x4*)g)[lane + 64 * j], bb = ((const f32x4*)b)[lane + 64 * j]; const f32x4 o = v[j] * rstd * gg + bb;
        if (OUT_BF16) { u32x2 w; w.x = cvt_pk_bf16(o[0], o[1]); w.y = cvt_pk_bf16(o[2], o[3]); ((u32x2*)orow)[lane + 64 * j] = w; }
        else ((f32x4*)orow)[lane + 64 * j] = o; }
}
__device__ __forceinline__ void cpow(float lrs, float th, int j, float& re, float& im) {
    double a = (double)j * (double)th * 0.15915494309189535; a -= rint(a); const float af = 2.0f * (float)a;
    const float mag = expf((float)j * lrs); re = mag * cospif(af); im = mag * sinpif(af);
}


#ifndef NAIVE_RG
#define NAIVE_RG 0
#endif
__device__ __forceinline__ void naive_rg_channel(const RgCtx& R, int c) {
    const int gcol = (c >> 6) * 256 + (c & 63);
    const float w0 = R.convw[c], w1 = R.convw[1024 + c], w2 = R.convw[2048 + c], w3 = R.convw[3072 + c], cb = R.convb[c], sp0 = R.sp[c], sp1 = R.sp[1024 + c];
    const bf16_t* xp = R.XR + c; float h = 0.f;
    for (int t = 0; t < SEQ; ++t) { const float xc = cb + w0 * bfu(xp[(size_t)t * 1024]) + w1 * bfu(xp[(size_t)(t + 1) * 1024]) + w2 * bfu(xp[(size_t)(t + 2) * 1024]) + w3 * bfu(xp[(size_t)(t + 3) * 1024]);
        const bf16_t* g = g_row(R, t) + gcol; float a, b; rg_gate(bfu(g[0]), bfu(g[128]), sp0, xc, a, b); h = a * h + b;
        R.ypre[(size_t)t * 2048 + 1024 + c] = (bf16_t)(cvt_pk_bf16(h, 0.f) & 0xffffu); }
    __builtin_amdgcn_fence(__ATOMIC_SEQ_CST, "agent");
    h = 0.f;
    for (int t = SEQ - 1; t >= 0; --t) { const float xc = cb + w0 * bfu(xp[(size_t)t * 1024]) + w1 * bfu(xp[(size_t)(t + 1) * 1024]) + w2 * bfu(xp[(size_t)(t + 2) * 1024]) + w3 * bfu(xp[(size_t)(t + 3) * 1024]);
        const bf16_t* g = g_row(R, t) + gcol; float a, b; rg_gate(bfu(g[64]), bfu(g[192]), sp1, xc, a, b); h = a * h + b;
        const size_t o = (size_t)t * 2048 + 1024 + c; const float y = (bfu(R.ypre[o]) + h) * gelu_tanh(bfu(R.Z[(size_t)t * 1024 + c]));
        R.ypre[o] = (bf16_t)(cvt_pk_bf16(y, 0.f) & 0xffffu); }
}

#ifndef NAIVE_S5
#define NAIVE_S5 0
#endif
__device__ __forceinline__ void naive_s5_group(const float* const* in, const bf16_t* U, float* tmp, bf16_t* YG, int g, int lane) {
    const float *lre = in[6], *lim = in[7], *lstep = in[8], *bre = in[9], *bim = in[10], *cre = in[11], *cim = in[12], *dd = in[13];
    for (int n = 0; n < 2; ++n) {
        const int p = lane, pi = (n * 64 + g) * 64 + p;
        const float lr = fminf(lre[pi], -1e-4f), li = lim[pi], step = expf(lstep[n * 64 + g]); float ar, ai; cpow(lr * step, li * step, 1, ar, ai);
        const float nr = ar - 1.0f, ni = ai, den = lr * lr + li * li; const float qr = (nr * lr + ni * li) / den, qi = (ni * lr - nr * li) / den;
        float hr = 0.f, hi = 0.f;
        for (int tt = 0; tt < SEQ; ++tt) { const int t = n == 0 ? tt : SEQ - 1 - tt; const bf16_t* up = U + (size_t)t * 1024 + g * 16;
            float bur = 0.f, bui = 0.f;
#pragma unroll
            for (int k = 0; k < 16; ++k) { const float uv = bfu(up[k]); const float br = bre[(size_t)pi * 16 + k], bi = bim[(size_t)pi * 16 + k]; bur += (qr * br - qi * bi) * uv; bui += (qr * bi + qi * br) * uv; }
            const float nhr = ar * hr - ai * hi + bur, nhi = ar * hi + ai * hr + bui; hr = nhr; hi = nhi;
#pragma unroll
            for (int k = 0; k < 16; ++k) { const size_t ci = ((size_t)(n * 64 + g) * 16 + k) * 64 + p; float v = cre[ci] * hr - cim[ci] * hi; v = wave_sum(v);
                if (lane == k) { const size_t o = (size_t)t * 1024 + g * 16 + k;
                    if (n == 0) tmp[o] = v; else { const float y = tmp[o] + v + dd[g * 16 + k] * bfu(up[k]); YG[o] = (bf16_t)(cvt_pk_bf16(gelu_tanh(y), 0.f) & 0xffffu); } } }
        }
        __builtin_amdgcn_fence(__ATOMIC_SEQ_CST, "agent");
    }
}

#define XB_TMO      128
#define XB_XCNT(j)  (256  + 64 * (j))
#define XB_XSUB(j)  (1280 + 64 * (j))
#define XB_XGEN(j)  (2304 + 64 * (j))
#define XB_TOP      3328
#define XB_TOPGEN   3392
#define XCD_BAR_WORDS 3456
#define XB_SPIN_CAP (1u << 18)
__device__ __forceinline__ unsigned xb_ld(unsigned* p)              { return __hip_atomic_load(p, __ATOMIC_RELAXED, __HIP_MEMORY_SCOPE_AGENT); }
__device__ __forceinline__ unsigned xb_add(unsigned* p, unsigned v) { return __hip_atomic_fetch_add(p, v, __ATOMIC_RELAXED, __HIP_MEMORY_SCOPE_AGENT); }
__device__ __forceinline__ unsigned xb_xcc_id() { return (unsigned)__builtin_amdgcn_s_getreg((3 << 11) | 20) & 0xFu; }
#define XB_SPIN(cond, bar) do { unsigned _sp = 0; while (cond) { __builtin_amdgcn_s_sleep(1); \
    if ((++_sp & 255u) == 0u) { if (xb_ld(&(bar)[XB_TMO])) break; if (_sp > XB_SPIN_CAP) { atomicAdd(&(bar)[XB_TMO], 1u); break; } } } } while (0)
struct XcdBarrier { unsigned* bar; unsigned x; volatile LAS unsigned* st; };
__device__ __forceinline__ void xcd_barrier_complete(unsigned* bar, unsigned x, unsigned G, unsigned& nloc, unsigned& nx) {
    unsigned sum, cnt, mine, sp = 0u;
    for (;;) {
        sum = 0u; cnt = 0u; mine = 0u;
#pragma unroll
        for (unsigned j = 0; j < 16; ++j) { const unsigned c = xb_ld(&bar[XB_XCNT(j)]); sum += c; cnt += (c > 0u) ? 1u : 0u; mine = (j == x) ? c : mine; }
        if (sum == G) break;
        __builtin_amdgcn_s_sleep(1);
        if ((++sp & 255u) == 0u) { if (xb_ld(&bar[XB_TMO])) break; if (sp > XB_SPIN_CAP) { atomicAdd(&bar[XB_TMO], 1u); break; } }
    }
    nloc = mine > 0u ? mine : 1u; nx = cnt > 0u ? cnt : 1u;
}
__device__ __forceinline__ void xcd_barrier(const XcdBarrier& b, unsigned G, int wave) {
    asm volatile("s_waitcnt vmcnt(0)" ::: "memory");
    __syncthreads();
    if (wave == 0) { if (fresh_lane() == 0) {
        unsigned* bar = b.bar;
        __builtin_amdgcn_s_waitcnt(0);
        unsigned nloc = b.st[0], nx = b.st[1];
        if (nloc == 0u) { xcd_barrier_complete(bar, b.x, G, nloc, nx); b.st[0] = nloc; b.st[1] = nx; }
        const unsigned old = xb_add(&bar[XB_XSUB(b.x)], 1u);
        const unsigned gen = old / nloc;
        if (old + 1u == (gen + 1u) * nloc) {
            __builtin_amdgcn_fence(__ATOMIC_RELEASE, "agent");
            asm volatile("s_waitcnt vmcnt(0)" ::: "memory");
            const unsigned og = xb_add(&bar[XB_TOP], 1u);
            const unsigned tg = og / nx;
            if (og + 1u == (tg + 1u) * nx) xb_add(&bar[XB_TOPGEN], 1u);
            else XB_SPIN(xb_ld(&bar[XB_TOPGEN]) == tg, bar);
            __builtin_amdgcn_fence(__ATOMIC_ACQUIRE, "agent");
            xb_add(&bar[XB_XGEN(b.x)], 1u);
            asm volatile("s_waitcnt vmcnt(0)" ::: "memory");
        } else {
            XB_SPIN(xb_ld(&bar[XB_XGEN(b.x)]) == gen, bar);
            __builtin_amdgcn_fence(__ATOMIC_ACQUIRE, "agent");
            asm volatile("s_waitcnt vmcnt(0)" ::: "memory");
        }
    } }
    __syncthreads();
}

__device__ __forceinline__ void grid_barrier(unsigned* bar, unsigned target, int wave) {
    asm volatile("s_waitcnt vmcnt(0)" ::: "memory");
    __syncthreads();
    if (wave == 0) { const int l = fresh_lane();
        if (l == 0) {
            __builtin_amdgcn_fence(__ATOMIC_RELEASE, "agent"); asm volatile("s_waitcnt vmcnt(0)" ::: "memory");
            __hip_atomic_fetch_add(bar, 1u, __ATOMIC_RELAXED, __HIP_MEMORY_SCOPE_AGENT);
            while (__hip_atomic_load(bar, __ATOMIC_RELAXED, __HIP_MEMORY_SCOPE_AGENT) < target) __builtin_amdgcn_s_sleep(2);
            __builtin_amdgcn_fence(__ATOMIC_ACQUIRE, "agent"); asm volatile("s_waitcnt vmcnt(0)" ::: "memory");
        } }
    __syncthreads();
}

struct Args { const float* in[38]; float* out; unsigned char* ws; int ph_lo, ph_hi; };
typedef const float* cfp_t;
typedef const __attribute__((address_space(4))) cfp_t* kin_t;

__device__ __forceinline__ void s5_precompute(const kin_t ain, unsigned char* aws, int g, int hq, int nh, LAS float* L, const int tid) {
    const float *lre = ain[6], *lim = ain[7], *lstep = ain[8], *bre = ain[9], *bim = ain[10], *cre = ain[11], *cim = ain[12], *dd = ain[13];
    LAS float *PWre = L, *PWim = L + 4224, *BBre = L + 8448, *BBim = L + 10496, *CCre = L + 12544, *CCim = L + 14592, *MT = L + 16640, *C2re = L + 33280, *C2im = L + 35328, *Dl = L + 37376;
    bf16_t* WGg = (bf16_t*)(aws + WS_WG) + (size_t)g * 768 * 512; bf16_t* WCg = (bf16_t*)(aws + WS_WC) + (size_t)g * 512 * 256;
#define PSTAMP(i) do { if (TSTAMP && blockIdx.x == 128 && tid == 0) ((unsigned long long*)(aws + WS_CTR + 1024))[i] = __builtin_amdgcn_s_memrealtime(); } while (0)
    PSTAMP(20);
    {
        const int np = tid & 127, jj = tid >> 7, n = np >> 6, p = np & 63; const int pi = (n * 64 + g) * 64 + p;
        const float lr = fminf(lre[pi], -1e-4f), li = lim[pi], step = expf(lstep[n * 64 + g]); const float lrs = lr * step, th = li * step;
        for (int j = jj; j <= 32; j += 4) { float r, i; cpow(lrs, th, j, r, i); PWre[np * 33 + j] = r; PWim[np * 33 + j] = i; }
        float l1r, l1i; cpow(lrs, th, 1, l1r, l1i);
        const float nr = l1r - 1.0f, ni = l1i, den = lr * lr + li * li; const float qr = (nr * lr + ni * li) / den, qi = (ni * lr - nr * li) / den;
#pragma unroll
        for (int k = jj * 4; k < jj * 4 + 4; ++k) { const float br = bre[(size_t)pi * 16 + k], bi = bim[(size_t)pi * 16 + k]; BBre[np * 16 + k] = qr * br - qi * bi; BBim[np * 16 + k] = qr * bi + qi * br; }
        for (int e = tid; e < 2048; e += 512) { const int n2 = e >> 10, k = (e >> 6) & 15, p2 = e & 63; const size_t ci = ((size_t)(n2 * 64 + g) * 16 + k) * 64 + p2; CCre[(n2 * 64 + p2) * 16 + k] = cre[ci]; CCim[(n2 * 64 + p2) * 16 + k] = cim[ci]; C2re[e] = cre[ci]; C2im[e] = cim[ci]; }
        if (tid < 16) Dl[tid] = dd[g * 16 + tid];
    }
    __syncthreads();
    PSTAMP(21);
    for (int i = 0; i < 3; ++i) {
        if (nh == 2) { if (i < 2 && i != hq) continue; if (i == 2 && (hq != 0 || tid >= 16)) continue; } else if (i == 2) continue;
        const int bq = (i == 2) ? 512 + tid : tid + 512 * i, n = bq >> 9, j = (bq >> 4) & 31, kob = (bq >> 2) & 3, kib = bq & 3;
        f32x4 m0 = {0.f, 0.f, 0.f, 0.f}, m1 = m0, m2 = m0, m3 = m0;
        for (int p = 0; p < 64; ++p) { const int np = n * 64 + p; const float pr = PWre[np * 33 + j], pi2 = PWim[np * 33 + j];
            const f32x4 br = *(const LAS f32x4*)(BBre + np * 16 + 4 * kib), bi = *(const LAS f32x4*)(BBim + np * 16 + 4 * kib), cr = *(const LAS f32x4*)(CCre + np * 16 + 4 * kob), ci = *(const LAS f32x4*)(CCim + np * 16 + 4 * kob);
            const f32x4 er = pr * br - pi2 * bi, ei = pr * bi + pi2 * br;
            m0 += cr[0] * er - ci[0] * ei; m1 += cr[1] * er - ci[1] * ei; m2 += cr[2] * er - ci[2] * ei; m3 += cr[3] * er - ci[3] * ei; }
        LAS float* o = MT + (n * 32 + j) * 260 + (4 * kob) * 16 + 4 * kib;
        *(LAS f32x4*)o = m0; *(LAS f32x4*)(o + 16) = m1; *(LAS f32x4*)(o + 32) = m2; *(LAS f32x4*)(o + 48) = m3;
    }
    __syncthreads();
    PSTAMP(22);
    for (int i = 0; i < 64; ++i) {
        const int idx = tid + 512 * i, row = idx >> 6, cp = idx & 63, t = row >> 4, ko = row & 15, s = cp >> 1, ki0 = (cp & 1) * 8;
        if (nh == 2 && ((t >= s) != (hq == 0))) continue;
        f32x4 v0, v1;
        if (t != s) { const LAS float* src = MT + ((t > s ? 0 : 1) * 32 + (t > s ? t - s : s - t)) * 260 + ko * 16 + ki0; v0 = *(const LAS f32x4*)src; v1 = *(const LAS f32x4*)(src + 4); }
        else { const LAS float* s0 = MT + ko * 16 + ki0; const LAS float* s1 = MT + 32 * 260 + ko * 16 + ki0; v0 = *(const LAS f32x4*)s0 + *(const LAS f32x4*)s1; v1 = *(const LAS f32x4*)(s0 + 4) + *(const LAS f32x4*)(s1 + 4);
            const float dv = Dl[ko];
#pragma unroll
            for (int e = 0; e < 4; ++e) { if (ki0 + e == ko) v0[e] += dv; if (ki0 + 4 + e == ko) v1[e] += dv; } }
        u32x4 w; w.x = cvt_pk_bf16(v0[0], v0[1]); w.y = cvt_pk_bf16(v0[2], v0[3]); w.z = cvt_pk_bf16(v1[0], v1[1]); w.w = cvt_pk_bf16(v1[2], v1[3]);
        *(u32x4*)(WGg + (size_t)row * 512 + cp * 8) = w;
    }
    for (int i = hq * (32 / nh); i < (hq + 1) * (32 / nh); ++i) {
        const int idx = tid + 512 * i, q = idx >> 6, cp = idx & 63, n = q >> 7, ri = (q >> 6) & 1, p = q & 63, s = cp >> 1, ki0 = (cp & 1) * 8, e = n == 0 ? 31 - s : s, np = n * 64 + p;
        const float pr = PWre[np * 33 + e], pi2 = PWim[np * 33 + e]; float v[8];
#pragma unroll
        for (int k = 0; k < 8; ++k) { const float br = BBre[np * 16 + ki0 + k], bi = BBim[np * 16 + ki0 + k]; v[k] = ri == 0 ? pr * br - pi2 * bi : pr * bi + pi2 * br; }
        u32x4 w; w.x = cvt_pk_bf16(v[0], v[1]); w.y = cvt_pk_bf16(v[2], v[3]); w.z = cvt_pk_bf16(v[4], v[5]); w.w = cvt_pk_bf16(v[6], v[7]);
        *(u32x4*)(WGg + (size_t)(512 + q) * 512 + cp * 8) = w;
    }
    for (int i = 0; i < 32 / nh; ++i) {
        const int idx = tid + 512 * i, row = nh == 2 ? idx >> 4 : idx >> 5, q0 = nh == 2 ? hq * 128 + (idx & 15) * 8 : (idx & 31) * 8, n = q0 >> 7, ri = (q0 >> 6) & 1, p0 = q0 & 63, t = row >> 4, ko = row & 15, e = n == 0 ? t + 1 : 32 - t; float v[8];
#pragma unroll
        for (int k = 0; k < 8; ++k) { const int np = n * 64 + p0 + k; const float cr = C2re[(n * 16 + ko) * 64 + p0 + k], ci = C2im[(n * 16 + ko) * 64 + p0 + k], pr = PWre[np * 33 + e], pi2 = PWim[np * 33 + e];
            v[k] = ri == 0 ? cr * pr - ci * pi2 : -(cr * pi2 + ci * pr); }
        u32x4 w; w.x = cvt_pk_bf16(v[0], v[1]); w.y = cvt_pk_bf16(v[2], v[3]); w.z = cvt_pk_bf16(v[4], v[5]); w.w = cvt_pk_bf16(v[6], v[7]);
        *(u32x4*)(WCg + (size_t)row * 256 + q0) = w;
    }
    __syncthreads();
    PSTAMP(23);
}


#ifndef DIAG
#define DIAG 0
#endif
__device__ __forceinline__ void diag_ffn(const float* const* in, const unsigned char* ws, const float* outp, unsigned* flagw, int gtid, int GT) {
    const bf16_t* h1 = (const bf16_t*)(ws + WS_HB); const bf16_t* T = (const bf16_t*)(ws + WS_T); const float* V2 = (const float*)(ws + WS_V2);
    const float *w1 = in[29], *b1 = in[30], *w2 = in[31], *b2 = in[32], *wp = in[33], *wg = in[34], *bg = in[35], *pp = in[1];
    for (int sidx = gtid; sidx < 16384; sidx += GT) {
        unsigned hsh = (unsigned)sidx * 2654435761u, h2 = ((unsigned)sidx + 977u) * 2246822519u; const int r = (hsh >> 8) % SEQ; const int c = (h2 >> 6) % DFF; const int c2 = c % DM;
        float a = b1[c]; for (int k = 0; k < DM; ++k) a += bfu(h1[(size_t)r * DM + k]) * w1[(size_t)k * DFF + c];
        a = fmaxf(a, 0.f); a = a * a; const float tv = bfu(T[(size_t)r * DFF + c]);
        if (fabsf(tv - a) > 0.008f * fabsf(a) + 0.006f) atomicAdd(flagw + 0, 1u);
        float f = b2[c2]; for (int k = 0; k < DFF; ++k) f += bfu(T[(size_t)r * DFF + k]) * w2[(size_t)k * DM + c2];
        float gt = bg[c2]; for (int k = 0; k < DM; ++k) gt += bfu(h1[(size_t)r * DM + k]) * wg[(size_t)k * DM + c2];
        float pw = 0.f; for (int k = 0; k < PLE; ++k) pw += pp[(size_t)r * PLE + k] * wp[(size_t)k * DM + c2];
        const float v2 = DN_ALPHA * bfu(h1[(size_t)r * DM + c2]) + f + fast_sigmoid(gt) * pw; const float got = V2[(size_t)r * DM + c2];
        if (fabsf(got - v2) > 0.008f * fabsf(v2) + 0.006f) atomicAdd(flagw + 1, 1u);
        { const float* vr = V2 + (size_t)r * DM; float m = 0.f; for (int k = 0; k < DM; ++k) m += vr[k]; m /= DM; float v = 0.f; for (int k = 0; k < DM; ++k) { const float d = vr[k] - m; v += d * d; } v /= DM;
          const float e = (vr[c2] - m) / sqrtf(v + LN_EPS) * in[36][c2] + in[37][c2]; const float go = outp[(size_t)r * DM + c2]; if (fabsf(go - e) > 0.004f * fabsf(e) + 0.003f) atomicAdd(flagw + 2, 1u); }
    }
}

__device__ __forceinline__ void diag_pre(const float* const* in, const unsigned char* ws, const unsigned char* dout, unsigned* flagw, int gtid, int GT) {
    const bf16_t* h0 = (const bf16_t*)(ws + WS_HB); const bf16_t* U = (const bf16_t*)(dout + DO_U); const bf16_t* XRb = (const bf16_t*)(ws + WS_XR) + 2048; const bf16_t* Z = (const bf16_t*)(dout + DO_Z);
    const bf16_t* ypre = (const bf16_t*)(dout + DO_YPRE); const bf16_t* ycat = (const bf16_t*)(ws + WS_YCAT); const bf16_t* yg = (const bf16_t*)(ws + WS_YS5G);
    const float *x = in[0], *lg = in[2], *lb = in[3], *win = in[4], *bin = in[5], *gw_ = in[14], *gb = in[15], *g5 = in[23], *gr = in[24];
    for (int sidx = gtid; sidx < 8192; sidx += GT) {
        unsigned hsh = (unsigned)sidx * 2654435761u, h2 = ((unsigned)sidx + 977u) * 2246822519u; const int r = (hsh >> 8) % SEQ; const int c = (h2 >> 6) % DIN; const int c2 = c % DM; const int c1 = c % DS5;
        { float m = 0.f; for (int k = 0; k < DM; ++k) m += x[(size_t)r * DM + k]; m /= DM; float v = 0.f; for (int k = 0; k < DM; ++k) { const float d = x[(size_t)r * DM + k] - m; v += d * d; } v /= DM;
          const float e = (x[(size_t)r * DM + c2] - m) / sqrtf(v + LN_EPS) * lg[c2] + lb[c2]; const float got = bfu(h0[(size_t)r * DM + c2]); if (fabsf(got - e) > 0.008f * fabsf(e) + 0.006f) atomicAdd(flagw + 0, 1u); }
        { float a = bin[c]; for (int k = 0; k < DM; ++k) a += bfu(h0[(size_t)r * DM + k]) * win[(size_t)k * DIN + c];
          const float got = c < 1024 ? bfu(U[(size_t)r * 1024 + c]) : (c < 2048 ? bfu(XRb[(size_t)r * 1024 + c - 1024]) : bfu(Z[(size_t)r * 1024 + c - 2048])); if (fabsf(got - a) > 0.008f * fabsf(a) + 0.006f) atomicAdd(flagw + 3, 1u); }
        { const int hf = c2 >> 10; float ss = 0.f; for (int k = 0; k < 1024; ++k) { const float y = bfu(ypre[(size_t)r * DM + hf * 1024 + k]); ss += y * y; }
          const float e = bfu(ypre[(size_t)r * DM + c2]) / sqrtf(ss / 1024.f + LN_EPS) * (hf ? gr[c2 - 1024] : g5[c2]); const float got = bfu(ycat[(size_t)r * DM + c2]); if (fabsf(got - e) > 0.008f * fabsf(e) + 0.006f) atomicAdd(flagw + 1, 1u); }
        { float a = gb[c1]; for (int k = 0; k < DS5; ++k) a += bfu(yg[(size_t)r * DS5 + k]) * gw_[(size_t)k * DS5 + c1];
          const float e = bfu(yg[(size_t)r * DS5 + c1]) * fast_sigmoid(a); const float got = bfu(ypre[(size_t)r * DM + c1]); if (fabsf(got - e) > 0.008f * fabsf(e) + 0.006f) atomicAdd(flagw + 2, 1u); }
    }
}

__device__ __forceinline__ void diag_v(const float* const* in, const unsigned char* ws, const unsigned char* dout, unsigned* flagw, int gtid, int GT) {
    const bf16_t* h0 = (const bf16_t*)(ws + WS_HB); const bf16_t* ycat = (const bf16_t*)(ws + WS_YCAT); const float* V = (const float*)dout; const float *wo = in[25], *bo = in[26];
    for (int sidx = gtid; sidx < 16384; sidx += GT) { unsigned hsh = (unsigned)sidx * 2654435761u, h2 = ((unsigned)sidx + 977u) * 2246822519u; const int r = (hsh >> 8) % SEQ; const int c = (h2 >> 6) % DM;
        float a = bo[c] + DN_ALPHA * bfu(h0[(size_t)r * DM + c]); for (int k = 0; k < DM; ++k) a += bfu(ycat[(size_t)r * DM + k]) * wo[(size_t)k * DM + c];
        const float got = V[(size_t)r * DM + c]; if (fabsf(got - a) > 0.008f * fabsf(a) + 0.006f) atomicAdd(flagw + 0, 1u); }
}

__device__ __forceinline__ void diag_g(const float* const* in, const unsigned char* ws, unsigned* flagw, int gtid, int GT) {
    const bf16_t* XRp = (const bf16_t*)(ws + WS_XR); const bf16_t* G0 = (const bf16_t*)(ws + WS_G0); const bf16_t* G1 = (const bf16_t*)(ws + WS_G1);
    const float *convw = in[16], *convb = in[17], *wa = in[18], *ba = in[19], *wx = in[20], *bxx = in[21];
    for (int sidx = gtid; sidx < 16384; sidx += GT) { unsigned hsh = (unsigned)sidx * 2654435761u; unsigned h2 = ((unsigned)sidx + 12345u) * 2246822519u; const int t = (hsh >> 7) % SEQ; const int col = (h2 >> 5) % 4096;
        const int h = col >> 8, row = col & 255, bj = row >> 7, dir = (row >> 6) & 1, ch = row & 63;
        const float* W = (bj == 0 ? wa : wx) + ((size_t)(dir * 16 + h) * 64) * 64 + ch; float a = (bj == 0 ? ba : bxx)[(dir * 16 + h) * 64 + ch];
        for (int i = 0; i < 64; ++i) { const int c = 64 * h + i; float xc = convb[c];
            for (int j = 0; j < 4; ++j) xc += convw[j * 1024 + c] * bfu(XRp[(size_t)(t + j) * 1024 + c]);
            a += xc * W[(size_t)i * 64]; }
        const float got = bfu((t < 4096 ? G0 : G1)[(size_t)(t & 4095) * 4096 + col]);
        if (fabsf(got - a) > 0.008f * fabsf(a) + 0.006f) atomicAdd(flagw + 0, 1u); }
}

#ifndef DIAG_HALF
#define DIAG_HALF 1
#endif
__device__ __forceinline__ void diag_max(const unsigned char* ws, unsigned* flagw, int gtid, int GT) {
    const bf16_t* ycat = (const bf16_t*)(ws + WS_YCAT); float mx = 0.f;
    for (size_t i = gtid; i < (size_t)SEQ * 1024; i += GT) { const size_t r = i >> 10, c = (i & 1023) + DIAG_HALF * 1024; mx = fmaxf(mx, fabsf(bfu(ycat[r * DM + c]))); }
    atomicMax(flagw + 0, __float_as_uint(mx));
}

#ifndef DIAG_SEL
#define DIAG_SEL 4
#endif
__device__ __forceinline__ void diag_rows(const float* outp, unsigned* flagw, int gw, int NGW, int lane) {
    for (int row = gw; row < SEQ; row += NGW) { float mx = 0.f; for (int j = lane; j < DM; j += 64) mx = fmaxf(mx, fabsf(outp[(size_t)row * DM + j]));
#pragma unroll
        for (int o = 1; o < 64; o <<= 1) mx = fmaxf(mx, __shfl_xor(mx, o));
        if (lane == 0 && mx > 12.0f) { atomicAdd(flagw + 0, 1u); atomicMin(flagw + 1, (unsigned)row); atomicMax(flagw + 2, (unsigned)row); } }
}

__device__ __forceinline__ void diag_rows_bf(const bf16_t* p, int ld, float thr, unsigned* flagw, int gw, int NGW, int lane) {
    for (int row = gw; row < SEQ; row += NGW) { float mx = 0.f; for (int j = lane; j < ld; j += 64) mx = fmaxf(mx, fabsf(bfu(p[(size_t)row * ld + j])));
#pragma unroll
        for (int o = 1; o < 64; o <<= 1) mx = fmaxf(mx, __shfl_xor(mx, o));
        if (lane == 0 && mx > thr) { atomicAdd(flagw + 0, 1u); atomicMin(flagw + 1, (unsigned)row); atomicMax(flagw + 2, (unsigned)row); } }
}
template <int PHMASK> __global__ void __launch_bounds__(512, 2) mega(Args) {
    extern __shared__ __attribute__((aligned(16))) unsigned char lds_raw[];
    LAS unsigned char* lds = (LAS unsigned char*)lds_raw;
    const int wave = __builtin_amdgcn_readfirstlane((int)threadIdx.x >> 6);
    const int G = gridDim.x, bx = blockIdx.x;
    const int gw = bx * 8 + wave, NGW = G * 8, GT = G * 512;
#define PH_IDS const int lane = fresh_lane(), tid = wave * 64 + lane, gtid = bx * 512 + tid; (void)tid; (void)gtid; (void)lane
    const kin_t KIN = (kin_t)__builtin_amdgcn_kernarg_segment_ptr();
    unsigned char* ws = (unsigned char*)KIN[39]; unsigned char* dout = (unsigned char*)KIN[38];
    const int* kint = (const int*)0; (void)kint;
#if DIAG == 2
    const int lo = ((const __attribute__((address_space(4))) int*)KIN)[80], hi = 7;
#elif DIAG == 3
    const int lo = ((const __attribute__((address_space(4))) int*)KIN)[80], hi = 8;
#elif DIAG == 4
    const int lo = ((const __attribute__((address_space(4))) int*)KIN)[80], hi = 5;
#elif DIAG == 6
    const int lo = ((const __attribute__((address_space(4))) int*)KIN)[80], hi = 7;
#elif DIAG == 8
    const int lo = ((const __attribute__((address_space(4))) int*)KIN)[80], hi = 9;
#elif DIAG == 11 || DIAG == 12
    const int lo = ((const __attribute__((address_space(4))) int*)KIN)[80], hi = 10;
#else
    const int lo = ((const __attribute__((address_space(4))) int*)KIN)[80], hi = ((const __attribute__((address_space(4))) int*)KIN)[81];
#endif
#define IN(k) (((PHMASK >> (k)) & 1) && lo <= (k) && (k) < hi)
    unsigned nbar = 0; unsigned* gbar = (unsigned*)(ws + WS_CTR) + 32; (void)gbar;
    XcdBarrier xb; xb.bar = (unsigned*)(ws + WS_CTR) + 5120; xb.x = xb_xcc_id(); xb.st = (volatile LAS unsigned*)(lds + 155000);
    if (wave == 0) { if (fresh_lane() == 0) { xb.st[0] = 0u; xb.st[1] = 0u; (void)xb_add(&xb.bar[XB_XCNT(xb.x)], 1u); } }
    __syncthreads();
    if (PHMASK == 0xfff && hi > 4096) cg::this_grid().sync();
#ifndef DBL_MASK
#define DBL_MASK 0
#endif
#define REPS(k) (((DBL_MASK >> (k)) & 1) ? 2 : 1)
#define SEAM(k) do { if (IN(k) && IN((k) + 1)) { ++nbar; xcd_barrier(xb, (unsigned)G, wave); if (TSTAMP && bx == 0 && wave == 0) { if (fresh_lane() == 0) ((unsigned long long*)(ws + WS_CTR + 1024))[(k) + 1] = __builtin_amdgcn_s_memrealtime(); } } } while (0)

#define MK_RG const RgCtx RG{(const bf16_t*)(ws + WS_XR), (const bf16_t*)(ws + WS_G0), (const bf16_t*)(ws + WS_G1), (const bf16_t*)(dout + DO_Z), KIN[16], KIN[17], (const float*)(ws + WS_SP), (float*)(ws + WS_AGG), (bf16_t*)(dout + DO_YPRE)}
    if (TSTAMP && bx == 0 && wave == 0) { if (fresh_lane() == 0) ((unsigned long long*)(ws + WS_CTR + 1024))[0] = __builtin_amdgcn_s_memrealtime(); }
    for (int rep = 0; rep < REPS(0); ++rep) {
    if (IN(0)) { PH_IDS;
        if (G != 256) { for (int g = bx; g < 64; g += G) s5_precompute(KIN, ws, g, 0, 1, (LAS float*)lds, tid); }
        {
            LAS float* scr = (LAS float*)(lds + wave * 16640);
            constexpr int I_IN = (DM / 64) * (DIN / 64), I_OUT = (DM / 64) * (DM / 64), I_PG = I_OUT, I_GLU = (DS5 / 64) * (DS5 / 64), I_PW = (PLE / 64) * (DM / 64), I_LN = SEQ / 4;
            constexpr int NITEMS = I_IN + I_OUT + I_PG + I_GLU + I_PW + I_LN;
            for (int it = gw; it < NITEMS; it += NGW) {
                int r = it;
                if (r < I_IN) { transpose_item(KIN[4], DM, DIN, (bf16_t*)(ws + WS_WINT), scr, r, lane); continue; } r -= I_IN;
                if (r < I_LN) { for (int q = 0; q < 4; ++q) { const int row = r * 4 + q; ln_row<true>(KIN[0] + (size_t)row * DM, KIN[2], KIN[3], (bf16_t*)(ws + WS_HB) + (size_t)row * DM, lane); } continue; } r -= I_LN;
                if (r < I_OUT) { transpose_item(KIN[25], DM, DM, (bf16_t*)(ws + WS_WOUTT), scr, r, lane); continue; } r -= I_OUT;
                if (r < I_PG) { transpose_item(KIN[34], DM, DM, (bf16_t*)(ws + WS_PLEGT), scr, r, lane); continue; } r -= I_PG;
                if (r < I_GLU) { transpose_item(KIN[14], DS5, DS5, (bf16_t*)(ws + WS_GLUT), scr, r, lane); continue; } r -= I_GLU;
                transpose_item(KIN[33], PLE, DM, (bf16_t*)(ws + WS_PLEWT), scr, r, lane);
            }
        }
        {   const float* pp = KIN[1]; bf16_t* pb = (bf16_t*)(ws + WS_PB);
            for (int i = gtid; i < SEQ * PLE / 4; i += GT) { const f32x4 v = ((const f32x4*)pp)[i]; u32x2 w; w.x = cvt_pk_bf16(v[0], v[1]); w.y = cvt_pk_bf16(v[2], v[3]); ((u32x2*)pb)[i] = w; }
            const float *convw = KIN[16], *convb = KIN[17], *wa = KIN[18], *ba = KIN[19], *wx = KIN[20], *bxx = KIN[21], *lam = KIN[22];
            bf16_t* rgw = (bf16_t*)(ws + WS_RGW);
            for (int i = gtid; i < 16 * 256 * 32; i += GT) { const int h = i >> 13, row = (i >> 5) & 255, K0 = (i & 31) * 8, j = K0 >> 6, i0 = K0 & 63, ch = row >> 2, bj = (row >> 1) & 1, dir = row & 1;
                const float* W = (bj == 0 ? wa : wx) + ((size_t)(dir * 16 + h) * 64) * 64 + ch; float v[8];
#pragma unroll
                for (int k = 0; k < 8; ++k) v[k] = convw[j * 1024 + 64 * h + i0 + k] * W[(size_t)(i0 + k) * 64];
                u32x4 w; w.x = cvt_pk_bf16(v[0], v[1]); w.y = cvt_pk_bf16(v[2], v[3]); w.z = cvt_pk_bf16(v[4], v[5]); w.w = cvt_pk_bf16(v[6], v[7]);
                *(u32x4*)(rgw + ((size_t)h * 256 + row) * 256 + K0) = w; }
            float* rgb = (float*)(ws + WS_RGBIAS);
            for (int i = gtid; i < 16 * 256; i += GT) { const int h = i >> 8, row = i & 255, ch = row >> 2, bj = (row >> 1) & 1, dir = row & 1;
                const float* W = (bj == 0 ? wa : wx) + ((size_t)(dir * 16 + h) * 64) * 64 + ch; float s = (bj == 0 ? ba : bxx)[(dir * 16 + h) * 64 + ch];
#pragma unroll
                for (int k = 0; k < 64; ++k) s += convb[64 * h + k] * W[(size_t)k * 64];
                rgb[i] = s; }
            float* spt = (float*)(ws + WS_SP);
            for (int i = gtid; i < 2 * 1024; i += GT) spt[i] = -8.0f * log1pf(expf(-lam[i]));
            unsigned* xr = (unsigned*)(ws + WS_XR);
            for (int i = gtid; i < 1024; i += GT) { xr[i] = 0u; xr[(size_t)(SEQ + 2) * 512 + i] = 0u; }
        }
    }
    if (rep + 1 < REPS(0)) { ++nbar; xcd_barrier(xb, (unsigned)G, wave); } }
    SEAM(0);
    for (int rep = 0; rep < REPS(1); ++rep) {
    if (IN(1)) { PH_IDS;
        SchedStd S; S.so.init(SEQ, DIN, G, bx); S.A = (const char*)(ws + WS_HB); S.B = (const char*)(ws + WS_WINT); S.a_tile = (size_t)256 * DM * 2; S.b_tile = (size_t)256 * DM * 2;
        EpiProj E{(bf16_t*)(dout + DO_U), (bf16_t*)(ws + WS_XR), (bf16_t*)(dout + DO_Z), KIN[5]};
        GEMM_PHASE(lds, wave, GParm{DM, DM * 2, 128, 64, 0}, S, E);
        if (G == 256 && bx >= 128) { __syncthreads(); const int t2 = wave * 64 + fresh_lane(); s5_precompute(KIN, ws, (bx - 128) >> 1, (bx - 128) & 1, 2, (LAS float*)lds, t2); }
    }
    if (rep + 1 < REPS(1)) { ++nbar; xcd_barrier(xb, (unsigned)G, wave); } }
    SEAM(1);
    for (int rep = 0; rep < REPS(2); ++rep) {
    if (IN(2)) { PH_IDS;
        { SchedS5a S{(const char*)(dout + DO_U), (const char*)(ws + WS_WG), G, bx}; EpiS5a E{(bf16_t*)(ws + WS_YINTRA), (float*)(ws + WS_S)};
          GEMM_PHASE(lds, wave, GParm{512, 1024, 128, 64, 0}, S, E); }
        { SchedRG S{(const char*)(ws + WS_XR), (const char*)(ws + WS_RGW), G, bx}; EpiG E{(bf16_t*)(ws + WS_G0), (bf16_t*)(ws + WS_G1), (const float*)(ws + WS_RGBIAS)};
          GEMM_PHASE(lds, wave, GParm{256, 2048, 2048, 64, 0}, S, E); }
    }
    if (rep + 1 < REPS(2)) { ++nbar; xcd_barrier(xb, (unsigned)G, wave); } }
    SEAM(2);
    for (int rep = 0; rep < REPS(3); ++rep) {
    if (IN(3)) { PH_IDS;
        if (bx < 128) {
            const int g = bx >> 1, n = bx & 1; const float* Sg = (const float*)(ws + WS_S) + (size_t)g * NCH * 256 + n * 128; LAS float* Ls = (LAS float*)lds;
            for (int i = tid; i < NCH * 32; i += 512) { const int c = i >> 5, q4 = (i & 31) * 4; *(LAS f32x4*)(Ls + c * 128 + q4) = *(const f32x4*)(Sg + (size_t)c * 256 + q4); }
            __syncthreads();
            if (wave == 0) { const int p = lane, pi = (n * 64 + g) * 64 + p;
                const float lr = fminf(KIN[6][pi], -1e-4f), li = KIN[7][pi], step = expf(KIN[8][n * 64 + g]); float ar, ai; cpow(lr * step, li * step, TC, ar, ai);
                bf16_t* hp = (bf16_t*)(ws + WS_HPREV) + (size_t)g * NCH * 256 + n * 128; float hr = 0.f, him = 0.f;
                for (int cc = 0; cc < NCH; ++cc) { const int c = n == 0 ? cc : NCH - 1 - cc;
                    hp[(size_t)c * 256 + p] = (bf16_t)(cvt_pk_bf16(hr, 0.f) & 0xffffu); hp[(size_t)c * 256 + 64 + p] = (bf16_t)(cvt_pk_bf16(him, 0.f) & 0xffffu);
                    const float sr = Ls[c * 128 + p], si = Ls[c * 128 + 64 + p]; const float nr = ar * hr - ai * him + sr, ni = ar * him + ai * hr + si; hr = nr; him = ni; } }
            __syncthreads();
        }
        { MK_RG; for (int un = bx; un < 256; un += G) rg_pass_a(RG, un & 1, un >> 1, tid); }
    }
    if (rep + 1 < REPS(3)) { ++nbar; xcd_barrier(xb, (unsigned)G, wave); } }
    SEAM(3);
    for (int rep = 0; rep < REPS(4); ++rep) {
    if (IN(4)) { PH_IDS;
#if NAIVE_S5
        if (gw < 64) naive_s5_group((const float* const*)0, (const bf16_t*)(dout + DO_U), (float*)(ws + WS_YINTRA), (bf16_t*)(ws + WS_YS5G), gw, lane);
#else
        { SchedS5b S{(const char*)(ws + WS_HPREV), (const char*)(ws + WS_WC), G, bx}; EpiS5b E{(const bf16_t*)(ws + WS_YINTRA), (bf16_t*)(ws + WS_YS5G)};
          GEMM_PHASE(lds, wave, GParm{256, 512, 128, 64, 0}, S, E); }
#endif
#if NAIVE_RG
        { MK_RG; if (gtid < 1024) naive_rg_channel(RG, gtid); }
#else
        { MK_RG; __syncthreads(); for (int un = bx; un < 256; un += G) { rg_pass_c(RG, un & 1, un >> 1, tid, (LAS float*)lds); __syncthreads(); } }
#endif
    }
    if (rep + 1 < REPS(4)) { ++nbar; xcd_barrier(xb, (unsigned)G, wave); } }
    SEAM(4);
    for (int rep = 0; rep < REPS(5); ++rep) {
    if (IN(5)) { PH_IDS;
        SchedStd S; S.so.init(SEQ, DS5, G, bx); S.A = (const char*)(ws + WS_YS5G); S.B = (const char*)(ws + WS_GLUT); S.a_tile = (size_t)256 * 16 * 2; S.b_tile = (size_t)256 * DS5 * 2;
        EpiGlu E{(const bf16_t*)(ws + WS_YS5G), (bf16_t*)(dout + DO_YPRE), KIN[15]};
        GEMM_PHASE(lds, wave, GParm{DS5, 32, 4u * GM_STRIDE * 2u, 16, GM_STRIDE}, S, E);
        if (G == 256 && bx >= 128) {
            LAS float* scr = (LAS float*)(lds + wave * 16640); constexpr int I_FF1 = (DM / 64) * (DFF / 64);
            for (int it = (bx - 128) * 8 + wave; it < FF1_IN_P5; it += 1024) transpose_item(KIN[29], DM, DFF, (bf16_t*)(ws + WS_FF1T), scr, it, lane); }
    }
    if (rep + 1 < REPS(5)) { ++nbar; xcd_barrier(xb, (unsigned)G, wave); } }
    SEAM(5);
    for (int rep = 0; rep < REPS(6); ++rep) {
    if (IN(6)) { PH_IDS;
        const float *g5 = KIN[23], *gr = KIN[24];
        for (int row = gw; row < SEQ; row += NGW) { const u32x4* yr = (const u32x4*)(dout + DO_YPRE) + (size_t)row * 256; u32x4* oc = (u32x4*)(ws + WS_YCAT) + (size_t)row * 256;
            u32x4 w[4]; float s0 = 0.f, s1 = 0.f;
#pragma unroll
            for (int j = 0; j < 4; ++j) { w[j] = yr[lane + 64 * j]; const float q = bf_lo(w[j].x) * bf_lo(w[j].x) + bf_hi(w[j].x) * bf_hi(w[j].x) + bf_lo(w[j].y) * bf_lo(w[j].y) + bf_hi(w[j].y) * bf_hi(w[j].y)
                + bf_lo(w[j].z) * bf_lo(w[j].z) + bf_hi(w[j].z) * bf_hi(w[j].z) + bf_lo(w[j].w) * bf_lo(w[j].w) + bf_hi(w[j].w) * bf_hi(w[j].w); if (j < 2) s0 += q; else s1 += q; }
            const float r0 = 1.0f / sqrtf(wave_sum(s0) * (1.f / 1024.f) + LN_EPS), r1 = 1.0f / sqrtf(wave_sum(s1) * (1.f / 1024.f) + LN_EPS);
#pragma unroll
            for (int j = 0; j < 4; ++j) { const int col = (lane + 64 * j) * 8; const float rs = j < 2 ? r0 : r1; const float* gp = j < 2 ? g5 + col : gr + (col - 1024);
                const f32x4 ga = *(const f32x4*)gp, gb = *(const f32x4*)(gp + 4);
                u32x4 o; o.x = cvt_pk_bf16(bf_lo(w[j].x) * rs * ga[0], bf_hi(w[j].x) * rs * ga[1]); o.y = cvt_pk_bf16(bf_lo(w[j].y) * rs * ga[2], bf_hi(w[j].y) * rs * ga[3]);
                o.z = cvt_pk_bf16(bf_lo(w[j].z) * rs * gb[0], bf_hi(w[j].z) * rs * gb[1]); o.w = cvt_pk_bf16(bf_lo(w[j].w) * rs * gb[2], bf_hi(w[j].w) * rs * gb[3]); oc[lane + 64 * j] = o; } }
        {
            LAS float* scr = (LAS float*)(lds + wave * 16640);
            constexpr int I_FF1 = (DM / 64) * (DFF / 64), I_FF2 = (DFF / 64) * (DM / 64);
            const int ff1_lo = (G == 256) ? FF1_IN_P5 : 0;
            for (int it = gw; it < I_FF2 + (I_FF1 - ff1_lo); it += NGW) {
                if (it < I_FF2) transpose_item(KIN[31], DFF, DM, (bf16_t*)(ws + WS_FF2T), scr, it, lane);
                else transpose_item(KIN[29], DM, DFF, (bf16_t*)(ws + WS_FF1T), scr, ff1_lo + it - I_FF2, lane); }
        }
    }
    if (rep + 1 < REPS(6)) { ++nbar; xcd_barrier(xb, (unsigned)G, wave); } }
    SEAM(6);
    for (int rep = 0; rep < REPS(7); ++rep) {
    if (IN(7)) { PH_IDS;
        SchedStd S; S.so.init(SEQ, DM, G, bx); S.A = (const char*)(ws + WS_YCAT); S.B = (const char*)(ws + WS_WOUTT); S.a_tile = (size_t)256 * DM * 2; S.b_tile = (size_t)256 * DM * 2;
        EpiResLn1 E{(bf16_t*)(ws + WS_HB), KIN[26], KIN[27], KIN[28], PanelStats8{(unsigned long long*)(ws + WS_AGG), (unsigned*)(ws + WS_CTR) + 1024, LN_EPS}};
        GEMM_PHASE(lds, wave, GParm{DM, DM * 2, 128, 64, 0}, S, E);
    }
    if (rep + 1 < REPS(7)) { ++nbar; xcd_barrier(xb, (unsigned)G, wave); } }
    for (int rep = 0; rep < REPS(8); ++rep) {
    if (IN(8)) { }
    if (rep + 1 < REPS(8)) { ++nbar; xcd_barrier(xb, (unsigned)G, wave); } }
    SEAM(8);
    for (int rep = 0; rep < REPS(9); ++rep) {
    if (IN(9)) { PH_IDS;
        static_assert(WS_PLEGT == WS_FF1T + (size_t)DFF * DM * 2, "gate weights must follow the FF1 weights");
        { SchedStd S; S.so.init(SEQ, DFF + DM, G, bx); S.A = (const char*)(ws + WS_HB); S.B = (const char*)(ws + WS_FF1T); S.a_tile = (size_t)256 * DM * 2; S.b_tile = (size_t)256 * DM * 2;
          EpiFF1G E{(bf16_t*)(ws + WS_T), (bf16_t*)dout, KIN[30], KIN[35]}; GEMM_PHASE(lds, wave, GParm{DM, DM * 2, 128, 64, 0}, S, E); }
        { SchedStd S; S.so.init(SEQ, DM, G, bx); S.A = (const char*)(ws + WS_PB); S.B = (const char*)(ws + WS_PLEWT); S.a_tile = (size_t)256 * PLE * 2; S.b_tile = (size_t)256 * PLE * 2;
          EpiPlain<0> E{(bf16_t*)dout + ((size_t)1 << 19), DM, nullptr, (size_t)1 << 20}; GEMM_PHASE(lds, wave, GParm{PLE, PLE * 2, 128, 64, 0}, S, E); }
    }
    if (rep + 1 < REPS(9)) { ++nbar; xcd_barrier(xb, (unsigned)G, wave); } }
    SEAM(9);
    for (int rep = 0; rep < REPS(10); ++rep) {
    if (IN(10)) { PH_IDS;
        SchedStd S; S.so.init(SEQ, DM, G, bx); S.A = (const char*)(ws + WS_T); S.B = (const char*)(ws + WS_FF2T); S.a_tile = (size_t)256 * DFF * 2; S.b_tile = (size_t)256 * DFF * 2;
        EpiResLn2 E{(const bf16_t*)(ws + WS_HB), KIN[32], KIN[36], KIN[37], (float*)dout, (const bf16_t*)dout, PanelStats8{(unsigned long long*)(ws + WS_AGG) + 65536, (unsigned*)(ws + WS_CTR) + 1024 + 64 * 32, LN_EPS}};
        GEMM_PHASE(lds, wave, GParm{DFF, DFF * 2, 128, 64, 0}, S, E);
    }
    if (rep + 1 < REPS(10)) { ++nbar; xcd_barrier(xb, (unsigned)G, wave); } }
    for (int rep = 0; rep < REPS(11); ++rep) {
    if (IN(11)) { }
    if (rep + 1 < REPS(11)) { ++nbar; xcd_barrier(xb, (unsigned)G, wave); } }
#ifdef EXTRA_BARRIERS
    for (int eb = 0; eb < EXTRA_BARRIERS; ++eb) { ++nbar; xcd_barrier(xb, (unsigned)G, wave); }
#endif
#if TSTAMP
    if (bx == 0 && wave == 0) { if (fresh_lane() == 0) { unsigned long long* st = (unsigned long long*)(ws + WS_CTR + 1024); st[12] = __builtin_amdgcn_s_memrealtime();
        ((float*)KIN[38])[0] = 8.0f * floorf((float)(long long)(__hip_atomic_load(st + TS_A1, __ATOMIC_RELAXED, __HIP_MEMORY_SCOPE_AGENT) - __hip_atomic_load(st + TS_A0, __ATOMIC_RELAXED, __HIP_MEMORY_SCOPE_AGENT)) * 0.00125f + 0.5f); } }
#endif
#if DIAG
    { ++nbar; xcd_barrier(xb, (unsigned)G, wave); PH_IDS; unsigned* flagw = (unsigned*)(ws + WS_CTR) + 48;
#if DIAG == 1
      diag_ffn((const float* const*)0, ws, ((float*)KIN[38]), flagw, gtid, GT);
#elif DIAG == 2
      diag_pre((const float* const*)0, ws, dout, flagw, gtid, GT);
#elif DIAG == 3
      diag_v((const float* const*)0, ws, dout, flagw, gtid, GT);
#elif DIAG == 4
      diag_g((const float* const*)0, ws, flagw, gtid, GT);
#elif DIAG == 6
      diag_max(ws, flagw, gtid, GT);
#else
      if (bx == 0 && tid == 0) flagw[1] = 0xffffffffu;
      ++nbar; xcd_barrier(xb, (unsigned)G, wave);
#if DIAG == 7
      diag_rows(((float*)KIN[38]), flagw, gw, NGW, lane);
#elif DIAG == 8
      diag_rows_bf((const bf16_t*)(ws + WS_HB), DM, 12.0f, flagw, gw, NGW, lane);
#elif DIAG == 9
      diag_rows((const float*)(ws + WS_V2), flagw, gw, NGW, lane);
#elif DIAG == 10
      diag_rows_bf((const bf16_t*)(ws + WS_T), DFF, 150.0f, flagw, gw, NGW, lane);
#elif DIAG == 11
      diag_rows_bf((const bf16_t*)(dout + DO_PW), DM, 8.0f, flagw, gw, NGW, lane);
#elif DIAG == 12
      diag_rows_bf((const bf16_t*)(dout + DO_SG), DM, 1.01f, flagw, gw, NGW, lane);
#endif
#endif
      ++nbar; xcd_barrier(xb, (unsigned)G, wave);
#if DIAG != 1
      for (int i = gtid; i < SEQ * DM; i += GT) ((float*)KIN[38])[i] = 0.f;
      ++nbar; xcd_barrier(xb, (unsigned)G, wave);
#endif
      if (bx == 0 && tid == 0) { unsigned code = 0; for (int q = 0; q < 4; ++q) if (__hip_atomic_load(flagw + q, __ATOMIC_RELAXED, __HIP_MEMORY_SCOPE_AGENT) > 100u) code |= 1u << q; if (DIAG >= 7) { const unsigned cnt = __hip_atomic_load(flagw, __ATOMIC_RELAXED, __HIP_MEMORY_SCOPE_AGENT), mn = __hip_atomic_load(flagw + 1, __ATOMIC_RELAXED, __HIP_MEMORY_SCOPE_AGENT), mxr = __hip_atomic_load(flagw + 2, __ATOMIC_RELAXED, __HIP_MEMORY_SCOPE_AGENT);
          const unsigned v = DIAG_SEL == 0 ? cnt : DIAG_SEL == 1 ? mn / 100u : DIAG_SEL == 2 ? mn % 100u : DIAG_SEL == 3 ? mxr / 100u : mxr % 100u; ((float*)KIN[38])[0] = 100.0f * (float)(v + 1u); }
      else ((float*)KIN[38])[0] = (DIAG == 6) ? 1000.0f * __uint_as_float(__hip_atomic_load(flagw, __ATOMIC_RELAXED, __HIP_MEMORY_SCOPE_AGENT)) : 1000.0f * (float)(code + 16u); } }
#endif
#undef IN
#undef SEAM
}


#if PER_PHASE_LAUNCH
template <int PH> static void set_attr_one() { (void)hipFuncSetAttribute((const void*)mega<(1 << PH)>, hipFuncAttributeMaxDynamicSharedMemorySize, LDS_BYTES); }
template <int PH> static void launch_one(Args a, int grid, hipStream_t stream) { a.ph_lo = PH; a.ph_hi = PH + 1; hipLaunchKernelGGL(mega<(1 << PH)>, dim3(grid), dim3(512), LDS_BYTES, stream, a); }
static void set_attrs() { set_attr_one<0>(); set_attr_one<1>(); set_attr_one<2>(); set_attr_one<3>(); set_attr_one<4>(); set_attr_one<5>(); set_attr_one<6>(); set_attr_one<7>(); set_attr_one<8>(); set_attr_one<9>(); set_attr_one<10>(); set_attr_one<11>(); }
static void launch_phases(const Args& a, int grid, hipStream_t stream) { launch_one<0>(a, grid, stream); launch_one<1>(a, grid, stream); launch_one<2>(a, grid, stream); launch_one<3>(a, grid, stream); launch_one<4>(a, grid, stream); launch_one<5>(a, grid, stream);
    launch_one<6>(a, grid, stream); launch_one<7>(a, grid, stream); launch_one<8>(a, grid, stream); launch_one<9>(a, grid, stream); launch_one<10>(a, grid, stream); launch_one<11>(a, grid, stream); }
#else
static void set_attrs() { (void)hipFuncSetAttribute((const void*)mega<0xfff>, hipFuncAttributeMaxDynamicSharedMemorySize, LDS_BYTES); }
#endif

extern "C" void kernel_launch(void* const* d_in, const int* in_sizes, int n_in, void* d_out, int out_size, void* d_ws, size_t ws_size, hipStream_t stream) {
    static int grid = 0;
    if (grid == 0) {
        if (n_in != 38 || out_size != SEQ * DM || ws_size < WS_END) { fprintf(stderr, "kernel_launch: unexpected shapes (n_in %d out %d ws %zu)\n", n_in, out_size, ws_size); grid = -1; return; }
        int dev = 0, cus = 0, per_cu = 0;
        hipGetDevice(&dev); hipDeviceGetAttribute(&cus, hipDeviceAttributeMultiprocessorCount, dev);
        set_attrs();
        per_cu = 1;
        (void)hipGetLastError();
        if (per_cu < 1) per_cu = 1;
        grid = cus;
    }
    if (grid < 0) return;
#ifdef POISON_NAN
    hipMemsetAsync(d_ws, 0xFF, WS_END, stream); hipMemsetAsync(d_out, 0xFF, (size_t)64 * MiB, stream);
#endif
    hipMemsetAsync((char*)d_ws + WS_CTR, 0, 40960, stream);
    Args a{};
    for (int i = 0; i < 38; ++i) a.in[i] = (const float*)d_in[i];
    a.out = (float*)d_out; a.ws = (unsigned char*)d_ws;
#if PER_PHASE_LAUNCH
    launch_phases(a, grid, stream);
#else
    a.ph_lo = 0; a.ph_hi = NPHASE;
    void* kargs[] = {&a};
    hipError_t e = hipLaunchCooperativeKernel((const void*)mega<0xfff>, dim3(grid), dim3(512), kargs, LDS_BYTES, stream);
    if (e != hipSuccess) fprintf(stderr, "cooperative launch failed: %s (grid %d)\n", hipGetErrorString(e), grid);
#endif
}
```

```cpp
#include <hip/hip_runtime.h>
#include <hip/hip_cooperative_groups.h>
#include <cstdio>
#include <cstdint>
namespace cg = cooperative_groups;

#ifndef PER_PHASE_LAUNCH
#define PER_PHASE_LAUNCH 0
#endif

#ifndef TSTAMP
#define TSTAMP 0
#define TS_A0 4
#define TS_A1 5
#define TS_B0 9
#define TS_B1 12
#endif
#define LAS __attribute__((address_space(3)))
typedef unsigned short bf16_t;
typedef short bf16x8 __attribute__((ext_vector_type(8)));
typedef float f32x4 __attribute__((ext_vector_type(4)));
typedef float f32x2 __attribute__((ext_vector_type(2)));
typedef unsigned u32x4 __attribute__((ext_vector_type(4)));
typedef unsigned u32x2 __attribute__((ext_vector_type(2)));

constexpr int SEQ = 8192, DM = 2048, DIN = 3072, DS5 = 1024, DRG = 1024, NG = 64, NP = 64, NK = 16, NH = 16, HD = 64, DFF = 8192, PLE = 256;
constexpr int TC = 32, NCH = SEQ / TC;
constexpr float LN_EPS = 1e-5f, DN_ALPHA = 1.18920711500272f;
constexpr int NPHASE = 12;

constexpr size_t MiB = (size_t)1 << 20;
constexpr size_t WS_FF2T = 0, WS_HB = 32 * MiB, WS_FF1T = 64 * MiB, WS_PLEGT = 96 * MiB, WS_PLEWT = 104 * MiB, WS_PB = 105 * MiB, WS_WOUTT = 109 * MiB,
    WS_V2 = 64 * MiB, WS_G0 = 0, WS_G1 = 64 * MiB,
    WS_WG = 128 * MiB, WS_WC = 176 * MiB, WS_RGW = 192 * MiB, WS_GLUT = 194 * MiB, WS_XR = 196 * MiB, WS_YINTRA = 213 * MiB, WS_S = 229 * MiB, WS_HPREV = 245 * MiB, WS_WINT = 229 * MiB,
    WS_YS5G = 128 * MiB, WS_YCAT = 144 * MiB, WS_T = 128 * MiB,
    WS_AGG = 256 * MiB, WS_CARRY = 258 * MiB, WS_SUMSQ = 259 * MiB, WS_RGBIAS = 259 * MiB + 64 * 1024, WS_SP = WS_RGBIAS + 16 * 1024, WS_CTR = WS_SP + 8 * 1024, WS_END = 260 * MiB;
constexpr size_t DO_YPRE = 0, DO_Z = 32 * MiB, DO_U = 48 * MiB, DO_SG = 0, DO_PW = 32 * MiB;
constexpr int FF1_IN_P5 = 3072;
constexpr int GM_STRIDE = SEQ * 16;
constexpr int LDS_BYTES = 152 * 1024;

typedef __bf16 bf16x2_t __attribute__((ext_vector_type(2)));
__device__ __forceinline__ unsigned cvt_pk_bf16(float lo, float hi) { const f32x2 v = {lo, hi}; const bf16x2_t b = __builtin_convertvector(v, bf16x2_t); return __builtin_bit_cast(unsigned, b); }
__device__ __forceinline__ float bf_lo(unsigned w) { return __uint_as_float(w << 16); }
__device__ __forceinline__ float bf_hi(unsigned w) { return __uint_as_float(w & 0xffff0000u); }
__device__ __forceinline__ f32x4 bf4(u32x2 w) { return (f32x4){bf_lo(w.x), bf_hi(w.x), bf_lo(w.y), bf_hi(w.y)}; }
__device__ __forceinline__ float fast_sigmoid(float x) { return __builtin_amdgcn_rcpf(1.0f + __expf(-x)); }
__device__ __forceinline__ float gelu_tanh(float x) { const float u = 1.5957691216057308f * (x + 0.044715f * x * x * x); return x * fast_sigmoid(u); }
__device__ __forceinline__ float wave_sum(float v) {
#pragma unroll
    for (int o = 1; o < 64; o <<= 1) v += __shfl_xor(v, o);
    return v;
}
__device__ __forceinline__ int lane_id() { return (int)__builtin_amdgcn_mbcnt_hi(~0u, __builtin_amdgcn_mbcnt_lo(~0u, 0u)); }
__device__ __forceinline__ int fresh_lane() { unsigned z = 0; asm volatile("" : "+s"(z)); return (int)__builtin_amdgcn_mbcnt_hi(~0u, __builtin_amdgcn_mbcnt_lo(~0u, z)); }
#define LDS_WAIT() asm volatile("s_waitcnt lgkmcnt(0)" ::: "memory")

namespace pg8 {
constexpr int BM = 256, BK = 64, HALF = 128, HTB = HALF * BK * 2, STAGE_BYTES = 8 * HTB, NXCD = 8, WGM = 8;
__host__ __device__ __forceinline__ int lds_byte(int r, int c) { const int st = (r >> 4) * 2 + (c >> 5), rr = r & 15, cc = c & 31, ob = rr * 64 + cc * 2; return st * 1024 + (ob ^ (((ob >> 9) & 1) << 5)); }
__host__ __device__ __forceinline__ void stage_rc(int b, int& R, int& C) { const int st = b / 1024, sb = b % 1024, swz = sb ^ (((sb >> 9) & 1) << 5); R = (st >> 1) * 16 + swz / 64; C = (st & 1) * 32 + (swz % 64) / 2; }
__host__ __device__ __forceinline__ int perm32(int rho) { const int n = rho >> 4, i = rho & 15; return 8 * (i >> 2) + 4 * n + (i & 3); }

struct Unit { int pm, pn; };
struct StaticOrder {
    int nM, nN, nwg, G, c;
    __host__ __device__ void init(int M, int N, int G_, int c_) { nM = M / BM; nN = N / BM; nwg = nM * nN; G = G_; c = c_; }
    __host__ __device__ bool next(int i, Unit& u) const {
        const long L = (long)i * G + c; if (L >= nwg) return false;
        int wgid = (int)L; { const int q = nwg / NXCD, r = nwg % NXCD, xcd = wgid % NXCD, off = wgid / NXCD; wgid = (xcd < r ? xcd * (q + 1) : r * (q + 1) + (xcd - r) * q) + off; }
        const int nig = WGM * nN, gid = wgid / nig, fm = gid * WGM, gsz = (nM - fm) < WGM ? (nM - fm) : WGM;
        u.pm = fm + ((wgid % nig) % gsz); u.pn = (wgid % nig) / gsz; return true;
    }
};
struct GUnit { const char* A; const char* B; int i0, i1; };
struct GParm { int K; unsigned a_rs, a_ks; int a_cw, a_cs; };

template <class Epi, class Sched>
__device__ __forceinline__ void gemm_phase(LAS unsigned char* lds, const int wid, const GParm gp, const Sched& S, const Epi& E) {
    const int lane = fresh_lane(), tid = wid * 64 + lane, wr = wid >> 2, wc = wid & 3, fr = lane & 15, fq = lane >> 4;
    const int K = gp.K, nt = K / BK;
    unsigned voffA[2], voffB[2];
#pragma unroll
    for (int i = 0; i < 2; ++i) { int R, C; stage_rc(tid * 16 + i * 8192, R, C); const int Rb = Epi::PERM ? ((R & ~31) + perm32(R & 31)) : R;
        voffA[i] = (unsigned)R * gp.a_rs + (unsigned)((C / gp.a_cw) * gp.a_cs + (C % gp.a_cw)) * 2u; voffB[i] = (unsigned)(Rb * K + C) * 2u; }
    const size_t ksA = gp.a_ks, ksB = (size_t)(BK * 2);
    const size_t hsA = (size_t)HALF * gp.a_rs, hsB = (size_t)HALF * K * 2;
    const unsigned ldsw = (unsigned)wid * 1024u;
    const int aoff = lds_byte(wr * 64 + fr, fq * 8), boff = lds_byte(wc * 32 + fr, fq * 8);
#define PG8_SA(b, h) (((b) * 2 + (h)) * HTB)
#define PG8_SB(b, h) ((4 + (b) * 2 + (h)) * HTB)
#define PG8_STAGE(bufoff, gbase, voff) do { _Pragma("unroll") for (int _i = 0; _i < 2; ++_i) \
        __builtin_amdgcn_global_load_lds((const unsigned*)((const char*)(gbase) + (voff)[_i]), (LAS unsigned*)(lds + (bufoff) + ldsw + _i * 8192), 16, 0, 0); } while (0)
#define PG8_LDA(dst, b, h) do { _Pragma("unroll") for (int m = 0; m < 4; ++m) _Pragma("unroll") for (int k = 0; k < 2; ++k) dst[m][k] = *(const LAS bf16x8*)(lds + PG8_SA(b, h) + aoff + m * 2048 + k * 1024); } while (0)
#define PG8_LDB(dst, b, h) do { _Pragma("unroll") for (int n = 0; n < 2; ++n) _Pragma("unroll") for (int k = 0; k < 2; ++k) dst[n][k] = *(const LAS bf16x8*)(lds + PG8_SB(b, h) + boff + n * 2048 + k * 1024); } while (0)
#define PG8_MMA(ai, bj, At, Bt) do { __builtin_amdgcn_s_setprio(1); _Pragma("unroll") for (int m = 0; m < 4; ++m) _Pragma("unroll") for (int n = 0; n < 2; ++n) _Pragma("unroll") for (int k = 0; k < 2; ++k) \
        acc[ai][bj][m][n] = __builtin_amdgcn_mfma_f32_16x16x32_bf16(Bt[n][k], At[m][k], acc[ai][bj][m][n], 0, 0, 0); __builtin_amdgcn_s_setprio(0); } while (0)
#define PG8_WAIT_V(n) asm volatile("s_waitcnt vmcnt(" #n ")" ::: "memory")
#define PG8_WAIT_L(n) asm volatile("s_waitcnt lgkmcnt(" #n ")" ::: "memory")
#define PG8_BAR __builtin_amdgcn_s_barrier()
#define PG8_SCHED __builtin_amdgcn_sched_barrier(0)
    GUnit cur, nxt; int ui = 0;
    if (!S.next(0, cur)) return;
    f32x4 acc[2][2][4][2];
#pragma unroll
    for (int a = 0; a < 2; ++a)
#pragma unroll
        for (int b = 0; b < 2; ++b)
#pragma unroll
            for (int m = 0; m < 4; ++m)
#pragma unroll
                for (int n = 0; n < 2; ++n) acc[a][b][m][n] = (f32x4){0.f, 0.f, 0.f, 0.f};
    bf16x8 At[4][2], B0[2][2], B1[2][2];
    const char* cA = cur.A; const char* cB = cur.B;
    PG8_STAGE(PG8_SB(0, 0), cB, voffB); PG8_STAGE(PG8_SB(0, 1), cB + hsB, voffB); PG8_STAGE(PG8_SA(0, 0), cA, voffA); PG8_STAGE(PG8_SA(0, 1), cA + hsA, voffA);
    if (wr == 1) PG8_BAR;
    PG8_WAIT_V(2); PG8_BAR;
    PG8_STAGE(PG8_SB(1, 0), cB + ksB, voffB); PG8_STAGE(PG8_SA(1, 0), cA + ksA, voffA); PG8_STAGE(PG8_SB(1, 1), cB + hsB + ksB, voffB);
    PG8_WAIT_V(6); PG8_BAR;
    for (;;) {
        const bool has_next = S.next(ui + 1, nxt);
        const char* nA = has_next ? nxt.A : cA; const char* nB = has_next ? nxt.B : cB;
        for (int t = 0; t < nt; t += 2) {
            const bool last = (t == nt - 2);
            const char* a1 = cA + (size_t)(t + 1) * ksA;
            const char* a2 = last ? nA : cA + (size_t)(t + 2) * ksA; const char* b2 = last ? nB : cB + (size_t)(t + 2) * ksB;
            const char* a3 = a2 + ksA; const char* b3 = b2 + ksB;
            PG8_LDB(B0, 0, 0); PG8_LDB(B1, 0, 1); PG8_SCHED; PG8_LDA(At, 0, 0); PG8_STAGE(PG8_SA(1, 1), a1 + hsA, voffA);
            PG8_WAIT_V(8); PG8_WAIT_L(0); PG8_BAR; PG8_MMA(0, 0, At, B0); PG8_MMA(0, 1, At, B1); PG8_BAR; PG8_SCHED;
            PG8_LDA(At, 0, 1); PG8_STAGE(PG8_SB(0, 0), b2, voffB); PG8_STAGE(PG8_SB(0, 1), b2 + hsB, voffB); PG8_STAGE(PG8_SA(0, 0), a2, voffA);
            PG8_WAIT_V(8); PG8_WAIT_L(0); PG8_BAR; PG8_MMA(1, 0, At, B0); PG8_MMA(1, 1, At, B1); PG8_BAR; PG8_SCHED;
            PG8_LDB(B0, 1, 0); PG8_LDB(B1, 1, 1); PG8_SCHED; PG8_LDA(At, 1, 0); PG8_STAGE(PG8_SA(0, 1), a2 + hsA, voffA);
            PG8_WAIT_V(8); PG8_WAIT_L(0); PG8_BAR; PG8_MMA(0, 0, At, B0); PG8_MMA(0, 1, At, B1); PG8_BAR; PG8_SCHED;
            PG8_LDA(At, 1, 1); PG8_STAGE(PG8_SB(1, 0), b3, voffB); PG8_STAGE(PG8_SB(1, 1), b3 + hsB, voffB); PG8_STAGE(PG8_SA(1, 0), a3, voffA);
            PG8_WAIT_V(8); PG8_WAIT_L(0); PG8_BAR; PG8_MMA(1, 0, At, B0); PG8_MMA(1, 1, At, B1); PG8_BAR; PG8_SCHED;
        }
        if (wr == 0) PG8_BAR;
        if constexpr (!Epi::AFTER_DRAIN) { const int l_o = fresh_lane(); E(acc, cur, wr, wc, l_o & 15, l_o >> 4); }
        if (!has_next) break;
#pragma unroll
        for (int a = 0; a < 2; ++a)
#pragma unroll
            for (int b = 0; b < 2; ++b)
#pragma unroll
                for (int m = 0; m < 4; ++m)
#pragma unroll
                    for (int n = 0; n < 2; ++n) acc[a][b][m][n] = (f32x4){0.f, 0.f, 0.f, 0.f};
        cur = nxt; cA = nA; cB = nB; ++ui;
        if (wr == 1) PG8_BAR;
    }
    PG8_WAIT_V(0);
    PG8_BAR;
    if constexpr (Epi::AFTER_DRAIN) { const int l_o = fresh_lane(); E.fused(acc, cur, wr, wc, l_o & 15, l_o >> 4, lds, wid); }
#undef PG8_SA
#undef PG8_SB
#undef PG8_STAGE
#undef PG8_LDA
#undef PG8_LDB
#undef PG8_MMA
#undef PG8_WAIT_V
#undef PG8_WAIT_L
#undef PG8_BAR
#undef PG8_SCHED
}
}
using pg8::GUnit; using pg8::GParm;
typedef f32x4 AccT[2][2][4][2];

struct SchedStd {
    pg8::StaticOrder so; const char* A; const char* B; size_t a_tile, b_tile;
    __device__ __forceinline__ bool next(int i, GUnit& u) const { pg8::Unit t; if (!so.next(i, t)) return false; u.A = A + (size_t)t.pm * a_tile; u.B = B + (size_t)t.pn * b_tile; u.i0 = t.pm; u.i1 = t.pn; return true; }
};
struct SchedS5a { const char* U; const char* WG; int G, c;
    __device__ __forceinline__ bool next(int i, GUnit& u) const { const int L = i * G + c; if (L >= 192) return false; const int g = L / 3, pn = L % 3;
        u.A = U + (size_t)g * GM_STRIDE * 2; u.B = WG + ((size_t)g * 768 + 256 * pn) * 512 * 2; u.i0 = g; u.i1 = pn; return true; } };
struct SchedS5b { const char* HP; const char* WC; int G, c;
    __device__ __forceinline__ bool next(int i, GUnit& u) const { const int L = i * G + c; if (L >= 128) return false; const int g = L / 2, pn = L % 2;
        u.A = HP + (size_t)g * 256 * 256 * 2; u.B = WC + ((size_t)g * 512 + 256 * pn) * 256 * 2; u.i0 = g; u.i1 = pn; return true; } };
struct SchedRG { const char* XR; const char* RGW; int G, c;
    __device__ __forceinline__ bool next(int i, GUnit& u) const { const int L = i * G + c; if (L >= 512) return false; const int h = L % 16, pm = L / 16;
        u.A = XR + ((size_t)(256 * pm) * 1024 + 64 * h) * 2; u.B = RGW + (size_t)h * 256 * 256 * 2; u.i0 = pm; u.i1 = h; return true; } };

template <int ACT> __device__ __forceinline__ void epi_bf16_store(const AccT& acc, bf16_t* tile, int ldc, const float* biast, int wr, int wc, int fr, int fq) {
    const int r0 = wr * 64 + fr, c0 = wc * 32 + 8 * fq;
    f32x4 bv[2][2];
#pragma unroll
    for (int bj = 0; bj < 2; ++bj)
#pragma unroll
        for (int n = 0; n < 2; ++n) bv[bj][n] = biast ? *(const f32x4*)(biast + c0 + bj * 128 + 4 * n) : (f32x4){0.f, 0.f, 0.f, 0.f};
#pragma unroll
    for (int ai = 0; ai < 2; ++ai)
#pragma unroll
        for (int m = 0; m < 4; ++m) { bf16_t* rowp = tile + (size_t)(r0 + ai * 128 + m * 16) * ldc + c0;
#pragma unroll
            for (int bj = 0; bj < 2; ++bj) { f32x4 v0 = acc[ai][bj][m][0] + bv[bj][0], v1 = acc[ai][bj][m][1] + bv[bj][1];
                if (ACT == 1) {
#pragma unroll
                    for (int j = 0; j < 4; ++j) { const float a = fmaxf(v0[j], 0.f), b = fmaxf(v1[j], 0.f); v0[j] = a * a; v1[j] = b * b; } }
                if (ACT == 2) {
#pragma unroll
                    for (int j = 0; j < 4; ++j) { v0[j] = fast_sigmoid(v0[j]); v1[j] = fast_sigmoid(v1[j]); } }
                u32x4 w; w.x = cvt_pk_bf16(v0[0], v0[1]); w.y = cvt_pk_bf16(v0[2], v0[3]); w.z = cvt_pk_bf16(v1[0], v1[1]); w.w = cvt_pk_bf16(v1[2], v1[3]);
                *(u32x4*)(rowp + bj * 128) = w; } }
}
struct EpiProj { static constexpr bool PERM = true, AFTER_DRAIN = false; bf16_t *U, *XR, *Z; const float* bias;
    __device__ __forceinline__ void operator()(AccT& acc, const GUnit& u, int wr, int wc, int fr, int fq) const {
        const int pm = u.i0, pn = u.i1;
        if (pn >= 4) { bf16_t* base = pn < 8 ? XR + 2 * 1024 : Z; epi_bf16_store<0>(acc, base + (size_t)pm * 256 * 1024 + (pn & 3) * 256, 1024, bias + pn * 256, wr, wc, fr, fq); return; }
        const int c0 = pn * 256 + wc * 32 + 8 * fq;
#pragma unroll
        for (int bj = 0; bj < 2; ++bj) { const int col = c0 + bj * 128; const f32x4 b0 = *(const f32x4*)(bias + col), b1 = *(const f32x4*)(bias + col + 4); bf16_t* gp = U + (size_t)(col >> 4) * GM_STRIDE + (col & 15);
#pragma unroll
            for (int ai = 0; ai < 2; ++ai)
#pragma unroll
                for (int m = 0; m < 4; ++m) { const int row = pm * 256 + ai * 128 + wr * 64 + m * 16 + fr; const f32x4 v0 = acc[ai][bj][m][0] + b0, v1 = acc[ai][bj][m][1] + b1;
                    u32x4 w; w.x = cvt_pk_bf16(v0[0], v0[1]); w.y = cvt_pk_bf16(v0[2], v0[3]); w.z = cvt_pk_bf16(v1[0], v1[1]); w.w = cvt_pk_bf16(v1[2], v1[3]);
                    *(u32x4*)(gp + (size_t)row * 16) = w; } }
    } };
template <int ACT> struct EpiPlain { static constexpr bool PERM = true, AFTER_DRAIN = false; bf16_t* O; int ldc; const float* bias; size_t pstride;
    __device__ __forceinline__ void operator()(AccT& acc, const GUnit& u, int wr, int wc, int fr, int fq) const {
        epi_bf16_store<ACT>(acc, O + (size_t)u.i0 * (pstride ? pstride : (size_t)256 * ldc) + u.i1 * 256, ldc, bias ? bias + u.i1 * 256 : nullptr, wr, wc, fr, fq); } };
struct EpiFF1G { static constexpr bool PERM = true, AFTER_DRAIN = false; bf16_t* T; bf16_t* SG; const float *b1, *bg;
    __device__ __forceinline__ void operator()(AccT& acc, const GUnit& u, int wr, int wc, int fr, int fq) const {
        const int pm = u.i0, pn = u.i1;
        if (pn < 32) epi_bf16_store<1>(acc, T + (size_t)pm * 256 * DFF + pn * 256, DFF, b1 + pn * 256, wr, wc, fr, fq);
        else epi_bf16_store<2>(acc, SG + (size_t)pm * ((size_t)1 << 20) + (pn - 32) * 256, DM, bg + (pn - 32) * 256, wr, wc, fr, fq); } };
struct EpiS5a { static constexpr bool PERM = true, AFTER_DRAIN = false; bf16_t* YI; float* S;
    __device__ __forceinline__ void operator()(AccT& acc, const GUnit& u, int wr, int wc, int fr, int fq) const {
        const int g = u.i0, pn = u.i1;
#pragma unroll
        for (int ai = 0; ai < 2; ++ai)
#pragma unroll
            for (int m = 0; m < 4; ++m) { const int r = ai * 128 + wr * 64 + m * 16 + fr;
#pragma unroll
                for (int bj = 0; bj < 2; ++bj) { const int c8 = bj * 128 + wc * 32 + 8 * fq; const f32x4 v0 = acc[ai][bj][m][0], v1 = acc[ai][bj][m][1];
                    if (pn < 2) { const int col = pn * 256 + c8, t = col >> 4, k0 = col & 15;
                        u32x4 w; w.x = cvt_pk_bf16(v0[0], v0[1]); w.y = cvt_pk_bf16(v0[2], v0[3]); w.z = cvt_pk_bf16(v1[0], v1[1]); w.w = cvt_pk_bf16(v1[2], v1[3]);
                        *(u32x4*)(YI + (size_t)g * GM_STRIDE + (size_t)r * 512 + col) = w; (void)t; (void)k0; }
                    else { float* sp = S + ((size_t)g * NCH + r) * 256 + c8; *(f32x4*)sp = v0; *(f32x4*)(sp + 4) = v1; } } }
    } };
struct EpiS5b { static constexpr bool PERM = true, AFTER_DRAIN = false; const bf16_t* YI; bf16_t* YG;
    __device__ __forceinline__ void operator()(AccT& acc, const GUnit& u, int wr, int wc, int fr, int fq) const {
        const int g = u.i0, pn = u.i1;
#pragma unroll
        for (int ai = 0; ai < 2; ++ai)
#pragma unroll
            for (int m = 0; m < 4; ++m) { const int r = ai * 128 + wr * 64 + m * 16 + fr;
#pragma unroll
                for (int bj = 0; bj < 2; ++bj) { const int col = pn * 256 + bj * 128 + wc * 32 + 8 * fq, t = col >> 4, k0 = col & 15;
                    const size_t off = (size_t)g * GM_STRIDE + (size_t)r * 512 + col; (void)t; (void)k0; const u32x4 yi = *(const u32x4*)(YI + off);
                    f32x4 v0 = acc[ai][bj][m][0] + (f32x4){bf_lo(yi.x), bf_hi(yi.x), bf_lo(yi.y), bf_hi(yi.y)}, v1 = acc[ai][bj][m][1] + (f32x4){bf_lo(yi.z), bf_hi(yi.z), bf_lo(yi.w), bf_hi(yi.w)};
#pragma unroll
                    for (int j = 0; j < 4; ++j) { v0[j] = gelu_tanh(v0[j]); v1[j] = gelu_tanh(v1[j]); }
                    u32x4 w; w.x = cvt_pk_bf16(v0[0], v0[1]); w.y = cvt_pk_bf16(v0[2], v0[3]); w.z = cvt_pk_bf16(v1[0], v1[1]); w.w = cvt_pk_bf16(v1[2], v1[3]);
                    *(u32x4*)(YG + off) = w; } }
    } };
struct EpiGlu { static constexpr bool PERM = true, AFTER_DRAIN = false; const bf16_t* YG; bf16_t* YPRE; const float* bias;
    __device__ __forceinline__ void operator()(AccT& acc, const GUnit& u, int wr, int wc, int fr, int fq) const {
        const int pm = u.i0, pn = u.i1; const int c0 = pn * 256 + wc * 32 + 8 * fq;
        f32x4 bv[2][2];
#pragma unroll
        for (int bj = 0; bj < 2; ++bj)
#pragma unroll
            for (int n = 0; n < 2; ++n) bv[bj][n] = *(const f32x4*)(bias + c0 + bj * 128 + 4 * n);
#pragma unroll
        for (int ai = 0; ai < 2; ++ai)
#pragma unroll
            for (int m = 0; m < 4; ++m) { const int row = pm * 256 + ai * 128 + wr * 64 + m * 16 + fr;
#pragma unroll
                for (int bj = 0; bj < 2; ++bj) { const int col = c0 + bj * 128; const u32x4 yv = *(const u32x4*)(YG + (size_t)(col >> 4) * GM_STRIDE + (size_t)row * 16 + (col & 15));
                    const f32x4 y0 = (f32x4){bf_lo(yv.x), bf_hi(yv.x), bf_lo(yv.y), bf_hi(yv.y)}, y1 = (f32x4){bf_lo(yv.z), bf_hi(yv.z), bf_lo(yv.w), bf_hi(yv.w)};
                    f32x4 v0 = acc[ai][bj][m][0] + bv[bj][0], v1 = acc[ai][bj][m][1] + bv[bj][1];
#pragma unroll
                    for (int j = 0; j < 4; ++j) { v0[j] = y0[j] * fast_sigmoid(v0[j]); v1[j] = y1[j] * fast_sigmoid(v1[j]); }
                    u32x4 w; w.x = cvt_pk_bf16(v0[0], v0[1]); w.y = cvt_pk_bf16(v0[2], v0[3]); w.z = cvt_pk_bf16(v1[0], v1[1]); w.w = cvt_pk_bf16(v1[2], v1[3]);
                    *(u32x4*)(YPRE + (size_t)row * 2048 + col) = w; }
                }
    } };
template <bool PLEADD> struct EpiRes { static constexpr bool PERM = false, AFTER_DRAIN = false; const bf16_t* HBp; const float* bias; float* V; const bf16_t* SG; const bf16_t* PW;
    __device__ __forceinline__ void operator()(AccT& acc, const GUnit& u, int wr, int wc, int fr, int fq) const {
        const int pm = u.i0, pn = u.i1; const int c0 = pn * 256 + wc * 32 + 4 * fq;
        f32x4 bv[2][2];
#pragma unroll
        for (int bj = 0; bj < 2; ++bj)
#pragma unroll
            for (int n = 0; n < 2; ++n) bv[bj][n] = *(const f32x4*)(bias + c0 + bj * 128 + n * 16);
#pragma unroll
        for (int ai = 0; ai < 2; ++ai)
#pragma unroll
            for (int m = 0; m < 4; ++m) { const int row = pm * 256 + ai * 128 + wr * 64 + m * 16 + fr;
#pragma unroll
                for (int bj = 0; bj < 2; ++bj)
#pragma unroll
                    for (int n = 0; n < 2; ++n) { const size_t off = (size_t)row * 2048 + c0 + bj * 128 + n * 16;
                        f32x4 v = acc[ai][bj][m][n] + bv[bj][n] + DN_ALPHA * bf4(*(const u32x2*)(HBp + off));
                        if (PLEADD) v += bf4(*(const u32x2*)(SG + off)) * bf4(*(const u32x2*)(PW + off));
                        *(f32x4*)(V + off) = v; } }
    } };


struct PanelStats8 { unsigned long long* xbuf; unsigned* cnt; float eps;
    __device__ __forceinline__ void run(const AccT& v, int pm, int pn, int wr, int wc, int fr, int fq, LAS unsigned char* lds, int wid) const {
        LAS f32x2* P = (LAS f32x2*)lds; LAS f32x2* S = (LAS f32x2*)(lds + 8192); const int lane = fq * 16 + fr;
#pragma unroll
        for (int ai = 0; ai < 2; ++ai)
#pragma unroll
            for (int m = 0; m < 4; ++m) { float s = 0.f;
#pragma unroll
                for (int bj = 0; bj < 2; ++bj)
#pragma unroll
                    for (int n = 0; n < 2; ++n) { const f32x4 x = v[ai][bj][m][n]; s += (x[0] + x[1]) + (x[2] + x[3]); }
                s += __shfl_xor(s, 16); s += __shfl_xor(s, 32);
                const float mw = s * (1.0f / 64.0f); float q = 0.f;
#pragma unroll
                for (int bj = 0; bj < 2; ++bj)
#pragma unroll
                    for (int n = 0; n < 2; ++n) { const f32x4 d = v[ai][bj][m][n] - mw; q += (d[0] * d[0] + d[1] * d[1]) + (d[2] * d[2] + d[3] * d[3]); }
                q += __shfl_xor(q, 16); q += __shfl_xor(q, 32);
                if (fq == 0) P[(ai * 128 + wr * 64 + m * 16 + fr) * 4 + wc] = (f32x2){mw, q}; }
        asm volatile("s_waitcnt lgkmcnt(0)" ::: "memory"); __builtin_amdgcn_s_barrier(); asm volatile("" ::: "memory");
        const int row = wid * 32 + (lane & 31);
        if (lane < 32) { const f32x2 a = P[row * 4 + 0], b = P[row * 4 + 1], c = P[row * 4 + 2], d = P[row * 4 + 3];
            const float mt = (a[0] + b[0] + c[0] + d[0]) * 0.25f; const float da = a[0] - mt, db = b[0] - mt, dc = c[0] - mt, dd = d[0] - mt;
            const float m2 = (a[1] + b[1]) + (c[1] + d[1]) + 64.0f * ((da * da + db * db) + (dc * dc + dd * dd));
            __hip_atomic_store(xbuf + ((size_t)(pm * 256 + row) * 8 + pn), ((unsigned long long)__float_as_uint(m2) << 32) | __float_as_uint(mt), __ATOMIC_RELAXED, __HIP_MEMORY_SCOPE_AGENT); }
        asm volatile("s_waitcnt vmcnt(0)" ::: "memory");
        if (lane == 0) __hip_atomic_fetch_add(cnt + 64 * pm, 1u, __ATOMIC_RELAXED, __HIP_MEMORY_SCOPE_AGENT);
        if (wid == 0) { unsigned sp = 0;
            while ((unsigned)__builtin_amdgcn_readfirstlane(__hip_atomic_load(cnt + 64 * pm, __ATOMIC_RELAXED, __HIP_MEMORY_SCOPE_AGENT)) < 64u) { __builtin_amdgcn_s_sleep(2); if (++sp > (1u << 22)) break; }
            __builtin_amdgcn_fence(__ATOMIC_ACQUIRE, "agent"); }
        asm volatile("s_waitcnt vmcnt(0) lgkmcnt(0)" ::: "memory"); __builtin_amdgcn_s_barrier(); asm volatile("" ::: "memory");
        if (lane < 32) { const unsigned long long* slot = xbuf + (size_t)(pm * 256 + row) * 8; float mt[8], m2[8]; float ms = 0.f;
#pragma unroll
            for (int t = 0; t < 8; ++t) { const unsigned long long w = __hip_atomic_load(slot + t, __ATOMIC_RELAXED, __HIP_MEMORY_SCOPE_AGENT); mt[t] = __uint_as_float((unsigned)w); m2[t] = __uint_as_float((unsigned)(w >> 32)); ms += mt[t]; }
            const float mean = ms * 0.125f; float q = 0.f;
#pragma unroll
            for (int t = 0; t < 8; ++t) { const float dm = mt[t] - mean; q += m2[t] + 256.0f * dm * dm; }
            S[row] = (f32x2){mean, 1.0f / sqrtf(q * (1.0f / 2048.0f) + eps)}; }
        asm volatile("s_waitcnt lgkmcnt(0)" ::: "memory"); __builtin_amdgcn_s_barrier(); asm volatile("" ::: "memory");
    } };
struct EpiResLn1 { static constexpr bool PERM = false, AFTER_DRAIN = true; bf16_t* HBp; const float *bias, *lng, *lnb; PanelStats8 st;
    __device__ __forceinline__ void fused(AccT& acc, const GUnit& u, int wr, int wc, int fr, int fq, LAS unsigned char* lds, int wid) const {
        const int pm = u.i0, pn = u.i1; const int c0 = pn * 256 + wc * 32 + 4 * fq; const LAS f32x2* S = (const LAS f32x2*)(lds + 8192);
#pragma unroll
        for (int bj = 0; bj < 2; ++bj)
#pragma unroll
            for (int n = 0; n < 2; ++n) { const f32x4 bv = *(const f32x4*)(bias + c0 + bj * 128 + n * 16);
#pragma unroll
                for (int ai = 0; ai < 2; ++ai)
#pragma unroll
                    for (int m = 0; m < 4; ++m) { const size_t off = (size_t)(pm * 256 + ai * 128 + wr * 64 + m * 16 + fr) * 2048 + c0 + bj * 128 + n * 16;
                        acc[ai][bj][m][n] += bv + DN_ALPHA * bf4(*(const u32x2*)(HBp + off)); } }
        st.run(acc, pm, pn, wr, wc, fr, fq, lds, wid);
#pragma unroll
        for (int bj = 0; bj < 2; ++bj)
#pragma unroll
            for (int n = 0; n < 2; ++n) { const f32x4 gg = *(const f32x4*)(lng + c0 + bj * 128 + n * 16), bb = *(const f32x4*)(lnb + c0 + bj * 128 + n * 16);
#pragma unroll
                for (int ai = 0; ai < 2; ++ai)
#pragma unroll
                    for (int m = 0; m < 4; ++m) { const int r = ai * 128 + wr * 64 + m * 16 + fr; const f32x2 sr = S[r]; const size_t off = (size_t)(pm * 256 + r) * 2048 + c0 + bj * 128 + n * 16;
                        const f32x4 o = (acc[ai][bj][m][n] - sr[0]) * sr[1] * gg + bb; u32x2 w; w.x = cvt_pk_bf16(o[0], o[1]); w.y = cvt_pk_bf16(o[2], o[3]); *(u32x2*)(HBp + off) = w; } }
    } };
struct EpiResLn2 { static constexpr bool PERM = false, AFTER_DRAIN = true; const bf16_t* HBp; const float *bias, *lng, *lnb; float* out; const bf16_t* SGPW; PanelStats8 st;
    __device__ __forceinline__ void fused(AccT& acc, const GUnit& u, int wr, int wc, int fr, int fq, LAS unsigned char* lds, int wid) const {
        const int pm = u.i0, pn = u.i1; const int c0 = pn * 256 + wc * 32 + 4 * fq; const LAS f32x2* S = (const LAS f32x2*)(lds + 8192);
        const bf16_t* sgp = SGPW + (size_t)pm * (1u << 20);
        f32x4 bv[2][2];
#pragma unroll
        for (int bj = 0; bj < 2; ++bj)
#pragma unroll
            for (int n = 0; n < 2; ++n) bv[bj][n] = *(const f32x4*)(bias + c0 + bj * 128 + n * 16);
#pragma unroll
        for (int ai = 0; ai < 2; ++ai)
#pragma unroll
            for (int m = 0; m < 4; ++m) { const int r = ai * 128 + wr * 64 + m * 16 + fr; const size_t lo = (size_t)r * 2048 + c0; const bf16_t* hp = HBp + (size_t)(pm * 256 + r) * 2048 + c0;
#pragma unroll
                for (int bj = 0; bj < 2; ++bj)
#pragma unroll
                    for (int n = 0; n < 2; ++n) { const int co = bj * 128 + n * 16;
                        acc[ai][bj][m][n] += bv[bj][n] + DN_ALPHA * bf4(*(const u32x2*)(hp + co)) + bf4(*(const u32x2*)(sgp + lo + co)) * bf4(*(const u32x2*)(sgp + (1u << 19) + lo + co)); }
                asm volatile("" : "+v"(acc[ai][0][m][0]), "+v"(acc[ai][0][m][1]), "+v"(acc[ai][1][m][0]), "+v"(acc[ai][1][m][1])); }
        st.run(acc, pm, pn, wr, wc, fr, fq, lds, wid);
#pragma unroll
        for (int bj = 0; bj < 2; ++bj)
#pragma unroll
            for (int n = 0; n < 2; ++n) { const f32x4 gg = *(const f32x4*)(lng + c0 + bj * 128 + n * 16), bb = *(const f32x4*)(lnb + c0 + bj * 128 + n * 16);
#pragma unroll
                for (int ai = 0; ai < 2; ++ai)
#pragma unroll
                    for (int m = 0; m < 4; ++m) { const int r = ai * 128 + wr * 64 + m * 16 + fr; const f32x2 sr = S[r];
                        *(f32x4*)(out + (size_t)(pm * 256 + r) * 2048 + c0 + bj * 128 + n * 16) = (acc[ai][bj][m][n] - sr[0]) * sr[1] * gg + bb; } }
    } };
struct EpiG { static constexpr bool PERM = true, AFTER_DRAIN = false; bf16_t *G0, *G1; const float* bias;
    __device__ __forceinline__ void operator()(AccT& acc, const GUnit& u, int wr, int wc, int fr, int fq) const {
        const int pm = u.i0, h = u.i1; bf16_t* base = (pm < 16 ? G0 : G1) + (size_t)(pm & 15) * 256 * 4096 + h * 256;
        epi_bf16_store<0>(acc, base, 4096, bias + h * 256, wr, wc, fr, fq); } };
__device__ __forceinline__ float bfu(unsigned short v) { return __uint_as_float(((unsigned)v) << 16); }
__device__ __forceinline__ void rg_gate(float pa, float px, float spv, float xc, float& a, float& b) {
    const float r = fast_sigmoid(pa), ig = fast_sigmoid(px); const float la = spv * r; a = __expf(la); const float x = 2.0f * la;
    const float om = -x * (1.0f + x * (0.5f + x * (0.16666667f + x * (0.041666668f + x * 0.008333334f))));
    b = __builtin_amdgcn_sqrtf(fmaxf(om, 0.f)) * ig * xc; }
__device__ __forceinline__ void rg_gate2(float pa, float px, float spv, float xc, float& a, float& b, float& r) {
    r = fast_sigmoid(pa); const float ig = fast_sigmoid(px); const float la = spv * r; a = __expf(la); const float x = 2.0f * la;
    const float om = -x * (1.0f + x * (0.5f + x * (0.16666667f + x * (0.041666668f + x * 0.008333334f))));
    b = __builtin_amdgcn_sqrtf(fmaxf(om, 0.f)) * ig * xc; }
struct RgCtx { const bf16_t *XR, *G0, *G1, *Z; const float *convw, *convb, *sp; float* agg; bf16_t* ypre; };
__device__ __forceinline__ const bf16_t* g_row(const RgCtx& R, int t) { return (t < 4096 ? R.G0 : R.G1) + (size_t)(t & 4095) * 4096; }
__device__ __forceinline__ void rg_pass_a(const RgCtx& R, int half, int seg, int tid) {
    const int c = half * 512 + tid, gcol = (c >> 6) * 256 + (c & 63) * 4, t0 = seg * 64;
    const float w0 = R.convw[c], w1 = R.convw[1024 + c], w2 = R.convw[2048 + c], w3 = R.convw[3072 + c], cb = R.convb[c], sp0 = R.sp[c], sp1 = R.sp[1024 + c];
    const bf16_t* xp = R.XR + c;
    float x0 = bfu(xp[(size_t)(t0 + 0) * 1024]), x1 = bfu(xp[(size_t)(t0 + 1) * 1024]), x2 = bfu(xp[(size_t)(t0 + 2) * 1024]);
    float Af = 1.f, Bf = 0.f, Ab = 1.f, Bb = 0.f;
    for (int tb = 0; tb < 64; tb += 16) {
        u32x2 gq[16]; unsigned short xn[16];
#pragma unroll
        for (int i = 0; i < 16; ++i) { const int t = t0 + tb + i; gq[i] = *(const u32x2*)(g_row(R, t) + gcol); xn[i] = xp[(size_t)(t + 3) * 1024]; }
#pragma unroll
        for (int i = 0; i < 16; ++i) { const float x3 = bfu(xn[i]); const float xc = cb + w0 * x0 + w1 * x1 + w2 * x2 + w3 * x3; x0 = x1; x1 = x2; x2 = x3;
            float a, b, r0, r1, b0; rg_gate2(bf_lo(gq[i].x), bf_lo(gq[i].y), sp0, xc, a, b, r0); Bf = a * Bf + b; Af = a * Af; b0 = b;
            rg_gate2(bf_hi(gq[i].x), bf_hi(gq[i].y), sp1, xc, a, b, r1); Bb = Ab * b + Bb; Ab = Ab * a;
            u32x2 w; w.x = cvt_pk_bf16(r0, r1); w.y = cvt_pk_bf16(b0, b); *(u32x2*)((bf16_t*)g_row(R, t0 + tb + i) + gcol) = w; }
    }
    *(f32x2*)(R.agg + ((size_t)(seg * 2 + 0) * 1024 + c) * 2) = (f32x2){Af, Bf};
    *(f32x2*)(R.agg + ((size_t)(seg * 2 + 1) * 1024 + c) * 2) = (f32x2){Ab, Bb};
}
__device__ __forceinline__ void rg_pass_c(const RgCtx& R, int half, int seg, int tid, LAS float* Lh) {
    const int c = half * 512 + tid, gcol = (c >> 6) * 256 + (c & 63) * 4, t0 = seg * 64;
    const float sp0 = R.sp[c], sp1 = R.sp[1024 + c];
    const f32x2* ag = (const f32x2*)R.agg;
    float hf = 0.f, hb = 0.f;
    {
#pragma unroll 1
        for (int sb = 0; sb < 128; sb += 32) { f32x2 ab[32];
#pragma unroll
            for (int i = 0; i < 32; ++i) { const int s2 = sb + i; ab[i] = (s2 < seg) ? ag[(size_t)(s2 * 2 + 0) * 1024 + c] : (f32x2){1.f, 0.f}; }
#pragma unroll
            for (int i = 0; i < 32; ++i) hf = ab[i][0] * hf + ab[i][1]; }
#pragma unroll 1
        for (int sb = 96; sb >= 0; sb -= 32) { f32x2 ab[32];
#pragma unroll
            for (int i = 0; i < 32; ++i) { const int s2 = sb + 31 - i; ab[i] = (s2 > seg) ? ag[(size_t)(s2 * 2 + 1) * 1024 + c] : (f32x2){1.f, 0.f}; }
#pragma unroll
            for (int i = 0; i < 32; ++i) hb = ab[i][0] * hb + ab[i][1]; }
    }
    {
        for (int tb = 0; tb < 64; tb += 16) {
            u32x2 gq[16];
#pragma unroll
            for (int i = 0; i < 16; ++i) gq[i] = *(const u32x2*)(g_row(R, t0 + tb + i) + gcol);
#pragma unroll
            for (int i = 0; i < 16; ++i) { const float a = __expf(sp0 * bf_lo(gq[i].x)); hf = a * hf + bf_lo(gq[i].y); Lh[(tb + i) * 512 + tid] = hf; }
        }
    }
    {
        for (int tb = 48; tb >= 0; tb -= 16) {
            u32x2 gq[16]; unsigned short zz[16];
#pragma unroll
            for (int i = 0; i < 16; ++i) { const int t = t0 + tb + 15 - i; gq[i] = *(const u32x2*)(g_row(R, t) + gcol); zz[i] = R.Z[(size_t)t * 1024 + c]; }
#pragma unroll
            for (int i = 0; i < 16; ++i) { const int tl = tb + 15 - i; const float a = __expf(sp1 * bf_hi(gq[i].x)); hb = a * hb + bf_hi(gq[i].y);
                const float o = (Lh[tl * 512 + tid] + hb) * gelu_tanh(bfu(zz[i]));
                R.ypre[(size_t)(t0 + tl) * 2048 + 1024 + c] = (bf16_t)(cvt_pk_bf16(o, 0.f) & 0xffffu); }
        }
    }
}

#ifndef NAIVE_GEMM
#define NAIVE_GEMM 0
#endif
template <class Epi, class Sched>
__device__ __forceinline__ void gemm_phase_naive(LAS unsigned char* lds, const int wid, const GParm gp, const Sched& S, const Epi& E) {
    const int lane = fresh_lane(), tid = wid * 64 + lane, wr = wid >> 2, wc = wid & 3, fr = lane & 15, fq = lane >> 4;
    GUnit cur;
    for (int ui = 0; S.next(ui, cur); ++ui) {
        f32x4 acc[2][2][4][2];
#pragma unroll
        for (int ai = 0; ai < 2; ++ai)
#pragma unroll
            for (int bj = 0; bj < 2; ++bj)
#pragma unroll
                for (int m = 0; m < 4; ++m)
#pragma unroll
                    for (int n = 0; n < 2; ++n)
#pragma unroll
                        for (int e = 0; e < 4; ++e) {
                            const int row = 128 * ai + 64 * wr + 16 * m + fr; const int col = Epi::PERM ? (128 * bj + 32 * wc + 8 * fq + 4 * n + e) : (128 * bj + 32 * wc + 16 * n + 4 * fq + e);
                            const char* ap = cur.A + (size_t)row * gp.a_rs; const char* bp = cur.B + (size_t)col * gp.K * 2; float sum = 0.f;
                            for (int k = 0; k < gp.K; k += 8) { const int kt = k >> 6, C = k & 63;
                                const u32x4 av = *(const u32x4*)(ap + (size_t)kt * gp.a_ks + ((C / gp.a_cw) * gp.a_cs + (C % gp.a_cw)) * 2), bv = *(const u32x4*)(bp + k * 2);
                                sum += bf_lo(av.x) * bf_lo(bv.x) + bf_hi(av.x) * bf_hi(bv.x) + bf_lo(av.y) * bf_lo(bv.y) + bf_hi(av.y) * bf_hi(bv.y) + bf_lo(av.z) * bf_lo(bv.z) + bf_hi(av.z) * bf_hi(bv.z) + bf_lo(av.w) * bf_lo(bv.w) + bf_hi(av.w) * bf_hi(bv.w); }
                            acc[ai][bj][m][n][e] = sum; }
        if constexpr (Epi::AFTER_DRAIN) { __syncthreads(); E.fused(acc, cur, wr, wc, fr, fq, lds, wid); } else E(acc, cur, wr, wc, fr, fq);
    }
    __syncthreads();
}
#if NAIVE_GEMM
#define GEMM_PHASE gemm_phase_naive
#else
#define GEMM_PHASE pg8::gemm_phase
#endif
__device__ __forceinline__ void transpose_item(const float* W, int K, int N, bf16_t* WT, LAS float* scr, int item, int lane) {
    const int nblk = N / 64, kb = item / nblk, nb = item % nblk, k0 = 64 * kb, n0 = 64 * nb;
    const float* src = W + (size_t)k0 * N + n0 + lane;
#pragma unroll 32
    for (int i = 0; i < 64; ++i) scr[i * 65 + lane] = __builtin_nontemporal_load(src + (size_t)i * N);
    LDS_WAIT();
    const int c = lane & 7;
#pragma unroll
    for (int j = 0; j < 8; ++j) { const int n = (lane >> 3) + 8 * j; const LAS float* sp = scr + (8 * c) * 65 + n;
        u32x4 o; o.x = cvt_pk_bf16(sp[0 * 65], sp[1 * 65]); o.y = cvt_pk_bf16(sp[2 * 65], sp[3 * 65]); o.z = cvt_pk_bf16(sp[4 * 65], sp[5 * 65]); o.w = cvt_pk_bf16(sp[6 * 65], sp[7 * 65]);
        *(u32x4*)(WT + (size_t)(n0 + n) * K + k0 + 8 * c) = o; }
    LDS_WAIT();
}
template <bool OUT_BF16> __device__ __forceinline__ void ln_row(const float* xrow, const float* g, const float* b, void* orow, int lane) {
    const f32x4* xr = (const f32x4*)xrow + lane; f32x4 v[8]; float s = 0.f;
#pragma unroll
    for (int j = 0; j < 8; ++j) { v[j] = __builtin_nontemporal_load(xr + 64 * j); s += (v[j][0] + v[j][1]) + (v[j][2] + v[j][3]); }
    const float mean = wave_sum(s) * (1.f / DM); float s2 = 0.f;
#pragma unroll
    for (int j = 0; j < 8; ++j) { v[j] = v[j] - mean; s2 += (v[j][0] * v[j][0] + v[j][1] * v[j][1]) + (v[j][2] * v[j][2] + v[j][3] * v[j][3]); }
    const float rstd = 1.0f / sqrtf(wave_sum(s2) * (1.f / DM) + LN_EPS);
#pragma unroll
    for (int j = 0; j < 8; ++j) { const f32x4 gg = ((const f32x4*)g)[lane + 64 * j], bb = ((const f32x4*)b)[lane + 64 * j]; const f32x4 o = v[j] * rstd * gg + bb;
        if (OUT_BF16) { u32x2 w; w.x = cvt_pk_bf16(o[0], o[1]); w.y = cvt_pk_bf16(o[2], o[3]); ((u32x2*)orow)[lane + 64 * j] = w; }
        else ((f32x4*)orow)[lane + 64 * j] = o; }
}
__device__ __forceinline__ void cpow(float lrs, float th, int j, float& re, float& im) {
    double a = (double)j * (double)th * 0.15915494309189535; a -= rint(a); const float af = 2.0f * (float)a;
    const float mag = expf((float)j * lrs); re = mag * cospif(af); im = mag * sinpif(af);
}


#ifndef NAIVE_RG
#define NAIVE_RG 0
#endif
__device__ __forceinline__ void naive_rg_channel(const RgCtx& R, int c) {
    const int gcol = (c >> 6) * 256 + (c & 63);
    const float w0 = R.convw[c], w1 = R.convw[1024 + c], w2 = R.convw[2048 + c], w3 = R.convw[3072 + c], cb = R.convb[c], sp0 = R.sp[c], sp1 = R.sp[1024 + c];
    const bf16_t* xp = R.XR + c; float h = 0.f;
    for (int t = 0; t < SEQ; ++t) { const float xc = cb + w0 * bfu(xp[(size_t)t * 1024]) + w1 * bfu(xp[(size_t)(t + 1) * 1024]) + w2 * bfu(xp[(size_t)(t + 2) * 1024]) + w3 * bfu(xp[(size_t)(t + 3) * 1024]);
        const bf16_t* g = g_row(R, t) + gcol; float a, b; rg_gate(bfu(g[0]), bfu(g[128]), sp0, xc, a, b); h = a * h + b;
        R.ypre[(size_t)t * 2048 + 1024 + c] = (bf16_t)(cvt_pk_bf16(h, 0.f) & 0xffffu); }
    __builtin_amdgcn_fence(__ATOMIC_SEQ_CST, "agent");
    h = 0.f;
    for (int t = SEQ - 1; t >= 0; --t) { const float xc = cb + w0 * bfu(xp[(size_t)t * 1024]) + w1 * bfu(xp[(size_t)(t + 1) * 1024]) + w2 * bfu(xp[(size_t)(t + 2) * 1024]) + w3 * bfu(xp[(size_t)(t + 3) * 1024]);
        const bf16_t* g = g_row(R, t) + gcol; float a, b; rg_gate(bfu(g[64]), bfu(g[192]), sp1, xc, a, b); h = a * h + b;
        const size_t o = (size_t)t * 2048 + 1024 + c; const float y = (bfu(R.ypre[o]) + h) * gelu_tanh(bfu(R.Z[(size_t)t * 1024 + c]));
        R.ypre[o] = (bf16_t)(cvt_pk_bf16(y, 0.f) & 0xffffu); }
}

#ifndef NAIVE_S5
#define NAIVE_S5 0
#endif
__device__ __forceinline__ void naive_s5_group(const float* const* in, const bf16_t* U, float* tmp, bf16_t* YG, int g, int lane) {
    const float *lre = in[6], *lim = in[7], *lstep = in[8], *bre = in[9], *bim = in[10], *cre = in[11], *cim = in[12], *dd = in[13];
    for (int n = 0; n < 2; ++n) {
        const int p = lane, pi = (n * 64 + g) * 64 + p;
        const float lr = fminf(lre[pi], -1e-4f), li = lim[pi], step = expf(lstep[n * 64 + g]); float ar, ai; cpow(lr * step, li * step, 1, ar, ai);
        const float nr = ar - 1.0f, ni = ai, den = lr * lr + li * li; const float qr = (nr * lr + ni * li) / den, qi = (ni * lr - nr * li) / den;
        float hr = 0.f, hi = 0.f;
        for (int tt = 0; tt < SEQ; ++tt) { const int t = n == 0 ? tt : SEQ - 1 - tt; const bf16_t* up = U + (size_t)t * 1024 + g * 16;
            float bur = 0.f, bui = 0.f;
#pragma unroll
            for (int k = 0; k < 16; ++k) { const float uv = bfu(up[k]); const float br = bre[(size_t)pi * 16 + k], bi = bim[(size_t)pi * 16 + k]; bur += (qr * br - qi * bi) * uv; bui += (qr * bi + qi * br) * uv; }
            const float nhr = ar * hr - ai * hi + bur, nhi = ar * hi + ai * hr + bui; hr = nhr; hi = nhi;
#pragma unroll
            for (int k = 0; k < 16; ++k) { const size_t ci = ((size_t)(n * 64 + g) * 16 + k) * 64 + p; float v = cre[ci] * hr - cim[ci] * hi; v = wave_sum(v);
                if (lane == k) { const size_t o = (size_t)t * 1024 + g * 16 + k;
                    if (n == 0) tmp[o] = v; else { const float y = tmp[o] + v + dd[g * 16 + k] * bfu(up[k]); YG[o] = (bf16_t)(cvt_pk_bf16(gelu_tanh(y), 0.f) & 0xffffu); } } }
        }
        __builtin_amdgcn_fence(__ATOMIC_SEQ_CST, "agent");
    }
}

#define XB_TMO      128
#define XB_XCNT(j)  (256  + 64 * (j))
#define XB_XSUB(j)  (1280 + 64 * (j))
#define XB_XGEN(j)  (2304 + 64 * (j))
#define XB_TOP      3328
#define XB_TOPGEN   3392
#define XCD_BAR_WORDS 3456
#define XB_SPIN_CAP (1u << 18)
__device__ __forceinline__ unsigned xb_ld(unsigned* p)              { return __hip_atomic_load(p, __ATOMIC_RELAXED, __HIP_MEMORY_SCOPE_AGENT); }
__device__ __forceinline__ unsigned xb_add(unsigned* p, unsigned v) { return __hip_atomic_fetch_add(p, v, __ATOMIC_RELAXED, __HIP_MEMORY_SCOPE_AGENT); }
__device__ __forceinline__ unsigned xb_xcc_id() { return (unsigned)__builtin_amdgcn_s_getreg((3 << 11) | 20) & 0xFu; }
#define XB_SPIN(cond, bar) do { unsigned _sp = 0; while (cond) { __builtin_amdgcn_s_sleep(1); \
    if ((++_sp & 255u) == 0u) { if (xb_ld(&(bar)[XB_TMO])) break; if (_sp > XB_SPIN_CAP) { atomicAdd(&(bar)[XB_TMO], 1u); break; } } } } while (0)
struct XcdBarrier { unsigned* bar; unsigned x; volatile LAS unsigned* st; };
__device__ __forceinline__ void xcd_barrier_complete(unsigned* bar, unsigned x, unsigned G, unsigned& nloc, unsigned& nx) {
    unsigned sum, cnt, mine, sp = 0u;
    for (;;) {
        sum = 0u; cnt = 0u; mine = 0u;
#pragma unroll
        for (unsigned j = 0; j < 16; ++j) { const unsigned c = xb_ld(&bar[XB_XCNT(j)]); sum += c; cnt += (c > 0u) ? 1u : 0u; mine = (j == x) ? c : mine; }
        if (sum == G) break;
        __builtin_amdgcn_s_sleep(1);
        if ((++sp & 255u) == 0u) { if (xb_ld(&bar[XB_TMO])) break; if (sp > XB_SPIN_CAP) { atomicAdd(&bar[XB_TMO], 1u); break; } }
    }
    nloc = mine > 0u ? mine : 1u; nx = cnt > 0u ? cnt : 1u;
}
__device__ __forceinline__ void xcd_barrier(const XcdBarrier& b, unsigned G, int wave) {
    asm volatile("s_waitcnt vmcnt(0)" ::: "memory");
    __syncthreads();
    if (wave == 0) { if (fresh_lane() == 0) {
        unsigned* bar = b.bar;
        __builtin_amdgcn_s_waitcnt(0);
        unsigned nloc = b.st[0], nx = b.st[1];
        if (nloc == 0u) { xcd_barrier_complete(bar, b.x, G, nloc, nx); b.st[0] = nloc; b.st[1] = nx; }
        const unsigned old = xb_add(&bar[XB_XSUB(b.x)], 1u);
        const unsigned gen = old / nloc;
        if (old + 1u == (gen + 1u) * nloc) {
            __builtin_amdgcn_fence(__ATOMIC_RELEASE, "agent");
            asm volatile("s_waitcnt vmcnt(0)" ::: "memory");
            const unsigned og = xb_add(&bar[XB_TOP], 1u);
            const unsigned tg = og / nx;
            if (og + 1u == (tg + 1u) * nx) xb_add(&bar[XB_TOPGEN], 1u);
            else XB_SPIN(xb_ld(&bar[XB_TOPGEN]) == tg, bar);
            __builtin_amdgcn_fence(__ATOMIC_ACQUIRE, "agent");
            xb_add(&bar[XB_XGEN(b.x)], 1u);
            asm volatile("s_waitcnt vmcnt(0)" ::: "memory");
        } else {
            XB_SPIN(xb_ld(&bar[XB_XGEN(b.x)]) == gen, bar);
            __builtin_amdgcn_fence(__ATOMIC_ACQUIRE, "agent");
            asm volatile("s_waitcnt vmcnt(0)" ::: "memory");
        }
    } }
    __syncthreads();
}

__device__ __forceinline__ void grid_barrier(unsigned* bar, unsigned target, int wave) {
    asm volatile("s_waitcnt vmcnt(0)" ::: "memory");
    __syncthreads();
    if (wave == 0) { const int l = fresh_lane();
        if (l == 0) {
            __builtin_amdgcn_fence(__ATOMIC_RELEASE, "agent"); asm volatile("s_waitcnt vmcnt(0)" ::: "memory");
            __hip_atomic_fetch_add(bar, 1u, __ATOMIC_RELAXED, __HIP_MEMORY_SCOPE_AGENT);
            while (__hip_atomic_load(bar, __ATOMIC_RELAXED, __HIP_MEMORY_SCOPE_AGENT) < target) __builtin_amdgcn_s_sleep(2);
            __builtin_amdgcn_fence(__ATOMIC_ACQUIRE, "agent"); asm volatile("s_waitcnt vmcnt(0)" ::: "memory");
        } }
    __syncthreads();
}

struct Args { const float* in[38]; float* out; unsigned char* ws; int ph_lo, ph_hi; };
typedef const float* cfp_t;
typedef const __attribute__((address_space(4))) cfp_t* kin_t;

__device__ __forceinline__ void s5_precompute(const kin_t ain, unsigned char* aws, int g, int hq, int nh, LAS float* L, const int tid) {
    const float *lre = ain[6], *lim = ain[7], *lstep = ain[8], *bre = ain[9], *bim = ain[10], *cre = ain[11], *cim = ain[12], *dd = ain[13];
    LAS float *PWre = L, *PWim = L + 4224, *BBre = L + 8448, *BBim = L + 10496, *CCre = L + 12544, *CCim = L + 14592, *MT = L + 16640, *C2re = L + 33280, *C2im = L + 35328, *Dl = L + 37376;
    bf16_t* WGg = (bf16_t*)(aws + WS_WG) + (size_t)g * 768 * 512; bf16_t* WCg = (bf16_t*)(aws + WS_WC) + (size_t)g * 512 * 256;
#define PSTAMP(i) do { if (TSTAMP && blockIdx.x == 128 && tid == 0) ((unsigned long long*)(aws + WS_CTR + 1024))[i] = __builtin_amdgcn_s_memrealtime(); } while (0)
    PSTAMP(20);
    {
        const int np = tid & 127, jj = tid >> 7, n = np >> 6, p = np & 63; const int pi = (n * 64 + g) * 64 + p;
        const float lr = fminf(lre[pi], -1e-4f), li = lim[pi], step = expf(lstep[n * 64 + g]); const float lrs = lr * step, th = li * step;
        for (int j = jj; j <= 32; j += 4) { float r, i; cpow(lrs, th, j, r, i); PWre[np * 33 + j] = r; PWim[np * 33 + j] = i; }
        float l1r, l1i; cpow(lrs, th, 1, l1r, l1i);
        const float nr = l1r - 1.0f, ni = l1i, den = lr * lr + li * li; const float qr = (nr * lr + ni * li) / den, qi = (ni * lr - nr * li) / den;
#pragma unroll
        for (int k = jj * 4; k < jj * 4 + 4; ++k) { const float br = bre[(size_t)pi * 16 + k], bi = bim[(size_t)pi * 16 + k]; BBre[np * 16 + k] = qr * br - qi * bi; BBim[np * 16 + k] = qr * bi + qi * br; }
        for (int e = tid; e < 2048; e += 512) { const int n2 = e >> 10, k = (e >> 6) & 15, p2 = e & 63; const size_t ci = ((size_t)(n2 * 64 + g) * 16 + k) * 64 + p2; CCre[(n2 * 64 + p2) * 16 + k] = cre[ci]; CCim[(n2 * 64 + p2) * 16 + k] = cim[ci]; C2re[e] = cre[ci]; C2im[e] = cim[ci]; }
        if (tid < 16) Dl[tid] = dd[g * 16 + tid];
    }
    __syncthreads();
    PSTAMP(21);
    for (int i = 0; i < 3; ++i) {
        if (nh == 2) { if (i < 2 && i != hq) continue; if (i == 2 && (hq != 0 || tid >= 16)) continue; } else if (i == 2) continue;
        const int bq = (i == 2) ? 512 + tid : tid + 512 * i, n = bq >> 9, j = (bq >> 4) & 31, kob = (bq >> 2) & 3, kib = bq & 3;
        f32x4 m0 = {0.f, 0.f, 0.f, 0.f}, m1 = m0, m2 = m0, m3 = m0;
        for (int p = 0; p < 64; ++p) { const int np = n * 64 + p; const float pr = PWre[np * 33 + j], pi2 = PWim[np * 33 + j];
            const f32x4 br = *(const LAS f32x4*)(BBre + np * 16 + 4 * kib), bi = *(const LAS f32x4*)(BBim + np * 16 + 4 * kib), cr = *(const LAS f32x4*)(CCre + np * 16 + 4 * kob), ci = *(const LAS f32x4*)(CCim + np * 16 + 4 * kob);
            const f32x4 er = pr * br - pi2 * bi, ei = pr * bi + pi2 * br;
            m0 += cr[0] * er - ci[0] * ei; m1 += cr[1] * er - ci[1] * ei; m2 += cr[2] * er - ci[2] * ei; m3 += cr[3] * er - ci[3] * ei; }
        LAS float* o = MT + (n * 32 + j) * 260 + (4 * kob) * 16 + 4 * kib;
        *(LAS f32x4*)o = m0; *(LAS f32x4*)(o + 16) = m1; *(LAS f32x4*)(o + 32) = m2; *(LAS f32x4*)(o + 48) = m3;
    }
    __syncthreads();
    PSTAMP(22);
    for (int i = 0; i < 64; ++i) {
        const int idx = tid + 512 * i, row = idx >> 6, cp = idx & 63, t = row >> 4, ko = row & 15, s = cp >> 1, ki0 = (cp & 1) * 8;
        if (nh == 2 && ((t >= s) != (hq == 0))) continue;
        f32x4 v0, v1;
        if (t != s) { const LAS float* src = MT + ((t > s ? 0 : 1) * 32 + (t > s ? t - s : s - t)) * 260 + ko * 16 + ki0; v0 = *(const LAS f32x4*)src; v1 = *(const LAS f32x4*)(src + 4); }
        else { const LAS float* s0 = MT + ko * 16 + ki0; const LAS float* s1 = MT + 32 * 260 + ko * 16 + ki0; v0 = *(const LAS f32x4*)s0 + *(const LAS f32x4*)s1; v1 = *(const LAS f32x4*)(s0 + 4) + *(const LAS f32x4*)(s1 + 4);
            const float dv = Dl[ko];
#pragma unroll
            for (int e = 0; e < 4; ++e) { if (ki0 + e == ko) v0[e] += dv; if (ki0 + 4 + e == ko) v1[e] += dv; } }
        u32x4 w; w.x = cvt_pk_bf16(v0[0], v0[1]); w.y = cvt_pk_bf16(v0[2], v0[3]); w.z = cvt_pk_bf16(v1[0], v1[1]); w.w = cvt_pk_bf16(v1[2], v1[3]);
        *(u32x4*)(WGg + (size_t)row * 512 + cp * 8) = w;
    }
    for (int i = hq * (32 / nh); i < (hq + 1) * (32 / nh); ++i) {
        const int idx = tid + 512 * i, q = idx >> 6, cp = idx & 63, n = q >> 7, ri = (q >> 6) & 1, p = q & 63, s = cp >> 1, ki0 = (cp & 1) * 8, e = n == 0 ? 31 - s : s, np = n * 64 + p;
        const float pr = PWre[np * 33 + e], pi2 = PWim[np * 33 + e]; float v[8];
#pragma unroll
        for (int k = 0; k < 8; ++k) { const float br = BBre[np * 16 + ki0 + k], bi = BBim[np * 16 + ki0 + k]; v[k] = ri == 0 ? pr * br - pi2 * bi : pr * bi + pi2 * br; }
        u32x4 w; w.x = cvt_pk_bf16(v[0], v[1]); w.y = cvt_pk_bf16(v[2], v[3]); w.z = cvt_pk_bf16(v[4], v[5]); w.w = cvt_pk_bf16(v[6], v[7]);
        *(u32x4*)(WGg + (size_t)(512 + q) * 512 + cp * 8) = w;
    }
    for (int i = 0; i < 32 / nh; ++i) {
        const int idx = tid + 512 * i, row = nh == 2 ? idx >> 4 : idx >> 5, q0 = nh == 2 ? hq * 128 + (idx & 15) * 8 : (idx & 31) * 8, n = q0 >> 7, ri = (q0 >> 6) & 1, p0 = q0 & 63, t = row >> 4, ko = row & 15, e = n == 0 ? t + 1 : 32 - t; float v[8];
#pragma unroll
        for (int k = 0; k < 8; ++k) { const int np = n * 64 + p0 + k; const float cr = C2re[(n * 16 + ko) * 64 + p0 + k], ci = C2im[(n * 16 + ko) * 64 + p0 + k], pr = PWre[np * 33 + e], pi2 = PWim[np * 33 + e];
            v[k] = ri == 0 ? cr * pr - ci * pi2 : -(cr * pi2 + ci * pr); }
        u32x4 w; w.x = cvt_pk_bf16(v[0], v[1]); w.y = cvt_pk_bf16(v[2], v[3]); w.z = cvt_pk_bf16(v[4], v[5]); w.w = cvt_pk_bf16(v[6], v[7]);
        *(u32x4*)(WCg + (size_t)row * 256 + q0) = w;
    }
    __syncthreads();
    PSTAMP(23);
}


#ifndef DIAG
#define DIAG 0
#endif
__device__ __forceinline__ void diag_ffn(const float* const* in, const unsigned char* ws, const float* outp, unsigned* flagw, int gtid, int GT) {
    const bf16_t* h1 = (const bf16_t*)(ws + WS_HB); const bf16_t* T = (const bf16_t*)(ws + WS_T); const float* V2 = (const float*)(ws + WS_V2);
    const float *w1 = in[29], *b1 = in[30], *w2 = in[31], *b2 = in[32], *wp = in[33], *wg = in[34], *bg = in[35], *pp = in[1];
    for (int sidx = gtid; sidx < 16384; sidx += GT) {
        unsigned hsh = (unsigned)sidx * 2654435761u, h2 = ((unsigned)sidx + 977u) * 2246822519u; const int r = (hsh >> 8) % SEQ; const int c = (h2 >> 6) % DFF; const int c2 = c % DM;
        float a = b1[c]; for (int k = 0; k < DM; ++k) a += bfu(h1[(size_t)r * DM + k]) * w1[(size_t)k * DFF + c];
        a = fmaxf(a, 0.f); a = a * a; const float tv = bfu(T[(size_t)r * DFF + c]);
        if (fabsf(tv - a) > 0.008f * fabsf(a) + 0.006f) atomicAdd(flagw + 0, 1u);
        float f = b2[c2]; for (int k = 0; k < DFF; ++k) f += bfu(T[(size_t)r * DFF + k]) * w2[(size_t)k * DM + c2];
        float gt = bg[c2]; for (int k = 0; k < DM; ++k) gt += bfu(h1[(size_t)r * DM + k]) * wg[(size_t)k * DM + c2];
        float pw = 0.f; for (int k = 0; k < PLE; ++k) pw += pp[(size_t)r * PLE + k] * wp[(size_t)k * DM + c2];
        const float v2 = DN_ALPHA * bfu(h1[(size_t)r * DM + c2]) + f + fast_sigmoid(gt) * pw; const float got = V2[(size_t)r * DM + c2];
        if (fabsf(got - v2) > 0.008f * fabsf(v2) + 0.006f) atomicAdd(flagw + 1, 1u);
        { const float* vr = V2 + (size_t)r * DM; float m = 0.f; for (int k = 0; k < DM; ++k) m += vr[k]; m /= DM; float v = 0.f; for (int k = 0; k < DM; ++k) { const float d = vr[k] - m; v += d * d; } v /= DM;
          const float e = (vr[c2] - m) / sqrtf(v + LN_EPS) * in[36][c2] + in[37][c2]; const float go = outp[(size_t)r * DM + c2]; if (fabsf(go - e) > 0.004f * fabsf(e) + 0.003f) atomicAdd(flagw + 2, 1u); }
    }
}

__device__ __forceinline__ void diag_pre(const float* const* in, const unsigned char* ws, const unsigned char* dout, unsigned* flagw, int gtid, int GT) {
    const bf16_t* h0 = (const bf16_t*)(ws + WS_HB); const bf16_t* U = (const bf16_t*)(dout + DO_U); const bf16_t* XRb = (const bf16_t*)(ws + WS_XR) + 2048; const bf16_t* Z = (const bf16_t*)(dout + DO_Z);
    const bf16_t* ypre = (const bf16_t*)(dout + DO_YPRE); const bf16_t* ycat = (const bf16_t*)(ws + WS_YCAT); const bf16_t* yg = (const bf16_t*)(ws + WS_YS5G);
    const float *x = in[0], *lg = in[2], *lb = in[3], *win = in[4], *bin = in[5], *gw_ = in[14], *gb = in[15], *g5 = in[23], *gr = in[24];
    for (int sidx = gtid; sidx < 8192; sidx += GT) {
        unsigned hsh = (unsigned)sidx * 2654435761u, h2 = ((unsigned)sidx + 977u) * 2246822519u; const int r = (hsh >> 8) % SEQ; const int c = (h2 >> 6) % DIN; const int c2 = c % DM; const int c1 = c % DS5;
        { float m = 0.f; for (int k = 0; k < DM; ++k) m += x[(size_t)r * DM + k]; m /= DM; float v = 0.f; for (int k = 0; k < DM; ++k) { const float d = x[(size_t)r * DM + k] - m; v += d * d; } v /= DM;
          const float e = (x[(size_t)r * DM + c2] - m) / sqrtf(v + LN_EPS) * lg[c2] + lb[c2]; const float got = bfu(h0[(size_t)r * DM + c2]); if (fabsf(got - e) > 0.008f * fabsf(e) + 0.006f) atomicAdd(flagw + 0, 1u); }
        { float a = bin[c]; for (int k = 0; k < DM; ++k) a += bfu(h0[(size_t)r * DM + k]) * win[(size_t)k * DIN + c];
          const float got = c < 1024 ? bfu(U[(size_t)r * 1024 + c]) : (c < 2048 ? bfu(XRb[(size_t)r * 1024 + c - 1024]) : bfu(Z[(size_t)r * 1024 + c - 2048])); if (fabsf(got - a) > 0.008f * fabsf(a) + 0.006f) atomicAdd(flagw + 3, 1u); }
        { const int hf = c2 >> 10; float ss = 0.f; for (int k = 0; k < 1024; ++k) { const float y = bfu(ypre[(size_t)r * DM + hf * 1024 + k]); ss += y * y; }
          const float e = bfu(ypre[(size_t)r * DM + c2]) / sqrtf(ss / 1024.f + LN_EPS) * (hf ? gr[c2 - 1024] : g5[c2]); const float got = bfu(ycat[(size_t)r * DM + c2]); if (fabsf(got - e) > 0.008f * fabsf(e) + 0.006f) atomicAdd(flagw + 1, 1u); }
        { float a = gb[c1]; for (int k = 0; k < DS5; ++k) a += bfu(yg[(size_t)r * DS5 + k]) * gw_[(size_t)k * DS5 + c1];
          const float e = bfu(yg[(size_t)r * DS5 + c1]) * fast_sigmoid(a); const float got = bfu(ypre[(size_t)r * DM + c1]); if (fabsf(got - e) > 0.008f * fabsf(e) + 0.006f) atomicAdd(flagw + 2, 1u); }
    }
}

__device__ __forceinline__ void diag_v(const float* const* in, const unsigned char* ws, const unsigned char* dout, unsigned* flagw, int gtid, int GT) {
    const bf16_t* h0 = (const bf16_t*)(ws + WS_HB); const bf16_t* ycat = (const bf16_t*)(ws + WS_YCAT); const float* V = (const float*)dout; const float *wo = in[25], *bo = in[26];
    for (int sidx = gtid; sidx < 16384; sidx += GT) { unsigned hsh = (unsigned)sidx * 2654435761u, h2 = ((unsigned)sidx + 977u) * 2246822519u; const int r = (hsh >> 8) % SEQ; const int c = (h2 >> 6) % DM;
        float a = bo[c] + DN_ALPHA * bfu(h0[(size_t)r * DM + c]); for (int k = 0; k < DM; ++k) a += bfu(ycat[(size_t)r * DM + k]) * wo[(size_t)k * DM + c];
        const float got = V[(size_t)r * DM + c]; if (fabsf(got - a) > 0.008f * fabsf(a) + 0.006f) atomicAdd(flagw + 0, 1u); }
}

__device__ __forceinline__ void diag_g(const float* const* in, const unsigned char* ws, unsigned* flagw, int gtid, int GT) {
    const bf16_t* XRp = (const bf16_t*)(ws + WS_XR); const bf16_t* G0 = (const bf16_t*)(ws + WS_G0); const bf16_t* G1 = (const bf16_t*)(ws + WS_G1);
    const float *convw = in[16], *convb = in[17], *wa = in[18], *ba = in[19], *wx = in[20], *bxx = in[21];
    for (int sidx = gtid; sidx < 16384; sidx += GT) { unsigned hsh = (unsigned)sidx * 2654435761u; unsigned h2 = ((unsigned)sidx + 12345u) * 2246822519u; const int t = (hsh >> 7) % SEQ; const int col = (h2 >> 5) % 4096;
        const int h = col >> 8, row = col & 255, bj = row >> 7, dir = (row >> 6) & 1, ch = row & 63;
        const float* W = (bj == 0 ? wa : wx) + ((size_t)(dir * 16 + h) * 64) * 64 + ch; float a = (bj == 0 ? ba : bxx)[(dir * 16 + h) * 64 + ch];
        for (int i = 0; i < 64; ++i) { const int c = 64 * h + i; float xc = convb[c];
            for (int j = 0; j < 4; ++j) xc += convw[j * 1024 + c] * bfu(XRp[(size_t)(t + j) * 1024 + c]);
            a += xc * W[(size_t)i * 64]; }
        const float got = bfu((t < 4096 ? G0 : G1)[(size_t)(t & 4095) * 4096 + col]);
        if (fabsf(got - a) > 0.008f * fabsf(a) + 0.006f) atomicAdd(flagw + 0, 1u); }
}

#ifndef DIAG_HALF
#define DIAG_HALF 1
#endif
__device__ __forceinline__ void diag_max(const unsigned char* ws, unsigned* flagw, int gtid, int GT) {
    const bf16_t* ycat = (const bf16_t*)(ws + WS_YCAT); float mx = 0.f;
    for (size_t i = gtid; i < (size_t)SEQ * 1024; i += GT) { const size_t r = i >> 10, c = (i & 1023) + DIAG_HALF * 1024; mx = fmaxf(mx, fabsf(bfu(ycat[r * DM + c]))); }
    atomicMax(flagw + 0, __float_as_uint(mx));
}

#ifndef DIAG_SEL
#define DIAG_SEL 4
#endif
__device__ __forceinline__ void diag_rows(const float* outp, unsigned* flagw, int gw, int NGW, int lane) {
    for (int row = gw; row < SEQ; row += NGW) { float mx = 0.f; for (int j = lane; j < DM; j += 64) mx = fmaxf(mx, fabsf(outp[(size_t)row * DM + j]));
#pragma unroll
        for (int o = 1; o < 64; o <<= 1) mx = fmaxf(mx, __shfl_xor(mx, o));
        if (lane == 0 && mx > 12.0f) { atomicAdd(flagw + 0, 1u); atomicMin(flagw + 1, (unsigned)row); atomicMax(flagw + 2, (unsigned)row); } }
}

__device__ __forceinline__ void diag_rows_bf(const bf16_t* p, int ld, float thr, unsigned* flagw, int gw, int NGW, int lane) {
    for (int row = gw; row < SEQ; row += NGW) { float mx = 0.f; for (int j = lane; j < ld; j += 64) mx = fmaxf(mx, fabsf(bfu(p[(size_t)row * ld + j])));
#pragma unroll
        for (int o = 1; o < 64; o <<= 1) mx = fmaxf(mx, __shfl_xor(mx, o));
        if (lane == 0 && mx > thr) { atomicAdd(flagw + 0, 1u); atomicMin(flagw + 1, (unsigned)row); atomicMax(flagw + 2, (unsigned)row); } }
}
template <int PHMASK> __global__ void __launch_bounds__(512, 2) mega(Args) {
    extern __shared__ __attribute__((aligned(16))) unsigned char lds_raw[];
    LAS unsigned char* lds = (LAS unsigned char*)lds_raw;
    const int wave = __builtin_amdgcn_readfirstlane((int)threadIdx.x >> 6);
    const int G = gridDim.x, bx = blockIdx.x;
    const int gw = bx * 8 + wave, NGW = G * 8, GT = G * 512;
#define PH_IDS const int lane = fresh_lane(), tid = wave * 64 + lane, gtid = bx * 512 + tid; (void)tid; (void)gtid; (void)lane
    const kin_t KIN = (kin_t)__builtin_amdgcn_kernarg_segment_ptr();
    unsigned char* ws = (unsigned char*)KIN[39]; unsigned char* dout = (unsigned char*)KIN[38];
    const int* kint = (const int*)0; (void)kint;
#if DIAG == 2
    const int lo = ((const __attribute__((address_space(4))) int*)KIN)[80], hi = 7;
#elif DIAG == 3
    const int lo = ((const __attribute__((address_space(4))) int*)KIN)[80], hi = 8;
#elif DIAG == 4
    const int lo = ((const __attribute__((address_space(4))) int*)KIN)[80], hi = 5;
#elif DIAG == 6
    const int lo = ((const __attribute__((address_space(4))) int*)KIN)[80], hi = 7;
#elif DIAG == 8
    const int lo = ((const __attribute__((address_space(4))) int*)KIN)[80], hi = 9;
#elif DIAG == 11 || DIAG == 12
    const int lo = ((const __attribute__((address_space(4))) int*)KIN)[80], hi = 10;
#else
    const int lo = ((const __attribute__((address_space(4))) int*)KIN)[80], hi = ((const __attribute__((address_space(4))) int*)KIN)[81];
#endif
#define IN(k) (((PHMASK >> (k)) & 1) && lo <= (k) && (k) < hi)
    unsigned nbar = 0; unsigned* gbar = (unsigned*)(ws + WS_CTR) + 32; (void)gbar;
    XcdBarrier xb; xb.bar = (unsigned*)(ws + WS_CTR) + 5120; xb.x = xb_xcc_id(); xb.st = (volatile LAS unsigned*)(lds + 155000);
    if (wave == 0) { if (fresh_lane() == 0) { xb.st[0] = 0u; xb.st[1] = 0u; (void)xb_add(&xb.bar[XB_XCNT(xb.x)], 1u); } }
    __syncthreads();
    if (PHMASK == 0xfff && hi > 4096) cg::this_grid().sync();
#ifndef DBL_MASK
#define DBL_MASK 0
#endif
#define REPS(k) (((DBL_MASK >> (k)) & 1) ? 2 : 1)
#define SEAM(k) do { if (IN(k) && IN((k) + 1)) { ++nbar; xcd_barrier(xb, (unsigned)G, wave); if (TSTAMP && bx == 0 && wave == 0) { if (fresh_lane() == 0) ((unsigned long long*)(ws + WS_CTR + 1024))[(k) + 1] = __builtin_amdgcn_s_memrealtime(); } } } while (0)

#define MK_RG const RgCtx RG{(const bf16_t*)(ws + WS_XR), (const bf16_t*)(ws + WS_G0), (const bf16_t*)(ws + WS_G1), (const bf16_t*)(dout + DO_Z), KIN[16], KIN[17], (const float*)(ws + WS_SP), (float*)(ws + WS_AGG), (bf16_t*)(dout + DO_YPRE)}
    if (TSTAMP && bx == 0 && wave == 0) { if (fresh_lane() == 0) ((unsigned long long*)(ws + WS_CTR + 1024))[0] = __builtin_amdgcn_s_memrealtime(); }
    for (int rep = 0; rep < REPS(0); ++rep) {
    if (IN(0)) { PH_IDS;
        if (G != 256) { for (int g = bx; g < 64; g += G) s5_precompute(KIN, ws, g, 0, 1, (LAS float*)lds, tid); }
        {
            LAS float* scr = (LAS float*)(lds + wave * 16640);
            constexpr int I_IN = (DM / 64) * (DIN / 64), I_OUT = (DM / 64) * (DM / 64), I_PG = I_OUT, I_GLU = (DS5 / 64) * (DS5 / 64), I_PW = (PLE / 64) * (DM / 64), I_LN = SEQ / 4;
            constexpr int NITEMS = I_IN + I_OUT + I_PG + I_GLU + I_PW + I_LN;
            for (int it = gw; it < NITEMS; it += NGW) {
                int r = it;
                if (r < I_IN) { transpose_item(KIN[4], DM, DIN, (bf16_t*)(ws + WS_WINT), scr, r, lane); continue; } r -= I_IN;
                if (r < I_LN) { for (int q = 0; q < 4; ++q) { const int row = r * 4 + q; ln_row<true>(KIN[0] + (size_t)row * DM, KIN[2], KIN[3], (bf16_t*)(ws + WS_HB) + (size_t)row * DM, lane); } continue; } r -= I_LN;
                if (r < I_OUT) { transpose_item(KIN[25], DM, DM, (bf16_t*)(ws + WS_WOUTT), scr, r, lane); continue; } r -= I_OUT;
                if (r < I_PG) { transpose_item(KIN[34], DM, DM, (bf16_t*)(ws + WS_PLEGT), scr, r, lane); continue; } r -= I_PG;
                if (r < I_GLU) { transpose_item(KIN[14], DS5, DS5, (bf16_t*)(ws + WS_GLUT), scr, r, lane); continue; } r -= I_GLU;
                transpose_item(KIN[33], PLE, DM, (bf16_t*)(ws + WS_PLEWT), scr, r, lane);
            }
        }
        {   const float* pp = KIN[1]; bf16_t* pb = (bf16_t*)(ws + WS_PB);
            for (int i = gtid; i < SEQ * PLE / 4; i += GT) { const f32x4 v = __builtin_nontemporal_load((const f32x4*)pp + i); u32x2 w; w.x = cvt_pk_bf16(v[0], v[1]); w.y = cvt_pk_bf16(v[2], v[3]); ((u32x2*)pb)[i] = w; }
            const float *convw = KIN[16], *convb = KIN[17], *wa = KIN[18], *ba = KIN[19], *wx = KIN[20], *bxx = KIN[21], *lam = KIN[22];
            bf16_t* rgw = (bf16_t*)(ws + WS_RGW);
            for (int i = gtid; i < 16 * 256 * 32; i += GT) { const int h = i >> 13, row = (i >> 5) & 255, K0 = (i & 31) * 8, j = K0 >> 6, i0 = K0 & 63, ch = row >> 2, bj = (row >> 1) & 1, dir = row & 1;
                const float* W = (bj == 0 ? wa : wx) + ((size_t)(dir * 16 + h) * 64) * 64 + ch; float v[8];
#pragma unroll
                for (int k = 0; k < 8; ++k) v[k] = convw[j * 1024 + 64 * h + i0 + k] * W[(size_t)(i0 + k) * 64];
                u32x4 w; w.x = cvt_pk_bf16(v[0], v[1]); w.y = cvt_pk_bf16(v[2], v[3]); w.z = cvt_pk_bf16(v[4], v[5]); w.w = cvt_pk_bf16(v[6], v[7]);
                *(u32x4*)(rgw + ((size_t)h * 256 + row) * 256 + K0) = w; }
            float* rgb = (float*)(ws + WS_RGBIAS);
            for (int i = gtid; i < 16 * 256; i += GT) { const int h = i >> 8, row = i & 255, ch = row >> 2, bj = (row >> 1) & 1, dir = row & 1;
                const float* W = (bj == 0 ? wa : wx) + ((size_t)(dir * 16 + h) * 64) * 64 + ch; float s = (bj == 0 ? ba : bxx)[(dir * 16 + h) * 64 + ch];
#pragma unroll
                for (int k = 0; k < 64; ++k) s += convb[64 * h + k] * W[(size_t)k * 64];
                rgb[i] = s; }
            float* spt = (float*)(ws + WS_SP);
            for (int i = gtid; i < 2 * 1024; i += GT) spt[i] = -8.0f * log1pf(expf(-lam[i]));
            unsigned* xr = (unsigned*)(ws + WS_XR);
            for (int i = gtid; i < 1024; i += GT) { xr[i] = 0u; xr[(size_t)(SEQ + 2) * 512 + i] = 0u; }
        }
    }
    if (rep + 1 < REPS(0)) { ++nbar; xcd_barrier(xb, (unsigned)G, wave); } }
    SEAM(0);
    for (int rep = 0; rep < REPS(1); ++rep) {
    if (IN(1)) { PH_IDS;
        SchedStd S; S.so.init(SEQ, DIN, G, bx); S.A = (const char*)(ws + WS_HB); S.B = (const char*)(ws + WS_WINT); S.a_tile = (size_t)256 * DM * 2; S.b_tile = (size_t)256 * DM * 2;
        EpiProj E{(bf16_t*)(dout + DO_U), (bf16_t*)(ws + WS_XR), (bf16_t*)(dout + DO_Z), KIN[5]};
        GEMM_PHASE(lds, wave, GParm{DM, DM * 2, 128, 64, 0}, S, E);
        if (G == 256 && bx >= 128) { __syncthreads(); const int t2 = wave * 64 + fresh_lane(); s5_precompute(KIN, ws, (bx - 128) >> 1, (bx - 128) & 1, 2, (LAS float*)lds, t2); }
    }
    if (rep + 1 < REPS(1)) { ++nbar; xcd_barrier(xb, (unsigned)G, wave); } }
    SEAM(1);
    for (int rep = 0; rep < REPS(2); ++rep) {
    if (IN(2)) { PH_IDS;
        { SchedS5a S{(const char*)(dout + DO_U), (const char*)(ws + WS_WG), G, bx}; EpiS5a E{(bf16_t*)(ws + WS_YINTRA), (float*)(ws + WS_S)};
          GEMM_PHASE(lds, wave, GParm{512, 1024, 128, 64, 0}, S, E); }
        { SchedRG S{(const char*)(ws + WS_XR), (const char*)(ws + WS_RGW), G, bx}; EpiG E{(bf16_t*)(ws + WS_G0), (bf16_t*)(ws + WS_G1), (const float*)(ws + WS_RGBIAS)};
          GEMM_PHASE(lds, wave, GParm{256, 2048, 2048, 64, 0}, S, E); }
    }
    if (rep + 1 < REPS(2)) { ++nbar; xcd_barrier(xb, (unsigned)G, wave); } }
    SEAM(2);
    for (int rep = 0; rep < REPS(3); ++rep) {
    if (IN(3)) { PH_IDS;
        if (bx < 128) {
            const int g = bx >> 1, n = bx & 1; const float* Sg = (const float*)(ws + WS_S) + (size_t)g * NCH * 256 + n * 128; LAS float* Ls = (LAS float*)lds;
            for (int i = tid; i < NCH * 32; i += 512) { const int c = i >> 5, q4 = (i & 31) * 4; *(LAS f32x4*)(Ls + c * 128 + q4) = *(const f32x4*)(Sg + (size_t)c * 256 + q4); }
            __syncthreads();
            if (wave == 0) { const int p = lane, pi = (n * 64 + g) * 64 + p;
                const float lr = fminf(KIN[6][pi], -1e-4f), li = KIN[7][pi], step = expf(KIN[8][n * 64 + g]); float ar, ai; cpow(lr * step, li * step, TC, ar, ai);
                bf16_t* hp = (bf16_t*)(ws + WS_HPREV) + (size_t)g * NCH * 256 + n * 128; float hr = 0.f, him = 0.f;
                for (int cc = 0; cc < NCH; ++cc) { const int c = n == 0 ? cc : NCH - 1 - cc;
                    hp[(size_t)c * 256 + p] = (bf16_t)(cvt_pk_bf16(hr, 0.f) & 0xffffu); hp[(size_t)c * 256 + 64 + p] = (bf16_t)(cvt_pk_bf16(him, 0.f) & 0xffffu);
                    const float sr = Ls[c * 128 + p], si = Ls[c * 128 + 64 + p]; const float nr = ar * hr - ai * him + sr, ni = ar * him + ai * hr + si; hr = nr; him = ni; } }
            __syncthreads();
        }
        { MK_RG; for (int un = bx; un < 256; un += G) rg_pass_a(RG, un & 1, un >> 1, tid); }
    }
    if (rep + 1 < REPS(3)) { ++nbar; xcd_barrier(xb, (unsigned)G, wave); } }
    SEAM(3);
    for (int rep = 0; rep < REPS(4); ++rep) {
    if (IN(4)) { PH_IDS;
#if NAIVE_S5
        if (gw < 64) naive_s5_group((const float* const*)0, (const bf16_t*)(dout + DO_U), (float*)(ws + WS_YINTRA), (bf16_t*)(ws + WS_YS5G), gw, lane);
#else
        { SchedS5b S{(const char*)(ws + WS_HPREV), (const char*)(ws + WS_WC), G, bx}; EpiS5b E{(const bf16_t*)(ws + WS_YINTRA), (bf16_t*)(ws + WS_YS5G)};
          GEMM_PHASE(lds, wave, GParm{256, 512, 128, 64, 0}, S, E); }
#endif
#if NAIVE_RG
        { MK_RG; if (gtid < 1024) naive_rg_channel(RG, gtid); }
#else
        { MK_RG; __syncthreads(); for (int un = bx; un < 256; un += G) { rg_pass_c(RG, un & 1, un >> 1, tid, (LAS float*)lds); __syncthreads(); } }
#endif
    }
    if (rep + 1 < REPS(4)) { ++nbar; xcd_barrier(xb, (unsigned)G, wave); } }
    SEAM(4);
    for (int rep = 0; rep < REPS(5); ++rep) {
    if (IN(5)) { PH_IDS;
        SchedStd S; S.so.init(SEQ, DS5, G, bx); S.A = (const char*)(ws + WS_YS5G); S.B = (const char*)(ws + WS_GLUT); S.a_tile = (size_t)256 * 16 * 2; S.b_tile = (size_t)256 * DS5 * 2;
        EpiGlu E{(const bf16_t*)(ws + WS_YS5G), (bf16_t*)(dout + DO_YPRE), KIN[15]};
        GEMM_PHASE(lds, wave, GParm{DS5, 32, 4u * GM_STRIDE * 2u, 16, GM_STRIDE}, S, E);
        if (G == 256 && bx >= 128) {
            LAS float* scr = (LAS float*)(lds + wave * 16640); constexpr int I_FF1 = (DM / 64) * (DFF / 64);
            for (int it = (bx - 128) * 8 + wave; it < FF1_IN_P5; it += 1024) transpose_item(KIN[29], DM, DFF, (bf16_t*)(ws + WS_FF1T), scr, it, lane); }
    }
    if (rep + 1 < REPS(5)) { ++nbar; xcd_barrier(xb, (unsigned)G, wave); } }
    SEAM(5);
    for (int rep = 0; rep < REPS(6); ++rep) {
    if (IN(6)) { PH_IDS;
        const float *g5 = KIN[23], *gr = KIN[24];
        for (int row = gw; row < SEQ; row += NGW) { const u32x4* yr = (const u32x4*)(dout + DO_YPRE) + (size_t)row * 256; u32x4* oc = (u32x4*)(ws + WS_YCAT) + (size_t)row * 256;
            u32x4 w[4]; float s0 = 0.f, s1 = 0.f;
#pragma unroll
            for (int j = 0; j < 4; ++j) { w[j] = __builtin_nontemporal_load(yr + lane + 64 * j); const float q = bf_lo(w[j].x) * bf_lo(w[j].x) + bf_hi(w[j].x) * bf_hi(w[j].x) + bf_lo(w[j].y) * bf_lo(w[j].y) + bf_hi(w[j].y) * bf_hi(w[j].y)
                + bf_lo(w[j].z) * bf_lo(w[j].z) + bf_hi(w[j].z) * bf_hi(w[j].z) + bf_lo(w[j].w) * bf_lo(w[j].w) + bf_hi(w[j].w) * bf_hi(w[j].w); if (j < 2) s0 += q; else s1 += q; }
            const float r0 = 1.0f / sqrtf(wave_sum(s0) * (1.f / 1024.f) + LN_EPS), r1 = 1.0f / sqrtf(wave_sum(s1) * (1.f / 1024.f) + LN_EPS);
#pragma unroll
            for (int j = 0; j < 4; ++j) { const int col = (lane + 64 * j) * 8; const float rs = j < 2 ? r0 : r1; const float* gp = j < 2 ? g5 + col : gr + (col - 1024);
                const f32x4 ga = *(const f32x4*)gp, gb = *(const f32x4*)(gp + 4);
                u32x4 o; o.x = cvt_pk_bf16(bf_lo(w[j].x) * rs * ga[0], bf_hi(w[j].x) * rs * ga[1]); o.y = cvt_pk_bf16(bf_lo(w[j].y) * rs * ga[2], bf_hi(w[j].y) * rs * ga[3]);
                o.z = cvt_pk_bf16(bf_lo(w[j].z) * rs * gb[0], bf_hi(w[j].z) * rs * gb[1]); o.w = cvt_pk_bf16(bf_lo(w[j].w) * rs * gb[2], bf_hi(w[j].w) * rs * gb[3]); oc[lane + 64 * j] = o; } }
        {
            LAS float* scr = (LAS float*)(lds + wave * 16640);
            constexpr int I_FF1 = (DM / 64) * (DFF / 64), I_FF2 = (DFF / 64) * (DM / 64);
            const int ff1_lo = (G == 256) ? FF1_IN_P5 : 0;
            for (int it = gw; it < I_FF2 + (I_FF1 - ff1_lo); it += NGW) {
                if (it < I_FF2) transpose_item(KIN[31], DFF, DM, (bf16_t*)(ws + WS_FF2T), scr, it, lane);
                else transpose_item(KIN[29], DM, DFF, (bf16_t*)(ws + WS_FF1T), scr, ff1_lo + it - I_FF2, lane); }
        }
    }
    if (rep + 1 < REPS(6)) { ++nbar; xcd_barrier(xb, (unsigned)G, wave); } }
    SEAM(6);
    for (int rep = 0; rep < REPS(7); ++rep) {
    if (IN(7)) { PH_IDS;
        SchedStd S; S.so.init(SEQ, DM, G, bx); S.A = (const char*)(ws + WS_YCAT); S.B = (const char*)(ws + WS_WOUTT); S.a_tile = (size_t)256 * DM * 2; S.b_tile = (size_t)256 * DM * 2;
        EpiResLn1 E{(bf16_t*)(ws + WS_HB), KIN[26], KIN[27], KIN[28], PanelStats8{(unsigned long long*)(ws + WS_AGG), (unsigned*)(ws + WS_CTR) + 1024, LN_EPS}};
        GEMM_PHASE(lds, wave, GParm{DM, DM * 2, 128, 64, 0}, S, E);
    }
    if (rep + 1 < REPS(7)) { ++nbar; xcd_barrier(xb, (unsigned)G, wave); } }
    for (int rep = 0; rep < REPS(8); ++rep) {
    if (IN(8)) { }
    if (rep + 1 < REPS(8)) { ++nbar; xcd_barrier(xb, (unsigned)G, wave); } }
    SEAM(8);
    for (int rep = 0; rep < REPS(9); ++rep) {
    if (IN(9)) { PH_IDS;
        static_assert(WS_PLEGT == WS_FF1T + (size_t)DFF * DM * 2, "gate weights must follow the FF1 weights");
        { SchedStd S; S.so.init(SEQ, DFF + DM, G, bx); S.A = (const char*)(ws + WS_HB); S.B = (const char*)(ws + WS_FF1T); S.a_tile = (size_t)256 * DM * 2; S.b_tile = (size_t)256 * DM * 2;
          EpiFF1G E{(bf16_t*)(ws + WS_T), (bf16_t*)dout, KIN[30], KIN[35]}; GEMM_PHASE(lds, wave, GParm{DM, DM * 2, 128, 64, 0}, S, E); }
        { SchedStd S; S.so.init(SEQ, DM, G, bx); S.A = (const char*)(ws + WS_PB); S.B = (const char*)(ws + WS_PLEWT); S.a_tile = (size_t)256 * PLE * 2; S.b_tile = (size_t)256 * PLE * 2;
          EpiPlain<0> E{(bf16_t*)dout + ((size_t)1 << 19), DM, nullptr, (size_t)1 << 20}; GEMM_PHASE(lds, wave, GParm{PLE, PLE * 2, 128, 64, 0}, S, E); }
    }
    if (rep + 1 < REPS(9)) { ++nbar; xcd_barrier(xb, (unsigned)G, wave); } }
    SEAM(9);
    for (int rep = 0; rep < REPS(10); ++rep) {
    if (IN(10)) { PH_IDS;
        SchedStd S; S.so.init(SEQ, DM, G, bx); S.A = (const char*)(ws + WS_T); S.B = (const char*)(ws + WS_FF2T); S.a_tile = (size_t)256 * DFF * 2; S.b_tile = (size_t)256 * DFF * 2;
        EpiResLn2 E{(const bf16_t*)(ws + WS_HB), KIN[32], KIN[36], KIN[37], (float*)dout, (const bf16_t*)dout, PanelStats8{(unsigned long long*)(ws + WS_AGG) + 65536, (unsigned*)(ws + WS_CTR) + 1024 + 64 * 32, LN_EPS}};
        GEMM_PHASE(lds, wave, GParm{DFF, DFF * 2, 128, 64, 0}, S, E);
    }
    if (rep + 1 < REPS(10)) { ++nbar; xcd_barrier(xb, (unsigned)G, wave); } }
    for (int rep = 0; rep < REPS(11); ++rep) {
    if (IN(11)) { }
    if (rep + 1 < REPS(11)) { ++nbar; xcd_barrier(xb, (unsigned)G, wave); } }
#ifdef EXTRA_BARRIERS
    for (int eb = 0; eb < EXTRA_BARRIERS; ++eb) { ++nbar; xcd_barrier(xb, (unsigned)G, wave); }
#endif
#if TSTAMP
    if (bx == 0 && wave == 0) { if (fresh_lane() == 0) { unsigned long long* st = (unsigned long long*)(ws + WS_CTR + 1024); st[12] = __builtin_amdgcn_s_memrealtime();
        ((float*)KIN[38])[0] = 8.0f * floorf((float)(long long)(__hip_atomic_load(st + TS_A1, __ATOMIC_RELAXED, __HIP_MEMORY_SCOPE_AGENT) - __hip_atomic_load(st + TS_A0, __ATOMIC_RELAXED, __HIP_MEMORY_SCOPE_AGENT)) * 0.00125f + 0.5f); } }
#endif
#if DIAG
    { ++nbar; xcd_barrier(xb, (unsigned)G, wave); PH_IDS; unsigned* flagw = (unsigned*)(ws + WS_CTR) + 48;
#if DIAG == 1
      diag_ffn((const float* const*)0, ws, ((float*)KIN[38]), flagw, gtid, GT);
#elif DIAG == 2
      diag_pre((const float* const*)0, ws, dout, flagw, gtid, GT);
#elif DIAG == 3
      diag_v((const float* const*)0, ws, dout, flagw, gtid, GT);
#elif DIAG == 4
      diag_g((const float* const*)0, ws, flagw, gtid, GT);
#elif DIAG == 6
      diag_max(ws, flagw, gtid, GT);
#else
      if (bx == 0 && tid == 0) flagw[1] = 0xffffffffu;
      ++nbar; xcd_barrier(xb, (unsigned)G, wave);
#if DIAG == 7
      diag_rows(((float*)KIN[38]), flagw, gw, NGW, lane);
#elif DIAG == 8
      diag_rows_bf((const bf16_t*)(ws + WS_HB), DM, 12.0f, flagw, gw, NGW, lane);
#elif DIAG == 9
      diag_rows((const float*)(ws + WS_V2), flagw, gw, NGW, lane);
#elif DIAG == 10
      diag_rows_bf((const bf16_t*)(ws + WS_T), DFF, 150.0f, flagw, gw, NGW, lane);
#elif DIAG == 11
      diag_rows_bf((const bf16_t*)(dout + DO_PW), DM, 8.0f, flagw, gw, NGW, lane);
#elif DIAG == 12
      diag_rows_bf((const bf16_t*)(dout + DO_SG), DM, 1.01f, flagw, gw, NGW, lane);
#endif
#endif
      ++nbar; xcd_barrier(xb, (unsigned)G, wave);
#if DIAG != 1
      for (int i = gtid; i < SEQ * DM; i += GT) ((float*)KIN[38])[i] = 0.f;
      ++nbar; xcd_barrier(xb, (unsigned)G, wave);
#endif
      if (bx == 0 && tid == 0) { unsigned code = 0; for (int q = 0; q < 4; ++q) if (__hip_atomic_load(flagw + q, __ATOMIC_RELAXED, __HIP_MEMORY_SCOPE_AGENT) > 100u) code |= 1u << q; if (DIAG >= 7) { const unsigned cnt = __hip_atomic_load(flagw, __ATOMIC_RELAXED, __HIP_MEMORY_SCOPE_AGENT), mn = __hip_atomic_load(flagw + 1, __ATOMIC_RELAXED, __HIP_MEMORY_SCOPE_AGENT), mxr = __hip_atomic_load(flagw + 2, __ATOMIC_RELAXED, __HIP_MEMORY_SCOPE_AGENT);
          const unsigned v = DIAG_SEL == 0 ? cnt : DIAG_SEL == 1 ? mn / 100u : DIAG_SEL == 2 ? mn % 100u : DIAG_SEL == 3 ? mxr / 100u : mxr % 100u; ((float*)KIN[38])[0] = 100.0f * (float)(v + 1u); }
      else ((float*)KIN[38])[0] = (DIAG == 6) ? 1000.0f * __uint_as_float(__hip_atomic_load(flagw, __ATOMIC_RELAXED, __HIP_MEMORY_SCOPE_AGENT)) : 1000.0f * (float)(code + 16u); } }
#endif
#undef IN
#undef SEAM
}


#if PER_PHASE_LAUNCH
template <int PH> static void set_attr_one() { (void)hipFuncSetAttribute((const void*)mega<(1 << PH)>, hipFuncAttributeMaxDynamicSharedMemorySize, LDS_BYTES); }
template <int PH> static void launch_one(Args a, int grid, hipStream_t stream) { a.ph_lo = PH; a.ph_hi = PH + 1; hipLaunchKernelGGL(mega<(1 << PH)>, dim3(grid), dim3(512), LDS_BYTES, stream, a); }
static void set_attrs() { set_attr_one<0>(); set_attr_one<1>(); set_attr_one<2>(); set_attr_one<3>(); set_attr_one<4>(); set_attr_one<5>(); set_attr_one<6>(); set_attr_one<7>(); set_attr_one<8>(); set_attr_one<9>(); set_attr_one<10>(); set_attr_one<11>(); }
static void launch_phases(const Args& a, int grid, hipStream_t stream) { launch_one<0>(a, grid, stream); launch_one<1>(a, grid, stream); launch_one<2>(a, grid, stream); launch_one<3>(a, grid, stream); launch_one<4>(a, grid, stream); launch_one<5>(a, grid, stream);
    launch_one<6>(a, grid, stream); launch_one<7>(a, grid, stream); launch_one<8>(a, grid, stream); launch_one<9>(a, grid, stream); launch_one<10>(a, grid, stream); launch_one<11>(a, grid, stream); }
#else
static void set_attrs() { (void)hipFuncSetAttribute((const void*)mega<0xfff>, hipFuncAttributeMaxDynamicSharedMemorySize, LDS_BYTES); }
#endif

extern "C" void kernel_launch(void* const* d_in, const int* in_sizes, int n_in, void* d_out, int out_size, void* d_ws, size_t ws_size, hipStream_t stream) {
    static int grid = 0;
    if (grid == 0) {
        if (n_in != 38 || out_size != SEQ * DM || ws_size < WS_END) { fprintf(stderr, "kernel_launch: unexpected shapes (n_in %d out %d ws %zu)\n", n_in, out_size, ws_size); grid = -1; return; }
        int dev = 0, cus = 0, per_cu = 0;
        hipGetDevice(&dev); hipDeviceGetAttribute(&cus, hipDeviceAttributeMultiprocessorCount, dev);
        set_attrs();
        per_cu = 1;
        (void)hipGetLastError();
        if (per_cu < 1) per_cu = 1;
        grid = cus;
    }
    if (grid < 0) return;
#ifdef POISON_NAN
    hipMemsetAsync(d_ws, 0xFF, WS_END, stream); hipMemsetAsync(d_out, 0xFF, (size_t)64 * MiB, stream);
#endif
    hipMemsetAsync((char*)d_ws + WS_CTR, 0, 40960, stream);
    Args a{};
    for (int i = 0; i < 38; ++i) a.in[i] = (const float*)d_in[i];
    a.out = (float*)d_out; a.ws = (unsigned char*)d_ws;
#if PER_PHASE_LAUNCH
    launch_phases(a, grid, stream);
#else
    a.ph_lo = 0; a.ph_hi = NPHASE;
    void* kargs[] = {&a};
    hipError_t e = hipLaunchCooperativeKernel((const void*)mega<0xfff>, dim3(grid), dim3(512), kargs, LDS_BYTES, stream);
    if (e != hipSuccess) fprintf(stderr, "cooperative launch failed: %s (grid %d)\n", hipGetErrorString(e), grid);
#endif
}
```

```cpp
#include <hip/hip_runtime.h>
#include <hip/hip_cooperative_groups.h>
#include <cstdio>
#include <cstdint>
namespace cg = cooperative_groups;

#ifndef PER_PHASE_LAUNCH
#define PER_PHASE_LAUNCH 0
#endif

#ifndef TSTAMP
#define TSTAMP 0
#define TS_A0 4
#define TS_A1 5
#define TS_B0 9
#define TS_B1 12
#endif
#define LAS __attribute__((address_space(3)))
typedef unsigned short bf16_t;
typedef short bf16x8 __attribute__((ext_vector_type(8)));
typedef float f32x4 __attribute__((ext_vector_type(4)));
typedef float f32x2 __attribute__((ext_vector_type(2)));
typedef unsigned u32x4 __attribute__((ext_vector_type(4)));
typedef unsigned u32x2 __attribute__((ext_vector_type(2)));

constexpr int SEQ = 8192, DM = 2048, DIN = 3072, DS5 = 1024, DRG = 1024, NG = 64, NP = 64, NK = 16, NH = 16, HD = 64, DFF = 8192, PLE = 256;
constexpr int TC = 32, NCH = SEQ / TC;
constexpr float LN_EPS = 1e-5f, DN_ALPHA = 1.18920711500272f;
constexpr int NPHASE = 12;

constexpr size_t MiB = (size_t)1 << 20;
constexpr size_t WS_FF2T = 0, WS_HB = 32 * MiB, WS_FF1T = 64 * MiB, WS_PLEGT = 96 * MiB, WS_PLEWT = 104 * MiB, WS_PB = 105 * MiB, WS_WOUTT = 109 * MiB,
    WS_V2 = 64 * MiB, WS_G0 = 0, WS_G1 = 64 * MiB,
    WS_WG = 128 * MiB, WS_WC = 176 * MiB, WS_RGW = 192 * MiB, WS_GLUT = 194 * MiB, WS_XR = 196 * MiB, WS_YINTRA = 213 * MiB, WS_S = 229 * MiB, WS_HPREV = 245 * MiB, WS_WINT = 229 * MiB,
    WS_YS5G = 128 * MiB, WS_YCAT = 144 * MiB, WS_T = 128 * MiB,
    WS_AGG = 256 * MiB, WS_CARRY = 258 * MiB, WS_SUMSQ = 259 * MiB, WS_RGBIAS = 259 * MiB + 64 * 1024, WS_SP = WS_RGBIAS + 16 * 1024, WS_CTR = WS_SP + 8 * 1024, WS_END = 260 * MiB;
constexpr size_t DO_YPRE = 0, DO_Z = 32 * MiB, DO_U = 48 * MiB, DO_SG = 0, DO_PW = 32 * MiB;
constexpr int FF1_IN_P5 = 4096;
constexpr int GM_STRIDE = SEQ * 16;
constexpr int LDS_BYTES = 152 * 1024;

typedef __bf16 bf16x2_t __attribute__((ext_vector_type(2)));
__device__ __forceinline__ unsigned cvt_pk_bf16(float lo, float hi) { const f32x2 v = {lo, hi}; const bf16x2_t b = __builtin_convertvector(v, bf16x2_t); return __builtin_bit_cast(unsigned, b); }
__device__ __forceinline__ float bf_lo(unsigned w) { return __uint_as_float(w << 16); }
__device__ __forceinline__ float bf_hi(unsigned w) { return __uint_as_float(w & 0xffff0000u); }
__device__ __forceinline__ f32x4 bf4(u32x2 w) { return (f32x4){bf_lo(w.x), bf_hi(w.x), bf_lo(w.y), bf_hi(w.y)}; }
__device__ __forceinline__ float fast_sigmoid(float x) { return __builtin_amdgcn_rcpf(1.0f + __expf(-x)); }
__device__ __forceinline__ float gelu_tanh(float x) { const float u = 1.5957691216057308f * (x + 0.044715f * x * x * x); return x * fast_sigmoid(u); }
__device__ __forceinline__ float wave_sum(float v) {
#pragma unroll
    for (int o = 1; o < 64; o <<= 1) v += __shfl_xor(v, o);
    return v;
}
__device__ __forceinline__ int lane_id() { return (int)__builtin_amdgcn_mbcnt_hi(~0u, __builtin_amdgcn_mbcnt_lo(~0u, 0u)); }
__device__ __forceinline__ int fresh_lane() { unsigned z = 0; asm volatile("" : "+s"(z)); return (int)__builtin_amdgcn_mbcnt_hi(~0u, __builtin_amdgcn_mbcnt_lo(~0u, z)); }
#define LDS_WAIT() asm volatile("s_waitcnt lgkmcnt(0)" ::: "memory")

namespace pg8 {
constexpr int BM = 256, BK = 64, HALF = 128, HTB = HALF * BK * 2, STAGE_BYTES = 8 * HTB, NXCD = 8, WGM = 8;
__host__ __device__ __forceinline__ int lds_byte(int r, int c) { const int st = (r >> 4) * 2 + (c >> 5), rr = r & 15, cc = c & 31, ob = rr * 64 + cc * 2; return st * 1024 + (ob ^ (((ob >> 9) & 1) << 5)); }
__host__ __device__ __forceinline__ void stage_rc(int b, int& R, int& C) { const int st = b / 1024, sb = b % 1024, swz = sb ^ (((sb >> 9) & 1) << 5); R = (st >> 1) * 16 + swz / 64; C = (st & 1) * 32 + (swz % 64) / 2; }
__host__ __device__ __forceinline__ int perm32(int rho) { const int n = rho >> 4, i = rho & 15; return 8 * (i >> 2) + 4 * n + (i & 3); }

struct Unit { int pm, pn; };
struct StaticOrder {
    int nM, nN, nwg, G, c;
    __host__ __device__ void init(int M, int N, int G_, int c_) { nM = M / BM; nN = N / BM; nwg = nM * nN; G = G_; c = c_; }
    __host__ __device__ bool next(int i, Unit& u) const {
        const long L = (long)i * G + c; if (L >= nwg) return false;
        int wgid = (int)L; { const int q = nwg / NXCD, r = nwg % NXCD, xcd = wgid % NXCD, off = wgid / NXCD; wgid = (xcd < r ? xcd * (q + 1) : r * (q + 1) + (xcd - r) * q) + off; }
        const int nig = WGM * nN, gid = wgid / nig, fm = gid * WGM, gsz = (nM - fm) < WGM ? (nM - fm) : WGM;
        u.pm = fm + ((wgid % nig) % gsz); u.pn = (wgid % nig) / gsz; return true;
    }
};
struct GUnit { const char* A; const char* B; int i0, i1; };
struct GParm { int K; unsigned a_rs, a_ks; int a_cw, a_cs; };

template <class Epi, class Sched>
__device__ __forceinline__ void gemm_phase(LAS unsigned char* lds, const int wid, const GParm gp, const Sched& S, const Epi& E) {
    const int lane = fresh_lane(), tid = wid * 64 + lane, wr = wid >> 2, wc = wid & 3, fr = lane & 15, fq = lane >> 4;
    const int K = gp.K, nt = K / BK;
    unsigned voffA[2], voffB[2];
#pragma unroll
    for (int i = 0; i < 2; ++i) { int R, C; stage_rc(tid * 16 + i * 8192, R, C); const int Rb = Epi::PERM ? ((R & ~31) + perm32(R & 31)) : R;
        voffA[i] = (unsigned)R * gp.a_rs + (unsigned)((C / gp.a_cw) * gp.a_cs + (C % gp.a_cw)) * 2u; voffB[i] = (unsigned)(Rb * K + C) * 2u; }
    const size_t ksA = gp.a_ks, ksB = (size_t)(BK * 2);
    const size_t hsA = (size_t)HALF * gp.a_rs, hsB = (size_t)HALF * K * 2;
    const unsigned ldsw = (unsigned)wid * 1024u;
    const int aoff = lds_byte(wr * 64 + fr, fq * 8), boff = lds_byte(wc * 32 + fr, fq * 8);
#define PG8_SA(b, h) (((b) * 2 + (h)) * HTB)
#define PG8_SB(b, h) ((4 + (b) * 2 + (h)) * HTB)
#define PG8_STAGE(bufoff, gbase, voff) do { _Pragma("unroll") for (int _i = 0; _i < 2; ++_i) \
        __builtin_amdgcn_global_load_lds((const unsigned*)((const char*)(gbase) + (voff)[_i]), (LAS unsigned*)(lds + (bufoff) + ldsw + _i * 8192), 16, 0, 0); } while (0)
#define PG8_LDA(dst, b, h) do { _Pragma("unroll") for (int m = 0; m < 4; ++m) _Pragma("unroll") for (int k = 0; k < 2; ++k) dst[m][k] = *(const LAS bf16x8*)(lds + PG8_SA(b, h) + aoff + m * 2048 + k * 1024); } while (0)
#define PG8_LDB(dst, b, h) do { _Pragma("unroll") for (int n = 0; n < 2; ++n) _Pragma("unroll") for (int k = 0; k < 2; ++k) dst[n][k] = *(const LAS bf16x8*)(lds + PG8_SB(b, h) + boff + n * 2048 + k * 1024); } while (0)
#define PG8_MMA(ai, bj, At, Bt) do { __builtin_amdgcn_s_setprio(1); _Pragma("unroll") for (int m = 0; m < 4; ++m) _Pragma("unroll") for (int n = 0; n < 2; ++n) _Pragma("unroll") for (int k = 0; k < 2; ++k) \
        acc[ai][bj][m][n] = __builtin_amdgcn_mfma_f32_16x16x32_bf16(Bt[n][k], At[m][k], acc[ai][bj][m][n], 0, 0, 0); __builtin_amdgcn_s_setprio(0); } while (0)
#define PG8_WAIT_V(n) asm volatile("s_waitcnt vmcnt(" #n ")" ::: "memory")
#define PG8_WAIT_L(n) asm volatile("s_waitcnt lgkmcnt(" #n ")" ::: "memory")
#define PG8_BAR __builtin_amdgcn_s_barrier()
#define PG8_SCHED __builtin_amdgcn_sched_barrier(0)
    GUnit cur, nxt; int ui = 0;
    if (!S.next(0, cur)) return;
    f32x4 acc[2][2][4][2];
#pragma unroll
    for (int a = 0; a < 2; ++a)
#pragma unroll
        for (int b = 0; b < 2; ++b)
#pragma unroll
            for (int m = 0; m < 4; ++m)
#pragma unroll
                for (int n = 0; n < 2; ++n) acc[a][b][m][n] = (f32x4){0.f, 0.f, 0.f, 0.f};
    bf16x8 At[4][2], B0[2][2], B1[2][2];
    const char* cA = cur.A; const char* cB = cur.B;
    PG8_STAGE(PG8_SB(0, 0), cB, voffB); PG8_STAGE(PG8_SB(0, 1), cB + hsB, voffB); PG8_STAGE(PG8_SA(0, 0), cA, voffA); PG8_STAGE(PG8_SA(0, 1), cA + hsA, voffA);
    if (wr == 1) PG8_BAR;
    PG8_WAIT_V(2); PG8_BAR;
    PG8_STAGE(PG8_SB(1, 0), cB + ksB, voffB); PG8_STAGE(PG8_SA(1, 0), cA + ksA, voffA); PG8_STAGE(PG8_SB(1, 1), cB + hsB + ksB, voffB);
    PG8_WAIT_V(6); PG8_BAR;
    for (;;) {
        const bool has_next = S.next(ui + 1, nxt);
        const char* nA = has_next ? nxt.A : cA; const char* nB = has_next ? nxt.B : cB;
        for (int t = 0; t < nt; t += 2) {
            const bool last = (t == nt - 2);
            const char* a1 = cA + (size_t)(t + 1) * ksA;
            const char* a2 = last ? nA : cA + (size_t)(t + 2) * ksA; const char* b2 = last ? nB : cB + (size_t)(t + 2) * ksB;
            const char* a3 = a2 + ksA; const char* b3 = b2 + ksB;
            PG8_LDB(B0, 0, 0); PG8_LDB(B1, 0, 1); PG8_SCHED; PG8_LDA(At, 0, 0); PG8_STAGE(PG8_SA(1, 1), a1 + hsA, voffA);
            PG8_WAIT_V(8); PG8_WAIT_L(0); PG8_BAR; PG8_MMA(0, 0, At, B0); PG8_MMA(0, 1, At, B1); PG8_BAR; PG8_SCHED;
            PG8_LDA(At, 0, 1); PG8_STAGE(PG8_SB(0, 0), b2, voffB); PG8_STAGE(PG8_SB(0, 1), b2 + hsB, voffB); PG8_STAGE(PG8_SA(0, 0), a2, voffA);
            PG8_WAIT_V(8); PG8_WAIT_L(0); PG8_BAR; PG8_MMA(1, 0, At, B0); PG8_MMA(1, 1, At, B1); PG8_BAR; PG8_SCHED;
            PG8_LDB(B0, 1, 0); PG8_LDB(B1, 1, 1); PG8_SCHED; PG8_LDA(At, 1, 0); PG8_STAGE(PG8_SA(0, 1), a2 + hsA, voffA);
            PG8_WAIT_V(8); PG8_WAIT_L(0); PG8_BAR; PG8_MMA(0, 0, At, B0); PG8_MMA(0, 1, At, B1); PG8_BAR; PG8_SCHED;
            PG8_LDA(At, 1, 1); PG8_STAGE(PG8_SB(1, 0), b3, voffB); PG8_STAGE(PG8_SB(1, 1), b3 + hsB, voffB); PG8_STAGE(PG8_SA(1, 0), a3, voffA);
            PG8_WAIT_V(8); PG8_WAIT_L(0); PG8_BAR; PG8_MMA(1, 0, At, B0); PG8_MMA(1, 1, At, B1); PG8_BAR; PG8_SCHED;
        }
        if (wr == 0) PG8_BAR;
        if constexpr (!Epi::AFTER_DRAIN) { const int l_o = fresh_lane(); E(acc, cur, wr, wc, l_o & 15, l_o >> 4); }
        if (!has_next) break;
#pragma unroll
        for (int a = 0; a < 2; ++a)
#pragma unroll
            for (int b = 0; b < 2; ++b)
#pragma unroll
                for (int m = 0; m < 4; ++m)
#pragma unroll
                    for (int n = 0; n < 2; ++n) acc[a][b][m][n] = (f32x4){0.f, 0.f, 0.f, 0.f};
        cur = nxt; cA = nA; cB = nB; ++ui;
        if (wr == 1) PG8_BAR;
    }
    PG8_WAIT_V(0);
    PG8_BAR;
    if constexpr (Epi::AFTER_DRAIN) { const int l_o = fresh_lane(); E.fused(acc, cur, wr, wc, l_o & 15, l_o >> 4, lds, wid); }
#undef PG8_SA
#undef PG8_SB
#undef PG8_STAGE
#undef PG8_LDA
#undef PG8_LDB
#undef PG8_MMA
#undef PG8_WAIT_V
#undef PG8_WAIT_L
#undef PG8_BAR
#undef PG8_SCHED
}
}
using pg8::GUnit; using pg8::GParm;
typedef f32x4 AccT[2][2][4][2];

struct SchedStd {
    pg8::StaticOrder so; const char* A; const char* B; size_t a_tile, b_tile;
    __device__ __forceinline__ bool next(int i, GUnit& u) const { pg8::Unit t; if (!so.next(i, t)) return false; u.A = A + (size_t)t.pm * a_tile; u.B = B + (size_t)t.pn * b_tile; u.i0 = t.pm; u.i1 = t.pn; return true; }
};
struct SchedS5a { const char* U; const char* WG; int G, c;
    __device__ __forceinline__ bool next(int i, GUnit& u) const { const int L = i * G + c; if (L >= 192) return false; const int g = L / 3, pn = L % 3;
        u.A = U + (size_t)g * GM_STRIDE * 2; u.B = WG + ((size_t)g * 768 + 256 * pn) * 512 * 2; u.i0 = g; u.i1 = pn; return true; } };
struct SchedS5b { const char* HP; const char* WC; int G, c;
    __device__ __forceinline__ bool next(int i, GUnit& u) const { const int L = i * G + c; if (L >= 128) return false; const int g = L / 2, pn = L % 2;
        u.A = HP + (size_t)g * 256 * 256 * 2; u.B = WC + ((size_t)g * 512 + 256 * pn) * 256 * 2; u.i0 = g; u.i1 = pn; return true; } };
struct SchedRG { const char* XR; const char* RGW; int G, c;
    __device__ __forceinline__ bool next(int i, GUnit& u) const { const int L = i * G + c; if (L >= 512) return false; const int h = L % 16, pm = L / 16;
        u.A = XR + ((size_t)(256 * pm) * 1024 + 64 * h) * 2; u.B = RGW + (size_t)h * 256 * 256 * 2; u.i0 = pm; u.i1 = h; return true; } };

template <int ACT> __device__ __forceinline__ void epi_bf16_store(const AccT& acc, bf16_t* tile, int ldc, const float* biast, int wr, int wc, int fr, int fq) {
    const int r0 = wr * 64 + fr, c0 = wc * 32 + 8 * fq;
    f32x4 bv[2][2];
#pragma unroll
    for (int bj = 0; bj < 2; ++bj)
#pragma unroll
        for (int n = 0; n < 2; ++n) bv[bj][n] = biast ? *(const f32x4*)(biast + c0 + bj * 128 + 4 * n) : (f32x4){0.f, 0.f, 0.f, 0.f};
#pragma unroll
    for (int ai = 0; ai < 2; ++ai)
#pragma unroll
        for (int m = 0; m < 4; ++m) { bf16_t* rowp = tile + (size_t)(r0 + ai * 128 + m * 16) * ldc + c0;
#pragma unroll
            for (int bj = 0; bj < 2; ++bj) { f32x4 v0 = acc[ai][bj][m][0] + bv[bj][0], v1 = acc[ai][bj][m][1] + bv[bj][1];
                if (ACT == 1) {
#pragma unroll
                    for (int j = 0; j < 4; ++j) { const float a = fmaxf(v0[j], 0.f), b = fmaxf(v1[j], 0.f); v0[j] = a * a; v1[j] = b * b; } }
                if (ACT == 2) {
#pragma unroll
                    for (int j = 0; j < 4; ++j) { v0[j] = fast_sigmoid(v0[j]); v1[j] = fast_sigmoid(v1[j]); } }
                u32x4 w; w.x = cvt_pk_bf16(v0[0], v0[1]); w.y = cvt_pk_bf16(v0[2], v0[3]); w.z = cvt_pk_bf16(v1[0], v1[1]); w.w = cvt_pk_bf16(v1[2], v1[3]);
                *(u32x4*)(rowp + bj * 128) = w; } }
}
struct EpiProj { static constexpr bool PERM = true, AFTER_DRAIN = false; bf16_t *U, *XR, *Z; const float* bias;
    __device__ __forceinline__ void operator()(AccT& acc, const GUnit& u, int wr, int wc, int fr, int fq) const {
        const int pm = u.i0, pn = u.i1;
        if (pn >= 4) { bf16_t* base = pn < 8 ? XR + 2 * 1024 : Z; epi_bf16_store<0>(acc, base + (size_t)pm * 256 * 1024 + (pn & 3) * 256, 1024, bias + pn * 256, wr, wc, fr, fq); return; }
        const int c0 = pn * 256 + wc * 32 + 8 * fq;
#pragma unroll
        for (int bj = 0; bj < 2; ++bj) { const int col = c0 + bj * 128; const f32x4 b0 = *(const f32x4*)(bias + col), b1 = *(const f32x4*)(bias + col + 4); bf16_t* gp = U + (size_t)(col >> 4) * GM_STRIDE + (col & 15);
#pragma unroll
            for (int ai = 0; ai < 2; ++ai)
#pragma unroll
                for (int m = 0; m < 4; ++m) { const int row = pm * 256 + ai * 128 + wr * 64 + m * 16 + fr; const f32x4 v0 = acc[ai][bj][m][0] + b0, v1 = acc[ai][bj][m][1] + b1;
                    u32x4 w; w.x = cvt_pk_bf16(v0[0], v0[1]); w.y = cvt_pk_bf16(v0[2], v0[3]); w.z = cvt_pk_bf16(v1[0], v1[1]); w.w = cvt_pk_bf16(v1[2], v1[3]);
                    *(u32x4*)(gp + (size_t)row * 16) = w; } }
    } };
template <int ACT> struct EpiPlain { static constexpr bool PERM = true, AFTER_DRAIN = false; bf16_t* O; int ldc; const float* bias; size_t pstride;
    __device__ __forceinline__ void operator()(AccT& acc, const GUnit& u, int wr, int wc, int fr, int fq) const {
        epi_bf16_store<ACT>(acc, O + (size_t)u.i0 * (pstride ? pstride : (size_t)256 * ldc) + u.i1 * 256, ldc, bias ? bias + u.i1 * 256 : nullptr, wr, wc, fr, fq); } };
struct EpiFF1G { static constexpr bool PERM = true, AFTER_DRAIN = false; bf16_t* T; bf16_t* SG; const float *b1, *bg;
    __device__ __forceinline__ void operator()(AccT& acc, const GUnit& u, int wr, int wc, int fr, int fq) const {
        const int pm = u.i0, pn = u.i1;
        if (pn < 32) epi_bf16_store<1>(acc, T + (size_t)pm * 256 * DFF + pn * 256, DFF, b1 + pn * 256, wr, wc, fr, fq);
        else epi_bf16_store<2>(acc, SG + (size_t)pm * ((size_t)1 << 20) + (pn - 32) * 256, DM, bg + (pn - 32) * 256, wr, wc, fr, fq); } };
struct EpiS5a { static constexpr bool PERM = true, AFTER_DRAIN = false; bf16_t* YI; float* S;
    __device__ __forceinline__ void operator()(AccT& acc, const GUnit& u, int wr, int wc, int fr, int fq) const {
        const int g = u.i0, pn = u.i1;
#pragma unroll
        for (int ai = 0; ai < 2; ++ai)
#pragma unroll
            for (int m = 0; m < 4; ++m) { const int r = ai * 128 + wr * 64 + m * 16 + fr;
#pragma unroll
                for (int bj = 0; bj < 2; ++bj) { const int c8 = bj * 128 + wc * 32 + 8 * fq; const f32x4 v0 = acc[ai][bj][m][0], v1 = acc[ai][bj][m][1];
                    if (pn < 2) { const int col = pn * 256 + c8, t = col >> 4, k0 = col & 15;
                        u32x4 w; w.x = cvt_pk_bf16(v0[0], v0[1]); w.y = cvt_pk_bf16(v0[2], v0[3]); w.z = cvt_pk_bf16(v1[0], v1[1]); w.w = cvt_pk_bf16(v1[2], v1[3]);
                        *(u32x4*)(YI + (size_t)g * GM_STRIDE + (size_t)r * 512 + col) = w; (void)t; (void)k0; }
                    else { float* sp = S + ((size_t)g * NCH + r) * 256 + c8; *(f32x4*)sp = v0; *(f32x4*)(sp + 4) = v1; } } }
    } };
struct EpiS5b { static constexpr bool PERM = true, AFTER_DRAIN = false; const bf16_t* YI; bf16_t* YG;
    __device__ __forceinline__ void operator()(AccT& acc, const GUnit& u, int wr, int wc, int fr, int fq) const {
        const int g = u.i0, pn = u.i1;
#pragma unroll
        for (int ai = 0; ai < 2; ++ai)
#pragma unroll
            for (int m = 0; m < 4; ++m) { const int r = ai * 128 + wr * 64 + m * 16 + fr;
#pragma unroll
                for (int bj = 0; bj < 2; ++bj) { const int col = pn * 256 + bj * 128 + wc * 32 + 8 * fq, t = col >> 4, k0 = col & 15;
                    const size_t off = (size_t)g * GM_STRIDE + (size_t)r * 512 + col; (void)t; (void)k0; const u32x4 yi = *(const u32x4*)(YI + off);
                    f32x4 v0 = acc[ai][bj][m][0] + (f32x4){bf_lo(yi.x), bf_hi(yi.x), bf_lo(yi.y), bf_hi(yi.y)}, v1 = acc[ai][bj][m][1] + (f32x4){bf_lo(yi.z), bf_hi(yi.z), bf_lo(yi.w), bf_hi(yi.w)};
#pragma unroll
                    for (int j = 0; j < 4; ++j) { v0[j] = gelu_tanh(v0[j]); v1[j] = gelu_tanh(v1[j]); }
                    u32x4 w; w.x = cvt_pk_bf16(v0[0], v0[1]); w.y = cvt_pk_bf16(v0[2], v0[3]); w.z = cvt_pk_bf16(v1[0], v1[1]); w.w = cvt_pk_bf16(v1[2], v1[3]);
                    *(u32x4*)(YG + off) = w; } }
    } };
struct EpiGlu { static constexpr bool PERM = true, AFTER_DRAIN = false; const bf16_t* YG; bf16_t* YPRE; const float* bias;
    __device__ __forceinline__ void operator()(AccT& acc, const GUnit& u, int wr, int wc, int fr, int fq) const {
        const int pm = u.i0, pn = u.i1; const int c0 = pn * 256 + wc * 32 + 8 * fq;
        f32x4 bv[2][2];
#pragma unroll
        for (int bj = 0; bj < 2; ++bj)
#pragma unroll
            for (int n = 0; n < 2; ++n) bv[bj][n] = *(const f32x4*)(bias + c0 + bj * 128 + 4 * n);
#pragma unroll
        for (int ai = 0; ai < 2; ++ai)
#pragma unroll
            for (int m = 0; m < 4; ++m) { const int row = pm * 256 + ai * 128 + wr * 64 + m * 16 + fr;
#pragma unroll
                for (int bj = 0; bj < 2; ++bj) { const int col = c0 + bj * 128; const u32x4 yv = *(const u32x4*)(YG + (size_t)(col >> 4) * GM_STRIDE + (size_t)row * 16 + (col & 15));
                    const f32x4 y0 = (f32x4){bf_lo(yv.x), bf_hi(yv.x), bf_lo(yv.y), bf_hi(yv.y)}, y1 = (f32x4){bf_lo(yv.z), bf_hi(yv.z), bf_lo(yv.w), bf_hi(yv.w)};
                    f32x4 v0 = acc[ai][bj][m][0] + bv[bj][0], v1 = acc[ai][bj][m][1] + bv[bj][1];
#pragma unroll
                    for (int j = 0; j < 4; ++j) { v0[j] = y0[j] * fast_sigmoid(v0[j]); v1[j] = y1[j] * fast_sigmoid(v1[j]); }
                    u32x4 w; w.x = cvt_pk_bf16(v0[0], v0[1]); w.y = cvt_pk_bf16(v0[2], v0[3]); w.z = cvt_pk_bf16(v1[0], v1[1]); w.w = cvt_pk_bf16(v1[2], v1[3]);
                    *(u32x4*)(YPRE + (size_t)row * 2048 + col) = w; }
                }
    } };
template <bool PLEADD> struct EpiRes { static constexpr bool PERM = false, AFTER_DRAIN = false; const bf16_t* HBp; const float* bias; float* V; const bf16_t* SG; const bf16_t* PW;
    __device__ __forceinline__ void operator()(AccT& acc, const GUnit& u, int wr, int wc, int fr, int fq) const {
        const int pm = u.i0, pn = u.i1; const int c0 = pn * 256 + wc * 32 + 4 * fq;
        f32x4 bv[2][2];
#pragma unroll
        for (int bj = 0; bj < 2; ++bj)
#pragma unroll
            for (int n = 0; n < 2; ++n) bv[bj][n] = *(const f32x4*)(bias + c0 + bj * 128 + n * 16);
#pragma unroll
        for (int ai = 0; ai < 2; ++ai)
#pragma unroll
            for (int m = 0; m < 4; ++m) { const int row = pm * 256 + ai * 128 + wr * 64 + m * 16 + fr;
#pragma unroll
                for (int bj = 0; bj < 2; ++bj)
#pragma unroll
                    for (int n = 0; n < 2; ++n) { const size_t off = (size_t)row * 2048 + c0 + bj * 128 + n * 16;
                        f32x4 v = acc[ai][bj][m][n] + bv[bj][n] + DN_ALPHA * bf4(*(const u32x2*)(HBp + off));
                        if (PLEADD) v += bf4(*(const u32x2*)(SG + off)) * bf4(*(const u32x2*)(PW + off));
                        *(f32x4*)(V + off) = v; } }
    } };


struct PanelStats8 { unsigned long long* xbuf; unsigned* cnt; float eps;
    __device__ __forceinline__ void run(const AccT& v, int pm, int pn, int wr, int wc, int fr, int fq, LAS unsigned char* lds, int wid) const {
        LAS f32x2* P = (LAS f32x2*)lds; LAS f32x2* S = (LAS f32x2*)(lds + 8192); const int lane = fq * 16 + fr;
#pragma unroll
        for (int ai = 0; ai < 2; ++ai)
#pragma unroll
            for (int m = 0; m < 4; ++m) { float s = 0.f;
#pragma unroll
                for (int bj = 0; bj < 2; ++bj)
#pragma unroll
                    for (int n = 0; n < 2; ++n) { const f32x4 x = v[ai][bj][m][n]; s += (x[0] + x[1]) + (x[2] + x[3]); }
                s += __shfl_xor(s, 16); s += __shfl_xor(s, 32);
                const float mw = s * (1.0f / 64.0f); float q = 0.f;
#pragma unroll
                for (int bj = 0; bj < 2; ++bj)
#pragma unroll
                    for (int n = 0; n < 2; ++n) { const f32x4 d = v[ai][bj][m][n] - mw; q += (d[0] * d[0] + d[1] * d[1]) + (d[2] * d[2] + d[3] * d[3]); }
                q += __shfl_xor(q, 16); q += __shfl_xor(q, 32);
                if (fq == 0) P[(ai * 128 + wr * 64 + m * 16 + fr) * 4 + wc] = (f32x2){mw, q}; }
        asm volatile("s_waitcnt lgkmcnt(0)" ::: "memory"); __builtin_amdgcn_s_barrier(); asm volatile("" ::: "memory");
        const int row = wid * 32 + (lane & 31);
        if (lane < 32) { const f32x2 a = P[row * 4 + 0], b = P[row * 4 + 1], c = P[row * 4 + 2], d = P[row * 4 + 3];
            const float mt = (a[0] + b[0] + c[0] + d[0]) * 0.25f; const float da = a[0] - mt, db = b[0] - mt, dc = c[0] - mt, dd = d[0] - mt;
            const float m2 = (a[1] + b[1]) + (c[1] + d[1]) + 64.0f * ((da * da + db * db) + (dc * dc + dd * dd));
            __hip_atomic_store(xbuf + ((size_t)(pm * 256 + row) * 8 + pn), ((unsigned long long)__float_as_uint(m2) << 32) | __float_as_uint(mt), __ATOMIC_RELAXED, __HIP_MEMORY_SCOPE_AGENT); }
        asm volatile("s_waitcnt vmcnt(0)" ::: "memory");
        if (lane == 0) __hip_atomic_fetch_add(cnt + 64 * pm, 1u, __ATOMIC_RELAXED, __HIP_MEMORY_SCOPE_AGENT);
        if (wid == 0) { unsigned sp = 0;
            while ((unsigned)__builtin_amdgcn_readfirstlane(__hip_atomic_load(cnt + 64 * pm, __ATOMIC_RELAXED, __HIP_MEMORY_SCOPE_AGENT)) < 64u) { __builtin_amdgcn_s_sleep(2); if (++sp > (1u << 22)) break; }
            __builtin_amdgcn_fence(__ATOMIC_ACQUIRE, "agent"); }
        asm volatile("s_waitcnt vmcnt(0) lgkmcnt(0)" ::: "memory"); __builtin_amdgcn_s_barrier(); asm volatile("" ::: "memory");
        if (lane < 32) { const unsigned long long* slot = xbuf + (size_t)(pm * 256 + row) * 8; float mt[8], m2[8]; float ms = 0.f;
#pragma unroll
            for (int t = 0; t < 8; ++t) { const unsigned long long w = __hip_atomic_load(slot + t, __ATOMIC_RELAXED, __HIP_MEMORY_SCOPE_AGENT); mt[t] = __uint_as_float((unsigned)w); m2[t] = __uint_as_float((unsigned)(w >> 32)); ms += mt[t]; }
            const float mean = ms * 0.125f; float q = 0.f;
#pragma unroll
            for (int t = 0; t < 8; ++t) { const float dm = mt[t] - mean; q += m2[t] + 256.0f * dm * dm; }
            S[row] = (f32x2){mean, 1.0f / sqrtf(q * (1.0f / 2048.0f) + eps)}; }
        asm volatile("s_waitcnt lgkmcnt(0)" ::: "memory"); __builtin_amdgcn_s_barrier(); asm volatile("" ::: "memory");
    } };
struct EpiResLn1 { static constexpr bool PERM = false, AFTER_DRAIN = true; bf16_t* HBp; const float *bias, *lng, *lnb; PanelStats8 st;
    __device__ __forceinline__ void fused(AccT& acc, const GUnit& u, int wr, int wc, int fr, int fq, LAS unsigned char* lds, int wid) const {
        const int pm = u.i0, pn = u.i1; const int c0 = pn * 256 + wc * 32 + 4 * fq; const LAS f32x2* S = (const LAS f32x2*)(lds + 8192);
#pragma unroll
        for (int bj = 0; bj < 2; ++bj)
#pragma unroll
            for (int n = 0; n < 2; ++n) { const f32x4 bv = *(const f32x4*)(bias + c0 + bj * 128 + n * 16);
#pragma unroll
                for (int ai = 0; ai < 2; ++ai)
#pragma unroll
                    for (int m = 0; m < 4; ++m) { const size_t off = (size_t)(pm * 256 + ai * 128 + wr * 64 + m * 16 + fr) * 2048 + c0 + bj * 128 + n * 16;
                        acc[ai][bj][m][n] += bv + DN_ALPHA * bf4(*(const u32x2*)(HBp + off)); } }
        st.run(acc, pm, pn, wr, wc, fr, fq, lds, wid);
#pragma unroll
        for (int bj = 0; bj < 2; ++bj)
#pragma unroll
            for (int n = 0; n < 2; ++n) { const f32x4 gg = *(const f32x4*)(lng + c0 + bj * 128 + n * 16), bb = *(const f32x4*)(lnb + c0 + bj * 128 + n * 16);
#pragma unroll
                for (int ai = 0; ai < 2; ++ai)
#pragma unroll
                    for (int m = 0; m < 4; ++m) { const int r = ai * 128 + wr * 64 + m * 16 + fr; const f32x2 sr = S[r]; const size_t off = (size_t)(pm * 256 + r) * 2048 + c0 + bj * 128 + n * 16;
                        const f32x4 o = (acc[ai][bj][m][n] - sr[0]) * sr[1] * gg + bb; u32x2 w; w.x = cvt_pk_bf16(o[0], o[1]); w.y = cvt_pk_bf16(o[2], o[3]); *(u32x2*)(HBp + off) = w; } }
    } };
struct EpiResLn2 { static constexpr bool PERM = false, AFTER_DRAIN = true; const bf16_t* HBp; const float *bias, *lng, *lnb; float* out; const bf16_t* SGPW; PanelStats8 st;
    __device__ __forceinline__ void fused(AccT& acc, const GUnit& u, int wr, int wc, int fr, int fq, LAS unsigned char* lds, int wid) const {
        const int pm = u.i0, pn = u.i1; const int c0 = pn * 256 + wc * 32 + 4 * fq; const LAS f32x2* S = (const LAS f32x2*)(lds + 8192);
        const bf16_t* sgp = SGPW + (size_t)pm * (1u << 20);
        f32x4 bv[2][2];
#pragma unroll
        for (int bj = 0; bj < 2; ++bj)
#pragma unroll
            for (int n = 0; n < 2; ++n) bv[bj][n] = *(const f32x4*)(bias + c0 + bj * 128 + n * 16);
#pragma unroll
        for (int ai = 0; ai < 2; ++ai)
#pragma unroll
            for (int m = 0; m < 4; ++m) { const int r = ai * 128 + wr * 64 + m * 16 + fr; const size_t lo = (size_t)r * 2048 + c0; const bf16_t* hp = HBp + (size_t)(pm * 256 + r) * 2048 + c0;
#pragma unroll
                for (int bj = 0; bj < 2; ++bj)
#pragma unroll
                    for (int n = 0; n < 2; ++n) { const int co = bj * 128 + n * 16;
                        acc[ai][bj][m][n] += bv[bj][n] + DN_ALPHA * bf4(*(const u32x2*)(hp + co)) + bf4(*(const u32x2*)(sgp + lo + co)) * bf4(*(const u32x2*)(sgp + (1u << 19) + lo + co)); }
                asm volatile("" : "+v"(acc[ai][0][m][0]), "+v"(acc[ai][0][m][1]), "+v"(acc[ai][1][m][0]), "+v"(acc[ai][1][m][1])); }
        st.run(acc, pm, pn, wr, wc, fr, fq, lds, wid);
#pragma unroll
        for (int bj = 0; bj < 2; ++bj)
#pragma unroll
            for (int n = 0; n < 2; ++n) { const f32x4 gg = *(const f32x4*)(lng + c0 + bj * 128 + n * 16), bb = *(const f32x4*)(lnb + c0 + bj * 128 + n * 16);
#pragma unroll
                for (int ai = 0; ai < 2; ++ai)
#pragma unroll
                    for (int m = 0; m < 4; ++m) { const int r = ai * 128 + wr * 64 + m * 16 + fr; const f32x2 sr = S[r];
                        *(f32x4*)(out + (size_t)(pm * 256 + r) * 2048 + c0 + bj * 128 + n * 16) = (acc[ai][bj][m][n] - sr[0]) * sr[1] * gg + bb; } }
    } };
struct EpiG { static constexpr bool PERM = true, AFTER_DRAIN = false; bf16_t *G0, *G1; const float* bias;
    __device__ __forceinline__ void operator()(AccT& acc, const GUnit& u, int wr, int wc, int fr, int fq) const {
        const int pm = u.i0, h = u.i1; bf16_t* base = (pm < 16 ? G0 : G1) + (size_t)(pm & 15) * 256 * 4096 + h * 256;
        epi_bf16_store<0>(acc, base, 4096, bias + h * 256, wr, wc, fr, fq); } };
__device__ __forceinline__ float bfu(unsigned short v) { return __uint_as_float(((unsigned)v) << 16); }
__device__ __forceinline__ void rg_gate(float pa, float px, float spv, float xc, float& a, float& b) {
    const float r = fast_sigmoid(pa), ig = fast_sigmoid(px); const float la = spv * r; a = __expf(la); const float x = 2.0f * la;
    const float om = -x * (1.0f + x * (0.5f + x * (0.16666667f + x * (0.041666668f + x * 0.008333334f))));
    b = __builtin_amdgcn_sqrtf(fmaxf(om, 0.f)) * ig * xc; }
__device__ __forceinline__ void rg_gate2(float pa, float px, float spv, float xc, float& a, float& b, float& r) {
    r = fast_sigmoid(pa); const float ig = fast_sigmoid(px); const float la = spv * r; a = __expf(la); const float x = 2.0f * la;
    const float om = -x * (1.0f + x * (0.5f + x * (0.16666667f + x * (0.041666668f + x * 0.008333334f))));
    b = __builtin_amdgcn_sqrtf(fmaxf(om, 0.f)) * ig * xc; }
struct RgCtx { const bf16_t *XR, *G0, *G1, *Z; const float *convw, *convb, *sp; float* agg; bf16_t* ypre; };
__device__ __forceinline__ const bf16_t* g_row(const RgCtx& R, int t) { return (t < 4096 ? R.G0 : R.G1) + (size_t)(t & 4095) * 4096; }
__device__ __forceinline__ void rg_pass_a(const RgCtx& R, int half, int seg, int tid) {
    const int c = half * 512 + tid, gcol = (c >> 6) * 256 + (c & 63) * 4, t0 = seg * 64;
    const float w0 = R.convw[c], w1 = R.convw[1024 + c], w2 = R.convw[2048 + c], w3 = R.convw[3072 + c], cb = R.convb[c], sp0 = R.sp[c], sp1 = R.sp[1024 + c];
    const bf16_t* xp = R.XR + c;
    float x0 = bfu(xp[(size_t)(t0 + 0) * 1024]), x1 = bfu(xp[(size_t)(t0 + 1) * 1024]), x2 = bfu(xp[(size_t)(t0 + 2) * 1024]);
    float Af = 1.f, Bf = 0.f, Ab = 1.f, Bb = 0.f;
    for (int tb = 0; tb < 64; tb += 16) {
        u32x2 gq[16]; unsigned short xn[16];
#pragma unroll
        for (int i = 0; i < 16; ++i) { const int t = t0 + tb + i; gq[i] = *(const u32x2*)(g_row(R, t) + gcol); xn[i] = xp[(size_t)(t + 3) * 1024]; }
#pragma unroll
        for (int i = 0; i < 16; ++i) { const float x3 = bfu(xn[i]); const float xc = cb + w0 * x0 + w1 * x1 + w2 * x2 + w3 * x3; x0 = x1; x1 = x2; x2 = x3;
            float a, b, r0, r1, b0; rg_gate2(bf_lo(gq[i].x), bf_lo(gq[i].y), sp0, xc, a, b, r0); Bf = a * Bf + b; Af = a * Af; b0 = b;
            rg_gate2(bf_hi(gq[i].x), bf_hi(gq[i].y), sp1, xc, a, b, r1); Bb = Ab * b + Bb; Ab = Ab * a;
            u32x2 w; w.x = cvt_pk_bf16(r0, r1); w.y = cvt_pk_bf16(b0, b); *(u32x2*)((bf16_t*)g_row(R, t0 + tb + i) + gcol) = w; }
    }
    *(f32x2*)(R.agg + ((size_t)(seg * 2 + 0) * 1024 + c) * 2) = (f32x2){Af, Bf};
    *(f32x2*)(R.agg + ((size_t)(seg * 2 + 1) * 1024 + c) * 2) = (f32x2){Ab, Bb};
}
__device__ __forceinline__ void rg_pass_c(const RgCtx& R, int half, int seg, int tid, LAS float* Lh) {
    const int c = half * 512 + tid, gcol = (c >> 6) * 256 + (c & 63) * 4, t0 = seg * 64;
    const float sp0 = R.sp[c], sp1 = R.sp[1024 + c];
    const f32x2* ag = (const f32x2*)R.agg;
    float hf = 0.f, hb = 0.f;
    {
#pragma unroll 1
        for (int sb = 0; sb < 128; sb += 32) { f32x2 ab[32];
#pragma unroll
            for (int i = 0; i < 32; ++i) { const int s2 = sb + i; ab[i] = (s2 < seg) ? ag[(size_t)(s2 * 2 + 0) * 1024 + c] : (f32x2){1.f, 0.f}; }
#pragma unroll
            for (int i = 0; i < 32; ++i) hf = ab[i][0] * hf + ab[i][1]; }
#pragma unroll 1
        for (int sb = 96; sb >= 0; sb -= 32) { f32x2 ab[32];
#pragma unroll
            for (int i = 0; i < 32; ++i) { const int s2 = sb + 31 - i; ab[i] = (s2 > seg) ? ag[(size_t)(s2 * 2 + 1) * 1024 + c] : (f32x2){1.f, 0.f}; }
#pragma unroll
            for (int i = 0; i < 32; ++i) hb = ab[i][0] * hb + ab[i][1]; }
    }
    {
        for (int tb = 0; tb < 64; tb += 16) {
            u32x2 gq[16];
#pragma unroll
            for (int i = 0; i < 16; ++i) gq[i] = *(const u32x2*)(g_row(R, t0 + tb + i) + gcol);
#pragma unroll
            for (int i = 0; i < 16; ++i) { const float a = __expf(sp0 * bf_lo(gq[i].x)); hf = a * hf + bf_lo(gq[i].y); Lh[(tb + i) * 512 + tid] = hf; }
        }
    }
    {
        for (int tb = 48; tb >= 0; tb -= 16) {
            u32x2 gq[16]; unsigned short zz[16];
#pragma unroll
            for (int i = 0; i < 16; ++i) { const int t = t0 + tb + 15 - i; gq[i] = *(const u32x2*)(g_row(R, t) + gcol); zz[i] = R.Z[(size_t)t * 1024 + c]; }
#pragma unroll
            for (int i = 0; i < 16; ++i) { const int tl = tb + 15 - i; const float a = __expf(sp1 * bf_hi(gq[i].x)); hb = a * hb + bf_hi(gq[i].y);
                const float o = (Lh[tl * 512 + tid] + hb) * gelu_tanh(bfu(zz[i]));
                R.ypre[(size_t)(t0 + tl) * 2048 + 1024 + c] = (bf16_t)(cvt_pk_bf16(o, 0.f) & 0xffffu); }
        }
    }
}

#ifndef NAIVE_GEMM
#define NAIVE_GEMM 0
#endif
template <class Epi, class Sched>
__device__ __forceinline__ void gemm_phase_naive(LAS unsigned char* lds, const int wid, const GParm gp, const Sched& S, const Epi& E) {
    const int lane = fresh_lane(), tid = wid * 64 + lane, wr = wid >> 2, wc = wid & 3, fr = lane & 15, fq = lane >> 4;
    GUnit cur;
    for (int ui = 0; S.next(ui, cur); ++ui) {
        f32x4 acc[2][2][4][2];
#pragma unroll
        for (int ai = 0; ai < 2; ++ai)
#pragma unroll
            for (int bj = 0; bj < 2; ++bj)
#pragma unroll
                for (int m = 0; m < 4; ++m)
#pragma unroll
                    for (int n = 0; n < 2; ++n)
#pragma unroll
                        for (int e = 0; e < 4; ++e) {
                            const int row = 128 * ai + 64 * wr + 16 * m + fr; const int col = Epi::PERM ? (128 * bj + 32 * wc + 8 * fq + 4 * n + e) : (128 * bj + 32 * wc + 16 * n + 4 * fq + e);
                            const char* ap = cur.A + (size_t)row * gp.a_rs; const char* bp = cur.B + (size_t)col * gp.K * 2; float sum = 0.f;
                            for (int k = 0; k < gp.K; k += 8) { const int kt = k >> 6, C = k & 63;
                                const u32x4 av = *(const u32x4*)(ap + (size_t)kt * gp.a_ks + ((C / gp.a_cw) * gp.a_cs + (C % gp.a_cw)) * 2), bv = *(const u32x4*)(bp + k * 2);
                                sum += bf_lo(av.x) * bf_lo(bv.x) + bf_hi(av.x) * bf_hi(bv.x) + bf_lo(av.y) * bf_lo(bv.y) + bf_hi(av.y) * bf_hi(bv.y) + bf_lo(av.z) * bf_lo(bv.z) + bf_hi(av.z) * bf_hi(bv.z) + bf_lo(av.w) * bf_lo(bv.w) + bf_hi(av.w) * bf_hi(bv.w); }
                            acc[ai][bj][m][n][e] = sum; }
        if constexpr (Epi::AFTER_DRAIN) { __syncthreads(); E.fused(acc, cur, wr, wc, fr, fq, lds, wid); } else E(acc, cur, wr, wc, fr, fq);
    }
    __syncthreads();
}
#if NAIVE_GEMM
#define GEMM_PHASE gemm_phase_naive
#else
#define GEMM_PHASE pg8::gemm_phase
#endif
__device__ __forceinline__ void transpose_item(const float* W, int K, int N, bf16_t* WT, LAS float* scr, int item, int lane) {
    const int nblk = N / 64, kb = item / nblk, nb = item % nblk, k0 = 64 * kb, n0 = 64 * nb;
    const float* src = W + (size_t)k0 * N + n0 + lane;
#pragma unroll 32
    for (int i = 0; i < 64; ++i) scr[i * 65 + lane] = __builtin_nontemporal_load(src + (size_t)i * N);
    LDS_WAIT();
    const int c = lane & 7;
#pragma unroll
    for (int j = 0; j < 8; ++j) { const int n = (lane >> 3) + 8 * j; const LAS float* sp = scr + (8 * c) * 65 + n;
        u32x4 o; o.x = cvt_pk_bf16(sp[0 * 65], sp[1 * 65]); o.y = cvt_pk_bf16(sp[2 * 65], sp[3 * 65]); o.z = cvt_pk_bf16(sp[4 * 65], sp[5 * 65]); o.w = cvt_pk_bf16(sp[6 * 65], sp[7 * 65]);
        *(u32x4*)(WT + (size_t)(n0 + n) * K + k0 + 8 * c) = o; }
    LDS_WAIT();
}
template <bool OUT_BF16> __device__ __forceinline__ void ln_row(const float* xrow, const float* g, const float* b, void* orow, int lane) {
    const f32x4* xr = (const f32x4*)xrow + lane; f32x4 v[8]; float s = 0.f;
#pragma unroll
    for (int j = 0; j < 8; ++j) { v[j] = __builtin_nontemporal_load(xr + 64 * j); s += (v[j][0] + v[j][1]) + (v[j][2] + v[j][3]); }
    const float mean = wave_sum(s) * (1.f / DM); float s2 = 0.f;
#pragma unroll
    for (int j = 0; j < 8; ++j) { v[j] = v[j] - mean; s2 += (v[j][0] * v[j][0] + v[j][1] * v[j][1]) + (v[j][2] * v[j][2] + v[j][3] * v[j][3]); }
    const float rstd = 1.0f / sqrtf(wave_sum(s2) * (1.f / DM) + LN_EPS);
#pragma unroll
    for (int j = 0; j < 8; ++j) { const f32x4 gg = ((const f32x4*)g)[lane + 64 * j], bb = ((const f32x4*)b)[lane + 64 * j]; const f32x4 o = v[j] * rstd * gg + bb;
        if (OUT_BF16) { u32x2 w; w.x = cvt_pk_bf16(o[0], o[1]); w.y = cvt_pk_bf16(o[2], o[3]); ((u32x2*)orow)[lane + 64 * j] = w; }
        else ((f32x4*)orow)[lane + 64 * j] = o; }
}
__device__ __forceinline__ void cpow(float lrs, float th, int j, float& re, float& im) {
    double a = (double)j * (double)th * 0.15915494309189535; a -= rint(a); const float af = 2.0f * (float)a;
    const float mag = expf((float)j * lrs); re = mag * cospif(af); im = mag * sinpif(af);
}


#ifndef NAIVE_RG
#define NAIVE_RG 0
#endif
__device__ __forceinline__ void naive_rg_channel(const RgCtx& R, int c) {
    const int gcol = (c >> 6) * 256 + (c & 63);
    const float w0 = R.convw[c], w1 = R.convw[1024 + c], w2 = R.convw[2048 + c], w3 = R.convw[3072 + c], cb = R.convb[c], sp0 = R.sp[c], sp1 = R.sp[1024 + c];
    const bf16_t* xp = R.XR + c; float h = 0.f;
    for (int t = 0; t < SEQ; ++t) { const float xc = cb + w0 * bfu(xp[(size_t)t * 1024]) + w1 * bfu(xp[(size_t)(t + 1) * 1024]) + w2 * bfu(xp[(size_t)(t + 2) * 1024]) + w3 * bfu(xp[(size_t)(t + 3) * 1024]);
        const bf16_t* g = g_row(R, t) + gcol; float a, b; rg_gate(bfu(g[0]), bfu(g[128]), sp0, xc, a, b); h = a * h + b;
        R.ypre[(size_t)t * 2048 + 1024 + c] = (bf16_t)(cvt_pk_bf16(h, 0.f) & 0xffffu); }
    __builtin_amdgcn_fence(__ATOMIC_SEQ_CST, "agent");
    h = 0.f;
    for (int t = SEQ - 1; t >= 0; --t) { const float xc = cb + w0 * bfu(xp[(size_t)t * 1024]) + w1 * bfu(xp[(size_t)(t + 1) * 1024]) + w2 * bfu(xp[(size_t)(t + 2) * 1024]) + w3 * bfu(xp[(size_t)(t + 3) * 1024]);
        const bf16_t* g = g_row(R, t) + gcol; float a, b; rg_gate(bfu(g[64]), bfu(g[192]), sp1, xc, a, b); h = a * h + b;
        const size_t o = (size_t)t * 2048 + 1024 + c; const float y = (bfu(R.ypre[o]) + h) * gelu_tanh(bfu(R.Z[(size_t)t * 1024 + c]));
        R.ypre[o] = (bf16_t)(cvt_pk_bf16(y, 0.f) & 0xffffu); }
}

#ifndef NAIVE_S5
#define NAIVE_S5 0
#endif
__device__ __forceinline__ void naive_s5_group(const float* const* in, const bf16_t* U, float* tmp, bf16_t* YG, int g, int lane) {
    const float *lre = in[6], *lim = in[7], *lstep = in[8], *bre = in[9], *bim = in[10], *cre = in[11], *cim = in[12], *dd = in[13];
    for (int n = 0; n < 2; ++n) {
        const int p = lane, pi = (n * 64 + g) * 64 + p;
        const float lr = fminf(lre[pi], -1e-4f), li = lim[pi], step = expf(lstep[n * 64 + g]); float ar, ai; cpow(lr * step, li * step, 1, ar, ai);
        const float nr = ar - 1.0f, ni = ai, den = lr * lr + li * li; const float qr = (nr * lr + ni * li) / den, qi = (ni * lr - nr * li) / den;
        float hr = 0.f, hi = 0.f;
        for (int tt = 0; tt < SEQ; ++tt) { const int t = n == 0 ? tt : SEQ - 1 - tt; const bf16_t* up = U + (size_t)t * 1024 + g * 16;
            float bur = 0.f, bui = 0.f;
#pragma unroll
            for (int k = 0; k < 16; ++k) { const float uv = bfu(up[k]); const float br = bre[(size_t)pi * 16 + k], bi = bim[(size_t)pi * 16 + k]; bur += (qr * br - qi * bi) * uv; bui += (qr * bi + qi * br) * uv; }
            const float nhr = ar * hr - ai * hi + bur, nhi = ar * hi + ai * hr + bui; hr = nhr; hi = nhi;
#pragma unroll
            for (int k = 0; k < 16; ++k) { const size_t ci = ((size_t)(n * 64 + g) * 16 + k) * 64 + p; float v = cre[ci] * hr - cim[ci] * hi; v = wave_sum(v);
                if (lane == k) { const size_t o = (size_t)t * 1024 + g * 16 + k;
                    if (n == 0) tmp[o] = v; else { const float y = tmp[o] + v + dd[g * 16 + k] * bfu(up[k]); YG[o] = (bf16_t)(cvt_pk_bf16(gelu_tanh(y), 0.f) & 0xffffu); } } }
        }
        __builtin_amdgcn_fence(__ATOMIC_SEQ_CST, "agent");
    }
}

#define XB_TMO      128
#define XB_XCNT(j)  (256  + 64 * (j))
#define XB_XSUB(j)  (1280 + 64 * (j))
#define XB_XGEN(j)  (2304 + 64 * (j))
#define XB_TOP      3328
#define XB_TOPGEN   3392
#define XCD_BAR_WORDS 3456
#define XB_SPIN_CAP (1u << 18)
__device__ __forceinline__ unsigned xb_ld(unsigned* p)              { return __hip_atomic_load(p, __ATOMIC_RELAXED, __HIP_MEMORY_SCOPE_AGENT); }
__device__ __forceinline__ unsigned xb_add(unsigned* p, unsigned v) { return __hip_atomic_fetch_add(p, v, __ATOMIC_RELAXED, __HIP_MEMORY_SCOPE_AGENT); }
__device__ __forceinline__ unsigned xb_xcc_id() { return (unsigned)__builtin_amdgcn_s_getreg((3 << 11) | 20) & 0xFu; }
#define XB_SPIN(cond, bar) do { unsigned _sp = 0; while (cond) { __builtin_amdgcn_s_sleep(1); \
    if ((++_sp & 255u) == 0u) { if (xb_ld(&(bar)[XB_TMO])) break; if (_sp > XB_SPIN_CAP) { atomicAdd(&(bar)[XB_TMO], 1u); break; } } } } while (0)
struct XcdBarrier { unsigned* bar; unsigned x; volatile LAS unsigned* st; };
__device__ __forceinline__ void xcd_barrier_complete(unsigned* bar, unsigned x, unsigned G, unsigned& nloc, unsigned& nx) {
    unsigned sum, cnt, mine, sp = 0u;
    for (;;) {
        sum = 0u; cnt = 0u; mine = 0u;
#pragma unroll
        for (unsigned j = 0; j < 16; ++j) { const unsigned c = xb_ld(&bar[XB_XCNT(j)]); sum += c; cnt += (c > 0u) ? 1u : 0u; mine = (j == x) ? c : mine; }
        if (sum == G) break;
        __builtin_amdgcn_s_sleep(1);
        if ((++sp & 255u) == 0u) { if (xb_ld(&bar[XB_TMO])) break; if (sp > XB_SPIN_CAP) { atomicAdd(&bar[XB_TMO], 1u); break; } }
    }
    nloc = mine > 0u ? mine : 1u; nx = cnt > 0u ? cnt : 1u;
}
__device__ __forceinline__ void xcd_barrier(const XcdBarrier& b, unsigned G, int wave) {
    asm volatile("s_waitcnt vmcnt(0)" ::: "memory");
    __syncthreads();
    if (wave == 0) { if (fresh_lane() == 0) {
        unsigned* bar = b.bar;
        __builtin_amdgcn_s_waitcnt(0);
        unsigned nloc = b.st[0], nx = b.st[1];
        if (nloc == 0u) { xcd_barrier_complete(bar, b.x, G, nloc, nx); b.st[0] = nloc; b.st[1] = nx; }
        const unsigned old = xb_add(&bar[XB_XSUB(b.x)], 1u);
        const unsigned gen = old / nloc;
        if (old + 1u == (gen + 1u) * nloc) {
            __builtin_amdgcn_fence(__ATOMIC_RELEASE, "agent");
            asm volatile("s_waitcnt vmcnt(0)" ::: "memory");
            const unsigned og = xb_add(&bar[XB_TOP], 1u);
            const unsigned tg = og / nx;
            if (og + 1u == (tg + 1u) * nx) xb_add(&bar[XB_TOPGEN], 1u);
            else XB_SPIN(xb_ld(&bar[XB_TOPGEN]) == tg, bar);
            __builtin_amdgcn_fence(__ATOMIC_ACQUIRE, "agent");
            xb_add(&bar[XB_XGEN(b.x)], 1u);
            asm volatile("s_waitcnt vmcnt(0)" ::: "memory");
        } else {
            XB_SPIN(xb_ld(&bar[XB_XGEN(b.x)]) == gen, bar);
            __builtin_amdgcn_fence(__ATOMIC_ACQUIRE, "agent");
            asm volatile("s_waitcnt vmcnt(0)" ::: "memory");
        }
    } }
    __syncthreads();
}

__device__ __forceinline__ void grid_barrier(unsigned* bar, unsigned target, int wave) {
    asm volatile("s_waitcnt vmcnt(0)" ::: "memory");
    __syncthreads();
    if (wave == 0) { const int l = fresh_lane();
        if (l == 0) {
            __builtin_amdgcn_fence(__ATOMIC_RELEASE, "agent"); asm volatile("s_waitcnt vmcnt(0)" ::: "memory");
            __hip_atomic_fetch_add(bar, 1u, __ATOMIC_RELAXED, __HIP_MEMORY_SCOPE_AGENT);
            while (__hip_atomic_load(bar, __ATOMIC_RELAXED, __HIP_MEMORY_SCOPE_AGENT) < target) __builtin_amdgcn_s_sleep(2);
            __builtin_amdgcn_fence(__ATOMIC_ACQUIRE, "agent"); asm volatile("s_waitcnt vmcnt(0)" ::: "memory");
        } }
    __syncthreads();
}

struct Args { const float* in[38]; float* out; unsigned char* ws; int ph_lo, ph_hi; };
typedef const float* cfp_t;
typedef const __attribute__((address_space(4))) cfp_t* kin_t;

__device__ __forceinline__ void s5_precompute(const kin_t ain, unsigned char* aws, int g, int hq, int nh, LAS float* L, const int tid) {
    const float *lre = ain[6], *lim = ain[7], *lstep = ain[8], *bre = ain[9], *bim = ain[10], *cre = ain[11], *cim = ain[12], *dd = ain[13];
    LAS float *PWre = L, *PWim = L + 4224, *BBre = L + 8448, *BBim = L + 10496, *CCre = L + 12544, *CCim = L + 14592, *MT = L + 16640, *C2re = L + 33280, *C2im = L + 35328, *Dl = L + 37376;
    bf16_t* WGg = (bf16_t*)(aws + WS_WG) + (size_t)g * 768 * 512; bf16_t* WCg = (bf16_t*)(aws + WS_WC) + (size_t)g * 512 * 256;
#define PSTAMP(i) do { if (TSTAMP && blockIdx.x == 128 && tid == 0) ((unsigned long long*)(aws + WS_CTR + 1024))[i] = __builtin_amdgcn_s_memrealtime(); } while (0)
    PSTAMP(20);
    {
        const int np = tid & 127, jj = tid >> 7, n = np >> 6, p = np & 63; const int pi = (n * 64 + g) * 64 + p;
        const float lr = fminf(lre[pi], -1e-4f), li = lim[pi], step = expf(lstep[n * 64 + g]); const float lrs = lr * step, th = li * step;
        for (int j = jj; j <= 32; j += 4) { float r, i; cpow(lrs, th, j, r, i); PWre[np * 33 + j] = r; PWim[np * 33 + j] = i; }
        float l1r, l1i; cpow(lrs, th, 1, l1r, l1i);
        const float nr = l1r - 1.0f, ni = l1i, den = lr * lr + li * li; const float qr = (nr * lr + ni * li) / den, qi = (ni * lr - nr * li) / den;
#pragma unroll
        for (int k = jj * 4; k < jj * 4 + 4; ++k) { const float br = bre[(size_t)pi * 16 + k], bi = bim[(size_t)pi * 16 + k]; BBre[np * 16 + k] = qr * br - qi * bi; BBim[np * 16 + k] = qr * bi + qi * br; }
        for (int e = tid; e < 2048; e += 512) { const int n2 = e >> 10, k = (e >> 6) & 15, p2 = e & 63; const size_t ci = ((size_t)(n2 * 64 + g) * 16 + k) * 64 + p2; CCre[(n2 * 64 + p2) * 16 + k] = cre[ci]; CCim[(n2 * 64 + p2) * 16 + k] = cim[ci]; C2re[e] = cre[ci]; C2im[e] = cim[ci]; }
        if (tid < 16) Dl[tid] = dd[g * 16 + tid];
    }
    __syncthreads();
    PSTAMP(21);
    for (int i = 0; i < 3; ++i) {
        if (nh == 2) { if (i < 2 && i != hq) continue; if (i == 2 && (hq != 0 || tid >= 16)) continue; } else if (i == 2) continue;
        const int bq = (i == 2) ? 512 + tid : tid + 512 * i, n = bq >> 9, j = (bq >> 4) & 31, kob = (bq >> 2) & 3, kib = bq & 3;
        f32x4 m0 = {0.f, 0.f, 0.f, 0.f}, m1 = m0, m2 = m0, m3 = m0;
        for (int p = 0; p < 64; ++p) { const int np = n * 64 + p; const float pr = PWre[np * 33 + j], pi2 = PWim[np * 33 + j];
            const f32x4 br = *(const LAS f32x4*)(BBre + np * 16 + 4 * kib), bi = *(const LAS f32x4*)(BBim + np * 16 + 4 * kib), cr = *(const LAS f32x4*)(CCre + np * 16 + 4 * kob), ci = *(const LAS f32x4*)(CCim + np * 16 + 4 * kob);
            const f32x4 er = pr * br - pi2 * bi, ei = pr * bi + pi2 * br;
            m0 += cr[0] * er - ci[0] * ei; m1 += cr[1] * er - ci[1] * ei; m2 += cr[2] * er - ci[2] * ei; m3 += cr[3] * er - ci[3] * ei; }
        LAS float* o = MT + (n * 32 + j) * 260 + (4 * kob) * 16 + 4 * kib;
        *(LAS f32x4*)o = m0; *(LAS f32x4*)(o + 16) = m1; *(LAS f32x4*)(o + 32) = m2; *(LAS f32x4*)(o + 48) = m3;
    }
    __syncthreads();
    PSTAMP(22);
    for (int i = 0; i < 64; ++i) {
        const int idx = tid + 512 * i, row = idx >> 6, cp = idx & 63, t = row >> 4, ko = row & 15, s = cp >> 1, ki0 = (cp & 1) * 8;
        if (nh == 2 && ((t >= s) != (hq == 0))) continue;
        f32x4 v0, v1;
        if (t != s) { const LAS float* src = MT + ((t > s ? 0 : 1) * 32 + (t > s ? t - s : s - t)) * 260 + ko * 16 + ki0; v0 = *(const LAS f32x4*)src; v1 = *(const LAS f32x4*)(src + 4); }
        else { const LAS float* s0 = MT + ko * 16 + ki0; const LAS float* s1 = MT + 32 * 260 + ko * 16 + ki0; v0 = *(const LAS f32x4*)s0 + *(const LAS f32x4*)s1; v1 = *(const LAS f32x4*)(s0 + 4) + *(const LAS f32x4*)(s1 + 4);
            const float dv = Dl[ko];
#pragma unroll
            for (int e = 0; e < 4; ++e) { if (ki0 + e == ko) v0[e] += dv; if (ki0 + 4 + e == ko) v1[e] += dv; } }
        u32x4 w; w.x = cvt_pk_bf16(v0[0], v0[1]); w.y = cvt_pk_bf16(v0[2], v0[3]); w.z = cvt_pk_bf16(v1[0], v1[1]); w.w = cvt_pk_bf16(v1[2], v1[3]);
        *(u32x4*)(WGg + (size_t)row * 512 + cp * 8) = w;
    }
    for (int i = hq * (32 / nh); i < (hq + 1) * (32 / nh); ++i) {
        const int idx = tid + 512 * i, q = idx >> 6, cp = idx & 63, n = q >> 7, ri = (q >> 6) & 1, p = q & 63, s = cp >> 1, ki0 = (cp & 1) * 8, e = n == 0 ? 31 - s : s, np = n * 64 + p;
        const float pr = PWre[np * 33 + e], pi2 = PWim[np * 33 + e]; float v[8];
#pragma unroll
        for (int k = 0; k < 8; ++k) { const float br = BBre[np * 16 + ki0 + k], bi = BBim[np * 16 + ki0 + k]; v[k] = ri == 0 ? pr * br - pi2 * bi : pr * bi + pi2 * br; }
        u32x4 w; w.x = cvt_pk_bf16(v[0], v[1]); w.y = cvt_pk_bf16(v[2], v[3]); w.z = cvt_pk_bf16(v[4], v[5]); w.w = cvt_pk_bf16(v[6], v[7]);
        *(u32x4*)(WGg + (size_t)(512 + q) * 512 + cp * 8) = w;
    }
    for (int i = 0; i < 32 / nh; ++i) {
        const int idx = tid + 512 * i, row = nh == 2 ? idx >> 4 : idx >> 5, q0 = nh == 2 ? hq * 128 + (idx & 15) * 8 : (idx & 31) * 8, n = q0 >> 7, ri = (q0 >> 6) & 1, p0 = q0 & 63, t = row >> 4, ko = row & 15, e = n == 0 ? t + 1 : 32 - t; float v[8];
#pragma unroll
        for (int k = 0; k < 8; ++k) { const int np = n * 64 + p0 + k; const float cr = C2re[(n * 16 + ko) * 64 + p0 + k], ci = C2im[(n * 16 + ko) * 64 + p0 + k], pr = PWre[np * 33 + e], pi2 = PWim[np * 33 + e];
            v[k] = ri == 0 ? cr * pr - ci * pi2 : -(cr * pi2 + ci * pr); }
        u32x4 w; w.x = cvt_pk_bf16(v[0], v[1]); w.y = cvt_pk_bf16(v[2], v[3]); w.z = cvt_pk_bf16(v[4], v[5]); w.w = cvt_pk_bf16(v[6], v[7]);
        *(u32x4*)(WCg + (size_t)row * 256 + q0) = w;
    }
    __syncthreads();
    PSTAMP(23);
}


#ifndef DIAG
#define DIAG 0
#endif
__device__ __forceinline__ void diag_ffn(const float* const* in, const unsigned char* ws, const float* outp, unsigned* flagw, int gtid, int GT) {
    const bf16_t* h1 = (const bf16_t*)(ws + WS_HB); const bf16_t* T = (const bf16_t*)(ws + WS_T); const float* V2 = (const float*)(ws + WS_V2);
    const float *w1 = in[29], *b1 = in[30], *w2 = in[31], *b2 = in[32], *wp = in[33], *wg = in[34], *bg = in[35], *pp = in[1];
    for (int sidx = gtid; sidx < 16384; sidx += GT) {
        unsigned hsh = (unsigned)sidx * 2654435761u, h2 = ((unsigned)sidx + 977u) * 2246822519u; const int r = (hsh >> 8) % SEQ; const int c = (h2 >> 6) % DFF; const int c2 = c % DM;
        float a = b1[c]; for (int k = 0; k < DM; ++k) a += bfu(h1[(size_t)r * DM + k]) * w1[(size_t)k * DFF + c];
        a = fmaxf(a, 0.f); a = a * a; const float tv = bfu(T[(size_t)r * DFF + c]);
        if (fabsf(tv - a) > 0.008f * fabsf(a) + 0.006f) atomicAdd(flagw + 0, 1u);
        float f = b2[c2]; for (int k = 0; k < DFF; ++k) f += bfu(T[(size_t)r * DFF + k]) * w2[(size_t)k * DM + c2];
        float gt = bg[c2]; for (int k = 0; k < DM; ++k) gt += bfu(h1[(size_t)r * DM + k]) * wg[(size_t)k * DM + c2];
        float pw = 0.f; for (int k = 0; k < PLE; ++k) pw += pp[(size_t)r * PLE + k] * wp[(size_t)k * DM + c2];
        const float v2 = DN_ALPHA * bfu(h1[(size_t)r * DM + c2]) + f + fast_sigmoid(gt) * pw; const float got = V2[(size_t)r * DM + c2];
        if (fabsf(got - v2) > 0.008f * fabsf(v2) + 0.006f) atomicAdd(flagw + 1, 1u);
        { const float* vr = V2 + (size_t)r * DM; float m = 0.f; for (int k = 0; k < DM; ++k) m += vr[k]; m /= DM; float v = 0.f; for (int k = 0; k < DM; ++k) { const float d = vr[k] - m; v += d * d; } v /= DM;
          const float e = (vr[c2] - m) / sqrtf(v + LN_EPS) * in[36][c2] + in[37][c2]; const float go = outp[(size_t)r * DM + c2]; if (fabsf(go - e) > 0.004f * fabsf(e) + 0.003f) atomicAdd(flagw + 2, 1u); }
    }
}

__device__ __forceinline__ void diag_pre(const float* const* in, const unsigned char* ws, const unsigned char* dout, unsigned* flagw, int gtid, int GT) {
    const bf16_t* h0 = (const bf16_t*)(ws + WS_HB); const bf16_t* U = (const bf16_t*)(dout + DO_U); const bf16_t* XRb = (const bf16_t*)(ws + WS_XR) + 2048; const bf16_t* Z = (const bf16_t*)(dout + DO_Z);
    const bf16_t* ypre = (const bf16_t*)(dout + DO_YPRE); const bf16_t* ycat = (const bf16_t*)(ws + WS_YCAT); const bf16_t* yg = (const bf16_t*)(ws + WS_YS5G);
    const float *x = in[0], *lg = in[2], *lb = in[3], *win = in[4], *bin = in[5], *gw_ = in[14], *gb = in[15], *g5 = in[23], *gr = in[24];
    for (int sidx = gtid; sidx < 8192; sidx += GT) {
        unsigned hsh = (unsigned)sidx * 2654435761u, h2 = ((unsigned)sidx + 977u) * 2246822519u; const int r = (hsh >> 8) % SEQ; const int c = (h2 >> 6) % DIN; const int c2 = c % DM; const int c1 = c % DS5;
        { float m = 0.f; for (int k = 0; k < DM; ++k) m += x[(size_t)r * DM + k]; m /= DM; float v = 0.f; for (int k = 0; k < DM; ++k) { const float d = x[(size_t)r * DM + k] - m; v += d * d; } v /= DM;
          const float e = (x[(size_t)r * DM + c2] - m) / sqrtf(v + LN_EPS) * lg[c2] + lb[c2]; const float got = bfu(h0[(size_t)r * DM + c2]); if (fabsf(got - e) > 0.008f * fabsf(e) + 0.006f) atomicAdd(flagw + 0, 1u); }
        { float a = bin[c]; for (int k = 0; k < DM; ++k) a += bfu(h0[(size_t)r * DM + k]) * win[(size_t)k * DIN + c];
          const float got = c < 1024 ? bfu(U[(size_t)r * 1024 + c]) : (c < 2048 ? bfu(XRb[(size_t)r * 1024 + c - 1024]) : bfu(Z[(size_t)r * 1024 + c - 2048])); if (fabsf(got - a) > 0.008f * fabsf(a) + 0.006f) atomicAdd(flagw + 3, 1u); }
        { const int hf = c2 >> 10; float ss = 0.f; for (int k = 0; k < 1024; ++k) { const float y = bfu(ypre[(size_t)r * DM + hf * 1024 + k]); ss += y * y; }
          const float e = bfu(ypre[(size_t)r * DM + c2]) / sqrtf(ss / 1024.f + LN_EPS) * (hf ? gr[c2 - 1024] : g5[c2]); const float got = bfu(ycat[(size_t)r * DM + c2]); if (fabsf(got - e) > 0.008f * fabsf(e) + 0.006f) atomicAdd(flagw + 1, 1u); }
        { float a = gb[c1]; for (int k = 0; k < DS5; ++k) a += bfu(yg[(size_t)r * DS5 + k]) * gw_[(size_t)k * DS5 + c1];
          const float e = bfu(yg[(size_t)r * DS5 + c1]) * fast_sigmoid(a); const float got = bfu(ypre[(size_t)r * DM + c1]); if (fabsf(got - e) > 0.008f * fabsf(e) + 0.006f) atomicAdd(flagw + 2, 1u); }
    }
}

__device__ __forceinline__ void diag_v(const float* const* in, const unsigned char* ws, const unsigned char* dout, unsigned* flagw, int gtid, int GT) {
    const bf16_t* h0 = (const bf16_t*)(ws + WS_HB); const bf16_t* ycat = (const bf16_t*)(ws + WS_YCAT); const float* V = (const float*)dout; const float *wo = in[25], *bo = in[26];
    for (int sidx = gtid; sidx < 16384; sidx += GT) { unsigned hsh = (unsigned)sidx * 2654435761u, h2 = ((unsigned)sidx + 977u) * 2246822519u; const int r = (hsh >> 8) % SEQ; const int c = (h2 >> 6) % DM;
        float a = bo[c] + DN_ALPHA * bfu(h0[(size_t)r * DM + c]); for (int k = 0; k < DM; ++k) a += bfu(ycat[(size_t)r * DM + k]) * wo[(size_t)k * DM + c];
        const float got = V[(size_t)r * DM + c]; if (fabsf(got - a) > 0.008f * fabsf(a) + 0.006f) atomicAdd(flagw + 0, 1u); }
}

__device__ __forceinline__ void diag_g(const float* const* in, const unsigned char* ws, unsigned* flagw, int gtid, int GT) {
    const bf16_t* XRp = (const bf16_t*)(ws + WS_XR); const bf16_t* G0 = (const bf16_t*)(ws + WS_G0); const bf16_t* G1 = (const bf16_t*)(ws + WS_G1);
    const float *convw = in[16], *convb = in[17], *wa = in[18], *ba = in[19], *wx = in[20], *bxx = in[21];
    for (int sidx = gtid; sidx < 16384; sidx += GT) { unsigned hsh = (unsigned)sidx * 2654435761u; unsigned h2 = ((unsigned)sidx + 12345u) * 2246822519u; const int t = (hsh >> 7) % SEQ; const int col = (h2 >> 5) % 4096;
        const int h = col >> 8, row = col & 255, bj = row >> 7, dir = (row >> 6) & 1, ch = row & 63;
        const float* W = (bj == 0 ? wa : wx) + ((size_t)(dir * 16 + h) * 64) * 64 + ch; float a = (bj == 0 ? ba : bxx)[(dir * 16 + h) * 64 + ch];
        for (int i = 0; i < 64; ++i) { const int c = 64 * h + i; float xc = convb[c];
            for (int j = 0; j < 4; ++j) xc += convw[j * 1024 + c] * bfu(XRp[(size_t)(t + j) * 1024 + c]);
            a += xc * W[(size_t)i * 64]; }
        const float got = bfu((t < 4096 ? G0 : G1)[(size_t)(t & 4095) * 4096 + col]);
        if (fabsf(got - a) > 0.008f * fabsf(a) + 0.006f) atomicAdd(flagw + 0, 1u); }
}

#ifndef DIAG_HALF
#define DIAG_HALF 1
#endif
__device__ __forceinline__ void diag_max(const unsigned char* ws, unsigned* flagw, int gtid, int GT) {
    const bf16_t* ycat = (const bf16_t*)(ws + WS_YCAT); float mx = 0.f;
    for (size_t i = gtid; i < (size_t)SEQ * 1024; i += GT) { const size_t r = i >> 10, c = (i & 1023) + DIAG_HALF * 1024; mx = fmaxf(mx, fabsf(bfu(ycat[r * DM + c]))); }
    atomicMax(flagw + 0, __float_as_uint(mx));
}

#ifndef DIAG_SEL
#define DIAG_SEL 4
#endif
__device__ __forceinline__ void diag_rows(const float* outp, unsigned* flagw, int gw, int NGW, int lane) {
    for (int row = gw; row < SEQ; row += NGW) { float mx = 0.f; for (int j = lane; j < DM; j += 64) mx = fmaxf(mx, fabsf(outp[(size_t)row * DM + j]));
#pragma unroll
        for (int o = 1; o < 64; o <<= 1) mx = fmaxf(mx, __shfl_xor(mx, o));
        if (lane == 0 && mx > 12.0f) { atomicAdd(flagw + 0, 1u); atomicMin(flagw + 1, (unsigned)row); atomicMax(flagw + 2, (unsigned)row); } }
}

__device__ __forceinline__ void diag_rows_bf(const bf16_t* p, int ld, float thr, unsigned* flagw, int gw, int NGW, int lane) {
    for (int row = gw; row < SEQ; row += NGW) { float mx = 0.f; for (int j = lane; j < ld; j += 64) mx = fmaxf(mx, fabsf(bfu(p[(size_t)row * ld + j])));
#pragma unroll
        for (int o = 1; o < 64; o <<= 1) mx = fmaxf(mx, __shfl_xor(mx, o));
        if (lane == 0 && mx > thr) { atomicAdd(flagw + 0, 1u); atomicMin(flagw + 1, (unsigned)row); atomicMax(flagw + 2, (unsigned)row); } }
}
template <int PHMASK> __global__ void __launch_bounds__(512, 2) mega(Args) {
    extern __shared__ __attribute__((aligned(16))) unsigned char lds_raw[];
    LAS unsigned char* lds = (LAS unsigned char*)lds_raw;
    const int wave = __builtin_amdgcn_readfirstlane((int)threadIdx.x >> 6);
    const int G = gridDim.x, bx = blockIdx.x;
    const int gw = bx * 8 + wave, NGW = G * 8, GT = G * 512;
#define PH_IDS const int lane = fresh_lane(), tid = wave * 64 + lane, gtid = bx * 512 + tid; (void)tid; (void)gtid; (void)lane
    const kin_t KIN = (kin_t)__builtin_amdgcn_kernarg_segment_ptr();
    unsigned char* ws = (unsigned char*)KIN[39]; unsigned char* dout = (unsigned char*)KIN[38];
    const int* kint = (const int*)0; (void)kint;
#if DIAG == 2
    const int lo = ((const __attribute__((address_space(4))) int*)KIN)[80], hi = 7;
#elif DIAG == 3
    const int lo = ((const __attribute__((address_space(4))) int*)KIN)[80], hi = 8;
#elif DIAG == 4
    const int lo = ((const __attribute__((address_space(4))) int*)KIN)[80], hi = 5;
#elif DIAG == 6
    const int lo = ((const __attribute__((address_space(4))) int*)KIN)[80], hi = 7;
#elif DIAG == 8
    const int lo = ((const __attribute__((address_space(4))) int*)KIN)[80], hi = 9;
#elif DIAG == 11 || DIAG == 12
    const int lo = ((const __attribute__((address_space(4))) int*)KIN)[80], hi = 10;
#else
    const int lo = ((const __attribute__((address_space(4))) int*)KIN)[80], hi = ((const __attribute__((address_space(4))) int*)KIN)[81];
#endif
#define IN(k) (((PHMASK >> (k)) & 1) && lo <= (k) && (k) < hi)
    unsigned nbar = 0; unsigned* gbar = (unsigned*)(ws + WS_CTR) + 32; (void)gbar;
    XcdBarrier xb; xb.bar = (unsigned*)(ws + WS_CTR) + 5120; xb.x = xb_xcc_id(); xb.st = (volatile LAS unsigned*)(lds + 155000);
    if (wave == 0) { if (fresh_lane() == 0) { xb.st[0] = 0u; xb.st[1] = 0u; (void)xb_add(&xb.bar[XB_XCNT(xb.x)], 1u); } }
    __syncthreads();
    if (PHMASK == 0xfff && hi > 4096) cg::this_grid().sync();
#ifndef DBL_MASK
#define DBL_MASK 0
#endif
#define REPS(k) (((DBL_MASK >> (k)) & 1) ? 2 : 1)
#define SEAM(k) do { if (IN(k) && IN((k) + 1)) { ++nbar; xcd_barrier(xb, (unsigned)G, wave); if (TSTAMP && bx == 0 && wave == 0) { if (fresh_lane() == 0) ((unsigned long long*)(ws + WS_CTR + 1024))[(k) + 1] = __builtin_amdgcn_s_memrealtime(); } } } while (0)

#define MK_RG const RgCtx RG{(const bf16_t*)(ws + WS_XR), (const bf16_t*)(ws + WS_G0), (const bf16_t*)(ws + WS_G1), (const bf16_t*)(dout + DO_Z), KIN[16], KIN[17], (const float*)(ws + WS_SP), (float*)(ws + WS_AGG), (bf16_t*)(dout + DO_YPRE)}
    if (TSTAMP && bx == 0 && wave == 0) { if (fresh_lane() == 0) ((unsigned long long*)(ws + WS_CTR + 1024))[0] = __builtin_amdgcn_s_memrealtime(); }
    for (int rep = 0; rep < REPS(0); ++rep) {
    if (IN(0)) { PH_IDS;
        if (G != 256) { for (int g = bx; g < 64; g += G) s5_precompute(KIN, ws, g, 0, 1, (LAS float*)lds, tid); }
        {
            LAS float* scr = (LAS float*)(lds + wave * 16640);
            constexpr int I_IN = (DM / 64) * (DIN / 64), I_OUT = (DM / 64) * (DM / 64), I_PG = I_OUT, I_GLU = (DS5 / 64) * (DS5 / 64), I_PW = (PLE / 64) * (DM / 64), I_LN = SEQ / 4;
            constexpr int NITEMS = I_IN + I_OUT + I_PG + I_GLU + I_PW + I_LN;
            for (int it = gw; it < NITEMS; it += NGW) {
                int r = it;
                if (r < I_IN) { transpose_item(KIN[4], DM, DIN, (bf16_t*)(ws + WS_WINT), scr, r, lane); continue; } r -= I_IN;
                if (r < I_LN) { for (int q = 0; q < 4; ++q) { const int row = r * 4 + q; ln_row<true>(KIN[0] + (size_t)row * DM, KIN[2], KIN[3], (bf16_t*)(ws + WS_HB) + (size_t)row * DM, lane); } continue; } r -= I_LN;
                if (r < I_OUT) { transpose_item(KIN[25], DM, DM, (bf16_t*)(ws + WS_WOUTT), scr, r, lane); continue; } r -= I_OUT;
                if (r < I_PG) { transpose_item(KIN[34], DM, DM, (bf16_t*)(ws + WS_PLEGT), scr, r, lane); continue; } r -= I_PG;
                if (r < I_GLU) { transpose_item(KIN[14], DS5, DS5, (bf16_t*)(ws + WS_GLUT), scr, r, lane); continue; } r -= I_GLU;
                transpose_item(KIN[33], PLE, DM, (bf16_t*)(ws + WS_PLEWT), scr, r, lane);
            }
        }
        {   const float* pp = KIN[1]; bf16_t* pb = (bf16_t*)(ws + WS_PB);
            for (int i = gtid; i < SEQ * PLE / 4; i += GT) { const f32x4 v = __builtin_nontemporal_load((const f32x4*)pp + i); u32x2 w; w.x = cvt_pk_bf16(v[0], v[1]); w.y = cvt_pk_bf16(v[2], v[3]); ((u32x2*)pb)[i] = w; }
            const float *convw = KIN[16], *convb = KIN[17], *wa = KIN[18], *ba = KIN[19], *wx = KIN[20], *bxx = KIN[21], *lam = KIN[22];
            bf16_t* rgw = (bf16_t*)(ws + WS_RGW);
            for (int i = gtid; i < 16 * 256 * 32; i += GT) { const int h = i >> 13, row = (i >> 5) & 255, K0 = (i & 31) * 8, j = K0 >> 6, i0 = K0 & 63, ch = row >> 2, bj = (row >> 1) & 1, dir = row & 1;
                const float* W = (bj == 0 ? wa : wx) + ((size_t)(dir * 16 + h) * 64) * 64 + ch; float v[8];
#pragma unroll
                for (int k = 0; k < 8; ++k) v[k] = convw[j * 1024 + 64 * h + i0 + k] * W[(size_t)(i0 + k) * 64];
                u32x4 w; w.x = cvt_pk_bf16(v[0], v[1]); w.y = cvt_pk_bf16(v[2], v[3]); w.z = cvt_pk_bf16(v[4], v[5]); w.w = cvt_pk_bf16(v[6], v[7]);
                *(u32x4*)(rgw + ((size_t)h * 256 + row) * 256 + K0) = w; }
            float* rgb = (float*)(ws + WS_RGBIAS);
            for (int i = gtid; i < 16 * 256; i += GT) { const int h = i >> 8, row = i & 255, ch = row >> 2, bj = (row >> 1) & 1, dir = row & 1;
                const float* W = (bj == 0 ? wa : wx) + ((size_t)(dir * 16 + h) * 64) * 64 + ch; float s = (bj == 0 ? ba : bxx)[(dir * 16 + h) * 64 + ch];
#pragma unroll
                for (int k = 0; k < 64; ++k) s += convb[64 * h + k] * W[(size_t)k * 64];
                rgb[i] = s; }
            float* spt = (float*)(ws + WS_SP);
            for (int i = gtid; i < 2 * 1024; i += GT) spt[i] = -8.0f * log1pf(expf(-lam[i]));
            unsigned* xr = (unsigned*)(ws + WS_XR);
            for (int i = gtid; i < 1024; i += GT) { xr[i] = 0u; xr[(size_t)(SEQ + 2) * 512 + i] = 0u; }
        }
    }
    if (rep + 1 < REPS(0)) { ++nbar; xcd_barrier(xb, (unsigned)G, wave); } }
    SEAM(0);
    for (int rep = 0; rep < REPS(1); ++rep) {
    if (IN(1)) { PH_IDS;
        SchedStd S; S.so.init(SEQ, DIN, G, bx); S.A = (const char*)(ws + WS_HB); S.B = (const char*)(ws + WS_WINT); S.a_tile = (size_t)256 * DM * 2; S.b_tile = (size_t)256 * DM * 2;
        EpiProj E{(bf16_t*)(dout + DO_U), (bf16_t*)(ws + WS_XR), (bf16_t*)(dout + DO_Z), KIN[5]};
        GEMM_PHASE(lds, wave, GParm{DM, DM * 2, 128, 64, 0}, S, E);
        if (G == 256 && bx >= 128) { __syncthreads(); const int t2 = wave * 64 + fresh_lane(); s5_precompute(KIN, ws, (bx - 128) >> 1, (bx - 128) & 1, 2, (LAS float*)lds, t2); }
    }
    if (rep + 1 < REPS(1)) { ++nbar; xcd_barrier(xb, (unsigned)G, wave); } }
    SEAM(1);
    for (int rep = 0; rep < REPS(2); ++rep) {
    if (IN(2)) { PH_IDS;
        { SchedS5a S{(const char*)(dout + DO_U), (const char*)(ws + WS_WG), G, bx}; EpiS5a E{(bf16_t*)(ws + WS_YINTRA), (float*)(ws + WS_S)};
          GEMM_PHASE(lds, wave, GParm{512, 1024, 128, 64, 0}, S, E); }
        { SchedRG S{(const char*)(ws + WS_XR), (const char*)(ws + WS_RGW), G, bx}; EpiG E{(bf16_t*)(ws + WS_G0), (bf16_t*)(ws + WS_G1), (const float*)(ws + WS_RGBIAS)};
          GEMM_PHASE(lds, wave, GParm{256, 2048, 2048, 64, 0}, S, E); }
    }
    if (rep + 1 < REPS(2)) { ++nbar; xcd_barrier(xb, (unsigned)G, wave); } }
    SEAM(2);
    for (int rep = 0; rep < REPS(3); ++rep) {
    if (IN(3)) { PH_IDS;
        if (bx < 128) {
            const int g = bx >> 1, n = bx & 1; const float* Sg = (const float*)(ws + WS_S) + (size_t)g * NCH * 256 + n * 128; LAS float* Ls = (LAS float*)lds;
            for (int i = tid; i < NCH * 32; i += 512) { const int c = i >> 5, q4 = (i & 31) * 4; *(LAS f32x4*)(Ls + c * 128 + q4) = *(const f32x4*)(Sg + (size_t)c * 256 + q4); }
            __syncthreads();
            if (wave == 0) { const int p = lane, pi = (n * 64 + g) * 64 + p;
                const float lr = fminf(KIN[6][pi], -1e-4f), li = KIN[7][pi], step = expf(KIN[8][n * 64 + g]); float ar, ai; cpow(lr * step, li * step, TC, ar, ai);
                bf16_t* hp = (bf16_t*)(ws + WS_HPREV) + (size_t)g * NCH * 256 + n * 128; float hr = 0.f, him = 0.f;
                for (int cc = 0; cc < NCH; ++cc) { const int c = n == 0 ? cc : NCH - 1 - cc;
                    hp[(size_t)c * 256 + p] = (bf16_t)(cvt_pk_bf16(hr, 0.f) & 0xffffu); hp[(size_t)c * 256 + 64 + p] = (bf16_t)(cvt_pk_bf16(him, 0.f) & 0xffffu);
                    const float sr = Ls[c * 128 + p], si = Ls[c * 128 + 64 + p]; const float nr = ar * hr - ai * him + sr, ni = ar * him + ai * hr + si; hr = nr; him = ni; } }
            __syncthreads();
        }
        { MK_RG; for (int un = bx; un < 256; un += G) rg_pass_a(RG, un & 1, un >> 1, tid); }
    }
    if (rep + 1 < REPS(3)) { ++nbar; xcd_barrier(xb, (unsigned)G, wave); } }
    SEAM(3);
    for (int rep = 0; rep < REPS(4); ++rep) {
    if (IN(4)) { PH_IDS;
#if NAIVE_S5
        if (gw < 64) naive_s5_group((const float* const*)0, (const bf16_t*)(dout + DO_U), (float*)(ws + WS_YINTRA), (bf16_t*)(ws + WS_YS5G), gw, lane);
#else
        { SchedS5b S{(const char*)(ws + WS_HPREV), (const char*)(ws + WS_WC), G, bx}; EpiS5b E{(const bf16_t*)(ws + WS_YINTRA), (bf16_t*)(ws + WS_YS5G)};
          GEMM_PHASE(lds, wave, GParm{256, 512, 128, 64, 0}, S, E); }
#endif
#if NAIVE_RG
        { MK_RG; if (gtid < 1024) naive_rg_channel(RG, gtid); }
#else
        { MK_RG; __syncthreads(); for (int un = bx; un < 256; un += G) { rg_pass_c(RG, un & 1, un >> 1, tid, (LAS float*)lds); __syncthreads(); } }
#endif
    }
    if (rep + 1 < REPS(4)) { ++nbar; xcd_barrier(xb, (unsigned)G, wave); } }
    SEAM(4);
    for (int rep = 0; rep < REPS(5); ++rep) {
    if (IN(5)) { PH_IDS;
        SchedStd S; S.so.init(SEQ, DS5, G, bx); S.A = (const char*)(ws + WS_YS5G); S.B = (const char*)(ws + WS_GLUT); S.a_tile = (size_t)256 * 16 * 2; S.b_tile = (size_t)256 * DS5 * 2;
        EpiGlu E{(const bf16_t*)(ws + WS_YS5G), (bf16_t*)(dout + DO_YPRE), KIN[15]};
        GEMM_PHASE(lds, wave, GParm{DS5, 32, 4u * GM_STRIDE * 2u, 16, GM_STRIDE}, S, E);
        if (G == 256 && bx >= 128) {
            LAS float* scr = (LAS float*)(lds + wave * 16640); constexpr int I_FF1 = (DM / 64) * (DFF / 64);
            for (int it = (bx - 128) * 8 + wave; it < FF1_IN_P5; it += 1024) transpose_item(KIN[29], DM, DFF, (bf16_t*)(ws + WS_FF1T), scr, it, lane); }
    }
    if (rep + 1 < REPS(5)) { ++nbar; xcd_barrier(xb, (unsigned)G, wave); } }
    SEAM(5);
    for (int rep = 0; rep < REPS(6); ++rep) {
    if (IN(6)) { PH_IDS;
        const float *g5 = KIN[23], *gr = KIN[24];
        for (int row = gw; row < SEQ; row += NGW) { const u32x4* yr = (const u32x4*)(dout + DO_YPRE) + (size_t)row * 256; u32x4* oc = (u32x4*)(ws + WS_YCAT) + (size_t)row * 256;
            u32x4 w[4]; float s0 = 0.f, s1 = 0.f;
#pragma unroll
            for (int j = 0; j < 4; ++j) { w[j] = __builtin_nontemporal_load(yr + lane + 64 * j); const float q = bf_lo(w[j].x) * bf_lo(w[j].x) + bf_hi(w[j].x) * bf_hi(w[j].x) + bf_lo(w[j].y) * bf_lo(w[j].y) + bf_hi(w[j].y) * bf_hi(w[j].y)
                + bf_lo(w[j].z) * bf_lo(w[j].z) + bf_hi(w[j].z) * bf_hi(w[j].z) + bf_lo(w[j].w) * bf_lo(w[j].w) + bf_hi(w[j].w) * bf_hi(w[j].w); if (j < 2) s0 += q; else s1 += q; }
            const float r0 = 1.0f / sqrtf(wave_sum(s0) * (1.f / 1024.f) + LN_EPS), r1 = 1.0f / sqrtf(wave_sum(s1) * (1.f / 1024.f) + LN_EPS);
#pragma unroll
            for (int j = 0; j < 4; ++j) { const int col = (lane + 64 * j) * 8; const float rs = j < 2 ? r0 : r1; const float* gp = j < 2 ? g5 + col : gr + (col - 1024);
                const f32x4 ga = *(const f32x4*)gp, gb = *(const f32x4*)(gp + 4);
                u32x4 o; o.x = cvt_pk_bf16(bf_lo(w[j].x) * rs * ga[0], bf_hi(w[j].x) * rs * ga[1]); o.y = cvt_pk_bf16(bf_lo(w[j].y) * rs * ga[2], bf_hi(w[j].y) * rs * ga[3]);
                o.z = cvt_pk_bf16(bf_lo(w[j].z) * rs * gb[0], bf_hi(w[j].z) * rs * gb[1]); o.w = cvt_pk_bf16(bf_lo(w[j].w) * rs * gb[2], bf_hi(w[j].w) * rs * gb[3]); oc[lane + 64 * j] = o; } }
        {
            LAS float* scr = (LAS float*)(lds + wave * 16640);
            constexpr int I_FF1 = (DM / 64) * (DFF / 64), I_FF2 = (DFF / 64) * (DM / 64);
            const int ff1_lo = (G == 256) ? FF1_IN_P5 : 0;
            for (int it = gw; it < I_FF2 + (I_FF1 - ff1_lo); it += NGW) {
                if (it < I_FF2) transpose_item(KIN[31], DFF, DM, (bf16_t*)(ws + WS_FF2T), scr, it, lane);
                else transpose_item(KIN[29], DM, DFF, (bf16_t*)(ws + WS_FF1T), scr, ff1_lo + it - I_FF2, lane); }
        }
    }
    if (rep + 1 < REPS(6)) { ++nbar; xcd_barrier(xb, (unsigned)G, wave); } }
    SEAM(6);
    for (int rep = 0; rep < REPS(7); ++rep) {
    if (IN(7)) { PH_IDS;
        SchedStd S; S.so.init(SEQ, DM, G, bx); S.A = (const char*)(ws + WS_YCAT); S.B = (const char*)(ws + WS_WOUTT); S.a_tile = (size_t)256 * DM * 2; S.b_tile = (size_t)256 * DM * 2;
        EpiResLn1 E{(bf16_t*)(ws + WS_HB), KIN[26], KIN[27], KIN[28], PanelStats8{(unsigned long long*)(ws + WS_AGG), (unsigned*)(ws + WS_CTR) + 1024, LN_EPS}};
        GEMM_PHASE(lds, wave, GParm{DM, DM * 2, 128, 64, 0}, S, E);
    }
    if (rep + 1 < REPS(7)) { ++nbar; xcd_barrier(xb, (unsigned)G, wave); } }
    for (int rep = 0; rep < REPS(8); ++rep) {
    if (IN(8)) { }
    if (rep + 1 < REPS(8)) { ++nbar; xcd_barrier(xb, (unsigned)G, wave); } }
    SEAM(8);
    for (int rep = 0; rep < REPS(9); ++rep) {
    if (IN(9)) { PH_IDS;
        static_assert(WS_PLEGT == WS_FF1T + (size_t)DFF * DM * 2, "gate weights must follow the FF1 weights");
        { SchedStd S; S.so.init(SEQ, DFF + DM, G, bx); S.A = (const char*)(ws + WS_HB); S.B = (const char*)(ws + WS_FF1T); S.a_tile = (size_t)256 * DM * 2; S.b_tile = (size_t)256 * DM * 2;
          EpiFF1G E{(bf16_t*)(ws + WS_T), (bf16_t*)dout, KIN[30], KIN[35]}; GEMM_PHASE(lds, wave, GParm{DM, DM * 2, 128, 64, 0}, S, E); }
        { SchedStd S; S.so.init(SEQ, DM, G, bx); S.A = (const char*)(ws + WS_PB); S.B = (const char*)(ws + WS_PLEWT); S.a_tile = (size_t)256 * PLE * 2; S.b_tile = (size_t)256 * PLE * 2;
          EpiPlain<0> E{(bf16_t*)dout + ((size_t)1 << 19), DM, nullptr, (size_t)1 << 20}; GEMM_PHASE(lds, wave, GParm{PLE, PLE * 2, 128, 64, 0}, S, E); }
    }
    if (rep + 1 < REPS(9)) { ++nbar; xcd_barrier(xb, (unsigned)G, wave); } }
    SEAM(9);
    for (int rep = 0; rep < REPS(10); ++rep) {
    if (IN(10)) { PH_IDS;
        SchedStd S; S.so.init(SEQ, DM, G, bx); S.A = (const char*)(ws + WS_T); S.B = (const char*)(ws + WS_FF2T); S.a_tile = (size_t)256 * DFF * 2; S.b_tile = (size_t)256 * DFF * 2;
        EpiResLn2 E{(const bf16_t*)(ws + WS_HB), KIN[32], KIN[36], KIN[37], (float*)dout, (const bf16_t*)dout, PanelStats8{(unsigned long long*)(ws + WS_AGG) + 65536, (unsigned*)(ws + WS_CTR) + 1024 + 64 * 32, LN_EPS}};
        GEMM_PHASE(lds, wave, GParm{DFF, DFF * 2, 128, 64, 0}, S, E);
    }
    if (rep + 1 < REPS(10)) { ++nbar; xcd_barrier(xb, (unsigned)G, wave); } }
    for (int rep = 0; rep < REPS(11); ++rep) {
    if (IN(11)) { }
    if (rep + 1 < REPS(11)) { ++nbar; xcd_barrier(xb, (unsigned)G, wave); } }
#ifdef EXTRA_BARRIERS
    for (int eb = 0; eb < EXTRA_BARRIERS; ++eb) { ++nbar; xcd_barrier(xb, (unsigned)G, wave); }
#endif
#if TSTAMP
    if (bx == 0 && wave == 0) { if (fresh_lane() == 0) { unsigned long long* st = (unsigned long long*)(ws + WS_CTR + 1024); st[12] = __builtin_amdgcn_s_memrealtime();
        ((float*)KIN[38])[0] = 8.0f * floorf((float)(long long)(__hip_atomic_load(st + TS_A1, __ATOMIC_RELAXED, __HIP_MEMORY_SCOPE_AGENT) - __hip_atomic_load(st + TS_A0, __ATOMIC_RELAXED, __HIP_MEMORY_SCOPE_AGENT)) * 0.00125f + 0.5f); } }
#endif
#if DIAG
    { ++nbar; xcd_barrier(xb, (unsigned)G, wave); PH_IDS; unsigned* flagw = (unsigned*)(ws + WS_CTR) + 48;
#if DIAG == 1
      diag_ffn((const float* const*)0, ws, ((float*)KIN[38]), flagw, gtid, GT);
#elif DIAG == 2
      diag_pre((const float* const*)0, ws, dout, flagw, gtid, GT);
#elif DIAG == 3
      diag_v((const float* const*)0, ws, dout, flagw, gtid, GT);
#elif DIAG == 4
      diag_g((const float* const*)0, ws, flagw, gtid, GT);
#elif DIAG == 6
      diag_max(ws, flagw, gtid, GT);
#else
      if (bx == 0 && tid == 0) flagw[1] = 0xffffffffu;
      ++nbar; xcd_barrier(xb, (unsigned)G, wave);
#if DIAG == 7
      diag_rows(((float*)KIN[38]), flagw, gw, NGW, lane);
#elif DIAG == 8
      diag_rows_bf((const bf16_t*)(ws + WS_HB), DM, 12.0f, flagw, gw, NGW, lane);
#elif DIAG == 9
      diag_rows((const float*)(ws + WS_V2), flagw, gw, NGW, lane);
#elif DIAG == 10
      diag_rows_bf((const bf16_t*)(ws + WS_T), DFF, 150.0f, flagw, gw, NGW, lane);
#elif DIAG == 11
      diag_rows_bf((const bf16_t*)(dout + DO_PW), DM, 8.0f, flagw, gw, NGW, lane);
#elif DIAG == 12
      diag_rows_bf((const bf16_t*)(dout + DO_SG), DM, 1.01f, flagw, gw, NGW, lane);
#endif
#endif
      ++nbar; xcd_barrier(xb, (unsigned)G, wave);
#if DIAG != 1
      for (int i = gtid; i < SEQ * DM; i += GT) ((float*)KIN[38])[i] = 0.f;
      ++nbar; xcd_barrier(xb, (unsigned)G, wave);
#endif
      if (bx == 0 && tid == 0) { unsigned code = 0; for (int q = 0; q < 4; ++q) if (__hip_atomic_load(flagw + q, __ATOMIC_RELAXED, __HIP_MEMORY_SCOPE_AGENT) > 100u) code |= 1u << q; if (DIAG >= 7) { const unsigned cnt = __hip_atomic_load(flagw, __ATOMIC_RELAXED, __HIP_MEMORY_SCOPE_AGENT), mn = __hip_atomic_load(flagw + 1, __ATOMIC_RELAXED, __HIP_MEMORY_SCOPE_AGENT), mxr = __hip_atomic_load(flagw + 2, __ATOMIC_RELAXED, __HIP_MEMORY_SCOPE_AGENT);
          const unsigned v = DIAG_SEL == 0 ? cnt : DIAG_SEL == 1 ? mn / 100u : DIAG_SEL == 2 ? mn % 100u : DIAG_SEL == 3 ? mxr / 100u : mxr % 100u; ((float*)KIN[38])[0] = 100.0f * (float)(v + 1u); }
      else ((float*)KIN[38])[0] = (DIAG == 6) ? 1000.0f * __uint_as_float(__hip_atomic_load(flagw, __ATOMIC_RELAXED, __HIP_MEMORY_SCOPE_AGENT)) : 1000.0f * (float)(code + 16u); } }
#endif
#undef IN
#undef SEAM
}


#if PER_PHASE_LAUNCH
template <int PH> static void set_attr_one() { (void)hipFuncSetAttribute((const void*)mega<(1 << PH)>, hipFuncAttributeMaxDynamicSharedMemorySize, LDS_BYTES); }
template <int PH> static void launch_one(Args a, int grid, hipStream_t stream) { a.ph_lo = PH; a.ph_hi = PH + 1; hipLaunchKernelGGL(mega<(1 << PH)>, dim3(grid), dim3(512), LDS_BYTES, stream, a); }
static void set_attrs() { set_attr_one<0>(); set_attr_one<1>(); set_attr_one<2>(); set_attr_one<3>(); set_attr_one<4>(); set_attr_one<5>(); set_attr_one<6>(); set_attr_one<7>(); set_attr_one<8>(); set_attr_one<9>(); set_attr_one<10>(); set_attr_one<11>(); }
static void launch_phases(const Args& a, int grid, hipStream_t stream) { launch_one<0>(a, grid, stream); launch_one<1>(a, grid, stream); launch_one<2>(a, grid, stream); launch_one<3>(a, grid, stream); launch_one<4>(a, grid, stream); launch_one<5>(a, grid, stream);
    launch_one<6>(a, grid, stream); launch_one<7>(a, grid, stream); launch_one<8>(a, grid, stream); launch_one<9>(a, grid, stream); launch_one<10>(a, grid, stream); launch_one<11>(a, grid, stream); }
#else
static void set_attrs() { (void)hipFuncSetAttribute((const void*)mega<0xfff>, hipFuncAttributeMaxDynamicSharedMemorySize, LDS_BYTES); }
#endif

extern "C" void kernel_launch(void* const* d_in, const int* in_sizes, int n_in, void* d_out, int out_size, void* d_ws, size_t ws_size, hipStream_t stream) {
    static int grid = 0;
    if (grid == 0) {
        if (n_in != 38 || out_size != SEQ * DM || ws_size < WS_END) { fprintf(stderr, "kernel_launch: unexpected shapes (n_in %d out %d ws %zu)\n", n_in, out_size, ws_size); grid = -1; return; }
        int dev = 0, cus = 0, per_cu = 0;
        hipGetDevice(&dev); hipDeviceGetAttribute(&cus, hipDeviceAttributeMultiprocessorCount, dev);
        set_attrs();
        per_cu = 1;
        (void)hipGetLastError();
        if (per_cu < 1) per_cu = 1;
        grid = cus;
    }
    if (grid < 0) return;
#ifdef POISON_NAN
    hipMemsetAsync(d_ws, 0xFF, WS_END, stream); hipMemsetAsync(d_out, 0xFF, (size_t)64 * MiB, stream);
#endif
    hipMemsetAsync((char*)d_ws + WS_CTR, 0, 40960, stream);
    Args a{};
    for (int i = 0; i < 38; ++i) a.in[i] = (const float*)d_in[i];
    a.out = (float*)d_out; a.ws = (unsigned char*)d_ws;
#if PER_PHASE_LAUNCH
    launch_phases(a, grid, stream);
#else
    a.ph_lo = 0; a.ph_hi = NPHASE;
    void* kargs[] = {&a};
    hipError_t e = hipLaunchCooperativeKernel((const void*)mega<0xfff>, dim3(grid), dim3(512), kargs, LDS_BYTES, stream);
    if (e != hipSuccess) fprintf(stderr, "cooperative launch failed: %s (grid %d)\n", hipGetErrorString(e), grid);
#endif
}
```

```cpp
#include <hip/hip_runtime.h>
#include <hip/hip_cooperative_groups.h>
#include <cstdio>
#include <cstdint>
namespace cg = cooperative_groups;

#ifndef PER_PHASE_LAUNCH
#define PER_PHASE_LAUNCH 0
#endif

#ifndef TSTAMP
#define TSTAMP 0
#define TS_A0 4
#define TS_A1 5
#define TS_B0 9
#define TS_B1 12
#endif
#define LAS __attribute__((address_space(3)))
typedef unsigned short bf16_t;
typedef short bf16x8 __attribute__((ext_vector_type(8)));
typedef float f32x4 __attribute__((ext_vector_type(4)));
typedef float f32x2 __attribute__((ext_vector_type(2)));
typedef unsigned u32x4 __attribute__((ext_vector_type(4)));
typedef unsigned u32x2 __attribute__((ext_vector_type(2)));

constexpr int SEQ = 8192, DM = 2048, DIN = 3072, DS5 = 1024, DRG = 1024, NG = 64, NP = 64, NK = 16, NH = 16, HD = 64, DFF = 8192, PLE = 256;
constexpr int TC = 32, NCH = SEQ / TC;
constexpr float LN_EPS = 1e-5f, DN_ALPHA = 1.18920711500272f;
constexpr int NPHASE = 12;

constexpr size_t MiB = (size_t)1 << 20;
constexpr size_t WS_FF2T = 0, WS_HB = 32 * MiB, WS_FF1T = 64 * MiB, WS_PLEGT = 96 * MiB, WS_PLEWT = 104 * MiB, WS_PB = 105 * MiB, WS_WOUTT = 109 * MiB,
    WS_V2 = 64 * MiB, WS_G0 = 0, WS_G1 = 64 * MiB,
    WS_WG = 128 * MiB, WS_WC = 176 * MiB, WS_RGW = 192 * MiB, WS_GLUT = 194 * MiB, WS_XR = 196 * MiB, WS_YINTRA = 213 * MiB, WS_S = 229 * MiB, WS_HPREV = 245 * MiB, WS_WINT = 229 * MiB,
    WS_YS5G = 128 * MiB, WS_YCAT = 144 * MiB, WS_T = 128 * MiB,
    WS_AGG = 256 * MiB, WS_CARRY = 258 * MiB, WS_SUMSQ = 259 * MiB, WS_RGBIAS = 259 * MiB + 64 * 1024, WS_SP = WS_RGBIAS + 16 * 1024, WS_CTR = WS_SP + 8 * 1024, WS_END = 260 * MiB;
constexpr size_t DO_YPRE = 0, DO_Z = 32 * MiB, DO_U = 48 * MiB, DO_SG = 0, DO_PW = 32 * MiB;
constexpr int FF1_IN_P5 = 4096;
constexpr int GM_STRIDE = SEQ * 16;
constexpr int LDS_BYTES = 152 * 1024;

typedef __bf16 bf16x2_t __attribute__((ext_vector_type(2)));
__device__ __forceinline__ unsigned cvt_pk_bf16(float lo, float hi) { const f32x2 v = {lo, hi}; const bf16x2_t b = __builtin_convertvector(v, bf16x2_t); return __builtin_bit_cast(unsigned, b); }
__device__ __forceinline__ float bf_lo(unsigned w) { return __uint_as_float(w << 16); }
__device__ __forceinline__ float bf_hi(unsigned w) { return __uint_as_float(w & 0xffff0000u); }
__device__ __forceinline__ f32x4 bf4(u32x2 w) { return (f32x4){bf_lo(w.x), bf_hi(w.x), bf_lo(w.y), bf_hi(w.y)}; }
__device__ __forceinline__ float fast_sigmoid(float x) { return __builtin_amdgcn_rcpf(1.0f + __expf(-x)); }
__device__ __forceinline__ float gelu_tanh(float x) { const float u = 1.5957691216057308f * (x + 0.044715f * x * x * x); return x * fast_sigmoid(u); }
__device__ __forceinline__ float wave_sum(float v) {
#pragma unroll
    for (int o = 1; o < 64; o <<= 1) v += __shfl_xor(v, o);
    return v;
}
__device__ __forceinline__ int lane_id() { return (int)__builtin_amdgcn_mbcnt_hi(~0u, __builtin_amdgcn_mbcnt_lo(~0u, 0u)); }
__device__ __forceinline__ int fresh_lane() { unsigned z = 0; asm volatile("" : "+s"(z)); return (int)__builtin_amdgcn_mbcnt_hi(~0u, __builtin_amdgcn_mbcnt_lo(~0u, z)); }
#define LDS_WAIT() asm volatile("s_waitcnt lgkmcnt(0)" ::: "memory")

namespace pg8 {
constexpr int BM = 256, BK = 64, HALF = 128, HTB = HALF * BK * 2, STAGE_BYTES = 8 * HTB, NXCD = 8, WGM = 8;
__host__ __device__ __forceinline__ int lds_byte(int r, int c) { const int st = (r >> 4) * 2 + (c >> 5), rr = r & 15, cc = c & 31, ob = rr * 64 + cc * 2; return st * 1024 + (ob ^ (((ob >> 9) & 1) << 5)); }
__host__ __device__ __forceinline__ void stage_rc(int b, int& R, int& C) { const int st = b / 1024, sb = b % 1024, swz = sb ^ (((sb >> 9) & 1) << 5); R = (st >> 1) * 16 + swz / 64; C = (st & 1) * 32 + (swz % 64) / 2; }
__host__ __device__ __forceinline__ int perm32(int rho) { const int n = rho >> 4, i = rho & 15; return 8 * (i >> 2) + 4 * n + (i & 3); }

struct Unit { int pm, pn; };
struct StaticOrder {
    int nM, nN, nwg, G, c;
    __host__ __device__ void init(int M, int N, int G_, int c_) { nM = M / BM; nN = N / BM; nwg = nM * nN; G = G_; c = c_; }
    __host__ __device__ bool next(int i, Unit& u) const {
        const long L = (long)i * G + c; if (L >= nwg) return false;
        int wgid = (int)L; { const int q = nwg / NXCD, r = nwg % NXCD, xcd = wgid % NXCD, off = wgid / NXCD; wgid = (xcd < r ? xcd * (q + 1) : r * (q + 1) + (xcd - r) * q) + off; }
        const int nig = WGM * nN, gid = wgid / nig, fm = gid * WGM, gsz = (nM - fm) < WGM ? (nM - fm) : WGM;
        u.pm = fm + ((wgid % nig) % gsz); u.pn = (wgid % nig) / gsz; return true;
    }
};
struct GUnit { const char* A; const char* B; int i0, i1; };
struct GParm { int K; unsigned a_rs, a_ks; int a_cw, a_cs; };

template <class Epi, class Sched>
__device__ __forceinline__ void gemm_phase(LAS unsigned char* lds, const int wid, const GParm gp, const Sched& S, const Epi& E) {
    const int lane = fresh_lane(), tid = wid * 64 + lane, wr = wid >> 2, wc = wid & 3, fr = lane & 15, fq = lane >> 4;
    const int K = gp.K, nt = K / BK;
    unsigned voffA[2], voffB[2];
#pragma unroll
    for (int i = 0; i < 2; ++i) { int R, C; stage_rc(tid * 16 + i * 8192, R, C); const int Rb = Epi::PERM ? ((R & ~31) + perm32(R & 31)) : R;
        voffA[i] = (unsigned)R * gp.a_rs + (unsigned)((C / gp.a_cw) * gp.a_cs + (C % gp.a_cw)) * 2u; voffB[i] = (unsigned)(Rb * K + C) * 2u; }
    const size_t ksA = gp.a_ks, ksB = (size_t)(BK * 2);
    const size_t hsA = (size_t)HALF * gp.a_rs, hsB = (size_t)HALF * K * 2;
    const unsigned ldsw = (unsigned)wid * 1024u;
    const int aoff = lds_byte(wr * 64 + fr, fq * 8), boff = lds_byte(wc * 32 + fr, fq * 8);
#define PG8_SA(b, h) (((b) * 2 + (h)) * HTB)
#define PG8_SB(b, h) ((4 + (b) * 2 + (h)) * HTB)
#define PG8_STAGE(bufoff, gbase, voff) do { _Pragma("unroll") for (int _i = 0; _i < 2; ++_i) \
        __builtin_amdgcn_global_load_lds((const unsigned*)((const char*)(gbase) + (voff)[_i]), (LAS unsigned*)(lds + (bufoff) + ldsw + _i * 8192), 16, 0, 0); } while (0)
#define PG8_LDA(dst, b, h) do { _Pragma("unroll") for (int m = 0; m < 4; ++m) _Pragma("unroll") for (int k = 0; k < 2; ++k) dst[m][k] = *(const LAS bf16x8*)(lds + PG8_SA(b, h) + aoff + m * 2048 + k * 1024); } while (0)
#define PG8_LDB(dst, b, h) do { _Pragma("unroll") for (int n = 0; n < 2; ++n) _Pragma("unroll") for (int k = 0; k < 2; ++k) dst[n][k] = *(const LAS bf16x8*)(lds + PG8_SB(b, h) + boff + n * 2048 + k * 1024); } while (0)
#define PG8_MMA(ai, bj, At, Bt) do { __builtin_amdgcn_s_setprio(1); _Pragma("unroll") for (int m = 0; m < 4; ++m) _Pragma("unroll") for (int n = 0; n < 2; ++n) _Pragma("unroll") for (int k = 0; k < 2; ++k) \
        acc[ai][bj][m][n] = __builtin_amdgcn_mfma_f32_16x16x32_bf16(Bt[n][k], At[m][k], acc[ai][bj][m][n], 0, 0, 0); __builtin_amdgcn_s_setprio(0); } while (0)
#define PG8_WAIT_V(n) asm volatile("s_waitcnt vmcnt(" #n ")" ::: "memory")
#define PG8_WAIT_L(n) asm volatile("s_waitcnt lgkmcnt(" #n ")" ::: "memory")
#define PG8_BAR __builtin_amdgcn_s_barrier()
#define PG8_SCHED __builtin_amdgcn_sched_barrier(0)
    GUnit cur, nxt; int ui = 0;
    if (!S.next(0, cur)) return;
    f32x4 acc[2][2][4][2];
#pragma unroll
    for (int a = 0; a < 2; ++a)
#pragma unroll
        for (int b = 0; b < 2; ++b)
#pragma unroll
            for (int m = 0; m < 4; ++m)
#pragma unroll
                for (int n = 0; n < 2; ++n) acc[a][b][m][n] = (f32x4){0.f, 0.f, 0.f, 0.f};
    bf16x8 At[4][2], B0[2][2], B1[2][2];
    const char* cA = cur.A; const char* cB = cur.B;
    PG8_STAGE(PG8_SB(0, 0), cB, voffB); PG8_STAGE(PG8_SB(0, 1), cB + hsB, voffB); PG8_STAGE(PG8_SA(0, 0), cA, voffA); PG8_STAGE(PG8_SA(0, 1), cA + hsA, voffA);
    if (wr == 1) PG8_BAR;
    PG8_WAIT_V(2); PG8_BAR;
    PG8_STAGE(PG8_SB(1, 0), cB + ksB, voffB); PG8_STAGE(PG8_SA(1, 0), cA + ksA, voffA); PG8_STAGE(PG8_SB(1, 1), cB + hsB + ksB, voffB);
    PG8_WAIT_V(6); PG8_BAR;
    for (;;) {
        const bool has_next = S.next(ui + 1, nxt);
        const char* nA = has_next ? nxt.A : cA; const char* nB = has_next ? nxt.B : cB;
        for (int t = 0; t < nt; t += 2) {
            const bool last = (t == nt - 2);
            const char* a1 = cA + (size_t)(t + 1) * ksA;
            const char* a2 = last ? nA : cA + (size_t)(t + 2) * ksA; const char* b2 = last ? nB : cB + (size_t)(t + 2) * ksB;
            const char* a3 = a2 + ksA; const char* b3 = b2 + ksB;
            PG8_LDB(B0, 0, 0); PG8_LDB(B1, 0, 1); PG8_SCHED; PG8_LDA(At, 0, 0); PG8_STAGE(PG8_SA(1, 1), a1 + hsA, voffA);
            PG8_WAIT_V(8); PG8_WAIT_L(0); PG8_BAR; PG8_MMA(0, 0, At, B0); PG8_MMA(0, 1, At, B1); PG8_BAR; PG8_SCHED;
            PG8_LDA(At, 0, 1); PG8_STAGE(PG8_SB(0, 0), b2, voffB); PG8_STAGE(PG8_SB(0, 1), b2 + hsB, voffB); PG8_STAGE(PG8_SA(0, 0), a2, voffA);
            PG8_WAIT_V(8); PG8_WAIT_L(0); PG8_BAR; PG8_MMA(1, 0, At, B0); PG8_MMA(1, 1, At, B1); PG8_BAR; PG8_SCHED;
            PG8_LDB(B0, 1, 0); PG8_LDB(B1, 1, 1); PG8_SCHED; PG8_LDA(At, 1, 0); PG8_STAGE(PG8_SA(0, 1), a2 + hsA, voffA);
            PG8_WAIT_V(8); PG8_WAIT_L(0); PG8_BAR; PG8_MMA(0, 0, At, B0); PG8_MMA(0, 1, At, B1); PG8_BAR; PG8_SCHED;
            PG8_LDA(At, 1, 1); PG8_STAGE(PG8_SB(1, 0), b3, voffB); PG8_STAGE(PG8_SB(1, 1), b3 + hsB, voffB); PG8_STAGE(PG8_SA(1, 0), a3, voffA);
            PG8_WAIT_V(8); PG8_WAIT_L(0); PG8_BAR; PG8_MMA(1, 0, At, B0); PG8_MMA(1, 1, At, B1); PG8_BAR; PG8_SCHED;
        }
        if (wr == 0) PG8_BAR;
        if constexpr (!Epi::AFTER_DRAIN) { const int l_o = fresh_lane(); E(acc, cur, wr, wc, l_o & 15, l_o >> 4); }
        if (!has_next) break;
#pragma unroll
        for (int a = 0; a < 2; ++a)
#pragma unroll
            for (int b = 0; b < 2; ++b)
#pragma unroll
                for (int m = 0; m < 4; ++m)
#pragma unroll
                    for (int n = 0; n < 2; ++n) acc[a][b][m][n] = (f32x4){0.f, 0.f, 0.f, 0.f};
        cur = nxt; cA = nA; cB = nB; ++ui;
        if (wr == 1) PG8_BAR;
    }
    PG8_WAIT_V(0);
    PG8_BAR;
    if constexpr (Epi::AFTER_DRAIN) { const int l_o = fresh_lane(); E.fused(acc, cur, wr, wc, l_o & 15, l_o >> 4, lds, wid); }
#undef PG8_SA
#undef PG8_SB
#undef PG8_STAGE
#undef PG8_LDA
#undef PG8_LDB
#undef PG8_MMA
#undef PG8_WAIT_V
#undef PG8_WAIT_L
#undef PG8_BAR
#undef PG8_SCHED
}
}
using pg8::GUnit; using pg8::GParm;
typedef f32x4 AccT[2][2][4][2];

struct SchedStd {
    pg8::StaticOrder so; const char* A; const char* B; size_t a_tile, b_tile;
    __device__ __forceinline__ bool next(int i, GUnit& u) const { pg8::Unit t; if (!so.next(i, t)) return false; u.A = A + (size_t)t.pm * a_tile; u.B = B + (size_t)t.pn * b_tile; u.i0 = t.pm; u.i1 = t.pn; return true; }
};
struct SchedS5a { const char* U; const char* WG; int G, c;
    __device__ __forceinline__ bool next(int i, GUnit& u) const { const int L = i * G + c; if (L >= 192) return false; const int g = L / 3, pn = L % 3;
        u.A = U + (size_t)g * GM_STRIDE * 2; u.B = WG + ((size_t)g * 768 + 256 * pn) * 512 * 2; u.i0 = g; u.i1 = pn; return true; } };
struct SchedS5b { const char* HP; const char* WC; int G, c;
    __device__ __forceinline__ bool next(int i, GUnit& u) const { const int L = i * G + c; if (L >= 128) return false; const int g = L / 2, pn = L % 2;
        u.A = HP + (size_t)g * 256 * 256 * 2; u.B = WC + ((size_t)g * 512 + 256 * pn) * 256 * 2; u.i0 = g; u.i1 = pn; return true; } };
struct SchedRG { const char* XR; const char* RGW; int G, c;
    __device__ __forceinline__ bool next(int i, GUnit& u) const { const int L = i * G + c; if (L >= 512) return false; const int h = L % 16, pm = L / 16;
        u.A = XR + ((size_t)(256 * pm) * 1024 + 64 * h) * 2; u.B = RGW + (size_t)h * 256 * 256 * 2; u.i0 = pm; u.i1 = h; return true; } };

template <int ACT> __device__ __forceinline__ void epi_bf16_store(const AccT& acc, bf16_t* tile, int ldc, const float* biast, int wr, int wc, int fr, int fq) {
    const int r0 = wr * 64 + fr, c0 = wc * 32 + 8 * fq;
    f32x4 bv[2][2];
#pragma unroll
    for (int bj = 0; bj < 2; ++bj)
#pragma unroll
        for (int n = 0; n < 2; ++n) bv[bj][n] = biast ? *(const f32x4*)(biast + c0 + bj * 128 + 4 * n) : (f32x4){0.f, 0.f, 0.f, 0.f};
#pragma unroll
    for (int ai = 0; ai < 2; ++ai)
#pragma unroll
        for (int m = 0; m < 4; ++m) { bf16_t* rowp = tile + (size_t)(r0 + ai * 128 + m * 16) * ldc + c0;
#pragma unroll
            for (int bj = 0; bj < 2; ++bj) { f32x4 v0 = acc[ai][bj][m][0] + bv[bj][0], v1 = acc[ai][bj][m][1] + bv[bj][1];
                if (ACT == 1) {
#pragma unroll
                    for (int j = 0; j < 4; ++j) { const float a = fmaxf(v0[j], 0.f), b = fmaxf(v1[j], 0.f); v0[j] = a * a; v1[j] = b * b; } }
                if (ACT == 2) {
#pragma unroll
                    for (int j = 0; j < 4; ++j) { v0[j] = fast_sigmoid(v0[j]); v1[j] = fast_sigmoid(v1[j]); } }
                u32x4 w; w.x = cvt_pk_bf16(v0[0], v0[1]); w.y = cvt_pk_bf16(v0[2], v0[3]); w.z = cvt_pk_bf16(v1[0], v1[1]); w.w = cvt_pk_bf16(v1[2], v1[3]);
                *(u32x4*)(rowp + bj * 128) = w; } }
}
struct EpiProj { static constexpr bool PERM = true, AFTER_DRAIN = false; bf16_t *U, *XR, *Z; const float* bias;
    __device__ __forceinline__ void operator()(AccT& acc, const GUnit& u, int wr, int wc, int fr, int fq) const {
        const int pm = u.i0, pn = u.i1;
        if (pn >= 4) { bf16_t* base = pn < 8 ? XR + 2 * 1024 : Z; epi_bf16_store<0>(acc, base + (size_t)pm * 256 * 1024 + (pn & 3) * 256, 1024, bias + pn * 256, wr, wc, fr, fq); return; }
        const int c0 = pn * 256 + wc * 32 + 8 * fq;
#pragma unroll
        for (int bj = 0; bj < 2; ++bj) { const int col = c0 + bj * 128; const f32x4 b0 = *(const f32x4*)(bias + col), b1 = *(const f32x4*)(bias + col + 4); bf16_t* gp = U + (size_t)(col >> 4) * GM_STRIDE + (col & 15);
#pragma unroll
            for (int ai = 0; ai < 2; ++ai)
#pragma unroll
                for (int m = 0; m < 4; ++m) { const int row = pm * 256 + ai * 128 + wr * 64 + m * 16 + fr; const f32x4 v0 = acc[ai][bj][m][0] + b0, v1 = acc[ai][bj][m][1] + b1;
                    u32x4 w; w.x = cvt_pk_bf16(v0[0], v0[1]); w.y = cvt_pk_bf16(v0[2], v0[3]); w.z = cvt_pk_bf16(v1[0], v1[1]); w.w = cvt_pk_bf16(v1[2], v1[3]);
                    *(u32x4*)(gp + (size_t)row * 16) = w; } }
    } };
template <int ACT> struct EpiPlain { static constexpr bool PERM = true, AFTER_DRAIN = false; bf16_t* O; int ldc; const float* bias; size_t pstride;
    __device__ __forceinline__ void operator()(AccT& acc, const GUnit& u, int wr, int wc, int fr, int fq) const {
        epi_bf16_store<ACT>(acc, O + (size_t)u.i0 * (pstride ? pstride : (size_t)256 * ldc) + u.i1 * 256, ldc, bias ? bias + u.i1 * 256 : nullptr, wr, wc, fr, fq); } };
struct EpiFF1G { static constexpr bool PERM = true, AFTER_DRAIN = false; bf16_t* T; bf16_t* SG; const float *b1, *bg;
    __device__ __forceinline__ void operator()(AccT& acc, const GUnit& u, int wr, int wc, int fr, int fq) const {
        const int pm = u.i0, pn = u.i1;
        if (pn < 32) epi_bf16_store<1>(acc, T + (size_t)pm * 256 * DFF + pn * 256, DFF, b1 + pn * 256, wr, wc, fr, fq);
        else epi_bf16_store<2>(acc, SG + (size_t)pm * ((size_t)1 << 20) + (pn - 32) * 256, DM, bg + (pn - 32) * 256, wr, wc, fr, fq); } };
struct EpiS5a { static constexpr bool PERM = true, AFTER_DRAIN = false; bf16_t* YI; float* S;
    __device__ __forceinline__ void operator()(AccT& acc, const GUnit& u, int wr, int wc, int fr, int fq) const {
        const int g = u.i0, pn = u.i1;
#pragma unroll
        for (int ai = 0; ai < 2; ++ai)
#pragma unroll
            for (int m = 0; m < 4; ++m) { const int r = ai * 128 + wr * 64 + m * 16 + fr;
#pragma unroll
                for (int bj = 0; bj < 2; ++bj) { const int c8 = bj * 128 + wc * 32 + 8 * fq; const f32x4 v0 = acc[ai][bj][m][0], v1 = acc[ai][bj][m][1];
                    if (pn < 2) { const int col = pn * 256 + c8, t = col >> 4, k0 = col & 15;
                        u32x4 w; w.x = cvt_pk_bf16(v0[0], v0[1]); w.y = cvt_pk_bf16(v0[2], v0[3]); w.z = cvt_pk_bf16(v1[0], v1[1]); w.w = cvt_pk_bf16(v1[2], v1[3]);
                        *(u32x4*)(YI + (size_t)g * GM_STRIDE + (size_t)r * 512 + col) = w; (void)t; (void)k0; }
                    else { float* sp = S + ((size_t)g * NCH + r) * 256 + c8; *(f32x4*)sp = v0; *(f32x4*)(sp + 4) = v1; } } }
    } };
struct EpiS5b { static constexpr bool PERM = true, AFTER_DRAIN = false; const bf16_t* YI; bf16_t* YG;
    __device__ __forceinline__ void operator()(AccT& acc, const GUnit& u, int wr, int wc, int fr, int fq) const {
        const int g = u.i0, pn = u.i1;
#pragma unroll
        for (int ai = 0; ai < 2; ++ai)
#pragma unroll
            for (int m = 0; m < 4; ++m) { const int r = ai * 128 + wr * 64 + m * 16 + fr;
#pragma unroll
                for (int bj = 0; bj < 2; ++bj) { const int col = pn * 256 + bj * 128 + wc * 32 + 8 * fq, t = col >> 4, k0 = col & 15;
                    const size_t off = (size_t)g * GM_STRIDE + (size_t)r * 512 + col; (void)t; (void)k0; const u32x4 yi = __builtin_nontemporal_load((const u32x4*)(YI + off));
                    f32x4 v0 = acc[ai][bj][m][0] + (f32x4){bf_lo(yi.x), bf_hi(yi.x), bf_lo(yi.y), bf_hi(yi.y)}, v1 = acc[ai][bj][m][1] + (f32x4){bf_lo(yi.z), bf_hi(yi.z), bf_lo(yi.w), bf_hi(yi.w)};
#pragma unroll
                    for (int j = 0; j < 4; ++j) { v0[j] = gelu_tanh(v0[j]); v1[j] = gelu_tanh(v1[j]); }
                    u32x4 w; w.x = cvt_pk_bf16(v0[0], v0[1]); w.y = cvt_pk_bf16(v0[2], v0[3]); w.z = cvt_pk_bf16(v1[0], v1[1]); w.w = cvt_pk_bf16(v1[2], v1[3]);
                    *(u32x4*)(YG + off) = w; } }
    } };
struct EpiGlu { static constexpr bool PERM = true, AFTER_DRAIN = false; const bf16_t* YG; bf16_t* YPRE; const float* bias;
    __device__ __forceinline__ void operator()(AccT& acc, const GUnit& u, int wr, int wc, int fr, int fq) const {
        const int pm = u.i0, pn = u.i1; const int c0 = pn * 256 + wc * 32 + 8 * fq;
        f32x4 bv[2][2];
#pragma unroll
        for (int bj = 0; bj < 2; ++bj)
#pragma unroll
            for (int n = 0; n < 2; ++n) bv[bj][n] = *(const f32x4*)(bias + c0 + bj * 128 + 4 * n);
#pragma unroll
        for (int ai = 0; ai < 2; ++ai)
#pragma unroll
            for (int m = 0; m < 4; ++m) { const int row = pm * 256 + ai * 128 + wr * 64 + m * 16 + fr;
#pragma unroll
                for (int bj = 0; bj < 2; ++bj) { const int col = c0 + bj * 128; const u32x4 yv = *(const u32x4*)(YG + (size_t)(col >> 4) * GM_STRIDE + (size_t)row * 16 + (col & 15));
                    const f32x4 y0 = (f32x4){bf_lo(yv.x), bf_hi(yv.x), bf_lo(yv.y), bf_hi(yv.y)}, y1 = (f32x4){bf_lo(yv.z), bf_hi(yv.z), bf_lo(yv.w), bf_hi(yv.w)};
                    f32x4 v0 = acc[ai][bj][m][0] + bv[bj][0], v1 = acc[ai][bj][m][1] + bv[bj][1];
#pragma unroll
                    for (int j = 0; j < 4; ++j) { v0[j] = y0[j] * fast_sigmoid(v0[j]); v1[j] = y1[j] * fast_sigmoid(v1[j]); }
                    u32x4 w; w.x = cvt_pk_bf16(v0[0], v0[1]); w.y = cvt_pk_bf16(v0[2], v0[3]); w.z = cvt_pk_bf16(v1[0], v1[1]); w.w = cvt_pk_bf16(v1[2], v1[3]);
                    *(u32x4*)(YPRE + (size_t)row * 2048 + col) = w; }
                }
    } };
template <bool PLEADD> struct EpiRes { static constexpr bool PERM = false, AFTER_DRAIN = false; const bf16_t* HBp; const float* bias; float* V; const bf16_t* SG; const bf16_t* PW;
    __device__ __forceinline__ void operator()(AccT& acc, const GUnit& u, int wr, int wc, int fr, int fq) const {
        const int pm = u.i0, pn = u.i1; const int c0 = pn * 256 + wc * 32 + 4 * fq;
        f32x4 bv[2][2];
#pragma unroll
        for (int bj = 0; bj < 2; ++bj)
#pragma unroll
            for (int n = 0; n < 2; ++n) bv[bj][n] = *(const f32x4*)(bias + c0 + bj * 128 + n * 16);
#pragma unroll
        for (int ai = 0; ai < 2; ++ai)
#pragma unroll
            for (int m = 0; m < 4; ++m) { const int row = pm * 256 + ai * 128 + wr * 64 + m * 16 + fr;
#pragma unroll
                for (int bj = 0; bj < 2; ++bj)
#pragma unroll
                    for (int n = 0; n < 2; ++n) { const size_t off = (size_t)row * 2048 + c0 + bj * 128 + n * 16;
                        f32x4 v = acc[ai][bj][m][n] + bv[bj][n] + DN_ALPHA * bf4(*(const u32x2*)(HBp + off));
                        if (PLEADD) v += bf4(*(const u32x2*)(SG + off)) * bf4(*(const u32x2*)(PW + off));
                        *(f32x4*)(V + off) = v; } }
    } };


struct PanelStats8 { unsigned long long* xbuf; unsigned* cnt; float eps;
    __device__ __forceinline__ void run(const AccT& v, int pm, int pn, int wr, int wc, int fr, int fq, LAS unsigned char* lds, int wid) const {
        LAS f32x2* P = (LAS f32x2*)lds; LAS f32x2* S = (LAS f32x2*)(lds + 8192); const int lane = fq * 16 + fr;
#pragma unroll
        for (int ai = 0; ai < 2; ++ai)
#pragma unroll
            for (int m = 0; m < 4; ++m) { float s = 0.f;
#pragma unroll
                for (int bj = 0; bj < 2; ++bj)
#pragma unroll
                    for (int n = 0; n < 2; ++n) { const f32x4 x = v[ai][bj][m][n]; s += (x[0] + x[1]) + (x[2] + x[3]); }
                s += __shfl_xor(s, 16); s += __shfl_xor(s, 32);
                const float mw = s * (1.0f / 64.0f); float q = 0.f;
#pragma unroll
                for (int bj = 0; bj < 2; ++bj)
#pragma unroll
                    for (int n = 0; n < 2; ++n) { const f32x4 d = v[ai][bj][m][n] - mw; q += (d[0] * d[0] + d[1] * d[1]) + (d[2] * d[2] + d[3] * d[3]); }
                q += __shfl_xor(q, 16); q += __shfl_xor(q, 32);
                if (fq == 0) P[(ai * 128 + wr * 64 + m * 16 + fr) * 4 + wc] = (f32x2){mw, q}; }
        asm volatile("s_waitcnt lgkmcnt(0)" ::: "memory"); __builtin_amdgcn_s_barrier(); asm volatile("" ::: "memory");
        const int row = wid * 32 + (lane & 31);
        if (lane < 32) { const f32x2 a = P[row * 4 + 0], b = P[row * 4 + 1], c = P[row * 4 + 2], d = P[row * 4 + 3];
            const float mt = (a[0] + b[0] + c[0] + d[0]) * 0.25f; const float da = a[0] - mt, db = b[0] - mt, dc = c[0] - mt, dd = d[0] - mt;
            const float m2 = (a[1] + b[1]) + (c[1] + d[1]) + 64.0f * ((da * da + db * db) + (dc * dc + dd * dd));
            __hip_atomic_store(xbuf + ((size_t)(pm * 256 + row) * 8 + pn), ((unsigned long long)__float_as_uint(m2) << 32) | __float_as_uint(mt), __ATOMIC_RELAXED, __HIP_MEMORY_SCOPE_AGENT); }
        asm volatile("s_waitcnt vmcnt(0)" ::: "memory");
        if (lane == 0) __hip_atomic_fetch_add(cnt + 64 * pm, 1u, __ATOMIC_RELAXED, __HIP_MEMORY_SCOPE_AGENT);
        if (wid == 0) { unsigned sp = 0;
            while ((unsigned)__builtin_amdgcn_readfirstlane(__hip_atomic_load(cnt + 64 * pm, __ATOMIC_RELAXED, __HIP_MEMORY_SCOPE_AGENT)) < 64u) { __builtin_amdgcn_s_sleep(2); if (++sp > (1u << 22)) break; }
            __builtin_amdgcn_fence(__ATOMIC_ACQUIRE, "agent"); }
        asm volatile("s_waitcnt vmcnt(0) lgkmcnt(0)" ::: "memory"); __builtin_amdgcn_s_barrier(); asm volatile("" ::: "memory");
        if (lane < 32) { const unsigned long long* slot = xbuf + (size_t)(pm * 256 + row) * 8; float mt[8], m2[8]; float ms = 0.f;
#pragma unroll
            for (int t = 0; t < 8; ++t) { const unsigned long long w = __hip_atomic_load(slot + t, __ATOMIC_RELAXED, __HIP_MEMORY_SCOPE_AGENT); mt[t] = __uint_as_float((unsigned)w); m2[t] = __uint_as_float((unsigned)(w >> 32)); ms += mt[t]; }
            const float mean = ms * 0.125f; float q = 0.f;
#pragma unroll
            for (int t = 0; t < 8; ++t) { const float dm = mt[t] - mean; q += m2[t] + 256.0f * dm * dm; }
            S[row] = (f32x2){mean, 1.0f / sqrtf(q * (1.0f / 2048.0f) + eps)}; }
        asm volatile("s_waitcnt lgkmcnt(0)" ::: "memory"); __builtin_amdgcn_s_barrier(); asm volatile("" ::: "memory");
    } };
struct EpiResLn1 { static constexpr bool PERM = false, AFTER_DRAIN = true; bf16_t* HBp; const float *bias, *lng, *lnb; PanelStats8 st;
    __device__ __forceinline__ void fused(AccT& acc, const GUnit& u, int wr, int wc, int fr, int fq, LAS unsigned char* lds, int wid) const {
        const int pm = u.i0, pn = u.i1; const int c0 = pn * 256 + wc * 32 + 4 * fq; const LAS f32x2* S = (const LAS f32x2*)(lds + 8192);
#pragma unroll
        for (int bj = 0; bj < 2; ++bj)
#pragma unroll
            for (int n = 0; n < 2; ++n) { const f32x4 bv = *(const f32x4*)(bias + c0 + bj * 128 + n * 16);
#pragma unroll
                for (int ai = 0; ai < 2; ++ai)
#pragma unroll
                    for (int m = 0; m < 4; ++m) { const size_t off = (size_t)(pm * 256 + ai * 128 + wr * 64 + m * 16 + fr) * 2048 + c0 + bj * 128 + n * 16;
                        acc[ai][bj][m][n] += bv + DN_ALPHA * bf4(*(const u32x2*)(HBp + off)); } }
        st.run(acc, pm, pn, wr, wc, fr, fq, lds, wid);
#pragma unroll
        for (int bj = 0; bj < 2; ++bj)
#pragma unroll
            for (int n = 0; n < 2; ++n) { const f32x4 gg = *(const f32x4*)(lng + c0 + bj * 128 + n * 16), bb = *(const f32x4*)(lnb + c0 + bj * 128 + n * 16);
#pragma unroll
                for (int ai = 0; ai < 2; ++ai)
#pragma unroll
                    for (int m = 0; m < 4; ++m) { const int r = ai * 128 + wr * 64 + m * 16 + fr; const f32x2 sr = S[r]; const size_t off = (size_t)(pm * 256 + r) * 2048 + c0 + bj * 128 + n * 16;
                        const f32x4 o = (acc[ai][bj][m][n] - sr[0]) * sr[1] * gg + bb; u32x2 w; w.x = cvt_pk_bf16(o[0], o[1]); w.y = cvt_pk_bf16(o[2], o[3]); *(u32x2*)(HBp + off) = w; } }
    } };
struct EpiResLn2 { static constexpr bool PERM = false, AFTER_DRAIN = true; const bf16_t* HBp; const float *bias, *lng, *lnb; float* out; const bf16_t* SGPW; PanelStats8 st;
    __device__ __forceinline__ void fused(AccT& acc, const GUnit& u, int wr, int wc, int fr, int fq, LAS unsigned char* lds, int wid) const {
        const int pm = u.i0, pn = u.i1; const int c0 = pn * 256 + wc * 32 + 4 * fq; const LAS f32x2* S = (const LAS f32x2*)(lds + 8192);
        const bf16_t* sgp = SGPW + (size_t)pm * (1u << 20);
        f32x4 bv[2][2];
#pragma unroll
        for (int bj = 0; bj < 2; ++bj)
#pragma unroll
            for (int n = 0; n < 2; ++n) bv[bj][n] = *(const f32x4*)(bias + c0 + bj * 128 + n * 16);
#pragma unroll
        for (int ai = 0; ai < 2; ++ai)
#pragma unroll
            for (int m = 0; m < 4; ++m) { const int r = ai * 128 + wr * 64 + m * 16 + fr; const size_t lo = (size_t)r * 2048 + c0; const bf16_t* hp = HBp + (size_t)(pm * 256 + r) * 2048 + c0;
#pragma unroll
                for (int bj = 0; bj < 2; ++bj)
#pragma unroll
                    for (int n = 0; n < 2; ++n) { const int co = bj * 128 + n * 16;
                        acc[ai][bj][m][n] += bv[bj][n] + DN_ALPHA * bf4(*(const u32x2*)(hp + co)) + bf4(*(const u32x2*)(sgp + lo + co)) * bf4(*(const u32x2*)(sgp + (1u << 19) + lo + co)); }
                asm volatile("" : "+v"(acc[ai][0][m][0]), "+v"(acc[ai][0][m][1]), "+v"(acc[ai][1][m][0]), "+v"(acc[ai][1][m][1])); }
        st.run(acc, pm, pn, wr, wc, fr, fq, lds, wid);
#pragma unroll
        for (int bj = 0; bj < 2; ++bj)
#pragma unroll
            for (int n = 0; n < 2; ++n) { const f32x4 gg = *(const f32x4*)(lng + c0 + bj * 128 + n * 16), bb = *(const f32x4*)(lnb + c0 + bj * 128 + n * 16);
#pragma unroll
                for (int ai = 0; ai < 2; ++ai)
#pragma unroll
                    for (int m = 0; m < 4; ++m) { const int r = ai * 128 + wr * 64 + m * 16 + fr; const f32x2 sr = S[r];
                        *(f32x4*)(out + (size_t)(pm * 256 + r) * 2048 + c0 + bj * 128 + n * 16) = (acc[ai][bj][m][n] - sr[0]) * sr[1] * gg + bb; } }
    } };
struct EpiG { static constexpr bool PERM = true, AFTER_DRAIN = false; bf16_t *G0, *G1; const float* bias;
    __device__ __forceinline__ void operator()(AccT& acc, const GUnit& u, int wr, int wc, int fr, int fq) const {
        const int pm = u.i0, h = u.i1; bf16_t* base = (pm < 16 ? G0 : G1) + (size_t)(pm & 15) * 256 * 4096 + h * 256;
        epi_bf16_store<0>(acc, base, 4096, bias + h * 256, wr, wc, fr, fq); } };
__device__ __forceinline__ float bfu(unsigned short v) { return __uint_as_float(((unsigned)v) << 16); }
__device__ __forceinline__ void rg_gate(float pa, float px, float spv, float xc, float& a, float& b) {
    const float r = fast_sigmoid(pa), ig = fast_sigmoid(px); const float la = spv * r; a = __expf(la); const float x = 2.0f * la;
    const float om = -x * (1.0f + x * (0.5f + x * (0.16666667f + x * (0.041666668f + x * 0.008333334f))));
    b = __builtin_amdgcn_sqrtf(fmaxf(om, 0.f)) * ig * xc; }
__device__ __forceinline__ void rg_gate2(float pa, float px, float spv, float xc, float& a, float& b, float& r) {
    r = fast_sigmoid(pa); const float ig = fast_sigmoid(px); const float la = spv * r; a = __expf(la); const float x = 2.0f * la;
    const float om = -x * (1.0f + x * (0.5f + x * (0.16666667f + x * (0.041666668f + x * 0.008333334f))));
    b = __builtin_amdgcn_sqrtf(fmaxf(om, 0.f)) * ig * xc; }
struct RgCtx { const bf16_t *XR, *G0, *G1, *Z; const float *convw, *convb, *sp; float* agg; bf16_t* ypre; };
__device__ __forceinline__ const bf16_t* g_row(const RgCtx& R, int t) { return (t < 4096 ? R.G0 : R.G1) + (size_t)(t & 4095) * 4096; }
__device__ __forceinline__ void rg_pass_a(const RgCtx& R, int half, int seg, int tid) {
    const int c = half * 512 + tid, gcol = (c >> 6) * 256 + (c & 63) * 4, t0 = seg * 64;
    const float w0 = R.convw[c], w1 = R.convw[1024 + c], w2 = R.convw[2048 + c], w3 = R.convw[3072 + c], cb = R.convb[c], sp0 = R.sp[c], sp1 = R.sp[1024 + c];
    const bf16_t* xp = R.XR + c;
    float x0 = bfu(xp[(size_t)(t0 + 0) * 1024]), x1 = bfu(xp[(size_t)(t0 + 1) * 1024]), x2 = bfu(xp[(size_t)(t0 + 2) * 1024]);
    float Af = 1.f, Bf = 0.f, Ab = 1.f, Bb = 0.f;
    for (int tb = 0; tb < 64; tb += 16) {
        u32x2 gq[16]; unsigned short xn[16];
#pragma unroll
        for (int i = 0; i < 16; ++i) { const int t = t0 + tb + i; gq[i] = *(const u32x2*)(g_row(R, t) + gcol); xn[i] = xp[(size_t)(t + 3) * 1024]; }
#pragma unroll
        for (int i = 0; i < 16; ++i) { const float x3 = bfu(xn[i]); const float xc = cb + w0 * x0 + w1 * x1 + w2 * x2 + w3 * x3; x0 = x1; x1 = x2; x2 = x3;
            float a, b, r0, r1, b0; rg_gate2(bf_lo(gq[i].x), bf_lo(gq[i].y), sp0, xc, a, b, r0); Bf = a * Bf + b; Af = a * Af; b0 = b;
            rg_gate2(bf_hi(gq[i].x), bf_hi(gq[i].y), sp1, xc, a, b, r1); Bb = Ab * b + Bb; Ab = Ab * a;
            u32x2 w; w.x = cvt_pk_bf16(r0, r1); w.y = cvt_pk_bf16(b0, b); *(u32x2*)((bf16_t*)g_row(R, t0 + tb + i) + gcol) = w; }
    }
    *(f32x2*)(R.agg + ((size_t)(seg * 2 + 0) * 1024 + c) * 2) = (f32x2){Af, Bf};
    *(f32x2*)(R.agg + ((size_t)(seg * 2 + 1) * 1024 + c) * 2) = (f32x2){Ab, Bb};
}
__device__ __forceinline__ void rg_pass_c(const RgCtx& R, int half, int seg, int tid, LAS float* Lh) {
    const int c = half * 512 + tid, gcol = (c >> 6) * 256 + (c & 63) * 4, t0 = seg * 64;
    const float sp0 = R.sp[c], sp1 = R.sp[1024 + c];
    const f32x2* ag = (const f32x2*)R.agg;
    float hf = 0.f, hb = 0.f;
    {
#pragma unroll 1
        for (int sb = 0; sb < 128; sb += 32) { f32x2 ab[32];
#pragma unroll
            for (int i = 0; i < 32; ++i) { const int s2 = sb + i; ab[i] = (s2 < seg) ? ag[(size_t)(s2 * 2 + 0) * 1024 + c] : (f32x2){1.f, 0.f}; }
#pragma unroll
            for (int i = 0; i < 32; ++i) hf = ab[i][0] * hf + ab[i][1]; }
#pragma unroll 1
        for (int sb = 96; sb >= 0; sb -= 32) { f32x2 ab[32];
#pragma unroll
            for (int i = 0; i < 32; ++i) { const int s2 = sb + 31 - i; ab[i] = (s2 > seg) ? ag[(size_t)(s2 * 2 + 1) * 1024 + c] : (f32x2){1.f, 0.f}; }
#pragma unroll
            for (int i = 0; i < 32; ++i) hb = ab[i][0] * hb + ab[i][1]; }
    }
    {
        for (int tb = 0; tb < 64; tb += 16) {
            u32x2 gq[16];
#pragma unroll
            for (int i = 0; i < 16; ++i) gq[i] = *(const u32x2*)(g_row(R, t0 + tb + i) + gcol);
#pragma unroll
            for (int i = 0; i < 16; ++i) { const float a = __expf(sp0 * bf_lo(gq[i].x)); hf = a * hf + bf_lo(gq[i].y); Lh[(tb + i) * 512 + tid] = hf; }
        }
    }
    {
        for (int tb = 48; tb >= 0; tb -= 16) {
            u32x2 gq[16]; unsigned short zz[16];
#pragma unroll
            for (int i = 0; i < 16; ++i) { const int t = t0 + tb + 15 - i; gq[i] = *(const u32x2*)(g_row(R, t) + gcol); zz[i] = __builtin_nontemporal_load(R.Z + (size_t)t * 1024 + c); }
#pragma unroll
            for (int i = 0; i < 16; ++i) { const int tl = tb + 15 - i; const float a = __expf(sp1 * bf_hi(gq[i].x)); hb = a * hb + bf_hi(gq[i].y);
                const float o = (Lh[tl * 512 + tid] + hb) * gelu_tanh(bfu(zz[i]));
                R.ypre[(size_t)(t0 + tl) * 2048 + 1024 + c] = (bf16_t)(cvt_pk_bf16(o, 0.f) & 0xffffu); }
        }
    }
}

#ifndef NAIVE_GEMM
#define NAIVE_GEMM 0
#endif
template <class Epi, class Sched>
__device__ __forceinline__ void gemm_phase_naive(LAS unsigned char* lds, const int wid, const GParm gp, const Sched& S, const Epi& E) {
    const int lane = fresh_lane(), tid = wid * 64 + lane, wr = wid >> 2, wc = wid & 3, fr = lane & 15, fq = lane >> 4;
    GUnit cur;
    for (int ui = 0; S.next(ui, cur); ++ui) {
        f32x4 acc[2][2][4][2];
#pragma unroll
        for (int ai = 0; ai < 2; ++ai)
#pragma unroll
            for (int bj = 0; bj < 2; ++bj)
#pragma unroll
                for (int m = 0; m < 4; ++m)
#pragma unroll
                    for (int n = 0; n < 2; ++n)
#pragma unroll
                        for (int e = 0; e < 4; ++e) {
                            const int row = 128 * ai + 64 * wr + 16 * m + fr; const int col = Epi::PERM ? (128 * bj + 32 * wc + 8 * fq + 4 * n + e) : (128 * bj + 32 * wc + 16 * n + 4 * fq + e);
                            const char* ap = cur.A + (size_t)row * gp.a_rs; const char* bp = cur.B + (size_t)col * gp.K * 2; float sum = 0.f;
                            for (int k = 0; k < gp.K; k += 8) { const int kt = k >> 6, C = k & 63;
                                const u32x4 av = *(const u32x4*)(ap + (size_t)kt * gp.a_ks + ((C / gp.a_cw) * gp.a_cs + (C % gp.a_cw)) * 2), bv = *(const u32x4*)(bp + k * 2);
                                sum += bf_lo(av.x) * bf_lo(bv.x) + bf_hi(av.x) * bf_hi(bv.x) + bf_lo(av.y) * bf_lo(bv.y) + bf_hi(av.y) * bf_hi(bv.y) + bf_lo(av.z) * bf_lo(bv.z) + bf_hi(av.z) * bf_hi(bv.z) + bf_lo(av.w) * bf_lo(bv.w) + bf_hi(av.w) * bf_hi(bv.w); }
                            acc[ai][bj][m][n][e] = sum; }
        if constexpr (Epi::AFTER_DRAIN) { __syncthreads(); E.fused(acc, cur, wr, wc, fr, fq, lds, wid); } else E(acc, cur, wr, wc, fr, fq);
    }
    __syncthreads();
}
#if NAIVE_GEMM
#define GEMM_PHASE gemm_phase_naive
#else
#define GEMM_PHASE pg8::gemm_phase
#endif
__device__ __forceinline__ void transpose_item(const float* W, int K, int N, bf16_t* WT, LAS float* scr, int item, int lane) {
    const int nblk = N / 64, kb = item / nblk, nb = item % nblk, k0 = 64 * kb, n0 = 64 * nb;
    const float* src = W + (size_t)k0 * N + n0 + lane;
#pragma unroll 32
    for (int i = 0; i < 64; ++i) scr[i * 65 + lane] = __builtin_nontemporal_load(src + (size_t)i * N);
    LDS_WAIT();
    const int c = lane & 7;
#pragma unroll
    for (int j = 0; j < 8; ++j) { const int n = (lane >> 3) + 8 * j; const LAS float* sp = scr + (8 * c) * 65 + n;
        u32x4 o; o.x = cvt_pk_bf16(sp[0 * 65], sp[1 * 65]); o.y = cvt_pk_bf16(sp[2 * 65], sp[3 * 65]); o.z = cvt_pk_bf16(sp[4 * 65], sp[5 * 65]); o.w = cvt_pk_bf16(sp[6 * 65], sp[7 * 65]);
        *(u32x4*)(WT + (size_t)(n0 + n) * K + k0 + 8 * c) = o; }
    LDS_WAIT();
}
template <bool OUT_BF16> __device__ __forceinline__ void ln_row(const float* xrow, const float* g, const float* b, void* orow, int lane) {
    const f32x4* xr = (const f32x4*)xrow + lane; f32x4 v[8]; float s = 0.f;
#pragma unroll
    for (int j = 0; j < 8; ++j) { v[j] = __builtin_nontemporal_load(xr + 64 * j); s += (v[j][0] + v[j][1]) + (v[j][2] + v[j][3]); }
    const float mean = wave_sum(s) * (1.f / DM); float s2 = 0.f;
#pragma unroll
    for (int j = 0; j < 8; ++j) { v[j] = v[j] - mean; s2 += (v[j][0] * v[j][0] + v[j][1] * v[j][1]) + (v[j][2] * v[j][2] + v[j][3] * v[j][3]); }
    const float rstd = 1.0f / sqrtf(wave_sum(s2) * (1.f / DM) + LN_EPS);
#pragma unroll
    for (int j = 0; j < 8; ++j) { const f32x4 gg = ((const f32x4*)g)[lane + 64 * j], bb = ((const f32x4*)b)[lane + 64 * j]; const f32x4 o = v[j] * rstd * gg + bb;
        if (OUT_BF16) { u32x2 w; w.x = cvt_pk_bf16(o[0], o[1]); w.y = cvt_pk_bf16(o[2], o[3]); ((u32x2*)orow)[lane + 64 * j] = w; }
        else ((f32x4*)orow)[lane + 64 * j] = o; }
}
__device__ __forceinline__ void cpow(float lrs, float th, int j, float& re, float& im) {
    double a = (double)j * (double)th * 0.15915494309189535; a -= rint(a); const float af = 2.0f * (float)a;
    const float mag = expf((float)j * lrs); re = mag * cospif(af); im = mag * sinpif(af);
}


#ifndef NAIVE_RG
#define NAIVE_RG 0
#endif
__device__ __forceinline__ void naive_rg_channel(const RgCtx& R, int c) {
    const int gcol = (c >> 6) * 256 + (c & 63);
    const float w0 = R.convw[c], w1 = R.convw[1024 + c], w2 = R.convw[2048 + c], w3 = R.convw[3072 + c], cb = R.convb[c], sp0 = R.sp[c], sp1 = R.sp[1024 + c];
    const bf16_t* xp = R.XR + c; float h = 0.f;
    for (int t = 0; t < SEQ; ++t) { const float xc = cb + w0 * bfu(xp[(size_t)t * 1024]) + w1 * bfu(xp[(size_t)(t + 1) * 1024]) + w2 * bfu(xp[(size_t)(t + 2) * 1024]) + w3 * bfu(xp[(size_t)(t + 3) * 1024]);
        const bf16_t* g = g_row(R, t) + gcol; float a, b; rg_gate(bfu(g[0]), bfu(g[128]), sp0, xc, a, b); h = a * h + b;
        R.ypre[(size_t)t * 2048 + 1024 + c] = (bf16_t)(cvt_pk_bf16(h, 0.f) & 0xffffu); }
    __builtin_amdgcn_fence(__ATOMIC_SEQ_CST, "agent");
    h = 0.f;
    for (int t = SEQ - 1; t >= 0; --t) { const float xc = cb + w0 * bfu(xp[(size_t)t * 1024]) + w1 * bfu(xp[(size_t)(t + 1) * 1024]) + w2 * bfu(xp[(size_t)(t + 2) * 1024]) + w3 * bfu(xp[(size_t)(t + 3) * 1024]);
        const bf16_t* g = g_row(R, t) + gcol; float a, b; rg_gate(bfu(g[64]), bfu(g[192]), sp1, xc, a, b); h = a * h + b;
        const size_t o = (size_t)t * 2048 + 1024 + c; const float y = (bfu(R.ypre[o]) + h) * gelu_tanh(bfu(R.Z[(size_t)t * 1024 + c]));
        R.ypre[o] = (bf16_t)(cvt_pk_bf16(y, 0.f) & 0xffffu); }
}

#ifndef NAIVE_S5
#define NAIVE_S5 0
#endif
__device__ __forceinline__ void naive_s5_group(const float* const* in, const bf16_t* U, float* tmp, bf16_t* YG, int g, int lane) {
    const float *lre = in[6], *lim = in[7], *lstep = in[8], *bre = in[9], *bim = in[10], *cre = in[11], *cim = in[12], *dd = in[13];
    for (int n = 0; n < 2; ++n) {
        const int p = lane, pi = (n * 64 + g) * 64 + p;
        const float lr = fminf(lre[pi], -1e-4f), li = lim[pi], step = expf(lstep[n * 64 + g]); float ar, ai; cpow(lr * step, li * step, 1, ar, ai);
        const float nr = ar - 1.0f, ni = ai, den = lr * lr + li * li; const float qr = (nr * lr + ni * li) / den, qi = (ni * lr - nr * li) / den;
        float hr = 0.f, hi = 0.f;
        for (int tt = 0; tt < SEQ; ++tt) { const int t = n == 0 ? tt : SEQ - 1 - tt; const bf16_t* up = U + (size_t)t * 1024 + g * 16;
            float bur = 0.f, bui = 0.f;
#pragma unroll
            for (int k = 0; k < 16; ++k) { const float uv = bfu(up[k]); const float br = bre[(size_t)pi * 16 + k], bi = bim[(size_t)pi * 16 + k]; bur += (qr * br - qi * bi) * uv; bui += (qr * bi + qi * br) * uv; }
            const float nhr = ar * hr - ai * hi + bur, nhi = ar * hi + ai * hr + bui; hr = nhr; hi = nhi;
#pragma unroll
            for (int k = 0; k < 16; ++k) { const size_t ci = ((size_t)(n * 64 + g) * 16 + k) * 64 + p; float v = cre[ci] * hr - cim[ci] * hi; v = wave_sum(v);
                if (lane == k) { const size_t o = (size_t)t * 1024 + g * 16 + k;
                    if (n == 0) tmp[o] = v; else { const float y = tmp[o] + v + dd[g * 16 + k] * bfu(up[k]); YG[o] = (bf16_t)(cvt_pk_bf16(gelu_tanh(y), 0.f) & 0xffffu); } } }
        }
        __builtin_amdgcn_fence(__ATOMIC_SEQ_CST, "agent");
    }
}

#define XB_TMO      128
#define XB_XCNT(j)  (256  + 64 * (j))
#define XB_XSUB(j)  (1280 + 64 * (j))
#define XB_XGEN(j)  (2304 + 64 * (j))
#define XB_TOP      3328
#define XB_TOPGEN   3392
#define XCD_BAR_WORDS 3456
#define XB_SPIN_CAP (1u << 18)
__device__ __forceinline__ unsigned xb_ld(unsigned* p)              { return __hip_atomic_load(p, __ATOMIC_RELAXED, __HIP_MEMORY_SCOPE_AGENT); }
__device__ __forceinline__ unsigned xb_add(unsigned* p, unsigned v) { return __hip_atomic_fetch_add(p, v, __ATOMIC_RELAXED, __HIP_MEMORY_SCOPE_AGENT); }
__device__ __forceinline__ unsigned xb_xcc_id() { return (unsigned)__builtin_amdgcn_s_getreg((3 << 11) | 20) & 0xFu; }
#define XB_SPIN(cond, bar) do { unsigned _sp = 0; while (cond) { __builtin_amdgcn_s_sleep(1); \
    if ((++_sp & 255u) == 0u) { if (xb_ld(&(bar)[XB_TMO])) break; if (_sp > XB_SPIN_CAP) { atomicAdd(&(bar)[XB_TMO], 1u); break; } } } } while (0)
struct XcdBarrier { unsigned* bar; unsigned x; volatile LAS unsigned* st; };
__device__ __forceinline__ void xcd_barrier_complete(unsigned* bar, unsigned x, unsigned G, unsigned& nloc, unsigned& nx) {
    unsigned sum, cnt, mine, sp = 0u;
    for (;;) {
        sum = 0u; cnt = 0u; mine = 0u;
#pragma unroll
        for (unsigned j = 0; j < 16; ++j) { const unsigned c = xb_ld(&bar[XB_XCNT(j)]); sum += c; cnt += (c > 0u) ? 1u : 0u; mine = (j == x) ? c : mine; }
        if (sum == G) break;
        __builtin_amdgcn_s_sleep(1);
        if ((++sp & 255u) == 0u) { if (xb_ld(&bar[XB_TMO])) break; if (sp > XB_SPIN_CAP) { atomicAdd(&bar[XB_TMO], 1u); break; } }
    }
    nloc = mine > 0u ? mine : 1u; nx = cnt > 0u ? cnt : 1u;
}
__device__ __forceinline__ void xcd_barrier(const XcdBarrier& b, unsigned G, int wave) {
    asm volatile("s_waitcnt vmcnt(0)" ::: "memory");
    __syncthreads();
    if (wave == 0) { if (fresh_lane() == 0) {
        unsigned* bar = b.bar;
        __builtin_amdgcn_s_waitcnt(0);
        unsigned nloc = b.st[0], nx = b.st[1];
        if (nloc == 0u) { xcd_barrier_complete(bar, b.x, G, nloc, nx); b.st[0] = nloc; b.st[1] = nx; }
        const unsigned old = xb_add(&bar[XB_XSUB(b.x)], 1u);
        const unsigned gen = old / nloc;
        if (old + 1u == (gen + 1u) * nloc) {
            __builtin_amdgcn_fence(__ATOMIC_RELEASE, "agent");
            asm volatile("s_waitcnt vmcnt(0)" ::: "memory");
            const unsigned og = xb_add(&bar[XB_TOP], 1u);
            const unsigned tg = og / nx;
            if (og + 1u == (tg + 1u) * nx) xb_add(&bar[XB_TOPGEN], 1u);
            else XB_SPIN(xb_ld(&bar[XB_TOPGEN]) == tg, bar);
            __builtin_amdgcn_fence(__ATOMIC_ACQUIRE, "agent");
            xb_add(&bar[XB_XGEN(b.x)], 1u);
            asm volatile("s_waitcnt vmcnt(0)" ::: "memory");
        } else {
            XB_SPIN(xb_ld(&bar[XB_XGEN(b.x)]) == gen, bar);
            __builtin_amdgcn_fence(__ATOMIC_ACQUIRE, "agent");
            asm volatile("s_waitcnt vmcnt(0)" ::: "memory");
        }
    } }
    __syncthreads();
}

__device__ __forceinline__ void grid_barrier(unsigned* bar, unsigned target, int wave) {
    asm volatile("s_waitcnt vmcnt(0)" ::: "memory");
    __syncthreads();
    if (wave == 0) { const int l = fresh_lane();
        if (l == 0) {
            __builtin_amdgcn_fence(__ATOMIC_RELEASE, "agent"); asm volatile("s_waitcnt vmcnt(0)" ::: "memory");
            __hip_atomic_fetch_add(bar, 1u, __ATOMIC_RELAXED, __HIP_MEMORY_SCOPE_AGENT);
            while (__hip_atomic_load(bar, __ATOMIC_RELAXED, __HIP_MEMORY_SCOPE_AGENT) < target) __builtin_amdgcn_s_sleep(2);
            __builtin_amdgcn_fence(__ATOMIC_ACQUIRE, "agent"); asm volatile("s_waitcnt vmcnt(0)" ::: "memory");
        } }
    __syncthreads();
}

struct Args { const float* in[38]; float* out; unsigned char* ws; int ph_lo, ph_hi; };
typedef const float* cfp_t;
typedef const __attribute__((address_space(4))) cfp_t* kin_t;

__device__ __forceinline__ void s5_precompute(const kin_t ain, unsigned char* aws, int g, int hq, int nh, LAS float* L, const int tid) {
    const float *lre = ain[6], *lim = ain[7], *lstep = ain[8], *bre = ain[9], *bim = ain[10], *cre = ain[11], *cim = ain[12], *dd = ain[13];
    LAS float *PWre = L, *PWim = L + 4224, *BBre = L + 8448, *BBim = L + 10496, *CCre = L + 12544, *CCim = L + 14592, *MT = L + 16640, *C2re = L + 33280, *C2im = L + 35328, *Dl = L + 37376;
    bf16_t* WGg = (bf16_t*)(aws + WS_WG) + (size_t)g * 768 * 512; bf16_t* WCg = (bf16_t*)(aws + WS_WC) + (size_t)g * 512 * 256;
#define PSTAMP(i) do { if (TSTAMP && blockIdx.x == 128 && tid == 0) ((unsigned long long*)(aws + WS_CTR + 1024))[i] = __builtin_amdgcn_s_memrealtime(); } while (0)
    PSTAMP(20);
    {
        const int np = tid & 127, jj = tid >> 7, n = np >> 6, p = np & 63; const int pi = (n * 64 + g) * 64 + p;
        const float lr = fminf(lre[pi], -1e-4f), li = lim[pi], step = expf(lstep[n * 64 + g]); const float lrs = lr * step, th = li * step;
        for (int j = jj; j <= 32; j += 4) { float r, i; cpow(lrs, th, j, r, i); PWre[np * 33 + j] = r; PWim[np * 33 + j] = i; }
        float l1r, l1i; cpow(lrs, th, 1, l1r, l1i);
        const float nr = l1r - 1.0f, ni = l1i, den = lr * lr + li * li; const float qr = (nr * lr + ni * li) / den, qi = (ni * lr - nr * li) / den;
#pragma unroll
        for (int k = jj * 4; k < jj * 4 + 4; ++k) { const float br = bre[(size_t)pi * 16 + k], bi = bim[(size_t)pi * 16 + k]; BBre[np * 16 + k] = qr * br - qi * bi; BBim[np * 16 + k] = qr * bi + qi * br; }
        for (int e = tid; e < 2048; e += 512) { const int n2 = e >> 10, k = (e >> 6) & 15, p2 = e & 63; const size_t ci = ((size_t)(n2 * 64 + g) * 16 + k) * 64 + p2; CCre[(n2 * 64 + p2) * 16 + k] = cre[ci]; CCim[(n2 * 64 + p2) * 16 + k] = cim[ci]; C2re[e] = cre[ci]; C2im[e] = cim[ci]; }
        if (tid < 16) Dl[tid] = dd[g * 16 + tid];
    }
    __syncthreads();
    PSTAMP(21);
    for (int i = 0; i < 3; ++i) {
        if (nh == 2) { if (i < 2 && i != hq) continue; if (i == 2 && (hq != 0 || tid >= 16)) continue; } else if (i == 2) continue;
        const int bq = (i == 2) ? 512 + tid : tid + 512 * i, n = bq >> 9, j = (bq >> 4) & 31, kob = (bq >> 2) & 3, kib = bq & 3;
        f32x4 m0 = {0.f, 0.f, 0.f, 0.f}, m1 = m0, m2 = m0, m3 = m0;
        for (int p = 0; p < 64; ++p) { const int np = n * 64 + p; const float pr = PWre[np * 33 + j], pi2 = PWim[np * 33 + j];
            const f32x4 br = *(const LAS f32x4*)(BBre + np * 16 + 4 * kib), bi = *(const LAS f32x4*)(BBim + np * 16 + 4 * kib), cr = *(const LAS f32x4*)(CCre + np * 16 + 4 * kob), ci = *(const LAS f32x4*)(CCim + np * 16 + 4 * kob);
            const f32x4 er = pr * br - pi2 * bi, ei = pr * bi + pi2 * br;
            m0 += cr[0] * er - ci[0] * ei; m1 += cr[1] * er - ci[1] * ei; m2 += cr[2] * er - ci[2] * ei; m3 += cr[3] * er - ci[3] * ei; }
        LAS float* o = MT + (n * 32 + j) * 260 + (4 * kob) * 16 + 4 * kib;
        *(LAS f32x4*)o = m0; *(LAS f32x4*)(o + 16) = m1; *(LAS f32x4*)(o + 32) = m2; *(LAS f32x4*)(o + 48) = m3;
    }
    __syncthreads();
    PSTAMP(22);
    for (int i = 0; i < 64; ++i) {
        const int idx = tid + 512 * i, row = idx >> 6, cp = idx & 63, t = row >> 4, ko = row & 15, s = cp >> 1, ki0 = (cp & 1) * 8;
        if (nh == 2 && ((t >= s) != (hq == 0))) continue;
        f32x4 v0, v1;
        if (t != s) { const LAS float* src = MT + ((t > s ? 0 : 1) * 32 + (t > s ? t - s : s - t)) * 260 + ko * 16 + ki0; v0 = *(const LAS f32x4*)src; v1 = *(const LAS f32x4*)(src + 4); }
        else { const LAS float* s0 = MT + ko * 16 + ki0; const LAS float* s1 = MT + 32 * 260 + ko * 16 + ki0; v0 = *(const LAS f32x4*)s0 + *(const LAS f32x4*)s1; v1 = *(const LAS f32x4*)(s0 + 4) + *(const LAS f32x4*)(s1 + 4);
            const float dv = Dl[ko];
#pragma unroll
            for (int e = 0; e < 4; ++e) { if (ki0 + e == ko) v0[e] += dv; if (ki0 + 4 + e == ko) v1[e] += dv; } }
        u32x4 w; w.x = cvt_pk_bf16(v0[0], v0[1]); w.y = cvt_pk_bf16(v0[2], v0[3]); w.z = cvt_pk_bf16(v1[0], v1[1]); w.w = cvt_pk_bf16(v1[2], v1[3]);
        *(u32x4*)(WGg + (size_t)row * 512 + cp * 8) = w;
    }
    for (int i = hq * (32 / nh); i < (hq + 1) * (32 / nh); ++i) {
        const int idx = tid + 512 * i, q = idx >> 6, cp = idx & 63, n = q >> 7, ri = (q >> 6) & 1, p = q & 63, s = cp >> 1, ki0 = (cp & 1) * 8, e = n == 0 ? 31 - s : s, np = n * 64 + p;
        const float pr = PWre[np * 33 + e], pi2 = PWim[np * 33 + e]; float v[8];
#pragma unroll
        for (int k = 0; k < 8; ++k) { const float br = BBre[np * 16 + ki0 + k], bi = BBim[np * 16 + ki0 + k]; v[k] = ri == 0 ? pr * br - pi2 * bi : pr * bi + pi2 * br; }
        u32x4 w; w.x = cvt_pk_bf16(v[0], v[1]); w.y = cvt_pk_bf16(v[2], v[3]); w.z = cvt_pk_bf16(v[4], v[5]); w.w = cvt_pk_bf16(v[6], v[7]);
        *(u32x4*)(WGg + (size_t)(512 + q) * 512 + cp * 8) = w;
    }
    for (int i = 0; i < 32 / nh; ++i) {
        const int idx = tid + 512 * i, row = nh == 2 ? idx >> 4 : idx >> 5, q0 = nh == 2 ? hq * 128 + (idx & 15) * 8 : (idx & 31) * 8, n = q0 >> 7, ri = (q0 >> 6) & 1, p0 = q0 & 63, t = row >> 4, ko = row & 15, e = n == 0 ? t + 1 : 32 - t; float v[8];
#pragma unroll
        for (int k = 0; k < 8; ++k) { const int np = n * 64 + p0 + k; const float cr = C2re[(n * 16 + ko) * 64 + p0 + k], ci = C2im[(n * 16 + ko) * 64 + p0 + k], pr = PWre[np * 33 + e], pi2 = PWim[np * 33 + e];
            v[k] = ri == 0 ? cr * pr - ci * pi2 : -(cr * pi2 + ci * pr); }
        u32x4 w; w.x = cvt_pk_bf16(v[0], v[1]); w.y = cvt_pk_bf16(v[2], v[3]); w.z = cvt_pk_bf16(v[4], v[5]); w.w = cvt_pk_bf16(v[6], v[7]);
        *(u32x4*)(WCg + (size_t)row * 256 + q0) = w;
    }
    __syncthreads();
    PSTAMP(23);
}


#ifndef DIAG
#define DIAG 0
#endif
__device__ __forceinline__ void diag_ffn(const float* const* in, const unsigned char* ws, const float* outp, unsigned* flagw, int gtid, int GT) {
    const bf16_t* h1 = (const bf16_t*)(ws + WS_HB); const bf16_t* T = (const bf16_t*)(ws + WS_T); const float* V2 = (const float*)(ws + WS_V2);
    const float *w1 = in[29], *b1 = in[30], *w2 = in[31], *b2 = in[32], *wp = in[33], *wg = in[34], *bg = in[35], *pp = in[1];
    for (int sidx = gtid; sidx < 16384; sidx += GT) {
        unsigned hsh = (unsigned)sidx * 2654435761u, h2 = ((unsigned)sidx + 977u) * 2246822519u; const int r = (hsh >> 8) % SEQ; const int c = (h2 >> 6) % DFF; const int c2 = c % DM;
        float a = b1[c]; for (int k = 0; k < DM; ++k) a += bfu(h1[(size_t)r * DM + k]) * w1[(size_t)k * DFF + c];
        a = fmaxf(a, 0.f); a = a * a; const float tv = bfu(T[(size_t)r * DFF + c]);
        if (fabsf(tv - a) > 0.008f * fabsf(a) + 0.006f) atomicAdd(flagw + 0, 1u);
        float f = b2[c2]; for (int k = 0; k < DFF; ++k) f += bfu(T[(size_t)r * DFF + k]) * w2[(size_t)k * DM + c2];
        float gt = bg[c2]; for (int k = 0; k < DM; ++k) gt += bfu(h1[(size_t)r * DM + k]) * wg[(size_t)k * DM + c2];
        float pw = 0.f; for (int k = 0; k < PLE; ++k) pw += pp[(size_t)r * PLE + k] * wp[(size_t)k * DM + c2];
        const float v2 = DN_ALPHA * bfu(h1[(size_t)r * DM + c2]) + f + fast_sigmoid(gt) * pw; const float got = V2[(size_t)r * DM + c2];
        if (fabsf(got - v2) > 0.008f * fabsf(v2) + 0.006f) atomicAdd(flagw + 1, 1u);
        { const float* vr = V2 + (size_t)r * DM; float m = 0.f; for (int k = 0; k < DM; ++k) m += vr[k]; m /= DM; float v = 0.f; for (int k = 0; k < DM; ++k) { const float d = vr[k] - m; v += d * d; } v /= DM;
          const float e = (vr[c2] - m) / sqrtf(v + LN_EPS) * in[36][c2] + in[37][c2]; const float go = outp[(size_t)r * DM + c2]; if (fabsf(go - e) > 0.004f * fabsf(e) + 0.003f) atomicAdd(flagw + 2, 1u); }
    }
}

__device__ __forceinline__ void diag_pre(const float* const* in, const unsigned char* ws, const unsigned char* dout, unsigned* flagw, int gtid, int GT) {
    const bf16_t* h0 = (const bf16_t*)(ws + WS_HB); const bf16_t* U = (const bf16_t*)(dout + DO_U); const bf16_t* XRb = (const bf16_t*)(ws + WS_XR) + 2048; const bf16_t* Z = (const bf16_t*)(dout + DO_Z);
    const bf16_t* ypre = (const bf16_t*)(dout + DO_YPRE); const bf16_t* ycat = (const bf16_t*)(ws + WS_YCAT); const bf16_t* yg = (const bf16_t*)(ws + WS_YS5G);
    const float *x = in[0], *lg = in[2], *lb = in[3], *win = in[4], *bin = in[5], *gw_ = in[14], *gb = in[15], *g5 = in[23], *gr = in[24];
    for (int sidx = gtid; sidx < 8192; sidx += GT) {
        unsigned hsh = (unsigned)sidx * 2654435761u, h2 = ((unsigned)sidx + 977u) * 2246822519u; const int r = (hsh >> 8) % SEQ; const int c = (h2 >> 6) % DIN; const int c2 = c % DM; const int c1 = c % DS5;
        { float m = 0.f; for (int k = 0; k < DM; ++k) m += x[(size_t)r * DM + k]; m /= DM; float v = 0.f; for (int k = 0; k < DM; ++k) { const float d = x[(size_t)r * DM + k] - m; v += d * d; } v /= DM;
          const float e = (x[(size_t)r * DM + c2] - m) / sqrtf(v + LN_EPS) * lg[c2] + lb[c2]; const float got = bfu(h0[(size_t)r * DM + c2]); if (fabsf(got - e) > 0.008f * fabsf(e) + 0.006f) atomicAdd(flagw + 0, 1u); }
        { float a = bin[c]; for (int k = 0; k < DM; ++k) a += bfu(h0[(size_t)r * DM + k]) * win[(size_t)k * DIN + c];
          const float got = c < 1024 ? bfu(U[(size_t)r * 1024 + c]) : (c < 2048 ? bfu(XRb[(size_t)r * 1024 + c - 1024]) : bfu(Z[(size_t)r * 1024 + c - 2048])); if (fabsf(got - a) > 0.008f * fabsf(a) + 0.006f) atomicAdd(flagw + 3, 1u); }
        { const int hf = c2 >> 10; float ss = 0.f; for (int k = 0; k < 1024; ++k) { const float y = bfu(ypre[(size_t)r * DM + hf * 1024 + k]); ss += y * y; }
          const float e = bfu(ypre[(size_t)r * DM + c2]) / sqrtf(ss / 1024.f + LN_EPS) * (hf ? gr[c2 - 1024] : g5[c2]); const float got = bfu(ycat[(size_t)r * DM + c2]); if (fabsf(got - e) > 0.008f * fabsf(e) + 0.006f) atomicAdd(flagw + 1, 1u); }
        { float a = gb[c1]; for (int k = 0; k < DS5; ++k) a += bfu(yg[(size_t)r * DS5 + k]) * gw_[(size_t)k * DS5 + c1];
          const float e = bfu(yg[(size_t)r * DS5 + c1]) * fast_sigmoid(a); const float got = bfu(ypre[(size_t)r * DM + c1]); if (fabsf(got - e) > 0.008f * fabsf(e) + 0.006f) atomicAdd(flagw + 2, 1u); }
    }
}

__device__ __forceinline__ void diag_v(const float* const* in, const unsigned char* ws, const unsigned char* dout, unsigned* flagw, int gtid, int GT) {
    const bf16_t* h0 = (const bf16_t*)(ws + WS_HB); const bf16_t* ycat = (const bf16_t*)(ws + WS_YCAT); const float* V = (const float*)dout; const float *wo = in[25], *bo = in[26];
    for (int sidx = gtid; sidx < 16384; sidx += GT) { unsigned hsh = (unsigned)sidx * 2654435761u, h2 = ((unsigned)sidx + 977u) * 2246822519u; const int r = (hsh >> 8) % SEQ; const int c = (h2 >> 6) % DM;
        float a = bo[c] + DN_ALPHA * bfu(h0[(size_t)r * DM + c]); for (int k = 0; k < DM; ++k) a += bfu(ycat[(size_t)r * DM + k]) * wo[(size_t)k * DM + c];
        const float got = V[(size_t)r * DM + c]; if (fabsf(got - a) > 0.008f * fabsf(a) + 0.006f) atomicAdd(flagw + 0, 1u); }
}

__device__ __forceinline__ void diag_g(const float* const* in, const unsigned char* ws, unsigned* flagw, int gtid, int GT) {
    const bf16_t* XRp = (const bf16_t*)(ws + WS_XR); const bf16_t* G0 = (const bf16_t*)(ws + WS_G0); const bf16_t* G1 = (const bf16_t*)(ws + WS_G1);
    const float *convw = in[16], *convb = in[17], *wa = in[18], *ba = in[19], *wx = in[20], *bxx = in[21];
    for (int sidx = gtid; sidx < 16384; sidx += GT) { unsigned hsh = (unsigned)sidx * 2654435761u; unsigned h2 = ((unsigned)sidx + 12345u) * 2246822519u; const int t = (hsh >> 7) % SEQ; const int col = (h2 >> 5) % 4096;
        const int h = col >> 8, row = col & 255, bj = row >> 7, dir = (row >> 6) & 1, ch = row & 63;
        const float* W = (bj == 0 ? wa : wx) + ((size_t)(dir * 16 + h) * 64) * 64 + ch; float a = (bj == 0 ? ba : bxx)[(dir * 16 + h) * 64 + ch];
        for (int i = 0; i < 64; ++i) { const int c = 64 * h + i; float xc = convb[c];
            for (int j = 0; j < 4; ++j) xc += convw[j * 1024 + c] * bfu(XRp[(size_t)(t + j) * 1024 + c]);
            a += xc * W[(size_t)i * 64]; }
        const float got = bfu((t < 4096 ? G0 : G1)[(size_t)(t & 4095) * 4096 + col]);
        if (fabsf(got - a) > 0.008f * fabsf(a) + 0.006f) atomicAdd(flagw + 0, 1u); }
}

#ifndef DIAG_HALF
#define DIAG_HALF 1
#endif
__device__ __forceinline__ void diag_max(const unsigned char* ws, unsigned* flagw, int gtid, int GT) {
    const bf16_t* ycat = (const bf16_t*)(ws + WS_YCAT); float mx = 0.f;
    for (size_t i = gtid; i < (size_t)SEQ * 1024; i += GT) { const size_t r = i >> 10, c = (i & 1023) + DIAG_HALF * 1024; mx = fmaxf(mx, fabsf(bfu(ycat[r * DM + c]))); }
    atomicMax(flagw + 0, __float_as_uint(mx));
}

#ifndef DIAG_SEL
#define DIAG_SEL 4
#endif
__device__ __forceinline__ void diag_rows(const float* outp, unsigned* flagw, int gw, int NGW, int lane) {
    for (int row = gw; row < SEQ; row += NGW) { float mx = 0.f; for (int j = lane; j < DM; j += 64) mx = fmaxf(mx, fabsf(outp[(size_t)row * DM + j]));
#pragma unroll
        for (int o = 1; o < 64; o <<= 1) mx = fmaxf(mx, __shfl_xor(mx, o));
        if (lane == 0 && mx > 12.0f) { atomicAdd(flagw + 0, 1u); atomicMin(flagw + 1, (unsigned)row); atomicMax(flagw + 2, (unsigned)row); } }
}

__device__ __forceinline__ void diag_rows_bf(const bf16_t* p, int ld, float thr, unsigned* flagw, int gw, int NGW, int lane) {
    for (int row = gw; row < SEQ; row += NGW) { float mx = 0.f; for (int j = lane; j < ld; j += 64) mx = fmaxf(mx, fabsf(bfu(p[(size_t)row * ld + j])));
#pragma unroll
        for (int o = 1; o < 64; o <<= 1) mx = fmaxf(mx, __shfl_xor(mx, o));
        if (lane == 0 && mx > thr) { atomicAdd(flagw + 0, 1u); atomicMin(flagw + 1, (unsigned)row); atomicMax(flagw + 2, (unsigned)row); } }
}
template <int PHMASK> __global__ void __launch_bounds__(512, 2) mega(Args) {
    extern __shared__ __attribute__((aligned(16))) unsigned char lds_raw[];
    LAS unsigned char* lds = (LAS unsigned char*)lds_raw;
    const int wave = __builtin_amdgcn_readfirstlane((int)threadIdx.x >> 6);
    const int G = gridDim.x, bx = blockIdx.x;
    const int gw = bx * 8 + wave, NGW = G * 8, GT = G * 512;
#define PH_IDS const int lane = fresh_lane(), tid = wave * 64 + lane, gtid = bx * 512 + tid; (void)tid; (void)gtid; (void)lane
    const kin_t KIN = (kin_t)__builtin_amdgcn_kernarg_segment_ptr();
    unsigned char* ws = (unsigned char*)KIN[39]; unsigned char* dout = (unsigned char*)KIN[38];
    const int* kint = (const int*)0; (void)kint;
#if DIAG == 2
    const int lo = ((const __attribute__((address_space(4))) int*)KIN)[80], hi = 7;
#elif DIAG == 3
    const int lo = ((const __attribute__((address_space(4))) int*)KIN)[80], hi = 8;
#elif DIAG == 4
    const int lo = ((const __attribute__((address_space(4))) int*)KIN)[80], hi = 5;
#elif DIAG == 6
    const int lo = ((const __attribute__((address_space(4))) int*)KIN)[80], hi = 7;
#elif DIAG == 8
    const int lo = ((const __attribute__((address_space(4))) int*)KIN)[80], hi = 9;
#elif DIAG == 11 || DIAG == 12
    const int lo = ((const __attribute__((address_space(4))) int*)KIN)[80], hi = 10;
#else
    const int lo = ((const __attribute__((address_space(4))) int*)KIN)[80], hi = ((const __attribute__((address_space(4))) int*)KIN)[81];
#endif
#define IN(k) (((PHMASK >> (k)) & 1) && lo <= (k) && (k) < hi)
    unsigned nbar = 0; unsigned* gbar = (unsigned*)(ws + WS_CTR) + 32; (void)gbar;
    XcdBarrier xb; xb.bar = (unsigned*)(ws + WS_CTR) + 5120; xb.x = xb_xcc_id(); xb.st = (volatile LAS unsigned*)(lds + 155000);
    if (wave == 0) { if (fresh_lane() == 0) { xb.st[0] = 0u; xb.st[1] = 0u; (void)xb_add(&xb.bar[XB_XCNT(xb.x)], 1u); } }
    __syncthreads();
    if (PHMASK == 0xfff && hi > 4096) cg::this_grid().sync();
#ifndef DBL_MASK
#define DBL_MASK 0
#endif
#define REPS(k) (((DBL_MASK >> (k)) & 1) ? 2 : 1)
#define SEAM(k) do { if (IN(k) && IN((k) + 1)) { ++nbar; xcd_barrier(xb, (unsigned)G, wave); if (TSTAMP && bx == 0 && wave == 0) { if (fresh_lane() == 0) ((unsigned long long*)(ws + WS_CTR + 1024))[(k) + 1] = __builtin_amdgcn_s_memrealtime(); } } } while (0)

#define MK_RG const RgCtx RG{(const bf16_t*)(ws + WS_XR), (const bf16_t*)(ws + WS_G0), (const bf16_t*)(ws + WS_G1), (const bf16_t*)(dout + DO_Z), KIN[16], KIN[17], (const float*)(ws + WS_SP), (float*)(ws + WS_AGG), (bf16_t*)(dout + DO_YPRE)}
    if (TSTAMP && bx == 0 && wave == 0) { if (fresh_lane() == 0) ((unsigned long long*)(ws + WS_CTR + 1024))[0] = __builtin_amdgcn_s_memrealtime(); }
    for (int rep = 0; rep < REPS(0); ++rep) {
    if (IN(0)) { PH_IDS;
        if (G != 256) { for (int g = bx; g < 64; g += G) s5_precompute(KIN, ws, g, 0, 1, (LAS float*)lds, tid); }
        {
            LAS float* scr = (LAS float*)(lds + wave * 16640);
            constexpr int I_IN = (DM / 64) * (DIN / 64), I_OUT = (DM / 64) * (DM / 64), I_PG = I_OUT, I_GLU = (DS5 / 64) * (DS5 / 64), I_PW = (PLE / 64) * (DM / 64), I_LN = SEQ / 4;
            constexpr int NITEMS = I_IN + I_OUT + I_PG + I_GLU + I_PW + I_LN;
            for (int it = gw; it < NITEMS; it += NGW) {
                int r = it;
                if (r < I_IN) { transpose_item(KIN[4], DM, DIN, (bf16_t*)(ws + WS_WINT), scr, r, lane); continue; } r -= I_IN;
                if (r < I_LN) { for (int q = 0; q < 4; ++q) { const int row = r * 4 + q; ln_row<true>(KIN[0] + (size_t)row * DM, KIN[2], KIN[3], (bf16_t*)(ws + WS_HB) + (size_t)row * DM, lane); } continue; } r -= I_LN;
                if (r < I_OUT) { transpose_item(KIN[25], DM, DM, (bf16_t*)(ws + WS_WOUTT), scr, r, lane); continue; } r -= I_OUT;
                if (r < I_PG) { transpose_item(KIN[34], DM, DM, (bf16_t*)(ws + WS_PLEGT), scr, r, lane); continue; } r -= I_PG;
                if (r < I_GLU) { transpose_item(KIN[14], DS5, DS5, (bf16_t*)(ws + WS_GLUT), scr, r, lane); continue; } r -= I_GLU;
                transpose_item(KIN[33], PLE, DM, (bf16_t*)(ws + WS_PLEWT), scr, r, lane);
            }
        }
        {   const float* pp = KIN[1]; bf16_t* pb = (bf16_t*)(ws + WS_PB);
            for (int i = gtid; i < SEQ * PLE / 4; i += GT) { const f32x4 v = __builtin_nontemporal_load((const f32x4*)pp + i); u32x2 w; w.x = cvt_pk_bf16(v[0], v[1]); w.y = cvt_pk_bf16(v[2], v[3]); ((u32x2*)pb)[i] = w; }
            const float *convw = KIN[16], *convb = KIN[17], *wa = KIN[18], *ba = KIN[19], *wx = KIN[20], *bxx = KIN[21], *lam = KIN[22];
            bf16_t* rgw = (bf16_t*)(ws + WS_RGW);
            for (int i = gtid; i < 16 * 256 * 32; i += GT) { const int h = i >> 13, row = (i >> 5) & 255, K0 = (i & 31) * 8, j = K0 >> 6, i0 = K0 & 63, ch = row >> 2, bj = (row >> 1) & 1, dir = row & 1;
                const float* W = (bj == 0 ? wa : wx) + ((size_t)(dir * 16 + h) * 64) * 64 + ch; float v[8];
#pragma unroll
                for (int k = 0; k < 8; ++k) v[k] = convw[j * 1024 + 64 * h + i0 + k] * W[(size_t)(i0 + k) * 64];
                u32x4 w; w.x = cvt_pk_bf16(v[0], v[1]); w.y = cvt_pk_bf16(v[2], v[3]); w.z = cvt_pk_bf16(v[4], v[5]); w.w = cvt_pk_bf16(v[6], v[7]);
                *(u32x4*)(rgw + ((size_t)h * 256 + row) * 256 + K0) = w; }
            float* rgb = (float*)(ws + WS_RGBIAS);
            for (int i = gtid; i < 16 * 256; i += GT) { const int h = i >> 8, row = i & 255, ch = row >> 2, bj = (row >> 1) & 1, dir = row & 1;
                const float* W = (bj == 0 ? wa : wx) + ((size_t)(dir * 16 + h) * 64) * 64 + ch; float s = (bj == 0 ? ba : bxx)[(dir * 16 + h) * 64 + ch];
#pragma unroll
                for (int k = 0; k < 64; ++k) s += convb[64 * h + k] * W[(size_t)k * 64];
                rgb[i] = s; }
            float* spt = (float*)(ws + WS_SP);
            for (int i = gtid; i < 2 * 1024; i += GT) spt[i] = -8.0f * log1pf(expf(-lam[i]));
            unsigned* xr = (unsigned*)(ws + WS_XR);
            for (int i = gtid; i < 1024; i += GT) { xr[i] = 0u; xr[(size_t)(SEQ + 2) * 512 + i] = 0u; }
        }
    }
    if (rep + 1 < REPS(0)) { ++nbar; xcd_barrier(xb, (unsigned)G, wave); } }
    SEAM(0);
    for (int rep = 0; rep < REPS(1); ++rep) {
    if (IN(1)) { PH_IDS;
        SchedStd S; S.so.init(SEQ, DIN, G, bx); S.A = (const char*)(ws + WS_HB); S.B = (const char*)(ws + WS_WINT); S.a_tile = (size_t)256 * DM * 2; S.b_tile = (size_t)256 * DM * 2;
        EpiProj E{(bf16_t*)(dout + DO_U), (bf16_t*)(ws + WS_XR), (bf16_t*)(dout + DO_Z), KIN[5]};
        GEMM_PHASE(lds, wave, GParm{DM, DM * 2, 128, 64, 0}, S, E);
        if (G == 256 && bx >= 128) { __syncthreads(); const int t2 = wave * 64 + fresh_lane(); s5_precompute(KIN, ws, (bx - 128) >> 1, (bx - 128) & 1, 2, (LAS float*)lds, t2); }
    }
    if (rep + 1 < REPS(1)) { ++nbar; xcd_barrier(xb, (unsigned)G, wave); } }
    SEAM(1);
    for (int rep = 0; rep < REPS(2); ++rep) {
    if (IN(2)) { PH_IDS;
        { SchedS5a S{(const char*)(dout + DO_U), (const char*)(ws + WS_WG), G, bx}; EpiS5a E{(bf16_t*)(ws + WS_YINTRA), (float*)(ws + WS_S)};
          GEMM_PHASE(lds, wave, GParm{512, 1024, 128, 64, 0}, S, E); }
        { SchedRG S{(const char*)(ws + WS_XR), (const char*)(ws + WS_RGW), G, bx}; EpiG E{(bf16_t*)(ws + WS_G0), (bf16_t*)(ws + WS_G1), (const float*)(ws + WS_RGBIAS)};
          GEMM_PHASE(lds, wave, GParm{256, 2048, 2048, 64, 0}, S, E); }
    }
    if (rep + 1 < REPS(2)) { ++nbar; xcd_barrier(xb, (unsigned)G, wave); } }
    SEAM(2);
    for (int rep = 0; rep < REPS(3); ++rep) {
    if (IN(3)) { PH_IDS;
        if (bx < 128) {
            const int g = bx >> 1, n = bx & 1; const float* Sg = (const float*)(ws + WS_S) + (size_t)g * NCH * 256 + n * 128; LAS float* Ls = (LAS float*)lds;
            for (int i = tid; i < NCH * 32; i += 512) { const int c = i >> 5, q4 = (i & 31) * 4; *(LAS f32x4*)(Ls + c * 128 + q4) = __builtin_nontemporal_load((const f32x4*)(Sg + (size_t)c * 256 + q4)); }
            __syncthreads();
            if (wave == 0) { const int p = lane, pi = (n * 64 + g) * 64 + p;
                const float lr = fminf(KIN[6][pi], -1e-4f), li = KIN[7][pi], step = expf(KIN[8][n * 64 + g]); float ar, ai; cpow(lr * step, li * step, TC, ar, ai);
                bf16_t* hp = (bf16_t*)(ws + WS_HPREV) + (size_t)g * NCH * 256 + n * 128; float hr = 0.f, him = 0.f;
                for (int cc = 0; cc < NCH; ++cc) { const int c = n == 0 ? cc : NCH - 1 - cc;
                    hp[(size_t)c * 256 + p] = (bf16_t)(cvt_pk_bf16(hr, 0.f) & 0xffffu); hp[(size_t)c * 256 + 64 + p] = (bf16_t)(cvt_pk_bf16(him, 0.f) & 0xffffu);
                    const float sr = Ls[c * 128 + p], si = Ls[c * 128 + 64 + p]; const float nr = ar * hr - ai * him + sr, ni = ar * him + ai * hr + si; hr = nr; him = ni; } }
            __syncthreads();
        }
        { MK_RG; for (int un = bx; un < 256; un += G) rg_pass_a(RG, un & 1, un >> 1, tid); }
    }
    if (rep + 1 < REPS(3)) { ++nbar; xcd_barrier(xb, (unsigned)G, wave); } }
    SEAM(3);
    for (int rep = 0; rep < REPS(4); ++rep) {
    if (IN(4)) { PH_IDS;
#if NAIVE_S5
        if (gw < 64) naive_s5_group((const float* const*)0, (const bf16_t*)(dout + DO_U), (float*)(ws + WS_YINTRA), (bf16_t*)(ws + WS_YS5G), gw, lane);
#else
        { SchedS5b S{(const char*)(ws + WS_HPREV), (const char*)(ws + WS_WC), G, bx}; EpiS5b E{(const bf16_t*)(ws + WS_YINTRA), (bf16_t*)(ws + WS_YS5G)};
          GEMM_PHASE(lds, wave, GParm{256, 512, 128, 64, 0}, S, E); }
#endif
#if NAIVE_RG
        { MK_RG; if (gtid < 1024) naive_rg_channel(RG, gtid); }
#else
        { MK_RG; __syncthreads(); for (int un = bx; un < 256; un += G) { rg_pass_c(RG, un & 1, un >> 1, tid, (LAS float*)lds); __syncthreads(); } }
#endif
    }
    if (rep + 1 < REPS(4)) { ++nbar; xcd_barrier(xb, (unsigned)G, wave); } }
    SEAM(4);
    for (int rep = 0; rep < REPS(5); ++rep) {
    if (IN(5)) { PH_IDS;
        SchedStd S; S.so.init(SEQ, DS5, G, bx); S.A = (const char*)(ws + WS_YS5G); S.B = (const char*)(ws + WS_GLUT); S.a_tile = (size_t)256 * 16 * 2; S.b_tile = (size_t)256 * DS5 * 2;
        EpiGlu E{(const bf16_t*)(ws + WS_YS5G), (bf16_t*)(dout + DO_YPRE), KIN[15]};
        GEMM_PHASE(lds, wave, GParm{DS5, 32, 4u * GM_STRIDE * 2u, 16, GM_STRIDE}, S, E);
        if (G == 256 && bx >= 128) {
            LAS float* scr = (LAS float*)(lds + wave * 16640); constexpr int I_FF1 = (DM / 64) * (DFF / 64);
            for (int it = (bx - 128) * 8 + wave; it < FF1_IN_P5; it += 1024) transpose_item(KIN[29], DM, DFF, (bf16_t*)(ws + WS_FF1T), scr, it, lane); }
    }
    if (rep + 1 < REPS(5)) { ++nbar; xcd_barrier(xb, (unsigned)G, wave); } }
    SEAM(5);
    for (int rep = 0; rep < REPS(6); ++rep) {
    if (IN(6)) { PH_IDS;
        const float *g5 = KIN[23], *gr = KIN[24];
        for (int row = gw; row < SEQ; row += NGW) { const u32x4* yr = (const u32x4*)(dout + DO_YPRE) + (size_t)row * 256; u32x4* oc = (u32x4*)(ws + WS_YCAT) + (size_t)row * 256;
            u32x4 w[4]; float s0 = 0.f, s1 = 0.f;
#pragma unroll
            for (int j = 0; j < 4; ++j) { w[j] = __builtin_nontemporal_load(yr + lane + 64 * j); const float q = bf_lo(w[j].x) * bf_lo(w[j].x) + bf_hi(w[j].x) * bf_hi(w[j].x) + bf_lo(w[j].y) * bf_lo(w[j].y) + bf_hi(w[j].y) * bf_hi(w[j].y)
                + bf_lo(w[j].z) * bf_lo(w[j].z) + bf_hi(w[j].z) * bf_hi(w[j].z) + bf_lo(w[j].w) * bf_lo(w[j].w) + bf_hi(w[j].w) * bf_hi(w[j].w); if (j < 2) s0 += q; else s1 += q; }
            const float r0 = 1.0f / sqrtf(wave_sum(s0) * (1.f / 1024.f) + LN_EPS), r1 = 1.0f / sqrtf(wave_sum(s1) * (1.f / 1024.f) + LN_EPS);
#pragma unroll
            for (int j = 0; j < 4; ++j) { const int col = (lane + 64 * j) * 8; const float rs = j < 2 ? r0 : r1; const float* gp = j < 2 ? g5 + col : gr + (col - 1024);
                const f32x4 ga = *(const f32x4*)gp, gb = *(const f32x4*)(gp + 4);
                u32x4 o; o.x = cvt_pk_bf16(bf_lo(w[j].x) * rs * ga[0], bf_hi(w[j].x) * rs * ga[1]); o.y = cvt_pk_bf16(bf_lo(w[j].y) * rs * ga[2], bf_hi(w[j].y) * rs * ga[3]);
                o.z = cvt_pk_bf16(bf_lo(w[j].z) * rs * gb[0], bf_hi(w[j].z) * rs * gb[1]); o.w = cvt_pk_bf16(bf_lo(w[j].w) * rs * gb[2], bf_hi(w[j].w) * rs * gb[3]); oc[lane + 64 * j] = o; } }
        {
            LAS float* scr = (LAS float*)(lds + wave * 16640);
            constexpr int I_FF1 = (DM / 64) * (DFF / 64), I_FF2 = (DFF / 64) * (DM / 64);
            const int ff1_lo = (G == 256) ? FF1_IN_P5 : 0;
            for (int it = gw; it < I_FF2 + (I_FF1 - ff1_lo); it += NGW) {
                if (it < I_FF2) transpose_item(KIN[31], DFF, DM, (bf16_t*)(ws + WS_FF2T), scr, it, lane);
                else transpose_item(KIN[29], DM, DFF, (bf16_t*)(ws + WS_FF1T), scr, ff1_lo + it - I_FF2, lane); }
        }
    }
    if (rep + 1 < REPS(6)) { ++nbar; xcd_barrier(xb, (unsigned)G, wave); } }
    SEAM(6);
    for (int rep = 0; rep < REPS(7); ++rep) {
    if (IN(7)) { PH_IDS;
        SchedStd S; S.so.init(SEQ, DM, G, bx); S.A = (const char*)(ws + WS_YCAT); S.B = (const char*)(ws + WS_WOUTT); S.a_tile = (size_t)256 * DM * 2; S.b_tile = (size_t)256 * DM * 2;
        EpiResLn1 E{(bf16_t*)(ws + WS_HB), KIN[26], KIN[27], KIN[28], PanelStats8{(unsigned long long*)(ws + WS_AGG), (unsigned*)(ws + WS_CTR) + 1024, LN_EPS}};
        GEMM_PHASE(lds, wave, GParm{DM, DM * 2, 128, 64, 0}, S, E);
    }
    if (rep + 1 < REPS(7)) { ++nbar; xcd_barrier(xb, (unsigned)G, wave); } }
    for (int rep = 0; rep < REPS(8); ++rep) {
    if (IN(8)) { }
    if (rep + 1 < REPS(8)) { ++nbar; xcd_barrier(xb, (unsigned)G, wave); } }
    SEAM(8);
    for (int rep = 0; rep < REPS(9); ++rep) {
    if (IN(9)) { PH_IDS;
        static_assert(WS_PLEGT == WS_FF1T + (size_t)DFF * DM * 2, "gate weights must follow the FF1 weights");
        { SchedStd S; S.so.init(SEQ, DFF + DM, G, bx); S.A = (const char*)(ws + WS_HB); S.B = (const char*)(ws + WS_FF1T); S.a_tile = (size_t)256 * DM * 2; S.b_tile = (size_t)256 * DM * 2;
          EpiFF1G E{(bf16_t*)(ws + WS_T), (bf16_t*)dout, KIN[30], KIN[35]}; GEMM_PHASE(lds, wave, GParm{DM, DM * 2, 128, 64, 0}, S, E); }
        { SchedStd S; S.so.init(SEQ, DM, G, bx); S.A = (const char*)(ws + WS_PB); S.B = (const char*)(ws + WS_PLEWT); S.a_tile = (size_t)256 * PLE * 2; S.b_tile = (size_t)256 * PLE * 2;
          EpiPlain<0> E{(bf16_t*)dout + ((size_t)1 << 19), DM, nullptr, (size_t)1 << 20}; GEMM_PHASE(lds, wave, GParm{PLE, PLE * 2, 128, 64, 0}, S, E); }
    }
    if (rep + 1 < REPS(9)) { ++nbar; xcd_barrier(xb, (unsigned)G, wave); } }
    SEAM(9);
    for (int rep = 0; rep < REPS(10); ++rep) {
    if (IN(10)) { PH_IDS;
        SchedStd S; S.so.init(SEQ, DM, G, bx); S.A = (const char*)(ws + WS_T); S.B = (const char*)(ws + WS_FF2T); S.a_tile = (size_t)256 * DFF * 2; S.b_tile = (size_t)256 * DFF * 2;
        EpiResLn2 E{(const bf16_t*)(ws + WS_HB), KIN[32], KIN[36], KIN[37], (float*)dout, (const bf16_t*)dout, PanelStats8{(unsigned long long*)(ws + WS_AGG) + 65536, (unsigned*)(ws + WS_CTR) + 1024 + 64 * 32, LN_EPS}};
        GEMM_PHASE(lds, wave, GParm{DFF, DFF * 2, 128, 64, 0}, S, E);
    }
    if (rep + 1 < REPS(10)) { ++nbar; xcd_barrier(xb, (unsigned)G, wave); } }
    for (int rep = 0; rep < REPS(11); ++rep) {
    if (IN(11)) { }
    if (rep + 1 < REPS(11)) { ++nbar; xcd_barrier(xb, (unsigned)G, wave); } }
#ifdef EXTRA_BARRIERS
    for (int eb = 0; eb < EXTRA_BARRIERS; ++eb) { ++nbar; xcd_barrier(xb, (unsigned)G, wave); }
#endif
#if TSTAMP
    if (bx == 0 && wave == 0) { if (fresh_lane() == 0) { unsigned long long* st = (unsigned long long*)(ws + WS_CTR + 1024); st[12] = __builtin_amdgcn_s_memrealtime();
        ((float*)KIN[38])[0] = 8.0f * floorf((float)(long long)(__hip_atomic_load(st + TS_A1, __ATOMIC_RELAXED, __HIP_MEMORY_SCOPE_AGENT) - __hip_atomic_load(st + TS_A0, __ATOMIC_RELAXED, __HIP_MEMORY_SCOPE_AGENT)) * 0.00125f + 0.5f); } }
#endif
#if DIAG
    { ++nbar; xcd_barrier(xb, (unsigned)G, wave); PH_IDS; unsigned* flagw = (unsigned*)(ws + WS_CTR) + 48;
#if DIAG == 1
      diag_ffn((const float* const*)0, ws, ((float*)KIN[38]), flagw, gtid, GT);
#elif DIAG == 2
      diag_pre((const float* const*)0, ws, dout, flagw, gtid, GT);
#elif DIAG == 3
      diag_v((const float* const*)0, ws, dout, flagw, gtid, GT);
#elif DIAG == 4
      diag_g((const float* const*)0, ws, flagw, gtid, GT);
#elif DIAG == 6
      diag_max(ws, flagw, gtid, GT);
#else
      if (bx == 0 && tid == 0) flagw[1] = 0xffffffffu;
      ++nbar; xcd_barrier(xb, (unsigned)G, wave);
#if DIAG == 7
      diag_rows(((float*)KIN[38]), flagw, gw, NGW, lane);
#elif DIAG == 8
      diag_rows_bf((const bf16_t*)(ws + WS_HB), DM, 12.0f, flagw, gw, NGW, lane);
#elif DIAG == 9
      diag_rows((const float*)(ws + WS_V2), flagw, gw, NGW, lane);
#elif DIAG == 10
      diag_rows_bf((const bf16_t*)(ws + WS_T), DFF, 150.0f, flagw, gw, NGW, lane);
#elif DIAG == 11
      diag_rows_bf((const bf16_t*)(dout + DO_PW), DM, 8.0f, flagw, gw, NGW, lane);
#elif DIAG == 12
      diag_rows_bf((const bf16_t*)(dout + DO_SG), DM, 1.01f, flagw, gw, NGW, lane);
#endif
#endif
      ++nbar; xcd_barrier(xb, (unsigned)G, wave);
#if DIAG != 1
      for (int i = gtid; i < SEQ * DM; i += GT) ((float*)KIN[38])[i] = 0.f;
      ++nbar; xcd_barrier(xb, (unsigned)G, wave);
#endif
      if (bx == 0 && tid == 0) { unsigned code = 0; for (int q = 0; q < 4; ++q) if (__hip_atomic_load(flagw + q, __ATOMIC_RELAXED, __HIP_MEMORY_SCOPE_AGENT) > 100u) code |= 1u << q; if (DIAG >= 7) { const unsigned cnt = __hip_atomic_load(flagw, __ATOMIC_RELAXED, __HIP_MEMORY_SCOPE_AGENT), mn = __hip_atomic_load(flagw + 1, __ATOMIC_RELAXED, __HIP_MEMORY_SCOPE_AGENT), mxr = __hip_atomic_load(flagw + 2, __ATOMIC_RELAXED, __HIP_MEMORY_SCOPE_AGENT);
          const unsigned v = DIAG_SEL == 0 ? cnt : DIAG_SEL == 1 ? mn / 100u : DIAG_SEL == 2 ? mn % 100u : DIAG_SEL == 3 ? mxr / 100u : mxr % 100u; ((float*)KIN[38])[0] = 100.0f * (float)(v + 1u); }
      else ((float*)KIN[38])[0] = (DIAG == 6) ? 1000.0f * __uint_as_float(__hip_atomic_load(flagw, __ATOMIC_RELAXED, __HIP_MEMORY_SCOPE_AGENT)) : 1000.0f * (float)(code + 16u); } }
#endif
#undef IN
#undef SEAM
}


#if PER_PHASE_LAUNCH
template <int PH> static void set_attr_one() { (void)hipFuncSetAttribute((const void*)mega<(1 << PH)>, hipFuncAttributeMaxDynamicSharedMemorySize, LDS_BYTES); }
template <int PH> static void launch_one(Args a, int grid, hipStream_t stream) { a.ph_lo = PH; a.ph_hi = PH + 1; hipLaunchKernelGGL(mega<(1 << PH)>, dim3(grid), dim3(512), LDS_BYTES, stream, a); }
static void set_attrs() { set_attr_one<0>(); set_attr_one<1>(); set_attr_one<2>(); set_attr_one<3>(); set_attr_one<4>(); set_attr_one<5>(); set_attr_one<6>(); set_attr_one<7>(); set_attr_one<8>(); set_attr_one<9>(); set_attr_one<10>(); set_attr_one<11>(); }
static void launch_phases(const Args& a, int grid, hipStream_t stream) { launch_one<0>(a, grid, stream); launch_one<1>(a, grid, stream); launch_one<2>(a, grid, stream); launch_one<3>(a, grid, stream); launch_one<4>(a, grid, stream); launch_one<5>(a, grid, stream);
    launch_one<6>(a, grid, stream); launch_one<7>(a, grid, stream); launch_one<8>(a, grid, stream); launch_one<9>(a, grid, stream); launch_one<10>(a, grid, stream); launch_one<11>(a, grid, stream); }
#else
static void set_attrs() { (void)hipFuncSetAttribute((const void*)mega<0xfff>, hipFuncAttributeMaxDynamicSharedMemorySize, LDS_BYTES); }
#endif

extern "C" void kernel_launch(void* const* d_in, const int* in_sizes, int n_in, void* d_out, int out_size, void* d_ws, size_t ws_size, hipStream_t stream) {
    static int grid = 0;
    if (grid == 0) {
        if (n_in != 38 || out_size != SEQ * DM || ws_size < WS_END) { fprintf(stderr, "kernel_launch: unexpected shapes (n_in %d out %d ws %zu)\n", n_in, out_size, ws_size); grid = -1; return; }
        int dev = 0, cus = 0, per_cu = 0;
        hipGetDevice(&dev); hipDeviceGetAttribute(&cus, hipDeviceAttributeMultiprocessorCount, dev);
        set_attrs();
        per_cu = 1;
        (void)hipGetLastError();
        if (per_cu < 1) per_cu = 1;
        grid = cus;
    }
    if (grid < 0) return;
#ifdef POISON_NAN
    hipMemsetAsync(d_ws, 0xFF, WS_END, stream); hipMemsetAsync(d_out, 0xFF, (size_t)64 * MiB, stream);
#endif
    hipMemsetAsync((char*)d_ws + WS_CTR, 0, 40960, stream);
    Args a{};
    for (int i = 0; i < 38; ++i) a.in[i] = (const float*)d_in[i];
    a.out = (float*)d_out; a.ws = (unsigned char*)d_ws;
#if PER_PHASE_LAUNCH
    launch_phases(a, grid, stream);
#else
    a.ph_lo = 0; a.ph_hi = NPHASE;
    void* kargs[] = {&a};
    hipError_t e = hipLaunchCooperativeKernel((const void*)mega<0xfff>, dim3(grid), dim3(512), kargs, LDS_BYTES, stream);
    if (e != hipSuccess) fprintf(stderr, "cooperative launch failed: %s (grid %d)\n", hipGetErrorString(e), grid);
#endif
}
```

```cpp
#include <hip/hip_runtime.h>
#include <hip/hip_cooperative_groups.h>
#include <cstdio>
#include <cstdint>
namespace cg = cooperative_groups;

#ifndef PER_PHASE_LAUNCH
#define PER_PHASE_LAUNCH 0
#endif

#ifndef TSTAMP
#define TSTAMP 0
#define TS_A0 4
#define TS_A1 5
#define TS_B0 9
#define TS_B1 12
#endif
#define LAS __attribute__((address_space(3)))
typedef unsigned short bf16_t;
typedef short bf16x8 __attribute__((ext_vector_type(8)));
typedef float f32x4 __attribute__((ext_vector_type(4)));
typedef float f32x2 __attribute__((ext_vector_type(2)));
typedef unsigned u32x4 __attribute__((ext_vector_type(4)));
typedef unsigned u32x2 __attribute__((ext_vector_type(2)));

constexpr int SEQ = 8192, DM = 2048, DIN = 3072, DS5 = 1024, DRG = 1024, NG = 64, NP = 64, NK = 16, NH = 16, HD = 64, DFF = 8192, PLE = 256;
constexpr int TC = 32, NCH = SEQ / TC;
constexpr float LN_EPS = 1e-5f, DN_ALPHA = 1.18920711500272f;
constexpr int NPHASE = 12;

constexpr size_t MiB = (size_t)1 << 20;
constexpr size_t WS_FF2T = 0, WS_HB = 32 * MiB, WS_FF1T = 64 * MiB, WS_PLEGT = 96 * MiB, WS_PLEWT = 104 * MiB, WS_PB = 105 * MiB, WS_WOUTT = 109 * MiB,
    WS_V2 = 64 * MiB, WS_G0 = 0, WS_G1 = 64 * MiB,
    WS_WG = 128 * MiB, WS_WC = 176 * MiB, WS_RGW = 192 * MiB, WS_GLUT = 194 * MiB, WS_XR = 196 * MiB, WS_YINTRA = 213 * MiB, WS_S = 229 * MiB, WS_HPREV = 245 * MiB, WS_WINT = 229 * MiB,
    WS_YS5G = 128 * MiB, WS_YCAT = 144 * MiB, WS_T = 128 * MiB,
    WS_AGG = 256 * MiB, WS_CARRY = 258 * MiB, WS_SUMSQ = 259 * MiB, WS_RGBIAS = 259 * MiB + 64 * 1024, WS_SP = WS_RGBIAS + 16 * 1024, WS_CTR = WS_SP + 8 * 1024, WS_END = 260 * MiB;
constexpr size_t DO_YPRE = 0, DO_Z = 32 * MiB, DO_U = 48 * MiB, DO_SG = 0, DO_PW = 32 * MiB;
constexpr int FF1_IN_P5 = 4096;
constexpr int GM_STRIDE = SEQ * 16;
constexpr int LDS_BYTES = 152 * 1024;

typedef __bf16 bf16x2_t __attribute__((ext_vector_type(2)));
__device__ __forceinline__ unsigned cvt_pk_bf16(float lo, float hi) { const f32x2 v = {lo, hi}; const bf16x2_t b = __builtin_convertvector(v, bf16x2_t); return __builtin_bit_cast(unsigned, b); }
__device__ __forceinline__ float bf_lo(unsigned w) { return __uint_as_float(w << 16); }
__device__ __forceinline__ float bf_hi(unsigned w) { return __uint_as_float(w & 0xffff0000u); }
__device__ __forceinline__ f32x4 bf4(u32x2 w) { return (f32x4){bf_lo(w.x), bf_hi(w.x), bf_lo(w.y), bf_hi(w.y)}; }
__device__ __forceinline__ float fast_sigmoid(float x) { return __builtin_amdgcn_rcpf(1.0f + __expf(-x)); }
__device__ __forceinline__ float gelu_tanh(float x) { const float u = 1.5957691216057308f * (x + 0.044715f * x * x * x); return x * fast_sigmoid(u); }
__device__ __forceinline__ float wave_sum(float v) {
#pragma unroll
    for (int o = 1; o < 64; o <<= 1) v += __shfl_xor(v, o);
    return v;
}
__device__ __forceinline__ int lane_id() { return (int)__builtin_amdgcn_mbcnt_hi(~0u, __builtin_amdgcn_mbcnt_lo(~0u, 0u)); }
__device__ __forceinline__ int fresh_lane() { unsigned z = 0; asm volatile("" : "+s"(z)); return (int)__builtin_amdgcn_mbcnt_hi(~0u, __builtin_amdgcn_mbcnt_lo(~0u, z)); }
#define LDS_WAIT() asm volatile("s_waitcnt lgkmcnt(0)" ::: "memory")

namespace pg8 {
constexpr int BM = 256, BK = 64, HALF = 128, HTB = HALF * BK * 2, STAGE_BYTES = 8 * HTB, NXCD = 8, WGM = 8;
__host__ __device__ __forceinline__ int lds_byte(int r, int c) { const int st = (r >> 4) * 2 + (c >> 5), rr = r & 15, cc = c & 31, ob = rr * 64 + cc * 2; return st * 1024 + (ob ^ (((ob >> 9) & 1) << 5)); }
__host__ __device__ __forceinline__ void stage_rc(int b, int& R, int& C) { const int st = b / 1024, sb = b % 1024, swz = sb ^ (((sb >> 9) & 1) << 5); R = (st >> 1) * 16 + swz / 64; C = (st & 1) * 32 + (swz % 64) / 2; }
__host__ __device__ __forceinline__ int perm32(int rho) { const int n = rho >> 4, i = rho & 15; return 8 * (i >> 2) + 4 * n + (i & 3); }

struct Unit { int pm, pn; };
struct StaticOrder {
    int nM, nN, nwg, G, c;
    __host__ __device__ void init(int M, int N, int G_, int c_) { nM = M / BM; nN = N / BM; nwg = nM * nN; G = G_; c = c_; }
    __host__ __device__ bool next(int i, Unit& u) const {
        const long L = (long)i * G + c; if (L >= nwg) return false;
        int wgid = (int)L; { const int q = nwg / NXCD, r = nwg % NXCD, xcd = wgid % NXCD, off = wgid / NXCD; wgid = (xcd < r ? xcd * (q + 1) : r * (q + 1) + (xcd - r) * q) + off; }
        const int nig = WGM * nN, gid = wgid / nig, fm = gid * WGM, gsz = (nM - fm) < WGM ? (nM - fm) : WGM;
        u.pm = fm + ((wgid % nig) % gsz); u.pn = (wgid % nig) / gsz; return true;
    }
};
struct GUnit { const char* A; const char* B; int i0, i1; };
struct GParm { int K; unsigned a_rs, a_ks; int a_cw, a_cs; };

template <class Epi, class Sched>
__device__ __forceinline__ void gemm_phase(LAS unsigned char* lds, const int wid, const GParm gp, const Sched& S, const Epi& E) {
    const int lane = fresh_lane(), tid = wid * 64 + lane, wr = wid >> 2, wc = wid & 3, fr = lane & 15, fq = lane >> 4;
    const int K = gp.K, nt = K / BK;
    unsigned voffA[2], voffB[2];
#pragma unroll
    for (int i = 0; i < 2; ++i) { int R, C; stage_rc(tid * 16 + i * 8192, R, C); const int Rb = Epi::PERM ? ((R & ~31) + perm32(R & 31)) : R;
        voffA[i] = (unsigned)R * gp.a_rs + (unsigned)((C / gp.a_cw) * gp.a_cs + (C % gp.a_cw)) * 2u; voffB[i] = (unsigned)(Rb * K + C) * 2u; }
    const size_t ksA = gp.a_ks, ksB = (size_t)(BK * 2);
    const size_t hsA = (size_t)HALF * gp.a_rs, hsB = (size_t)HALF * K * 2;
    const unsigned ldsw = (unsigned)wid * 1024u;
    const int aoff = lds_byte(wr * 64 + fr, fq * 8), boff = lds_byte(wc * 32 + fr, fq * 8);
#define PG8_SA(b, h) (((b) * 2 + (h)) * HTB)
#define PG8_SB(b, h) ((4 + (b) * 2 + (h)) * HTB)
#define PG8_STAGE(bufoff, gbase, voff) do { _Pragma("unroll") for (int _i = 0; _i < 2; ++_i) \
        __builtin_amdgcn_global_load_lds((const unsigned*)((const char*)(gbase) + (voff)[_i]), (LAS unsigned*)(lds + (bufoff) + ldsw + _i * 8192), 16, 0, 0); } while (0)
#define PG8_LDA(dst, b, h) do { _Pragma("unroll") for (int m = 0; m < 4; ++m) _Pragma("unroll") for (int k = 0; k < 2; ++k) dst[m][k] = *(const LAS bf16x8*)(lds + PG8_SA(b, h) + aoff + m * 2048 + k * 1024); } while (0)
#define PG8_LDB(dst, b, h) do { _Pragma("unroll") for (int n = 0; n < 2; ++n) _Pragma("unroll") for (int k = 0; k < 2; ++k) dst[n][k] = *(const LAS bf16x8*)(lds + PG8_SB(b, h) + boff + n * 2048 + k * 1024); } while (0)
#define PG8_MMA(ai, bj, At, Bt) do { __builtin_amdgcn_s_setprio(1); _Pragma("unroll") for (int m = 0; m < 4; ++m) _Pragma("unroll") for (int n = 0; n < 2; ++n) _Pragma("unroll") for (int k = 0; k < 2; ++k) \
        acc[ai][bj][m][n] = __builtin_amdgcn_mfma_f32_16x16x32_bf16(Bt[n][k], At[m][k], acc[ai][bj][m][n], 0, 0, 0); __builtin_amdgcn_s_setprio(0); } while (0)
#define PG8_WAIT_V(n) asm volatile("s_waitcnt vmcnt(" #n ")" ::: "memory")
#define PG8_WAIT_L(n) asm volatile("s_waitcnt lgkmcnt(" #n ")" ::: "memory")
#define PG8_BAR __builtin_amdgcn_s_barrier()
#define PG8_SCHED __builtin_amdgcn_sched_barrier(0)
    GUnit cur, nxt; int ui = 0;
    if (!S.next(0, cur)) return;
    f32x4 acc[2][2][4][2];
#pragma unroll
    for (int a = 0; a < 2; ++a)
#pragma unroll
        for (int b = 0; b < 2; ++b)
#pragma unroll
            for (int m = 0; m < 4; ++m)
#pragma unroll
                for (int n = 0; n < 2; ++n) acc[a][b][m][n] = (f32x4){0.f, 0.f, 0.f, 0.f};
    bf16x8 At[4][2], B0[2][2], B1[2][2];
    const char* cA = cur.A; const char* cB = cur.B;
    PG8_STAGE(PG8_SB(0, 0), cB, voffB); PG8_STAGE(PG8_SB(0, 1), cB + hsB, voffB); PG8_STAGE(PG8_SA(0, 0), cA, voffA); PG8_STAGE(PG8_SA(0, 1), cA + hsA, voffA);
    if (wr == 1) PG8_BAR;
    PG8_WAIT_V(2); PG8_BAR;
    PG8_STAGE(PG8_SB(1, 0), cB + ksB, voffB); PG8_STAGE(PG8_SA(1, 0), cA + ksA, voffA); PG8_STAGE(PG8_SB(1, 1), cB + hsB + ksB, voffB);
    PG8_WAIT_V(6); PG8_BAR;
    for (;;) {
        const bool has_next = S.next(ui + 1, nxt);
        const char* nA = has_next ? nxt.A : cA; const char* nB = has_next ? nxt.B : cB;
        for (int t = 0; t < nt; t += 2) {
            const bool last = (t == nt - 2);
            const char* a1 = cA + (size_t)(t + 1) * ksA;
            const char* a2 = last ? nA : cA + (size_t)(t + 2) * ksA; const char* b2 = last ? nB : cB + (size_t)(t + 2) * ksB;
            const char* a3 = a2 + ksA; const char* b3 = b2 + ksB;
            PG8_LDB(B0, 0, 0); PG8_LDB(B1, 0, 1); PG8_SCHED; PG8_LDA(At, 0, 0); PG8_STAGE(PG8_SA(1, 1), a1 + hsA, voffA);
            PG8_WAIT_V(8); PG8_WAIT_L(0); PG8_BAR; PG8_MMA(0, 0, At, B0); PG8_MMA(0, 1, At, B1); PG8_BAR; PG8_SCHED;
            PG8_LDA(At, 0, 1); PG8_STAGE(PG8_SB(0, 0), b2, voffB); PG8_STAGE(PG8_SB(0, 1), b2 + hsB, voffB); PG8_STAGE(PG8_SA(0, 0), a2, voffA);
            PG8_WAIT_V(8); PG8_WAIT_L(0); PG8_BAR; PG8_MMA(1, 0, At, B0); PG8_MMA(1, 1, At, B1); PG8_BAR; PG8_SCHED;
            PG8_LDB(B0, 1, 0); PG8_LDB(B1, 1, 1); PG8_SCHED; PG8_LDA(At, 1, 0); PG8_STAGE(PG8_SA(0, 1), a2 + hsA, voffA);
            PG8_WAIT_V(8); PG8_WAIT_L(0); PG8_BAR; PG8_MMA(0, 0, At, B0); PG8_MMA(0, 1, At, B1); PG8_BAR; PG8_SCHED;
            PG8_LDA(At, 1, 1); PG8_STAGE(PG8_SB(1, 0), b3, voffB); PG8_STAGE(PG8_SB(1, 1), b3 + hsB, voffB); PG8_STAGE(PG8_SA(1, 0), a3, voffA);
            PG8_WAIT_V(8); PG8_WAIT_L(0); PG8_BAR; PG8_MMA(1, 0, At, B0); PG8_MMA(1, 1, At, B1); PG8_BAR; PG8_SCHED;
        }
        if (wr == 0) PG8_BAR;
        if constexpr (!Epi::AFTER_DRAIN) { const int l_o = fresh_lane(); E(acc, cur, wr, wc, l_o & 15, l_o >> 4); }
        if (!has_next) break;
#pragma unroll
        for (int a = 0; a < 2; ++a)
#pragma unroll
            for (int b = 0; b < 2; ++b)
#pragma unroll
                for (int m = 0; m < 4; ++m)
#pragma unroll
                    for (int n = 0; n < 2; ++n) acc[a][b][m][n] = (f32x4){0.f, 0.f, 0.f, 0.f};
        cur = nxt; cA = nA; cB = nB; ++ui;
        if (wr == 1) PG8_BAR;
    }
    PG8_WAIT_V(0);
    PG8_BAR;
    if constexpr (Epi::AFTER_DRAIN) { const int l_o = fresh_lane(); E.fused(acc, cur, wr, wc, l_o & 15, l_o >> 4, lds, wid); }
#undef PG8_SA
#undef PG8_SB
#undef PG8_STAGE
#undef PG8_LDA
#undef PG8_LDB
#undef PG8_MMA
#undef PG8_WAIT_V
#undef PG8_WAIT_L
#undef PG8_BAR
#undef PG8_SCHED
}
}
using pg8::GUnit; using pg8::GParm;
typedef f32x4 AccT[2][2][4][2];

struct SchedStd {
    pg8::StaticOrder so; const char* A; const char* B; size_t a_tile, b_tile;
    __device__ __forceinline__ bool next(int i, GUnit& u) const { pg8::Unit t; if (!so.next(i, t)) return false; u.A = A + (size_t)t.pm * a_tile; u.B = B + (size_t)t.pn * b_tile; u.i0 = t.pm; u.i1 = t.pn; return true; }
};
struct SchedS5a { const char* U; const char* WG; int G, c;
    __device__ __forceinline__ bool next(int i, GUnit& u) const { const int L = i * G + c; if (L >= 192) return false; const int g = L / 3, pn = L % 3;
        u.A = U + (size_t)g * GM_STRIDE * 2; u.B = WG + ((size_t)g * 768 + 256 * pn) * 512 * 2; u.i0 = g; u.i1 = pn; return true; } };
struct SchedS5b { const char* HP; const char* WC; int G, c;
    __device__ __forceinline__ bool next(int i, GUnit& u) const { const int L = i * G + c; if (L >= 128) return false; const int g = L / 2, pn = L % 2;
        u.A = HP + (size_t)g * 256 * 256 * 2; u.B = WC + ((size_t)g * 512 + 256 * pn) * 256 * 2; u.i0 = g; u.i1 = pn; return true; } };
struct SchedRG { const char* XR; const char* RGW; int G, c;
    __device__ __forceinline__ bool next(int i, GUnit& u) const { const int L = i * G + c; if (L >= 512) return false; const int h = L % 16, pm = L / 16;
        u.A = XR + ((size_t)(256 * pm) * 1024 + 64 * h) * 2; u.B = RGW + (size_t)h * 256 * 256 * 2; u.i0 = pm; u.i1 = h; return true; } };

template <int ACT> __device__ __forceinline__ void epi_bf16_store(const AccT& acc, bf16_t* tile, int ldc, const float* biast, int wr, int wc, int fr, int fq) {
    const int r0 = wr * 64 + fr, c0 = wc * 32 + 8 * fq;
    f32x4 bv[2][2];
#pragma unroll
    for (int bj = 0; bj < 2; ++bj)
#pragma unroll
        for (int n = 0; n < 2; ++n) bv[bj][n] = biast ? *(const f32x4*)(biast + c0 + bj * 128 + 4 * n) : (f32x4){0.f, 0.f, 0.f, 0.f};
#pragma unroll
    for (int ai = 0; ai < 2; ++ai)
#pragma unroll
        for (int m = 0; m < 4; ++m) { bf16_t* rowp = tile + (size_t)(r0 + ai * 128 + m * 16) * ldc + c0;
#pragma unroll
            for (int bj = 0; bj < 2; ++bj) { f32x4 v0 = acc[ai][bj][m][0] + bv[bj][0], v1 = acc[ai][bj][m][1] + bv[bj][1];
                if (ACT == 1) {
#pragma unroll
                    for (int j = 0; j < 4; ++j) { const float a = fmaxf(v0[j], 0.f), b = fmaxf(v1[j], 0.f); v0[j] = a * a; v1[j] = b * b; } }
                if (ACT == 2) {
#pragma unroll
                    for (int j = 0; j < 4; ++j) { v0[j] = fast_sigmoid(v0[j]); v1[j] = fast_sigmoid(v1[j]); } }
                u32x4 w; w.x = cvt_pk_bf16(v0[0], v0[1]); w.y = cvt_pk_bf16(v0[2], v0[3]); w.z = cvt_pk_bf16(v1[0], v1[1]); w.w = cvt_pk_bf16(v1[2], v1[3]);
                *(u32x4*)(rowp + bj * 128) = w; } }
}
struct EpiProj { static constexpr bool PERM = true, AFTER_DRAIN = false; bf16_t *U, *XR, *Z; const float* bias;
    __device__ __forceinline__ void operator()(AccT& acc, const GUnit& u, int wr, int wc, int fr, int fq) const {
        const int pm = u.i0, pn = u.i1;
        if (pn >= 4) { bf16_t* base = pn < 8 ? XR + 2 * 1024 : Z; epi_bf16_store<0>(acc, base + (size_t)pm * 256 * 1024 + (pn & 3) * 256, 1024, bias + pn * 256, wr, wc, fr, fq); return; }
        const int c0 = pn * 256 + wc * 32 + 8 * fq;
#pragma unroll
        for (int bj = 0; bj < 2; ++bj) { const int col = c0 + bj * 128; const f32x4 b0 = *(const f32x4*)(bias + col), b1 = *(const f32x4*)(bias + col + 4); bf16_t* gp = U + (size_t)(col >> 4) * GM_STRIDE + (col & 15);
#pragma unroll
            for (int ai = 0; ai < 2; ++ai)
#pragma unroll
                for (int m = 0; m < 4; ++m) { const int row = pm * 256 + ai * 128 + wr * 64 + m * 16 + fr; const f32x4 v0 = acc[ai][bj][m][0] + b0, v1 = acc[ai][bj][m][1] + b1;
                    u32x4 w; w.x = cvt_pk_bf16(v0[0], v0[1]); w.y = cvt_pk_bf16(v0[2], v0[3]); w.z = cvt_pk_bf16(v1[0], v1[1]); w.w = cvt_pk_bf16(v1[2], v1[3]);
                    *(u32x4*)(gp + (size_t)row * 16) = w; } }
    } };
template <int ACT> struct EpiPlain { static constexpr bool PERM = true, AFTER_DRAIN = false; bf16_t* O; int ldc; const float* bias; size_t pstride;
    __device__ __forceinline__ void operator()(AccT& acc, const GUnit& u, int wr, int wc, int fr, int fq) const {
        epi_bf16_store<ACT>(acc, O + (size_t)u.i0 * (pstride ? pstride : (size_t)256 * ldc) + u.i1 * 256, ldc, bias ? bias + u.i1 * 256 : nullptr, wr, wc, fr, fq); } };
struct EpiFF1G { static constexpr bool PERM = true, AFTER_DRAIN = false; bf16_t* T; bf16_t* SG; const float *b1, *bg;
    __device__ __forceinline__ void operator()(AccT& acc, const GUnit& u, int wr, int wc, int fr, int fq) const {
        const int pm = u.i0, pn = u.i1;
        if (pn < 32) epi_bf16_store<1>(acc, T + (size_t)pm * 256 * DFF + pn * 256, DFF, b1 + pn * 256, wr, wc, fr, fq);
        else epi_bf16_store<2>(acc, SG + (size_t)pm * ((size_t)1 << 20) + (pn - 32) * 256, DM, bg + (pn - 32) * 256, wr, wc, fr, fq); } };
struct EpiS5a { static constexpr bool PERM = true, AFTER_DRAIN = false; bf16_t* YI; float* S;
    __device__ __forceinline__ void operator()(AccT& acc, const GUnit& u, int wr, int wc, int fr, int fq) const {
        const int g = u.i0, pn = u.i1;
#pragma unroll
        for (int ai = 0; ai < 2; ++ai)
#pragma unroll
            for (int m = 0; m < 4; ++m) { const int r = ai * 128 + wr * 64 + m * 16 + fr;
#pragma unroll
                for (int bj = 0; bj < 2; ++bj) { const int c8 = bj * 128 + wc * 32 + 8 * fq; const f32x4 v0 = acc[ai][bj][m][0], v1 = acc[ai][bj][m][1];
                    if (pn < 2) { const int col = pn * 256 + c8, t = col >> 4, k0 = col & 15;
                        u32x4 w; w.x = cvt_pk_bf16(v0[0], v0[1]); w.y = cvt_pk_bf16(v0[2], v0[3]); w.z = cvt_pk_bf16(v1[0], v1[1]); w.w = cvt_pk_bf16(v1[2], v1[3]);
                        *(u32x4*)(YI + (size_t)g * GM_STRIDE + (size_t)r * 512 + col) = w; (void)t; (void)k0; }
                    else { float* sp = S + ((size_t)g * NCH + r) * 256 + c8; *(f32x4*)sp = v0; *(f32x4*)(sp + 4) = v1; } } }
    } };
struct EpiS5b { static constexpr bool PERM = true, AFTER_DRAIN = false; const bf16_t* YI; bf16_t* YG;
    __device__ __forceinline__ void operator()(AccT& acc, const GUnit& u, int wr, int wc, int fr, int fq) const {
        const int g = u.i0, pn = u.i1;
#pragma unroll
        for (int ai = 0; ai < 2; ++ai)
#pragma unroll
            for (int m = 0; m < 4; ++m) { const int r = ai * 128 + wr * 64 + m * 16 + fr;
#pragma unroll
                for (int bj = 0; bj < 2; ++bj) { const int col = pn * 256 + bj * 128 + wc * 32 + 8 * fq, t = col >> 4, k0 = col & 15;
                    const size_t off = (size_t)g * GM_STRIDE + (size_t)r * 512 + col; (void)t; (void)k0; const u32x4 yi = __builtin_nontemporal_load((const u32x4*)(YI + off));
                    f32x4 v0 = acc[ai][bj][m][0] + (f32x4){bf_lo(yi.x), bf_hi(yi.x), bf_lo(yi.y), bf_hi(yi.y)}, v1 = acc[ai][bj][m][1] + (f32x4){bf_lo(yi.z), bf_hi(yi.z), bf_lo(yi.w), bf_hi(yi.w)};
#pragma unroll
                    for (int j = 0; j < 4; ++j) { v0[j] = gelu_tanh(v0[j]); v1[j] = gelu_tanh(v1[j]); }
                    u32x4 w; w.x = cvt_pk_bf16(v0[0], v0[1]); w.y = cvt_pk_bf16(v0[2], v0[3]); w.z = cvt_pk_bf16(v1[0], v1[1]); w.w = cvt_pk_bf16(v1[2], v1[3]);
                    *(u32x4*)(YG + off) = w; } }
    } };
struct EpiGlu { static constexpr bool PERM = true, AFTER_DRAIN = false; const bf16_t* YG; bf16_t* YPRE; const float* bias;
    __device__ __forceinline__ void operator()(AccT& acc, const GUnit& u, int wr, int wc, int fr, int fq) const {
        const int pm = u.i0, pn = u.i1; const int c0 = pn * 256 + wc * 32 + 8 * fq;
        f32x4 bv[2][2];
#pragma unroll
        for (int bj = 0; bj < 2; ++bj)
#pragma unroll
            for (int n = 0; n < 2; ++n) bv[bj][n] = *(const f32x4*)(bias + c0 + bj * 128 + 4 * n);
#pragma unroll
        for (int ai = 0; ai < 2; ++ai)
#pragma unroll
            for (int m = 0; m < 4; ++m) { const int row = pm * 256 + ai * 128 + wr * 64 + m * 16 + fr;
#pragma unroll
                for (int bj = 0; bj < 2; ++bj) { const int col = c0 + bj * 128; const u32x4 yv = *(const u32x4*)(YG + (size_t)(col >> 4) * GM_STRIDE + (size_t)row * 16 + (col & 15));
                    const f32x4 y0 = (f32x4){bf_lo(yv.x), bf_hi(yv.x), bf_lo(yv.y), bf_hi(yv.y)}, y1 = (f32x4){bf_lo(yv.z), bf_hi(yv.z), bf_lo(yv.w), bf_hi(yv.w)};
                    f32x4 v0 = acc[ai][bj][m][0] + bv[bj][0], v1 = acc[ai][bj][m][1] + bv[bj][1];
#pragma unroll
                    for (int j = 0; j < 4; ++j) { v0[j] = y0[j] * fast_sigmoid(v0[j]); v1[j] = y1[j] * fast_sigmoid(v1[j]); }
                    u32x4 w; w.x = cvt_pk_bf16(v0[0], v0[1]); w.y = cvt_pk_bf16(v0[2], v0[3]); w.z = cvt_pk_bf16(v1[0], v1[1]); w.w = cvt_pk_bf16(v1[2], v1[3]);
                    *(u32x4*)(YPRE + (size_t)row * 2048 + col) = w; }
                }
    } };
template <bool PLEADD> struct EpiRes { static constexpr bool PERM = false, AFTER_DRAIN = false; const bf16_t* HBp; const float* bias; float* V; const bf16_t* SG; const bf16_t* PW;
    __device__ __forceinline__ void operator()(AccT& acc, const GUnit& u, int wr, int wc, int fr, int fq) const {
        const int pm = u.i0, pn = u.i1; const int c0 = pn * 256 + wc * 32 + 4 * fq;
        f32x4 bv[2][2];
#pragma unroll
        for (int bj = 0; bj < 2; ++bj)
#pragma unroll
            for (int n = 0; n < 2; ++n) bv[bj][n] = *(const f32x4*)(bias + c0 + bj * 128 + n * 16);
#pragma unroll
        for (int ai = 0; ai < 2; ++ai)
#pragma unroll
            for (int m = 0; m < 4; ++m) { const int row = pm * 256 + ai * 128 + wr * 64 + m * 16 + fr;
#pragma unroll
                for (int bj = 0; bj < 2; ++bj)
#pragma unroll
                    for (int n = 0; n < 2; ++n) { const size_t off = (size_t)row * 2048 + c0 + bj * 128 + n * 16;
                        f32x4 v = acc[ai][bj][m][n] + bv[bj][n] + DN_ALPHA * bf4(*(const u32x2*)(HBp + off));
                        if (PLEADD) v += bf4(*(const u32x2*)(SG + off)) * bf4(*(const u32x2*)(PW + off));
                        *(f32x4*)(V + off) = v; } }
    } };


struct PanelStats8 { unsigned long long* xbuf; unsigned* cnt; float eps;
    __device__ __forceinline__ void run(const AccT& v, int pm, int pn, int wr, int wc, int fr, int fq, LAS unsigned char* lds, int wid) const {
        LAS f32x2* P = (LAS f32x2*)lds; LAS f32x2* S = (LAS f32x2*)(lds + 8192); const int lane = fq * 16 + fr;
#pragma unroll
        for (int ai = 0; ai < 2; ++ai)
#pragma unroll
            for (int m = 0; m < 4; ++m) { float s = 0.f;
#pragma unroll
                for (int bj = 0; bj < 2; ++bj)
#pragma unroll
                    for (int n = 0; n < 2; ++n) { const f32x4 x = v[ai][bj][m][n]; s += (x[0] + x[1]) + (x[2] + x[3]); }
                s += __shfl_xor(s, 16); s += __shfl_xor(s, 32);
                const float mw = s * (1.0f / 64.0f); float q = 0.f;
#pragma unroll
                for (int bj = 0; bj < 2; ++bj)
#pragma unroll
                    for (int n = 0; n < 2; ++n) { const f32x4 d = v[ai][bj][m][n] - mw; q += (d[0] * d[0] + d[1] * d[1]) + (d[2] * d[2] + d[3] * d[3]); }
                q += __shfl_xor(q, 16); q += __shfl_xor(q, 32);
                if (fq == 0) P[(ai * 128 + wr * 64 + m * 16 + fr) * 4 + wc] = (f32x2){mw, q}; }
        asm volatile("s_waitcnt lgkmcnt(0)" ::: "memory"); __builtin_amdgcn_s_barrier(); asm volatile("" ::: "memory");
        const int row = wid * 32 + (lane & 31);
        if (lane < 32) { const f32x2 a = P[row * 4 + 0], b = P[row * 4 + 1], c = P[row * 4 + 2], d = P[row * 4 + 3];
            const float mt = (a[0] + b[0] + c[0] + d[0]) * 0.25f; const float da = a[0] - mt, db = b[0] - mt, dc = c[0] - mt, dd = d[0] - mt;
            const float m2 = (a[1] + b[1]) + (c[1] + d[1]) + 64.0f * ((da * da + db * db) + (dc * dc + dd * dd));
            __hip_atomic_store(xbuf + ((size_t)(pm * 256 + row) * 8 + pn), ((unsigned long long)__float_as_uint(m2) << 32) | __float_as_uint(mt), __ATOMIC_RELAXED, __HIP_MEMORY_SCOPE_AGENT); }
        asm volatile("s_waitcnt vmcnt(0)" ::: "memory");
        if (lane == 0) __hip_atomic_fetch_add(cnt + 64 * pm, 1u, __ATOMIC_RELAXED, __HIP_MEMORY_SCOPE_AGENT);
        if (wid == 0) { unsigned sp = 0;
            while ((unsigned)__builtin_amdgcn_readfirstlane(__hip_atomic_load(cnt + 64 * pm, __ATOMIC_RELAXED, __HIP_MEMORY_SCOPE_AGENT)) < 64u) { __builtin_amdgcn_s_sleep(2); if (++sp > (1u << 22)) break; }
            __builtin_amdgcn_fence(__ATOMIC_ACQUIRE, "agent"); }
        asm volatile("s_waitcnt vmcnt(0) lgkmcnt(0)" ::: "memory"); __builtin_amdgcn_s_barrier(); asm volatile("" ::: "memory");
        if (lane < 32) { const unsigned long long* slot = xbuf + (size_t)(pm * 256 + row) * 8; float mt[8], m2[8]; float ms = 0.f;
#pragma unroll
            for (int t = 0; t < 8; ++t) { const unsigned long long w = __hip_atomic_load(slot + t, __ATOMIC_RELAXED, __HIP_MEMORY_SCOPE_AGENT); mt[t] = __uint_as_float((unsigned)w); m2[t] = __uint_as_float((unsigned)(w >> 32)); ms += mt[t]; }
            const float mean = ms * 0.125f; float q = 0.f;
#pragma unroll
            for (int t = 0; t < 8; ++t) { const float dm = mt[t] - mean; q += m2[t] + 256.0f * dm * dm; }
            S[row] = (f32x2){mean, 1.0f / sqrtf(q * (1.0f / 2048.0f) + eps)}; }
        asm volatile("s_waitcnt lgkmcnt(0)" ::: "memory"); __builtin_amdgcn_s_barrier(); asm volatile("" ::: "memory");
    } };
struct EpiResLn1 { static constexpr bool PERM = false, AFTER_DRAIN = true; bf16_t* HBp; const float *bias, *lng, *lnb; PanelStats8 st;
    __device__ __forceinline__ void fused(AccT& acc, const GUnit& u, int wr, int wc, int fr, int fq, LAS unsigned char* lds, int wid) const {
        const int pm = u.i0, pn = u.i1; const int c0 = pn * 256 + wc * 32 + 4 * fq; const LAS f32x2* S = (const LAS f32x2*)(lds + 8192);
#pragma unroll
        for (int bj = 0; bj < 2; ++bj)
#pragma unroll
            for (int n = 0; n < 2; ++n) { const f32x4 bv = *(const f32x4*)(bias + c0 + bj * 128 + n * 16);
#pragma unroll
                for (int ai = 0; ai < 2; ++ai)
#pragma unroll
                    for (int m = 0; m < 4; ++m) { const size_t off = (size_t)(pm * 256 + ai * 128 + wr * 64 + m * 16 + fr) * 2048 + c0 + bj * 128 + n * 16;
                        acc[ai][bj][m][n] += bv + DN_ALPHA * bf4(*(const u32x2*)(HBp + off)); } }
        st.run(acc, pm, pn, wr, wc, fr, fq, lds, wid);
#pragma unroll
        for (int bj = 0; bj < 2; ++bj)
#pragma unroll
            for (int n = 0; n < 2; ++n) { const f32x4 gg = *(const f32x4*)(lng + c0 + bj * 128 + n * 16), bb = *(const f32x4*)(lnb + c0 + bj * 128 + n * 16);
#pragma unroll
                for (int ai = 0; ai < 2; ++ai)
#pragma unroll
                    for (int m = 0; m < 4; ++m) { const int r = ai * 128 + wr * 64 + m * 16 + fr; const f32x2 sr = S[r]; const size_t off = (size_t)(pm * 256 + r) * 2048 + c0 + bj * 128 + n * 16;
                        const f32x4 o = (acc[ai][bj][m][n] - sr[0]) * sr[1] * gg + bb; u32x2 w; w.x = cvt_pk_bf16(o[0], o[1]); w.y = cvt_pk_bf16(o[2], o[3]); *(u32x2*)(HBp + off) = w; } }
    } };
struct EpiResLn2 { static constexpr bool PERM = false, AFTER_DRAIN = true; const bf16_t* HBp; const float *bias, *lng, *lnb; float* out; const bf16_t* SGPW; PanelStats8 st;
    __device__ __forceinline__ void fused(AccT& acc, const GUnit& u, int wr, int wc, int fr, int fq, LAS unsigned char* lds, int wid) const {
        const int pm = u.i0, pn = u.i1; const int c0 = pn * 256 + wc * 32 + 4 * fq; const LAS f32x2* S = (const LAS f32x2*)(lds + 8192);
        const bf16_t* sgp = SGPW + (size_t)pm * (1u << 20);
        f32x4 bv[2][2];
#pragma unroll
        for (int bj = 0; bj < 2; ++bj)
#pragma unroll
            for (int n = 0; n < 2; ++n) bv[bj][n] = *(const f32x4*)(bias + c0 + bj * 128 + n * 16);
#pragma unroll
        for (int ai = 0; ai < 2; ++ai)
#pragma unroll
            for (int m = 0; m < 4; ++m) { const int r = ai * 128 + wr * 64 + m * 16 + fr; const size_t lo = (size_t)r * 2048 + c0; const bf16_t* hp = HBp + (size_t)(pm * 256 + r) * 2048 + c0;
#pragma unroll
                for (int bj = 0; bj < 2; ++bj)
#pragma unroll
                    for (int n = 0; n < 2; ++n) { const int co = bj * 128 + n * 16;
                        acc[ai][bj][m][n] += bv[bj][n] + DN_ALPHA * bf4(*(const u32x2*)(hp + co)) + bf4(*(const u32x2*)(sgp + lo + co)) * bf4(*(const u32x2*)(sgp + (1u << 19) + lo + co)); }
                asm volatile("" : "+v"(acc[ai][0][m][0]), "+v"(acc[ai][0][m][1]), "+v"(acc[ai][1][m][0]), "+v"(acc[ai][1][m][1])); }
        st.run(acc, pm, pn, wr, wc, fr, fq, lds, wid);
#pragma unroll
        for (int bj = 0; bj < 2; ++bj)
#pragma unroll
            for (int n = 0; n < 2; ++n) { const f32x4 gg = *(const f32x4*)(lng + c0 + bj * 128 + n * 16), bb = *(const f32x4*)(lnb + c0 + bj * 128 + n * 16);
#pragma unroll
                for (int ai = 0; ai < 2; ++ai)
#pragma unroll
                    for (int m = 0; m < 4; ++m) { const int r = ai * 128 + wr * 64 + m * 16 + fr; const f32x2 sr = S[r];
                        *(f32x4*)(out + (size_t)(pm * 256 + r) * 2048 + c0 + bj * 128 + n * 16) = (acc[ai][bj][m][n] - sr[0]) * sr[1] * gg + bb; } }
    } };
struct EpiG { static constexpr bool PERM = true, AFTER_DRAIN = false; bf16_t *G0, *G1; const float* bias;
    __device__ __forceinline__ void operator()(AccT& acc, const GUnit& u, int wr, int wc, int fr, int fq) const {
        const int pm = u.i0, h = u.i1; bf16_t* base = (pm < 16 ? G0 : G1) + (size_t)(pm & 15) * 256 * 4096 + h * 256;
        epi_bf16_store<0>(acc, base, 4096, bias + h * 256, wr, wc, fr, fq); } };
__device__ __forceinline__ float bfu(unsigned short v) { return __uint_as_float(((unsigned)v) << 16); }
__device__ __forceinline__ void rg_gate(float pa, float px, float spv, float xc, float& a, float& b) {
    const float r = fast_sigmoid(pa), ig = fast_sigmoid(px); const float la = spv * r; a = __expf(la); const float x = 2.0f * la;
    const float om = -x * (1.0f + x * (0.5f + x * (0.16666667f + x * (0.041666668f + x * 0.008333334f))));
    b = __builtin_amdgcn_sqrtf(fmaxf(om, 0.f)) * ig * xc; }
__device__ __forceinline__ void rg_gate2(float pa, float px, float spv, float xc, float& a, float& b, float& r) {
    r = fast_sigmoid(pa); const float ig = fast_sigmoid(px); const float la = spv * r; a = __expf(la); const float x = 2.0f * la;
    const float om = -x * (1.0f + x * (0.5f + x * (0.16666667f + x * (0.041666668f + x * 0.008333334f))));
    b = __builtin_amdgcn_sqrtf(fmaxf(om, 0.f)) * ig * xc; }
struct RgCtx { const bf16_t *XR, *G0, *G1, *Z; const float *convw, *convb, *sp; float* agg; bf16_t* ypre; };
__device__ __forceinline__ const bf16_t* g_row(const RgCtx& R, int t) { return (t < 4096 ? R.G0 : R.G1) + (size_t)(t & 4095) * 4096; }
__device__ __forceinline__ void rg_pass_a(const RgCtx& R, int half, int seg, int tid) {
    const int c = half * 512 + tid, gcol = (c >> 6) * 256 + (c & 63) * 4, t0 = seg * 64;
    const float w0 = R.convw[c], w1 = R.convw[1024 + c], w2 = R.convw[2048 + c], w3 = R.convw[3072 + c], cb = R.convb[c], sp0 = R.sp[c], sp1 = R.sp[1024 + c];
    const bf16_t* xp = R.XR + c;
    float x0 = bfu(xp[(size_t)(t0 + 0) * 1024]), x1 = bfu(xp[(size_t)(t0 + 1) * 1024]), x2 = bfu(xp[(size_t)(t0 + 2) * 1024]);
    float Af = 1.f, Bf = 0.f, Ab = 1.f, Bb = 0.f;
    for (int tb = 0; tb < 64; tb += 16) {
        u32x2 gq[16]; unsigned short xn[16];
#pragma unroll
        for (int i = 0; i < 16; ++i) { const int t = t0 + tb + i; gq[i] = *(const u32x2*)(g_row(R, t) + gcol); xn[i] = xp[(size_t)(t + 3) * 1024]; }
#pragma unroll
        for (int i = 0; i < 16; ++i) { const float x3 = bfu(xn[i]); const float xc = cb + w0 * x0 + w1 * x1 + w2 * x2 + w3 * x3; x0 = x1; x1 = x2; x2 = x3;
            float a, b, r0, r1, b0; rg_gate2(bf_lo(gq[i].x), bf_lo(gq[i].y), sp0, xc, a, b, r0); Bf = a * Bf + b; Af = a * Af; b0 = b;
            rg_gate2(bf_hi(gq[i].x), bf_hi(gq[i].y), sp1, xc, a, b, r1); Bb = Ab * b + Bb; Ab = Ab * a;
            u32x2 w; w.x = cvt_pk_bf16(r0, r1); w.y = cvt_pk_bf16(b0, b); *(u32x2*)((bf16_t*)g_row(R, t0 + tb + i) + gcol) = w; }
    }
    *(f32x2*)(R.agg + ((size_t)(seg * 2 + 0) * 1024 + c) * 2) = (f32x2){Af, Bf};
    *(f32x2*)(R.agg + ((size_t)(seg * 2 + 1) * 1024 + c) * 2) = (f32x2){Ab, Bb};
}
__device__ __forceinline__ void rg_pass_c(const RgCtx& R, int half, int seg, int tid, LAS float* Lh) {
    const int c = half * 512 + tid, gcol = (c >> 6) * 256 + (c & 63) * 4, t0 = seg * 64;
    const float sp0 = R.sp[c], sp1 = R.sp[1024 + c];
    const f32x2* ag = (const f32x2*)R.agg;
    float hf = 0.f, hb = 0.f;
    {
#pragma unroll 1
        for (int sb = 0; sb < 128; sb += 32) { f32x2 ab[32];
#pragma unroll
            for (int i = 0; i < 32; ++i) { const int s2 = sb + i; ab[i] = (s2 < seg) ? ag[(size_t)(s2 * 2 + 0) * 1024 + c] : (f32x2){1.f, 0.f}; }
#pragma unroll
            for (int i = 0; i < 32; ++i) hf = ab[i][0] * hf + ab[i][1]; }
#pragma unroll 1
        for (int sb = 96; sb >= 0; sb -= 32) { f32x2 ab[32];
#pragma unroll
            for (int i = 0; i < 32; ++i) { const int s2 = sb + 31 - i; ab[i] = (s2 > seg) ? ag[(size_t)(s2 * 2 + 1) * 1024 + c] : (f32x2){1.f, 0.f}; }
#pragma unroll
            for (int i = 0; i < 32; ++i) hb = ab[i][0] * hb + ab[i][1]; }
    }
    {
        for (int tb = 0; tb < 64; tb += 16) {
            u32x2 gq[16];
#pragma unroll
            for (int i = 0; i < 16; ++i) gq[i] = *(const u32x2*)(g_row(R, t0 + tb + i) + gcol);
#pragma unroll
            for (int i = 0; i < 16; ++i) { const float a = __expf(sp0 * bf_lo(gq[i].x)); hf = a * hf + bf_lo(gq[i].y); Lh[(tb + i) * 512 + tid] = hf; }
        }
    }
    {
        for (int tb = 48; tb >= 0; tb -= 16) {
            u32x2 gq[16]; unsigned short zz[16];
#pragma unroll
            for (int i = 0; i < 16; ++i) { const int t = t0 + tb + 15 - i; gq[i] = *(const u32x2*)(g_row(R, t) + gcol); zz[i] = __builtin_nontemporal_load(R.Z + (size_t)t * 1024 + c); }
#pragma unroll
            for (int i = 0; i < 16; ++i) { const int tl = tb + 15 - i; const float a = __expf(sp1 * bf_hi(gq[i].x)); hb = a * hb + bf_hi(gq[i].y);
                const float o = (Lh[tl * 512 + tid] + hb) * gelu_tanh(bfu(zz[i]));
                R.ypre[(size_t)(t0 + tl) * 2048 + 1024 + c] = (bf16_t)(cvt_pk_bf16(o, 0.f) & 0xffffu); }
        }
    }
}

#ifndef NAIVE_GEMM
#define NAIVE_GEMM 0
#endif
template <class Epi, class Sched>
__device__ __forceinline__ void gemm_phase_naive(LAS unsigned char* lds, const int wid, const GParm gp, const Sched& S, const Epi& E) {
    const int lane = fresh_lane(), tid = wid * 64 + lane, wr = wid >> 2, wc = wid & 3, fr = lane & 15, fq = lane >> 4;
    GUnit cur;
    for (int ui = 0; S.next(ui, cur); ++ui) {
        f32x4 acc[2][2][4][2];
#pragma unroll
        for (int ai = 0; ai < 2; ++ai)
#pragma unroll
            for (int bj = 0; bj < 2; ++bj)
#pragma unroll
                for (int m = 0; m < 4; ++m)
#pragma unroll
                    for (int n = 0; n < 2; ++n)
#pragma unroll
                        for (int e = 0; e < 4; ++e) {
                            const int row = 128 * ai + 64 * wr + 16 * m + fr; const int col = Epi::PERM ? (128 * bj + 32 * wc + 8 * fq + 4 * n + e) : (128 * bj + 32 * wc + 16 * n + 4 * fq + e);
                            const char* ap = cur.A + (size_t)row * gp.a_rs; const char* bp = cur.B + (size_t)col * gp.K * 2; float sum = 0.f;
                            for (int k = 0; k < gp.K; k += 8) { const int kt = k >> 6, C = k & 63;
                                const u32x4 av = *(const u32x4*)(ap + (size_t)kt * gp.a_ks + ((C / gp.a_cw) * gp.a_cs + (C % gp.a_cw)) * 2), bv = *(const u32x4*)(bp + k * 2);
                                sum += bf_lo(av.x) * bf_lo(bv.x) + bf_hi(av.x) * bf_hi(bv.x) + bf_lo(av.y) * bf_lo(bv.y) + bf_hi(av.y) * bf_hi(bv.y) + bf_lo(av.z) * bf_lo(bv.z) + bf_hi(av.z) * bf_hi(bv.z) + bf_lo(av.w) * bf_lo(bv.w) + bf_hi(av.w) * bf_hi(bv.w); }
                            acc[ai][bj][m][n][e] = sum; }
        if constexpr (Epi::AFTER_DRAIN) { __syncthreads(); E.fused(acc, cur, wr, wc, fr, fq, lds, wid); } else E(acc, cur, wr, wc, fr, fq);
    }
    __syncthreads();
}
#if NAIVE_GEMM
#define GEMM_PHASE gemm_phase_naive
#else
#define GEMM_PHASE pg8::gemm_phase
#endif
__device__ __forceinline__ void transpose_item(const float* W, int K, int N, bf16_t* WT, LAS float* scr, int item, int lane) {
    const int nblk = N / 64, kb = item / nblk, nb = item % nblk, k0 = 64 * kb, n0 = 64 * nb;
    const float* src = W + (size_t)k0 * N + n0 + lane;
#pragma unroll
    for (int i = 0; i < 64; ++i) scr[i * 65 + lane] = __builtin_nontemporal_load(src + (size_t)i * N);
    LDS_WAIT();
    const int c = lane & 7;
#pragma unroll
    for (int j = 0; j < 8; ++j) { const int n = (lane >> 3) + 8 * j; const LAS float* sp = scr + (8 * c) * 65 + n;
        u32x4 o; o.x = cvt_pk_bf16(sp[0 * 65], sp[1 * 65]); o.y = cvt_pk_bf16(sp[2 * 65], sp[3 * 65]); o.z = cvt_pk_bf16(sp[4 * 65], sp[5 * 65]); o.w = cvt_pk_bf16(sp[6 * 65], sp[7 * 65]);
        *(u32x4*)(WT + (size_t)(n0 + n) * K + k0 + 8 * c) = o; }
    LDS_WAIT();
}
template <bool OUT_BF16> __device__ __forceinline__ void ln_row(const float* xrow, const float* g, const float* b, void* orow, int lane) {
    const f32x4* xr = (const f32x4*)xrow + lane; f32x4 v[8]; float s = 0.f;
#pragma unroll
    for (int j = 0; j < 8; ++j) { v[j] = __builtin_nontemporal_load(xr + 64 * j); s += (v[j][0] + v[j][1]) + (v[j][2] + v[j][3]); }
    const float mean = wave_sum(s) * (1.f / DM); float s2 = 0.f;
#pragma unroll
    for (int j = 0; j < 8; ++j) { v[j] = v[j] - mean; s2 += (v[j][0] * v[j][0] + v[j][1] * v[j][1]) + (v[j][2] * v[j][2] + v[j][3] * v[j][3]); }
    const float rstd = 1.0f / sqrtf(wave_sum(s2) * (1.f / DM) + LN_EPS);
#pragma unroll
    for (int j = 0; j < 8; ++j) { const f32x4 gg = ((const f32x4*)g)[lane + 64 * j], bb = ((const f32x4*)b)[lane + 64 * j]; const f32x4 o = v[j] * rstd * gg + bb;
        if (OUT_BF16) { u32x2 w; w.x = cvt_pk_bf16(o[0], o[1]); w.y = cvt_pk_bf16(o[2], o[3]); ((u32x2*)orow)[lane + 64 * j] = w; }
        else ((f32x4*)orow)[lane + 64 * j] = o; }
}
__device__ __forceinline__ void cpow(float lrs, float th, int j, float& re, float& im) {
    double a = (double)j * (double)th * 0.15915494309189535; a -= rint(a); const float af = 2.0f * (float)a;
    const float mag = expf((float)j * lrs); re = mag * cospif(af); im = mag * sinpif(af);
}


#ifndef NAIVE_RG
#define NAIVE_RG 0
#endif
__device__ __forceinline__ void naive_rg_channel(const RgCtx& R, int c) {
    const int gcol = (c >> 6) * 256 + (c & 63);
    const float w0 = R.convw[c], w1 = R.convw[1024 + c], w2 = R.convw[2048 + c], w3 = R.convw[3072 + c], cb = R.convb[c], sp0 = R.sp[c], sp1 = R.sp[1024 + c];
    const bf16_t* xp = R.XR + c; float h = 0.f;
    for (int t = 0; t < SEQ; ++t) { const float xc = cb + w0 * bfu(xp[(size_t)t * 1024]) + w1 * bfu(xp[(size_t)(t + 1) * 1024]) + w2 * bfu(xp[(size_t)(t + 2) * 1024]) + w3 * bfu(xp[(size_t)(t + 3) * 1024]);
        const bf16_t* g = g_row(R, t) + gcol; float a, b; rg_gate(bfu(g[0]), bfu(g[128]), sp0, xc, a, b); h = a * h + b;
        R.ypre[(size_t)t * 2048 + 1024 + c] = (bf16_t)(cvt_pk_bf16(h, 0.f) & 0xffffu); }
    __builtin_amdgcn_fence(__ATOMIC_SEQ_CST, "agent");
    h = 0.f;
    for (int t = SEQ - 1; t >= 0; --t) { const float xc = cb + w0 * bfu(xp[(size_t)t * 1024]) + w1 * bfu(xp[(size_t)(t + 1) * 1024]) + w2 * bfu(xp[(size_t)(t + 2) * 1024]) + w3 * bfu(xp[(size_t)(t + 3) * 1024]);
        const bf16_t* g = g_row(R, t) + gcol; float a, b; rg_gate(bfu(g[64]), bfu(g[192]), sp1, xc, a, b); h = a * h + b;
        const size_t o = (size_t)t * 2048 + 1024 + c; const float y = (bfu(R.ypre[o]) + h) * gelu_tanh(bfu(R.Z[(size_t)t * 1024 + c]));
        R.ypre[o] = (bf16_t)(cvt_pk_bf16(y, 0.f) & 0xffffu); }
}

#ifndef NAIVE_S5
#define NAIVE_S5 0
#endif
__device__ __forceinline__ void naive_s5_group(const float* const* in, const bf16_t* U, float* tmp, bf16_t* YG, int g, int lane) {
    const float *lre = in[6], *lim = in[7], *lstep = in[8], *bre = in[9], *bim = in[10], *cre = in[11], *cim = in[12], *dd = in[13];
    for (int n = 0; n < 2; ++n) {
        const int p = lane, pi = (n * 64 + g) * 64 + p;
        const float lr = fminf(lre[pi], -1e-4f), li = lim[pi], step = expf(lstep[n * 64 + g]); float ar, ai; cpow(lr * step, li * step, 1, ar, ai);
        const float nr = ar - 1.0f, ni = ai, den = lr * lr + li * li; const float qr = (nr * lr + ni * li) / den, qi = (ni * lr - nr * li) / den;
        float hr = 0.f, hi = 0.f;
        for (int tt = 0; tt < SEQ; ++tt) { const int t = n == 0 ? tt : SEQ - 1 - tt; const bf16_t* up = U + (size_t)t * 1024 + g * 16;
            float bur = 0.f, bui = 0.f;
#pragma unroll
            for (int k = 0; k < 16; ++k) { const float uv = bfu(up[k]); const float br = bre[(size_t)pi * 16 + k], bi = bim[(size_t)pi * 16 + k]; bur += (qr * br - qi * bi) * uv; bui += (qr * bi + qi * br) * uv; }
            const float nhr = ar * hr - ai * hi + bur, nhi = ar * hi + ai * hr + bui; hr = nhr; hi = nhi;
#pragma unroll
            for (int k = 0; k < 16; ++k) { const size_t ci = ((size_t)(n * 64 + g) * 16 + k) * 64 + p; float v = cre[ci] * hr - cim[ci] * hi; v = wave_sum(v);
                if (lane == k) { const size_t o = (size_t)t * 1024 + g * 16 + k;
                    if (n == 0) tmp[o] = v; else { const float y = tmp[o] + v + dd[g * 16 + k] * bfu(up[k]); YG[o] = (bf16_t)(cvt_pk_bf16(gelu_tanh(y), 0.f) & 0xffffu); } } }
        }
        __builtin_amdgcn_fence(__ATOMIC_SEQ_CST, "agent");
    }
}

#define XB_TMO      128
#define XB_XCNT(j)  (256  + 64 * (j))
#define XB_XSUB(j)  (1280 + 64 * (j))
#define XB_XGEN(j)  (2304 + 64 * (j))
#define XB_TOP      3328
#define XB_TOPGEN   3392
#define XCD_BAR_WORDS 3456
#define XB_SPIN_CAP (1u << 18)
__device__ __forceinline__ unsigned xb_ld(unsigned* p)              { return __hip_atomic_load(p, __ATOMIC_RELAXED, __HIP_MEMORY_SCOPE_AGENT); }
__device__ __forceinline__ unsigned xb_add(unsigned* p, unsigned v) { return __hip_atomic_fetch_add(p, v, __ATOMIC_RELAXED, __HIP_MEMORY_SCOPE_AGENT); }
__device__ __forceinline__ unsigned xb_xcc_id() { return (unsigned)__builtin_amdgcn_s_getreg((3 << 11) | 20) & 0xFu; }
#define XB_SPIN(cond, bar) do { unsigned _sp = 0; while (cond) { __builtin_amdgcn_s_sleep(1); \
    if ((++_sp & 255u) == 0u) { if (xb_ld(&(bar)[XB_TMO])) break; if (_sp > XB_SPIN_CAP) { atomicAdd(&(bar)[XB_TMO], 1u); break; } } } } while (0)
struct XcdBarrier { unsigned* bar; unsigned x; volatile LAS unsigned* st; };
__device__ __forceinline__ void xcd_barrier_complete(unsigned* bar, unsigned x, unsigned G, unsigned& nloc, unsigned& nx) {
    unsigned sum, cnt, mine, sp = 0u;
    for (;;) {
        sum = 0u; cnt = 0u; mine = 0u;
#pragma unroll
        for (unsigned j = 0; j < 16; ++j) { const unsigned c = xb_ld(&bar[XB_XCNT(j)]); sum += c; cnt += (c > 0u) ? 1u : 0u; mine = (j == x) ? c : mine; }
        if (sum == G) break;
        __builtin_amdgcn_s_sleep(1);
        if ((++sp & 255u) == 0u) { if (xb_ld(&bar[XB_TMO])) break; if (sp > XB_SPIN_CAP) { atomicAdd(&bar[XB_TMO], 1u); break; } }
    }
    nloc = mine > 0u ? mine : 1u; nx = cnt > 0u ? cnt : 1u;
}
__device__ __forceinline__ void xcd_barrier(const XcdBarrier& b, unsigned G, int wave) {
    asm volatile("s_waitcnt vmcnt(0)" ::: "memory");
    __syncthreads();
    if (wave == 0) { if (fresh_lane() == 0) {
        unsigned* bar = b.bar;
        __builtin_amdgcn_s_waitcnt(0);
        unsigned nloc = b.st[0], nx = b.st[1];
        if (nloc == 0u) { xcd_barrier_complete(bar, b.x, G, nloc, nx); b.st[0] = nloc; b.st[1] = nx; }
        const unsigned old = xb_add(&bar[XB_XSUB(b.x)], 1u);
        const unsigned gen = old / nloc;
        if (old + 1u == (gen + 1u) * nloc) {
            __builtin_amdgcn_fence(__ATOMIC_RELEASE, "agent");
            asm volatile("s_waitcnt vmcnt(0)" ::: "memory");
            const unsigned og = xb_add(&bar[XB_TOP], 1u);
            const unsigned tg = og / nx;
            if (og + 1u == (tg + 1u) * nx) xb_add(&bar[XB_TOPGEN], 1u);
            else XB_SPIN(xb_ld(&bar[XB_TOPGEN]) == tg, bar);
            __builtin_amdgcn_fence(__ATOMIC_ACQUIRE, "agent");
            xb_add(&bar[XB_XGEN(b.x)], 1u);
            asm volatile("s_waitcnt vmcnt(0)" ::: "memory");
        } else {
            XB_SPIN(xb_ld(&bar[XB_XGEN(b.x)]) == gen, bar);
            __builtin_amdgcn_fence(__ATOMIC_ACQUIRE, "agent");
            asm volatile("s_waitcnt vmcnt(0)" ::: "memory");
        }
    } }
    __syncthreads();
}

__device__ __forceinline__ void grid_barrier(unsigned* bar, unsigned target, int wave) {
    asm volatile("s_waitcnt vmcnt(0)" ::: "memory");
    __syncthreads();
    if (wave == 0) { const int l = fresh_lane();
        if (l == 0) {
            __builtin_amdgcn_fence(__ATOMIC_RELEASE, "agent"); asm volatile("s_waitcnt vmcnt(0)" ::: "memory");
            __hip_atomic_fetch_add(bar, 1u, __ATOMIC_RELAXED, __HIP_MEMORY_SCOPE_AGENT);
            while (__hip_atomic_load(bar, __ATOMIC_RELAXED, __HIP_MEMORY_SCOPE_AGENT) < target) __builtin_amdgcn_s_sleep(2);
            __builtin_amdgcn_fence(__ATOMIC_ACQUIRE, "agent"); asm volatile("s_waitcnt vmcnt(0)" ::: "memory");
        } }
    __syncthreads();
}

struct Args { const float* in[38]; float* out; unsigned char* ws; int ph_lo, ph_hi; };
typedef const float* cfp_t;
typedef const __attribute__((address_space(4))) cfp_t* kin_t;

__device__ __forceinline__ void s5_precompute(const kin_t ain, unsigned char* aws, int g, int hq, int nh, LAS float* L, const int tid) {
    const float *lre = ain[6], *lim = ain[7], *lstep = ain[8], *bre = ain[9], *bim = ain[10], *cre = ain[11], *cim = ain[12], *dd = ain[13];
    LAS float *PWre = L, *PWim = L + 4224, *BBre = L + 8448, *BBim = L + 10496, *CCre = L + 12544, *CCim = L + 14592, *MT = L + 16640, *C2re = L + 33280, *C2im = L + 35328, *Dl = L + 37376;
    bf16_t* WGg = (bf16_t*)(aws + WS_WG) + (size_t)g * 768 * 512; bf16_t* WCg = (bf16_t*)(aws + WS_WC) + (size_t)g * 512 * 256;
#define PSTAMP(i) do { if (TSTAMP && blockIdx.x == 128 && tid == 0) ((unsigned long long*)(aws + WS_CTR + 1024))[i] = __builtin_amdgcn_s_memrealtime(); } while (0)
    PSTAMP(20);
    {
        const int np = tid & 127, jj = tid >> 7, n = np >> 6, p = np & 63; const int pi = (n * 64 + g) * 64 + p;
        const float lr = fminf(lre[pi], -1e-4f), li = lim[pi], step = expf(lstep[n * 64 + g]); const float lrs = lr * step, th = li * step;
        for (int j = jj; j <= 32; j += 4) { float r, i; cpow(lrs, th, j, r, i); PWre[np * 33 + j] = r; PWim[np * 33 + j] = i; }
        float l1r, l1i; cpow(lrs, th, 1, l1r, l1i);
        const float nr = l1r - 1.0f, ni = l1i, den = lr * lr + li * li; const float qr = (nr * lr + ni * li) / den, qi = (ni * lr - nr * li) / den;
#pragma unroll
        for (int k = jj * 4; k < jj * 4 + 4; ++k) { const float br = bre[(size_t)pi * 16 + k], bi = bim[(size_t)pi * 16 + k]; BBre[np * 16 + k] = qr * br - qi * bi; BBim[np * 16 + k] = qr * bi + qi * br; }
        for (int e = tid; e < 2048; e += 512) { const int n2 = e >> 10, k = (e >> 6) & 15, p2 = e & 63; const size_t ci = ((size_t)(n2 * 64 + g) * 16 + k) * 64 + p2; CCre[(n2 * 64 + p2) * 16 + k] = cre[ci]; CCim[(n2 * 64 + p2) * 16 + k] = cim[ci]; C2re[e] = cre[ci]; C2im[e] = cim[ci]; }
        if (tid < 16) Dl[tid] = dd[g * 16 + tid];
    }
    __syncthreads();
    PSTAMP(21);
    for (int i = 0; i < 3; ++i) {
        if (nh == 2) { if (i < 2 && i != hq) continue; if (i == 2 && (hq != 0 || tid >= 16)) continue; } else if (i == 2) continue;
        const int bq = (i == 2) ? 512 + tid : tid + 512 * i, n = bq >> 9, j = (bq >> 4) & 31, kob = (bq >> 2) & 3, kib = bq & 3;
        f32x4 m0 = {0.f, 0.f, 0.f, 0.f}, m1 = m0, m2 = m0, m3 = m0;
        for (int p = 0; p < 64; ++p) { const int np = n * 64 + p; const float pr = PWre[np * 33 + j], pi2 = PWim[np * 33 + j];
            const f32x4 br = *(const LAS f32x4*)(BBre + np * 16 + 4 * kib), bi = *(const LAS f32x4*)(BBim + np * 16 + 4 * kib), cr = *(const LAS f32x4*)(CCre + np * 16 + 4 * kob), ci = *(const LAS f32x4*)(CCim + np * 16 + 4 * kob);
            const f32x4 er = pr * br - pi2 * bi, ei = pr * bi + pi2 * br;
            m0 += cr[0] * er - ci[0] * ei; m1 += cr[1] * er - ci[1] * ei; m2 += cr[2] * er - ci[2] * ei; m3 += cr[3] * er - ci[3] * ei; }
        LAS float* o = MT + (n * 32 + j) * 260 + (4 * kob) * 16 + 4 * kib;
        *(LAS f32x4*)o = m0; *(LAS f32x4*)(o + 16) = m1; *(LAS f32x4*)(o + 32) = m2; *(LAS f32x4*)(o + 48) = m3;
    }
    __syncthreads();
    PSTAMP(22);
    for (int i = 0; i < 64; ++i) {
        const int idx = tid + 512 * i, row = idx >> 6, cp = idx & 63, t = row >> 4, ko = row & 15, s = cp >> 1, ki0 = (cp & 1) * 8;
        if (nh == 2 && ((t >= s) != (hq == 0))) continue;
        f32x4 v0, v1;
        if (t != s) { const LAS float* src = MT + ((t > s ? 0 : 1) * 32 + (t > s ? t - s : s - t)) * 260 + ko * 16 + ki0; v0 = *(const LAS f32x4*)src; v1 = *(const LAS f32x4*)(src + 4); }
        else { const LAS float* s0 = MT + ko * 16 + ki0; const LAS float* s1 = MT + 32 * 260 + ko * 16 + ki0; v0 = *(const LAS f32x4*)s0 + *(const LAS f32x4*)s1; v1 = *(const LAS f32x4*)(s0 + 4) + *(const LAS f32x4*)(s1 + 4);
            const float dv = Dl[ko];
#pragma unroll
            for (int e = 0; e < 4; ++e) { if (ki0 + e == ko) v0[e] += dv; if (ki0 + 4 + e == ko) v1[e] += dv; } }
        u32x4 w; w.x = cvt_pk_bf16(v0[0], v0[1]); w.y = cvt_pk_bf16(v0[2], v0[3]); w.z = cvt_pk_bf16(v1[0], v1[1]); w.w = cvt_pk_bf16(v1[2], v1[3]);
        *(u32x4*)(WGg + (size_t)row * 512 + cp * 8) = w;
    }
    for (int i = hq * (32 / nh); i < (hq + 1) * (32 / nh); ++i) {
        const int idx = tid + 512 * i, q = idx >> 6, cp = idx & 63, n = q >> 7, ri = (q >> 6) & 1, p = q & 63, s = cp >> 1, ki0 = (cp & 1) * 8, e = n == 0 ? 31 - s : s, np = n * 64 + p;
        const float pr = PWre[np * 33 + e], pi2 = PWim[np * 33 + e]; float v[8];
#pragma unroll
        for (int k = 0; k < 8; ++k) { const float br = BBre[np * 16 + ki0 + k], bi = BBim[np * 16 + ki0 + k]; v[k] = ri == 0 ? pr * br - pi2 * bi : pr * bi + pi2 * br; }
        u32x4 w; w.x = cvt_pk_bf16(v[0], v[1]); w.y = cvt_pk_bf16(v[2], v[3]); w.z = cvt_pk_bf16(v[4], v[5]); w.w = cvt_pk_bf16(v[6], v[7]);
        *(u32x4*)(WGg + (size_t)(512 + q) * 512 + cp * 8) = w;
    }
    for (int i = 0; i < 32 / nh; ++i) {
        const int idx = tid + 512 * i, row = nh == 2 ? idx >> 4 : idx >> 5, q0 = nh == 2 ? hq * 128 + (idx & 15) * 8 : (idx & 31) * 8, n = q0 >> 7, ri = (q0 >> 6) & 1, p0 = q0 & 63, t = row >> 4, ko = row & 15, e = n == 0 ? t + 1 : 32 - t; float v[8];
#pragma unroll
        for (int k = 0; k < 8; ++k) { const int np = n * 64 + p0 + k; const float cr = C2re[(n * 16 + ko) * 64 + p0 + k], ci = C2im[(n * 16 + ko) * 64 + p0 + k], pr = PWre[np * 33 + e], pi2 = PWim[np * 33 + e];
            v[k] = ri == 0 ? cr * pr - ci * pi2 : -(cr * pi2 + ci * pr); }
        u32x4 w; w.x = cvt_pk_bf16(v[0], v[1]); w.y = cvt_pk_bf16(v[2], v[3]); w.z = cvt_pk_bf16(v[4], v[5]); w.w = cvt_pk_bf16(v[6], v[7]);
        *(u32x4*)(WCg + (size_t)row * 256 + q0) = w;
    }
    __syncthreads();
    PSTAMP(23);
}


#ifndef DIAG
#define DIAG 0
#endif
__device__ __forceinline__ void diag_ffn(const float* const* in, const unsigned char* ws, const float* outp, unsigned* flagw, int gtid, int GT) {
    const bf16_t* h1 = (const bf16_t*)(ws + WS_HB); const bf16_t* T = (const bf16_t*)(ws + WS_T); const float* V2 = (const float*)(ws + WS_V2);
    const float *w1 = in[29], *b1 = in[30], *w2 = in[31], *b2 = in[32], *wp = in[33], *wg = in[34], *bg = in[35], *pp = in[1];
    for (int sidx = gtid; sidx < 16384; sidx += GT) {
        unsigned hsh = (unsigned)sidx * 2654435761u, h2 = ((unsigned)sidx + 977u) * 2246822519u; const int r = (hsh >> 8) % SEQ; const int c = (h2 >> 6) % DFF; const int c2 = c % DM;
        float a = b1[c]; for (int k = 0; k < DM; ++k) a += bfu(h1[(size_t)r * DM + k]) * w1[(size_t)k * DFF + c];
        a = fmaxf(a, 0.f); a = a * a; const float tv = bfu(T[(size_t)r * DFF + c]);
        if (fabsf(tv - a) > 0.008f * fabsf(a) + 0.006f) atomicAdd(flagw + 0, 1u);
        float f = b2[c2]; for (int k = 0; k < DFF; ++k) f += bfu(T[(size_t)r * DFF + k]) * w2[(size_t)k * DM + c2];
        float gt = bg[c2]; for (int k = 0; k < DM; ++k) gt += bfu(h1[(size_t)r * DM + k]) * wg[(size_t)k * DM + c2];
        float pw = 0.f; for (int k = 0; k < PLE; ++k) pw += pp[(size_t)r * PLE + k] * wp[(size_t)k * DM + c2];
        const float v2 = DN_ALPHA * bfu(h1[(size_t)r * DM + c2]) + f + fast_sigmoid(gt) * pw; const float got = V2[(size_t)r * DM + c2];
        if (fabsf(got - v2) > 0.008f * fabsf(v2) + 0.006f) atomicAdd(flagw + 1, 1u);
        { const float* vr = V2 + (size_t)r * DM; float m = 0.f; for (int k = 0; k < DM; ++k) m += vr[k]; m /= DM; float v = 0.f; for (int k = 0; k < DM; ++k) { const float d = vr[k] - m; v += d * d; } v /= DM;
          const float e = (vr[c2] - m) / sqrtf(v + LN_EPS) * in[36][c2] + in[37][c2]; const float go = outp[(size_t)r * DM + c2]; if (fabsf(go - e) > 0.004f * fabsf(e) + 0.003f) atomicAdd(flagw + 2, 1u); }
    }
}

__device__ __forceinline__ void diag_pre(const float* const* in, const unsigned char* ws, const unsigned char* dout, unsigned* flagw, int gtid, int GT) {
    const bf16_t* h0 = (const bf16_t*)(ws + WS_HB); const bf16_t* U = (const bf16_t*)(dout + DO_U); const bf16_t* XRb = (const bf16_t*)(ws + WS_XR) + 2048; const bf16_t* Z = (const bf16_t*)(dout + DO_Z);
    const bf16_t* ypre = (const bf16_t*)(dout + DO_YPRE); const bf16_t* ycat = (const bf16_t*)(ws + WS_YCAT); const bf16_t* yg = (const bf16_t*)(ws + WS_YS5G);
    const float *x = in[0], *lg = in[2], *lb = in[3], *win = in[4], *bin = in[5], *gw_ = in[14], *gb = in[15], *g5 = in[23], *gr = in[24];
    for (int sidx = gtid; sidx < 8192; sidx += GT) {
        unsigned hsh = (unsigned)sidx * 2654435761u, h2 = ((unsigned)sidx + 977u) * 2246822519u; const int r = (hsh >> 8) % SEQ; const int c = (h2 >> 6) % DIN; const int c2 = c % DM; const int c1 = c % DS5;
        { float m = 0.f; for (int k = 0; k < DM; ++k) m += x[(size_t)r * DM + k]; m /= DM; float v = 0.f; for (int k = 0; k < DM; ++k) { const float d = x[(size_t)r * DM + k] - m; v += d * d; } v /= DM;
          const float e = (x[(size_t)r * DM + c2] - m) / sqrtf(v + LN_EPS) * lg[c2] + lb[c2]; const float got = bfu(h0[(size_t)r * DM + c2]); if (fabsf(got - e) > 0.008f * fabsf(e) + 0.006f) atomicAdd(flagw + 0, 1u); }
        { float a = bin[c]; for (int k = 0; k < DM; ++k) a += bfu(h0[(size_t)r * DM + k]) * win[(size_t)k * DIN + c];
          const float got = c < 1024 ? bfu(U[(size_t)r * 1024 + c]) : (c < 2048 ? bfu(XRb[(size_t)r * 1024 + c - 1024]) : bfu(Z[(size_t)r * 1024 + c - 2048])); if (fabsf(got - a) > 0.008f * fabsf(a) + 0.006f) atomicAdd(flagw + 3, 1u); }
        { const int hf = c2 >> 10; float ss = 0.f; for (int k = 0; k < 1024; ++k) { const float y = bfu(ypre[(size_t)r * DM + hf * 1024 + k]); ss += y * y; }
          const float e = bfu(ypre[(size_t)r * DM + c2]) / sqrtf(ss / 1024.f + LN_EPS) * (hf ? gr[c2 - 1024] : g5[c2]); const float got = bfu(ycat[(size_t)r * DM + c2]); if (fabsf(got - e) > 0.008f * fabsf(e) + 0.006f) atomicAdd(flagw + 1, 1u); }
        { float a = gb[c1]; for (int k = 0; k < DS5; ++k) a += bfu(yg[(size_t)r * DS5 + k]) * gw_[(size_t)k * DS5 + c1];
          const float e = bfu(yg[(size_t)r * DS5 + c1]) * fast_sigmoid(a); const float got = bfu(ypre[(size_t)r * DM + c1]); if (fabsf(got - e) > 0.008f * fabsf(e) + 0.006f) atomicAdd(flagw + 2, 1u); }
    }
}

__device__ __forceinline__ void diag_v(const float* const* in, const unsigned char* ws, const unsigned char* dout, unsigned* flagw, int gtid, int GT) {
    const bf16_t* h0 = (const bf16_t*)(ws + WS_HB); const bf16_t* ycat = (const bf16_t*)(ws + WS_YCAT); const float* V = (const float*)dout; const float *wo = in[25], *bo = in[26];
    for (int sidx = gtid; sidx < 16384; sidx += GT) { unsigned hsh = (unsigned)sidx * 2654435761u, h2 = ((unsigned)sidx + 977u) * 2246822519u; const int r = (hsh >> 8) % SEQ; const int c = (h2 >> 6) % DM;
        float a = bo[c] + DN_ALPHA * bfu(h0[(size_t)r * DM + c]); for (int k = 0; k < DM; ++k) a += bfu(ycat[(size_t)r * DM + k]) * wo[(size_t)k * DM + c];
        const float got = V[(size_t)r * DM + c]; if (fabsf(got - a) > 0.008f * fabsf(a) + 0.006f) atomicAdd(flagw + 0, 1u); }
}

__device__ __forceinline__ void diag_g(const float* const* in, const unsigned char* ws, unsigned* flagw, int gtid, int GT) {
    const bf16_t* XRp = (const bf16_t*)(ws + WS_XR); const bf16_t* G0 = (const bf16_t*)(ws + WS_G0); const bf16_t* G1 = (const bf16_t*)(ws + WS_G1);
    const float *convw = in[16], *convb = in[17], *wa = in[18], *ba = in[19], *wx = in[20], *bxx = in[21];
    for (int sidx = gtid; sidx < 16384; sidx += GT) { unsigned hsh = (unsigned)sidx * 2654435761u; unsigned h2 = ((unsigned)sidx + 12345u) * 2246822519u; const int t = (hsh >> 7) % SEQ; const int col = (h2 >> 5) % 4096;
        const int h = col >> 8, row = col & 255, bj = row >> 7, dir = (row >> 6) & 1, ch = row & 63;
        const float* W = (bj == 0 ? wa : wx) + ((size_t)(dir * 16 + h) * 64) * 64 + ch; float a = (bj == 0 ? ba : bxx)[(dir * 16 + h) * 64 + ch];
        for (int i = 0; i < 64; ++i) { const int c = 64 * h + i; float xc = convb[c];
            for (int j = 0; j < 4; ++j) xc += convw[j * 1024 + c] * bfu(XRp[(size_t)(t + j) * 1024 + c]);
            a += xc * W[(size_t)i * 64]; }
        const float got = bfu((t < 4096 ? G0 : G1)[(size_t)(t & 4095) * 4096 + col]);
        if (fabsf(got - a) > 0.008f * fabsf(a) + 0.006f) atomicAdd(flagw + 0, 1u); }
}

#ifndef DIAG_HALF
#define DIAG_HALF 1
#endif
__device__ __forceinline__ void diag_max(const unsigned char* ws, unsigned* flagw, int gtid, int GT) {
    const bf16_t* ycat = (const bf16_t*)(ws + WS_YCAT); float mx = 0.f;
    for (size_t i = gtid; i < (size_t)SEQ * 1024; i += GT) { const size_t r = i >> 10, c = (i & 1023) + DIAG_HALF * 1024; mx = fmaxf(mx, fabsf(bfu(ycat[r * DM + c]))); }
    atomicMax(flagw + 0, __float_as_uint(mx));
}

#ifndef DIAG_SEL
#define DIAG_SEL 4
#endif
__device__ __forceinline__ void diag_rows(const float* outp, unsigned* flagw, int gw, int NGW, int lane) {
    for (int row = gw; row < SEQ; row += NGW) { float mx = 0.f; for (int j = lane; j < DM; j += 64) mx = fmaxf(mx, fabsf(outp[(size_t)row * DM + j]));
#pragma unroll
        for (int o = 1; o < 64; o <<= 1) mx = fmaxf(mx, __shfl_xor(mx, o));
        if (lane == 0 && mx > 12.0f) { atomicAdd(flagw + 0, 1u); atomicMin(flagw + 1, (unsigned)row); atomicMax(flagw + 2, (unsigned)row); } }
}

__device__ __forceinline__ void diag_rows_bf(const bf16_t* p, int ld, float thr, unsigned* flagw, int gw, int NGW, int lane) {
    for (int row = gw; row < SEQ; row += NGW) { float mx = 0.f; for (int j = lane; j < ld; j += 64) mx = fmaxf(mx, fabsf(bfu(p[(size_t)row * ld + j])));
#pragma unroll
        for (int o = 1; o < 64; o <<= 1) mx = fmaxf(mx, __shfl_xor(mx, o));
        if (lane == 0 && mx > thr) { atomicAdd(flagw + 0, 1u); atomicMin(flagw + 1, (unsigned)row); atomicMax(flagw + 2, (unsigned)row); } }
}
template <int PHMASK> __global__ void __launch_bounds__(512, 2) mega(Args) {
    extern __shared__ __attribute__((aligned(16))) unsigned char lds_raw[];
    LAS unsigned char* lds = (LAS unsigned char*)lds_raw;
    const int wave = __builtin_amdgcn_readfirstlane((int)threadIdx.x >> 6);
    const int G = gridDim.x, bx = blockIdx.x;
    const int gw = bx * 8 + wave, NGW = G * 8, GT = G * 512;
#define PH_IDS const int lane = fresh_lane(), tid = wave * 64 + lane, gtid = bx * 512 + tid; (void)tid; (void)gtid; (void)lane
    const kin_t KIN = (kin_t)__builtin_amdgcn_kernarg_segment_ptr();
    unsigned char* ws = (unsigned char*)KIN[39]; unsigned char* dout = (unsigned char*)KIN[38];
    const int* kint = (const int*)0; (void)kint;
#if DIAG == 2
    const int lo = ((const __attribute__((address_space(4))) int*)KIN)[80], hi = 7;
#elif DIAG == 3
    const int lo = ((const __attribute__((address_space(4))) int*)KIN)[80], hi = 8;
#elif DIAG == 4
    const int lo = ((const __attribute__((address_space(4))) int*)KIN)[80], hi = 5;
#elif DIAG == 6
    const int lo = ((const __attribute__((address_space(4))) int*)KIN)[80], hi = 7;
#elif DIAG == 8
    const int lo = ((const __attribute__((address_space(4))) int*)KIN)[80], hi = 9;
#elif DIAG == 11 || DIAG == 12
    const int lo = ((const __attribute__((address_space(4))) int*)KIN)[80], hi = 10;
#else
    const int lo = ((const __attribute__((address_space(4))) int*)KIN)[80], hi = ((const __attribute__((address_space(4))) int*)KIN)[81];
#endif
#define IN(k) (((PHMASK >> (k)) & 1) && lo <= (k) && (k) < hi)
    unsigned nbar = 0; unsigned* gbar = (unsigned*)(ws + WS_CTR) + 32; (void)gbar;
    XcdBarrier xb; xb.bar = (unsigned*)(ws + WS_CTR) + 5120; xb.x = xb_xcc_id(); xb.st = (volatile LAS unsigned*)(lds + 155000);
    if (wave == 0) { if (fresh_lane() == 0) { xb.st[0] = 0u; xb.st[1] = 0u; (void)xb_add(&xb.bar[XB_XCNT(xb.x)], 1u); } }
    __syncthreads();
    if (PHMASK == 0xfff && hi > 4096) cg::this_grid().sync();
#ifndef DBL_MASK
#define DBL_MASK 0
#endif
#define REPS(k) (((DBL_MASK >> (k)) & 1) ? 2 : 1)
#define SEAM(k) do { if (IN(k) && IN((k) + 1)) { ++nbar; xcd_barrier(xb, (unsigned)G, wave); if (TSTAMP && bx == 0 && wave == 0) { if (fresh_lane() == 0) ((unsigned long long*)(ws + WS_CTR + 1024))[(k) + 1] = __builtin_amdgcn_s_memrealtime(); } } } while (0)

#define MK_RG const RgCtx RG{(const bf16_t*)(ws + WS_XR), (const bf16_t*)(ws + WS_G0), (const bf16_t*)(ws + WS_G1), (const bf16_t*)(dout + DO_Z), KIN[16], KIN[17], (const float*)(ws + WS_SP), (float*)(ws + WS_AGG), (bf16_t*)(dout + DO_YPRE)}
    if (TSTAMP && bx == 0 && wave == 0) { if (fresh_lane() == 0) ((unsigned long long*)(ws + WS_CTR + 1024))[0] = __builtin_amdgcn_s_memrealtime(); }
    for (int rep = 0; rep < REPS(0); ++rep) {
    if (IN(0)) { PH_IDS;
        if (G != 256) { for (int g = bx; g < 64; g += G) s5_precompute(KIN, ws, g, 0, 1, (LAS float*)lds, tid); }
        {
            LAS float* scr = (LAS float*)(lds + wave * 16640);
            constexpr int I_IN = (DM / 64) * (DIN / 64), I_OUT = (DM / 64) * (DM / 64), I_PG = I_OUT, I_GLU = (DS5 / 64) * (DS5 / 64), I_PW = (PLE / 64) * (DM / 64), I_LN = SEQ / 4;
            constexpr int NITEMS = I_IN + I_OUT + I_PG + I_GLU + I_PW + I_LN;
            for (int it = gw; it < NITEMS; it += NGW) {
                int r = it;
                if (r < I_IN) { transpose_item(KIN[4], DM, DIN, (bf16_t*)(ws + WS_WINT), scr, r, lane); continue; } r -= I_IN;
                if (r < I_LN) { for (int q = 0; q < 4; ++q) { const int row = r * 4 + q; ln_row<true>(KIN[0] + (size_t)row * DM, KIN[2], KIN[3], (bf16_t*)(ws + WS_HB) + (size_t)row * DM, lane); } continue; } r -= I_LN;
                if (r < I_OUT) { transpose_item(KIN[25], DM, DM, (bf16_t*)(ws + WS_WOUTT), scr, r, lane); continue; } r -= I_OUT;
                if (r < I_PG) { transpose_item(KIN[34], DM, DM, (bf16_t*)(ws + WS_PLEGT), scr, r, lane); continue; } r -= I_PG;
                if (r < I_GLU) { transpose_item(KIN[14], DS5, DS5, (bf16_t*)(ws + WS_GLUT), scr, r, lane); continue; } r -= I_GLU;
                transpose_item(KIN[33], PLE, DM, (bf16_t*)(ws + WS_PLEWT), scr, r, lane);
            }
        }
        {   const float* pp = KIN[1]; bf16_t* pb = (bf16_t*)(ws + WS_PB);
            for (int i = gtid; i < SEQ * PLE / 4; i += GT) { const f32x4 v = __builtin_nontemporal_load((const f32x4*)pp + i); u32x2 w; w.x = cvt_pk_bf16(v[0], v[1]); w.y = cvt_pk_bf16(v[2], v[3]); ((u32x2*)pb)[i] = w; }
            const float *convw = KIN[16], *convb = KIN[17], *wa = KIN[18], *ba = KIN[19], *wx = KIN[20], *bxx = KIN[21], *lam = KIN[22];
            bf16_t* rgw = (bf16_t*)(ws + WS_RGW);
            for (int i = gtid; i < 16 * 256 * 32; i += GT) { const int h = i >> 13, row = (i >> 5) & 255, K0 = (i & 31) * 8, j = K0 >> 6, i0 = K0 & 63, ch = row >> 2, bj = (row >> 1) & 1, dir = row & 1;
                const float* W = (bj == 0 ? wa : wx) + ((size_t)(dir * 16 + h) * 64) * 64 + ch; float v[8];
#pragma unroll
                for (int k = 0; k < 8; ++k) v[k] = convw[j * 1024 + 64 * h + i0 + k] * W[(size_t)(i0 + k) * 64];
                u32x4 w; w.x = cvt_pk_bf16(v[0], v[1]); w.y = cvt_pk_bf16(v[2], v[3]); w.z = cvt_pk_bf16(v[4], v[5]); w.w = cvt_pk_bf16(v[6], v[7]);
                *(u32x4*)(rgw + ((size_t)h * 256 + row) * 256 + K0) = w; }
            float* rgb = (float*)(ws + WS_RGBIAS);
            for (int i = gtid; i < 16 * 256; i += GT) { const int h = i >> 8, row = i & 255, ch = row >> 2, bj = (row >> 1) & 1, dir = row & 1;
                const float* W = (bj == 0 ? wa : wx) + ((size_t)(dir * 16 + h) * 64) * 64 + ch; float s = (bj == 0 ? ba : bxx)[(dir * 16 + h) * 64 + ch];
#pragma unroll
                for (int k = 0; k < 64; ++k) s += convb[64 * h + k] * W[(size_t)k * 64];
                rgb[i] = s; }
            float* spt = (float*)(ws + WS_SP);
            for (int i = gtid; i < 2 * 1024; i += GT) spt[i] = -8.0f * log1pf(expf(-lam[i]));
            unsigned* xr = (unsigned*)(ws + WS_XR);
            for (int i = gtid; i < 1024; i += GT) { xr[i] = 0u; xr[(size_t)(SEQ + 2) * 512 + i] = 0u; }
        }
    }
    if (rep + 1 < REPS(0)) { ++nbar; xcd_barrier(xb, (unsigned)G, wave); } }
    SEAM(0);
    for (int rep = 0; rep < REPS(1); ++rep) {
    if (IN(1)) { PH_IDS;
        SchedStd S; S.so.init(SEQ, DIN, G, bx); S.A = (const char*)(ws + WS_HB); S.B = (const char*)(ws + WS_WINT); S.a_tile = (size_t)256 * DM * 2; S.b_tile = (size_t)256 * DM * 2;
        EpiProj E{(bf16_t*)(dout + DO_U), (bf16_t*)(ws + WS_XR), (bf16_t*)(dout + DO_Z), KIN[5]};
        GEMM_PHASE(lds, wave, GParm{DM, DM * 2, 128, 64, 0}, S, E);
        if (G == 256 && bx >= 128) { __syncthreads(); const int t2 = wave * 64 + fresh_lane(); s5_precompute(KIN, ws, (bx - 128) >> 1, (bx - 128) & 1, 2, (LAS float*)lds, t2); }
    }
    if (rep + 1 < REPS(1)) { ++nbar; xcd_barrier(xb, (unsigned)G, wave); } }
    SEAM(1);
    for (int rep = 0; rep < REPS(2); ++rep) {
    if (IN(2)) { PH_IDS;
        { SchedS5a S{(const char*)(dout + DO_U), (const char*)(ws + WS_WG), G, bx}; EpiS5a E{(bf16_t*)(ws + WS_YINTRA), (float*)(ws + WS_S)};
          GEMM_PHASE(lds, wave, GParm{512, 1024, 128, 64, 0}, S, E); }
        { SchedRG S{(const char*)(ws + WS_XR), (const char*)(ws + WS_RGW), G, bx}; EpiG E{(bf16_t*)(ws + WS_G0), (bf16_t*)(ws + WS_G1), (const float*)(ws + WS_RGBIAS)};
          GEMM_PHASE(lds, wave, GParm{256, 2048, 2048, 64, 0}, S, E); }
    }
    if (rep + 1 < REPS(2)) { ++nbar; xcd_barrier(xb, (unsigned)G, wave); } }
    SEAM(2);
    for (int rep = 0; rep < REPS(3); ++rep) {
    if (IN(3)) { PH_IDS;
        if (bx < 128) {
            const int g = bx >> 1, n = bx & 1; const float* Sg = (const float*)(ws + WS_S) + (size_t)g * NCH * 256 + n * 128; LAS float* Ls = (LAS float*)lds;
            for (int i = tid; i < NCH * 32; i += 512) { const int c = i >> 5, q4 = (i & 31) * 4; *(LAS f32x4*)(Ls + c * 128 + q4) = __builtin_nontemporal_load((const f32x4*)(Sg + (size_t)c * 256 + q4)); }
            __syncthreads();
            if (wave == 0) { const int p = lane, pi = (n * 64 + g) * 64 + p;
                const float lr = fminf(KIN[6][pi], -1e-4f), li = KIN[7][pi], step = expf(KIN[8][n * 64 + g]); float ar, ai; cpow(lr * step, li * step, TC, ar, ai);
                bf16_t* hp = (bf16_t*)(ws + WS_HPREV) + (size_t)g * NCH * 256 + n * 128; float hr = 0.f, him = 0.f;
                for (int cc = 0; cc < NCH; ++cc) { const int c = n == 0 ? cc : NCH - 1 - cc;
                    hp[(size_t)c * 256 + p] = (bf16_t)(cvt_pk_bf16(hr, 0.f) & 0xffffu); hp[(size_t)c * 256 + 64 + p] = (bf16_t)(cvt_pk_bf16(him, 0.f) & 0xffffu);
                    const float sr = Ls[c * 128 + p], si = Ls[c * 128 + 64 + p]; const float nr = ar * hr - ai * him + sr, ni = ar * him + ai * hr + si; hr = nr; him = ni; } }
            __syncthreads();
        }
        { MK_RG; for (int un = bx; un < 256; un += G) rg_pass_a(RG, un & 1, un >> 1, tid); }
    }
    if (rep + 1 < REPS(3)) { ++nbar; xcd_barrier(xb, (unsigned)G, wave); } }
    SEAM(3);
    for (int rep = 0; rep < REPS(4); ++rep) {
    if (IN(4)) { PH_IDS;
#if NAIVE_S5
        if (gw < 64) naive_s5_group((const float* const*)0, (const bf16_t*)(dout + DO_U), (float*)(ws + WS_YINTRA), (bf16_t*)(ws + WS_YS5G), gw, lane);
#else
        { SchedS5b S{(const char*)(ws + WS_HPREV), (const char*)(ws + WS_WC), G, bx}; EpiS5b E{(const bf16_t*)(ws + WS_YINTRA), (bf16_t*)(ws + WS_YS5G)};
          GEMM_PHASE(lds, wave, GParm{256, 512, 128, 64, 0}, S, E); }
#endif
#if NAIVE_RG
        { MK_RG; if (gtid < 1024) naive_rg_channel(RG, gtid); }
#else
        { MK_RG; __syncthreads(); for (int un = bx; un < 256; un += G) { rg_pass_c(RG, un & 1, un >> 1, tid, (LAS float*)lds); __syncthreads(); } }
#endif
    }
    if (rep + 1 < REPS(4)) { ++nbar; xcd_barrier(xb, (unsigned)G, wave); } }
    SEAM(4);
    for (int rep = 0; rep < REPS(5); ++rep) {
    if (IN(5)) { PH_IDS;
        SchedStd S; S.so.init(SEQ, DS5, G, bx); S.A = (const char*)(ws + WS_YS5G); S.B = (const char*)(ws + WS_GLUT); S.a_tile = (size_t)256 * 16 * 2; S.b_tile = (size_t)256 * DS5 * 2;
        EpiGlu E{(const bf16_t*)(ws + WS_YS5G), (bf16_t*)(dout + DO_YPRE), KIN[15]};
        GEMM_PHASE(lds, wave, GParm{DS5, 32, 4u * GM_STRIDE * 2u, 16, GM_STRIDE}, S, E);
        if (G == 256 && bx >= 128) {
            LAS float* scr = (LAS float*)(lds + wave * 16640); constexpr int I_FF1 = (DM / 64) * (DFF / 64);
            for (int it = (bx - 128) * 8 + wave; it < FF1_IN_P5; it += 1024) transpose_item(KIN[29], DM, DFF, (bf16_t*)(ws + WS_FF1T), scr, it, lane); }
    }
    if (rep + 1 < REPS(5)) { ++nbar; xcd_barrier(xb, (unsigned)G, wave); } }
    SEAM(5);
    for (int rep = 0; rep < REPS(6); ++rep) {
    if (IN(6)) { PH_IDS;
        const float *g5 = KIN[23], *gr = KIN[24];
        for (int row = gw; row < SEQ; row += NGW) { const u32x4* yr = (const u32x4*)(dout + DO_YPRE) + (size_t)row * 256; u32x4* oc = (u32x4*)(ws + WS_YCAT) + (size_t)row * 256;
            u32x4 w[4]; float s0 = 0.f, s1 = 0.f;
#pragma unroll
            for (int j = 0; j < 4; ++j) { w[j] = __builtin_nontemporal_load(yr + lane + 64 * j); const float q = bf_lo(w[j].x) * bf_lo(w[j].x) + bf_hi(w[j].x) * bf_hi(w[j].x) + bf_lo(w[j].y) * bf_lo(w[j].y) + bf_hi(w[j].y) * bf_hi(w[j].y)
                + bf_lo(w[j].z) * bf_lo(w[j].z) + bf_hi(w[j].z) * bf_hi(w[j].z) + bf_lo(w[j].w) * bf_lo(w[j].w) + bf_hi(w[j].w) * bf_hi(w[j].w); if (j < 2) s0 += q; else s1 += q; }
            const float r0 = 1.0f / sqrtf(wave_sum(s0) * (1.f / 1024.f) + LN_EPS), r1 = 1.0f / sqrtf(wave_sum(s1) * (1.f / 1024.f) + LN_EPS);
#pragma unroll
            for (int j = 0; j < 4; ++j) { const int col = (lane + 64 * j) * 8; const float rs = j < 2 ? r0 : r1; const float* gp = j < 2 ? g5 + col : gr + (col - 1024);
                const f32x4 ga = *(const f32x4*)gp, gb = *(const f32x4*)(gp + 4);
                u32x4 o; o.x = cvt_pk_bf16(bf_lo(w[j].x) * rs * ga[0], bf_hi(w[j].x) * rs * ga[1]); o.y = cvt_pk_bf16(bf_lo(w[j].y) * rs * ga[2], bf_hi(w[j].y) * rs * ga[3]);
                o.z = cvt_pk_bf16(bf_lo(w[j].z) * rs * gb[0], bf_hi(w[j].z) * rs * gb[1]); o.w = cvt_pk_bf16(bf_lo(w[j].w) * rs * gb[2], bf_hi(w[j].w) * rs * gb[3]); oc[lane + 64 * j] = o; } }
        {
            LAS float* scr = (LAS float*)(lds + wave * 16640);
            constexpr int I_FF1 = (DM / 64) * (DFF / 64), I_FF2 = (DFF / 64) * (DM / 64);
            const int ff1_lo = (G == 256) ? FF1_IN_P5 : 0;
            for (int it = gw; it < I_FF2 + (I_FF1 - ff1_lo); it += NGW) {
                if (it < I_FF2) transpose_item(KIN[31], DFF, DM, (bf16_t*)(ws + WS_FF2T), scr, it, lane);
                else transpose_item(KIN[29], DM, DFF, (bf16_t*)(ws + WS_FF1T), scr, ff1_lo + it - I_FF2, lane); }
        }
    }
    if (rep + 1 < REPS(6)) { ++nbar; xcd_barrier(xb, (unsigned)G, wave); } }
    SEAM(6);
    for (int rep = 0; rep < REPS(7); ++rep) {
    if (IN(7)) { PH_IDS;
        SchedStd S; S.so.init(SEQ, DM, G, bx); S.A = (const char*)(ws + WS_YCAT); S.B = (const char*)(ws + WS_WOUTT); S.a_tile = (size_t)256 * DM * 2; S.b_tile = (size_t)256 * DM * 2;
        EpiResLn1 E{(bf16_t*)(ws + WS_HB), KIN[26], KIN[27], KIN[28], PanelStats8{(unsigned long long*)(ws + WS_AGG), (unsigned*)(ws + WS_CTR) + 1024, LN_EPS}};
        GEMM_PHASE(lds, wave, GParm{DM, DM * 2, 128, 64, 0}, S, E);
    }
    if (rep + 1 < REPS(7)) { ++nbar; xcd_barrier(xb, (unsigned)G, wave); } }
    for (int rep = 0; rep < REPS(8); ++rep) {
    if (IN(8)) { }
    if (rep + 1 < REPS(8)) { ++nbar; xcd_barrier(xb, (unsigned)G, wave); } }
    SEAM(8);
    for (int rep = 0; rep < REPS(9); ++rep) {
    if (IN(9)) { PH_IDS;
        static_assert(WS_PLEGT == WS_FF1T + (size_t)DFF * DM * 2, "gate weights must follow the FF1 weights");
        { SchedStd S; S.so.init(SEQ, DFF + DM, G, bx); S.A = (const char*)(ws + WS_HB); S.B = (const char*)(ws + WS_FF1T); S.a_tile = (size_t)256 * DM * 2; S.b_tile = (size_t)256 * DM * 2;
          EpiFF1G E{(bf16_t*)(ws + WS_T), (bf16_t*)dout, KIN[30], KIN[35]}; GEMM_PHASE(lds, wave, GParm{DM, DM * 2, 128, 64, 0}, S, E); }
        { SchedStd S; S.so.init(SEQ, DM, G, bx); S.A = (const char*)(ws + WS_PB); S.B = (const char*)(ws + WS_PLEWT); S.a_tile = (size_t)256 * PLE * 2; S.b_tile = (size_t)256 * PLE * 2;
          EpiPlain<0> E{(bf16_t*)dout + ((size_t)1 << 19), DM, nullptr, (size_t)1 << 20}; GEMM_PHASE(lds, wave, GParm{PLE, PLE * 2, 128, 64, 0}, S, E); }
    }
    if (rep + 1 < REPS(9)) { ++nbar; xcd_barrier(xb, (unsigned)G, wave); } }
    SEAM(9);
    for (int rep = 0; rep < REPS(10); ++rep) {
    if (IN(10)) { PH_IDS;
        SchedStd S; S.so.init(SEQ, DM, G, bx); S.A = (const char*)(ws + WS_T); S.B = (const char*)(ws + WS_FF2T); S.a_tile = (size_t)256 * DFF * 2; S.b_tile = (size_t)256 * DFF * 2;
        EpiResLn2 E{(const bf16_t*)(ws + WS_HB), KIN[32], KIN[36], KIN[37], (float*)dout, (const bf16_t*)dout, PanelStats8{(unsigned long long*)(ws + WS_AGG) + 65536, (unsigned*)(ws + WS_CTR) + 1024 + 64 * 32, LN_EPS}};
        GEMM_PHASE(lds, wave, GParm{DFF, DFF * 2, 128, 64, 0}, S, E);
    }
    if (rep + 1 < REPS(10)) { ++nbar; xcd_barrier(xb, (unsigned)G, wave); } }
    for (int rep = 0; rep < REPS(11); ++rep) {
    if (IN(11)) { }
    if (rep + 1 < REPS(11)) { ++nbar; xcd_barrier(xb, (unsigned)G, wave); } }
#ifdef EXTRA_BARRIERS
    for (int eb = 0; eb < EXTRA_BARRIERS; ++eb) { ++nbar; xcd_barrier(xb, (unsigned)G, wave); }
#endif
#if TSTAMP
    if (bx == 0 && wave == 0) { if (fresh_lane() == 0) { unsigned long long* st = (unsigned long long*)(ws + WS_CTR + 1024); st[12] = __builtin_amdgcn_s_memrealtime();
        ((float*)KIN[38])[0] = 8.0f * floorf((float)(long long)(__hip_atomic_load(st + TS_A1, __ATOMIC_RELAXED, __HIP_MEMORY_SCOPE_AGENT) - __hip_atomic_load(st + TS_A0, __ATOMIC_RELAXED, __HIP_MEMORY_SCOPE_AGENT)) * 0.00125f + 0.5f); } }
#endif
#if DIAG
    { ++nbar; xcd_barrier(xb, (unsigned)G, wave); PH_IDS; unsigned* flagw = (unsigned*)(ws + WS_CTR) + 48;
#if DIAG == 1
      diag_ffn((const float* const*)0, ws, ((float*)KIN[38]), flagw, gtid, GT);
#elif DIAG == 2
      diag_pre((const float* const*)0, ws, dout, flagw, gtid, GT);
#elif DIAG == 3
      diag_v((const float* const*)0, ws, dout, flagw, gtid, GT);
#elif DIAG == 4
      diag_g((const float* const*)0, ws, flagw, gtid, GT);
#elif DIAG == 6
      diag_max(ws, flagw, gtid, GT);
#else
      if (bx == 0 && tid == 0) flagw[1] = 0xffffffffu;
      ++nbar; xcd_barrier(xb, (unsigned)G, wave);
#if DIAG == 7
      diag_rows(((float*)KIN[38]), flagw, gw, NGW, lane);
#elif DIAG == 8
      diag_rows_bf((const bf16_t*)(ws + WS_HB), DM, 12.0f, flagw, gw, NGW, lane);
#elif DIAG == 9
      diag_rows((const float*)(ws + WS_V2), flagw, gw, NGW, lane);
#elif DIAG == 10
      diag_rows_bf((const bf16_t*)(ws + WS_T), DFF, 150.0f, flagw, gw, NGW, lane);
#elif DIAG == 11
      diag_rows_bf((const bf16_t*)(dout + DO_PW), DM, 8.0f, flagw, gw, NGW, lane);
#elif DIAG == 12
      diag_rows_bf((const bf16_t*)(dout + DO_SG), DM, 1.01f, flagw, gw, NGW, lane);
#endif
#endif
      ++nbar; xcd_barrier(xb, (unsigned)G, wave);
#if DIAG != 1
      for (int i = gtid; i < SEQ * DM; i += GT) ((float*)KIN[38])[i] = 0.f;
      ++nbar; xcd_barrier(xb, (unsigned)G, wave);
#endif
      if (bx == 0 && tid == 0) { unsigned code = 0; for (int q = 0; q < 4; ++q) if (__hip_atomic_load(flagw + q, __ATOMIC_RELAXED, __HIP_MEMORY_SCOPE_AGENT) > 100u) code |= 1u << q; if (DIAG >= 7) { const unsigned cnt = __hip_atomic_load(flagw, __ATOMIC_RELAXED, __HIP_MEMORY_SCOPE_AGENT), mn = __hip_atomic_load(flagw + 1, __ATOMIC_RELAXED, __HIP_MEMORY_SCOPE_AGENT), mxr = __hip_atomic_load(flagw + 2, __ATOMIC_RELAXED, __HIP_MEMORY_SCOPE_AGENT);
          const unsigned v = DIAG_SEL == 0 ? cnt : DIAG_SEL == 1 ? mn / 100u : DIAG_SEL == 2 ? mn % 100u : DIAG_SEL == 3 ? mxr / 100u : mxr % 100u; ((float*)KIN[38])[0] = 100.0f * (float)(v + 1u); }
      else ((float*)KIN[38])[0] = (DIAG == 6) ? 1000.0f * __uint_as_float(__hip_atomic_load(flagw, __ATOMIC_RELAXED, __HIP_MEMORY_SCOPE_AGENT)) : 1000.0f * (float)(code + 16u); } }
#endif
#undef IN
#undef SEAM
}


#if PER_PHASE_LAUNCH
template <int PH> static void set_attr_one() { (void)hipFuncSetAttribute((const void*)mega<(1 << PH)>, hipFuncAttributeMaxDynamicSharedMemorySize, LDS_BYTES); }
template <int PH> static void launch_one(Args a, int grid, hipStream_t stream) { a.ph_lo = PH; a.ph_hi = PH + 1; hipLaunchKernelGGL(mega<(1 << PH)>, dim3(grid), dim3(512), LDS_BYTES, stream, a); }
static void set_attrs() { set_attr_one<0>(); set_attr_one<1>(); set_attr_one<2>(); set_attr_one<3>(); set_attr_one<4>(); set_attr_one<5>(); set_attr_one<6>(); set_attr_one<7>(); set_attr_one<8>(); set_attr_one<9>(); set_attr_one<10>(); set_attr_one<11>(); }
static void launch_phases(const Args& a, int grid, hipStream_t stream) { launch_one<0>(a, grid, stream); launch_one<1>(a, grid, stream); launch_one<2>(a, grid, stream); launch_one<3>(a, grid, stream); launch_one<4>(a, grid, stream); launch_one<5>(a, grid, stream);
    launch_one<6>(a, grid, stream); launch_one<7>(a, grid, stream); launch_one<8>(a, grid, stream); launch_one<9>(a, grid, stream); launch_one<10>(a, grid, stream); launch_one<11>(a, grid, stream); }
#else
static void set_attrs() { (void)hipFuncSetAttribute((const void*)mega<0xfff>, hipFuncAttributeMaxDynamicSharedMemorySize, LDS_BYTES); }
#endif

extern "C" void kernel_launch(void* const* d_in, const int* in_sizes, int n_in, void* d_out, int out_size, void* d_ws, size_t ws_size, hipStream_t stream) {
    static int grid = 0;
    if (grid == 0) {
        if (n_in != 38 || out_size != SEQ * DM || ws_size < WS_END) { fprintf(stderr, "kernel_launch: unexpected shapes (n_in %d out %d ws %zu)\n", n_in, out_size, ws_size); grid = -1; return; }
        int dev = 0, cus = 0, per_cu = 0;
        hipGetDevice(&dev); hipDeviceGetAttribute(&cus, hipDeviceAttributeMultiprocessorCount, dev);
        set_attrs();
        per_cu = 1;
        (void)hipGetLastError();
        if (per_cu < 1) per_cu = 1;
        grid = cus;
    }
    if (grid < 0) return;
#ifdef POISON_NAN
    hipMemsetAsync(d_ws, 0xFF, WS_END, stream); hipMemsetAsync(d_out, 0xFF, (size_t)64 * MiB, stream);
#endif
    hipMemsetAsync((char*)d_ws + WS_CTR, 0, 40960, stream);
    Args a{};
    for (int i = 0; i < 38; ++i) a.in[i] = (const float*)d_in[i];
    a.out = (float*)d_out; a.ws = (unsigned char*)d_ws;
#if PER_PHASE_LAUNCH
    launch_phases(a, grid, stream);
#else
    a.ph_lo = 0; a.ph_hi = NPHASE;
    void* kargs[] = {&a};
    hipError_t e = hipLaunchCooperativeKernel((const void*)mega<0xfff>, dim3(grid), dim3(512), kargs, LDS_BYTES, stream);
    if (e != hipSuccess) fprintf(stderr, "cooperative launch failed: %s (grid %d)\n", hipGetErrorString(e), grid);
#endif
}
```

```cpp
#include <hip/hip_runtime.h>
#include <hip/hip_cooperative_groups.h>
#include <cstdio>
#include <cstdint>
namespace cg = cooperative_groups;

#ifndef PER_PHASE_LAUNCH
#define PER_PHASE_LAUNCH 0
#endif

#ifndef TSTAMP
#define TSTAMP 0
#define TS_A0 4
#define TS_A1 5
#define TS_B0 9
#define TS_B1 12
#endif
#define LAS __attribute__((address_space(3)))
typedef unsigned short bf16_t;
typedef short bf16x8 __attribute__((ext_vector_type(8)));
typedef float f32x4 __attribute__((ext_vector_type(4)));
typedef float f32x2 __attribute__((ext_vector_type(2)));
typedef unsigned u32x4 __attribute__((ext_vector_type(4)));
typedef unsigned u32x2 __attribute__((ext_vector_type(2)));

constexpr int SEQ = 8192, DM = 2048, DIN = 3072, DS5 = 1024, DRG = 1024, NG = 64, NP = 64, NK = 16, NH = 16, HD = 64, DFF = 8192, PLE = 256;
constexpr int TC = 32, NCH = SEQ / TC;
constexpr float LN_EPS = 1e-5f, DN_ALPHA = 1.18920711500272f;
constexpr int NPHASE = 12;

constexpr size_t MiB = (size_t)1 << 20;
constexpr size_t WS_FF2T = 0, WS_HB = 32 * MiB, WS_FF1T = 64 * MiB, WS_PLEGT = 96 * MiB, WS_PLEWT = 104 * MiB, WS_PB = 105 * MiB, WS_WOUTT = 109 * MiB,
    WS_V2 = 64 * MiB, WS_G0 = 0, WS_G1 = 64 * MiB,
    WS_WG = 128 * MiB, WS_WC = 176 * MiB, WS_RGW = 192 * MiB, WS_GLUT = 194 * MiB, WS_XR = 196 * MiB, WS_YINTRA = 213 * MiB, WS_S = 229 * MiB, WS_HPREV = 245 * MiB, WS_WINT = 229 * MiB,
    WS_YS5G = 128 * MiB, WS_YCAT = 144 * MiB, WS_T = 128 * MiB,
    WS_AGG = 256 * MiB, WS_CARRY = 258 * MiB, WS_SUMSQ = 259 * MiB, WS_RGBIAS = 259 * MiB + 64 * 1024, WS_SP = WS_RGBIAS + 16 * 1024, WS_CTR = WS_SP + 8 * 1024, WS_END = 260 * MiB;
constexpr size_t DO_YPRE = 0, DO_Z = 32 * MiB, DO_U = 48 * MiB, DO_SG = 0, DO_PW = 32 * MiB;
constexpr int FF1_IN_P5 = 4096;
constexpr int GM_STRIDE = SEQ * 16;
constexpr int LDS_BYTES = 152 * 1024;

typedef __bf16 bf16x2_t __attribute__((ext_vector_type(2)));
__device__ __forceinline__ unsigned cvt_pk_bf16(float lo, float hi) { const f32x2 v = {lo, hi}; const bf16x2_t b = __builtin_convertvector(v, bf16x2_t); return __builtin_bit_cast(unsigned, b); }
__device__ __forceinline__ float bf_lo(unsigned w) { return __uint_as_float(w << 16); }
__device__ __forceinline__ float bf_hi(unsigned w) { return __uint_as_float(w & 0xffff0000u); }
__device__ __forceinline__ f32x4 bf4(u32x2 w) { return (f32x4){bf_lo(w.x), bf_hi(w.x), bf_lo(w.y), bf_hi(w.y)}; }
__device__ __forceinline__ float fast_sigmoid(float x) { return __builtin_amdgcn_rcpf(1.0f + __expf(-x)); }
__device__ __forceinline__ float gelu_tanh(float x) { const float u = 1.5957691216057308f * (x + 0.044715f * x * x * x); return x * fast_sigmoid(u); }
__device__ __forceinline__ float wave_sum(float v) {
#pragma unroll
    for (int o = 1; o < 64; o <<= 1) v += __shfl_xor(v, o);
    return v;
}
__device__ __forceinline__ int lane_id() { return (int)__builtin_amdgcn_mbcnt_hi(~0u, __builtin_amdgcn_mbcnt_lo(~0u, 0u)); }
__device__ __forceinline__ int fresh_lane() { unsigned z = 0; asm volatile("" : "+s"(z)); return (int)__builtin_amdgcn_mbcnt_hi(~0u, __builtin_amdgcn_mbcnt_lo(~0u, z)); }
#define LDS_WAIT() asm volatile("s_waitcnt lgkmcnt(0)" ::: "memory")

namespace pg8 {
constexpr int BM = 256, BK = 64, HALF = 128, HTB = HALF * BK * 2, STAGE_BYTES = 8 * HTB, NXCD = 8, WGM = 8;
__host__ __device__ __forceinline__ int lds_byte(int r, int c) { const int st = (r >> 4) * 2 + (c >> 5), rr = r & 15, cc = c & 31, ob = rr * 64 + cc * 2; return st * 1024 + (ob ^ (((ob >> 9) & 1) << 5)); }
__host__ __device__ __forceinline__ void stage_rc(int b, int& R, int& C) { const int st = b / 1024, sb = b % 1024, swz = sb ^ (((sb >> 9) & 1) << 5); R = (st >> 1) * 16 + swz / 64; C = (st & 1) * 32 + (swz % 64) / 2; }
__host__ __device__ __forceinline__ int perm32(int rho) { const int n = rho >> 4, i = rho & 15; return 8 * (i >> 2) + 4 * n + (i & 3); }

struct Unit { int pm, pn; };
struct StaticOrder {
    int nM, nN, nwg, G, c;
    __host__ __device__ void init(int M, int N, int G_, int c_) { nM = M / BM; nN = N / BM; nwg = nM * nN; G = G_; c = c_; }
    __host__ __device__ bool next(int i, Unit& u) const {
        const long L = (long)i * G + c; if (L >= nwg) return false;
        int wgid = (int)L; { const int q = nwg / NXCD, r = nwg % NXCD, xcd = wgid % NXCD, off = wgid / NXCD; wgid = (xcd < r ? xcd * (q + 1) : r * (q + 1) + (xcd - r) * q) + off; }
        const int nig = WGM * nN, gid = wgid / nig, fm = gid * WGM, gsz = (nM - fm) < WGM ? (nM - fm) : WGM;
        u.pm = fm + ((wgid % nig) % gsz); u.pn = (wgid % nig) / gsz; return true;
    }
};
struct GUnit { const char* A; const char* B; int i0, i1; };
struct GParm { int K; unsigned a_rs, a_ks; int a_cw, a_cs; };

template <class Epi, class Sched>
__device__ __forceinline__ void gemm_phase(LAS unsigned char* lds, const int wid, const GParm gp, const Sched& S, const Epi& E) {
    const int lane = fresh_lane(), tid = wid * 64 + lane, wr = wid >> 2, wc = wid & 3, fr = lane & 15, fq = lane >> 4;
    const int K = gp.K, nt = K / BK;
    unsigned voffA[2], voffB[2];
#pragma unroll
    for (int i = 0; i < 2; ++i) { int R, C; stage_rc(tid * 16 + i * 8192, R, C); const int Rb = Epi::PERM ? ((R & ~31) + perm32(R & 31)) : R;
        voffA[i] = (unsigned)R * gp.a_rs + (unsigned)((C / gp.a_cw) * gp.a_cs + (C % gp.a_cw)) * 2u; voffB[i] = (unsigned)(Rb * K + C) * 2u; }
    const size_t ksA = gp.a_ks, ksB = (size_t)(BK * 2);
    const size_t hsA = (size_t)HALF * gp.a_rs, hsB = (size_t)HALF * K * 2;
    const unsigned ldsw = (unsigned)wid * 1024u;
    const int aoff = lds_byte(wr * 64 + fr, fq * 8), boff = lds_byte(wc * 32 + fr, fq * 8);
#define PG8_SA(b, h) (((b) * 2 + (h)) * HTB)
#define PG8_SB(b, h) ((4 + (b) * 2 + (h)) * HTB)
#define PG8_STAGE(bufoff, gbase, voff) do { _Pragma("unroll") for (int _i = 0; _i < 2; ++_i) \
        __builtin_amdgcn_global_load_lds((const unsigned*)((const char*)(gbase) + (voff)[_i]), (LAS unsigned*)(lds + (bufoff) + ldsw + _i * 8192), 16, 0, 0); } while (0)
#define PG8_LDA(dst, b, h) do { _Pragma("unroll") for (int m = 0; m < 4; ++m) _Pragma("unroll") for (int k = 0; k < 2; ++k) dst[m][k] = *(const LAS bf16x8*)(lds + PG8_SA(b, h) + aoff + m * 2048 + k * 1024); } while (0)
#define PG8_LDB(dst, b, h) do { _Pragma("unroll") for (int n = 0; n < 2; ++n) _Pragma("unroll") for (int k = 0; k < 2; ++k) dst[n][k] = *(const LAS bf16x8*)(lds + PG8_SB(b, h) + boff + n * 2048 + k * 1024); } while (0)
#define PG8_MMA(ai, bj, At, Bt) do { __builtin_amdgcn_s_setprio(1); _Pragma("unroll") for (int m = 0; m < 4; ++m) _Pragma("unroll") for (int n = 0; n < 2; ++n) _Pragma("unroll") for (int k = 0; k < 2; ++k) \
        acc[ai][bj][m][n] = __builtin_amdgcn_mfma_f32_16x16x32_bf16(Bt[n][k], At[m][k], acc[ai][bj][m][n], 0, 0, 0); __builtin_amdgcn_s_setprio(0); } while (0)
#define PG8_WAIT_V(n) asm volatile("s_waitcnt vmcnt(" #n ")" ::: "memory")
#define PG8_WAIT_L(n) asm volatile("s_waitcnt lgkmcnt(" #n ")" ::: "memory")
#define PG8_BAR __builtin_amdgcn_s_barrier()
#define PG8_SCHED __builtin_amdgcn_sched_barrier(0)
    GUnit cur, nxt; int ui = 0;
    if (!S.next(0, cur)) return;
    f32x4 acc[2][2][4][2];
#pragma unroll
    for (int a = 0; a < 2; ++a)
#pragma unroll
        for (int b = 0; b < 2; ++b)
#pragma unroll
            for (int m = 0; m < 4; ++m)
#pragma unroll
                for (int n = 0; n < 2; ++n) acc[a][b][m][n] = (f32x4){0.f, 0.f, 0.f, 0.f};
    bf16x8 At[4][2], B0[2][2], B1[2][2];
    const char* cA = cur.A; const char* cB = cur.B;
    PG8_STAGE(PG8_SB(0, 0), cB, voffB); PG8_STAGE(PG8_SB(0, 1), cB + hsB, voffB); PG8_STAGE(PG8_SA(0, 0), cA, voffA); PG8_STAGE(PG8_SA(0, 1), cA + hsA, voffA);
    if (wr == 1) PG8_BAR;
    PG8_WAIT_V(2); PG8_BAR;
    PG8_STAGE(PG8_SB(1, 0), cB + ksB, voffB); PG8_STAGE(PG8_SA(1, 0), cA + ksA, voffA); PG8_STAGE(PG8_SB(1, 1), cB + hsB + ksB, voffB);
    PG8_WAIT_V(6); PG8_BAR;
    for (;;) {
        const bool has_next = S.next(ui + 1, nxt);
        const char* nA = has_next ? nxt.A : cA; const char* nB = has_next ? nxt.B : cB;
        for (int t = 0; t < nt; t += 2) {
            const bool last = (t == nt - 2);
            const char* a1 = cA + (size_t)(t + 1) * ksA;
            const char* a2 = last ? nA : cA + (size_t)(t + 2) * ksA; const char* b2 = last ? nB : cB + (size_t)(t + 2) * ksB;
            const char* a3 = a2 + ksA; const char* b3 = b2 + ksB;
            PG8_LDB(B0, 0, 0); PG8_LDB(B1, 0, 1); PG8_SCHED; PG8_LDA(At, 0, 0); PG8_STAGE(PG8_SA(1, 1), a1 + hsA, voffA);
            PG8_WAIT_V(8); PG8_WAIT_L(0); PG8_BAR; PG8_MMA(0, 0, At, B0); PG8_MMA(0, 1, At, B1); PG8_BAR; PG8_SCHED;
            PG8_LDA(At, 0, 1); PG8_STAGE(PG8_SB(0, 0), b2, voffB); PG8_STAGE(PG8_SB(0, 1), b2 + hsB, voffB); PG8_STAGE(PG8_SA(0, 0), a2, voffA);
            PG8_WAIT_V(8); PG8_WAIT_L(0); PG8_BAR; PG8_MMA(1, 0, At, B0); PG8_MMA(1, 1, At, B1); PG8_BAR; PG8_SCHED;
            PG8_LDB(B0, 1, 0); PG8_LDB(B1, 1, 1); PG8_SCHED; PG8_LDA(At, 1, 0); PG8_STAGE(PG8_SA(0, 1), a2 + hsA, voffA);
            PG8_WAIT_V(8); PG8_WAIT_L(0); PG8_BAR; PG8_MMA(0, 0, At, B0); PG8_MMA(0, 1, At, B1); PG8_BAR; PG8_SCHED;
            PG8_LDA(At, 1, 1); PG8_STAGE(PG8_SB(1, 0), b3, voffB); PG8_STAGE(PG8_SB(1, 1), b3 + hsB, voffB); PG8_STAGE(PG8_SA(1, 0), a3, voffA);
            PG8_WAIT_V(8); PG8_WAIT_L(0); PG8_BAR; PG8_MMA(1, 0, At, B0); PG8_MMA(1, 1, At, B1); PG8_BAR; PG8_SCHED;
        }
        if (wr == 0) PG8_BAR;
        if constexpr (!Epi::AFTER_DRAIN) { const int l_o = fresh_lane(); E(acc, cur, wr, wc, l_o & 15, l_o >> 4); }
        if (!has_next) break;
#pragma unroll
        for (int a = 0; a < 2; ++a)
#pragma unroll
            for (int b = 0; b < 2; ++b)
#pragma unroll
                for (int m = 0; m < 4; ++m)
#pragma unroll
                    for (int n = 0; n < 2; ++n) acc[a][b][m][n] = (f32x4){0.f, 0.f, 0.f, 0.f};
        cur = nxt; cA = nA; cB = nB; ++ui;
        if (wr == 1) PG8_BAR;
    }
    PG8_WAIT_V(0);
    PG8_BAR;
    if constexpr (Epi::AFTER_DRAIN) { const int l_o = fresh_lane(); E.fused(acc, cur, wr, wc, l_o & 15, l_o >> 4, lds, wid); }
#undef PG8_SA
#undef PG8_SB
#undef PG8_STAGE
#undef PG8_LDA
#undef PG8_LDB
#undef PG8_MMA
#undef PG8_WAIT_V
#undef PG8_WAIT_L
#undef PG8_BAR
#undef PG8_SCHED
}
}
using pg8::GUnit; using pg8::GParm;
typedef f32x4 AccT[2][2][4][2];

struct SchedStd {
    pg8::StaticOrder so; const char* A; const char* B; size_t a_tile, b_tile;
    __device__ __forceinline__ bool next(int i, GUnit& u) const { pg8::Unit t; if (!so.next(i, t)) return false; u.A = A + (size_t)t.pm * a_tile; u.B = B + (size_t)t.pn * b_tile; u.i0 = t.pm; u.i1 = t.pn; return true; }
};
struct SchedS5a { const char* U; const char* WG; int G, c;
    __device__ __forceinline__ bool next(int i, GUnit& u) const { const int L = i * G + c; if (L >= 192) return false; const int g = L / 3, pn = L % 3;
        u.A = U + (size_t)g * GM_STRIDE * 2; u.B = WG + ((size_t)g * 768 + 256 * pn) * 512 * 2; u.i0 = g; u.i1 = pn; return true; } };
struct SchedS5b { const char* HP; const char* WC; int G, c;
    __device__ __forceinline__ bool next(int i, GUnit& u) const { const int L = i * G + c; if (L >= 128) return false; const int g = L / 2, pn = L % 2;
        u.A = HP + (size_t)g * 256 * 256 * 2; u.B = WC + ((size_t)g * 512 + 256 * pn) * 256 * 2; u.i0 = g; u.i1 = pn; return true; } };
struct SchedRG { const char* XR; const char* RGW; int G, c;
    __device__ __forceinline__ bool next(int i, GUnit& u) const { const int L = i * G + c; if (L >= 512) return false; const int h = L % 16, pm = L / 16;
        u.A = XR + ((size_t)(256 * pm) * 1024 + 64 * h) * 2; u.B = RGW + (size_t)h * 256 * 256 * 2; u.i0 = pm; u.i1 = h; return true; } };

template <int ACT> __device__ __forceinline__ void epi_bf16_store(const AccT& acc, bf16_t* tile, int ldc, const float* biast, int wr, int wc, int fr, int fq) {
    const int r0 = wr * 64 + fr, c0 = wc * 32 + 8 * fq;
    f32x4 bv[2][2];
#pragma unroll
    for (int bj = 0; bj < 2; ++bj)
#pragma unroll
        for (int n = 0; n < 2; ++n) bv[bj][n] = biast ? *(const f32x4*)(biast + c0 + bj * 128 + 4 * n) : (f32x4){0.f, 0.f, 0.f, 0.f};
#pragma unroll
    for (int ai = 0; ai < 2; ++ai)
#pragma unroll
        for (int m = 0; m < 4; ++m) { bf16_t* rowp = tile + (size_t)(r0 + ai * 128 + m * 16) * ldc + c0;
#pragma unroll
            for (int bj = 0; bj < 2; ++bj) { f32x4 v0 = acc[ai][bj][m][0] + bv[bj][0], v1 = acc[ai][bj][m][1] + bv[bj][1];
                if (ACT == 1) {
#pragma unroll
                    for (int j = 0; j < 4; ++j) { const float a = fmaxf(v0[j], 0.f), b = fmaxf(v1[j], 0.f); v0[j] = a * a; v1[j] = b * b; } }
                if (ACT == 2) {
#pragma unroll
                    for (int j = 0; j < 4; ++j) { v0[j] = fast_sigmoid(v0[j]); v1[j] = fast_sigmoid(v1[j]); } }
                u32x4 w; w.x = cvt_pk_bf16(v0[0], v0[1]); w.y = cvt_pk_bf16(v0[2], v0[3]); w.z = cvt_pk_bf16(v1[0], v1[1]); w.w = cvt_pk_bf16(v1[2], v1[3]);
                *(u32x4*)(rowp + bj * 128) = w; } }
}
struct EpiProj { static constexpr bool PERM = true, AFTER_DRAIN = false; bf16_t *U, *XR, *Z; const float* bias;
    __device__ __forceinline__ void operator()(AccT& acc, const GUnit& u, int wr, int wc, int fr, int fq) const {
        const int pm = u.i0, pn = u.i1;
        if (pn >= 4) { bf16_t* base = pn < 8 ? XR + 2 * 1024 : Z; epi_bf16_store<0>(acc, base + (size_t)pm * 256 * 1024 + (pn & 3) * 256, 1024, bias + pn * 256, wr, wc, fr, fq); return; }
        const int c0 = pn * 256 + wc * 32 + 8 * fq;
#pragma unroll
        for (int bj = 0; bj < 2; ++bj) { const int col = c0 + bj * 128; const f32x4 b0 = *(const f32x4*)(bias + col), b1 = *(const f32x4*)(bias + col + 4); bf16_t* gp = U + (size_t)(col >> 4) * GM_STRIDE + (col & 15);
#pragma unroll
            for (int ai = 0; ai < 2; ++ai)
#pragma unroll
                for (int m = 0; m < 4; ++m) { const int row = pm * 256 + ai * 128 + wr * 64 + m * 16 + fr; const f32x4 v0 = acc[ai][bj][m][0] + b0, v1 = acc[ai][bj][m][1] + b1;
                    u32x4 w; w.x = cvt_pk_bf16(v0[0], v0[1]); w.y = cvt_pk_bf16(v0[2], v0[3]); w.z = cvt_pk_bf16(v1[0], v1[1]); w.w = cvt_pk_bf16(v1[2], v1[3]);
                    *(u32x4*)(gp + (size_t)row * 16) = w; } }
    } };
template <int ACT> struct EpiPlain { static constexpr bool PERM = true, AFTER_DRAIN = false; bf16_t* O; int ldc; const float* bias; size_t pstride;
    __device__ __forceinline__ void operator()(AccT& acc, const GUnit& u, int wr, int wc, int fr, int fq) const {
        epi_bf16_store<ACT>(acc, O + (size_t)u.i0 * (pstride ? pstride : (size_t)256 * ldc) + u.i1 * 256, ldc, bias ? bias + u.i1 * 256 : nullptr, wr, wc, fr, fq); } };
struct EpiFF1G { static constexpr bool PERM = true, AFTER_DRAIN = false; bf16_t* T; bf16_t* SG; const float *b1, *bg;
    __device__ __forceinline__ void operator()(AccT& acc, const GUnit& u, int wr, int wc, int fr, int fq) const {
        const int pm = u.i0, pn = u.i1;
        if (pn < 32) epi_bf16_store<1>(acc, T + (size_t)pm * 256 * DFF + pn * 256, DFF, b1 + pn * 256, wr, wc, fr, fq);
        else epi_bf16_store<2>(acc, SG + (size_t)pm * ((size_t)1 << 20) + (pn - 32) * 256, DM, bg + (pn - 32) * 256, wr, wc, fr, fq); } };
struct EpiS5a { static constexpr bool PERM = true, AFTER_DRAIN = false; bf16_t* YI; float* S;
    __device__ __forceinline__ void operator()(AccT& acc, const GUnit& u, int wr, int wc, int fr, int fq) const {
        const int g = u.i0, pn = u.i1;
#pragma unroll
        for (int ai = 0; ai < 2; ++ai)
#pragma unroll
            for (int m = 0; m < 4; ++m) { const int r = ai * 128 + wr * 64 + m * 16 + fr;
#pragma unroll
                for (int bj = 0; bj < 2; ++bj) { const int c8 = bj * 128 + wc * 32 + 8 * fq; const f32x4 v0 = acc[ai][bj][m][0], v1 = acc[ai][bj][m][1];
                    if (pn < 2) { const int col = pn * 256 + c8, t = col >> 4, k0 = col & 15;
                        u32x4 w; w.x = cvt_pk_bf16(v0[0], v0[1]); w.y = cvt_pk_bf16(v0[2], v0[3]); w.z = cvt_pk_bf16(v1[0], v1[1]); w.w = cvt_pk_bf16(v1[2], v1[3]);
                        *(u32x4*)(YI + (size_t)g * GM_STRIDE + (size_t)r * 512 + col) = w; (void)t; (void)k0; }
                    else { float* sp = S + ((size_t)g * NCH + r) * 256 + c8; *(f32x4*)sp = v0; *(f32x4*)(sp + 4) = v1; } } }
    } };
struct EpiS5b { static constexpr bool PERM = true, AFTER_DRAIN = false; const bf16_t* YI; bf16_t* YG;
    __device__ __forceinline__ void operator()(AccT& acc, const GUnit& u, int wr, int wc, int fr, int fq) const {
        const int g = u.i0, pn = u.i1;
#pragma unroll
        for (int ai = 0; ai < 2; ++ai)
#pragma unroll
            for (int m = 0; m < 4; ++m) { const int r = ai * 128 + wr * 64 + m * 16 + fr;
#pragma unroll
                for (int bj = 0; bj < 2; ++bj) { const int col = pn * 256 + bj * 128 + wc * 32 + 8 * fq, t = col >> 4, k0 = col & 15;
                    const size_t off = (size_t)g * GM_STRIDE + (size_t)r * 512 + col; (void)t; (void)k0; const u32x4 yi = __builtin_nontemporal_load((const u32x4*)(YI + off));
                    f32x4 v0 = acc[ai][bj][m][0] + (f32x4){bf_lo(yi.x), bf_hi(yi.x), bf_lo(yi.y), bf_hi(yi.y)}, v1 = acc[ai][bj][m][1] + (f32x4){bf_lo(yi.z), bf_hi(yi.z), bf_lo(yi.w), bf_hi(yi.w)};
#pragma unroll
                    for (int j = 0; j < 4; ++j) { v0[j] = gelu_tanh(v0[j]); v1[j] = gelu_tanh(v1[j]); }
                    u32x4 w; w.x = cvt_pk_bf16(v0[0], v0[1]); w.y = cvt_pk_bf16(v0[2], v0[3]); w.z = cvt_pk_bf16(v1[0], v1[1]); w.w = cvt_pk_bf16(v1[2], v1[3]);
                    *(u32x4*)(YG + off) = w; } }
    } };
struct EpiGlu { static constexpr bool PERM = true, AFTER_DRAIN = false; const bf16_t* YG; bf16_t* YPRE; const float* bias;
    __device__ __forceinline__ void operator()(AccT& acc, const GUnit& u, int wr, int wc, int fr, int fq) const {
        const int pm = u.i0, pn = u.i1; const int c0 = pn * 256 + wc * 32 + 8 * fq;
        f32x4 bv[2][2];
#pragma unroll
        for (int bj = 0; bj < 2; ++bj)
#pragma unroll
            for (int n = 0; n < 2; ++n) bv[bj][n] = *(const f32x4*)(bias + c0 + bj * 128 + 4 * n);
#pragma unroll
        for (int ai = 0; ai < 2; ++ai)
#pragma unroll
            for (int m = 0; m < 4; ++m) { const int row = pm * 256 + ai * 128 + wr * 64 + m * 16 + fr;
#pragma unroll
                for (int bj = 0; bj < 2; ++bj) { const int col = c0 + bj * 128; const u32x4 yv = *(const u32x4*)(YG + (size_t)(col >> 4) * GM_STRIDE + (size_t)row * 16 + (col & 15));
                    const f32x4 y0 = (f32x4){bf_lo(yv.x), bf_hi(yv.x), bf_lo(yv.y), bf_hi(yv.y)}, y1 = (f32x4){bf_lo(yv.z), bf_hi(yv.z), bf_lo(yv.w), bf_hi(yv.w)};
                    f32x4 v0 = acc[ai][bj][m][0] + bv[bj][0], v1 = acc[ai][bj][m][1] + bv[bj][1];
#pragma unroll
                    for (int j = 0; j < 4; ++j) { v0[j] = y0[j] * fast_sigmoid(v0[j]); v1[j] = y1[j] * fast_sigmoid(v1[j]); }
                    u32x4 w; w.x = cvt_pk_bf16(v0[0], v0[1]); w.y = cvt_pk_bf16(v0[2], v0[3]); w.z = cvt_pk_bf16(v1[0], v1[1]); w.w = cvt_pk_bf16(v1[2], v1[3]);
                    *(u32x4*)(YPRE + (size_t)row * 2048 + col) = w; }
                }
    } };
template <bool PLEADD> struct EpiRes { static constexpr bool PERM = false, AFTER_DRAIN = false; const bf16_t* HBp; const float* bias; float* V; const bf16_t* SG; const bf16_t* PW;
    __device__ __forceinline__ void operator()(AccT& acc, const GUnit& u, int wr, int wc, int fr, int fq) const {
        const int pm = u.i0, pn = u.i1; const int c0 = pn * 256 + wc * 32 + 4 * fq;
        f32x4 bv[2][2];
#pragma unroll
        for (int bj = 0; bj < 2; ++bj)
#pragma unroll
            for (int n = 0; n < 2; ++n) bv[bj][n] = *(const f32x4*)(bias + c0 + bj * 128 + n * 16);
#pragma unroll
        for (int ai = 0; ai < 2; ++ai)
#pragma unroll
            for (int m = 0; m < 4; ++m) { const int row = pm * 256 + ai * 128 + wr * 64 + m * 16 + fr;
#pragma unroll
                for (int bj = 0; bj < 2; ++bj)
#pragma unroll
                    for (int n = 0; n < 2; ++n) { const size_t off = (size_t)row * 2048 + c0 + bj * 128 + n * 16;
                        f32x4 v = acc[ai][bj][m][n] + bv[bj][n] + DN_ALPHA * bf4(*(const u32x2*)(HBp + off));
                        if (PLEADD) v += bf4(*(const u32x2*)(SG + off)) * bf4(*(const u32x2*)(PW + off));
                        *(f32x4*)(V + off) = v; } }
    } };


struct PanelStats8 { unsigned long long* xbuf; unsigned* cnt; float eps;
    __device__ __forceinline__ void run(const AccT& v, int pm, int pn, int wr, int wc, int fr, int fq, LAS unsigned char* lds, int wid) const {
        LAS f32x2* P = (LAS f32x2*)lds; LAS f32x2* S = (LAS f32x2*)(lds + 8192); const int lane = fq * 16 + fr;
#pragma unroll
        for (int ai = 0; ai < 2; ++ai)
#pragma unroll
            for (int m = 0; m < 4; ++m) { float s = 0.f;
#pragma unroll
                for (int bj = 0; bj < 2; ++bj)
#pragma unroll
                    for (int n = 0; n < 2; ++n) { const f32x4 x = v[ai][bj][m][n]; s += (x[0] + x[1]) + (x[2] + x[3]); }
                s += __shfl_xor(s, 16); s += __shfl_xor(s, 32);
                const float mw = s * (1.0f / 64.0f); float q = 0.f;
#pragma unroll
                for (int bj = 0; bj < 2; ++bj)
#pragma unroll
                    for (int n = 0; n < 2; ++n) { const f32x4 d = v[ai][bj][m][n] - mw; q += (d[0] * d[0] + d[1] * d[1]) + (d[2] * d[2] + d[3] * d[3]); }
                q += __shfl_xor(q, 16); q += __shfl_xor(q, 32);
                if (fq == 0) P[(ai * 128 + wr * 64 + m * 16 + fr) * 4 + wc] = (f32x2){mw, q}; }
        asm volatile("s_waitcnt lgkmcnt(0)" ::: "memory"); __builtin_amdgcn_s_barrier(); asm volatile("" ::: "memory");
        const int row = wid * 32 + (lane & 31);
        if (lane < 32) { const f32x2 a = P[row * 4 + 0], b = P[row * 4 + 1], c = P[row * 4 + 2], d = P[row * 4 + 3];
            const float mt = (a[0] + b[0] + c[0] + d[0]) * 0.25f; const float da = a[0] - mt, db = b[0] - mt, dc = c[0] - mt, dd = d[0] - mt;
            const float m2 = (a[1] + b[1]) + (c[1] + d[1]) + 64.0f * ((da * da + db * db) + (dc * dc + dd * dd));
            __hip_atomic_store(xbuf + ((size_t)(pm * 256 + row) * 8 + pn), ((unsigned long long)__float_as_uint(m2) << 32) | __float_as_uint(mt), __ATOMIC_RELAXED, __HIP_MEMORY_SCOPE_AGENT); }
        asm volatile("s_waitcnt vmcnt(0)" ::: "memory");
        if (lane == 0) __hip_atomic_fetch_add(cnt + 64 * pm, 1u, __ATOMIC_RELAXED, __HIP_MEMORY_SCOPE_AGENT);
        if (wid == 0) { unsigned sp = 0;
            while ((unsigned)__builtin_amdgcn_readfirstlane(__hip_atomic_load(cnt + 64 * pm, __ATOMIC_RELAXED, __HIP_MEMORY_SCOPE_AGENT)) < 64u) { __builtin_amdgcn_s_sleep(2); if (++sp > (1u << 22)) break; }
            __builtin_amdgcn_fence(__ATOMIC_ACQUIRE, "agent"); }
        asm volatile("s_waitcnt vmcnt(0) lgkmcnt(0)" ::: "memory"); __builtin_amdgcn_s_barrier(); asm volatile("" ::: "memory");
        if (lane < 32) { const unsigned long long* slot = xbuf + (size_t)(pm * 256 + row) * 8; float mt[8], m2[8]; float ms = 0.f;
#pragma unroll
            for (int t = 0; t < 8; ++t) { const unsigned long long w = __hip_atomic_load(slot + t, __ATOMIC_RELAXED, __HIP_MEMORY_SCOPE_AGENT); mt[t] = __uint_as_float((unsigned)w); m2[t] = __uint_as_float((unsigned)(w >> 32)); ms += mt[t]; }
            const float mean = ms * 0.125f; float q = 0.f;
#pragma unroll
            for (int t = 0; t < 8; ++t) { const float dm = mt[t] - mean; q += m2[t] + 256.0f * dm * dm; }
            S[row] = (f32x2){mean, 1.0f / sqrtf(q * (1.0f / 2048.0f) + eps)}; }
        asm volatile("s_waitcnt lgkmcnt(0)" ::: "memory"); __builtin_amdgcn_s_barrier(); asm volatile("" ::: "memory");
    } };
struct EpiResLn1 { static constexpr bool PERM = false, AFTER_DRAIN = true; bf16_t* HBp; const float *bias, *lng, *lnb; PanelStats8 st;
    __device__ __forceinline__ void fused(AccT& acc, const GUnit& u, int wr, int wc, int fr, int fq, LAS unsigned char* lds, int wid) const {
        const int pm = u.i0, pn = u.i1; const int c0 = pn * 256 + wc * 32 + 4 * fq; const LAS f32x2* S = (const LAS f32x2*)(lds + 8192);
#pragma unroll
        for (int bj = 0; bj < 2; ++bj)
#pragma unroll
            for (int n = 0; n < 2; ++n) { const f32x4 bv = *(const f32x4*)(bias + c0 + bj * 128 + n * 16);
#pragma unroll
                for (int ai = 0; ai < 2; ++ai)
#pragma unroll
                    for (int m = 0; m < 4; ++m) { const size_t off = (size_t)(pm * 256 + ai * 128 + wr * 64 + m * 16 + fr) * 2048 + c0 + bj * 128 + n * 16;
                        acc[ai][bj][m][n] += bv + DN_ALPHA * bf4(*(const u32x2*)(HBp + off)); } }
        st.run(acc, pm, pn, wr, wc, fr, fq, lds, wid);
#pragma unroll
        for (int bj = 0; bj < 2; ++bj)
#pragma unroll
            for (int n = 0; n < 2; ++n) { const f32x4 gg = *(const f32x4*)(lng + c0 + bj * 128 + n * 16), bb = *(const f32x4*)(lnb + c0 + bj * 128 + n * 16);
#pragma unroll
                for (int ai = 0; ai < 2; ++ai)
#pragma unroll
                    for (int m = 0; m < 4; ++m) { const int r = ai * 128 + wr * 64 + m * 16 + fr; const f32x2 sr = S[r]; const size_t off = (size_t)(pm * 256 + r) * 2048 + c0 + bj * 128 + n * 16;
                        const f32x4 o = (acc[ai][bj][m][n] - sr[0]) * sr[1] * gg + bb; u32x2 w; w.x = cvt_pk_bf16(o[0], o[1]); w.y = cvt_pk_bf16(o[2], o[3]); *(u32x2*)(HBp + off) = w; } }
    } };
struct EpiResLn2 { static constexpr bool PERM = false, AFTER_DRAIN = true; const bf16_t* HBp; const float *bias, *lng, *lnb; float* out; const bf16_t* SGPW; PanelStats8 st;
    __device__ __forceinline__ void fused(AccT& acc, const GUnit& u, int wr, int wc, int fr, int fq, LAS unsigned char* lds, int wid) const {
        const int pm = u.i0, pn = u.i1; const int c0 = pn * 256 + wc * 32 + 4 * fq; const LAS f32x2* S = (const LAS f32x2*)(lds + 8192);
        const bf16_t* sgp = SGPW + (size_t)pm * (1u << 20);
        f32x4 bv[2][2];
#pragma unroll
        for (int bj = 0; bj < 2; ++bj)
#pragma unroll
            for (int n = 0; n < 2; ++n) bv[bj][n] = *(const f32x4*)(bias + c0 + bj * 128 + n * 16);
#pragma unroll
        for (int ai = 0; ai < 2; ++ai)
#pragma unroll
            for (int m = 0; m < 4; ++m) { const int r = ai * 128 + wr * 64 + m * 16 + fr; const size_t lo = (size_t)r * 2048 + c0; const bf16_t* hp = HBp + (size_t)(pm * 256 + r) * 2048 + c0;
#pragma unroll
                for (int bj = 0; bj < 2; ++bj)
#pragma unroll
                    for (int n = 0; n < 2; ++n) { const int co = bj * 128 + n * 16;
                        acc[ai][bj][m][n] += bv[bj][n] + DN_ALPHA * bf4(*(const u32x2*)(hp + co)) + bf4(*(const u32x2*)(sgp + lo + co)) * bf4(*(const u32x2*)(sgp + (1u << 19) + lo + co)); }
                asm volatile("" : "+v"(acc[ai][0][m][0]), "+v"(acc[ai][0][m][1]), "+v"(acc[ai][1][m][0]), "+v"(acc[ai][1][m][1])); }
        st.run(acc, pm, pn, wr, wc, fr, fq, lds, wid);
#pragma unroll
        for (int bj = 0; bj < 2; ++bj)
#pragma unroll
            for (int n = 0; n < 2; ++n) { const f32x4 gg = *(const f32x4*)(lng + c0 + bj * 128 + n * 16), bb = *(const f32x4*)(lnb + c0 + bj * 128 + n * 16);
#pragma unroll
                for (int ai = 0; ai < 2; ++ai)
#pragma unroll
                    for (int m = 0; m < 4; ++m) { const int r = ai * 128 + wr * 64 + m * 16 + fr; const f32x2 sr = S[r];
                        *(f32x4*)(out + (size_t)(pm * 256 + r) * 2048 + c0 + bj * 128 + n * 16) = (acc[ai][bj][m][n] - sr[0]) * sr[1] * gg + bb; } }
    } };
struct EpiG { static constexpr bool PERM = true, AFTER_DRAIN = false; bf16_t *G0, *G1; const float* bias;
    __device__ __forceinline__ void operator()(AccT& acc, const GUnit& u, int wr, int wc, int fr, int fq) const {
        const int pm = u.i0, h = u.i1; bf16_t* base = (pm < 16 ? G0 : G1) + (size_t)(pm & 15) * 256 * 4096 + h * 256;
        epi_bf16_store<0>(acc, base, 4096, bias + h * 256, wr, wc, fr, fq); } };
__device__ __forceinline__ float bfu(unsigned short v) { return __uint_as_float(((unsigned)v) << 16); }
__device__ __forceinline__ void rg_gate(float pa, float px, float spv, float xc, float& a, float& b) {
    const float r = fast_sigmoid(pa), ig = fast_sigmoid(px); const float la = spv * r; a = __expf(la); const float x = 2.0f * la;
    const float om = -x * (1.0f + x * (0.5f + x * (0.16666667f + x * (0.041666668f + x * 0.008333334f))));
    b = __builtin_amdgcn_sqrtf(fmaxf(om, 0.f)) * ig * xc; }
__device__ __forceinline__ void rg_gate2(float pa, float px, float spv, float xc, float& a, float& b, float& r) {
    r = fast_sigmoid(pa); const float ig = fast_sigmoid(px); const float la = spv * r; a = __expf(la); const float x = 2.0f * la;
    const float om = -x * (1.0f + x * (0.5f + x * (0.16666667f + x * (0.041666668f + x * 0.008333334f))));
    b = __builtin_amdgcn_sqrtf(fmaxf(om, 0.f)) * ig * xc; }
struct RgCtx { const bf16_t *XR, *G0, *G1, *Z; const float *convw, *convb, *sp; float* agg; bf16_t* ypre; };
__device__ __forceinline__ const bf16_t* g_row(const RgCtx& R, int t) { return (t < 4096 ? R.G0 : R.G1) + (size_t)(t & 4095) * 4096; }
__device__ __forceinline__ void rg_pass_a(const RgCtx& R, int half, int seg, int tid) {
    const int c = half * 512 + tid, gcol = (c >> 6) * 256 + (c & 63) * 4, t0 = seg * 64;
    const float w0 = R.convw[c], w1 = R.convw[1024 + c], w2 = R.convw[2048 + c], w3 = R.convw[3072 + c], cb = R.convb[c], sp0 = R.sp[c], sp1 = R.sp[1024 + c];
    const bf16_t* xp = R.XR + c;
    float x0 = bfu(xp[(size_t)(t0 + 0) * 1024]), x1 = bfu(xp[(size_t)(t0 + 1) * 1024]), x2 = bfu(xp[(size_t)(t0 + 2) * 1024]);
    float Af = 1.f, Bf = 0.f, Ab = 1.f, Bb = 0.f;
    for (int tb = 0; tb < 64; tb += 16) {
        u32x2 gq[16]; unsigned short xn[16];
#pragma unroll
        for (int i = 0; i < 16; ++i) { const int t = t0 + tb + i; gq[i] = *(const u32x2*)(g_row(R, t) + gcol); xn[i] = xp[(size_t)(t + 3) * 1024]; }
#pragma unroll
        for (int i = 0; i < 16; ++i) { const float x3 = bfu(xn[i]); const float xc = cb + w0 * x0 + w1 * x1 + w2 * x2 + w3 * x3; x0 = x1; x1 = x2; x2 = x3;
            float a, b, r0, r1, b0; rg_gate2(bf_lo(gq[i].x), bf_lo(gq[i].y), sp0, xc, a, b, r0); Bf = a * Bf + b; Af = a * Af; b0 = b;
            rg_gate2(bf_hi(gq[i].x), bf_hi(gq[i].y), sp1, xc, a, b, r1); Bb = Ab * b + Bb; Ab = Ab * a;
            u32x2 w; w.x = cvt_pk_bf16(r0, r1); w.y = cvt_pk_bf16(b0, b); *(u32x2*)((bf16_t*)g_row(R, t0 + tb + i) + gcol) = w; }
    }
    *(f32x2*)(R.agg + ((size_t)(seg * 2 + 0) * 1024 + c) * 2) = (f32x2){Af, Bf};
    *(f32x2*)(R.agg + ((size_t)(seg * 2 + 1) * 1024 + c) * 2) = (f32x2){Ab, Bb};
}
__device__ __forceinline__ void rg_pass_c(const RgCtx& R, int half, int seg, int tid, LAS float* Lh) {
    const int c = half * 512 + tid, gcol = (c >> 6) * 256 + (c & 63) * 4, t0 = seg * 64;
    const float sp0 = R.sp[c], sp1 = R.sp[1024 + c];
    const f32x2* ag = (const f32x2*)R.agg;
    float hf = 0.f, hb = 0.f;
    {
#pragma unroll 1
        for (int sb = 0; sb < 128; sb += 32) { f32x2 ab[32];
#pragma unroll
            for (int i = 0; i < 32; ++i) { const int s2 = sb + i; ab[i] = (s2 < seg) ? ag[(size_t)(s2 * 2 + 0) * 1024 + c] : (f32x2){1.f, 0.f}; }
#pragma unroll
            for (int i = 0; i < 32; ++i) hf = ab[i][0] * hf + ab[i][1]; }
#pragma unroll 1
        for (int sb = 96; sb >= 0; sb -= 32) { f32x2 ab[32];
#pragma unroll
            for (int i = 0; i < 32; ++i) { const int s2 = sb + 31 - i; ab[i] = (s2 > seg) ? ag[(size_t)(s2 * 2 + 1) * 1024 + c] : (f32x2){1.f, 0.f}; }
#pragma unroll
            for (int i = 0; i < 32; ++i) hb = ab[i][0] * hb + ab[i][1]; }
    }
    {
        for (int tb = 0; tb < 64; tb += 16) {
            u32x2 gq[16];
#pragma unroll
            for (int i = 0; i < 16; ++i) gq[i] = *(const u32x2*)(g_row(R, t0 + tb + i) + gcol);
#pragma unroll
            for (int i = 0; i < 16; ++i) { const float a = __expf(sp0 * bf_lo(gq[i].x)); hf = a * hf + bf_lo(gq[i].y); Lh[(tb + i) * 512 + tid] = hf; }
        }
    }
    {
        for (int tb = 48; tb >= 0; tb -= 16) {
            u32x2 gq[16]; unsigned short zz[16];
#pragma unroll
            for (int i = 0; i < 16; ++i) { const int t = t0 + tb + 15 - i; gq[i] = *(const u32x2*)(g_row(R, t) + gcol); zz[i] = __builtin_nontemporal_load(R.Z + (size_t)t * 1024 + c); }
#pragma unroll
            for (int i = 0; i < 16; ++i) { const int tl = tb + 15 - i; const float a = __expf(sp1 * bf_hi(gq[i].x)); hb = a * hb + bf_hi(gq[i].y);
                const float o = (Lh[tl * 512 + tid] + hb) * gelu_tanh(bfu(zz[i]));
                R.ypre[(size_t)(t0 + tl) * 2048 + 1024 + c] = (bf16_t)(cvt_pk_bf16(o, 0.f) & 0xffffu); }
        }
    }
}

#ifndef NAIVE_GEMM
#define NAIVE_GEMM 0
#endif
template <class Epi, class Sched>
__device__ __forceinline__ void gemm_phase_naive(LAS unsigned char* lds, const int wid, const GParm gp, const Sched& S, const Epi& E) {
    const int lane = fresh_lane(), tid = wid * 64 + lane, wr = wid >> 2, wc = wid & 3, fr = lane & 15, fq = lane >> 4;
    GUnit cur;
    for (int ui = 0; S.next(ui, cur); ++ui) {
        f32x4 acc[2][2][4][2];
#pragma unroll
        for (int ai = 0; ai < 2; ++ai)
#pragma unroll
            for (int bj = 0; bj < 2; ++bj)
#pragma unroll
                for (int m = 0; m < 4; ++m)
#pragma unroll
                    for (int n = 0; n < 2; ++n)
#pragma unroll
                        for (int e = 0; e < 4; ++e) {
                            const int row = 128 * ai + 64 * wr + 16 * m + fr; const int col = Epi::PERM ? (128 * bj + 32 * wc + 8 * fq + 4 * n + e) : (128 * bj + 32 * wc + 16 * n + 4 * fq + e);
                            const char* ap = cur.A + (size_t)row * gp.a_rs; const char* bp = cur.B + (size_t)col * gp.K * 2; float sum = 0.f;
                            for (int k = 0; k < gp.K; k += 8) { const int kt = k >> 6, C = k & 63;
                                const u32x4 av = *(const u32x4*)(ap + (size_t)kt * gp.a_ks + ((C / gp.a_cw) * gp.a_cs + (C % gp.a_cw)) * 2), bv = *(const u32x4*)(bp + k * 2);
                                sum += bf_lo(av.x) * bf_lo(bv.x) + bf_hi(av.x) * bf_hi(bv.x) + bf_lo(av.y) * bf_lo(bv.y) + bf_hi(av.y) * bf_hi(bv.y) + bf_lo(av.z) * bf_lo(bv.z) + bf_hi(av.z) * bf_hi(bv.z) + bf_lo(av.w) * bf_lo(bv.w) + bf_hi(av.w) * bf_hi(bv.w); }
                            acc[ai][bj][m][n][e] = sum; }
        if constexpr (Epi::AFTER_DRAIN) { __syncthreads(); E.fused(acc, cur, wr, wc, fr, fq, lds, wid); } else E(acc, cur, wr, wc, fr, fq);
    }
    __syncthreads();
}
#if NAIVE_GEMM
#define GEMM_PHASE gemm_phase_naive
#else
#define GEMM_PHASE pg8::gemm_phase
#endif
__device__ __forceinline__ void transpose_item(const float* W, int K, int N, bf16_t* WT, LAS float* scr, int item, int lane) {
    const int nblk = N / 64, kb = item / nblk, nb = item % nblk, k0 = 64 * kb, n0 = 64 * nb;
    const float* src = W + (size_t)k0 * N + n0 + lane;
#pragma unroll
    for (int i = 0; i < 64; ++i) scr[i * 65 + lane] = __builtin_nontemporal_load(src + (size_t)i * N);
    LDS_WAIT();
    const int c = lane & 7;
#pragma unroll
    for (int j = 0; j < 8; ++j) { const int n = (lane >> 3) + 8 * j; const LAS float* sp = scr + (8 * c) * 65 + n;
        u32x4 o; o.x = cvt_pk_bf16(sp[0 * 65], sp[1 * 65]); o.y = cvt_pk_bf16(sp[2 * 65], sp[3 * 65]); o.z = cvt_pk_bf16(sp[4 * 65], sp[5 * 65]); o.w = cvt_pk_bf16(sp[6 * 65], sp[7 * 65]);
        *(u32x4*)(WT + (size_t)(n0 + n) * K + k0 + 8 * c) = o; }
    LDS_WAIT();
}
template <bool OUT_BF16> __device__ __forceinline__ void ln_row(const float* xrow, const float* g, const float* b, void* orow, int lane) {
    const f32x4* xr = (const f32x4*)xrow + lane; f32x4 v[8]; float s = 0.f;
#pragma unroll
    for (int j = 0; j < 8; ++j) { v[j] = __builtin_nontemporal_load(xr + 64 * j); s += (v[j][0] + v[j][1]) + (v[j][2] + v[j][3]); }
    const float mean = wave_sum(s) * (1.f / DM); float s2 = 0.f;
#pragma unroll
    for (int j = 0; j < 8; ++j) { v[j] = v[j] - mean; s2 += (v[j][0] * v[j][0] + v[j][1] * v[j][1]) + (v[j][2] * v[j][2] + v[j][3] * v[j][3]); }
    const float rstd = 1.0f / sqrtf(wave_sum(s2) * (1.f / DM) + LN_EPS);
#pragma unroll
    for (int j = 0; j < 8; ++j) { const f32x4 gg = ((const f32x4*)g)[lane + 64 * j], bb = ((const f32x4*)b)[lane + 64 * j]; const f32x4 o = v[j] * rstd * gg + bb;
        if (OUT_BF16) { u32x2 w; w.x = cvt_pk_bf16(o[0], o[1]); w.y = cvt_pk_bf16(o[2], o[3]); ((u32x2*)orow)[lane + 64 * j] = w; }
        else ((f32x4*)orow)[lane + 64 * j] = o; }
}
__device__ __forceinline__ void cpow(float lrs, float th, int j, float& re, float& im) {
    double a = (double)j * (double)th * 0.15915494309189535; a -= rint(a); const float af = 2.0f * (float)a;
    const float mag = expf((float)j * lrs); re = mag * cospif(af); im = mag * sinpif(af);
}


#ifndef NAIVE_RG
#define NAIVE_RG 0
#endif
__device__ __forceinline__ void naive_rg_channel(const RgCtx& R, int c) {
    const int gcol = (c >> 6) * 256 + (c & 63);
    const float w0 = R.convw[c], w1 = R.convw[1024 + c], w2 = R.convw[2048 + c], w3 = R.convw[3072 + c], cb = R.convb[c], sp0 = R.sp[c], sp1 = R.sp[1024 + c];
    const bf16_t* xp = R.XR + c; float h = 0.f;
    for (int t = 0; t < SEQ; ++t) { const float xc = cb + w0 * bfu(xp[(size_t)t * 1024]) + w1 * bfu(xp[(size_t)(t + 1) * 1024]) + w2 * bfu(xp[(size_t)(t + 2) * 1024]) + w3 * bfu(xp[(size_t)(t + 3) * 1024]);
        const bf16_t* g = g_row(R, t) + gcol; float a, b; rg_gate(bfu(g[0]), bfu(g[128]), sp0, xc, a, b); h = a * h + b;
        R.ypre[(size_t)t * 2048 + 1024 + c] = (bf16_t)(cvt_pk_bf16(h, 0.f) & 0xffffu); }
    __builtin_amdgcn_fence(__ATOMIC_SEQ_CST, "agent");
    h = 0.f;
    for (int t = SEQ - 1; t >= 0; --t) { const float xc = cb + w0 * bfu(xp[(size_t)t * 1024]) + w1 * bfu(xp[(size_t)(t + 1) * 1024]) + w2 * bfu(xp[(size_t)(t + 2) * 1024]) + w3 * bfu(xp[(size_t)(t + 3) * 1024]);
        const bf16_t* g = g_row(R, t) + gcol; float a, b; rg_gate(bfu(g[64]), bfu(g[192]), sp1, xc, a, b); h = a * h + b;
        const size_t o = (size_t)t * 2048 + 1024 + c; const float y = (bfu(R.ypre[o]) + h) * gelu_tanh(bfu(R.Z[(size_t)t * 1024 + c]));
        R.ypre[o] = (bf16_t)(cvt_pk_bf16(y, 0.f) & 0xffffu); }
}

#ifndef NAIVE_S5
#define NAIVE_S5 0
#endif
__device__ __forceinline__ void naive_s5_group(const float* const* in, const bf16_t* U, float* tmp, bf16_t* YG, int g, int lane) {
    const float *lre = in[6], *lim = in[7], *lstep = in[8], *bre = in[9], *bim = in[10], *cre = in[11], *cim = in[12], *dd = in[13];
    for (int n = 0; n < 2; ++n) {
        const int p = lane, pi = (n * 64 + g) * 64 + p;
        const float lr = fminf(lre[pi], -1e-4f), li = lim[pi], step = expf(lstep[n * 64 + g]); float ar, ai; cpow(lr * step, li * step, 1, ar, ai);
        const float nr = ar - 1.0f, ni = ai, den = lr * lr + li * li; const float qr = (nr * lr + ni * li) / den, qi = (ni * lr - nr * li) / den;
        float hr = 0.f, hi = 0.f;
        for (int tt = 0; tt < SEQ; ++tt) { const int t = n == 0 ? tt : SEQ - 1 - tt; const bf16_t* up = U + (size_t)t * 1024 + g * 16;
            float bur = 0.f, bui = 0.f;
#pragma unroll
            for (int k = 0; k < 16; ++k) { const float uv = bfu(up[k]); const float br = bre[(size_t)pi * 16 + k], bi = bim[(size_t)pi * 16 + k]; bur += (qr * br - qi * bi) * uv; bui += (qr * bi + qi * br) * uv; }
            const float nhr = ar * hr - ai * hi + bur, nhi = ar * hi + ai * hr + bui; hr = nhr; hi = nhi;
#pragma unroll
            for (int k = 0; k < 16; ++k) { const size_t ci = ((size_t)(n * 64 + g) * 16 + k) * 64 + p; float v = cre[ci] * hr - cim[ci] * hi; v = wave_sum(v);
                if (lane == k) { const size_t o = (size_t)t * 1024 + g * 16 + k;
                    if (n == 0) tmp[o] = v; else { const float y = tmp[o] + v + dd[g * 16 + k] * bfu(up[k]); YG[o] = (bf16_t)(cvt_pk_bf16(gelu_tanh(y), 0.f) & 0xffffu); } } }
        }
        __builtin_amdgcn_fence(__ATOMIC_SEQ_CST, "agent");
    }
}

#define XB_TMO      128
#define XB_XCNT(j)  (256  + 64 * (j))
#define XB_XSUB(j)  (1280 + 64 * (j))
#define XB_XGEN(j)  (2304 + 64 * (j))
#define XB_TOP      3328
#define XB_TOPGEN   3392
#define XCD_BAR_WORDS 3456
#define XB_SPIN_CAP (1u << 18)
__device__ __forceinline__ unsigned xb_ld(unsigned* p)              { return __hip_atomic_load(p, __ATOMIC_RELAXED, __HIP_MEMORY_SCOPE_AGENT); }
__device__ __forceinline__ unsigned xb_add(unsigned* p, unsigned v) { return __hip_atomic_fetch_add(p, v, __ATOMIC_RELAXED, __HIP_MEMORY_SCOPE_AGENT); }
__device__ __forceinline__ unsigned xb_xcc_id() { return (unsigned)__builtin_amdgcn_s_getreg((3 << 11) | 20) & 0xFu; }
#define XB_SPIN(cond, bar) do { unsigned _sp = 0; while (cond) { __builtin_amdgcn_s_sleep(1); \
    if ((++_sp & 255u) == 0u) { if (xb_ld(&(bar)[XB_TMO])) break; if (_sp > XB_SPIN_CAP) { atomicAdd(&(bar)[XB_TMO], 1u); break; } } } } while (0)
struct XcdBarrier { unsigned* bar; unsigned x; volatile LAS unsigned* st; };
__device__ __forceinline__ void xcd_barrier_complete(unsigned* bar, unsigned x, unsigned G, unsigned& nloc, unsigned& nx) {
    unsigned sum, cnt, mine, sp = 0u;
    for (;;) {
        sum = 0u; cnt = 0u; mine = 0u;
#pragma unroll
        for (unsigned j = 0; j < 16; ++j) { const unsigned c = xb_ld(&bar[XB_XCNT(j)]); sum += c; cnt += (c > 0u) ? 1u : 0u; mine = (j == x) ? c : mine; }
        if (sum == G) break;
        __builtin_amdgcn_s_sleep(1);
        if ((++sp & 255u) == 0u) { if (xb_ld(&bar[XB_TMO])) break; if (sp > XB_SPIN_CAP) { atomicAdd(&bar[XB_TMO], 1u); break; } }
    }
    nloc = mine > 0u ? mine : 1u; nx = cnt > 0u ? cnt : 1u;
}
__device__ __forceinline__ void xcd_barrier(const XcdBarrier& b, unsigned G, int wave) {
    asm volatile("s_waitcnt vmcnt(0)" ::: "memory");
    __syncthreads();
    if (wave == 0) { if (fresh_lane() == 0) {
        unsigned* bar = b.bar;
        __builtin_amdgcn_s_waitcnt(0);
        unsigned nloc = b.st[0], nx = b.st[1];
        if (nloc == 0u) { xcd_barrier_complete(bar, b.x, G, nloc, nx); b.st[0] = nloc; b.st[1] = nx; }
        const unsigned old = xb_add(&bar[XB_XSUB(b.x)], 1u);
        const unsigned gen = old / nloc;
        if (old + 1u == (gen + 1u) * nloc) {
            __builtin_amdgcn_fence(__ATOMIC_RELEASE, "agent");
            asm volatile("s_waitcnt vmcnt(0)" ::: "memory");
            const unsigned og = xb_add(&bar[XB_TOP], 1u);
            const unsigned tg = og / nx;
            if (og + 1u == (tg + 1u) * nx) xb_add(&bar[XB_TOPGEN], 1u);
            else XB_SPIN(xb_ld(&bar[XB_TOPGEN]) == tg, bar);
            __builtin_amdgcn_fence(__ATOMIC_ACQUIRE, "agent");
            xb_add(&bar[XB_XGEN(b.x)], 1u);
            asm volatile("s_waitcnt vmcnt(0)" ::: "memory");
        } else {
            XB_SPIN(xb_ld(&bar[XB_XGEN(b.x)]) == gen, bar);
            __builtin_amdgcn_fence(__ATOMIC_ACQUIRE, "agent");
            asm volatile("s_waitcnt vmcnt(0)" ::: "memory");
        }
    } }
    __syncthreads();
}

__device__ __forceinline__ void grid_barrier(unsigned* bar, unsigned target, int wave) {
    asm volatile("s_waitcnt vmcnt(0)" ::: "memory");
    __syncthreads();
    if (wave == 0) { const int l = fresh_lane();
        if (l == 0) {
            __builtin_amdgcn_fence(__ATOMIC_RELEASE, "agent"); asm volatile("s_waitcnt vmcnt(0)" ::: "memory");
            __hip_atomic_fetch_add(bar, 1u, __ATOMIC_RELAXED, __HIP_MEMORY_SCOPE_AGENT);
            while (__hip_atomic_load(bar, __ATOMIC_RELAXED, __HIP_MEMORY_SCOPE_AGENT) < target) __builtin_amdgcn_s_sleep(2);
            __builtin_amdgcn_fence(__ATOMIC_ACQUIRE, "agent"); asm volatile("s_waitcnt vmcnt(0)" ::: "memory");
        } }
    __syncthreads();
}

struct Args { const float* in[38]; float* out; unsigned char* ws; int ph_lo, ph_hi; };
typedef const float* cfp_t;
typedef const __attribute__((address_space(4))) cfp_t* kin_t;

__device__ __forceinline__ void s5_precompute(const kin_t ain, unsigned char* aws, int g, int hq, int nh, LAS float* L, const int tid) {
    const float *lre = ain[6], *lim = ain[7], *lstep = ain[8], *bre = ain[9], *bim = ain[10], *cre = ain[11], *cim = ain[12], *dd = ain[13];
    LAS float *PWre = L, *PWim = L + 4224, *BBre = L + 8448, *BBim = L + 10496, *CCre = L + 12544, *CCim = L + 14592, *MT = L + 16640, *C2re = L + 33280, *C2im = L + 35328, *Dl = L + 37376;
    bf16_t* WGg = (bf16_t*)(aws + WS_WG) + (size_t)g * 768 * 512; bf16_t* WCg = (bf16_t*)(aws + WS_WC) + (size_t)g * 512 * 256;
#define PSTAMP(i) do { if (TSTAMP && blockIdx.x == 128 && tid == 0) ((unsigned long long*)(aws + WS_CTR + 1024))[i] = __builtin_amdgcn_s_memrealtime(); } while (0)
    PSTAMP(20);
    {
        const int np = tid & 127, jj = tid >> 7, n = np >> 6, p = np & 63; const int pi = (n * 64 + g) * 64 + p;
        const float lr = fminf(lre[pi], -1e-4f), li = lim[pi], step = expf(lstep[n * 64 + g]); const float lrs = lr * step, th = li * step;
        for (int j = jj; j <= 32; j += 4) { float r, i; cpow(lrs, th, j, r, i); PWre[np * 33 + j] = r; PWim[np * 33 + j] = i; }
        float l1r, l1i; cpow(lrs, th, 1, l1r, l1i);
        const float nr = l1r - 1.0f, ni = l1i, den = lr * lr + li * li; const float qr = (nr * lr + ni * li) / den, qi = (ni * lr - nr * li) / den;
#pragma unroll
        for (int k = jj * 4; k < jj * 4 + 4; ++k) { const float br = bre[(size_t)pi * 16 + k], bi = bim[(size_t)pi * 16 + k]; BBre[np * 16 + k] = qr * br - qi * bi; BBim[np * 16 + k] = qr * bi + qi * br; }
        for (int e = tid; e < 2048; e += 512) { const int n2 = e >> 10, k = (e >> 6) & 15, p2 = e & 63; const size_t ci = ((size_t)(n2 * 64 + g) * 16 + k) * 64 + p2; CCre[(n2 * 64 + p2) * 16 + k] = cre[ci]; CCim[(n2 * 64 + p2) * 16 + k] = cim[ci]; C2re[e] = cre[ci]; C2im[e] = cim[ci]; }
        if (tid < 16) Dl[tid] = dd[g * 16 + tid];
    }
    __syncthreads();
    PSTAMP(21);
    for (int i = 0; i < 3; ++i) {
        if (nh == 2) { if (i < 2 && i != hq) continue; if (i == 2 && (hq != 0 || tid >= 16)) continue; } else if (i == 2) continue;
        const int bq = (i == 2) ? 512 + tid : tid + 512 * i, n = bq >> 9, j = (bq >> 4) & 31, kob = (bq >> 2) & 3, kib = bq & 3;
        f32x4 m0 = {0.f, 0.f, 0.f, 0.f}, m1 = m0, m2 = m0, m3 = m0;
        for (int p = 0; p < 64; ++p) { const int np = n * 64 + p; const float pr = PWre[np * 33 + j], pi2 = PWim[np * 33 + j];
            const f32x4 br = *(const LAS f32x4*)(BBre + np * 16 + 4 * kib), bi = *(const LAS f32x4*)(BBim + np * 16 + 4 * kib), cr = *(const LAS f32x4*)(CCre + np * 16 + 4 * kob), ci = *(const LAS f32x4*)(CCim + np * 16 + 4 * kob);
            const f32x4 er = pr * br - pi2 * bi, ei = pr * bi + pi2 * br;
            m0 += cr[0] * er - ci[0] * ei; m1 += cr[1] * er - ci[1] * ei; m2 += cr[2] * er - ci[2] * ei; m3 += cr[3] * er - ci[3] * ei; }
        LAS float* o = MT + (n * 32 + j) * 260 + (4 * kob) * 16 + 4 * kib;
        *(LAS f32x4*)o = m0; *(LAS f32x4*)(o + 16) = m1; *(LAS f32x4*)(o + 32) = m2; *(LAS f32x4*)(o + 48) = m3;
    }
    __syncthreads();
    PSTAMP(22);
    for (int i = 0; i < 64; ++i) {
        const int idx = tid + 512 * i, row = idx >> 6, cp = idx & 63, t = row >> 4, ko = row & 15, s = cp >> 1, ki0 = (cp & 1) * 8;
        if (nh == 2 && ((t >= s) != (hq == 0))) continue;
        f32x4 v0, v1;
        if (t != s) { const LAS float* src = MT + ((t > s ? 0 : 1) * 32 + (t > s ? t - s : s - t)) * 260 + ko * 16 + ki0; v0 = *(const LAS f32x4*)src; v1 = *(const LAS f32x4*)(src + 4); }
        else { const LAS float* s0 = MT + ko * 16 + ki0; const LAS float* s1 = MT + 32 * 260 + ko * 16 + ki0; v0 = *(const LAS f32x4*)s0 + *(const LAS f32x4*)s1; v1 = *(const LAS f32x4*)(s0 + 4) + *(const LAS f32x4*)(s1 + 4);
            const float dv = Dl[ko];
#pragma unroll
            for (int e = 0; e < 4; ++e) { if (ki0 + e == ko) v0[e] += dv; if (ki0 + 4 + e == ko) v1[e] += dv; } }
        u32x4 w; w.x = cvt_pk_bf16(v0[0], v0[1]); w.y = cvt_pk_bf16(v0[2], v0[3]); w.z = cvt_pk_bf16(v1[0], v1[1]); w.w = cvt_pk_bf16(v1[2], v1[3]);
        *(u32x4*)(WGg + (size_t)row * 512 + cp * 8) = w;
    }
    for (int i = hq * (32 / nh); i < (hq + 1) * (32 / nh); ++i) {
        const int idx = tid + 512 * i, q = idx >> 6, cp = idx & 63, n = q >> 7, ri = (q >> 6) & 1, p = q & 63, s = cp >> 1, ki0 = (cp & 1) * 8, e = n == 0 ? 31 - s : s, np = n * 64 + p;
        const float pr = PWre[np * 33 + e], pi2 = PWim[np * 33 + e]; float v[8];
#pragma unroll
        for (int k = 0; k < 8; ++k) { const float br = BBre[np * 16 + ki0 + k], bi = BBim[np * 16 + ki0 + k]; v[k] = ri == 0 ? pr * br - pi2 * bi : pr * bi + pi2 * br; }
        u32x4 w; w.x = cvt_pk_bf16(v[0], v[1]); w.y = cvt_pk_bf16(v[2], v[3]); w.z = cvt_pk_bf16(v[4], v[5]); w.w = cvt_pk_bf16(v[6], v[7]);
        *(u32x4*)(WGg + (size_t)(512 + q) * 512 + cp * 8) = w;
    }
    for (int i = 0; i < 32 / nh; ++i) {
        const int idx = tid + 512 * i, row = nh == 2 ? idx >> 4 : idx >> 5, q0 = nh == 2 ? hq * 128 + (idx & 15) * 8 : (idx & 31) * 8, n = q0 >> 7, ri = (q0 >> 6) & 1, p0 = q0 & 63, t = row >> 4, ko = row & 15, e = n == 0 ? t + 1 : 32 - t; float v[8];
#pragma unroll
        for (int k = 0; k < 8; ++k) { const int np = n * 64 + p0 + k; const float cr = C2re[(n * 16 + ko) * 64 + p0 + k], ci = C2im[(n * 16 + ko) * 64 + p0 + k], pr = PWre[np * 33 + e], pi2 = PWim[np * 33 + e];
            v[k] = ri == 0 ? cr * pr - ci * pi2 : -(cr * pi2 + ci * pr); }
        u32x4 w; w.x = cvt_pk_bf16(v[0], v[1]); w.y = cvt_pk_bf16(v[2], v[3]); w.z = cvt_pk_bf16(v[4], v[5]); w.w = cvt_pk_bf16(v[6], v[7]);
        *(u32x4*)(WCg + (size_t)row * 256 + q0) = w;
    }
    __syncthreads();
    PSTAMP(23);
}


#ifndef DIAG
#define DIAG 0
#endif
__device__ __forceinline__ void diag_ffn(const float* const* in, const unsigned char* ws, const float* outp, unsigned* flagw, int gtid, int GT) {
    const bf16_t* h1 = (const bf16_t*)(ws + WS_HB); const bf16_t* T = (const bf16_t*)(ws + WS_T); const float* V2 = (const float*)(ws + WS_V2);
    const float *w1 = in[29], *b1 = in[30], *w2 = in[31], *b2 = in[32], *wp = in[33], *wg = in[34], *bg = in[35], *pp = in[1];
    for (int sidx = gtid; sidx < 16384; sidx += GT) {
        unsigned hsh = (unsigned)sidx * 2654435761u, h2 = ((unsigned)sidx + 977u) * 2246822519u; const int r = (hsh >> 8) % SEQ; const int c = (h2 >> 6) % DFF; const int c2 = c % DM;
        float a = b1[c]; for (int k = 0; k < DM; ++k) a += bfu(h1[(size_t)r * DM + k]) * w1[(size_t)k * DFF + c];
        a = fmaxf(a, 0.f); a = a * a; const float tv = bfu(T[(size_t)r * DFF + c]);
        if (fabsf(tv - a) > 0.008f * fabsf(a) + 0.006f) atomicAdd(flagw + 0, 1u);
        float f = b2[c2]; for (int k = 0; k < DFF; ++k) f += bfu(T[(size_t)r * DFF + k]) * w2[(size_t)k * DM + c2];
        float gt = bg[c2]; for (int k = 0; k < DM; ++k) gt += bfu(h1[(size_t)r * DM + k]) * wg[(size_t)k * DM + c2];
        float pw = 0.f; for (int k = 0; k < PLE; ++k) pw += pp[(size_t)r * PLE + k] * wp[(size_t)k * DM + c2];
        const float v2 = DN_ALPHA * bfu(h1[(size_t)r * DM + c2]) + f + fast_sigmoid(gt) * pw; const float got = V2[(size_t)r * DM + c2];
        if (fabsf(got - v2) > 0.008f * fabsf(v2) + 0.006f) atomicAdd(flagw + 1, 1u);
        { const float* vr = V2 + (size_t)r * DM; float m = 0.f; for (int k = 0; k < DM; ++k) m += vr[k]; m /= DM; float v = 0.f; for (int k = 0; k < DM; ++k) { const float d = vr[k] - m; v += d * d; } v /= DM;
          const float e = (vr[c2] - m) / sqrtf(v + LN_EPS) * in[36][c2] + in[37][c2]; const float go = outp[(size_t)r * DM + c2]; if (fabsf(go - e) > 0.004f * fabsf(e) + 0.003f) atomicAdd(flagw + 2, 1u); }
    }
}

__device__ __forceinline__ void diag_pre(const float* const* in, const unsigned char* ws, const unsigned char* dout, unsigned* flagw, int gtid, int GT) {
    const bf16_t* h0 = (const bf16_t*)(ws + WS_HB); const bf16_t* U = (const bf16_t*)(dout + DO_U); const bf16_t* XRb = (const bf16_t*)(ws + WS_XR) + 2048; const bf16_t* Z = (const bf16_t*)(dout + DO_Z);
    const bf16_t* ypre = (const bf16_t*)(dout + DO_YPRE); const bf16_t* ycat = (const bf16_t*)(ws + WS_YCAT); const bf16_t* yg = (const bf16_t*)(ws + WS_YS5G);
    const float *x = in[0], *lg = in[2], *lb = in[3], *win = in[4], *bin = in[5], *gw_ = in[14], *gb = in[15], *g5 = in[23], *gr = in[24];
    for (int sidx = gtid; sidx < 8192; sidx += GT) {
        unsigned hsh = (unsigned)sidx * 2654435761u, h2 = ((unsigned)sidx + 977u) * 2246822519u; const int r = (hsh >> 8) % SEQ; const int c = (h2 >> 6) % DIN; const int c2 = c % DM; const int c1 = c % DS5;
        { float m = 0.f; for (int k = 0; k < DM; ++k) m += x[(size_t)r * DM + k]; m /= DM; float v = 0.f; for (int k = 0; k < DM; ++k) { const float d = x[(size_t)r * DM + k] - m; v += d * d; } v /= DM;
          const float e = (x[(size_t)r * DM + c2] - m) / sqrtf(v + LN_EPS) * lg[c2] + lb[c2]; const float got = bfu(h0[(size_t)r * DM + c2]); if (fabsf(got - e) > 0.008f * fabsf(e) + 0.006f) atomicAdd(flagw + 0, 1u); }
        { float a = bin[c]; for (int k = 0; k < DM; ++k) a += bfu(h0[(size_t)r * DM + k]) * win[(size_t)k * DIN + c];
          const float got = c < 1024 ? bfu(U[(size_t)r * 1024 + c]) : (c < 2048 ? bfu(XRb[(size_t)r * 1024 + c - 1024]) : bfu(Z[(size_t)r * 1024 + c - 2048])); if (fabsf(got - a) > 0.008f * fabsf(a) + 0.006f) atomicAdd(flagw + 3, 1u); }
        { const int hf = c2 >> 10; float ss = 0.f; for (int k = 0; k < 1024; ++k) { const float y = bfu(ypre[(size_t)r * DM + hf * 1024 + k]); ss += y * y; }
          const float e = bfu(ypre[(size_t)r * DM + c2]) / sqrtf(ss / 1024.f + LN_EPS) * (hf ? gr[c2 - 1024] : g5[c2]); const float got = bfu(ycat[(size_t)r * DM + c2]); if (fabsf(got - e) > 0.008f * fabsf(e) + 0.006f) atomicAdd(flagw + 1, 1u); }
        { float a = gb[c1]; for (int k = 0; k < DS5; ++k) a += bfu(yg[(size_t)r * DS5 + k]) * gw_[(size_t)k * DS5 + c1];
          const float e = bfu(yg[(size_t)r * DS5 + c1]) * fast_sigmoid(a); const float got = bfu(ypre[(size_t)r * DM + c1]); if (fabsf(got - e) > 0.008f * fabsf(e) + 0.006f) atomicAdd(flagw + 2, 1u); }
    }
}

__device__ __forceinline__ void diag_v(const float* const* in, const unsigned char* ws, const unsigned char* dout, unsigned* flagw, int gtid, int GT) {
    const bf16_t* h0 = (const bf16_t*)(ws + WS_HB); const bf16_t* ycat = (const bf16_t*)(ws + WS_YCAT); const float* V = (const float*)dout; const float *wo = in[25], *bo = in[26];
    for (int sidx = gtid; sidx < 16384; sidx += GT) { unsigned hsh = (unsigned)sidx * 2654435761u, h2 = ((unsigned)sidx + 977u) * 2246822519u; const int r = (hsh >> 8) % SEQ; const int c = (h2 >> 6) % DM;
        float a = bo[c] + DN_ALPHA * bfu(h0[(size_t)r * DM + c]); for (int k = 0; k < DM; ++k) a += bfu(ycat[(size_t)r * DM + k]) * wo[(size_t)k * DM + c];
        const float got = V[(size_t)r * DM + c]; if (fabsf(got - a) > 0.008f * fabsf(a) + 0.006f) atomicAdd(flagw + 0, 1u); }
}

__device__ __forceinline__ void diag_g(const float* const* in, const unsigned char* ws, unsigned* flagw, int gtid, int GT) {
    const bf16_t* XRp = (const bf16_t*)(ws + WS_XR); const bf16_t* G0 = (const bf16_t*)(ws + WS_G0); const bf16_t* G1 = (const bf16_t*)(ws + WS_G1);
    const float *convw = in[16], *convb = in[17], *wa = in[18], *ba = in[19], *wx = in[20], *bxx = in[21];
    for (int sidx = gtid; sidx < 16384; sidx += GT) { unsigned hsh = (unsigned)sidx * 2654435761u; unsigned h2 = ((unsigned)sidx + 12345u) * 2246822519u; const int t = (hsh >> 7) % SEQ; const int col = (h2 >> 5) % 4096;
        const int h = col >> 8, row = col & 255, bj = row >> 7, dir = (row >> 6) & 1, ch = row & 63;
        const float* W = (bj == 0 ? wa : wx) + ((size_t)(dir * 16 + h) * 64) * 64 + ch; float a = (bj == 0 ? ba : bxx)[(dir * 16 + h) * 64 + ch];
        for (int i = 0; i < 64; ++i) { const int c = 64 * h + i; float xc = convb[c];
            for (int j = 0; j < 4; ++j) xc += convw[j * 1024 + c] * bfu(XRp[(size_t)(t + j) * 1024 + c]);
            a += xc * W[(size_t)i * 64]; }
        const float got = bfu((t < 4096 ? G0 : G1)[(size_t)(t & 4095) * 4096 + col]);
        if (fabsf(got - a) > 0.008f * fabsf(a) + 0.006f) atomicAdd(flagw + 0, 1u); }
}

#ifndef DIAG_HALF
#define DIAG_HALF 1
#endif
__device__ __forceinline__ void diag_max(const unsigned char* ws, unsigned* flagw, int gtid, int GT) {
    const bf16_t* ycat = (const bf16_t*)(ws + WS_YCAT); float mx = 0.f;
    for (size_t i = gtid; i < (size_t)SEQ * 1024; i += GT) { const size_t r = i >> 10, c = (i & 1023) + DIAG_HALF * 1024; mx = fmaxf(mx, fabsf(bfu(ycat[r * DM + c]))); }
    atomicMax(flagw + 0, __float_as_uint(mx));
}

#ifndef DIAG_SEL
#define DIAG_SEL 4
#endif
__device__ __forceinline__ void diag_rows(const float* outp, unsigned* flagw, int gw, int NGW, int lane) {
    for (int row = gw; row < SEQ; row += NGW) { float mx = 0.f; for (int j = lane; j < DM; j += 64) mx = fmaxf(mx, fabsf(outp[(size_t)row * DM + j]));
#pragma unroll
        for (int o = 1; o < 64; o <<= 1) mx = fmaxf(mx, __shfl_xor(mx, o));
        if (lane == 0 && mx > 12.0f) { atomicAdd(flagw + 0, 1u); atomicMin(flagw + 1, (unsigned)row); atomicMax(flagw + 2, (unsigned)row); } }
}

__device__ __forceinline__ void diag_rows_bf(const bf16_t* p, int ld, float thr, unsigned* flagw, int gw, int NGW, int lane) {
    for (int row = gw; row < SEQ; row += NGW) { float mx = 0.f; for (int j = lane; j < ld; j += 64) mx = fmaxf(mx, fabsf(bfu(p[(size_t)row * ld + j])));
#pragma unroll
        for (int o = 1; o < 64; o <<= 1) mx = fmaxf(mx, __shfl_xor(mx, o));
        if (lane == 0 && mx > thr) { atomicAdd(flagw + 0, 1u); atomicMin(flagw + 1, (unsigned)row); atomicMax(flagw + 2, (unsigned)row); } }
}
template <int PHMASK> __global__ void __launch_bounds__(512, 2) mega(Args) {
    extern __shared__ __attribute__((aligned(16))) unsigned char lds_raw[];
    LAS unsigned char* lds = (LAS unsigned char*)lds_raw;
    const int wave = __builtin_amdgcn_readfirstlane((int)threadIdx.x >> 6);
    const int G = gridDim.x, bx = blockIdx.x;
    const int gw = bx * 8 + wave, NGW = G * 8, GT = G * 512;
#define PH_IDS const int lane = fresh_lane(), tid = wave * 64 + lane, gtid = bx * 512 + tid; (void)tid; (void)gtid; (void)lane
    const kin_t KIN = (kin_t)__builtin_amdgcn_kernarg_segment_ptr();
    unsigned char* ws = (unsigned char*)KIN[39]; unsigned char* dout = (unsigned char*)KIN[38];
    const int* kint = (const int*)0; (void)kint;
#if DIAG == 2
    const int lo = ((const __attribute__((address_space(4))) int*)KIN)[80], hi = 7;
#elif DIAG == 3
    const int lo = ((const __attribute__((address_space(4))) int*)KIN)[80], hi = 8;
#elif DIAG == 4
    const int lo = ((const __attribute__((address_space(4))) int*)KIN)[80], hi = 5;
#elif DIAG == 6
    const int lo = ((const __attribute__((address_space(4))) int*)KIN)[80], hi = 7;
#elif DIAG == 8
    const int lo = ((const __attribute__((address_space(4))) int*)KIN)[80], hi = 9;
#elif DIAG == 11 || DIAG == 12
    const int lo = ((const __attribute__((address_space(4))) int*)KIN)[80], hi = 10;
#else
    const int lo = ((const __attribute__((address_space(4))) int*)KIN)[80], hi = ((const __attribute__((address_space(4))) int*)KIN)[81];
#endif
#define IN(k) (((PHMASK >> (k)) & 1) && lo <= (k) && (k) < hi)
    unsigned nbar = 0; unsigned* gbar = (unsigned*)(ws + WS_CTR) + 32; (void)gbar;
    XcdBarrier xb; xb.bar = (unsigned*)(ws + WS_CTR) + 5120; xb.x = xb_xcc_id(); xb.st = (volatile LAS unsigned*)(lds + 155000);
    if (wave == 0) { if (fresh_lane() == 0) { xb.st[0] = 0u; xb.st[1] = 0u; (void)xb_add(&xb.bar[XB_XCNT(xb.x)], 1u); } }
    __syncthreads();
    if (PHMASK == 0xfff && hi > 4096) cg::this_grid().sync();
#ifndef DBL_MASK
#define DBL_MASK 0
#endif
#define REPS(k) (((DBL_MASK >> (k)) & 1) ? 2 : 1)
#define SEAM(k) do { if (IN(k) && IN((k) + 1)) { ++nbar; xcd_barrier(xb, (unsigned)G, wave); if (TSTAMP && bx == 0 && wave == 0) { if (fresh_lane() == 0) ((unsigned long long*)(ws + WS_CTR + 1024))[(k) + 1] = __builtin_amdgcn_s_memrealtime(); } } } while (0)

#define MK_RG const RgCtx RG{(const bf16_t*)(ws + WS_XR), (const bf16_t*)(ws + WS_G0), (const bf16_t*)(ws + WS_G1), (const bf16_t*)(dout + DO_Z), KIN[16], KIN[17], (const float*)(ws + WS_SP), (float*)(ws + WS_AGG), (bf16_t*)(dout + DO_YPRE)}
    if (TSTAMP && bx == 0 && wave == 0) { if (fresh_lane() == 0) ((unsigned long long*)(ws + WS_CTR + 1024))[0] = __builtin_amdgcn_s_memrealtime(); }
    for (int rep = 0; rep < REPS(0); ++rep) {
    if (IN(0)) { PH_IDS;
        if (G != 256) { for (int g = bx; g < 64; g += G) s5_precompute(KIN, ws, g, 0, 1, (LAS float*)lds, tid); }
        {
            LAS float* scr = (LAS float*)(lds + wave * 16640);
            constexpr int I_IN = (DM / 64) * (DIN / 64), I_OUT = (DM / 64) * (DM / 64), I_PG = I_OUT, I_GLU = (DS5 / 64) * (DS5 / 64), I_PW = (PLE / 64) * (DM / 64), I_LN = SEQ / 4;
            constexpr int NITEMS = I_IN + I_OUT + I_PG + I_GLU + I_PW + I_LN;
            for (int it = gw; it < NITEMS; it += NGW) {
                int r = it;
                if (r < I_IN) { transpose_item(KIN[4], DM, DIN, (bf16_t*)(ws + WS_WINT), scr, r, lane); continue; } r -= I_IN;
                if (r < I_LN) { for (int q = 0; q < 4; ++q) { const int row = r * 4 + q; ln_row<true>(KIN[0] + (size_t)row * DM, KIN[2], KIN[3], (bf16_t*)(ws + WS_HB) + (size_t)row * DM, lane); } continue; } r -= I_LN;
                if (r < I_OUT) { transpose_item(KIN[25], DM, DM, (bf16_t*)(ws + WS_WOUTT), scr, r, lane); continue; } r -= I_OUT;
                if (r < I_PG) { transpose_item(KIN[34], DM, DM, (bf16_t*)(ws + WS_PLEGT), scr, r, lane); continue; } r -= I_PG;
                if (r < I_GLU) { transpose_item(KIN[14], DS5, DS5, (bf16_t*)(ws + WS_GLUT), scr, r, lane); continue; } r -= I_GLU;
                transpose_item(KIN[33], PLE, DM, (bf16_t*)(ws + WS_PLEWT), scr, r, lane);
            }
        }
        {   const float* pp = KIN[1]; bf16_t* pb = (bf16_t*)(ws + WS_PB);
            for (int i = gtid; i < SEQ * PLE / 4; i += GT) { const f32x4 v = __builtin_nontemporal_load((const f32x4*)pp + i); u32x2 w; w.x = cvt_pk_bf16(v[0], v[1]); w.y = cvt_pk_bf16(v[2], v[3]); ((u32x2*)pb)[i] = w; }
            const float *convw = KIN[16], *convb = KIN[17], *wa = KIN[18], *ba = KIN[19], *wx = KIN[20], *bxx = KIN[21], *lam = KIN[22];
            bf16_t* rgw = (bf16_t*)(ws + WS_RGW);
            for (int i = gtid; i < 16 * 256 * 32; i += GT) { const int h = i >> 13, row = (i >> 5) & 255, K0 = (i & 31) * 8, j = K0 >> 6, i0 = K0 & 63, ch = row >> 2, bj = (row >> 1) & 1, dir = row & 1;
                const float* W = (bj == 0 ? wa : wx) + ((size_t)(dir * 16 + h) * 64) * 64 + ch; float v[8];
#pragma unroll
                for (int k = 0; k < 8; ++k) v[k] = convw[j * 1024 + 64 * h + i0 + k] * W[(size_t)(i0 + k) * 64];
                u32x4 w; w.x = cvt_pk_bf16(v[0], v[1]); w.y = cvt_pk_bf16(v[2], v[3]); w.z = cvt_pk_bf16(v[4], v[5]); w.w = cvt_pk_bf16(v[6], v[7]);
                *(u32x4*)(rgw + ((size_t)h * 256 + row) * 256 + K0) = w; }
            float* rgb = (float*)(ws + WS_RGBIAS);
            for (int i = gtid; i < 16 * 256; i += GT) { const int h = i >> 8, row = i & 255, ch = row >> 2, bj = (row >> 1) & 1, dir = row & 1;
                const float* W = (bj == 0 ? wa : wx) + ((size_t)(dir * 16 + h) * 64) * 64 + ch; float s = (bj == 0 ? ba : bxx)[(dir * 16 + h) * 64 + ch];
#pragma unroll
                for (int k = 0; k < 64; ++k) s += convb[64 * h + k] * W[(size_t)k * 64];
                rgb[i] = s; }
            float* spt = (float*)(ws + WS_SP);
            for (int i = gtid; i < 2 * 1024; i += GT) spt[i] = -8.0f * log1pf(expf(-lam[i]));
            unsigned* xr = (unsigned*)(ws + WS_XR);
            for (int i = gtid; i < 1024; i += GT) { xr[i] = 0u; xr[(size_t)(SEQ + 2) * 512 + i] = 0u; }
        }
    }
    if (rep + 1 < REPS(0)) { ++nbar; xcd_barrier(xb, (unsigned)G, wave); } }
    SEAM(0);
    for (int rep = 0; rep < REPS(1); ++rep) {
    if (IN(1)) { PH_IDS;
        SchedStd S; S.so.init(SEQ, DIN, G, bx); S.A = (const char*)(ws + WS_HB); S.B = (const char*)(ws + WS_WINT); S.a_tile = (size_t)256 * DM * 2; S.b_tile = (size_t)256 * DM * 2;
        EpiProj E{(bf16_t*)(dout + DO_U), (bf16_t*)(ws + WS_XR), (bf16_t*)(dout + DO_Z), KIN[5]};
        GEMM_PHASE(lds, wave, GParm{DM, DM * 2, 128, 64, 0}, S, E);
        if (G == 256 && bx >= 128) { __syncthreads(); const int t2 = wave * 64 + fresh_lane(); s5_precompute(KIN, ws, (bx - 128) >> 1, (bx - 128) & 1, 2, (LAS float*)lds, t2); }
    }
    if (rep + 1 < REPS(1)) { ++nbar; xcd_barrier(xb, (unsigned)G, wave); } }
    SEAM(1);
    for (int rep = 0; rep < REPS(2); ++rep) {
    if (IN(2)) { PH_IDS;
        { SchedS5a S{(const char*)(dout + DO_U), (const char*)(ws + WS_WG), G, bx}; EpiS5a E{(bf16_t*)(ws + WS_YINTRA), (float*)(ws + WS_S)};
          GEMM_PHASE(lds, wave, GParm{512, 1024, 128, 64, 0}, S, E); }
        { SchedRG S{(const char*)(ws + WS_XR), (const char*)(ws + WS_RGW), G, bx}; EpiG E{(bf16_t*)(ws + WS_G0), (bf16_t*)(ws + WS_G1), (const float*)(ws + WS_RGBIAS)};
          GEMM_PHASE(lds, wave, GParm{256, 2048, 2048, 64, 0}, S, E); }
    }
    if (rep + 1 < REPS(2)) { ++nbar; xcd_barrier(xb, (unsigned)G, wave); } }
    SEAM(2);
    for (int rep = 0; rep < REPS(3); ++rep) {
    if (IN(3)) { PH_IDS;
        if (bx < 128) {
            const int g = bx >> 1, n = bx & 1; const float* Sg = (const float*)(ws + WS_S) + (size_t)g * NCH * 256 + n * 128; LAS float* Ls = (LAS float*)lds;
            for (int i = tid; i < NCH * 32; i += 512) { const int c = i >> 5, q4 = (i & 31) * 4; *(LAS f32x4*)(Ls + c * 128 + q4) = __builtin_nontemporal_load((const f32x4*)(Sg + (size_t)c * 256 + q4)); }
            __syncthreads();
            {
                const int p = lane, pi = (n * 64 + g) * 64 + p; LAS float* Le = Ls + NCH * 128;
                const float lr = fminf(KIN[6][pi], -1e-4f), li = KIN[7][pi], step = expf(KIN[8][n * 64 + g]); float ar, ai, wr_, wi_; cpow(lr * step, li * step, TC, ar, ai); cpow(lr * step, li * step, TC * 32, wr_, wi_);
                float hr = 0.f, him = 0.f;
                for (int cc = 0; cc < 32; ++cc) { const int c = wave * 32 + (n == 0 ? cc : 31 - cc); const float sr = Ls[c * 128 + p], si = Ls[c * 128 + 64 + p]; const float nr = ar * hr - ai * him + sr, ni = ar * him + ai * hr + si; hr = nr; him = ni; }
                Le[wave * 128 + p] = hr; Le[wave * 128 + 64 + p] = him;
                __syncthreads();
                hr = 0.f; him = 0.f;
                if (n == 0) { for (int w2 = 0; w2 < wave; ++w2) { const float er = Le[w2 * 128 + p], ei = Le[w2 * 128 + 64 + p]; const float nr = wr_ * hr - wi_ * him + er, ni = wr_ * him + wi_ * hr + ei; hr = nr; him = ni; } }
                else { for (int w2 = 7; w2 > wave; --w2) { const float er = Le[w2 * 128 + p], ei = Le[w2 * 128 + 64 + p]; const float nr = wr_ * hr - wi_ * him + er, ni = wr_ * him + wi_ * hr + ei; hr = nr; him = ni; } }
                bf16_t* hp = (bf16_t*)(ws + WS_HPREV) + (size_t)g * NCH * 256 + n * 128;
                for (int cc = 0; cc < 32; ++cc) { const int c = wave * 32 + (n == 0 ? cc : 31 - cc);
                    hp[(size_t)c * 256 + p] = (bf16_t)(cvt_pk_bf16(hr, 0.f) & 0xffffu); hp[(size_t)c * 256 + 64 + p] = (bf16_t)(cvt_pk_bf16(him, 0.f) & 0xffffu);
                    const float sr = Ls[c * 128 + p], si = Ls[c * 128 + 64 + p]; const float nr = ar * hr - ai * him + sr, ni = ar * him + ai * hr + si; hr = nr; him = ni; } }
            __syncthreads();
        }
        { MK_RG; for (int un = bx; un < 256; un += G) rg_pass_a(RG, un & 1, un >> 1, tid); }
    }
    if (rep + 1 < REPS(3)) { ++nbar; xcd_barrier(xb, (unsigned)G, wave); } }
    SEAM(3);
    for (int rep = 0; rep < REPS(4); ++rep) {
    if (IN(4)) { PH_IDS;
#if NAIVE_S5
        if (gw < 64) naive_s5_group((const float* const*)0, (const bf16_t*)(dout + DO_U), (float*)(ws + WS_YINTRA), (bf16_t*)(ws + WS_YS5G), gw, lane);
#else
        { SchedS5b S{(const char*)(ws + WS_HPREV), (const char*)(ws + WS_WC), G, bx}; EpiS5b E{(const bf16_t*)(ws + WS_YINTRA), (bf16_t*)(ws + WS_YS5G)};
          GEMM_PHASE(lds, wave, GParm{256, 512, 128, 64, 0}, S, E); }
#endif
#if NAIVE_RG
        { MK_RG; if (gtid < 1024) naive_rg_channel(RG, gtid); }
#else
        { MK_RG; __syncthreads(); for (int un = bx; un < 256; un += G) { rg_pass_c(RG, un & 1, un >> 1, tid, (LAS float*)lds); __syncthreads(); } }
#endif
    }
    if (rep + 1 < REPS(4)) { ++nbar; xcd_barrier(xb, (unsigned)G, wave); } }
    SEAM(4);
    for (int rep = 0; rep < REPS(5); ++rep) {
    if (IN(5)) { PH_IDS;
        SchedStd S; S.so.init(SEQ, DS5, G, bx); S.A = (const char*)(ws + WS_YS5G); S.B = (const char*)(ws + WS_GLUT); S.a_tile = (size_t)256 * 16 * 2; S.b_tile = (size_t)256 * DS5 * 2;
        EpiGlu E{(const bf16_t*)(ws + WS_YS5G), (bf16_t*)(dout + DO_YPRE), KIN[15]};
        GEMM_PHASE(lds, wave, GParm{DS5, 32, 4u * GM_STRIDE * 2u, 16, GM_STRIDE}, S, E);
        if (G == 256 && bx >= 128) {
            LAS float* scr = (LAS float*)(lds + wave * 16640); constexpr int I_FF1 = (DM / 64) * (DFF / 64);
            for (int it = (bx - 128) * 8 + wave; it < FF1_IN_P5; it += 1024) transpose_item(KIN[29], DM, DFF, (bf16_t*)(ws + WS_FF1T), scr, it, lane); }
    }
    if (rep + 1 < REPS(5)) { ++nbar; xcd_barrier(xb, (unsigned)G, wave); } }
    SEAM(5);
    for (int rep = 0; rep < REPS(6); ++rep) {
    if (IN(6)) { PH_IDS;
        const float *g5 = KIN[23], *gr = KIN[24];
        for (int row = gw; row < SEQ; row += NGW) { const u32x4* yr = (const u32x4*)(dout + DO_YPRE) + (size_t)row * 256; u32x4* oc = (u32x4*)(ws + WS_YCAT) + (size_t)row * 256;
            u32x4 w[4]; float s0 = 0.f, s1 = 0.f;
#pragma unroll
            for (int j = 0; j < 4; ++j) { w[j] = __builtin_nontemporal_load(yr + lane + 64 * j); const float q = bf_lo(w[j].x) * bf_lo(w[j].x) + bf_hi(w[j].x) * bf_hi(w[j].x) + bf_lo(w[j].y) * bf_lo(w[j].y) + bf_hi(w[j].y) * bf_hi(w[j].y)
                + bf_lo(w[j].z) * bf_lo(w[j].z) + bf_hi(w[j].z) * bf_hi(w[j].z) + bf_lo(w[j].w) * bf_lo(w[j].w) + bf_hi(w[j].w) * bf_hi(w[j].w); if (j < 2) s0 += q; else s1 += q; }
            const float r0 = 1.0f / sqrtf(wave_sum(s0) * (1.f / 1024.f) + LN_EPS), r1 = 1.0f / sqrtf(wave_sum(s1) * (1.f / 1024.f) + LN_EPS);
#pragma unroll
            for (int j = 0; j < 4; ++j) { const int col = (lane + 64 * j) * 8; const float rs = j < 2 ? r0 : r1; const float* gp = j < 2 ? g5 + col : gr + (col - 1024);
                const f32x4 ga = *(const f32x4*)gp, gb = *(const f32x4*)(gp + 4);
                u32x4 o; o.x = cvt_pk_bf16(bf_lo(w[j].x) * rs * ga[0], bf_hi(w[j].x) * rs * ga[1]); o.y = cvt_pk_bf16(bf_lo(w[j].y) * rs * ga[2], bf_hi(w[j].y) * rs * ga[3]);
                o.z = cvt_pk_bf16(bf_lo(w[j].z) * rs * gb[0], bf_hi(w[j].z) * rs * gb[1]); o.w = cvt_pk_bf16(bf_lo(w[j].w) * rs * gb[2], bf_hi(w[j].w) * rs * gb[3]); oc[lane + 64 * j] = o; } }
        {
            LAS float* scr = (LAS float*)(lds + wave * 16640);
            constexpr int I_FF1 = (DM / 64) * (DFF / 64), I_FF2 = (DFF / 64) * (DM / 64);
            const int ff1_lo = (G == 256) ? FF1_IN_P5 : 0;
            for (int it = gw; it < I_FF2 + (I_FF1 - ff1_lo); it += NGW) {
                if (it < I_FF2) transpose_item(KIN[31], DFF, DM, (bf16_t*)(ws + WS_FF2T), scr, it, lane);
                else transpose_item(KIN[29], DM, DFF, (bf16_t*)(ws + WS_FF1T), scr, ff1_lo + it - I_FF2, lane); }
        }
    }
    if (rep + 1 < REPS(6)) { ++nbar; xcd_barrier(xb, (unsigned)G, wave); } }
    SEAM(6);
    for (int rep = 0; rep < REPS(7); ++rep) {
    if (IN(7)) { PH_IDS;
        SchedStd S; S.so.init(SEQ, DM, G, bx); S.A = (const char*)(ws + WS_YCAT); S.B = (const char*)(ws + WS_WOUTT); S.a_tile = (size_t)256 * DM * 2; S.b_tile = (size_t)256 * DM * 2;
        EpiResLn1 E{(bf16_t*)(ws + WS_HB), KIN[26], KIN[27], KIN[28], PanelStats8{(unsigned long long*)(ws + WS_AGG), (unsigned*)(ws + WS_CTR) + 1024, LN_EPS}};
        GEMM_PHASE(lds, wave, GParm{DM, DM * 2, 128, 64, 0}, S, E);
    }
    if (rep + 1 < REPS(7)) { ++nbar; xcd_barrier(xb, (unsigned)G, wave); } }
    for (int rep = 0; rep < REPS(8); ++rep) {
    if (IN(8)) { }
    if (rep + 1 < REPS(8)) { ++nbar; xcd_barrier(xb, (unsigned)G, wave); } }
    SEAM(8);
    for (int rep = 0; rep < REPS(9); ++rep) {
    if (IN(9)) { PH_IDS;
        static_assert(WS_PLEGT == WS_FF1T + (size_t)DFF * DM * 2, "gate weights must follow the FF1 weights");
        { SchedStd S; S.so.init(SEQ, DFF + DM, G, bx); S.A = (const char*)(ws + WS_HB); S.B = (const char*)(ws + WS_FF1T); S.a_tile = (size_t)256 * DM * 2; S.b_tile = (size_t)256 * DM * 2;
          EpiFF1G E{(bf16_t*)(ws + WS_T), (bf16_t*)dout, KIN[30], KIN[35]}; GEMM_PHASE(lds, wave, GParm{DM, DM * 2, 128, 64, 0}, S, E); }
        { SchedStd S; S.so.init(SEQ, DM, G, bx); S.A = (const char*)(ws + WS_PB); S.B = (const char*)(ws + WS_PLEWT); S.a_tile = (size_t)256 * PLE * 2; S.b_tile = (size_t)256 * PLE * 2;
          EpiPlain<0> E{(bf16_t*)dout + ((size_t)1 << 19), DM, nullptr, (size_t)1 << 20}; GEMM_PHASE(lds, wave, GParm{PLE, PLE * 2, 128, 64, 0}, S, E); }
    }
    if (rep + 1 < REPS(9)) { ++nbar; xcd_barrier(xb, (unsigned)G, wave); } }
    SEAM(9);
    for (int rep = 0; rep < REPS(10); ++rep) {
    if (IN(10)) { PH_IDS;
        SchedStd S; S.so.init(SEQ, DM, G, bx); S.A = (const char*)(ws + WS_T); S.B = (const char*)(ws + WS_FF2T); S.a_tile = (size_t)256 * DFF * 2; S.b_tile = (size_t)256 * DFF * 2;
        EpiResLn2 E{(const bf16_t*)(ws + WS_HB), KIN[32], KIN[36], KIN[37], (float*)dout, (const bf16_t*)dout, PanelStats8{(unsigned long long*)(ws + WS_AGG) + 65536, (unsigned*)(ws + WS_CTR) + 1024 + 64 * 32, LN_EPS}};
        GEMM_PHASE(lds, wave, GParm{DFF, DFF * 2, 128, 64, 0}, S, E);
    }
    if (rep + 1 < REPS(10)) { ++nbar; xcd_barrier(xb, (unsigned)G, wave); } }
    for (int rep = 0; rep < REPS(11); ++rep) {
    if (IN(11)) { }
    if (rep + 1 < REPS(11)) { ++nbar; xcd_barrier(xb, (unsigned)G, wave); } }
#ifdef EXTRA_BARRIERS
    for (int eb = 0; eb < EXTRA_BARRIERS; ++eb) { ++nbar; xcd_barrier(xb, (unsigned)G, wave); }
#endif
#if TSTAMP
    if (bx == 0 && wave == 0) { if (fresh_lane() == 0) { unsigned long long* st = (unsigned long long*)(ws + WS_CTR + 1024); st[12] = __builtin_amdgcn_s_memrealtime();
        ((float*)KIN[38])[0] = 8.0f * floorf((float)(long long)(__hip_atomic_load(st + TS_A1, __ATOMIC_RELAXED, __HIP_MEMORY_SCOPE_AGENT) - __hip_atomic_load(st + TS_A0, __ATOMIC_RELAXED, __HIP_MEMORY_SCOPE_AGENT)) * 0.00125f + 0.5f); } }
#endif
#if DIAG
    { ++nbar; xcd_barrier(xb, (unsigned)G, wave); PH_IDS; unsigned* flagw = (unsigned*)(ws + WS_CTR) + 48;
#if DIAG == 1
      diag_ffn((const float* const*)0, ws, ((float*)KIN[38]), flagw, gtid, GT);
#elif DIAG == 2
      diag_pre((const float* const*)0, ws, dout, flagw, gtid, GT);
#elif DIAG == 3
      diag_v((const float* const*)0, ws, dout, flagw, gtid, GT);
#elif DIAG == 4
      diag_g((const float* const*)0, ws, flagw, gtid, GT);
#elif DIAG == 6
      diag_max(ws, flagw, gtid, GT);
#else
      if (bx == 0 && tid == 0) flagw[1] = 0xffffffffu;
      ++nbar; xcd_barrier(xb, (unsigned)G, wave);
#if DIAG == 7
      diag_rows(((float*)KIN[38]), flagw, gw, NGW, lane);
#elif DIAG == 8
      diag_rows_bf((const bf16_t*)(ws + WS_HB), DM, 12.0f, flagw, gw, NGW, lane);
#elif DIAG == 9
      diag_rows((const float*)(ws + WS_V2), flagw, gw, NGW, lane);
#elif DIAG == 10
      diag_rows_bf((const bf16_t*)(ws + WS_T), DFF, 150.0f, flagw, gw, NGW, lane);
#elif DIAG == 11
      diag_rows_bf((const bf16_t*)(dout + DO_PW), DM, 8.0f, flagw, gw, NGW, lane);
#elif DIAG == 12
      diag_rows_bf((const bf16_t*)(dout + DO_SG), DM, 1.01f, flagw, gw, NGW, lane);
#endif
#endif
      ++nbar; xcd_barrier(xb, (unsigned)G, wave);
#if DIAG != 1
      for (int i = gtid; i < SEQ * DM; i += GT) ((float*)KIN[38])[i] = 0.f;
      ++nbar; xcd_barrier(xb, (unsigned)G, wave);
#endif
      if (bx == 0 && tid == 0) { unsigned code = 0; for (int q = 0; q < 4; ++q) if (__hip_atomic_load(flagw + q, __ATOMIC_RELAXED, __HIP_MEMORY_SCOPE_AGENT) > 100u) code |= 1u << q; if (DIAG >= 7) { const unsigned cnt = __hip_atomic_load(flagw, __ATOMIC_RELAXED, __HIP_MEMORY_SCOPE_AGENT), mn = __hip_atomic_load(flagw + 1, __ATOMIC_RELAXED, __HIP_MEMORY_SCOPE_AGENT), mxr = __hip_atomic_load(flagw + 2, __ATOMIC_RELAXED, __HIP_MEMORY_SCOPE_AGENT);
          const unsigned v = DIAG_SEL == 0 ? cnt : DIAG_SEL == 1 ? mn / 100u : DIAG_SEL == 2 ? mn % 100u : DIAG_SEL == 3 ? mxr / 100u : mxr % 100u; ((float*)KIN[38])[0] = 100.0f * (float)(v + 1u); }
      else ((float*)KIN[38])[0] = (DIAG == 6) ? 1000.0f * __uint_as_float(__hip_atomic_load(flagw, __ATOMIC_RELAXED, __HIP_MEMORY_SCOPE_AGENT)) : 1000.0f * (float)(code + 16u); } }
#endif
#undef IN
#undef SEAM
}


#if PER_PHASE_LAUNCH
template <int PH> static void set_attr_one() { (void)hipFuncSetAttribute((const void*)mega<(1 << PH)>, hipFuncAttributeMaxDynamicSharedMemorySize, LDS_BYTES); }
template <int PH> static void launch_one(Args a, int grid, hipStream_t stream) { a.ph_lo = PH; a.ph_hi = PH + 1; hipLaunchKernelGGL(mega<(1 << PH)>, dim3(grid), dim3(512), LDS_BYTES, stream, a); }
static void set_attrs() { set_attr_one<0>(); set_attr_one<1>(); set_attr_one<2>(); set_attr_one<3>(); set_attr_one<4>(); set_attr_one<5>(); set_attr_one<6>(); set_attr_one<7>(); set_attr_one<8>(); set_attr_one<9>(); set_attr_one<10>(); set_attr_one<11>(); }
static void launch_phases(const Args& a, int grid, hipStream_t stream) { launch_one<0>(a, grid, stream); launch_one<1>(a, grid, stream); launch_one<2>(a, grid, stream); launch_one<3>(a, grid, stream); launch_one<4>(a, grid, stream); launch_one<5>(a, grid, stream);
    launch_one<6>(a, grid, stream); launch_one<7>(a, grid, stream); launch_one<8>(a, grid, stream); launch_one<9>(a, grid, stream); launch_one<10>(a, grid, stream); launch_one<11>(a, grid, stream); }
#else
static void set_attrs() { (void)hipFuncSetAttribute((const void*)mega<0xfff>, hipFuncAttributeMaxDynamicSharedMemorySize, LDS_BYTES); }
#endif

extern "C" void kernel_launch(void* const* d_in, const int* in_sizes, int n_in, void* d_out, int out_size, void* d_ws, size_t ws_size, hipStream_t stream) {
    static int grid = 0;
    if (grid == 0) {
        if (n_in != 38 || out_size != SEQ * DM || ws_size < WS_END) { fprintf(stderr, "kernel_launch: unexpected shapes (n_in %d out %d ws %zu)\n", n_in, out_size, ws_size); grid = -1; return; }
        int dev = 0, cus = 0, per_cu = 0;
        hipGetDevice(&dev); hipDeviceGetAttribute(&cus, hipDeviceAttributeMultiprocessorCount, dev);
        set_attrs();
        per_cu = 1;
        (void)hipGetLastError();
        if (per_cu < 1) per_cu = 1;
        grid = cus;
    }
    if (grid < 0) return;
#ifdef POISON_NAN
    hipMemsetAsync(d_ws, 0xFF, WS_END, stream); hipMemsetAsync(d_out, 0xFF, (size_t)64 * MiB, stream);
#endif
    hipMemsetAsync((char*)d_ws + WS_CTR, 0, 40960, stream);
    Args a{};
    for (int i = 0; i < 38; ++i) a.in[i] = (const float*)d_in[i];
    a.out = (float*)d_out; a.ws = (unsigned char*)d_ws;
#if PER_PHASE_LAUNCH
    launch_phases(a, grid, stream);
#else
    a.ph_lo = 0; a.ph_hi = NPHASE;
    void* kargs[] = {&a};
    hipError_t e = hipLaunchCooperativeKernel((const void*)mega<0xfff>, dim3(grid), dim3(512), kargs, LDS_BYTES, stream);
    if (e != hipSuccess) fprintf(stderr, "cooperative launch failed: %s (grid %d)\n", hipGetErrorString(e), grid);
#endif
}
```
